# Optimizing an MI355X kernel written in HIP

```python
import math
import jax, jax.numpy as jnp
from jax import lax
import numpy as np

D_MODEL = 1024
BATCH = 8
SEQ = 4096
DEPTH = 1

RWKV_WIDTH = D_MODEL // 2
RWKV_HEAD = 64
RWKV_HEADS = RWKV_WIDTH // RWKV_HEAD
DECAY_RANK = 64
AAA_RANK = 64
GATE_RANK = 128
RWKV_SPLITS = (RWKV_WIDTH, 2 * RWKV_WIDTH, 3 * RWKV_WIDTH,
               3 * RWKV_WIDTH + DECAY_RANK, 3 * RWKV_WIDTH + DECAY_RANK + AAA_RANK)
N_RWKV_COLS = 3 * RWKV_WIDTH + DECAY_RANK + AAA_RANK + GATE_RANK
LNX_EPS = 64e-5
S5_WIDTH = D_MODEL // 2
S5_GROUP = 16
S5_GROUPS = S5_WIDTH // S5_GROUP
S5_STATE = 64
STEP_MIN = 1e-3
STEP_MAX = 1e-1
N_IN_COLS = N_RWKV_COLS + S5_WIDTH + 2 * D_MODEL
D_FF = 256 * ((8 * D_MODEL // 3 + 255) // 256)
CONV_WIDTH = 3
NORM_EPS = 1e-6

kernel_name = 'hybrid_rwkv7_s5_gated_merge_convffn'


def rms_norm(x, g):
    xf = x.astype(jnp.float32)
    y = xf * lax.rsqrt(jnp.mean(xf * xf, axis=-1, keepdims=True) + NORM_EPS)
    return y.astype(x.dtype) * g


def token_shift(p, mu):
    prev = jnp.pad(p, ((0, 0), (1, 0), (0, 0)))[:, :-1]
    return p + (prev - p) * mu


def wkv7_scan(r, decay, k, v, a_vec, b_vec):
    bsz, _, nh, n = r.shape

    def step(S, inp):
        r_t, w_t, k_t, v_t, a_t, b_t = inp
        sa = jnp.einsum('bhij,bhj->bhi', S, a_t)
        S = (S * w_t[:, :, None, :] + sa[..., None] * b_t[:, :, None, :]
             + v_t[..., None] * k_t[:, :, None, :])
        return S, jnp.einsum('bhij,bhj->bhi', S, r_t)

    xs = tuple(jnp.moveaxis(t, 1, 0) for t in (r, decay, k, v, a_vec, b_vec))
    S0 = jnp.zeros((bsz, nh, n, n), jnp.float32)
    _, ys = lax.scan(step, S0, xs)
    return jnp.moveaxis(ys, 0, 1)


def rwkv7_branch(p, mu, w0, w2, a0, a2, g2, k_k, k_a, r_k, lnx_w, lnx_b):
    dtype = p.dtype
    f32 = jnp.float32
    bsz, L, _ = p.shape
    p = token_shift(p.astype(f32), mu.astype(f32))
    r, k, v, wd, ad, gd = jnp.split(p, RWKV_SPLITS, axis=-1)
    w = -jax.nn.softplus(-(w0 + jnp.tanh(wd) @ w2)) - 0.5
    decay = jnp.exp(-jnp.exp(w))
    a = jax.nn.sigmoid(a0 + ad @ a2)
    g = jax.nn.sigmoid(gd) @ g2
    hs = (bsz, L, RWKV_HEADS, RWKV_HEAD)
    kk = (k * k_k).reshape(hs)
    kk = kk / jnp.maximum(jnp.linalg.norm(kk, axis=-1, keepdims=True), 1e-12)
    k = k * (1.0 + (a - 1.0) * k_a)
    rh, kh, vh = r.reshape(hs), k.reshape(hs), v.reshape(hs)
    ah = a.reshape(hs)
    y = wkv7_scan(rh, decay.reshape(hs), kh, vh, -kk, kk * ah)
    mean = jnp.mean(y, axis=-1, keepdims=True)
    var = jnp.mean(jnp.square(y - mean), axis=-1, keepdims=True)
    y = ((y - mean) * lax.rsqrt(var + LNX_EPS)).reshape(bsz, L, RWKV_WIDTH) * lnx_w + lnx_b
    bonus = jnp.sum(rh * kh * r_k, axis=-1, keepdims=True) * vh
    y = (y + bonus.reshape(bsz, L, RWKV_WIDTH)) * g
    return y.astype(dtype)


def s5_combine(left, right):
    a_i, b_i = left
    a_j, b_j = right
    return a_j * a_i, a_j * b_i + b_j


def s5_branch(u, a_re, a_im, b_re, b_im, c_re, c_im, d, log_step, w_glu, b_glu):
    f32 = jnp.float32
    bsz, L, _ = u.shape
    lam = lax.complex(a_re.astype(f32), a_im.astype(f32))
    dt = jnp.exp(log_step.astype(f32))[:, None]
    a_bar = jnp.exp(lam * dt)
    b_bar = ((a_bar - 1.0) / lam)[..., None] * lax.complex(b_re.astype(f32), b_im.astype(f32))
    c = lax.complex(c_re.astype(f32), c_im.astype(f32))
    ug = u.astype(f32).reshape(bsz, L, S5_GROUPS, S5_GROUP)
    bu = jnp.einsum('gpc,blgc->blgp', b_bar, ug.astype(jnp.complex64))
    a_elems = jnp.broadcast_to(a_bar, (1, L, S5_GROUPS, S5_STATE))
    _, states = lax.associative_scan(s5_combine, (a_elems, bu), axis=1)
    y = jnp.real(jnp.einsum('gcp,blgp->blgc', c, states)) + d.astype(f32).reshape(S5_GROUPS, S5_GROUP) * ug
    y = jax.nn.gelu(y.reshape(bsz, L, S5_WIDTH)).astype(u.dtype)
    return y * jax.nn.sigmoid(y @ w_glu + b_glu)


def conv_ffn(h, w_up, conv_w, conv_b, w_down):
    L = h.shape[1]
    z = h @ w_up
    zp = jnp.pad(z, ((0, 0), (CONV_WIDTH - 1, 0), (0, 0)))
    z = conv_b + sum(conv_w[j] * zp[:, j:j + L] for j in range(CONV_WIDTH))
    gate, val = jnp.split(z, 2, axis=-1)
    return (jax.nn.gelu(gate) * val) @ w_down


def setup_inputs(seed: int = 0) -> dict:
    key = jax.random.key(seed)
    ks = jax.random.split(key, 40)
    f32 = jnp.float32
    Ld, W, G, P, C, F = DEPTH, RWKV_WIDTH, S5_GROUPS, S5_STATE, S5_GROUP, D_FF

    def nrm(k, shape, scale):
        return jax.random.normal(k, shape, f32) * scale

    def gain(k, shape):
        return 1.0 + 0.05 * jax.random.normal(k, shape, f32)

    n = jnp.arange(P, dtype=f32)
    return {
        'x': nrm(ks[0], (BATCH, SEQ, D_MODEL), 1.0),
        'norm_mix_pre': gain(ks[1], (Ld, D_MODEL)),
        'norm_mix_post': gain(ks[2], (Ld, D_MODEL)),
        'norm_ffn_pre': gain(ks[3], (Ld, D_MODEL)),
        'norm_ffn_post': gain(ks[4], (Ld, D_MODEL)),
        'w_in': nrm(ks[5], (Ld, D_MODEL, N_IN_COLS), D_MODEL ** -0.5),
        'b_gate': nrm(ks[6], (Ld, 2 * D_MODEL), 0.02),
        'rwkv_shift_mu': jax.random.uniform(ks[7], (Ld, N_RWKV_COLS), f32, 0.0, 1.0),
        'rwkv_w0': jax.random.uniform(ks[8], (Ld, W), f32, -6.0, -1.0),
        'rwkv_w2': nrm(ks[9], (Ld, DECAY_RANK, W), 0.1 * DECAY_RANK ** -0.5),
        'rwkv_a0': nrm(ks[10], (Ld, W), 0.1),
        'rwkv_a2': nrm(ks[11], (Ld, AAA_RANK, W), 0.1 * AAA_RANK ** -0.5),
        'rwkv_g2': nrm(ks[12], (Ld, GATE_RANK, W), GATE_RANK ** -0.5),
        'rwkv_k_k': 0.85 + 0.05 * jax.random.normal(ks[13], (Ld, W), f32),
        'rwkv_k_a': gain(ks[14], (Ld, W)),
        'rwkv_r_k': nrm(ks[15], (Ld, RWKV_HEADS, RWKV_HEAD), 0.3),
        'rwkv_lnx_w': gain(ks[16], (Ld, W)),
        'rwkv_lnx_b': nrm(ks[17], (Ld, W), 0.02),
        's5_a_re': -0.5 + 0.01 * jax.random.normal(ks[18], (Ld, G, P), f32),
        's5_a_im': math.pi * n + 0.01 * jax.random.normal(ks[19], (Ld, G, P), f32),
        's5_b_re': nrm(ks[20], (Ld, G, P, C), (2 * C) ** -0.5),
        's5_b_im': nrm(ks[21], (Ld, G, P, C), (2 * C) ** -0.5),
        's5_c_re': nrm(ks[22], (Ld, G, C, P), P ** -0.5),
        's5_c_im': nrm(ks[23], (Ld, G, C, P), P ** -0.5),
        's5_d': nrm(ks[24], (Ld, S5_WIDTH), 1.0),
        's5_log_step': jax.random.uniform(ks[25], (Ld, G), f32, math.log(STEP_MIN), math.log(STEP_MAX)),
        's5_w_glu': nrm(ks[26], (Ld, S5_WIDTH, S5_WIDTH), S5_WIDTH ** -0.5),
        's5_b_glu': nrm(ks[27], (Ld, S5_WIDTH), 0.02),
        'w_branch_rwkv': nrm(ks[28], (Ld, W, D_MODEL), W ** -0.5),
        'w_branch_s5': nrm(ks[29], (Ld, S5_WIDTH, D_MODEL), S5_WIDTH ** -0.5),
        'w_out': nrm(ks[30], (Ld, D_MODEL, D_MODEL), D_MODEL ** -0.5),
        'ffn_w_up': nrm(ks[31], (Ld, D_MODEL, 2 * F), D_MODEL ** -0.5),
        'ffn_conv_w': nrm(ks[32], (Ld, CONV_WIDTH, 2 * F), CONV_WIDTH ** -0.5),
        'ffn_conv_b': nrm(ks[33], (Ld, 2 * F), 0.02),
        'ffn_w_down': nrm(ks[34], (Ld, F, D_MODEL), F ** -0.5),
    }


def reference(x, norm_mix_pre, norm_mix_post, norm_ffn_pre, norm_ffn_post, w_in, b_gate,
              rwkv_shift_mu, rwkv_w0, rwkv_w2, rwkv_a0, rwkv_a2, rwkv_g2, rwkv_k_k, rwkv_k_a,
              rwkv_r_k, rwkv_lnx_w, rwkv_lnx_b, s5_a_re, s5_a_im, s5_b_re, s5_b_im, s5_c_re,
              s5_c_im, s5_d, s5_log_step, s5_w_glu, s5_b_glu, w_branch_rwkv, w_branch_s5, w_out,
              ffn_w_up, ffn_conv_w, ffn_conv_b, ffn_w_down):
    for l in range(DEPTH):
        h = rms_norm(x, norm_mix_pre[l])
        proj = h @ w_in[l]
        p_rwkv = proj[..., :N_RWKV_COLS]
        u_s5 = proj[..., N_RWKV_COLS:N_RWKV_COLS + S5_WIDTH]
        gates = jax.nn.sigmoid(proj[..., N_RWKV_COLS + S5_WIDTH:] + b_gate[l])
        g_rwkv, g_s5 = jnp.split(gates, 2, axis=-1)
        o_rwkv = rwkv7_branch(p_rwkv, rwkv_shift_mu[l], rwkv_w0[l], rwkv_w2[l], rwkv_a0[l],
                              rwkv_a2[l], rwkv_g2[l], rwkv_k_k[l], rwkv_k_a[l], rwkv_r_k[l],
                              rwkv_lnx_w[l], rwkv_lnx_b[l]) @ w_branch_rwkv[l]
        o_s5 = s5_branch(u_s5, s5_a_re[l], s5_a_im[l], s5_b_re[l], s5_b_im[l], s5_c_re[l],
                         s5_c_im[l], s5_d[l], s5_log_step[l], s5_w_glu[l], s5_b_glu[l]) @ w_branch_s5[l]
        mixed = (g_rwkv * o_rwkv + g_s5 * o_s5) @ w_out[l]
        x = x + rms_norm(mixed, norm_mix_post[l])
        h = rms_norm(x, norm_ffn_pre[l])
        f = conv_ffn(h, ffn_w_up[l], ffn_conv_w[l], ffn_conv_b[l], ffn_w_down[l])
        x = x + rms_norm(f, norm_ffn_post[l])
    return x
```

```cpp
#include <hip/hip_runtime.h>
#include <cstdio>
#include <cstdint>

#define LAS __attribute__((address_space(3)))
#define GAS __attribute__((address_space(1)))
typedef unsigned short bf16_t;
typedef short bf16x8 __attribute__((ext_vector_type(8)));
typedef float f32x4 __attribute__((ext_vector_type(4)));
typedef float f32x2 __attribute__((ext_vector_type(2)));
typedef unsigned u32x4 __attribute__((ext_vector_type(4)));
typedef unsigned u32x2 __attribute__((ext_vector_type(2)));
typedef GAS unsigned gu32;

constexpr int T = 32768, SEQ = 4096, NB = 8, D = 1024, NIN = 4352, NRW = 1792, RW = 512, FF = 2816, FH = 1408;
constexpr int NHEAD = 8, HD = 64, NCH = 64  , NUNIT = NB * NHEAD * NCH;
constexpr int S5G = 32, S5ROWS = T / 16, UGLD = 384;

constexpr size_t MiB = 1u << 20;
constexpr size_t WS_CTL = 0, CTL_ZERO_BYTES = 1 * MiB;
constexpr size_t WS_WIN = 1 * MiB;
constexpr size_t WS_WUP = WS_WIN + (size_t)NIN * D * 2;
constexpr size_t WS_WDN = WS_WUP + (size_t)2 * FF * D * 2;
constexpr size_t WS_WOUT = WS_WDN + (size_t)D * FF * 2;
constexpr size_t WS_WBRS = WS_WOUT + (size_t)D * D * 2;
constexpr size_t WS_WGLU = WS_WBRS + (size_t)D * D * 2;
constexpr size_t WS_W2T = WS_WGLU + (size_t)RW * RW * 2;
constexpr size_t WS_A2T = WS_W2T + (size_t)RW * 64 * 2;
constexpr size_t WS_G2T = WS_A2T + (size_t)RW * 64 * 2;
constexpr size_t WS_B1A = WS_G2T + (size_t)RW * 128 * 2;
constexpr size_t WS_B1B = WS_B1A + (size_t)S5G * 256 * 256 * 2;
constexpr size_t WS_AL = WS_B1B + (size_t)S5G * 256 * 384 * 2;
constexpr size_t WS_WEND = WS_AL + (size_t)S5G * 64 * 2 * 4;
static_assert(WS_WEND <= 44 * MiB, "weights region");
constexpr size_t WS_XN = 44 * MiB;
constexpr size_t WS_QRT = 44 * MiB, WS_WYT = 76 * MiB;
constexpr size_t WS_MERGED = 44 * MiB, WS_H2 = 44 * MiB, WS_F = 44 * MiB;
constexpr size_t WS_PR = 108 * MiB;
constexpr size_t WS_MIXED = 304 * MiB, WS_STAT1 = 368 * MiB;
constexpr size_t WS_ACT = 108 * MiB;
constexpr size_t WS_STAT2 = 284 * MiB;
constexpr size_t WS_UG = 220 * MiB;
constexpr size_t WS_GATES = 268 * MiB;
constexpr size_t WS_SLOC = 396 * MiB, WS_YSP = 396 * MiB;
constexpr size_t WS_GBUF = 428 * MiB;
constexpr size_t WS_BONUS = 460 * MiB;
constexpr size_t WS_VT = 461 * MiB;
constexpr size_t WS_LRSCR = 493 * MiB;
constexpr size_t WS_Z = 336 * MiB;
constexpr size_t WS_END = 512 * MiB;
constexpr size_t DO_H = 0, DO_GT = 36 * MiB, DO_SST = 96 * MiB, DO_YRS = 0;
constexpr int GLD = 72;

constexpr int CW_BAR = 4096, CW_HF = 32768;
constexpr size_t WS_HZ = 290 * MiB, HZ_BYTES = (size_t)2816 * 4 * 2 * 32 * 8;

constexpr int RING_BYTES = 131072, LDSCTL_OFF = RING_BYTES, MISC_OFF = LDSCTL_OFF + 320, XTRA_OFF = LDSCTL_OFF + 1024, LDS_BYTES = 155648;
constexpr int NWAVES = 8;

#define RLX_AGENT __ATOMIC_RELAXED, __HIP_MEMORY_SCOPE_AGENT
#define LDS_WAIT() asm volatile("s_waitcnt lgkmcnt(0)" ::: "memory")
#define VM_WAIT() asm volatile("s_waitcnt vmcnt(0)" ::: "memory")

typedef __bf16 bf16x2_t __attribute__((ext_vector_type(2)));
__device__ __forceinline__ unsigned cvt_pk_bf16(float lo, float hi) { const f32x2 v = {lo, hi}; return __builtin_bit_cast(unsigned, __builtin_convertvector(v, bf16x2_t)); }
__device__ __forceinline__ float bf_lo(unsigned w) { return __uint_as_float(w << 16); }
__device__ __forceinline__ float bf_hi(unsigned w) { return __uint_as_float(w & 0xffff0000u); }
__device__ __forceinline__ float bf1(bf16_t h) { return __uint_as_float((unsigned)h << 16); }
__device__ __forceinline__ float fexp(float x) { return __builtin_amdgcn_exp2f(x * 1.44269504089f); }
__device__ __forceinline__ float fsigmoid(float x) { return __builtin_amdgcn_rcpf(1.0f + __builtin_amdgcn_exp2f(-1.44269504089f * x)); }
__device__ __forceinline__ float ftanh(float x) { return 1.0f - 2.0f * __builtin_amdgcn_rcpf(1.0f + __builtin_amdgcn_exp2f(2.88539008178f * x)); }
__device__ __forceinline__ float fgelu(float x) { const float u = 0.7978845608f * (x + 0.044715f * x * x * x); return x * fsigmoid(2.0f * u); }
__device__ __forceinline__ void unpack8(u32x4 w, float (&f)[8]) { f[0] = bf_lo(w.x); f[1] = bf_hi(w.x); f[2] = bf_lo(w.y); f[3] = bf_hi(w.y); f[4] = bf_lo(w.z); f[5] = bf_hi(w.z); f[6] = bf_lo(w.w); f[7] = bf_hi(w.w); }
__device__ __forceinline__ u32x4 pack8(const float (&f)[8]) { u32x4 w; w.x = cvt_pk_bf16(f[0], f[1]); w.y = cvt_pk_bf16(f[2], f[3]); w.z = cvt_pk_bf16(f[4], f[5]); w.w = cvt_pk_bf16(f[6], f[7]); return w; }
__device__ __forceinline__ float wave_sum(float v) {
#pragma unroll
    for (int o = 1; o < 64; o <<= 1) v += __shfl_xor(v, o);
    return v;
}

#define XB_TMO      128
#define XB_XCNT(j)  (256  + 64 * (j))
#define XB_XSUB(j)  (1280 + 64 * (j))
#define XB_XGEN(j)  (2304 + 64 * (j))
#define XB_TOP      3328
#define XB_TOPGEN   3392
#define XCD_BAR_WORDS 3456
#define XB_SPIN_CAP (1u << 18)
__device__ __forceinline__ unsigned xb_ld(unsigned* p)              { return __hip_atomic_load(p, __ATOMIC_RELAXED, __HIP_MEMORY_SCOPE_AGENT); }
__device__ __forceinline__ unsigned xb_add(unsigned* p, unsigned v) { return __hip_atomic_fetch_add(p, v, __ATOMIC_RELAXED, __HIP_MEMORY_SCOPE_AGENT); }
__device__ __forceinline__ unsigned xb_xcc_id() { return (unsigned)__builtin_amdgcn_s_getreg((3 << 11) | 20) & 0xFu; }
#define XB_SPIN(cond, bar) do { unsigned _sp = 0; while (cond) { __builtin_amdgcn_s_sleep(1); \
    if ((++_sp & 255u) == 0u) { if (xb_ld(&(bar)[XB_TMO])) break; if (_sp > XB_SPIN_CAP) { atomicAdd(&(bar)[XB_TMO], 1u); break; } } } } while (0)
struct XcdBarrier { unsigned* bar; unsigned x; volatile LAS unsigned* st; };
__device__ __forceinline__ XcdBarrier xcd_barrier_post(unsigned* bar, volatile LAS unsigned* st) {
    XcdBarrier b; b.bar = bar; b.x = xb_xcc_id(); b.st = st;
    if (threadIdx.x == 0) (void)xb_add(&bar[XB_XCNT(b.x)], 1u);
    return b;
}
__device__ __forceinline__ void xcd_barrier_complete(unsigned* bar, unsigned x, unsigned& nloc, unsigned& nx) {
    const unsigned G = gridDim.x * gridDim.y * gridDim.z;
    unsigned sum, cnt, mine, sp = 0u;
    for (;;) {
        sum = 0u; cnt = 0u; mine = 0u;
#pragma unroll
        for (unsigned j = 0; j < 16; ++j) { const unsigned c = xb_ld(&bar[XB_XCNT(j)]); sum += c; cnt += (c > 0u) ? 1u : 0u; mine = (j == x) ? c : mine; }
        if (sum == G) break;
        __builtin_amdgcn_s_sleep(1);
        if ((++sp & 255u) == 0u) { if (xb_ld(&bar[XB_TMO])) break; if (sp > XB_SPIN_CAP) { atomicAdd(&bar[XB_TMO], 1u); break; } }
    }
    nloc = mine > 0u ? mine : 1u; nx = cnt > 0u ? cnt : 1u;
}
__device__ __forceinline__ void xcd_barrier(const XcdBarrier& b) {
    asm volatile("s_waitcnt vmcnt(0)" ::: "memory");
    __syncthreads();
    if (threadIdx.x == 0) {
        unsigned* bar = b.bar;
        __builtin_amdgcn_s_waitcnt(0);
        unsigned nloc = b.st[0], nx = b.st[1];
        if (nloc == 0u) { xcd_barrier_complete(bar, b.x, nloc, nx); b.st[0] = nloc; b.st[1] = nx; }
        const unsigned old = xb_add(&bar[XB_XSUB(b.x)], 1u);
        const unsigned gen = old / nloc;
        if (old + 1u == (gen + 1u) * nloc) {
            __builtin_amdgcn_fence(__ATOMIC_RELEASE, "agent");
            asm volatile("s_waitcnt vmcnt(0)" ::: "memory");
            const unsigned og = xb_add(&bar[XB_TOP], 1u);
            const unsigned tg = og / nx;
            if (og + 1u == (tg + 1u) * nx) xb_add(&bar[XB_TOPGEN], 1u);
            else XB_SPIN(xb_ld(&bar[XB_TOPGEN]) == tg, bar);
            __builtin_amdgcn_fence(__ATOMIC_ACQUIRE, "agent");
            xb_add(&bar[XB_XGEN(b.x)], 1u);
            asm volatile("s_waitcnt vmcnt(0)" ::: "memory");
        } else {
            XB_SPIN(xb_ld(&bar[XB_XGEN(b.x)]) == gen, bar);
            __builtin_amdgcn_fence(__ATOMIC_ACQUIRE, "agent");
            asm volatile("s_waitcnt vmcnt(0)" ::: "memory");
        }
    }
    __syncthreads();
}

namespace pg8 {
constexpr int BM = 256, BK = 64, HALF = 128, HTB = HALF * BK * 2, STAGE_BYTES = 8 * HTB, NXCD = 8, WGM = 8;
__host__ __device__ __forceinline__ int lds_byte(int r, int c) { const int st = (r >> 4) * 2 + (c >> 5), rr = r & 15, cc = c & 31, ob = rr * 64 + cc * 2; return st * 1024 + (ob ^ (((ob >> 9) & 1) << 5)); }
__host__ __device__ __forceinline__ void stage_rc(int b, int& R, int& C) { const int st = b / 1024, sb = b % 1024, swz = sb ^ (((sb >> 9) & 1) << 5); R = (st >> 1) * 16 + swz / 64; C = (st & 1) * 32 + (swz % 64) / 2; }
__host__ __device__ __forceinline__ int perm32(int rho) { const int n = rho >> 4, i = rho & 15; return 8 * (i >> 2) + 4 * n + (i & 3); }

struct Unit { const char* a; const char* b; int pm, pn; };
struct Gemm { int K, lda, ldb, amode; };

struct StaticOrder {
    const bf16_t* A; const bf16_t* Bt; int lda, ldb;
    int nM, nN, nwg, G, c; size_t tstepA;
    __device__ void init(const bf16_t* A_, const bf16_t* Bt_, int lda_, int ldb_, int M, int N, int G_, int c_) { A = A_; Bt = Bt_; lda = lda_; ldb = ldb_; nM = M / BM; nN = N / BM; nwg = nM * nN; G = G_; c = c_; tstepA = (size_t)BM * lda * 2; }
    __device__ bool next(int i, Unit& u) const {
        const long L = (long)i * G + c; if (L >= nwg) return false;
        int wgid = (int)L; { const int q = nwg / NXCD, r = nwg % NXCD, xcd = wgid % NXCD, off = wgid / NXCD; wgid = (xcd < r ? xcd * (q + 1) : r * (q + 1) + (xcd - r) * q) + off; }
        const int nig = WGM * nN, gid = wgid / nig, fm = gid * WGM, gsz = (nM - fm) < WGM ? (nM - fm) : WGM;
        u.pm = fm + ((wgid % nig) % gsz); u.pn = (wgid % nig) / gsz;
        u.a = (const char*)A + (size_t)u.pm * tstepA; u.b = (const char*)Bt + (size_t)u.pn * BM * ldb * 2; return true;
    }
};

template <class Epi, class Sched, bool ALIGN_EPI = false, bool SP2 = true>
__device__ __forceinline__ void gemm_phase(LAS unsigned char* lds, const Gemm g, const Sched& S, const Epi& E, const int tid) {
    const int wid = __builtin_amdgcn_readfirstlane(tid >> 6), lane = tid & 63, wr = wid >> 2, wc = wid & 3, fr = lane & 15, fq = lane >> 4;
    const int K = g.K, nt = K / BK;
    unsigned voffA[2], voffB[2];
#pragma unroll
    for (int i = 0; i < 2; ++i) { int R, C; stage_rc(tid * 16 + i * 8192, R, C); const int Rb = Epi::PERM ? ((R & ~31) + perm32(R & 31)) : R;
        voffA[i] = g.amode ? (unsigned)((((C >> 4) * S5ROWS + (R >> 4)) * 256 + (R & 15) * 16 + (C & 15)) * 2) : (unsigned)(R * g.lda + C) * 2u; voffB[i] = (unsigned)(Rb * g.ldb + C) * 2u; }
    const size_t kstepB = (size_t)(BK * 2), kstepA = g.amode ? (size_t)4 * S5ROWS * 256 * 2 : (size_t)(BK * 2);
    const size_t hstepA = g.amode ? (size_t)8 * 256 * 2 : (size_t)HALF * g.lda * 2, hstepB = (size_t)HALF * g.ldb * 2;
    const unsigned ldsw = (unsigned)wid * 1024u;
    const int aoff = lds_byte(wr * 64 + fr, fq * 8), boff = lds_byte(wc * 32 + fr, fq * 8);
#define PG8_SA(b, h) (((b) * 2 + (h)) * HTB)
#define PG8_SB(b, h) ((4 + (b) * 2 + (h)) * HTB)
#define PG8_STAGE(bufoff, gbase, voff) do { _Pragma("unroll") for (int _i = 0; _i < 2; ++_i) \
        __builtin_amdgcn_global_load_lds((const unsigned*)((const char*)(gbase) + (voff)[_i]), (LAS unsigned*)(lds + (bufoff) + ldsw + _i * 8192), 16, 0, 0); } while (0)
#define PG8_LDA(dst, b, h) do { _Pragma("unroll") for (int m = 0; m < 4; ++m) _Pragma("unroll") for (int k = 0; k < 2; ++k) dst[m][k] = *(const LAS bf16x8*)(lds + PG8_SA(b, h) + aoff + m * 2048 + k * 1024); } while (0)
#define PG8_LDB(dst, b, h) do { _Pragma("unroll") for (int n = 0; n < 2; ++n) _Pragma("unroll") for (int k = 0; k < 2; ++k) dst[n][k] = *(const LAS bf16x8*)(lds + PG8_SB(b, h) + boff + n * 2048 + k * 1024); } while (0)
#define PG8_MMA(ai, bj, At, Bt) do { __builtin_amdgcn_s_setprio(1); _Pragma("unroll") for (int m = 0; m < 4; ++m) _Pragma("unroll") for (int n = 0; n < 2; ++n) _Pragma("unroll") for (int k = 0; k < 2; ++k) \
        acc[ai][bj][m][n] = __builtin_amdgcn_mfma_f32_16x16x32_bf16(Bt[n][k], At[m][k], acc[ai][bj][m][n], 0, 0, 0); __builtin_amdgcn_s_setprio(0); } while (0)
#define PG8_WAIT_V(n) asm volatile("s_waitcnt vmcnt(" #n ")" ::: "memory")
#define PG8_WAIT_L(n) asm volatile("s_waitcnt lgkmcnt(" #n ")" ::: "memory")
#define PG8_BAR __builtin_amdgcn_s_barrier()
#define PG8_SCHED __builtin_amdgcn_sched_barrier(0)
    Unit cur, nxt; int ui = 0;
    if (!S.next(0, cur)) return;
    f32x4 acc[2][2][4][2];
#pragma unroll
    for (int a = 0; a < 2; ++a)
#pragma unroll
        for (int b = 0; b < 2; ++b)
#pragma unroll
            for (int m = 0; m < 4; ++m)
#pragma unroll
                for (int n = 0; n < 2; ++n) acc[a][b][m][n] = (f32x4){0.f, 0.f, 0.f, 0.f};
    bf16x8 At[4][2], B0[2][2], B1[2][2];
    const char* cA = cur.a; const char* cB = cur.b;
    static_assert(SP2, "only the SP2 loop is kept");
    PG8_STAGE(PG8_SB(0, 0), cB, voffB); PG8_STAGE(PG8_SB(0, 1), cB + hstepB, voffB); PG8_STAGE(PG8_SA(0, 0), cA, voffA); PG8_STAGE(PG8_SA(0, 1), cA + hstepA, voffA);
    if (wr == 1) PG8_BAR;
    PG8_WAIT_V(2); PG8_BAR;
    PG8_STAGE(PG8_SB(1, 0), cB + kstepB, voffB); PG8_STAGE(PG8_SA(1, 0), cA + kstepA, voffA); PG8_STAGE(PG8_SB(1, 1), cB + hstepB + kstepB, voffB);
    PG8_WAIT_V(6); PG8_BAR;
    for (;;) {
        const bool has_next = S.next(ui + 1, nxt);
        const char* nA = has_next ? nxt.a : cA; const char* nB = has_next ? nxt.b : cB;
#pragma unroll 1
        for (int t = 0; t < nt; t += 2) {
            const bool last = (t == nt - 2);
            const char* a1 = cA + (size_t)(t + 1) * kstepA;
            const char* a2 = last ? nA : cA + (size_t)(t + 2) * kstepA; const char* b2 = last ? nB : cB + (size_t)(t + 2) * kstepB;
            const char* a3 = a2 + kstepA; const char* b3 = b2 + kstepB;
            PG8_LDB(B0, 0, 0); PG8_LDB(B1, 0, 1); PG8_SCHED; PG8_LDA(At, 0, 0); PG8_STAGE(PG8_SA(1, 1), a1 + hstepA, voffA);
            PG8_WAIT_V(8); PG8_WAIT_L(0); PG8_BAR; PG8_MMA(0, 0, At, B0); PG8_MMA(0, 1, At, B1); PG8_BAR; PG8_SCHED;
            PG8_LDA(At, 0, 1); PG8_STAGE(PG8_SB(0, 0), b2, voffB); PG8_STAGE(PG8_SB(0, 1), b2 + hstepB, voffB); PG8_STAGE(PG8_SA(0, 0), a2, voffA);
            PG8_WAIT_V(8); PG8_WAIT_L(0); PG8_BAR; PG8_MMA(1, 0, At, B0); PG8_MMA(1, 1, At, B1); PG8_BAR; PG8_SCHED;
            PG8_LDB(B0, 1, 0); PG8_LDB(B1, 1, 1); PG8_SCHED; PG8_LDA(At, 1, 0); PG8_STAGE(PG8_SA(0, 1), a2 + hstepA, voffA);
            PG8_WAIT_V(8); PG8_WAIT_L(0); PG8_BAR; PG8_MMA(0, 0, At, B0); PG8_MMA(0, 1, At, B1); PG8_BAR; PG8_SCHED;
            PG8_LDA(At, 1, 1); PG8_STAGE(PG8_SB(1, 0), b3, voffB); PG8_STAGE(PG8_SB(1, 1), b3 + hstepB, voffB); PG8_STAGE(PG8_SA(1, 0), a3, voffA);
            PG8_WAIT_V(8); PG8_WAIT_L(0); PG8_BAR; PG8_MMA(1, 0, At, B0); PG8_MMA(1, 1, At, B1); PG8_BAR; PG8_SCHED;
        }
        if constexpr (ALIGN_EPI) { if (wr == 0) PG8_BAR; }
        E(acc, cur, wr, wc, fr, fq);
        if (!has_next) break;
#pragma unroll
        for (int a = 0; a < 2; ++a)
#pragma unroll
            for (int b = 0; b < 2; ++b)
#pragma unroll
                for (int m = 0; m < 4; ++m)
#pragma unroll
                    for (int n = 0; n < 2; ++n) acc[a][b][m][n] = (f32x4){0.f, 0.f, 0.f, 0.f};
        cur = nxt; cA = nA; cB = nB; ++ui;
        if constexpr (ALIGN_EPI) { if (wr == 1) PG8_BAR; }
    }
    PG8_WAIT_V(0);
    if constexpr (!ALIGN_EPI) { if (wr == 0) PG8_BAR; }
    PG8_BAR;
#undef PG8_SA
#undef PG8_SB
#undef PG8_STAGE
#undef PG8_LDA
#undef PG8_LDB
#undef PG8_MMA
#undef PG8_WAIT_V
#undef PG8_WAIT_L
#undef PG8_BAR
#undef PG8_SCHED
}

template <class F> struct EpiGen8 {
    static constexpr bool PERM = true, HAS_MID = false; F f; int mid_t;
    __device__ __forceinline__ void mid(f32x4 (&)[2][2][4][2], const Unit&, int, int, int, int) const {}
    __device__ __forceinline__ void operator()(const f32x4 (&acc)[2][2][4][2], const Unit& u, int wr, int wc, int fr, int fq) const {
#pragma unroll
        for (int ai = 0; ai < 2; ++ai)
#pragma unroll
            for (int m = 0; m < 4; ++m) { const int r = ai * HALF + wr * 64 + m * 16 + fr;
#pragma unroll
                for (int bj = 0; bj < 2; ++bj) f(u, r, bj * HALF + wc * 32 + 8 * fq, acc[ai][bj][m][0], acc[ai][bj][m][1]);
                if constexpr (F::PIN) __builtin_amdgcn_sched_barrier(0); }
    }
};
}

typedef const float* cfp_t;
typedef __attribute__((address_space(4))) const cfp_t* InTab;
struct Frame {
    LAS unsigned char* lds;
    volatile LAS unsigned* MISC;
    gu32* ctl;
    int tid, lane, wave, vcu, G;
    unsigned char* ws; unsigned char* dout; unsigned char* ws0; unsigned char* dout0;
    InTab in;
};
enum { I_X = 0, I_NMPRE, I_NMPOST, I_NFPRE, I_NFPOST, I_WIN, I_BGATE, I_MU, I_W0, I_W2, I_A0, I_A2, I_G2, I_KK, I_KA, I_RK, I_LNW, I_LNB,
       I_SARE, I_SAIM, I_SBRE, I_SBIM, I_SCRE, I_SCIM, I_SD, I_SLOG, I_WGLU, I_BGLU, I_WBR, I_WBS, I_WOUT, I_WUP, I_CONVW, I_CONVB, I_WDN };

__device__ __forceinline__ void p0_transpose_item(const float* W, int ldw, int k0, int src0, bf16_t* WT, int ldt, int drow0, int koff, const float* kscale, LAS float* scr, int lane) {
    const int q = lane & 7, rb = lane >> 3;
    f32x4 v[8]; float sc[8];
#pragma unroll
    for (int i = 0; i < 8; ++i) { const int kk = 8 * i + rb; v[i] = __builtin_nontemporal_load((const f32x4*)(W + (size_t)(k0 + kk) * ldw + src0 + 4 * q)); sc[i] = kscale ? kscale[k0 + kk] : 1.0f; }
#pragma unroll
    for (int i = 0; i < 8; ++i) { const int kk = 8 * i + rb; LAS float* d = scr + kk * 33 + 4 * q; d[0] = v[i].x * sc[i]; d[1] = v[i].y * sc[i]; d[2] = v[i].z * sc[i]; d[3] = v[i].w * sc[i]; }
    LDS_WAIT(); asm volatile("" ::: "memory");
    const int c = lane & 7;
#pragma unroll
    for (int j = 0; j < 4; ++j) { const int n = (lane >> 3) + 8 * j; const LAS float* s = scr + (8 * c) * 33 + n;
        u32x4 o; o.x = cvt_pk_bf16(s[0 * 33], s[1 * 33]); o.y = cvt_pk_bf16(s[2 * 33], s[3 * 33]); o.z = cvt_pk_bf16(s[4 * 33], s[5 * 33]); o.w = cvt_pk_bf16(s[6 * 33], s[7 * 33]);
        *(GAS u32x4*)(WT + (size_t)(drow0 + n) * ldt + koff + k0 + 8 * c) = o; }
    LDS_WAIT(); asm volatile("" ::: "memory");
}
struct TrMat { int in_idx, K, N, ldt, koff, kind; size_t dst; int scale_idx; };
__device__ __forceinline__ void p0_do_matrix(Frame& F, const TrMat& mtx, int r, LAS float* scr) {
    const int nblk = mtx.N / 32, kb = r / nblk, nb = r % nblk;
    int src0 = 32 * nb;
    if (mtx.kind == 1) {
        const int pn = (32 * nb) >> 8, within = (32 * nb) & 255;
        src0 = (within < 128 ? 0 : FF - 128) + 128 * pn + within;
    }
    p0_transpose_item(F.in[mtx.in_idx], mtx.N, 64 * kb, src0, (bf16_t*)(F.ws + mtx.dst), mtx.ldt, 32 * nb, mtx.koff, mtx.scale_idx >= 0 ? F.in[mtx.scale_idx] : nullptr, scr, F.lane);
}
__device__ __forceinline__ void p0_s5_group(Frame& F, int g) {
    LAS float* pwr = (LAS float*)(F.lds);
    LAS float* pwi = pwr + 17 * 64;
    LAS float* bbr = pwi + 17 * 64;
    LAS float* bbi = bbr + 1024;
    LAS float* cre = bbi + 1024;
    LAS float* cim = cre + 1024;
    LAS float* kk = cim + 1024;
    const float dt = expf(F.in[I_SLOG][g]);
    for (int idx = F.tid; idx < 17 * 64; idx += 512) { const int k = idx >> 6, p = idx & 63;
        const float are = F.in[I_SARE][g * 64 + p], aim = F.in[I_SAIM][g * 64 + p];
        const float mag = expf((float)k * are * dt); float sn, cs; sincosf((float)k * aim * dt, &sn, &cs);
        pwr[idx] = mag * cs; pwi[idx] = mag * sn; }
    for (int idx = F.tid; idx < 1024; idx += 512) { cre[idx] = F.in[I_SCRE][g * 1024 + idx]; cim[idx] = F.in[I_SCIM][g * 1024 + idx]; }
    __syncthreads();
    for (int idx = F.tid; idx < 1024; idx += 512) { const int p = idx >> 4;
        const float are = F.in[I_SARE][g * 64 + p], aim = F.in[I_SAIM][g * 64 + p];
        const float nr = pwr[64 + p] - 1.0f, ni = pwi[64 + p];
        const float den = 1.0f / (are * are + aim * aim);
        const float qr = (nr * are + ni * aim) * den, qi = (ni * are - nr * aim) * den;
        const float br = F.in[I_SBRE][g * 1024 + idx], bi = F.in[I_SBIM][g * 1024 + idx];
        bbr[idx] = qr * br - qi * bi; bbi[idx] = qr * bi + qi * br; }
    __syncthreads();
    {
        const int kc = F.tid & 255, ph = F.tid >> 8, k = kc >> 4, c = kc & 15; float s[16];
#pragma unroll
        for (int e = 0; e < 16; ++e) s[e] = 0.f;
        for (int p = 32 * ph; p < 32 * ph + 32; ++p) { const float cr_ = cre[c * 64 + p], ci_ = cim[c * 64 + p], pr_ = pwr[k * 64 + p], pi_ = pwi[k * 64 + p];
            const float xr = cr_ * pr_ - ci_ * pi_, xi = cr_ * pi_ + ci_ * pr_;
#pragma unroll
            for (int e4 = 0; e4 < 4; ++e4) { const f32x4 br = *(LAS const f32x4*)(bbr + p * 16 + 4 * e4), bi = *(LAS const f32x4*)(bbi + p * 16 + 4 * e4);
#pragma unroll
                for (int e = 0; e < 4; ++e) s[4 * e4 + e] += xr * br[e] - xi * bi[e]; } }
        LAS float* part = kk + 4096;
        if (ph == 1) {
#pragma unroll
            for (int e4 = 0; e4 < 4; ++e4) *(LAS f32x4*)(part + kc * 16 + 4 * e4) = (f32x4){s[4 * e4], s[4 * e4 + 1], s[4 * e4 + 2], s[4 * e4 + 3]}; }
        __syncthreads();
        if (ph == 0) {
#pragma unroll
            for (int e4 = 0; e4 < 4; ++e4) { const f32x4 o = *(LAS const f32x4*)(part + kc * 16 + 4 * e4);
#pragma unroll
                for (int e = 0; e < 4; ++e) { float v = s[4 * e4 + e] + o[e]; if (k == 0 && c == 4 * e4 + e) v += F.in[I_SD][g * 16 + c]; kk[kc * 16 + 4 * e4 + e] = v; } } }
    }
    __syncthreads();
    bf16_t* B1b = (bf16_t*)(F.ws + WS_B1B) + (size_t)g * 256 * 384;
    for (int idx = F.tid; idx < 256 * 192; idx += 512) { const int n = idx / 192, k2 = (idx % 192) * 2; const int t = n >> 4, c = n & 15; float v[2];
#pragma unroll
        for (int e = 0; e < 2; ++e) { const int kx = k2 + e;
            if (kx < 256) { const int tau = kx >> 4, cp = kx & 15; v[e] = (t >= tau) ? kk[(t - tau) * 256 + c * 16 + cp] : 0.f; }
            else { const int si = kx - 256, p = si >> 1; const float xr = cre[c * 64 + p] * pwr[(t + 1) * 64 + p] - cim[c * 64 + p] * pwi[(t + 1) * 64 + p], xi = cre[c * 64 + p] * pwi[(t + 1) * 64 + p] + cim[c * 64 + p] * pwr[(t + 1) * 64 + p];
                v[e] = (si & 1) ? -xi : xr; } }
        *(unsigned*)(B1b + (size_t)n * 384 + k2) = cvt_pk_bf16(v[0], v[1]); }
    bf16_t* B1a = (bf16_t*)(F.ws + WS_B1A) + (size_t)g * 256 * 256;
    for (int idx = F.tid; idx < 256 * 128; idx += 512) { const int n = idx >> 7, k2 = (idx & 127) * 2; float v[2] = {0.f, 0.f};
        if (n < 128) { const int p = n >> 1;
#pragma unroll
            for (int e = 0; e < 2; ++e) { const int kx = k2 + e, tau = kx >> 4, cp = kx & 15; const float pr_ = pwr[(15 - tau) * 64 + p], pi_ = pwi[(15 - tau) * 64 + p];
                const float xr = pr_ * bbr[p * 16 + cp] - pi_ * bbi[p * 16 + cp], xi = pr_ * bbi[p * 16 + cp] + pi_ * bbr[p * 16 + cp]; v[e] = (n & 1) ? xi : xr; } }
        *(unsigned*)(B1a + (size_t)n * 256 + k2) = cvt_pk_bf16(v[0], v[1]); }
    float* aL = (float*)(F.ws + WS_AL) + g * 128;
    if (F.tid < 64) { aL[2 * F.tid] = pwr[16 * 64 + F.tid]; aL[2 * F.tid + 1] = pwi[16 * 64 + F.tid]; }
    __syncthreads();
}
__device__ __forceinline__ void p0_prologue(Frame& F) {
    if (F.vcu < S5G) p0_s5_group(F, F.vcu);
    if (F.vcu < S5G && F.G > S5G) return;
    LAS float* scr = (LAS float*)(F.lds + F.wave * 16384);
    const int gw = (F.G > S5G ? F.vcu - S5G : F.vcu) * NWAVES + F.wave, NGW = (F.G > S5G ? F.G - S5G : F.G) * NWAVES;
    int base = 0;
#define DO_MAT(in_idx, K_, N_, ldt_, koff_, kind_, dst_, sc_) do { const TrMat mtx{in_idx, K_, N_, ldt_, koff_, kind_, dst_, sc_}; const int items = ((K_) / 64) * ((N_) / 32); \
        for (int it = gw; it < base + items; it += NGW) { if (it >= base) p0_do_matrix(F, mtx, it - base, scr); } base += items; } while (0)
    DO_MAT(I_WIN, D, NIN, D, 0, 0, WS_WIN, I_NMPRE); DO_MAT(I_WUP, D, 2 * FF, D, 0, 1, WS_WUP, I_NFPRE); DO_MAT(I_WDN, FF, D, FF, 0, 0, WS_WDN, -1); DO_MAT(I_WOUT, D, D, D, 0, 0, WS_WOUT, -1);
    DO_MAT(I_WBR, RW, D, D, 0, 0, WS_WBRS, -1); DO_MAT(I_WBS, RW, D, D, RW, 0, WS_WBRS, -1); DO_MAT(I_WGLU, RW, RW, RW, 0, 0, WS_WGLU, -1);
    DO_MAT(I_W2, 64, RW, 64, 0, 0, WS_W2T, -1); DO_MAT(I_A2, 64, RW, 64, 0, 0, WS_A2T, -1); DO_MAT(I_G2, 128, RW, 128, 0, 0, WS_G2T, -1);
#undef DO_MAT
    if (F.vcu >= S5G || F.G <= S5G) {
        bf16_t* XN = (bf16_t*)(F.ws + WS_XN);
        const int gw2 = gw, NGW2 = NGW;
        for (int m = gw2; m < T; m += 2 * NGW2) {
            const int m1 = (m + NGW2 < T) ? m + NGW2 : m;
            const GAS f32x4* xr0 = (const GAS f32x4*)(F.in[I_X] + (size_t)m * D) + F.lane; const GAS f32x4* xr1 = (const GAS f32x4*)(F.in[I_X] + (size_t)m1 * D) + F.lane;
            f32x4 v0[4], v1[4]; float s0 = 0.f, s1 = 0.f;
#pragma unroll
            for (int j = 0; j < 4; ++j) { v0[j] = __builtin_nontemporal_load((const f32x4*)(xr0 + 64 * j)); v1[j] = __builtin_nontemporal_load((const f32x4*)(xr1 + 64 * j)); }
#pragma unroll
            for (int j = 0; j < 4; ++j) { s0 += (v0[j].x * v0[j].x + v0[j].y * v0[j].y) + (v0[j].z * v0[j].z + v0[j].w * v0[j].w); s1 += (v1[j].x * v1[j].x + v1[j].y * v1[j].y) + (v1[j].z * v1[j].z + v1[j].w * v1[j].w); }
            const float r0 = 1.0f / sqrtf(wave_sum(s0) * (1.f / D) + 1e-6f), r1 = 1.0f / sqrtf(wave_sum(s1) * (1.f / D) + 1e-6f);
            GAS u32x2* o0 = (GAS u32x2*)(XN + (size_t)m * D) + F.lane; GAS u32x2* o1 = (GAS u32x2*)(XN + (size_t)m1 * D) + F.lane;
#pragma unroll
            for (int j = 0; j < 4; ++j) { u32x2 w; w.x = cvt_pk_bf16(v0[j].x * r0, v0[j].y * r0); w.y = cvt_pk_bf16(v0[j].z * r0, v0[j].w * r0); o0[64 * j] = w;
                u32x2 w1; w1.x = cvt_pk_bf16(v1[j].x * r1, v1[j].y * r1); w1.y = cvt_pk_bf16(v1[j].z * r1, v1[j].w * r1); o1[64 * j] = w1; }
        }
    }
}

struct EpiInProj {
    static constexpr bool PERM = true, HAS_MID = false;
    bf16_t* PR; bf16_t* UG; bf16_t* GT; const float* bg; int mid_t;
    __device__ __forceinline__ void mid(f32x4 (&)[2][2][4][2], const pg8::Unit&, int, int, int, int) const {}
    __device__ __forceinline__ void operator()(const f32x4 (&acc)[2][2][4][2], const pg8::Unit& u, int wr, int wc, int fr, int fq) const {
        f32x4 b0[2], b1[2];
        if (u.pn >= 9) {
#pragma unroll
            for (int bj = 0; bj < 2; ++bj) { const int gc = (u.pn - 9) * 256 + bj * 128 + wc * 32 + 8 * fq; b0[bj] = *(const f32x4*)(bg + gc); b1[bj] = *(const f32x4*)(bg + gc + 4); } }
#pragma unroll
        for (int ai = 0; ai < 2; ++ai)
#pragma unroll
            for (int m = 0; m < 4; ++m) { const int row = u.pm * 256 + ai * 128 + wr * 64 + m * 16 + fr;
#pragma unroll
                for (int bj = 0; bj < 2; ++bj) { const int cl = bj * 128 + wc * 32 + 8 * fq; const f32x4 v0 = acc[ai][bj][m][0], v1 = acc[ai][bj][m][1]; u32x4 w;
                    if (u.pn < 7) { w.x = cvt_pk_bf16(v0[0], v0[1]); w.y = cvt_pk_bf16(v0[2], v0[3]); w.z = cvt_pk_bf16(v1[0], v1[1]); w.w = cvt_pk_bf16(v1[2], v1[3]);
                        *(u32x4*)(PR + (size_t)row * NRW + u.pn * 256 + cl) = w; }
                    else if (u.pn < 9) { const int cr = (u.pn - 7) * 256 + cl, g = cr >> 4, c0 = cr & 15;
                        w.x = cvt_pk_bf16(v0[0], v0[1]); w.y = cvt_pk_bf16(v0[2], v0[3]); w.z = cvt_pk_bf16(v1[0], v1[1]); w.w = cvt_pk_bf16(v1[2], v1[3]);
                        *(u32x4*)(UG + ((size_t)g * S5ROWS + (row >> 4)) * UGLD + (row & 15) * 16 + c0) = w; }
                    else { const int gc = (u.pn - 9) * 256 + cl;
                        w.x = cvt_pk_bf16(fsigmoid(v0[0] + b0[bj][0]), fsigmoid(v0[1] + b0[bj][1])); w.y = cvt_pk_bf16(fsigmoid(v0[2] + b0[bj][2]), fsigmoid(v0[3] + b0[bj][3]));
                        w.z = cvt_pk_bf16(fsigmoid(v1[0] + b1[bj][0]), fsigmoid(v1[1] + b1[bj][1])); w.w = cvt_pk_bf16(fsigmoid(v1[2] + b1[bj][2]), fsigmoid(v1[3] + b1[bj][3]));
                        __builtin_nontemporal_store(w, (u32x4*)(GT + (size_t)row * 2048 + gc)); } }
                __builtin_amdgcn_sched_barrier(0); }
    }
};
struct FS5Out {
    static constexpr bool PIN = true;
    bf16_t* YSP;
    __device__ __forceinline__ void operator()(const pg8::Unit& u, int r, int cl, f32x4 v0, f32x4 v1) const {
        const int crow = u.pm * 256 + r; u32x4 w;
        w.x = cvt_pk_bf16(fgelu(v0[0]), fgelu(v0[1])); w.y = cvt_pk_bf16(fgelu(v0[2]), fgelu(v0[3])); w.z = cvt_pk_bf16(fgelu(v1[0]), fgelu(v1[1])); w.w = cvt_pk_bf16(fgelu(v1[2]), fgelu(v1[3]));
        *(u32x4*)(YSP + ((size_t)u.pn * S5ROWS + crow) * 256 + cl) = w;
    }
};
struct EpiGlu {
    static constexpr bool PERM = true, HAS_MID = false;
    const bf16_t* YSP; bf16_t* YS; const float* bglu; int mid_t;
    __device__ __forceinline__ void mid(f32x4 (&)[2][2][4][2], const pg8::Unit&, int, int, int, int) const {}
    __device__ __forceinline__ void operator()(const f32x4 (&acc)[2][2][4][2], const pg8::Unit& u, int wr, int wc, int fr, int fq) const {
        u32x4 yv[2][4][2]; f32x4 b0[2], b1[2];
#pragma unroll
        for (int bj = 0; bj < 2; ++bj) { const int col = u.pn * 256 + bj * 128 + wc * 32 + 8 * fq; b0[bj] = *(const f32x4*)(bglu + col); b1[bj] = *(const f32x4*)(bglu + col + 4); }
#pragma unroll
        for (int ai = 0; ai < 2; ++ai)
#pragma unroll
            for (int m = 0; m < 4; ++m)
#pragma unroll
                for (int bj = 0; bj < 2; ++bj) { const int row = u.pm * 256 + ai * 128 + wr * 64 + m * 16 + fr, col = u.pn * 256 + bj * 128 + wc * 32 + 8 * fq;
                    yv[ai][m][bj] = __builtin_nontemporal_load((const u32x4*)(YSP + ((size_t)(col >> 4) * S5ROWS + (row >> 4)) * 256 + (row & 15) * 16 + (col & 15))); }
#pragma unroll
        for (int ai = 0; ai < 2; ++ai)
#pragma unroll
            for (int m = 0; m < 4; ++m) {
#pragma unroll
                for (int bj = 0; bj < 2; ++bj) { const int row = u.pm * 256 + ai * 128 + wr * 64 + m * 16 + fr, col = u.pn * 256 + bj * 128 + wc * 32 + 8 * fq; float y[8]; unpack8(yv[ai][m][bj], y);
                    const f32x4 v0 = acc[ai][bj][m][0], v1 = acc[ai][bj][m][1]; u32x4 w;
                    w.x = cvt_pk_bf16(y[0] * fsigmoid(v0[0] + b0[bj][0]), y[1] * fsigmoid(v0[1] + b0[bj][1])); w.y = cvt_pk_bf16(y[2] * fsigmoid(v0[2] + b0[bj][2]), y[3] * fsigmoid(v0[3] + b0[bj][3]));
                    w.z = cvt_pk_bf16(y[4] * fsigmoid(v1[0] + b1[bj][0]), y[5] * fsigmoid(v1[1] + b1[bj][1])); w.w = cvt_pk_bf16(y[6] * fsigmoid(v1[2] + b1[bj][2]), y[7] * fsigmoid(v1[3] + b1[bj][3]));
                    *(u32x4*)(YS + (size_t)row * D + RW + col) = w; }
                __builtin_amdgcn_sched_barrier(0); }
    }
};
struct FStore {
    static constexpr bool PIN = false;
    bf16_t* O; int ldc;
    __device__ __forceinline__ void operator()(const pg8::Unit& u, int r, int cl, f32x4 v0, f32x4 v1) const {
        u32x4 w; w.x = cvt_pk_bf16(v0[0], v0[1]); w.y = cvt_pk_bf16(v0[2], v0[3]); w.z = cvt_pk_bf16(v1[0], v1[1]); w.w = cvt_pk_bf16(v1[2], v1[3]);
        *(u32x4*)(O + (size_t)(u.pm * 256 + r) * ldc + u.pn * 256 + cl) = w;
    }
};
struct EpiMergeA {
    static constexpr bool PERM = true, HAS_MID = false;
    const bf16_t* GT; bf16_t* O; int mid_t;
    __device__ __forceinline__ void mid(f32x4 (&)[2][2][4][2], const pg8::Unit&, int, int, int, int) const {}
    __device__ __forceinline__ void operator()(const f32x4 (&acc)[2][2][4][2], const pg8::Unit& u, int wr, int wc, int fr, int fq) const {
        u32x4 gv[2][4][2];
#pragma unroll
        for (int ai = 0; ai < 2; ++ai)
#pragma unroll
            for (int m = 0; m < 4; ++m)
#pragma unroll
                for (int bj = 0; bj < 2; ++bj) { const int row = u.pm * 256 + ai * 128 + wr * 64 + m * 16 + fr, col = u.pn * 256 + bj * 128 + wc * 32 + 8 * fq;
                    gv[ai][m][bj] = __builtin_nontemporal_load((const u32x4*)(GT + (size_t)row * 2048 + col)); }
#pragma unroll
        for (int ai = 0; ai < 2; ++ai)
#pragma unroll
            for (int m = 0; m < 4; ++m) {
#pragma unroll
                for (int bj = 0; bj < 2; ++bj) { const int row = u.pm * 256 + ai * 128 + wr * 64 + m * 16 + fr, col = u.pn * 256 + bj * 128 + wc * 32 + 8 * fq; float g[8]; unpack8(gv[ai][m][bj], g);
                    const f32x4 v0 = acc[ai][bj][m][0], v1 = acc[ai][bj][m][1]; u32x4 w;
                    w.x = cvt_pk_bf16(v0[0] * g[0], v0[1] * g[1]); w.y = cvt_pk_bf16(v0[2] * g[2], v0[3] * g[3]); w.z = cvt_pk_bf16(v1[0] * g[4], v1[1] * g[5]); w.w = cvt_pk_bf16(v1[2] * g[6], v1[3] * g[7]);
                    *(u32x4*)(O + (size_t)row * D + col) = w; }
                __builtin_amdgcn_sched_barrier(0); }
    }
};
struct EpiMergeB {
    static constexpr bool PERM = true, HAS_MID = false;
    const bf16_t* GT; bf16_t* O; int mid_t;
    __device__ __forceinline__ void mid(f32x4 (&)[2][2][4][2], const pg8::Unit&, int, int, int, int) const {}
    __device__ __forceinline__ void operator()(const f32x4 (&acc)[2][2][4][2], const pg8::Unit& u, int wr, int wc, int fr, int fq) const {
#pragma unroll
        for (int ai = 0; ai < 2; ++ai) {
            u32x4 gv[4][2], tv[4][2];
#pragma unroll
            for (int m = 0; m < 4; ++m)
#pragma unroll
                for (int bj = 0; bj < 2; ++bj) { const int row = u.pm * 256 + ai * 128 + wr * 64 + m * 16 + fr, col = u.pn * 256 + bj * 128 + wc * 32 + 8 * fq;
                    gv[m][bj] = __builtin_nontemporal_load((const u32x4*)(GT + (size_t)row * 2048 + 1024 + col)); tv[m][bj] = *(const u32x4*)(O + (size_t)row * D + col); }
            __builtin_amdgcn_sched_barrier(0);
#pragma unroll
            for (int m = 0; m < 4; ++m) {
#pragma unroll
                for (int bj = 0; bj < 2; ++bj) { const int row = u.pm * 256 + ai * 128 + wr * 64 + m * 16 + fr, col = u.pn * 256 + bj * 128 + wc * 32 + 8 * fq; float g[8], t1[8]; unpack8(gv[m][bj], g); unpack8(tv[m][bj], t1);
                    const f32x4 v0 = acc[ai][bj][m][0], v1 = acc[ai][bj][m][1]; u32x4 w;
                    w.x = cvt_pk_bf16(t1[0] + v0[0] * g[0], t1[1] + v0[1] * g[1]); w.y = cvt_pk_bf16(t1[2] + v0[2] * g[2], t1[3] + v0[3] * g[3]);
                    w.z = cvt_pk_bf16(t1[4] + v1[0] * g[4], t1[5] + v1[1] * g[5]); w.w = cvt_pk_bf16(t1[6] + v1[2] * g[6], t1[7] + v1[3] * g[7]);
                    *(u32x4*)(O + (size_t)row * D + col) = w; }
                __builtin_amdgcn_sched_barrier(0); }
        }
    }
};
struct UpOrder {
    const bf16_t* H2; const bf16_t* Wt; int G, c;
    __device__ bool next(int i, pg8::Unit& u) const {
        constexpr int nM = NB * 16, nN = 22, nwg = nM * nN;
        const long L = (long)i * G + c; if (L >= nwg) return false;
        int wgid = (int)L; { const int q = nwg / 8, r = nwg % 8, xcd = wgid % 8, off = wgid / 8; wgid = (xcd < r ? xcd * (q + 1) : r * (q + 1) + (xcd - r) * q) + off; }
        const int nig = 8 * nN, gid = wgid / nig, fm = gid * 8, gsz = (nM - fm) < 8 ? (nM - fm) : 8;
        u.pm = fm + ((wgid % nig) % gsz); u.pn = (wgid % nig) / gsz;
        u.a = (const char*)H2 + ((size_t)u.pm * 256 * D) * 2; u.b = (const char*)(Wt + (size_t)u.pn * 256 * D); return true;
    }
};
template <int CTRL> __device__ __forceinline__ unsigned dppu(unsigned v) { return (unsigned)__builtin_amdgcn_update_dpp(0, (int)v, CTRL, 0xf, 0xf, true); }
struct EpiConvAct {
    static constexpr bool PERM = true, HAS_MID = false;
    bf16_t* ACT; const float* cw; const float* cb; LAS unsigned* EX; unsigned long long* HZ; unsigned* tmo; int mid_t;
    __device__ __forceinline__ void mid(f32x4 (&)[2][2][4][2], const pg8::Unit&, int, int, int, int) const {}
    __device__ __forceinline__ void operator()(f32x4 (&acc)[2][2][4][2], const pg8::Unit& u, int wr, int wc, int fr, int fq) const {
        const int b = u.pm >> 4, k = u.pm & 15, t0 = 256 * k;
        u32x2 zp[2][2][4][2];
#pragma unroll
        for (int ai = 0; ai < 2; ++ai)
#pragma unroll
            for (int bj = 0; bj < 2; ++bj)
#pragma unroll
                for (int m = 0; m < 4; ++m)
#pragma unroll
                    for (int n = 0; n < 2; ++n) { const f32x4 v = acc[ai][bj][m][n]; u32x2 w; w.x = cvt_pk_bf16(v[0], v[1]); w.y = cvt_pk_bf16(v[2], v[3]); zp[ai][bj][m][n] = w; }
        if (fr >= 14) {
#pragma unroll
            for (int ai = 0; ai < 2; ++ai)
#pragma unroll
                for (int bj = 0; bj < 2; ++bj)
#pragma unroll
                    for (int n = 0; n < 2; ++n) *(LAS u32x2*)(EX + (((wc * 4 + 2 * ai + wr) * 2 + (fr - 14)) * 32 + bj * 16 + fq * 4 + n * 2)) = zp[ai][bj][3][n]; }
        if (wr == 1 && k < 15 && fr >= 14) {
            unsigned long long* hz = HZ + ((size_t)(u.pm * 22 + u.pn) * 8 + wc * 2 + (fr - 14)) * 32;
#pragma unroll
            for (int bj = 0; bj < 2; ++bj)
#pragma unroll
                for (int n = 0; n < 2; ++n) { __hip_atomic_store(hz + bj * 16 + fq * 4 + n * 2, (1ull << 32) | zp[1][bj][3][n].x, RLX_AGENT); __hip_atomic_store(hz + bj * 16 + fq * 4 + n * 2 + 1, (1ull << 32) | zp[1][bj][3][n].y, RLX_AGENT); }
        }
        asm volatile("s_waitcnt lgkmcnt(0)" ::: "memory"); __builtin_amdgcn_s_barrier(); asm volatile("" ::: "memory");
        const int ch0 = u.pn * 128 + wc * 32 + 8 * fq;
        f32x4 wg[2][3], wv[2][3], bg[2], bv[2];
#pragma unroll
        for (int n = 0; n < 2; ++n) {
#pragma unroll
            for (int j = 0; j < 3; ++j) { wg[n][j] = *(const f32x4*)(cw + (size_t)j * 2 * FF + ch0 + 4 * n); wv[n][j] = *(const f32x4*)(cw + (size_t)j * 2 * FF + FF + ch0 + 4 * n); }
            bg[n] = *(const f32x4*)(cb + ch0 + 4 * n); bv[n] = *(const f32x4*)(cb + FF + ch0 + 4 * n); }
#pragma unroll
        for (int gi = 1; gi <= 8; ++gi) {
            const int ai = (gi & 7) >> 2, m = gi & 3, blk = 2 * ai + wr;
            u32x2 pp[2][2];
#pragma unroll
            for (int bj = 0; bj < 2; ++bj)
#pragma unroll
                for (int n = 0; n < 2; ++n) { pp[bj][n].x = 0u; pp[bj][n].y = 0u; }
            if (m > 0) {
#pragma unroll
                for (int bj = 0; bj < 2; ++bj)
#pragma unroll
                    for (int n = 0; n < 2; ++n) pp[bj][n] = zp[ai][bj][m - 1][n];
            } else if (blk > 0) {
                if (fr >= 14) {
#pragma unroll
                    for (int bj = 0; bj < 2; ++bj)
#pragma unroll
                        for (int n = 0; n < 2; ++n) pp[bj][n] = *(LAS const u32x2*)(EX + (((wc * 4 + blk - 1) * 2 + (fr - 14)) * 32 + bj * 16 + fq * 4 + n * 2)); }
            } else if (k > 0) {
                if (fr >= 14) {
                    const unsigned long long* hz = HZ + ((size_t)((u.pm - 1) * 22 + u.pn) * 8 + wc * 2 + (fr - 14)) * 32;
#pragma unroll
                    for (int bj = 0; bj < 2; ++bj)
#pragma unroll
                        for (int n = 0; n < 2; ++n) { unsigned long long x0, x1; unsigned sp_ = 0;
                            for (;;) { x0 = __hip_atomic_load(hz + bj * 16 + fq * 4 + n * 2, RLX_AGENT); x1 = __hip_atomic_load(hz + bj * 16 + fq * 4 + n * 2 + 1, RLX_AGENT);
                                if ((x0 >> 32) == 1ull && (x1 >> 32) == 1ull) break; __builtin_amdgcn_s_sleep(2); if (++sp_ > (1u << 20)) { __hip_atomic_store(tmo, 1u, RLX_AGENT); break; } }
                            pp[bj][n].x = (unsigned)x0; pp[bj][n].y = (unsigned)x1; } }
            }
            u32x2 outp[2];
#pragma unroll
            for (int n = 0; n < 2; ++n) {
                const u32x2 zg = zp[ai][0][m][n], zv = zp[ai][1][m][n], pg = pp[0][n], pv = pp[1][n];
                u32x2 g1, g2, v1, v2;
                g1.x = dppu<0x111>(zg.x) | dppu<0x10F>(pg.x); g1.y = dppu<0x111>(zg.y) | dppu<0x10F>(pg.y); g2.x = dppu<0x112>(zg.x) | dppu<0x10E>(pg.x); g2.y = dppu<0x112>(zg.y) | dppu<0x10E>(pg.y);
                v1.x = dppu<0x111>(zv.x) | dppu<0x10F>(pv.x); v1.y = dppu<0x111>(zv.y) | dppu<0x10F>(pv.y); v2.x = dppu<0x112>(zv.x) | dppu<0x10E>(pv.x); v2.y = dppu<0x112>(zv.y) | dppu<0x10E>(pv.y);
                const float z0g[4] = {bf_lo(zg.x), bf_hi(zg.x), bf_lo(zg.y), bf_hi(zg.y)}, z1g[4] = {bf_lo(g1.x), bf_hi(g1.x), bf_lo(g1.y), bf_hi(g1.y)}, z2g[4] = {bf_lo(g2.x), bf_hi(g2.x), bf_lo(g2.y), bf_hi(g2.y)};
                const float z0v[4] = {bf_lo(zv.x), bf_hi(zv.x), bf_lo(zv.y), bf_hi(zv.y)}, z1v[4] = {bf_lo(v1.x), bf_hi(v1.x), bf_lo(v1.y), bf_hi(v1.y)}, z2v[4] = {bf_lo(v2.x), bf_hi(v2.x), bf_lo(v2.y), bf_hi(v2.y)};
                float o[4];
#pragma unroll
                for (int e = 0; e < 4; ++e) { const float cg = bg[n][e] + wg[n][0][e] * z2g[e] + wg[n][1][e] * z1g[e] + wg[n][2][e] * z0g[e], cv = bv[n][e] + wv[n][0][e] * z2v[e] + wv[n][1][e] * z1v[e] + wv[n][2][e] * z0v[e];
                    o[e] = fgelu(cg) * cv; }
                outp[n].x = cvt_pk_bf16(o[0], o[1]); outp[n].y = cvt_pk_bf16(o[2], o[3]);
            }
            const int r = 128 * ai + 64 * wr + 16 * m + fr;
            { u32x4 w4; w4.x = outp[0].x; w4.y = outp[0].y; w4.z = outp[1].x; w4.w = outp[1].y; *(u32x4*)(ACT + ((size_t)(b * SEQ + t0 + r)) * FF + ch0) = w4; }
            __builtin_amdgcn_sched_barrier(0);
        }
    }
};
struct EpiRowStat {
    static constexpr bool PERM = true, HAS_MID = false; bf16_t* O; float* STAT; int mid_t;
    __device__ __forceinline__ void mid(f32x4 (&)[2][2][4][2], const pg8::Unit&, int, int, int, int) const {}
    __device__ __forceinline__ void operator()(const f32x4 (&acc)[2][2][4][2], const pg8::Unit& u, int wr, int wc, int fr, int fq) const {
#pragma unroll
        for (int ai = 0; ai < 2; ++ai)
#pragma unroll
            for (int m = 0; m < 4; ++m) { const int row = u.pm * 256 + ai * 128 + wr * 64 + m * 16 + fr; float s = 0.f;
#pragma unroll
                for (int bj = 0; bj < 2; ++bj) { const int col = u.pn * 256 + bj * 128 + wc * 32 + 8 * fq; const f32x4 v0 = acc[ai][bj][m][0], v1 = acc[ai][bj][m][1]; u32x4 w;
                    s += (v0[0] * v0[0] + v0[1] * v0[1]) + (v0[2] * v0[2] + v0[3] * v0[3]) + (v1[0] * v1[0] + v1[1] * v1[1]) + (v1[2] * v1[2] + v1[3] * v1[3]);
                    w.x = cvt_pk_bf16(v0[0], v0[1]); w.y = cvt_pk_bf16(v0[2], v0[3]); w.z = cvt_pk_bf16(v1[0], v1[1]); w.w = cvt_pk_bf16(v1[2], v1[3]);
                    __builtin_nontemporal_store(w, (u32x4*)(O + (size_t)row * D + col)); }
                s += __shfl_xor(s, 16); s += __shfl_xor(s, 32);
                if (fq == 0) STAT[(size_t)row * 16 + u.pn * 4 + wc] = s; }
    }
};
struct EpiSloc {
    static constexpr bool PERM = false, HAS_MID = false; float* SL; int mid_t;
    __device__ __forceinline__ void mid(f32x4 (&)[2][2][4][2], const pg8::Unit&, int, int, int, int) const {}
    __device__ __forceinline__ void operator()(const f32x4 (&acc)[2][2][4][2], const pg8::Unit& u, int wr, int wc, int fr, int fq) const {
#pragma unroll
        for (int ai = 0; ai < 2; ++ai)
#pragma unroll
            for (int m = 0; m < 4; ++m) { const int row = u.pm * 256 + ai * 128 + wr * 64 + m * 16 + fr; float* p = SL + ((size_t)u.pn * S5ROWS + row) * 128 + wc * 32 + 4 * fq;
                *(f32x4*)(p) = acc[ai][0][m][0]; *(f32x4*)(p + 16) = acc[ai][0][m][1]; }
    }
};
struct S5Order {
    const bf16_t* UG; const bf16_t* Bt; int ldb, G, c;
    __device__ bool next(int i, pg8::Unit& u) const { const int L = i * G + c; if (L >= S5G * 8) return false; const int g = L >> 3; u.pm = L & 7; u.pn = g;
        u.a = (const char*)(UG + ((size_t)g * S5ROWS + u.pm * 256) * UGLD); u.b = (const char*)(Bt + (size_t)g * 256 * ldb); return true; }
};

constexpr int LW = 72;
constexpr int SLOT = 64 * LW * 2;
#define SL(i) ((i) * SLOT)
#define BAR_LDS() do { asm volatile("s_waitcnt lgkmcnt(0)" ::: "memory"); __builtin_amdgcn_s_barrier(); asm volatile("" ::: "memory"); } while (0)
struct LdsMat { LAS const unsigned char* p; int ld; __device__ __forceinline__ bf16x8 frag(int row, int k) const { return *(LAS const bf16x8*)(p + ((size_t)row * ld + k) * 2); } };
struct GlbMat { const bf16_t* p; int ld; __device__ __forceinline__ bf16x8 frag(int row, int k) const { return *(const bf16x8*)(p + (size_t)row * ld + k); } };
template <int KD, class YM, class XM, class EPI>
__device__ __forceinline__ void mm64(const YM& Y, const XM& X, int wid, int lane, const EPI& epi) {
    asm volatile("" : "+v"(lane), "+s"(wid));
    const int at = wid >> 1, bt0 = (wid & 1) * 2, fr = lane & 15, fq = lane >> 4;
    f32x4 acc[2] = {(f32x4){0.f, 0.f, 0.f, 0.f}, (f32x4){0.f, 0.f, 0.f, 0.f}};
#pragma unroll
    for (int s = 0; s < KD / 32; ++s) {
        const bf16x8 yf = Y.frag(16 * at + fr, 32 * s + 8 * fq);
#pragma unroll
        for (int bi = 0; bi < 2; ++bi) { const bf16x8 xf = X.frag(16 * (bt0 + bi) + fr, 32 * s + 8 * fq);
            acc[bi] = __builtin_amdgcn_mfma_f32_16x16x32_bf16(xf, yf, acc[bi], 0, 0, 0); }
    }
#pragma unroll
    for (int bi = 0; bi < 2; ++bi) epi(16 * at + fr, 16 * (bt0 + bi) + 4 * fq, acc[bi]);
}
__device__ __forceinline__ void ld_yf(const LdsMat& Y, int at, int fr, int fq, bf16x8 (&y)[2]) {
#pragma unroll
    for (int s = 0; s < 2; ++s) y[s] = Y.frag(16 * at + fr, 32 * s + 8 * fq);
}
__device__ __forceinline__ void ld_xf(const LdsMat& X, int bt0, int fr, int fq, bf16x8 (&x)[2][2]) {
#pragma unroll
    for (int s = 0; s < 2; ++s)
#pragma unroll
        for (int bi = 0; bi < 2; ++bi) x[s][bi] = X.frag(16 * (bt0 + bi) + fr, 32 * s + 8 * fq);
}
__device__ __forceinline__ void mm_f(const bf16x8 (&y)[2], const bf16x8 (&x)[2][2], f32x4 (&acc)[2]) {
#pragma unroll
    for (int bi = 0; bi < 2; ++bi) acc[bi] = (f32x4){0.f, 0.f, 0.f, 0.f};
#pragma unroll
    for (int s = 0; s < 2; ++s)
#pragma unroll
        for (int bi = 0; bi < 2; ++bi) acc[bi] = __builtin_amdgcn_mfma_f32_16x16x32_bf16(x[s][bi], y[s], acc[bi], 0, 0, 0);
}
template <int KD>
__device__ __forceinline__ void preload_x(const GlbMat& X, int wid, int lane, bf16x8 (&xf)[KD / 32][2]) {
    const int bt0 = (wid & 1) * 2, fr = lane & 15, fq = lane >> 4;
#pragma unroll
    for (int s = 0; s < KD / 32; ++s)
#pragma unroll
        for (int bi = 0; bi < 2; ++bi) xf[s][bi] = X.frag(16 * (bt0 + bi) + fr, 32 * s + 8 * fq);
}
template <int KD, class YM, class EPI>
__device__ __forceinline__ void mm64_pre(const YM& Y, const bf16x8 (&xf)[KD / 32][2], int wid, int lane, const EPI& epi) {
    const int at = wid >> 1, bt0 = (wid & 1) * 2, fr = lane & 15, fq = lane >> 4;
    f32x4 acc[2] = {(f32x4){0.f, 0.f, 0.f, 0.f}, (f32x4){0.f, 0.f, 0.f, 0.f}};
#pragma unroll
    for (int s = 0; s < KD / 32; ++s) {
        const bf16x8 yf = Y.frag(16 * at + fr, 32 * s + 8 * fq);
#pragma unroll
        for (int bi = 0; bi < 2; ++bi) acc[bi] = __builtin_amdgcn_mfma_f32_16x16x32_bf16(xf[s][bi], yf, acc[bi], 0, 0, 0);
    }
#pragma unroll
    for (int bi = 0; bi < 2; ++bi) epi(16 * at + fr, 16 * (bt0 + bi) + 4 * fq, acc[bi]);
}
__device__ __forceinline__ void st_lds4(LAS unsigned char* base, int a, int b0, f32x4 v) { u32x2 w; w.x = cvt_pk_bf16(v[0], v[1]); w.y = cvt_pk_bf16(v[2], v[3]); *(LAS u32x2*)(base + ((size_t)a * LW + b0) * 2) = w; }
__device__ __forceinline__ f32x4 ld_lds4(LAS const unsigned char* base, int a, int b0) { const u32x2 w = *(LAS const u32x2*)(base + ((size_t)a * LW + b0) * 2); return (f32x4){bf_lo(w.x), bf_hi(w.x), bf_lo(w.y), bf_hi(w.y)}; }
__device__ __forceinline__ void st_glb4p(bf16_t* base, int a, int b0, f32x4 v) { u32x2 w; w.x = cvt_pk_bf16(v[0], v[1]); w.y = cvt_pk_bf16(v[2], v[3]); __builtin_nontemporal_store(w, (u32x2*)(base + (size_t)a * GLD + b0)); }
__device__ __forceinline__ void st_glb4(bf16_t* base, int a, int b0, f32x4 v) { u32x2 w; w.x = cvt_pk_bf16(v[0], v[1]); w.y = cvt_pk_bf16(v[2], v[3]); __builtin_nontemporal_store(w, (u32x2*)(base + (size_t)a * 64 + b0)); }

struct PrePf { u32x4 qa[3], qp[3], ra[4], rp[4]; };
__device__ __forceinline__ void rwkv_pre_fetch(Frame& F, int unit, bool lr_first, PrePf& P, int tid) {
    const int bh = unit >> 6, c = unit & 63, b = bh >> 3, h = bh & 7;
    const int t = tid >> 3, jb = tid & 7, j0 = jb * 8;
    const int tg = b * SEQ + c * 64 + t;
    const bool hasprev = (c * 64 + t) > 0;
    const bf16_t* prow = (const bf16_t*)(F.ws + WS_PR) + (size_t)tg * NRW; const bf16_t* pprv = hasprev ? prow - NRW : prow;
#pragma unroll
    for (int seg = 0; seg < 3; ++seg) { const int col = seg * 512 + h * 64 + j0; P.qa[seg] = *(const u32x4*)(prow + col); P.qp[seg] = *(const u32x4*)(pprv + col); }
    const u32x4* scr = (const u32x4*)(F.ws + WS_LRSCR) + ((size_t)F.vcu * 512 + tid) * 4;
    const u32x4* pa = lr_first ? (const u32x4*)(prow + 1536 + jb * 32) : scr; const u32x4* pp = lr_first ? (const u32x4*)(pprv + 1536 + jb * 32) : scr;
#pragma unroll
    for (int q4 = 0; q4 < 4; ++q4) { P.ra[q4] = pa[q4]; P.rp[q4] = pp[q4]; }
}
__device__ __forceinline__ void rwkv_pre_unit(Frame& F, int unit, int next_unit, bool lr_first, bool next_first, PrePf& P) {
    LAS unsigned char* L = F.lds;
    LAS float* XT = (LAS float*)(F.lds + XTRA_OFF);
    int tid = F.tid; asm volatile("" : "+v"(tid));
    int wid = F.wave; asm volatile("" : "+s"(wid));
    const int lane = tid & 63;
    const int bh = unit >> 6, c = unit & 63, b = bh >> 3, h = bh & 7;
    const int t = tid >> 3, jb = tid & 7, j0 = jb * 8;
    const int tg = b * SEQ + c * 64 + t;
    const bool hasprev = (c * 64 + t) > 0;
    const bf16_t* PR = (const bf16_t*)(F.ws + WS_PR);
    const bf16_t* prow = PR + (size_t)tg * NRW; const bf16_t* pprev = prow - NRW;
    LAS const float* mu = (LAS const float*)(F.lds + XTRA_OFF + 4096);
    LAS const float* par = mu + NRW;
    bf16x8 xw[2][2], xa[2][2], xg[4][2];
    {
        const GlbMat Xw{(const bf16_t*)(F.ws + WS_W2T) + (size_t)h * 64 * 64, 64}, Xa{(const bf16_t*)(F.ws + WS_A2T) + (size_t)h * 64 * 64, 64}, Xg{(const bf16_t*)(F.ws + WS_G2T) + (size_t)h * 64 * 128, 128};
        preload_x<64>(Xw, wid, lane, xw); preload_x<64>(Xa, wid, lane, xa); preload_x<128>(Xg, wid, lane, xg);
    }
    float rs[8], ks[8], vs[8];
    {
        const int c0 = 1536 + jb * 32;
        const float pmask = hasprev ? 1.f : 0.f;
        f32x4 mq[3][2];
#pragma unroll
        for (int seg = 0; seg < 3; ++seg) { const int col = seg * 512 + h * 64 + j0; mq[seg][0] = *(LAS const f32x4*)(mu + col); mq[seg][1] = *(LAS const f32x4*)(mu + col + 4); }
        LAS unsigned char* dst = (jb < 2) ? (L + SL(0) + ((size_t)t * LW + jb * 32) * 2) : (jb < 4) ? (L + SL(1) + ((size_t)t * LW + (jb - 2) * 32) * 2) : (L + SL(2) + ((size_t)t * 136 + (jb - 4) * 32) * 2);
        u32x4* scr = (u32x4*)(F.ws + WS_LRSCR) + ((size_t)F.vcu * 512 + tid) * 4;
        if (lr_first) {
            f32x4 ma[4][2];
#pragma unroll
            for (int q4 = 0; q4 < 4; ++q4) { ma[q4][0] = *(LAS const f32x4*)(mu + c0 + q4 * 8); ma[q4][1] = *(LAS const f32x4*)(mu + c0 + q4 * 8 + 4); }
#pragma unroll
            for (int q4 = 0; q4 < 4; ++q4) { float x[8], xp[8], o[8]; unpack8(P.ra[q4], x); unpack8(P.rp[q4], xp);
#pragma unroll
                for (int e = 0; e < 8; ++e) { const float mm = e < 4 ? ma[q4][0][e] : ma[q4][1][e - 4]; const float s = x[e] + (xp[e] * pmask - x[e]) * mm;
                    const float ex = __builtin_amdgcn_exp2f((jb < 2 ? 2.88539008178f : -1.44269504089f) * s), rc = __builtin_amdgcn_rcpf(1.0f + ex);
                    o[e] = jb < 2 ? 1.0f - 2.0f * rc : (jb < 4 ? s : rc); }
                const u32x4 w = pack8(o); *(LAS u32x4*)(dst + q4 * 16) = w; scr[q4] = w; }
        } else {
#pragma unroll
            for (int q4 = 0; q4 < 4; ++q4) *(LAS u32x4*)(dst + q4 * 16) = P.ra[q4];
        }
#pragma unroll
        for (int seg = 0; seg < 3; ++seg) { float x[8], xp[8]; unpack8(P.qa[seg], x); unpack8(P.qp[seg], xp);
#pragma unroll
            for (int e = 0; e < 8; ++e) { const float mm = e < 4 ? mq[seg][0][e] : mq[seg][1][e - 4]; const float s = x[e] + (xp[e] * pmask - x[e]) * mm; if (seg == 0) rs[e] = s; else if (seg == 1) ks[e] = s; else vs[e] = s; } }
    }
    BAR_LDS();
    {
        const LdsMat Yw{L + SL(0), LW}, Ya{L + SL(1), LW}, Yg{L + SL(2), 136};
        mm64_pre<64>(Yw, xw, wid, lane, [&](int a, int b0, f32x4 v) { *(LAS f32x4*)(L + SL(4) + ((size_t)a * 68 + b0) * 4) = v; });
        mm64_pre<64>(Ya, xa, wid, lane, [&](int a, int b0, f32x4 v) { *(LAS f32x4*)(L + SL(6) + ((size_t)a * 68 + b0) * 4) = v; });
        mm64_pre<128>(Yg, xg, wid, lane, [&](int a, int b0, f32x4 v) { *(LAS f32x4*)(L + SL(8) + ((size_t)a * 68 + b0) * 4) = v; });
    }
    BAR_LDS();
    float ld[8], kp[8], av[8], bv[8];
    {
        const int hc = h * 64 + j0;
        float wp[8], ap[8], gg[8], w0[8], a0[8], kkw[8], kaw[8], rk[8];
        *(f32x4*)&wp[0] = *(LAS f32x4*)(L + SL(4) + ((size_t)t * 68 + j0) * 4); *(f32x4*)&wp[4] = *(LAS f32x4*)(L + SL(4) + ((size_t)t * 68 + j0 + 4) * 4);
        *(f32x4*)&ap[0] = *(LAS f32x4*)(L + SL(6) + ((size_t)t * 68 + j0) * 4); *(f32x4*)&ap[4] = *(LAS f32x4*)(L + SL(6) + ((size_t)t * 68 + j0 + 4) * 4);
        *(f32x4*)&gg[0] = *(LAS f32x4*)(L + SL(8) + ((size_t)t * 68 + j0) * 4); *(f32x4*)&gg[4] = *(LAS f32x4*)(L + SL(8) + ((size_t)t * 68 + j0 + 4) * 4);
        *(f32x4*)&w0[0] = *(LAS const f32x4*)(par + 0 + hc); *(f32x4*)&w0[4] = *(LAS const f32x4*)(par + 0 + hc + 4);
        *(f32x4*)&a0[0] = *(LAS const f32x4*)(par + 512 + hc); *(f32x4*)&a0[4] = *(LAS const f32x4*)(par + 512 + hc + 4);
        *(f32x4*)&kkw[0] = *(LAS const f32x4*)(par + 1024 + hc); *(f32x4*)&kkw[4] = *(LAS const f32x4*)(par + 1024 + hc + 4);
        *(f32x4*)&kaw[0] = *(LAS const f32x4*)(par + 1536 + hc); *(f32x4*)&kaw[4] = *(LAS const f32x4*)(par + 1536 + hc + 4);
        *(f32x4*)&rk[0] = *(LAS const f32x4*)(par + 2048 + hc); *(f32x4*)&rk[4] = *(LAS const f32x4*)(par + 2048 + hc + 4);
        float ss = 0.f, bon = 0.f, kkv[8], eta[8];
#pragma unroll
        for (int e = 0; e < 8; ++e) {
            ld[e] = -0.60653065971f * fsigmoid(w0[e] + wp[e]);
            eta[e] = fsigmoid(a0[e] + ap[e]);
            kkv[e] = ks[e] * kkw[e]; ss += kkv[e] * kkv[e];
            kp[e] = ks[e] * (1.0f + (eta[e] - 1.0f) * kaw[e]);
            bon += rs[e] * kp[e] * rk[e];
        }
        ss += __shfl_xor(ss, 1); ss += __shfl_xor(ss, 2); ss += __shfl_xor(ss, 4);
        bon += __shfl_xor(bon, 1); bon += __shfl_xor(bon, 2); bon += __shfl_xor(bon, 4);
        const float inv = __builtin_amdgcn_rcpf(fmaxf(__builtin_amdgcn_sqrtf(ss), 1e-12f));
#pragma unroll
        for (int e = 0; e < 8; ++e) { const float kk = kkv[e] * inv; av[e] = -kk; bv[e] = kk * eta[e]; }
        if (jb == 0) ((float*)(F.ws + WS_BONUS))[(size_t)tg * 8 + h] = bon;
        *(u32x4*)((bf16_t*)(F.ws + WS_GBUF) + (size_t)tg * RW + hc) = pack8(gg);
    }
    float Lc[8];
#pragma unroll
    for (int e = 0; e < 8; ++e) { float x = ld[e];
        float y = __shfl_up(x, 8); if (lane >= 8) x += y;
        y = __shfl_up(x, 16); if (lane >= 16) x += y;
        y = __shfl_up(x, 32); if (lane >= 32) x += y;
        Lc[e] = x; }
    if (lane >= 56) {
#pragma unroll
        for (int e = 0; e < 8; ++e) XT[wid * 64 + j0 + e] = Lc[e]; }
    BAR_LDS();
    float LC[8], gC[8];
    {
        float pre[8], tot[8];
#pragma unroll
        for (int e = 0; e < 8; ++e) { pre[e] = 0.f; tot[e] = 0.f; }
#pragma unroll
        for (int w = 0; w < 8; ++w) { const f32x4 x0 = *(LAS const f32x4*)(XT + w * 64 + j0), x1 = *(LAS const f32x4*)(XT + w * 64 + j0 + 4); const float sel = (w < wid) ? 1.f : 0.f;
#pragma unroll
            for (int e = 0; e < 4; ++e) { tot[e] += x0[e]; tot[4 + e] += x1[e]; pre[e] += sel * x0[e]; pre[4 + e] += sel * x1[e]; } }
#pragma unroll
        for (int e = 0; e < 8; ++e) { Lc[e] += pre[e]; LC[e] = tot[e]; gC[e] = fexp(LC[e]); }
    }
    if (t == 63) {
#pragma unroll
        for (int e = 0; e < 8; ++e) XT[512 + j0 + e] = gC[e]; }
    {
        float o0[8], o1[8], o2[8], o3[8], o4[8], o5[8];
#pragma unroll
        for (int e = 0; e < 8; ++e) { const float ein = fexp(Lc[e]), eout = __builtin_amdgcn_rcpf(ein), eex = fexp(Lc[e] - ld[e]), eg = gC[e] * eout;
            o0[e] = rs[e] * ein; o1[e] = kp[e] * eout; o2[e] = av[e] * eex; o3[e] = bv[e] * eout; o4[e] = bv[e] * eg; o5[e] = kp[e] * eg; }
        const size_t off = ((size_t)t * LW + j0) * 2;
        *(LAS u32x4*)(L + SL(10) + off) = pack8(o0); *(LAS u32x4*)(L + SL(11) + off) = pack8(o1); *(LAS u32x4*)(L + SL(12) + off) = pack8(o2); *(LAS u32x4*)(L + SL(13) + off) = pack8(o3);
        *(LAS u32x4*)(L + SL(0) + off) = pack8(o4); *(LAS u32x4*)(L + SL(1) + off) = pack8(o5); *(LAS u32x4*)(L + SL(2) + off) = pack8(vs);
    }
    BAR_LDS();
    {
        const int srcs[4] = {12, 0, 1, 2}, dsts[4] = {4, 5, 6, 7};
#pragma unroll
        for (int q = 0; q < 4; ++q) { unsigned short hv[8];
#pragma unroll
            for (int e = 0; e < 8; ++e) hv[e] = *(LAS const unsigned short*)(L + SL(srcs[q]) + ((size_t)(8 * wid + e) * LW + lane) * 2);
            u32x4 w; w.x = hv[0] | ((unsigned)hv[1] << 16); w.y = hv[2] | ((unsigned)hv[3] << 16); w.z = hv[4] | ((unsigned)hv[5] << 16); w.w = hv[6] | ((unsigned)hv[7] << 16);
            *(LAS u32x4*)(L + SL(dsts[q]) + ((size_t)lane * LW + 8 * wid) * 2) = w;
            if (q == 3) *(u32x4*)((bf16_t*)(F.ws + WS_VT) + (size_t)unit * 4096 + lane * 64 + 8 * wid) = w; }
    }
    BAR_LDS();
    if (next_unit < NUNIT) rwkv_pre_fetch(F, next_unit, next_first, P, tid);
    {
        const LdsMat Rt{L + SL(10), LW}, Kt{L + SL(11), LW}, At{L + SL(12), LW}, Bt{L + SL(13), LW};
        f32x4 nd = (f32x4){0.f, 0.f, 0.f, 0.f}, ntd = nd;
        {
            int ln = lane, wd = wid; asm volatile("" : "+v"(ln), "+s"(wd));
            const int at = wd >> 1, bt0 = (wd & 1) * 2, fr = ln & 15, fq = ln >> 4, a = 16 * at + fr;
            bf16x8 yA[2], yK[2], yR[2], xB[2][2], xA[2][2], xK[2][2];
            ld_yf(At, at, fr, fq, yA); ld_xf(Bt, bt0, fr, fq, xB); ld_yf(Kt, at, fr, fq, yK); ld_xf(At, bt0, fr, fq, xA); ld_yf(Rt, at, fr, fq, yR); ld_xf(Kt, bt0, fr, fq, xK);
            const bool diag = bt0 == (at & 2);
            bf16x8 xd[2];
            if (diag) ld_yf(Bt, at, fr, fq, xd);
            f32x4 c0[2], c1[2], c2[2], c3[2];
            mm_f(yA, xB, c0); mm_f(yK, xA, c1); mm_f(yR, xB, c2); mm_f(yR, xK, c3);
            if (diag) {
                f32x4 v = (f32x4){0.f, 0.f, 0.f, 0.f};
#pragma unroll
                for (int s = 0; s < 2; ++s) v = __builtin_amdgcn_mfma_f32_16x16x32_bf16(yA[s], xd[s], v, 0, 0, 0);
#pragma unroll
                for (int e = 0; e < 4; ++e) v[e] = (fr < 4 * fq + e) ? v[e] : 0.f;
                nd = v; }
#pragma unroll
            for (int bi = 0; bi < 2; ++bi) { const int b0 = 16 * (bt0 + bi) + 4 * fq; f32x4 v0 = c0[bi], v1 = c1[bi], v2 = c2[bi], v3 = c3[bi];
#pragma unroll
                for (int e = 0; e < 4; ++e) { v0[e] = (b0 + e < a) ? v0[e] : 0.f; v1[e] = (a < b0 + e) ? v1[e] : 0.f; v2[e] = (b0 + e <= a) ? v2[e] : 0.f; v3[e] = (b0 + e <= a) ? v3[e] : 0.f; }
                st_lds4(L + SL(1), a, b0, v0); st_lds4(L + SL(2), a, b0, v1); st_lds4(L + SL(3), a, b0, v2); st_lds4(L + SL(8), a, b0, v3);
                if (bt0 + bi == at) ntd = v0; }
        }
        const int at = wid >> 1;
        if (((wid & 1) * 2 == (at & 2))) {
            const int fr = lane & 15, fq = lane >> 4;
            auto op = [](f32x4 v) { u32x4 w; w.x = cvt_pk_bf16(v[0], v[1]); w.y = cvt_pk_bf16(v[2], v[3]); w.z = 0u; w.w = 0u; return __builtin_bit_cast(bf16x8, w); };
            const f32x4 zero = (f32x4){0.f, 0.f, 0.f, 0.f};
            const f32x4 Lm = ntd, LT = nd;
            f32x4 Q = Lm;
#pragma unroll
            for (int e = 0; e < 4; ++e) Q[e] += (4 * fq + e == fr) ? 1.f : 0.f;
            const f32x4 L2 = __builtin_amdgcn_mfma_f32_16x16x32_bf16(op(LT), op(Lm), zero, 0, 0, 0), L2T = __builtin_amdgcn_mfma_f32_16x16x32_bf16(op(Lm), op(LT), zero, 0, 0, 0);
            Q = __builtin_amdgcn_mfma_f32_16x16x32_bf16(op(L2T), op(Q), Q, 0, 0, 0);
            const f32x4 L4 = __builtin_amdgcn_mfma_f32_16x16x32_bf16(op(L2T), op(L2), zero, 0, 0, 0), L4T = __builtin_amdgcn_mfma_f32_16x16x32_bf16(op(L2), op(L2T), zero, 0, 0, 0);
            Q = __builtin_amdgcn_mfma_f32_16x16x32_bf16(op(L4T), op(Q), Q, 0, 0, 0);
            const f32x4 L8T = __builtin_amdgcn_mfma_f32_16x16x32_bf16(op(L4), op(L4T), zero, 0, 0, 0);
            Q = __builtin_amdgcn_mfma_f32_16x16x32_bf16(op(L8T), op(Q), Q, 0, 0, 0);
            st_lds4(L + SL(9), 16 * at + fr, 4 * fq, Q);
        }
    }
    BAR_LDS();
    {
        const int fr = lane & 15, fq = lane >> 4;
        LAS const unsigned char* zsl = L + (wid < 4 ? SL(4) : SL(2)); LAS unsigned char* dsl = L + (wid < 4 ? SL(11) : SL(12));
        const int arow = 16 * (wid & 3) + fr;
        u32x2 zp[4];
#pragma unroll
        for (int c = 0; c < 4; ++c) {
            f32x4 acc = ld_lds4(zsl, arow, 16 * c + 4 * fq);
            if (c >= 1) {
                const u32x2 alo = *(LAS const u32x2*)(L + SL(1) + ((size_t)(16 * c + fr) * LW + 4 * fq) * 2), ahi = *(LAS const u32x2*)(L + SL(1) + ((size_t)(16 * c + fr) * LW + 16 + 4 * fq) * 2);
                u32x4 aw; aw.x = alo.x; aw.y = alo.y; aw.z = ahi.x; aw.w = ahi.y;
                u32x4 bw; bw.x = zp[0].x; bw.y = zp[0].y; bw.z = c >= 2 ? zp[1].x : 0u; bw.w = c >= 2 ? zp[1].y : 0u;
                acc = __builtin_amdgcn_mfma_f32_16x16x32_bf16(__builtin_bit_cast(bf16x8, aw), __builtin_bit_cast(bf16x8, bw), acc, 0, 0, 0); }
            if (c == 3) {
                const u32x2 alo = *(LAS const u32x2*)(L + SL(1) + ((size_t)(48 + fr) * LW + 32 + 4 * fq) * 2);
                u32x4 aw; aw.x = alo.x; aw.y = alo.y; aw.z = 0u; aw.w = 0u;
                u32x4 bw; bw.x = zp[2].x; bw.y = zp[2].y; bw.z = 0u; bw.w = 0u;
                acc = __builtin_amdgcn_mfma_f32_16x16x32_bf16(__builtin_bit_cast(bf16x8, aw), __builtin_bit_cast(bf16x8, bw), acc, 0, 0, 0); }
            const u32x2 dlo = *(LAS const u32x2*)(L + SL(9) + ((size_t)(16 * c + fr) * LW + 4 * fq) * 2);
            u32x4 aw; aw.x = dlo.x; aw.y = dlo.y; aw.z = 0u; aw.w = 0u;
            u32x4 bw; bw.x = cvt_pk_bf16(acc[0], acc[1]); bw.y = cvt_pk_bf16(acc[2], acc[3]); bw.z = 0u; bw.w = 0u;
            const f32x4 r = __builtin_amdgcn_mfma_f32_16x16x32_bf16(__builtin_bit_cast(bf16x8, aw), __builtin_bit_cast(bf16x8, bw), (f32x4){0.f, 0.f, 0.f, 0.f}, 0, 0, 0);
            zp[c].x = cvt_pk_bf16(r[0], r[1]); zp[c].y = cvt_pk_bf16(r[2], r[3]);
            *(LAS u32x2*)(dsl + ((size_t)arow * LW + 16 * c + 4 * fq) * 2) = zp[c];
        }
    }
    BAR_LDS();
    {
        const int sAT = 11, sAkT = 12, sHk = 0;
        const LdsMat AT{L + SL(sAT), LW}, AkT{L + SL(sAkT), LW}, AbrT{L + SL(3), LW}, BgT{L + SL(5), LW}, VTm{L + SL(7), LW};
        bf16_t* QRT = (bf16_t*)(F.ws + WS_QRT) + (size_t)unit * 4096; bf16_t* WYT = (bf16_t*)(F.ws + WS_WYT) + (size_t)unit * 4096;
        bf16_t* GTg = (bf16_t*)(F.dout + DO_GT) + (size_t)unit * (64 * GLD); bf16_t* Hg = (bf16_t*)(F.dout + DO_H) + (size_t)unit * (64 * GLD);
        {
            int ln = lane, wd = wid; asm volatile("" : "+v"(ln), "+s"(wd));
            const int at = wd >> 1, bt0 = (wd & 1) * 2, fr = ln & 15, fq = ln >> 4, a = 16 * at + fr;
            bf16x8 yA[2], yB[2], xT[2][2], xK[2][2];
            ld_yf(BgT, at, fr, fq, yB); ld_xf(AkT, bt0, fr, fq, xK); ld_yf(AbrT, at, fr, fq, yA); ld_xf(AT, bt0, fr, fq, xT);
            f32x4 eH[2], eR[2], eW[2];
#pragma unroll
            for (int bi = 0; bi < 2; ++bi) { const int b0 = 16 * (bt0 + bi) + 4 * fq; eH[bi] = ld_lds4(L + SL(6), a, b0); eR[bi] = ld_lds4(L + SL(10), a, b0); eW[bi] = ld_lds4(L + SL(8), a, b0); }
            const float gdiag = XT[512 + a];
            f32x4 cH[2], cQ[2], cW[2], cG[2];
            mm_f(yB, xK, cH); mm_f(yA, xT, cQ); mm_f(yA, xK, cW); mm_f(yB, xT, cG);
#pragma unroll
            for (int bi = 0; bi < 2; ++bi) { const int b0 = 16 * (bt0 + bi) + 4 * fq;
                st_lds4(L + SL(sHk), a, b0, cH[bi] + eH[bi]);
                st_glb4(QRT, a, b0, cQ[bi] + eR[bi]);
                st_glb4(WYT, a, b0, cW[bi] + eW[bi]);
                f32x4 v = cG[bi];
#pragma unroll
                for (int e = 0; e < 4; ++e) v[e] += (b0 + e == a) ? gdiag : 0.f;
                st_glb4p(GTg, a, b0, v); }
        }
        BAR_LDS();
        const LdsMat HkT{L + SL(sHk), LW};
        mm64<64>(VTm, HkT, wid, lane, [&](int a, int b0, f32x4 v) { st_glb4p(Hg, a, b0, v); });
    }
    BAR_LDS();
}

constexpr int RS_SLOT = 12 * 1024;
constexpr int RS_DEPTH = 8, RS_AHEAD = 6;
__device__ __forceinline__ void rwkv_scan_block(Frame& F, int item) {
    const int bh = item >> 2, qi = item & 3, lane = F.lane, fr = lane & 15, fq = lane >> 4, wid = F.wave;
    const char* GTg = (const char*)(F.dout + DO_GT) + (size_t)bh * 64 * (64 * GLD * 2);
    const char* Hg = (const char*)(F.dout + DO_H) + (size_t)bh * 64 * (64 * GLD * 2) + (size_t)qi * (16 * GLD * 2);
    bf16_t* SST = (bf16_t*)(F.dout + DO_SST) + (size_t)bh * 64 * 4096;
    LAS unsigned char* L = F.lds;
    auto issue = [&](int c) {
        if (wid >= 1) {
            LAS unsigned char* slot = L + (c & (RS_DEPTH - 1)) * RS_SLOT;
#pragma unroll
            for (int k = 0; k < 2; ++k) { const int pc = (wid - 1) + 7 * k;
                if (pc < 12) {
                    const char* src;
                    if (pc < 9) src = GTg + (size_t)c * (64 * GLD * 2) + pc * 1024 + lane * 16;
                    else { int off = (pc - 9) * 1024 + lane * 16; off = off > 2304 - 16 ? 2304 - 16 : off; src = Hg + (size_t)c * (64 * GLD * 2) + off; }
                    __builtin_amdgcn_global_load_lds((const unsigned*)src, (LAS unsigned*)(slot + pc * 1024), 16, 0, 0); } }
        }
    };
    f32x4 acc[4];
#pragma unroll
    for (int mt = 0; mt < 4; ++mt) acc[mt] = (f32x4){0.f, 0.f, 0.f, 0.f};
#pragma unroll 1
    for (int c = 0; c < RS_AHEAD; ++c) issue(c);
#pragma unroll 1
    for (int c = 0; c < NCH; ++c) {
        if (c + RS_AHEAD < NCH) issue(c + RS_AHEAD);
        if (c + RS_AHEAD < NCH) { if (wid >= 1 && wid <= 5) asm volatile("s_waitcnt vmcnt(12)" ::: "memory"); else if (wid >= 6) asm volatile("s_waitcnt vmcnt(6)" ::: "memory"); }
        else if (wid >= 1) asm volatile("s_waitcnt vmcnt(0)" ::: "memory");
        __builtin_amdgcn_s_barrier(); asm volatile("" ::: "memory");
        if (wid == 0) {
            LAS const unsigned char* slot = L + (c & (RS_DEPTH - 1)) * RS_SLOT;
            u32x2 ga[4][2][2], hv[4];
#pragma unroll
            for (int mt = 0; mt < 4; ++mt) {
#pragma unroll
                for (int s = 0; s < 2; ++s)
#pragma unroll
                    for (int hh = 0; hh < 2; ++hh) ga[mt][s][hh] = *(LAS const u32x2*)(slot + ((16 * mt + fr) * GLD + 16 * (2 * s + hh) + 4 * fq) * 2);
                hv[mt] = *(LAS const u32x2*)(slot + 9216 + (fr * GLD + 16 * mt + 4 * fq) * 2); }
            bf16_t* Sc = SST + (size_t)c * 4096; u32x2 sp[4];
#pragma unroll
            for (int mt = 0; mt < 4; ++mt) { sp[mt].x = cvt_pk_bf16(acc[mt][0], acc[mt][1]); sp[mt].y = cvt_pk_bf16(acc[mt][2], acc[mt][3]);
                *(u32x2*)(Sc + (size_t)(16 * qi + fr) * 64 + 16 * mt + 4 * fq) = sp[mt]; }
            bf16x8 sb[2];
#pragma unroll
            for (int s = 0; s < 2; ++s) { u32x4 w; w.x = sp[2 * s].x; w.y = sp[2 * s].y; w.z = sp[2 * s + 1].x; w.w = sp[2 * s + 1].y; sb[s] = __builtin_bit_cast(bf16x8, w); }
#pragma unroll
            for (int mt = 0; mt < 4; ++mt) { f32x4 a = (f32x4){bf_lo(hv[mt].x), bf_hi(hv[mt].x), bf_lo(hv[mt].y), bf_hi(hv[mt].y)};
#pragma unroll
                for (int s = 0; s < 2; ++s) { u32x4 w; w.x = ga[mt][s][0].x; w.y = ga[mt][s][0].y; w.z = ga[mt][s][1].x; w.w = ga[mt][s][1].y;
                    a = __builtin_amdgcn_mfma_f32_16x16x32_bf16(__builtin_bit_cast(bf16x8, w), sb[s], a, 0, 0, 0); }
                acc[mt] = a; }
            asm volatile("s_waitcnt lgkmcnt(0)" ::: "memory");
        }
    }
    asm volatile("s_waitcnt vmcnt(0)" ::: "memory");
    __builtin_amdgcn_s_barrier(); asm volatile("" ::: "memory");
}
__device__ __forceinline__ void s5_scan_block(Frame& F, int gb) {
    const int g = gb >> 3, b = gb & 7, p = F.lane, w = F.wave;
    const float* aL = (const float*)(F.ws + WS_AL) + g * 128; const float ar = aL[2 * p], ai = aL[2 * p + 1];
    const float* SLc = (const float*)(F.ws + WS_SLOC) + ((size_t)g * S5ROWS + b * 256 + 32 * w) * 128 + 2 * p;
    bf16_t* UG = (bf16_t*)(F.ws + WS_UG) + ((size_t)g * S5ROWS + b * 256 + 32 * w) * UGLD + 256 + 2 * p;
    LAS float* E = (LAS float*)(F.lds);
    f32x2 l[32];
#pragma unroll
    for (int k = 0; k < 32; ++k) l[k] = *(const f32x2*)(SLc + (size_t)k * 128);
    float sr = 0.f, si = 0.f;
#pragma unroll
    for (int k = 0; k < 32; ++k) { const float nr = ar * sr - ai * si + l[k].x, ni = ar * si + ai * sr + l[k].y; l[k].x = sr; l[k].y = si; sr = nr; si = ni; }
    E[(w * 64 + p) * 2] = sr; E[(w * 64 + p) * 2 + 1] = si;
    float pr = ar, pi = ai;
#pragma unroll
    for (int q = 0; q < 5; ++q) { const float nr = pr * pr - pi * pi, ni = 2.f * pr * pi; pr = nr; pi = ni; }
    asm volatile("s_waitcnt lgkmcnt(0)" ::: "memory"); __builtin_amdgcn_s_barrier(); asm volatile("" ::: "memory");
    float cr = 0.f, ci = 0.f;
#pragma unroll
    for (int w2 = 0; w2 < 7; ++w2) { if (w2 < w) { const float er = E[(w2 * 64 + p) * 2], ei = E[(w2 * 64 + p) * 2 + 1]; const float nr = pr * cr - pi * ci + er, ni = pr * ci + pi * cr + ei; cr = nr; ci = ni; } }
#pragma unroll
    for (int k = 0; k < 32; ++k) { *(unsigned*)(UG + (size_t)k * UGLD) = cvt_pk_bf16(l[k].x + cr, l[k].y + ci); const float nr = ar * cr - ai * ci, ni = ar * ci + ai * cr; cr = nr; ci = ni; }
    asm volatile("s_waitcnt lgkmcnt(0)" ::: "memory"); __builtin_amdgcn_s_barrier(); asm volatile("" ::: "memory");
}
struct OutY { bf16x8 yq[2], yw[2]; u32x2 pv[4], pp[4], gv[4]; float bon; };
__device__ __forceinline__ void rwkv_out_loady(Frame& F, int unit, int at, OutY& Lq) {
    const int lane = F.lane, fr = lane & 15, fq = lane >> 4;
    const int bh = unit >> 6, c = unit & 63, b = bh >> 3, h = bh & 7;
    const bf16_t* QRT = (const bf16_t*)(F.ws + WS_QRT) + (size_t)unit * 4096; const bf16_t* WYT = (const bf16_t*)(F.ws + WS_WYT) + (size_t)unit * 4096;
#pragma unroll
    for (int s = 0; s < 2; ++s) { Lq.yq[s] = __builtin_nontemporal_load((const bf16x8*)(QRT + (size_t)(16 * at + fr) * 64 + 32 * s + 8 * fq)); Lq.yw[s] = __builtin_nontemporal_load((const bf16x8*)(WYT + (size_t)(16 * at + fr) * 64 + 32 * s + 8 * fq)); }
    const int tl = c * 64 + 16 * at + fr, tg = b * SEQ + tl;
    const bf16_t* prow = (const bf16_t*)(F.ws + WS_PR) + (size_t)tg * NRW + 1024 + h * 64;
    const bf16_t* gb = (const bf16_t*)(F.ws + WS_GBUF) + (size_t)tg * RW + h * 64;
    Lq.bon = ((const float*)(F.ws + WS_BONUS))[(size_t)tg * 8 + h];
    const bf16_t* pprev = prow - (tl > 0 ? NRW : 0);
#pragma unroll
    for (int bt = 0; bt < 4; ++bt) { const int i0 = 16 * bt + 4 * fq; Lq.pv[bt] = *(const u32x2*)(prow + i0); Lq.pp[bt] = *(const u32x2*)(pprev + i0); Lq.gv[bt] = *(const u32x2*)(gb + i0); }
}
__device__ __forceinline__ void rwkv_out_comp(Frame& F, int unit, int at, const bf16x8 (&xs)[2][4], const bf16x8 (&xv)[2][4], const OutY& Lq) {
    const int lane = F.lane, fr = lane & 15, fq = lane >> 4;
    const int bh = unit >> 6, c = unit & 63, b = bh >> 3, h = bh & 7;
    f32x4 m4[4], lw[4], lb[4];
#pragma unroll
    for (int bt = 0; bt < 4; ++bt) { const int i0 = 16 * bt + 4 * fq; m4[bt] = *(const f32x4*)(F.in[I_MU] + 1024 + h * 64 + i0); lw[bt] = *(const f32x4*)(F.in[I_LNW] + h * 64 + i0); lb[bt] = *(const f32x4*)(F.in[I_LNB] + h * 64 + i0); }
    f32x4 acc[4];
#pragma unroll
    for (int bt = 0; bt < 4; ++bt) acc[bt] = (f32x4){0.f, 0.f, 0.f, 0.f};
#pragma unroll
    for (int s = 0; s < 2; ++s)
#pragma unroll
        for (int bt = 0; bt < 4; ++bt) {
            acc[bt] = __builtin_amdgcn_mfma_f32_16x16x32_bf16(xs[s][bt], Lq.yq[s], acc[bt], 0, 0, 0);
            acc[bt] = __builtin_amdgcn_mfma_f32_16x16x32_bf16(xv[s][bt], Lq.yw[s], acc[bt], 0, 0, 0); }
    float s1 = 0.f;
#pragma unroll
    for (int bt = 0; bt < 4; ++bt) s1 += (acc[bt][0] + acc[bt][1]) + (acc[bt][2] + acc[bt][3]);
    s1 += __shfl_xor(s1, 16); s1 += __shfl_xor(s1, 32);
    const float mean = s1 * (1.f / 64.f); float s2 = 0.f;
#pragma unroll
    for (int bt = 0; bt < 4; ++bt) { const f32x4 d = acc[bt] - mean; s2 += (d[0] * d[0] + d[1] * d[1]) + (d[2] * d[2] + d[3] * d[3]); }
    s2 += __shfl_xor(s2, 16); s2 += __shfl_xor(s2, 32);
    const float rstd = __builtin_amdgcn_rsqf(s2 * (1.f / 64.f) + 64e-5f);
    const int tl = c * 64 + 16 * at + fr, tg = b * SEQ + tl;
    const float pmask = tl > 0 ? 1.f : 0.f;
    bf16_t* YRS = (bf16_t*)(F.dout + DO_YRS) + (size_t)tg * D + h * 64;
#pragma unroll
    for (int bt = 0; bt < 4; ++bt) { const int i0 = 16 * bt + 4 * fq;
        const u32x2 pv = Lq.pv[bt], pp = Lq.pp[bt], gv = Lq.gv[bt];
        const float x[4] = {bf_lo(pv.x), bf_hi(pv.x), bf_lo(pv.y), bf_hi(pv.y)}, xp[4] = {bf_lo(pp.x) * pmask, bf_hi(pp.x) * pmask, bf_lo(pp.y) * pmask, bf_hi(pp.y) * pmask}, gg[4] = {bf_lo(gv.x), bf_hi(gv.x), bf_lo(gv.y), bf_hi(gv.y)};
        float o[4];
#pragma unroll
        for (int e = 0; e < 4; ++e) { const float vsh = x[e] + (xp[e] - x[e]) * m4[bt][e]; o[e] = ((acc[bt][e] - mean) * rstd * lw[bt][e] + lb[bt][e] + Lq.bon * vsh) * gg[e]; }
        u32x2 w; w.x = cvt_pk_bf16(o[0], o[1]); w.y = cvt_pk_bf16(o[2], o[3]); *(u32x2*)(YRS + i0) = w; }
}
__device__ __forceinline__ void rwkv_out_units(Frame& F) {
    const int lane = F.lane, fr = lane & 15, fq = lane >> 4;
    for (int unit = F.vcu * NWAVES + F.wave; unit < NUNIT; unit += F.G * NWAVES) {
        const bf16_t* VT = (const bf16_t*)(F.ws + WS_VT) + (size_t)unit * 4096; const bf16_t* SST = (const bf16_t*)(F.dout + DO_SST) + (size_t)unit * 4096;
        bf16x8 xs[2][4], xv[2][4]; OutY A, B;
#pragma unroll
        for (int s = 0; s < 2; ++s)
#pragma unroll
            for (int bt = 0; bt < 4; ++bt) { xs[s][bt] = __builtin_nontemporal_load((const bf16x8*)(SST + (size_t)(16 * bt + fr) * 64 + 32 * s + 8 * fq)); xv[s][bt] = __builtin_nontemporal_load((const bf16x8*)(VT + (size_t)(16 * bt + fr) * 64 + 32 * s + 8 * fq)); }
        rwkv_out_loady(F, unit, 0, A); rwkv_out_loady(F, unit, 1, B); __builtin_amdgcn_sched_barrier(0);
        rwkv_out_comp(F, unit, 0, xs, xv, A); __builtin_amdgcn_sched_barrier(0); rwkv_out_loady(F, unit, 2, A); __builtin_amdgcn_sched_barrier(0);
        rwkv_out_comp(F, unit, 1, xs, xv, B); __builtin_amdgcn_sched_barrier(0); rwkv_out_loady(F, unit, 3, B); __builtin_amdgcn_sched_barrier(0);
        rwkv_out_comp(F, unit, 2, xs, xv, A); __builtin_amdgcn_sched_barrier(0);
        rwkv_out_comp(F, unit, 3, xs, xv, B); __builtin_amdgcn_sched_barrier(0);
    }
}

__device__ __forceinline__ void p8_rows(Frame& F) {
    const int gw = F.vcu * NWAVES + F.wave, NGW = F.G * NWAVES, lane = F.lane;
    const bf16_t* MX = (const bf16_t*)(F.ws + WS_MIXED); const float* ST = (const float*)(F.ws + WS_STAT1); bf16_t* H2 = (bf16_t*)(F.ws + WS_H2); float* X1 = (float*)F.dout;
    f32x4 gp[4];
#pragma unroll
    for (int j = 0; j < 4; ++j) gp[j] = *(const f32x4*)(F.in[I_NMPOST] + 256 * j + 4 * lane);
    for (int m0 = gw; m0 < T; m0 += 2 * NGW) {
        int mm[2] = {m0, (m0 + NGW < T) ? m0 + NGW : m0};
        f32x4 xv[2][4]; u32x2 mw[2][4]; float st[2];
#pragma unroll
        for (int q = 0; q < 2; ++q) { st[q] = (lane < 16) ? ST[(size_t)mm[q] * 16 + lane] : 0.f;
#pragma unroll
            for (int j = 0; j < 4; ++j) { const int col = 256 * j + 4 * lane; xv[q][j] = __builtin_nontemporal_load((const f32x4*)(F.in[I_X] + (size_t)mm[q] * D + col)); mw[q][j] = __builtin_nontemporal_load((const u32x2*)(MX + (size_t)mm[q] * D + col)); } }
#pragma unroll
        for (int q = 0; q < 2; ++q) {
            const float rstd1 = __builtin_amdgcn_rsqf(wave_sum(st[q]) * (1.f / D) + 1e-6f);
            f32x4 v[4]; float s = 0.f;
#pragma unroll
            for (int j = 0; j < 4; ++j) { const int col = 256 * j + 4 * lane;
                v[j].x = xv[q][j].x + bf_lo(mw[q][j].x) * rstd1 * gp[j].x; v[j].y = xv[q][j].y + bf_hi(mw[q][j].x) * rstd1 * gp[j].y; v[j].z = xv[q][j].z + bf_lo(mw[q][j].y) * rstd1 * gp[j].z; v[j].w = xv[q][j].w + bf_hi(mw[q][j].y) * rstd1 * gp[j].w;
                s += (v[j].x * v[j].x + v[j].y * v[j].y) + (v[j].z * v[j].z + v[j].w * v[j].w);
                }
            const float rstd2 = __builtin_amdgcn_rsqf(wave_sum(s) * (1.f / D) + 1e-6f);
#pragma unroll
            for (int j = 0; j < 4; ++j) { u32x2 w; w.x = cvt_pk_bf16(v[j].x * rstd2, v[j].y * rstd2); w.y = cvt_pk_bf16(v[j].z * rstd2, v[j].w * rstd2); *(u32x2*)(H2 + (size_t)mm[q] * D + 256 * j + 4 * lane) = w; }
        }
    }
}
__device__ __forceinline__ void p12_rows(Frame& F) {
    const int gw = F.vcu * NWAVES + F.wave, NGW = F.G * NWAVES, lane = F.lane;
    const bf16_t* FB = (const bf16_t*)(F.ws + WS_F); const bf16_t* MX = (const bf16_t*)(F.ws + WS_MIXED);
    const float* ST1 = (const float*)(F.ws + WS_STAT1); const float* ST2 = (const float*)(F.ws + WS_STAT2); float* OUT = (float*)F.dout;
    f32x4 gp[4], gq[4];
#pragma unroll
    for (int j = 0; j < 4; ++j) { gp[j] = *(const f32x4*)(F.in[I_NMPOST] + 256 * j + 4 * lane); gq[j] = *(const f32x4*)(F.in[I_NFPOST] + 256 * j + 4 * lane); }
    for (int m0 = gw; m0 < T; m0 += 2 * NGW) {
        int mm[2] = {m0, (m0 + NGW < T) ? m0 + NGW : m0};
        f32x4 xv[2][4]; u32x2 mw[2][4], fw[2][4]; float s1[2], s2[2];
#pragma unroll
        for (int q = 0; q < 2; ++q) { s1[q] = (lane < 16) ? ST1[(size_t)mm[q] * 16 + lane] : 0.f; s2[q] = (lane < 16) ? ST2[(size_t)mm[q] * 16 + lane] : 0.f;
#pragma unroll
            for (int j = 0; j < 4; ++j) { const int col = 256 * j + 4 * lane; xv[q][j] = __builtin_nontemporal_load((const f32x4*)(F.in[I_X] + (size_t)mm[q] * D + col));
                mw[q][j] = __builtin_nontemporal_load((const u32x2*)(MX + (size_t)mm[q] * D + col)); fw[q][j] = __builtin_nontemporal_load((const u32x2*)(FB + (size_t)mm[q] * D + col)); } }
#pragma unroll
        for (int q = 0; q < 2; ++q) {
            const float rstd1 = __builtin_amdgcn_rsqf(wave_sum(s1[q]) * (1.f / D) + 1e-6f), rstd3 = __builtin_amdgcn_rsqf(wave_sum(s2[q]) * (1.f / D) + 1e-6f);
#pragma unroll
            for (int j = 0; j < 4; ++j) { const int col = 256 * j + 4 * lane; f32x4 o;
                o.x = xv[q][j].x + bf_lo(mw[q][j].x) * rstd1 * gp[j].x; o.y = xv[q][j].y + bf_hi(mw[q][j].x) * rstd1 * gp[j].y; o.z = xv[q][j].z + bf_lo(mw[q][j].y) * rstd1 * gp[j].z; o.w = xv[q][j].w + bf_hi(mw[q][j].y) * rstd1 * gp[j].w;
                o.x += bf_lo(fw[q][j].x) * rstd3 * gq[j].x; o.y += bf_hi(fw[q][j].x) * rstd3 * gq[j].y; o.z += bf_lo(fw[q][j].y) * rstd3 * gq[j].z; o.w += bf_hi(fw[q][j].y) * rstd3 * gq[j].w;
                __builtin_nontemporal_store(o, (f32x4*)(OUT + (size_t)mm[q] * D + col)); }
        }
    }
}

#ifndef MK_PER_PHASE
#define MK_PER_PHASE 0
#endif
constexpr int NPHASE = 12;
struct Args { const float* in[35]; float* out; unsigned char* ws; int ph_lo, ph_hi; };
static_assert(sizeof(Args) == 35 * 8 + 8 + 8 + 8, "Args has no padding");

__device__ __forceinline__ bool phase_begin(Frame& F) { unsigned long long z = 0; asm volatile("" : "+s"(z), "+v"(F.tid)); F.ws = F.ws0 + z; F.dout = F.dout0 + z;     F.lane = F.tid & 63; F.wave = __builtin_amdgcn_readfirstlane(F.tid >> 6); return true; }
__global__ void __launch_bounds__(NWAVES * 64, 2) fwd_kernel(Args args) {
    extern __shared__ __attribute__((aligned(16))) unsigned char lds_raw[];
    Frame F;
    F.lds = (LAS unsigned char*)lds_raw;
    F.MISC = (volatile LAS unsigned*)(F.lds + MISC_OFF);
    F.tid = threadIdx.x; F.lane = F.tid & 63; F.wave = __builtin_amdgcn_readfirstlane(F.tid >> 6);
    F.G = gridDim.x; { const int bx = blockIdx.x; F.vcu = (F.G % 8 == 0) ? (bx % 8) * (F.G / 8) + bx / 8 : bx; }
    F.ws0 = args.ws; F.dout0 = (unsigned char*)args.out; F.ws = F.ws0; F.dout = F.dout0; F.ctl = (gu32*)(args.ws + WS_CTL);
    F.in = (InTab)__builtin_amdgcn_kernarg_segment_ptr();
    for (int u = F.tid; u < (LDS_BYTES - LDSCTL_OFF) / 4; u += NWAVES * 64) ((LAS unsigned*)(F.lds + LDSCTL_OFF))[u] = 0u;
    __syncthreads();
    XcdBarrier bar; bar.bar = (unsigned*)(F.ctl + CW_BAR); bar.x = 0; bar.st = nullptr;
    if (!MK_PER_PHASE) bar = xcd_barrier_post((unsigned*)(F.ctl + CW_BAR), F.MISC + 8);
    const int lo = args.ph_lo, hi = args.ph_hi;
#ifndef PHMASK
#define PHMASK 0xffffffffu
#endif
#define IN(k) (((PHMASK >> (k)) & 1u) && lo <= (k) && (k) < hi && phase_begin(F))
#ifndef REPMASK
#define REPMASK 0u
#endif
#define REPS(k) ((((REPMASK) >> (k)) & 1u) ? 2 : 1)
#define PH(k) for (int rep_ = 0; rep_ < REPS(k); ++rep_, (rep_ < REPS(k) ? xcd_barrier(bar) : (void)0))
#define INQ(k) (lo <= (k) && (k) < hi)
#define SEAM(k) do { if (INQ(k) && INQ((k) + 1)) xcd_barrier(bar); } while (0)
#define WSB(off) ((bf16_t*)(F.ws + (off)))
    const int bx = (int)blockIdx.x;

    PH(0) if (IN(0)) { p0_prologue(F); }
    SEAM(0);
    PH(1) if (IN(1)) {
        pg8::Gemm g{D, D, D, 0}; pg8::StaticOrder S; S.init(WSB(WS_XN), WSB(WS_WIN), D, D, T, NIN, F.G, bx);
        EpiInProj E{WSB(WS_PR), WSB(WS_UG), WSB(WS_GATES), F.in[I_BGATE], 0};
        pg8::gemm_phase<EpiInProj, pg8::StaticOrder, true>(F.lds, g, S, E, F.tid);
    }
    SEAM(1);
    PH(2) if (IN(2)) {
        PrePf pf;
        if (F.vcu < NB * NCH) rwkv_pre_fetch(F, (((F.vcu >> 6) * NHEAD) << 6) + (F.vcu & 63), true, pf, F.tid);
        {
            LAS f32x4* TB = (LAS f32x4*)(F.lds + XTRA_OFF + 4096);
            if (F.tid < NRW / 4) TB[F.tid] = ((const f32x4*)F.in[I_MU])[F.tid];
            const int pq = F.tid >> 7, pi = F.tid & 127;
            const float* psrc = pq == 0 ? F.in[I_W0] : pq == 1 ? F.in[I_A0] : pq == 2 ? F.in[I_KK] : F.in[I_KA];
            TB[NRW / 4 + F.tid] = ((const f32x4*)psrc)[pi];
            if (F.tid < 128) TB[NRW / 4 + 512 + F.tid] = ((const f32x4*)F.in[I_RK])[F.tid];
            BAR_LDS();
        }
        for (int pc = F.vcu; pc < NB * NCH; pc += F.G) {
#pragma unroll 1
            for (int hh = 0; hh < NHEAD; ++hh) { const int bq = pc >> 6, cq = pc & 63, u = ((bq * NHEAD + hh) << 6) + cq;
                const int un = (hh < NHEAD - 1) ? u + 64 : ((pc + F.G < NB * NCH) ? ((((pc + F.G) >> 6) * NHEAD) << 6) + ((pc + F.G) & 63) : NUNIT);
                rwkv_pre_unit(F, u, un, hh == 0, hh == NHEAD - 1, pf); } }
        pg8::Gemm g{256, UGLD, 256, 0}; S5Order S{WSB(WS_UG), WSB(WS_B1A), 256, F.G, bx};
        EpiSloc E{(float*)(F.ws + WS_SLOC), 0};
        pg8::gemm_phase<EpiSloc, S5Order, true>(F.lds, g, S, E, F.tid);
    }
    SEAM(2);
    PH(3) if (IN(3)) {
        for (int gb = F.vcu; gb < S5G * NB; gb += F.G) s5_scan_block(F, gb);
        for (int it = F.vcu; it < NB * NHEAD * 4; it += F.G) rwkv_scan_block(F, it);
    }
    SEAM(3);
    PH(4) if (IN(4)) {
        rwkv_out_units(F);
        VM_WAIT(); __syncthreads();
        pg8::Gemm g{384, UGLD, 384, 0}; S5Order S{WSB(WS_UG), WSB(WS_B1B), 384, F.G, bx};
        pg8::EpiGen8<FS5Out> E{FS5Out{WSB(WS_YSP)}, 0};
        pg8::gemm_phase<pg8::EpiGen8<FS5Out>, S5Order, true>(F.lds, g, S, E, F.tid);
    }
    SEAM(4);
    PH(5) if (IN(5)) {
        pg8::Gemm g{RW, RW, RW, 1}; pg8::StaticOrder S; S.init(WSB(WS_YSP), WSB(WS_WGLU), RW, RW, T, RW, F.G, bx); S.tstepA = (size_t)16 * 256 * 2;
        EpiGlu E{WSB(WS_YSP), (bf16_t*)(F.dout + DO_YRS), F.in[I_BGLU], 0};
        pg8::gemm_phase<EpiGlu, pg8::StaticOrder, true>(F.lds, g, S, E, F.tid);
    }
    SEAM(5);
    PH(6) if (IN(6)) {
        pg8::Gemm g{RW, D, D, 0};
        { pg8::StaticOrder S; S.init((const bf16_t*)(F.dout + DO_YRS), WSB(WS_WBRS), D, D, T, D, F.G, bx);
          EpiMergeA E{WSB(WS_GATES), WSB(WS_MERGED), 0};
          pg8::gemm_phase<EpiMergeA, pg8::StaticOrder, true>(F.lds, g, S, E, F.tid); }
        { pg8::StaticOrder S; S.init((const bf16_t*)(F.dout + DO_YRS) + RW, WSB(WS_WBRS) + RW, D, D, T, D, F.G, bx);
          EpiMergeB E{WSB(WS_GATES), WSB(WS_MERGED), 0};
          pg8::gemm_phase<EpiMergeB, pg8::StaticOrder, true>(F.lds, g, S, E, F.tid); }
    }
    SEAM(6);
    PH(7) if (IN(7)) {
        pg8::Gemm g{D, D, D, 0}; pg8::StaticOrder S; S.init(WSB(WS_MERGED), WSB(WS_WOUT), D, D, T, D, F.G, bx);
        EpiRowStat E{WSB(WS_MIXED), (float*)(F.ws + WS_STAT1), 0};
        pg8::gemm_phase<EpiRowStat, pg8::StaticOrder, false>(F.lds, g, S, E, F.tid);
    }
    SEAM(7);
    PH(8) if (IN(8)) { p8_rows(F);
        for (size_t i = (size_t)bx * 512 + F.tid; i < HZ_BYTES / 16; i += (size_t)F.G * 512) ((u32x4*)(F.ws + WS_HZ))[i] = (u32x4){0u, 0u, 0u, 0u}; }
    SEAM(8);
    PH(9) if (IN(9)) {
        pg8::Gemm g{D, D, D, 0}; UpOrder S{WSB(WS_H2), WSB(WS_WUP), F.G, bx};
        EpiConvAct E{WSB(WS_ACT), F.in[I_CONVW], F.in[I_CONVB], (LAS unsigned*)(F.lds + XTRA_OFF), (unsigned long long*)(F.ws + WS_HZ), (unsigned*)(F.ctl + 2), 0};
        pg8::gemm_phase<EpiConvAct, UpOrder, true>(F.lds, g, S, E, F.tid);
    }
    SEAM(9);
    PH(10) if (IN(10)) {
        pg8::Gemm g{FF, FF, FF, 0}; pg8::StaticOrder S; S.init(WSB(WS_ACT), WSB(WS_WDN), FF, FF, T, D, F.G, bx);
        EpiRowStat E{WSB(WS_F), (float*)(F.ws + WS_STAT2), 0};
        pg8::gemm_phase<EpiRowStat, pg8::StaticOrder, false>(F.lds, g, S, E, F.tid);
    }
    SEAM(10);
    if (IN(11)) p12_rows(F);
#undef IN
#undef INQ
#undef SEAM
#undef WSB
}

extern "C" void kernel_launch(void* const* d_in, const int* in_sizes, int n_in, void* d_out, int out_size, void* d_ws, size_t ws_size, hipStream_t stream) {
    static int grid = 0;
    if (grid == 0) {
        if (n_in != 35 || in_sizes[0] != T * D || out_size != T * D || ws_size < WS_END) { fprintf(stderr, "kernel_launch: unexpected shapes: n_in %d in0 %d out %d ws %zu (need %zu)\n", n_in, n_in > 0 ? in_sizes[0] : -1, out_size, ws_size, (size_t)WS_END); grid = -1; return; }
        int dev = 0, cus = 0, per_cu = 0;
        if (hipGetDevice(&dev) != hipSuccess || hipDeviceGetAttribute(&cus, hipDeviceAttributeMultiprocessorCount, dev) != hipSuccess) { fprintf(stderr, "kernel_launch: device query failed\n"); grid = -1; return; }
        if (hipFuncSetAttribute((const void*)fwd_kernel, hipFuncAttributeMaxDynamicSharedMemorySize, LDS_BYTES) != hipSuccess) { fprintf(stderr, "kernel_launch: hipFuncSetAttribute failed\n"); grid = -1; return; }
        if (hipOccupancyMaxActiveBlocksPerMultiprocessor(&per_cu, (const void*)fwd_kernel, NWAVES * 64, LDS_BYTES) != hipSuccess || per_cu < 1) fprintf(stderr, "kernel_launch: occupancy query reports %d blocks per CU\n", per_cu);
        (void)hipGetLastError();
        grid = cus;
    }
    if (grid < 0) return;
    if (hipMemsetAsync((char*)d_ws + WS_CTL, 0, CTL_ZERO_BYTES, stream) != hipSuccess) { fprintf(stderr, "kernel_launch: memset failed\n"); return; }
    Args a{};
    for (int i = 0; i < 35; ++i) a.in[i] = (const float*)d_in[i];
    a.out = (float*)d_out; a.ws = (unsigned char*)d_ws;
#if MK_PER_PHASE
    for (int ph = 0; ph < NPHASE; ++ph) { a.ph_lo = ph; a.ph_hi = ph + 1; hipLaunchKernelGGL(fwd_kernel, dim3(grid), dim3(NWAVES * 64), LDS_BYTES, stream, a); }
#else
    a.ph_lo = 0; a.ph_hi = NPHASE;
    hipLaunchKernelGGL(fwd_kernel, dim3(grid), dim3(NWAVES * 64), LDS_BYTES, stream, a);
#endif
    const hipError_t le = hipPeekAtLastError();
    if (le != hipSuccess) fprintf(stderr, "kernel_launch: launch failed: %s\n", hipGetErrorName(le));
}
```

```cpp
#include <hip/hip_runtime.h>
#include <cstdio>
#include <cstdint>

#define LAS __attribute__((address_space(3)))
#define GAS __attribute__((address_space(1)))
typedef unsigned short bf16_t;
typedef short bf16x8 __attribute__((ext_vector_type(8)));
typedef float f32x4 __attribute__((ext_vector_type(4)));
typedef float f32x2 __attribute__((ext_vector_type(2)));
typedef unsigned u32x4 __attribute__((ext_vector_type(4)));
typedef unsigned u32x2 __attribute__((ext_vector_type(2)));
typedef GAS unsigned gu32;

constexpr int T = 32768, SEQ = 4096, NB = 8, D = 1024, NIN = 4352, NRW = 1792, RW = 512, FF = 2816, FH = 1408;
constexpr int NHEAD = 8, HD = 64, NCH = 64  , NUNIT = NB * NHEAD * NCH;
constexpr int S5G = 32, S5ROWS = T / 16, UGLD = 384;

constexpr size_t MiB = 1u << 20;
constexpr size_t WS_CTL = 0, CTL_ZERO_BYTES = 1 * MiB;
constexpr size_t WS_WIN = 1 * MiB;
constexpr size_t WS_WUP = WS_WIN + (size_t)NIN * D * 2;
constexpr size_t WS_WDN = WS_WUP + (size_t)2 * FF * D * 2;
constexpr size_t WS_WOUT = WS_WDN + (size_t)D * FF * 2;
constexpr size_t WS_WBRS = WS_WOUT + (size_t)D * D * 2;
constexpr size_t WS_WGLU = WS_WBRS + (size_t)D * D * 2;
constexpr size_t WS_W2T = WS_WGLU + (size_t)RW * RW * 2;
constexpr size_t WS_A2T = WS_W2T + (size_t)RW * 64 * 2;
constexpr size_t WS_G2T = WS_A2T + (size_t)RW * 64 * 2;
constexpr size_t WS_B1A = WS_G2T + (size_t)RW * 128 * 2;
constexpr size_t WS_B1B = WS_B1A + (size_t)S5G * 256 * 256 * 2;
constexpr size_t WS_AL = WS_B1B + (size_t)S5G * 256 * 384 * 2;
constexpr size_t WS_WEND = WS_AL + (size_t)S5G * 64 * 2 * 4;
static_assert(WS_WEND <= 44 * MiB, "weights region");
constexpr size_t WS_XN = 44 * MiB;
constexpr size_t WS_QRT = 44 * MiB, WS_WYT = 76 * MiB;
constexpr size_t WS_MERGED = 44 * MiB, WS_H2 = 44 * MiB, WS_F = 44 * MiB;
constexpr size_t WS_PR = 108 * MiB;
constexpr size_t WS_MIXED = 304 * MiB, WS_STAT1 = 368 * MiB;
constexpr size_t WS_ACT = 108 * MiB;
constexpr size_t WS_STAT2 = 284 * MiB;
constexpr size_t WS_UG = 220 * MiB;
constexpr size_t WS_GATES = 268 * MiB;
constexpr size_t WS_SLOC = 396 * MiB, WS_YSP = 396 * MiB;
constexpr size_t WS_GBUF = 428 * MiB;
constexpr size_t WS_BONUS = 460 * MiB;
constexpr size_t WS_VT = 461 * MiB;
constexpr size_t WS_LRSCR = 493 * MiB;
constexpr size_t WS_Z = 336 * MiB;
constexpr size_t WS_END = 512 * MiB;
constexpr size_t DO_H = 0, DO_GT = 36 * MiB, DO_SST = 96 * MiB, DO_YRS = 0;
constexpr int GLD = 72;

constexpr int CW_BAR = 4096, CW_HF = 32768;
constexpr size_t WS_HZ = 290 * MiB, HZ_BYTES = (size_t)2816 * 4 * 2 * 32 * 8;

constexpr int RING_BYTES = 131072, LDSCTL_OFF = RING_BYTES, MISC_OFF = LDSCTL_OFF + 320, XTRA_OFF = LDSCTL_OFF + 1024, LDS_BYTES = 155648;
constexpr int NWAVES = 8;

#define RLX_AGENT __ATOMIC_RELAXED, __HIP_MEMORY_SCOPE_AGENT
#define LDS_WAIT() asm volatile("s_waitcnt lgkmcnt(0)" ::: "memory")
#define VM_WAIT() asm volatile("s_waitcnt vmcnt(0)" ::: "memory")

typedef __bf16 bf16x2_t __attribute__((ext_vector_type(2)));
__device__ __forceinline__ unsigned cvt_pk_bf16(float lo, float hi) { const f32x2 v = {lo, hi}; return __builtin_bit_cast(unsigned, __builtin_convertvector(v, bf16x2_t)); }
__device__ __forceinline__ float bf_lo(unsigned w) { return __uint_as_float(w << 16); }
__device__ __forceinline__ float bf_hi(unsigned w) { return __uint_as_float(w & 0xffff0000u); }
__device__ __forceinline__ float bf1(bf16_t h) { return __uint_as_float((unsigned)h << 16); }
__device__ __forceinline__ float fexp(float x) { return __builtin_amdgcn_exp2f(x * 1.44269504089f); }
__device__ __forceinline__ float fsigmoid(float x) { return __builtin_amdgcn_rcpf(1.0f + __builtin_amdgcn_exp2f(-1.44269504089f * x)); }
__device__ __forceinline__ float ftanh(float x) { return 1.0f - 2.0f * __builtin_amdgcn_rcpf(1.0f + __builtin_amdgcn_exp2f(2.88539008178f * x)); }
__device__ __forceinline__ float fgelu(float x) { const float u = 0.7978845608f * (x + 0.044715f * x * x * x); return x * fsigmoid(2.0f * u); }
__device__ __forceinline__ void unpack8(u32x4 w, float (&f)[8]) { f[0] = bf_lo(w.x); f[1] = bf_hi(w.x); f[2] = bf_lo(w.y); f[3] = bf_hi(w.y); f[4] = bf_lo(w.z); f[5] = bf_hi(w.z); f[6] = bf_lo(w.w); f[7] = bf_hi(w.w); }
__device__ __forceinline__ u32x4 pack8(const float (&f)[8]) { u32x4 w; w.x = cvt_pk_bf16(f[0], f[1]); w.y = cvt_pk_bf16(f[2], f[3]); w.z = cvt_pk_bf16(f[4], f[5]); w.w = cvt_pk_bf16(f[6], f[7]); return w; }
__device__ __forceinline__ float wave_sum(float v) {
#pragma unroll
    for (int o = 1; o < 64; o <<= 1) v += __shfl_xor(v, o);
    return v;
}

#define XB_TMO      128
#define XB_XCNT(j)  (256  + 64 * (j))
#define XB_XSUB(j)  (1280 + 64 * (j))
#define XB_XGEN(j)  (2304 + 64 * (j))
#define XB_TOP      3328
#define XB_TOPGEN   3392
#define XCD_BAR_WORDS 3456
#define XB_SPIN_CAP (1u << 18)
__device__ __forceinline__ unsigned xb_ld(unsigned* p)              { return __hip_atomic_load(p, __ATOMIC_RELAXED, __HIP_MEMORY_SCOPE_AGENT); }
__device__ __forceinline__ unsigned xb_add(unsigned* p, unsigned v) { return __hip_atomic_fetch_add(p, v, __ATOMIC_RELAXED, __HIP_MEMORY_SCOPE_AGENT); }
__device__ __forceinline__ unsigned xb_xcc_id() { return (unsigned)__builtin_amdgcn_s_getreg((3 << 11) | 20) & 0xFu; }
#define XB_SPIN(cond, bar) do { unsigned _sp = 0; while (cond) { __builtin_amdgcn_s_sleep(1); \
    if ((++_sp & 255u) == 0u) { if (xb_ld(&(bar)[XB_TMO])) break; if (_sp > XB_SPIN_CAP) { atomicAdd(&(bar)[XB_TMO], 1u); break; } } } } while (0)
struct XcdBarrier { unsigned* bar; unsigned x; volatile LAS unsigned* st; };
__device__ __forceinline__ XcdBarrier xcd_barrier_post(unsigned* bar, volatile LAS unsigned* st) {
    XcdBarrier b; b.bar = bar; b.x = xb_xcc_id(); b.st = st;
    if (threadIdx.x == 0) (void)xb_add(&bar[XB_XCNT(b.x)], 1u);
    return b;
}
__device__ __forceinline__ void xcd_barrier_complete(unsigned* bar, unsigned x, unsigned& nloc, unsigned& nx) {
    const unsigned G = gridDim.x * gridDim.y * gridDim.z;
    unsigned sum, cnt, mine, sp = 0u;
    for (;;) {
        sum = 0u; cnt = 0u; mine = 0u;
#pragma unroll
        for (unsigned j = 0; j < 16; ++j) { const unsigned c = xb_ld(&bar[XB_XCNT(j)]); sum += c; cnt += (c > 0u) ? 1u : 0u; mine = (j == x) ? c : mine; }
        if (sum == G) break;
        __builtin_amdgcn_s_sleep(1);
        if ((++sp & 255u) == 0u) { if (xb_ld(&bar[XB_TMO])) break; if (sp > XB_SPIN_CAP) { atomicAdd(&bar[XB_TMO], 1u); break; } }
    }
    nloc = mine > 0u ? mine : 1u; nx = cnt > 0u ? cnt : 1u;
}
__device__ __forceinline__ void xcd_barrier(const XcdBarrier& b) {
    asm volatile("s_waitcnt vmcnt(0)" ::: "memory");
    __syncthreads();
    if (threadIdx.x == 0) {
        unsigned* bar = b.bar;
        __builtin_amdgcn_s_waitcnt(0);
        unsigned nloc = b.st[0], nx = b.st[1];
        if (nloc == 0u) { xcd_barrier_complete(bar, b.x, nloc, nx); b.st[0] = nloc; b.st[1] = nx; }
        const unsigned old = xb_add(&bar[XB_XSUB(b.x)], 1u);
        const unsigned gen = old / nloc;
        if (old + 1u == (gen + 1u) * nloc) {
            __builtin_amdgcn_fence(__ATOMIC_RELEASE, "agent");
            asm volatile("s_waitcnt vmcnt(0)" ::: "memory");
            const unsigned og = xb_add(&bar[XB_TOP], 1u);
            const unsigned tg = og / nx;
            if (og + 1u == (tg + 1u) * nx) xb_add(&bar[XB_TOPGEN], 1u);
            else XB_SPIN(xb_ld(&bar[XB_TOPGEN]) == tg, bar);
            __builtin_amdgcn_fence(__ATOMIC_ACQUIRE, "agent");
            xb_add(&bar[XB_XGEN(b.x)], 1u);
            asm volatile("s_waitcnt vmcnt(0)" ::: "memory");
        } else {
            XB_SPIN(xb_ld(&bar[XB_XGEN(b.x)]) == gen, bar);
            __builtin_amdgcn_fence(__ATOMIC_ACQUIRE, "agent");
            asm volatile("s_waitcnt vmcnt(0)" ::: "memory");
        }
    }
    __syncthreads();
}

namespace pg8 {
constexpr int BM = 256, BK = 64, HALF = 128, HTB = HALF * BK * 2, STAGE_BYTES = 8 * HTB, NXCD = 8, WGM = 8;
__host__ __device__ __forceinline__ int lds_byte(int r, int c) { const int st = (r >> 4) * 2 + (c >> 5), rr = r & 15, cc = c & 31, ob = rr * 64 + cc * 2; return st * 1024 + (ob ^ (((ob >> 9) & 1) << 5)); }
__host__ __device__ __forceinline__ void stage_rc(int b, int& R, int& C) { const int st = b / 1024, sb = b % 1024, swz = sb ^ (((sb >> 9) & 1) << 5); R = (st >> 1) * 16 + swz / 64; C = (st & 1) * 32 + (swz % 64) / 2; }
__host__ __device__ __forceinline__ int perm32(int rho) { const int n = rho >> 4, i = rho & 15; return 8 * (i >> 2) + 4 * n + (i & 3); }

struct Unit { const char* a; const char* b; int pm, pn; };
struct Gemm { int K, lda, ldb, amode; };

struct StaticOrder {
    const bf16_t* A; const bf16_t* Bt; int lda, ldb;
    int nM, nN, nwg, G, c; size_t tstepA;
    __device__ void init(const bf16_t* A_, const bf16_t* Bt_, int lda_, int ldb_, int M, int N, int G_, int c_) { A = A_; Bt = Bt_; lda = lda_; ldb = ldb_; nM = M / BM; nN = N / BM; nwg = nM * nN; G = G_; c = c_; tstepA = (size_t)BM * lda * 2; }
    __device__ bool next(int i, Unit& u) const {
        const long L = (long)i * G + c; if (L >= nwg) return false;
        int wgid = (int)L; { const int q = nwg / NXCD, r = nwg % NXCD, xcd = wgid % NXCD, off = wgid / NXCD; wgid = (xcd < r ? xcd * (q + 1) : r * (q + 1) + (xcd - r) * q) + off; }
        const int nig = WGM * nN, gid = wgid / nig, fm = gid * WGM, gsz = (nM - fm) < WGM ? (nM - fm) : WGM;
        u.pm = fm + ((wgid % nig) % gsz); u.pn = (wgid % nig) / gsz;
        u.a = (const char*)A + (size_t)u.pm * tstepA; u.b = (const char*)Bt + (size_t)u.pn * BM * ldb * 2; return true;
    }
};

template <class Epi, class Sched, bool ALIGN_EPI = false, bool SP2 = true>
__device__ __forceinline__ void gemm_phase(LAS unsigned char* lds, const Gemm g, const Sched& S, const Epi& E, const int tid) {
    const int wid = __builtin_amdgcn_readfirstlane(tid >> 6), lane = tid & 63, wr = wid >> 2, wc = wid & 3, fr = lane & 15, fq = lane >> 4;
    const int K = g.K, nt = K / BK;
    unsigned voffA[2], voffB[2];
#pragma unroll
    for (int i = 0; i < 2; ++i) { int R, C; stage_rc(tid * 16 + i * 8192, R, C); const int Rb = Epi::PERM ? ((R & ~31) + perm32(R & 31)) : R;
        voffA[i] = g.amode ? (unsigned)((((C >> 4) * S5ROWS + (R >> 4)) * 256 + (R & 15) * 16 + (C & 15)) * 2) : (unsigned)(R * g.lda + C) * 2u; voffB[i] = (unsigned)(Rb * g.ldb + C) * 2u; }
    const size_t kstepB = (size_t)(BK * 2), kstepA = g.amode ? (size_t)4 * S5ROWS * 256 * 2 : (size_t)(BK * 2);
    const size_t hstepA = g.amode ? (size_t)8 * 256 * 2 : (size_t)HALF * g.lda * 2, hstepB = (size_t)HALF * g.ldb * 2;
    const unsigned ldsw = (unsigned)wid * 1024u;
    const int aoff = lds_byte(wr * 64 + fr, fq * 8), boff = lds_byte(wc * 32 + fr, fq * 8);
#define PG8_SA(b, h) (((b) * 2 + (h)) * HTB)
#define PG8_SB(b, h) ((4 + (b) * 2 + (h)) * HTB)
#define PG8_STAGE(bufoff, gbase, voff) do { _Pragma("unroll") for (int _i = 0; _i < 2; ++_i) \
        __builtin_amdgcn_global_load_lds((const unsigned*)((const char*)(gbase) + (voff)[_i]), (LAS unsigned*)(lds + (bufoff) + ldsw + _i * 8192), 16, 0, 0); } while (0)
#define PG8_LDA(dst, b, h) do { _Pragma("unroll") for (int m = 0; m < 4; ++m) _Pragma("unroll") for (int k = 0; k < 2; ++k) dst[m][k] = *(const LAS bf16x8*)(lds + PG8_SA(b, h) + aoff + m * 2048 + k * 1024); } while (0)
#define PG8_LDB(dst, b, h) do { _Pragma("unroll") for (int n = 0; n < 2; ++n) _Pragma("unroll") for (int k = 0; k < 2; ++k) dst[n][k] = *(const LAS bf16x8*)(lds + PG8_SB(b, h) + boff + n * 2048 + k * 1024); } while (0)
#define PG8_MMA(ai, bj, At, Bt) do { __builtin_amdgcn_s_setprio(1); _Pragma("unroll") for (int m = 0; m < 4; ++m) _Pragma("unroll") for (int n = 0; n < 2; ++n) _Pragma("unroll") for (int k = 0; k < 2; ++k) \
        acc[ai][bj][m][n] = __builtin_amdgcn_mfma_f32_16x16x32_bf16(Bt[n][k], At[m][k], acc[ai][bj][m][n], 0, 0, 0); __builtin_amdgcn_s_setprio(0); } while (0)
#define PG8_WAIT_V(n) asm volatile("s_waitcnt vmcnt(" #n ")" ::: "memory")
#define PG8_WAIT_L(n) asm volatile("s_waitcnt lgkmcnt(" #n ")" ::: "memory")
#define PG8_BAR __builtin_amdgcn_s_barrier()
#define PG8_SCHED __builtin_amdgcn_sched_barrier(0)
    Unit cur, nxt; int ui = 0;
    if (!S.next(0, cur)) return;
    f32x4 acc[2][2][4][2];
#pragma unroll
    for (int a = 0; a < 2; ++a)
#pragma unroll
        for (int b = 0; b < 2; ++b)
#pragma unroll
            for (int m = 0; m < 4; ++m)
#pragma unroll
                for (int n = 0; n < 2; ++n) acc[a][b][m][n] = (f32x4){0.f, 0.f, 0.f, 0.f};
    bf16x8 At[4][2], B0[2][2], B1[2][2];
    const char* cA = cur.a; const char* cB = cur.b;
    static_assert(SP2, "only the SP2 loop is kept");
    PG8_STAGE(PG8_SB(0, 0), cB, voffB); PG8_STAGE(PG8_SB(0, 1), cB + hstepB, voffB); PG8_STAGE(PG8_SA(0, 0), cA, voffA); PG8_STAGE(PG8_SA(0, 1), cA + hstepA, voffA);
    if (wr == 1) PG8_BAR;
    PG8_WAIT_V(2); PG8_BAR;
    PG8_STAGE(PG8_SB(1, 0), cB + kstepB, voffB); PG8_STAGE(PG8_SA(1, 0), cA + kstepA, voffA); PG8_STAGE(PG8_SB(1, 1), cB + hstepB + kstepB, voffB);
    PG8_WAIT_V(6); PG8_BAR;
    for (;;) {
        const bool has_next = S.next(ui + 1, nxt);
        const char* nA = has_next ? nxt.a : cA; const char* nB = has_next ? nxt.b : cB;
#pragma unroll 1
        for (int t = 0; t < nt; t += 2) {
            const bool last = (t == nt - 2);
            const char* a1 = cA + (size_t)(t + 1) * kstepA;
            const char* a2 = last ? nA : cA + (size_t)(t + 2) * kstepA; const char* b2 = last ? nB : cB + (size_t)(t + 2) * kstepB;
            const char* a3 = a2 + kstepA; const char* b3 = b2 + kstepB;
            PG8_LDB(B0, 0, 0); PG8_LDB(B1, 0, 1); PG8_SCHED; PG8_LDA(At, 0, 0); PG8_STAGE(PG8_SA(1, 1), a1 + hstepA, voffA);
            PG8_WAIT_V(8); PG8_WAIT_L(0); PG8_BAR; PG8_MMA(0, 0, At, B0); PG8_MMA(0, 1, At, B1); PG8_BAR; PG8_SCHED;
            PG8_LDA(At, 0, 1); PG8_STAGE(PG8_SB(0, 0), b2, voffB); PG8_STAGE(PG8_SB(0, 1), b2 + hstepB, voffB); PG8_STAGE(PG8_SA(0, 0), a2, voffA);
            PG8_WAIT_V(8); PG8_WAIT_L(0); PG8_BAR; PG8_MMA(1, 0, At, B0); PG8_MMA(1, 1, At, B1); PG8_BAR; PG8_SCHED;
            PG8_LDB(B0, 1, 0); PG8_LDB(B1, 1, 1); PG8_SCHED; PG8_LDA(At, 1, 0); PG8_STAGE(PG8_SA(0, 1), a2 + hstepA, voffA);
            PG8_WAIT_V(8); PG8_WAIT_L(0); PG8_BAR; PG8_MMA(0, 0, At, B0); PG8_MMA(0, 1, At, B1); PG8_BAR; PG8_SCHED;
            PG8_LDA(At, 1, 1); PG8_STAGE(PG8_SB(1, 0), b3, voffB); PG8_STAGE(PG8_SB(1, 1), b3 + hstepB, voffB); PG8_STAGE(PG8_SA(1, 0), a3, voffA);
            PG8_WAIT_V(8); PG8_WAIT_L(0); PG8_BAR; PG8_MMA(1, 0, At, B0); PG8_MMA(1, 1, At, B1); PG8_BAR; PG8_SCHED;
        }
        if constexpr (ALIGN_EPI) { if (wr == 0) PG8_BAR; }
        E(acc, cur, wr, wc, fr, fq);
        if (!has_next) break;
#pragma unroll
        for (int a = 0; a < 2; ++a)
#pragma unroll
            for (int b = 0; b < 2; ++b)
#pragma unroll
                for (int m = 0; m < 4; ++m)
#pragma unroll
                    for (int n = 0; n < 2; ++n) acc[a][b][m][n] = (f32x4){0.f, 0.f, 0.f, 0.f};
        cur = nxt; cA = nA; cB = nB; ++ui;
        if constexpr (ALIGN_EPI) { if (wr == 1) PG8_BAR; }
    }
    PG8_WAIT_V(0);
    if constexpr (!ALIGN_EPI) { if (wr == 0) PG8_BAR; }
    PG8_BAR;
#undef PG8_SA
#undef PG8_SB
#undef PG8_STAGE
#undef PG8_LDA
#undef PG8_LDB
#undef PG8_MMA
#undef PG8_WAIT_V
#undef PG8_WAIT_L
#undef PG8_BAR
#undef PG8_SCHED
}

template <class F> struct EpiGen8 {
    static constexpr bool PERM = true, HAS_MID = false; F f; int mid_t;
    __device__ __forceinline__ void mid(f32x4 (&)[2][2][4][2], const Unit&, int, int, int, int) const {}
    __device__ __forceinline__ void operator()(const f32x4 (&acc)[2][2][4][2], const Unit& u, int wr, int wc, int fr, int fq) const {
#pragma unroll
        for (int ai = 0; ai < 2; ++ai)
#pragma unroll
            for (int m = 0; m < 4; ++m) { const int r = ai * HALF + wr * 64 + m * 16 + fr;
#pragma unroll
                for (int bj = 0; bj < 2; ++bj) f(u, r, bj * HALF + wc * 32 + 8 * fq, acc[ai][bj][m][0], acc[ai][bj][m][1]);
                if constexpr (F::PIN) __builtin_amdgcn_sched_barrier(0); }
    }
};
}

typedef const float* cfp_t;
typedef __attribute__((address_space(4))) const cfp_t* InTab;
struct Frame {
    LAS unsigned char* lds;
    volatile LAS unsigned* MISC;
    gu32* ctl;
    int tid, lane, wave, vcu, G;
    unsigned char* ws; unsigned char* dout; unsigned char* ws0; unsigned char* dout0;
    InTab in;
};
enum { I_X = 0, I_NMPRE, I_NMPOST, I_NFPRE, I_NFPOST, I_WIN, I_BGATE, I_MU, I_W0, I_W2, I_A0, I_A2, I_G2, I_KK, I_KA, I_RK, I_LNW, I_LNB,
       I_SARE, I_SAIM, I_SBRE, I_SBIM, I_SCRE, I_SCIM, I_SD, I_SLOG, I_WGLU, I_BGLU, I_WBR, I_WBS, I_WOUT, I_WUP, I_CONVW, I_CONVB, I_WDN };

__device__ __forceinline__ void p0_transpose_item(const float* W, int ldw, int k0, int src0, bf16_t* WT, int ldt, int drow0, int koff, const float* kscale, LAS float* scr, int lane) {
    const int q = lane & 7, rb = lane >> 3;
    f32x4 v[8]; float sc[8];
#pragma unroll
    for (int i = 0; i < 8; ++i) { const int kk = 8 * i + rb; v[i] = __builtin_nontemporal_load((const f32x4*)(W + (size_t)(k0 + kk) * ldw + src0 + 4 * q)); sc[i] = kscale ? kscale[k0 + kk] : 1.0f; }
#pragma unroll
    for (int i = 0; i < 8; ++i) { const int kk = 8 * i + rb; LAS float* d = scr + kk * 33 + 4 * q; d[0] = v[i].x * sc[i]; d[1] = v[i].y * sc[i]; d[2] = v[i].z * sc[i]; d[3] = v[i].w * sc[i]; }
    LDS_WAIT(); asm volatile("" ::: "memory");
    const int c = lane & 7;
#pragma unroll
    for (int j = 0; j < 4; ++j) { const int n = (lane >> 3) + 8 * j; const LAS float* s = scr + (8 * c) * 33 + n;
        u32x4 o; o.x = cvt_pk_bf16(s[0 * 33], s[1 * 33]); o.y = cvt_pk_bf16(s[2 * 33], s[3 * 33]); o.z = cvt_pk_bf16(s[4 * 33], s[5 * 33]); o.w = cvt_pk_bf16(s[6 * 33], s[7 * 33]);
        *(GAS u32x4*)(WT + (size_t)(drow0 + n) * ldt + koff + k0 + 8 * c) = o; }
    LDS_WAIT(); asm volatile("" ::: "memory");
}
struct TrMat { int in_idx, K, N, ldt, koff, kind; size_t dst; int scale_idx; };
__device__ __forceinline__ void p0_do_matrix(Frame& F, const TrMat& mtx, int r, LAS float* scr) {
    const int nblk = mtx.N / 32, kb = r / nblk, nb = r % nblk;
    int src0 = 32 * nb;
    if (mtx.kind == 1) {
        const int pn = (32 * nb) >> 8, within = (32 * nb) & 255;
        src0 = (within < 128 ? 0 : FF - 128) + 128 * pn + within;
    }
    p0_transpose_item(F.in[mtx.in_idx], mtx.N, 64 * kb, src0, (bf16_t*)(F.ws + mtx.dst), mtx.ldt, 32 * nb, mtx.koff, mtx.scale_idx >= 0 ? F.in[mtx.scale_idx] : nullptr, scr, F.lane);
}
__device__ __forceinline__ void p0_s5_group(Frame& F, int g) {
    LAS float* pwr = (LAS float*)(F.lds);
    LAS float* pwi = pwr + 17 * 64;
    LAS float* bbr = pwi + 17 * 64;
    LAS float* bbi = bbr + 1024;
    LAS float* cre = bbi + 1024;
    LAS float* cim = cre + 1024;
    LAS float* kk = cim + 1024;
    const float dt = expf(F.in[I_SLOG][g]);
    for (int idx = F.tid; idx < 17 * 64; idx += 512) { const int k = idx >> 6, p = idx & 63;
        const float are = F.in[I_SARE][g * 64 + p], aim = F.in[I_SAIM][g * 64 + p];
        const float mag = expf((float)k * are * dt); float sn, cs; sincosf((float)k * aim * dt, &sn, &cs);
        pwr[idx] = mag * cs; pwi[idx] = mag * sn; }
    for (int idx = F.tid; idx < 1024; idx += 512) { cre[idx] = F.in[I_SCRE][g * 1024 + idx]; cim[idx] = F.in[I_SCIM][g * 1024 + idx]; }
    __syncthreads();
    for (int idx = F.tid; idx < 1024; idx += 512) { const int p = idx >> 4;
        const float are = F.in[I_SARE][g * 64 + p], aim = F.in[I_SAIM][g * 64 + p];
        const float nr = pwr[64 + p] - 1.0f, ni = pwi[64 + p];
        const float den = 1.0f / (are * are + aim * aim);
        const float qr = (nr * are + ni * aim) * den, qi = (ni * are - nr * aim) * den;
        const float br = F.in[I_SBRE][g * 1024 + idx], bi = F.in[I_SBIM][g * 1024 + idx];
        bbr[idx] = qr * br - qi * bi; bbi[idx] = qr * bi + qi * br; }
    __syncthreads();
    {
        const int kc = F.tid & 255, ph = F.tid >> 8, k = kc >> 4, c = kc & 15; float s[16];
#pragma unroll
        for (int e = 0; e < 16; ++e) s[e] = 0.f;
        for (int p = 32 * ph; p < 32 * ph + 32; ++p) { const float cr_ = cre[c * 64 + p], ci_ = cim[c * 64 + p], pr_ = pwr[k * 64 + p], pi_ = pwi[k * 64 + p];
            const float xr = cr_ * pr_ - ci_ * pi_, xi = cr_ * pi_ + ci_ * pr_;
#pragma unroll
            for (int e4 = 0; e4 < 4; ++e4) { const f32x4 br = *(LAS const f32x4*)(bbr + p * 16 + 4 * e4), bi = *(LAS const f32x4*)(bbi + p * 16 + 4 * e4);
#pragma unroll
                for (int e = 0; e < 4; ++e) s[4 * e4 + e] += xr * br[e] - xi * bi[e]; } }
        LAS float* part = kk + 4096;
        if (ph == 1) {
#pragma unroll
            for (int e4 = 0; e4 < 4; ++e4) *(LAS f32x4*)(part + kc * 16 + 4 * e4) = (f32x4){s[4 * e4], s[4 * e4 + 1], s[4 * e4 + 2], s[4 * e4 + 3]}; }
        __syncthreads();
        if (ph == 0) {
#pragma unroll
            for (int e4 = 0; e4 < 4; ++e4) { const f32x4 o = *(LAS const f32x4*)(part + kc * 16 + 4 * e4);
#pragma unroll
                for (int e = 0; e < 4; ++e) { float v = s[4 * e4 + e] + o[e]; if (k == 0 && c == 4 * e4 + e) v += F.in[I_SD][g * 16 + c]; kk[kc * 16 + 4 * e4 + e] = v; } } }
    }
    __syncthreads();
    bf16_t* B1b = (bf16_t*)(F.ws + WS_B1B) + (size_t)g * 256 * 384;
    for (int idx = F.tid; idx < 256 * 192; idx += 512) { const int n = idx / 192, k2 = (idx % 192) * 2; const int t = n >> 4, c = n & 15; float v[2];
#pragma unroll
        for (int e = 0; e < 2; ++e) { const int kx = k2 + e;
            if (kx < 256) { const int tau = kx >> 4, cp = kx & 15; v[e] = (t >= tau) ? kk[(t - tau) * 256 + c * 16 + cp] : 0.f; }
            else { const int si = kx - 256, p = si >> 1; const float xr = cre[c * 64 + p] * pwr[(t + 1) * 64 + p] - cim[c * 64 + p] * pwi[(t + 1) * 64 + p], xi = cre[c * 64 + p] * pwi[(t + 1) * 64 + p] + cim[c * 64 + p] * pwr[(t + 1) * 64 + p];
                v[e] = (si & 1) ? -xi : xr; } }
        *(unsigned*)(B1b + (size_t)n * 384 + k2) = cvt_pk_bf16(v[0], v[1]); }
    bf16_t* B1a = (bf16_t*)(F.ws + WS_B1A) + (size_t)g * 256 * 256;
    for (int idx = F.tid; idx < 256 * 128; idx += 512) { const int n = idx >> 7, k2 = (idx & 127) * 2; float v[2] = {0.f, 0.f};
        if (n < 128) { const int p = n >> 1;
#pragma unroll
            for (int e = 0; e < 2; ++e) { const int kx = k2 + e, tau = kx >> 4, cp = kx & 15; const float pr_ = pwr[(15 - tau) * 64 + p], pi_ = pwi[(15 - tau) * 64 + p];
                const float xr = pr_ * bbr[p * 16 + cp] - pi_ * bbi[p * 16 + cp], xi = pr_ * bbi[p * 16 + cp] + pi_ * bbr[p * 16 + cp]; v[e] = (n & 1) ? xi : xr; } }
        *(unsigned*)(B1a + (size_t)n * 256 + k2) = cvt_pk_bf16(v[0], v[1]); }
    float* aL = (float*)(F.ws + WS_AL) + g * 128;
    if (F.tid < 64) { aL[2 * F.tid] = pwr[16 * 64 + F.tid]; aL[2 * F.tid + 1] = pwi[16 * 64 + F.tid]; }
    __syncthreads();
}
__device__ __forceinline__ void p0_prologue(Frame& F) {
    if (F.vcu < S5G) p0_s5_group(F, F.vcu);
    if (F.vcu < S5G && F.G > S5G) return;
    LAS float* scr = (LAS float*)(F.lds + F.wave * 16384);
    const int gw = (F.G > S5G ? F.vcu - S5G : F.vcu) * NWAVES + F.wave, NGW = (F.G > S5G ? F.G - S5G : F.G) * NWAVES;
    int base = 0;
#define DO_MAT(in_idx, K_, N_, ldt_, koff_, kind_, dst_, sc_) do { const TrMat mtx{in_idx, K_, N_, ldt_, koff_, kind_, dst_, sc_}; const int items = ((K_) / 64) * ((N_) / 32); \
        for (int it = gw; it < base + items; it += NGW) { if (it >= base) p0_do_matrix(F, mtx, it - base, scr); } base += items; } while (0)
    DO_MAT(I_WIN, D, NIN, D, 0, 0, WS_WIN, I_NMPRE); DO_MAT(I_WUP, D, 2 * FF, D, 0, 1, WS_WUP, I_NFPRE); DO_MAT(I_WDN, FF, D, FF, 0, 0, WS_WDN, -1); DO_MAT(I_WOUT, D, D, D, 0, 0, WS_WOUT, -1);
    DO_MAT(I_WBR, RW, D, D, 0, 0, WS_WBRS, -1); DO_MAT(I_WBS, RW, D, D, RW, 0, WS_WBRS, -1); DO_MAT(I_WGLU, RW, RW, RW, 0, 0, WS_WGLU, -1);
    DO_MAT(I_W2, 64, RW, 64, 0, 0, WS_W2T, -1); DO_MAT(I_A2, 64, RW, 64, 0, 0, WS_A2T, -1); DO_MAT(I_G2, 128, RW, 128, 0, 0, WS_G2T, -1);
#undef DO_MAT
    if (F.vcu >= S5G || F.G <= S5G) {
        bf16_t* XN = (bf16_t*)(F.ws + WS_XN);
        const int gw2 = gw, NGW2 = NGW;
        for (int m = gw2; m < T; m += 2 * NGW2) {
            const int m1 = (m + NGW2 < T) ? m + NGW2 : m;
            const GAS f32x4* xr0 = (const GAS f32x4*)(F.in[I_X] + (size_t)m * D) + F.lane; const GAS f32x4* xr1 = (const GAS f32x4*)(F.in[I_X] + (size_t)m1 * D) + F.lane;
            f32x4 v0[4], v1[4]; float s0 = 0.f, s1 = 0.f;
#pragma unroll
            for (int j = 0; j < 4; ++j) { v0[j] = __builtin_nontemporal_load((const f32x4*)(xr0 + 64 * j)); v1[j] = __builtin_nontemporal_load((const f32x4*)(xr1 + 64 * j)); }
#pragma unroll
            for (int j = 0; j < 4; ++j) { s0 += (v0[j].x * v0[j].x + v0[j].y * v0[j].y) + (v0[j].z * v0[j].z + v0[j].w * v0[j].w); s1 += (v1[j].x * v1[j].x + v1[j].y * v1[j].y) + (v1[j].z * v1[j].z + v1[j].w * v1[j].w); }
            const float r0 = 1.0f / sqrtf(wave_sum(s0) * (1.f / D) + 1e-6f), r1 = 1.0f / sqrtf(wave_sum(s1) * (1.f / D) + 1e-6f);
            GAS u32x2* o0 = (GAS u32x2*)(XN + (size_t)m * D) + F.lane; GAS u32x2* o1 = (GAS u32x2*)(XN + (size_t)m1 * D) + F.lane;
#pragma unroll
            for (int j = 0; j < 4; ++j) { u32x2 w; w.x = cvt_pk_bf16(v0[j].x * r0, v0[j].y * r0); w.y = cvt_pk_bf16(v0[j].z * r0, v0[j].w * r0); o0[64 * j] = w;
                u32x2 w1; w1.x = cvt_pk_bf16(v1[j].x * r1, v1[j].y * r1); w1.y = cvt_pk_bf16(v1[j].z * r1, v1[j].w * r1); o1[64 * j] = w1; }
        }
    }
}

struct EpiInProj {
    static constexpr bool PERM = true, HAS_MID = false;
    bf16_t* PR; bf16_t* UG; bf16_t* GT; const float* bg; int mid_t;
    __device__ __forceinline__ void mid(f32x4 (&)[2][2][4][2], const pg8::Unit&, int, int, int, int) const {}
    __device__ __forceinline__ void operator()(const f32x4 (&acc)[2][2][4][2], const pg8::Unit& u, int wr, int wc, int fr, int fq) const {
        f32x4 b0[2], b1[2];
        if (u.pn >= 9) {
#pragma unroll
            for (int bj = 0; bj < 2; ++bj) { const int gc = (u.pn - 9) * 256 + bj * 128 + wc * 32 + 8 * fq; b0[bj] = *(const f32x4*)(bg + gc); b1[bj] = *(const f32x4*)(bg + gc + 4); } }
#pragma unroll
        for (int ai = 0; ai < 2; ++ai)
#pragma unroll
            for (int m = 0; m < 4; ++m) { const int row = u.pm * 256 + ai * 128 + wr * 64 + m * 16 + fr;
#pragma unroll
                for (int bj = 0; bj < 2; ++bj) { const int cl = bj * 128 + wc * 32 + 8 * fq; const f32x4 v0 = acc[ai][bj][m][0], v1 = acc[ai][bj][m][1]; u32x4 w;
                    if (u.pn < 7) { w.x = cvt_pk_bf16(v0[0], v0[1]); w.y = cvt_pk_bf16(v0[2], v0[3]); w.z = cvt_pk_bf16(v1[0], v1[1]); w.w = cvt_pk_bf16(v1[2], v1[3]);
                        *(u32x4*)(PR + (size_t)row * NRW + u.pn * 256 + cl) = w; }
                    else if (u.pn < 9) { const int cr = (u.pn - 7) * 256 + cl, g = cr >> 4, c0 = cr & 15;
                        w.x = cvt_pk_bf16(v0[0], v0[1]); w.y = cvt_pk_bf16(v0[2], v0[3]); w.z = cvt_pk_bf16(v1[0], v1[1]); w.w = cvt_pk_bf16(v1[2], v1[3]);
                        *(u32x4*)(UG + ((size_t)g * S5ROWS + (row >> 4)) * UGLD + (row & 15) * 16 + c0) = w; }
                    else { const int gc = (u.pn - 9) * 256 + cl;
                        w.x = cvt_pk_bf16(fsigmoid(v0[0] + b0[bj][0]), fsigmoid(v0[1] + b0[bj][1])); w.y = cvt_pk_bf16(fsigmoid(v0[2] + b0[bj][2]), fsigmoid(v0[3] + b0[bj][3]));
                        w.z = cvt_pk_bf16(fsigmoid(v1[0] + b1[bj][0]), fsigmoid(v1[1] + b1[bj][1])); w.w = cvt_pk_bf16(fsigmoid(v1[2] + b1[bj][2]), fsigmoid(v1[3] + b1[bj][3]));
                        __builtin_nontemporal_store(w, (u32x4*)(GT + (size_t)row * 2048 + gc)); } }
                __builtin_amdgcn_sched_barrier(0); }
    }
};
struct FS5Out {
    static constexpr bool PIN = true;
    bf16_t* YSP;
    __device__ __forceinline__ void operator()(const pg8::Unit& u, int r, int cl, f32x4 v0, f32x4 v1) const {
        const int crow = u.pm * 256 + r; u32x4 w;
        w.x = cvt_pk_bf16(fgelu(v0[0]), fgelu(v0[1])); w.y = cvt_pk_bf16(fgelu(v0[2]), fgelu(v0[3])); w.z = cvt_pk_bf16(fgelu(v1[0]), fgelu(v1[1])); w.w = cvt_pk_bf16(fgelu(v1[2]), fgelu(v1[3]));
        *(u32x4*)(YSP + ((size_t)u.pn * S5ROWS + crow) * 256 + cl) = w;
    }
};
struct EpiGlu {
    static constexpr bool PERM = true, HAS_MID = false;
    const bf16_t* YSP; bf16_t* YS; const float* bglu; int mid_t;
    __device__ __forceinline__ void mid(f32x4 (&)[2][2][4][2], const pg8::Unit&, int, int, int, int) const {}
    __device__ __forceinline__ void operator()(const f32x4 (&acc)[2][2][4][2], const pg8::Unit& u, int wr, int wc, int fr, int fq) const {
        u32x4 yv[2][4][2]; f32x4 b0[2], b1[2];
#pragma unroll
        for (int bj = 0; bj < 2; ++bj) { const int col = u.pn * 256 + bj * 128 + wc * 32 + 8 * fq; b0[bj] = *(const f32x4*)(bglu + col); b1[bj] = *(const f32x4*)(bglu + col + 4); }
#pragma unroll
        for (int ai = 0; ai < 2; ++ai)
#pragma unroll
            for (int m = 0; m < 4; ++m)
#pragma unroll
                for (int bj = 0; bj < 2; ++bj) { const int row = u.pm * 256 + ai * 128 + wr * 64 + m * 16 + fr, col = u.pn * 256 + bj * 128 + wc * 32 + 8 * fq;
                    yv[ai][m][bj] = __builtin_nontemporal_load((const u32x4*)(YSP + ((size_t)(col >> 4) * S5ROWS + (row >> 4)) * 256 + (row & 15) * 16 + (col & 15))); }
#pragma unroll
        for (int ai = 0; ai < 2; ++ai)
#pragma unroll
            for (int m = 0; m < 4; ++m) {
#pragma unroll
                for (int bj = 0; bj < 2; ++bj) { const int row = u.pm * 256 + ai * 128 + wr * 64 + m * 16 + fr, col = u.pn * 256 + bj * 128 + wc * 32 + 8 * fq; float y[8]; unpack8(yv[ai][m][bj], y);
                    const f32x4 v0 = acc[ai][bj][m][0], v1 = acc[ai][bj][m][1]; u32x4 w;
                    w.x = cvt_pk_bf16(y[0] * fsigmoid(v0[0] + b0[bj][0]), y[1] * fsigmoid(v0[1] + b0[bj][1])); w.y = cvt_pk_bf16(y[2] * fsigmoid(v0[2] + b0[bj][2]), y[3] * fsigmoid(v0[3] + b0[bj][3]));
                    w.z = cvt_pk_bf16(y[4] * fsigmoid(v1[0] + b1[bj][0]), y[5] * fsigmoid(v1[1] + b1[bj][1])); w.w = cvt_pk_bf16(y[6] * fsigmoid(v1[2] + b1[bj][2]), y[7] * fsigmoid(v1[3] + b1[bj][3]));
                    *(u32x4*)(YS + (size_t)row * D + RW + col) = w; }
                __builtin_amdgcn_sched_barrier(0); }
    }
};
struct FStore {
    static constexpr bool PIN = false;
    bf16_t* O; int ldc;
    __device__ __forceinline__ void operator()(const pg8::Unit& u, int r, int cl, f32x4 v0, f32x4 v1) const {
        u32x4 w; w.x = cvt_pk_bf16(v0[0], v0[1]); w.y = cvt_pk_bf16(v0[2], v0[3]); w.z = cvt_pk_bf16(v1[0], v1[1]); w.w = cvt_pk_bf16(v1[2], v1[3]);
        *(u32x4*)(O + (size_t)(u.pm * 256 + r) * ldc + u.pn * 256 + cl) = w;
    }
};
struct EpiMergeA {
    static constexpr bool PERM = true, HAS_MID = false;
    const bf16_t* GT; bf16_t* O; int mid_t;
    __device__ __forceinline__ void mid(f32x4 (&)[2][2][4][2], const pg8::Unit&, int, int, int, int) const {}
    __device__ __forceinline__ void operator()(const f32x4 (&acc)[2][2][4][2], const pg8::Unit& u, int wr, int wc, int fr, int fq) const {
        u32x4 gv[2][4][2];
#pragma unroll
        for (int ai = 0; ai < 2; ++ai)
#pragma unroll
            for (int m = 0; m < 4; ++m)
#pragma unroll
                for (int bj = 0; bj < 2; ++bj) { const int row = u.pm * 256 + ai * 128 + wr * 64 + m * 16 + fr, col = u.pn * 256 + bj * 128 + wc * 32 + 8 * fq;
                    gv[ai][m][bj] = __builtin_nontemporal_load((const u32x4*)(GT + (size_t)row * 2048 + col)); }
#pragma unroll
        for (int ai = 0; ai < 2; ++ai)
#pragma unroll
            for (int m = 0; m < 4; ++m) {
#pragma unroll
                for (int bj = 0; bj < 2; ++bj) { const int row = u.pm * 256 + ai * 128 + wr * 64 + m * 16 + fr, col = u.pn * 256 + bj * 128 + wc * 32 + 8 * fq; float g[8]; unpack8(gv[ai][m][bj], g);
                    const f32x4 v0 = acc[ai][bj][m][0], v1 = acc[ai][bj][m][1]; u32x4 w;
                    w.x = cvt_pk_bf16(v0[0] * g[0], v0[1] * g[1]); w.y = cvt_pk_bf16(v0[2] * g[2], v0[3] * g[3]); w.z = cvt_pk_bf16(v1[0] * g[4], v1[1] * g[5]); w.w = cvt_pk_bf16(v1[2] * g[6], v1[3] * g[7]);
                    *(u32x4*)(O + (size_t)row * D + col) = w; }
                __builtin_amdgcn_sched_barrier(0); }
    }
};
struct EpiMergeB {
    static constexpr bool PERM = true, HAS_MID = false;
    const bf16_t* GT; bf16_t* O; int mid_t;
    __device__ __forceinline__ void mid(f32x4 (&)[2][2][4][2], const pg8::Unit&, int, int, int, int) const {}
    __device__ __forceinline__ void operator()(const f32x4 (&acc)[2][2][4][2], const pg8::Unit& u, int wr, int wc, int fr, int fq) const {
#pragma unroll
        for (int ai = 0; ai < 2; ++ai) {
            u32x4 gv[4][2], tv[4][2];
#pragma unroll
            for (int m = 0; m < 4; ++m)
#pragma unroll
                for (int bj = 0; bj < 2; ++bj) { const int row = u.pm * 256 + ai * 128 + wr * 64 + m * 16 + fr, col = u.pn * 256 + bj * 128 + wc * 32 + 8 * fq;
                    gv[m][bj] = __builtin_nontemporal_load((const u32x4*)(GT + (size_t)row * 2048 + 1024 + col)); tv[m][bj] = *(const u32x4*)(O + (size_t)row * D + col); }
            __builtin_amdgcn_sched_barrier(0);
#pragma unroll
            for (int m = 0; m < 4; ++m) {
#pragma unroll
                for (int bj = 0; bj < 2; ++bj) { const int row = u.pm * 256 + ai * 128 + wr * 64 + m * 16 + fr, col = u.pn * 256 + bj * 128 + wc * 32 + 8 * fq; float g[8], t1[8]; unpack8(gv[m][bj], g); unpack8(tv[m][bj], t1);
                    const f32x4 v0 = acc[ai][bj][m][0], v1 = acc[ai][bj][m][1]; u32x4 w;
                    w.x = cvt_pk_bf16(t1[0] + v0[0] * g[0], t1[1] + v0[1] * g[1]); w.y = cvt_pk_bf16(t1[2] + v0[2] * g[2], t1[3] + v0[3] * g[3]);
                    w.z = cvt_pk_bf16(t1[4] + v1[0] * g[4], t1[5] + v1[1] * g[5]); w.w = cvt_pk_bf16(t1[6] + v1[2] * g[6], t1[7] + v1[3] * g[7]);
                    *(u32x4*)(O + (size_t)row * D + col) = w; }
                __builtin_amdgcn_sched_barrier(0); }
        }
    }
};
struct UpOrder {
    const bf16_t* H2; const bf16_t* Wt; int G, c;
    __device__ bool next(int i, pg8::Unit& u) const {
        constexpr int nM = NB * 16, nN = 22, nwg = nM * nN;
        const long L = (long)i * G + c; if (L >= nwg) return false;
        int wgid = (int)L; { const int q = nwg / 8, r = nwg % 8, xcd = wgid % 8, off = wgid / 8; wgid = (xcd < r ? xcd * (q + 1) : r * (q + 1) + (xcd - r) * q) + off; }
        const int nig = 8 * nN, gid = wgid / nig, fm = gid * 8, gsz = (nM - fm) < 8 ? (nM - fm) : 8;
        u.pm = fm + ((wgid % nig) % gsz); u.pn = (wgid % nig) / gsz;
        u.a = (const char*)H2 + ((size_t)u.pm * 256 * D) * 2; u.b = (const char*)(Wt + (size_t)u.pn * 256 * D); return true;
    }
};
template <int CTRL> __device__ __forceinline__ unsigned dppu(unsigned v) { return (unsigned)__builtin_amdgcn_update_dpp(0, (int)v, CTRL, 0xf, 0xf, true); }
struct EpiConvAct {
    static constexpr bool PERM = true, HAS_MID = false;
    bf16_t* ACT; const float* cw; const float* cb; LAS unsigned* EX; unsigned long long* HZ; unsigned* tmo; int mid_t;
    __device__ __forceinline__ void mid(f32x4 (&)[2][2][4][2], const pg8::Unit&, int, int, int, int) const {}
    __device__ __forceinline__ void operator()(f32x4 (&acc)[2][2][4][2], const pg8::Unit& u, int wr, int wc, int fr, int fq) const {
        const int b = u.pm >> 4, k = u.pm & 15, t0 = 256 * k;
        u32x2 zp[2][2][4][2];
#pragma unroll
        for (int ai = 0; ai < 2; ++ai)
#pragma unroll
            for (int bj = 0; bj < 2; ++bj)
#pragma unroll
                for (int m = 0; m < 4; ++m)
#pragma unroll
                    for (int n = 0; n < 2; ++n) { const f32x4 v = acc[ai][bj][m][n]; u32x2 w; w.x = cvt_pk_bf16(v[0], v[1]); w.y = cvt_pk_bf16(v[2], v[3]); zp[ai][bj][m][n] = w; }
        if (fr >= 14) {
#pragma unroll
            for (int ai = 0; ai < 2; ++ai)
#pragma unroll
                for (int bj = 0; bj < 2; ++bj)
#pragma unroll
                    for (int n = 0; n < 2; ++n) *(LAS u32x2*)(EX + (((wc * 4 + 2 * ai + wr) * 2 + (fr - 14)) * 32 + bj * 16 + fq * 4 + n * 2)) = zp[ai][bj][3][n]; }
        if (wr == 1 && k < 15 && fr >= 14) {
            unsigned long long* hz = HZ + ((size_t)(u.pm * 22 + u.pn) * 8 + wc * 2 + (fr - 14)) * 32;
#pragma unroll
            for (int bj = 0; bj < 2; ++bj)
#pragma unroll
                for (int n = 0; n < 2; ++n) { __hip_atomic_store(hz + bj * 16 + fq * 4 + n * 2, (1ull << 32) | zp[1][bj][3][n].x, RLX_AGENT); __hip_atomic_store(hz + bj * 16 + fq * 4 + n * 2 + 1, (1ull << 32) | zp[1][bj][3][n].y, RLX_AGENT); }
        }
        asm volatile("s_waitcnt lgkmcnt(0)" ::: "memory"); __builtin_amdgcn_s_barrier(); asm volatile("" ::: "memory");
        const int ch0 = u.pn * 128 + wc * 32 + 8 * fq;
        f32x4 wg[2][3], wv[2][3], bg[2], bv[2];
#pragma unroll
        for (int n = 0; n < 2; ++n) {
#pragma unroll
            for (int j = 0; j < 3; ++j) { wg[n][j] = *(const f32x4*)(cw + (size_t)j * 2 * FF + ch0 + 4 * n); wv[n][j] = *(const f32x4*)(cw + (size_t)j * 2 * FF + FF + ch0 + 4 * n); }
            bg[n] = *(const f32x4*)(cb + ch0 + 4 * n); bv[n] = *(const f32x4*)(cb + FF + ch0 + 4 * n); }
#pragma unroll
        for (int gi = 1; gi <= 8; ++gi) {
            const int ai = (gi & 7) >> 2, m = gi & 3, blk = 2 * ai + wr;
            u32x2 pp[2][2];
#pragma unroll
            for (int bj = 0; bj < 2; ++bj)
#pragma unroll
                for (int n = 0; n < 2; ++n) { pp[bj][n].x = 0u; pp[bj][n].y = 0u; }
            if (m > 0) {
#pragma unroll
                for (int bj = 0; bj < 2; ++bj)
#pragma unroll
                    for (int n = 0; n < 2; ++n) pp[bj][n] = zp[ai][bj][m - 1][n];
            } else if (blk > 0) {
                if (fr >= 14) {
#pragma unroll
                    for (int bj = 0; bj < 2; ++bj)
#pragma unroll
                        for (int n = 0; n < 2; ++n) pp[bj][n] = *(LAS const u32x2*)(EX + (((wc * 4 + blk - 1) * 2 + (fr - 14)) * 32 + bj * 16 + fq * 4 + n * 2)); }
            } else if (k > 0) {
                if (fr >= 14) {
                    const unsigned long long* hz = HZ + ((size_t)((u.pm - 1) * 22 + u.pn) * 8 + wc * 2 + (fr - 14)) * 32;
#pragma unroll
                    for (int bj = 0; bj < 2; ++bj)
#pragma unroll
                        for (int n = 0; n < 2; ++n) { unsigned long long x0, x1; unsigned sp_ = 0;
                            for (;;) { x0 = __hip_atomic_load(hz + bj * 16 + fq * 4 + n * 2, RLX_AGENT); x1 = __hip_atomic_load(hz + bj * 16 + fq * 4 + n * 2 + 1, RLX_AGENT);
                                if ((x0 >> 32) == 1ull && (x1 >> 32) == 1ull) break; __builtin_amdgcn_s_sleep(2); if (++sp_ > (1u << 20)) { __hip_atomic_store(tmo, 1u, RLX_AGENT); break; } }
                            pp[bj][n].x = (unsigned)x0; pp[bj][n].y = (unsigned)x1; } }
            }
            u32x2 outp[2];
#pragma unroll
            for (int n = 0; n < 2; ++n) {
                const u32x2 zg = zp[ai][0][m][n], zv = zp[ai][1][m][n], pg = pp[0][n], pv = pp[1][n];
                u32x2 g1, g2, v1, v2;
                g1.x = dppu<0x111>(zg.x) | dppu<0x10F>(pg.x); g1.y = dppu<0x111>(zg.y) | dppu<0x10F>(pg.y); g2.x = dppu<0x112>(zg.x) | dppu<0x10E>(pg.x); g2.y = dppu<0x112>(zg.y) | dppu<0x10E>(pg.y);
                v1.x = dppu<0x111>(zv.x) | dppu<0x10F>(pv.x); v1.y = dppu<0x111>(zv.y) | dppu<0x10F>(pv.y); v2.x = dppu<0x112>(zv.x) | dppu<0x10E>(pv.x); v2.y = dppu<0x112>(zv.y) | dppu<0x10E>(pv.y);
                const float z0g[4] = {bf_lo(zg.x), bf_hi(zg.x), bf_lo(zg.y), bf_hi(zg.y)}, z1g[4] = {bf_lo(g1.x), bf_hi(g1.x), bf_lo(g1.y), bf_hi(g1.y)}, z2g[4] = {bf_lo(g2.x), bf_hi(g2.x), bf_lo(g2.y), bf_hi(g2.y)};
                const float z0v[4] = {bf_lo(zv.x), bf_hi(zv.x), bf_lo(zv.y), bf_hi(zv.y)}, z1v[4] = {bf_lo(v1.x), bf_hi(v1.x), bf_lo(v1.y), bf_hi(v1.y)}, z2v[4] = {bf_lo(v2.x), bf_hi(v2.x), bf_lo(v2.y), bf_hi(v2.y)};
                float o[4];
#pragma unroll
                for (int e = 0; e < 4; ++e) { const float cg = bg[n][e] + wg[n][0][e] * z2g[e] + wg[n][1][e] * z1g[e] + wg[n][2][e] * z0g[e], cv = bv[n][e] + wv[n][0][e] * z2v[e] + wv[n][1][e] * z1v[e] + wv[n][2][e] * z0v[e];
                    o[e] = fgelu(cg) * cv; }
                outp[n].x = cvt_pk_bf16(o[0], o[1]); outp[n].y = cvt_pk_bf16(o[2], o[3]);
            }
            const int r = 128 * ai + 64 * wr + 16 * m + fr;
            { u32x4 w4; w4.x = outp[0].x; w4.y = outp[0].y; w4.z = outp[1].x; w4.w = outp[1].y; *(u32x4*)(ACT + ((size_t)(b * SEQ + t0 + r)) * FF + ch0) = w4; }
            __builtin_amdgcn_sched_barrier(0);
        }
    }
};
struct EpiRowStat {
    static constexpr bool PERM = true, HAS_MID = false; bf16_t* O; float* STAT; int mid_t;
    __device__ __forceinline__ void mid(f32x4 (&)[2][2][4][2], const pg8::Unit&, int, int, int, int) const {}
    __device__ __forceinline__ void operator()(const f32x4 (&acc)[2][2][4][2], const pg8::Unit& u, int wr, int wc, int fr, int fq) const {
#pragma unroll
        for (int ai = 0; ai < 2; ++ai)
#pragma unroll
            for (int m = 0; m < 4; ++m) { const int row = u.pm * 256 + ai * 128 + wr * 64 + m * 16 + fr; float s = 0.f;
#pragma unroll
                for (int bj = 0; bj < 2; ++bj) { const int col = u.pn * 256 + bj * 128 + wc * 32 + 8 * fq; const f32x4 v0 = acc[ai][bj][m][0], v1 = acc[ai][bj][m][1]; u32x4 w;
                    s += (v0[0] * v0[0] + v0[1] * v0[1]) + (v0[2] * v0[2] + v0[3] * v0[3]) + (v1[0] * v1[0] + v1[1] * v1[1]) + (v1[2] * v1[2] + v1[3] * v1[3]);
                    w.x = cvt_pk_bf16(v0[0], v0[1]); w.y = cvt_pk_bf16(v0[2], v0[3]); w.z = cvt_pk_bf16(v1[0], v1[1]); w.w = cvt_pk_bf16(v1[2], v1[3]);
                    __builtin_nontemporal_store(w, (u32x4*)(O + (size_t)row * D + col)); }
                s += __shfl_xor(s, 16); s += __shfl_xor(s, 32);
                if (fq == 0) STAT[(size_t)row * 16 + u.pn * 4 + wc] = s; }
    }
};
struct EpiSloc {
    static constexpr bool PERM = false, HAS_MID = false; float* SL; int mid_t;
    __device__ __forceinline__ void mid(f32x4 (&)[2][2][4][2], const pg8::Unit&, int, int, int, int) const {}
    __device__ __forceinline__ void operator()(const f32x4 (&acc)[2][2][4][2], const pg8::Unit& u, int wr, int wc, int fr, int fq) const {
#pragma unroll
        for (int ai = 0; ai < 2; ++ai)
#pragma unroll
            for (int m = 0; m < 4; ++m) { const int row = u.pm * 256 + ai * 128 + wr * 64 + m * 16 + fr; float* p = SL + ((size_t)u.pn * S5ROWS + row) * 128 + wc * 32 + 4 * fq;
                *(f32x4*)(p) = acc[ai][0][m][0]; *(f32x4*)(p + 16) = acc[ai][0][m][1]; }
    }
};
struct S5Order {
    const bf16_t* UG; const bf16_t* Bt; int ldb, G, c;
    __device__ bool next(int i, pg8::Unit& u) const { const int L = i * G + c; if (L >= S5G * 8) return false; const int g = L >> 3; u.pm = L & 7; u.pn = g;
        u.a = (const char*)(UG + ((size_t)g * S5ROWS + u.pm * 256) * UGLD); u.b = (const char*)(Bt + (size_t)g * 256 * ldb); return true; }
};

constexpr int LW = 72;
constexpr int SLOT = 64 * LW * 2;
#define SL(i) ((i) * SLOT)
#define BAR_LDS() do { asm volatile("s_waitcnt lgkmcnt(0)" ::: "memory"); __builtin_amdgcn_s_barrier(); asm volatile("" ::: "memory"); } while (0)
struct LdsMat { LAS const unsigned char* p; int ld; __device__ __forceinline__ bf16x8 frag(int row, int k) const { return *(LAS const bf16x8*)(p + ((size_t)row * ld + k) * 2); } };
struct GlbMat { const bf16_t* p; int ld; __device__ __forceinline__ bf16x8 frag(int row, int k) const { return *(const bf16x8*)(p + (size_t)row * ld + k); } };
template <int KD, class YM, class XM, class EPI>
__device__ __forceinline__ void mm64(const YM& Y, const XM& X, int wid, int lane, const EPI& epi) {
    asm volatile("" : "+v"(lane), "+s"(wid));
    const int at = wid >> 1, bt0 = (wid & 1) * 2, fr = lane & 15, fq = lane >> 4;
    f32x4 acc[2] = {(f32x4){0.f, 0.f, 0.f, 0.f}, (f32x4){0.f, 0.f, 0.f, 0.f}};
#pragma unroll
    for (int s = 0; s < KD / 32; ++s) {
        const bf16x8 yf = Y.frag(16 * at + fr, 32 * s + 8 * fq);
#pragma unroll
        for (int bi = 0; bi < 2; ++bi) { const bf16x8 xf = X.frag(16 * (bt0 + bi) + fr, 32 * s + 8 * fq);
            acc[bi] = __builtin_amdgcn_mfma_f32_16x16x32_bf16(xf, yf, acc[bi], 0, 0, 0); }
    }
#pragma unroll
    for (int bi = 0; bi < 2; ++bi) epi(16 * at + fr, 16 * (bt0 + bi) + 4 * fq, acc[bi]);
}
__device__ __forceinline__ void ld_yf(const LdsMat& Y, int at, int fr, int fq, bf16x8 (&y)[2]) {
#pragma unroll
    for (int s = 0; s < 2; ++s) y[s] = Y.frag(16 * at + fr, 32 * s + 8 * fq);
}
__device__ __forceinline__ void ld_xf(const LdsMat& X, int bt0, int fr, int fq, bf16x8 (&x)[2][2]) {
#pragma unroll
    for (int s = 0; s < 2; ++s)
#pragma unroll
        for (int bi = 0; bi < 2; ++bi) x[s][bi] = X.frag(16 * (bt0 + bi) + fr, 32 * s + 8 * fq);
}
__device__ __forceinline__ void mm_f(const bf16x8 (&y)[2], const bf16x8 (&x)[2][2], f32x4 (&acc)[2]) {
#pragma unroll
    for (int bi = 0; bi < 2; ++bi) acc[bi] = (f32x4){0.f, 0.f, 0.f, 0.f};
#pragma unroll
    for (int s = 0; s < 2; ++s)
#pragma unroll
        for (int bi = 0; bi < 2; ++bi) acc[bi] = __builtin_amdgcn_mfma_f32_16x16x32_bf16(x[s][bi], y[s], acc[bi], 0, 0, 0);
}
template <int KD>
__device__ __forceinline__ void preload_x(const GlbMat& X, int wid, int lane, bf16x8 (&xf)[KD / 32][2]) {
    const int bt0 = (wid & 1) * 2, fr = lane & 15, fq = lane >> 4;
#pragma unroll
    for (int s = 0; s < KD / 32; ++s)
#pragma unroll
        for (int bi = 0; bi < 2; ++bi) xf[s][bi] = X.frag(16 * (bt0 + bi) + fr, 32 * s + 8 * fq);
}
template <int KD, class YM, class EPI>
__device__ __forceinline__ void mm64_pre(const YM& Y, const bf16x8 (&xf)[KD / 32][2], int wid, int lane, const EPI& epi) {
    const int at = wid >> 1, bt0 = (wid & 1) * 2, fr = lane & 15, fq = lane >> 4;
    f32x4 acc[2] = {(f32x4){0.f, 0.f, 0.f, 0.f}, (f32x4){0.f, 0.f, 0.f, 0.f}};
#pragma unroll
    for (int s = 0; s < KD / 32; ++s) {
        const bf16x8 yf = Y.frag(16 * at + fr, 32 * s + 8 * fq);
#pragma unroll
        for (int bi = 0; bi < 2; ++bi) acc[bi] = __builtin_amdgcn_mfma_f32_16x16x32_bf16(xf[s][bi], yf, acc[bi], 0, 0, 0);
    }
#pragma unroll
    for (int bi = 0; bi < 2; ++bi) epi(16 * at + fr, 16 * (bt0 + bi) + 4 * fq, acc[bi]);
}
__device__ __forceinline__ void st_lds4(LAS unsigned char* base, int a, int b0, f32x4 v) { u32x2 w; w.x = cvt_pk_bf16(v[0], v[1]); w.y = cvt_pk_bf16(v[2], v[3]); *(LAS u32x2*)(base + ((size_t)a * LW + b0) * 2) = w; }
__device__ __forceinline__ f32x4 ld_lds4(LAS const unsigned char* base, int a, int b0) { const u32x2 w = *(LAS const u32x2*)(base + ((size_t)a * LW + b0) * 2); return (f32x4){bf_lo(w.x), bf_hi(w.x), bf_lo(w.y), bf_hi(w.y)}; }
__device__ __forceinline__ void st_glb4p(bf16_t* base, int a, int b0, f32x4 v) { u32x2 w; w.x = cvt_pk_bf16(v[0], v[1]); w.y = cvt_pk_bf16(v[2], v[3]); __builtin_nontemporal_store(w, (u32x2*)(base + (size_t)a * GLD + b0)); }
__device__ __forceinline__ void st_glb4(bf16_t* base, int a, int b0, f32x4 v) { u32x2 w; w.x = cvt_pk_bf16(v[0], v[1]); w.y = cvt_pk_bf16(v[2], v[3]); __builtin_nontemporal_store(w, (u32x2*)(base + (size_t)a * 64 + b0)); }

struct PrePf { u32x4 qa[3], qp[3], ra[4], rp[4]; };
__device__ __forceinline__ void rwkv_pre_fetch(Frame& F, int unit, bool lr_first, PrePf& P, int tid) {
    const int bh = unit >> 6, c = unit & 63, b = bh >> 3, h = bh & 7;
    const int t = tid >> 3, jb = tid & 7, j0 = jb * 8;
    const int tg = b * SEQ + c * 64 + t;
    const bool hasprev = (c * 64 + t) > 0;
    const bf16_t* prow = (const bf16_t*)(F.ws + WS_PR) + (size_t)tg * NRW; const bf16_t* pprv = hasprev ? prow - NRW : prow;
#pragma unroll
    for (int seg = 0; seg < 3; ++seg) { const int col = seg * 512 + h * 64 + j0; P.qa[seg] = *(const u32x4*)(prow + col); P.qp[seg] = *(const u32x4*)(pprv + col); }
    const u32x4* scr = (const u32x4*)(F.ws + WS_LRSCR) + ((size_t)F.vcu * 512 + tid) * 4;
    const u32x4* pa = lr_first ? (const u32x4*)(prow + 1536 + jb * 32) : scr; const u32x4* pp = lr_first ? (const u32x4*)(pprv + 1536 + jb * 32) : scr;
#pragma unroll
    for (int q4 = 0; q4 < 4; ++q4) { P.ra[q4] = pa[q4]; P.rp[q4] = pp[q4]; }
}
__device__ __forceinline__ void rwkv_pre_unit(Frame& F, int unit, int next_unit, bool lr_first, bool next_first, PrePf& P) {
    LAS unsigned char* L = F.lds;
    LAS float* XT = (LAS float*)(F.lds + XTRA_OFF);
    int tid = F.tid; asm volatile("" : "+v"(tid));
    int wid = F.wave; asm volatile("" : "+s"(wid));
    const int lane = tid & 63;
    const int bh = unit >> 6, c = unit & 63, b = bh >> 3, h = bh & 7;
    const int t = tid >> 3, jb = tid & 7, j0 = jb * 8;
    const int tg = b * SEQ + c * 64 + t;
    const bool hasprev = (c * 64 + t) > 0;
    const bf16_t* PR = (const bf16_t*)(F.ws + WS_PR);
    const bf16_t* prow = PR + (size_t)tg * NRW; const bf16_t* pprev = prow - NRW;
    LAS const float* mu = (LAS const float*)(F.lds + XTRA_OFF + 4096);
    LAS const float* par = mu + NRW;
    bf16x8 xw[2][2], xa[2][2], xg[4][2];
    {
        const GlbMat Xw{(const bf16_t*)(F.ws + WS_W2T) + (size_t)h * 64 * 64, 64}, Xa{(const bf16_t*)(F.ws + WS_A2T) + (size_t)h * 64 * 64, 64}, Xg{(const bf16_t*)(F.ws + WS_G2T) + (size_t)h * 64 * 128, 128};
        preload_x<64>(Xw, wid, lane, xw); preload_x<64>(Xa, wid, lane, xa); preload_x<128>(Xg, wid, lane, xg);
    }
    float rs[8], ks[8], vs[8];
    {
        const int c0 = 1536 + jb * 32;
        const float pmask = hasprev ? 1.f : 0.f;
        f32x4 mq[3][2];
#pragma unroll
        for (int seg = 0; seg < 3; ++seg) { const int col = seg * 512 + h * 64 + j0; mq[seg][0] = *(LAS const f32x4*)(mu + col); mq[seg][1] = *(LAS const f32x4*)(mu + col + 4); }
        LAS unsigned char* dst = (jb < 2) ? (L + SL(0) + ((size_t)t * LW + jb * 32) * 2) : (jb < 4) ? (L + SL(1) + ((size_t)t * LW + (jb - 2) * 32) * 2) : (L + SL(2) + ((size_t)t * 136 + (jb - 4) * 32) * 2);
        u32x4* scr = (u32x4*)(F.ws + WS_LRSCR) + ((size_t)F.vcu * 512 + tid) * 4;
        if (lr_first) {
            f32x4 ma[4][2];
#pragma unroll
            for (int q4 = 0; q4 < 4; ++q4) { ma[q4][0] = *(LAS const f32x4*)(mu + c0 + q4 * 8); ma[q4][1] = *(LAS const f32x4*)(mu + c0 + q4 * 8 + 4); }
#pragma unroll
            for (int q4 = 0; q4 < 4; ++q4) { float x[8], xp[8], o[8]; unpack8(P.ra[q4], x); unpack8(P.rp[q4], xp);
#pragma unroll
                for (int e = 0; e < 8; ++e) { const float mm = e < 4 ? ma[q4][0][e] : ma[q4][1][e - 4]; const float s = x[e] + (xp[e] * pmask - x[e]) * mm;
                    const float ex = __builtin_amdgcn_exp2f((jb < 2 ? 2.88539008178f : -1.44269504089f) * s), rc = __builtin_amdgcn_rcpf(1.0f + ex);
                    o[e] = jb < 2 ? 1.0f - 2.0f * rc : (jb < 4 ? s : rc); }
                const u32x4 w = pack8(o); *(LAS u32x4*)(dst + q4 * 16) = w; scr[q4] = w; }
        } else {
#pragma unroll
            for (int q4 = 0; q4 < 4; ++q4) *(LAS u32x4*)(dst + q4 * 16) = P.ra[q4];
        }
#pragma unroll
        for (int seg = 0; seg < 3; ++seg) { float x[8], xp[8]; unpack8(P.qa[seg], x); unpack8(P.qp[seg], xp);
#pragma unroll
            for (int e = 0; e < 8; ++e) { const float mm = e < 4 ? mq[seg][0][e] : mq[seg][1][e - 4]; const float s = x[e] + (xp[e] * pmask - x[e]) * mm; if (seg == 0) rs[e] = s; else if (seg == 1) ks[e] = s; else vs[e] = s; } }
    }
    BAR_LDS();
    {
        const LdsMat Yw{L + SL(0), LW}, Ya{L + SL(1), LW}, Yg{L + SL(2), 136};
        mm64_pre<64>(Yw, xw, wid, lane, [&](int a, int b0, f32x4 v) { *(LAS f32x4*)(L + SL(4) + ((size_t)a * 68 + b0) * 4) = v; });
        mm64_pre<64>(Ya, xa, wid, lane, [&](int a, int b0, f32x4 v) { *(LAS f32x4*)(L + SL(6) + ((size_t)a * 68 + b0) * 4) = v; });
        mm64_pre<128>(Yg, xg, wid, lane, [&](int a, int b0, f32x4 v) { *(LAS f32x4*)(L + SL(8) + ((size_t)a * 68 + b0) * 4) = v; });
    }
    BAR_LDS();
    float ld[8], kp[8], av[8], bv[8];
    {
        const int hc = h * 64 + j0;
        float wp[8], ap[8], gg[8], w0[8], a0[8], kkw[8], kaw[8], rk[8];
        *(f32x4*)&wp[0] = *(LAS f32x4*)(L + SL(4) + ((size_t)t * 68 + j0) * 4); *(f32x4*)&wp[4] = *(LAS f32x4*)(L + SL(4) + ((size_t)t * 68 + j0 + 4) * 4);
        *(f32x4*)&ap[0] = *(LAS f32x4*)(L + SL(6) + ((size_t)t * 68 + j0) * 4); *(f32x4*)&ap[4] = *(LAS f32x4*)(L + SL(6) + ((size_t)t * 68 + j0 + 4) * 4);
        *(f32x4*)&gg[0] = *(LAS f32x4*)(L + SL(8) + ((size_t)t * 68 + j0) * 4); *(f32x4*)&gg[4] = *(LAS f32x4*)(L + SL(8) + ((size_t)t * 68 + j0 + 4) * 4);
        *(f32x4*)&w0[0] = *(LAS const f32x4*)(par + 0 + hc); *(f32x4*)&w0[4] = *(LAS const f32x4*)(par + 0 + hc + 4);
        *(f32x4*)&a0[0] = *(LAS const f32x4*)(par + 512 + hc); *(f32x4*)&a0[4] = *(LAS const f32x4*)(par + 512 + hc + 4);
        *(f32x4*)&kkw[0] = *(LAS const f32x4*)(par + 1024 + hc); *(f32x4*)&kkw[4] = *(LAS const f32x4*)(par + 1024 + hc + 4);
        *(f32x4*)&kaw[0] = *(LAS const f32x4*)(par + 1536 + hc); *(f32x4*)&kaw[4] = *(LAS const f32x4*)(par + 1536 + hc + 4);
        *(f32x4*)&rk[0] = *(LAS const f32x4*)(par + 2048 + hc); *(f32x4*)&rk[4] = *(LAS const f32x4*)(par + 2048 + hc + 4);
        float ss = 0.f, bon = 0.f, kkv[8], eta[8];
#pragma unroll
        for (int e = 0; e < 8; ++e) {
            ld[e] = -0.60653065971f * fsigmoid(w0[e] + wp[e]);
            eta[e] = fsigmoid(a0[e] + ap[e]);
            kkv[e] = ks[e] * kkw[e]; ss += kkv[e] * kkv[e];
            kp[e] = ks[e] * (1.0f + (eta[e] - 1.0f) * kaw[e]);
            bon += rs[e] * kp[e] * rk[e];
        }
        ss += __shfl_xor(ss, 1); ss += __shfl_xor(ss, 2); ss += __shfl_xor(ss, 4);
        bon += __shfl_xor(bon, 1); bon += __shfl_xor(bon, 2); bon += __shfl_xor(bon, 4);
        const float inv = __builtin_amdgcn_rcpf(fmaxf(__builtin_amdgcn_sqrtf(ss), 1e-12f));
#pragma unroll
        for (int e = 0; e < 8; ++e) { const float kk = kkv[e] * inv; av[e] = -kk; bv[e] = kk * eta[e]; }
        if (jb == 0) ((float*)(F.ws + WS_BONUS))[(size_t)tg * 8 + h] = bon;
        *(u32x4*)((bf16_t*)(F.ws + WS_GBUF) + (size_t)tg * RW + hc) = pack8(gg);
    }
    float Lc[8];
#pragma unroll
    for (int e = 0; e < 8; ++e) { float x = ld[e];
        float y = __shfl_up(x, 8); if (lane >= 8) x += y;
        y = __shfl_up(x, 16); if (lane >= 16) x += y;
        y = __shfl_up(x, 32); if (lane >= 32) x += y;
        Lc[e] = x; }
    if (lane >= 56) {
#pragma unroll
        for (int e = 0; e < 8; ++e) XT[wid * 64 + j0 + e] = Lc[e]; }
    BAR_LDS();
    float LC[8], gC[8];
    {
        float pre[8], tot[8];
#pragma unroll
        for (int e = 0; e < 8; ++e) { pre[e] = 0.f; tot[e] = 0.f; }
#pragma unroll
        for (int w = 0; w < 8; ++w) { const f32x4 x0 = *(LAS const f32x4*)(XT + w * 64 + j0), x1 = *(LAS const f32x4*)(XT + w * 64 + j0 + 4); const float sel = (w < wid) ? 1.f : 0.f;
#pragma unroll
            for (int e = 0; e < 4; ++e) { tot[e] += x0[e]; tot[4 + e] += x1[e]; pre[e] += sel * x0[e]; pre[4 + e] += sel * x1[e]; } }
#pragma unroll
        for (int e = 0; e < 8; ++e) { Lc[e] += pre[e]; LC[e] = tot[e]; gC[e] = fexp(LC[e]); }
    }
    if (t == 63) {
#pragma unroll
        for (int e = 0; e < 8; ++e) XT[512 + j0 + e] = gC[e]; }
    {
        float o0[8], o1[8], o2[8], o3[8], o4[8], o5[8];
#pragma unroll
        for (int e = 0; e < 8; ++e) { const float ein = fexp(Lc[e]), eout = __builtin_amdgcn_rcpf(ein), eex = fexp(Lc[e] - ld[e]), eg = gC[e] * eout;
            o0[e] = rs[e] * ein; o1[e] = kp[e] * eout; o2[e] = av[e] * eex; o3[e] = bv[e] * eout; o4[e] = bv[e] * eg; o5[e] = kp[e] * eg; }
        const size_t off = ((size_t)t * LW + j0) * 2;
        *(LAS u32x4*)(L + SL(10) + off) = pack8(o0); *(LAS u32x4*)(L + SL(11) + off) = pack8(o1); *(LAS u32x4*)(L + SL(12) + off) = pack8(o2); *(LAS u32x4*)(L + SL(13) + off) = pack8(o3);
        *(LAS u32x4*)(L + SL(0) + off) = pack8(o4); *(LAS u32x4*)(L + SL(1) + off) = pack8(o5); *(LAS u32x4*)(L + SL(2) + off) = pack8(vs);
    }
    BAR_LDS();
    {
        const int srcs[4] = {12, 0, 1, 2}, dsts[4] = {4, 5, 6, 7};
#pragma unroll
        for (int q = 0; q < 4; ++q) { unsigned short hv[8];
#pragma unroll
            for (int e = 0; e < 8; ++e) hv[e] = *(LAS const unsigned short*)(L + SL(srcs[q]) + ((size_t)(8 * wid + e) * LW + lane) * 2);
            u32x4 w; w.x = hv[0] | ((unsigned)hv[1] << 16); w.y = hv[2] | ((unsigned)hv[3] << 16); w.z = hv[4] | ((unsigned)hv[5] << 16); w.w = hv[6] | ((unsigned)hv[7] << 16);
            *(LAS u32x4*)(L + SL(dsts[q]) + ((size_t)lane * LW + 8 * wid) * 2) = w;
        }
    }
    BAR_LDS();
    if (next_unit < NUNIT) rwkv_pre_fetch(F, next_unit, next_first, P, tid);
    const int crow = tid >> 3, cch = tid & 7;
    __builtin_nontemporal_store(*(LAS const u32x4*)(L + SL(7) + ((size_t)crow * LW + cch * 8) * 2), (u32x4*)((bf16_t*)(F.ws + WS_VT) + (size_t)unit * 4096 + crow * 64 + cch * 8));
    {
        const LdsMat Rt{L + SL(10), LW}, Kt{L + SL(11), LW}, At{L + SL(12), LW}, Bt{L + SL(13), LW};
        f32x4 nd = (f32x4){0.f, 0.f, 0.f, 0.f}, ntd = nd;
        {
            int ln = lane, wd = wid; asm volatile("" : "+v"(ln), "+s"(wd));
            const int at = wd >> 1, bt0 = (wd & 1) * 2, fr = ln & 15, fq = ln >> 4, a = 16 * at + fr;
            bf16x8 yA[2], yK[2], yR[2], xB[2][2], xA[2][2], xK[2][2];
            ld_yf(At, at, fr, fq, yA); ld_xf(Bt, bt0, fr, fq, xB); ld_yf(Kt, at, fr, fq, yK); ld_xf(At, bt0, fr, fq, xA); ld_yf(Rt, at, fr, fq, yR); ld_xf(Kt, bt0, fr, fq, xK);
            const bool diag = bt0 == (at & 2);
            bf16x8 xd[2];
            if (diag) ld_yf(Bt, at, fr, fq, xd);
            f32x4 c0[2], c1[2], c2[2], c3[2];
            mm_f(yA, xB, c0); mm_f(yK, xA, c1); mm_f(yR, xB, c2); mm_f(yR, xK, c3);
            if (diag) {
                f32x4 v = (f32x4){0.f, 0.f, 0.f, 0.f};
#pragma unroll
                for (int s = 0; s < 2; ++s) v = __builtin_amdgcn_mfma_f32_16x16x32_bf16(yA[s], xd[s], v, 0, 0, 0);
#pragma unroll
                for (int e = 0; e < 4; ++e) v[e] = (fr < 4 * fq + e) ? v[e] : 0.f;
                nd = v; }
#pragma unroll
            for (int bi = 0; bi < 2; ++bi) { const int b0 = 16 * (bt0 + bi) + 4 * fq; f32x4 v0 = c0[bi], v1 = c1[bi], v2 = c2[bi], v3 = c3[bi];
#pragma unroll
                for (int e = 0; e < 4; ++e) { v0[e] = (b0 + e < a) ? v0[e] : 0.f; v1[e] = (a < b0 + e) ? v1[e] : 0.f; v2[e] = (b0 + e <= a) ? v2[e] : 0.f; v3[e] = (b0 + e <= a) ? v3[e] : 0.f; }
                st_lds4(L + SL(1), a, b0, v0); st_lds4(L + SL(2), a, b0, v1); st_lds4(L + SL(3), a, b0, v2); st_lds4(L + SL(8), a, b0, v3);
                if (bt0 + bi == at) ntd = v0; }
        }
        const int at = wid >> 1;
        if (((wid & 1) * 2 == (at & 2))) {
            const int fr = lane & 15, fq = lane >> 4;
            auto op = [](f32x4 v) { u32x4 w; w.x = cvt_pk_bf16(v[0], v[1]); w.y = cvt_pk_bf16(v[2], v[3]); w.z = 0u; w.w = 0u; return __builtin_bit_cast(bf16x8, w); };
            const f32x4 zero = (f32x4){0.f, 0.f, 0.f, 0.f};
            const f32x4 Lm = ntd, LT = nd;
            f32x4 Q = Lm;
#pragma unroll
            for (int e = 0; e < 4; ++e) Q[e] += (4 * fq + e == fr) ? 1.f : 0.f;
            const f32x4 L2 = __builtin_amdgcn_mfma_f32_16x16x32_bf16(op(LT), op(Lm), zero, 0, 0, 0), L2T = __builtin_amdgcn_mfma_f32_16x16x32_bf16(op(Lm), op(LT), zero, 0, 0, 0);
            Q = __builtin_amdgcn_mfma_f32_16x16x32_bf16(op(L2T), op(Q), Q, 0, 0, 0);
            const f32x4 L4 = __builtin_amdgcn_mfma_f32_16x16x32_bf16(op(L2T), op(L2), zero, 0, 0, 0), L4T = __builtin_amdgcn_mfma_f32_16x16x32_bf16(op(L2), op(L2T), zero, 0, 0, 0);
            Q = __builtin_amdgcn_mfma_f32_16x16x32_bf16(op(L4T), op(Q), Q, 0, 0, 0);
            const f32x4 L8T = __builtin_amdgcn_mfma_f32_16x16x32_bf16(op(L4), op(L4T), zero, 0, 0, 0);
            Q = __builtin_amdgcn_mfma_f32_16x16x32_bf16(op(L8T), op(Q), Q, 0, 0, 0);
            st_lds4(L + SL(9), 16 * at + fr, 4 * fq, Q);
        }
    }
    BAR_LDS();
    {
        const int fr = lane & 15, fq = lane >> 4;
        LAS const unsigned char* zsl = L + (wid < 4 ? SL(4) : SL(2)); LAS unsigned char* dsl = L + (wid < 4 ? SL(11) : SL(12));
        const int arow = 16 * (wid & 3) + fr;
        u32x2 zp[4];
#pragma unroll
        for (int c = 0; c < 4; ++c) {
            f32x4 acc = ld_lds4(zsl, arow, 16 * c + 4 * fq);
            if (c >= 1) {
                const u32x2 alo = *(LAS const u32x2*)(L + SL(1) + ((size_t)(16 * c + fr) * LW + 4 * fq) * 2), ahi = *(LAS const u32x2*)(L + SL(1) + ((size_t)(16 * c + fr) * LW + 16 + 4 * fq) * 2);
                u32x4 aw; aw.x = alo.x; aw.y = alo.y; aw.z = ahi.x; aw.w = ahi.y;
                u32x4 bw; bw.x = zp[0].x; bw.y = zp[0].y; bw.z = c >= 2 ? zp[1].x : 0u; bw.w = c >= 2 ? zp[1].y : 0u;
                acc = __builtin_amdgcn_mfma_f32_16x16x32_bf16(__builtin_bit_cast(bf16x8, aw), __builtin_bit_cast(bf16x8, bw), acc, 0, 0, 0); }
            if (c == 3) {
                const u32x2 alo = *(LAS const u32x2*)(L + SL(1) + ((size_t)(48 + fr) * LW + 32 + 4 * fq) * 2);
                u32x4 aw; aw.x = alo.x; aw.y = alo.y; aw.z = 0u; aw.w = 0u;
                u32x4 bw; bw.x = zp[2].x; bw.y = zp[2].y; bw.z = 0u; bw.w = 0u;
                acc = __builtin_amdgcn_mfma_f32_16x16x32_bf16(__builtin_bit_cast(bf16x8, aw), __builtin_bit_cast(bf16x8, bw), acc, 0, 0, 0); }
            const u32x2 dlo = *(LAS const u32x2*)(L + SL(9) + ((size_t)(16 * c + fr) * LW + 4 * fq) * 2);
            u32x4 aw; aw.x = dlo.x; aw.y = dlo.y; aw.z = 0u; aw.w = 0u;
            u32x4 bw; bw.x = cvt_pk_bf16(acc[0], acc[1]); bw.y = cvt_pk_bf16(acc[2], acc[3]); bw.z = 0u; bw.w = 0u;
            const f32x4 r = __builtin_amdgcn_mfma_f32_16x16x32_bf16(__builtin_bit_cast(bf16x8, aw), __builtin_bit_cast(bf16x8, bw), (f32x4){0.f, 0.f, 0.f, 0.f}, 0, 0, 0);
            zp[c].x = cvt_pk_bf16(r[0], r[1]); zp[c].y = cvt_pk_bf16(r[2], r[3]);
            *(LAS u32x2*)(dsl + ((size_t)arow * LW + 16 * c + 4 * fq) * 2) = zp[c];
        }
    }
    BAR_LDS();
    {
        const int sAT = 11, sAkT = 12, sHk = 0;
        const LdsMat AT{L + SL(sAT), LW}, AkT{L + SL(sAkT), LW}, AbrT{L + SL(3), LW}, BgT{L + SL(5), LW}, VTm{L + SL(7), LW};
        bf16_t* QRT = (bf16_t*)(F.ws + WS_QRT) + (size_t)unit * 4096; bf16_t* WYT = (bf16_t*)(F.ws + WS_WYT) + (size_t)unit * 4096;
        bf16_t* GTg = (bf16_t*)(F.dout + DO_GT) + (size_t)unit * (64 * GLD); bf16_t* Hg = (bf16_t*)(F.dout + DO_H) + (size_t)unit * (64 * GLD);
        {
            int ln = lane, wd = wid; asm volatile("" : "+v"(ln), "+s"(wd));
            const int at = wd >> 1, bt0 = (wd & 1) * 2, fr = ln & 15, fq = ln >> 4, a = 16 * at + fr;
            bf16x8 yA[2], yB[2], xT[2][2], xK[2][2];
            ld_yf(BgT, at, fr, fq, yB); ld_xf(AkT, bt0, fr, fq, xK); ld_yf(AbrT, at, fr, fq, yA); ld_xf(AT, bt0, fr, fq, xT);
            f32x4 eH[2], eR[2], eW[2];
#pragma unroll
            for (int bi = 0; bi < 2; ++bi) { const int b0 = 16 * (bt0 + bi) + 4 * fq; eH[bi] = ld_lds4(L + SL(6), a, b0); eR[bi] = ld_lds4(L + SL(10), a, b0); eW[bi] = ld_lds4(L + SL(8), a, b0); }
            const float gdiag = XT[512 + a];
            f32x4 cH[2], cQ[2], cW[2], cG[2];
            mm_f(yB, xK, cH); mm_f(yA, xT, cQ); mm_f(yA, xK, cW); mm_f(yB, xT, cG);
#pragma unroll
            for (int bi = 0; bi < 2; ++bi) { const int b0 = 16 * (bt0 + bi) + 4 * fq;
                st_lds4(L + SL(sHk), a, b0, cH[bi] + eH[bi]);
                st_lds4(L + SL(1), a, b0, cQ[bi] + eR[bi]);
                st_lds4(L + SL(2), a, b0, cW[bi] + eW[bi]);
                f32x4 v = cG[bi];
#pragma unroll
                for (int e = 0; e < 4; ++e) v[e] += (b0 + e == a) ? gdiag : 0.f;
                st_lds4(L + SL(4), a, b0, v); }
        }
        BAR_LDS();
        const LdsMat HkT{L + SL(sHk), LW};
        mm64<64>(VTm, HkT, wid, lane, [&](int a, int b0, f32x4 v) { st_lds4(L + SL(13), a, b0, v); });
        __builtin_nontemporal_store(*(LAS const u32x4*)(L + SL(1) + ((size_t)crow * LW + cch * 8) * 2), (u32x4*)(QRT + crow * 64 + cch * 8));
        __builtin_nontemporal_store(*(LAS const u32x4*)(L + SL(2) + ((size_t)crow * LW + cch * 8) * 2), (u32x4*)(WYT + crow * 64 + cch * 8));
        __builtin_nontemporal_store(*(LAS const u32x4*)(L + SL(4) + (size_t)tid * 16), (u32x4*)GTg + tid);
        if (tid < 64) __builtin_nontemporal_store(*(LAS const u32x4*)(L + SL(4) + (size_t)(512 + tid) * 16), (u32x4*)GTg + 512 + tid);
        BAR_LDS();
        __builtin_nontemporal_store(*(LAS const u32x4*)(L + SL(13) + (size_t)tid * 16), (u32x4*)Hg + tid);
        if (tid < 64) __builtin_nontemporal_store(*(LAS const u32x4*)(L + SL(13) + (size_t)(512 + tid) * 16), (u32x4*)Hg + 512 + tid);
    }
}

constexpr int RS_SLOT = 12 * 1024;
constexpr int RS_DEPTH = 8, RS_AHEAD = 6;
__device__ __forceinline__ void rwkv_scan_block(Frame& F, int item) {
    const int bh = item >> 2, qi = item & 3, lane = F.lane, fr = lane & 15, fq = lane >> 4, wid = F.wave;
    const char* GTg = (const char*)(F.dout + DO_GT) + (size_t)bh * 64 * (64 * GLD * 2);
    const char* Hg = (const char*)(F.dout + DO_H) + (size_t)bh * 64 * (64 * GLD * 2) + (size_t)qi * (16 * GLD * 2);
    bf16_t* SST = (bf16_t*)(F.dout + DO_SST) + (size_t)bh * 64 * 4096;
    LAS unsigned char* L = F.lds;
    auto issue = [&](int c) {
        if (wid >= 1) {
            LAS unsigned char* slot = L + (c & (RS_DEPTH - 1)) * RS_SLOT;
#pragma unroll
            for (int k = 0; k < 2; ++k) { const int pc = (wid - 1) + 7 * k;
                if (pc < 12) {
                    const char* src;
                    if (pc < 9) src = GTg + (size_t)c * (64 * GLD * 2) + pc * 1024 + lane * 16;
                    else { int off = (pc - 9) * 1024 + lane * 16; off = off > 2304 - 16 ? 2304 - 16 : off; src = Hg + (size_t)c * (64 * GLD * 2) + off; }
                    __builtin_amdgcn_global_load_lds((const unsigned*)src, (LAS unsigned*)(slot + pc * 1024), 16, 0, 0); } }
        }
    };
    f32x4 acc[4];
#pragma unroll
    for (int mt = 0; mt < 4; ++mt) acc[mt] = (f32x4){0.f, 0.f, 0.f, 0.f};
#pragma unroll 1
    for (int c = 0; c < RS_AHEAD; ++c) issue(c);
#pragma unroll 1
    for (int c = 0; c < NCH; ++c) {
        if (c + RS_AHEAD < NCH) issue(c + RS_AHEAD);
        if (c + RS_AHEAD < NCH) { if (wid >= 1 && wid <= 5) asm volatile("s_waitcnt vmcnt(12)" ::: "memory"); else if (wid >= 6) asm volatile("s_waitcnt vmcnt(6)" ::: "memory"); }
        else if (wid >= 1) asm volatile("s_waitcnt vmcnt(0)" ::: "memory");
        __builtin_amdgcn_s_barrier(); asm volatile("" ::: "memory");
        if (wid == 0) {
            LAS const unsigned char* slot = L + (c & (RS_DEPTH - 1)) * RS_SLOT;
            u32x2 ga[4][2][2], hv[4];
#pragma unroll
            for (int mt = 0; mt < 4; ++mt) {
#pragma unroll
                for (int s = 0; s < 2; ++s)
#pragma unroll
                    for (int hh = 0; hh < 2; ++hh) ga[mt][s][hh] = *(LAS const u32x2*)(slot + ((16 * mt + fr) * GLD + 16 * (2 * s + hh) + 4 * fq) * 2);
                hv[mt] = *(LAS const u32x2*)(slot + 9216 + (fr * GLD + 16 * mt + 4 * fq) * 2); }
            bf16_t* Sc = SST + (size_t)c * 4096; u32x2 sp[4];
#pragma unroll
            for (int mt = 0; mt < 4; ++mt) { sp[mt].x = cvt_pk_bf16(acc[mt][0], acc[mt][1]); sp[mt].y = cvt_pk_bf16(acc[mt][2], acc[mt][3]);
                *(u32x2*)(Sc + (size_t)(16 * qi + fr) * 64 + 16 * mt + 4 * fq) = sp[mt]; }
            bf16x8 sb[2];
#pragma unroll
            for (int s = 0; s < 2; ++s) { u32x4 w; w.x = sp[2 * s].x; w.y = sp[2 * s].y; w.z = sp[2 * s + 1].x; w.w = sp[2 * s + 1].y; sb[s] = __builtin_bit_cast(bf16x8, w); }
#pragma unroll
            for (int mt = 0; mt < 4; ++mt) { f32x4 a = (f32x4){bf_lo(hv[mt].x), bf_hi(hv[mt].x), bf_lo(hv[mt].y), bf_hi(hv[mt].y)};
#pragma unroll
                for (int s = 0; s < 2; ++s) { u32x4 w; w.x = ga[mt][s][0].x; w.y = ga[mt][s][0].y; w.z = ga[mt][s][1].x; w.w = ga[mt][s][1].y;
                    a = __builtin_amdgcn_mfma_f32_16x16x32_bf16(__builtin_bit_cast(bf16x8, w), sb[s], a, 0, 0, 0); }
                acc[mt] = a; }
            asm volatile("s_waitcnt lgkmcnt(0)" ::: "memory");
        }
    }
    asm volatile("s_waitcnt vmcnt(0)" ::: "memory");
    __builtin_amdgcn_s_barrier(); asm volatile("" ::: "memory");
}
__device__ __forceinline__ void s5_scan_block(Frame& F, int gb) {
    const int g = gb >> 3, b = gb & 7, p = F.lane, w = F.wave;
    const float* aL = (const float*)(F.ws + WS_AL) + g * 128; const float ar = aL[2 * p], ai = aL[2 * p + 1];
    const float* SLc = (const float*)(F.ws + WS_SLOC) + ((size_t)g * S5ROWS + b * 256 + 32 * w) * 128 + 2 * p;
    bf16_t* UG = (bf16_t*)(F.ws + WS_UG) + ((size_t)g * S5ROWS + b * 256 + 32 * w) * UGLD + 256 + 2 * p;
    LAS float* E = (LAS float*)(F.lds);
    f32x2 l[32];
#pragma unroll
    for (int k = 0; k < 32; ++k) l[k] = *(const f32x2*)(SLc + (size_t)k * 128);
    float sr = 0.f, si = 0.f;
#pragma unroll
    for (int k = 0; k < 32; ++k) { const float nr = ar * sr - ai * si + l[k].x, ni = ar * si + ai * sr + l[k].y; l[k].x = sr; l[k].y = si; sr = nr; si = ni; }
    E[(w * 64 + p) * 2] = sr; E[(w * 64 + p) * 2 + 1] = si;
    float pr = ar, pi = ai;
#pragma unroll
    for (int q = 0; q < 5; ++q) { const float nr = pr * pr - pi * pi, ni = 2.f * pr * pi; pr = nr; pi = ni; }
    asm volatile("s_waitcnt lgkmcnt(0)" ::: "memory"); __builtin_amdgcn_s_barrier(); asm volatile("" ::: "memory");
    float cr = 0.f, ci = 0.f;
#pragma unroll
    for (int w2 = 0; w2 < 7; ++w2) { if (w2 < w) { const float er = E[(w2 * 64 + p) * 2], ei = E[(w2 * 64 + p) * 2 + 1]; const float nr = pr * cr - pi * ci + er, ni = pr * ci + pi * cr + ei; cr = nr; ci = ni; } }
#pragma unroll
    for (int k = 0; k < 32; ++k) { *(unsigned*)(UG + (size_t)k * UGLD) = cvt_pk_bf16(l[k].x + cr, l[k].y + ci); const float nr = ar * cr - ai * ci, ni = ar * ci + ai * cr; cr = nr; ci = ni; }
    asm volatile("s_waitcnt lgkmcnt(0)" ::: "memory"); __builtin_amdgcn_s_barrier(); asm volatile("" ::: "memory");
}
struct OutY { bf16x8 yq[2], yw[2]; u32x2 pv[4], pp[4], gv[4]; float bon; };
__device__ __forceinline__ void rwkv_out_loady(Frame& F, int unit, int at, OutY& Lq) {
    const int lane = F.lane, fr = lane & 15, fq = lane >> 4;
    const int bh = unit >> 6, c = unit & 63, b = bh >> 3, h = bh & 7;
    const bf16_t* QRT = (const bf16_t*)(F.ws + WS_QRT) + (size_t)unit * 4096; const bf16_t* WYT = (const bf16_t*)(F.ws + WS_WYT) + (size_t)unit * 4096;
#pragma unroll
    for (int s = 0; s < 2; ++s) { Lq.yq[s] = __builtin_nontemporal_load((const bf16x8*)(QRT + (size_t)(16 * at + fr) * 64 + 32 * s + 8 * fq)); Lq.yw[s] = __builtin_nontemporal_load((const bf16x8*)(WYT + (size_t)(16 * at + fr) * 64 + 32 * s + 8 * fq)); }
    const int tl = c * 64 + 16 * at + fr, tg = b * SEQ + tl;
    const bf16_t* prow = (const bf16_t*)(F.ws + WS_PR) + (size_t)tg * NRW + 1024 + h * 64;
    const bf16_t* gb = (const bf16_t*)(F.ws + WS_GBUF) + (size_t)tg * RW + h * 64;
    Lq.bon = ((const float*)(F.ws + WS_BONUS))[(size_t)tg * 8 + h];
    const bf16_t* pprev = prow - (tl > 0 ? NRW : 0);
#pragma unroll
    for (int bt = 0; bt < 4; ++bt) { const int i0 = 16 * bt + 4 * fq; Lq.pv[bt] = *(const u32x2*)(prow + i0); Lq.pp[bt] = *(const u32x2*)(pprev + i0); Lq.gv[bt] = *(const u32x2*)(gb + i0); }
}
__device__ __forceinline__ void rwkv_out_comp(Frame& F, int unit, int at, const bf16x8 (&xs)[2][4], const bf16x8 (&xv)[2][4], const OutY& Lq) {
    const int lane = F.lane, fr = lane & 15, fq = lane >> 4;
    const int bh = unit >> 6, c = unit & 63, b = bh >> 3, h = bh & 7;
    f32x4 m4[4], lw[4], lb[4];
#pragma unroll
    for (int bt = 0; bt < 4; ++bt) { const int i0 = 16 * bt + 4 * fq; m4[bt] = *(const f32x4*)(F.in[I_MU] + 1024 + h * 64 + i0); lw[bt] = *(const f32x4*)(F.in[I_LNW] + h * 64 + i0); lb[bt] = *(const f32x4*)(F.in[I_LNB] + h * 64 + i0); }
    f32x4 acc[4];
#pragma unroll
    for (int bt = 0; bt < 4; ++bt) acc[bt] = (f32x4){0.f, 0.f, 0.f, 0.f};
#pragma unroll
    for (int s = 0; s < 2; ++s)
#pragma unroll
        for (int bt = 0; bt < 4; ++bt) {
            acc[bt] = __builtin_amdgcn_mfma_f32_16x16x32_bf16(xs[s][bt], Lq.yq[s], acc[bt], 0, 0, 0);
            acc[bt] = __builtin_amdgcn_mfma_f32_16x16x32_bf16(xv[s][bt], Lq.yw[s], acc[bt], 0, 0, 0); }
    float s1 = 0.f;
#pragma unroll
    for (int bt = 0; bt < 4; ++bt) s1 += (acc[bt][0] + acc[bt][1]) + (acc[bt][2] + acc[bt][3]);
    s1 += __shfl_xor(s1, 16); s1 += __shfl_xor(s1, 32);
    const float mean = s1 * (1.f / 64.f); float s2 = 0.f;
#pragma unroll
    for (int bt = 0; bt < 4; ++bt) { const f32x4 d = acc[bt] - mean; s2 += (d[0] * d[0] + d[1] * d[1]) + (d[2] * d[2] + d[3] * d[3]); }
    s2 += __shfl_xor(s2, 16); s2 += __shfl_xor(s2, 32);
    const float rstd = __builtin_amdgcn_rsqf(s2 * (1.f / 64.f) + 64e-5f);
    const int tl = c * 64 + 16 * at + fr, tg = b * SEQ + tl;
    const float pmask = tl > 0 ? 1.f : 0.f;
    bf16_t* YRS = (bf16_t*)(F.dout + DO_YRS) + (size_t)tg * D + h * 64;
#pragma unroll
    for (int bt = 0; bt < 4; ++bt) { const int i0 = 16 * bt + 4 * fq;
        const u32x2 pv = Lq.pv[bt], pp = Lq.pp[bt], gv = Lq.gv[bt];
        const float x[4] = {bf_lo(pv.x), bf_hi(pv.x), bf_lo(pv.y), bf_hi(pv.y)}, xp[4] = {bf_lo(pp.x) * pmask, bf_hi(pp.x) * pmask, bf_lo(pp.y) * pmask, bf_hi(pp.y) * pmask}, gg[4] = {bf_lo(gv.x), bf_hi(gv.x), bf_lo(gv.y), bf_hi(gv.y)};
        float o[4];
#pragma unroll
        for (int e = 0; e < 4; ++e) { const float vsh = x[e] + (xp[e] - x[e]) * m4[bt][e]; o[e] = ((acc[bt][e] - mean) * rstd * lw[bt][e] + lb[bt][e] + Lq.bon * vsh) * gg[e]; }
        u32x2 w; w.x = cvt_pk_bf16(o[0], o[1]); w.y = cvt_pk_bf16(o[2], o[3]); *(u32x2*)(YRS + i0) = w; }
}
__device__ __forceinline__ void rwkv_out_units(Frame& F) {
    const int lane = F.lane, fr = lane & 15, fq = lane >> 4;
    for (int unit = F.vcu * NWAVES + F.wave; unit < NUNIT; unit += F.G * NWAVES) {
        const bf16_t* VT = (const bf16_t*)(F.ws + WS_VT) + (size_t)unit * 4096; const bf16_t* SST = (const bf16_t*)(F.dout + DO_SST) + (size_t)unit * 4096;
        bf16x8 xs[2][4], xv[2][4]; OutY A, B;
#pragma unroll
        for (int s = 0; s < 2; ++s)
#pragma unroll
            for (int bt = 0; bt < 4; ++bt) { xs[s][bt] = __builtin_nontemporal_load((const bf16x8*)(SST + (size_t)(16 * bt + fr) * 64 + 32 * s + 8 * fq)); xv[s][bt] = __builtin_nontemporal_load((const bf16x8*)(VT + (size_t)(16 * bt + fr) * 64 + 32 * s + 8 * fq)); }
        rwkv_out_loady(F, unit, 0, A); rwkv_out_loady(F, unit, 1, B); __builtin_amdgcn_sched_barrier(0);
        rwkv_out_comp(F, unit, 0, xs, xv, A); __builtin_amdgcn_sched_barrier(0); rwkv_out_loady(F, unit, 2, A); __builtin_amdgcn_sched_barrier(0);
        rwkv_out_comp(F, unit, 1, xs, xv, B); __builtin_amdgcn_sched_barrier(0); rwkv_out_loady(F, unit, 3, B); __builtin_amdgcn_sched_barrier(0);
        rwkv_out_comp(F, unit, 2, xs, xv, A); __builtin_amdgcn_sched_barrier(0);
        rwkv_out_comp(F, unit, 3, xs, xv, B); __builtin_amdgcn_sched_barrier(0);
    }
}

__device__ __forceinline__ void p8_rows(Frame& F) {
    const int gw = F.vcu * NWAVES + F.wave, NGW = F.G * NWAVES, lane = F.lane;
    const bf16_t* MX = (const bf16_t*)(F.ws + WS_MIXED); const float* ST = (const float*)(F.ws + WS_STAT1); bf16_t* H2 = (bf16_t*)(F.ws + WS_H2); float* X1 = (float*)F.dout;
    f32x4 gp[4];
#pragma unroll
    for (int j = 0; j < 4; ++j) gp[j] = *(const f32x4*)(F.in[I_NMPOST] + 256 * j + 4 * lane);
    for (int m0 = gw; m0 < T; m0 += 2 * NGW) {
        int mm[2] = {m0, (m0 + NGW < T) ? m0 + NGW : m0};
        f32x4 xv[2][4]; u32x2 mw[2][4]; float st[2];
#pragma unroll
        for (int q = 0; q < 2; ++q) { st[q] = (lane < 16) ? ST[(size_t)mm[q] * 16 + lane] : 0.f;
#pragma unroll
            for (int j = 0; j < 4; ++j) { const int col = 256 * j + 4 * lane; xv[q][j] = __builtin_nontemporal_load((const f32x4*)(F.in[I_X] + (size_t)mm[q] * D + col)); mw[q][j] = __builtin_nontemporal_load((const u32x2*)(MX + (size_t)mm[q] * D + col)); } }
#pragma unroll
        for (int q = 0; q < 2; ++q) {
            const float rstd1 = __builtin_amdgcn_rsqf(wave_sum(st[q]) * (1.f / D) + 1e-6f);
            f32x4 v[4]; float s = 0.f;
#pragma unroll
            for (int j = 0; j < 4; ++j) { const int col = 256 * j + 4 * lane;
                v[j].x = xv[q][j].x + bf_lo(mw[q][j].x) * rstd1 * gp[j].x; v[j].y = xv[q][j].y + bf_hi(mw[q][j].x) * rstd1 * gp[j].y; v[j].z = xv[q][j].z + bf_lo(mw[q][j].y) * rstd1 * gp[j].z; v[j].w = xv[q][j].w + bf_hi(mw[q][j].y) * rstd1 * gp[j].w;
                s += (v[j].x * v[j].x + v[j].y * v[j].y) + (v[j].z * v[j].z + v[j].w * v[j].w);
                }
            const float rstd2 = __builtin_amdgcn_rsqf(wave_sum(s) * (1.f / D) + 1e-6f);
#pragma unroll
            for (int j = 0; j < 4; ++j) { u32x2 w; w.x = cvt_pk_bf16(v[j].x * rstd2, v[j].y * rstd2); w.y = cvt_pk_bf16(v[j].z * rstd2, v[j].w * rstd2); *(u32x2*)(H2 + (size_t)mm[q] * D + 256 * j + 4 * lane) = w; }
        }
    }
}
__device__ __forceinline__ void p12_rows(Frame& F) {
    const int gw = F.vcu * NWAVES + F.wave, NGW = F.G * NWAVES, lane = F.lane;
    const bf16_t* FB = (const bf16_t*)(F.ws + WS_F); const bf16_t* MX = (const bf16_t*)(F.ws + WS_MIXED);
    const float* ST1 = (const float*)(F.ws + WS_STAT1); const float* ST2 = (const float*)(F.ws + WS_STAT2); float* OUT = (float*)F.dout;
    f32x4 gp[4], gq[4];
#pragma unroll
    for (int j = 0; j < 4; ++j) { gp[j] = *(const f32x4*)(F.in[I_NMPOST] + 256 * j + 4 * lane); gq[j] = *(const f32x4*)(F.in[I_NFPOST] + 256 * j + 4 * lane); }
    for (int m0 = gw; m0 < T; m0 += 2 * NGW) {
        int mm[2] = {m0, (m0 + NGW < T) ? m0 + NGW : m0};
        f32x4 xv[2][4]; u32x2 mw[2][4], fw[2][4]; float s1[2], s2[2];
#pragma unroll
        for (int q = 0; q < 2; ++q) { s1[q] = (lane < 16) ? ST1[(size_t)mm[q] * 16 + lane] : 0.f; s2[q] = (lane < 16) ? ST2[(size_t)mm[q] * 16 + lane] : 0.f;
#pragma unroll
            for (int j = 0; j < 4; ++j) { const int col = 256 * j + 4 * lane; xv[q][j] = __builtin_nontemporal_load((const f32x4*)(F.in[I_X] + (size_t)mm[q] * D + col));
                mw[q][j] = __builtin_nontemporal_load((const u32x2*)(MX + (size_t)mm[q] * D + col)); fw[q][j] = __builtin_nontemporal_load((const u32x2*)(FB + (size_t)mm[q] * D + col)); } }
#pragma unroll
        for (int q = 0; q < 2; ++q) {
            const float rstd1 = __builtin_amdgcn_rsqf(wave_sum(s1[q]) * (1.f / D) + 1e-6f), rstd3 = __builtin_amdgcn_rsqf(wave_sum(s2[q]) * (1.f / D) + 1e-6f);
#pragma unroll
            for (int j = 0; j < 4; ++j) { const int col = 256 * j + 4 * lane; f32x4 o;
                o.x = xv[q][j].x + bf_lo(mw[q][j].x) * rstd1 * gp[j].x; o.y = xv[q][j].y + bf_hi(mw[q][j].x) * rstd1 * gp[j].y; o.z = xv[q][j].z + bf_lo(mw[q][j].y) * rstd1 * gp[j].z; o.w = xv[q][j].w + bf_hi(mw[q][j].y) * rstd1 * gp[j].w;
                o.x += bf_lo(fw[q][j].x) * rstd3 * gq[j].x; o.y += bf_hi(fw[q][j].x) * rstd3 * gq[j].y; o.z += bf_lo(fw[q][j].y) * rstd3 * gq[j].z; o.w += bf_hi(fw[q][j].y) * rstd3 * gq[j].w;
                __builtin_nontemporal_store(o, (f32x4*)(OUT + (size_t)mm[q] * D + col)); }
        }
    }
}

#ifndef MK_PER_PHASE
#define MK_PER_PHASE 0
#endif
constexpr int NPHASE = 12;
struct Args { const float* in[35]; float* out; unsigned char* ws; int ph_lo, ph_hi; };
static_assert(sizeof(Args) == 35 * 8 + 8 + 8 + 8, "Args has no padding");

__device__ __forceinline__ bool phase_begin(Frame& F) { unsigned long long z = 0; asm volatile("" : "+s"(z), "+v"(F.tid)); F.ws = F.ws0 + z; F.dout = F.dout0 + z;     F.lane = F.tid & 63; F.wave = __builtin_amdgcn_readfirstlane(F.tid >> 6); return true; }
__global__ void __launch_bounds__(NWAVES * 64, 2) fwd_kernel(Args args) {
    extern __shared__ __attribute__((aligned(16))) unsigned char lds_raw[];
    Frame F;
    F.lds = (LAS unsigned char*)lds_raw;
    F.MISC = (volatile LAS unsigned*)(F.lds + MISC_OFF);
    F.tid = threadIdx.x; F.lane = F.tid & 63; F.wave = __builtin_amdgcn_readfirstlane(F.tid >> 6);
    F.G = gridDim.x; { const int bx = blockIdx.x; F.vcu = (F.G % 8 == 0) ? (bx % 8) * (F.G / 8) + bx / 8 : bx; }
    F.ws0 = args.ws; F.dout0 = (unsigned char*)args.out; F.ws = F.ws0; F.dout = F.dout0; F.ctl = (gu32*)(args.ws + WS_CTL);
    F.in = (InTab)__builtin_amdgcn_kernarg_segment_ptr();
    for (int u = F.tid; u < (LDS_BYTES - LDSCTL_OFF) / 4; u += NWAVES * 64) ((LAS unsigned*)(F.lds + LDSCTL_OFF))[u] = 0u;
    __syncthreads();
    XcdBarrier bar; bar.bar = (unsigned*)(F.ctl + CW_BAR); bar.x = 0; bar.st = nullptr;
    if (!MK_PER_PHASE) bar = xcd_barrier_post((unsigned*)(F.ctl + CW_BAR), F.MISC + 8);
    const int lo = args.ph_lo, hi = args.ph_hi;
#ifndef PHMASK
#define PHMASK 0xffffffffu
#endif
#define IN(k) (((PHMASK >> (k)) & 1u) && lo <= (k) && (k) < hi && phase_begin(F))
#ifndef REPMASK
#define REPMASK 0u
#endif
#define REPS(k) ((((REPMASK) >> (k)) & 1u) ? 2 : 1)
#define PH(k) for (int rep_ = 0; rep_ < REPS(k); ++rep_, (rep_ < REPS(k) ? xcd_barrier(bar) : (void)0))
#define INQ(k) (lo <= (k) && (k) < hi)
#define SEAM(k) do { if (INQ(k) && INQ((k) + 1)) xcd_barrier(bar); } while (0)
#define WSB(off) ((bf16_t*)(F.ws + (off)))
    const int bx = (int)blockIdx.x;

    PH(0) if (IN(0)) { p0_prologue(F); }
    SEAM(0);
    PH(1) if (IN(1)) {
        pg8::Gemm g{D, D, D, 0}; pg8::StaticOrder S; S.init(WSB(WS_XN), WSB(WS_WIN), D, D, T, NIN, F.G, bx);
        EpiInProj E{WSB(WS_PR), WSB(WS_UG), WSB(WS_GATES), F.in[I_BGATE], 0};
        pg8::gemm_phase<EpiInProj, pg8::StaticOrder, true>(F.lds, g, S, E, F.tid);
    }
    SEAM(1);
    PH(2) if (IN(2)) {
        PrePf pf;
        if (F.vcu < NB * NCH) rwkv_pre_fetch(F, (((F.vcu >> 6) * NHEAD) << 6) + (F.vcu & 63), true, pf, F.tid);
        {
            LAS f32x4* TB = (LAS f32x4*)(F.lds + XTRA_OFF + 4096);
            if (F.tid < NRW / 4) TB[F.tid] = ((const f32x4*)F.in[I_MU])[F.tid];
            const int pq = F.tid >> 7, pi = F.tid & 127;
            const float* psrc = pq == 0 ? F.in[I_W0] : pq == 1 ? F.in[I_A0] : pq == 2 ? F.in[I_KK] : F.in[I_KA];
            TB[NRW / 4 + F.tid] = ((const f32x4*)psrc)[pi];
            if (F.tid < 128) TB[NRW / 4 + 512 + F.tid] = ((const f32x4*)F.in[I_RK])[F.tid];
            BAR_LDS();
        }
        for (int pc = F.vcu; pc < NB * NCH; pc += F.G) {
#pragma unroll 1
            for (int hh = 0; hh < NHEAD; ++hh) { const int bq = pc >> 6, cq = pc & 63, u = ((bq * NHEAD + hh) << 6) + cq;
                const int un = (hh < NHEAD - 1) ? u + 64 : ((pc + F.G < NB * NCH) ? ((((pc + F.G) >> 6) * NHEAD) << 6) + ((pc + F.G) & 63) : NUNIT);
                rwkv_pre_unit(F, u, un, hh == 0, hh == NHEAD - 1, pf); } }
        BAR_LDS();
        pg8::Gemm g{256, UGLD, 256, 0}; S5Order S{WSB(WS_UG), WSB(WS_B1A), 256, F.G, bx};
        EpiSloc E{(float*)(F.ws + WS_SLOC), 0};
        pg8::gemm_phase<EpiSloc, S5Order, true>(F.lds, g, S, E, F.tid);
    }
    SEAM(2);
    PH(3) if (IN(3)) {
        for (int gb = F.vcu; gb < S5G * NB; gb += F.G) s5_scan_block(F, gb);
        for (int it = F.vcu; it < NB * NHEAD * 4; it += F.G) rwkv_scan_block(F, it);
    }
    SEAM(3);
    PH(4) if (IN(4)) {
        rwkv_out_units(F);
        VM_WAIT(); __syncthreads();
        pg8::Gemm g{384, UGLD, 384, 0}; S5Order S{WSB(WS_UG), WSB(WS_B1B), 384, F.G, bx};
        pg8::EpiGen8<FS5Out> E{FS5Out{WSB(WS_YSP)}, 0};
        pg8::gemm_phase<pg8::EpiGen8<FS5Out>, S5Order, true>(F.lds, g, S, E, F.tid);
    }
    SEAM(4);
    PH(5) if (IN(5)) {
        pg8::Gemm g{RW, RW, RW, 1}; pg8::StaticOrder S; S.init(WSB(WS_YSP), WSB(WS_WGLU), RW, RW, T, RW, F.G, bx); S.tstepA = (size_t)16 * 256 * 2;
        EpiGlu E{WSB(WS_YSP), (bf16_t*)(F.dout + DO_YRS), F.in[I_BGLU], 0};
        pg8::gemm_phase<EpiGlu, pg8::StaticOrder, true>(F.lds, g, S, E, F.tid);
    }
    SEAM(5);
    PH(6) if (IN(6)) {
        pg8::Gemm g{RW, D, D, 0};
        { pg8::StaticOrder S; S.init((const bf16_t*)(F.dout + DO_YRS), WSB(WS_WBRS), D, D, T, D, F.G, bx);
          EpiMergeA E{WSB(WS_GATES), WSB(WS_MERGED), 0};
          pg8::gemm_phase<EpiMergeA, pg8::StaticOrder, true>(F.lds, g, S, E, F.tid); }
        { pg8::StaticOrder S; S.init((const bf16_t*)(F.dout + DO_YRS) + RW, WSB(WS_WBRS) + RW, D, D, T, D, F.G, bx);
          EpiMergeB E{WSB(WS_GATES), WSB(WS_MERGED), 0};
          pg8::gemm_phase<EpiMergeB, pg8::StaticOrder, true>(F.lds, g, S, E, F.tid); }
    }
    SEAM(6);
    PH(7) if (IN(7)) {
        pg8::Gemm g{D, D, D, 0}; pg8::StaticOrder S; S.init(WSB(WS_MERGED), WSB(WS_WOUT), D, D, T, D, F.G, bx);
        EpiRowStat E{WSB(WS_MIXED), (float*)(F.ws + WS_STAT1), 0};
        pg8::gemm_phase<EpiRowStat, pg8::StaticOrder, false>(F.lds, g, S, E, F.tid);
    }
    SEAM(7);
    PH(8) if (IN(8)) { p8_rows(F);
        for (size_t i = (size_t)bx * 512 + F.tid; i < HZ_BYTES / 16; i += (size_t)F.G * 512) ((u32x4*)(F.ws + WS_HZ))[i] = (u32x4){0u, 0u, 0u, 0u}; }
    SEAM(8);
    PH(9) if (IN(9)) {
        pg8::Gemm g{D, D, D, 0}; UpOrder S{WSB(WS_H2), WSB(WS_WUP), F.G, bx};
        EpiConvAct E{WSB(WS_ACT), F.in[I_CONVW], F.in[I_CONVB], (LAS unsigned*)(F.lds + XTRA_OFF), (unsigned long long*)(F.ws + WS_HZ), (unsigned*)(F.ctl + 2), 0};
        pg8::gemm_phase<EpiConvAct, UpOrder, true>(F.lds, g, S, E, F.tid);
    }
    SEAM(9);
    PH(10) if (IN(10)) {
        pg8::Gemm g{FF, FF, FF, 0}; pg8::StaticOrder S; S.init(WSB(WS_ACT), WSB(WS_WDN), FF, FF, T, D, F.G, bx);
        EpiRowStat E{WSB(WS_F), (float*)(F.ws + WS_STAT2), 0};
        pg8::gemm_phase<EpiRowStat, pg8::StaticOrder, false>(F.lds, g, S, E, F.tid);
    }
    SEAM(10);
    if (IN(11)) p12_rows(F);
#undef IN
#undef INQ
#undef SEAM
#undef WSB
}

extern "C" void kernel_launch(void* const* d_in, const int* in_sizes, int n_in, void* d_out, int out_size, void* d_ws, size_t ws_size, hipStream_t stream) {
    static int grid = 0;
    if (grid == 0) {
        if (n_in != 35 || in_sizes[0] != T * D || out_size != T * D || ws_size < WS_END) { fprintf(stderr, "kernel_launch: unexpected shapes: n_in %d in0 %d out %d ws %zu (need %zu)\n", n_in, n_in > 0 ? in_sizes[0] : -1, out_size, ws_size, (size_t)WS_END); grid = -1; return; }
        int dev = 0, cus = 0, per_cu = 0;
        if (hipGetDevice(&dev) != hipSuccess || hipDeviceGetAttribute(&cus, hipDeviceAttributeMultiprocessorCount, dev) != hipSuccess) { fprintf(stderr, "kernel_launch: device query failed\n"); grid = -1; return; }
        if (hipFuncSetAttribute((const void*)fwd_kernel, hipFuncAttributeMaxDynamicSharedMemorySize, LDS_BYTES) != hipSuccess) { fprintf(stderr, "kernel_launch: hipFuncSetAttribute failed\n"); grid = -1; return; }
        if (hipOccupancyMaxActiveBlocksPerMultiprocessor(&per_cu, (const void*)fwd_kernel, NWAVES * 64, LDS_BYTES) != hipSuccess || per_cu < 1) fprintf(stderr, "kernel_launch: occupancy query reports %d blocks per CU\n", per_cu);
        (void)hipGetLastError();
        grid = cus;
    }
    if (grid < 0) return;
    if (hipMemsetAsync((char*)d_ws + WS_CTL, 0, CTL_ZERO_BYTES, stream) != hipSuccess) { fprintf(stderr, "kernel_launch: memset failed\n"); return; }
    Args a{};
    for (int i = 0; i < 35; ++i) a.in[i] = (const float*)d_in[i];
    a.out = (float*)d_out; a.ws = (unsigned char*)d_ws;
#if MK_PER_PHASE
    for (int ph = 0; ph < NPHASE; ++ph) { a.ph_lo = ph; a.ph_hi = ph + 1; hipLaunchKernelGGL(fwd_kernel, dim3(grid), dim3(NWAVES * 64), LDS_BYTES, stream, a); }
#else
    a.ph_lo = 0; a.ph_hi = NPHASE;
    hipLaunchKernelGGL(fwd_kernel, dim3(grid), dim3(NWAVES * 64), LDS_BYTES, stream, a);
#endif
    const hipError_t le = hipPeekAtLastError();
    if (le != hipSuccess) fprintf(stderr, "kernel_launch: launch failed: %s\n", hipGetErrorName(le));
}
```

```cpp
#include <hip/hip_runtime.h>
#include <cstdio>
#include <cstdint>

#define LAS __attribute__((address_space(3)))
#define GAS __attribute__((address_space(1)))
typedef unsigned short bf16_t;
typedef short bf16x8 __attribute__((ext_vector_type(8)));
typedef float f32x4 __attribute__((ext_vector_type(4)));
typedef float f32x2 __attribute__((ext_vector_type(2)));
typedef unsigned u32x4 __attribute__((ext_vector_type(4)));
typedef unsigned u32x2 __attribute__((ext_vector_type(2)));
typedef GAS unsigned gu32;

constexpr int T = 32768, SEQ = 4096, NB = 8, D = 1024, NIN = 4352, NRW = 1792, RW = 512, FF = 2816, FH = 1408;
constexpr int NHEAD = 8, HD = 64, NCH = 64  , NUNIT = NB * NHEAD * NCH;
constexpr int S5G = 32, S5ROWS = T / 16, UGLD = 384;

constexpr size_t MiB = 1u << 20;
constexpr size_t WS_CTL = 0, CTL_ZERO_BYTES = 1 * MiB;
constexpr size_t WS_WIN = 1 * MiB;
constexpr size_t WS_WUP = WS_WIN + (size_t)NIN * D * 2;
constexpr size_t WS_WDN = WS_WUP + (size_t)2 * FF * D * 2;
constexpr size_t WS_WOUT = WS_WDN + (size_t)D * FF * 2;
constexpr size_t WS_WBRS = WS_WOUT + (size_t)D * D * 2;
constexpr size_t WS_WGLU = WS_WBRS + (size_t)D * D * 2;
constexpr size_t WS_W2T = WS_WGLU + (size_t)RW * RW * 2;
constexpr size_t WS_A2T = WS_W2T + (size_t)RW * 64 * 2;
constexpr size_t WS_G2T = WS_A2T + (size_t)RW * 64 * 2;
constexpr size_t WS_B1A = WS_G2T + (size_t)RW * 128 * 2;
constexpr size_t WS_B1B = WS_B1A + (size_t)S5G * 256 * 256 * 2;
constexpr size_t WS_AL = WS_B1B + (size_t)S5G * 256 * 384 * 2;
constexpr size_t WS_WEND = WS_AL + (size_t)S5G * 64 * 2 * 4;
static_assert(WS_WEND <= 44 * MiB, "weights region");
constexpr size_t WS_XN = 44 * MiB;
constexpr size_t WS_QRT = 44 * MiB, WS_WYT = 76 * MiB;
constexpr size_t WS_MERGED = 44 * MiB, WS_H2 = 44 * MiB, WS_F = 44 * MiB;
constexpr size_t WS_PR = 108 * MiB;
constexpr size_t WS_MIXED = 304 * MiB, WS_STAT1 = 368 * MiB;
constexpr size_t WS_ACT = 108 * MiB;
constexpr size_t WS_STAT2 = 284 * MiB;
constexpr size_t WS_UG = 220 * MiB;
constexpr size_t WS_GATES = 268 * MiB;
constexpr size_t WS_SLOC = 396 * MiB, WS_YSP = 396 * MiB;
constexpr size_t WS_GBUF = 428 * MiB;
constexpr size_t WS_BONUS = 460 * MiB;
constexpr size_t WS_VT = 461 * MiB;
constexpr size_t WS_LRSCR = 493 * MiB;
constexpr size_t WS_Z = 336 * MiB;
constexpr size_t WS_END = 512 * MiB;
constexpr size_t DO_H = 0, DO_GT = 36 * MiB, DO_SST = 96 * MiB, DO_YRS = 0;
constexpr int GLD = 72;

constexpr int CW_BAR = 4096, CW_HF = 32768;
constexpr size_t WS_HZ = 290 * MiB, HZ_BYTES = (size_t)2816 * 4 * 2 * 32 * 8;

constexpr int RING_BYTES = 131072, LDSCTL_OFF = RING_BYTES, MISC_OFF = LDSCTL_OFF + 320, XTRA_OFF = LDSCTL_OFF + 1024, LDS_BYTES = 155648;
constexpr int NWAVES = 8;

#define RLX_AGENT __ATOMIC_RELAXED, __HIP_MEMORY_SCOPE_AGENT
#define LDS_WAIT() asm volatile("s_waitcnt lgkmcnt(0)" ::: "memory")
#define VM_WAIT() asm volatile("s_waitcnt vmcnt(0)" ::: "memory")

typedef __bf16 bf16x2_t __attribute__((ext_vector_type(2)));
__device__ __forceinline__ unsigned cvt_pk_bf16(float lo, float hi) { const f32x2 v = {lo, hi}; return __builtin_bit_cast(unsigned, __builtin_convertvector(v, bf16x2_t)); }
__device__ __forceinline__ float bf_lo(unsigned w) { return __uint_as_float(w << 16); }
__device__ __forceinline__ float bf_hi(unsigned w) { return __uint_as_float(w & 0xffff0000u); }
__device__ __forceinline__ float bf1(bf16_t h) { return __uint_as_float((unsigned)h << 16); }
__device__ __forceinline__ float fexp(float x) { return __builtin_amdgcn_exp2f(x * 1.44269504089f); }
__device__ __forceinline__ float fsigmoid(float x) { return __builtin_amdgcn_rcpf(1.0f + __builtin_amdgcn_exp2f(-1.44269504089f * x)); }
__device__ __forceinline__ float ftanh(float x) { return 1.0f - 2.0f * __builtin_amdgcn_rcpf(1.0f + __builtin_amdgcn_exp2f(2.88539008178f * x)); }
__device__ __forceinline__ float fgelu(float x) { const float u = 0.7978845608f * (x + 0.044715f * x * x * x); return x * fsigmoid(2.0f * u); }
__device__ __forceinline__ void unpack8(u32x4 w, float (&f)[8]) { f[0] = bf_lo(w.x); f[1] = bf_hi(w.x); f[2] = bf_lo(w.y); f[3] = bf_hi(w.y); f[4] = bf_lo(w.z); f[5] = bf_hi(w.z); f[6] = bf_lo(w.w); f[7] = bf_hi(w.w); }
__device__ __forceinline__ u32x4 pack8(const float (&f)[8]) { u32x4 w; w.x = cvt_pk_bf16(f[0], f[1]); w.y = cvt_pk_bf16(f[2], f[3]); w.z = cvt_pk_bf16(f[4], f[5]); w.w = cvt_pk_bf16(f[6], f[7]); return w; }
__device__ __forceinline__ float wave_sum(float v) {
#pragma unroll
    for (int o = 1; o < 64; o <<= 1) v += __shfl_xor(v, o);
    return v;
}

#define XB_TMO      128
#define XB_XCNT(j)  (256  + 64 * (j))
#define XB_XSUB(j)  (1280 + 64 * (j))
#define XB_XGEN(j)  (2304 + 64 * (j))
#define XB_TOP      3328
#define XB_TOPGEN   3392
#define XCD_BAR_WORDS 3456
#define XB_SPIN_CAP (1u << 18)
__device__ __forceinline__ unsigned xb_ld(unsigned* p)              { return __hip_atomic_load(p, __ATOMIC_RELAXED, __HIP_MEMORY_SCOPE_AGENT); }
__device__ __forceinline__ unsigned xb_add(unsigned* p, unsigned v) { return __hip_atomic_fetch_add(p, v, __ATOMIC_RELAXED, __HIP_MEMORY_SCOPE_AGENT); }
__device__ __forceinline__ unsigned xb_xcc_id() { return (unsigned)__builtin_amdgcn_s_getreg((3 << 11) | 20) & 0xFu; }
#define XB_SPIN(cond, bar) do { unsigned _sp = 0; while (cond) { __builtin_amdgcn_s_sleep(1); \
    if ((++_sp & 255u) == 0u) { if (xb_ld(&(bar)[XB_TMO])) break; if (_sp > XB_SPIN_CAP) { atomicAdd(&(bar)[XB_TMO], 1u); break; } } } } while (0)
struct XcdBarrier { unsigned* bar; unsigned x; volatile LAS unsigned* st; };
__device__ __forceinline__ XcdBarrier xcd_barrier_post(unsigned* bar, volatile LAS unsigned* st) {
    XcdBarrier b; b.bar = bar; b.x = xb_xcc_id(); b.st = st;
    if (threadIdx.x == 0) (void)xb_add(&bar[XB_XCNT(b.x)], 1u);
    return b;
}
__device__ __forceinline__ void xcd_barrier_complete(unsigned* bar, unsigned x, unsigned& nloc, unsigned& nx) {
    const unsigned G = gridDim.x * gridDim.y * gridDim.z;
    unsigned sum, cnt, mine, sp = 0u;
    for (;;) {
        sum = 0u; cnt = 0u; mine = 0u;
#pragma unroll
        for (unsigned j = 0; j < 16; ++j) { const unsigned c = xb_ld(&bar[XB_XCNT(j)]); sum += c; cnt += (c > 0u) ? 1u : 0u; mine = (j == x) ? c : mine; }
        if (sum == G) break;
        __builtin_amdgcn_s_sleep(1);
        if ((++sp & 255u) == 0u) { if (xb_ld(&bar[XB_TMO])) break; if (sp > XB_SPIN_CAP) { atomicAdd(&bar[XB_TMO], 1u); break; } }
    }
    nloc = mine > 0u ? mine : 1u; nx = cnt > 0u ? cnt : 1u;
}
__device__ __forceinline__ void xcd_barrier(const XcdBarrier& b) {
    asm volatile("s_waitcnt vmcnt(0)" ::: "memory");
    __syncthreads();
    if (threadIdx.x == 0) {
        unsigned* bar = b.bar;
        __builtin_amdgcn_s_waitcnt(0);
        unsigned nloc = b.st[0], nx = b.st[1];
        if (nloc == 0u) { xcd_barrier_complete(bar, b.x, nloc, nx); b.st[0] = nloc; b.st[1] = nx; }
        const unsigned old = xb_add(&bar[XB_XSUB(b.x)], 1u);
        const unsigned gen = old / nloc;
        if (old + 1u == (gen + 1u) * nloc) {
            __builtin_amdgcn_fence(__ATOMIC_RELEASE, "agent");
            asm volatile("s_waitcnt vmcnt(0)" ::: "memory");
            const unsigned og = xb_add(&bar[XB_TOP], 1u);
            const unsigned tg = og / nx;
            if (og + 1u == (tg + 1u) * nx) xb_add(&bar[XB_TOPGEN], 1u);
            else XB_SPIN(xb_ld(&bar[XB_TOPGEN]) == tg, bar);
            __builtin_amdgcn_fence(__ATOMIC_ACQUIRE, "agent");
            xb_add(&bar[XB_XGEN(b.x)], 1u);
            asm volatile("s_waitcnt vmcnt(0)" ::: "memory");
        } else {
            XB_SPIN(xb_ld(&bar[XB_XGEN(b.x)]) == gen, bar);
            __builtin_amdgcn_fence(__ATOMIC_ACQUIRE, "agent");
            asm volatile("s_waitcnt vmcnt(0)" ::: "memory");
        }
    }
    __syncthreads();
}

namespace pg8 {
constexpr int BM = 256, BK = 64, HALF = 128, HTB = HALF * BK * 2, STAGE_BYTES = 8 * HTB, NXCD = 8, WGM = 8;
__host__ __device__ __forceinline__ int lds_byte(int r, int c) { const int st = (r >> 4) * 2 + (c >> 5), rr = r & 15, cc = c & 31, ob = rr * 64 + cc * 2; return st * 1024 + (ob ^ (((ob >> 9) & 1) << 5)); }
__host__ __device__ __forceinline__ void stage_rc(int b, int& R, int& C) { const int st = b / 1024, sb = b % 1024, swz = sb ^ (((sb >> 9) & 1) << 5); R = (st >> 1) * 16 + swz / 64; C = (st & 1) * 32 + (swz % 64) / 2; }
__host__ __device__ __forceinline__ int perm32(int rho) { const int n = rho >> 4, i = rho & 15; return 8 * (i >> 2) + 4 * n + (i & 3); }

struct Unit { const char* a; const char* b; int pm, pn; };
struct Gemm { int K, lda, ldb, amode; };

struct StaticOrder {
    const bf16_t* A; const bf16_t* Bt; int lda, ldb;
    int nM, nN, nwg, G, c; size_t tstepA;
    __device__ void init(const bf16_t* A_, const bf16_t* Bt_, int lda_, int ldb_, int M, int N, int G_, int c_) { A = A_; Bt = Bt_; lda = lda_; ldb = ldb_; nM = M / BM; nN = N / BM; nwg = nM * nN; G = G_; c = c_; tstepA = (size_t)BM * lda * 2; }
    __device__ bool next(int i, Unit& u) const {
        const long L = (long)i * G + c; if (L >= nwg) return false;
        int wgid = (int)L; { const int q = nwg / NXCD, r = nwg % NXCD, xcd = wgid % NXCD, off = wgid / NXCD; wgid = (xcd < r ? xcd * (q + 1) : r * (q + 1) + (xcd - r) * q) + off; }
        const int nig = WGM * nN, gid = wgid / nig, fm = gid * WGM, gsz = (nM - fm) < WGM ? (nM - fm) : WGM;
        u.pm = fm + ((wgid % nig) % gsz); u.pn = (wgid % nig) / gsz;
        u.a = (const char*)A + (size_t)u.pm * tstepA; u.b = (const char*)Bt + (size_t)u.pn * BM * ldb * 2; return true;
    }
};

template <class Epi, class Sched, bool ALIGN_EPI = false, bool SP2 = true>
__device__ __forceinline__ void gemm_phase(LAS unsigned char* lds, const Gemm g, const Sched& S, const Epi& E, const int tid) {
    const int wid = __builtin_amdgcn_readfirstlane(tid >> 6), lane = tid & 63, wr = wid >> 2, wc = wid & 3, fr = lane & 15, fq = lane >> 4;
    const int K = g.K, nt = K / BK;
    unsigned voffA[2], voffB[2];
#pragma unroll
    for (int i = 0; i < 2; ++i) { int R, C; stage_rc(tid * 16 + i * 8192, R, C); const int Rb = Epi::PERM ? ((R & ~31) + perm32(R & 31)) : R;
        voffA[i] = g.amode ? (unsigned)((((C >> 4) * S5ROWS + (R >> 4)) * 256 + (R & 15) * 16 + (C & 15)) * 2) : (unsigned)(R * g.lda + C) * 2u; voffB[i] = (unsigned)(Rb * g.ldb + C) * 2u; }
    const size_t kstepB = (size_t)(BK * 2), kstepA = g.amode ? (size_t)4 * S5ROWS * 256 * 2 : (size_t)(BK * 2);
    const size_t hstepA = g.amode ? (size_t)8 * 256 * 2 : (size_t)HALF * g.lda * 2, hstepB = (size_t)HALF * g.ldb * 2;
    const unsigned ldsw = (unsigned)wid * 1024u;
    const int aoff = lds_byte(wr * 64 + fr, fq * 8), boff = lds_byte(wc * 32 + fr, fq * 8);
#define PG8_SA(b, h) (((b) * 2 + (h)) * HTB)
#define PG8_SB(b, h) ((4 + (b) * 2 + (h)) * HTB)
#define PG8_STAGE(bufoff, gbase, voff) do { _Pragma("unroll") for (int _i = 0; _i < 2; ++_i) \
        __builtin_amdgcn_global_load_lds((const unsigned*)((const char*)(gbase) + (voff)[_i]), (LAS unsigned*)(lds + (bufoff) + ldsw + _i * 8192), 16, 0, 0); } while (0)
#define PG8_LDA(dst, b, h) do { _Pragma("unroll") for (int m = 0; m < 4; ++m) _Pragma("unroll") for (int k = 0; k < 2; ++k) dst[m][k] = *(const LAS bf16x8*)(lds + PG8_SA(b, h) + aoff + m * 2048 + k * 1024); } while (0)
#define PG8_LDB(dst, b, h) do { _Pragma("unroll") for (int n = 0; n < 2; ++n) _Pragma("unroll") for (int k = 0; k < 2; ++k) dst[n][k] = *(const LAS bf16x8*)(lds + PG8_SB(b, h) + boff + n * 2048 + k * 1024); } while (0)
#define PG8_MMA(ai, bj, At, Bt) do { __builtin_amdgcn_s_setprio(1); _Pragma("unroll") for (int m = 0; m < 4; ++m) _Pragma("unroll") for (int n = 0; n < 2; ++n) _Pragma("unroll") for (int k = 0; k < 2; ++k) \
        acc[ai][bj][m][n] = __builtin_amdgcn_mfma_f32_16x16x32_bf16(Bt[n][k], At[m][k], acc[ai][bj][m][n], 0, 0, 0); __builtin_amdgcn_s_setprio(0); } while (0)
#define PG8_WAIT_V(n) asm volatile("s_waitcnt vmcnt(" #n ")" ::: "memory")
#define PG8_WAIT_L(n) asm volatile("s_waitcnt lgkmcnt(" #n ")" ::: "memory")
#define PG8_BAR __builtin_amdgcn_s_barrier()
#define PG8_SCHED __builtin_amdgcn_sched_barrier(0)
    Unit cur, nxt; int ui = 0;
    if (!S.next(0, cur)) return;
    f32x4 acc[2][2][4][2];
#pragma unroll
    for (int a = 0; a < 2; ++a)
#pragma unroll
        for (int b = 0; b < 2; ++b)
#pragma unroll
            for (int m = 0; m < 4; ++m)
#pragma unroll
                for (int n = 0; n < 2; ++n) acc[a][b][m][n] = (f32x4){0.f, 0.f, 0.f, 0.f};
    bf16x8 At[4][2], B0[2][2], B1[2][2];
    const char* cA = cur.a; const char* cB = cur.b;
    static_assert(SP2, "only the SP2 loop is kept");
    PG8_STAGE(PG8_SB(0, 0), cB, voffB); PG8_STAGE(PG8_SB(0, 1), cB + hstepB, voffB); PG8_STAGE(PG8_SA(0, 0), cA, voffA); PG8_STAGE(PG8_SA(0, 1), cA + hstepA, voffA);
    if (wr == 1) PG8_BAR;
    PG8_WAIT_V(2); PG8_BAR;
    PG8_STAGE(PG8_SB(1, 0), cB + kstepB, voffB); PG8_STAGE(PG8_SA(1, 0), cA + kstepA, voffA); PG8_STAGE(PG8_SB(1, 1), cB + hstepB + kstepB, voffB);
    PG8_WAIT_V(6); PG8_BAR;
    for (;;) {
        const bool has_next = S.next(ui + 1, nxt);
        const char* nA = has_next ? nxt.a : cA; const char* nB = has_next ? nxt.b : cB;
#pragma unroll 1
        for (int t = 0; t < nt; t += 2) {
            const bool last = (t == nt - 2);
            const char* a1 = cA + (size_t)(t + 1) * kstepA;
            const char* a2 = last ? nA : cA + (size_t)(t + 2) * kstepA; const char* b2 = last ? nB : cB + (size_t)(t + 2) * kstepB;
            const char* a3 = a2 + kstepA; const char* b3 = b2 + kstepB;
            PG8_LDB(B0, 0, 0); PG8_LDB(B1, 0, 1); PG8_SCHED; PG8_LDA(At, 0, 0); PG8_STAGE(PG8_SA(1, 1), a1 + hstepA, voffA);
            PG8_WAIT_V(8); PG8_WAIT_L(0); PG8_BAR; PG8_MMA(0, 0, At, B0); PG8_MMA(0, 1, At, B1); PG8_BAR; PG8_SCHED;
            PG8_LDA(At, 0, 1); PG8_STAGE(PG8_SB(0, 0), b2, voffB); PG8_STAGE(PG8_SB(0, 1), b2 + hstepB, voffB); PG8_STAGE(PG8_SA(0, 0), a2, voffA);
            PG8_WAIT_V(8); PG8_WAIT_L(0); PG8_BAR; PG8_MMA(1, 0, At, B0); PG8_MMA(1, 1, At, B1); PG8_BAR; PG8_SCHED;
            PG8_LDB(B0, 1, 0); PG8_LDB(B1, 1, 1); PG8_SCHED; PG8_LDA(At, 1, 0); PG8_STAGE(PG8_SA(0, 1), a2 + hstepA, voffA);
            PG8_WAIT_V(8); PG8_WAIT_L(0); PG8_BAR; PG8_MMA(0, 0, At, B0); PG8_MMA(0, 1, At, B1); PG8_BAR; PG8_SCHED;
            PG8_LDA(At, 1, 1); PG8_STAGE(PG8_SB(1, 0), b3, voffB); PG8_STAGE(PG8_SB(1, 1), b3 + hstepB, voffB); PG8_STAGE(PG8_SA(1, 0), a3, voffA);
            PG8_WAIT_V(8); PG8_WAIT_L(0); PG8_BAR; PG8_MMA(1, 0, At, B0); PG8_MMA(1, 1, At, B1); PG8_BAR; PG8_SCHED;
        }
        if constexpr (ALIGN_EPI) { if (wr == 0) PG8_BAR; }
        E(acc, cur, wr, wc, fr, fq);
        if (!has_next) break;
#pragma unroll
        for (int a = 0; a < 2; ++a)
#pragma unroll
            for (int b = 0; b < 2; ++b)
#pragma unroll
                for (int m = 0; m < 4; ++m)
#pragma unroll
                    for (int n = 0; n < 2; ++n) acc[a][b][m][n] = (f32x4){0.f, 0.f, 0.f, 0.f};
        cur = nxt; cA = nA; cB = nB; ++ui;
        if constexpr (ALIGN_EPI) { if (wr == 1) PG8_BAR; }
    }
    PG8_WAIT_V(0);
    if constexpr (!ALIGN_EPI) { if (wr == 0) PG8_BAR; }
    PG8_BAR;
#undef PG8_SA
#undef PG8_SB
#undef PG8_STAGE
#undef PG8_LDA
#undef PG8_LDB
#undef PG8_MMA
#undef PG8_WAIT_V
#undef PG8_WAIT_L
#undef PG8_BAR
#undef PG8_SCHED
}

template <class F> struct EpiGen8 {
    static constexpr bool PERM = true, HAS_MID = false; F f; int mid_t;
    __device__ __forceinline__ void mid(f32x4 (&)[2][2][4][2], const Unit&, int, int, int, int) const {}
    __device__ __forceinline__ void operator()(const f32x4 (&acc)[2][2][4][2], const Unit& u, int wr, int wc, int fr, int fq) const {
#pragma unroll
        for (int ai = 0; ai < 2; ++ai)
#pragma unroll
            for (int m = 0; m < 4; ++m) { const int r = ai * HALF + wr * 64 + m * 16 + fr;
#pragma unroll
                for (int bj = 0; bj < 2; ++bj) f(u, r, bj * HALF + wc * 32 + 8 * fq, acc[ai][bj][m][0], acc[ai][bj][m][1]);
                if constexpr (F::PIN) __builtin_amdgcn_sched_barrier(0); }
    }
};
}

typedef const float* cfp_t;
typedef __attribute__((address_space(4))) const cfp_t* InTab;
struct Frame {
    LAS unsigned char* lds;
    volatile LAS unsigned* MISC;
    gu32* ctl;
    int tid, lane, wave, vcu, G;
    unsigned char* ws; unsigned char* dout; unsigned char* ws0; unsigned char* dout0;
    InTab in;
};
enum { I_X = 0, I_NMPRE, I_NMPOST, I_NFPRE, I_NFPOST, I_WIN, I_BGATE, I_MU, I_W0, I_W2, I_A0, I_A2, I_G2, I_KK, I_KA, I_RK, I_LNW, I_LNB,
       I_SARE, I_SAIM, I_SBRE, I_SBIM, I_SCRE, I_SCIM, I_SD, I_SLOG, I_WGLU, I_BGLU, I_WBR, I_WBS, I_WOUT, I_WUP, I_CONVW, I_CONVB, I_WDN };

__device__ __forceinline__ void p0_transpose_item(const float* W, int ldw, int k0, int src0, bf16_t* WT, int ldt, int drow0, int koff, const float* kscale, LAS float* scr, int lane) {
    const int q = lane & 7, rb = lane >> 3;
    f32x4 v[8]; float sc[8];
#pragma unroll
    for (int i = 0; i < 8; ++i) { const int kk = 8 * i + rb; v[i] = __builtin_nontemporal_load((const f32x4*)(W + (size_t)(k0 + kk) * ldw + src0 + 4 * q)); sc[i] = kscale ? kscale[k0 + kk] : 1.0f; }
#pragma unroll
    for (int i = 0; i < 8; ++i) { const int kk = 8 * i + rb; LAS float* d = scr + kk * 33 + 4 * q; d[0] = v[i].x * sc[i]; d[1] = v[i].y * sc[i]; d[2] = v[i].z * sc[i]; d[3] = v[i].w * sc[i]; }
    LDS_WAIT(); asm volatile("" ::: "memory");
    const int c = lane & 7;
#pragma unroll
    for (int j = 0; j < 4; ++j) { const int n = (lane >> 3) + 8 * j; const LAS float* s = scr + (8 * c) * 33 + n;
        u32x4 o; o.x = cvt_pk_bf16(s[0 * 33], s[1 * 33]); o.y = cvt_pk_bf16(s[2 * 33], s[3 * 33]); o.z = cvt_pk_bf16(s[4 * 33], s[5 * 33]); o.w = cvt_pk_bf16(s[6 * 33], s[7 * 33]);
        *(GAS u32x4*)(WT + (size_t)(drow0 + n) * ldt + koff + k0 + 8 * c) = o; }
    LDS_WAIT(); asm volatile("" ::: "memory");
}
struct TrMat { int in_idx, K, N, ldt, koff, kind; size_t dst; int scale_idx; };
__device__ __forceinline__ void p0_do_matrix(Frame& F, const TrMat& mtx, int r, LAS float* scr) {
    const int nblk = mtx.N / 32, kb = r / nblk, nb = r % nblk;
    int src0 = 32 * nb;
    if (mtx.kind == 1) {
        const int pn = (32 * nb) >> 8, within = (32 * nb) & 255;
        src0 = (within < 128 ? 0 : FF - 128) + 128 * pn + within;
    }
    p0_transpose_item(F.in[mtx.in_idx], mtx.N, 64 * kb, src0, (bf16_t*)(F.ws + mtx.dst), mtx.ldt, 32 * nb, mtx.koff, mtx.scale_idx >= 0 ? F.in[mtx.scale_idx] : nullptr, scr, F.lane);
}
__device__ __forceinline__ void p0_s5_group(Frame& F, int g) {
    LAS float* pwr = (LAS float*)(F.lds);
    LAS float* pwi = pwr + 17 * 64;
    LAS float* bbr = pwi + 17 * 64;
    LAS float* bbi = bbr + 1024;
    LAS float* cre = bbi + 1024;
    LAS float* cim = cre + 1024;
    LAS float* kk = cim + 1024;
    const float dt = expf(F.in[I_SLOG][g]);
    for (int idx = F.tid; idx < 17 * 64; idx += 512) { const int k = idx >> 6, p = idx & 63;
        const float are = F.in[I_SARE][g * 64 + p], aim = F.in[I_SAIM][g * 64 + p];
        const float mag = expf((float)k * are * dt); float sn, cs; sincosf((float)k * aim * dt, &sn, &cs);
        pwr[idx] = mag * cs; pwi[idx] = mag * sn; }
    for (int idx = F.tid; idx < 1024; idx += 512) { cre[idx] = F.in[I_SCRE][g * 1024 + idx]; cim[idx] = F.in[I_SCIM][g * 1024 + idx]; }
    __syncthreads();
    for (int idx = F.tid; idx < 1024; idx += 512) { const int p = idx >> 4;
        const float are = F.in[I_SARE][g * 64 + p], aim = F.in[I_SAIM][g * 64 + p];
        const float nr = pwr[64 + p] - 1.0f, ni = pwi[64 + p];
        const float den = 1.0f / (are * are + aim * aim);
        const float qr = (nr * are + ni * aim) * den, qi = (ni * are - nr * aim) * den;
        const float br = F.in[I_SBRE][g * 1024 + idx], bi = F.in[I_SBIM][g * 1024 + idx];
        bbr[idx] = qr * br - qi * bi; bbi[idx] = qr * bi + qi * br; }
    __syncthreads();
    {
        const int kc = F.tid & 255, ph = F.tid >> 8, k = kc >> 4, c = kc & 15; float s[16];
#pragma unroll
        for (int e = 0; e < 16; ++e) s[e] = 0.f;
        for (int p = 32 * ph; p < 32 * ph + 32; ++p) { const float cr_ = cre[c * 64 + p], ci_ = cim[c * 64 + p], pr_ = pwr[k * 64 + p], pi_ = pwi[k * 64 + p];
            const float xr = cr_ * pr_ - ci_ * pi_, xi = cr_ * pi_ + ci_ * pr_;
#pragma unroll
            for (int e4 = 0; e4 < 4; ++e4) { const f32x4 br = *(LAS const f32x4*)(bbr + p * 16 + 4 * e4), bi = *(LAS const f32x4*)(bbi + p * 16 + 4 * e4);
#pragma unroll
                for (int e = 0; e < 4; ++e) s[4 * e4 + e] += xr * br[e] - xi * bi[e]; } }
        LAS float* part = kk + 4096;
        if (ph == 1) {
#pragma unroll
            for (int e4 = 0; e4 < 4; ++e4) *(LAS f32x4*)(part + kc * 16 + 4 * e4) = (f32x4){s[4 * e4], s[4 * e4 + 1], s[4 * e4 + 2], s[4 * e4 + 3]}; }
        __syncthreads();
        if (ph == 0) {
#pragma unroll
            for (int e4 = 0; e4 < 4; ++e4) { const f32x4 o = *(LAS const f32x4*)(part + kc * 16 + 4 * e4);
#pragma unroll
                for (int e = 0; e < 4; ++e) { float v = s[4 * e4 + e] + o[e]; if (k == 0 && c == 4 * e4 + e) v += F.in[I_SD][g * 16 + c]; kk[kc * 16 + 4 * e4 + e] = v; } } }
    }
    __syncthreads();
    bf16_t* B1b = (bf16_t*)(F.ws + WS_B1B) + (size_t)g * 256 * 384;
    for (int idx = F.tid; idx < 256 * 192; idx += 512) { const int n = idx / 192, k2 = (idx % 192) * 2; const int t = n >> 4, c = n & 15; float v[2];
#pragma unroll
        for (int e = 0; e < 2; ++e) { const int kx = k2 + e;
            if (kx < 256) { const int tau = kx >> 4, cp = kx & 15; v[e] = (t >= tau) ? kk[(t - tau) * 256 + c * 16 + cp] : 0.f; }
            else { const int si = kx - 256, p = si >> 1; const float xr = cre[c * 64 + p] * pwr[(t + 1) * 64 + p] - cim[c * 64 + p] * pwi[(t + 1) * 64 + p], xi = cre[c * 64 + p] * pwi[(t + 1) * 64 + p] + cim[c * 64 + p] * pwr[(t + 1) * 64 + p];
                v[e] = (si & 1) ? -xi : xr; } }
        *(unsigned*)(B1b + (size_t)n * 384 + k2) = cvt_pk_bf16(v[0], v[1]); }
    bf16_t* B1a = (bf16_t*)(F.ws + WS_B1A) + (size_t)g * 256 * 256;
    for (int idx = F.tid; idx < 256 * 128; idx += 512) { const int n = idx >> 7, k2 = (idx & 127) * 2; float v[2] = {0.f, 0.f};
        if (n < 128) { const int p = n >> 1;
#pragma unroll
            for (int e = 0; e < 2; ++e) { const int kx = k2 + e, tau = kx >> 4, cp = kx & 15; const float pr_ = pwr[(15 - tau) * 64 + p], pi_ = pwi[(15 - tau) * 64 + p];
                const float xr = pr_ * bbr[p * 16 + cp] - pi_ * bbi[p * 16 + cp], xi = pr_ * bbi[p * 16 + cp] + pi_ * bbr[p * 16 + cp]; v[e] = (n & 1) ? xi : xr; } }
        *(unsigned*)(B1a + (size_t)n * 256 + k2) = cvt_pk_bf16(v[0], v[1]); }
    float* aL = (float*)(F.ws + WS_AL) + g * 128;
    if (F.tid < 64) { aL[2 * F.tid] = pwr[16 * 64 + F.tid]; aL[2 * F.tid + 1] = pwi[16 * 64 + F.tid]; }
    __syncthreads();
}
__device__ __forceinline__ void p0_prologue(Frame& F) {
    if (F.vcu < S5G) p0_s5_group(F, F.vcu);
    if (F.vcu < S5G && F.G > S5G) return;
    LAS float* scr = (LAS float*)(F.lds + F.wave * 16384);
    const int gw = (F.G > S5G ? F.vcu - S5G : F.vcu) * NWAVES + F.wave, NGW = (F.G > S5G ? F.G - S5G : F.G) * NWAVES;
    int base = 0;
#define DO_MAT(in_idx, K_, N_, ldt_, koff_, kind_, dst_, sc_) do { const TrMat mtx{in_idx, K_, N_, ldt_, koff_, kind_, dst_, sc_}; const int items = ((K_) / 64) * ((N_) / 32); \
        for (int it = gw; it < base + items; it += NGW) { if (it >= base) p0_do_matrix(F, mtx, it - base, scr); } base += items; } while (0)
    DO_MAT(I_WIN, D, NIN, D, 0, 0, WS_WIN, I_NMPRE); DO_MAT(I_WUP, D, 2 * FF, D, 0, 1, WS_WUP, I_NFPRE); DO_MAT(I_WDN, FF, D, FF, 0, 0, WS_WDN, -1); DO_MAT(I_WOUT, D, D, D, 0, 0, WS_WOUT, -1);
    DO_MAT(I_WBR, RW, D, D, 0, 0, WS_WBRS, -1); DO_MAT(I_WBS, RW, D, D, RW, 0, WS_WBRS, -1); DO_MAT(I_WGLU, RW, RW, RW, 0, 0, WS_WGLU, -1);
    DO_MAT(I_W2, 64, RW, 64, 0, 0, WS_W2T, -1); DO_MAT(I_A2, 64, RW, 64, 0, 0, WS_A2T, -1); DO_MAT(I_G2, 128, RW, 128, 0, 0, WS_G2T, -1);
#undef DO_MAT
    if (F.vcu >= S5G || F.G <= S5G) {
        bf16_t* XN = (bf16_t*)(F.ws + WS_XN);
        const int gw2 = gw, NGW2 = NGW;
        for (int m = gw2; m < T; m += 2 * NGW2) {
            const int m1 = (m + NGW2 < T) ? m + NGW2 : m;
            const GAS f32x4* xr0 = (const GAS f32x4*)(F.in[I_X] + (size_t)m * D) + F.lane; const GAS f32x4* xr1 = (const GAS f32x4*)(F.in[I_X] + (size_t)m1 * D) + F.lane;
            f32x4 v0[4], v1[4]; float s0 = 0.f, s1 = 0.f;
#pragma unroll
            for (int j = 0; j < 4; ++j) { v0[j] = __builtin_nontemporal_load((const f32x4*)(xr0 + 64 * j)); v1[j] = __builtin_nontemporal_load((const f32x4*)(xr1 + 64 * j)); }
#pragma unroll
            for (int j = 0; j < 4; ++j) { s0 += (v0[j].x * v0[j].x + v0[j].y * v0[j].y) + (v0[j].z * v0[j].z + v0[j].w * v0[j].w); s1 += (v1[j].x * v1[j].x + v1[j].y * v1[j].y) + (v1[j].z * v1[j].z + v1[j].w * v1[j].w); }
            const float r0 = 1.0f / sqrtf(wave_sum(s0) * (1.f / D) + 1e-6f), r1 = 1.0f / sqrtf(wave_sum(s1) * (1.f / D) + 1e-6f);
            GAS u32x2* o0 = (GAS u32x2*)(XN + (size_t)m * D) + F.lane; GAS u32x2* o1 = (GAS u32x2*)(XN + (size_t)m1 * D) + F.lane;
#pragma unroll
            for (int j = 0; j < 4; ++j) { u32x2 w; w.x = cvt_pk_bf16(v0[j].x * r0, v0[j].y * r0); w.y = cvt_pk_bf16(v0[j].z * r0, v0[j].w * r0); o0[64 * j] = w;
                u32x2 w1; w1.x = cvt_pk_bf16(v1[j].x * r1, v1[j].y * r1); w1.y = cvt_pk_bf16(v1[j].z * r1, v1[j].w * r1); o1[64 * j] = w1; }
        }
    }
}

struct EpiInProj {
    static constexpr bool PERM = true, HAS_MID = false;
    bf16_t* PR; bf16_t* UG; bf16_t* GT; const float* bg; int mid_t;
    __device__ __forceinline__ void mid(f32x4 (&)[2][2][4][2], const pg8::Unit&, int, int, int, int) const {}
    __device__ __forceinline__ void operator()(const f32x4 (&acc)[2][2][4][2], const pg8::Unit& u, int wr, int wc, int fr, int fq) const {
        f32x4 b0[2], b1[2];
        if (u.pn >= 9) {
#pragma unroll
            for (int bj = 0; bj < 2; ++bj) { const int gc = (u.pn - 9) * 256 + bj * 128 + wc * 32 + 8 * fq; b0[bj] = *(const f32x4*)(bg + gc); b1[bj] = *(const f32x4*)(bg + gc + 4); } }
#pragma unroll
        for (int ai = 0; ai < 2; ++ai)
#pragma unroll
            for (int m = 0; m < 4; ++m) { const int row = u.pm * 256 + ai * 128 + wr * 64 + m * 16 + fr;
#pragma unroll
                for (int bj = 0; bj < 2; ++bj) { const int cl = bj * 128 + wc * 32 + 8 * fq; const f32x4 v0 = acc[ai][bj][m][0], v1 = acc[ai][bj][m][1]; u32x4 w;
                    if (u.pn < 7) { w.x = cvt_pk_bf16(v0[0], v0[1]); w.y = cvt_pk_bf16(v0[2], v0[3]); w.z = cvt_pk_bf16(v1[0], v1[1]); w.w = cvt_pk_bf16(v1[2], v1[3]);
                        *(u32x4*)(PR + (size_t)row * NRW + u.pn * 256 + cl) = w; }
                    else if (u.pn < 9) { const int cr = (u.pn - 7) * 256 + cl, g = cr >> 4, c0 = cr & 15;
                        w.x = cvt_pk_bf16(v0[0], v0[1]); w.y = cvt_pk_bf16(v0[2], v0[3]); w.z = cvt_pk_bf16(v1[0], v1[1]); w.w = cvt_pk_bf16(v1[2], v1[3]);
                        *(u32x4*)(UG + ((size_t)g * S5ROWS + (row >> 4)) * UGLD + (row & 15) * 16 + c0) = w; }
                    else { const int gc = (u.pn - 9) * 256 + cl;
                        w.x = cvt_pk_bf16(fsigmoid(v0[0] + b0[bj][0]), fsigmoid(v0[1] + b0[bj][1])); w.y = cvt_pk_bf16(fsigmoid(v0[2] + b0[bj][2]), fsigmoid(v0[3] + b0[bj][3]));
                        w.z = cvt_pk_bf16(fsigmoid(v1[0] + b1[bj][0]), fsigmoid(v1[1] + b1[bj][1])); w.w = cvt_pk_bf16(fsigmoid(v1[2] + b1[bj][2]), fsigmoid(v1[3] + b1[bj][3]));
                        __builtin_nontemporal_store(w, (u32x4*)(GT + (size_t)row * 2048 + gc)); } }
                __builtin_amdgcn_sched_barrier(0); }
    }
};
struct FS5Out {
    static constexpr bool PIN = true;
    bf16_t* YSP;
    __device__ __forceinline__ void operator()(const pg8::Unit& u, int r, int cl, f32x4 v0, f32x4 v1) const {
        const int crow = u.pm * 256 + r; u32x4 w;
        w.x = cvt_pk_bf16(fgelu(v0[0]), fgelu(v0[1])); w.y = cvt_pk_bf16(fgelu(v0[2]), fgelu(v0[3])); w.z = cvt_pk_bf16(fgelu(v1[0]), fgelu(v1[1])); w.w = cvt_pk_bf16(fgelu(v1[2]), fgelu(v1[3]));
        *(u32x4*)(YSP + ((size_t)u.pn * S5ROWS + crow) * 256 + cl) = w;
    }
};
struct EpiGlu {
    static constexpr bool PERM = true, HAS_MID = false;
    const bf16_t* YSP; bf16_t* YS; const float* bglu; int mid_t;
    __device__ __forceinline__ void mid(f32x4 (&)[2][2][4][2], const pg8::Unit&, int, int, int, int) const {}
    __device__ __forceinline__ void operator()(const f32x4 (&acc)[2][2][4][2], const pg8::Unit& u, int wr, int wc, int fr, int fq) const {
        u32x4 yv[2][4][2]; f32x4 b0[2], b1[2];
#pragma unroll
        for (int bj = 0; bj < 2; ++bj) { const int col = u.pn * 256 + bj * 128 + wc * 32 + 8 * fq; b0[bj] = *(const f32x4*)(bglu + col); b1[bj] = *(const f32x4*)(bglu + col + 4); }
#pragma unroll
        for (int ai = 0; ai < 2; ++ai)
#pragma unroll
            for (int m = 0; m < 4; ++m)
#pragma unroll
                for (int bj = 0; bj < 2; ++bj) { const int row = u.pm * 256 + ai * 128 + wr * 64 + m * 16 + fr, col = u.pn * 256 + bj * 128 + wc * 32 + 8 * fq;
                    yv[ai][m][bj] = __builtin_nontemporal_load((const u32x4*)(YSP + ((size_t)(col >> 4) * S5ROWS + (row >> 4)) * 256 + (row & 15) * 16 + (col & 15))); }
#pragma unroll
        for (int ai = 0; ai < 2; ++ai)
#pragma unroll
            for (int m = 0; m < 4; ++m) {
#pragma unroll
                for (int bj = 0; bj < 2; ++bj) { const int row = u.pm * 256 + ai * 128 + wr * 64 + m * 16 + fr, col = u.pn * 256 + bj * 128 + wc * 32 + 8 * fq; float y[8]; unpack8(yv[ai][m][bj], y);
                    const f32x4 v0 = acc[ai][bj][m][0], v1 = acc[ai][bj][m][1]; u32x4 w;
                    w.x = cvt_pk_bf16(y[0] * fsigmoid(v0[0] + b0[bj][0]), y[1] * fsigmoid(v0[1] + b0[bj][1])); w.y = cvt_pk_bf16(y[2] * fsigmoid(v0[2] + b0[bj][2]), y[3] * fsigmoid(v0[3] + b0[bj][3]));
                    w.z = cvt_pk_bf16(y[4] * fsigmoid(v1[0] + b1[bj][0]), y[5] * fsigmoid(v1[1] + b1[bj][1])); w.w = cvt_pk_bf16(y[6] * fsigmoid(v1[2] + b1[bj][2]), y[7] * fsigmoid(v1[3] + b1[bj][3]));
                    *(u32x4*)(YS + (size_t)row * D + RW + col) = w; }
                __builtin_amdgcn_sched_barrier(0); }
    }
};
struct FStore {
    static constexpr bool PIN = false;
    bf16_t* O; int ldc;
    __device__ __forceinline__ void operator()(const pg8::Unit& u, int r, int cl, f32x4 v0, f32x4 v1) const {
        u32x4 w; w.x = cvt_pk_bf16(v0[0], v0[1]); w.y = cvt_pk_bf16(v0[2], v0[3]); w.z = cvt_pk_bf16(v1[0], v1[1]); w.w = cvt_pk_bf16(v1[2], v1[3]);
        *(u32x4*)(O + (size_t)(u.pm * 256 + r) * ldc + u.pn * 256 + cl) = w;
    }
};
struct EpiMergeA {
    static constexpr bool PERM = true, HAS_MID = false;
    const bf16_t* GT; bf16_t* O; int mid_t;
    __device__ __forceinline__ void mid(f32x4 (&)[2][2][4][2], const pg8::Unit&, int, int, int, int) const {}
    __device__ __forceinline__ void operator()(const f32x4 (&acc)[2][2][4][2], const pg8::Unit& u, int wr, int wc, int fr, int fq) const {
        u32x4 gv[2][4][2];
#pragma unroll
        for (int ai = 0; ai < 2; ++ai)
#pragma unroll
            for (int m = 0; m < 4; ++m)
#pragma unroll
                for (int bj = 0; bj < 2; ++bj) { const int row = u.pm * 256 + ai * 128 + wr * 64 + m * 16 + fr, col = u.pn * 256 + bj * 128 + wc * 32 + 8 * fq;
                    gv[ai][m][bj] = __builtin_nontemporal_load((const u32x4*)(GT + (size_t)row * 2048 + col)); }
#pragma unroll
        for (int ai = 0; ai < 2; ++ai)
#pragma unroll
            for (int m = 0; m < 4; ++m) {
#pragma unroll
                for (int bj = 0; bj < 2; ++bj) { const int row = u.pm * 256 + ai * 128 + wr * 64 + m * 16 + fr, col = u.pn * 256 + bj * 128 + wc * 32 + 8 * fq; float g[8]; unpack8(gv[ai][m][bj], g);
                    const f32x4 v0 = acc[ai][bj][m][0], v1 = acc[ai][bj][m][1]; u32x4 w;
                    w.x = cvt_pk_bf16(v0[0] * g[0], v0[1] * g[1]); w.y = cvt_pk_bf16(v0[2] * g[2], v0[3] * g[3]); w.z = cvt_pk_bf16(v1[0] * g[4], v1[1] * g[5]); w.w = cvt_pk_bf16(v1[2] * g[6], v1[3] * g[7]);
                    *(u32x4*)(O + (size_t)row * D + col) = w; }
                __builtin_amdgcn_sched_barrier(0); }
    }
};
struct EpiMergeB {
    static constexpr bool PERM = true, HAS_MID = false;
    const bf16_t* GT; bf16_t* O; int mid_t;
    __device__ __forceinline__ void mid(f32x4 (&)[2][2][4][2], const pg8::Unit&, int, int, int, int) const {}
    __device__ __forceinline__ void operator()(const f32x4 (&acc)[2][2][4][2], const pg8::Unit& u, int wr, int wc, int fr, int fq) const {
#pragma unroll
        for (int ai = 0; ai < 2; ++ai) {
            u32x4 gv[4][2], tv[4][2];
#pragma unroll
            for (int m = 0; m < 4; ++m)
#pragma unroll
                for (int bj = 0; bj < 2; ++bj) { const int row = u.pm * 256 + ai * 128 + wr * 64 + m * 16 + fr, col = u.pn * 256 + bj * 128 + wc * 32 + 8 * fq;
                    gv[m][bj] = __builtin_nontemporal_load((const u32x4*)(GT + (size_t)row * 2048 + 1024 + col)); tv[m][bj] = *(const u32x4*)(O + (size_t)row * D + col); }
            __builtin_amdgcn_sched_barrier(0);
#pragma unroll
            for (int m = 0; m < 4; ++m) {
#pragma unroll
                for (int bj = 0; bj < 2; ++bj) { const int row = u.pm * 256 + ai * 128 + wr * 64 + m * 16 + fr, col = u.pn * 256 + bj * 128 + wc * 32 + 8 * fq; float g[8], t1[8]; unpack8(gv[m][bj], g); unpack8(tv[m][bj], t1);
                    const f32x4 v0 = acc[ai][bj][m][0], v1 = acc[ai][bj][m][1]; u32x4 w;
                    w.x = cvt_pk_bf16(t1[0] + v0[0] * g[0], t1[1] + v0[1] * g[1]); w.y = cvt_pk_bf16(t1[2] + v0[2] * g[2], t1[3] + v0[3] * g[3]);
                    w.z = cvt_pk_bf16(t1[4] + v1[0] * g[4], t1[5] + v1[1] * g[5]); w.w = cvt_pk_bf16(t1[6] + v1[2] * g[6], t1[7] + v1[3] * g[7]);
                    *(u32x4*)(O + (size_t)row * D + col) = w; }
                __builtin_amdgcn_sched_barrier(0); }
        }
    }
};
struct UpOrder {
    const bf16_t* H2; const bf16_t* Wt; int G, c;
    __device__ bool next(int i, pg8::Unit& u) const {
        constexpr int nM = NB * 16, nN = 22, nwg = nM * nN;
        const long L = (long)i * G + c; if (L >= nwg) return false;
        int wgid = (int)L; { const int q = nwg / 8, r = nwg % 8, xcd = wgid % 8, off = wgid / 8; wgid = (xcd < r ? xcd * (q + 1) : r * (q + 1) + (xcd - r) * q) + off; }
        const int nig = 8 * nN, gid = wgid / nig, fm = gid * 8, gsz = (nM - fm) < 8 ? (nM - fm) : 8;
        u.pm = fm + ((wgid % nig) % gsz); u.pn = (wgid % nig) / gsz;
        u.a = (const char*)H2 + ((size_t)u.pm * 256 * D) * 2; u.b = (const char*)(Wt + (size_t)u.pn * 256 * D); return true;
    }
};
template <int CTRL> __device__ __forceinline__ unsigned dppu(unsigned v) { return (unsigned)__builtin_amdgcn_update_dpp(0, (int)v, CTRL, 0xf, 0xf, true); }
struct EpiConvAct {
    static constexpr bool PERM = true, HAS_MID = false;
    bf16_t* ACT; const float* cw; const float* cb; LAS unsigned* EX; unsigned long long* HZ; unsigned* tmo; int mid_t;
    __device__ __forceinline__ void mid(f32x4 (&)[2][2][4][2], const pg8::Unit&, int, int, int, int) const {}
    __device__ __forceinline__ void operator()(f32x4 (&acc)[2][2][4][2], const pg8::Unit& u, int wr, int wc, int fr, int fq) const {
        const int b = u.pm >> 4, k = u.pm & 15, t0 = 256 * k;
        u32x2 zp[2][2][4][2];
#pragma unroll
        for (int ai = 0; ai < 2; ++ai)
#pragma unroll
            for (int bj = 0; bj < 2; ++bj)
#pragma unroll
                for (int m = 0; m < 4; ++m)
#pragma unroll
                    for (int n = 0; n < 2; ++n) { const f32x4 v = acc[ai][bj][m][n]; u32x2 w; w.x = cvt_pk_bf16(v[0], v[1]); w.y = cvt_pk_bf16(v[2], v[3]); zp[ai][bj][m][n] = w; }
        if (fr >= 14) {
#pragma unroll
            for (int ai = 0; ai < 2; ++ai)
#pragma unroll
                for (int bj = 0; bj < 2; ++bj)
#pragma unroll
                    for (int n = 0; n < 2; ++n) *(LAS u32x2*)(EX + (((wc * 4 + 2 * ai + wr) * 2 + (fr - 14)) * 32 + bj * 16 + fq * 4 + n * 2)) = zp[ai][bj][3][n]; }
        if (wr == 1 && k < 15 && fr >= 14) {
            unsigned long long* hz = HZ + ((size_t)(u.pm * 22 + u.pn) * 8 + wc * 2 + (fr - 14)) * 32;
#pragma unroll
            for (int bj = 0; bj < 2; ++bj)
#pragma unroll
                for (int n = 0; n < 2; ++n) { __hip_atomic_store(hz + bj * 16 + fq * 4 + n * 2, (1ull << 32) | zp[1][bj][3][n].x, RLX_AGENT); __hip_atomic_store(hz + bj * 16 + fq * 4 + n * 2 + 1, (1ull << 32) | zp[1][bj][3][n].y, RLX_AGENT); }
        }
        asm volatile("s_waitcnt lgkmcnt(0)" ::: "memory"); __builtin_amdgcn_s_barrier(); asm volatile("" ::: "memory");
        const int ch0 = u.pn * 128 + wc * 32 + 8 * fq;
        f32x4 wg[2][3], wv[2][3], bg[2], bv[2];
#pragma unroll
        for (int n = 0; n < 2; ++n) {
#pragma unroll
            for (int j = 0; j < 3; ++j) { wg[n][j] = *(const f32x4*)(cw + (size_t)j * 2 * FF + ch0 + 4 * n); wv[n][j] = *(const f32x4*)(cw + (size_t)j * 2 * FF + FF + ch0 + 4 * n); }
            bg[n] = *(const f32x4*)(cb + ch0 + 4 * n); bv[n] = *(const f32x4*)(cb + FF + ch0 + 4 * n); }
#pragma unroll
        for (int gi = 1; gi <= 8; ++gi) {
            const int ai = (gi & 7) >> 2, m = gi & 3, blk = 2 * ai + wr;
            u32x2 pp[2][2];
#pragma unroll
            for (int bj = 0; bj < 2; ++bj)
#pragma unroll
                for (int n = 0; n < 2; ++n) { pp[bj][n].x = 0u; pp[bj][n].y = 0u; }
            if (m > 0) {
#pragma unroll
                for (int bj = 0; bj < 2; ++bj)
#pragma unroll
                    for (int n = 0; n < 2; ++n) pp[bj][n] = zp[ai][bj][m - 1][n];
            } else if (blk > 0) {
                if (fr >= 14) {
#pragma unroll
                    for (int bj = 0; bj < 2; ++bj)
#pragma unroll
                        for (int n = 0; n < 2; ++n) pp[bj][n] = *(LAS const u32x2*)(EX + (((wc * 4 + blk - 1) * 2 + (fr - 14)) * 32 + bj * 16 + fq * 4 + n * 2)); }
            } else if (k > 0) {
                if (fr >= 14) {
                    const unsigned long long* hz = HZ + ((size_t)((u.pm - 1) * 22 + u.pn) * 8 + wc * 2 + (fr - 14)) * 32;
#pragma unroll
                    for (int bj = 0; bj < 2; ++bj)
#pragma unroll
                        for (int n = 0; n < 2; ++n) { unsigned long long x0, x1; unsigned sp_ = 0;
                            for (;;) { x0 = __hip_atomic_load(hz + bj * 16 + fq * 4 + n * 2, RLX_AGENT); x1 = __hip_atomic_load(hz + bj * 16 + fq * 4 + n * 2 + 1, RLX_AGENT);
                                if ((x0 >> 32) == 1ull && (x1 >> 32) == 1ull) break; __builtin_amdgcn_s_sleep(2); if (++sp_ > (1u << 20)) { __hip_atomic_store(tmo, 1u, RLX_AGENT); break; } }
                            pp[bj][n].x = (unsigned)x0; pp[bj][n].y = (unsigned)x1; } }
            }
            u32x2 outp[2];
#pragma unroll
            for (int n = 0; n < 2; ++n) {
                const u32x2 zg = zp[ai][0][m][n], zv = zp[ai][1][m][n], pg = pp[0][n], pv = pp[1][n];
                u32x2 g1, g2, v1, v2;
                g1.x = dppu<0x111>(zg.x) | dppu<0x10F>(pg.x); g1.y = dppu<0x111>(zg.y) | dppu<0x10F>(pg.y); g2.x = dppu<0x112>(zg.x) | dppu<0x10E>(pg.x); g2.y = dppu<0x112>(zg.y) | dppu<0x10E>(pg.y);
                v1.x = dppu<0x111>(zv.x) | dppu<0x10F>(pv.x); v1.y = dppu<0x111>(zv.y) | dppu<0x10F>(pv.y); v2.x = dppu<0x112>(zv.x) | dppu<0x10E>(pv.x); v2.y = dppu<0x112>(zv.y) | dppu<0x10E>(pv.y);
                const float z0g[4] = {bf_lo(zg.x), bf_hi(zg.x), bf_lo(zg.y), bf_hi(zg.y)}, z1g[4] = {bf_lo(g1.x), bf_hi(g1.x), bf_lo(g1.y), bf_hi(g1.y)}, z2g[4] = {bf_lo(g2.x), bf_hi(g2.x), bf_lo(g2.y), bf_hi(g2.y)};
                const float z0v[4] = {bf_lo(zv.x), bf_hi(zv.x), bf_lo(zv.y), bf_hi(zv.y)}, z1v[4] = {bf_lo(v1.x), bf_hi(v1.x), bf_lo(v1.y), bf_hi(v1.y)}, z2v[4] = {bf_lo(v2.x), bf_hi(v2.x), bf_lo(v2.y), bf_hi(v2.y)};
                float o[4];
#pragma unroll
                for (int e = 0; e < 4; ++e) { const float cg = bg[n][e] + wg[n][0][e] * z2g[e] + wg[n][1][e] * z1g[e] + wg[n][2][e] * z0g[e], cv = bv[n][e] + wv[n][0][e] * z2v[e] + wv[n][1][e] * z1v[e] + wv[n][2][e] * z0v[e];
                    o[e] = fgelu(cg) * cv; }
                outp[n].x = cvt_pk_bf16(o[0], o[1]); outp[n].y = cvt_pk_bf16(o[2], o[3]);
            }
            const int r = 128 * ai + 64 * wr + 16 * m + fr;
            { u32x4 w4; w4.x = outp[0].x; w4.y = outp[0].y; w4.z = outp[1].x; w4.w = outp[1].y; *(u32x4*)(ACT + ((size_t)(b * SEQ + t0 + r)) * FF + ch0) = w4; }
            __builtin_amdgcn_sched_barrier(0);
        }
    }
};
struct EpiRowStat {
    static constexpr bool PERM = true, HAS_MID = false; bf16_t* O; float* STAT; int mid_t;
    __device__ __forceinline__ void mid(f32x4 (&)[2][2][4][2], const pg8::Unit&, int, int, int, int) const {}
    __device__ __forceinline__ void operator()(const f32x4 (&acc)[2][2][4][2], const pg8::Unit& u, int wr, int wc, int fr, int fq) const {
#pragma unroll
        for (int ai = 0; ai < 2; ++ai)
#pragma unroll
            for (int m = 0; m < 4; ++m) { const int row = u.pm * 256 + ai * 128 + wr * 64 + m * 16 + fr; float s = 0.f;
#pragma unroll
                for (int bj = 0; bj < 2; ++bj) { const int col = u.pn * 256 + bj * 128 + wc * 32 + 8 * fq; const f32x4 v0 = acc[ai][bj][m][0], v1 = acc[ai][bj][m][1]; u32x4 w;
                    s += (v0[0] * v0[0] + v0[1] * v0[1]) + (v0[2] * v0[2] + v0[3] * v0[3]) + (v1[0] * v1[0] + v1[1] * v1[1]) + (v1[2] * v1[2] + v1[3] * v1[3]);
                    w.x = cvt_pk_bf16(v0[0], v0[1]); w.y = cvt_pk_bf16(v0[2], v0[3]); w.z = cvt_pk_bf16(v1[0], v1[1]); w.w = cvt_pk_bf16(v1[2], v1[3]);
                    __builtin_nontemporal_store(w, (u32x4*)(O + (size_t)row * D + col)); }
                s += __shfl_xor(s, 16); s += __shfl_xor(s, 32);
                if (fq == 0) STAT[(size_t)row * 16 + u.pn * 4 + wc] = s; }
    }
};
struct EpiSloc {
    static constexpr bool PERM = false, HAS_MID = false; float* SL; int mid_t;
    __device__ __forceinline__ void mid(f32x4 (&)[2][2][4][2], const pg8::Unit&, int, int, int, int) const {}
    __device__ __forceinline__ void operator()(const f32x4 (&acc)[2][2][4][2], const pg8::Unit& u, int wr, int wc, int fr, int fq) const {
#pragma unroll
        for (int ai = 0; ai < 2; ++ai)
#pragma unroll
            for (int m = 0; m < 4; ++m) { const int row = u.pm * 256 + ai * 128 + wr * 64 + m * 16 + fr; float* p = SL + ((size_t)u.pn * S5ROWS + row) * 128 + wc * 32 + 4 * fq;
                *(f32x4*)(p) = acc[ai][0][m][0]; *(f32x4*)(p + 16) = acc[ai][0][m][1]; }
    }
};
struct S5Order {
    const bf16_t* UG; const bf16_t* Bt; int ldb, G, c;
    __device__ bool next(int i, pg8::Unit& u) const { const int L = i * G + c; if (L >= S5G * 8) return false; const int g = L >> 3; u.pm = L & 7; u.pn = g;
        u.a = (const char*)(UG + ((size_t)g * S5ROWS + u.pm * 256) * UGLD); u.b = (const char*)(Bt + (size_t)g * 256 * ldb); return true; }
};

constexpr int LW = 72;
constexpr int SLOT = 64 * LW * 2;
#define SL(i) ((i) * SLOT)
#define BAR_LDS() do { asm volatile("s_waitcnt lgkmcnt(0)" ::: "memory"); __builtin_amdgcn_s_barrier(); asm volatile("" ::: "memory"); } while (0)
struct LdsMat { LAS const unsigned char* p; int ld; __device__ __forceinline__ bf16x8 frag(int row, int k) const { return *(LAS const bf16x8*)(p + ((size_t)row * ld + k) * 2); } };
struct GlbMat { const bf16_t* p; int ld; __device__ __forceinline__ bf16x8 frag(int row, int k) const { return *(const bf16x8*)(p + (size_t)row * ld + k); } };
template <int KD, class YM, class XM, class EPI>
__device__ __forceinline__ void mm64(const YM& Y, const XM& X, int wid, int lane, const EPI& epi) {
    asm volatile("" : "+v"(lane), "+s"(wid));
    const int at = wid >> 1, bt0 = (wid & 1) * 2, fr = lane & 15, fq = lane >> 4;
    f32x4 acc[2] = {(f32x4){0.f, 0.f, 0.f, 0.f}, (f32x4){0.f, 0.f, 0.f, 0.f}};
#pragma unroll
    for (int s = 0; s < KD / 32; ++s) {
        const bf16x8 yf = Y.frag(16 * at + fr, 32 * s + 8 * fq);
#pragma unroll
        for (int bi = 0; bi < 2; ++bi) { const bf16x8 xf = X.frag(16 * (bt0 + bi) + fr, 32 * s + 8 * fq);
            acc[bi] = __builtin_amdgcn_mfma_f32_16x16x32_bf16(xf, yf, acc[bi], 0, 0, 0); }
    }
#pragma unroll
    for (int bi = 0; bi < 2; ++bi) epi(16 * at + fr, 16 * (bt0 + bi) + 4 * fq, acc[bi]);
}
__device__ __forceinline__ void ld_yf(const LdsMat& Y, int at, int fr, int fq, bf16x8 (&y)[2]) {
#pragma unroll
    for (int s = 0; s < 2; ++s) y[s] = Y.frag(16 * at + fr, 32 * s + 8 * fq);
}
__device__ __forceinline__ void ld_xf(const LdsMat& X, int bt0, int fr, int fq, bf16x8 (&x)[2][2]) {
#pragma unroll
    for (int s = 0; s < 2; ++s)
#pragma unroll
        for (int bi = 0; bi < 2; ++bi) x[s][bi] = X.frag(16 * (bt0 + bi) + fr, 32 * s + 8 * fq);
}
__device__ __forceinline__ void mm_f(const bf16x8 (&y)[2], const bf16x8 (&x)[2][2], f32x4 (&acc)[2]) {
#pragma unroll
    for (int bi = 0; bi < 2; ++bi) acc[bi] = (f32x4){0.f, 0.f, 0.f, 0.f};
#pragma unroll
    for (int s = 0; s < 2; ++s)
#pragma unroll
        for (int bi = 0; bi < 2; ++bi) acc[bi] = __builtin_amdgcn_mfma_f32_16x16x32_bf16(x[s][bi], y[s], acc[bi], 0, 0, 0);
}
template <int KD>
__device__ __forceinline__ void preload_x(const GlbMat& X, int wid, int lane, bf16x8 (&xf)[KD / 32][2]) {
    const int bt0 = (wid & 1) * 2, fr = lane & 15, fq = lane >> 4;
#pragma unroll
    for (int s = 0; s < KD / 32; ++s)
#pragma unroll
        for (int bi = 0; bi < 2; ++bi) xf[s][bi] = X.frag(16 * (bt0 + bi) + fr, 32 * s + 8 * fq);
}
template <int KD, class YM, class EPI>
__device__ __forceinline__ void mm64_pre(const YM& Y, const bf16x8 (&xf)[KD / 32][2], int wid, int lane, const EPI& epi) {
    const int at = wid >> 1, bt0 = (wid & 1) * 2, fr = lane & 15, fq = lane >> 4;
    f32x4 acc[2] = {(f32x4){0.f, 0.f, 0.f, 0.f}, (f32x4){0.f, 0.f, 0.f, 0.f}};
#pragma unroll
    for (int s = 0; s < KD / 32; ++s) {
        const bf16x8 yf = Y.frag(16 * at + fr, 32 * s + 8 * fq);
#pragma unroll
        for (int bi = 0; bi < 2; ++bi) acc[bi] = __builtin_amdgcn_mfma_f32_16x16x32_bf16(xf[s][bi], yf, acc[bi], 0, 0, 0);
    }
#pragma unroll
    for (int bi = 0; bi < 2; ++bi) epi(16 * at + fr, 16 * (bt0 + bi) + 4 * fq, acc[bi]);
}
__device__ __forceinline__ void st_lds4(LAS unsigned char* base, int a, int b0, f32x4 v) { u32x2 w; w.x = cvt_pk_bf16(v[0], v[1]); w.y = cvt_pk_bf16(v[2], v[3]); *(LAS u32x2*)(base + ((size_t)a * LW + b0) * 2) = w; }
__device__ __forceinline__ f32x4 ld_lds4(LAS const unsigned char* base, int a, int b0) { const u32x2 w = *(LAS const u32x2*)(base + ((size_t)a * LW + b0) * 2); return (f32x4){bf_lo(w.x), bf_hi(w.x), bf_lo(w.y), bf_hi(w.y)}; }
__device__ __forceinline__ void st_glb4p(bf16_t* base, int a, int b0, f32x4 v) { u32x2 w; w.x = cvt_pk_bf16(v[0], v[1]); w.y = cvt_pk_bf16(v[2], v[3]); __builtin_nontemporal_store(w, (u32x2*)(base + (size_t)a * GLD + b0)); }
__device__ __forceinline__ void st_glb4(bf16_t* base, int a, int b0, f32x4 v) { u32x2 w; w.x = cvt_pk_bf16(v[0], v[1]); w.y = cvt_pk_bf16(v[2], v[3]); __builtin_nontemporal_store(w, (u32x2*)(base + (size_t)a * 64 + b0)); }

struct PrePf { u32x4 qa[3], qp[3], ra[4], rp[4], wt[4]; };
__device__ __forceinline__ void rwkv_pre_fetch(Frame& F, int unit, bool lr_first, PrePf& P, int tid) {
    const int bh = unit >> 6, c = unit & 63, b = bh >> 3, h = bh & 7;
    const int t = tid >> 3, jb = tid & 7, j0 = jb * 8;
    const int tg = b * SEQ + c * 64 + t;
    const bool hasprev = (c * 64 + t) > 0;
    const bf16_t* prow = (const bf16_t*)(F.ws + WS_PR) + (size_t)tg * NRW; const bf16_t* pprv = hasprev ? prow - NRW : prow;
#pragma unroll
    for (int seg = 0; seg < 3; ++seg) { const int col = seg * 512 + h * 64 + j0; P.qa[seg] = *(const u32x4*)(prow + col); P.qp[seg] = *(const u32x4*)(pprv + col); }
    const u32x4* scr = (const u32x4*)(F.ws + WS_LRSCR) + ((size_t)F.vcu * 512 + tid) * 4;
    const u32x4* pa = lr_first ? (const u32x4*)(prow + 1536 + jb * 32) : scr; const u32x4* pp = lr_first ? (const u32x4*)(pprv + 1536 + jb * 32) : scr;
#pragma unroll
    for (int q4 = 0; q4 < 4; ++q4) { P.ra[q4] = pa[q4]; P.rp[q4] = pp[q4]; }
    P.wt[0] = ((const u32x4*)(F.ws + WS_W2T) + (size_t)h * 512)[tid]; P.wt[1] = ((const u32x4*)(F.ws + WS_A2T) + (size_t)h * 512)[tid];
    P.wt[2] = ((const u32x4*)(F.ws + WS_G2T) + (size_t)h * 1024)[tid]; P.wt[3] = ((const u32x4*)(F.ws + WS_G2T) + (size_t)h * 1024)[512 + tid];
}
__device__ __forceinline__ void rwkv_pre_put_w(LAS unsigned char* L, const PrePf& P, int tid) {
    const int r8 = tid >> 3, c8 = tid & 7, r16 = tid >> 4, c16 = tid & 15;
    *(LAS u32x4*)(L + SL(10) + ((size_t)r8 * LW + c8 * 8) * 2) = P.wt[0]; *(LAS u32x4*)(L + SL(11) + ((size_t)r8 * LW + c8 * 8) * 2) = P.wt[1];
    *(LAS u32x4*)(L + SL(12) + ((size_t)r16 * 136 + c16 * 8) * 2) = P.wt[2]; *(LAS u32x4*)(L + SL(12) + ((size_t)(32 + r16) * 136 + c16 * 8) * 2) = P.wt[3];
}
__device__ __forceinline__ void rwkv_pre_unit(Frame& F, int unit, int next_unit, bool lr_first, bool next_first, PrePf& P) {
    LAS unsigned char* L = F.lds;
    LAS float* XT = (LAS float*)(F.lds + XTRA_OFF);
    int tid = F.tid; asm volatile("" : "+v"(tid));
    int wid = F.wave; asm volatile("" : "+s"(wid));
    const int lane = tid & 63;
    const int bh = unit >> 6, c = unit & 63, b = bh >> 3, h = bh & 7;
    const int t = tid >> 3, jb = tid & 7, j0 = jb * 8;
    const int tg = b * SEQ + c * 64 + t;
    const bool hasprev = (c * 64 + t) > 0;
    const bf16_t* PR = (const bf16_t*)(F.ws + WS_PR);
    const bf16_t* prow = PR + (size_t)tg * NRW; const bf16_t* pprev = prow - NRW;
    LAS const float* mu = (LAS const float*)(F.lds + XTRA_OFF + 4096);
    LAS const float* par = mu + NRW;
    float rs[8], ks[8], vs[8];
    {
        const int c0 = 1536 + jb * 32;
        const float pmask = hasprev ? 1.f : 0.f;
        f32x4 mq[3][2];
#pragma unroll
        for (int seg = 0; seg < 3; ++seg) { const int col = seg * 512 + h * 64 + j0; mq[seg][0] = *(LAS const f32x4*)(mu + col); mq[seg][1] = *(LAS const f32x4*)(mu + col + 4); }
        LAS unsigned char* dst = (jb < 2) ? (L + SL(0) + ((size_t)t * LW + jb * 32) * 2) : (jb < 4) ? (L + SL(1) + ((size_t)t * LW + (jb - 2) * 32) * 2) : (L + SL(2) + ((size_t)t * 136 + (jb - 4) * 32) * 2);
        u32x4* scr = (u32x4*)(F.ws + WS_LRSCR) + ((size_t)F.vcu * 512 + tid) * 4;
        if (lr_first) {
            f32x4 ma[4][2];
#pragma unroll
            for (int q4 = 0; q4 < 4; ++q4) { ma[q4][0] = *(LAS const f32x4*)(mu + c0 + q4 * 8); ma[q4][1] = *(LAS const f32x4*)(mu + c0 + q4 * 8 + 4); }
#pragma unroll
            for (int q4 = 0; q4 < 4; ++q4) { float x[8], xp[8], o[8]; unpack8(P.ra[q4], x); unpack8(P.rp[q4], xp);
#pragma unroll
                for (int e = 0; e < 8; ++e) { const float mm = e < 4 ? ma[q4][0][e] : ma[q4][1][e - 4]; const float s = x[e] + (xp[e] * pmask - x[e]) * mm;
                    const float ex = __builtin_amdgcn_exp2f((jb < 2 ? 2.88539008178f : -1.44269504089f) * s), rc = __builtin_amdgcn_rcpf(1.0f + ex);
                    o[e] = jb < 2 ? 1.0f - 2.0f * rc : (jb < 4 ? s : rc); }
                const u32x4 w = pack8(o); *(LAS u32x4*)(dst + q4 * 16) = w; scr[q4] = w; }
        } else {
#pragma unroll
            for (int q4 = 0; q4 < 4; ++q4) *(LAS u32x4*)(dst + q4 * 16) = P.ra[q4];
        }
#pragma unroll
        for (int seg = 0; seg < 3; ++seg) { float x[8], xp[8]; unpack8(P.qa[seg], x); unpack8(P.qp[seg], xp);
#pragma unroll
            for (int e = 0; e < 8; ++e) { const float mm = e < 4 ? mq[seg][0][e] : mq[seg][1][e - 4]; const float s = x[e] + (xp[e] * pmask - x[e]) * mm; if (seg == 0) rs[e] = s; else if (seg == 1) ks[e] = s; else vs[e] = s; } }
    }
    BAR_LDS();
    {
        const LdsMat Yw{L + SL(0), LW}, Ya{L + SL(1), LW}, Yg{L + SL(2), 136};
        const LdsMat Xw{L + SL(10), LW}, Xa{L + SL(11), LW}, Xg{L + SL(12), 136};
        mm64<64>(Yw, Xw, wid, lane, [&](int a, int b0, f32x4 v) { *(LAS f32x4*)(L + SL(4) + ((size_t)a * 68 + b0) * 4) = v; });
        mm64<64>(Ya, Xa, wid, lane, [&](int a, int b0, f32x4 v) { *(LAS f32x4*)(L + SL(6) + ((size_t)a * 68 + b0) * 4) = v; });
        mm64<128>(Yg, Xg, wid, lane, [&](int a, int b0, f32x4 v) { *(LAS f32x4*)(L + SL(8) + ((size_t)a * 68 + b0) * 4) = v; });
    }
    BAR_LDS();
    float ld[8], kp[8], av[8], bv[8];
    {
        const int hc = h * 64 + j0;
        float wp[8], ap[8], gg[8], w0[8], a0[8], kkw[8], kaw[8], rk[8];
        *(f32x4*)&wp[0] = *(LAS f32x4*)(L + SL(4) + ((size_t)t * 68 + j0) * 4); *(f32x4*)&wp[4] = *(LAS f32x4*)(L + SL(4) + ((size_t)t * 68 + j0 + 4) * 4);
        *(f32x4*)&ap[0] = *(LAS f32x4*)(L + SL(6) + ((size_t)t * 68 + j0) * 4); *(f32x4*)&ap[4] = *(LAS f32x4*)(L + SL(6) + ((size_t)t * 68 + j0 + 4) * 4);
        *(f32x4*)&gg[0] = *(LAS f32x4*)(L + SL(8) + ((size_t)t * 68 + j0) * 4); *(f32x4*)&gg[4] = *(LAS f32x4*)(L + SL(8) + ((size_t)t * 68 + j0 + 4) * 4);
        *(f32x4*)&w0[0] = *(LAS const f32x4*)(par + 0 + hc); *(f32x4*)&w0[4] = *(LAS const f32x4*)(par + 0 + hc + 4);
        *(f32x4*)&a0[0] = *(LAS const f32x4*)(par + 512 + hc); *(f32x4*)&a0[4] = *(LAS const f32x4*)(par + 512 + hc + 4);
        *(f32x4*)&kkw[0] = *(LAS const f32x4*)(par + 1024 + hc); *(f32x4*)&kkw[4] = *(LAS const f32x4*)(par + 1024 + hc + 4);
        *(f32x4*)&kaw[0] = *(LAS const f32x4*)(par + 1536 + hc); *(f32x4*)&kaw[4] = *(LAS const f32x4*)(par + 1536 + hc + 4);
        *(f32x4*)&rk[0] = *(LAS const f32x4*)(par + 2048 + hc); *(f32x4*)&rk[4] = *(LAS const f32x4*)(par + 2048 + hc + 4);
        float ss = 0.f, bon = 0.f, kkv[8], eta[8];
#pragma unroll
        for (int e = 0; e < 8; ++e) {
            ld[e] = -0.60653065971f * fsigmoid(w0[e] + wp[e]);
            eta[e] = fsigmoid(a0[e] + ap[e]);
            kkv[e] = ks[e] * kkw[e]; ss += kkv[e] * kkv[e];
            kp[e] = ks[e] * (1.0f + (eta[e] - 1.0f) * kaw[e]);
            bon += rs[e] * kp[e] * rk[e];
        }
        ss += __shfl_xor(ss, 1); ss += __shfl_xor(ss, 2); ss += __shfl_xor(ss, 4);
        bon += __shfl_xor(bon, 1); bon += __shfl_xor(bon, 2); bon += __shfl_xor(bon, 4);
        const float inv = __builtin_amdgcn_rcpf(fmaxf(__builtin_amdgcn_sqrtf(ss), 1e-12f));
#pragma unroll
        for (int e = 0; e < 8; ++e) { const float kk = kkv[e] * inv; av[e] = -kk; bv[e] = kk * eta[e]; }
        if (jb == 0) ((float*)(F.ws + WS_BONUS))[(size_t)tg * 8 + h] = bon;
        *(u32x4*)((bf16_t*)(F.ws + WS_GBUF) + (size_t)tg * RW + hc) = pack8(gg);
    }
    float Lc[8];
#pragma unroll
    for (int e = 0; e < 8; ++e) { float x = ld[e];
        float y = __shfl_up(x, 8); if (lane >= 8) x += y;
        y = __shfl_up(x, 16); if (lane >= 16) x += y;
        y = __shfl_up(x, 32); if (lane >= 32) x += y;
        Lc[e] = x; }
    if (lane >= 56) {
#pragma unroll
        for (int e = 0; e < 8; ++e) XT[wid * 64 + j0 + e] = Lc[e]; }
    BAR_LDS();
    float LC[8], gC[8];
    {
        float pre[8], tot[8];
#pragma unroll
        for (int e = 0; e < 8; ++e) { pre[e] = 0.f; tot[e] = 0.f; }
#pragma unroll
        for (int w = 0; w < 8; ++w) { const f32x4 x0 = *(LAS const f32x4*)(XT + w * 64 + j0), x1 = *(LAS const f32x4*)(XT + w * 64 + j0 + 4); const float sel = (w < wid) ? 1.f : 0.f;
#pragma unroll
            for (int e = 0; e < 4; ++e) { tot[e] += x0[e]; tot[4 + e] += x1[e]; pre[e] += sel * x0[e]; pre[4 + e] += sel * x1[e]; } }
#pragma unroll
        for (int e = 0; e < 8; ++e) { Lc[e] += pre[e]; LC[e] = tot[e]; gC[e] = fexp(LC[e]); }
    }
    if (t == 63) {
#pragma unroll
        for (int e = 0; e < 8; ++e) XT[512 + j0 + e] = gC[e]; }
    {
        float o0[8], o1[8], o2[8], o3[8], o4[8], o5[8];
#pragma unroll
        for (int e = 0; e < 8; ++e) { const float ein = fexp(Lc[e]), eout = __builtin_amdgcn_rcpf(ein), eex = fexp(Lc[e] - ld[e]), eg = gC[e] * eout;
            o0[e] = rs[e] * ein; o1[e] = kp[e] * eout; o2[e] = av[e] * eex; o3[e] = bv[e] * eout; o4[e] = bv[e] * eg; o5[e] = kp[e] * eg; }
        const size_t off = ((size_t)t * LW + j0) * 2;
        *(LAS u32x4*)(L + SL(10) + off) = pack8(o0); *(LAS u32x4*)(L + SL(11) + off) = pack8(o1); *(LAS u32x4*)(L + SL(12) + off) = pack8(o2); *(LAS u32x4*)(L + SL(13) + off) = pack8(o3);
        *(LAS u32x4*)(L + SL(0) + off) = pack8(o4); *(LAS u32x4*)(L + SL(1) + off) = pack8(o5); *(LAS u32x4*)(L + SL(2) + off) = pack8(vs);
    }
    BAR_LDS();
    {
        const int srcs[4] = {12, 0, 1, 2}, dsts[4] = {4, 5, 6, 7};
#pragma unroll
        for (int q = 0; q < 4; ++q) { unsigned short hv[8];
#pragma unroll
            for (int e = 0; e < 8; ++e) hv[e] = *(LAS const unsigned short*)(L + SL(srcs[q]) + ((size_t)(8 * wid + e) * LW + lane) * 2);
            u32x4 w; w.x = hv[0] | ((unsigned)hv[1] << 16); w.y = hv[2] | ((unsigned)hv[3] << 16); w.z = hv[4] | ((unsigned)hv[5] << 16); w.w = hv[6] | ((unsigned)hv[7] << 16);
            *(LAS u32x4*)(L + SL(dsts[q]) + ((size_t)lane * LW + 8 * wid) * 2) = w;
        }
    }
    BAR_LDS();
    if (next_unit < NUNIT) rwkv_pre_fetch(F, next_unit, next_first, P, tid);
    const int crow = tid >> 3, cch = tid & 7;
    __builtin_nontemporal_store(*(LAS const u32x4*)(L + SL(7) + ((size_t)crow * LW + cch * 8) * 2), (u32x4*)((bf16_t*)(F.ws + WS_VT) + (size_t)unit * 4096 + crow * 64 + cch * 8));
    {
        const LdsMat Rt{L + SL(10), LW}, Kt{L + SL(11), LW}, At{L + SL(12), LW}, Bt{L + SL(13), LW};
        f32x4 nd = (f32x4){0.f, 0.f, 0.f, 0.f}, ntd = nd;
        {
            int ln = lane, wd = wid; asm volatile("" : "+v"(ln), "+s"(wd));
            const int at = wd >> 1, bt0 = (wd & 1) * 2, fr = ln & 15, fq = ln >> 4, a = 16 * at + fr;
            bf16x8 yA[2], yK[2], yR[2], xB[2][2], xA[2][2], xK[2][2];
            ld_yf(At, at, fr, fq, yA); ld_xf(Bt, bt0, fr, fq, xB); ld_yf(Kt, at, fr, fq, yK); ld_xf(At, bt0, fr, fq, xA); ld_yf(Rt, at, fr, fq, yR); ld_xf(Kt, bt0, fr, fq, xK);
            const bool diag = bt0 == (at & 2);
            bf16x8 xd[2];
            if (diag) ld_yf(Bt, at, fr, fq, xd);
            f32x4 c0[2], c1[2], c2[2], c3[2];
            mm_f(yA, xB, c0); mm_f(yK, xA, c1); mm_f(yR, xB, c2); mm_f(yR, xK, c3);
            if (diag) {
                f32x4 v = (f32x4){0.f, 0.f, 0.f, 0.f};
#pragma unroll
                for (int s = 0; s < 2; ++s) v = __builtin_amdgcn_mfma_f32_16x16x32_bf16(yA[s], xd[s], v, 0, 0, 0);
#pragma unroll
                for (int e = 0; e < 4; ++e) v[e] = (fr < 4 * fq + e) ? v[e] : 0.f;
                nd = v; }
#pragma unroll
            for (int bi = 0; bi < 2; ++bi) { const int b0 = 16 * (bt0 + bi) + 4 * fq; f32x4 v0 = c0[bi], v1 = c1[bi], v2 = c2[bi], v3 = c3[bi];
#pragma unroll
                for (int e = 0; e < 4; ++e) { v0[e] = (b0 + e < a) ? v0[e] : 0.f; v1[e] = (a < b0 + e) ? v1[e] : 0.f; v2[e] = (b0 + e <= a) ? v2[e] : 0.f; v3[e] = (b0 + e <= a) ? v3[e] : 0.f; }
                st_lds4(L + SL(1), a, b0, v0); st_lds4(L + SL(2), a, b0, v1); st_lds4(L + SL(3), a, b0, v2); st_lds4(L + SL(8), a, b0, v3);
                if (bt0 + bi == at) ntd = v0; }
        }
        const int at = wid >> 1;
        if (((wid & 1) * 2 == (at & 2))) {
            const int fr = lane & 15, fq = lane >> 4;
            auto op = [](f32x4 v) { u32x4 w; w.x = cvt_pk_bf16(v[0], v[1]); w.y = cvt_pk_bf16(v[2], v[3]); w.z = 0u; w.w = 0u; return __builtin_bit_cast(bf16x8, w); };
            const f32x4 zero = (f32x4){0.f, 0.f, 0.f, 0.f};
            const f32x4 Lm = ntd, LT = nd;
            f32x4 Q = Lm;
#pragma unroll
            for (int e = 0; e < 4; ++e) Q[e] += (4 * fq + e == fr) ? 1.f : 0.f;
            const f32x4 L2 = __builtin_amdgcn_mfma_f32_16x16x32_bf16(op(LT), op(Lm), zero, 0, 0, 0), L2T = __builtin_amdgcn_mfma_f32_16x16x32_bf16(op(Lm), op(LT), zero, 0, 0, 0);
            Q = __builtin_amdgcn_mfma_f32_16x16x32_bf16(op(L2T), op(Q), Q, 0, 0, 0);
            const f32x4 L4 = __builtin_amdgcn_mfma_f32_16x16x32_bf16(op(L2T), op(L2), zero, 0, 0, 0), L4T = __builtin_amdgcn_mfma_f32_16x16x32_bf16(op(L2), op(L2T), zero, 0, 0, 0);
            Q = __builtin_amdgcn_mfma_f32_16x16x32_bf16(op(L4T), op(Q), Q, 0, 0, 0);
            const f32x4 L8T = __builtin_amdgcn_mfma_f32_16x16x32_bf16(op(L4), op(L4T), zero, 0, 0, 0);
            Q = __builtin_amdgcn_mfma_f32_16x16x32_bf16(op(L8T), op(Q), Q, 0, 0, 0);
            st_lds4(L + SL(9), 16 * at + fr, 4 * fq, Q);
        }
    }
    BAR_LDS();
    {
        const int fr = lane & 15, fq = lane >> 4;
        LAS const unsigned char* zsl = L + (wid < 4 ? SL(4) : SL(2)); LAS unsigned char* dsl = L + (wid < 4 ? SL(11) : SL(12));
        const int arow = 16 * (wid & 3) + fr;
        u32x2 zp[4];
#pragma unroll
        for (int c = 0; c < 4; ++c) {
            f32x4 acc = ld_lds4(zsl, arow, 16 * c + 4 * fq);
            if (c >= 1) {
                const u32x2 alo = *(LAS const u32x2*)(L + SL(1) + ((size_t)(16 * c + fr) * LW + 4 * fq) * 2), ahi = *(LAS const u32x2*)(L + SL(1) + ((size_t)(16 * c + fr) * LW + 16 + 4 * fq) * 2);
                u32x4 aw; aw.x = alo.x; aw.y = alo.y; aw.z = ahi.x; aw.w = ahi.y;
                u32x4 bw; bw.x = zp[0].x; bw.y = zp[0].y; bw.z = c >= 2 ? zp[1].x : 0u; bw.w = c >= 2 ? zp[1].y : 0u;
                acc = __builtin_amdgcn_mfma_f32_16x16x32_bf16(__builtin_bit_cast(bf16x8, aw), __builtin_bit_cast(bf16x8, bw), acc, 0, 0, 0); }
            if (c == 3) {
                const u32x2 alo = *(LAS const u32x2*)(L + SL(1) + ((size_t)(48 + fr) * LW + 32 + 4 * fq) * 2);
                u32x4 aw; aw.x = alo.x; aw.y = alo.y; aw.z = 0u; aw.w = 0u;
                u32x4 bw; bw.x = zp[2].x; bw.y = zp[2].y; bw.z = 0u; bw.w = 0u;
                acc = __builtin_amdgcn_mfma_f32_16x16x32_bf16(__builtin_bit_cast(bf16x8, aw), __builtin_bit_cast(bf16x8, bw), acc, 0, 0, 0); }
            const u32x2 dlo = *(LAS const u32x2*)(L + SL(9) + ((size_t)(16 * c + fr) * LW + 4 * fq) * 2);
            u32x4 aw; aw.x = dlo.x; aw.y = dlo.y; aw.z = 0u; aw.w = 0u;
            u32x4 bw; bw.x = cvt_pk_bf16(acc[0], acc[1]); bw.y = cvt_pk_bf16(acc[2], acc[3]); bw.z = 0u; bw.w = 0u;
            const f32x4 r = __builtin_amdgcn_mfma_f32_16x16x32_bf16(__builtin_bit_cast(bf16x8, aw), __builtin_bit_cast(bf16x8, bw), (f32x4){0.f, 0.f, 0.f, 0.f}, 0, 0, 0);
            zp[c].x = cvt_pk_bf16(r[0], r[1]); zp[c].y = cvt_pk_bf16(r[2], r[3]);
            *(LAS u32x2*)(dsl + ((size_t)arow * LW + 16 * c + 4 * fq) * 2) = zp[c];
        }
    }
    BAR_LDS();
    {
        const int sAT = 11, sAkT = 12, sHk = 0;
        const LdsMat AT{L + SL(sAT), LW}, AkT{L + SL(sAkT), LW}, AbrT{L + SL(3), LW}, BgT{L + SL(5), LW}, VTm{L + SL(7), LW};
        bf16_t* QRT = (bf16_t*)(F.ws + WS_QRT) + (size_t)unit * 4096; bf16_t* WYT = (bf16_t*)(F.ws + WS_WYT) + (size_t)unit * 4096;
        bf16_t* GTg = (bf16_t*)(F.dout + DO_GT) + (size_t)unit * (64 * GLD); bf16_t* Hg = (bf16_t*)(F.dout + DO_H) + (size_t)unit * (64 * GLD);
        {
            int ln = lane, wd = wid; asm volatile("" : "+v"(ln), "+s"(wd));
            const int at = wd >> 1, bt0 = (wd & 1) * 2, fr = ln & 15, fq = ln >> 4, a = 16 * at + fr;
            bf16x8 yA[2], yB[2], xT[2][2], xK[2][2];
            ld_yf(BgT, at, fr, fq, yB); ld_xf(AkT, bt0, fr, fq, xK); ld_yf(AbrT, at, fr, fq, yA); ld_xf(AT, bt0, fr, fq, xT);
            f32x4 eH[2], eR[2], eW[2];
#pragma unroll
            for (int bi = 0; bi < 2; ++bi) { const int b0 = 16 * (bt0 + bi) + 4 * fq; eH[bi] = ld_lds4(L + SL(6), a, b0); eR[bi] = ld_lds4(L + SL(10), a, b0); eW[bi] = ld_lds4(L + SL(8), a, b0); }
            const float gdiag = XT[512 + a];
            f32x4 cH[2], cQ[2], cW[2], cG[2];
            mm_f(yB, xK, cH); mm_f(yA, xT, cQ); mm_f(yA, xK, cW); mm_f(yB, xT, cG);
#pragma unroll
            for (int bi = 0; bi < 2; ++bi) { const int b0 = 16 * (bt0 + bi) + 4 * fq;
                st_lds4(L + SL(sHk), a, b0, cH[bi] + eH[bi]);
                st_lds4(L + SL(1), a, b0, cQ[bi] + eR[bi]);
                st_lds4(L + SL(2), a, b0, cW[bi] + eW[bi]);
                f32x4 v = cG[bi];
#pragma unroll
                for (int e = 0; e < 4; ++e) v[e] += (b0 + e == a) ? gdiag : 0.f;
                st_lds4(L + SL(4), a, b0, v); }
        }
        BAR_LDS();
        const LdsMat HkT{L + SL(sHk), LW};
        mm64<64>(VTm, HkT, wid, lane, [&](int a, int b0, f32x4 v) { st_lds4(L + SL(9), a, b0, v); });
        __builtin_nontemporal_store(*(LAS const u32x4*)(L + SL(1) + ((size_t)crow * LW + cch * 8) * 2), (u32x4*)(QRT + crow * 64 + cch * 8));
        __builtin_nontemporal_store(*(LAS const u32x4*)(L + SL(2) + ((size_t)crow * LW + cch * 8) * 2), (u32x4*)(WYT + crow * 64 + cch * 8));
        __builtin_nontemporal_store(*(LAS const u32x4*)(L + SL(4) + (size_t)tid * 16), (u32x4*)GTg + tid);
        if (tid < 64) __builtin_nontemporal_store(*(LAS const u32x4*)(L + SL(4) + (size_t)(512 + tid) * 16), (u32x4*)GTg + 512 + tid);
        if (next_unit < NUNIT) rwkv_pre_put_w(L, P, tid);
        BAR_LDS();
        __builtin_nontemporal_store(*(LAS const u32x4*)(L + SL(9) + (size_t)tid * 16), (u32x4*)Hg + tid);
        if (tid < 64) __builtin_nontemporal_store(*(LAS const u32x4*)(L + SL(9) + (size_t)(512 + tid) * 16), (u32x4*)Hg + 512 + tid);
    }
}

constexpr int RS_SLOT = 12 * 1024;
constexpr int RS_DEPTH = 8, RS_AHEAD = 6;
__device__ __forceinline__ void rwkv_scan_block(Frame& F, int item) {
    const int bh = item >> 2, qi = item & 3, lane = F.lane, fr = lane & 15, fq = lane >> 4, wid = F.wave;
    const char* GTg = (const char*)(F.dout + DO_GT) + (size_t)bh * 64 * (64 * GLD * 2);
    const char* Hg = (const char*)(F.dout + DO_H) + (size_t)bh * 64 * (64 * GLD * 2) + (size_t)qi * (16 * GLD * 2);
    bf16_t* SST = (bf16_t*)(F.dout + DO_SST) + (size_t)bh * 64 * 4096;
    LAS unsigned char* L = F.lds;
    auto issue = [&](int c) {
        if (wid >= 1) {
            LAS unsigned char* slot = L + (c & (RS_DEPTH - 1)) * RS_SLOT;
#pragma unroll
            for (int k = 0; k < 2; ++k) { const int pc = (wid - 1) + 7 * k;
                if (pc < 12) {
                    const char* src;
                    if (pc < 9) src = GTg + (size_t)c * (64 * GLD * 2) + pc * 1024 + lane * 16;
                    else { int off = (pc - 9) * 1024 + lane * 16; off = off > 2304 - 16 ? 2304 - 16 : off; src = Hg + (size_t)c * (64 * GLD * 2) + off; }
                    __builtin_amdgcn_global_load_lds((const unsigned*)src, (LAS unsigned*)(slot + pc * 1024), 16, 0, 0); } }
        }
    };
    f32x4 acc[4];
#pragma unroll
    for (int mt = 0; mt < 4; ++mt) acc[mt] = (f32x4){0.f, 0.f, 0.f, 0.f};
#pragma unroll 1
    for (int c = 0; c < RS_AHEAD; ++c) issue(c);
#pragma unroll 1
    for (int c = 0; c < NCH; ++c) {
        if (c + RS_AHEAD < NCH) issue(c + RS_AHEAD);
        if (c + RS_AHEAD < NCH) { if (wid >= 1 && wid <= 5) asm volatile("s_waitcnt vmcnt(12)" ::: "memory"); else if (wid >= 6) asm volatile("s_waitcnt vmcnt(6)" ::: "memory"); }
        else if (wid >= 1) asm volatile("s_waitcnt vmcnt(0)" ::: "memory");
        __builtin_amdgcn_s_barrier(); asm volatile("" ::: "memory");
        if (wid == 0) {
            LAS const unsigned char* slot = L + (c & (RS_DEPTH - 1)) * RS_SLOT;
            u32x2 ga[4][2][2], hv[4];
#pragma unroll
            for (int mt = 0; mt < 4; ++mt) {
#pragma unroll
                for (int s = 0; s < 2; ++s)
#pragma unroll
                    for (int hh = 0; hh < 2; ++hh) ga[mt][s][hh] = *(LAS const u32x2*)(slot + ((16 * mt + fr) * GLD + 16 * (2 * s + hh) + 4 * fq) * 2);
                hv[mt] = *(LAS const u32x2*)(slot + 9216 + (fr * GLD + 16 * mt + 4 * fq) * 2); }
            bf16_t* Sc = SST + (size_t)c * 4096; u32x2 sp[4];
#pragma unroll
            for (int mt = 0; mt < 4; ++mt) { sp[mt].x = cvt_pk_bf16(acc[mt][0], acc[mt][1]); sp[mt].y = cvt_pk_bf16(acc[mt][2], acc[mt][3]);
                *(u32x2*)(Sc + (size_t)(16 * qi + fr) * 64 + 16 * mt + 4 * fq) = sp[mt]; }
            bf16x8 sb[2];
#pragma unroll
            for (int s = 0; s < 2; ++s) { u32x4 w; w.x = sp[2 * s].x; w.y = sp[2 * s].y; w.z = sp[2 * s + 1].x; w.w = sp[2 * s + 1].y; sb[s] = __builtin_bit_cast(bf16x8, w); }
#pragma unroll
            for (int mt = 0; mt < 4; ++mt) { f32x4 a = (f32x4){bf_lo(hv[mt].x), bf_hi(hv[mt].x), bf_lo(hv[mt].y), bf_hi(hv[mt].y)};
#pragma unroll
                for (int s = 0; s < 2; ++s) { u32x4 w; w.x = ga[mt][s][0].x; w.y = ga[mt][s][0].y; w.z = ga[mt][s][1].x; w.w = ga[mt][s][1].y;
                    a = __builtin_amdgcn_mfma_f32_16x16x32_bf16(__builtin_bit_cast(bf16x8, w), sb[s], a, 0, 0, 0); }
                acc[mt] = a; }
            asm volatile("s_waitcnt lgkmcnt(0)" ::: "memory");
        }
    }
    asm volatile("s_waitcnt vmcnt(0)" ::: "memory");
    __builtin_amdgcn_s_barrier(); asm volatile("" ::: "memory");
}
__device__ __forceinline__ void s5_scan_block(Frame& F, int gb) {
    const int g = gb >> 3, b = gb & 7, p = F.lane, w = F.wave;
    const float* aL = (const float*)(F.ws + WS_AL) + g * 128; const float ar = aL[2 * p], ai = aL[2 * p + 1];
    const float* SLc = (const float*)(F.ws + WS_SLOC) + ((size_t)g * S5ROWS + b * 256 + 32 * w) * 128 + 2 * p;
    bf16_t* UG = (bf16_t*)(F.ws + WS_UG) + ((size_t)g * S5ROWS + b * 256 + 32 * w) * UGLD + 256 + 2 * p;
    LAS float* E = (LAS float*)(F.lds);
    f32x2 l[32];
#pragma unroll
    for (int k = 0; k < 32; ++k) l[k] = *(const f32x2*)(SLc + (size_t)k * 128);
    float sr = 0.f, si = 0.f;
#pragma unroll
    for (int k = 0; k < 32; ++k) { const float nr = ar * sr - ai * si + l[k].x, ni = ar * si + ai * sr + l[k].y; l[k].x = sr; l[k].y = si; sr = nr; si = ni; }
    E[(w * 64 + p) * 2] = sr; E[(w * 64 + p) * 2 + 1] = si;
    float pr = ar, pi = ai;
#pragma unroll
    for (int q = 0; q < 5; ++q) { const float nr = pr * pr - pi * pi, ni = 2.f * pr * pi; pr = nr; pi = ni; }
    asm volatile("s_waitcnt lgkmcnt(0)" ::: "memory"); __builtin_amdgcn_s_barrier(); asm volatile("" ::: "memory");
    float cr = 0.f, ci = 0.f;
#pragma unroll
    for (int w2 = 0; w2 < 7; ++w2) { if (w2 < w) { const float er = E[(w2 * 64 + p) * 2], ei = E[(w2 * 64 + p) * 2 + 1]; const float nr = pr * cr - pi * ci + er, ni = pr * ci + pi * cr + ei; cr = nr; ci = ni; } }
#pragma unroll
    for (int k = 0; k < 32; ++k) { *(unsigned*)(UG + (size_t)k * UGLD) = cvt_pk_bf16(l[k].x + cr, l[k].y + ci); const float nr = ar * cr - ai * ci, ni = ar * ci + ai * cr; cr = nr; ci = ni; }
    asm volatile("s_waitcnt lgkmcnt(0)" ::: "memory"); __builtin_amdgcn_s_barrier(); asm volatile("" ::: "memory");
}
struct OutY { bf16x8 yq[2], yw[2]; u32x2 pv[4], pp[4], gv[4]; float bon; };
__device__ __forceinline__ void rwkv_out_loady(Frame& F, int unit, int at, OutY& Lq) {
    const int lane = F.lane, fr = lane & 15, fq = lane >> 4;
    const int bh = unit >> 6, c = unit & 63, b = bh >> 3, h = bh & 7;
    const bf16_t* QRT = (const bf16_t*)(F.ws + WS_QRT) + (size_t)unit * 4096; const bf16_t* WYT = (const bf16_t*)(F.ws + WS_WYT) + (size_t)unit * 4096;
#pragma unroll
    for (int s = 0; s < 2; ++s) { Lq.yq[s] = __builtin_nontemporal_load((const bf16x8*)(QRT + (size_t)(16 * at + fr) * 64 + 32 * s + 8 * fq)); Lq.yw[s] = __builtin_nontemporal_load((const bf16x8*)(WYT + (size_t)(16 * at + fr) * 64 + 32 * s + 8 * fq)); }
    const int tl = c * 64 + 16 * at + fr, tg = b * SEQ + tl;
    const bf16_t* prow = (const bf16_t*)(F.ws + WS_PR) + (size_t)tg * NRW + 1024 + h * 64;
    const bf16_t* gb = (const bf16_t*)(F.ws + WS_GBUF) + (size_t)tg * RW + h * 64;
    Lq.bon = ((const float*)(F.ws + WS_BONUS))[(size_t)tg * 8 + h];
    const bf16_t* pprev = prow - (tl > 0 ? NRW : 0);
#pragma unroll
    for (int bt = 0; bt < 4; ++bt) { const int i0 = 16 * bt + 4 * fq; Lq.pv[bt] = *(const u32x2*)(prow + i0); Lq.pp[bt] = *(const u32x2*)(pprev + i0); Lq.gv[bt] = *(const u32x2*)(gb + i0); }
}
__device__ __forceinline__ void rwkv_out_comp(Frame& F, int unit, int at, const bf16x8 (&xs)[2][4], const bf16x8 (&xv)[2][4], const OutY& Lq) {
    const int lane = F.lane, fr = lane & 15, fq = lane >> 4;
    const int bh = unit >> 6, c = unit & 63, b = bh >> 3, h = bh & 7;
    f32x4 m4[4], lw[4], lb[4];
#pragma unroll
    for (int bt = 0; bt < 4; ++bt) { const int i0 = 16 * bt + 4 * fq; m4[bt] = *(const f32x4*)(F.in[I_MU] + 1024 + h * 64 + i0); lw[bt] = *(const f32x4*)(F.in[I_LNW] + h * 64 + i0); lb[bt] = *(const f32x4*)(F.in[I_LNB] + h * 64 + i0); }
    f32x4 acc[4];
#pragma unroll
    for (int bt = 0; bt < 4; ++bt) acc[bt] = (f32x4){0.f, 0.f, 0.f, 0.f};
#pragma unroll
    for (int s = 0; s < 2; ++s)
#pragma unroll
        for (int bt = 0; bt < 4; ++bt) {
            acc[bt] = __builtin_amdgcn_mfma_f32_16x16x32_bf16(xs[s][bt], Lq.yq[s], acc[bt], 0, 0, 0);
            acc[bt] = __builtin_amdgcn_mfma_f32_16x16x32_bf16(xv[s][bt], Lq.yw[s], acc[bt], 0, 0, 0); }
    float s1 = 0.f;
#pragma unroll
    for (int bt = 0; bt < 4; ++bt) s1 += (acc[bt][0] + acc[bt][1]) + (acc[bt][2] + acc[bt][3]);
    s1 += __shfl_xor(s1, 16); s1 += __shfl_xor(s1, 32);
    const float mean = s1 * (1.f / 64.f); float s2 = 0.f;
#pragma unroll
    for (int bt = 0; bt < 4; ++bt) { const f32x4 d = acc[bt] - mean; s2 += (d[0] * d[0] + d[1] * d[1]) + (d[2] * d[2] + d[3] * d[3]); }
    s2 += __shfl_xor(s2, 16); s2 += __shfl_xor(s2, 32);
    const float rstd = __builtin_amdgcn_rsqf(s2 * (1.f / 64.f) + 64e-5f);
    const int tl = c * 64 + 16 * at + fr, tg = b * SEQ + tl;
    const float pmask = tl > 0 ? 1.f : 0.f;
    bf16_t* YRS = (bf16_t*)(F.dout + DO_YRS) + (size_t)tg * D + h * 64;
#pragma unroll
    for (int bt = 0; bt < 4; ++bt) { const int i0 = 16 * bt + 4 * fq;
        const u32x2 pv = Lq.pv[bt], pp = Lq.pp[bt], gv = Lq.gv[bt];
        const float x[4] = {bf_lo(pv.x), bf_hi(pv.x), bf_lo(pv.y), bf_hi(pv.y)}, xp[4] = {bf_lo(pp.x) * pmask, bf_hi(pp.x) * pmask, bf_lo(pp.y) * pmask, bf_hi(pp.y) * pmask}, gg[4] = {bf_lo(gv.x), bf_hi(gv.x), bf_lo(gv.y), bf_hi(gv.y)};
        float o[4];
#pragma unroll
        for (int e = 0; e < 4; ++e) { const float vsh = x[e] + (xp[e] - x[e]) * m4[bt][e]; o[e] = ((acc[bt][e] - mean) * rstd * lw[bt][e] + lb[bt][e] + Lq.bon * vsh) * gg[e]; }
        u32x2 w; w.x = cvt_pk_bf16(o[0], o[1]); w.y = cvt_pk_bf16(o[2], o[3]); *(u32x2*)(YRS + i0) = w; }
}
__device__ __forceinline__ void rwkv_out_units(Frame& F) {
    const int lane = F.lane, fr = lane & 15, fq = lane >> 4;
    for (int unit = F.vcu * NWAVES + F.wave; unit < NUNIT; unit += F.G * NWAVES) {
        const bf16_t* VT = (const bf16_t*)(F.ws + WS_VT) + (size_t)unit * 4096; const bf16_t* SST = (const bf16_t*)(F.dout + DO_SST) + (size_t)unit * 4096;
        bf16x8 xs[2][4], xv[2][4]; OutY A, B;
#pragma unroll
        for (int s = 0; s < 2; ++s)
#pragma unroll
            for (int bt = 0; bt < 4; ++bt) { xs[s][bt] = __builtin_nontemporal_load((const bf16x8*)(SST + (size_t)(16 * bt + fr) * 64 + 32 * s + 8 * fq)); xv[s][bt] = __builtin_nontemporal_load((const bf16x8*)(VT + (size_t)(16 * bt + fr) * 64 + 32 * s + 8 * fq)); }
        rwkv_out_loady(F, unit, 0, A); rwkv_out_loady(F, unit, 1, B); __builtin_amdgcn_sched_barrier(0);
        rwkv_out_comp(F, unit, 0, xs, xv, A); __builtin_amdgcn_sched_barrier(0); rwkv_out_loady(F, unit, 2, A); __builtin_amdgcn_sched_barrier(0);
        rwkv_out_comp(F, unit, 1, xs, xv, B); __builtin_amdgcn_sched_barrier(0); rwkv_out_loady(F, unit, 3, B); __builtin_amdgcn_sched_barrier(0);
        rwkv_out_comp(F, unit, 2, xs, xv, A); __builtin_amdgcn_sched_barrier(0);
        rwkv_out_comp(F, unit, 3, xs, xv, B); __builtin_amdgcn_sched_barrier(0);
    }
}

__device__ __forceinline__ void p8_rows(Frame& F) {
    const int gw = F.vcu * NWAVES + F.wave, NGW = F.G * NWAVES, lane = F.lane;
    const bf16_t* MX = (const bf16_t*)(F.ws + WS_MIXED); const float* ST = (const float*)(F.ws + WS_STAT1); bf16_t* H2 = (bf16_t*)(F.ws + WS_H2); float* X1 = (float*)F.dout;
    f32x4 gp[4];
#pragma unroll
    for (int j = 0; j < 4; ++j) gp[j] = *(const f32x4*)(F.in[I_NMPOST] + 256 * j + 4 * lane);
    for (int m0 = gw; m0 < T; m0 += 2 * NGW) {
        int mm[2] = {m0, (m0 + NGW < T) ? m0 + NGW : m0};
        f32x4 xv[2][4]; u32x2 mw[2][4]; float st[2];
#pragma unroll
        for (int q = 0; q < 2; ++q) { st[q] = (lane < 16) ? ST[(size_t)mm[q] * 16 + lane] : 0.f;
#pragma unroll
            for (int j = 0; j < 4; ++j) { const int col = 256 * j + 4 * lane; xv[q][j] = __builtin_nontemporal_load((const f32x4*)(F.in[I_X] + (size_t)mm[q] * D + col)); mw[q][j] = __builtin_nontemporal_load((const u32x2*)(MX + (size_t)mm[q] * D + col)); } }
#pragma unroll
        for (int q = 0; q < 2; ++q) {
            const float rstd1 = __builtin_amdgcn_rsqf(wave_sum(st[q]) * (1.f / D) + 1e-6f);
            f32x4 v[4]; float s = 0.f;
#pragma unroll
            for (int j = 0; j < 4; ++j) { const int col = 256 * j + 4 * lane;
                v[j].x = xv[q][j].x + bf_lo(mw[q][j].x) * rstd1 * gp[j].x; v[j].y = xv[q][j].y + bf_hi(mw[q][j].x) * rstd1 * gp[j].y; v[j].z = xv[q][j].z + bf_lo(mw[q][j].y) * rstd1 * gp[j].z; v[j].w = xv[q][j].w + bf_hi(mw[q][j].y) * rstd1 * gp[j].w;
                s += (v[j].x * v[j].x + v[j].y * v[j].y) + (v[j].z * v[j].z + v[j].w * v[j].w);
                }
            const float rstd2 = __builtin_amdgcn_rsqf(wave_sum(s) * (1.f / D) + 1e-6f);
#pragma unroll
            for (int j = 0; j < 4; ++j) { u32x2 w; w.x = cvt_pk_bf16(v[j].x * rstd2, v[j].y * rstd2); w.y = cvt_pk_bf16(v[j].z * rstd2, v[j].w * rstd2); *(u32x2*)(H2 + (size_t)mm[q] * D + 256 * j + 4 * lane) = w; }
        }
    }
}
__device__ __forceinline__ void p12_rows(Frame& F) {
    const int gw = F.vcu * NWAVES + F.wave, NGW = F.G * NWAVES, lane = F.lane;
    const bf16_t* FB = (const bf16_t*)(F.ws + WS_F); const bf16_t* MX = (const bf16_t*)(F.ws + WS_MIXED);
    const float* ST1 = (const float*)(F.ws + WS_STAT1); const float* ST2 = (const float*)(F.ws + WS_STAT2); float* OUT = (float*)F.dout;
    f32x4 gp[4], gq[4];
#pragma unroll
    for (int j = 0; j < 4; ++j) { gp[j] = *(const f32x4*)(F.in[I_NMPOST] + 256 * j + 4 * lane); gq[j] = *(const f32x4*)(F.in[I_NFPOST] + 256 * j + 4 * lane); }
    for (int m0 = gw; m0 < T; m0 += 2 * NGW) {
        int mm[2] = {m0, (m0 + NGW < T) ? m0 + NGW : m0};
        f32x4 xv[2][4]; u32x2 mw[2][4], fw[2][4]; float s1[2], s2[2];
#pragma unroll
        for (int q = 0; q < 2; ++q) { s1[q] = (lane < 16) ? ST1[(size_t)mm[q] * 16 + lane] : 0.f; s2[q] = (lane < 16) ? ST2[(size_t)mm[q] * 16 + lane] : 0.f;
#pragma unroll
            for (int j = 0; j < 4; ++j) { const int col = 256 * j + 4 * lane; xv[q][j] = __builtin_nontemporal_load((const f32x4*)(F.in[I_X] + (size_t)mm[q] * D + col));
                mw[q][j] = __builtin_nontemporal_load((const u32x2*)(MX + (size_t)mm[q] * D + col)); fw[q][j] = __builtin_nontemporal_load((const u32x2*)(FB + (size_t)mm[q] * D + col)); } }
#pragma unroll
        for (int q = 0; q < 2; ++q) {
            const float rstd1 = __builtin_amdgcn_rsqf(wave_sum(s1[q]) * (1.f / D) + 1e-6f), rstd3 = __builtin_amdgcn_rsqf(wave_sum(s2[q]) * (1.f / D) + 1e-6f);
#pragma unroll
            for (int j = 0; j < 4; ++j) { const int col = 256 * j + 4 * lane; f32x4 o;
                o.x = xv[q][j].x + bf_lo(mw[q][j].x) * rstd1 * gp[j].x; o.y = xv[q][j].y + bf_hi(mw[q][j].x) * rstd1 * gp[j].y; o.z = xv[q][j].z + bf_lo(mw[q][j].y) * rstd1 * gp[j].z; o.w = xv[q][j].w + bf_hi(mw[q][j].y) * rstd1 * gp[j].w;
                o.x += bf_lo(fw[q][j].x) * rstd3 * gq[j].x; o.y += bf_hi(fw[q][j].x) * rstd3 * gq[j].y; o.z += bf_lo(fw[q][j].y) * rstd3 * gq[j].z; o.w += bf_hi(fw[q][j].y) * rstd3 * gq[j].w;
                __builtin_nontemporal_store(o, (f32x4*)(OUT + (size_t)mm[q] * D + col)); }
        }
    }
}

#ifndef MK_PER_PHASE
#define MK_PER_PHASE 0
#endif
constexpr int NPHASE = 12;
struct Args { const float* in[35]; float* out; unsigned char* ws; int ph_lo, ph_hi; };
static_assert(sizeof(Args) == 35 * 8 + 8 + 8 + 8, "Args has no padding");

__device__ __forceinline__ bool phase_begin(Frame& F) { unsigned long long z = 0; asm volatile("" : "+s"(z), "+v"(F.tid)); F.ws = F.ws0 + z; F.dout = F.dout0 + z;     F.lane = F.tid & 63; F.wave = __builtin_amdgcn_readfirstlane(F.tid >> 6); return true; }
__global__ void __launch_bounds__(NWAVES * 64, 2) fwd_kernel(Args args) {
    extern __shared__ __attribute__((aligned(16))) unsigned char lds_raw[];
    Frame F;
    F.lds = (LAS unsigned char*)lds_raw;
    F.MISC = (volatile LAS unsigned*)(F.lds + MISC_OFF);
    F.tid = threadIdx.x; F.lane = F.tid & 63; F.wave = __builtin_amdgcn_readfirstlane(F.tid >> 6);
    F.G = gridDim.x; { const int bx = blockIdx.x; F.vcu = (F.G % 8 == 0) ? (bx % 8) * (F.G / 8) + bx / 8 : bx; }
    F.ws0 = args.ws; F.dout0 = (unsigned char*)args.out; F.ws = F.ws0; F.dout = F.dout0; F.ctl = (gu32*)(args.ws + WS_CTL);
    F.in = (InTab)__builtin_amdgcn_kernarg_segment_ptr();
    for (int u = F.tid; u < (LDS_BYTES - LDSCTL_OFF) / 4; u += NWAVES * 64) ((LAS unsigned*)(F.lds + LDSCTL_OFF))[u] = 0u;
    __syncthreads();
    XcdBarrier bar; bar.bar = (unsigned*)(F.ctl + CW_BAR); bar.x = 0; bar.st = nullptr;
    if (!MK_PER_PHASE) bar = xcd_barrier_post((unsigned*)(F.ctl + CW_BAR), F.MISC + 8);
    const int lo = args.ph_lo, hi = args.ph_hi;
#ifndef PHMASK
#define PHMASK 0xffffffffu
#endif
#define IN(k) (((PHMASK >> (k)) & 1u) && lo <= (k) && (k) < hi && phase_begin(F))
#ifndef REPMASK
#define REPMASK 0u
#endif
#define REPS(k) ((((REPMASK) >> (k)) & 1u) ? 2 : 1)
#define PH(k) for (int rep_ = 0; rep_ < REPS(k); ++rep_, (rep_ < REPS(k) ? xcd_barrier(bar) : (void)0))
#define INQ(k) (lo <= (k) && (k) < hi)
#define SEAM(k) do { if (INQ(k) && INQ((k) + 1)) xcd_barrier(bar); } while (0)
#define WSB(off) ((bf16_t*)(F.ws + (off)))
    const int bx = (int)blockIdx.x;

    PH(0) if (IN(0)) { p0_prologue(F); }
    SEAM(0);
    PH(1) if (IN(1)) {
        pg8::Gemm g{D, D, D, 0}; pg8::StaticOrder S; S.init(WSB(WS_XN), WSB(WS_WIN), D, D, T, NIN, F.G, bx);
        EpiInProj E{WSB(WS_PR), WSB(WS_UG), WSB(WS_GATES), F.in[I_BGATE], 0};
        pg8::gemm_phase<EpiInProj, pg8::StaticOrder, true>(F.lds, g, S, E, F.tid);
    }
    SEAM(1);
    PH(2) if (IN(2)) {
        PrePf pf;
        if (F.vcu < NB * NCH) { rwkv_pre_fetch(F, (((F.vcu >> 6) * NHEAD) << 6) + (F.vcu & 63), true, pf, F.tid); rwkv_pre_put_w(F.lds, pf, F.tid); }
        {
            LAS f32x4* TB = (LAS f32x4*)(F.lds + XTRA_OFF + 4096);
            if (F.tid < NRW / 4) TB[F.tid] = ((const f32x4*)F.in[I_MU])[F.tid];
            const int pq = F.tid >> 7, pi = F.tid & 127;
            const float* psrc = pq == 0 ? F.in[I_W0] : pq == 1 ? F.in[I_A0] : pq == 2 ? F.in[I_KK] : F.in[I_KA];
            TB[NRW / 4 + F.tid] = ((const f32x4*)psrc)[pi];
            if (F.tid < 128) TB[NRW / 4 + 512 + F.tid] = ((const f32x4*)F.in[I_RK])[F.tid];
            BAR_LDS();
        }
        for (int pc = F.vcu; pc < NB * NCH; pc += F.G) {
#pragma unroll 1
            for (int hh = 0; hh < NHEAD; ++hh) { const int bq = pc >> 6, cq = pc & 63, u = ((bq * NHEAD + hh) << 6) + cq;
                const int un = (hh < NHEAD - 1) ? u + 64 : ((pc + F.G < NB * NCH) ? ((((pc + F.G) >> 6) * NHEAD) << 6) + ((pc + F.G) & 63) : NUNIT);
                rwkv_pre_unit(F, u, un, hh == 0, hh == NHEAD - 1, pf); } }
        BAR_LDS();
        pg8::Gemm g{256, UGLD, 256, 0}; S5Order S{WSB(WS_UG), WSB(WS_B1A), 256, F.G, bx};
        EpiSloc E{(float*)(F.ws + WS_SLOC), 0};
        pg8::gemm_phase<EpiSloc, S5Order, true>(F.lds, g, S, E, F.tid);
    }
    SEAM(2);
    PH(3) if (IN(3)) {
        for (int gb = F.vcu; gb < S5G * NB; gb += F.G) s5_scan_block(F, gb);
        for (int it = F.vcu; it < NB * NHEAD * 4; it += F.G) rwkv_scan_block(F, it);
    }
    SEAM(3);
    PH(4) if (IN(4)) {
        rwkv_out_units(F);
        VM_WAIT(); __syncthreads();
        pg8::Gemm g{384, UGLD, 384, 0}; S5Order S{WSB(WS_UG), WSB(WS_B1B), 384, F.G, bx};
        pg8::EpiGen8<FS5Out> E{FS5Out{WSB(WS_YSP)}, 0};
        pg8::gemm_phase<pg8::EpiGen8<FS5Out>, S5Order, true>(F.lds, g, S, E, F.tid);
    }
    SEAM(4);
    PH(5) if (IN(5)) {
        pg8::Gemm g{RW, RW, RW, 1}; pg8::StaticOrder S; S.init(WSB(WS_YSP), WSB(WS_WGLU), RW, RW, T, RW, F.G, bx); S.tstepA = (size_t)16 * 256 * 2;
        EpiGlu E{WSB(WS_YSP), (bf16_t*)(F.dout + DO_YRS), F.in[I_BGLU], 0};
        pg8::gemm_phase<EpiGlu, pg8::StaticOrder, true>(F.lds, g, S, E, F.tid);
    }
    SEAM(5);
    PH(6) if (IN(6)) {
        pg8::Gemm g{RW, D, D, 0};
        { pg8::StaticOrder S; S.init((const bf16_t*)(F.dout + DO_YRS), WSB(WS_WBRS), D, D, T, D, F.G, bx);
          EpiMergeA E{WSB(WS_GATES), WSB(WS_MERGED), 0};
          pg8::gemm_phase<EpiMergeA, pg8::StaticOrder, true>(F.lds, g, S, E, F.tid); }
        { pg8::StaticOrder S; S.init((const bf16_t*)(F.dout + DO_YRS) + RW, WSB(WS_WBRS) + RW, D, D, T, D, F.G, bx);
          EpiMergeB E{WSB(WS_GATES), WSB(WS_MERGED), 0};
          pg8::gemm_phase<EpiMergeB, pg8::StaticOrder, true>(F.lds, g, S, E, F.tid); }
    }
    SEAM(6);
    PH(7) if (IN(7)) {
        pg8::Gemm g{D, D, D, 0}; pg8::StaticOrder S; S.init(WSB(WS_MERGED), WSB(WS_WOUT), D, D, T, D, F.G, bx);
        EpiRowStat E{WSB(WS_MIXED), (float*)(F.ws + WS_STAT1), 0};
        pg8::gemm_phase<EpiRowStat, pg8::StaticOrder, false>(F.lds, g, S, E, F.tid);
    }
    SEAM(7);
    PH(8) if (IN(8)) { p8_rows(F);
        for (size_t i = (size_t)bx * 512 + F.tid; i < HZ_BYTES / 16; i += (size_t)F.G * 512) ((u32x4*)(F.ws + WS_HZ))[i] = (u32x4){0u, 0u, 0u, 0u}; }
    SEAM(8);
    PH(9) if (IN(9)) {
        pg8::Gemm g{D, D, D, 0}; UpOrder S{WSB(WS_H2), WSB(WS_WUP), F.G, bx};
        EpiConvAct E{WSB(WS_ACT), F.in[I_CONVW], F.in[I_CONVB], (LAS unsigned*)(F.lds + XTRA_OFF), (unsigned long long*)(F.ws + WS_HZ), (unsigned*)(F.ctl + 2), 0};
        pg8::gemm_phase<EpiConvAct, UpOrder, true>(F.lds, g, S, E, F.tid);
    }
    SEAM(9);
    PH(10) if (IN(10)) {
        pg8::Gemm g{FF, FF, FF, 0}; pg8::StaticOrder S; S.init(WSB(WS_ACT), WSB(WS_WDN), FF, FF, T, D, F.G, bx);
        EpiRowStat E{WSB(WS_F), (float*)(F.ws + WS_STAT2), 0};
        pg8::gemm_phase<EpiRowStat, pg8::StaticOrder, false>(F.lds, g, S, E, F.tid);
    }
    SEAM(10);
    if (IN(11)) p12_rows(F);
#undef IN
#undef INQ
#undef SEAM
#undef WSB
}

extern "C" void kernel_launch(void* const* d_in, const int* in_sizes, int n_in, void* d_out, int out_size, void* d_ws, size_t ws_size, hipStream_t stream) {
    static int grid = 0;
    if (grid == 0) {
        if (n_in != 35 || in_sizes[0] != T * D || out_size != T * D || ws_size < WS_END) { fprintf(stderr, "kernel_launch: unexpected shapes: n_in %d in0 %d out %d ws %zu (need %zu)\n", n_in, n_in > 0 ? in_sizes[0] : -1, out_size, ws_size, (size_t)WS_END); grid = -1; return; }
        int dev = 0, cus = 0, per_cu = 0;
        if (hipGetDevice(&dev) != hipSuccess || hipDeviceGetAttribute(&cus, hipDeviceAttributeMultiprocessorCount, dev) != hipSuccess) { fprintf(stderr, "kernel_launch: device query failed\n"); grid = -1; return; }
        if (hipFuncSetAttribute((const void*)fwd_kernel, hipFuncAttributeMaxDynamicSharedMemorySize, LDS_BYTES) != hipSuccess) { fprintf(stderr, "kernel_launch: hipFuncSetAttribute failed\n"); grid = -1; return; }
        if (hipOccupancyMaxActiveBlocksPerMultiprocessor(&per_cu, (const void*)fwd_kernel, NWAVES * 64, LDS_BYTES) != hipSuccess || per_cu < 1) fprintf(stderr, "kernel_launch: occupancy query reports %d blocks per CU\n", per_cu);
        (void)hipGetLastError();
        grid = cus;
    }
    if (grid < 0) return;
    if (hipMemsetAsync((char*)d_ws + WS_CTL, 0, CTL_ZERO_BYTES, stream) != hipSuccess) { fprintf(stderr, "kernel_launch: memset failed\n"); return; }
    Args a{};
    for (int i = 0; i < 35; ++i) a.in[i] = (const float*)d_in[i];
    a.out = (float*)d_out; a.ws = (unsigned char*)d_ws;
#if MK_PER_PHASE
    for (int ph = 0; ph < NPHASE; ++ph) { a.ph_lo = ph; a.ph_hi = ph + 1; hipLaunchKernelGGL(fwd_kernel, dim3(grid), dim3(NWAVES * 64), LDS_BYTES, stream, a); }
#else
    a.ph_lo = 0; a.ph_hi = NPHASE;
    hipLaunchKernelGGL(fwd_kernel, dim3(grid), dim3(NWAVES * 64), LDS_BYTES, stream, a);
#endif
    const hipError_t le = hipPeekAtLastError();
    if (le != hipSuccess) fprintf(stderr, "kernel_launch: launch failed: %s\n", hipGetErrorName(le));
}
```

```cpp
#include <hip/hip_runtime.h>
#include <cstdio>
#include <cstdint>

#define LAS __attribute__((address_space(3)))
#define GAS __attribute__((address_space(1)))
typedef unsigned short bf16_t;
typedef short bf16x8 __attribute__((ext_vector_type(8)));
typedef float f32x4 __attribute__((ext_vector_type(4)));
typedef float f32x2 __attribute__((ext_vector_type(2)));
typedef unsigned u32x4 __attribute__((ext_vector_type(4)));
typedef unsigned u32x2 __attribute__((ext_vector_type(2)));
typedef GAS unsigned gu32;

constexpr int T = 32768, SEQ = 4096, NB = 8, D = 1024, NIN = 4352, NRW = 1792, RW = 512, FF = 2816, FH = 1408;
constexpr int NHEAD = 8, HD = 64, NCH = 64  , NUNIT = NB * NHEAD * NCH;
constexpr int S5G = 32, S5ROWS = T / 16, UGLD = 384;

constexpr size_t MiB = 1u << 20;
constexpr size_t WS_CTL = 0, CTL_ZERO_BYTES = 1 * MiB;
constexpr size_t WS_WIN = 1 * MiB;
constexpr size_t WS_WUP = WS_WIN + (size_t)NIN * D * 2;
constexpr size_t WS_WDN = WS_WUP + (size_t)2 * FF * D * 2;
constexpr size_t WS_WOUT = WS_WDN + (size_t)D * FF * 2;
constexpr size_t WS_WBRS = WS_WOUT + (size_t)D * D * 2;
constexpr size_t WS_WGLU = WS_WBRS + (size_t)D * D * 2;
constexpr size_t WS_W2T = WS_WGLU + (size_t)RW * RW * 2;
constexpr size_t WS_A2T = WS_W2T + (size_t)RW * 64 * 2;
constexpr size_t WS_G2T = WS_A2T + (size_t)RW * 64 * 2;
constexpr size_t WS_B1A = WS_G2T + (size_t)RW * 128 * 2;
constexpr size_t WS_B1B = WS_B1A + (size_t)S5G * 256 * 256 * 2;
constexpr size_t WS_AL = WS_B1B + (size_t)S5G * 256 * 384 * 2;
constexpr size_t WS_WEND = WS_AL + (size_t)S5G * 64 * 2 * 4;
static_assert(WS_WEND <= 44 * MiB, "weights region");
constexpr size_t WS_XN = 44 * MiB;
constexpr size_t WS_QRT = 44 * MiB, WS_WYT = 76 * MiB;
constexpr size_t WS_MERGED = 44 * MiB, WS_H2 = 44 * MiB, WS_F = 44 * MiB;
constexpr size_t WS_PR = 108 * MiB;
constexpr size_t WS_MIXED = 304 * MiB, WS_STAT1 = 368 * MiB;
constexpr size_t WS_ACT = 108 * MiB;
constexpr size_t WS_STAT2 = 284 * MiB;
constexpr size_t WS_UG = 220 * MiB;
constexpr size_t WS_GATES = 268 * MiB;
constexpr size_t WS_SLOC = 396 * MiB, WS_YSP = 396 * MiB;
constexpr size_t WS_GBUF = 428 * MiB;
constexpr size_t WS_BONUS = 460 * MiB;
constexpr size_t WS_VT = 461 * MiB;
constexpr size_t WS_LRSCR = 493 * MiB;
constexpr size_t WS_Z = 336 * MiB;
constexpr size_t WS_END = 512 * MiB;
constexpr size_t DO_H = 0, DO_GT = 36 * MiB, DO_SST = 96 * MiB, DO_YRS = 0;
constexpr int GLD = 72;

constexpr int CW_BAR = 4096, CW_HF = 32768;
constexpr size_t WS_HZ = 290 * MiB, HZ_BYTES = (size_t)2816 * 4 * 2 * 32 * 8;

constexpr int RING_BYTES = 131072, LDSCTL_OFF = RING_BYTES, MISC_OFF = LDSCTL_OFF + 320, XTRA_OFF = LDSCTL_OFF + 1024, LDS_BYTES = 155648;
constexpr int NWAVES = 8;

#define RLX_AGENT __ATOMIC_RELAXED, __HIP_MEMORY_SCOPE_AGENT
#define LDS_WAIT() asm volatile("s_waitcnt lgkmcnt(0)" ::: "memory")
#define VM_WAIT() asm volatile("s_waitcnt vmcnt(0)" ::: "memory")

typedef __bf16 bf16x2_t __attribute__((ext_vector_type(2)));
__device__ __forceinline__ unsigned cvt_pk_bf16(float lo, float hi) { const f32x2 v = {lo, hi}; return __builtin_bit_cast(unsigned, __builtin_convertvector(v, bf16x2_t)); }
__device__ __forceinline__ float bf_lo(unsigned w) { return __uint_as_float(w << 16); }
__device__ __forceinline__ float bf_hi(unsigned w) { return __uint_as_float(w & 0xffff0000u); }
__device__ __forceinline__ float bf1(bf16_t h) { return __uint_as_float((unsigned)h << 16); }
__device__ __forceinline__ float fexp(float x) { return __builtin_amdgcn_exp2f(x * 1.44269504089f); }
__device__ __forceinline__ float fsigmoid(float x) { return __builtin_amdgcn_rcpf(1.0f + __builtin_amdgcn_exp2f(-1.44269504089f * x)); }
__device__ __forceinline__ float ftanh(float x) { return 1.0f - 2.0f * __builtin_amdgcn_rcpf(1.0f + __builtin_amdgcn_exp2f(2.88539008178f * x)); }
__device__ __forceinline__ float fgelu(float x) { const float u = 0.7978845608f * (x + 0.044715f * x * x * x); return x * fsigmoid(2.0f * u); }
__device__ __forceinline__ void unpack8(u32x4 w, float (&f)[8]) { f[0] = bf_lo(w.x); f[1] = bf_hi(w.x); f[2] = bf_lo(w.y); f[3] = bf_hi(w.y); f[4] = bf_lo(w.z); f[5] = bf_hi(w.z); f[6] = bf_lo(w.w); f[7] = bf_hi(w.w); }
__device__ __forceinline__ u32x4 pack8(const float (&f)[8]) { u32x4 w; w.x = cvt_pk_bf16(f[0], f[1]); w.y = cvt_pk_bf16(f[2], f[3]); w.z = cvt_pk_bf16(f[4], f[5]); w.w = cvt_pk_bf16(f[6], f[7]); return w; }
__device__ __forceinline__ float wave_sum(float v) {
#pragma unroll
    for (int o = 1; o < 64; o <<= 1) v += __shfl_xor(v, o);
    return v;
}

#define XB_TMO      128
#define XB_XCNT(j)  (256  + 64 * (j))
#define XB_XSUB(j)  (1280 + 64 * (j))
#define XB_XGEN(j)  (2304 + 64 * (j))
#define XB_TOP      3328
#define XB_TOPGEN   3392
#define XCD_BAR_WORDS 3456
#define XB_SPIN_CAP (1u << 18)
__device__ __forceinline__ unsigned xb_ld(unsigned* p)              { return __hip_atomic_load(p, __ATOMIC_RELAXED, __HIP_MEMORY_SCOPE_AGENT); }
__device__ __forceinline__ unsigned xb_add(unsigned* p, unsigned v) { return __hip_atomic_fetch_add(p, v, __ATOMIC_RELAXED, __HIP_MEMORY_SCOPE_AGENT); }
__device__ __forceinline__ unsigned xb_xcc_id() { return (unsigned)__builtin_amdgcn_s_getreg((3 << 11) | 20) & 0xFu; }
#define XB_SPIN(cond, bar) do { unsigned _sp = 0; while (cond) { __builtin_amdgcn_s_sleep(1); \
    if ((++_sp & 255u) == 0u) { if (xb_ld(&(bar)[XB_TMO])) break; if (_sp > XB_SPIN_CAP) { atomicAdd(&(bar)[XB_TMO], 1u); break; } } } } while (0)
struct XcdBarrier { unsigned* bar; unsigned x; volatile LAS unsigned* st; };
__device__ __forceinline__ XcdBarrier xcd_barrier_post(unsigned* bar, volatile LAS unsigned* st) {
    XcdBarrier b; b.bar = bar; b.x = xb_xcc_id(); b.st = st;
    if (threadIdx.x == 0) (void)xb_add(&bar[XB_XCNT(b.x)], 1u);
    return b;
}
__device__ __forceinline__ void xcd_barrier_complete(unsigned* bar, unsigned x, unsigned& nloc, unsigned& nx) {
    const unsigned G = gridDim.x * gridDim.y * gridDim.z;
    unsigned sum, cnt, mine, sp = 0u;
    for (;;) {
        sum = 0u; cnt = 0u; mine = 0u;
#pragma unroll
        for (unsigned j = 0; j < 16; ++j) { const unsigned c = xb_ld(&bar[XB_XCNT(j)]); sum += c; cnt += (c > 0u) ? 1u : 0u; mine = (j == x) ? c : mine; }
        if (sum == G) break;
        __builtin_amdgcn_s_sleep(1);
        if ((++sp & 255u) == 0u) { if (xb_ld(&bar[XB_TMO])) break; if (sp > XB_SPIN_CAP) { atomicAdd(&bar[XB_TMO], 1u); break; } }
    }
    nloc = mine > 0u ? mine : 1u; nx = cnt > 0u ? cnt : 1u;
}
__device__ __forceinline__ void xcd_barrier(const XcdBarrier& b) {
    asm volatile("s_waitcnt vmcnt(0)" ::: "memory");
    __syncthreads();
    if (threadIdx.x == 0) {
        unsigned* bar = b.bar;
        __builtin_amdgcn_s_waitcnt(0);
        unsigned nloc = b.st[0], nx = b.st[1];
        if (nloc == 0u) { xcd_barrier_complete(bar, b.x, nloc, nx); b.st[0] = nloc; b.st[1] = nx; }
        const unsigned old = xb_add(&bar[XB_XSUB(b.x)], 1u);
        const unsigned gen = old / nloc;
        if (old + 1u == (gen + 1u) * nloc) {
            __builtin_amdgcn_fence(__ATOMIC_RELEASE, "agent");
            asm volatile("s_waitcnt vmcnt(0)" ::: "memory");
            const unsigned og = xb_add(&bar[XB_TOP], 1u);
            const unsigned tg = og / nx;
            if (og + 1u == (tg + 1u) * nx) xb_add(&bar[XB_TOPGEN], 1u);
            else XB_SPIN(xb_ld(&bar[XB_TOPGEN]) == tg, bar);
            __builtin_amdgcn_fence(__ATOMIC_ACQUIRE, "agent");
            xb_add(&bar[XB_XGEN(b.x)], 1u);
            asm volatile("s_waitcnt vmcnt(0)" ::: "memory");
        } else {
            XB_SPIN(xb_ld(&bar[XB_XGEN(b.x)]) == gen, bar);
            __builtin_amdgcn_fence(__ATOMIC_ACQUIRE, "agent");
            asm volatile("s_waitcnt vmcnt(0)" ::: "memory");
        }
    }
    __syncthreads();
}

namespace pg8 {
constexpr int BM = 256, BK = 64, HALF = 128, HTB = HALF * BK * 2, STAGE_BYTES = 8 * HTB, NXCD = 8, WGM = 8;
__host__ __device__ __forceinline__ int lds_byte(int r, int c) { const int st = (r >> 4) * 2 + (c >> 5), rr = r & 15, cc = c & 31, ob = rr * 64 + cc * 2; return st * 1024 + (ob ^ (((ob >> 9) & 1) << 5)); }
__host__ __device__ __forceinline__ void stage_rc(int b, int& R, int& C) { const int st = b / 1024, sb = b % 1024, swz = sb ^ (((sb >> 9) & 1) << 5); R = (st >> 1) * 16 + swz / 64; C = (st & 1) * 32 + (swz % 64) / 2; }
__host__ __device__ __forceinline__ int perm32(int rho) { const int n = rho >> 4, i = rho & 15; return 8 * (i >> 2) + 4 * n + (i & 3); }

struct Unit { const char* a; const char* b; int pm, pn; };
struct Gemm { int K, lda, ldb, amode; };

struct StaticOrder {
    const bf16_t* A; const bf16_t* Bt; int lda, ldb;
    int nM, nN, nwg, G, c; size_t tstepA;
    __device__ void init(const bf16_t* A_, const bf16_t* Bt_, int lda_, int ldb_, int M, int N, int G_, int c_) { A = A_; Bt = Bt_; lda = lda_; ldb = ldb_; nM = M / BM; nN = N / BM; nwg = nM * nN; G = G_; c = c_; tstepA = (size_t)BM * lda * 2; }
    __device__ bool next(int i, Unit& u) const {
        const long L = (long)i * G + c; if (L >= nwg) return false;
        int wgid = (int)L; { const int q = nwg / NXCD, r = nwg % NXCD, xcd = wgid % NXCD, off = wgid / NXCD; wgid = (xcd < r ? xcd * (q + 1) : r * (q + 1) + (xcd - r) * q) + off; }
        const int nig = WGM * nN, gid = wgid / nig, fm = gid * WGM, gsz = (nM - fm) < WGM ? (nM - fm) : WGM;
        u.pm = fm + ((wgid % nig) % gsz); u.pn = (wgid % nig) / gsz;
        u.a = (const char*)A + (size_t)u.pm * tstepA; u.b = (const char*)Bt + (size_t)u.pn * BM * ldb * 2; return true;
    }
};

template <class Epi, class Sched, bool ALIGN_EPI = false, bool SP2 = true>
__device__ __forceinline__ void gemm_phase(LAS unsigned char* lds, const Gemm g, const Sched& S, const Epi& E, const int tid) {
    const int wid = __builtin_amdgcn_readfirstlane(tid >> 6), lane = tid & 63, wr = wid >> 2, wc = wid & 3, fr = lane & 15, fq = lane >> 4;
    const int K = g.K, nt = K / BK;
    unsigned voffA[2], voffB[2];
#pragma unroll
    for (int i = 0; i < 2; ++i) { int R, C; stage_rc(tid * 16 + i * 8192, R, C); const int Rb = Epi::PERM ? ((R & ~31) + perm32(R & 31)) : R;
        voffA[i] = g.amode ? (unsigned)((((C >> 4) * S5ROWS + (R >> 4)) * 256 + (R & 15) * 16 + (C & 15)) * 2) : (unsigned)(R * g.lda + C) * 2u; voffB[i] = (unsigned)(Rb * g.ldb + C) * 2u; }
    const size_t kstepB = (size_t)(BK * 2), kstepA = g.amode ? (size_t)4 * S5ROWS * 256 * 2 : (size_t)(BK * 2);
    const size_t hstepA = g.amode ? (size_t)8 * 256 * 2 : (size_t)HALF * g.lda * 2, hstepB = (size_t)HALF * g.ldb * 2;
    const unsigned ldsw = (unsigned)wid * 1024u;
    const int aoff = lds_byte(wr * 64 + fr, fq * 8), boff = lds_byte(wc * 32 + fr, fq * 8);
#define PG8_SA(b, h) (((b) * 2 + (h)) * HTB)
#define PG8_SB(b, h) ((4 + (b) * 2 + (h)) * HTB)
#define PG8_STAGE(bufoff, gbase, voff) do { _Pragma("unroll") for (int _i = 0; _i < 2; ++_i) \
        __builtin_amdgcn_global_load_lds((const unsigned*)((const char*)(gbase) + (voff)[_i]), (LAS unsigned*)(lds + (bufoff) + ldsw + _i * 8192), 16, 0, 0); } while (0)
#define PG8_LDA(dst, b, h) do { _Pragma("unroll") for (int m = 0; m < 4; ++m) _Pragma("unroll") for (int k = 0; k < 2; ++k) dst[m][k] = *(const LAS bf16x8*)(lds + PG8_SA(b, h) + aoff + m * 2048 + k * 1024); } while (0)
#define PG8_LDB(dst, b, h) do { _Pragma("unroll") for (int n = 0; n < 2; ++n) _Pragma("unroll") for (int k = 0; k < 2; ++k) dst[n][k] = *(const LAS bf16x8*)(lds + PG8_SB(b, h) + boff + n * 2048 + k * 1024); } while (0)
#define PG8_MMA(ai, bj, At, Bt) do { __builtin_amdgcn_s_setprio(1); _Pragma("unroll") for (int m = 0; m < 4; ++m) _Pragma("unroll") for (int n = 0; n < 2; ++n) _Pragma("unroll") for (int k = 0; k < 2; ++k) \
        acc[ai][bj][m][n] = __builtin_amdgcn_mfma_f32_16x16x32_bf16(Bt[n][k], At[m][k], acc[ai][bj][m][n], 0, 0, 0); __builtin_amdgcn_s_setprio(0); } while (0)
#define PG8_WAIT_V(n) asm volatile("s_waitcnt vmcnt(" #n ")" ::: "memory")
#define PG8_WAIT_L(n) asm volatile("s_waitcnt lgkmcnt(" #n ")" ::: "memory")
#define PG8_BAR __builtin_amdgcn_s_barrier()
#define PG8_SCHED __builtin_amdgcn_sched_barrier(0)
    Unit cur, nxt; int ui = 0;
    if (!S.next(0, cur)) return;
    f32x4 acc[2][2][4][2];
#pragma unroll
    for (int a = 0; a < 2; ++a)
#pragma unroll
        for (int b = 0; b < 2; ++b)
#pragma unroll
            for (int m = 0; m < 4; ++m)
#pragma unroll
                for (int n = 0; n < 2; ++n) acc[a][b][m][n] = (f32x4){0.f, 0.f, 0.f, 0.f};
    bf16x8 At[4][2], B0[2][2], B1[2][2];
    const char* cA = cur.a; const char* cB = cur.b;
    static_assert(SP2, "only the SP2 loop is kept");
    PG8_STAGE(PG8_SB(0, 0), cB, voffB); PG8_STAGE(PG8_SB(0, 1), cB + hstepB, voffB); PG8_STAGE(PG8_SA(0, 0), cA, voffA); PG8_STAGE(PG8_SA(0, 1), cA + hstepA, voffA);
    if (wr == 1) PG8_BAR;
    PG8_WAIT_V(2); PG8_BAR;
    PG8_STAGE(PG8_SB(1, 0), cB + kstepB, voffB); PG8_STAGE(PG8_SA(1, 0), cA + kstepA, voffA); PG8_STAGE(PG8_SB(1, 1), cB + hstepB + kstepB, voffB);
    PG8_WAIT_V(6); PG8_BAR;
    for (;;) {
        const bool has_next = S.next(ui + 1, nxt);
        const char* nA = has_next ? nxt.a : cA; const char* nB = has_next ? nxt.b : cB;
#pragma unroll 1
        for (int t = 0; t < nt; t += 2) {
            const bool last = (t == nt - 2);
            const char* a1 = cA + (size_t)(t + 1) * kstepA;
            const char* a2 = last ? nA : cA + (size_t)(t + 2) * kstepA; const char* b2 = last ? nB : cB + (size_t)(t + 2) * kstepB;
            const char* a3 = a2 + kstepA; const char* b3 = b2 + kstepB;
            PG8_LDB(B0, 0, 0); PG8_LDB(B1, 0, 1); PG8_SCHED; PG8_LDA(At, 0, 0); PG8_STAGE(PG8_SA(1, 1), a1 + hstepA, voffA);
            PG8_WAIT_V(8); PG8_WAIT_L(0); PG8_BAR; PG8_MMA(0, 0, At, B0); PG8_MMA(0, 1, At, B1); PG8_BAR; PG8_SCHED;
            PG8_LDA(At, 0, 1); PG8_STAGE(PG8_SB(0, 0), b2, voffB); PG8_STAGE(PG8_SB(0, 1), b2 + hstepB, voffB); PG8_STAGE(PG8_SA(0, 0), a2, voffA);
            PG8_WAIT_V(8); PG8_WAIT_L(0); PG8_BAR; PG8_MMA(1, 0, At, B0); PG8_MMA(1, 1, At, B1); PG8_BAR; PG8_SCHED;
            PG8_LDB(B0, 1, 0); PG8_LDB(B1, 1, 1); PG8_SCHED; PG8_LDA(At, 1, 0); PG8_STAGE(PG8_SA(0, 1), a2 + hstepA, voffA);
            PG8_WAIT_V(8); PG8_WAIT_L(0); PG8_BAR; PG8_MMA(0, 0, At, B0); PG8_MMA(0, 1, At, B1); PG8_BAR; PG8_SCHED;
            PG8_LDA(At, 1, 1); PG8_STAGE(PG8_SB(1, 0), b3, voffB); PG8_STAGE(PG8_SB(1, 1), b3 + hstepB, voffB); PG8_STAGE(PG8_SA(1, 0), a3, voffA);
            PG8_WAIT_V(8); PG8_WAIT_L(0); PG8_BAR; PG8_MMA(1, 0, At, B0); PG8_MMA(1, 1, At, B1); PG8_BAR; PG8_SCHED;
        }
        if constexpr (ALIGN_EPI) { if (wr == 0) PG8_BAR; }
        E(acc, cur, wr, wc, fr, fq);
        if (!has_next) break;
#pragma unroll
        for (int a = 0; a < 2; ++a)
#pragma unroll
            for (int b = 0; b < 2; ++b)
#pragma unroll
                for (int m = 0; m < 4; ++m)
#pragma unroll
                    for (int n = 0; n < 2; ++n) acc[a][b][m][n] = (f32x4){0.f, 0.f, 0.f, 0.f};
        cur = nxt; cA = nA; cB = nB; ++ui;
        if constexpr (ALIGN_EPI) { if (wr == 1) PG8_BAR; }
    }
    PG8_WAIT_V(0);
    if constexpr (!ALIGN_EPI) { if (wr == 0) PG8_BAR; }
    PG8_BAR;
#undef PG8_SA
#undef PG8_SB
#undef PG8_STAGE
#undef PG8_LDA
#undef PG8_LDB
#undef PG8_MMA
#undef PG8_WAIT_V
#undef PG8_WAIT_L
#undef PG8_BAR
#undef PG8_SCHED
}

template <class F> struct EpiGen8 {
    static constexpr bool PERM = true, HAS_MID = false; F f; int mid_t;
    __device__ __forceinline__ void mid(f32x4 (&)[2][2][4][2], const Unit&, int, int, int, int) const {}
    __device__ __forceinline__ void operator()(const f32x4 (&acc)[2][2][4][2], const Unit& u, int wr, int wc, int fr, int fq) const {
#pragma unroll
        for (int ai = 0; ai < 2; ++ai)
#pragma unroll
            for (int m = 0; m < 4; ++m) { const int r = ai * HALF + wr * 64 + m * 16 + fr;
#pragma unroll
                for (int bj = 0; bj < 2; ++bj) f(u, r, bj * HALF + wc * 32 + 8 * fq, acc[ai][bj][m][0], acc[ai][bj][m][1]);
                if constexpr (F::PIN) __builtin_amdgcn_sched_barrier(0); }
    }
};
}

typedef const float* cfp_t;
typedef __attribute__((address_space(4))) const cfp_t* InTab;
struct Frame {
    LAS unsigned char* lds;
    volatile LAS unsigned* MISC;
    gu32* ctl;
    int tid, lane, wave, vcu, G;
    unsigned char* ws; unsigned char* dout; unsigned char* ws0; unsigned char* dout0;
    InTab in;
};
enum { I_X = 0, I_NMPRE, I_NMPOST, I_NFPRE, I_NFPOST, I_WIN, I_BGATE, I_MU, I_W0, I_W2, I_A0, I_A2, I_G2, I_KK, I_KA, I_RK, I_LNW, I_LNB,
       I_SARE, I_SAIM, I_SBRE, I_SBIM, I_SCRE, I_SCIM, I_SD, I_SLOG, I_WGLU, I_BGLU, I_WBR, I_WBS, I_WOUT, I_WUP, I_CONVW, I_CONVB, I_WDN };

__device__ __forceinline__ void p0_transpose_item(const float* W, int ldw, int k0, int src0, bf16_t* WT, int ldt, int drow0, int koff, const float* kscale, LAS float* scr, int lane) {
    const int q = lane & 7, rb = lane >> 3;
    f32x4 v[8]; float sc[8];
#pragma unroll
    for (int i = 0; i < 8; ++i) { const int kk = 8 * i + rb; v[i] = __builtin_nontemporal_load((const f32x4*)(W + (size_t)(k0 + kk) * ldw + src0 + 4 * q)); sc[i] = kscale ? kscale[k0 + kk] : 1.0f; }
#pragma unroll
    for (int i = 0; i < 8; ++i) { const int kk = 8 * i + rb; LAS float* d = scr + kk * 33 + 4 * q; d[0] = v[i].x * sc[i]; d[1] = v[i].y * sc[i]; d[2] = v[i].z * sc[i]; d[3] = v[i].w * sc[i]; }
    LDS_WAIT(); asm volatile("" ::: "memory");
    const int c = lane & 7;
#pragma unroll
    for (int j = 0; j < 4; ++j) { const int n = (lane >> 3) + 8 * j; const LAS float* s = scr + (8 * c) * 33 + n;
        u32x4 o; o.x = cvt_pk_bf16(s[0 * 33], s[1 * 33]); o.y = cvt_pk_bf16(s[2 * 33], s[3 * 33]); o.z = cvt_pk_bf16(s[4 * 33], s[5 * 33]); o.w = cvt_pk_bf16(s[6 * 33], s[7 * 33]);
        *(GAS u32x4*)(WT + (size_t)(drow0 + n) * ldt + koff + k0 + 8 * c) = o; }
    LDS_WAIT(); asm volatile("" ::: "memory");
}
struct TrMat { int in_idx, K, N, ldt, koff, kind; size_t dst; int scale_idx; };
__device__ __forceinline__ void p0_do_matrix(Frame& F, const TrMat& mtx, int r, LAS float* scr) {
    const int nblk = mtx.N / 32, kb = r / nblk, nb = r % nblk;
    int src0 = 32 * nb;
    if (mtx.kind == 1) {
        const int pn = (32 * nb) >> 8, within = (32 * nb) & 255;
        src0 = (within < 128 ? 0 : FF - 128) + 128 * pn + within;
    }
    p0_transpose_item(F.in[mtx.in_idx], mtx.N, 64 * kb, src0, (bf16_t*)(F.ws + mtx.dst), mtx.ldt, 32 * nb, mtx.koff, mtx.scale_idx >= 0 ? F.in[mtx.scale_idx] : nullptr, scr, F.lane);
}
__device__ __forceinline__ void p0_s5_group(Frame& F, int g) {
    LAS float* pwr = (LAS float*)(F.lds);
    LAS float* pwi = pwr + 17 * 64;
    LAS float* bbr = pwi + 17 * 64;
    LAS float* bbi = bbr + 1024;
    LAS float* cre = bbi + 1024;
    LAS float* cim = cre + 1024;
    LAS float* kk = cim + 1024;
    const float dt = expf(F.in[I_SLOG][g]);
    for (int idx = F.tid; idx < 17 * 64; idx += 512) { const int k = idx >> 6, p = idx & 63;
        const float are = F.in[I_SARE][g * 64 + p], aim = F.in[I_SAIM][g * 64 + p];
        const float mag = expf((float)k * are * dt); float sn, cs; sincosf((float)k * aim * dt, &sn, &cs);
        pwr[idx] = mag * cs; pwi[idx] = mag * sn; }
    for (int idx = F.tid; idx < 1024; idx += 512) { cre[idx] = F.in[I_SCRE][g * 1024 + idx]; cim[idx] = F.in[I_SCIM][g * 1024 + idx]; }
    __syncthreads();
    for (int idx = F.tid; idx < 1024; idx += 512) { const int p = idx >> 4;
        const float are = F.in[I_SARE][g * 64 + p], aim = F.in[I_SAIM][g * 64 + p];
        const float nr = pwr[64 + p] - 1.0f, ni = pwi[64 + p];
        const float den = 1.0f / (are * are + aim * aim);
        const float qr = (nr * are + ni * aim) * den, qi = (ni * are - nr * aim) * den;
        const float br = F.in[I_SBRE][g * 1024 + idx], bi = F.in[I_SBIM][g * 1024 + idx];
        bbr[idx] = qr * br - qi * bi; bbi[idx] = qr * bi + qi * br; }
    __syncthreads();
    {
        const int kc = F.tid & 255, ph = F.tid >> 8, k = kc >> 4, c = kc & 15; float s[16];
#pragma unroll
        for (int e = 0; e < 16; ++e) s[e] = 0.f;
        for (int p = 32 * ph; p < 32 * ph + 32; ++p) { const float cr_ = cre[c * 64 + p], ci_ = cim[c * 64 + p], pr_ = pwr[k * 64 + p], pi_ = pwi[k * 64 + p];
            const float xr = cr_ * pr_ - ci_ * pi_, xi = cr_ * pi_ + ci_ * pr_;
#pragma unroll
            for (int e4 = 0; e4 < 4; ++e4) { const f32x4 br = *(LAS const f32x4*)(bbr + p * 16 + 4 * e4), bi = *(LAS const f32x4*)(bbi + p * 16 + 4 * e4);
#pragma unroll
                for (int e = 0; e < 4; ++e) s[4 * e4 + e] += xr * br[e] - xi * bi[e]; } }
        LAS float* part = kk + 4096;
        if (ph == 1) {
#pragma unroll
            for (int e4 = 0; e4 < 4; ++e4) *(LAS f32x4*)(part + kc * 16 + 4 * e4) = (f32x4){s[4 * e4], s[4 * e4 + 1], s[4 * e4 + 2], s[4 * e4 + 3]}; }
        __syncthreads();
        if (ph == 0) {
#pragma unroll
            for (int e4 = 0; e4 < 4; ++e4) { const f32x4 o = *(LAS const f32x4*)(part + kc * 16 + 4 * e4);
#pragma unroll
                for (int e = 0; e < 4; ++e) { float v = s[4 * e4 + e] + o[e]; if (k == 0 && c == 4 * e4 + e) v += F.in[I_SD][g * 16 + c]; kk[kc * 16 + 4 * e4 + e] = v; } } }
    }
    __syncthreads();
    bf16_t* B1b = (bf16_t*)(F.ws + WS_B1B) + (size_t)g * 256 * 384;
    for (int idx = F.tid; idx < 256 * 192; idx += 512) { const int n = idx / 192, k2 = (idx % 192) * 2; const int t = n >> 4, c = n & 15; float v[2];
#pragma unroll
        for (int e = 0; e < 2; ++e) { const int kx = k2 + e;
            if (kx < 256) { const int tau = kx >> 4, cp = kx & 15; v[e] = (t >= tau) ? kk[(t - tau) * 256 + c * 16 + cp] : 0.f; }
            else { const int si = kx - 256, p = si >> 1; const float xr = cre[c * 64 + p] * pwr[(t + 1) * 64 + p] - cim[c * 64 + p] * pwi[(t + 1) * 64 + p], xi = cre[c * 64 + p] * pwi[(t + 1) * 64 + p] + cim[c * 64 + p] * pwr[(t + 1) * 64 + p];
                v[e] = (si & 1) ? -xi : xr; } }
        *(unsigned*)(B1b + (size_t)n * 384 + k2) = cvt_pk_bf16(v[0], v[1]); }
    bf16_t* B1a = (bf16_t*)(F.ws + WS_B1A) + (size_t)g * 256 * 256;
    for (int idx = F.tid; idx < 256 * 128; idx += 512) { const int n = idx >> 7, k2 = (idx & 127) * 2; float v[2] = {0.f, 0.f};
        if (n < 128) { const int p = n >> 1;
#pragma unroll
            for (int e = 0; e < 2; ++e) { const int kx = k2 + e, tau = kx >> 4, cp = kx & 15; const float pr_ = pwr[(15 - tau) * 64 + p], pi_ = pwi[(15 - tau) * 64 + p];
                const float xr = pr_ * bbr[p * 16 + cp] - pi_ * bbi[p * 16 + cp], xi = pr_ * bbi[p * 16 + cp] + pi_ * bbr[p * 16 + cp]; v[e] = (n & 1) ? xi : xr; } }
        *(unsigned*)(B1a + (size_t)n * 256 + k2) = cvt_pk_bf16(v[0], v[1]); }
    float* aL = (float*)(F.ws + WS_AL) + g * 128;
    if (F.tid < 64) { aL[2 * F.tid] = pwr[16 * 64 + F.tid]; aL[2 * F.tid + 1] = pwi[16 * 64 + F.tid]; }
    __syncthreads();
}
__device__ __forceinline__ void p0_prologue(Frame& F) {
    if (F.vcu < S5G) p0_s5_group(F, F.vcu);
    if (F.vcu < S5G && F.G > S5G) return;
    LAS float* scr = (LAS float*)(F.lds + F.wave * 16384);
    const int gw = (F.G > S5G ? F.vcu - S5G : F.vcu) * NWAVES + F.wave, NGW = (F.G > S5G ? F.G - S5G : F.G) * NWAVES;
    int base = 0;
#define DO_MAT(in_idx, K_, N_, ldt_, koff_, kind_, dst_, sc_) do { const TrMat mtx{in_idx, K_, N_, ldt_, koff_, kind_, dst_, sc_}; const int items = ((K_) / 64) * ((N_) / 32); \
        for (int it = gw; it < base + items; it += NGW) { if (it >= base) p0_do_matrix(F, mtx, it - base, scr); } base += items; } while (0)
    DO_MAT(I_WIN, D, NIN, D, 0, 0, WS_WIN, I_NMPRE); DO_MAT(I_WUP, D, 2 * FF, D, 0, 1, WS_WUP, I_NFPRE); DO_MAT(I_WDN, FF, D, FF, 0, 0, WS_WDN, -1); DO_MAT(I_WOUT, D, D, D, 0, 0, WS_WOUT, -1);
    DO_MAT(I_WBR, RW, D, D, 0, 0, WS_WBRS, -1); DO_MAT(I_WBS, RW, D, D, RW, 0, WS_WBRS, -1); DO_MAT(I_WGLU, RW, RW, RW, 0, 0, WS_WGLU, -1);
    DO_MAT(I_W2, 64, RW, 64, 0, 0, WS_W2T, -1); DO_MAT(I_A2, 64, RW, 64, 0, 0, WS_A2T, -1); DO_MAT(I_G2, 128, RW, 128, 0, 0, WS_G2T, -1);
#undef DO_MAT
    if (F.vcu >= S5G || F.G <= S5G) {
        bf16_t* XN = (bf16_t*)(F.ws + WS_XN);
        const int gw2 = gw, NGW2 = NGW;
        for (int m = gw2; m < T; m += 2 * NGW2) {
            const int m1 = (m + NGW2 < T) ? m + NGW2 : m;
            const GAS f32x4* xr0 = (const GAS f32x4*)(F.in[I_X] + (size_t)m * D) + F.lane; const GAS f32x4* xr1 = (const GAS f32x4*)(F.in[I_X] + (size_t)m1 * D) + F.lane;
            f32x4 v0[4], v1[4]; float s0 = 0.f, s1 = 0.f;
#pragma unroll
            for (int j = 0; j < 4; ++j) { v0[j] = __builtin_nontemporal_load((const f32x4*)(xr0 + 64 * j)); v1[j] = __builtin_nontemporal_load((const f32x4*)(xr1 + 64 * j)); }
#pragma unroll
            for (int j = 0; j < 4; ++j) { s0 += (v0[j].x * v0[j].x + v0[j].y * v0[j].y) + (v0[j].z * v0[j].z + v0[j].w * v0[j].w); s1 += (v1[j].x * v1[j].x + v1[j].y * v1[j].y) + (v1[j].z * v1[j].z + v1[j].w * v1[j].w); }
            const float r0 = 1.0f / sqrtf(wave_sum(s0) * (1.f / D) + 1e-6f), r1 = 1.0f / sqrtf(wave_sum(s1) * (1.f / D) + 1e-6f);
            GAS u32x2* o0 = (GAS u32x2*)(XN + (size_t)m * D) + F.lane; GAS u32x2* o1 = (GAS u32x2*)(XN + (size_t)m1 * D) + F.lane;
#pragma unroll
            for (int j = 0; j < 4; ++j) { u32x2 w; w.x = cvt_pk_bf16(v0[j].x * r0, v0[j].y * r0); w.y = cvt_pk_bf16(v0[j].z * r0, v0[j].w * r0); o0[64 * j] = w;
                u32x2 w1; w1.x = cvt_pk_bf16(v1[j].x * r1, v1[j].y * r1); w1.y = cvt_pk_bf16(v1[j].z * r1, v1[j].w * r1); o1[64 * j] = w1; }
        }
    }
}

struct EpiInProj {
    static constexpr bool PERM = true, HAS_MID = false;
    bf16_t* PR; bf16_t* UG; bf16_t* GT; const float* bg; int mid_t;
    __device__ __forceinline__ void mid(f32x4 (&)[2][2][4][2], const pg8::Unit&, int, int, int, int) const {}
    __device__ __forceinline__ void operator()(const f32x4 (&acc)[2][2][4][2], const pg8::Unit& u, int wr, int wc, int fr, int fq) const {
        f32x4 b0[2], b1[2];
        if (u.pn >= 9) {
#pragma unroll
            for (int bj = 0; bj < 2; ++bj) { const int gc = (u.pn - 9) * 256 + bj * 128 + wc * 32 + 8 * fq; b0[bj] = *(const f32x4*)(bg + gc); b1[bj] = *(const f32x4*)(bg + gc + 4); } }
#pragma unroll
        for (int ai = 0; ai < 2; ++ai)
#pragma unroll
            for (int m = 0; m < 4; ++m) { const int row = u.pm * 256 + ai * 128 + wr * 64 + m * 16 + fr;
#pragma unroll
                for (int bj = 0; bj < 2; ++bj) { const int cl = bj * 128 + wc * 32 + 8 * fq; const f32x4 v0 = acc[ai][bj][m][0], v1 = acc[ai][bj][m][1]; u32x4 w;
                    if (u.pn < 7) { w.x = cvt_pk_bf16(v0[0], v0[1]); w.y = cvt_pk_bf16(v0[2], v0[3]); w.z = cvt_pk_bf16(v1[0], v1[1]); w.w = cvt_pk_bf16(v1[2], v1[3]);
                        *(u32x4*)(PR + (size_t)row * NRW + u.pn * 256 + cl) = w; }
                    else if (u.pn < 9) { const int cr = (u.pn - 7) * 256 + cl, g = cr >> 4, c0 = cr & 15;
                        w.x = cvt_pk_bf16(v0[0], v0[1]); w.y = cvt_pk_bf16(v0[2], v0[3]); w.z = cvt_pk_bf16(v1[0], v1[1]); w.w = cvt_pk_bf16(v1[2], v1[3]);
                        *(u32x4*)(UG + ((size_t)g * S5ROWS + (row >> 4)) * UGLD + (row & 15) * 16 + c0) = w; }
                    else { const int gc = (u.pn - 9) * 256 + cl;
                        w.x = cvt_pk_bf16(fsigmoid(v0[0] + b0[bj][0]), fsigmoid(v0[1] + b0[bj][1])); w.y = cvt_pk_bf16(fsigmoid(v0[2] + b0[bj][2]), fsigmoid(v0[3] + b0[bj][3]));
                        w.z = cvt_pk_bf16(fsigmoid(v1[0] + b1[bj][0]), fsigmoid(v1[1] + b1[bj][1])); w.w = cvt_pk_bf16(fsigmoid(v1[2] + b1[bj][2]), fsigmoid(v1[3] + b1[bj][3]));
                        __builtin_nontemporal_store(w, (u32x4*)(GT + (size_t)row * 2048 + gc)); } }
                __builtin_amdgcn_sched_barrier(0); }
    }
};
struct FS5Out {
    static constexpr bool PIN = true;
    bf16_t* YSP;
    __device__ __forceinline__ void operator()(const pg8::Unit& u, int r, int cl, f32x4 v0, f32x4 v1) const {
        const int crow = u.pm * 256 + r; u32x4 w;
        w.x = cvt_pk_bf16(fgelu(v0[0]), fgelu(v0[1])); w.y = cvt_pk_bf16(fgelu(v0[2]), fgelu(v0[3])); w.z = cvt_pk_bf16(fgelu(v1[0]), fgelu(v1[1])); w.w = cvt_pk_bf16(fgelu(v1[2]), fgelu(v1[3]));
        *(u32x4*)(YSP + ((size_t)u.pn * S5ROWS + crow) * 256 + cl) = w;
    }
};
struct EpiGlu {
    static constexpr bool PERM = true, HAS_MID = false;
    const bf16_t* YSP; bf16_t* YS; const float* bglu; int mid_t;
    __device__ __forceinline__ void mid(f32x4 (&)[2][2][4][2], const pg8::Unit&, int, int, int, int) const {}
    __device__ __forceinline__ void operator()(const f32x4 (&acc)[2][2][4][2], const pg8::Unit& u, int wr, int wc, int fr, int fq) const {
        u32x4 yv[2][4][2]; f32x4 b0[2], b1[2];
#pragma unroll
        for (int bj = 0; bj < 2; ++bj) { const int col = u.pn * 256 + bj * 128 + wc * 32 + 8 * fq; b0[bj] = *(const f32x4*)(bglu + col); b1[bj] = *(const f32x4*)(bglu + col + 4); }
#pragma unroll
        for (int ai = 0; ai < 2; ++ai)
#pragma unroll
            for (int m = 0; m < 4; ++m)
#pragma unroll
                for (int bj = 0; bj < 2; ++bj) { const int row = u.pm * 256 + ai * 128 + wr * 64 + m * 16 + fr, col = u.pn * 256 + bj * 128 + wc * 32 + 8 * fq;
                    yv[ai][m][bj] = __builtin_nontemporal_load((const u32x4*)(YSP + ((size_t)(col >> 4) * S5ROWS + (row >> 4)) * 256 + (row & 15) * 16 + (col & 15))); }
#pragma unroll
        for (int ai = 0; ai < 2; ++ai)
#pragma unroll
            for (int m = 0; m < 4; ++m) {
#pragma unroll
                for (int bj = 0; bj < 2; ++bj) { const int row = u.pm * 256 + ai * 128 + wr * 64 + m * 16 + fr, col = u.pn * 256 + bj * 128 + wc * 32 + 8 * fq; float y[8]; unpack8(yv[ai][m][bj], y);
                    const f32x4 v0 = acc[ai][bj][m][0], v1 = acc[ai][bj][m][1]; u32x4 w;
                    w.x = cvt_pk_bf16(y[0] * fsigmoid(v0[0] + b0[bj][0]), y[1] * fsigmoid(v0[1] + b0[bj][1])); w.y = cvt_pk_bf16(y[2] * fsigmoid(v0[2] + b0[bj][2]), y[3] * fsigmoid(v0[3] + b0[bj][3]));
                    w.z = cvt_pk_bf16(y[4] * fsigmoid(v1[0] + b1[bj][0]), y[5] * fsigmoid(v1[1] + b1[bj][1])); w.w = cvt_pk_bf16(y[6] * fsigmoid(v1[2] + b1[bj][2]), y[7] * fsigmoid(v1[3] + b1[bj][3]));
                    *(u32x4*)(YS + (size_t)row * D + RW + col) = w; }
                __builtin_amdgcn_sched_barrier(0); }
    }
};
struct FStore {
    static constexpr bool PIN = false;
    bf16_t* O; int ldc;
    __device__ __forceinline__ void operator()(const pg8::Unit& u, int r, int cl, f32x4 v0, f32x4 v1) const {
        u32x4 w; w.x = cvt_pk_bf16(v0[0], v0[1]); w.y = cvt_pk_bf16(v0[2], v0[3]); w.z = cvt_pk_bf16(v1[0], v1[1]); w.w = cvt_pk_bf16(v1[2], v1[3]);
        *(u32x4*)(O + (size_t)(u.pm * 256 + r) * ldc + u.pn * 256 + cl) = w;
    }
};
struct EpiMergeA {
    static constexpr bool PERM = true, HAS_MID = false;
    const bf16_t* GT; bf16_t* O; int mid_t;
    __device__ __forceinline__ void mid(f32x4 (&)[2][2][4][2], const pg8::Unit&, int, int, int, int) const {}
    __device__ __forceinline__ void operator()(const f32x4 (&acc)[2][2][4][2], const pg8::Unit& u, int wr, int wc, int fr, int fq) const {
        u32x4 gv[2][4][2];
#pragma unroll
        for (int ai = 0; ai < 2; ++ai)
#pragma unroll
            for (int m = 0; m < 4; ++m)
#pragma unroll
                for (int bj = 0; bj < 2; ++bj) { const int row = u.pm * 256 + ai * 128 + wr * 64 + m * 16 + fr, col = u.pn * 256 + bj * 128 + wc * 32 + 8 * fq;
                    gv[ai][m][bj] = __builtin_nontemporal_load((const u32x4*)(GT + (size_t)row * 2048 + col)); }
#pragma unroll
        for (int ai = 0; ai < 2; ++ai)
#pragma unroll
            for (int m = 0; m < 4; ++m) {
#pragma unroll
                for (int bj = 0; bj < 2; ++bj) { const int row = u.pm * 256 + ai * 128 + wr * 64 + m * 16 + fr, col = u.pn * 256 + bj * 128 + wc * 32 + 8 * fq; float g[8]; unpack8(gv[ai][m][bj], g);
                    const f32x4 v0 = acc[ai][bj][m][0], v1 = acc[ai][bj][m][1]; u32x4 w;
                    w.x = cvt_pk_bf16(v0[0] * g[0], v0[1] * g[1]); w.y = cvt_pk_bf16(v0[2] * g[2], v0[3] * g[3]); w.z = cvt_pk_bf16(v1[0] * g[4], v1[1] * g[5]); w.w = cvt_pk_bf16(v1[2] * g[6], v1[3] * g[7]);
                    *(u32x4*)(O + (size_t)row * D + col) = w; }
                __builtin_amdgcn_sched_barrier(0); }
    }
};
struct EpiMergeB {
    static constexpr bool PERM = true, HAS_MID = false;
    const bf16_t* GT; bf16_t* O; int mid_t;
    __device__ __forceinline__ void mid(f32x4 (&)[2][2][4][2], const pg8::Unit&, int, int, int, int) const {}
    __device__ __forceinline__ void operator()(const f32x4 (&acc)[2][2][4][2], const pg8::Unit& u, int wr, int wc, int fr, int fq) const {
#pragma unroll
        for (int ai = 0; ai < 2; ++ai) {
            u32x4 gv[4][2], tv[4][2];
#pragma unroll
            for (int m = 0; m < 4; ++m)
#pragma unroll
                for (int bj = 0; bj < 2; ++bj) { const int row = u.pm * 256 + ai * 128 + wr * 64 + m * 16 + fr, col = u.pn * 256 + bj * 128 + wc * 32 + 8 * fq;
                    gv[m][bj] = __builtin_nontemporal_load((const u32x4*)(GT + (size_t)row * 2048 + 1024 + col)); tv[m][bj] = *(const u32x4*)(O + (size_t)row * D + col); }
            __builtin_amdgcn_sched_barrier(0);
#pragma unroll
            for (int m = 0; m < 4; ++m) {
#pragma unroll
                for (int bj = 0; bj < 2; ++bj) { const int row = u.pm * 256 + ai * 128 + wr * 64 + m * 16 + fr, col = u.pn * 256 + bj * 128 + wc * 32 + 8 * fq; float g[8], t1[8]; unpack8(gv[m][bj], g); unpack8(tv[m][bj], t1);
                    const f32x4 v0 = acc[ai][bj][m][0], v1 = acc[ai][bj][m][1]; u32x4 w;
                    w.x = cvt_pk_bf16(t1[0] + v0[0] * g[0], t1[1] + v0[1] * g[1]); w.y = cvt_pk_bf16(t1[2] + v0[2] * g[2], t1[3] + v0[3] * g[3]);
                    w.z = cvt_pk_bf16(t1[4] + v1[0] * g[4], t1[5] + v1[1] * g[5]); w.w = cvt_pk_bf16(t1[6] + v1[2] * g[6], t1[7] + v1[3] * g[7]);
                    *(u32x4*)(O + (size_t)row * D + col) = w; }
                __builtin_amdgcn_sched_barrier(0); }
        }
    }
};
struct UpOrder {
    const bf16_t* H2; const bf16_t* Wt; int G, c;
    __device__ bool next(int i, pg8::Unit& u) const {
        constexpr int nM = NB * 16, nN = 22, nwg = nM * nN;
        const long L = (long)i * G + c; if (L >= nwg) return false;
        int wgid = (int)L; { const int q = nwg / 8, r = nwg % 8, xcd = wgid % 8, off = wgid / 8; wgid = (xcd < r ? xcd * (q + 1) : r * (q + 1) + (xcd - r) * q) + off; }
        const int nig = 8 * nN, gid = wgid / nig, fm = gid * 8, gsz = (nM - fm) < 8 ? (nM - fm) : 8;
        u.pm = fm + ((wgid % nig) % gsz); u.pn = (wgid % nig) / gsz;
        u.a = (const char*)H2 + ((size_t)u.pm * 256 * D) * 2; u.b = (const char*)(Wt + (size_t)u.pn * 256 * D); return true;
    }
};
template <int CTRL> __device__ __forceinline__ unsigned dppu(unsigned v) { return (unsigned)__builtin_amdgcn_update_dpp(0, (int)v, CTRL, 0xf, 0xf, true); }
struct EpiConvAct {
    static constexpr bool PERM = true, HAS_MID = false;
    bf16_t* ACT; const float* cw; const float* cb; LAS unsigned* EX; unsigned long long* HZ; unsigned* tmo; int mid_t;
    __device__ __forceinline__ void mid(f32x4 (&)[2][2][4][2], const pg8::Unit&, int, int, int, int) const {}
    __device__ __forceinline__ void operator()(f32x4 (&acc)[2][2][4][2], const pg8::Unit& u, int wr, int wc, int fr, int fq) const {
        const int b = u.pm >> 4, k = u.pm & 15, t0 = 256 * k;
        u32x2 zp[2][2][4][2];
#pragma unroll
        for (int ai = 0; ai < 2; ++ai)
#pragma unroll
            for (int bj = 0; bj < 2; ++bj)
#pragma unroll
                for (int m = 0; m < 4; ++m)
#pragma unroll
                    for (int n = 0; n < 2; ++n) { const f32x4 v = acc[ai][bj][m][n]; u32x2 w; w.x = cvt_pk_bf16(v[0], v[1]); w.y = cvt_pk_bf16(v[2], v[3]); zp[ai][bj][m][n] = w; }
        if (fr >= 14) {
#pragma unroll
            for (int ai = 0; ai < 2; ++ai)
#pragma unroll
                for (int bj = 0; bj < 2; ++bj)
#pragma unroll
                    for (int n = 0; n < 2; ++n) *(LAS u32x2*)(EX + (((wc * 4 + 2 * ai + wr) * 2 + (fr - 14)) * 32 + bj * 16 + fq * 4 + n * 2)) = zp[ai][bj][3][n]; }
        if (wr == 1 && k < 15 && fr >= 14) {
            unsigned long long* hz = HZ + ((size_t)(u.pm * 22 + u.pn) * 8 + wc * 2 + (fr - 14)) * 32;
#pragma unroll
            for (int bj = 0; bj < 2; ++bj)
#pragma unroll
                for (int n = 0; n < 2; ++n) { __hip_atomic_store(hz + bj * 16 + fq * 4 + n * 2, (1ull << 32) | zp[1][bj][3][n].x, RLX_AGENT); __hip_atomic_store(hz + bj * 16 + fq * 4 + n * 2 + 1, (1ull << 32) | zp[1][bj][3][n].y, RLX_AGENT); }
        }
        asm volatile("s_waitcnt lgkmcnt(0)" ::: "memory"); __builtin_amdgcn_s_barrier(); asm volatile("" ::: "memory");
        const int ch0 = u.pn * 128 + wc * 32 + 8 * fq;
        f32x4 wg[2][3], wv[2][3], bg[2], bv[2];
#pragma unroll
        for (int n = 0; n < 2; ++n) {
#pragma unroll
            for (int j = 0; j < 3; ++j) { wg[n][j] = *(const f32x4*)(cw + (size_t)j * 2 * FF + ch0 + 4 * n); wv[n][j] = *(const f32x4*)(cw + (size_t)j * 2 * FF + FF + ch0 + 4 * n); }
            bg[n] = *(const f32x4*)(cb + ch0 + 4 * n); bv[n] = *(const f32x4*)(cb + FF + ch0 + 4 * n); }
#pragma unroll
        for (int gi = 1; gi <= 8; ++gi) {
            const int ai = (gi & 7) >> 2, m = gi & 3, blk = 2 * ai + wr;
            u32x2 pp[2][2];
#pragma unroll
            for (int bj = 0; bj < 2; ++bj)
#pragma unroll
                for (int n = 0; n < 2; ++n) { pp[bj][n].x = 0u; pp[bj][n].y = 0u; }
            if (m > 0) {
#pragma unroll
                for (int bj = 0; bj < 2; ++bj)
#pragma unroll
                    for (int n = 0; n < 2; ++n) pp[bj][n] = zp[ai][bj][m - 1][n];
            } else if (blk > 0) {
                if (fr >= 14) {
#pragma unroll
                    for (int bj = 0; bj < 2; ++bj)
#pragma unroll
                        for (int n = 0; n < 2; ++n) pp[bj][n] = *(LAS const u32x2*)(EX + (((wc * 4 + blk - 1) * 2 + (fr - 14)) * 32 + bj * 16 + fq * 4 + n * 2)); }
            } else if (k > 0) {
                if (fr >= 14) {
                    const unsigned long long* hz = HZ + ((size_t)((u.pm - 1) * 22 + u.pn) * 8 + wc * 2 + (fr - 14)) * 32;
#pragma unroll
                    for (int bj = 0; bj < 2; ++bj)
#pragma unroll
                        for (int n = 0; n < 2; ++n) { unsigned long long x0, x1; unsigned sp_ = 0;
                            for (;;) { x0 = __hip_atomic_load(hz + bj * 16 + fq * 4 + n * 2, RLX_AGENT); x1 = __hip_atomic_load(hz + bj * 16 + fq * 4 + n * 2 + 1, RLX_AGENT);
                                if ((x0 >> 32) == 1ull && (x1 >> 32) == 1ull) break; __builtin_amdgcn_s_sleep(2); if (++sp_ > (1u << 20)) { __hip_atomic_store(tmo, 1u, RLX_AGENT); break; } }
                            pp[bj][n].x = (unsigned)x0; pp[bj][n].y = (unsigned)x1; } }
            }
            u32x2 outp[2];
#pragma unroll
            for (int n = 0; n < 2; ++n) {
                const u32x2 zg = zp[ai][0][m][n], zv = zp[ai][1][m][n], pg = pp[0][n], pv = pp[1][n];
                u32x2 g1, g2, v1, v2;
                g1.x = dppu<0x111>(zg.x) | dppu<0x10F>(pg.x); g1.y = dppu<0x111>(zg.y) | dppu<0x10F>(pg.y); g2.x = dppu<0x112>(zg.x) | dppu<0x10E>(pg.x); g2.y = dppu<0x112>(zg.y) | dppu<0x10E>(pg.y);
                v1.x = dppu<0x111>(zv.x) | dppu<0x10F>(pv.x); v1.y = dppu<0x111>(zv.y) | dppu<0x10F>(pv.y); v2.x = dppu<0x112>(zv.x) | dppu<0x10E>(pv.x); v2.y = dppu<0x112>(zv.y) | dppu<0x10E>(pv.y);
                const float z0g[4] = {bf_lo(zg.x), bf_hi(zg.x), bf_lo(zg.y), bf_hi(zg.y)}, z1g[4] = {bf_lo(g1.x), bf_hi(g1.x), bf_lo(g1.y), bf_hi(g1.y)}, z2g[4] = {bf_lo(g2.x), bf_hi(g2.x), bf_lo(g2.y), bf_hi(g2.y)};
                const float z0v[4] = {bf_lo(zv.x), bf_hi(zv.x), bf_lo(zv.y), bf_hi(zv.y)}, z1v[4] = {bf_lo(v1.x), bf_hi(v1.x), bf_lo(v1.y), bf_hi(v1.y)}, z2v[4] = {bf_lo(v2.x), bf_hi(v2.x), bf_lo(v2.y), bf_hi(v2.y)};
                float o[4];
#pragma unroll
                for (int e = 0; e < 4; ++e) { const float cg = bg[n][e] + wg[n][0][e] * z2g[e] + wg[n][1][e] * z1g[e] + wg[n][2][e] * z0g[e], cv = bv[n][e] + wv[n][0][e] * z2v[e] + wv[n][1][e] * z1v[e] + wv[n][2][e] * z0v[e];
                    o[e] = fgelu(cg) * cv; }
                outp[n].x = cvt_pk_bf16(o[0], o[1]); outp[n].y = cvt_pk_bf16(o[2], o[3]);
            }
            const int r = 128 * ai + 64 * wr + 16 * m + fr;
            { u32x4 w4; w4.x = outp[0].x; w4.y = outp[0].y; w4.z = outp[1].x; w4.w = outp[1].y; *(u32x4*)(ACT + ((size_t)(b * SEQ + t0 + r)) * FF + ch0) = w4; }
            __builtin_amdgcn_sched_barrier(0);
        }
    }
};
struct EpiRowStat {
    static constexpr bool PERM = true, HAS_MID = false; bf16_t* O; float* STAT; int mid_t;
    __device__ __forceinline__ void mid(f32x4 (&)[2][2][4][2], const pg8::Unit&, int, int, int, int) const {}
    __device__ __forceinline__ void operator()(const f32x4 (&acc)[2][2][4][2], const pg8::Unit& u, int wr, int wc, int fr, int fq) const {
#pragma unroll
        for (int ai = 0; ai < 2; ++ai)
#pragma unroll
            for (int m = 0; m < 4; ++m) { const int row = u.pm * 256 + ai * 128 + wr * 64 + m * 16 + fr; float s = 0.f;
#pragma unroll
                for (int bj = 0; bj < 2; ++bj) { const int col = u.pn * 256 + bj * 128 + wc * 32 + 8 * fq; const f32x4 v0 = acc[ai][bj][m][0], v1 = acc[ai][bj][m][1]; u32x4 w;
                    s += (v0[0] * v0[0] + v0[1] * v0[1]) + (v0[2] * v0[2] + v0[3] * v0[3]) + (v1[0] * v1[0] + v1[1] * v1[1]) + (v1[2] * v1[2] + v1[3] * v1[3]);
                    w.x = cvt_pk_bf16(v0[0], v0[1]); w.y = cvt_pk_bf16(v0[2], v0[3]); w.z = cvt_pk_bf16(v1[0], v1[1]); w.w = cvt_pk_bf16(v1[2], v1[3]);
                    __builtin_nontemporal_store(w, (u32x4*)(O + (size_t)row * D + col)); }
                s += __shfl_xor(s, 16); s += __shfl_xor(s, 32);
                if (fq == 0) STAT[(size_t)row * 16 + u.pn * 4 + wc] = s; }
    }
};
struct EpiSloc {
    static constexpr bool PERM = false, HAS_MID = false; float* SL; int mid_t;
    __device__ __forceinline__ void mid(f32x4 (&)[2][2][4][2], const pg8::Unit&, int, int, int, int) const {}
    __device__ __forceinline__ void operator()(const f32x4 (&acc)[2][2][4][2], const pg8::Unit& u, int wr, int wc, int fr, int fq) const {
#pragma unroll
        for (int ai = 0; ai < 2; ++ai)
#pragma unroll
            for (int m = 0; m < 4; ++m) { const int row = u.pm * 256 + ai * 128 + wr * 64 + m * 16 + fr; float* p = SL + ((size_t)u.pn * S5ROWS + row) * 128 + wc * 32 + 4 * fq;
                *(f32x4*)(p) = acc[ai][0][m][0]; *(f32x4*)(p + 16) = acc[ai][0][m][1]; }
    }
};
struct S5Order {
    const bf16_t* UG; const bf16_t* Bt; int ldb, G, c;
    __device__ bool next(int i, pg8::Unit& u) const { const int L = i * G + c; if (L >= S5G * 8) return false; const int g = L >> 3; u.pm = L & 7; u.pn = g;
        u.a = (const char*)(UG + ((size_t)g * S5ROWS + u.pm * 256) * UGLD); u.b = (const char*)(Bt + (size_t)g * 256 * ldb); return true; }
};

constexpr int LW = 72;
constexpr int SLOT = 64 * LW * 2;
#define SL(i) ((i) * SLOT)
#define BAR_LDS() do { asm volatile("s_waitcnt lgkmcnt(0)" ::: "memory"); __builtin_amdgcn_s_barrier(); asm volatile("" ::: "memory"); } while (0)
struct LdsMat { LAS const unsigned char* p; int ld; __device__ __forceinline__ bf16x8 frag(int row, int k) const { return *(LAS const bf16x8*)(p + ((size_t)row * ld + k) * 2); } };
struct GlbMat { const bf16_t* p; int ld; __device__ __forceinline__ bf16x8 frag(int row, int k) const { return *(const bf16x8*)(p + (size_t)row * ld + k); } };
template <int KD, class YM, class XM, class EPI>
__device__ __forceinline__ void mm64(const YM& Y, const XM& X, int wid, int lane, const EPI& epi) {
    asm volatile("" : "+v"(lane), "+s"(wid));
    const int at = wid >> 1, bt0 = (wid & 1) * 2, fr = lane & 15, fq = lane >> 4;
    f32x4 acc[2] = {(f32x4){0.f, 0.f, 0.f, 0.f}, (f32x4){0.f, 0.f, 0.f, 0.f}};
#pragma unroll
    for (int s = 0; s < KD / 32; ++s) {
        const bf16x8 yf = Y.frag(16 * at + fr, 32 * s + 8 * fq);
#pragma unroll
        for (int bi = 0; bi < 2; ++bi) { const bf16x8 xf = X.frag(16 * (bt0 + bi) + fr, 32 * s + 8 * fq);
            acc[bi] = __builtin_amdgcn_mfma_f32_16x16x32_bf16(xf, yf, acc[bi], 0, 0, 0); }
    }
#pragma unroll
    for (int bi = 0; bi < 2; ++bi) epi(16 * at + fr, 16 * (bt0 + bi) + 4 * fq, acc[bi]);
}
__device__ __forceinline__ void ld_yf(const LdsMat& Y, int at, int fr, int fq, bf16x8 (&y)[2]) {
#pragma unroll
    for (int s = 0; s < 2; ++s) y[s] = Y.frag(16 * at + fr, 32 * s + 8 * fq);
}
__device__ __forceinline__ void ld_xf(const LdsMat& X, int bt0, int fr, int fq, bf16x8 (&x)[2][2]) {
#pragma unroll
    for (int s = 0; s < 2; ++s)
#pragma unroll
        for (int bi = 0; bi < 2; ++bi) x[s][bi] = X.frag(16 * (bt0 + bi) + fr, 32 * s + 8 * fq);
}
__device__ __forceinline__ void mm_f(const bf16x8 (&y)[2], const bf16x8 (&x)[2][2], f32x4 (&acc)[2]) {
#pragma unroll
    for (int bi = 0; bi < 2; ++bi) acc[bi] = (f32x4){0.f, 0.f, 0.f, 0.f};
#pragma unroll
    for (int s = 0; s < 2; ++s)
#pragma unroll
        for (int bi = 0; bi < 2; ++bi) acc[bi] = __builtin_amdgcn_mfma_f32_16x16x32_bf16(x[s][bi], y[s], acc[bi], 0, 0, 0);
}
template <int KD>
__device__ __forceinline__ void preload_x(const GlbMat& X, int wid, int lane, bf16x8 (&xf)[KD / 32][2]) {
    const int bt0 = (wid & 1) * 2, fr = lane & 15, fq = lane >> 4;
#pragma unroll
    for (int s = 0; s < KD / 32; ++s)
#pragma unroll
        for (int bi = 0; bi < 2; ++bi) xf[s][bi] = X.frag(16 * (bt0 + bi) + fr, 32 * s + 8 * fq);
}
template <int KD, class YM, class EPI>
__device__ __forceinline__ void mm64_pre(const YM& Y, const bf16x8 (&xf)[KD / 32][2], int wid, int lane, const EPI& epi) {
    const int at = wid >> 1, bt0 = (wid & 1) * 2, fr = lane & 15, fq = lane >> 4;
    f32x4 acc[2] = {(f32x4){0.f, 0.f, 0.f, 0.f}, (f32x4){0.f, 0.f, 0.f, 0.f}};
#pragma unroll
    for (int s = 0; s < KD / 32; ++s) {
        const bf16x8 yf = Y.frag(16 * at + fr, 32 * s + 8 * fq);
#pragma unroll
        for (int bi = 0; bi < 2; ++bi) acc[bi] = __builtin_amdgcn_mfma_f32_16x16x32_bf16(xf[s][bi], yf, acc[bi], 0, 0, 0);
    }
#pragma unroll
    for (int bi = 0; bi < 2; ++bi) epi(16 * at + fr, 16 * (bt0 + bi) + 4 * fq, acc[bi]);
}
__device__ __forceinline__ void st_lds4(LAS unsigned char* base, int a, int b0, f32x4 v) { u32x2 w; w.x = cvt_pk_bf16(v[0], v[1]); w.y = cvt_pk_bf16(v[2], v[3]); *(LAS u32x2*)(base + ((size_t)a * LW + b0) * 2) = w; }
__device__ __forceinline__ f32x4 ld_lds4(LAS const unsigned char* base, int a, int b0) { const u32x2 w = *(LAS const u32x2*)(base + ((size_t)a * LW + b0) * 2); return (f32x4){bf_lo(w.x), bf_hi(w.x), bf_lo(w.y), bf_hi(w.y)}; }
__device__ __forceinline__ void st_glb4p(bf16_t* base, int a, int b0, f32x4 v) { u32x2 w; w.x = cvt_pk_bf16(v[0], v[1]); w.y = cvt_pk_bf16(v[2], v[3]); __builtin_nontemporal_store(w, (u32x2*)(base + (size_t)a * GLD + b0)); }
__device__ __forceinline__ void st_glb4(bf16_t* base, int a, int b0, f32x4 v) { u32x2 w; w.x = cvt_pk_bf16(v[0], v[1]); w.y = cvt_pk_bf16(v[2], v[3]); __builtin_nontemporal_store(w, (u32x2*)(base + (size_t)a * 64 + b0)); }

struct PrePf { u32x4 qa[3], qp[3], ra[4], rp[4], wt[4]; };
__device__ __forceinline__ void rwkv_pre_fetch(Frame& F, int unit, bool lr_first, PrePf& P, int tid) {
    const int bh = unit >> 6, c = unit & 63, b = bh >> 3, h = bh & 7;
    const int t = tid >> 3, jb = tid & 7, j0 = jb * 8;
    const int tg = b * SEQ + c * 64 + t;
    const bool hasprev = (c * 64 + t) > 0;
    const bf16_t* prow = (const bf16_t*)(F.ws + WS_PR) + (size_t)tg * NRW; const bf16_t* pprv = hasprev ? prow - NRW : prow;
#pragma unroll
    for (int seg = 0; seg < 3; ++seg) { const int col = seg * 512 + h * 64 + j0; P.qa[seg] = *(const u32x4*)(prow + col); P.qp[seg] = *(const u32x4*)(pprv + col); }
    const u32x4* scr = (const u32x4*)(F.ws + WS_LRSCR) + ((size_t)F.vcu * 512 + tid) * 4;
    const u32x4* pa = lr_first ? (const u32x4*)(prow + 1536 + jb * 32) : scr; const u32x4* pp = lr_first ? (const u32x4*)(pprv + 1536 + jb * 32) : scr;
#pragma unroll
    for (int q4 = 0; q4 < 4; ++q4) { P.ra[q4] = pa[q4]; P.rp[q4] = pp[q4]; }
    P.wt[0] = ((const u32x4*)(F.ws + WS_W2T) + (size_t)h * 512)[tid]; P.wt[1] = ((const u32x4*)(F.ws + WS_A2T) + (size_t)h * 512)[tid];
    P.wt[2] = ((const u32x4*)(F.ws + WS_G2T) + (size_t)h * 1024)[tid]; P.wt[3] = ((const u32x4*)(F.ws + WS_G2T) + (size_t)h * 1024)[512 + tid];
}
__device__ __forceinline__ void rwkv_pre_put_w(LAS unsigned char* L, const PrePf& P, int tid) {
    const int r8 = tid >> 3, c8 = tid & 7, r16 = tid >> 4, c16 = tid & 15;
    *(LAS u32x4*)(L + SL(10) + ((size_t)r8 * LW + c8 * 8) * 2) = P.wt[0]; *(LAS u32x4*)(L + SL(11) + ((size_t)r8 * LW + c8 * 8) * 2) = P.wt[1];
    *(LAS u32x4*)(L + SL(12) + ((size_t)r16 * 136 + c16 * 8) * 2) = P.wt[2]; *(LAS u32x4*)(L + SL(12) + ((size_t)(32 + r16) * 136 + c16 * 8) * 2) = P.wt[3];
}
__device__ __forceinline__ void rwkv_pre_unit(Frame& F, int unit, int next_unit, bool lr_first, bool next_first, PrePf& P) {
    LAS unsigned char* L = F.lds;
    LAS float* XT = (LAS float*)(F.lds + XTRA_OFF);
    int tid = F.tid; asm volatile("" : "+v"(tid));
    int wid = F.wave; asm volatile("" : "+s"(wid));
    const int lane = tid & 63;
    const int bh = unit >> 6, c = unit & 63, b = bh >> 3, h = bh & 7;
    const int t = tid >> 3, jb = tid & 7, j0 = jb * 8;
    const int tg = b * SEQ + c * 64 + t;
    const bool hasprev = (c * 64 + t) > 0;
    const bf16_t* PR = (const bf16_t*)(F.ws + WS_PR);
    const bf16_t* prow = PR + (size_t)tg * NRW; const bf16_t* pprev = prow - NRW;
    LAS const float* mu = (LAS const float*)(F.lds + XTRA_OFF + 4096);
    LAS const float* par = mu + NRW;
    float rs[8], ks[8], vs[8];
    {
        const int c0 = 1536 + jb * 32;
        const float pmask = hasprev ? 1.f : 0.f;
        f32x4 mq[3][2];
#pragma unroll
        for (int seg = 0; seg < 3; ++seg) { const int col = seg * 512 + h * 64 + j0; mq[seg][0] = *(LAS const f32x4*)(mu + col); mq[seg][1] = *(LAS const f32x4*)(mu + col + 4); }
        LAS unsigned char* dst = (jb < 2) ? (L + SL(0) + ((size_t)t * LW + jb * 32) * 2) : (jb < 4) ? (L + SL(1) + ((size_t)t * LW + (jb - 2) * 32) * 2) : (L + SL(2) + ((size_t)t * 136 + (jb - 4) * 32) * 2);
        u32x4* scr = (u32x4*)(F.ws + WS_LRSCR) + ((size_t)F.vcu * 512 + tid) * 4;
        if (lr_first) {
            f32x4 ma[4][2];
#pragma unroll
            for (int q4 = 0; q4 < 4; ++q4) { ma[q4][0] = *(LAS const f32x4*)(mu + c0 + q4 * 8); ma[q4][1] = *(LAS const f32x4*)(mu + c0 + q4 * 8 + 4); }
#pragma unroll
            for (int q4 = 0; q4 < 4; ++q4) { float x[8], xp[8], o[8]; unpack8(P.ra[q4], x); unpack8(P.rp[q4], xp);
#pragma unroll
                for (int e = 0; e < 8; ++e) { const float mm = e < 4 ? ma[q4][0][e] : ma[q4][1][e - 4]; const float s = x[e] + (xp[e] * pmask - x[e]) * mm;
                    const float ex = __builtin_amdgcn_exp2f((jb < 2 ? 2.88539008178f : -1.44269504089f) * s), rc = __builtin_amdgcn_rcpf(1.0f + ex);
                    o[e] = jb < 2 ? 1.0f - 2.0f * rc : (jb < 4 ? s : rc); }
                const u32x4 w = pack8(o); *(LAS u32x4*)(dst + q4 * 16) = w; scr[q4] = w; }
        } else {
#pragma unroll
            for (int q4 = 0; q4 < 4; ++q4) *(LAS u32x4*)(dst + q4 * 16) = P.ra[q4];
        }
#pragma unroll
        for (int seg = 0; seg < 3; ++seg) { float x[8], xp[8]; unpack8(P.qa[seg], x); unpack8(P.qp[seg], xp);
#pragma unroll
            for (int e = 0; e < 8; ++e) { const float mm = e < 4 ? mq[seg][0][e] : mq[seg][1][e - 4]; const float s = x[e] + (xp[e] * pmask - x[e]) * mm; if (seg == 0) rs[e] = s; else if (seg == 1) ks[e] = s; else vs[e] = s; } }
    }
    BAR_LDS();
    {
        const LdsMat Yw{L + SL(0), LW}, Ya{L + SL(1), LW}, Yg{L + SL(2), 136};
        const LdsMat Xw{L + SL(10), LW}, Xa{L + SL(11), LW}, Xg{L + SL(12), 136};
        mm64<64>(Yw, Xw, wid, lane, [&](int a, int b0, f32x4 v) { *(LAS f32x4*)(L + SL(4) + ((size_t)a * 68 + b0) * 4) = v; });
        mm64<64>(Ya, Xa, wid, lane, [&](int a, int b0, f32x4 v) { *(LAS f32x4*)(L + SL(6) + ((size_t)a * 68 + b0) * 4) = v; });
        mm64<128>(Yg, Xg, wid, lane, [&](int a, int b0, f32x4 v) { *(LAS f32x4*)(L + SL(8) + ((size_t)a * 68 + b0) * 4) = v; });
    }
    BAR_LDS();
    float ld[8], kp[8], av[8], bv[8];
    {
        const int hc = h * 64 + j0;
        float wp[8], ap[8], gg[8], w0[8], a0[8], kkw[8], kaw[8], rk[8];
        *(f32x4*)&wp[0] = *(LAS f32x4*)(L + SL(4) + ((size_t)t * 68 + j0) * 4); *(f32x4*)&wp[4] = *(LAS f32x4*)(L + SL(4) + ((size_t)t * 68 + j0 + 4) * 4);
        *(f32x4*)&ap[0] = *(LAS f32x4*)(L + SL(6) + ((size_t)t * 68 + j0) * 4); *(f32x4*)&ap[4] = *(LAS f32x4*)(L + SL(6) + ((size_t)t * 68 + j0 + 4) * 4);
        *(f32x4*)&gg[0] = *(LAS f32x4*)(L + SL(8) + ((size_t)t * 68 + j0) * 4); *(f32x4*)&gg[4] = *(LAS f32x4*)(L + SL(8) + ((size_t)t * 68 + j0 + 4) * 4);
        *(f32x4*)&w0[0] = *(LAS const f32x4*)(par + 0 + hc); *(f32x4*)&w0[4] = *(LAS const f32x4*)(par + 0 + hc + 4);
        *(f32x4*)&a0[0] = *(LAS const f32x4*)(par + 512 + hc); *(f32x4*)&a0[4] = *(LAS const f32x4*)(par + 512 + hc + 4);
        *(f32x4*)&kkw[0] = *(LAS const f32x4*)(par + 1024 + hc); *(f32x4*)&kkw[4] = *(LAS const f32x4*)(par + 1024 + hc + 4);
        *(f32x4*)&kaw[0] = *(LAS const f32x4*)(par + 1536 + hc); *(f32x4*)&kaw[4] = *(LAS const f32x4*)(par + 1536 + hc + 4);
        *(f32x4*)&rk[0] = *(LAS const f32x4*)(par + 2048 + hc); *(f32x4*)&rk[4] = *(LAS const f32x4*)(par + 2048 + hc + 4);
        float ss = 0.f, bon = 0.f, kkv[8], eta[8];
#pragma unroll
        for (int e = 0; e < 8; ++e) {
            ld[e] = -0.60653065971f * fsigmoid(w0[e] + wp[e]);
            eta[e] = fsigmoid(a0[e] + ap[e]);
            kkv[e] = ks[e] * kkw[e]; ss += kkv[e] * kkv[e];
            kp[e] = ks[e] * (1.0f + (eta[e] - 1.0f) * kaw[e]);
            bon += rs[e] * kp[e] * rk[e];
        }
        ss += __shfl_xor(ss, 1); ss += __shfl_xor(ss, 2); ss += __shfl_xor(ss, 4);
        bon += __shfl_xor(bon, 1); bon += __shfl_xor(bon, 2); bon += __shfl_xor(bon, 4);
        const float inv = __builtin_amdgcn_rcpf(fmaxf(__builtin_amdgcn_sqrtf(ss), 1e-12f));
#pragma unroll
        for (int e = 0; e < 8; ++e) { const float kk = kkv[e] * inv; av[e] = -kk; bv[e] = kk * eta[e]; }
        if (jb == 0) ((float*)(F.ws + WS_BONUS))[(size_t)tg * 8 + h] = bon;
        *(u32x4*)((bf16_t*)(F.ws + WS_GBUF) + (size_t)tg * RW + hc) = pack8(gg);
    }
    float Lc[8];
#pragma unroll
    for (int e = 0; e < 8; ++e) { float x = ld[e];
        float y = __shfl_up(x, 8); if (lane >= 8) x += y;
        y = __shfl_up(x, 16); if (lane >= 16) x += y;
        y = __shfl_up(x, 32); if (lane >= 32) x += y;
        Lc[e] = x; }
    if (lane >= 56) {
#pragma unroll
        for (int e = 0; e < 8; ++e) XT[wid * 64 + j0 + e] = Lc[e]; }
    BAR_LDS();
    {
        float pre[8];
#pragma unroll
        for (int e = 0; e < 8; ++e) pre[e] = 0.f;
#pragma unroll
        for (int w = 0; w < 7; ++w) if (w < wid) { const f32x4 x0 = *(LAS const f32x4*)(XT + w * 64 + j0), x1 = *(LAS const f32x4*)(XT + w * 64 + j0 + 4);
#pragma unroll
            for (int e = 0; e < 4; ++e) { pre[e] += x0[e]; pre[4 + e] += x1[e]; } }
#pragma unroll
        for (int e = 0; e < 8; ++e) Lc[e] += pre[e];
    }
    if (t == 63) {
#pragma unroll
        for (int e = 0; e < 8; ++e) XT[512 + j0 + e] = fexp(Lc[e]); }
    {
        float o0[8], o1[8], o2[8], o3[8];
#pragma unroll
        for (int e = 0; e < 8; ++e) { const float ein = fexp(Lc[e]), eout = __builtin_amdgcn_rcpf(ein), eex = fexp(Lc[e] - ld[e]);
            o0[e] = rs[e] * ein; o1[e] = kp[e] * eout; o2[e] = av[e] * eex; o3[e] = bv[e] * eout; }
        const size_t off = ((size_t)t * LW + j0) * 2;
        *(LAS u32x4*)(L + SL(10) + off) = pack8(o0); *(LAS u32x4*)(L + SL(11) + off) = pack8(o1); *(LAS u32x4*)(L + SL(12) + off) = pack8(o2); *(LAS u32x4*)(L + SL(13) + off) = pack8(o3);
        *(LAS u32x4*)(L + SL(2) + off) = pack8(vs);
    }
    BAR_LDS();
    {
        const int srcs[4] = {12, 13, 11, 2}, dsts[4] = {4, 5, 6, 7};
#pragma unroll
        for (int q = 0; q < 4; ++q) { unsigned short hv[8];
#pragma unroll
            for (int e = 0; e < 8; ++e) hv[e] = *(LAS const unsigned short*)(L + SL(srcs[q]) + ((size_t)(8 * wid + e) * LW + lane) * 2);
            u32x4 w; w.x = hv[0] | ((unsigned)hv[1] << 16); w.y = hv[2] | ((unsigned)hv[3] << 16); w.z = hv[4] | ((unsigned)hv[5] << 16); w.w = hv[6] | ((unsigned)hv[7] << 16);
            *(LAS u32x4*)(L + SL(dsts[q]) + ((size_t)lane * LW + 8 * wid) * 2) = w;
        }
    }
    BAR_LDS();
    if (next_unit < NUNIT) rwkv_pre_fetch(F, next_unit, next_first, P, tid);
    const int crow = tid >> 3, cch = tid & 7;
    __builtin_nontemporal_store(*(LAS const u32x4*)(L + SL(7) + ((size_t)crow * LW + cch * 8) * 2), (u32x4*)((bf16_t*)(F.ws + WS_VT) + (size_t)unit * 4096 + crow * 64 + cch * 8));
    {
        const LdsMat Rt{L + SL(10), LW}, Kt{L + SL(11), LW}, At{L + SL(12), LW}, Bt{L + SL(13), LW};
        f32x4 nd = (f32x4){0.f, 0.f, 0.f, 0.f}, ntd = nd;
        {
            int ln = lane, wd = wid; asm volatile("" : "+v"(ln), "+s"(wd));
            const int at = wd >> 1, bt0 = (wd & 1) * 2, fr = ln & 15, fq = ln >> 4, a = 16 * at + fr;
            bf16x8 yA[2], yK[2], yR[2], xB[2][2], xA[2][2], xK[2][2];
            ld_yf(At, at, fr, fq, yA); ld_xf(Bt, bt0, fr, fq, xB); ld_yf(Kt, at, fr, fq, yK); ld_xf(At, bt0, fr, fq, xA); ld_yf(Rt, at, fr, fq, yR); ld_xf(Kt, bt0, fr, fq, xK);
            const bool diag = bt0 == (at & 2);
            bf16x8 xd[2];
            if (diag) ld_yf(Bt, at, fr, fq, xd);
            f32x4 c0[2], c1[2], c2[2], c3[2];
            mm_f(yA, xB, c0); mm_f(yK, xA, c1); mm_f(yR, xB, c2); mm_f(yR, xK, c3);
            if (diag) {
                f32x4 v = (f32x4){0.f, 0.f, 0.f, 0.f};
#pragma unroll
                for (int s = 0; s < 2; ++s) v = __builtin_amdgcn_mfma_f32_16x16x32_bf16(yA[s], xd[s], v, 0, 0, 0);
#pragma unroll
                for (int e = 0; e < 4; ++e) v[e] = (fr < 4 * fq + e) ? v[e] : 0.f;
                nd = v; }
#pragma unroll
            for (int bi = 0; bi < 2; ++bi) { const int b0 = 16 * (bt0 + bi) + 4 * fq; f32x4 v0 = c0[bi], v1 = c1[bi], v2 = c2[bi], v3 = c3[bi];
#pragma unroll
                for (int e = 0; e < 4; ++e) { v0[e] = (b0 + e < a) ? v0[e] : 0.f; v1[e] = (a < b0 + e) ? v1[e] : 0.f; v2[e] = (b0 + e <= a) ? v2[e] : 0.f; v3[e] = (b0 + e <= a) ? v3[e] : 0.f; }
                st_lds4(L + SL(1), a, b0, v0); st_lds4(L + SL(2), a, b0, v1); st_lds4(L + SL(3), a, b0, v2); st_lds4(L + SL(8), a, b0, v3);
                if (bt0 + bi == at) ntd = v0; }
        }
        const int at = wid >> 1;
        if (((wid & 1) * 2 == (at & 2))) {
            const int fr = lane & 15, fq = lane >> 4;
            auto op = [](f32x4 v) { u32x4 w; w.x = cvt_pk_bf16(v[0], v[1]); w.y = cvt_pk_bf16(v[2], v[3]); w.z = 0u; w.w = 0u; return __builtin_bit_cast(bf16x8, w); };
            const f32x4 zero = (f32x4){0.f, 0.f, 0.f, 0.f};
            const f32x4 Lm = ntd, LT = nd;
            f32x4 Q = Lm;
#pragma unroll
            for (int e = 0; e < 4; ++e) Q[e] += (4 * fq + e == fr) ? 1.f : 0.f;
            const f32x4 L2 = __builtin_amdgcn_mfma_f32_16x16x32_bf16(op(LT), op(Lm), zero, 0, 0, 0), L2T = __builtin_amdgcn_mfma_f32_16x16x32_bf16(op(Lm), op(LT), zero, 0, 0, 0);
            Q = __builtin_amdgcn_mfma_f32_16x16x32_bf16(op(L2T), op(Q), Q, 0, 0, 0);
            const f32x4 L4 = __builtin_amdgcn_mfma_f32_16x16x32_bf16(op(L2T), op(L2), zero, 0, 0, 0), L4T = __builtin_amdgcn_mfma_f32_16x16x32_bf16(op(L2), op(L2T), zero, 0, 0, 0);
            Q = __builtin_amdgcn_mfma_f32_16x16x32_bf16(op(L4T), op(Q), Q, 0, 0, 0);
            const f32x4 L8T = __builtin_amdgcn_mfma_f32_16x16x32_bf16(op(L4), op(L4T), zero, 0, 0, 0);
            Q = __builtin_amdgcn_mfma_f32_16x16x32_bf16(op(L8T), op(Q), Q, 0, 0, 0);
            st_lds4(L + SL(9), 16 * at + fr, 4 * fq, Q);
        }
    }
    BAR_LDS();
    {
        const int fr = lane & 15, fq = lane >> 4;
        LAS const unsigned char* zsl = L + (wid < 4 ? SL(4) : SL(2)); LAS unsigned char* dsl = L + (wid < 4 ? SL(11) : SL(12));
        const int arow = 16 * (wid & 3) + fr;
        u32x2 zp[4];
#pragma unroll
        for (int c = 0; c < 4; ++c) {
            f32x4 acc = ld_lds4(zsl, arow, 16 * c + 4 * fq);
            if (c >= 1) {
                const u32x2 alo = *(LAS const u32x2*)(L + SL(1) + ((size_t)(16 * c + fr) * LW + 4 * fq) * 2), ahi = *(LAS const u32x2*)(L + SL(1) + ((size_t)(16 * c + fr) * LW + 16 + 4 * fq) * 2);
                u32x4 aw; aw.x = alo.x; aw.y = alo.y; aw.z = ahi.x; aw.w = ahi.y;
                u32x4 bw; bw.x = zp[0].x; bw.y = zp[0].y; bw.z = c >= 2 ? zp[1].x : 0u; bw.w = c >= 2 ? zp[1].y : 0u;
                acc = __builtin_amdgcn_mfma_f32_16x16x32_bf16(__builtin_bit_cast(bf16x8, aw), __builtin_bit_cast(bf16x8, bw), acc, 0, 0, 0); }
            if (c == 3) {
                const u32x2 alo = *(LAS const u32x2*)(L + SL(1) + ((size_t)(48 + fr) * LW + 32 + 4 * fq) * 2);
                u32x4 aw; aw.x = alo.x; aw.y = alo.y; aw.z = 0u; aw.w = 0u;
                u32x4 bw; bw.x = zp[2].x; bw.y = zp[2].y; bw.z = 0u; bw.w = 0u;
                acc = __builtin_amdgcn_mfma_f32_16x16x32_bf16(__builtin_bit_cast(bf16x8, aw), __builtin_bit_cast(bf16x8, bw), acc, 0, 0, 0); }
            const u32x2 dlo = *(LAS const u32x2*)(L + SL(9) + ((size_t)(16 * c + fr) * LW + 4 * fq) * 2);
            u32x4 aw; aw.x = dlo.x; aw.y = dlo.y; aw.z = 0u; aw.w = 0u;
            u32x4 bw; bw.x = cvt_pk_bf16(acc[0], acc[1]); bw.y = cvt_pk_bf16(acc[2], acc[3]); bw.z = 0u; bw.w = 0u;
            const f32x4 r = __builtin_amdgcn_mfma_f32_16x16x32_bf16(__builtin_bit_cast(bf16x8, aw), __builtin_bit_cast(bf16x8, bw), (f32x4){0.f, 0.f, 0.f, 0.f}, 0, 0, 0);
            zp[c].x = cvt_pk_bf16(r[0], r[1]); zp[c].y = cvt_pk_bf16(r[2], r[3]);
            *(LAS u32x2*)(dsl + ((size_t)arow * LW + 16 * c + 4 * fq) * 2) = zp[c];
        }
    }
    BAR_LDS();
    {
        const int sAT = 11, sAkT = 12, sHk = 0;
        const LdsMat AT{L + SL(sAT), LW}, AkT{L + SL(sAkT), LW}, AbrT{L + SL(3), LW}, BgT{L + SL(5), LW}, VTm{L + SL(7), LW};
        bf16_t* QRT = (bf16_t*)(F.ws + WS_QRT) + (size_t)unit * 4096; bf16_t* WYT = (bf16_t*)(F.ws + WS_WYT) + (size_t)unit * 4096;
        bf16_t* GTg = (bf16_t*)(F.dout + DO_GT) + (size_t)unit * (64 * GLD); bf16_t* Hg = (bf16_t*)(F.dout + DO_H) + (size_t)unit * (64 * GLD);
        {
            int ln = lane, wd = wid; asm volatile("" : "+v"(ln), "+s"(wd));
            const int at = wd >> 1, bt0 = (wd & 1) * 2, fr = ln & 15, fq = ln >> 4, a = 16 * at + fr;
            bf16x8 yA[2], yB[2], xT[2][2], xK[2][2];
            ld_yf(BgT, at, fr, fq, yB); ld_xf(AkT, bt0, fr, fq, xK); ld_yf(AbrT, at, fr, fq, yA); ld_xf(AT, bt0, fr, fq, xT);
            f32x4 eH[2], eR[2], eW[2];
#pragma unroll
            for (int bi = 0; bi < 2; ++bi) { const int b0 = 16 * (bt0 + bi) + 4 * fq; eH[bi] = ld_lds4(L + SL(6), a, b0); eR[bi] = ld_lds4(L + SL(10), a, b0); eW[bi] = ld_lds4(L + SL(8), a, b0); }
            const float gdiag = XT[512 + a];
            f32x4 cH[2], cQ[2], cW[2], cG[2];
            mm_f(yB, xK, cH); mm_f(yA, xT, cQ); mm_f(yA, xK, cW); mm_f(yB, xT, cG);
#pragma unroll
            for (int bi = 0; bi < 2; ++bi) { const int b0 = 16 * (bt0 + bi) + 4 * fq;
                st_lds4(L + SL(sHk), a, b0, (cH[bi] + eH[bi]) * gdiag);
                st_lds4(L + SL(1), a, b0, cQ[bi] + eR[bi]);
                st_lds4(L + SL(2), a, b0, cW[bi] + eW[bi]);
                f32x4 v = cG[bi];
#pragma unroll
                for (int e = 0; e < 4; ++e) v[e] += (b0 + e == a) ? 1.f : 0.f;
                st_lds4(L + SL(4), a, b0, v * gdiag); }
        }
        BAR_LDS();
        const LdsMat HkT{L + SL(sHk), LW};
        mm64<64>(VTm, HkT, wid, lane, [&](int a, int b0, f32x4 v) { st_lds4(L + SL(9), a, b0, v); });
        __builtin_nontemporal_store(*(LAS const u32x4*)(L + SL(1) + ((size_t)crow * LW + cch * 8) * 2), (u32x4*)(QRT + crow * 64 + cch * 8));
        __builtin_nontemporal_store(*(LAS const u32x4*)(L + SL(2) + ((size_t)crow * LW + cch * 8) * 2), (u32x4*)(WYT + crow * 64 + cch * 8));
        __builtin_nontemporal_store(*(LAS const u32x4*)(L + SL(4) + (size_t)tid * 16), (u32x4*)GTg + tid);
        if (tid < 64) __builtin_nontemporal_store(*(LAS const u32x4*)(L + SL(4) + (size_t)(512 + tid) * 16), (u32x4*)GTg + 512 + tid);
        if (next_unit < NUNIT) rwkv_pre_put_w(L, P, tid);
        BAR_LDS();
        __builtin_nontemporal_store(*(LAS const u32x4*)(L + SL(9) + (size_t)tid * 16), (u32x4*)Hg + tid);
        if (tid < 64) __builtin_nontemporal_store(*(LAS const u32x4*)(L + SL(9) + (size_t)(512 + tid) * 16), (u32x4*)Hg + 512 + tid);
    }
}

constexpr int RS_SLOT = 12 * 1024;
constexpr int RS_DEPTH = 8, RS_AHEAD = 6;
__device__ __forceinline__ void rwkv_scan_block(Frame& F, int item) {
    const int bh = item >> 2, qi = item & 3, lane = F.lane, fr = lane & 15, fq = lane >> 4, wid = F.wave;
    const char* GTg = (const char*)(F.dout + DO_GT) + (size_t)bh * 64 * (64 * GLD * 2);
    const char* Hg = (const char*)(F.dout + DO_H) + (size_t)bh * 64 * (64 * GLD * 2) + (size_t)qi * (16 * GLD * 2);
    bf16_t* SST = (bf16_t*)(F.dout + DO_SST) + (size_t)bh * 64 * 4096;
    LAS unsigned char* L = F.lds;
    auto issue = [&](int c) {
        if (wid >= 1) {
            LAS unsigned char* slot = L + (c & (RS_DEPTH - 1)) * RS_SLOT;
#pragma unroll
            for (int k = 0; k < 2; ++k) { const int pc = (wid - 1) + 7 * k;
                if (pc < 12) {
                    const char* src;
                    if (pc < 9) src = GTg + (size_t)c * (64 * GLD * 2) + pc * 1024 + lane * 16;
                    else { int off = (pc - 9) * 1024 + lane * 16; off = off > 2304 - 16 ? 2304 - 16 : off; src = Hg + (size_t)c * (64 * GLD * 2) + off; }
                    __builtin_amdgcn_global_load_lds((const unsigned*)src, (LAS unsigned*)(slot + pc * 1024), 16, 0, 0); } }
        }
    };
    f32x4 acc[4];
#pragma unroll
    for (int mt = 0; mt < 4; ++mt) acc[mt] = (f32x4){0.f, 0.f, 0.f, 0.f};
#pragma unroll 1
    for (int c = 0; c < RS_AHEAD; ++c) issue(c);
#pragma unroll 1
    for (int c = 0; c < NCH; ++c) {
        if (c + RS_AHEAD < NCH) issue(c + RS_AHEAD);
        if (c + RS_AHEAD < NCH) { if (wid >= 1 && wid <= 5) asm volatile("s_waitcnt vmcnt(12)" ::: "memory"); else if (wid >= 6) asm volatile("s_waitcnt vmcnt(6)" ::: "memory"); }
        else if (wid >= 1) asm volatile("s_waitcnt vmcnt(0)" ::: "memory");
        __builtin_amdgcn_s_barrier(); asm volatile("" ::: "memory");
        if (wid == 0) {
            LAS const unsigned char* slot = L + (c & (RS_DEPTH - 1)) * RS_SLOT;
            u32x2 ga[4][2][2], hv[4];
#pragma unroll
            for (int mt = 0; mt < 4; ++mt) {
#pragma unroll
                for (int s = 0; s < 2; ++s)
#pragma unroll
                    for (int hh = 0; hh < 2; ++hh) ga[mt][s][hh] = *(LAS const u32x2*)(slot + ((16 * mt + fr) * GLD + 16 * (2 * s + hh) + 4 * fq) * 2);
                hv[mt] = *(LAS const u32x2*)(slot + 9216 + (fr * GLD + 16 * mt + 4 * fq) * 2); }
            bf16_t* Sc = SST + (size_t)c * 4096; u32x2 sp[4];
#pragma unroll
            for (int mt = 0; mt < 4; ++mt) { sp[mt].x = cvt_pk_bf16(acc[mt][0], acc[mt][1]); sp[mt].y = cvt_pk_bf16(acc[mt][2], acc[mt][3]);
                *(u32x2*)(Sc + (size_t)(16 * qi + fr) * 64 + 16 * mt + 4 * fq) = sp[mt]; }
            bf16x8 sb[2];
#pragma unroll
            for (int s = 0; s < 2; ++s) { u32x4 w; w.x = sp[2 * s].x; w.y = sp[2 * s].y; w.z = sp[2 * s + 1].x; w.w = sp[2 * s + 1].y; sb[s] = __builtin_bit_cast(bf16x8, w); }
#pragma unroll
            for (int mt = 0; mt < 4; ++mt) { f32x4 a = (f32x4){bf_lo(hv[mt].x), bf_hi(hv[mt].x), bf_lo(hv[mt].y), bf_hi(hv[mt].y)};
#pragma unroll
                for (int s = 0; s < 2; ++s) { u32x4 w; w.x = ga[mt][s][0].x; w.y = ga[mt][s][0].y; w.z = ga[mt][s][1].x; w.w = ga[mt][s][1].y;
                    a = __builtin_amdgcn_mfma_f32_16x16x32_bf16(__builtin_bit_cast(bf16x8, w), sb[s], a, 0, 0, 0); }
                acc[mt] = a; }
            asm volatile("s_waitcnt lgkmcnt(0)" ::: "memory");
        }
    }
    asm volatile("s_waitcnt vmcnt(0)" ::: "memory");
    __builtin_amdgcn_s_barrier(); asm volatile("" ::: "memory");
}
__device__ __forceinline__ void s5_scan_block(Frame& F, int gb) {
    const int g = gb >> 3, b = gb & 7, p = F.lane, w = F.wave;
    const float* aL = (const float*)(F.ws + WS_AL) + g * 128; const float ar = aL[2 * p], ai = aL[2 * p + 1];
    const float* SLc = (const float*)(F.ws + WS_SLOC) + ((size_t)g * S5ROWS + b * 256 + 32 * w) * 128 + 2 * p;
    bf16_t* UG = (bf16_t*)(F.ws + WS_UG) + ((size_t)g * S5ROWS + b * 256 + 32 * w) * UGLD + 256 + 2 * p;
    LAS float* E = (LAS float*)(F.lds);
    f32x2 l[32];
#pragma unroll
    for (int k = 0; k < 32; ++k) l[k] = *(const f32x2*)(SLc + (size_t)k * 128);
    float sr = 0.f, si = 0.f;
#pragma unroll
    for (int k = 0; k < 32; ++k) { const float nr = ar * sr - ai * si + l[k].x, ni = ar * si + ai * sr + l[k].y; l[k].x = sr; l[k].y = si; sr = nr; si = ni; }
    E[(w * 64 + p) * 2] = sr; E[(w * 64 + p) * 2 + 1] = si;
    float pr = ar, pi = ai;
#pragma unroll
    for (int q = 0; q < 5; ++q) { const float nr = pr * pr - pi * pi, ni = 2.f * pr * pi; pr = nr; pi = ni; }
    asm volatile("s_waitcnt lgkmcnt(0)" ::: "memory"); __builtin_amdgcn_s_barrier(); asm volatile("" ::: "memory");
    float cr = 0.f, ci = 0.f;
#pragma unroll
    for (int w2 = 0; w2 < 7; ++w2) { if (w2 < w) { const float er = E[(w2 * 64 + p) * 2], ei = E[(w2 * 64 + p) * 2 + 1]; const float nr = pr * cr - pi * ci + er, ni = pr * ci + pi * cr + ei; cr = nr; ci = ni; } }
#pragma unroll
    for (int k = 0; k < 32; ++k) { *(unsigned*)(UG + (size_t)k * UGLD) = cvt_pk_bf16(l[k].x + cr, l[k].y + ci); const float nr = ar * cr - ai * ci, ni = ar * ci + ai * cr; cr = nr; ci = ni; }
    asm volatile("s_waitcnt lgkmcnt(0)" ::: "memory"); __builtin_amdgcn_s_barrier(); asm volatile("" ::: "memory");
}
struct OutY { bf16x8 yq[2], yw[2]; u32x2 pv[4], pp[4], gv[4]; float bon; };
__device__ __forceinline__ void rwkv_out_loady(Frame& F, int unit, int at, OutY& Lq) {
    const int lane = F.lane, fr = lane & 15, fq = lane >> 4;
    const int bh = unit >> 6, c = unit & 63, b = bh >> 3, h = bh & 7;
    const bf16_t* QRT = (const bf16_t*)(F.ws + WS_QRT) + (size_t)unit * 4096; const bf16_t* WYT = (const bf16_t*)(F.ws + WS_WYT) + (size_t)unit * 4096;
#pragma unroll
    for (int s = 0; s < 2; ++s) { Lq.yq[s] = __builtin_nontemporal_load((const bf16x8*)(QRT + (size_t)(16 * at + fr) * 64 + 32 * s + 8 * fq)); Lq.yw[s] = __builtin_nontemporal_load((const bf16x8*)(WYT + (size_t)(16 * at + fr) * 64 + 32 * s + 8 * fq)); }
    const int tl = c * 64 + 16 * at + fr, tg = b * SEQ + tl;
    const bf16_t* prow = (const bf16_t*)(F.ws + WS_PR) + (size_t)tg * NRW + 1024 + h * 64;
    const bf16_t* gb = (const bf16_t*)(F.ws + WS_GBUF) + (size_t)tg * RW + h * 64;
    Lq.bon = ((const float*)(F.ws + WS_BONUS))[(size_t)tg * 8 + h];
    const bf16_t* pprev = prow - (tl > 0 ? NRW : 0);
#pragma unroll
    for (int bt = 0; bt < 4; ++bt) { const int i0 = 16 * bt + 4 * fq; Lq.pv[bt] = *(const u32x2*)(prow + i0); Lq.pp[bt] = *(const u32x2*)(pprev + i0); Lq.gv[bt] = *(const u32x2*)(gb + i0); }
}
__device__ __forceinline__ void rwkv_out_comp(Frame& F, int unit, int at, const bf16x8 (&xs)[2][4], const bf16x8 (&xv)[2][4], const OutY& Lq) {
    const int lane = F.lane, fr = lane & 15, fq = lane >> 4;
    const int bh = unit >> 6, c = unit & 63, b = bh >> 3, h = bh & 7;
    f32x4 m4[4], lw[4], lb[4];
#pragma unroll
    for (int bt = 0; bt < 4; ++bt) { const int i0 = 16 * bt + 4 * fq; m4[bt] = *(const f32x4*)(F.in[I_MU] + 1024 + h * 64 + i0); lw[bt] = *(const f32x4*)(F.in[I_LNW] + h * 64 + i0); lb[bt] = *(const f32x4*)(F.in[I_LNB] + h * 64 + i0); }
    f32x4 acc[4];
#pragma unroll
    for (int bt = 0; bt < 4; ++bt) acc[bt] = (f32x4){0.f, 0.f, 0.f, 0.f};
#pragma unroll
    for (int s = 0; s < 2; ++s)
#pragma unroll
        for (int bt = 0; bt < 4; ++bt) {
            acc[bt] = __builtin_amdgcn_mfma_f32_16x16x32_bf16(xs[s][bt], Lq.yq[s], acc[bt], 0, 0, 0);
            acc[bt] = __builtin_amdgcn_mfma_f32_16x16x32_bf16(xv[s][bt], Lq.yw[s], acc[bt], 0, 0, 0); }
    float s1 = 0.f;
#pragma unroll
    for (int bt = 0; bt < 4; ++bt) s1 += (acc[bt][0] + acc[bt][1]) + (acc[bt][2] + acc[bt][3]);
    s1 += __shfl_xor(s1, 16); s1 += __shfl_xor(s1, 32);
    const float mean = s1 * (1.f / 64.f); float s2 = 0.f;
#pragma unroll
    for (int bt = 0; bt < 4; ++bt) { const f32x4 d = acc[bt] - mean; s2 += (d[0] * d[0] + d[1] * d[1]) + (d[2] * d[2] + d[3] * d[3]); }
    s2 += __shfl_xor(s2, 16); s2 += __shfl_xor(s2, 32);
    const float rstd = __builtin_amdgcn_rsqf(s2 * (1.f / 64.f) + 64e-5f);
    const int tl = c * 64 + 16 * at + fr, tg = b * SEQ + tl;
    const float pmask = tl > 0 ? 1.f : 0.f;
    bf16_t* YRS = (bf16_t*)(F.dout + DO_YRS) + (size_t)tg * D + h * 64;
#pragma unroll
    for (int bt = 0; bt < 4; ++bt) { const int i0 = 16 * bt + 4 * fq;
        const u32x2 pv = Lq.pv[bt], pp = Lq.pp[bt], gv = Lq.gv[bt];
        const float x[4] = {bf_lo(pv.x), bf_hi(pv.x), bf_lo(pv.y), bf_hi(pv.y)}, xp[4] = {bf_lo(pp.x) * pmask, bf_hi(pp.x) * pmask, bf_lo(pp.y) * pmask, bf_hi(pp.y) * pmask}, gg[4] = {bf_lo(gv.x), bf_hi(gv.x), bf_lo(gv.y), bf_hi(gv.y)};
        float o[4];
#pragma unroll
        for (int e = 0; e < 4; ++e) { const float vsh = x[e] + (xp[e] - x[e]) * m4[bt][e]; o[e] = ((acc[bt][e] - mean) * rstd * lw[bt][e] + lb[bt][e] + Lq.bon * vsh) * gg[e]; }
        u32x2 w; w.x = cvt_pk_bf16(o[0], o[1]); w.y = cvt_pk_bf16(o[2], o[3]); *(u32x2*)(YRS + i0) = w; }
}
__device__ __forceinline__ void rwkv_out_units(Frame& F) {
    const int lane = F.lane, fr = lane & 15, fq = lane >> 4;
    for (int unit = F.vcu * NWAVES + F.wave; unit < NUNIT; unit += F.G * NWAVES) {
        const bf16_t* VT = (const bf16_t*)(F.ws + WS_VT) + (size_t)unit * 4096; const bf16_t* SST = (const bf16_t*)(F.dout + DO_SST) + (size_t)unit * 4096;
        bf16x8 xs[2][4], xv[2][4]; OutY A, B;
#pragma unroll
        for (int s = 0; s < 2; ++s)
#pragma unroll
            for (int bt = 0; bt < 4; ++bt) { xs[s][bt] = __builtin_nontemporal_load((const bf16x8*)(SST + (size_t)(16 * bt + fr) * 64 + 32 * s + 8 * fq)); xv[s][bt] = __builtin_nontemporal_load((const bf16x8*)(VT + (size_t)(16 * bt + fr) * 64 + 32 * s + 8 * fq)); }
        rwkv_out_loady(F, unit, 0, A); rwkv_out_loady(F, unit, 1, B); __builtin_amdgcn_sched_barrier(0);
        rwkv_out_comp(F, unit, 0, xs, xv, A); __builtin_amdgcn_sched_barrier(0); rwkv_out_loady(F, unit, 2, A); __builtin_amdgcn_sched_barrier(0);
        rwkv_out_comp(F, unit, 1, xs, xv, B); __builtin_amdgcn_sched_barrier(0); rwkv_out_loady(F, unit, 3, B); __builtin_amdgcn_sched_barrier(0);
        rwkv_out_comp(F, unit, 2, xs, xv, A); __builtin_amdgcn_sched_barrier(0);
        rwkv_out_comp(F, unit, 3, xs, xv, B); __builtin_amdgcn_sched_barrier(0);
    }
}

__device__ __forceinline__ void p8_rows(Frame& F) {
    const int gw = F.vcu * NWAVES + F.wave, NGW = F.G * NWAVES, lane = F.lane;
    const bf16_t* MX = (const bf16_t*)(F.ws + WS_MIXED); const float* ST = (const float*)(F.ws + WS_STAT1); bf16_t* H2 = (bf16_t*)(F.ws + WS_H2); float* X1 = (float*)F.dout;
    f32x4 gp[4];
#pragma unroll
    for (int j = 0; j < 4; ++j) gp[j] = *(const f32x4*)(F.in[I_NMPOST] + 256 * j + 4 * lane);
    for (int m0 = gw; m0 < T; m0 += 2 * NGW) {
        int mm[2] = {m0, (m0 + NGW < T) ? m0 + NGW : m0};
        f32x4 xv[2][4]; u32x2 mw[2][4]; float st[2];
#pragma unroll
        for (int q = 0; q < 2; ++q) { st[q] = (lane < 16) ? ST[(size_t)mm[q] * 16 + lane] : 0.f;
#pragma unroll
            for (int j = 0; j < 4; ++j) { const int col = 256 * j + 4 * lane; xv[q][j] = __builtin_nontemporal_load((const f32x4*)(F.in[I_X] + (size_t)mm[q] * D + col)); mw[q][j] = __builtin_nontemporal_load((const u32x2*)(MX + (size_t)mm[q] * D + col)); } }
#pragma unroll
        for (int q = 0; q < 2; ++q) {
            const float rstd1 = __builtin_amdgcn_rsqf(wave_sum(st[q]) * (1.f / D) + 1e-6f);
            f32x4 v[4]; float s = 0.f;
#pragma unroll
            for (int j = 0; j < 4; ++j) { const int col = 256 * j + 4 * lane;
                v[j].x = xv[q][j].x + bf_lo(mw[q][j].x) * rstd1 * gp[j].x; v[j].y = xv[q][j].y + bf_hi(mw[q][j].x) * rstd1 * gp[j].y; v[j].z = xv[q][j].z + bf_lo(mw[q][j].y) * rstd1 * gp[j].z; v[j].w = xv[q][j].w + bf_hi(mw[q][j].y) * rstd1 * gp[j].w;
                s += (v[j].x * v[j].x + v[j].y * v[j].y) + (v[j].z * v[j].z + v[j].w * v[j].w);
                }
            const float rstd2 = __builtin_amdgcn_rsqf(wave_sum(s) * (1.f / D) + 1e-6f);
#pragma unroll
            for (int j = 0; j < 4; ++j) { u32x2 w; w.x = cvt_pk_bf16(v[j].x * rstd2, v[j].y * rstd2); w.y = cvt_pk_bf16(v[j].z * rstd2, v[j].w * rstd2); *(u32x2*)(H2 + (size_t)mm[q] * D + 256 * j + 4 * lane) = w; }
        }
    }
}
__device__ __forceinline__ void p12_rows(Frame& F) {
    const int gw = F.vcu * NWAVES + F.wave, NGW = F.G * NWAVES, lane = F.lane;
    const bf16_t* FB = (const bf16_t*)(F.ws + WS_F); const bf16_t* MX = (const bf16_t*)(F.ws + WS_MIXED);
    const float* ST1 = (const float*)(F.ws + WS_STAT1); const float* ST2 = (const float*)(F.ws + WS_STAT2); float* OUT = (float*)F.dout;
    f32x4 gp[4], gq[4];
#pragma unroll
    for (int j = 0; j < 4; ++j) { gp[j] = *(const f32x4*)(F.in[I_NMPOST] + 256 * j + 4 * lane); gq[j] = *(const f32x4*)(F.in[I_NFPOST] + 256 * j + 4 * lane); }
    for (int m0 = gw; m0 < T; m0 += 2 * NGW) {
        int mm[2] = {m0, (m0 + NGW < T) ? m0 + NGW : m0};
        f32x4 xv[2][4]; u32x2 mw[2][4], fw[2][4]; float s1[2], s2[2];
#pragma unroll
        for (int q = 0; q < 2; ++q) { s1[q] = (lane < 16) ? ST1[(size_t)mm[q] * 16 + lane] : 0.f; s2[q] = (lane < 16) ? ST2[(size_t)mm[q] * 16 + lane] : 0.f;
#pragma unroll
            for (int j = 0; j < 4; ++j) { const int col = 256 * j + 4 * lane; xv[q][j] = __builtin_nontemporal_load((const f32x4*)(F.in[I_X] + (size_t)mm[q] * D + col));
                mw[q][j] = __builtin_nontemporal_load((const u32x2*)(MX + (size_t)mm[q] * D + col)); fw[q][j] = __builtin_nontemporal_load((const u32x2*)(FB + (size_t)mm[q] * D + col)); } }
#pragma unroll
        for (int q = 0; q < 2; ++q) {
            const float rstd1 = __builtin_amdgcn_rsqf(wave_sum(s1[q]) * (1.f / D) + 1e-6f), rstd3 = __builtin_amdgcn_rsqf(wave_sum(s2[q]) * (1.f / D) + 1e-6f);
#pragma unroll
            for (int j = 0; j < 4; ++j) { const int col = 256 * j + 4 * lane; f32x4 o;
                o.x = xv[q][j].x + bf_lo(mw[q][j].x) * rstd1 * gp[j].x; o.y = xv[q][j].y + bf_hi(mw[q][j].x) * rstd1 * gp[j].y; o.z = xv[q][j].z + bf_lo(mw[q][j].y) * rstd1 * gp[j].z; o.w = xv[q][j].w + bf_hi(mw[q][j].y) * rstd1 * gp[j].w;
                o.x += bf_lo(fw[q][j].x) * rstd3 * gq[j].x; o.y += bf_hi(fw[q][j].x) * rstd3 * gq[j].y; o.z += bf_lo(fw[q][j].y) * rstd3 * gq[j].z; o.w += bf_hi(fw[q][j].y) * rstd3 * gq[j].w;
                __builtin_nontemporal_store(o, (f32x4*)(OUT + (size_t)mm[q] * D + col)); }
        }
    }
}

#ifndef MK_PER_PHASE
#define MK_PER_PHASE 0
#endif
constexpr int NPHASE = 12;
struct Args { const float* in[35]; float* out; unsigned char* ws; int ph_lo, ph_hi; };
static_assert(sizeof(Args) == 35 * 8 + 8 + 8 + 8, "Args has no padding");

__device__ __forceinline__ bool phase_begin(Frame& F) { unsigned long long z = 0; asm volatile("" : "+s"(z), "+v"(F.tid)); F.ws = F.ws0 + z; F.dout = F.dout0 + z;     F.lane = F.tid & 63; F.wave = __builtin_amdgcn_readfirstlane(F.tid >> 6); return true; }
__global__ void __launch_bounds__(NWAVES * 64, 2) fwd_kernel(Args args) {
    extern __shared__ __attribute__((aligned(16))) unsigned char lds_raw[];
    Frame F;
    F.lds = (LAS unsigned char*)lds_raw;
    F.MISC = (volatile LAS unsigned*)(F.lds + MISC_OFF);
    F.tid = threadIdx.x; F.lane = F.tid & 63; F.wave = __builtin_amdgcn_readfirstlane(F.tid >> 6);
    F.G = gridDim.x; { const int bx = blockIdx.x; F.vcu = (F.G % 8 == 0) ? (bx % 8) * (F.G / 8) + bx / 8 : bx; }
    F.ws0 = args.ws; F.dout0 = (unsigned char*)args.out; F.ws = F.ws0; F.dout = F.dout0; F.ctl = (gu32*)(args.ws + WS_CTL);
    F.in = (InTab)__builtin_amdgcn_kernarg_segment_ptr();
    for (int u = F.tid; u < (LDS_BYTES - LDSCTL_OFF) / 4; u += NWAVES * 64) ((LAS unsigned*)(F.lds + LDSCTL_OFF))[u] = 0u;
    __syncthreads();
    XcdBarrier bar; bar.bar = (unsigned*)(F.ctl + CW_BAR); bar.x = 0; bar.st = nullptr;
    if (!MK_PER_PHASE) bar = xcd_barrier_post((unsigned*)(F.ctl + CW_BAR), F.MISC + 8);
    const int lo = args.ph_lo, hi = args.ph_hi;
#ifndef PHMASK
#define PHMASK 0xffffffffu
#endif
#define IN(k) (((PHMASK >> (k)) & 1u) && lo <= (k) && (k) < hi && phase_begin(F))
#ifndef REPMASK
#define REPMASK 0u
#endif
#define REPS(k) ((((REPMASK) >> (k)) & 1u) ? 2 : 1)
#define PH(k) for (int rep_ = 0; rep_ < REPS(k); ++rep_, (rep_ < REPS(k) ? xcd_barrier(bar) : (void)0))
#define INQ(k) (lo <= (k) && (k) < hi)
#define SEAM(k) do { if (INQ(k) && INQ((k) + 1)) xcd_barrier(bar); } while (0)
#define WSB(off) ((bf16_t*)(F.ws + (off)))
    const int bx = (int)blockIdx.x;

    PH(0) if (IN(0)) { p0_prologue(F); }
    SEAM(0);
    PH(1) if (IN(1)) {
        pg8::Gemm g{D, D, D, 0}; pg8::StaticOrder S; S.init(WSB(WS_XN), WSB(WS_WIN), D, D, T, NIN, F.G, bx);
        EpiInProj E{WSB(WS_PR), WSB(WS_UG), WSB(WS_GATES), F.in[I_BGATE], 0};
        pg8::gemm_phase<EpiInProj, pg8::StaticOrder, true>(F.lds, g, S, E, F.tid);
    }
    SEAM(1);
    PH(2) if (IN(2)) {
        PrePf pf;
        if (F.vcu < NB * NCH) { rwkv_pre_fetch(F, (((F.vcu >> 6) * NHEAD) << 6) + (F.vcu & 63), true, pf, F.tid); rwkv_pre_put_w(F.lds, pf, F.tid); }
        {
            LAS f32x4* TB = (LAS f32x4*)(F.lds + XTRA_OFF + 4096);
            if (F.tid < NRW / 4) TB[F.tid] = ((const f32x4*)F.in[I_MU])[F.tid];
            const int pq = F.tid >> 7, pi = F.tid & 127;
            const float* psrc = pq == 0 ? F.in[I_W0] : pq == 1 ? F.in[I_A0] : pq == 2 ? F.in[I_KK] : F.in[I_KA];
            TB[NRW / 4 + F.tid] = ((const f32x4*)psrc)[pi];
            if (F.tid < 128) TB[NRW / 4 + 512 + F.tid] = ((const f32x4*)F.in[I_RK])[F.tid];
            BAR_LDS();
        }
        for (int pc = F.vcu; pc < NB * NCH; pc += F.G) {
#pragma unroll 1
            for (int hh = 0; hh < NHEAD; ++hh) { const int bq = pc >> 6, cq = pc & 63, u = ((bq * NHEAD + hh) << 6) + cq;
                const int un = (hh < NHEAD - 1) ? u + 64 : ((pc + F.G < NB * NCH) ? ((((pc + F.G) >> 6) * NHEAD) << 6) + ((pc + F.G) & 63) : NUNIT);
                rwkv_pre_unit(F, u, un, hh == 0, hh == NHEAD - 1, pf); } }
        BAR_LDS();
        pg8::Gemm g{256, UGLD, 256, 0}; S5Order S{WSB(WS_UG), WSB(WS_B1A), 256, F.G, bx};
        EpiSloc E{(float*)(F.ws + WS_SLOC), 0};
        pg8::gemm_phase<EpiSloc, S5Order, true>(F.lds, g, S, E, F.tid);
    }
    SEAM(2);
    PH(3) if (IN(3)) {
        for (int gb = F.vcu; gb < S5G * NB; gb += F.G) s5_scan_block(F, gb);
        for (int it = F.vcu; it < NB * NHEAD * 4; it += F.G) rwkv_scan_block(F, it);
    }
    SEAM(3);
    PH(4) if (IN(4)) {
        rwkv_out_units(F);
        VM_WAIT(); __syncthreads();
        pg8::Gemm g{384, UGLD, 384, 0}; S5Order S{WSB(WS_UG), WSB(WS_B1B), 384, F.G, bx};
        pg8::EpiGen8<FS5Out> E{FS5Out{WSB(WS_YSP)}, 0};
        pg8::gemm_phase<pg8::EpiGen8<FS5Out>, S5Order, true>(F.lds, g, S, E, F.tid);
    }
    SEAM(4);
    PH(5) if (IN(5)) {
        pg8::Gemm g{RW, RW, RW, 1}; pg8::StaticOrder S; S.init(WSB(WS_YSP), WSB(WS_WGLU), RW, RW, T, RW, F.G, bx); S.tstepA = (size_t)16 * 256 * 2;
        EpiGlu E{WSB(WS_YSP), (bf16_t*)(F.dout + DO_YRS), F.in[I_BGLU], 0};
        pg8::gemm_phase<EpiGlu, pg8::StaticOrder, true>(F.lds, g, S, E, F.tid);
    }
    SEAM(5);
    PH(6) if (IN(6)) {
        pg8::Gemm g{RW, D, D, 0};
        { pg8::StaticOrder S; S.init((const bf16_t*)(F.dout + DO_YRS), WSB(WS_WBRS), D, D, T, D, F.G, bx);
          EpiMergeA E{WSB(WS_GATES), WSB(WS_MERGED), 0};
          pg8::gemm_phase<EpiMergeA, pg8::StaticOrder, true>(F.lds, g, S, E, F.tid); }
        { pg8::StaticOrder S; S.init((const bf16_t*)(F.dout + DO_YRS) + RW, WSB(WS_WBRS) + RW, D, D, T, D, F.G, bx);
          EpiMergeB E{WSB(WS_GATES), WSB(WS_MERGED), 0};
          pg8::gemm_phase<EpiMergeB, pg8::StaticOrder, true>(F.lds, g, S, E, F.tid); }
    }
    SEAM(6);
    PH(7) if (IN(7)) {
        pg8::Gemm g{D, D, D, 0}; pg8::StaticOrder S; S.init(WSB(WS_MERGED), WSB(WS_WOUT), D, D, T, D, F.G, bx);
        EpiRowStat E{WSB(WS_MIXED), (float*)(F.ws + WS_STAT1), 0};
        pg8::gemm_phase<EpiRowStat, pg8::StaticOrder, false>(F.lds, g, S, E, F.tid);
    }
    SEAM(7);
    PH(8) if (IN(8)) { p8_rows(F);
        for (size_t i = (size_t)bx * 512 + F.tid; i < HZ_BYTES / 16; i += (size_t)F.G * 512) ((u32x4*)(F.ws + WS_HZ))[i] = (u32x4){0u, 0u, 0u, 0u}; }
    SEAM(8);
    PH(9) if (IN(9)) {
        pg8::Gemm g{D, D, D, 0}; UpOrder S{WSB(WS_H2), WSB(WS_WUP), F.G, bx};
        EpiConvAct E{WSB(WS_ACT), F.in[I_CONVW], F.in[I_CONVB], (LAS unsigned*)(F.lds + XTRA_OFF), (unsigned long long*)(F.ws + WS_HZ), (unsigned*)(F.ctl + 2), 0};
        pg8::gemm_phase<EpiConvAct, UpOrder, true>(F.lds, g, S, E, F.tid);
    }
    SEAM(9);
    PH(10) if (IN(10)) {
        pg8::Gemm g{FF, FF, FF, 0}; pg8::StaticOrder S; S.init(WSB(WS_ACT), WSB(WS_WDN), FF, FF, T, D, F.G, bx);
        EpiRowStat E{WSB(WS_F), (float*)(F.ws + WS_STAT2), 0};
        pg8::gemm_phase<EpiRowStat, pg8::StaticOrder, false>(F.lds, g, S, E, F.tid);
    }
    SEAM(10);
    if (IN(11)) p12_rows(F);
#undef IN
#undef INQ
#undef SEAM
#undef WSB
}

extern "C" void kernel_launch(void* const* d_in, const int* in_sizes, int n_in, void* d_out, int out_size, void* d_ws, size_t ws_size, hipStream_t stream) {
    static int grid = 0;
    if (grid == 0) {
        if (n_in != 35 || in_sizes[0] != T * D || out_size != T * D || ws_size < WS_END) { fprintf(stderr, "kernel_launch: unexpected shapes: n_in %d in0 %d out %d ws %zu (need %zu)\n", n_in, n_in > 0 ? in_sizes[0] : -1, out_size, ws_size, (size_t)WS_END); grid = -1; return; }
        int dev = 0, cus = 0, per_cu = 0;
        if (hipGetDevice(&dev) != hipSuccess || hipDeviceGetAttribute(&cus, hipDeviceAttributeMultiprocessorCount, dev) != hipSuccess) { fprintf(stderr, "kernel_launch: device query failed\n"); grid = -1; return; }
        if (hipFuncSetAttribute((const void*)fwd_kernel, hipFuncAttributeMaxDynamicSharedMemorySize, LDS_BYTES) != hipSuccess) { fprintf(stderr, "kernel_launch: hipFuncSetAttribute failed\n"); grid = -1; return; }
        if (hipOccupancyMaxActiveBlocksPerMultiprocessor(&per_cu, (const void*)fwd_kernel, NWAVES * 64, LDS_BYTES) != hipSuccess || per_cu < 1) fprintf(stderr, "kernel_launch: occupancy query reports %d blocks per CU\n", per_cu);
        (void)hipGetLastError();
        grid = cus;
    }
    if (grid < 0) return;
    if (hipMemsetAsync((char*)d_ws + WS_CTL, 0, CTL_ZERO_BYTES, stream) != hipSuccess) { fprintf(stderr, "kernel_launch: memset failed\n"); return; }
    Args a{};
    for (int i = 0; i < 35; ++i) a.in[i] = (const float*)d_in[i];
    a.out = (float*)d_out; a.ws = (unsigned char*)d_ws;
#if MK_PER_PHASE
    for (int ph = 0; ph < NPHASE; ++ph) { a.ph_lo = ph; a.ph_hi = ph + 1; hipLaunchKernelGGL(fwd_kernel, dim3(grid), dim3(NWAVES * 64), LDS_BYTES, stream, a); }
#else
    a.ph_lo = 0; a.ph_hi = NPHASE;
    hipLaunchKernelGGL(fwd_kernel, dim3(grid), dim3(NWAVES * 64), LDS_BYTES, stream, a);
#endif
    const hipError_t le = hipPeekAtLastError();
    if (le != hipSuccess) fprintf(stderr, "kernel_launch: launch failed: %s\n", hipGetErrorName(le));
}
```

```cpp
#include <hip/hip_runtime.h>
#include <cstdio>
#include <cstdint>

#define LAS __attribute__((address_space(3)))
#define GAS __attribute__((address_space(1)))
typedef unsigned short bf16_t;
typedef short bf16x8 __attribute__((ext_vector_type(8)));
typedef float f32x4 __attribute__((ext_vector_type(4)));
typedef float f32x2 __attribute__((ext_vector_type(2)));
typedef unsigned u32x4 __attribute__((ext_vector_type(4)));
typedef unsigned u32x2 __attribute__((ext_vector_type(2)));
typedef GAS unsigned gu32;

constexpr int T = 32768, SEQ = 4096, NB = 8, D = 1024, NIN = 4352, NRW = 1792, RW = 512, FF = 2816, FH = 1408;
constexpr int NHEAD = 8, HD = 64, NCH = 64  , NUNIT = NB * NHEAD * NCH;
constexpr int S5G = 32, S5ROWS = T / 16, UGLD = 384;

constexpr size_t MiB = 1u << 20;
constexpr size_t WS_CTL = 0, CTL_ZERO_BYTES = 1 * MiB;
constexpr size_t WS_WIN = 1 * MiB;
constexpr size_t WS_WUP = WS_WIN + (size_t)NIN * D * 2;
constexpr size_t WS_WDN = WS_WUP + (size_t)2 * FF * D * 2;
constexpr size_t WS_WOUT = WS_WDN + (size_t)D * FF * 2;
constexpr size_t WS_WBRS = WS_WOUT + (size_t)D * D * 2;
constexpr size_t WS_WGLU = WS_WBRS + (size_t)D * D * 2;
constexpr size_t WS_W2T = WS_WGLU + (size_t)RW * RW * 2;
constexpr size_t WS_A2T = WS_W2T + (size_t)RW * 64 * 2;
constexpr size_t WS_G2T = WS_A2T + (size_t)RW * 64 * 2;
constexpr size_t WS_B1A = WS_G2T + (size_t)RW * 128 * 2;
constexpr size_t WS_B1B = WS_B1A + (size_t)S5G * 256 * 256 * 2;
constexpr size_t WS_AL = WS_B1B + (size_t)S5G * 256 * 384 * 2;
constexpr size_t WS_WEND = WS_AL + (size_t)S5G * 64 * 2 * 4;
static_assert(WS_WEND <= 44 * MiB, "weights region");
constexpr size_t WS_XN = 44 * MiB;
constexpr size_t WS_QRT = 44 * MiB, WS_WYT = 76 * MiB;
constexpr size_t WS_MERGED = 44 * MiB, WS_H2 = 44 * MiB, WS_F = 44 * MiB;
constexpr size_t WS_PR = 108 * MiB;
constexpr size_t WS_MIXED = 304 * MiB, WS_STAT1 = 368 * MiB;
constexpr size_t WS_ACT = 108 * MiB;
constexpr size_t WS_STAT2 = 284 * MiB;
constexpr size_t WS_UG = 220 * MiB;
constexpr size_t WS_GATES = 268 * MiB;
constexpr size_t WS_SLOC = 396 * MiB, WS_YSP = 396 * MiB;
constexpr size_t WS_GBUF = 428 * MiB;
constexpr size_t WS_BONUS = 460 * MiB;
constexpr size_t WS_VT = 461 * MiB;
constexpr size_t WS_LRSCR = 493 * MiB;
constexpr size_t WS_Z = 336 * MiB;
constexpr size_t WS_END = 512 * MiB;
constexpr size_t DO_H = 0, DO_GT = 36 * MiB, DO_SST = 96 * MiB, DO_YRS = 0;
constexpr int GLD = 72;

constexpr int CW_BAR = 4096, CW_HF = 32768, CW_XNQ = 64;
constexpr size_t WS_HZ = 290 * MiB, HZ_BYTES = (size_t)2816 * 4 * 2 * 32 * 8;

constexpr int RING_BYTES = 131072, LDSCTL_OFF = RING_BYTES, MISC_OFF = LDSCTL_OFF + 320, XTRA_OFF = LDSCTL_OFF + 1024, LDS_BYTES = 155648;
constexpr int NWAVES = 8;

#define RLX_AGENT __ATOMIC_RELAXED, __HIP_MEMORY_SCOPE_AGENT
#define LDS_WAIT() asm volatile("s_waitcnt lgkmcnt(0)" ::: "memory")
#define VM_WAIT() asm volatile("s_waitcnt vmcnt(0)" ::: "memory")

typedef __bf16 bf16x2_t __attribute__((ext_vector_type(2)));
__device__ __forceinline__ unsigned cvt_pk_bf16(float lo, float hi) { const f32x2 v = {lo, hi}; return __builtin_bit_cast(unsigned, __builtin_convertvector(v, bf16x2_t)); }
__device__ __forceinline__ float bf_lo(unsigned w) { return __uint_as_float(w << 16); }
__device__ __forceinline__ float bf_hi(unsigned w) { return __uint_as_float(w & 0xffff0000u); }
__device__ __forceinline__ float bf1(bf16_t h) { return __uint_as_float((unsigned)h << 16); }
__device__ __forceinline__ float fexp(float x) { return __builtin_amdgcn_exp2f(x * 1.44269504089f); }
__device__ __forceinline__ float fsigmoid(float x) { return __builtin_amdgcn_rcpf(1.0f + __builtin_amdgcn_exp2f(-1.44269504089f * x)); }
__device__ __forceinline__ float ftanh(float x) { return 1.0f - 2.0f * __builtin_amdgcn_rcpf(1.0f + __builtin_amdgcn_exp2f(2.88539008178f * x)); }
__device__ __forceinline__ float fgelu(float x) { const float u = 0.7978845608f * (x + 0.044715f * x * x * x); return x * fsigmoid(2.0f * u); }
__device__ __forceinline__ void unpack8(u32x4 w, float (&f)[8]) { f[0] = bf_lo(w.x); f[1] = bf_hi(w.x); f[2] = bf_lo(w.y); f[3] = bf_hi(w.y); f[4] = bf_lo(w.z); f[5] = bf_hi(w.z); f[6] = bf_lo(w.w); f[7] = bf_hi(w.w); }
__device__ __forceinline__ u32x4 pack8(const float (&f)[8]) { u32x4 w; w.x = cvt_pk_bf16(f[0], f[1]); w.y = cvt_pk_bf16(f[2], f[3]); w.z = cvt_pk_bf16(f[4], f[5]); w.w = cvt_pk_bf16(f[6], f[7]); return w; }
__device__ __forceinline__ float wave_sum(float v) {
#pragma unroll
    for (int o = 1; o < 64; o <<= 1) v += __shfl_xor(v, o);
    return v;
}

#define XB_TMO      128
#define XB_XCNT(j)  (256  + 64 * (j))
#define XB_XSUB(j)  (1280 + 64 * (j))
#define XB_XGEN(j)  (2304 + 64 * (j))
#define XB_TOP      3328
#define XB_TOPGEN   3392
#define XCD_BAR_WORDS 3456
#define XB_SPIN_CAP (1u << 18)
__device__ __forceinline__ unsigned xb_ld(unsigned* p)              { return __hip_atomic_load(p, __ATOMIC_RELAXED, __HIP_MEMORY_SCOPE_AGENT); }
__device__ __forceinline__ unsigned xb_add(unsigned* p, unsigned v) { return __hip_atomic_fetch_add(p, v, __ATOMIC_RELAXED, __HIP_MEMORY_SCOPE_AGENT); }
__device__ __forceinline__ unsigned xb_xcc_id() { return (unsigned)__builtin_amdgcn_s_getreg((3 << 11) | 20) & 0xFu; }
#define XB_SPIN(cond, bar) do { unsigned _sp = 0; while (cond) { __builtin_amdgcn_s_sleep(1); \
    if ((++_sp & 255u) == 0u) { if (xb_ld(&(bar)[XB_TMO])) break; if (_sp > XB_SPIN_CAP) { atomicAdd(&(bar)[XB_TMO], 1u); break; } } } } while (0)
struct XcdBarrier { unsigned* bar; unsigned x; volatile LAS unsigned* st; };
__device__ __forceinline__ XcdBarrier xcd_barrier_post(unsigned* bar, volatile LAS unsigned* st) {
    XcdBarrier b; b.bar = bar; b.x = xb_xcc_id(); b.st = st;
    if (threadIdx.x == 0) (void)xb_add(&bar[XB_XCNT(b.x)], 1u);
    return b;
}
__device__ __forceinline__ void xcd_barrier_complete(unsigned* bar, unsigned x, unsigned& nloc, unsigned& nx) {
    const unsigned G = gridDim.x * gridDim.y * gridDim.z;
    unsigned sum, cnt, mine, sp = 0u;
    for (;;) {
        sum = 0u; cnt = 0u; mine = 0u;
#pragma unroll
        for (unsigned j = 0; j < 16; ++j) { const unsigned c = xb_ld(&bar[XB_XCNT(j)]); sum += c; cnt += (c > 0u) ? 1u : 0u; mine = (j == x) ? c : mine; }
        if (sum == G) break;
        __builtin_amdgcn_s_sleep(1);
        if ((++sp & 255u) == 0u) { if (xb_ld(&bar[XB_TMO])) break; if (sp > XB_SPIN_CAP) { atomicAdd(&bar[XB_TMO], 1u); break; } }
    }
    nloc = mine > 0u ? mine : 1u; nx = cnt > 0u ? cnt : 1u;
}
__device__ __forceinline__ void xcd_barrier(const XcdBarrier& b) {
    asm volatile("s_waitcnt vmcnt(0)" ::: "memory");
    __syncthreads();
    if (threadIdx.x == 0) {
        unsigned* bar = b.bar;
        __builtin_amdgcn_s_waitcnt(0);
        unsigned nloc = b.st[0], nx = b.st[1];
        if (nloc == 0u) { xcd_barrier_complete(bar, b.x, nloc, nx); b.st[0] = nloc; b.st[1] = nx; }
        const unsigned old = xb_add(&bar[XB_XSUB(b.x)], 1u);
        const unsigned gen = old / nloc;
        if (old + 1u == (gen + 1u) * nloc) {
            __builtin_amdgcn_fence(__ATOMIC_RELEASE, "agent");
            asm volatile("s_waitcnt vmcnt(0)" ::: "memory");
            const unsigned og = xb_add(&bar[XB_TOP], 1u);
            const unsigned tg = og / nx;
            if (og + 1u == (tg + 1u) * nx) xb_add(&bar[XB_TOPGEN], 1u);
            else XB_SPIN(xb_ld(&bar[XB_TOPGEN]) == tg, bar);
            __builtin_amdgcn_fence(__ATOMIC_ACQUIRE, "agent");
            xb_add(&bar[XB_XGEN(b.x)], 1u);
            asm volatile("s_waitcnt vmcnt(0)" ::: "memory");
        } else {
            XB_SPIN(xb_ld(&bar[XB_XGEN(b.x)]) == gen, bar);
            __builtin_amdgcn_fence(__ATOMIC_ACQUIRE, "agent");
            asm volatile("s_waitcnt vmcnt(0)" ::: "memory");
        }
    }
    __syncthreads();
}

namespace pg8 {
constexpr int BM = 256, BK = 64, HALF = 128, HTB = HALF * BK * 2, STAGE_BYTES = 8 * HTB, NXCD = 8, WGM = 8;
__host__ __device__ __forceinline__ int lds_byte(int r, int c) { const int st = (r >> 4) * 2 + (c >> 5), rr = r & 15, cc = c & 31, ob = rr * 64 + cc * 2; return st * 1024 + (ob ^ (((ob >> 9) & 1) << 5)); }
__host__ __device__ __forceinline__ void stage_rc(int b, int& R, int& C) { const int st = b / 1024, sb = b % 1024, swz = sb ^ (((sb >> 9) & 1) << 5); R = (st >> 1) * 16 + swz / 64; C = (st & 1) * 32 + (swz % 64) / 2; }
__host__ __device__ __forceinline__ int perm32(int rho) { const int n = rho >> 4, i = rho & 15; return 8 * (i >> 2) + 4 * n + (i & 3); }

struct Unit { const char* a; const char* b; int pm, pn; };
struct Gemm { int K, lda, ldb, amode; };

struct StaticOrder {
    const bf16_t* A; const bf16_t* Bt; int lda, ldb;
    int nM, nN, nwg, G, c; size_t tstepA;
    __device__ void init(const bf16_t* A_, const bf16_t* Bt_, int lda_, int ldb_, int M, int N, int G_, int c_) { A = A_; Bt = Bt_; lda = lda_; ldb = ldb_; nM = M / BM; nN = N / BM; nwg = nM * nN; G = G_; c = c_; tstepA = (size_t)BM * lda * 2; }
    __device__ bool next(int i, Unit& u) const {
        const long L = (long)i * G + c; if (L >= nwg) return false;
        int wgid = (int)L; { const int q = nwg / NXCD, r = nwg % NXCD, xcd = wgid % NXCD, off = wgid / NXCD; wgid = (xcd < r ? xcd * (q + 1) : r * (q + 1) + (xcd - r) * q) + off; }
        const int nig = WGM * nN, gid = wgid / nig, fm = gid * WGM, gsz = (nM - fm) < WGM ? (nM - fm) : WGM;
        u.pm = fm + ((wgid % nig) % gsz); u.pn = (wgid % nig) / gsz;
        u.a = (const char*)A + (size_t)u.pm * tstepA; u.b = (const char*)Bt + (size_t)u.pn * BM * ldb * 2; return true;
    }
};

template <class Epi, class Sched, bool ALIGN_EPI = false, bool SP2 = true>
__device__ __forceinline__ void gemm_phase(LAS unsigned char* lds, const Gemm g, const Sched& S, const Epi& E, const int tid) {
    const int wid = __builtin_amdgcn_readfirstlane(tid >> 6), lane = tid & 63, wr = wid >> 2, wc = wid & 3, fr = lane & 15, fq = lane >> 4;
    const int K = g.K, nt = K / BK;
    unsigned voffA[2], voffB[2];
#pragma unroll
    for (int i = 0; i < 2; ++i) { int R, C; stage_rc(tid * 16 + i * 8192, R, C); const int Rb = Epi::PERM ? ((R & ~31) + perm32(R & 31)) : R;
        voffA[i] = g.amode ? (unsigned)((((C >> 4) * S5ROWS + (R >> 4)) * 256 + (R & 15) * 16 + (C & 15)) * 2) : (unsigned)(R * g.lda + C) * 2u; voffB[i] = (unsigned)(Rb * g.ldb + C) * 2u; }
    const size_t kstepB = (size_t)(BK * 2), kstepA = g.amode ? (size_t)4 * S5ROWS * 256 * 2 : (size_t)(BK * 2);
    const size_t hstepA = g.amode ? (size_t)8 * 256 * 2 : (size_t)HALF * g.lda * 2, hstepB = (size_t)HALF * g.ldb * 2;
    const unsigned ldsw = (unsigned)wid * 1024u;
    const int aoff = lds_byte(wr * 64 + fr, fq * 8), boff = lds_byte(wc * 32 + fr, fq * 8);
#define PG8_SA(b, h) (((b) * 2 + (h)) * HTB)
#define PG8_SB(b, h) ((4 + (b) * 2 + (h)) * HTB)
#define PG8_STAGE(bufoff, gbase, voff) do { _Pragma("unroll") for (int _i = 0; _i < 2; ++_i) \
        __builtin_amdgcn_global_load_lds((const unsigned*)((const char*)(gbase) + (voff)[_i]), (LAS unsigned*)(lds + (bufoff) + ldsw + _i * 8192), 16, 0, 0); } while (0)
#define PG8_LDA(dst, b, h) do { _Pragma("unroll") for (int m = 0; m < 4; ++m) _Pragma("unroll") for (int k = 0; k < 2; ++k) dst[m][k] = *(const LAS bf16x8*)(lds + PG8_SA(b, h) + aoff + m * 2048 + k * 1024); } while (0)
#define PG8_LDB(dst, b, h) do { _Pragma("unroll") for (int n = 0; n < 2; ++n) _Pragma("unroll") for (int k = 0; k < 2; ++k) dst[n][k] = *(const LAS bf16x8*)(lds + PG8_SB(b, h) + boff + n * 2048 + k * 1024); } while (0)
#define PG8_MMA(ai, bj, At, Bt) do { __builtin_amdgcn_s_setprio(1); _Pragma("unroll") for (int m = 0; m < 4; ++m) _Pragma("unroll") for (int n = 0; n < 2; ++n) _Pragma("unroll") for (int k = 0; k < 2; ++k) \
        acc[ai][bj][m][n] = __builtin_amdgcn_mfma_f32_16x16x32_bf16(Bt[n][k], At[m][k], acc[ai][bj][m][n], 0, 0, 0); __builtin_amdgcn_s_setprio(0); } while (0)
#define PG8_WAIT_V(n) asm volatile("s_waitcnt vmcnt(" #n ")" ::: "memory")
#define PG8_WAIT_L(n) asm volatile("s_waitcnt lgkmcnt(" #n ")" ::: "memory")
#define PG8_BAR __builtin_amdgcn_s_barrier()
#define PG8_SCHED __builtin_amdgcn_sched_barrier(0)
    Unit cur, nxt; int ui = 0;
    if (!S.next(0, cur)) return;
    f32x4 acc[2][2][4][2];
#pragma unroll
    for (int a = 0; a < 2; ++a)
#pragma unroll
        for (int b = 0; b < 2; ++b)
#pragma unroll
            for (int m = 0; m < 4; ++m)
#pragma unroll
                for (int n = 0; n < 2; ++n) acc[a][b][m][n] = (f32x4){0.f, 0.f, 0.f, 0.f};
    bf16x8 At[4][2], B0[2][2], B1[2][2];
    const char* cA = cur.a; const char* cB = cur.b;
    static_assert(SP2, "only the SP2 loop is kept");
    PG8_STAGE(PG8_SB(0, 0), cB, voffB); PG8_STAGE(PG8_SB(0, 1), cB + hstepB, voffB); PG8_STAGE(PG8_SA(0, 0), cA, voffA); PG8_STAGE(PG8_SA(0, 1), cA + hstepA, voffA);
    if (wr == 1) PG8_BAR;
    PG8_WAIT_V(2); PG8_BAR;
    PG8_STAGE(PG8_SB(1, 0), cB + kstepB, voffB); PG8_STAGE(PG8_SA(1, 0), cA + kstepA, voffA); PG8_STAGE(PG8_SB(1, 1), cB + hstepB + kstepB, voffB);
    PG8_WAIT_V(6); PG8_BAR;
    for (;;) {
        const bool has_next = S.next(ui + 1, nxt);
        const char* nA = has_next ? nxt.a : cA; const char* nB = has_next ? nxt.b : cB;
#pragma unroll 1
        for (int t = 0; t < nt; t += 2) {
            const bool last = (t == nt - 2);
            const char* a1 = cA + (size_t)(t + 1) * kstepA;
            const char* a2 = last ? nA : cA + (size_t)(t + 2) * kstepA; const char* b2 = last ? nB : cB + (size_t)(t + 2) * kstepB;
            const char* a3 = a2 + kstepA; const char* b3 = b2 + kstepB;
            PG8_LDB(B0, 0, 0); PG8_LDB(B1, 0, 1); PG8_SCHED; PG8_LDA(At, 0, 0); PG8_STAGE(PG8_SA(1, 1), a1 + hstepA, voffA);
            PG8_WAIT_V(8); PG8_WAIT_L(0); PG8_BAR; PG8_MMA(0, 0, At, B0); PG8_MMA(0, 1, At, B1); PG8_BAR; PG8_SCHED;
            PG8_LDA(At, 0, 1); PG8_STAGE(PG8_SB(0, 0), b2, voffB); PG8_STAGE(PG8_SB(0, 1), b2 + hstepB, voffB); PG8_STAGE(PG8_SA(0, 0), a2, voffA);
            PG8_WAIT_V(8); PG8_WAIT_L(0); PG8_BAR; PG8_MMA(1, 0, At, B0); PG8_MMA(1, 1, At, B1); PG8_BAR; PG8_SCHED;
            PG8_LDB(B0, 1, 0); PG8_LDB(B1, 1, 1); PG8_SCHED; PG8_LDA(At, 1, 0); PG8_STAGE(PG8_SA(0, 1), a2 + hstepA, voffA);
            PG8_WAIT_V(8); PG8_WAIT_L(0); PG8_BAR; PG8_MMA(0, 0, At, B0); PG8_MMA(0, 1, At, B1); PG8_BAR; PG8_SCHED;
            PG8_LDA(At, 1, 1); PG8_STAGE(PG8_SB(1, 0), b3, voffB); PG8_STAGE(PG8_SB(1, 1), b3 + hstepB, voffB); PG8_STAGE(PG8_SA(1, 0), a3, voffA);
            PG8_WAIT_V(8); PG8_WAIT_L(0); PG8_BAR; PG8_MMA(1, 0, At, B0); PG8_MMA(1, 1, At, B1); PG8_BAR; PG8_SCHED;
        }
        if constexpr (ALIGN_EPI) { if (wr == 0) PG8_BAR; }
        E(acc, cur, wr, wc, fr, fq);
        if (!has_next) break;
#pragma unroll
        for (int a = 0; a < 2; ++a)
#pragma unroll
            for (int b = 0; b < 2; ++b)
#pragma unroll
                for (int m = 0; m < 4; ++m)
#pragma unroll
                    for (int n = 0; n < 2; ++n) acc[a][b][m][n] = (f32x4){0.f, 0.f, 0.f, 0.f};
        cur = nxt; cA = nA; cB = nB; ++ui;
        if constexpr (ALIGN_EPI) { if (wr == 1) PG8_BAR; }
    }
    PG8_WAIT_V(0);
    if constexpr (!ALIGN_EPI) { if (wr == 0) PG8_BAR; }
    PG8_BAR;
#undef PG8_SA
#undef PG8_SB
#undef PG8_STAGE
#undef PG8_LDA
#undef PG8_LDB
#undef PG8_MMA
#undef PG8_WAIT_V
#undef PG8_WAIT_L
#undef PG8_BAR
#undef PG8_SCHED
}

template <class F> struct EpiGen8 {
    static constexpr bool PERM = true, HAS_MID = false; F f; int mid_t;
    __device__ __forceinline__ void mid(f32x4 (&)[2][2][4][2], const Unit&, int, int, int, int) const {}
    __device__ __forceinline__ void operator()(const f32x4 (&acc)[2][2][4][2], const Unit& u, int wr, int wc, int fr, int fq) const {
#pragma unroll
        for (int ai = 0; ai < 2; ++ai)
#pragma unroll
            for (int m = 0; m < 4; ++m) { const int r = ai * HALF + wr * 64 + m * 16 + fr;
#pragma unroll
                for (int bj = 0; bj < 2; ++bj) f(u, r, bj * HALF + wc * 32 + 8 * fq, acc[ai][bj][m][0], acc[ai][bj][m][1]);
                if constexpr (F::PIN) __builtin_amdgcn_sched_barrier(0); }
    }
};
}

typedef const float* cfp_t;
typedef __attribute__((address_space(4))) const cfp_t* InTab;
struct Frame {
    LAS unsigned char* lds;
    volatile LAS unsigned* MISC;
    gu32* ctl;
    int tid, lane, wave, vcu, G;
    unsigned char* ws; unsigned char* dout; unsigned char* ws0; unsigned char* dout0;
    InTab in;
};
enum { I_X = 0, I_NMPRE, I_NMPOST, I_NFPRE, I_NFPOST, I_WIN, I_BGATE, I_MU, I_W0, I_W2, I_A0, I_A2, I_G2, I_KK, I_KA, I_RK, I_LNW, I_LNB,
       I_SARE, I_SAIM, I_SBRE, I_SBIM, I_SCRE, I_SCIM, I_SD, I_SLOG, I_WGLU, I_BGLU, I_WBR, I_WBS, I_WOUT, I_WUP, I_CONVW, I_CONVB, I_WDN };

__device__ __forceinline__ void p0_transpose_item(const float* W, int ldw, int k0, int src0, bf16_t* WT, int ldt, int drow0, int koff, const float* kscale, LAS float* scr, int lane) {
    const int q = lane & 7, rb = lane >> 3;
    f32x4 v[8]; float sc[8];
#pragma unroll
    for (int i = 0; i < 8; ++i) { const int kk = 8 * i + rb; v[i] = __builtin_nontemporal_load((const f32x4*)(W + (size_t)(k0 + kk) * ldw + src0 + 4 * q)); sc[i] = kscale ? kscale[k0 + kk] : 1.0f; }
#pragma unroll
    for (int i = 0; i < 8; ++i) { const int kk = 8 * i + rb; LAS float* d = scr + kk * 33 + 4 * q; d[0] = v[i].x * sc[i]; d[1] = v[i].y * sc[i]; d[2] = v[i].z * sc[i]; d[3] = v[i].w * sc[i]; }
    LDS_WAIT(); asm volatile("" ::: "memory");
    const int c = lane & 7;
#pragma unroll
    for (int j = 0; j < 4; ++j) { const int n = (lane >> 3) + 8 * j; const LAS float* s = scr + (8 * c) * 33 + n;
        u32x4 o; o.x = cvt_pk_bf16(s[0 * 33], s[1 * 33]); o.y = cvt_pk_bf16(s[2 * 33], s[3 * 33]); o.z = cvt_pk_bf16(s[4 * 33], s[5 * 33]); o.w = cvt_pk_bf16(s[6 * 33], s[7 * 33]);
        *(GAS u32x4*)(WT + (size_t)(drow0 + n) * ldt + koff + k0 + 8 * c) = o; }
    LDS_WAIT(); asm volatile("" ::: "memory");
}
struct TrMat { int in_idx, K, N, ldt, koff, kind; size_t dst; int scale_idx; };
__device__ __forceinline__ void p0_do_matrix(Frame& F, const TrMat& mtx, int r, LAS float* scr) {
    const int nblk = mtx.N / 32, kb = r / nblk, nb = r % nblk;
    int src0 = 32 * nb;
    if (mtx.kind == 1) {
        const int pn = (32 * nb) >> 8, within = (32 * nb) & 255;
        src0 = (within < 128 ? 0 : FF - 128) + 128 * pn + within;
    }
    p0_transpose_item(F.in[mtx.in_idx], mtx.N, 64 * kb, src0, (bf16_t*)(F.ws + mtx.dst), mtx.ldt, 32 * nb, mtx.koff, mtx.scale_idx >= 0 ? F.in[mtx.scale_idx] : nullptr, scr, F.lane);
}
__device__ __forceinline__ void p0_s5_group(Frame& F, int g) {
    LAS float* pwr = (LAS float*)(F.lds);
    LAS float* pwi = pwr + 17 * 64;
    LAS float* bbr = pwi + 17 * 64;
    LAS float* bbi = bbr + 1024;
    LAS float* cre = bbi + 1024;
    LAS float* cim = cre + 1024;
    LAS float* kk = cim + 1024;
    const float dt = expf(F.in[I_SLOG][g]);
    for (int idx = F.tid; idx < 17 * 64; idx += 512) { const int k = idx >> 6, p = idx & 63;
        const float are = F.in[I_SARE][g * 64 + p], aim = F.in[I_SAIM][g * 64 + p];
        const float mag = expf((float)k * are * dt); float sn, cs; sincosf((float)k * aim * dt, &sn, &cs);
        pwr[idx] = mag * cs; pwi[idx] = mag * sn; }
    for (int idx = F.tid; idx < 1024; idx += 512) { cre[idx] = F.in[I_SCRE][g * 1024 + idx]; cim[idx] = F.in[I_SCIM][g * 1024 + idx]; }
    __syncthreads();
    for (int idx = F.tid; idx < 1024; idx += 512) { const int p = idx >> 4;
        const float are = F.in[I_SARE][g * 64 + p], aim = F.in[I_SAIM][g * 64 + p];
        const float nr = pwr[64 + p] - 1.0f, ni = pwi[64 + p];
        const float den = 1.0f / (are * are + aim * aim);
        const float qr = (nr * are + ni * aim) * den, qi = (ni * are - nr * aim) * den;
        const float br = F.in[I_SBRE][g * 1024 + idx], bi = F.in[I_SBIM][g * 1024 + idx];
        bbr[idx] = qr * br - qi * bi; bbi[idx] = qr * bi + qi * br; }
    __syncthreads();
    {
        const int kc = F.tid & 255, ph = F.tid >> 8, k = kc >> 4, c = kc & 15; float s[16];
#pragma unroll
        for (int e = 0; e < 16; ++e) s[e] = 0.f;
        for (int p = 32 * ph; p < 32 * ph + 32; ++p) { const float cr_ = cre[c * 64 + p], ci_ = cim[c * 64 + p], pr_ = pwr[k * 64 + p], pi_ = pwi[k * 64 + p];
            const float xr = cr_ * pr_ - ci_ * pi_, xi = cr_ * pi_ + ci_ * pr_;
#pragma unroll
            for (int e4 = 0; e4 < 4; ++e4) { const f32x4 br = *(LAS const f32x4*)(bbr + p * 16 + 4 * e4), bi = *(LAS const f32x4*)(bbi + p * 16 + 4 * e4);
#pragma unroll
                for (int e = 0; e < 4; ++e) s[4 * e4 + e] += xr * br[e] - xi * bi[e]; } }
        LAS float* part = kk + 4096;
        if (ph == 1) {
#pragma unroll
            for (int e4 = 0; e4 < 4; ++e4) *(LAS f32x4*)(part + kc * 16 + 4 * e4) = (f32x4){s[4 * e4], s[4 * e4 + 1], s[4 * e4 + 2], s[4 * e4 + 3]}; }
        __syncthreads();
        if (ph == 0) {
#pragma unroll
            for (int e4 = 0; e4 < 4; ++e4) { const f32x4 o = *(LAS const f32x4*)(part + kc * 16 + 4 * e4);
#pragma unroll
                for (int e = 0; e < 4; ++e) { float v = s[4 * e4 + e] + o[e]; if (k == 0 && c == 4 * e4 + e) v += F.in[I_SD][g * 16 + c]; kk[kc * 16 + 4 * e4 + e] = v; } } }
    }
    __syncthreads();
    bf16_t* B1b = (bf16_t*)(F.ws + WS_B1B) + (size_t)g * 256 * 384;
    for (int idx = F.tid; idx < 256 * 48; idx += 512) { const int n = idx / 48, j = idx - n * 48, t = n >> 4, c = n & 15; float v[8];
        if (j < 32) { const int tau = j >> 1, cp0 = (j & 1) * 8; const int ko = (t >= tau ? t - tau : 0) * 256 + c * 16 + cp0; const float m = (t >= tau) ? 1.f : 0.f;
            const f32x4 a0 = *(LAS const f32x4*)(kk + ko), a1 = *(LAS const f32x4*)(kk + ko + 4);
#pragma unroll
            for (int e = 0; e < 4; ++e) { v[e] = a0[e] * m; v[4 + e] = a1[e] * m; } }
        else { const int p0 = (j - 32) * 4; const f32x4 cr4 = *(LAS const f32x4*)(cre + c * 64 + p0), ci4 = *(LAS const f32x4*)(cim + c * 64 + p0), pr4 = *(LAS const f32x4*)(pwr + (t + 1) * 64 + p0), pi4 = *(LAS const f32x4*)(pwi + (t + 1) * 64 + p0);
#pragma unroll
            for (int q = 0; q < 4; ++q) { v[2 * q] = cr4[q] * pr4[q] - ci4[q] * pi4[q]; v[2 * q + 1] = -(cr4[q] * pi4[q] + ci4[q] * pr4[q]); } }
        *(u32x4*)(B1b + (size_t)n * 384 + 8 * j) = pack8(v); }
    bf16_t* B1a = (bf16_t*)(F.ws + WS_B1A) + (size_t)g * 256 * 256;
    for (int idx = F.tid; idx < 256 * 32; idx += 512) { const int n = idx >> 5, j = idx & 31; float v[8];
#pragma unroll
        for (int e = 0; e < 8; ++e) v[e] = 0.f;
        if (n < 128) { const int p = n >> 1, tau = j >> 1, cp0 = (j & 1) * 8; const float pr_ = pwr[(15 - tau) * 64 + p], pi_ = pwi[(15 - tau) * 64 + p];
            const f32x4 r0 = *(LAS const f32x4*)(bbr + p * 16 + cp0), r1 = *(LAS const f32x4*)(bbr + p * 16 + cp0 + 4), i0 = *(LAS const f32x4*)(bbi + p * 16 + cp0), i1 = *(LAS const f32x4*)(bbi + p * 16 + cp0 + 4);
#pragma unroll
            for (int e = 0; e < 8; ++e) { const float br = e < 4 ? r0[e & 3] : r1[e & 3], bi = e < 4 ? i0[e & 3] : i1[e & 3]; v[e] = (n & 1) ? (pr_ * bi + pi_ * br) : (pr_ * br - pi_ * bi); } }
        *(u32x4*)(B1a + (size_t)n * 256 + 8 * j) = pack8(v); }
    float* aL = (float*)(F.ws + WS_AL) + g * 128;
    if (F.tid < 64) { aL[2 * F.tid] = pwr[16 * 64 + F.tid]; aL[2 * F.tid + 1] = pwi[16 * 64 + F.tid]; }
    __syncthreads();
}
#define DO_MAT(in_idx, K_, N_, ldt_, koff_, kind_, dst_, sc_) do { const TrMat mtx{in_idx, K_, N_, ldt_, koff_, kind_, dst_, sc_}; const int items = ((K_) / 64) * ((N_) / 32); \
        for (int it = gw; it < base + items; it += NGW) { if (it >= base) p0_do_matrix(F, mtx, it - base, scr); } base += items; } while (0)
__device__ __forceinline__ void p0_late_mats(Frame& F, int gw, int NGW) {
    LAS float* scr = (LAS float*)(F.lds + F.wave * 16384);
    int base = 0;
    DO_MAT(I_WUP, D, 2 * FF, D, 0, 1, WS_WUP, I_NFPRE); DO_MAT(I_WDN, FF, D, FF, 0, 0, WS_WDN, -1); DO_MAT(I_WOUT, D, D, D, 0, 0, WS_WOUT, -1);
    DO_MAT(I_WBR, RW, D, D, 0, 0, WS_WBRS, -1); DO_MAT(I_WBS, RW, D, D, RW, 0, WS_WBRS, -1); DO_MAT(I_WGLU, RW, RW, RW, 0, 0, WS_WGLU, -1);
}
__device__ __forceinline__ void p0_prologue(Frame& F) {
    const bool s5wg = F.vcu < S5G && F.G > S5G;
    if (F.vcu < S5G) p0_s5_group(F, F.vcu);
    if (!s5wg) {
        LAS float* scr = (LAS float*)(F.lds + F.wave * 16384);
        const int gw = (F.G > S5G ? F.vcu - S5G : F.vcu) * NWAVES + F.wave, NGW = (F.G > S5G ? F.G - S5G : F.G) * NWAVES;
        int base = 0;
        DO_MAT(I_WIN, D, NIN, D, 0, 0, WS_WIN, I_NMPRE);
        DO_MAT(I_W2, 64, RW, 64, 0, 0, WS_W2T, -1); DO_MAT(I_A2, 64, RW, 64, 0, 0, WS_A2T, -1); DO_MAT(I_G2, 128, RW, 128, 0, 0, WS_G2T, -1);
    }
    {
        bf16_t* XN = (bf16_t*)(F.ws + WS_XN);
        const int nch = T / 4, split = (F.G > S5G) ? nch / 2 : 0;
#pragma unroll 1
        for (int pass = 0; pass < 2; ++pass) {
            if (pass == 0 && (s5wg || split == 0)) continue;
            const int lo = pass == 0 ? 0 : split, hi = pass == 0 ? split : nch;
            const int gw = (pass == 0 ? F.vcu - S5G : F.vcu) * NWAVES + F.wave, NGW = (pass == 0 ? F.G - S5G : F.G) * NWAVES;
#pragma unroll 1
            for (int ch = lo + gw; ch < hi; ch += NGW) {
                const int m = 4 * ch;
                f32x4 v[4][4]; float s[4];
#pragma unroll
                for (int q = 0; q < 4; ++q) { const GAS f32x4* xr = (const GAS f32x4*)(F.in[I_X] + (size_t)(m + q) * D) + F.lane;
#pragma unroll
                    for (int j = 0; j < 4; ++j) v[q][j] = __builtin_nontemporal_load((const f32x4*)(xr + 64 * j)); }
#pragma unroll
                for (int q = 0; q < 4; ++q) { s[q] = 0.f;
#pragma unroll
                    for (int j = 0; j < 4; ++j) s[q] += (v[q][j].x * v[q][j].x + v[q][j].y * v[q][j].y) + (v[q][j].z * v[q][j].z + v[q][j].w * v[q][j].w); }
#pragma unroll
                for (int q = 0; q < 4; ++q) { const float r = 1.0f / sqrtf(wave_sum(s[q]) * (1.f / D) + 1e-6f);
                    GAS u32x2* o = (GAS u32x2*)(XN + (size_t)(m + q) * D) + F.lane;
#pragma unroll
                    for (int j = 0; j < 4; ++j) { u32x2 w; w.x = cvt_pk_bf16(v[q][j].x * r, v[q][j].y * r); w.y = cvt_pk_bf16(v[q][j].z * r, v[q][j].w * r); o[64 * j] = w; } }
            }
        }
    }
}

struct EpiInProj {
    static constexpr bool PERM = true, HAS_MID = false;
    bf16_t* PR; bf16_t* UG; bf16_t* GT; const float* bg; int mid_t;
    __device__ __forceinline__ void mid(f32x4 (&)[2][2][4][2], const pg8::Unit&, int, int, int, int) const {}
    __device__ __forceinline__ void operator()(const f32x4 (&acc)[2][2][4][2], const pg8::Unit& u, int wr, int wc, int fr, int fq) const {
        f32x4 b0[2], b1[2];
        if (u.pn >= 9) {
#pragma unroll
            for (int bj = 0; bj < 2; ++bj) { const int gc = (u.pn - 9) * 256 + bj * 128 + wc * 32 + 8 * fq; b0[bj] = *(const f32x4*)(bg + gc); b1[bj] = *(const f32x4*)(bg + gc + 4); } }
#pragma unroll
        for (int ai = 0; ai < 2; ++ai)
#pragma unroll
            for (int m = 0; m < 4; ++m) { const int row = u.pm * 256 + ai * 128 + wr * 64 + m * 16 + fr;
#pragma unroll
                for (int bj = 0; bj < 2; ++bj) { const int cl = bj * 128 + wc * 32 + 8 * fq; const f32x4 v0 = acc[ai][bj][m][0], v1 = acc[ai][bj][m][1]; u32x4 w;
                    if (u.pn < 7) { w.x = cvt_pk_bf16(v0[0], v0[1]); w.y = cvt_pk_bf16(v0[2], v0[3]); w.z = cvt_pk_bf16(v1[0], v1[1]); w.w = cvt_pk_bf16(v1[2], v1[3]);
                        *(u32x4*)(PR + (size_t)row * NRW + u.pn * 256 + cl) = w; }
                    else if (u.pn < 9) { const int cr = (u.pn - 7) * 256 + cl, g = cr >> 4, c0 = cr & 15;
                        w.x = cvt_pk_bf16(v0[0], v0[1]); w.y = cvt_pk_bf16(v0[2], v0[3]); w.z = cvt_pk_bf16(v1[0], v1[1]); w.w = cvt_pk_bf16(v1[2], v1[3]);
                        *(u32x4*)(UG + ((size_t)g * S5ROWS + (row >> 4)) * UGLD + (row & 15) * 16 + c0) = w; }
                    else { const int gc = (u.pn - 9) * 256 + cl;
                        w.x = cvt_pk_bf16(fsigmoid(v0[0] + b0[bj][0]), fsigmoid(v0[1] + b0[bj][1])); w.y = cvt_pk_bf16(fsigmoid(v0[2] + b0[bj][2]), fsigmoid(v0[3] + b0[bj][3]));
                        w.z = cvt_pk_bf16(fsigmoid(v1[0] + b1[bj][0]), fsigmoid(v1[1] + b1[bj][1])); w.w = cvt_pk_bf16(fsigmoid(v1[2] + b1[bj][2]), fsigmoid(v1[3] + b1[bj][3]));
                        __builtin_nontemporal_store(w, (u32x4*)(GT + (size_t)row * 2048 + gc)); } }
                __builtin_amdgcn_sched_barrier(0); }
    }
};
struct FS5Out {
    static constexpr bool PIN = true;
    bf16_t* YSP;
    __device__ __forceinline__ void operator()(const pg8::Unit& u, int r, int cl, f32x4 v0, f32x4 v1) const {
        const int crow = u.pm * 256 + r; u32x4 w;
        w.x = cvt_pk_bf16(fgelu(v0[0]), fgelu(v0[1])); w.y = cvt_pk_bf16(fgelu(v0[2]), fgelu(v0[3])); w.z = cvt_pk_bf16(fgelu(v1[0]), fgelu(v1[1])); w.w = cvt_pk_bf16(fgelu(v1[2]), fgelu(v1[3]));
        *(u32x4*)(YSP + ((size_t)u.pn * S5ROWS + crow) * 256 + cl) = w;
    }
};
struct EpiGlu {
    static constexpr bool PERM = true, HAS_MID = false;
    const bf16_t* YSP; bf16_t* YS; const float* bglu; int mid_t;
    __device__ __forceinline__ void mid(f32x4 (&)[2][2][4][2], const pg8::Unit&, int, int, int, int) const {}
    __device__ __forceinline__ void operator()(const f32x4 (&acc)[2][2][4][2], const pg8::Unit& u, int wr, int wc, int fr, int fq) const {
        u32x4 yv[2][4][2]; f32x4 b0[2], b1[2];
#pragma unroll
        for (int bj = 0; bj < 2; ++bj) { const int col = u.pn * 256 + bj * 128 + wc * 32 + 8 * fq; b0[bj] = *(const f32x4*)(bglu + col); b1[bj] = *(const f32x4*)(bglu + col + 4); }
#pragma unroll
        for (int ai = 0; ai < 2; ++ai)
#pragma unroll
            for (int m = 0; m < 4; ++m)
#pragma unroll
                for (int bj = 0; bj < 2; ++bj) { const int row = u.pm * 256 + ai * 128 + wr * 64 + m * 16 + fr, col = u.pn * 256 + bj * 128 + wc * 32 + 8 * fq;
                    yv[ai][m][bj] = __builtin_nontemporal_load((const u32x4*)(YSP + ((size_t)(col >> 4) * S5ROWS + (row >> 4)) * 256 + (row & 15) * 16 + (col & 15))); }
#pragma unroll
        for (int ai = 0; ai < 2; ++ai)
#pragma unroll
            for (int m = 0; m < 4; ++m) {
#pragma unroll
                for (int bj = 0; bj < 2; ++bj) { const int row = u.pm * 256 + ai * 128 + wr * 64 + m * 16 + fr, col = u.pn * 256 + bj * 128 + wc * 32 + 8 * fq; float y[8]; unpack8(yv[ai][m][bj], y);
                    const f32x4 v0 = acc[ai][bj][m][0], v1 = acc[ai][bj][m][1]; u32x4 w;
                    w.x = cvt_pk_bf16(y[0] * fsigmoid(v0[0] + b0[bj][0]), y[1] * fsigmoid(v0[1] + b0[bj][1])); w.y = cvt_pk_bf16(y[2] * fsigmoid(v0[2] + b0[bj][2]), y[3] * fsigmoid(v0[3] + b0[bj][3]));
                    w.z = cvt_pk_bf16(y[4] * fsigmoid(v1[0] + b1[bj][0]), y[5] * fsigmoid(v1[1] + b1[bj][1])); w.w = cvt_pk_bf16(y[6] * fsigmoid(v1[2] + b1[bj][2]), y[7] * fsigmoid(v1[3] + b1[bj][3]));
                    *(u32x4*)(YS + (size_t)row * D + RW + col) = w; }
                __builtin_amdgcn_sched_barrier(0); }
    }
};
struct FStore {
    static constexpr bool PIN = false;
    bf16_t* O; int ldc;
    __device__ __forceinline__ void operator()(const pg8::Unit& u, int r, int cl, f32x4 v0, f32x4 v1) const {
        u32x4 w; w.x = cvt_pk_bf16(v0[0], v0[1]); w.y = cvt_pk_bf16(v0[2], v0[3]); w.z = cvt_pk_bf16(v1[0], v1[1]); w.w = cvt_pk_bf16(v1[2], v1[3]);
        *(u32x4*)(O + (size_t)(u.pm * 256 + r) * ldc + u.pn * 256 + cl) = w;
    }
};
struct EpiMergeA {
    static constexpr bool PERM = true, HAS_MID = false;
    const bf16_t* GT; bf16_t* O; int mid_t;
    __device__ __forceinline__ void mid(f32x4 (&)[2][2][4][2], const pg8::Unit&, int, int, int, int) const {}
    __device__ __forceinline__ void operator()(const f32x4 (&acc)[2][2][4][2], const pg8::Unit& u, int wr, int wc, int fr, int fq) const {
        u32x4 gv[2][4][2];
#pragma unroll
        for (int ai = 0; ai < 2; ++ai)
#pragma unroll
            for (int m = 0; m < 4; ++m)
#pragma unroll
                for (int bj = 0; bj < 2; ++bj) { const int row = u.pm * 256 + ai * 128 + wr * 64 + m * 16 + fr, col = u.pn * 256 + bj * 128 + wc * 32 + 8 * fq;
                    gv[ai][m][bj] = __builtin_nontemporal_load((const u32x4*)(GT + (size_t)row * 2048 + col)); }
#pragma unroll
        for (int ai = 0; ai < 2; ++ai)
#pragma unroll
            for (int m = 0; m < 4; ++m) {
#pragma unroll
                for (int bj = 0; bj < 2; ++bj) { const int row = u.pm * 256 + ai * 128 + wr * 64 + m * 16 + fr, col = u.pn * 256 + bj * 128 + wc * 32 + 8 * fq; float g[8]; unpack8(gv[ai][m][bj], g);
                    const f32x4 v0 = acc[ai][bj][m][0], v1 = acc[ai][bj][m][1]; u32x4 w;
                    w.x = cvt_pk_bf16(v0[0] * g[0], v0[1] * g[1]); w.y = cvt_pk_bf16(v0[2] * g[2], v0[3] * g[3]); w.z = cvt_pk_bf16(v1[0] * g[4], v1[1] * g[5]); w.w = cvt_pk_bf16(v1[2] * g[6], v1[3] * g[7]);
                    *(u32x4*)(O + (size_t)row * D + col) = w; }
                __builtin_amdgcn_sched_barrier(0); }
    }
};
struct EpiMergeB {
    static constexpr bool PERM = true, HAS_MID = false;
    const bf16_t* GT; bf16_t* O; int mid_t;
    __device__ __forceinline__ void mid(f32x4 (&)[2][2][4][2], const pg8::Unit&, int, int, int, int) const {}
    __device__ __forceinline__ void operator()(const f32x4 (&acc)[2][2][4][2], const pg8::Unit& u, int wr, int wc, int fr, int fq) const {
#pragma unroll
        for (int ai = 0; ai < 2; ++ai) {
            u32x4 gv[4][2], tv[4][2];
#pragma unroll
            for (int m = 0; m < 4; ++m)
#pragma unroll
                for (int bj = 0; bj < 2; ++bj) { const int row = u.pm * 256 + ai * 128 + wr * 64 + m * 16 + fr, col = u.pn * 256 + bj * 128 + wc * 32 + 8 * fq;
                    gv[m][bj] = __builtin_nontemporal_load((const u32x4*)(GT + (size_t)row * 2048 + 1024 + col)); tv[m][bj] = *(const u32x4*)(O + (size_t)row * D + col); }
            __builtin_amdgcn_sched_barrier(0);
#pragma unroll
            for (int m = 0; m < 4; ++m) {
#pragma unroll
                for (int bj = 0; bj < 2; ++bj) { const int row = u.pm * 256 + ai * 128 + wr * 64 + m * 16 + fr, col = u.pn * 256 + bj * 128 + wc * 32 + 8 * fq; float g[8], t1[8]; unpack8(gv[m][bj], g); unpack8(tv[m][bj], t1);
                    const f32x4 v0 = acc[ai][bj][m][0], v1 = acc[ai][bj][m][1]; u32x4 w;
                    w.x = cvt_pk_bf16(t1[0] + v0[0] * g[0], t1[1] + v0[1] * g[1]); w.y = cvt_pk_bf16(t1[2] + v0[2] * g[2], t1[3] + v0[3] * g[3]);
                    w.z = cvt_pk_bf16(t1[4] + v1[0] * g[4], t1[5] + v1[1] * g[5]); w.w = cvt_pk_bf16(t1[6] + v1[2] * g[6], t1[7] + v1[3] * g[7]);
                    *(u32x4*)(O + (size_t)row * D + col) = w; }
                __builtin_amdgcn_sched_barrier(0); }
        }
    }
};
struct UpOrder {
    const bf16_t* H2; const bf16_t* Wt; int G, c;
    __device__ bool next(int i, pg8::Unit& u) const {
        constexpr int nM = NB * 16, nN = 22, nwg = nM * nN;
        const long L = (long)i * G + c; if (L >= nwg) return false;
        int wgid = (int)L; { const int q = nwg / 8, r = nwg % 8, xcd = wgid % 8, off = wgid / 8; wgid = (xcd < r ? xcd * (q + 1) : r * (q + 1) + (xcd - r) * q) + off; }
        const int nig = 8 * nN, gid = wgid / nig, fm = gid * 8, gsz = (nM - fm) < 8 ? (nM - fm) : 8;
        u.pm = fm + ((wgid % nig) % gsz); u.pn = (wgid % nig) / gsz;
        u.a = (const char*)H2 + ((size_t)u.pm * 256 * D) * 2; u.b = (const char*)(Wt + (size_t)u.pn * 256 * D); return true;
    }
};
template <int CTRL> __device__ __forceinline__ unsigned dppu(unsigned v) { return (unsigned)__builtin_amdgcn_update_dpp(0, (int)v, CTRL, 0xf, 0xf, true); }
struct EpiConvAct {
    static constexpr bool PERM = true, HAS_MID = false;
    bf16_t* ACT; const float* cw; const float* cb; LAS unsigned* EX; unsigned long long* HZ; unsigned* tmo; int mid_t;
    __device__ __forceinline__ void mid(f32x4 (&)[2][2][4][2], const pg8::Unit&, int, int, int, int) const {}
    __device__ __forceinline__ void operator()(f32x4 (&acc)[2][2][4][2], const pg8::Unit& u, int wr, int wc, int fr, int fq) const {
        const int b = u.pm >> 4, k = u.pm & 15, t0 = 256 * k;
        u32x2 zp[2][2][4][2];
#pragma unroll
        for (int ai = 0; ai < 2; ++ai)
#pragma unroll
            for (int bj = 0; bj < 2; ++bj)
#pragma unroll
                for (int m = 0; m < 4; ++m)
#pragma unroll
                    for (int n = 0; n < 2; ++n) { const f32x4 v = acc[ai][bj][m][n]; u32x2 w; w.x = cvt_pk_bf16(v[0], v[1]); w.y = cvt_pk_bf16(v[2], v[3]); zp[ai][bj][m][n] = w; }
        if (fr >= 14) {
#pragma unroll
            for (int ai = 0; ai < 2; ++ai)
#pragma unroll
                for (int bj = 0; bj < 2; ++bj)
#pragma unroll
                    for (int n = 0; n < 2; ++n) *(LAS u32x2*)(EX + (((wc * 4 + 2 * ai + wr) * 2 + (fr - 14)) * 32 + bj * 16 + fq * 4 + n * 2)) = zp[ai][bj][3][n]; }
        if (wr == 1 && k < 15 && fr >= 14) {
            unsigned long long* hz = HZ + ((size_t)(u.pm * 22 + u.pn) * 8 + wc * 2 + (fr - 14)) * 32;
#pragma unroll
            for (int bj = 0; bj < 2; ++bj)
#pragma unroll
                for (int n = 0; n < 2; ++n) { __hip_atomic_store(hz + bj * 16 + fq * 4 + n * 2, (1ull << 32) | zp[1][bj][3][n].x, RLX_AGENT); __hip_atomic_store(hz + bj * 16 + fq * 4 + n * 2 + 1, (1ull << 32) | zp[1][bj][3][n].y, RLX_AGENT); }
        }
        asm volatile("s_waitcnt lgkmcnt(0)" ::: "memory"); __builtin_amdgcn_s_barrier(); asm volatile("" ::: "memory");
        const int ch0 = u.pn * 128 + wc * 32 + 8 * fq;
        f32x4 wg[2][3], wv[2][3], bg[2], bv[2];
#pragma unroll
        for (int n = 0; n < 2; ++n) {
#pragma unroll
            for (int j = 0; j < 3; ++j) { wg[n][j] = *(const f32x4*)(cw + (size_t)j * 2 * FF + ch0 + 4 * n); wv[n][j] = *(const f32x4*)(cw + (size_t)j * 2 * FF + FF + ch0 + 4 * n); }
            bg[n] = *(const f32x4*)(cb + ch0 + 4 * n); bv[n] = *(const f32x4*)(cb + FF + ch0 + 4 * n); }
#pragma unroll
        for (int gi = 1; gi <= 8; ++gi) {
            const int ai = (gi & 7) >> 2, m = gi & 3, blk = 2 * ai + wr;
            u32x2 pp[2][2];
#pragma unroll
            for (int bj = 0; bj < 2; ++bj)
#pragma unroll
                for (int n = 0; n < 2; ++n) { pp[bj][n].x = 0u; pp[bj][n].y = 0u; }
            if (m > 0) {
#pragma unroll
                for (int bj = 0; bj < 2; ++bj)
#pragma unroll
                    for (int n = 0; n < 2; ++n) pp[bj][n] = zp[ai][bj][m - 1][n];
            } else if (blk > 0) {
                if (fr >= 14) {
#pragma unroll
                    for (int bj = 0; bj < 2; ++bj)
#pragma unroll
                        for (int n = 0; n < 2; ++n) pp[bj][n] = *(LAS const u32x2*)(EX + (((wc * 4 + blk - 1) * 2 + (fr - 14)) * 32 + bj * 16 + fq * 4 + n * 2)); }
            } else if (k > 0) {
                if (fr >= 14) {
                    const unsigned long long* hz = HZ + ((size_t)((u.pm - 1) * 22 + u.pn) * 8 + wc * 2 + (fr - 14)) * 32;
#pragma unroll
                    for (int bj = 0; bj < 2; ++bj)
#pragma unroll
                        for (int n = 0; n < 2; ++n) { unsigned long long x0, x1; unsigned sp_ = 0;
                            for (;;) { x0 = __hip_atomic_load(hz + bj * 16 + fq * 4 + n * 2, RLX_AGENT); x1 = __hip_atomic_load(hz + bj * 16 + fq * 4 + n * 2 + 1, RLX_AGENT);
                                if ((x0 >> 32) == 1ull && (x1 >> 32) == 1ull) break; __builtin_amdgcn_s_sleep(2); if (++sp_ > (1u << 20)) { __hip_atomic_store(tmo, 1u, RLX_AGENT); break; } }
                            pp[bj][n].x = (unsigned)x0; pp[bj][n].y = (unsigned)x1; } }
            }
            u32x2 outp[2];
#pragma unroll
            for (int n = 0; n < 2; ++n) {
                const u32x2 zg = zp[ai][0][m][n], zv = zp[ai][1][m][n], pg = pp[0][n], pv = pp[1][n];
                u32x2 g1, g2, v1, v2;
                g1.x = dppu<0x111>(zg.x) | dppu<0x10F>(pg.x); g1.y = dppu<0x111>(zg.y) | dppu<0x10F>(pg.y); g2.x = dppu<0x112>(zg.x) | dppu<0x10E>(pg.x); g2.y = dppu<0x112>(zg.y) | dppu<0x10E>(pg.y);
                v1.x = dppu<0x111>(zv.x) | dppu<0x10F>(pv.x); v1.y = dppu<0x111>(zv.y) | dppu<0x10F>(pv.y); v2.x = dppu<0x112>(zv.x) | dppu<0x10E>(pv.x); v2.y = dppu<0x112>(zv.y) | dppu<0x10E>(pv.y);
                const float z0g[4] = {bf_lo(zg.x), bf_hi(zg.x), bf_lo(zg.y), bf_hi(zg.y)}, z1g[4] = {bf_lo(g1.x), bf_hi(g1.x), bf_lo(g1.y), bf_hi(g1.y)}, z2g[4] = {bf_lo(g2.x), bf_hi(g2.x), bf_lo(g2.y), bf_hi(g2.y)};
                const float z0v[4] = {bf_lo(zv.x), bf_hi(zv.x), bf_lo(zv.y), bf_hi(zv.y)}, z1v[4] = {bf_lo(v1.x), bf_hi(v1.x), bf_lo(v1.y), bf_hi(v1.y)}, z2v[4] = {bf_lo(v2.x), bf_hi(v2.x), bf_lo(v2.y), bf_hi(v2.y)};
                float o[4];
#pragma unroll
                for (int e = 0; e < 4; ++e) { const float cg = bg[n][e] + wg[n][0][e] * z2g[e] + wg[n][1][e] * z1g[e] + wg[n][2][e] * z0g[e], cv = bv[n][e] + wv[n][0][e] * z2v[e] + wv[n][1][e] * z1v[e] + wv[n][2][e] * z0v[e];
                    o[e] = fgelu(cg) * cv; }
                outp[n].x = cvt_pk_bf16(o[0], o[1]); outp[n].y = cvt_pk_bf16(o[2], o[3]);
            }
            const int r = 128 * ai + 64 * wr + 16 * m + fr;
            { u32x4 w4; w4.x = outp[0].x; w4.y = outp[0].y; w4.z = outp[1].x; w4.w = outp[1].y; *(u32x4*)(ACT + ((size_t)(b * SEQ + t0 + r)) * FF + ch0) = w4; }
            __builtin_amdgcn_sched_barrier(0);
        }
    }
};
struct EpiRowStat {
    static constexpr bool PERM = true, HAS_MID = false; bf16_t* O; float* STAT; int mid_t;
    __device__ __forceinline__ void mid(f32x4 (&)[2][2][4][2], const pg8::Unit&, int, int, int, int) const {}
    __device__ __forceinline__ void operator()(const f32x4 (&acc)[2][2][4][2], const pg8::Unit& u, int wr, int wc, int fr, int fq) const {
#pragma unroll
        for (int ai = 0; ai < 2; ++ai)
#pragma unroll
            for (int m = 0; m < 4; ++m) { const int row = u.pm * 256 + ai * 128 + wr * 64 + m * 16 + fr; float s = 0.f;
#pragma unroll
                for (int bj = 0; bj < 2; ++bj) { const int col = u.pn * 256 + bj * 128 + wc * 32 + 8 * fq; const f32x4 v0 = acc[ai][bj][m][0], v1 = acc[ai][bj][m][1]; u32x4 w;
                    s += (v0[0] * v0[0] + v0[1] * v0[1]) + (v0[2] * v0[2] + v0[3] * v0[3]) + (v1[0] * v1[0] + v1[1] * v1[1]) + (v1[2] * v1[2] + v1[3] * v1[3]);
                    w.x = cvt_pk_bf16(v0[0], v0[1]); w.y = cvt_pk_bf16(v0[2], v0[3]); w.z = cvt_pk_bf16(v1[0], v1[1]); w.w = cvt_pk_bf16(v1[2], v1[3]);
                    __builtin_nontemporal_store(w, (u32x4*)(O + (size_t)row * D + col)); }
                s += __shfl_xor(s, 16); s += __shfl_xor(s, 32);
                if (fq == 0) STAT[(size_t)row * 16 + u.pn * 4 + wc] = s; }
    }
};
struct EpiSloc {
    static constexpr bool PERM = false, HAS_MID = false; float* SL; int mid_t;
    __device__ __forceinline__ void mid(f32x4 (&)[2][2][4][2], const pg8::Unit&, int, int, int, int) const {}
    __device__ __forceinline__ void operator()(const f32x4 (&acc)[2][2][4][2], const pg8::Unit& u, int wr, int wc, int fr, int fq) const {
#pragma unroll
        for (int ai = 0; ai < 2; ++ai)
#pragma unroll
            for (int m = 0; m < 4; ++m) { const int row = u.pm * 256 + ai * 128 + wr * 64 + m * 16 + fr; float* p = SL + ((size_t)u.pn * S5ROWS + row) * 128 + wc * 32 + 4 * fq;
                *(f32x4*)(p) = acc[ai][0][m][0]; *(f32x4*)(p + 16) = acc[ai][0][m][1]; }
    }
};
struct S5Order {
    const bf16_t* UG; const bf16_t* Bt; int ldb, G, c;
    __device__ bool next(int i, pg8::Unit& u) const { const int L = i * G + c; if (L >= S5G * 8) return false; const int g = L >> 3; u.pm = L & 7; u.pn = g;
        u.a = (const char*)(UG + ((size_t)g * S5ROWS + u.pm * 256) * UGLD); u.b = (const char*)(Bt + (size_t)g * 256 * ldb); return true; }
};

constexpr int LW = 72;
constexpr int SLOT = 64 * LW * 2;
#define SL(i) ((i) * SLOT)
#define BAR_LDS() do { asm volatile("s_waitcnt lgkmcnt(0)" ::: "memory"); __builtin_amdgcn_s_barrier(); asm volatile("" ::: "memory"); } while (0)
struct LdsMat { LAS const unsigned char* p; int ld; __device__ __forceinline__ bf16x8 frag(int row, int k) const { return *(LAS const bf16x8*)(p + ((size_t)row * ld + k) * 2); } };
struct GlbMat { const bf16_t* p; int ld; __device__ __forceinline__ bf16x8 frag(int row, int k) const { return *(const bf16x8*)(p + (size_t)row * ld + k); } };
template <int KD, class YM, class XM, class EPI>
__device__ __forceinline__ void mm64(const YM& Y, const XM& X, int wid, int lane, const EPI& epi) {
    asm volatile("" : "+v"(lane), "+s"(wid));
    const int at = wid >> 1, bt0 = (wid & 1) * 2, fr = lane & 15, fq = lane >> 4;
    f32x4 acc[2] = {(f32x4){0.f, 0.f, 0.f, 0.f}, (f32x4){0.f, 0.f, 0.f, 0.f}};
#pragma unroll
    for (int s = 0; s < KD / 32; ++s) {
        const bf16x8 yf = Y.frag(16 * at + fr, 32 * s + 8 * fq);
#pragma unroll
        for (int bi = 0; bi < 2; ++bi) { const bf16x8 xf = X.frag(16 * (bt0 + bi) + fr, 32 * s + 8 * fq);
            acc[bi] = __builtin_amdgcn_mfma_f32_16x16x32_bf16(xf, yf, acc[bi], 0, 0, 0); }
    }
#pragma unroll
    for (int bi = 0; bi < 2; ++bi) epi(16 * at + fr, 16 * (bt0 + bi) + 4 * fq, acc[bi]);
}
__device__ __forceinline__ void ld_yf(const LdsMat& Y, int at, int fr, int fq, bf16x8 (&y)[2]) {
#pragma unroll
    for (int s = 0; s < 2; ++s) y[s] = Y.frag(16 * at + fr, 32 * s + 8 * fq);
}
__device__ __forceinline__ void ld_xf(const LdsMat& X, int bt0, int fr, int fq, bf16x8 (&x)[2][2]) {
#pragma unroll
    for (int s = 0; s < 2; ++s)
#pragma unroll
        for (int bi = 0; bi < 2; ++bi) x[s][bi] = X.frag(16 * (bt0 + bi) + fr, 32 * s + 8 * fq);
}
__device__ __forceinline__ void mm_f(const bf16x8 (&y)[2], const bf16x8 (&x)[2][2], f32x4 (&acc)[2]) {
#pragma unroll
    for (int bi = 0; bi < 2; ++bi) acc[bi] = (f32x4){0.f, 0.f, 0.f, 0.f};
#pragma unroll
    for (int s = 0; s < 2; ++s)
#pragma unroll
        for (int bi = 0; bi < 2; ++bi) acc[bi] = __builtin_amdgcn_mfma_f32_16x16x32_bf16(x[s][bi], y[s], acc[bi], 0, 0, 0);
}
template <int KD>
__device__ __forceinline__ void preload_x(const GlbMat& X, int wid, int lane, bf16x8 (&xf)[KD / 32][2]) {
    const int bt0 = (wid & 1) * 2, fr = lane & 15, fq = lane >> 4;
#pragma unroll
    for (int s = 0; s < KD / 32; ++s)
#pragma unroll
        for (int bi = 0; bi < 2; ++bi) xf[s][bi] = X.frag(16 * (bt0 + bi) + fr, 32 * s + 8 * fq);
}
template <int KD, class YM, class EPI>
__device__ __forceinline__ void mm64_pre(const YM& Y, const bf16x8 (&xf)[KD / 32][2], int wid, int lane, const EPI& epi) {
    const int at = wid >> 1, bt0 = (wid & 1) * 2, fr = lane & 15, fq = lane >> 4;
    f32x4 acc[2] = {(f32x4){0.f, 0.f, 0.f, 0.f}, (f32x4){0.f, 0.f, 0.f, 0.f}};
#pragma unroll
    for (int s = 0; s < KD / 32; ++s) {
        const bf16x8 yf = Y.frag(16 * at + fr, 32 * s + 8 * fq);
#pragma unroll
        for (int bi = 0; bi < 2; ++bi) acc[bi] = __builtin_amdgcn_mfma_f32_16x16x32_bf16(xf[s][bi], yf, acc[bi], 0, 0, 0);
    }
#pragma unroll
    for (int bi = 0; bi < 2; ++bi) epi(16 * at + fr, 16 * (bt0 + bi) + 4 * fq, acc[bi]);
}
__device__ __forceinline__ void st_lds4(LAS unsigned char* base, int a, int b0, f32x4 v) { u32x2 w; w.x = cvt_pk_bf16(v[0], v[1]); w.y = cvt_pk_bf16(v[2], v[3]); *(LAS u32x2*)(base + ((size_t)a * LW + b0) * 2) = w; }
__device__ __forceinline__ f32x4 ld_lds4(LAS const unsigned char* base, int a, int b0) { const u32x2 w = *(LAS const u32x2*)(base + ((size_t)a * LW + b0) * 2); return (f32x4){bf_lo(w.x), bf_hi(w.x), bf_lo(w.y), bf_hi(w.y)}; }
__device__ __forceinline__ void st_glb4p(bf16_t* base, int a, int b0, f32x4 v) { u32x2 w; w.x = cvt_pk_bf16(v[0], v[1]); w.y = cvt_pk_bf16(v[2], v[3]); __builtin_nontemporal_store(w, (u32x2*)(base + (size_t)a * GLD + b0)); }
__device__ __forceinline__ void st_glb4(bf16_t* base, int a, int b0, f32x4 v) { u32x2 w; w.x = cvt_pk_bf16(v[0], v[1]); w.y = cvt_pk_bf16(v[2], v[3]); __builtin_nontemporal_store(w, (u32x2*)(base + (size_t)a * 64 + b0)); }

struct PrePf { u32x4 qa[3], qp[3], ra[4], rp[4], wt[4]; };
__device__ __forceinline__ void rwkv_pre_fetch(Frame& F, int unit, bool lr_first, PrePf& P, int tid) {
    const int bh = unit >> 6, c = unit & 63, b = bh >> 3, h = bh & 7;
    const int t = tid >> 3, jb = tid & 7, j0 = jb * 8;
    const int tg = b * SEQ + c * 64 + t;
    const bool hasprev = (c * 64 + t) > 0;
    const bf16_t* prow = (const bf16_t*)(F.ws + WS_PR) + (size_t)tg * NRW; const bf16_t* pprv = hasprev ? prow - NRW : prow;
#pragma unroll
    for (int seg = 0; seg < 3; ++seg) { const int col = seg * 512 + h * 64 + j0; P.qa[seg] = *(const u32x4*)(prow + col); P.qp[seg] = *(const u32x4*)(pprv + col); }
    const u32x4* scr = (const u32x4*)(F.ws + WS_LRSCR) + ((size_t)F.vcu * 512 + tid) * 4;
    const u32x4* pa = lr_first ? (const u32x4*)(prow + 1536 + jb * 32) : scr; const u32x4* pp = lr_first ? (const u32x4*)(pprv + 1536 + jb * 32) : scr;
#pragma unroll
    for (int q4 = 0; q4 < 4; ++q4) { P.ra[q4] = pa[q4]; P.rp[q4] = pp[q4]; }
    P.wt[0] = ((const u32x4*)(F.ws + WS_W2T) + (size_t)h * 512)[tid]; P.wt[1] = ((const u32x4*)(F.ws + WS_A2T) + (size_t)h * 512)[tid];
    P.wt[2] = ((const u32x4*)(F.ws + WS_G2T) + (size_t)h * 1024)[tid]; P.wt[3] = ((const u32x4*)(F.ws + WS_G2T) + (size_t)h * 1024)[512 + tid];
}
__device__ __forceinline__ void rwkv_pre_put_w(LAS unsigned char* L, const PrePf& P, int tid) {
    const int r8 = tid >> 3, c8 = tid & 7, r16 = tid >> 4, c16 = tid & 15;
    *(LAS u32x4*)(L + SL(10) + ((size_t)r8 * LW + c8 * 8) * 2) = P.wt[0]; *(LAS u32x4*)(L + SL(11) + ((size_t)r8 * LW + c8 * 8) * 2) = P.wt[1];
    *(LAS u32x4*)(L + SL(12) + ((size_t)r16 * 136 + c16 * 8) * 2) = P.wt[2]; *(LAS u32x4*)(L + SL(12) + ((size_t)(32 + r16) * 136 + c16 * 8) * 2) = P.wt[3];
}
__device__ __forceinline__ void rwkv_pre_unit(Frame& F, int unit, int next_unit, bool lr_first, bool next_first, PrePf& P) {
    LAS unsigned char* L = F.lds;
    LAS float* XT = (LAS float*)(F.lds + XTRA_OFF);
    int tid = F.tid; asm volatile("" : "+v"(tid));
    int wid = F.wave; asm volatile("" : "+s"(wid));
    const int lane = tid & 63;
    const int bh = unit >> 6, c = unit & 63, b = bh >> 3, h = bh & 7;
    const int t = tid >> 3, jb = tid & 7, j0 = jb * 8;
    const int tg = b * SEQ + c * 64 + t;
    const bool hasprev = (c * 64 + t) > 0;
    const bf16_t* PR = (const bf16_t*)(F.ws + WS_PR);
    const bf16_t* prow = PR + (size_t)tg * NRW; const bf16_t* pprev = prow - NRW;
    LAS const float* mu = (LAS const float*)(F.lds + XTRA_OFF + 4096);
    LAS const float* par = mu + NRW;
    float rs[8], ks[8], vs[8];
    {
        const int c0 = 1536 + jb * 32;
        const float pmask = hasprev ? 1.f : 0.f;
        f32x4 mq[3][2];
#pragma unroll
        for (int seg = 0; seg < 3; ++seg) { const int col = seg * 512 + h * 64 + j0; mq[seg][0] = *(LAS const f32x4*)(mu + col); mq[seg][1] = *(LAS const f32x4*)(mu + col + 4); }
        LAS unsigned char* dst = (jb < 2) ? (L + SL(0) + ((size_t)t * LW + jb * 32) * 2) : (jb < 4) ? (L + SL(1) + ((size_t)t * LW + (jb - 2) * 32) * 2) : (L + SL(2) + ((size_t)t * 136 + (jb - 4) * 32) * 2);
        u32x4* scr = (u32x4*)(F.ws + WS_LRSCR) + ((size_t)F.vcu * 512 + tid) * 4;
        if (lr_first) {
            f32x4 ma[4][2];
#pragma unroll
            for (int q4 = 0; q4 < 4; ++q4) { ma[q4][0] = *(LAS const f32x4*)(mu + c0 + q4 * 8); ma[q4][1] = *(LAS const f32x4*)(mu + c0 + q4 * 8 + 4); }
#pragma unroll
            for (int q4 = 0; q4 < 4; ++q4) { float x[8], xp[8], o[8]; unpack8(P.ra[q4], x); unpack8(P.rp[q4], xp);
#pragma unroll
                for (int e = 0; e < 8; ++e) { const float mm = e < 4 ? ma[q4][0][e] : ma[q4][1][e - 4]; const float s = x[e] + (xp[e] * pmask - x[e]) * mm;
                    const float ex = __builtin_amdgcn_exp2f((jb < 2 ? 2.88539008178f : -1.44269504089f) * s), rc = __builtin_amdgcn_rcpf(1.0f + ex);
                    o[e] = jb < 2 ? 1.0f - 2.0f * rc : (jb < 4 ? s : rc); }
                const u32x4 w = pack8(o); *(LAS u32x4*)(dst + q4 * 16) = w; scr[q4] = w; }
        } else {
#pragma unroll
            for (int q4 = 0; q4 < 4; ++q4) *(LAS u32x4*)(dst + q4 * 16) = P.ra[q4];
        }
#pragma unroll
        for (int seg = 0; seg < 3; ++seg) { float x[8], xp[8]; unpack8(P.qa[seg], x); unpack8(P.qp[seg], xp);
#pragma unroll
            for (int e = 0; e < 8; ++e) { const float mm = e < 4 ? mq[seg][0][e] : mq[seg][1][e - 4]; const float s = x[e] + (xp[e] * pmask - x[e]) * mm; if (seg == 0) rs[e] = s; else if (seg == 1) ks[e] = s; else vs[e] = s; } }
    }
    BAR_LDS();
    {
        const LdsMat Yw{L + SL(0), LW}, Ya{L + SL(1), LW}, Yg{L + SL(2), 136};
        const LdsMat Xw{L + SL(10), LW}, Xa{L + SL(11), LW}, Xg{L + SL(12), 136};
        mm64<64>(Yw, Xw, wid, lane, [&](int a, int b0, f32x4 v) { *(LAS f32x4*)(L + SL(4) + ((size_t)a * 68 + b0) * 4) = v; });
        mm64<64>(Ya, Xa, wid, lane, [&](int a, int b0, f32x4 v) { *(LAS f32x4*)(L + SL(6) + ((size_t)a * 68 + b0) * 4) = v; });
        mm64<128>(Yg, Xg, wid, lane, [&](int a, int b0, f32x4 v) { *(LAS f32x4*)(L + SL(8) + ((size_t)a * 68 + b0) * 4) = v; });
    }
    BAR_LDS();
    float ld[8], kp[8], av[8], bv[8];
    {
        const int hc = h * 64 + j0;
        float wp[8], ap[8], gg[8], w0[8], a0[8], kkw[8], kaw[8], rk[8];
        *(f32x4*)&wp[0] = *(LAS f32x4*)(L + SL(4) + ((size_t)t * 68 + j0) * 4); *(f32x4*)&wp[4] = *(LAS f32x4*)(L + SL(4) + ((size_t)t * 68 + j0 + 4) * 4);
        *(f32x4*)&ap[0] = *(LAS f32x4*)(L + SL(6) + ((size_t)t * 68 + j0) * 4); *(f32x4*)&ap[4] = *(LAS f32x4*)(L + SL(6) + ((size_t)t * 68 + j0 + 4) * 4);
        *(f32x4*)&gg[0] = *(LAS f32x4*)(L + SL(8) + ((size_t)t * 68 + j0) * 4); *(f32x4*)&gg[4] = *(LAS f32x4*)(L + SL(8) + ((size_t)t * 68 + j0 + 4) * 4);
        *(f32x4*)&w0[0] = *(LAS const f32x4*)(par + 0 + hc); *(f32x4*)&w0[4] = *(LAS const f32x4*)(par + 0 + hc + 4);
        *(f32x4*)&a0[0] = *(LAS const f32x4*)(par + 512 + hc); *(f32x4*)&a0[4] = *(LAS const f32x4*)(par + 512 + hc + 4);
        *(f32x4*)&kkw[0] = *(LAS const f32x4*)(par + 1024 + hc); *(f32x4*)&kkw[4] = *(LAS const f32x4*)(par + 1024 + hc + 4);
        *(f32x4*)&kaw[0] = *(LAS const f32x4*)(par + 1536 + hc); *(f32x4*)&kaw[4] = *(LAS const f32x4*)(par + 1536 + hc + 4);
        *(f32x4*)&rk[0] = *(LAS const f32x4*)(par + 2048 + hc); *(f32x4*)&rk[4] = *(LAS const f32x4*)(par + 2048 + hc + 4);
        float ss = 0.f, bon = 0.f, kkv[8], eta[8];
#pragma unroll
        for (int e = 0; e < 8; ++e) {
            ld[e] = -0.60653065971f * fsigmoid(w0[e] + wp[e]);
            eta[e] = fsigmoid(a0[e] + ap[e]);
            kkv[e] = ks[e] * kkw[e]; ss += kkv[e] * kkv[e];
            kp[e] = ks[e] * (1.0f + (eta[e] - 1.0f) * kaw[e]);
            bon += rs[e] * kp[e] * rk[e];
        }
        ss += __shfl_xor(ss, 1); ss += __shfl_xor(ss, 2); ss += __shfl_xor(ss, 4);
        bon += __shfl_xor(bon, 1); bon += __shfl_xor(bon, 2); bon += __shfl_xor(bon, 4);
        const float inv = __builtin_amdgcn_rcpf(fmaxf(__builtin_amdgcn_sqrtf(ss), 1e-12f));
#pragma unroll
        for (int e = 0; e < 8; ++e) { const float kk = kkv[e] * inv; av[e] = -kk; bv[e] = kk * eta[e]; }
        if (jb == 0) ((float*)(F.ws + WS_BONUS))[(size_t)tg * 8 + h] = bon;
        *(u32x4*)((bf16_t*)(F.ws + WS_GBUF) + (size_t)tg * RW + hc) = pack8(gg);
    }
    float Lc[8];
#pragma unroll
    for (int e = 0; e < 8; ++e) { float x = ld[e];
        float y = __shfl_up(x, 8); if (lane >= 8) x += y;
        y = __shfl_up(x, 16); if (lane >= 16) x += y;
        y = __shfl_up(x, 32); if (lane >= 32) x += y;
        Lc[e] = x; }
    if (lane >= 56) {
#pragma unroll
        for (int e = 0; e < 8; ++e) XT[wid * 64 + j0 + e] = Lc[e]; }
    BAR_LDS();
    {
        float pre[8];
#pragma unroll
        for (int e = 0; e < 8; ++e) pre[e] = 0.f;
#pragma unroll
        for (int w = 0; w < 7; ++w) if (w < wid) { const f32x4 x0 = *(LAS const f32x4*)(XT + w * 64 + j0), x1 = *(LAS const f32x4*)(XT + w * 64 + j0 + 4);
#pragma unroll
            for (int e = 0; e < 4; ++e) { pre[e] += x0[e]; pre[4 + e] += x1[e]; } }
#pragma unroll
        for (int e = 0; e < 8; ++e) Lc[e] += pre[e];
    }
    if (t == 63) {
#pragma unroll
        for (int e = 0; e < 8; ++e) XT[512 + j0 + e] = fexp(Lc[e]); }
    {
        float o0[8], o1[8], o2[8], o3[8];
#pragma unroll
        for (int e = 0; e < 8; ++e) { const float ein = fexp(Lc[e]), eout = __builtin_amdgcn_rcpf(ein), eex = fexp(Lc[e] - ld[e]);
            o0[e] = rs[e] * ein; o1[e] = kp[e] * eout; o2[e] = av[e] * eex; o3[e] = bv[e] * eout; }
        const size_t off = ((size_t)t * LW + j0) * 2;
        *(LAS u32x4*)(L + SL(10) + off) = pack8(o0); *(LAS u32x4*)(L + SL(11) + off) = pack8(o1); *(LAS u32x4*)(L + SL(12) + off) = pack8(o2); *(LAS u32x4*)(L + SL(13) + off) = pack8(o3);
        *(LAS u32x4*)(L + SL(2) + off) = pack8(vs);
    }
    BAR_LDS();
    {
        const int srcs[4] = {12, 13, 11, 2}, dsts[4] = {4, 5, 6, 7};
#pragma unroll
        for (int q = 0; q < 4; ++q) { unsigned short hv[8];
#pragma unroll
            for (int e = 0; e < 8; ++e) hv[e] = *(LAS const unsigned short*)(L + SL(srcs[q]) + ((size_t)(8 * wid + e) * LW + lane) * 2);
            u32x4 w; w.x = hv[0] | ((unsigned)hv[1] << 16); w.y = hv[2] | ((unsigned)hv[3] << 16); w.z = hv[4] | ((unsigned)hv[5] << 16); w.w = hv[6] | ((unsigned)hv[7] << 16);
            *(LAS u32x4*)(L + SL(dsts[q]) + ((size_t)lane * LW + 8 * wid) * 2) = w;
        }
    }
    BAR_LDS();
    if (next_unit < NUNIT) rwkv_pre_fetch(F, next_unit, next_first, P, tid);
    const int crow = tid >> 3, cch = tid & 7;
    __builtin_nontemporal_store(*(LAS const u32x4*)(L + SL(7) + ((size_t)crow * LW + cch * 8) * 2), (u32x4*)((bf16_t*)(F.ws + WS_VT) + (size_t)unit * 4096 + crow * 64 + cch * 8));
    {
        const LdsMat Rt{L + SL(10), LW}, Kt{L + SL(11), LW}, At{L + SL(12), LW}, Bt{L + SL(13), LW};
        f32x4 nd = (f32x4){0.f, 0.f, 0.f, 0.f}, ntd = nd;
        {
            int ln = lane, wd = wid; asm volatile("" : "+v"(ln), "+s"(wd));
            const int at = wd >> 1, bt0 = (wd & 1) * 2, fr = ln & 15, fq = ln >> 4, a = 16 * at + fr;
            bf16x8 yA[2], yK[2], yR[2], xB[2][2], xA[2][2], xK[2][2];
            ld_yf(At, at, fr, fq, yA); ld_xf(Bt, bt0, fr, fq, xB); ld_yf(Kt, at, fr, fq, yK); ld_xf(At, bt0, fr, fq, xA); ld_yf(Rt, at, fr, fq, yR); ld_xf(Kt, bt0, fr, fq, xK);
            const bool diag = bt0 == (at & 2);
            bf16x8 xd[2];
            if (diag) ld_yf(Bt, at, fr, fq, xd);
            f32x4 c0[2], c1[2], c2[2], c3[2];
            mm_f(yA, xB, c0); mm_f(yK, xA, c1); mm_f(yR, xB, c2); mm_f(yR, xK, c3);
            if (diag) {
                f32x4 v = (f32x4){0.f, 0.f, 0.f, 0.f};
#pragma unroll
                for (int s = 0; s < 2; ++s) v = __builtin_amdgcn_mfma_f32_16x16x32_bf16(yA[s], xd[s], v, 0, 0, 0);
#pragma unroll
                for (int e = 0; e < 4; ++e) v[e] = (fr < 4 * fq + e) ? v[e] : 0.f;
                nd = v; }
#pragma unroll
            for (int bi = 0; bi < 2; ++bi) { const int b0 = 16 * (bt0 + bi) + 4 * fq; f32x4 v0 = c0[bi], v1 = c1[bi], v2 = c2[bi], v3 = c3[bi];
#pragma unroll
                for (int e = 0; e < 4; ++e) { v0[e] = (b0 + e < a) ? v0[e] : 0.f; v1[e] = (a < b0 + e) ? v1[e] : 0.f; v2[e] = (b0 + e <= a) ? v2[e] : 0.f; v3[e] = (b0 + e <= a) ? v3[e] : 0.f; }
                st_lds4(L + SL(1), a, b0, v0); st_lds4(L + SL(2), a, b0, v1); st_lds4(L + SL(3), a, b0, v2); st_lds4(L + SL(8), a, b0, v3);
                if (bt0 + bi == at) ntd = v0; }
        }
        const int at = wid >> 1;
        if (((wid & 1) * 2 == (at & 2))) {
            const int fr = lane & 15, fq = lane >> 4;
            auto op = [](f32x4 v) { u32x4 w; w.x = cvt_pk_bf16(v[0], v[1]); w.y = cvt_pk_bf16(v[2], v[3]); w.z = 0u; w.w = 0u; return __builtin_bit_cast(bf16x8, w); };
            const f32x4 zero = (f32x4){0.f, 0.f, 0.f, 0.f};
            const f32x4 Lm = ntd, LT = nd;
            f32x4 Q = Lm;
#pragma unroll
            for (int e = 0; e < 4; ++e) Q[e] += (4 * fq + e == fr) ? 1.f : 0.f;
            const f32x4 L2 = __builtin_amdgcn_mfma_f32_16x16x32_bf16(op(LT), op(Lm), zero, 0, 0, 0), L2T = __builtin_amdgcn_mfma_f32_16x16x32_bf16(op(Lm), op(LT), zero, 0, 0, 0);
            Q = __builtin_amdgcn_mfma_f32_16x16x32_bf16(op(L2T), op(Q), Q, 0, 0, 0);
            const f32x4 L4 = __builtin_amdgcn_mfma_f32_16x16x32_bf16(op(L2T), op(L2), zero, 0, 0, 0), L4T = __builtin_amdgcn_mfma_f32_16x16x32_bf16(op(L2), op(L2T), zero, 0, 0, 0);
            Q = __builtin_amdgcn_mfma_f32_16x16x32_bf16(op(L4T), op(Q), Q, 0, 0, 0);
            const f32x4 L8T = __builtin_amdgcn_mfma_f32_16x16x32_bf16(op(L4), op(L4T), zero, 0, 0, 0);
            Q = __builtin_amdgcn_mfma_f32_16x16x32_bf16(op(L8T), op(Q), Q, 0, 0, 0);
            st_lds4(L + SL(9), 16 * at + fr, 4 * fq, Q);
        }
    }
    BAR_LDS();
    {
        const int fr = lane & 15, fq = lane >> 4;
        LAS const unsigned char* zsl = L + (wid < 4 ? SL(4) : SL(2)); LAS unsigned char* dsl = L + (wid < 4 ? SL(11) : SL(12));
        const int arow = 16 * (wid & 3) + fr;
        u32x2 zp[4];
#pragma unroll
        for (int c = 0; c < 4; ++c) {
            f32x4 acc = ld_lds4(zsl, arow, 16 * c + 4 * fq);
            if (c >= 1) {
                const u32x2 alo = *(LAS const u32x2*)(L + SL(1) + ((size_t)(16 * c + fr) * LW + 4 * fq) * 2), ahi = *(LAS const u32x2*)(L + SL(1) + ((size_t)(16 * c + fr) * LW + 16 + 4 * fq) * 2);
                u32x4 aw; aw.x = alo.x; aw.y = alo.y; aw.z = ahi.x; aw.w = ahi.y;
                u32x4 bw; bw.x = zp[0].x; bw.y = zp[0].y; bw.z = c >= 2 ? zp[1].x : 0u; bw.w = c >= 2 ? zp[1].y : 0u;
                acc = __builtin_amdgcn_mfma_f32_16x16x32_bf16(__builtin_bit_cast(bf16x8, aw), __builtin_bit_cast(bf16x8, bw), acc, 0, 0, 0); }
            if (c == 3) {
                const u32x2 alo = *(LAS const u32x2*)(L + SL(1) + ((size_t)(48 + fr) * LW + 32 + 4 * fq) * 2);
                u32x4 aw; aw.x = alo.x; aw.y = alo.y; aw.z = 0u; aw.w = 0u;
                u32x4 bw; bw.x = zp[2].x; bw.y = zp[2].y; bw.z = 0u; bw.w = 0u;
                acc = __builtin_amdgcn_mfma_f32_16x16x32_bf16(__builtin_bit_cast(bf16x8, aw), __builtin_bit_cast(bf16x8, bw), acc, 0, 0, 0); }
            const u32x2 dlo = *(LAS const u32x2*)(L + SL(9) + ((size_t)(16 * c + fr) * LW + 4 * fq) * 2);
            u32x4 aw; aw.x = dlo.x; aw.y = dlo.y; aw.z = 0u; aw.w = 0u;
            u32x4 bw; bw.x = cvt_pk_bf16(acc[0], acc[1]); bw.y = cvt_pk_bf16(acc[2], acc[3]); bw.z = 0u; bw.w = 0u;
            const f32x4 r = __builtin_amdgcn_mfma_f32_16x16x32_bf16(__builtin_bit_cast(bf16x8, aw), __builtin_bit_cast(bf16x8, bw), (f32x4){0.f, 0.f, 0.f, 0.f}, 0, 0, 0);
            zp[c].x = cvt_pk_bf16(r[0], r[1]); zp[c].y = cvt_pk_bf16(r[2], r[3]);
            *(LAS u32x2*)(dsl + ((size_t)arow * LW + 16 * c + 4 * fq) * 2) = zp[c];
        }
    }
    BAR_LDS();
    {
        const int sAT = 11, sAkT = 12, sHk = 0;
        const LdsMat AT{L + SL(sAT), LW}, AkT{L + SL(sAkT), LW}, AbrT{L + SL(3), LW}, BgT{L + SL(5), LW}, VTm{L + SL(7), LW};
        bf16_t* QRT = (bf16_t*)(F.ws + WS_QRT) + (size_t)unit * 4096; bf16_t* WYT = (bf16_t*)(F.ws + WS_WYT) + (size_t)unit * 4096;
        bf16_t* GTg = (bf16_t*)(F.dout + DO_GT) + (size_t)unit * (64 * GLD); bf16_t* Hg = (bf16_t*)(F.dout + DO_H) + (size_t)unit * (64 * GLD);
        {
            int ln = lane, wd = wid; asm volatile("" : "+v"(ln), "+s"(wd));
            const int at = wd >> 1, bt0 = (wd & 1) * 2, fr = ln & 15, fq = ln >> 4, a = 16 * at + fr;
            bf16x8 yA[2], yB[2], xT[2][2], xK[2][2];
            ld_yf(BgT, at, fr, fq, yB); ld_xf(AkT, bt0, fr, fq, xK); ld_yf(AbrT, at, fr, fq, yA); ld_xf(AT, bt0, fr, fq, xT);
            f32x4 eH[2], eR[2], eW[2];
#pragma unroll
            for (int bi = 0; bi < 2; ++bi) { const int b0 = 16 * (bt0 + bi) + 4 * fq; eH[bi] = ld_lds4(L + SL(6), a, b0); eR[bi] = ld_lds4(L + SL(10), a, b0); eW[bi] = ld_lds4(L + SL(8), a, b0); }
            const float gdiag = XT[512 + a];
            f32x4 cH[2], cQ[2], cW[2], cG[2];
            mm_f(yB, xK, cH); mm_f(yA, xT, cQ); mm_f(yA, xK, cW); mm_f(yB, xT, cG);
#pragma unroll
            for (int bi = 0; bi < 2; ++bi) { const int b0 = 16 * (bt0 + bi) + 4 * fq;
                st_lds4(L + SL(sHk), a, b0, (cH[bi] + eH[bi]) * gdiag);
                st_lds4(L + SL(1), a, b0, cQ[bi] + eR[bi]);
                st_lds4(L + SL(2), a, b0, cW[bi] + eW[bi]);
                f32x4 v = cG[bi];
#pragma unroll
                for (int e = 0; e < 4; ++e) v[e] += (b0 + e == a) ? 1.f : 0.f;
                st_lds4(L + SL(4), a, b0, v * gdiag); }
        }
        BAR_LDS();
        const LdsMat HkT{L + SL(sHk), LW};
        mm64<64>(VTm, HkT, wid, lane, [&](int a, int b0, f32x4 v) { st_lds4(L + SL(9), a, b0, v); });
        __builtin_nontemporal_store(*(LAS const u32x4*)(L + SL(1) + ((size_t)crow * LW + cch * 8) * 2), (u32x4*)(QRT + crow * 64 + cch * 8));
        __builtin_nontemporal_store(*(LAS const u32x4*)(L + SL(2) + ((size_t)crow * LW + cch * 8) * 2), (u32x4*)(WYT + crow * 64 + cch * 8));
        __builtin_nontemporal_store(*(LAS const u32x4*)(L + SL(4) + (size_t)tid * 16), (u32x4*)GTg + tid);
        if (tid < 64) __builtin_nontemporal_store(*(LAS const u32x4*)(L + SL(4) + (size_t)(512 + tid) * 16), (u32x4*)GTg + 512 + tid);
        if (next_unit < NUNIT) rwkv_pre_put_w(L, P, tid);
        BAR_LDS();
        __builtin_nontemporal_store(*(LAS const u32x4*)(L + SL(9) + (size_t)tid * 16), (u32x4*)Hg + tid);
        if (tid < 64) __builtin_nontemporal_store(*(LAS const u32x4*)(L + SL(9) + (size_t)(512 + tid) * 16), (u32x4*)Hg + 512 + tid);
    }
}

constexpr int RS_SLOT = 12 * 1024;
constexpr int RS_DEPTH = 8, RS_AHEAD = 6;
__device__ __forceinline__ void rwkv_scan_block(Frame& F, int item) {
    const int bh = item >> 2, qi = item & 3, lane = F.lane, fr = lane & 15, fq = lane >> 4, wid = F.wave;
    const char* GTg = (const char*)(F.dout + DO_GT) + (size_t)bh * 64 * (64 * GLD * 2);
    const char* Hg = (const char*)(F.dout + DO_H) + (size_t)bh * 64 * (64 * GLD * 2) + (size_t)qi * (16 * GLD * 2);
    bf16_t* SST = (bf16_t*)(F.dout + DO_SST) + (size_t)bh * 64 * 4096;
    LAS unsigned char* L = F.lds;
    auto issue = [&](int c) {
        if (wid >= 1) {
            LAS unsigned char* slot = L + (c & (RS_DEPTH - 1)) * RS_SLOT;
#pragma unroll
            for (int k = 0; k < 2; ++k) { const int pc = (wid - 1) + 7 * k;
                if (pc < 12) {
                    const char* src;
                    if (pc < 9) src = GTg + (size_t)c * (64 * GLD * 2) + pc * 1024 + lane * 16;
                    else { int off = (pc - 9) * 1024 + lane * 16; off = off > 2304 - 16 ? 2304 - 16 : off; src = Hg + (size_t)c * (64 * GLD * 2) + off; }
                    __builtin_amdgcn_global_load_lds((const unsigned*)src, (LAS unsigned*)(slot + pc * 1024), 16, 0, 0); } }
        }
    };
    f32x4 acc[4];
#pragma unroll
    for (int mt = 0; mt < 4; ++mt) acc[mt] = (f32x4){0.f, 0.f, 0.f, 0.f};
#pragma unroll 1
    for (int c = 0; c < RS_AHEAD; ++c) issue(c);
#pragma unroll 1
    for (int c = 0; c < NCH; ++c) {
        if (c + RS_AHEAD < NCH) issue(c + RS_AHEAD);
        if (c + RS_AHEAD < NCH) { if (wid >= 1 && wid <= 5) asm volatile("s_waitcnt vmcnt(12)" ::: "memory"); else if (wid >= 6) asm volatile("s_waitcnt vmcnt(6)" ::: "memory"); }
        else if (wid >= 1) asm volatile("s_waitcnt vmcnt(0)" ::: "memory");
        __builtin_amdgcn_s_barrier(); asm volatile("" ::: "memory");
        if (wid == 0) {
            LAS const unsigned char* slot = L + (c & (RS_DEPTH - 1)) * RS_SLOT;
            u32x2 ga[4][2][2], hv[4];
#pragma unroll
            for (int mt = 0; mt < 4; ++mt) {
#pragma unroll
                for (int s = 0; s < 2; ++s)
#pragma unroll
                    for (int hh = 0; hh < 2; ++hh) ga[mt][s][hh] = *(LAS const u32x2*)(slot + ((16 * mt + fr) * GLD + 16 * (2 * s + hh) + 4 * fq) * 2);
                hv[mt] = *(LAS const u32x2*)(slot + 9216 + (fr * GLD + 16 * mt + 4 * fq) * 2); }
            bf16_t* Sc = SST + (size_t)c * 4096; u32x2 sp[4];
#pragma unroll
            for (int mt = 0; mt < 4; ++mt) { sp[mt].x = cvt_pk_bf16(acc[mt][0], acc[mt][1]); sp[mt].y = cvt_pk_bf16(acc[mt][2], acc[mt][3]);
                *(u32x2*)(Sc + (size_t)(16 * qi + fr) * 64 + 16 * mt + 4 * fq) = sp[mt]; }
            bf16x8 sb[2];
#pragma unroll
            for (int s = 0; s < 2; ++s) { u32x4 w; w.x = sp[2 * s].x; w.y = sp[2 * s].y; w.z = sp[2 * s + 1].x; w.w = sp[2 * s + 1].y; sb[s] = __builtin_bit_cast(bf16x8, w); }
#pragma unroll
            for (int mt = 0; mt < 4; ++mt) { f32x4 a = (f32x4){bf_lo(hv[mt].x), bf_hi(hv[mt].x), bf_lo(hv[mt].y), bf_hi(hv[mt].y)};
#pragma unroll
                for (int s = 0; s < 2; ++s) { u32x4 w; w.x = ga[mt][s][0].x; w.y = ga[mt][s][0].y; w.z = ga[mt][s][1].x; w.w = ga[mt][s][1].y;
                    a = __builtin_amdgcn_mfma_f32_16x16x32_bf16(__builtin_bit_cast(bf16x8, w), sb[s], a, 0, 0, 0); }
                acc[mt] = a; }
            asm volatile("s_waitcnt lgkmcnt(0)" ::: "memory");
        }
    }
    asm volatile("s_waitcnt vmcnt(0)" ::: "memory");
    __builtin_amdgcn_s_barrier(); asm volatile("" ::: "memory");
}
__device__ __forceinline__ void s5_scan_block(Frame& F, int gb) {
    const int g = gb >> 3, b = gb & 7, p = F.lane, w = F.wave;
    const float* aL = (const float*)(F.ws + WS_AL) + g * 128; const float ar = aL[2 * p], ai = aL[2 * p + 1];
    const float* SLc = (const float*)(F.ws + WS_SLOC) + ((size_t)g * S5ROWS + b * 256 + 32 * w) * 128 + 2 * p;
    bf16_t* UG = (bf16_t*)(F.ws + WS_UG) + ((size_t)g * S5ROWS + b * 256 + 32 * w) * UGLD + 256 + 2 * p;
    LAS float* E = (LAS float*)(F.lds);
    f32x2 l[32];
#pragma unroll
    for (int k = 0; k < 32; ++k) l[k] = *(const f32x2*)(SLc + (size_t)k * 128);
    float sr = 0.f, si = 0.f;
#pragma unroll
    for (int k = 0; k < 32; ++k) { const float nr = ar * sr - ai * si + l[k].x, ni = ar * si + ai * sr + l[k].y; l[k].x = sr; l[k].y = si; sr = nr; si = ni; }
    E[(w * 64 + p) * 2] = sr; E[(w * 64 + p) * 2 + 1] = si;
    float pr = ar, pi = ai;
#pragma unroll
    for (int q = 0; q < 5; ++q) { const float nr = pr * pr - pi * pi, ni = 2.f * pr * pi; pr = nr; pi = ni; }
    asm volatile("s_waitcnt lgkmcnt(0)" ::: "memory"); __builtin_amdgcn_s_barrier(); asm volatile("" ::: "memory");
    float cr = 0.f, ci = 0.f;
#pragma unroll
    for (int w2 = 0; w2 < 7; ++w2) { if (w2 < w) { const float er = E[(w2 * 64 + p) * 2], ei = E[(w2 * 64 + p) * 2 + 1]; const float nr = pr * cr - pi * ci + er, ni = pr * ci + pi * cr + ei; cr = nr; ci = ni; } }
#pragma unroll
    for (int k = 0; k < 32; ++k) { *(unsigned*)(UG + (size_t)k * UGLD) = cvt_pk_bf16(l[k].x + cr, l[k].y + ci); const float nr = ar * cr - ai * ci, ni = ar * ci + ai * cr; cr = nr; ci = ni; }
    asm volatile("s_waitcnt lgkmcnt(0)" ::: "memory"); __builtin_amdgcn_s_barrier(); asm volatile("" ::: "memory");
}
struct OutY { bf16x8 yq[2], yw[2]; u32x2 pv[4], pp[4], gv[4]; float bon; };
__device__ __forceinline__ void rwkv_out_loady(Frame& F, int unit, int at, OutY& Lq) {
    const int lane = F.lane, fr = lane & 15, fq = lane >> 4;
    const int bh = unit >> 6, c = unit & 63, b = bh >> 3, h = bh & 7;
    const bf16_t* QRT = (const bf16_t*)(F.ws + WS_QRT) + (size_t)unit * 4096; const bf16_t* WYT = (const bf16_t*)(F.ws + WS_WYT) + (size_t)unit * 4096;
#pragma unroll
    for (int s = 0; s < 2; ++s) { Lq.yq[s] = __builtin_nontemporal_load((const bf16x8*)(QRT + (size_t)(16 * at + fr) * 64 + 32 * s + 8 * fq)); Lq.yw[s] = __builtin_nontemporal_load((const bf16x8*)(WYT + (size_t)(16 * at + fr) * 64 + 32 * s + 8 * fq)); }
    const int tl = c * 64 + 16 * at + fr, tg = b * SEQ + tl;
    const bf16_t* prow = (const bf16_t*)(F.ws + WS_PR) + (size_t)tg * NRW + 1024 + h * 64;
    const bf16_t* gb = (const bf16_t*)(F.ws + WS_GBUF) + (size_t)tg * RW + h * 64;
    Lq.bon = ((const float*)(F.ws + WS_BONUS))[(size_t)tg * 8 + h];
    const bf16_t* pprev = prow - (tl > 0 ? NRW : 0);
#pragma unroll
    for (int bt = 0; bt < 4; ++bt) { const int i0 = 16 * bt + 4 * fq; Lq.pv[bt] = *(const u32x2*)(prow + i0); Lq.pp[bt] = *(const u32x2*)(pprev + i0); Lq.gv[bt] = *(const u32x2*)(gb + i0); }
}
__device__ __forceinline__ void rwkv_out_comp(Frame& F, int unit, int at, const bf16x8 (&xs)[2][4], const bf16x8 (&xv)[2][4], const OutY& Lq) {
    const int lane = F.lane, fr = lane & 15, fq = lane >> 4;
    const int bh = unit >> 6, c = unit & 63, b = bh >> 3, h = bh & 7;
    f32x4 m4[4], lw[4], lb[4];
#pragma unroll
    for (int bt = 0; bt < 4; ++bt) { const int i0 = 16 * bt + 4 * fq; m4[bt] = *(const f32x4*)(F.in[I_MU] + 1024 + h * 64 + i0); lw[bt] = *(const f32x4*)(F.in[I_LNW] + h * 64 + i0); lb[bt] = *(const f32x4*)(F.in[I_LNB] + h * 64 + i0); }
    f32x4 acc[4];
#pragma unroll
    for (int bt = 0; bt < 4; ++bt) acc[bt] = (f32x4){0.f, 0.f, 0.f, 0.f};
#pragma unroll
    for (int s = 0; s < 2; ++s)
#pragma unroll
        for (int bt = 0; bt < 4; ++bt) {
            acc[bt] = __builtin_amdgcn_mfma_f32_16x16x32_bf16(xs[s][bt], Lq.yq[s], acc[bt], 0, 0, 0);
            acc[bt] = __builtin_amdgcn_mfma_f32_16x16x32_bf16(xv[s][bt], Lq.yw[s], acc[bt], 0, 0, 0); }
    float s1 = 0.f;
#pragma unroll
    for (int bt = 0; bt < 4; ++bt) s1 += (acc[bt][0] + acc[bt][1]) + (acc[bt][2] + acc[bt][3]);
    s1 += __shfl_xor(s1, 16); s1 += __shfl_xor(s1, 32);
    const float mean = s1 * (1.f / 64.f); float s2 = 0.f;
#pragma unroll
    for (int bt = 0; bt < 4; ++bt) { const f32x4 d = acc[bt] - mean; s2 += (d[0] * d[0] + d[1] * d[1]) + (d[2] * d[2] + d[3] * d[3]); }
    s2 += __shfl_xor(s2, 16); s2 += __shfl_xor(s2, 32);
    const float rstd = __builtin_amdgcn_rsqf(s2 * (1.f / 64.f) + 64e-5f);
    const int tl = c * 64 + 16 * at + fr, tg = b * SEQ + tl;
    const float pmask = tl > 0 ? 1.f : 0.f;
    bf16_t* YRS = (bf16_t*)(F.dout + DO_YRS) + (size_t)tg * D + h * 64;
#pragma unroll
    for (int bt = 0; bt < 4; ++bt) { const int i0 = 16 * bt + 4 * fq;
        const u32x2 pv = Lq.pv[bt], pp = Lq.pp[bt], gv = Lq.gv[bt];
        const float x[4] = {bf_lo(pv.x), bf_hi(pv.x), bf_lo(pv.y), bf_hi(pv.y)}, xp[4] = {bf_lo(pp.x) * pmask, bf_hi(pp.x) * pmask, bf_lo(pp.y) * pmask, bf_hi(pp.y) * pmask}, gg[4] = {bf_lo(gv.x), bf_hi(gv.x), bf_lo(gv.y), bf_hi(gv.y)};
        float o[4];
#pragma unroll
        for (int e = 0; e < 4; ++e) { const float vsh = x[e] + (xp[e] - x[e]) * m4[bt][e]; o[e] = ((acc[bt][e] - mean) * rstd * lw[bt][e] + lb[bt][e] + Lq.bon * vsh) * gg[e]; }
        u32x2 w; w.x = cvt_pk_bf16(o[0], o[1]); w.y = cvt_pk_bf16(o[2], o[3]); *(u32x2*)(YRS + i0) = w; }
}
__device__ __forceinline__ void rwkv_out_units(Frame& F) {
    const int lane = F.lane, fr = lane & 15, fq = lane >> 4;
    for (int unit = F.vcu * NWAVES + F.wave; unit < NUNIT; unit += F.G * NWAVES) {
        const bf16_t* VT = (const bf16_t*)(F.ws + WS_VT) + (size_t)unit * 4096; const bf16_t* SST = (const bf16_t*)(F.dout + DO_SST) + (size_t)unit * 4096;
        bf16x8 xs[2][4], xv[2][4]; OutY A, B;
#pragma unroll
        for (int s = 0; s < 2; ++s)
#pragma unroll
            for (int bt = 0; bt < 4; ++bt) { xs[s][bt] = __builtin_nontemporal_load((const bf16x8*)(SST + (size_t)(16 * bt + fr) * 64 + 32 * s + 8 * fq)); xv[s][bt] = __builtin_nontemporal_load((const bf16x8*)(VT + (size_t)(16 * bt + fr) * 64 + 32 * s + 8 * fq)); }
        rwkv_out_loady(F, unit, 0, A); rwkv_out_loady(F, unit, 1, B); __builtin_amdgcn_sched_barrier(0);
        rwkv_out_comp(F, unit, 0, xs, xv, A); __builtin_amdgcn_sched_barrier(0); rwkv_out_loady(F, unit, 2, A); __builtin_amdgcn_sched_barrier(0);
        rwkv_out_comp(F, unit, 1, xs, xv, B); __builtin_amdgcn_sched_barrier(0); rwkv_out_loady(F, unit, 3, B); __builtin_amdgcn_sched_barrier(0);
        rwkv_out_comp(F, unit, 2, xs, xv, A); __builtin_amdgcn_sched_barrier(0);
        rwkv_out_comp(F, unit, 3, xs, xv, B); __builtin_amdgcn_sched_barrier(0);
    }
}

__device__ __forceinline__ void p8_rows(Frame& F) {
    const int gw = F.vcu * NWAVES + F.wave, NGW = F.G * NWAVES, lane = F.lane;
    const bf16_t* MX = (const bf16_t*)(F.ws + WS_MIXED); const float* ST = (const float*)(F.ws + WS_STAT1); bf16_t* H2 = (bf16_t*)(F.ws + WS_H2); float* X1 = (float*)F.dout;
    f32x4 gp[4];
#pragma unroll
    for (int j = 0; j < 4; ++j) gp[j] = *(const f32x4*)(F.in[I_NMPOST] + 256 * j + 4 * lane);
    for (int m0 = gw; m0 < T; m0 += 2 * NGW) {
        int mm[2] = {m0, (m0 + NGW < T) ? m0 + NGW : m0};
        f32x4 xv[2][4]; u32x2 mw[2][4]; float st[2];
#pragma unroll
        for (int q = 0; q < 2; ++q) { st[q] = (lane < 16) ? ST[(size_t)mm[q] * 16 + lane] : 0.f;
#pragma unroll
            for (int j = 0; j < 4; ++j) { const int col = 256 * j + 4 * lane; xv[q][j] = __builtin_nontemporal_load((const f32x4*)(F.in[I_X] + (size_t)mm[q] * D + col)); mw[q][j] = __builtin_nontemporal_load((const u32x2*)(MX + (size_t)mm[q] * D + col)); } }
#pragma unroll
        for (int q = 0; q < 2; ++q) {
            const float rstd1 = __builtin_amdgcn_rsqf(wave_sum(st[q]) * (1.f / D) + 1e-6f);
            f32x4 v[4]; float s = 0.f;
#pragma unroll
            for (int j = 0; j < 4; ++j) { const int col = 256 * j + 4 * lane;
                v[j].x = xv[q][j].x + bf_lo(mw[q][j].x) * rstd1 * gp[j].x; v[j].y = xv[q][j].y + bf_hi(mw[q][j].x) * rstd1 * gp[j].y; v[j].z = xv[q][j].z + bf_lo(mw[q][j].y) * rstd1 * gp[j].z; v[j].w = xv[q][j].w + bf_hi(mw[q][j].y) * rstd1 * gp[j].w;
                s += (v[j].x * v[j].x + v[j].y * v[j].y) + (v[j].z * v[j].z + v[j].w * v[j].w);
                }
            const float rstd2 = __builtin_amdgcn_rsqf(wave_sum(s) * (1.f / D) + 1e-6f);
#pragma unroll
            for (int j = 0; j < 4; ++j) { u32x2 w; w.x = cvt_pk_bf16(v[j].x * rstd2, v[j].y * rstd2); w.y = cvt_pk_bf16(v[j].z * rstd2, v[j].w * rstd2); *(u32x2*)(H2 + (size_t)mm[q] * D + 256 * j + 4 * lane) = w; }
        }
    }
}
__device__ __forceinline__ void p12_rows(Frame& F) {
    const int gw = F.vcu * NWAVES + F.wave, NGW = F.G * NWAVES, lane = F.lane;
    const bf16_t* FB = (const bf16_t*)(F.ws + WS_F); const bf16_t* MX = (const bf16_t*)(F.ws + WS_MIXED);
    const float* ST1 = (const float*)(F.ws + WS_STAT1); const float* ST2 = (const float*)(F.ws + WS_STAT2); float* OUT = (float*)F.dout;
    f32x4 gp[4], gq[4];
#pragma unroll
    for (int j = 0; j < 4; ++j) { gp[j] = *(const f32x4*)(F.in[I_NMPOST] + 256 * j + 4 * lane); gq[j] = *(const f32x4*)(F.in[I_NFPOST] + 256 * j + 4 * lane); }
    for (int m0 = gw; m0 < T; m0 += 2 * NGW) {
        int mm[2] = {m0, (m0 + NGW < T) ? m0 + NGW : m0};
        f32x4 xv[2][4]; u32x2 mw[2][4], fw[2][4]; float s1[2], s2[2];
#pragma unroll
        for (int q = 0; q < 2; ++q) { s1[q] = (lane < 16) ? ST1[(size_t)mm[q] * 16 + lane] : 0.f; s2[q] = (lane < 16) ? ST2[(size_t)mm[q] * 16 + lane] : 0.f;
#pragma unroll
            for (int j = 0; j < 4; ++j) { const int col = 256 * j + 4 * lane; xv[q][j] = __builtin_nontemporal_load((const f32x4*)(F.in[I_X] + (size_t)mm[q] * D + col));
                mw[q][j] = __builtin_nontemporal_load((const u32x2*)(MX + (size_t)mm[q] * D + col)); fw[q][j] = __builtin_nontemporal_load((const u32x2*)(FB + (size_t)mm[q] * D + col)); } }
#pragma unroll
        for (int q = 0; q < 2; ++q) {
            const float rstd1 = __builtin_amdgcn_rsqf(wave_sum(s1[q]) * (1.f / D) + 1e-6f), rstd3 = __builtin_amdgcn_rsqf(wave_sum(s2[q]) * (1.f / D) + 1e-6f);
#pragma unroll
            for (int j = 0; j < 4; ++j) { const int col = 256 * j + 4 * lane; f32x4 o;
                o.x = xv[q][j].x + bf_lo(mw[q][j].x) * rstd1 * gp[j].x; o.y = xv[q][j].y + bf_hi(mw[q][j].x) * rstd1 * gp[j].y; o.z = xv[q][j].z + bf_lo(mw[q][j].y) * rstd1 * gp[j].z; o.w = xv[q][j].w + bf_hi(mw[q][j].y) * rstd1 * gp[j].w;
                o.x += bf_lo(fw[q][j].x) * rstd3 * gq[j].x; o.y += bf_hi(fw[q][j].x) * rstd3 * gq[j].y; o.z += bf_lo(fw[q][j].y) * rstd3 * gq[j].z; o.w += bf_hi(fw[q][j].y) * rstd3 * gq[j].w;
                __builtin_nontemporal_store(o, (f32x4*)(OUT + (size_t)mm[q] * D + col)); }
        }
    }
}

#ifndef MK_PER_PHASE
#define MK_PER_PHASE 0
#endif
constexpr int NPHASE = 12;
struct Args { const float* in[35]; float* out; unsigned char* ws; int ph_lo, ph_hi; };
static_assert(sizeof(Args) == 35 * 8 + 8 + 8 + 8, "Args has no padding");

__device__ __forceinline__ bool phase_begin(Frame& F) { unsigned long long z = 0; asm volatile("" : "+s"(z), "+v"(F.tid)); F.ws = F.ws0 + z; F.dout = F.dout0 + z;     F.lane = F.tid & 63; F.wave = __builtin_amdgcn_readfirstlane(F.tid >> 6); return true; }
__global__ void __launch_bounds__(NWAVES * 64, 2) fwd_kernel(Args args) {
    extern __shared__ __attribute__((aligned(16))) unsigned char lds_raw[];
    Frame F;
    F.lds = (LAS unsigned char*)lds_raw;
    F.MISC = (volatile LAS unsigned*)(F.lds + MISC_OFF);
    F.tid = threadIdx.x; F.lane = F.tid & 63; F.wave = __builtin_amdgcn_readfirstlane(F.tid >> 6);
    F.G = gridDim.x; { const int bx = blockIdx.x; F.vcu = (F.G % 8 == 0) ? (bx % 8) * (F.G / 8) + bx / 8 : bx; }
    F.ws0 = args.ws; F.dout0 = (unsigned char*)args.out; F.ws = F.ws0; F.dout = F.dout0; F.ctl = (gu32*)(args.ws + WS_CTL);
    F.in = (InTab)__builtin_amdgcn_kernarg_segment_ptr();
    for (int u = F.tid; u < (LDS_BYTES - LDSCTL_OFF) / 4; u += NWAVES * 64) ((LAS unsigned*)(F.lds + LDSCTL_OFF))[u] = 0u;
    __syncthreads();
    XcdBarrier bar; bar.bar = (unsigned*)(F.ctl + CW_BAR); bar.x = 0; bar.st = nullptr;
    if (!MK_PER_PHASE) bar = xcd_barrier_post((unsigned*)(F.ctl + CW_BAR), F.MISC + 8);
    const int lo = args.ph_lo, hi = args.ph_hi;
#ifndef PHMASK
#define PHMASK 0xffffffffu
#endif
#define IN(k) (((PHMASK >> (k)) & 1u) && lo <= (k) && (k) < hi && phase_begin(F))
#ifndef REPMASK
#define REPMASK 0u
#endif
#define REPS(k) ((((REPMASK) >> (k)) & 1u) ? 2 : 1)
#define PH(k) for (int rep_ = 0; rep_ < REPS(k); ++rep_, (rep_ < REPS(k) ? xcd_barrier(bar) : (void)0))
#define INQ(k) (lo <= (k) && (k) < hi)
#define SEAM(k) do { if (INQ(k) && INQ((k) + 1)) xcd_barrier(bar); } while (0)
#define WSB(off) ((bf16_t*)(F.ws + (off)))
    const int bx = (int)blockIdx.x;

    PH(0) if (IN(0)) { p0_prologue(F); }
    SEAM(0);
    PH(1) if (IN(1)) {
        pg8::Gemm g{D, D, D, 0}; pg8::StaticOrder S; S.init(WSB(WS_XN), WSB(WS_WIN), D, D, T, NIN, F.G, bx);
        EpiInProj E{WSB(WS_PR), WSB(WS_UG), WSB(WS_GATES), F.in[I_BGATE], 0};
        pg8::gemm_phase<EpiInProj, pg8::StaticOrder, true>(F.lds, g, S, E, F.tid);
        { const int rem = ((T / 256) * (NIN / 256)) % F.G;
          if (rem == 0) p0_late_mats(F, bx * NWAVES + F.wave, F.G * NWAVES); else if (bx >= rem) p0_late_mats(F, (bx - rem) * NWAVES + F.wave, (F.G - rem) * NWAVES); }
    }
    SEAM(1);
    PH(2) if (IN(2)) {
        PrePf pf;
        if (F.vcu < NB * NCH) { rwkv_pre_fetch(F, (((F.vcu >> 6) * NHEAD) << 6) + (F.vcu & 63), true, pf, F.tid); rwkv_pre_put_w(F.lds, pf, F.tid); }
        {
            LAS f32x4* TB = (LAS f32x4*)(F.lds + XTRA_OFF + 4096);
            if (F.tid < NRW / 4) TB[F.tid] = ((const f32x4*)F.in[I_MU])[F.tid];
            const int pq = F.tid >> 7, pi = F.tid & 127;
            const float* psrc = pq == 0 ? F.in[I_W0] : pq == 1 ? F.in[I_A0] : pq == 2 ? F.in[I_KK] : F.in[I_KA];
            TB[NRW / 4 + F.tid] = ((const f32x4*)psrc)[pi];
            if (F.tid < 128) TB[NRW / 4 + 512 + F.tid] = ((const f32x4*)F.in[I_RK])[F.tid];
            BAR_LDS();
        }
        for (int pc = F.vcu; pc < NB * NCH; pc += F.G) {
#pragma unroll 1
            for (int hh = 0; hh < NHEAD; ++hh) { const int bq = pc >> 6, cq = pc & 63, u = ((bq * NHEAD + hh) << 6) + cq;
                const int un = (hh < NHEAD - 1) ? u + 64 : ((pc + F.G < NB * NCH) ? ((((pc + F.G) >> 6) * NHEAD) << 6) + ((pc + F.G) & 63) : NUNIT);
                rwkv_pre_unit(F, u, un, hh == 0, hh == NHEAD - 1, pf); } }
        BAR_LDS();
        pg8::Gemm g{256, UGLD, 256, 0}; S5Order S{WSB(WS_UG), WSB(WS_B1A), 256, F.G, bx};
        EpiSloc E{(float*)(F.ws + WS_SLOC), 0};
        pg8::gemm_phase<EpiSloc, S5Order, true>(F.lds, g, S, E, F.tid);
    }
    SEAM(2);
    PH(3) if (IN(3)) {
        for (int gb = F.vcu; gb < S5G * NB; gb += F.G) s5_scan_block(F, gb);
        for (int it = F.vcu; it < NB * NHEAD * 4; it += F.G) rwkv_scan_block(F, it);
    }
    SEAM(3);
    PH(4) if (IN(4)) {
        rwkv_out_units(F);
        VM_WAIT(); __syncthreads();
        pg8::Gemm g{384, UGLD, 384, 0}; S5Order S{WSB(WS_UG), WSB(WS_B1B), 384, F.G, bx};
        pg8::EpiGen8<FS5Out> E{FS5Out{WSB(WS_YSP)}, 0};
        pg8::gemm_phase<pg8::EpiGen8<FS5Out>, S5Order, true>(F.lds, g, S, E, F.tid);
    }
    SEAM(4);
    PH(5) if (IN(5)) {
        pg8::Gemm g{RW, RW, RW, 1}; pg8::StaticOrder S; S.init(WSB(WS_YSP), WSB(WS_WGLU), RW, RW, T, RW, F.G, bx); S.tstepA = (size_t)16 * 256 * 2;
        EpiGlu E{WSB(WS_YSP), (bf16_t*)(F.dout + DO_YRS), F.in[I_BGLU], 0};
        pg8::gemm_phase<EpiGlu, pg8::StaticOrder, true>(F.lds, g, S, E, F.tid);
    }
    SEAM(5);
    PH(6) if (IN(6)) {
        pg8::Gemm g{RW, D, D, 0};
        { pg8::StaticOrder S; S.init((const bf16_t*)(F.dout + DO_YRS), WSB(WS_WBRS), D, D, T, D, F.G, bx);
          EpiMergeA E{WSB(WS_GATES), WSB(WS_MERGED), 0};
          pg8::gemm_phase<EpiMergeA, pg8::StaticOrder, true>(F.lds, g, S, E, F.tid); }
        { pg8::StaticOrder S; S.init((const bf16_t*)(F.dout + DO_YRS) + RW, WSB(WS_WBRS) + RW, D, D, T, D, F.G, bx);
          EpiMergeB E{WSB(WS_GATES), WSB(WS_MERGED), 0};
          pg8::gemm_phase<EpiMergeB, pg8::StaticOrder, true>(F.lds, g, S, E, F.tid); }
    }
    SEAM(6);
    PH(7) if (IN(7)) {
        pg8::Gemm g{D, D, D, 0}; pg8::StaticOrder S; S.init(WSB(WS_MERGED), WSB(WS_WOUT), D, D, T, D, F.G, bx);
        EpiRowStat E{WSB(WS_MIXED), (float*)(F.ws + WS_STAT1), 0};
        pg8::gemm_phase<EpiRowStat, pg8::StaticOrder, false>(F.lds, g, S, E, F.tid);
    }
    SEAM(7);
    PH(8) if (IN(8)) { p8_rows(F);
        for (size_t i = (size_t)bx * 512 + F.tid; i < HZ_BYTES / 16; i += (size_t)F.G * 512) ((u32x4*)(F.ws + WS_HZ))[i] = (u32x4){0u, 0u, 0u, 0u}; }
    SEAM(8);
    PH(9) if (IN(9)) {
        pg8::Gemm g{D, D, D, 0}; UpOrder S{WSB(WS_H2), WSB(WS_WUP), F.G, bx};
        EpiConvAct E{WSB(WS_ACT), F.in[I_CONVW], F.in[I_CONVB], (LAS unsigned*)(F.lds + XTRA_OFF), (unsigned long long*)(F.ws + WS_HZ), (unsigned*)(F.ctl + 2), 0};
        pg8::gemm_phase<EpiConvAct, UpOrder, true>(F.lds, g, S, E, F.tid);
    }
    SEAM(9);
    PH(10) if (IN(10)) {
        pg8::Gemm g{FF, FF, FF, 0}; pg8::StaticOrder S; S.init(WSB(WS_ACT), WSB(WS_WDN), FF, FF, T, D, F.G, bx);
        EpiRowStat E{WSB(WS_F), (float*)(F.ws + WS_STAT2), 0};
        pg8::gemm_phase<EpiRowStat, pg8::StaticOrder, false>(F.lds, g, S, E, F.tid);
    }
    SEAM(10);
    if (IN(11)) p12_rows(F);
#undef IN
#undef INQ
#undef SEAM
#undef WSB
}

extern "C" void kernel_launch(void* const* d_in, const int* in_sizes, int n_in, void* d_out, int out_size, void* d_ws, size_t ws_size, hipStream_t stream) {
    static int grid = 0;
    if (grid == 0) {
        if (n_in != 35 || in_sizes[0] != T * D || out_size != T * D || ws_size < WS_END) { fprintf(stderr, "kernel_launch: unexpected shapes: n_in %d in0 %d out %d ws %zu (need %zu)\n", n_in, n_in > 0 ? in_sizes[0] : -1, out_size, ws_size, (size_t)WS_END); grid = -1; return; }
        int dev = 0, cus = 0, per_cu = 0;
        if (hipGetDevice(&dev) != hipSuccess || hipDeviceGetAttribute(&cus, hipDeviceAttributeMultiprocessorCount, dev) != hipSuccess) { fprintf(stderr, "kernel_launch: device query failed\n"); grid = -1; return; }
        if (hipFuncSetAttribute((const void*)fwd_kernel, hipFuncAttributeMaxDynamicSharedMemorySize, LDS_BYTES) != hipSuccess) { fprintf(stderr, "kernel_launch: hipFuncSetAttribute failed\n"); grid = -1; return; }
        if (hipOccupancyMaxActiveBlocksPerMultiprocessor(&per_cu, (const void*)fwd_kernel, NWAVES * 64, LDS_BYTES) != hipSuccess || per_cu < 1) fprintf(stderr, "kernel_launch: occupancy query reports %d blocks per CU\n", per_cu);
        (void)hipGetLastError();
        grid = cus;
    }
    if (grid < 0) return;
    if (hipMemsetAsync((char*)d_ws + WS_CTL, 0, CTL_ZERO_BYTES, stream) != hipSuccess) { fprintf(stderr, "kernel_launch: memset failed\n"); return; }
    Args a{};
    for (int i = 0; i < 35; ++i) a.in[i] = (const float*)d_in[i];
    a.out = (float*)d_out; a.ws = (unsigned char*)d_ws;
#if MK_PER_PHASE
    for (int ph = 0; ph < NPHASE; ++ph) { a.ph_lo = ph; a.ph_hi = ph + 1; hipLaunchKernelGGL(fwd_kernel, dim3(grid), dim3(NWAVES * 64), LDS_BYTES, stream, a); }
#else
    a.ph_lo = 0; a.ph_hi = NPHASE;
    hipLaunchKernelGGL(fwd_kernel, dim3(grid), dim3(NWAVES * 64), LDS_BYTES, stream, a);
#endif
    const hipError_t le = hipPeekAtLastError();
    if (le != hipSuccess) fprintf(stderr, "kernel_launch: launch failed: %s\n", hipGetErrorName(le));
}
```

```cpp
#include <hip/hip_runtime.h>
#include <cstdio>
#include <cstdint>

#define LAS __attribute__((address_space(3)))
#define GAS __attribute__((address_space(1)))
typedef unsigned short bf16_t;
typedef short bf16x8 __attribute__((ext_vector_type(8)));
typedef float f32x4 __attribute__((ext_vector_type(4)));
typedef float f32x2 __attribute__((ext_vector_type(2)));
typedef unsigned u32x4 __attribute__((ext_vector_type(4)));
typedef unsigned u32x2 __attribute__((ext_vector_type(2)));
typedef GAS unsigned gu32;

constexpr int T = 32768, SEQ = 4096, NB = 8, D = 1024, NIN = 4352, NRW = 1792, RW = 512, FF = 2816, FH = 1408;
constexpr int NHEAD = 8, HD = 64, NCH = 64  , NUNIT = NB * NHEAD * NCH;
constexpr int S5G = 32, S5ROWS = T / 16, UGLD = 384;

constexpr size_t MiB = 1u << 20;
constexpr size_t WS_CTL = 0, CTL_ZERO_BYTES = 1 * MiB;
constexpr size_t WS_WIN = 1 * MiB;
constexpr size_t WS_WUP = WS_WIN + (size_t)NIN * D * 2;
constexpr size_t WS_WDN = WS_WUP + (size_t)2 * FF * D * 2;
constexpr size_t WS_WOUT = WS_WDN + (size_t)D * FF * 2;
constexpr size_t WS_WBRS = WS_WOUT + (size_t)D * D * 2;
constexpr size_t WS_WGLU = WS_WBRS + (size_t)D * D * 2;
constexpr size_t WS_W2T = WS_WGLU + (size_t)RW * RW * 2;
constexpr size_t WS_A2T = WS_W2T + (size_t)RW * 64 * 2;
constexpr size_t WS_G2T = WS_A2T + (size_t)RW * 64 * 2;
constexpr size_t WS_B1A = WS_G2T + (size_t)RW * 128 * 2;
constexpr size_t WS_B1B = WS_B1A + (size_t)S5G * 256 * 256 * 2;
constexpr size_t WS_AL = WS_B1B + (size_t)S5G * 256 * 384 * 2;
constexpr size_t WS_WEND = WS_AL + (size_t)S5G * 64 * 2 * 4;
static_assert(WS_WEND <= 44 * MiB, "weights region");
constexpr size_t WS_XN = 44 * MiB;
constexpr size_t WS_QRT = 44 * MiB, WS_WYT = 76 * MiB;
constexpr size_t WS_MERGED = 44 * MiB, WS_H2 = 44 * MiB, WS_F = 44 * MiB;
constexpr size_t WS_PR = 108 * MiB;
constexpr size_t WS_MIXED = 304 * MiB, WS_STAT1 = 368 * MiB;
constexpr size_t WS_ACT = 108 * MiB;
constexpr size_t WS_STAT2 = 284 * MiB;
constexpr size_t WS_UG = 220 * MiB;
constexpr size_t WS_GATES = 268 * MiB;
constexpr size_t WS_SLOC = 396 * MiB, WS_YSP = 396 * MiB;
constexpr size_t WS_GBUF = 428 * MiB;
constexpr size_t WS_BONUS = 460 * MiB;
constexpr size_t WS_VT = 461 * MiB;
constexpr size_t WS_LRSCR = 493 * MiB;
constexpr size_t WS_Z = 336 * MiB;
constexpr size_t WS_END = 512 * MiB;
constexpr size_t DO_H = 0, DO_GT = 36 * MiB, DO_SST = 96 * MiB, DO_YRS = 0;
constexpr int GLD = 72;

constexpr int CW_BAR = 4096, CW_HF = 32768, CW_XNQ = 64;
constexpr size_t WS_HZ = 290 * MiB, HZ_BYTES = (size_t)2816 * 4 * 2 * 32 * 8;

constexpr int RING_BYTES = 131072, LDSCTL_OFF = RING_BYTES, MISC_OFF = LDSCTL_OFF + 320, XTRA_OFF = LDSCTL_OFF + 1024, LDS_BYTES = 155648;
constexpr int NWAVES = 8;

#define RLX_AGENT __ATOMIC_RELAXED, __HIP_MEMORY_SCOPE_AGENT
#define LDS_WAIT() asm volatile("s_waitcnt lgkmcnt(0)" ::: "memory")
#define VM_WAIT() asm volatile("s_waitcnt vmcnt(0)" ::: "memory")

typedef __bf16 bf16x2_t __attribute__((ext_vector_type(2)));
__device__ __forceinline__ unsigned cvt_pk_bf16(float lo, float hi) { const f32x2 v = {lo, hi}; return __builtin_bit_cast(unsigned, __builtin_convertvector(v, bf16x2_t)); }
__device__ __forceinline__ float bf_lo(unsigned w) { return __uint_as_float(w << 16); }
__device__ __forceinline__ float bf_hi(unsigned w) { return __uint_as_float(w & 0xffff0000u); }
__device__ __forceinline__ float bf1(bf16_t h) { return __uint_as_float((unsigned)h << 16); }
__device__ __forceinline__ float fexp(float x) { return __builtin_amdgcn_exp2f(x * 1.44269504089f); }
__device__ __forceinline__ float fsigmoid(float x) { return __builtin_amdgcn_rcpf(1.0f + __builtin_amdgcn_exp2f(-1.44269504089f * x)); }
__device__ __forceinline__ float ftanh(float x) { return 1.0f - 2.0f * __builtin_amdgcn_rcpf(1.0f + __builtin_amdgcn_exp2f(2.88539008178f * x)); }
__device__ __forceinline__ float fgelu(float x) { const float u = 0.7978845608f * (x + 0.044715f * x * x * x); return x * fsigmoid(2.0f * u); }
__device__ __forceinline__ void unpack8(u32x4 w, float (&f)[8]) { f[0] = bf_lo(w.x); f[1] = bf_hi(w.x); f[2] = bf_lo(w.y); f[3] = bf_hi(w.y); f[4] = bf_lo(w.z); f[5] = bf_hi(w.z); f[6] = bf_lo(w.w); f[7] = bf_hi(w.w); }
__device__ __forceinline__ u32x4 pack8(const float (&f)[8]) { u32x4 w; w.x = cvt_pk_bf16(f[0], f[1]); w.y = cvt_pk_bf16(f[2], f[3]); w.z = cvt_pk_bf16(f[4], f[5]); w.w = cvt_pk_bf16(f[6], f[7]); return w; }
__device__ __forceinline__ float wave_sum(float v) {
#pragma unroll
    for (int o = 1; o < 64; o <<= 1) v += __shfl_xor(v, o);
    return v;
}

#define XB_TMO      128
#define XB_XCNT(j)  (256  + 64 * (j))
#define XB_XSUB(j)  (1280 + 64 * (j))
#define XB_XGEN(j)  (2304 + 64 * (j))
#define XB_TOP      3328
#define XB_TOPGEN   3392
#define XCD_BAR_WORDS 3456
#define XB_SPIN_CAP (1u << 18)
__device__ __forceinline__ unsigned xb_ld(unsigned* p)              { return __hip_atomic_load(p, __ATOMIC_RELAXED, __HIP_MEMORY_SCOPE_AGENT); }
__device__ __forceinline__ unsigned xb_add(unsigned* p, unsigned v) { return __hip_atomic_fetch_add(p, v, __ATOMIC_RELAXED, __HIP_MEMORY_SCOPE_AGENT); }
__device__ __forceinline__ unsigned xb_xcc_id() { return (unsigned)__builtin_amdgcn_s_getreg((3 << 11) | 20) & 0xFu; }
#define XB_SPIN(cond, bar) do { unsigned _sp = 0; while (cond) { __builtin_amdgcn_s_sleep(1); \
    if ((++_sp & 255u) == 0u) { if (xb_ld(&(bar)[XB_TMO])) break; if (_sp > XB_SPIN_CAP) { atomicAdd(&(bar)[XB_TMO], 1u); break; } } } } while (0)
struct XcdBarrier { unsigned* bar; unsigned x; volatile LAS unsigned* st; };
__device__ __forceinline__ XcdBarrier xcd_barrier_post(unsigned* bar, volatile LAS unsigned* st) {
    XcdBarrier b; b.bar = bar; b.x = xb_xcc_id(); b.st = st;
    if (threadIdx.x == 0) (void)xb_add(&bar[XB_XCNT(b.x)], 1u);
    return b;
}
__device__ __forceinline__ void xcd_barrier_complete(unsigned* bar, unsigned x, unsigned& nloc, unsigned& nx) {
    const unsigned G = gridDim.x * gridDim.y * gridDim.z;
    unsigned sum, cnt, mine, sp = 0u;
    for (;;) {
        sum = 0u; cnt = 0u; mine = 0u;
#pragma unroll
        for (unsigned j = 0; j < 16; ++j) { const unsigned c = xb_ld(&bar[XB_XCNT(j)]); sum += c; cnt += (c > 0u) ? 1u : 0u; mine = (j == x) ? c : mine; }
        if (sum == G) break;
        __builtin_amdgcn_s_sleep(1);
        if ((++sp & 255u) == 0u) { if (xb_ld(&bar[XB_TMO])) break; if (sp > XB_SPIN_CAP) { atomicAdd(&bar[XB_TMO], 1u); break; } }
    }
    nloc = mine > 0u ? mine : 1u; nx = cnt > 0u ? cnt : 1u;
}
__device__ __forceinline__ void xcd_barrier(const XcdBarrier& b) {
    asm volatile("s_waitcnt vmcnt(0)" ::: "memory");
    __syncthreads();
    if (threadIdx.x == 0) {
        unsigned* bar = b.bar;
        __builtin_amdgcn_s_waitcnt(0);
        unsigned nloc = b.st[0], nx = b.st[1];
        if (nloc == 0u) { xcd_barrier_complete(bar, b.x, nloc, nx); b.st[0] = nloc; b.st[1] = nx; }
        const unsigned old = xb_add(&bar[XB_XSUB(b.x)], 1u);
        const unsigned gen = old / nloc;
        if (old + 1u == (gen + 1u) * nloc) {
            __builtin_amdgcn_fence(__ATOMIC_RELEASE, "agent");
            asm volatile("s_waitcnt vmcnt(0)" ::: "memory");
            const unsigned og = xb_add(&bar[XB_TOP], 1u);
            const unsigned tg = og / nx;
            if (og + 1u == (tg + 1u) * nx) xb_add(&bar[XB_TOPGEN], 1u);
            else XB_SPIN(xb_ld(&bar[XB_TOPGEN]) == tg, bar);
            __builtin_amdgcn_fence(__ATOMIC_ACQUIRE, "agent");
            xb_add(&bar[XB_XGEN(b.x)], 1u);
            asm volatile("s_waitcnt vmcnt(0)" ::: "memory");
        } else {
            XB_SPIN(xb_ld(&bar[XB_XGEN(b.x)]) == gen, bar);
            __builtin_amdgcn_fence(__ATOMIC_ACQUIRE, "agent");
            asm volatile("s_waitcnt vmcnt(0)" ::: "memory");
        }
    }
    __syncthreads();
}

namespace pg8 {
constexpr int BM = 256, BK = 64, HALF = 128, HTB = HALF * BK * 2, STAGE_BYTES = 8 * HTB, NXCD = 8, WGM = 8;
__host__ __device__ __forceinline__ int lds_byte(int r, int c) { const int st = (r >> 4) * 2 + (c >> 5), rr = r & 15, cc = c & 31, ob = rr * 64 + cc * 2; return st * 1024 + (ob ^ (((ob >> 9) & 1) << 5)); }
__host__ __device__ __forceinline__ void stage_rc(int b, int& R, int& C) { const int st = b / 1024, sb = b % 1024, swz = sb ^ (((sb >> 9) & 1) << 5); R = (st >> 1) * 16 + swz / 64; C = (st & 1) * 32 + (swz % 64) / 2; }
__host__ __device__ __forceinline__ int perm32(int rho) { const int n = rho >> 4, i = rho & 15; return 8 * (i >> 2) + 4 * n + (i & 3); }

struct Unit { const char* a; const char* b; int pm, pn; };
struct Gemm { int K, lda, ldb, amode; };

struct StaticOrder {
    const bf16_t* A; const bf16_t* Bt; int lda, ldb;
    int nM, nN, nwg, G, c; size_t tstepA;
    __device__ void init(const bf16_t* A_, const bf16_t* Bt_, int lda_, int ldb_, int M, int N, int G_, int c_) { A = A_; Bt = Bt_; lda = lda_; ldb = ldb_; nM = M / BM; nN = N / BM; nwg = nM * nN; G = G_; c = c_; tstepA = (size_t)BM * lda * 2; }
    __device__ bool next(int i, Unit& u) const {
        const long L = (long)i * G + c; if (L >= nwg) return false;
        int wgid = (int)L; { const int q = nwg / NXCD, r = nwg % NXCD, xcd = wgid % NXCD, off = wgid / NXCD; wgid = (xcd < r ? xcd * (q + 1) : r * (q + 1) + (xcd - r) * q) + off; }
        const int nig = WGM * nN, gid = wgid / nig, fm = gid * WGM, gsz = (nM - fm) < WGM ? (nM - fm) : WGM;
        u.pm = fm + ((wgid % nig) % gsz); u.pn = (wgid % nig) / gsz;
        u.a = (const char*)A + (size_t)u.pm * tstepA; u.b = (const char*)Bt + (size_t)u.pn * BM * ldb * 2; return true;
    }
};

template <class Epi, class Sched, bool ALIGN_EPI = false, bool SP2 = true>
__device__ __forceinline__ void gemm_phase(LAS unsigned char* lds, const Gemm g, const Sched& S, const Epi& E, const int tid) {
    const int wid = __builtin_amdgcn_readfirstlane(tid >> 6), lane = tid & 63, wr = wid >> 2, wc = wid & 3, fr = lane & 15, fq = lane >> 4;
    const int K = g.K, nt = K / BK;
    unsigned voffA[2], voffB[2];
#pragma unroll
    for (int i = 0; i < 2; ++i) { int R, C; stage_rc(tid * 16 + i * 8192, R, C); const int Rb = Epi::PERM ? ((R & ~31) + perm32(R & 31)) : R;
        voffA[i] = g.amode ? (unsigned)((((C >> 4) * S5ROWS + (R >> 4)) * 256 + (R & 15) * 16 + (C & 15)) * 2) : (unsigned)(R * g.lda + C) * 2u; voffB[i] = (unsigned)(Rb * g.ldb + C) * 2u; }
    const size_t kstepB = (size_t)(BK * 2), kstepA = g.amode ? (size_t)4 * S5ROWS * 256 * 2 : (size_t)(BK * 2);
    const size_t hstepA = g.amode ? (size_t)8 * 256 * 2 : (size_t)HALF * g.lda * 2, hstepB = (size_t)HALF * g.ldb * 2;
    const unsigned ldsw = (unsigned)wid * 1024u;
    const int aoff = lds_byte(wr * 64 + fr, fq * 8), boff = lds_byte(wc * 32 + fr, fq * 8);
#define PG8_SA(b, h) (((b) * 2 + (h)) * HTB)
#define PG8_SB(b, h) ((4 + (b) * 2 + (h)) * HTB)
#define PG8_STAGE(bufoff, gbase, voff) do { _Pragma("unroll") for (int _i = 0; _i < 2; ++_i) \
        __builtin_amdgcn_global_load_lds((const unsigned*)((const char*)(gbase) + (voff)[_i]), (LAS unsigned*)(lds + (bufoff) + ldsw + _i * 8192), 16, 0, 0); } while (0)
#define PG8_LDA(dst, b, h) do { _Pragma("unroll") for (int m = 0; m < 4; ++m) _Pragma("unroll") for (int k = 0; k < 2; ++k) dst[m][k] = *(const LAS bf16x8*)(lds + PG8_SA(b, h) + aoff + m * 2048 + k * 1024); } while (0)
#define PG8_LDB(dst, b, h) do { _Pragma("unroll") for (int n = 0; n < 2; ++n) _Pragma("unroll") for (int k = 0; k < 2; ++k) dst[n][k] = *(const LAS bf16x8*)(lds + PG8_SB(b, h) + boff + n * 2048 + k * 1024); } while (0)
#define PG8_MMA(ai, bj, At, Bt) do { __builtin_amdgcn_s_setprio(1); _Pragma("unroll") for (int m = 0; m < 4; ++m) _Pragma("unroll") for (int n = 0; n < 2; ++n) _Pragma("unroll") for (int k = 0; k < 2; ++k) \
        acc[ai][bj][m][n] = __builtin_amdgcn_mfma_f32_16x16x32_bf16(Bt[n][k], At[m][k], acc[ai][bj][m][n], 0, 0, 0); __builtin_amdgcn_s_setprio(0); } while (0)
#define PG8_WAIT_V(n) asm volatile("s_waitcnt vmcnt(" #n ")" ::: "memory")
#define PG8_WAIT_L(n) asm volatile("s_waitcnt lgkmcnt(" #n ")" ::: "memory")
#define PG8_BAR __builtin_amdgcn_s_barrier()
#define PG8_SCHED __builtin_amdgcn_sched_barrier(0)
    Unit cur, nxt; int ui = 0;
    if (!S.next(0, cur)) return;
    f32x4 acc[2][2][4][2];
#pragma unroll
    for (int a = 0; a < 2; ++a)
#pragma unroll
        for (int b = 0; b < 2; ++b)
#pragma unroll
            for (int m = 0; m < 4; ++m)
#pragma unroll
                for (int n = 0; n < 2; ++n) acc[a][b][m][n] = (f32x4){0.f, 0.f, 0.f, 0.f};
    bf16x8 At[4][2], B0[2][2], B1[2][2];
    const char* cA = cur.a; const char* cB = cur.b;
    static_assert(SP2, "only the SP2 loop is kept");
    PG8_STAGE(PG8_SB(0, 0), cB, voffB); PG8_STAGE(PG8_SB(0, 1), cB + hstepB, voffB); PG8_STAGE(PG8_SA(0, 0), cA, voffA); PG8_STAGE(PG8_SA(0, 1), cA + hstepA, voffA);
    if (wr == 1) PG8_BAR;
    PG8_WAIT_V(2); PG8_BAR;
    PG8_STAGE(PG8_SB(1, 0), cB + kstepB, voffB); PG8_STAGE(PG8_SA(1, 0), cA + kstepA, voffA); PG8_STAGE(PG8_SB(1, 1), cB + hstepB + kstepB, voffB);
    PG8_WAIT_V(6); PG8_BAR;
    for (;;) {
        const bool has_next = S.next(ui + 1, nxt);
        const char* nA = has_next ? nxt.a : cA; const char* nB = has_next ? nxt.b : cB;
#pragma unroll 1
        for (int t = 0; t < nt; t += 2) {
            const bool last = (t == nt - 2);
            const char* a1 = cA + (size_t)(t + 1) * kstepA;
            const char* a2 = last ? nA : cA + (size_t)(t + 2) * kstepA; const char* b2 = last ? nB : cB + (size_t)(t + 2) * kstepB;
            const char* a3 = a2 + kstepA; const char* b3 = b2 + kstepB;
            PG8_LDB(B0, 0, 0); PG8_LDB(B1, 0, 1); PG8_SCHED; PG8_LDA(At, 0, 0); PG8_STAGE(PG8_SA(1, 1), a1 + hstepA, voffA);
            PG8_WAIT_V(8); PG8_WAIT_L(0); PG8_BAR; PG8_MMA(0, 0, At, B0); PG8_MMA(0, 1, At, B1); PG8_BAR; PG8_SCHED;
            PG8_LDA(At, 0, 1); PG8_STAGE(PG8_SB(0, 0), b2, voffB); PG8_STAGE(PG8_SB(0, 1), b2 + hstepB, voffB); PG8_STAGE(PG8_SA(0, 0), a2, voffA);
            PG8_WAIT_V(8); PG8_WAIT_L(0); PG8_BAR; PG8_MMA(1, 0, At, B0); PG8_MMA(1, 1, At, B1); PG8_BAR; PG8_SCHED;
            PG8_LDB(B0, 1, 0); PG8_LDB(B1, 1, 1); PG8_SCHED; PG8_LDA(At, 1, 0); PG8_STAGE(PG8_SA(0, 1), a2 + hstepA, voffA);
            PG8_WAIT_V(8); PG8_WAIT_L(0); PG8_BAR; PG8_MMA(0, 0, At, B0); PG8_MMA(0, 1, At, B1); PG8_BAR; PG8_SCHED;
            PG8_LDA(At, 1, 1); PG8_STAGE(PG8_SB(1, 0), b3, voffB); PG8_STAGE(PG8_SB(1, 1), b3 + hstepB, voffB); PG8_STAGE(PG8_SA(1, 0), a3, voffA);
            PG8_WAIT_V(8); PG8_WAIT_L(0); PG8_BAR; PG8_MMA(1, 0, At, B0); PG8_MMA(1, 1, At, B1); PG8_BAR; PG8_SCHED;
        }
        if constexpr (ALIGN_EPI) { if (wr == 0) PG8_BAR; }
        E(acc, cur, wr, wc, fr, fq);
        if (!has_next) break;
#pragma unroll
        for (int a = 0; a < 2; ++a)
#pragma unroll
            for (int b = 0; b < 2; ++b)
#pragma unroll
                for (int m = 0; m < 4; ++m)
#pragma unroll
                    for (int n = 0; n < 2; ++n) acc[a][b][m][n] = (f32x4){0.f, 0.f, 0.f, 0.f};
        cur = nxt; cA = nA; cB = nB; ++ui;
        if constexpr (ALIGN_EPI) { if (wr == 1) PG8_BAR; }
    }
    PG8_WAIT_V(0);
    if constexpr (!ALIGN_EPI) { if (wr == 0) PG8_BAR; }
    PG8_BAR;
#undef PG8_SA
#undef PG8_SB
#undef PG8_STAGE
#undef PG8_LDA
#undef PG8_LDB
#undef PG8_MMA
#undef PG8_WAIT_V
#undef PG8_WAIT_L
#undef PG8_BAR
#undef PG8_SCHED
}

template <class F> struct EpiGen8 {
    static constexpr bool PERM = true, HAS_MID = false; F f; int mid_t;
    __device__ __forceinline__ void mid(f32x4 (&)[2][2][4][2], const Unit&, int, int, int, int) const {}
    __device__ __forceinline__ void operator()(const f32x4 (&acc)[2][2][4][2], const Unit& u, int wr, int wc, int fr, int fq) const {
#pragma unroll
        for (int ai = 0; ai < 2; ++ai)
#pragma unroll
            for (int m = 0; m < 4; ++m) { const int r = ai * HALF + wr * 64 + m * 16 + fr;
#pragma unroll
                for (int bj = 0; bj < 2; ++bj) f(u, r, bj * HALF + wc * 32 + 8 * fq, acc[ai][bj][m][0], acc[ai][bj][m][1]);
                if constexpr (F::PIN) __builtin_amdgcn_sched_barrier(0); }
    }
};
}

typedef const float* cfp_t;
typedef __attribute__((address_space(4))) const cfp_t* InTab;
struct Frame {
    LAS unsigned char* lds;
    volatile LAS unsigned* MISC;
    gu32* ctl;
    int tid, lane, wave, vcu, G;
    unsigned char* ws; unsigned char* dout; unsigned char* ws0; unsigned char* dout0;
    InTab in;
};
enum { I_X = 0, I_NMPRE, I_NMPOST, I_NFPRE, I_NFPOST, I_WIN, I_BGATE, I_MU, I_W0, I_W2, I_A0, I_A2, I_G2, I_KK, I_KA, I_RK, I_LNW, I_LNB,
       I_SARE, I_SAIM, I_SBRE, I_SBIM, I_SCRE, I_SCIM, I_SD, I_SLOG, I_WGLU, I_BGLU, I_WBR, I_WBS, I_WOUT, I_WUP, I_CONVW, I_CONVB, I_WDN };

__device__ __forceinline__ void p0_transpose_item(const float* W, int ldw, int k0, int src0, bf16_t* WT, int ldt, int drow0, int koff, const float* kscale, LAS float* scr, int lane) {
    const int q = lane & 7, rb = lane >> 3;
    f32x4 v[8]; float sc[8];
#pragma unroll
    for (int i = 0; i < 8; ++i) { const int kk = 8 * i + rb; v[i] = __builtin_nontemporal_load((const f32x4*)(W + (size_t)(k0 + kk) * ldw + src0 + 4 * q)); sc[i] = kscale ? kscale[k0 + kk] : 1.0f; }
#pragma unroll
    for (int i = 0; i < 8; ++i) { const int kk = 8 * i + rb; LAS float* d = scr + kk * 33 + 4 * q; d[0] = v[i].x * sc[i]; d[1] = v[i].y * sc[i]; d[2] = v[i].z * sc[i]; d[3] = v[i].w * sc[i]; }
    LDS_WAIT(); asm volatile("" ::: "memory");
    const int c = lane & 7;
#pragma unroll
    for (int j = 0; j < 4; ++j) { const int n = (lane >> 3) + 8 * j; const LAS float* s = scr + (8 * c) * 33 + n;
        u32x4 o; o.x = cvt_pk_bf16(s[0 * 33], s[1 * 33]); o.y = cvt_pk_bf16(s[2 * 33], s[3 * 33]); o.z = cvt_pk_bf16(s[4 * 33], s[5 * 33]); o.w = cvt_pk_bf16(s[6 * 33], s[7 * 33]);
        *(GAS u32x4*)(WT + (size_t)(drow0 + n) * ldt + koff + k0 + 8 * c) = o; }
    LDS_WAIT(); asm volatile("" ::: "memory");
}
struct TrMat { int in_idx, K, N, ldt, koff, kind; size_t dst; int scale_idx; };
__device__ __forceinline__ void p0_do_matrix(Frame& F, const TrMat& mtx, int r, LAS float* scr) {
    const int nblk = mtx.N / 32, kb = r / nblk, nb = r % nblk;
    int src0 = 32 * nb;
    if (mtx.kind == 1) {
        const int pn = (32 * nb) >> 8, within = (32 * nb) & 255;
        src0 = (within < 128 ? 0 : FF - 128) + 128 * pn + within;
    }
    p0_transpose_item(F.in[mtx.in_idx], mtx.N, 64 * kb, src0, (bf16_t*)(F.ws + mtx.dst), mtx.ldt, 32 * nb, mtx.koff, mtx.scale_idx >= 0 ? F.in[mtx.scale_idx] : nullptr, scr, F.lane);
}
__device__ __forceinline__ void p0_s5_group(Frame& F, int g) {
    LAS float* pwr = (LAS float*)(F.lds);
    LAS float* pwi = pwr + 17 * 64;
    LAS float* bbr = pwi + 17 * 64;
    LAS float* bbi = bbr + 1024;
    LAS float* cre = bbi + 1024;
    LAS float* cim = cre + 1024;
    LAS float* kk = cim + 1024;
    const float dt = expf(F.in[I_SLOG][g]);
    for (int idx = F.tid; idx < 17 * 64; idx += 512) { const int k = idx >> 6, p = idx & 63;
        const float are = F.in[I_SARE][g * 64 + p], aim = F.in[I_SAIM][g * 64 + p];
        const float mag = expf((float)k * are * dt); float sn, cs; sincosf((float)k * aim * dt, &sn, &cs);
        pwr[idx] = mag * cs; pwi[idx] = mag * sn; }
    for (int idx = F.tid; idx < 1024; idx += 512) { cre[idx] = F.in[I_SCRE][g * 1024 + idx]; cim[idx] = F.in[I_SCIM][g * 1024 + idx]; }
    __syncthreads();
    for (int idx = F.tid; idx < 1024; idx += 512) { const int p = idx >> 4;
        const float are = F.in[I_SARE][g * 64 + p], aim = F.in[I_SAIM][g * 64 + p];
        const float nr = pwr[64 + p] - 1.0f, ni = pwi[64 + p];
        const float den = 1.0f / (are * are + aim * aim);
        const float qr = (nr * are + ni * aim) * den, qi = (ni * are - nr * aim) * den;
        const float br = F.in[I_SBRE][g * 1024 + idx], bi = F.in[I_SBIM][g * 1024 + idx];
        bbr[idx] = qr * br - qi * bi; bbi[idx] = qr * bi + qi * br; }
    __syncthreads();
    {
        const int kc = F.tid & 255, ph = F.tid >> 8, k = kc >> 4, c = kc & 15; float s[16];
#pragma unroll
        for (int e = 0; e < 16; ++e) s[e] = 0.f;
        for (int p = 32 * ph; p < 32 * ph + 32; ++p) { const float cr_ = cre[c * 64 + p], ci_ = cim[c * 64 + p], pr_ = pwr[k * 64 + p], pi_ = pwi[k * 64 + p];
            const float xr = cr_ * pr_ - ci_ * pi_, xi = cr_ * pi_ + ci_ * pr_;
#pragma unroll
            for (int e4 = 0; e4 < 4; ++e4) { const f32x4 br = *(LAS const f32x4*)(bbr + p * 16 + 4 * e4), bi = *(LAS const f32x4*)(bbi + p * 16 + 4 * e4);
#pragma unroll
                for (int e = 0; e < 4; ++e) s[4 * e4 + e] += xr * br[e] - xi * bi[e]; } }
        LAS float* part = kk + 4096;
        if (ph == 1) {
#pragma unroll
            for (int e4 = 0; e4 < 4; ++e4) *(LAS f32x4*)(part + kc * 16 + 4 * e4) = (f32x4){s[4 * e4], s[4 * e4 + 1], s[4 * e4 + 2], s[4 * e4 + 3]}; }
        __syncthreads();
        if (ph == 0) {
#pragma unroll
            for (int e4 = 0; e4 < 4; ++e4) { const f32x4 o = *(LAS const f32x4*)(part + kc * 16 + 4 * e4);
#pragma unroll
                for (int e = 0; e < 4; ++e) { float v = s[4 * e4 + e] + o[e]; if (k == 0 && c == 4 * e4 + e) v += F.in[I_SD][g * 16 + c]; kk[kc * 16 + 4 * e4 + e] = v; } } }
    }
    __syncthreads();
    bf16_t* B1b = (bf16_t*)(F.ws + WS_B1B) + (size_t)g * 256 * 384;
    for (int idx = F.tid; idx < 256 * 48; idx += 512) { const int n = idx / 48, j = idx - n * 48, t = n >> 4, c = n & 15; float v[8];
        if (j < 32) { const int tau = j >> 1, cp0 = (j & 1) * 8; const int ko = (t >= tau ? t - tau : 0) * 256 + c * 16 + cp0; const float m = (t >= tau) ? 1.f : 0.f;
            const f32x4 a0 = *(LAS const f32x4*)(kk + ko), a1 = *(LAS const f32x4*)(kk + ko + 4);
#pragma unroll
            for (int e = 0; e < 4; ++e) { v[e] = a0[e] * m; v[4 + e] = a1[e] * m; } }
        else { const int p0 = (j - 32) * 4; const f32x4 cr4 = *(LAS const f32x4*)(cre + c * 64 + p0), ci4 = *(LAS const f32x4*)(cim + c * 64 + p0), pr4 = *(LAS const f32x4*)(pwr + (t + 1) * 64 + p0), pi4 = *(LAS const f32x4*)(pwi + (t + 1) * 64 + p0);
#pragma unroll
            for (int q = 0; q < 4; ++q) { v[2 * q] = cr4[q] * pr4[q] - ci4[q] * pi4[q]; v[2 * q + 1] = -(cr4[q] * pi4[q] + ci4[q] * pr4[q]); } }
        *(u32x4*)(B1b + (size_t)n * 384 + 8 * j) = pack8(v); }
    bf16_t* B1a = (bf16_t*)(F.ws + WS_B1A) + (size_t)g * 256 * 256;
    for (int idx = F.tid; idx < 256 * 32; idx += 512) { const int n = idx >> 5, j = idx & 31; float v[8];
#pragma unroll
        for (int e = 0; e < 8; ++e) v[e] = 0.f;
        if (n < 128) { const int p = n >> 1, tau = j >> 1, cp0 = (j & 1) * 8; const float pr_ = pwr[(15 - tau) * 64 + p], pi_ = pwi[(15 - tau) * 64 + p];
            const f32x4 r0 = *(LAS const f32x4*)(bbr + p * 16 + cp0), r1 = *(LAS const f32x4*)(bbr + p * 16 + cp0 + 4), i0 = *(LAS const f32x4*)(bbi + p * 16 + cp0), i1 = *(LAS const f32x4*)(bbi + p * 16 + cp0 + 4);
#pragma unroll
            for (int e = 0; e < 8; ++e) { const float br = e < 4 ? r0[e & 3] : r1[e & 3], bi = e < 4 ? i0[e & 3] : i1[e & 3]; v[e] = (n & 1) ? (pr_ * bi + pi_ * br) : (pr_ * br - pi_ * bi); } }
        *(u32x4*)(B1a + (size_t)n * 256 + 8 * j) = pack8(v); }
    float* aL = (float*)(F.ws + WS_AL) + g * 128;
    if (F.tid < 64) { aL[2 * F.tid] = pwr[16 * 64 + F.tid]; aL[2 * F.tid + 1] = pwi[16 * 64 + F.tid]; }
    __syncthreads();
}
#define DO_MAT(in_idx, K_, N_, ldt_, koff_, kind_, dst_, sc_) do { const TrMat mtx{in_idx, K_, N_, ldt_, koff_, kind_, dst_, sc_}; const int items = ((K_) / 64) * ((N_) / 32); \
        for (int it = gw; it < base + items; it += NGW) { if (it >= base) p0_do_matrix(F, mtx, it - base, scr); } base += items; } while (0)
__device__ __forceinline__ void p0_late_mats(Frame& F, int gw, int NGW) {
    LAS float* scr = (LAS float*)(F.lds + F.wave * 16384);
    int base = 0;
    DO_MAT(I_WUP, D, 2 * FF, D, 0, 1, WS_WUP, I_NFPRE); DO_MAT(I_WDN, FF, D, FF, 0, 0, WS_WDN, -1); DO_MAT(I_WOUT, D, D, D, 0, 0, WS_WOUT, -1);
    DO_MAT(I_WBR, RW, D, D, 0, 0, WS_WBRS, -1); DO_MAT(I_WBS, RW, D, D, RW, 0, WS_WBRS, -1); DO_MAT(I_WGLU, RW, RW, RW, 0, 0, WS_WGLU, -1);
}
__device__ __forceinline__ void p0_prologue(Frame& F) {
    const bool s5wg = F.vcu < S5G && F.G > S5G;
    if (F.vcu < S5G) p0_s5_group(F, F.vcu);
    if (!s5wg) {
        LAS float* scr = (LAS float*)(F.lds + F.wave * 16384);
        const int gw = (F.G > S5G ? F.vcu - S5G : F.vcu) * NWAVES + F.wave, NGW = (F.G > S5G ? F.G - S5G : F.G) * NWAVES;
        int base = 0;
        DO_MAT(I_WIN, D, NIN, D, 0, 0, WS_WIN, I_NMPRE);
        DO_MAT(I_W2, 64, RW, 64, 0, 0, WS_W2T, -1); DO_MAT(I_A2, 64, RW, 64, 0, 0, WS_A2T, -1); DO_MAT(I_G2, 128, RW, 128, 0, 0, WS_G2T, -1);
    }
    {
        bf16_t* XN = (bf16_t*)(F.ws + WS_XN);
        const int nch = T / 4, split = (F.G > S5G) ? nch / 2 : 0;
#pragma unroll 1
        for (int pass = 0; pass < 2; ++pass) {
            if (pass == 0 && (s5wg || split == 0)) continue;
            const int lo = pass == 0 ? 0 : split, hi = pass == 0 ? split : nch;
            const int gw = (pass == 0 ? F.vcu - S5G : F.vcu) * NWAVES + F.wave, NGW = (pass == 0 ? F.G - S5G : F.G) * NWAVES;
#pragma unroll 1
            for (int ch = lo + gw; ch < hi; ch += NGW) {
                const int m = 4 * ch;
                f32x4 v[4][4]; float s[4];
#pragma unroll
                for (int q = 0; q < 4; ++q) { const GAS f32x4* xr = (const GAS f32x4*)(F.in[I_X] + (size_t)(m + q) * D) + F.lane;
#pragma unroll
                    for (int j = 0; j < 4; ++j) v[q][j] = __builtin_nontemporal_load((const f32x4*)(xr + 64 * j)); }
#pragma unroll
                for (int q = 0; q < 4; ++q) { s[q] = 0.f;
#pragma unroll
                    for (int j = 0; j < 4; ++j) s[q] += (v[q][j].x * v[q][j].x + v[q][j].y * v[q][j].y) + (v[q][j].z * v[q][j].z + v[q][j].w * v[q][j].w); }
#pragma unroll
                for (int q = 0; q < 4; ++q) { const float r = 1.0f / sqrtf(wave_sum(s[q]) * (1.f / D) + 1e-6f);
                    GAS u32x2* o = (GAS u32x2*)(XN + (size_t)(m + q) * D) + F.lane;
#pragma unroll
                    for (int j = 0; j < 4; ++j) { u32x2 w; w.x = cvt_pk_bf16(v[q][j].x * r, v[q][j].y * r); w.y = cvt_pk_bf16(v[q][j].z * r, v[q][j].w * r); o[64 * j] = w; } }
            }
        }
    }
}

struct EpiInProj {
    static constexpr bool PERM = true, HAS_MID = false;
    bf16_t* PR; bf16_t* UG; bf16_t* GT; const float* bg; int mid_t;
    __device__ __forceinline__ void mid(f32x4 (&)[2][2][4][2], const pg8::Unit&, int, int, int, int) const {}
    __device__ __forceinline__ void operator()(const f32x4 (&acc)[2][2][4][2], const pg8::Unit& u, int wr, int wc, int fr, int fq) const {
        f32x4 b0[2], b1[2];
        if (u.pn >= 9) {
#pragma unroll
            for (int bj = 0; bj < 2; ++bj) { const int gc = (u.pn - 9) * 256 + bj * 128 + wc * 32 + 8 * fq; b0[bj] = *(const f32x4*)(bg + gc); b1[bj] = *(const f32x4*)(bg + gc + 4); } }
#pragma unroll
        for (int ai = 0; ai < 2; ++ai)
#pragma unroll
            for (int m = 0; m < 4; ++m) { const int row = u.pm * 256 + ai * 128 + wr * 64 + m * 16 + fr;
#pragma unroll
                for (int bj = 0; bj < 2; ++bj) { const int cl = bj * 128 + wc * 32 + 8 * fq; const f32x4 v0 = acc[ai][bj][m][0], v1 = acc[ai][bj][m][1]; u32x4 w;
                    if (u.pn < 7) { w.x = cvt_pk_bf16(v0[0], v0[1]); w.y = cvt_pk_bf16(v0[2], v0[3]); w.z = cvt_pk_bf16(v1[0], v1[1]); w.w = cvt_pk_bf16(v1[2], v1[3]);
                        *(u32x4*)(PR + (size_t)row * NRW + u.pn * 256 + cl) = w; }
                    else if (u.pn < 9) { const int cr = (u.pn - 7) * 256 + cl, g = cr >> 4, c0 = cr & 15;
                        w.x = cvt_pk_bf16(v0[0], v0[1]); w.y = cvt_pk_bf16(v0[2], v0[3]); w.z = cvt_pk_bf16(v1[0], v1[1]); w.w = cvt_pk_bf16(v1[2], v1[3]);
                        *(u32x4*)(UG + ((size_t)g * S5ROWS + (row >> 4)) * UGLD + (row & 15) * 16 + c0) = w; }
                    else { const int gc = (u.pn - 9) * 256 + cl;
                        w.x = cvt_pk_bf16(fsigmoid(v0[0] + b0[bj][0]), fsigmoid(v0[1] + b0[bj][1])); w.y = cvt_pk_bf16(fsigmoid(v0[2] + b0[bj][2]), fsigmoid(v0[3] + b0[bj][3]));
                        w.z = cvt_pk_bf16(fsigmoid(v1[0] + b1[bj][0]), fsigmoid(v1[1] + b1[bj][1])); w.w = cvt_pk_bf16(fsigmoid(v1[2] + b1[bj][2]), fsigmoid(v1[3] + b1[bj][3]));
                        __builtin_nontemporal_store(w, (u32x4*)(GT + ((size_t)(u.pm * 8 + (u.pn - 9)) << 16) + (((wr * 4 + wc) * 16 + (ai * 4 + m) * 2 + bj) << 9) + (fq * 16 + fr) * 8)); } }
                __builtin_amdgcn_sched_barrier(0); }
    }
};
struct FS5Out {
    static constexpr bool PIN = true;
    bf16_t* YSP;
    __device__ __forceinline__ void operator()(const pg8::Unit& u, int r, int cl, f32x4 v0, f32x4 v1) const {
        const int crow = u.pm * 256 + r; u32x4 w;
        w.x = cvt_pk_bf16(fgelu(v0[0]), fgelu(v0[1])); w.y = cvt_pk_bf16(fgelu(v0[2]), fgelu(v0[3])); w.z = cvt_pk_bf16(fgelu(v1[0]), fgelu(v1[1])); w.w = cvt_pk_bf16(fgelu(v1[2]), fgelu(v1[3]));
        *(u32x4*)(YSP + ((size_t)u.pn * S5ROWS + crow) * 256 + cl) = w;
    }
};
struct EpiGlu {
    static constexpr bool PERM = true, HAS_MID = false;
    const bf16_t* YSP; bf16_t* YS; const float* bglu; int mid_t;
    __device__ __forceinline__ void mid(f32x4 (&)[2][2][4][2], const pg8::Unit&, int, int, int, int) const {}
    __device__ __forceinline__ void operator()(const f32x4 (&acc)[2][2][4][2], const pg8::Unit& u, int wr, int wc, int fr, int fq) const {
        u32x4 yv[2][4][2]; f32x4 b0[2], b1[2];
#pragma unroll
        for (int bj = 0; bj < 2; ++bj) { const int col = u.pn * 256 + bj * 128 + wc * 32 + 8 * fq; b0[bj] = *(const f32x4*)(bglu + col); b1[bj] = *(const f32x4*)(bglu + col + 4); }
#pragma unroll
        for (int ai = 0; ai < 2; ++ai)
#pragma unroll
            for (int m = 0; m < 4; ++m)
#pragma unroll
                for (int bj = 0; bj < 2; ++bj) { const int row = u.pm * 256 + ai * 128 + wr * 64 + m * 16 + fr, col = u.pn * 256 + bj * 128 + wc * 32 + 8 * fq;
                    yv[ai][m][bj] = __builtin_nontemporal_load((const u32x4*)(YSP + ((size_t)(col >> 4) * S5ROWS + (row >> 4)) * 256 + (row & 15) * 16 + (col & 15))); }
#pragma unroll
        for (int ai = 0; ai < 2; ++ai)
#pragma unroll
            for (int m = 0; m < 4; ++m) {
#pragma unroll
                for (int bj = 0; bj < 2; ++bj) { const int row = u.pm * 256 + ai * 128 + wr * 64 + m * 16 + fr, col = u.pn * 256 + bj * 128 + wc * 32 + 8 * fq; float y[8]; unpack8(yv[ai][m][bj], y);
                    const f32x4 v0 = acc[ai][bj][m][0], v1 = acc[ai][bj][m][1]; u32x4 w;
                    w.x = cvt_pk_bf16(y[0] * fsigmoid(v0[0] + b0[bj][0]), y[1] * fsigmoid(v0[1] + b0[bj][1])); w.y = cvt_pk_bf16(y[2] * fsigmoid(v0[2] + b0[bj][2]), y[3] * fsigmoid(v0[3] + b0[bj][3]));
                    w.z = cvt_pk_bf16(y[4] * fsigmoid(v1[0] + b1[bj][0]), y[5] * fsigmoid(v1[1] + b1[bj][1])); w.w = cvt_pk_bf16(y[6] * fsigmoid(v1[2] + b1[bj][2]), y[7] * fsigmoid(v1[3] + b1[bj][3]));
                    *(u32x4*)(YS + (size_t)row * D + RW + col) = w; }
                __builtin_amdgcn_sched_barrier(0); }
    }
};
struct FStore {
    static constexpr bool PIN = false;
    bf16_t* O; int ldc;
    __device__ __forceinline__ void operator()(const pg8::Unit& u, int r, int cl, f32x4 v0, f32x4 v1) const {
        u32x4 w; w.x = cvt_pk_bf16(v0[0], v0[1]); w.y = cvt_pk_bf16(v0[2], v0[3]); w.z = cvt_pk_bf16(v1[0], v1[1]); w.w = cvt_pk_bf16(v1[2], v1[3]);
        *(u32x4*)(O + (size_t)(u.pm * 256 + r) * ldc + u.pn * 256 + cl) = w;
    }
};
struct EpiMergeA {
    static constexpr bool PERM = true, HAS_MID = false;
    const bf16_t* GT; bf16_t* T1; int mid_t;
    __device__ __forceinline__ void mid(f32x4 (&)[2][2][4][2], const pg8::Unit&, int, int, int, int) const {}
    __device__ __forceinline__ void operator()(const f32x4 (&acc)[2][2][4][2], const pg8::Unit& u, int wr, int wc, int fr, int fq) const {
        u32x4 gv[2][4][2];
#pragma unroll
        for (int ai = 0; ai < 2; ++ai)
#pragma unroll
            for (int m = 0; m < 4; ++m)
#pragma unroll
                for (int bj = 0; bj < 2; ++bj) gv[ai][m][bj] = __builtin_nontemporal_load((const u32x4*)(GT + ((size_t)(u.pm * 8 + u.pn) << 16) + (((wr * 4 + wc) * 16 + (ai * 4 + m) * 2 + bj) << 9) + (fq * 16 + fr) * 8));
#pragma unroll
        for (int ai = 0; ai < 2; ++ai)
#pragma unroll
            for (int m = 0; m < 4; ++m) {
#pragma unroll
                for (int bj = 0; bj < 2; ++bj) { float g[8]; unpack8(gv[ai][m][bj], g);
                    const f32x4 v0 = acc[ai][bj][m][0], v1 = acc[ai][bj][m][1]; u32x4 w;
                    w.x = cvt_pk_bf16(v0[0] * g[0], v0[1] * g[1]); w.y = cvt_pk_bf16(v0[2] * g[2], v0[3] * g[3]); w.z = cvt_pk_bf16(v1[0] * g[4], v1[1] * g[5]); w.w = cvt_pk_bf16(v1[2] * g[6], v1[3] * g[7]);
                    *(u32x4*)(T1 + ((size_t)(u.pm * 4 + u.pn) << 16) + (((wr * 4 + wc) * 16 + (ai * 4 + m) * 2 + bj) << 9) + (fq * 16 + fr) * 8) = w; }
                __builtin_amdgcn_sched_barrier(0); }
    }
};
struct EpiMergeB {
    static constexpr bool PERM = true, HAS_MID = false;
    const bf16_t* GT; const bf16_t* T1; bf16_t* O; int mid_t;
    __device__ __forceinline__ void mid(f32x4 (&)[2][2][4][2], const pg8::Unit&, int, int, int, int) const {}
    __device__ __forceinline__ void operator()(const f32x4 (&acc)[2][2][4][2], const pg8::Unit& u, int wr, int wc, int fr, int fq) const {
#pragma unroll
        for (int ai = 0; ai < 2; ++ai) {
            u32x4 gv[4][2], tv[4][2];
#pragma unroll
            for (int m = 0; m < 4; ++m)
#pragma unroll
                for (int bj = 0; bj < 2; ++bj) { const size_t fo = (((wr * 4 + wc) * 16 + (ai * 4 + m) * 2 + bj) << 9) + (fq * 16 + fr) * 8;
                    gv[m][bj] = __builtin_nontemporal_load((const u32x4*)(GT + ((size_t)(u.pm * 8 + 4 + u.pn) << 16) + fo)); tv[m][bj] = __builtin_nontemporal_load((const u32x4*)(T1 + ((size_t)(u.pm * 4 + u.pn) << 16) + fo)); }
            __builtin_amdgcn_sched_barrier(0);
#pragma unroll
            for (int m = 0; m < 4; ++m) {
#pragma unroll
                for (int bj = 0; bj < 2; ++bj) { const int row = u.pm * 256 + ai * 128 + wr * 64 + m * 16 + fr, col = u.pn * 256 + bj * 128 + wc * 32 + 8 * fq; float g[8], t1[8]; unpack8(gv[m][bj], g); unpack8(tv[m][bj], t1);
                    const f32x4 v0 = acc[ai][bj][m][0], v1 = acc[ai][bj][m][1]; u32x4 w;
                    w.x = cvt_pk_bf16(t1[0] + v0[0] * g[0], t1[1] + v0[1] * g[1]); w.y = cvt_pk_bf16(t1[2] + v0[2] * g[2], t1[3] + v0[3] * g[3]);
                    w.z = cvt_pk_bf16(t1[4] + v1[0] * g[4], t1[5] + v1[1] * g[5]); w.w = cvt_pk_bf16(t1[6] + v1[2] * g[6], t1[7] + v1[3] * g[7]);
                    *(u32x4*)(O + (size_t)row * D + col) = w; }
                __builtin_amdgcn_sched_barrier(0); }
        }
    }
};
struct UpOrder {
    const bf16_t* H2; const bf16_t* Wt; int G, c;
    __device__ bool next(int i, pg8::Unit& u) const {
        constexpr int nM = NB * 16, nN = 22, nwg = nM * nN;
        const long L = (long)i * G + c; if (L >= nwg) return false;
        int wgid = (int)L; { const int q = nwg / 8, r = nwg % 8, xcd = wgid % 8, off = wgid / 8; wgid = (xcd < r ? xcd * (q + 1) : r * (q + 1) + (xcd - r) * q) + off; }
        const int nig = 8 * nN, gid = wgid / nig, fm = gid * 8, gsz = (nM - fm) < 8 ? (nM - fm) : 8;
        u.pm = fm + ((wgid % nig) % gsz); u.pn = (wgid % nig) / gsz;
        u.a = (const char*)H2 + ((size_t)u.pm * 256 * D) * 2; u.b = (const char*)(Wt + (size_t)u.pn * 256 * D); return true;
    }
};
template <int CTRL> __device__ __forceinline__ unsigned dppu(unsigned v) { return (unsigned)__builtin_amdgcn_update_dpp(0, (int)v, CTRL, 0xf, 0xf, true); }
struct EpiConvAct {
    static constexpr bool PERM = true, HAS_MID = false;
    bf16_t* ACT; const float* cw; const float* cb; LAS unsigned* EX; unsigned long long* HZ; unsigned* tmo; int mid_t;
    __device__ __forceinline__ void mid(f32x4 (&)[2][2][4][2], const pg8::Unit&, int, int, int, int) const {}
    __device__ __forceinline__ void operator()(f32x4 (&acc)[2][2][4][2], const pg8::Unit& u, int wr, int wc, int fr, int fq) const {
        const int b = u.pm >> 4, k = u.pm & 15, t0 = 256 * k;
        u32x2 zp[2][2][4][2];
#pragma unroll
        for (int ai = 0; ai < 2; ++ai)
#pragma unroll
            for (int bj = 0; bj < 2; ++bj)
#pragma unroll
                for (int m = 0; m < 4; ++m)
#pragma unroll
                    for (int n = 0; n < 2; ++n) { const f32x4 v = acc[ai][bj][m][n]; u32x2 w; w.x = cvt_pk_bf16(v[0], v[1]); w.y = cvt_pk_bf16(v[2], v[3]); zp[ai][bj][m][n] = w; }
        if (fr >= 14) {
#pragma unroll
            for (int ai = 0; ai < 2; ++ai)
#pragma unroll
                for (int bj = 0; bj < 2; ++bj)
#pragma unroll
                    for (int n = 0; n < 2; ++n) *(LAS u32x2*)(EX + (((wc * 4 + 2 * ai + wr) * 2 + (fr - 14)) * 32 + bj * 16 + fq * 4 + n * 2)) = zp[ai][bj][3][n]; }
        if (wr == 1 && k < 15 && fr >= 14) {
            unsigned long long* hz = HZ + ((size_t)(u.pm * 22 + u.pn) * 8 + wc * 2 + (fr - 14)) * 32;
#pragma unroll
            for (int bj = 0; bj < 2; ++bj)
#pragma unroll
                for (int n = 0; n < 2; ++n) { __hip_atomic_store(hz + bj * 16 + fq * 4 + n * 2, (1ull << 32) | zp[1][bj][3][n].x, RLX_AGENT); __hip_atomic_store(hz + bj * 16 + fq * 4 + n * 2 + 1, (1ull << 32) | zp[1][bj][3][n].y, RLX_AGENT); }
        }
        asm volatile("s_waitcnt lgkmcnt(0)" ::: "memory"); __builtin_amdgcn_s_barrier(); asm volatile("" ::: "memory");
        const int ch0 = u.pn * 128 + wc * 32 + 8 * fq;
        f32x4 wg[2][3], wv[2][3], bg[2], bv[2];
#pragma unroll
        for (int n = 0; n < 2; ++n) {
#pragma unroll
            for (int j = 0; j < 3; ++j) { wg[n][j] = *(const f32x4*)(cw + (size_t)j * 2 * FF + ch0 + 4 * n); wv[n][j] = *(const f32x4*)(cw + (size_t)j * 2 * FF + FF + ch0 + 4 * n); }
            bg[n] = *(const f32x4*)(cb + ch0 + 4 * n); bv[n] = *(const f32x4*)(cb + FF + ch0 + 4 * n); }
#pragma unroll
        for (int gi = 1; gi <= 8; ++gi) {
            const int ai = (gi & 7) >> 2, m = gi & 3, blk = 2 * ai + wr;
            u32x2 pp[2][2];
#pragma unroll
            for (int bj = 0; bj < 2; ++bj)
#pragma unroll
                for (int n = 0; n < 2; ++n) { pp[bj][n].x = 0u; pp[bj][n].y = 0u; }
            if (m > 0) {
#pragma unroll
                for (int bj = 0; bj < 2; ++bj)
#pragma unroll
                    for (int n = 0; n < 2; ++n) pp[bj][n] = zp[ai][bj][m - 1][n];
            } else if (blk > 0) {
                if (fr >= 14) {
#pragma unroll
                    for (int bj = 0; bj < 2; ++bj)
#pragma unroll
                        for (int n = 0; n < 2; ++n) pp[bj][n] = *(LAS const u32x2*)(EX + (((wc * 4 + blk - 1) * 2 + (fr - 14)) * 32 + bj * 16 + fq * 4 + n * 2)); }
            } else if (k > 0) {
                if (fr >= 14) {
                    const unsigned long long* hz = HZ + ((size_t)((u.pm - 1) * 22 + u.pn) * 8 + wc * 2 + (fr - 14)) * 32;
#pragma unroll
                    for (int bj = 0; bj < 2; ++bj)
#pragma unroll
                        for (int n = 0; n < 2; ++n) { unsigned long long x0, x1; unsigned sp_ = 0;
                            for (;;) { x0 = __hip_atomic_load(hz + bj * 16 + fq * 4 + n * 2, RLX_AGENT); x1 = __hip_atomic_load(hz + bj * 16 + fq * 4 + n * 2 + 1, RLX_AGENT);
                                if ((x0 >> 32) == 1ull && (x1 >> 32) == 1ull) break; __builtin_amdgcn_s_sleep(2); if (++sp_ > (1u << 20)) { __hip_atomic_store(tmo, 1u, RLX_AGENT); break; } }
                            pp[bj][n].x = (unsigned)x0; pp[bj][n].y = (unsigned)x1; } }
            }
            u32x2 outp[2];
#pragma unroll
            for (int n = 0; n < 2; ++n) {
                const u32x2 zg = zp[ai][0][m][n], zv = zp[ai][1][m][n], pg = pp[0][n], pv = pp[1][n];
                u32x2 g1, g2, v1, v2;
                g1.x = dppu<0x111>(zg.x) | dppu<0x10F>(pg.x); g1.y = dppu<0x111>(zg.y) | dppu<0x10F>(pg.y); g2.x = dppu<0x112>(zg.x) | dppu<0x10E>(pg.x); g2.y = dppu<0x112>(zg.y) | dppu<0x10E>(pg.y);
                v1.x = dppu<0x111>(zv.x) | dppu<0x10F>(pv.x); v1.y = dppu<0x111>(zv.y) | dppu<0x10F>(pv.y); v2.x = dppu<0x112>(zv.x) | dppu<0x10E>(pv.x); v2.y = dppu<0x112>(zv.y) | dppu<0x10E>(pv.y);
                const float z0g[4] = {bf_lo(zg.x), bf_hi(zg.x), bf_lo(zg.y), bf_hi(zg.y)}, z1g[4] = {bf_lo(g1.x), bf_hi(g1.x), bf_lo(g1.y), bf_hi(g1.y)}, z2g[4] = {bf_lo(g2.x), bf_hi(g2.x), bf_lo(g2.y), bf_hi(g2.y)};
                const float z0v[4] = {bf_lo(zv.x), bf_hi(zv.x), bf_lo(zv.y), bf_hi(zv.y)}, z1v[4] = {bf_lo(v1.x), bf_hi(v1.x), bf_lo(v1.y), bf_hi(v1.y)}, z2v[4] = {bf_lo(v2.x), bf_hi(v2.x), bf_lo(v2.y), bf_hi(v2.y)};
                float o[4];
#pragma unroll
                for (int e = 0; e < 4; ++e) { const float cg = bg[n][e] + wg[n][0][e] * z2g[e] + wg[n][1][e] * z1g[e] + wg[n][2][e] * z0g[e], cv = bv[n][e] + wv[n][0][e] * z2v[e] + wv[n][1][e] * z1v[e] + wv[n][2][e] * z0v[e];
                    o[e] = fgelu(cg) * cv; }
                outp[n].x = cvt_pk_bf16(o[0], o[1]); outp[n].y = cvt_pk_bf16(o[2], o[3]);
            }
            const int r = 128 * ai + 64 * wr + 16 * m + fr;
            { u32x4 w4; w4.x = outp[0].x; w4.y = outp[0].y; w4.z = outp[1].x; w4.w = outp[1].y; *(u32x4*)(ACT + ((size_t)(b * SEQ + t0 + r)) * FF + ch0) = w4; }
            __builtin_amdgcn_sched_barrier(0);
        }
    }
};
struct EpiRowStat {
    static constexpr bool PERM = true, HAS_MID = false; bf16_t* O; float* STAT; int mid_t;
    __device__ __forceinline__ void mid(f32x4 (&)[2][2][4][2], const pg8::Unit&, int, int, int, int) const {}
    __device__ __forceinline__ void operator()(const f32x4 (&acc)[2][2][4][2], const pg8::Unit& u, int wr, int wc, int fr, int fq) const {
#pragma unroll
        for (int ai = 0; ai < 2; ++ai)
#pragma unroll
            for (int m = 0; m < 4; ++m) { const int row = u.pm * 256 + ai * 128 + wr * 64 + m * 16 + fr; float s = 0.f;
#pragma unroll
                for (int bj = 0; bj < 2; ++bj) { const int col = u.pn * 256 + bj * 128 + wc * 32 + 8 * fq; const f32x4 v0 = acc[ai][bj][m][0], v1 = acc[ai][bj][m][1]; u32x4 w;
                    s += (v0[0] * v0[0] + v0[1] * v0[1]) + (v0[2] * v0[2] + v0[3] * v0[3]) + (v1[0] * v1[0] + v1[1] * v1[1]) + (v1[2] * v1[2] + v1[3] * v1[3]);
                    w.x = cvt_pk_bf16(v0[0], v0[1]); w.y = cvt_pk_bf16(v0[2], v0[3]); w.z = cvt_pk_bf16(v1[0], v1[1]); w.w = cvt_pk_bf16(v1[2], v1[3]);
                    __builtin_nontemporal_store(w, (u32x4*)(O + (size_t)row * D + col)); }
                s += __shfl_xor(s, 16); s += __shfl_xor(s, 32);
                if (fq == 0) STAT[(size_t)row * 16 + u.pn * 4 + wc] = s; }
    }
};
struct EpiSloc {
    static constexpr bool PERM = false, HAS_MID = false; float* SL; int mid_t;
    __device__ __forceinline__ void mid(f32x4 (&)[2][2][4][2], const pg8::Unit&, int, int, int, int) const {}
    __device__ __forceinline__ void operator()(const f32x4 (&acc)[2][2][4][2], const pg8::Unit& u, int wr, int wc, int fr, int fq) const {
#pragma unroll
        for (int ai = 0; ai < 2; ++ai)
#pragma unroll
            for (int m = 0; m < 4; ++m) { const int row = u.pm * 256 + ai * 128 + wr * 64 + m * 16 + fr; float* p = SL + ((size_t)u.pn * S5ROWS + row) * 128 + wc * 32 + 4 * fq;
                *(f32x4*)(p) = acc[ai][0][m][0]; *(f32x4*)(p + 16) = acc[ai][0][m][1]; }
    }
};
struct S5Order {
    const bf16_t* UG; const bf16_t* Bt; int ldb, G, c;
    __device__ bool next(int i, pg8::Unit& u) const { const int L = i * G + c; if (L >= S5G * 8) return false; const int g = L >> 3; u.pm = L & 7; u.pn = g;
        u.a = (const char*)(UG + ((size_t)g * S5ROWS + u.pm * 256) * UGLD); u.b = (const char*)(Bt + (size_t)g * 256 * ldb); return true; }
};

constexpr int LW = 72;
constexpr int SLOT = 64 * LW * 2;
#define SL(i) ((i) * SLOT)
#define BAR_LDS() do { asm volatile("s_waitcnt lgkmcnt(0)" ::: "memory"); __builtin_amdgcn_s_barrier(); asm volatile("" ::: "memory"); } while (0)
struct LdsMat { LAS const unsigned char* p; int ld; __device__ __forceinline__ bf16x8 frag(int row, int k) const { return *(LAS const bf16x8*)(p + ((size_t)row * ld + k) * 2); } };
struct GlbMat { const bf16_t* p; int ld; __device__ __forceinline__ bf16x8 frag(int row, int k) const { return *(const bf16x8*)(p + (size_t)row * ld + k); } };
template <int KD, class YM, class XM, class EPI>
__device__ __forceinline__ void mm64(const YM& Y, const XM& X, int wid, int lane, const EPI& epi) {
    asm volatile("" : "+v"(lane), "+s"(wid));
    const int at = wid >> 1, bt0 = (wid & 1) * 2, fr = lane & 15, fq = lane >> 4;
    f32x4 acc[2] = {(f32x4){0.f, 0.f, 0.f, 0.f}, (f32x4){0.f, 0.f, 0.f, 0.f}};
#pragma unroll
    for (int s = 0; s < KD / 32; ++s) {
        const bf16x8 yf = Y.frag(16 * at + fr, 32 * s + 8 * fq);
#pragma unroll
        for (int bi = 0; bi < 2; ++bi) { const bf16x8 xf = X.frag(16 * (bt0 + bi) + fr, 32 * s + 8 * fq);
            acc[bi] = __builtin_amdgcn_mfma_f32_16x16x32_bf16(xf, yf, acc[bi], 0, 0, 0); }
    }
#pragma unroll
    for (int bi = 0; bi < 2; ++bi) epi(16 * at + fr, 16 * (bt0 + bi) + 4 * fq, acc[bi]);
}
__device__ __forceinline__ void ld_yf(const LdsMat& Y, int at, int fr, int fq, bf16x8 (&y)[2]) {
#pragma unroll
    for (int s = 0; s < 2; ++s) y[s] = Y.frag(16 * at + fr, 32 * s + 8 * fq);
}
__device__ __forceinline__ void ld_xf(const LdsMat& X, int bt0, int fr, int fq, bf16x8 (&x)[2][2]) {
#pragma unroll
    for (int s = 0; s < 2; ++s)
#pragma unroll
        for (int bi = 0; bi < 2; ++bi) x[s][bi] = X.frag(16 * (bt0 + bi) + fr, 32 * s + 8 * fq);
}
__device__ __forceinline__ void mm_f(const bf16x8 (&y)[2], const bf16x8 (&x)[2][2], f32x4 (&acc)[2]) {
#pragma unroll
    for (int bi = 0; bi < 2; ++bi) acc[bi] = (f32x4){0.f, 0.f, 0.f, 0.f};
#pragma unroll
    for (int s = 0; s < 2; ++s)
#pragma unroll
        for (int bi = 0; bi < 2; ++bi) acc[bi] = __builtin_amdgcn_mfma_f32_16x16x32_bf16(x[s][bi], y[s], acc[bi], 0, 0, 0);
}
template <int KD>
__device__ __forceinline__ void preload_x(const GlbMat& X, int wid, int lane, bf16x8 (&xf)[KD / 32][2]) {
    const int bt0 = (wid & 1) * 2, fr = lane & 15, fq = lane >> 4;
#pragma unroll
    for (int s = 0; s < KD / 32; ++s)
#pragma unroll
        for (int bi = 0; bi < 2; ++bi) xf[s][bi] = X.frag(16 * (bt0 + bi) + fr, 32 * s + 8 * fq);
}
template <int KD, class YM, class EPI>
__device__ __forceinline__ void mm64_pre(const YM& Y, const bf16x8 (&xf)[KD / 32][2], int wid, int lane, const EPI& epi) {
    const int at = wid >> 1, bt0 = (wid & 1) * 2, fr = lane & 15, fq = lane >> 4;
    f32x4 acc[2] = {(f32x4){0.f, 0.f, 0.f, 0.f}, (f32x4){0.f, 0.f, 0.f, 0.f}};
#pragma unroll
    for (int s = 0; s < KD / 32; ++s) {
        const bf16x8 yf = Y.frag(16 * at + fr, 32 * s + 8 * fq);
#pragma unroll
        for (int bi = 0; bi < 2; ++bi) acc[bi] = __builtin_amdgcn_mfma_f32_16x16x32_bf16(xf[s][bi], yf, acc[bi], 0, 0, 0);
    }
#pragma unroll
    for (int bi = 0; bi < 2; ++bi) epi(16 * at + fr, 16 * (bt0 + bi) + 4 * fq, acc[bi]);
}
__device__ __forceinline__ void st_lds4(LAS unsigned char* base, int a, int b0, f32x4 v) { u32x2 w; w.x = cvt_pk_bf16(v[0], v[1]); w.y = cvt_pk_bf16(v[2], v[3]); *(LAS u32x2*)(base + ((size_t)a * LW + b0) * 2) = w; }
__device__ __forceinline__ f32x4 ld_lds4(LAS const unsigned char* base, int a, int b0) { const u32x2 w = *(LAS const u32x2*)(base + ((size_t)a * LW + b0) * 2); return (f32x4){bf_lo(w.x), bf_hi(w.x), bf_lo(w.y), bf_hi(w.y)}; }
__device__ __forceinline__ void st_glb4p(bf16_t* base, int a, int b0, f32x4 v) { u32x2 w; w.x = cvt_pk_bf16(v[0], v[1]); w.y = cvt_pk_bf16(v[2], v[3]); __builtin_nontemporal_store(w, (u32x2*)(base + (size_t)a * GLD + b0)); }
__device__ __forceinline__ void st_glb4(bf16_t* base, int a, int b0, f32x4 v) { u32x2 w; w.x = cvt_pk_bf16(v[0], v[1]); w.y = cvt_pk_bf16(v[2], v[3]); __builtin_nontemporal_store(w, (u32x2*)(base + (size_t)a * 64 + b0)); }

struct PrePf { u32x4 qa[3], qp[3], ra[4], rp[4], wt[4]; };
__device__ __forceinline__ void rwkv_pre_fetch(Frame& F, int unit, bool lr_first, PrePf& P, int tid) {
    const int bh = unit >> 6, c = unit & 63, b = bh >> 3, h = bh & 7;
    const int t = tid >> 3, jb = tid & 7, j0 = jb * 8;
    const int tg = b * SEQ + c * 64 + t;
    const bool hasprev = (c * 64 + t) > 0;
    const bf16_t* prow = (const bf16_t*)(F.ws + WS_PR) + (size_t)tg * NRW; const bf16_t* pprv = hasprev ? prow - NRW : prow;
#pragma unroll
    for (int seg = 0; seg < 3; ++seg) { const int col = seg * 512 + h * 64 + j0; P.qa[seg] = *(const u32x4*)(prow + col); P.qp[seg] = *(const u32x4*)(pprv + col); }
    const u32x4* scr = (const u32x4*)(F.ws + WS_LRSCR) + ((size_t)F.vcu * 512 + tid) * 4;
    const u32x4* pa = lr_first ? (const u32x4*)(prow + 1536 + jb * 32) : scr; const u32x4* pp = lr_first ? (const u32x4*)(pprv + 1536 + jb * 32) : scr;
#pragma unroll
    for (int q4 = 0; q4 < 4; ++q4) { P.ra[q4] = pa[q4]; P.rp[q4] = pp[q4]; }
    P.wt[0] = ((const u32x4*)(F.ws + WS_W2T) + (size_t)h * 512)[tid]; P.wt[1] = ((const u32x4*)(F.ws + WS_A2T) + (size_t)h * 512)[tid];
    P.wt[2] = ((const u32x4*)(F.ws + WS_G2T) + (size_t)h * 1024)[tid]; P.wt[3] = ((const u32x4*)(F.ws + WS_G2T) + (size_t)h * 1024)[512 + tid];
}
__device__ __forceinline__ void rwkv_pre_put_w(LAS unsigned char* L, const PrePf& P, int tid) {
    const int r8 = tid >> 3, c8 = tid & 7, r16 = tid >> 4, c16 = tid & 15;
    *(LAS u32x4*)(L + SL(10) + ((size_t)r8 * LW + c8 * 8) * 2) = P.wt[0]; *(LAS u32x4*)(L + SL(11) + ((size_t)r8 * LW + c8 * 8) * 2) = P.wt[1];
    *(LAS u32x4*)(L + SL(12) + ((size_t)r16 * 136 + c16 * 8) * 2) = P.wt[2]; *(LAS u32x4*)(L + SL(12) + ((size_t)(32 + r16) * 136 + c16 * 8) * 2) = P.wt[3];
}
__device__ __forceinline__ void rwkv_pre_unit(Frame& F, int unit, int next_unit, bool lr_first, bool next_first, PrePf& P) {
    LAS unsigned char* L = F.lds;
    LAS float* XT = (LAS float*)(F.lds + XTRA_OFF);
    int tid = F.tid; asm volatile("" : "+v"(tid));
    int wid = F.wave; asm volatile("" : "+s"(wid));
    const int lane = tid & 63;
    const int bh = unit >> 6, c = unit & 63, b = bh >> 3, h = bh & 7;
    const int t = tid >> 3, jb = tid & 7, j0 = jb * 8;
    const int tg = b * SEQ + c * 64 + t;
    const bool hasprev = (c * 64 + t) > 0;
    const bf16_t* PR = (const bf16_t*)(F.ws + WS_PR);
    const bf16_t* prow = PR + (size_t)tg * NRW; const bf16_t* pprev = prow - NRW;
    LAS const float* mu = (LAS const float*)(F.lds + XTRA_OFF + 4096);
    LAS const float* par = mu + NRW;
    float rs[8], ks[8], vs[8];
    {
        const int c0 = 1536 + jb * 32;
        const float pmask = hasprev ? 1.f : 0.f;
        f32x4 mq[3][2];
#pragma unroll
        for (int seg = 0; seg < 3; ++seg) { const int col = seg * 512 + h * 64 + j0; mq[seg][0] = *(LAS const f32x4*)(mu + col); mq[seg][1] = *(LAS const f32x4*)(mu + col + 4); }
        LAS unsigned char* dst = (jb < 2) ? (L + SL(0) + ((size_t)t * LW + jb * 32) * 2) : (jb < 4) ? (L + SL(1) + ((size_t)t * LW + (jb - 2) * 32) * 2) : (L + SL(2) + ((size_t)t * 136 + (jb - 4) * 32) * 2);
        u32x4* scr = (u32x4*)(F.ws + WS_LRSCR) + ((size_t)F.vcu * 512 + tid) * 4;
        if (lr_first) {
            f32x4 ma[4][2];
#pragma unroll
            for (int q4 = 0; q4 < 4; ++q4) { ma[q4][0] = *(LAS const f32x4*)(mu + c0 + q4 * 8); ma[q4][1] = *(LAS const f32x4*)(mu + c0 + q4 * 8 + 4); }
#pragma unroll
            for (int q4 = 0; q4 < 4; ++q4) { float x[8], xp[8], o[8]; unpack8(P.ra[q4], x); unpack8(P.rp[q4], xp);
#pragma unroll
                for (int e = 0; e < 8; ++e) { const float mm = e < 4 ? ma[q4][0][e] : ma[q4][1][e - 4]; const float s = x[e] + (xp[e] * pmask - x[e]) * mm;
                    const float ex = __builtin_amdgcn_exp2f((jb < 2 ? 2.88539008178f : -1.44269504089f) * s), rc = __builtin_amdgcn_rcpf(1.0f + ex);
                    o[e] = jb < 2 ? 1.0f - 2.0f * rc : (jb < 4 ? s : rc); }
                const u32x4 w = pack8(o); *(LAS u32x4*)(dst + q4 * 16) = w; scr[q4] = w; }
        } else {
#pragma unroll
            for (int q4 = 0; q4 < 4; ++q4) *(LAS u32x4*)(dst + q4 * 16) = P.ra[q4];
        }
#pragma unroll
        for (int seg = 0; seg < 3; ++seg) { float x[8], xp[8]; unpack8(P.qa[seg], x); unpack8(P.qp[seg], xp);
#pragma unroll
            for (int e = 0; e < 8; ++e) { const float mm = e < 4 ? mq[seg][0][e] : mq[seg][1][e - 4]; const float s = x[e] + (xp[e] * pmask - x[e]) * mm; if (seg == 0) rs[e] = s; else if (seg == 1) ks[e] = s; else vs[e] = s; } }
    }
    BAR_LDS();
    {
        const LdsMat Yw{L + SL(0), LW}, Ya{L + SL(1), LW}, Yg{L + SL(2), 136};
        const LdsMat Xw{L + SL(10), LW}, Xa{L + SL(11), LW}, Xg{L + SL(12), 136};
        mm64<64>(Yw, Xw, wid, lane, [&](int a, int b0, f32x4 v) { *(LAS f32x4*)(L + SL(4) + ((size_t)a * 68 + b0) * 4) = v; });
        mm64<64>(Ya, Xa, wid, lane, [&](int a, int b0, f32x4 v) { *(LAS f32x4*)(L + SL(6) + ((size_t)a * 68 + b0) * 4) = v; });
        mm64<128>(Yg, Xg, wid, lane, [&](int a, int b0, f32x4 v) { *(LAS f32x4*)(L + SL(8) + ((size_t)a * 68 + b0) * 4) = v; });
    }
    BAR_LDS();
    float ld[8], kp[8], av[8], bv[8];
    {
        const int hc = h * 64 + j0;
        float wp[8], ap[8], gg[8], w0[8], a0[8], kkw[8], kaw[8], rk[8];
        *(f32x4*)&wp[0] = *(LAS f32x4*)(L + SL(4) + ((size_t)t * 68 + j0) * 4); *(f32x4*)&wp[4] = *(LAS f32x4*)(L + SL(4) + ((size_t)t * 68 + j0 + 4) * 4);
        *(f32x4*)&ap[0] = *(LAS f32x4*)(L + SL(6) + ((size_t)t * 68 + j0) * 4); *(f32x4*)&ap[4] = *(LAS f32x4*)(L + SL(6) + ((size_t)t * 68 + j0 + 4) * 4);
        *(f32x4*)&gg[0] = *(LAS f32x4*)(L + SL(8) + ((size_t)t * 68 + j0) * 4); *(f32x4*)&gg[4] = *(LAS f32x4*)(L + SL(8) + ((size_t)t * 68 + j0 + 4) * 4);
        *(f32x4*)&w0[0] = *(LAS const f32x4*)(par + 0 + hc); *(f32x4*)&w0[4] = *(LAS const f32x4*)(par + 0 + hc + 4);
        *(f32x4*)&a0[0] = *(LAS const f32x4*)(par + 512 + hc); *(f32x4*)&a0[4] = *(LAS const f32x4*)(par + 512 + hc + 4);
        *(f32x4*)&kkw[0] = *(LAS const f32x4*)(par + 1024 + hc); *(f32x4*)&kkw[4] = *(LAS const f32x4*)(par + 1024 + hc + 4);
        *(f32x4*)&kaw[0] = *(LAS const f32x4*)(par + 1536 + hc); *(f32x4*)&kaw[4] = *(LAS const f32x4*)(par + 1536 + hc + 4);
        *(f32x4*)&rk[0] = *(LAS const f32x4*)(par + 2048 + hc); *(f32x4*)&rk[4] = *(LAS const f32x4*)(par + 2048 + hc + 4);
        float ss = 0.f, bon = 0.f, kkv[8], eta[8];
#pragma unroll
        for (int e = 0; e < 8; ++e) {
            ld[e] = -0.60653065971f * fsigmoid(w0[e] + wp[e]);
            eta[e] = fsigmoid(a0[e] + ap[e]);
            kkv[e] = ks[e] * kkw[e]; ss += kkv[e] * kkv[e];
            kp[e] = ks[e] * (1.0f + (eta[e] - 1.0f) * kaw[e]);
            bon += rs[e] * kp[e] * rk[e];
        }
        ss += __shfl_xor(ss, 1); ss += __shfl_xor(ss, 2); ss += __shfl_xor(ss, 4);
        bon += __shfl_xor(bon, 1); bon += __shfl_xor(bon, 2); bon += __shfl_xor(bon, 4);
        const float inv = __builtin_amdgcn_rcpf(fmaxf(__builtin_amdgcn_sqrtf(ss), 1e-12f));
#pragma unroll
        for (int e = 0; e < 8; ++e) { const float kk = kkv[e] * inv; av[e] = -kk; bv[e] = kk * eta[e]; }
        if (jb == 0) ((float*)(F.ws + WS_BONUS))[(size_t)tg * 8 + h] = bon;
        *(u32x4*)((bf16_t*)(F.ws + WS_GBUF) + (size_t)tg * RW + hc) = pack8(gg);
    }
    float Lc[8];
#pragma unroll
    for (int e = 0; e < 8; ++e) { float x = ld[e];
        float y = __shfl_up(x, 8); if (lane >= 8) x += y;
        y = __shfl_up(x, 16); if (lane >= 16) x += y;
        y = __shfl_up(x, 32); if (lane >= 32) x += y;
        Lc[e] = x; }
    if (lane >= 56) {
#pragma unroll
        for (int e = 0; e < 8; ++e) XT[wid * 64 + j0 + e] = Lc[e]; }
    BAR_LDS();
    {
        float pre[8];
#pragma unroll
        for (int e = 0; e < 8; ++e) pre[e] = 0.f;
#pragma unroll
        for (int w = 0; w < 7; ++w) if (w < wid) { const f32x4 x0 = *(LAS const f32x4*)(XT + w * 64 + j0), x1 = *(LAS const f32x4*)(XT + w * 64 + j0 + 4);
#pragma unroll
            for (int e = 0; e < 4; ++e) { pre[e] += x0[e]; pre[4 + e] += x1[e]; } }
#pragma unroll
        for (int e = 0; e < 8; ++e) Lc[e] += pre[e];
    }
    if (t == 63) {
#pragma unroll
        for (int e = 0; e < 8; ++e) XT[512 + j0 + e] = fexp(Lc[e]); }
    {
        float o0[8], o1[8], o2[8], o3[8];
#pragma unroll
        for (int e = 0; e < 8; ++e) { const float ein = fexp(Lc[e]), eout = __builtin_amdgcn_rcpf(ein), eex = fexp(Lc[e] - ld[e]);
            o0[e] = rs[e] * ein; o1[e] = kp[e] * eout; o2[e] = av[e] * eex; o3[e] = bv[e] * eout; }
        const size_t off = ((size_t)t * LW + j0) * 2;
        *(LAS u32x4*)(L + SL(10) + off) = pack8(o0); *(LAS u32x4*)(L + SL(11) + off) = pack8(o1); *(LAS u32x4*)(L + SL(12) + off) = pack8(o2); *(LAS u32x4*)(L + SL(13) + off) = pack8(o3);
        *(LAS u32x4*)(L + SL(2) + off) = pack8(vs);
    }
    BAR_LDS();
    {
        const int srcs[4] = {12, 13, 11, 2}, dsts[4] = {4, 5, 6, 7};
#pragma unroll
        for (int q = 0; q < 4; ++q) { unsigned short hv[8];
#pragma unroll
            for (int e = 0; e < 8; ++e) hv[e] = *(LAS const unsigned short*)(L + SL(srcs[q]) + ((size_t)(8 * wid + e) * LW + lane) * 2);
            u32x4 w; w.x = hv[0] | ((unsigned)hv[1] << 16); w.y = hv[2] | ((unsigned)hv[3] << 16); w.z = hv[4] | ((unsigned)hv[5] << 16); w.w = hv[6] | ((unsigned)hv[7] << 16);
            *(LAS u32x4*)(L + SL(dsts[q]) + ((size_t)lane * LW + 8 * wid) * 2) = w;
        }
    }
    BAR_LDS();
    if (next_unit < NUNIT) rwkv_pre_fetch(F, next_unit, next_first, P, tid);
    const int crow = tid >> 3, cch = tid & 7;
    __builtin_nontemporal_store(*(LAS const u32x4*)(L + SL(7) + ((size_t)crow * LW + cch * 8) * 2), (u32x4*)((bf16_t*)(F.ws + WS_VT) + (size_t)unit * 4096 + crow * 64 + cch * 8));
    {
        const LdsMat Rt{L + SL(10), LW}, Kt{L + SL(11), LW}, At{L + SL(12), LW}, Bt{L + SL(13), LW};
        f32x4 nd = (f32x4){0.f, 0.f, 0.f, 0.f}, ntd = nd;
        {
            int ln = lane, wd = wid; asm volatile("" : "+v"(ln), "+s"(wd));
            const int at = wd >> 1, bt0 = (wd & 1) * 2, fr = ln & 15, fq = ln >> 4, a = 16 * at + fr;
            bf16x8 yA[2], yK[2], yR[2], xB[2][2], xA[2][2], xK[2][2];
            ld_yf(At, at, fr, fq, yA); ld_xf(Bt, bt0, fr, fq, xB); ld_yf(Kt, at, fr, fq, yK); ld_xf(At, bt0, fr, fq, xA); ld_yf(Rt, at, fr, fq, yR); ld_xf(Kt, bt0, fr, fq, xK);
            const bool diag = bt0 == (at & 2);
            bf16x8 xd[2];
            if (diag) ld_yf(Bt, at, fr, fq, xd);
            f32x4 c0[2], c1[2], c2[2], c3[2];
            mm_f(yA, xB, c0); mm_f(yK, xA, c1); mm_f(yR, xB, c2); mm_f(yR, xK, c3);
            if (diag) {
                f32x4 v = (f32x4){0.f, 0.f, 0.f, 0.f};
#pragma unroll
                for (int s = 0; s < 2; ++s) v = __builtin_amdgcn_mfma_f32_16x16x32_bf16(yA[s], xd[s], v, 0, 0, 0);
#pragma unroll
                for (int e = 0; e < 4; ++e) v[e] = (fr < 4 * fq + e) ? v[e] : 0.f;
                nd = v; }
#pragma unroll
            for (int bi = 0; bi < 2; ++bi) { const int b0 = 16 * (bt0 + bi) + 4 * fq; f32x4 v0 = c0[bi], v1 = c1[bi], v2 = c2[bi], v3 = c3[bi];
#pragma unroll
                for (int e = 0; e < 4; ++e) { v0[e] = (b0 + e < a) ? v0[e] : 0.f; v1[e] = (a < b0 + e) ? v1[e] : 0.f; v2[e] = (b0 + e <= a) ? v2[e] : 0.f; v3[e] = (b0 + e <= a) ? v3[e] : 0.f; }
                st_lds4(L + SL(1), a, b0, v0); st_lds4(L + SL(2), a, b0, v1); st_lds4(L + SL(3), a, b0, v2); st_lds4(L + SL(8), a, b0, v3);
                if (bt0 + bi == at) ntd = v0; }
        }
        const int at = wid >> 1;
        if (((wid & 1) * 2 == (at & 2))) {
            const int fr = lane & 15, fq = lane >> 4;
            auto op = [](f32x4 v) { u32x4 w; w.x = cvt_pk_bf16(v[0], v[1]); w.y = cvt_pk_bf16(v[2], v[3]); w.z = 0u; w.w = 0u; return __builtin_bit_cast(bf16x8, w); };
            const f32x4 zero = (f32x4){0.f, 0.f, 0.f, 0.f};
            const f32x4 Lm = ntd, LT = nd;
            f32x4 Q = Lm;
#pragma unroll
            for (int e = 0; e < 4; ++e) Q[e] += (4 * fq + e == fr) ? 1.f : 0.f;
            const f32x4 L2 = __builtin_amdgcn_mfma_f32_16x16x32_bf16(op(LT), op(Lm), zero, 0, 0, 0), L2T = __builtin_amdgcn_mfma_f32_16x16x32_bf16(op(Lm), op(LT), zero, 0, 0, 0);
            Q = __builtin_amdgcn_mfma_f32_16x16x32_bf16(op(L2T), op(Q), Q, 0, 0, 0);
            const f32x4 L4 = __builtin_amdgcn_mfma_f32_16x16x32_bf16(op(L2T), op(L2), zero, 0, 0, 0), L4T = __builtin_amdgcn_mfma_f32_16x16x32_bf16(op(L2), op(L2T), zero, 0, 0, 0);
            Q = __builtin_amdgcn_mfma_f32_16x16x32_bf16(op(L4T), op(Q), Q, 0, 0, 0);
            const f32x4 L8T = __builtin_amdgcn_mfma_f32_16x16x32_bf16(op(L4), op(L4T), zero, 0, 0, 0);
            Q = __builtin_amdgcn_mfma_f32_16x16x32_bf16(op(L8T), op(Q), Q, 0, 0, 0);
            st_lds4(L + SL(9), 16 * at + fr, 4 * fq, Q);
        }
    }
    BAR_LDS();
    {
        const int fr = lane & 15, fq = lane >> 4;
        LAS const unsigned char* zsl = L + (wid < 4 ? SL(4) : SL(2)); LAS unsigned char* dsl = L + (wid < 4 ? SL(11) : SL(12));
        const int arow = 16 * (wid & 3) + fr;
        u32x2 zp[4];
#pragma unroll
        for (int c = 0; c < 4; ++c) {
            f32x4 acc = ld_lds4(zsl, arow, 16 * c + 4 * fq);
            if (c >= 1) {
                const u32x2 alo = *(LAS const u32x2*)(L + SL(1) + ((size_t)(16 * c + fr) * LW + 4 * fq) * 2), ahi = *(LAS const u32x2*)(L + SL(1) + ((size_t)(16 * c + fr) * LW + 16 + 4 * fq) * 2);
                u32x4 aw; aw.x = alo.x; aw.y = alo.y; aw.z = ahi.x; aw.w = ahi.y;
                u32x4 bw; bw.x = zp[0].x; bw.y = zp[0].y; bw.z = c >= 2 ? zp[1].x : 0u; bw.w = c >= 2 ? zp[1].y : 0u;
                acc = __builtin_amdgcn_mfma_f32_16x16x32_bf16(__builtin_bit_cast(bf16x8, aw), __builtin_bit_cast(bf16x8, bw), acc, 0, 0, 0); }
            if (c == 3) {
                const u32x2 alo = *(LAS const u32x2*)(L + SL(1) + ((size_t)(48 + fr) * LW + 32 + 4 * fq) * 2);
                u32x4 aw; aw.x = alo.x; aw.y = alo.y; aw.z = 0u; aw.w = 0u;
                u32x4 bw; bw.x = zp[2].x; bw.y = zp[2].y; bw.z = 0u; bw.w = 0u;
                acc = __builtin_amdgcn_mfma_f32_16x16x32_bf16(__builtin_bit_cast(bf16x8, aw), __builtin_bit_cast(bf16x8, bw), acc, 0, 0, 0); }
            const u32x2 dlo = *(LAS const u32x2*)(L + SL(9) + ((size_t)(16 * c + fr) * LW + 4 * fq) * 2);
            u32x4 aw; aw.x = dlo.x; aw.y = dlo.y; aw.z = 0u; aw.w = 0u;
            u32x4 bw; bw.x = cvt_pk_bf16(acc[0], acc[1]); bw.y = cvt_pk_bf16(acc[2], acc[3]); bw.z = 0u; bw.w = 0u;
            const f32x4 r = __builtin_amdgcn_mfma_f32_16x16x32_bf16(__builtin_bit_cast(bf16x8, aw), __builtin_bit_cast(bf16x8, bw), (f32x4){0.f, 0.f, 0.f, 0.f}, 0, 0, 0);
            zp[c].x = cvt_pk_bf16(r[0], r[1]); zp[c].y = cvt_pk_bf16(r[2], r[3]);
            *(LAS u32x2*)(dsl + ((size_t)arow * LW + 16 * c + 4 * fq) * 2) = zp[c];
        }
    }
    BAR_LDS();
    {
        const int sAT = 11, sAkT = 12, sHk = 0;
        const LdsMat AT{L + SL(sAT), LW}, AkT{L + SL(sAkT), LW}, AbrT{L + SL(3), LW}, BgT{L + SL(5), LW}, VTm{L + SL(7), LW};
        bf16_t* QRT = (bf16_t*)(F.ws + WS_QRT) + (size_t)unit * 4096; bf16_t* WYT = (bf16_t*)(F.ws + WS_WYT) + (size_t)unit * 4096;
        bf16_t* GTg = (bf16_t*)(F.dout + DO_GT) + (size_t)unit * (64 * GLD); bf16_t* Hg = (bf16_t*)(F.dout + DO_H) + (size_t)unit * (64 * GLD);
        {
            int ln = lane, wd = wid; asm volatile("" : "+v"(ln), "+s"(wd));
            const int at = wd >> 1, bt0 = (wd & 1) * 2, fr = ln & 15, fq = ln >> 4, a = 16 * at + fr;
            bf16x8 yA[2], yB[2], xT[2][2], xK[2][2];
            ld_yf(BgT, at, fr, fq, yB); ld_xf(AkT, bt0, fr, fq, xK); ld_yf(AbrT, at, fr, fq, yA); ld_xf(AT, bt0, fr, fq, xT);
            f32x4 eH[2], eR[2], eW[2];
#pragma unroll
            for (int bi = 0; bi < 2; ++bi) { const int b0 = 16 * (bt0 + bi) + 4 * fq; eH[bi] = ld_lds4(L + SL(6), a, b0); eR[bi] = ld_lds4(L + SL(10), a, b0); eW[bi] = ld_lds4(L + SL(8), a, b0); }
            const float gdiag = XT[512 + a];
            f32x4 cH[2], cQ[2], cW[2], cG[2];
            mm_f(yB, xK, cH); mm_f(yA, xT, cQ); mm_f(yA, xK, cW); mm_f(yB, xT, cG);
#pragma unroll
            for (int bi = 0; bi < 2; ++bi) { const int b0 = 16 * (bt0 + bi) + 4 * fq;
                st_lds4(L + SL(sHk), a, b0, (cH[bi] + eH[bi]) * gdiag);
                st_lds4(L + SL(1), a, b0, cQ[bi] + eR[bi]);
                st_lds4(L + SL(2), a, b0, cW[bi] + eW[bi]);
                f32x4 v = cG[bi];
#pragma unroll
                for (int e = 0; e < 4; ++e) v[e] += (b0 + e == a) ? 1.f : 0.f;
                st_lds4(L + SL(4), a, b0, v * gdiag); }
        }
        BAR_LDS();
        const LdsMat HkT{L + SL(sHk), LW};
        mm64<64>(VTm, HkT, wid, lane, [&](int a, int b0, f32x4 v) { st_lds4(L + SL(9), a, b0, v); });
        __builtin_nontemporal_store(*(LAS const u32x4*)(L + SL(1) + ((size_t)crow * LW + cch * 8) * 2), (u32x4*)(QRT + crow * 64 + cch * 8));
        __builtin_nontemporal_store(*(LAS const u32x4*)(L + SL(2) + ((size_t)crow * LW + cch * 8) * 2), (u32x4*)(WYT + crow * 64 + cch * 8));
        __builtin_nontemporal_store(*(LAS const u32x4*)(L + SL(4) + (size_t)tid * 16), (u32x4*)GTg + tid);
        if (tid < 64) __builtin_nontemporal_store(*(LAS const u32x4*)(L + SL(4) + (size_t)(512 + tid) * 16), (u32x4*)GTg + 512 + tid);
        if (next_unit < NUNIT) rwkv_pre_put_w(L, P, tid);
        BAR_LDS();
        __builtin_nontemporal_store(*(LAS const u32x4*)(L + SL(9) + (size_t)tid * 16), (u32x4*)Hg + tid);
        if (tid < 64) __builtin_nontemporal_store(*(LAS const u32x4*)(L + SL(9) + (size_t)(512 + tid) * 16), (u32x4*)Hg + 512 + tid);
    }
}

constexpr int RS_SLOT = 12 * 1024;
constexpr int RS_DEPTH = 8, RS_AHEAD = 6;
__device__ __forceinline__ void rwkv_scan_block(Frame& F, int item) {
    const int bh = item >> 2, qi = item & 3, lane = F.lane, fr = lane & 15, fq = lane >> 4, wid = F.wave;
    const char* GTg = (const char*)(F.dout + DO_GT) + (size_t)bh * 64 * (64 * GLD * 2);
    const char* Hg = (const char*)(F.dout + DO_H) + (size_t)bh * 64 * (64 * GLD * 2) + (size_t)qi * (16 * GLD * 2);
    bf16_t* SST = (bf16_t*)(F.dout + DO_SST) + (size_t)bh * 64 * 4096;
    LAS unsigned char* L = F.lds;
    auto issue = [&](int c) {
        if (wid >= 1) {
            LAS unsigned char* slot = L + (c & (RS_DEPTH - 1)) * RS_SLOT;
#pragma unroll
            for (int k = 0; k < 2; ++k) { const int pc = (wid - 1) + 7 * k;
                if (pc < 12) {
                    const char* src;
                    if (pc < 9) src = GTg + (size_t)c * (64 * GLD * 2) + pc * 1024 + lane * 16;
                    else { int off = (pc - 9) * 1024 + lane * 16; off = off > 2304 - 16 ? 2304 - 16 : off; src = Hg + (size_t)c * (64 * GLD * 2) + off; }
                    __builtin_amdgcn_global_load_lds((const unsigned*)src, (LAS unsigned*)(slot + pc * 1024), 16, 0, 0); } }
        }
    };
    f32x4 acc[4];
#pragma unroll
    for (int mt = 0; mt < 4; ++mt) acc[mt] = (f32x4){0.f, 0.f, 0.f, 0.f};
#pragma unroll 1
    for (int c = 0; c < RS_AHEAD; ++c) issue(c);
#pragma unroll 1
    for (int c = 0; c < NCH; ++c) {
        if (c + RS_AHEAD < NCH) issue(c + RS_AHEAD);
        if (c + RS_AHEAD < NCH) { if (wid >= 1 && wid <= 5) asm volatile("s_waitcnt vmcnt(12)" ::: "memory"); else if (wid >= 6) asm volatile("s_waitcnt vmcnt(6)" ::: "memory"); }
        else if (wid >= 1) asm volatile("s_waitcnt vmcnt(0)" ::: "memory");
        __builtin_amdgcn_s_barrier(); asm volatile("" ::: "memory");
        if (wid == 0) {
            LAS const unsigned char* slot = L + (c & (RS_DEPTH - 1)) * RS_SLOT;
            u32x2 ga[4][2][2], hv[4];
#pragma unroll
            for (int mt = 0; mt < 4; ++mt) {
#pragma unroll
                for (int s = 0; s < 2; ++s)
#pragma unroll
                    for (int hh = 0; hh < 2; ++hh) ga[mt][s][hh] = *(LAS const u32x2*)(slot + ((16 * mt + fr) * GLD + 16 * (2 * s + hh) + 4 * fq) * 2);
                hv[mt] = *(LAS const u32x2*)(slot + 9216 + (fr * GLD + 16 * mt + 4 * fq) * 2); }
            bf16_t* Sc = SST + (size_t)c * 4096; u32x2 sp[4];
#pragma unroll
            for (int mt = 0; mt < 4; ++mt) { sp[mt].x = cvt_pk_bf16(acc[mt][0], acc[mt][1]); sp[mt].y = cvt_pk_bf16(acc[mt][2], acc[mt][3]);
                *(u32x2*)(Sc + (size_t)(16 * qi + fr) * 64 + 16 * mt + 4 * fq) = sp[mt]; }
            bf16x8 sb[2];
#pragma unroll
            for (int s = 0; s < 2; ++s) { u32x4 w; w.x = sp[2 * s].x; w.y = sp[2 * s].y; w.z = sp[2 * s + 1].x; w.w = sp[2 * s + 1].y; sb[s] = __builtin_bit_cast(bf16x8, w); }
#pragma unroll
            for (int mt = 0; mt < 4; ++mt) { f32x4 a = (f32x4){bf_lo(hv[mt].x), bf_hi(hv[mt].x), bf_lo(hv[mt].y), bf_hi(hv[mt].y)};
#pragma unroll
                for (int s = 0; s < 2; ++s) { u32x4 w; w.x = ga[mt][s][0].x; w.y = ga[mt][s][0].y; w.z = ga[mt][s][1].x; w.w = ga[mt][s][1].y;
                    a = __builtin_amdgcn_mfma_f32_16x16x32_bf16(__builtin_bit_cast(bf16x8, w), sb[s], a, 0, 0, 0); }
                acc[mt] = a; }
            asm volatile("s_waitcnt lgkmcnt(0)" ::: "memory");
        }
    }
    asm volatile("s_waitcnt vmcnt(0)" ::: "memory");
    __builtin_amdgcn_s_barrier(); asm volatile("" ::: "memory");
}
__device__ __forceinline__ void s5_scan_block(Frame& F, int gb) {
    const int g = gb >> 3, b = gb & 7, p = F.lane, w = F.wave;
    const float* aL = (const float*)(F.ws + WS_AL) + g * 128; const float ar = aL[2 * p], ai = aL[2 * p + 1];
    const float* SLc = (const float*)(F.ws + WS_SLOC) + ((size_t)g * S5ROWS + b * 256 + 32 * w) * 128 + 2 * p;
    bf16_t* UG = (bf16_t*)(F.ws + WS_UG) + ((size_t)g * S5ROWS + b * 256 + 32 * w) * UGLD + 256 + 2 * p;
    LAS float* E = (LAS float*)(F.lds);
    f32x2 l[32];
#pragma unroll
    for (int k = 0; k < 32; ++k) l[k] = *(const f32x2*)(SLc + (size_t)k * 128);
    float sr = 0.f, si = 0.f;
#pragma unroll
    for (int k = 0; k < 32; ++k) { const float nr = ar * sr - ai * si + l[k].x, ni = ar * si + ai * sr + l[k].y; l[k].x = sr; l[k].y = si; sr = nr; si = ni; }
    E[(w * 64 + p) * 2] = sr; E[(w * 64 + p) * 2 + 1] = si;
    float pr = ar, pi = ai;
#pragma unroll
    for (int q = 0; q < 5; ++q) { const float nr = pr * pr - pi * pi, ni = 2.f * pr * pi; pr = nr; pi = ni; }
    asm volatile("s_waitcnt lgkmcnt(0)" ::: "memory"); __builtin_amdgcn_s_barrier(); asm volatile("" ::: "memory");
    float cr = 0.f, ci = 0.f;
#pragma unroll
    for (int w2 = 0; w2 < 7; ++w2) { if (w2 < w) { const float er = E[(w2 * 64 + p) * 2], ei = E[(w2 * 64 + p) * 2 + 1]; const float nr = pr * cr - pi * ci + er, ni = pr * ci + pi * cr + ei; cr = nr; ci = ni; } }
#pragma unroll
    for (int k = 0; k < 32; ++k) { *(unsigned*)(UG + (size_t)k * UGLD) = cvt_pk_bf16(l[k].x + cr, l[k].y + ci); const float nr = ar * cr - ai * ci, ni = ar * ci + ai * cr; cr = nr; ci = ni; }
    asm volatile("s_waitcnt lgkmcnt(0)" ::: "memory"); __builtin_amdgcn_s_barrier(); asm volatile("" ::: "memory");
}
struct OutY { bf16x8 yq[2], yw[2]; u32x2 pv[4], pp[4], gv[4]; float bon; };
__device__ __forceinline__ void rwkv_out_loady(Frame& F, int unit, int at, OutY& Lq) {
    const int lane = F.lane, fr = lane & 15, fq = lane >> 4;
    const int bh = unit >> 6, c = unit & 63, b = bh >> 3, h = bh & 7;
    const bf16_t* QRT = (const bf16_t*)(F.ws + WS_QRT) + (size_t)unit * 4096; const bf16_t* WYT = (const bf16_t*)(F.ws + WS_WYT) + (size_t)unit * 4096;
#pragma unroll
    for (int s = 0; s < 2; ++s) { Lq.yq[s] = __builtin_nontemporal_load((const bf16x8*)(QRT + (size_t)(16 * at + fr) * 64 + 32 * s + 8 * fq)); Lq.yw[s] = __builtin_nontemporal_load((const bf16x8*)(WYT + (size_t)(16 * at + fr) * 64 + 32 * s + 8 * fq)); }
    const int tl = c * 64 + 16 * at + fr, tg = b * SEQ + tl;
    const bf16_t* prow = (const bf16_t*)(F.ws + WS_PR) + (size_t)tg * NRW + 1024 + h * 64;
    const bf16_t* gb = (const bf16_t*)(F.ws + WS_GBUF) + (size_t)tg * RW + h * 64;
    Lq.bon = ((const float*)(F.ws + WS_BONUS))[(size_t)tg * 8 + h];
    const bf16_t* pprev = prow - (tl > 0 ? NRW : 0);
#pragma unroll
    for (int bt = 0; bt < 4; ++bt) { const int i0 = 16 * bt + 4 * fq; Lq.pv[bt] = *(const u32x2*)(prow + i0); Lq.pp[bt] = *(const u32x2*)(pprev + i0); Lq.gv[bt] = *(const u32x2*)(gb + i0); }
}
__device__ __forceinline__ void rwkv_out_comp(Frame& F, int unit, int at, const bf16x8 (&xs)[2][4], const bf16x8 (&xv)[2][4], const OutY& Lq) {
    const int lane = F.lane, fr = lane & 15, fq = lane >> 4;
    const int bh = unit >> 6, c = unit & 63, b = bh >> 3, h = bh & 7;
    f32x4 m4[4], lw[4], lb[4];
#pragma unroll
    for (int bt = 0; bt < 4; ++bt) { const int i0 = 16 * bt + 4 * fq; m4[bt] = *(const f32x4*)(F.in[I_MU] + 1024 + h * 64 + i0); lw[bt] = *(const f32x4*)(F.in[I_LNW] + h * 64 + i0); lb[bt] = *(const f32x4*)(F.in[I_LNB] + h * 64 + i0); }
    f32x4 acc[4];
#pragma unroll
    for (int bt = 0; bt < 4; ++bt) acc[bt] = (f32x4){0.f, 0.f, 0.f, 0.f};
#pragma unroll
    for (int s = 0; s < 2; ++s)
#pragma unroll
        for (int bt = 0; bt < 4; ++bt) {
            acc[bt] = __builtin_amdgcn_mfma_f32_16x16x32_bf16(xs[s][bt], Lq.yq[s], acc[bt], 0, 0, 0);
            acc[bt] = __builtin_amdgcn_mfma_f32_16x16x32_bf16(xv[s][bt], Lq.yw[s], acc[bt], 0, 0, 0); }
    float s1 = 0.f;
#pragma unroll
    for (int bt = 0; bt < 4; ++bt) s1 += (acc[bt][0] + acc[bt][1]) + (acc[bt][2] + acc[bt][3]);
    s1 += __shfl_xor(s1, 16); s1 += __shfl_xor(s1, 32);
    const float mean = s1 * (1.f / 64.f); float s2 = 0.f;
#pragma unroll
    for (int bt = 0; bt < 4; ++bt) { const f32x4 d = acc[bt] - mean; s2 += (d[0] * d[0] + d[1] * d[1]) + (d[2] * d[2] + d[3] * d[3]); }
    s2 += __shfl_xor(s2, 16); s2 += __shfl_xor(s2, 32);
    const float rstd = __builtin_amdgcn_rsqf(s2 * (1.f / 64.f) + 64e-5f);
    const int tl = c * 64 + 16 * at + fr, tg = b * SEQ + tl;
    const float pmask = tl > 0 ? 1.f : 0.f;
    bf16_t* YRS = (bf16_t*)(F.dout + DO_YRS) + (size_t)tg * D + h * 64;
#pragma unroll
    for (int bt = 0; bt < 4; ++bt) { const int i0 = 16 * bt + 4 * fq;
        const u32x2 pv = Lq.pv[bt], pp = Lq.pp[bt], gv = Lq.gv[bt];
        const float x[4] = {bf_lo(pv.x), bf_hi(pv.x), bf_lo(pv.y), bf_hi(pv.y)}, xp[4] = {bf_lo(pp.x) * pmask, bf_hi(pp.x) * pmask, bf_lo(pp.y) * pmask, bf_hi(pp.y) * pmask}, gg[4] = {bf_lo(gv.x), bf_hi(gv.x), bf_lo(gv.y), bf_hi(gv.y)};
        float o[4];
#pragma unroll
        for (int e = 0; e < 4; ++e) { const float vsh = x[e] + (xp[e] - x[e]) * m4[bt][e]; o[e] = ((acc[bt][e] - mean) * rstd * lw[bt][e] + lb[bt][e] + Lq.bon * vsh) * gg[e]; }
        u32x2 w; w.x = cvt_pk_bf16(o[0], o[1]); w.y = cvt_pk_bf16(o[2], o[3]); *(u32x2*)(YRS + i0) = w; }
}
__device__ __forceinline__ void rwkv_out_units(Frame& F) {
    const int lane = F.lane, fr = lane & 15, fq = lane >> 4;
    for (int unit = F.vcu * NWAVES + F.wave; unit < NUNIT; unit += F.G * NWAVES) {
        const bf16_t* VT = (const bf16_t*)(F.ws + WS_VT) + (size_t)unit * 4096; const bf16_t* SST = (const bf16_t*)(F.dout + DO_SST) + (size_t)unit * 4096;
        bf16x8 xs[2][4], xv[2][4]; OutY A, B;
#pragma unroll
        for (int s = 0; s < 2; ++s)
#pragma unroll
            for (int bt = 0; bt < 4; ++bt) { xs[s][bt] = __builtin_nontemporal_load((const bf16x8*)(SST + (size_t)(16 * bt + fr) * 64 + 32 * s + 8 * fq)); xv[s][bt] = __builtin_nontemporal_load((const bf16x8*)(VT + (size_t)(16 * bt + fr) * 64 + 32 * s + 8 * fq)); }
        rwkv_out_loady(F, unit, 0, A); rwkv_out_loady(F, unit, 1, B); __builtin_amdgcn_sched_barrier(0);
        rwkv_out_comp(F, unit, 0, xs, xv, A); __builtin_amdgcn_sched_barrier(0); rwkv_out_loady(F, unit, 2, A); __builtin_amdgcn_sched_barrier(0);
        rwkv_out_comp(F, unit, 1, xs, xv, B); __builtin_amdgcn_sched_barrier(0); rwkv_out_loady(F, unit, 3, B); __builtin_amdgcn_sched_barrier(0);
        rwkv_out_comp(F, unit, 2, xs, xv, A); __builtin_amdgcn_sched_barrier(0);
        rwkv_out_comp(F, unit, 3, xs, xv, B); __builtin_amdgcn_sched_barrier(0);
    }
}

__device__ __forceinline__ void p8_rows(Frame& F) {
    const int gw = F.vcu * NWAVES + F.wave, NGW = F.G * NWAVES, lane = F.lane;
    const bf16_t* MX = (const bf16_t*)(F.ws + WS_MIXED); const float* ST = (const float*)(F.ws + WS_STAT1); bf16_t* H2 = (bf16_t*)(F.ws + WS_H2); float* X1 = (float*)F.dout;
    f32x4 gp[4];
#pragma unroll
    for (int j = 0; j < 4; ++j) gp[j] = *(const f32x4*)(F.in[I_NMPOST] + 256 * j + 4 * lane);
    for (int m0 = gw; m0 < T; m0 += 2 * NGW) {
        int mm[2] = {m0, (m0 + NGW < T) ? m0 + NGW : m0};
        f32x4 xv[2][4]; u32x2 mw[2][4]; float st[2];
#pragma unroll
        for (int q = 0; q < 2; ++q) { st[q] = (lane < 16) ? ST[(size_t)mm[q] * 16 + lane] : 0.f;
#pragma unroll
            for (int j = 0; j < 4; ++j) { const int col = 256 * j + 4 * lane; xv[q][j] = __builtin_nontemporal_load((const f32x4*)(F.in[I_X] + (size_t)mm[q] * D + col)); mw[q][j] = __builtin_nontemporal_load((const u32x2*)(MX + (size_t)mm[q] * D + col)); } }
#pragma unroll
        for (int q = 0; q < 2; ++q) {
            const float rstd1 = __builtin_amdgcn_rsqf(wave_sum(st[q]) * (1.f / D) + 1e-6f);
            f32x4 v[4]; float s = 0.f;
#pragma unroll
            for (int j = 0; j < 4; ++j) { const int col = 256 * j + 4 * lane;
                v[j].x = xv[q][j].x + bf_lo(mw[q][j].x) * rstd1 * gp[j].x; v[j].y = xv[q][j].y + bf_hi(mw[q][j].x) * rstd1 * gp[j].y; v[j].z = xv[q][j].z + bf_lo(mw[q][j].y) * rstd1 * gp[j].z; v[j].w = xv[q][j].w + bf_hi(mw[q][j].y) * rstd1 * gp[j].w;
                s += (v[j].x * v[j].x + v[j].y * v[j].y) + (v[j].z * v[j].z + v[j].w * v[j].w);
                }
            const float rstd2 = __builtin_amdgcn_rsqf(wave_sum(s) * (1.f / D) + 1e-6f);
#pragma unroll
            for (int j = 0; j < 4; ++j) { u32x2 w; w.x = cvt_pk_bf16(v[j].x * rstd2, v[j].y * rstd2); w.y = cvt_pk_bf16(v[j].z * rstd2, v[j].w * rstd2); *(u32x2*)(H2 + (size_t)mm[q] * D + 256 * j + 4 * lane) = w; }
        }
    }
}
__device__ __forceinline__ void p12_rows(Frame& F) {
    const int gw = F.vcu * NWAVES + F.wave, NGW = F.G * NWAVES, lane = F.lane;
    const bf16_t* FB = (const bf16_t*)(F.ws + WS_F); const bf16_t* MX = (const bf16_t*)(F.ws + WS_MIXED);
    const float* ST1 = (const float*)(F.ws + WS_STAT1); const float* ST2 = (const float*)(F.ws + WS_STAT2); float* OUT = (float*)F.dout;
    f32x4 gp[4], gq[4];
#pragma unroll
    for (int j = 0; j < 4; ++j) { gp[j] = *(const f32x4*)(F.in[I_NMPOST] + 256 * j + 4 * lane); gq[j] = *(const f32x4*)(F.in[I_NFPOST] + 256 * j + 4 * lane); }
    for (int m0 = gw; m0 < T; m0 += 2 * NGW) {
        int mm[2] = {m0, (m0 + NGW < T) ? m0 + NGW : m0};
        f32x4 xv[2][4]; u32x2 mw[2][4], fw[2][4]; float s1[2], s2[2];
#pragma unroll
        for (int q = 0; q < 2; ++q) { s1[q] = (lane < 16) ? ST1[(size_t)mm[q] * 16 + lane] : 0.f; s2[q] = (lane < 16) ? ST2[(size_t)mm[q] * 16 + lane] : 0.f;
#pragma unroll
            for (int j = 0; j < 4; ++j) { const int col = 256 * j + 4 * lane; xv[q][j] = __builtin_nontemporal_load((const f32x4*)(F.in[I_X] + (size_t)mm[q] * D + col));
                mw[q][j] = __builtin_nontemporal_load((const u32x2*)(MX + (size_t)mm[q] * D + col)); fw[q][j] = __builtin_nontemporal_load((const u32x2*)(FB + (size_t)mm[q] * D + col)); } }
#pragma unroll
        for (int q = 0; q < 2; ++q) {
            const float rstd1 = __builtin_amdgcn_rsqf(wave_sum(s1[q]) * (1.f / D) + 1e-6f), rstd3 = __builtin_amdgcn_rsqf(wave_sum(s2[q]) * (1.f / D) + 1e-6f);
#pragma unroll
            for (int j = 0; j < 4; ++j) { const int col = 256 * j + 4 * lane; f32x4 o;
                o.x = xv[q][j].x + bf_lo(mw[q][j].x) * rstd1 * gp[j].x; o.y = xv[q][j].y + bf_hi(mw[q][j].x) * rstd1 * gp[j].y; o.z = xv[q][j].z + bf_lo(mw[q][j].y) * rstd1 * gp[j].z; o.w = xv[q][j].w + bf_hi(mw[q][j].y) * rstd1 * gp[j].w;
                o.x += bf_lo(fw[q][j].x) * rstd3 * gq[j].x; o.y += bf_hi(fw[q][j].x) * rstd3 * gq[j].y; o.z += bf_lo(fw[q][j].y) * rstd3 * gq[j].z; o.w += bf_hi(fw[q][j].y) * rstd3 * gq[j].w;
                __builtin_nontemporal_store(o, (f32x4*)(OUT + (size_t)mm[q] * D + col)); }
        }
    }
}

#ifndef MK_PER_PHASE
#define MK_PER_PHASE 0
#endif
constexpr int NPHASE = 12;
struct Args { const float* in[35]; float* out; unsigned char* ws; int ph_lo, ph_hi; };
static_assert(sizeof(Args) == 35 * 8 + 8 + 8 + 8, "Args has no padding");

__device__ __forceinline__ bool phase_begin(Frame& F) { unsigned long long z = 0; asm volatile("" : "+s"(z), "+v"(F.tid)); F.ws = F.ws0 + z; F.dout = F.dout0 + z;     F.lane = F.tid & 63; F.wave = __builtin_amdgcn_readfirstlane(F.tid >> 6); return true; }
__global__ void __launch_bounds__(NWAVES * 64, 2) fwd_kernel(Args args) {
    extern __shared__ __attribute__((aligned(16))) unsigned char lds_raw[];
    Frame F;
    F.lds = (LAS unsigned char*)lds_raw;
    F.MISC = (volatile LAS unsigned*)(F.lds + MISC_OFF);
    F.tid = threadIdx.x; F.lane = F.tid & 63; F.wave = __builtin_amdgcn_readfirstlane(F.tid >> 6);
    F.G = gridDim.x; { const int bx = blockIdx.x; F.vcu = (F.G % 8 == 0) ? (bx % 8) * (F.G / 8) + bx / 8 : bx; }
    F.ws0 = args.ws; F.dout0 = (unsigned char*)args.out; F.ws = F.ws0; F.dout = F.dout0; F.ctl = (gu32*)(args.ws + WS_CTL);
    F.in = (InTab)__builtin_amdgcn_kernarg_segment_ptr();
    for (int u = F.tid; u < (LDS_BYTES - LDSCTL_OFF) / 4; u += NWAVES * 64) ((LAS unsigned*)(F.lds + LDSCTL_OFF))[u] = 0u;
    __syncthreads();
    XcdBarrier bar; bar.bar = (unsigned*)(F.ctl + CW_BAR); bar.x = 0; bar.st = nullptr;
    if (!MK_PER_PHASE) bar = xcd_barrier_post((unsigned*)(F.ctl + CW_BAR), F.MISC + 8);
    const int lo = args.ph_lo, hi = args.ph_hi;
#ifndef PHMASK
#define PHMASK 0xffffffffu
#endif
#define IN(k) (((PHMASK >> (k)) & 1u) && lo <= (k) && (k) < hi && phase_begin(F))
#ifndef REPMASK
#define REPMASK 0u
#endif
#define REPS(k) ((((REPMASK) >> (k)) & 1u) ? 2 : 1)
#define PH(k) for (int rep_ = 0; rep_ < REPS(k); ++rep_, (rep_ < REPS(k) ? xcd_barrier(bar) : (void)0))
#define INQ(k) (lo <= (k) && (k) < hi)
#define SEAM(k) do { if (INQ(k) && INQ((k) + 1)) xcd_barrier(bar); } while (0)
#define WSB(off) ((bf16_t*)(F.ws + (off)))
    const int bx = (int)blockIdx.x;

    PH(0) if (IN(0)) { p0_prologue(F); }
    SEAM(0);
    PH(1) if (IN(1)) {
        pg8::Gemm g{D, D, D, 0}; pg8::StaticOrder S; S.init(WSB(WS_XN), WSB(WS_WIN), D, D, T, NIN, F.G, bx);
        EpiInProj E{WSB(WS_PR), WSB(WS_UG), WSB(WS_GATES), F.in[I_BGATE], 0};
        pg8::gemm_phase<EpiInProj, pg8::StaticOrder, true>(F.lds, g, S, E, F.tid);
        { const int rem = ((T / 256) * (NIN / 256)) % F.G;
          if (rem == 0) p0_late_mats(F, bx * NWAVES + F.wave, F.G * NWAVES); else if (bx >= rem) p0_late_mats(F, (bx - rem) * NWAVES + F.wave, (F.G - rem) * NWAVES); }
    }
    SEAM(1);
    PH(2) if (IN(2)) {
        PrePf pf;
        if (F.vcu < NB * NCH) { rwkv_pre_fetch(F, (((F.vcu >> 6) * NHEAD) << 6) + (F.vcu & 63), true, pf, F.tid); rwkv_pre_put_w(F.lds, pf, F.tid); }
        {
            LAS f32x4* TB = (LAS f32x4*)(F.lds + XTRA_OFF + 4096);
            if (F.tid < NRW / 4) TB[F.tid] = ((const f32x4*)F.in[I_MU])[F.tid];
            const int pq = F.tid >> 7, pi = F.tid & 127;
            const float* psrc = pq == 0 ? F.in[I_W0] : pq == 1 ? F.in[I_A0] : pq == 2 ? F.in[I_KK] : F.in[I_KA];
            TB[NRW / 4 + F.tid] = ((const f32x4*)psrc)[pi];
            if (F.tid < 128) TB[NRW / 4 + 512 + F.tid] = ((const f32x4*)F.in[I_RK])[F.tid];
            BAR_LDS();
        }
        for (int pc = F.vcu; pc < NB * NCH; pc += F.G) {
#pragma unroll 1
            for (int hh = 0; hh < NHEAD; ++hh) { const int bq = pc >> 6, cq = pc & 63, u = ((bq * NHEAD + hh) << 6) + cq;
                const int un = (hh < NHEAD - 1) ? u + 64 : ((pc + F.G < NB * NCH) ? ((((pc + F.G) >> 6) * NHEAD) << 6) + ((pc + F.G) & 63) : NUNIT);
                rwkv_pre_unit(F, u, un, hh == 0, hh == NHEAD - 1, pf); } }
        BAR_LDS();
        pg8::Gemm g{256, UGLD, 256, 0}; S5Order S{WSB(WS_UG), WSB(WS_B1A), 256, F.G, bx};
        EpiSloc E{(float*)(F.ws + WS_SLOC), 0};
        pg8::gemm_phase<EpiSloc, S5Order, true>(F.lds, g, S, E, F.tid);
    }
    SEAM(2);
    PH(3) if (IN(3)) {
        for (int gb = F.vcu; gb < S5G * NB; gb += F.G) s5_scan_block(F, gb);
        for (int it = F.vcu; it < NB * NHEAD * 4; it += F.G) rwkv_scan_block(F, it);
    }
    SEAM(3);
    PH(4) if (IN(4)) {
        rwkv_out_units(F);
        VM_WAIT(); __syncthreads();
        pg8::Gemm g{384, UGLD, 384, 0}; S5Order S{WSB(WS_UG), WSB(WS_B1B), 384, F.G, bx};
        pg8::EpiGen8<FS5Out> E{FS5Out{WSB(WS_YSP)}, 0};
        pg8::gemm_phase<pg8::EpiGen8<FS5Out>, S5Order, true>(F.lds, g, S, E, F.tid);
    }
    SEAM(4);
    PH(5) if (IN(5)) {
        pg8::Gemm g{RW, RW, RW, 1}; pg8::StaticOrder S; S.init(WSB(WS_YSP), WSB(WS_WGLU), RW, RW, T, RW, F.G, bx); S.tstepA = (size_t)16 * 256 * 2;
        EpiGlu E{WSB(WS_YSP), (bf16_t*)(F.dout + DO_YRS), F.in[I_BGLU], 0};
        pg8::gemm_phase<EpiGlu, pg8::StaticOrder, true>(F.lds, g, S, E, F.tid);
    }
    SEAM(5);
    PH(6) if (IN(6)) {
        pg8::Gemm g{RW, D, D, 0};
        { pg8::StaticOrder S; S.init((const bf16_t*)(F.dout + DO_YRS), WSB(WS_WBRS), D, D, T, D, F.G, bx);
          EpiMergeA E{WSB(WS_GATES), WSB(WS_PR), 0};
          pg8::gemm_phase<EpiMergeA, pg8::StaticOrder, true>(F.lds, g, S, E, F.tid); }
        { pg8::StaticOrder S; S.init((const bf16_t*)(F.dout + DO_YRS) + RW, WSB(WS_WBRS) + RW, D, D, T, D, F.G, bx);
          EpiMergeB E{WSB(WS_GATES), WSB(WS_PR), WSB(WS_MERGED), 0};
          pg8::gemm_phase<EpiMergeB, pg8::StaticOrder, true>(F.lds, g, S, E, F.tid); }
    }
    SEAM(6);
    PH(7) if (IN(7)) {
        pg8::Gemm g{D, D, D, 0}; pg8::StaticOrder S; S.init(WSB(WS_MERGED), WSB(WS_WOUT), D, D, T, D, F.G, bx);
        EpiRowStat E{WSB(WS_MIXED), (float*)(F.ws + WS_STAT1), 0};
        pg8::gemm_phase<EpiRowStat, pg8::StaticOrder, false>(F.lds, g, S, E, F.tid);
    }
    SEAM(7);
    PH(8) if (IN(8)) { p8_rows(F);
        for (size_t i = (size_t)bx * 512 + F.tid; i < HZ_BYTES / 16; i += (size_t)F.G * 512) ((u32x4*)(F.ws + WS_HZ))[i] = (u32x4){0u, 0u, 0u, 0u}; }
    SEAM(8);
    PH(9) if (IN(9)) {
        pg8::Gemm g{D, D, D, 0}; UpOrder S{WSB(WS_H2), WSB(WS_WUP), F.G, bx};
        EpiConvAct E{WSB(WS_ACT), F.in[I_CONVW], F.in[I_CONVB], (LAS unsigned*)(F.lds + XTRA_OFF), (unsigned long long*)(F.ws + WS_HZ), (unsigned*)(F.ctl + 2), 0};
        pg8::gemm_phase<EpiConvAct, UpOrder, true>(F.lds, g, S, E, F.tid);
    }
    SEAM(9);
    PH(10) if (IN(10)) {
        pg8::Gemm g{FF, FF, FF, 0}; pg8::StaticOrder S; S.init(WSB(WS_ACT), WSB(WS_WDN), FF, FF, T, D, F.G, bx);
        EpiRowStat E{WSB(WS_F), (float*)(F.ws + WS_STAT2), 0};
        pg8::gemm_phase<EpiRowStat, pg8::StaticOrder, false>(F.lds, g, S, E, F.tid);
    }
    SEAM(10);
    if (IN(11)) p12_rows(F);
#undef IN
#undef INQ
#undef SEAM
#undef WSB
}

extern "C" void kernel_launch(void* const* d_in, const int* in_sizes, int n_in, void* d_out, int out_size, void* d_ws, size_t ws_size, hipStream_t stream) {
    static int grid = 0;
    if (grid == 0) {
        if (n_in != 35 || in_sizes[0] != T * D || out_size != T * D || ws_size < WS_END) { fprintf(stderr, "kernel_launch: unexpected shapes: n_in %d in0 %d out %d ws %zu (need %zu)\n", n_in, n_in > 0 ? in_sizes[0] : -1, out_size, ws_size, (size_t)WS_END); grid = -1; return; }
        int dev = 0, cus = 0, per_cu = 0;
        if (hipGetDevice(&dev) != hipSuccess || hipDeviceGetAttribute(&cus, hipDeviceAttributeMultiprocessorCount, dev) != hipSuccess) { fprintf(stderr, "kernel_launch: device query failed\n"); grid = -1; return; }
        if (hipFuncSetAttribute((const void*)fwd_kernel, hipFuncAttributeMaxDynamicSharedMemorySize, LDS_BYTES) != hipSuccess) { fprintf(stderr, "kernel_launch: hipFuncSetAttribute failed\n"); grid = -1; return; }
        if (hipOccupancyMaxActiveBlocksPerMultiprocessor(&per_cu, (const void*)fwd_kernel, NWAVES * 64, LDS_BYTES) != hipSuccess || per_cu < 1) fprintf(stderr, "kernel_launch: occupancy query reports %d blocks per CU\n", per_cu);
        (void)hipGetLastError();
        grid = cus;
    }
    if (grid < 0) return;
    if (hipMemsetAsync((char*)d_ws + WS_CTL, 0, CTL_ZERO_BYTES, stream) != hipSuccess) { fprintf(stderr, "kernel_launch: memset failed\n"); return; }
    Args a{};
    for (int i = 0; i < 35; ++i) a.in[i] = (const float*)d_in[i];
    a.out = (float*)d_out; a.ws = (unsigned char*)d_ws;
#if MK_PER_PHASE
    for (int ph = 0; ph < NPHASE; ++ph) { a.ph_lo = ph; a.ph_hi = ph + 1; hipLaunchKernelGGL(fwd_kernel, dim3(grid), dim3(NWAVES * 64), LDS_BYTES, stream, a); }
#else
    a.ph_lo = 0; a.ph_hi = NPHASE;
    hipLaunchKernelGGL(fwd_kernel, dim3(grid), dim3(NWAVES * 64), LDS_BYTES, stream, a);
#endif
    const hipError_t le = hipPeekAtLastError();
    if (le != hipSuccess) fprintf(stderr, "kernel_launch: launch failed: %s\n", hipGetErrorName(le));
}
```

```cpp
#include <hip/hip_runtime.h>
#include <cstdio>
#include <cstdint>

#define LAS __attribute__((address_space(3)))
#define GAS __attribute__((address_space(1)))
typedef unsigned short bf16_t;
typedef short bf16x8 __attribute__((ext_vector_type(8)));
typedef float f32x4 __attribute__((ext_vector_type(4)));
typedef float f32x2 __attribute__((ext_vector_type(2)));
typedef unsigned u32x4 __attribute__((ext_vector_type(4)));
typedef unsigned u32x2 __attribute__((ext_vector_type(2)));
typedef GAS unsigned gu32;

constexpr int T = 32768, SEQ = 4096, NB = 8, D = 1024, NIN = 4352, NRW = 1792, RW = 512, FF = 2816, FH = 1408;
constexpr int NHEAD = 8, HD = 64, NCH = 64  , NUNIT = NB * NHEAD * NCH;
constexpr int S5G = 32, S5ROWS = T / 16, UGLD = 384;

constexpr size_t MiB = 1u << 20;
constexpr size_t WS_CTL = 0, CTL_ZERO_BYTES = 1 * MiB;
constexpr size_t WS_WIN = 1 * MiB;
constexpr size_t WS_WUP = WS_WIN + (size_t)NIN * D * 2;
constexpr size_t WS_WDN = WS_WUP + (size_t)2 * FF * D * 2;
constexpr size_t WS_WOUT = WS_WDN + (size_t)D * FF * 2;
constexpr size_t WS_WBRS = WS_WOUT + (size_t)D * D * 2;
constexpr size_t WS_WGLU = WS_WBRS + (size_t)D * D * 2;
constexpr size_t WS_W2T = WS_WGLU + (size_t)RW * RW * 2;
constexpr size_t WS_A2T = WS_W2T + (size_t)RW * 64 * 2;
constexpr size_t WS_G2T = WS_A2T + (size_t)RW * 64 * 2;
constexpr size_t WS_B1A = WS_G2T + (size_t)RW * 128 * 2;
constexpr size_t WS_B1B = WS_B1A + (size_t)S5G * 256 * 256 * 2;
constexpr size_t WS_AL = WS_B1B + (size_t)S5G * 256 * 384 * 2;
constexpr size_t WS_WEND = WS_AL + (size_t)S5G * 64 * 2 * 4;
static_assert(WS_WEND <= 44 * MiB, "weights region");
constexpr size_t WS_XN = 44 * MiB;
constexpr size_t WS_QRT = 44 * MiB, WS_WYT = 76 * MiB;
constexpr size_t WS_MERGED = 44 * MiB, WS_H2 = 44 * MiB, WS_F = 44 * MiB;
constexpr size_t WS_PR = 108 * MiB;
constexpr size_t WS_MIXED = 304 * MiB, WS_STAT1 = 368 * MiB;
constexpr size_t WS_ACT = 108 * MiB;
constexpr size_t WS_STAT2 = 284 * MiB;
constexpr size_t WS_UG = 220 * MiB;
constexpr size_t WS_GATES = 268 * MiB;
constexpr size_t WS_SLOC = 396 * MiB, WS_YSP = 396 * MiB;
constexpr size_t WS_GBUF = 428 * MiB;
constexpr size_t WS_BONUS = 460 * MiB;
constexpr size_t WS_VT = 461 * MiB;
constexpr size_t WS_LRSCR = 493 * MiB;
constexpr size_t WS_Z = 336 * MiB;
constexpr size_t WS_END = 512 * MiB;
constexpr size_t DO_H = 0, DO_GT = 36 * MiB, DO_SST = 96 * MiB, DO_YRS = 0;
constexpr int GLD = 72;

constexpr int CW_BAR = 4096, CW_HF = 32768, CW_XNQ = 64;
constexpr size_t WS_HZ = 290 * MiB, HZ_BYTES = (size_t)2816 * 4 * 2 * 32 * 8;

constexpr int RING_BYTES = 131072, LDSCTL_OFF = RING_BYTES, MISC_OFF = LDSCTL_OFF + 320, XTRA_OFF = LDSCTL_OFF + 1024, LDS_BYTES = 155648;
constexpr int NWAVES = 8;

#define RLX_AGENT __ATOMIC_RELAXED, __HIP_MEMORY_SCOPE_AGENT
#define LDS_WAIT() asm volatile("s_waitcnt lgkmcnt(0)" ::: "memory")
#define VM_WAIT() asm volatile("s_waitcnt vmcnt(0)" ::: "memory")

typedef __bf16 bf16x2_t __attribute__((ext_vector_type(2)));
__device__ __forceinline__ unsigned cvt_pk_bf16(float lo, float hi) { const f32x2 v = {lo, hi}; return __builtin_bit_cast(unsigned, __builtin_convertvector(v, bf16x2_t)); }
__device__ __forceinline__ float bf_lo(unsigned w) { return __uint_as_float(w << 16); }
__device__ __forceinline__ float bf_hi(unsigned w) { return __uint_as_float(w & 0xffff0000u); }
__device__ __forceinline__ float bf1(bf16_t h) { return __uint_as_float((unsigned)h << 16); }
__device__ __forceinline__ float fexp(float x) { return __builtin_amdgcn_exp2f(x * 1.44269504089f); }
__device__ __forceinline__ float fsigmoid(float x) { return __builtin_amdgcn_rcpf(1.0f + __builtin_amdgcn_exp2f(-1.44269504089f * x)); }
__device__ __forceinline__ float ftanh(float x) { return 1.0f - 2.0f * __builtin_amdgcn_rcpf(1.0f + __builtin_amdgcn_exp2f(2.88539008178f * x)); }
__device__ __forceinline__ float fgelu(float x) { const float u = 0.7978845608f * (x + 0.044715f * x * x * x); return x * fsigmoid(2.0f * u); }
__device__ __forceinline__ void unpack8(u32x4 w, float (&f)[8]) { f[0] = bf_lo(w.x); f[1] = bf_hi(w.x); f[2] = bf_lo(w.y); f[3] = bf_hi(w.y); f[4] = bf_lo(w.z); f[5] = bf_hi(w.z); f[6] = bf_lo(w.w); f[7] = bf_hi(w.w); }
__device__ __forceinline__ u32x4 pack8(const float (&f)[8]) { u32x4 w; w.x = cvt_pk_bf16(f[0], f[1]); w.y = cvt_pk_bf16(f[2], f[3]); w.z = cvt_pk_bf16(f[4], f[5]); w.w = cvt_pk_bf16(f[6], f[7]); return w; }
__device__ __forceinline__ float wave_sum(float v) {
#pragma unroll
    for (int o = 1; o < 64; o <<= 1) v += __shfl_xor(v, o);
    return v;
}

#define XB_TMO      128
#define XB_XCNT(j)  (256  + 64 * (j))
#define XB_XSUB(j)  (1280 + 64 * (j))
#define XB_XGEN(j)  (2304 + 64 * (j))
#define XB_TOP      3328
#define XB_TOPGEN   3392
#define XCD_BAR_WORDS 3456
#define XB_SPIN_CAP (1u << 18)
__device__ __forceinline__ unsigned xb_ld(unsigned* p)              { return __hip_atomic_load(p, __ATOMIC_RELAXED, __HIP_MEMORY_SCOPE_AGENT); }
__device__ __forceinline__ unsigned xb_add(unsigned* p, unsigned v) { return __hip_atomic_fetch_add(p, v, __ATOMIC_RELAXED, __HIP_MEMORY_SCOPE_AGENT); }
__device__ __forceinline__ unsigned xb_xcc_id() { return (unsigned)__builtin_amdgcn_s_getreg((3 << 11) | 20) & 0xFu; }
#define XB_SPIN(cond, bar) do { unsigned _sp = 0; while (cond) { __builtin_amdgcn_s_sleep(1); \
    if ((++_sp & 255u) == 0u) { if (xb_ld(&(bar)[XB_TMO])) break; if (_sp > XB_SPIN_CAP) { atomicAdd(&(bar)[XB_TMO], 1u); break; } } } } while (0)
struct XcdBarrier { unsigned* bar; unsigned x; volatile LAS unsigned* st; };
__device__ __forceinline__ XcdBarrier xcd_barrier_post(unsigned* bar, volatile LAS unsigned* st) {
    XcdBarrier b; b.bar = bar; b.x = xb_xcc_id(); b.st = st;
    if (threadIdx.x == 0) (void)xb_add(&bar[XB_XCNT(b.x)], 1u);
    return b;
}
__device__ __forceinline__ void xcd_barrier_complete(unsigned* bar, unsigned x, unsigned& nloc, unsigned& nx) {
    const unsigned G = gridDim.x * gridDim.y * gridDim.z;
    unsigned sum, cnt, mine, sp = 0u;
    for (;;) {
        sum = 0u; cnt = 0u; mine = 0u;
#pragma unroll
        for (unsigned j = 0; j < 16; ++j) { const unsigned c = xb_ld(&bar[XB_XCNT(j)]); sum += c; cnt += (c > 0u) ? 1u : 0u; mine = (j == x) ? c : mine; }
        if (sum == G) break;
        __builtin_amdgcn_s_sleep(1);
        if ((++sp & 255u) == 0u) { if (xb_ld(&bar[XB_TMO])) break; if (sp > XB_SPIN_CAP) { atomicAdd(&bar[XB_TMO], 1u); break; } }
    }
    nloc = mine > 0u ? mine : 1u; nx = cnt > 0u ? cnt : 1u;
}
__device__ __forceinline__ void xcd_barrier(const XcdBarrier& b) {
    asm volatile("s_waitcnt vmcnt(0)" ::: "memory");
    __syncthreads();
    if (threadIdx.x == 0) {
        unsigned* bar = b.bar;
        __builtin_amdgcn_s_waitcnt(0);
        unsigned nloc = b.st[0], nx = b.st[1];
        if (nloc == 0u) { xcd_barrier_complete(bar, b.x, nloc, nx); b.st[0] = nloc; b.st[1] = nx; }
        const unsigned old = xb_add(&bar[XB_XSUB(b.x)], 1u);
        const unsigned gen = old / nloc;
        if (old + 1u == (gen + 1u) * nloc) {
            __builtin_amdgcn_fence(__ATOMIC_RELEASE, "agent");
            asm volatile("s_waitcnt vmcnt(0)" ::: "memory");
            const unsigned og = xb_add(&bar[XB_TOP], 1u);
            const unsigned tg = og / nx;
            if (og + 1u == (tg + 1u) * nx) xb_add(&bar[XB_TOPGEN], 1u);
            else XB_SPIN(xb_ld(&bar[XB_TOPGEN]) == tg, bar);
            __builtin_amdgcn_fence(__ATOMIC_ACQUIRE, "agent");
            xb_add(&bar[XB_XGEN(b.x)], 1u);
            asm volatile("s_waitcnt vmcnt(0)" ::: "memory");
        } else {
            XB_SPIN(xb_ld(&bar[XB_XGEN(b.x)]) == gen, bar);
            __builtin_amdgcn_fence(__ATOMIC_ACQUIRE, "agent");
            asm volatile("s_waitcnt vmcnt(0)" ::: "memory");
        }
    }
    __syncthreads();
}

namespace pg8 {
constexpr int BM = 256, BK = 64, HALF = 128, HTB = HALF * BK * 2, STAGE_BYTES = 8 * HTB, NXCD = 8, WGM = 8;
__host__ __device__ __forceinline__ int lds_byte(int r, int c) { const int st = (r >> 4) * 2 + (c >> 5), rr = r & 15, cc = c & 31, ob = rr * 64 + cc * 2; return st * 1024 + (ob ^ (((ob >> 9) & 1) << 5)); }
__host__ __device__ __forceinline__ void stage_rc(int b, int& R, int& C) { const int st = b / 1024, sb = b % 1024, swz = sb ^ (((sb >> 9) & 1) << 5); R = (st >> 1) * 16 + swz / 64; C = (st & 1) * 32 + (swz % 64) / 2; }
__host__ __device__ __forceinline__ int perm32(int rho) { const int n = rho >> 4, i = rho & 15; return 8 * (i >> 2) + 4 * n + (i & 3); }

struct Unit { const char* a; const char* b; int pm, pn; };
struct Gemm { int K, lda, ldb, amode; };

struct StaticOrder {
    const bf16_t* A; const bf16_t* Bt; int lda, ldb;
    int nM, nN, nwg, G, c; size_t tstepA;
    __device__ void init(const bf16_t* A_, const bf16_t* Bt_, int lda_, int ldb_, int M, int N, int G_, int c_) { A = A_; Bt = Bt_; lda = lda_; ldb = ldb_; nM = M / BM; nN = N / BM; nwg = nM * nN; G = G_; c = c_; tstepA = (size_t)BM * lda * 2; }
    __device__ bool next(int i, Unit& u) const {
        const long L = (long)i * G + c; if (L >= nwg) return false;
        int wgid = (int)L; { const int q = nwg / NXCD, r = nwg % NXCD, xcd = wgid % NXCD, off = wgid / NXCD; wgid = (xcd < r ? xcd * (q + 1) : r * (q + 1) + (xcd - r) * q) + off; }
        const int nig = WGM * nN, gid = wgid / nig, fm = gid * WGM, gsz = (nM - fm) < WGM ? (nM - fm) : WGM;
        u.pm = fm + ((wgid % nig) % gsz); u.pn = (wgid % nig) / gsz;
        u.a = (const char*)A + (size_t)u.pm * tstepA; u.b = (const char*)Bt + (size_t)u.pn * BM * ldb * 2; return true;
    }
};

template <class Epi, class Sched, bool ALIGN_EPI = false, bool SP2 = true>
__device__ __forceinline__ void gemm_phase(LAS unsigned char* lds, const Gemm g, const Sched& S, const Epi& E, const int tid) {
    const int wid = __builtin_amdgcn_readfirstlane(tid >> 6), lane = tid & 63, wr = wid >> 2, wc = wid & 3, fr = lane & 15, fq = lane >> 4;
    const int K = g.K, nt = K / BK;
    unsigned voffA[2], voffB[2];
#pragma unroll
    for (int i = 0; i < 2; ++i) { int R, C; stage_rc(tid * 16 + i * 8192, R, C); const int Rb = Epi::PERM ? ((R & ~31) + perm32(R & 31)) : R;
        voffA[i] = g.amode ? (unsigned)((((C >> 4) * S5ROWS + (R >> 4)) * 256 + (R & 15) * 16 + (C & 15)) * 2) : (unsigned)(R * g.lda + C) * 2u; voffB[i] = (unsigned)(Rb * g.ldb + C) * 2u; }
    const size_t kstepB = (size_t)(BK * 2), kstepA = g.amode ? (size_t)4 * S5ROWS * 256 * 2 : (size_t)(BK * 2);
    const size_t hstepA = g.amode ? (size_t)8 * 256 * 2 : (size_t)HALF * g.lda * 2, hstepB = (size_t)HALF * g.ldb * 2;
    const unsigned ldsw = (unsigned)wid * 1024u;
    const int aoff = lds_byte(wr * 64 + fr, fq * 8), boff = lds_byte(wc * 32 + fr, fq * 8);
#define PG8_SA(b, h) (((b) * 2 + (h)) * HTB)
#define PG8_SB(b, h) ((4 + (b) * 2 + (h)) * HTB)
#define PG8_STAGE(bufoff, gbase, voff) do { _Pragma("unroll") for (int _i = 0; _i < 2; ++_i) \
        __builtin_amdgcn_global_load_lds((const unsigned*)((const char*)(gbase) + (voff)[_i]), (LAS unsigned*)(lds + (bufoff) + ldsw + _i * 8192), 16, 0, 0); } while (0)
#define PG8_LDA(dst, b, h) do { _Pragma("unroll") for (int m = 0; m < 4; ++m) _Pragma("unroll") for (int k = 0; k < 2; ++k) dst[m][k] = *(const LAS bf16x8*)(lds + PG8_SA(b, h) + aoff + m * 2048 + k * 1024); } while (0)
#define PG8_LDB(dst, b, h) do { _Pragma("unroll") for (int n = 0; n < 2; ++n) _Pragma("unroll") for (int k = 0; k < 2; ++k) dst[n][k] = *(const LAS bf16x8*)(lds + PG8_SB(b, h) + boff + n * 2048 + k * 1024); } while (0)
#define PG8_MMA(ai, bj, At, Bt) do { __builtin_amdgcn_s_setprio(1); _Pragma("unroll") for (int m = 0; m < 4; ++m) _Pragma("unroll") for (int n = 0; n < 2; ++n) _Pragma("unroll") for (int k = 0; k < 2; ++k) \
        acc[ai][bj][m][n] = __builtin_amdgcn_mfma_f32_16x16x32_bf16(Bt[n][k], At[m][k], acc[ai][bj][m][n], 0, 0, 0); __builtin_amdgcn_s_setprio(0); } while (0)
#define PG8_WAIT_V(n) asm volatile("s_waitcnt vmcnt(" #n ")" ::: "memory")
#define PG8_WAIT_L(n) asm volatile("s_waitcnt lgkmcnt(" #n ")" ::: "memory")
#define PG8_BAR __builtin_amdgcn_s_barrier()
#define PG8_SCHED __builtin_amdgcn_sched_barrier(0)
    Unit cur, nxt; int ui = 0;
    if (!S.next(0, cur)) return;
    f32x4 acc[2][2][4][2];
#pragma unroll
    for (int a = 0; a < 2; ++a)
#pragma unroll
        for (int b = 0; b < 2; ++b)
#pragma unroll
            for (int m = 0; m < 4; ++m)
#pragma unroll
                for (int n = 0; n < 2; ++n) acc[a][b][m][n] = (f32x4){0.f, 0.f, 0.f, 0.f};
    bf16x8 At[4][2], B0[2][2], B1[2][2];
    const char* cA = cur.a; const char* cB = cur.b;
    static_assert(SP2, "only the SP2 loop is kept");
    PG8_STAGE(PG8_SB(0, 0), cB, voffB); PG8_STAGE(PG8_SB(0, 1), cB + hstepB, voffB); PG8_STAGE(PG8_SA(0, 0), cA, voffA); PG8_STAGE(PG8_SA(0, 1), cA + hstepA, voffA);
    if (wr == 1) PG8_BAR;
    PG8_WAIT_V(2); PG8_BAR;
    PG8_STAGE(PG8_SB(1, 0), cB + kstepB, voffB); PG8_STAGE(PG8_SA(1, 0), cA + kstepA, voffA); PG8_STAGE(PG8_SB(1, 1), cB + hstepB + kstepB, voffB);
    PG8_WAIT_V(6); PG8_BAR;
    for (;;) {
        const bool has_next = S.next(ui + 1, nxt);
        const char* nA = has_next ? nxt.a : cA; const char* nB = has_next ? nxt.b : cB;
#pragma unroll 1
        for (int t = 0; t < nt; t += 2) {
            if constexpr (Epi::HAS_MID) { if (t == E.mid_t) { E.mid(acc, cur, wr, wc, fr, fq); PG8_SCHED; } }
            const bool last = (t == nt - 2);
            const char* a1 = cA + (size_t)(t + 1) * kstepA;
            const char* a2 = last ? nA : cA + (size_t)(t + 2) * kstepA; const char* b2 = last ? nB : cB + (size_t)(t + 2) * kstepB;
            const char* a3 = a2 + kstepA; const char* b3 = b2 + kstepB;
            PG8_LDB(B0, 0, 0); PG8_LDB(B1, 0, 1); PG8_SCHED; PG8_LDA(At, 0, 0); PG8_STAGE(PG8_SA(1, 1), a1 + hstepA, voffA);
            PG8_WAIT_V(8); PG8_WAIT_L(0); PG8_BAR; PG8_MMA(0, 0, At, B0); PG8_MMA(0, 1, At, B1); PG8_BAR; PG8_SCHED;
            PG8_LDA(At, 0, 1); PG8_STAGE(PG8_SB(0, 0), b2, voffB); PG8_STAGE(PG8_SB(0, 1), b2 + hstepB, voffB); PG8_STAGE(PG8_SA(0, 0), a2, voffA);
            PG8_WAIT_V(8); PG8_WAIT_L(0); PG8_BAR; PG8_MMA(1, 0, At, B0); PG8_MMA(1, 1, At, B1); PG8_BAR; PG8_SCHED;
            PG8_LDB(B0, 1, 0); PG8_LDB(B1, 1, 1); PG8_SCHED; PG8_LDA(At, 1, 0); PG8_STAGE(PG8_SA(0, 1), a2 + hstepA, voffA);
            PG8_WAIT_V(8); PG8_WAIT_L(0); PG8_BAR; PG8_MMA(0, 0, At, B0); PG8_MMA(0, 1, At, B1); PG8_BAR; PG8_SCHED;
            PG8_LDA(At, 1, 1); PG8_STAGE(PG8_SB(1, 0), b3, voffB); PG8_STAGE(PG8_SB(1, 1), b3 + hstepB, voffB); PG8_STAGE(PG8_SA(1, 0), a3, voffA);
            PG8_WAIT_V(8); PG8_WAIT_L(0); PG8_BAR; PG8_MMA(1, 0, At, B0); PG8_MMA(1, 1, At, B1); PG8_BAR; PG8_SCHED;
        }
        if constexpr (ALIGN_EPI) { if (wr == 0) PG8_BAR; }
        E(acc, cur, wr, wc, fr, fq);
        if (!has_next) break;
#pragma unroll
        for (int a = 0; a < 2; ++a)
#pragma unroll
            for (int b = 0; b < 2; ++b)
#pragma unroll
                for (int m = 0; m < 4; ++m)
#pragma unroll
                    for (int n = 0; n < 2; ++n) acc[a][b][m][n] = (f32x4){0.f, 0.f, 0.f, 0.f};
        cur = nxt; cA = nA; cB = nB; ++ui;
        if constexpr (ALIGN_EPI) { if (wr == 1) PG8_BAR; }
    }
    PG8_WAIT_V(0);
    if constexpr (!ALIGN_EPI) { if (wr == 0) PG8_BAR; }
    PG8_BAR;
#undef PG8_SA
#undef PG8_SB
#undef PG8_STAGE
#undef PG8_LDA
#undef PG8_LDB
#undef PG8_MMA
#undef PG8_WAIT_V
#undef PG8_WAIT_L
#undef PG8_BAR
#undef PG8_SCHED
}

template <class F> struct EpiGen8 {
    static constexpr bool PERM = true, HAS_MID = false; F f; int mid_t;
    __device__ __forceinline__ void mid(f32x4 (&)[2][2][4][2], const Unit&, int, int, int, int) const {}
    __device__ __forceinline__ void operator()(const f32x4 (&acc)[2][2][4][2], const Unit& u, int wr, int wc, int fr, int fq) const {
#pragma unroll
        for (int ai = 0; ai < 2; ++ai)
#pragma unroll
            for (int m = 0; m < 4; ++m) { const int r = ai * HALF + wr * 64 + m * 16 + fr;
#pragma unroll
                for (int bj = 0; bj < 2; ++bj) f(u, r, bj * HALF + wc * 32 + 8 * fq, acc[ai][bj][m][0], acc[ai][bj][m][1]);
                if constexpr (F::PIN) __builtin_amdgcn_sched_barrier(0); }
    }
};
}

typedef const float* cfp_t;
typedef __attribute__((address_space(4))) const cfp_t* InTab;
struct Frame {
    LAS unsigned char* lds;
    volatile LAS unsigned* MISC;
    gu32* ctl;
    int tid, lane, wave, vcu, G;
    unsigned char* ws; unsigned char* dout; unsigned char* ws0; unsigned char* dout0;
    InTab in;
};
enum { I_X = 0, I_NMPRE, I_NMPOST, I_NFPRE, I_NFPOST, I_WIN, I_BGATE, I_MU, I_W0, I_W2, I_A0, I_A2, I_G2, I_KK, I_KA, I_RK, I_LNW, I_LNB,
       I_SARE, I_SAIM, I_SBRE, I_SBIM, I_SCRE, I_SCIM, I_SD, I_SLOG, I_WGLU, I_BGLU, I_WBR, I_WBS, I_WOUT, I_WUP, I_CONVW, I_CONVB, I_WDN };

__device__ __forceinline__ void p0_transpose_item(const float* W, int ldw, int k0, int src0, bf16_t* WT, int ldt, int drow0, int koff, const float* kscale, LAS float* scr, int lane) {
    const int q = lane & 7, rb = lane >> 3;
    f32x4 v[8]; float sc[8];
#pragma unroll
    for (int i = 0; i < 8; ++i) { const int kk = 8 * i + rb; v[i] = __builtin_nontemporal_load((const f32x4*)(W + (size_t)(k0 + kk) * ldw + src0 + 4 * q)); sc[i] = kscale ? kscale[k0 + kk] : 1.0f; }
#pragma unroll
    for (int i = 0; i < 8; ++i) { const int kk = 8 * i + rb; LAS float* d = scr + kk * 33 + 4 * q; d[0] = v[i].x * sc[i]; d[1] = v[i].y * sc[i]; d[2] = v[i].z * sc[i]; d[3] = v[i].w * sc[i]; }
    LDS_WAIT(); asm volatile("" ::: "memory");
    const int c = lane & 7;
#pragma unroll
    for (int j = 0; j < 4; ++j) { const int n = (lane >> 3) + 8 * j; const LAS float* s = scr + (8 * c) * 33 + n;
        u32x4 o; o.x = cvt_pk_bf16(s[0 * 33], s[1 * 33]); o.y = cvt_pk_bf16(s[2 * 33], s[3 * 33]); o.z = cvt_pk_bf16(s[4 * 33], s[5 * 33]); o.w = cvt_pk_bf16(s[6 * 33], s[7 * 33]);
        *(GAS u32x4*)(WT + (size_t)(drow0 + n) * ldt + koff + k0 + 8 * c) = o; }
    LDS_WAIT(); asm volatile("" ::: "memory");
}
struct TrMat { int in_idx, K, N, ldt, koff, kind; size_t dst; int scale_idx; };
__device__ __forceinline__ void p0_do_matrix(Frame& F, const TrMat& mtx, int r, LAS float* scr) {
    const int nblk = mtx.N / 32, kb = r / nblk, nb = r % nblk;
    int src0 = 32 * nb;
    if (mtx.kind == 1) {
        const int pn = (32 * nb) >> 8, within = (32 * nb) & 255;
        src0 = (within < 128 ? 0 : FF - 128) + 128 * pn + within;
    }
    p0_transpose_item(F.in[mtx.in_idx], mtx.N, 64 * kb, src0, (bf16_t*)(F.ws + mtx.dst), mtx.ldt, 32 * nb, mtx.koff, mtx.scale_idx >= 0 ? F.in[mtx.scale_idx] : nullptr, scr, F.lane);
}
__device__ __forceinline__ void p0_s5_group(Frame& F, int g) {
    LAS float* pwr = (LAS float*)(F.lds);
    LAS float* pwi = pwr + 17 * 64;
    LAS float* bbr = pwi + 17 * 64;
    LAS float* bbi = bbr + 1024;
    LAS float* cre = bbi + 1024;
    LAS float* cim = cre + 1024;
    LAS float* kk = cim + 1024;
    const float dt = expf(F.in[I_SLOG][g]);
    for (int idx = F.tid; idx < 17 * 64; idx += 512) { const int k = idx >> 6, p = idx & 63;
        const float are = F.in[I_SARE][g * 64 + p], aim = F.in[I_SAIM][g * 64 + p];
        const float mag = expf((float)k * are * dt); float sn, cs; sincosf((float)k * aim * dt, &sn, &cs);
        pwr[idx] = mag * cs; pwi[idx] = mag * sn; }
    for (int idx = F.tid; idx < 1024; idx += 512) { cre[idx] = F.in[I_SCRE][g * 1024 + idx]; cim[idx] = F.in[I_SCIM][g * 1024 + idx]; }
    __syncthreads();
    for (int idx = F.tid; idx < 1024; idx += 512) { const int p = idx >> 4;
        const float are = F.in[I_SARE][g * 64 + p], aim = F.in[I_SAIM][g * 64 + p];
        const float nr = pwr[64 + p] - 1.0f, ni = pwi[64 + p];
        const float den = 1.0f / (are * are + aim * aim);
        const float qr = (nr * are + ni * aim) * den, qi = (ni * are - nr * aim) * den;
        const float br = F.in[I_SBRE][g * 1024 + idx], bi = F.in[I_SBIM][g * 1024 + idx];
        bbr[idx] = qr * br - qi * bi; bbi[idx] = qr * bi + qi * br; }
    __syncthreads();
    {
        const int kc = F.tid & 255, ph = F.tid >> 8, k = kc >> 4, c = kc & 15; float s[16];
#pragma unroll
        for (int e = 0; e < 16; ++e) s[e] = 0.f;
        for (int p = 32 * ph; p < 32 * ph + 32; ++p) { const float cr_ = cre[c * 64 + p], ci_ = cim[c * 64 + p], pr_ = pwr[k * 64 + p], pi_ = pwi[k * 64 + p];
            const float xr = cr_ * pr_ - ci_ * pi_, xi = cr_ * pi_ + ci_ * pr_;
#pragma unroll
            for (int e4 = 0; e4 < 4; ++e4) { const f32x4 br = *(LAS const f32x4*)(bbr + p * 16 + 4 * e4), bi = *(LAS const f32x4*)(bbi + p * 16 + 4 * e4);
#pragma unroll
                for (int e = 0; e < 4; ++e) s[4 * e4 + e] += xr * br[e] - xi * bi[e]; } }
        LAS float* part = kk + 4096;
        if (ph == 1) {
#pragma unroll
            for (int e4 = 0; e4 < 4; ++e4) *(LAS f32x4*)(part + kc * 16 + 4 * e4) = (f32x4){s[4 * e4], s[4 * e4 + 1], s[4 * e4 + 2], s[4 * e4 + 3]}; }
        __syncthreads();
        if (ph == 0) {
#pragma unroll
            for (int e4 = 0; e4 < 4; ++e4) { const f32x4 o = *(LAS const f32x4*)(part + kc * 16 + 4 * e4);
#pragma unroll
                for (int e = 0; e < 4; ++e) { float v = s[4 * e4 + e] + o[e]; if (k == 0 && c == 4 * e4 + e) v += F.in[I_SD][g * 16 + c]; kk[kc * 16 + 4 * e4 + e] = v; } } }
    }
    __syncthreads();
    bf16_t* B1b = (bf16_t*)(F.ws + WS_B1B) + (size_t)g * 256 * 384;
    for (int idx = F.tid; idx < 256 * 48; idx += 512) { const int n = idx / 48, j = idx - n * 48, t = n >> 4, c = n & 15; float v[8];
        if (j < 32) { const int tau = j >> 1, cp0 = (j & 1) * 8; const int ko = (t >= tau ? t - tau : 0) * 256 + c * 16 + cp0; const float m = (t >= tau) ? 1.f : 0.f;
            const f32x4 a0 = *(LAS const f32x4*)(kk + ko), a1 = *(LAS const f32x4*)(kk + ko + 4);
#pragma unroll
            for (int e = 0; e < 4; ++e) { v[e] = a0[e] * m; v[4 + e] = a1[e] * m; } }
        else { const int p0 = (j - 32) * 4; const f32x4 cr4 = *(LAS const f32x4*)(cre + c * 64 + p0), ci4 = *(LAS const f32x4*)(cim + c * 64 + p0), pr4 = *(LAS const f32x4*)(pwr + (t + 1) * 64 + p0), pi4 = *(LAS const f32x4*)(pwi + (t + 1) * 64 + p0);
#pragma unroll
            for (int q = 0; q < 4; ++q) { v[2 * q] = cr4[q] * pr4[q] - ci4[q] * pi4[q]; v[2 * q + 1] = -(cr4[q] * pi4[q] + ci4[q] * pr4[q]); } }
        *(u32x4*)(B1b + (size_t)n * 384 + 8 * j) = pack8(v); }
    bf16_t* B1a = (bf16_t*)(F.ws + WS_B1A) + (size_t)g * 256 * 256;
    for (int idx = F.tid; idx < 256 * 32; idx += 512) { const int n = idx >> 5, j = idx & 31; float v[8];
#pragma unroll
        for (int e = 0; e < 8; ++e) v[e] = 0.f;
        if (n < 128) { const int p = n >> 1, tau = j >> 1, cp0 = (j & 1) * 8; const float pr_ = pwr[(15 - tau) * 64 + p], pi_ = pwi[(15 - tau) * 64 + p];
            const f32x4 r0 = *(LAS const f32x4*)(bbr + p * 16 + cp0), r1 = *(LAS const f32x4*)(bbr + p * 16 + cp0 + 4), i0 = *(LAS const f32x4*)(bbi + p * 16 + cp0), i1 = *(LAS const f32x4*)(bbi + p * 16 + cp0 + 4);
#pragma unroll
            for (int e = 0; e < 8; ++e) { const float br = e < 4 ? r0[e & 3] : r1[e & 3], bi = e < 4 ? i0[e & 3] : i1[e & 3]; v[e] = (n & 1) ? (pr_ * bi + pi_ * br) : (pr_ * br - pi_ * bi); } }
        *(u32x4*)(B1a + (size_t)n * 256 + 8 * j) = pack8(v); }
    float* aL = (float*)(F.ws + WS_AL) + g * 128;
    if (F.tid < 64) { aL[2 * F.tid] = pwr[16 * 64 + F.tid]; aL[2 * F.tid + 1] = pwi[16 * 64 + F.tid]; }
    __syncthreads();
}
#define DO_MAT(in_idx, K_, N_, ldt_, koff_, kind_, dst_, sc_) do { const TrMat mtx{in_idx, K_, N_, ldt_, koff_, kind_, dst_, sc_}; const int items = ((K_) / 64) * ((N_) / 32); \
        for (int it = gw; it < base + items; it += NGW) { if (it >= base) p0_do_matrix(F, mtx, it - base, scr); } base += items; } while (0)
__device__ __forceinline__ void p0_late_mats(Frame& F, int gw, int NGW) {
    LAS float* scr = (LAS float*)(F.lds + F.wave * 16384);
    int base = 0;
    DO_MAT(I_WUP, D, 2 * FF, D, 0, 1, WS_WUP, I_NFPRE); DO_MAT(I_WDN, FF, D, FF, 0, 0, WS_WDN, -1); DO_MAT(I_WOUT, D, D, D, 0, 0, WS_WOUT, -1);
    DO_MAT(I_WBR, RW, D, D, 0, 0, WS_WBRS, -1); DO_MAT(I_WBS, RW, D, D, RW, 0, WS_WBRS, -1); DO_MAT(I_WGLU, RW, RW, RW, 0, 0, WS_WGLU, -1);
}
__device__ __forceinline__ void p0_prologue(Frame& F) {
    const bool s5wg = F.vcu < S5G && F.G > S5G;
    if (F.vcu < S5G) p0_s5_group(F, F.vcu);
    if (!s5wg) {
        LAS float* scr = (LAS float*)(F.lds + F.wave * 16384);
        const int gw = (F.G > S5G ? F.vcu - S5G : F.vcu) * NWAVES + F.wave, NGW = (F.G > S5G ? F.G - S5G : F.G) * NWAVES;
        int base = 0;
        DO_MAT(I_WIN, D, NIN, D, 0, 0, WS_WIN, I_NMPRE);
        DO_MAT(I_W2, 64, RW, 64, 0, 0, WS_W2T, -1); DO_MAT(I_A2, 64, RW, 64, 0, 0, WS_A2T, -1); DO_MAT(I_G2, 128, RW, 128, 0, 0, WS_G2T, -1);
    }
    {
        bf16_t* XN = (bf16_t*)(F.ws + WS_XN);
        const int nch = T / 4, split = (F.G > S5G) ? nch / 2 : 0;
#pragma unroll 1
        for (int pass = 0; pass < 2; ++pass) {
            if (pass == 0 && (s5wg || split == 0)) continue;
            const int lo = pass == 0 ? 0 : split, hi = pass == 0 ? split : nch;
            const int gw = (pass == 0 ? F.vcu - S5G : F.vcu) * NWAVES + F.wave, NGW = (pass == 0 ? F.G - S5G : F.G) * NWAVES;
#pragma unroll 1
            for (int ch = lo + gw; ch < hi; ch += NGW) {
                const int m = 4 * ch;
                f32x4 v[4][4]; float s[4];
#pragma unroll
                for (int q = 0; q < 4; ++q) { const GAS f32x4* xr = (const GAS f32x4*)(F.in[I_X] + (size_t)(m + q) * D) + F.lane;
#pragma unroll
                    for (int j = 0; j < 4; ++j) v[q][j] = __builtin_nontemporal_load((const f32x4*)(xr + 64 * j)); }
#pragma unroll
                for (int q = 0; q < 4; ++q) { s[q] = 0.f;
#pragma unroll
                    for (int j = 0; j < 4; ++j) s[q] += (v[q][j].x * v[q][j].x + v[q][j].y * v[q][j].y) + (v[q][j].z * v[q][j].z + v[q][j].w * v[q][j].w); }
#pragma unroll
                for (int q = 0; q < 4; ++q) { const float r = 1.0f / sqrtf(wave_sum(s[q]) * (1.f / D) + 1e-6f);
                    GAS u32x2* o = (GAS u32x2*)(XN + (size_t)(m + q) * D) + F.lane;
#pragma unroll
                    for (int j = 0; j < 4; ++j) { u32x2 w; w.x = cvt_pk_bf16(v[q][j].x * r, v[q][j].y * r); w.y = cvt_pk_bf16(v[q][j].z * r, v[q][j].w * r); o[64 * j] = w; } }
            }
        }
    }
}

struct EpiInProj {
    static constexpr bool PERM = true, HAS_MID = false;
    bf16_t* PR; bf16_t* UG; bf16_t* GT; const float* bg; int mid_t;
    __device__ __forceinline__ void mid(f32x4 (&)[2][2][4][2], const pg8::Unit&, int, int, int, int) const {}
    __device__ __forceinline__ void operator()(const f32x4 (&acc)[2][2][4][2], const pg8::Unit& u, int wr, int wc, int fr, int fq) const {
        f32x4 b0[2], b1[2];
        if (u.pn >= 9) {
#pragma unroll
            for (int bj = 0; bj < 2; ++bj) { const int gc = (u.pn - 9) * 256 + bj * 128 + wc * 32 + 8 * fq; b0[bj] = *(const f32x4*)(bg + gc); b1[bj] = *(const f32x4*)(bg + gc + 4); } }
#pragma unroll
        for (int ai = 0; ai < 2; ++ai)
#pragma unroll
            for (int m = 0; m < 4; ++m) { const int row = u.pm * 256 + ai * 128 + wr * 64 + m * 16 + fr;
#pragma unroll
                for (int bj = 0; bj < 2; ++bj) { const int cl = bj * 128 + wc * 32 + 8 * fq; const f32x4 v0 = acc[ai][bj][m][0], v1 = acc[ai][bj][m][1]; u32x4 w;
                    if (u.pn < 7) { w.x = cvt_pk_bf16(v0[0], v0[1]); w.y = cvt_pk_bf16(v0[2], v0[3]); w.z = cvt_pk_bf16(v1[0], v1[1]); w.w = cvt_pk_bf16(v1[2], v1[3]);
                        *(u32x4*)(PR + (size_t)row * NRW + u.pn * 256 + cl) = w; }
                    else if (u.pn < 9) { const int cr = (u.pn - 7) * 256 + cl, g = cr >> 4, c0 = cr & 15;
                        w.x = cvt_pk_bf16(v0[0], v0[1]); w.y = cvt_pk_bf16(v0[2], v0[3]); w.z = cvt_pk_bf16(v1[0], v1[1]); w.w = cvt_pk_bf16(v1[2], v1[3]);
                        *(u32x4*)(UG + ((size_t)g * S5ROWS + (row >> 4)) * UGLD + (row & 15) * 16 + c0) = w; }
                    else { const int gc = (u.pn - 9) * 256 + cl;
                        w.x = cvt_pk_bf16(fsigmoid(v0[0] + b0[bj][0]), fsigmoid(v0[1] + b0[bj][1])); w.y = cvt_pk_bf16(fsigmoid(v0[2] + b0[bj][2]), fsigmoid(v0[3] + b0[bj][3]));
                        w.z = cvt_pk_bf16(fsigmoid(v1[0] + b1[bj][0]), fsigmoid(v1[1] + b1[bj][1])); w.w = cvt_pk_bf16(fsigmoid(v1[2] + b1[bj][2]), fsigmoid(v1[3] + b1[bj][3]));
                        __builtin_nontemporal_store(w, (u32x4*)(GT + ((size_t)(u.pm * 8 + (u.pn - 9)) << 16) + (((wr * 4 + wc) * 16 + (ai * 4 + m) * 2 + bj) << 9) + (fq * 16 + fr) * 8)); } }
                __builtin_amdgcn_sched_barrier(0); }
    }
};
struct FS5Out {
    static constexpr bool PIN = true;
    bf16_t* YSP;
    __device__ __forceinline__ void operator()(const pg8::Unit& u, int r, int cl, f32x4 v0, f32x4 v1) const {
        const int crow = u.pm * 256 + r; u32x4 w;
        w.x = cvt_pk_bf16(fgelu(v0[0]), fgelu(v0[1])); w.y = cvt_pk_bf16(fgelu(v0[2]), fgelu(v0[3])); w.z = cvt_pk_bf16(fgelu(v1[0]), fgelu(v1[1])); w.w = cvt_pk_bf16(fgelu(v1[2]), fgelu(v1[3]));
        *(u32x4*)(YSP + ((size_t)u.pn * S5ROWS + crow) * 256 + cl) = w;
    }
};
struct EpiGlu {
    static constexpr bool PERM = true, HAS_MID = false;
    const bf16_t* YSP; bf16_t* YS; const float* bglu; int mid_t;
    __device__ __forceinline__ void mid(f32x4 (&)[2][2][4][2], const pg8::Unit&, int, int, int, int) const {}
    __device__ __forceinline__ void operator()(const f32x4 (&acc)[2][2][4][2], const pg8::Unit& u, int wr, int wc, int fr, int fq) const {
        u32x4 yv[2][4][2]; f32x4 b0[2], b1[2];
#pragma unroll
        for (int bj = 0; bj < 2; ++bj) { const int col = u.pn * 256 + bj * 128 + wc * 32 + 8 * fq; b0[bj] = *(const f32x4*)(bglu + col); b1[bj] = *(const f32x4*)(bglu + col + 4); }
#pragma unroll
        for (int ai = 0; ai < 2; ++ai)
#pragma unroll
            for (int m = 0; m < 4; ++m)
#pragma unroll
                for (int bj = 0; bj < 2; ++bj) { const int row = u.pm * 256 + ai * 128 + wr * 64 + m * 16 + fr, col = u.pn * 256 + bj * 128 + wc * 32 + 8 * fq;
                    yv[ai][m][bj] = __builtin_nontemporal_load((const u32x4*)(YSP + ((size_t)(col >> 4) * S5ROWS + (row >> 4)) * 256 + (row & 15) * 16 + (col & 15))); }
#pragma unroll
        for (int ai = 0; ai < 2; ++ai)
#pragma unroll
            for (int m = 0; m < 4; ++m) {
#pragma unroll
                for (int bj = 0; bj < 2; ++bj) { const int row = u.pm * 256 + ai * 128 + wr * 64 + m * 16 + fr, col = u.pn * 256 + bj * 128 + wc * 32 + 8 * fq; float y[8]; unpack8(yv[ai][m][bj], y);
                    const f32x4 v0 = acc[ai][bj][m][0], v1 = acc[ai][bj][m][1]; u32x4 w;
                    w.x = cvt_pk_bf16(y[0] * fsigmoid(v0[0] + b0[bj][0]), y[1] * fsigmoid(v0[1] + b0[bj][1])); w.y = cvt_pk_bf16(y[2] * fsigmoid(v0[2] + b0[bj][2]), y[3] * fsigmoid(v0[3] + b0[bj][3]));
                    w.z = cvt_pk_bf16(y[4] * fsigmoid(v1[0] + b1[bj][0]), y[5] * fsigmoid(v1[1] + b1[bj][1])); w.w = cvt_pk_bf16(y[6] * fsigmoid(v1[2] + b1[bj][2]), y[7] * fsigmoid(v1[3] + b1[bj][3]));
                    *(u32x4*)(YS + (size_t)row * D + RW + col) = w; }
                __builtin_amdgcn_sched_barrier(0); }
    }
};
struct FStore {
    static constexpr bool PIN = false;
    bf16_t* O; int ldc;
    __device__ __forceinline__ void operator()(const pg8::Unit& u, int r, int cl, f32x4 v0, f32x4 v1) const {
        u32x4 w; w.x = cvt_pk_bf16(v0[0], v0[1]); w.y = cvt_pk_bf16(v0[2], v0[3]); w.z = cvt_pk_bf16(v1[0], v1[1]); w.w = cvt_pk_bf16(v1[2], v1[3]);
        *(u32x4*)(O + (size_t)(u.pm * 256 + r) * ldc + u.pn * 256 + cl) = w;
    }
};
struct EpiMerge {
    static constexpr bool PERM = true, HAS_MID = true;
    const bf16_t* GT; bf16_t* O; int mid_t;
    __device__ __forceinline__ void mid(f32x4 (&acc)[2][2][4][2], const pg8::Unit& u, int wr, int wc, int fr, int fq) const {
        unsigned vo = (unsigned)((((wr * 4 + wc) * 16) << 9) + (fq * 16 + fr) * 8) * 2u; asm volatile("" : "+v"(vo));
        const char* gr = (const char*)(GT + ((size_t)(u.pm * 8 + u.pn) << 16)); const char* gs = (const char*)(GT + ((size_t)(u.pm * 8 + 4 + u.pn) << 16));
#pragma unroll
        for (int ai = 0; ai < 2; ++ai)
#pragma unroll
            for (int m = 0; m < 4; ++m) {
                u32x4 a[2], b[2];
#pragma unroll
                for (int bj = 0; bj < 2; ++bj) { const unsigned go = vo + (unsigned)((((ai * 4 + m) * 2 + bj) << 9) * 2); a[bj] = __builtin_nontemporal_load((const u32x4*)(gr + go)); b[bj] = __builtin_nontemporal_load((const u32x4*)(gs + go)); }
                __builtin_amdgcn_sched_barrier(0);
#pragma unroll
                for (int bj = 0; bj < 2; ++bj) {
                    const unsigned aw[4] = {a[bj].x, a[bj].y, a[bj].z, a[bj].w}, bw[4] = {b[bj].x, b[bj].y, b[bj].z, b[bj].w};
#pragma unroll
                    for (int h = 0; h < 4; ++h) {
                        acc[ai][bj][m][h >> 1][2 * (h & 1)] *= bf_lo(aw[h]) * __builtin_amdgcn_rcpf(bf_lo(bw[h]));
                        acc[ai][bj][m][h >> 1][2 * (h & 1) + 1] *= bf_hi(aw[h]) * __builtin_amdgcn_rcpf(bf_hi(bw[h])); } }
                __builtin_amdgcn_sched_barrier(0);
            }
    }
    __device__ __forceinline__ void operator()(const f32x4 (&acc)[2][2][4][2], const pg8::Unit& u, int wr, int wc, int fr, int fq) const {
        const size_t lo = ((size_t)((wr * 4 + wc) * 16) << 9) + (fq * 16 + fr) * 8;
        const bf16_t* gs = GT + ((size_t)(u.pm * 8 + 4 + u.pn) << 16) + lo;
        u32x4 gv[2][4][2];
#pragma unroll
        for (int ai = 0; ai < 2; ++ai)
#pragma unroll
            for (int m = 0; m < 4; ++m)
#pragma unroll
                for (int bj = 0; bj < 2; ++bj) gv[ai][m][bj] = __builtin_nontemporal_load((const u32x4*)(gs + (((ai * 4 + m) * 2 + bj) << 9)));
#pragma unroll
        for (int ai = 0; ai < 2; ++ai)
#pragma unroll
            for (int m = 0; m < 4; ++m) {
#pragma unroll
                for (int bj = 0; bj < 2; ++bj) { const int row = u.pm * 256 + ai * 128 + wr * 64 + m * 16 + fr, col = u.pn * 256 + bj * 128 + wc * 32 + 8 * fq; float g[8]; unpack8(gv[ai][m][bj], g);
                    const f32x4 v0 = acc[ai][bj][m][0], v1 = acc[ai][bj][m][1]; u32x4 w;
                    w.x = cvt_pk_bf16(v0[0] * g[0], v0[1] * g[1]); w.y = cvt_pk_bf16(v0[2] * g[2], v0[3] * g[3]); w.z = cvt_pk_bf16(v1[0] * g[4], v1[1] * g[5]); w.w = cvt_pk_bf16(v1[2] * g[6], v1[3] * g[7]);
                    *(u32x4*)(O + (size_t)row * D + col) = w; }
                __builtin_amdgcn_sched_barrier(0); }
    }
};
struct UpOrder {
    const bf16_t* H2; const bf16_t* Wt; int G, c;
    __device__ bool next(int i, pg8::Unit& u) const {
        constexpr int nM = NB * 16, nN = 22, nwg = nM * nN;
        const long L = (long)i * G + c; if (L >= nwg) return false;
        int wgid = (int)L; { const int q = nwg / 8, r = nwg % 8, xcd = wgid % 8, off = wgid / 8; wgid = (xcd < r ? xcd * (q + 1) : r * (q + 1) + (xcd - r) * q) + off; }
        const int nig = 8 * nN, gid = wgid / nig, fm = gid * 8, gsz = (nM - fm) < 8 ? (nM - fm) : 8;
        u.pm = fm + ((wgid % nig) % gsz); u.pn = (wgid % nig) / gsz;
        u.a = (const char*)H2 + ((size_t)u.pm * 256 * D) * 2; u.b = (const char*)(Wt + (size_t)u.pn * 256 * D); return true;
    }
};
template <int CTRL> __device__ __forceinline__ unsigned dppu(unsigned v) { return (unsigned)__builtin_amdgcn_update_dpp(0, (int)v, CTRL, 0xf, 0xf, true); }
struct EpiConvAct {
    static constexpr bool PERM = true, HAS_MID = false;
    bf16_t* ACT; const float* cw; const float* cb; LAS unsigned* EX; unsigned long long* HZ; unsigned* tmo; int mid_t;
    __device__ __forceinline__ void mid(f32x4 (&)[2][2][4][2], const pg8::Unit&, int, int, int, int) const {}
    __device__ __forceinline__ void operator()(f32x4 (&acc)[2][2][4][2], const pg8::Unit& u, int wr, int wc, int fr, int fq) const {
        const int b = u.pm >> 4, k = u.pm & 15, t0 = 256 * k;
        u32x2 zp[2][2][4][2];
#pragma unroll
        for (int ai = 0; ai < 2; ++ai)
#pragma unroll
            for (int bj = 0; bj < 2; ++bj)
#pragma unroll
                for (int m = 0; m < 4; ++m)
#pragma unroll
                    for (int n = 0; n < 2; ++n) { const f32x4 v = acc[ai][bj][m][n]; u32x2 w; w.x = cvt_pk_bf16(v[0], v[1]); w.y = cvt_pk_bf16(v[2], v[3]); zp[ai][bj][m][n] = w; }
        if (fr >= 14) {
#pragma unroll
            for (int ai = 0; ai < 2; ++ai)
#pragma unroll
                for (int bj = 0; bj < 2; ++bj)
#pragma unroll
                    for (int n = 0; n < 2; ++n) *(LAS u32x2*)(EX + (((wc * 4 + 2 * ai + wr) * 2 + (fr - 14)) * 32 + bj * 16 + fq * 4 + n * 2)) = zp[ai][bj][3][n]; }
        if (wr == 1 && k < 15 && fr >= 14) {
            unsigned long long* hz = HZ + ((size_t)(u.pm * 22 + u.pn) * 8 + wc * 2 + (fr - 14)) * 32;
#pragma unroll
            for (int bj = 0; bj < 2; ++bj)
#pragma unroll
                for (int n = 0; n < 2; ++n) { __hip_atomic_store(hz + bj * 16 + fq * 4 + n * 2, (1ull << 32) | zp[1][bj][3][n].x, RLX_AGENT); __hip_atomic_store(hz + bj * 16 + fq * 4 + n * 2 + 1, (1ull << 32) | zp[1][bj][3][n].y, RLX_AGENT); }
        }
        asm volatile("s_waitcnt lgkmcnt(0)" ::: "memory"); __builtin_amdgcn_s_barrier(); asm volatile("" ::: "memory");
        const int ch0 = u.pn * 128 + wc * 32 + 8 * fq;
        f32x4 wg[2][3], wv[2][3], bg[2], bv[2];
#pragma unroll
        for (int n = 0; n < 2; ++n) {
#pragma unroll
            for (int j = 0; j < 3; ++j) { wg[n][j] = *(const f32x4*)(cw + (size_t)j * 2 * FF + ch0 + 4 * n); wv[n][j] = *(const f32x4*)(cw + (size_t)j * 2 * FF + FF + ch0 + 4 * n); }
            bg[n] = *(const f32x4*)(cb + ch0 + 4 * n); bv[n] = *(const f32x4*)(cb + FF + ch0 + 4 * n); }
#pragma unroll
        for (int gi = 1; gi <= 8; ++gi) {
            const int ai = (gi & 7) >> 2, m = gi & 3, blk = 2 * ai + wr;
            u32x2 pp[2][2];
#pragma unroll
            for (int bj = 0; bj < 2; ++bj)
#pragma unroll
                for (int n = 0; n < 2; ++n) { pp[bj][n].x = 0u; pp[bj][n].y = 0u; }
            if (m > 0) {
#pragma unroll
                for (int bj = 0; bj < 2; ++bj)
#pragma unroll
                    for (int n = 0; n < 2; ++n) pp[bj][n] = zp[ai][bj][m - 1][n];
            } else if (blk > 0) {
                if (fr >= 14) {
#pragma unroll
                    for (int bj = 0; bj < 2; ++bj)
#pragma unroll
                        for (int n = 0; n < 2; ++n) pp[bj][n] = *(LAS const u32x2*)(EX + (((wc * 4 + blk - 1) * 2 + (fr - 14)) * 32 + bj * 16 + fq * 4 + n * 2)); }
            } else if (k > 0) {
                if (fr >= 14) {
                    const unsigned long long* hz = HZ + ((size_t)((u.pm - 1) * 22 + u.pn) * 8 + wc * 2 + (fr - 14)) * 32;
#pragma unroll
                    for (int bj = 0; bj < 2; ++bj)
#pragma unroll
                        for (int n = 0; n < 2; ++n) { unsigned long long x0, x1; unsigned sp_ = 0;
                            for (;;) { x0 = __hip_atomic_load(hz + bj * 16 + fq * 4 + n * 2, RLX_AGENT); x1 = __hip_atomic_load(hz + bj * 16 + fq * 4 + n * 2 + 1, RLX_AGENT);
                                if ((x0 >> 32) == 1ull && (x1 >> 32) == 1ull) break; __builtin_amdgcn_s_sleep(2); if (++sp_ > (1u << 20)) { __hip_atomic_store(tmo, 1u, RLX_AGENT); break; } }
                            pp[bj][n].x = (unsigned)x0; pp[bj][n].y = (unsigned)x1; } }
            }
            u32x2 outp[2];
#pragma unroll
            for (int n = 0; n < 2; ++n) {
                const u32x2 zg = zp[ai][0][m][n], zv = zp[ai][1][m][n], pg = pp[0][n], pv = pp[1][n];
                u32x2 g1, g2, v1, v2;
                g1.x = dppu<0x111>(zg.x) | dppu<0x10F>(pg.x); g1.y = dppu<0x111>(zg.y) | dppu<0x10F>(pg.y); g2.x = dppu<0x112>(zg.x) | dppu<0x10E>(pg.x); g2.y = dppu<0x112>(zg.y) | dppu<0x10E>(pg.y);
                v1.x = dppu<0x111>(zv.x) | dppu<0x10F>(pv.x); v1.y = dppu<0x111>(zv.y) | dppu<0x10F>(pv.y); v2.x = dppu<0x112>(zv.x) | dppu<0x10E>(pv.x); v2.y = dppu<0x112>(zv.y) | dppu<0x10E>(pv.y);
                const float z0g[4] = {bf_lo(zg.x), bf_hi(zg.x), bf_lo(zg.y), bf_hi(zg.y)}, z1g[4] = {bf_lo(g1.x), bf_hi(g1.x), bf_lo(g1.y), bf_hi(g1.y)}, z2g[4] = {bf_lo(g2.x), bf_hi(g2.x), bf_lo(g2.y), bf_hi(g2.y)};
                const float z0v[4] = {bf_lo(zv.x), bf_hi(zv.x), bf_lo(zv.y), bf_hi(zv.y)}, z1v[4] = {bf_lo(v1.x), bf_hi(v1.x), bf_lo(v1.y), bf_hi(v1.y)}, z2v[4] = {bf_lo(v2.x), bf_hi(v2.x), bf_lo(v2.y), bf_hi(v2.y)};
                float o[4];
#pragma unroll
                for (int e = 0; e < 4; ++e) { const float cg = bg[n][e] + wg[n][0][e] * z2g[e] + wg[n][1][e] * z1g[e] + wg[n][2][e] * z0g[e], cv = bv[n][e] + wv[n][0][e] * z2v[e] + wv[n][1][e] * z1v[e] + wv[n][2][e] * z0v[e];
                    o[e] = fgelu(cg) * cv; }
                outp[n].x = cvt_pk_bf16(o[0], o[1]); outp[n].y = cvt_pk_bf16(o[2], o[3]);
            }
            const int r = 128 * ai + 64 * wr + 16 * m + fr;
            { u32x4 w4; w4.x = outp[0].x; w4.y = outp[0].y; w4.z = outp[1].x; w4.w = outp[1].y; *(u32x4*)(ACT + ((size_t)(b * SEQ + t0 + r)) * FF + ch0) = w4; }
            __builtin_amdgcn_sched_barrier(0);
        }
    }
};
struct EpiRowStat {
    static constexpr bool PERM = true, HAS_MID = false; bf16_t* O; float* STAT; int mid_t;
    __device__ __forceinline__ void mid(f32x4 (&)[2][2][4][2], const pg8::Unit&, int, int, int, int) const {}
    __device__ __forceinline__ void operator()(const f32x4 (&acc)[2][2][4][2], const pg8::Unit& u, int wr, int wc, int fr, int fq) const {
#pragma unroll
        for (int ai = 0; ai < 2; ++ai)
#pragma unroll
            for (int m = 0; m < 4; ++m) { const int row = u.pm * 256 + ai * 128 + wr * 64 + m * 16 + fr; float s = 0.f;
#pragma unroll
                for (int bj = 0; bj < 2; ++bj) { const int col = u.pn * 256 + bj * 128 + wc * 32 + 8 * fq; const f32x4 v0 = acc[ai][bj][m][0], v1 = acc[ai][bj][m][1]; u32x4 w;
                    s += (v0[0] * v0[0] + v0[1] * v0[1]) + (v0[2] * v0[2] + v0[3] * v0[3]) + (v1[0] * v1[0] + v1[1] * v1[1]) + (v1[2] * v1[2] + v1[3] * v1[3]);
                    w.x = cvt_pk_bf16(v0[0], v0[1]); w.y = cvt_pk_bf16(v0[2], v0[3]); w.z = cvt_pk_bf16(v1[0], v1[1]); w.w = cvt_pk_bf16(v1[2], v1[3]);
                    __builtin_nontemporal_store(w, (u32x4*)(O + (size_t)row * D + col)); }
                s += __shfl_xor(s, 16); s += __shfl_xor(s, 32);
                if (fq == 0) STAT[(size_t)row * 16 + u.pn * 4 + wc] = s; }
    }
};
struct EpiSloc {
    static constexpr bool PERM = false, HAS_MID = false; float* SL; int mid_t;
    __device__ __forceinline__ void mid(f32x4 (&)[2][2][4][2], const pg8::Unit&, int, int, int, int) const {}
    __device__ __forceinline__ void operator()(const f32x4 (&acc)[2][2][4][2], const pg8::Unit& u, int wr, int wc, int fr, int fq) const {
#pragma unroll
        for (int ai = 0; ai < 2; ++ai)
#pragma unroll
            for (int m = 0; m < 4; ++m) { const int row = u.pm * 256 + ai * 128 + wr * 64 + m * 16 + fr; float* p = SL + ((size_t)u.pn * S5ROWS + row) * 128 + wc * 32 + 4 * fq;
                *(f32x4*)(p) = acc[ai][0][m][0]; *(f32x4*)(p + 16) = acc[ai][0][m][1]; }
    }
};
struct S5Order {
    const bf16_t* UG; const bf16_t* Bt; int ldb, G, c;
    __device__ bool next(int i, pg8::Unit& u) const { const int L = i * G + c; if (L >= S5G * 8) return false; const int g = L >> 3; u.pm = L & 7; u.pn = g;
        u.a = (const char*)(UG + ((size_t)g * S5ROWS + u.pm * 256) * UGLD); u.b = (const char*)(Bt + (size_t)g * 256 * ldb); return true; }
};

constexpr int LW = 72;
constexpr int SLOT = 64 * LW * 2;
#define SL(i) ((i) * SLOT)
#define BAR_LDS() do { asm volatile("s_waitcnt lgkmcnt(0)" ::: "memory"); __builtin_amdgcn_s_barrier(); asm volatile("" ::: "memory"); } while (0)
struct LdsMat { LAS const unsigned char* p; int ld; __device__ __forceinline__ bf16x8 frag(int row, int k) const { return *(LAS const bf16x8*)(p + ((size_t)row * ld + k) * 2); } };
struct GlbMat { const bf16_t* p; int ld; __device__ __forceinline__ bf16x8 frag(int row, int k) const { return *(const bf16x8*)(p + (size_t)row * ld + k); } };
template <int KD, class YM, class XM, class EPI>
__device__ __forceinline__ void mm64(const YM& Y, const XM& X, int wid, int lane, const EPI& epi) {
    asm volatile("" : "+v"(lane), "+s"(wid));
    const int at = wid >> 1, bt0 = (wid & 1) * 2, fr = lane & 15, fq = lane >> 4;
    f32x4 acc[2] = {(f32x4){0.f, 0.f, 0.f, 0.f}, (f32x4){0.f, 0.f, 0.f, 0.f}};
#pragma unroll
    for (int s = 0; s < KD / 32; ++s) {
        const bf16x8 yf = Y.frag(16 * at + fr, 32 * s + 8 * fq);
#pragma unroll
        for (int bi = 0; bi < 2; ++bi) { const bf16x8 xf = X.frag(16 * (bt0 + bi) + fr, 32 * s + 8 * fq);
            acc[bi] = __builtin_amdgcn_mfma_f32_16x16x32_bf16(xf, yf, acc[bi], 0, 0, 0); }
    }
#pragma unroll
    for (int bi = 0; bi < 2; ++bi) epi(16 * at + fr, 16 * (bt0 + bi) + 4 * fq, acc[bi]);
}
__device__ __forceinline__ void ld_yf(const LdsMat& Y, int at, int fr, int fq, bf16x8 (&y)[2]) {
#pragma unroll
    for (int s = 0; s < 2; ++s) y[s] = Y.frag(16 * at + fr, 32 * s + 8 * fq);
}
__device__ __forceinline__ void ld_xf(const LdsMat& X, int bt0, int fr, int fq, bf16x8 (&x)[2][2]) {
#pragma unroll
    for (int s = 0; s < 2; ++s)
#pragma unroll
        for (int bi = 0; bi < 2; ++bi) x[s][bi] = X.frag(16 * (bt0 + bi) + fr, 32 * s + 8 * fq);
}
__device__ __forceinline__ void mm_f(const bf16x8 (&y)[2], const bf16x8 (&x)[2][2], f32x4 (&acc)[2]) {
#pragma unroll
    for (int bi = 0; bi < 2; ++bi) acc[bi] = (f32x4){0.f, 0.f, 0.f, 0.f};
#pragma unroll
    for (int s = 0; s < 2; ++s)
#pragma unroll
        for (int bi = 0; bi < 2; ++bi) acc[bi] = __builtin_amdgcn_mfma_f32_16x16x32_bf16(x[s][bi], y[s], acc[bi], 0, 0, 0);
}
template <int KD>
__device__ __forceinline__ void preload_x(const GlbMat& X, int wid, int lane, bf16x8 (&xf)[KD / 32][2]) {
    const int bt0 = (wid & 1) * 2, fr = lane & 15, fq = lane >> 4;
#pragma unroll
    for (int s = 0; s < KD / 32; ++s)
#pragma unroll
        for (int bi = 0; bi < 2; ++bi) xf[s][bi] = X.frag(16 * (bt0 + bi) + fr, 32 * s + 8 * fq);
}
template <int KD, class YM, class EPI>
__device__ __forceinline__ void mm64_pre(const YM& Y, const bf16x8 (&xf)[KD / 32][2], int wid, int lane, const EPI& epi) {
    const int at = wid >> 1, bt0 = (wid & 1) * 2, fr = lane & 15, fq = lane >> 4;
    f32x4 acc[2] = {(f32x4){0.f, 0.f, 0.f, 0.f}, (f32x4){0.f, 0.f, 0.f, 0.f}};
#pragma unroll
    for (int s = 0; s < KD / 32; ++s) {
        const bf16x8 yf = Y.frag(16 * at + fr, 32 * s + 8 * fq);
#pragma unroll
        for (int bi = 0; bi < 2; ++bi) acc[bi] = __builtin_amdgcn_mfma_f32_16x16x32_bf16(xf[s][bi], yf, acc[bi], 0, 0, 0);
    }
#pragma unroll
    for (int bi = 0; bi < 2; ++bi) epi(16 * at + fr, 16 * (bt0 + bi) + 4 * fq, acc[bi]);
}
__device__ __forceinline__ void st_lds4(LAS unsigned char* base, int a, int b0, f32x4 v) { u32x2 w; w.x = cvt_pk_bf16(v[0], v[1]); w.y = cvt_pk_bf16(v[2], v[3]); *(LAS u32x2*)(base + ((size_t)a * LW + b0) * 2) = w; }
__device__ __forceinline__ f32x4 ld_lds4(LAS const unsigned char* base, int a, int b0) { const u32x2 w = *(LAS const u32x2*)(base + ((size_t)a * LW + b0) * 2); return (f32x4){bf_lo(w.x), bf_hi(w.x), bf_lo(w.y), bf_hi(w.y)}; }
__device__ __forceinline__ void st_glb4p(bf16_t* base, int a, int b0, f32x4 v) { u32x2 w; w.x = cvt_pk_bf16(v[0], v[1]); w.y = cvt_pk_bf16(v[2], v[3]); __builtin_nontemporal_store(w, (u32x2*)(base + (size_t)a * GLD + b0)); }
__device__ __forceinline__ void st_glb4(bf16_t* base, int a, int b0, f32x4 v) { u32x2 w; w.x = cvt_pk_bf16(v[0], v[1]); w.y = cvt_pk_bf16(v[2], v[3]); __builtin_nontemporal_store(w, (u32x2*)(base + (size_t)a * 64 + b0)); }

struct PrePf { u32x4 qa[3], qp[3], ra[4], rp[4], wt[4]; };
__device__ __forceinline__ void rwkv_pre_fetch(Frame& F, int unit, bool lr_first, PrePf& P, int tid) {
    const int bh = unit >> 6, c = unit & 63, b = bh >> 3, h = bh & 7;
    const int t = tid >> 3, jb = tid & 7, j0 = jb * 8;
    const int tg = b * SEQ + c * 64 + t;
    const bool hasprev = (c * 64 + t) > 0;
    const bf16_t* prow = (const bf16_t*)(F.ws + WS_PR) + (size_t)tg * NRW; const bf16_t* pprv = hasprev ? prow - NRW : prow;
#pragma unroll
    for (int seg = 0; seg < 3; ++seg) { const int col = seg * 512 + h * 64 + j0; P.qa[seg] = *(const u32x4*)(prow + col); P.qp[seg] = *(const u32x4*)(pprv + col); }
    const u32x4* scr = (const u32x4*)(F.ws + WS_LRSCR) + ((size_t)F.vcu * 512 + tid) * 4;
    const u32x4* pa = lr_first ? (const u32x4*)(prow + 1536 + jb * 32) : scr; const u32x4* pp = lr_first ? (const u32x4*)(pprv + 1536 + jb * 32) : scr;
#pragma unroll
    for (int q4 = 0; q4 < 4; ++q4) { P.ra[q4] = pa[q4]; P.rp[q4] = pp[q4]; }
    P.wt[0] = ((const u32x4*)(F.ws + WS_W2T) + (size_t)h * 512)[tid]; P.wt[1] = ((const u32x4*)(F.ws + WS_A2T) + (size_t)h * 512)[tid];
    P.wt[2] = ((const u32x4*)(F.ws + WS_G2T) + (size_t)h * 1024)[tid]; P.wt[3] = ((const u32x4*)(F.ws + WS_G2T) + (size_t)h * 1024)[512 + tid];
}
__device__ __forceinline__ void rwkv_pre_put_w(LAS unsigned char* L, const PrePf& P, int tid) {
    const int r8 = tid >> 3, c8 = tid & 7, r16 = tid >> 4, c16 = tid & 15;
    *(LAS u32x4*)(L + SL(10) + ((size_t)r8 * LW + c8 * 8) * 2) = P.wt[0]; *(LAS u32x4*)(L + SL(11) + ((size_t)r8 * LW + c8 * 8) * 2) = P.wt[1];
    *(LAS u32x4*)(L + SL(12) + ((size_t)r16 * 136 + c16 * 8) * 2) = P.wt[2]; *(LAS u32x4*)(L + SL(12) + ((size_t)(32 + r16) * 136 + c16 * 8) * 2) = P.wt[3];
}
__device__ __forceinline__ void rwkv_pre_unit(Frame& F, int unit, int next_unit, bool lr_first, bool next_first, PrePf& P) {
    LAS unsigned char* L = F.lds;
    LAS float* XT = (LAS float*)(F.lds + XTRA_OFF);
    int tid = F.tid; asm volatile("" : "+v"(tid));
    int wid = F.wave; asm volatile("" : "+s"(wid));
    const int lane = tid & 63;
    const int bh = unit >> 6, c = unit & 63, b = bh >> 3, h = bh & 7;
    const int t = tid >> 3, jb = tid & 7, j0 = jb * 8;
    const int tg = b * SEQ + c * 64 + t;
    const bool hasprev = (c * 64 + t) > 0;
    const bf16_t* PR = (const bf16_t*)(F.ws + WS_PR);
    const bf16_t* prow = PR + (size_t)tg * NRW; const bf16_t* pprev = prow - NRW;
    LAS const float* mu = (LAS const float*)(F.lds + XTRA_OFF + 4096);
    LAS const float* par = mu + NRW;
    float rs[8], ks[8], vs[8];
    {
        const int c0 = 1536 + jb * 32;
        const float pmask = hasprev ? 1.f : 0.f;
        f32x4 mq[3][2];
#pragma unroll
        for (int seg = 0; seg < 3; ++seg) { const int col = seg * 512 + h * 64 + j0; mq[seg][0] = *(LAS const f32x4*)(mu + col); mq[seg][1] = *(LAS const f32x4*)(mu + col + 4); }
        LAS unsigned char* dst = (jb < 2) ? (L + SL(0) + ((size_t)t * LW + jb * 32) * 2) : (jb < 4) ? (L + SL(1) + ((size_t)t * LW + (jb - 2) * 32) * 2) : (L + SL(2) + ((size_t)t * 136 + (jb - 4) * 32) * 2);
        u32x4* scr = (u32x4*)(F.ws + WS_LRSCR) + ((size_t)F.vcu * 512 + tid) * 4;
        if (lr_first) {
            f32x4 ma[4][2];
#pragma unroll
            for (int q4 = 0; q4 < 4; ++q4) { ma[q4][0] = *(LAS const f32x4*)(mu + c0 + q4 * 8); ma[q4][1] = *(LAS const f32x4*)(mu + c0 + q4 * 8 + 4); }
#pragma unroll
            for (int q4 = 0; q4 < 4; ++q4) { float x[8], xp[8], o[8]; unpack8(P.ra[q4], x); unpack8(P.rp[q4], xp);
#pragma unroll
                for (int e = 0; e < 8; ++e) { const float mm = e < 4 ? ma[q4][0][e] : ma[q4][1][e - 4]; const float s = x[e] + (xp[e] * pmask - x[e]) * mm;
                    const float ex = __builtin_amdgcn_exp2f((jb < 2 ? 2.88539008178f : -1.44269504089f) * s), rc = __builtin_amdgcn_rcpf(1.0f + ex);
                    o[e] = jb < 2 ? 1.0f - 2.0f * rc : (jb < 4 ? s : rc); }
                const u32x4 w = pack8(o); *(LAS u32x4*)(dst + q4 * 16) = w; scr[q4] = w; }
        } else {
#pragma unroll
            for (int q4 = 0; q4 < 4; ++q4) *(LAS u32x4*)(dst + q4 * 16) = P.ra[q4];
        }
#pragma unroll
        for (int seg = 0; seg < 3; ++seg) { float x[8], xp[8]; unpack8(P.qa[seg], x); unpack8(P.qp[seg], xp);
#pragma unroll
            for (int e = 0; e < 8; ++e) { const float mm = e < 4 ? mq[seg][0][e] : mq[seg][1][e - 4]; const float s = x[e] + (xp[e] * pmask - x[e]) * mm; if (seg == 0) rs[e] = s; else if (seg == 1) ks[e] = s; else vs[e] = s; } }
    }
    BAR_LDS();
    {
        const LdsMat Yw{L + SL(0), LW}, Ya{L + SL(1), LW}, Yg{L + SL(2), 136};
        const LdsMat Xw{L + SL(10), LW}, Xa{L + SL(11), LW}, Xg{L + SL(12), 136};
        mm64<64>(Yw, Xw, wid, lane, [&](int a, int b0, f32x4 v) { *(LAS f32x4*)(L + SL(4) + ((size_t)a * 68 + b0) * 4) = v; });
        mm64<64>(Ya, Xa, wid, lane, [&](int a, int b0, f32x4 v) { *(LAS f32x4*)(L + SL(6) + ((size_t)a * 68 + b0) * 4) = v; });
        mm64<128>(Yg, Xg, wid, lane, [&](int a, int b0, f32x4 v) { *(LAS f32x4*)(L + SL(8) + ((size_t)a * 68 + b0) * 4) = v; });
    }
    BAR_LDS();
    float ld[8], kp[8], av[8], bv[8];
    {
        const int hc = h * 64 + j0;
        float wp[8], ap[8], gg[8], w0[8], a0[8], kkw[8], kaw[8], rk[8];
        *(f32x4*)&wp[0] = *(LAS f32x4*)(L + SL(4) + ((size_t)t * 68 + j0) * 4); *(f32x4*)&wp[4] = *(LAS f32x4*)(L + SL(4) + ((size_t)t * 68 + j0 + 4) * 4);
        *(f32x4*)&ap[0] = *(LAS f32x4*)(L + SL(6) + ((size_t)t * 68 + j0) * 4); *(f32x4*)&ap[4] = *(LAS f32x4*)(L + SL(6) + ((size_t)t * 68 + j0 + 4) * 4);
        *(f32x4*)&gg[0] = *(LAS f32x4*)(L + SL(8) + ((size_t)t * 68 + j0) * 4); *(f32x4*)&gg[4] = *(LAS f32x4*)(L + SL(8) + ((size_t)t * 68 + j0 + 4) * 4);
        *(f32x4*)&w0[0] = *(LAS const f32x4*)(par + 0 + hc); *(f32x4*)&w0[4] = *(LAS const f32x4*)(par + 0 + hc + 4);
        *(f32x4*)&a0[0] = *(LAS const f32x4*)(par + 512 + hc); *(f32x4*)&a0[4] = *(LAS const f32x4*)(par + 512 + hc + 4);
        *(f32x4*)&kkw[0] = *(LAS const f32x4*)(par + 1024 + hc); *(f32x4*)&kkw[4] = *(LAS const f32x4*)(par + 1024 + hc + 4);
        *(f32x4*)&kaw[0] = *(LAS const f32x4*)(par + 1536 + hc); *(f32x4*)&kaw[4] = *(LAS const f32x4*)(par + 1536 + hc + 4);
        *(f32x4*)&rk[0] = *(LAS const f32x4*)(par + 2048 + hc); *(f32x4*)&rk[4] = *(LAS const f32x4*)(par + 2048 + hc + 4);
        float ss = 0.f, bon = 0.f, kkv[8], eta[8];
#pragma unroll
        for (int e = 0; e < 8; ++e) {
            ld[e] = -0.60653065971f * fsigmoid(w0[e] + wp[e]);
            eta[e] = fsigmoid(a0[e] + ap[e]);
            kkv[e] = ks[e] * kkw[e]; ss += kkv[e] * kkv[e];
            kp[e] = ks[e] * (1.0f + (eta[e] - 1.0f) * kaw[e]);
            bon += rs[e] * kp[e] * rk[e];
        }
        ss += __shfl_xor(ss, 1); ss += __shfl_xor(ss, 2); ss += __shfl_xor(ss, 4);
        bon += __shfl_xor(bon, 1); bon += __shfl_xor(bon, 2); bon += __shfl_xor(bon, 4);
        const float inv = __builtin_amdgcn_rcpf(fmaxf(__builtin_amdgcn_sqrtf(ss), 1e-12f));
#pragma unroll
        for (int e = 0; e < 8; ++e) { const float kk = kkv[e] * inv; av[e] = -kk; bv[e] = kk * eta[e]; }
        if (jb == 0) ((float*)(F.ws + WS_BONUS))[(size_t)tg * 8 + h] = bon;
        *(u32x4*)((bf16_t*)(F.ws + WS_GBUF) + (size_t)tg * RW + hc) = pack8(gg);
    }
    float Lc[8];
#pragma unroll
    for (int e = 0; e < 8; ++e) { float x = ld[e];
        float y = __shfl_up(x, 8); if (lane >= 8) x += y;
        y = __shfl_up(x, 16); if (lane >= 16) x += y;
        y = __shfl_up(x, 32); if (lane >= 32) x += y;
        Lc[e] = x; }
    if (lane >= 56) {
#pragma unroll
        for (int e = 0; e < 8; ++e) XT[wid * 64 + j0 + e] = Lc[e]; }
    BAR_LDS();
    {
        float pre[8];
#pragma unroll
        for (int e = 0; e < 8; ++e) pre[e] = 0.f;
#pragma unroll
        for (int w = 0; w < 7; ++w) if (w < wid) { const f32x4 x0 = *(LAS const f32x4*)(XT + w * 64 + j0), x1 = *(LAS const f32x4*)(XT + w * 64 + j0 + 4);
#pragma unroll
            for (int e = 0; e < 4; ++e) { pre[e] += x0[e]; pre[4 + e] += x1[e]; } }
#pragma unroll
        for (int e = 0; e < 8; ++e) Lc[e] += pre[e];
    }
    if (t == 63) {
#pragma unroll
        for (int e = 0; e < 8; ++e) XT[512 + j0 + e] = fexp(Lc[e]); }
    {
        float o0[8], o1[8], o2[8], o3[8];
#pragma unroll
        for (int e = 0; e < 8; ++e) { const float ein = fexp(Lc[e]), eout = __builtin_amdgcn_rcpf(ein), eex = fexp(Lc[e] - ld[e]);
            o0[e] = rs[e] * ein; o1[e] = kp[e] * eout; o2[e] = av[e] * eex; o3[e] = bv[e] * eout; }
        const size_t off = ((size_t)t * LW + j0) * 2;
        *(LAS u32x4*)(L + SL(10) + off) = pack8(o0); *(LAS u32x4*)(L + SL(11) + off) = pack8(o1); *(LAS u32x4*)(L + SL(12) + off) = pack8(o2); *(LAS u32x4*)(L + SL(13) + off) = pack8(o3);
        *(LAS u32x4*)(L + SL(2) + off) = pack8(vs);
    }
    BAR_LDS();
    {
        const int srcs[4] = {12, 13, 11, 2}, dsts[4] = {4, 5, 6, 7};
#pragma unroll
        for (int q = 0; q < 4; ++q) { unsigned short hv[8];
#pragma unroll
            for (int e = 0; e < 8; ++e) hv[e] = *(LAS const unsigned short*)(L + SL(srcs[q]) + ((size_t)(8 * wid + e) * LW + lane) * 2);
            u32x4 w; w.x = hv[0] | ((unsigned)hv[1] << 16); w.y = hv[2] | ((unsigned)hv[3] << 16); w.z = hv[4] | ((unsigned)hv[5] << 16); w.w = hv[6] | ((unsigned)hv[7] << 16);
            *(LAS u32x4*)(L + SL(dsts[q]) + ((size_t)lane * LW + 8 * wid) * 2) = w;
        }
    }
    BAR_LDS();
    if (next_unit < NUNIT) rwkv_pre_fetch(F, next_unit, next_first, P, tid);
    const int crow = tid >> 3, cch = tid & 7;
    __builtin_nontemporal_store(*(LAS const u32x4*)(L + SL(7) + ((size_t)crow * LW + cch * 8) * 2), (u32x4*)((bf16_t*)(F.ws + WS_VT) + (size_t)unit * 4096 + crow * 64 + cch * 8));
    {
        const LdsMat Rt{L + SL(10), LW}, Kt{L + SL(11), LW}, At{L + SL(12), LW}, Bt{L + SL(13), LW};
        f32x4 nd = (f32x4){0.f, 0.f, 0.f, 0.f}, ntd = nd;
        {
            int ln = lane, wd = wid; asm volatile("" : "+v"(ln), "+s"(wd));
            const int at = wd >> 1, bt0 = (wd & 1) * 2, fr = ln & 15, fq = ln >> 4, a = 16 * at + fr;
            bf16x8 yA[2], yK[2], yR[2], xB[2][2], xA[2][2], xK[2][2];
            ld_yf(At, at, fr, fq, yA); ld_xf(Bt, bt0, fr, fq, xB); ld_yf(Kt, at, fr, fq, yK); ld_xf(At, bt0, fr, fq, xA); ld_yf(Rt, at, fr, fq, yR); ld_xf(Kt, bt0, fr, fq, xK);
            const bool diag = bt0 == (at & 2);
            bf16x8 xd[2];
            if (diag) ld_yf(Bt, at, fr, fq, xd);
            f32x4 c0[2], c1[2], c2[2], c3[2];
            mm_f(yA, xB, c0); mm_f(yK, xA, c1); mm_f(yR, xB, c2); mm_f(yR, xK, c3);
            if (diag) {
                f32x4 v = (f32x4){0.f, 0.f, 0.f, 0.f};
#pragma unroll
                for (int s = 0; s < 2; ++s) v = __builtin_amdgcn_mfma_f32_16x16x32_bf16(yA[s], xd[s], v, 0, 0, 0);
#pragma unroll
                for (int e = 0; e < 4; ++e) v[e] = (fr < 4 * fq + e) ? v[e] : 0.f;
                nd = v; }
#pragma unroll
            for (int bi = 0; bi < 2; ++bi) { const int b0 = 16 * (bt0 + bi) + 4 * fq; f32x4 v0 = c0[bi], v1 = c1[bi], v2 = c2[bi], v3 = c3[bi];
#pragma unroll
                for (int e = 0; e < 4; ++e) { v0[e] = (b0 + e < a) ? v0[e] : 0.f; v1[e] = (a < b0 + e) ? v1[e] : 0.f; v2[e] = (b0 + e <= a) ? v2[e] : 0.f; v3[e] = (b0 + e <= a) ? v3[e] : 0.f; }
                st_lds4(L + SL(1), a, b0, v0); st_lds4(L + SL(2), a, b0, v1); st_lds4(L + SL(3), a, b0, v2); st_lds4(L + SL(8), a, b0, v3);
                if (bt0 + bi == at) ntd = v0; }
        }
        const int at = wid >> 1;
        if (((wid & 1) * 2 == (at & 2))) {
            const int fr = lane & 15, fq = lane >> 4;
            auto op = [](f32x4 v) { u32x4 w; w.x = cvt_pk_bf16(v[0], v[1]); w.y = cvt_pk_bf16(v[2], v[3]); w.z = 0u; w.w = 0u; return __builtin_bit_cast(bf16x8, w); };
            const f32x4 zero = (f32x4){0.f, 0.f, 0.f, 0.f};
            const f32x4 Lm = ntd, LT = nd;
            f32x4 Q = Lm;
#pragma unroll
            for (int e = 0; e < 4; ++e) Q[e] += (4 * fq + e == fr) ? 1.f : 0.f;
            const f32x4 L2 = __builtin_amdgcn_mfma_f32_16x16x32_bf16(op(LT), op(Lm), zero, 0, 0, 0), L2T = __builtin_amdgcn_mfma_f32_16x16x32_bf16(op(Lm), op(LT), zero, 0, 0, 0);
            Q = __builtin_amdgcn_mfma_f32_16x16x32_bf16(op(L2T), op(Q), Q, 0, 0, 0);
            const f32x4 L4 = __builtin_amdgcn_mfma_f32_16x16x32_bf16(op(L2T), op(L2), zero, 0, 0, 0), L4T = __builtin_amdgcn_mfma_f32_16x16x32_bf16(op(L2), op(L2T), zero, 0, 0, 0);
            Q = __builtin_amdgcn_mfma_f32_16x16x32_bf16(op(L4T), op(Q), Q, 0, 0, 0);
            const f32x4 L8T = __builtin_amdgcn_mfma_f32_16x16x32_bf16(op(L4), op(L4T), zero, 0, 0, 0);
            Q = __builtin_amdgcn_mfma_f32_16x16x32_bf16(op(L8T), op(Q), Q, 0, 0, 0);
            st_lds4(L + SL(9), 16 * at + fr, 4 * fq, Q);
        }
    }
    BAR_LDS();
    {
        const int fr = lane & 15, fq = lane >> 4;
        LAS const unsigned char* zsl = L + (wid < 4 ? SL(4) : SL(2)); LAS unsigned char* dsl = L + (wid < 4 ? SL(11) : SL(12));
        const int arow = 16 * (wid & 3) + fr;
        u32x2 zp[4];
#pragma unroll
        for (int c = 0; c < 4; ++c) {
            f32x4 acc = ld_lds4(zsl, arow, 16 * c + 4 * fq);
            if (c >= 1) {
                const u32x2 alo = *(LAS const u32x2*)(L + SL(1) + ((size_t)(16 * c + fr) * LW + 4 * fq) * 2), ahi = *(LAS const u32x2*)(L + SL(1) + ((size_t)(16 * c + fr) * LW + 16 + 4 * fq) * 2);
                u32x4 aw; aw.x = alo.x; aw.y = alo.y; aw.z = ahi.x; aw.w = ahi.y;
                u32x4 bw; bw.x = zp[0].x; bw.y = zp[0].y; bw.z = c >= 2 ? zp[1].x : 0u; bw.w = c >= 2 ? zp[1].y : 0u;
                acc = __builtin_amdgcn_mfma_f32_16x16x32_bf16(__builtin_bit_cast(bf16x8, aw), __builtin_bit_cast(bf16x8, bw), acc, 0, 0, 0); }
            if (c == 3) {
                const u32x2 alo = *(LAS const u32x2*)(L + SL(1) + ((size_t)(48 + fr) * LW + 32 + 4 * fq) * 2);
                u32x4 aw; aw.x = alo.x; aw.y = alo.y; aw.z = 0u; aw.w = 0u;
                u32x4 bw; bw.x = zp[2].x; bw.y = zp[2].y; bw.z = 0u; bw.w = 0u;
                acc = __builtin_amdgcn_mfma_f32_16x16x32_bf16(__builtin_bit_cast(bf16x8, aw), __builtin_bit_cast(bf16x8, bw), acc, 0, 0, 0); }
            const u32x2 dlo = *(LAS const u32x2*)(L + SL(9) + ((size_t)(16 * c + fr) * LW + 4 * fq) * 2);
            u32x4 aw; aw.x = dlo.x; aw.y = dlo.y; aw.z = 0u; aw.w = 0u;
            u32x4 bw; bw.x = cvt_pk_bf16(acc[0], acc[1]); bw.y = cvt_pk_bf16(acc[2], acc[3]); bw.z = 0u; bw.w = 0u;
            const f32x4 r = __builtin_amdgcn_mfma_f32_16x16x32_bf16(__builtin_bit_cast(bf16x8, aw), __builtin_bit_cast(bf16x8, bw), (f32x4){0.f, 0.f, 0.f, 0.f}, 0, 0, 0);
            zp[c].x = cvt_pk_bf16(r[0], r[1]); zp[c].y = cvt_pk_bf16(r[2], r[3]);
            *(LAS u32x2*)(dsl + ((size_t)arow * LW + 16 * c + 4 * fq) * 2) = zp[c];
        }
    }
    BAR_LDS();
    {
        const int sAT = 11, sAkT = 12, sHk = 0;
        const LdsMat AT{L + SL(sAT), LW}, AkT{L + SL(sAkT), LW}, AbrT{L + SL(3), LW}, BgT{L + SL(5), LW}, VTm{L + SL(7), LW};
        bf16_t* QRT = (bf16_t*)(F.ws + WS_QRT) + (size_t)unit * 4096; bf16_t* WYT = (bf16_t*)(F.ws + WS_WYT) + (size_t)unit * 4096;
        bf16_t* GTg = (bf16_t*)(F.dout + DO_GT) + (size_t)unit * (64 * GLD); bf16_t* Hg = (bf16_t*)(F.dout + DO_H) + (size_t)unit * (64 * GLD);
        {
            int ln = lane, wd = wid; asm volatile("" : "+v"(ln), "+s"(wd));
            const int at = wd >> 1, bt0 = (wd & 1) * 2, fr = ln & 15, fq = ln >> 4, a = 16 * at + fr;
            bf16x8 yA[2], yB[2], xT[2][2], xK[2][2];
            ld_yf(BgT, at, fr, fq, yB); ld_xf(AkT, bt0, fr, fq, xK); ld_yf(AbrT, at, fr, fq, yA); ld_xf(AT, bt0, fr, fq, xT);
            f32x4 eH[2], eR[2], eW[2];
#pragma unroll
            for (int bi = 0; bi < 2; ++bi) { const int b0 = 16 * (bt0 + bi) + 4 * fq; eH[bi] = ld_lds4(L + SL(6), a, b0); eR[bi] = ld_lds4(L + SL(10), a, b0); eW[bi] = ld_lds4(L + SL(8), a, b0); }
            const float gdiag = XT[512 + a];
            f32x4 cH[2], cQ[2], cW[2], cG[2];
            mm_f(yB, xK, cH); mm_f(yA, xT, cQ); mm_f(yA, xK, cW); mm_f(yB, xT, cG);
#pragma unroll
            for (int bi = 0; bi < 2; ++bi) { const int b0 = 16 * (bt0 + bi) + 4 * fq;
                st_lds4(L + SL(sHk), a, b0, (cH[bi] + eH[bi]) * gdiag);
                st_lds4(L + SL(1), a, b0, cQ[bi] + eR[bi]);
                st_lds4(L + SL(2), a, b0, cW[bi] + eW[bi]);
                f32x4 v = cG[bi];
#pragma unroll
                for (int e = 0; e < 4; ++e) v[e] += (b0 + e == a) ? 1.f : 0.f;
                st_lds4(L + SL(4), a, b0, v * gdiag); }
        }
        BAR_LDS();
        const LdsMat HkT{L + SL(sHk), LW};
        mm64<64>(VTm, HkT, wid, lane, [&](int a, int b0, f32x4 v) { st_lds4(L + SL(9), a, b0, v); });
        __builtin_nontemporal_store(*(LAS const u32x4*)(L + SL(1) + ((size_t)crow * LW + cch * 8) * 2), (u32x4*)(QRT + crow * 64 + cch * 8));
        __builtin_nontemporal_store(*(LAS const u32x4*)(L + SL(2) + ((size_t)crow * LW + cch * 8) * 2), (u32x4*)(WYT + crow * 64 + cch * 8));
        __builtin_nontemporal_store(*(LAS const u32x4*)(L + SL(4) + (size_t)tid * 16), (u32x4*)GTg + tid);
        if (tid < 64) __builtin_nontemporal_store(*(LAS const u32x4*)(L + SL(4) + (size_t)(512 + tid) * 16), (u32x4*)GTg + 512 + tid);
        if (next_unit < NUNIT) rwkv_pre_put_w(L, P, tid);
        BAR_LDS();
        __builtin_nontemporal_store(*(LAS const u32x4*)(L + SL(9) + (size_t)tid * 16), (u32x4*)Hg + tid);
        if (tid < 64) __builtin_nontemporal_store(*(LAS const u32x4*)(L + SL(9) + (size_t)(512 + tid) * 16), (u32x4*)Hg + 512 + tid);
    }
}

constexpr int RS_SLOT = 12 * 1024;
constexpr int RS_DEPTH = 8, RS_AHEAD = 6;
__device__ __forceinline__ void rwkv_scan_block(Frame& F, int item) {
    const int bh = item >> 2, qi = item & 3, lane = F.lane, fr = lane & 15, fq = lane >> 4, wid = F.wave;
    const char* GTg = (const char*)(F.dout + DO_GT) + (size_t)bh * 64 * (64 * GLD * 2);
    const char* Hg = (const char*)(F.dout + DO_H) + (size_t)bh * 64 * (64 * GLD * 2) + (size_t)qi * (16 * GLD * 2);
    bf16_t* SST = (bf16_t*)(F.dout + DO_SST) + (size_t)bh * 64 * 4096;
    LAS unsigned char* L = F.lds;
    auto issue = [&](int c) {
        if (wid >= 1) {
            LAS unsigned char* slot = L + (c & (RS_DEPTH - 1)) * RS_SLOT;
#pragma unroll
            for (int k = 0; k < 2; ++k) { const int pc = (wid - 1) + 7 * k;
                if (pc < 12) {
                    const char* src;
                    if (pc < 9) src = GTg + (size_t)c * (64 * GLD * 2) + pc * 1024 + lane * 16;
                    else { int off = (pc - 9) * 1024 + lane * 16; off = off > 2304 - 16 ? 2304 - 16 : off; src = Hg + (size_t)c * (64 * GLD * 2) + off; }
                    __builtin_amdgcn_global_load_lds((const unsigned*)src, (LAS unsigned*)(slot + pc * 1024), 16, 0, 0); } }
        }
    };
    f32x4 acc[4];
#pragma unroll
    for (int mt = 0; mt < 4; ++mt) acc[mt] = (f32x4){0.f, 0.f, 0.f, 0.f};
#pragma unroll 1
    for (int c = 0; c < RS_AHEAD; ++c) issue(c);
#pragma unroll 1
    for (int c = 0; c < NCH; ++c) {
        if (c + RS_AHEAD < NCH) issue(c + RS_AHEAD);
        if (c + RS_AHEAD < NCH) { if (wid >= 1 && wid <= 5) asm volatile("s_waitcnt vmcnt(12)" ::: "memory"); else if (wid >= 6) asm volatile("s_waitcnt vmcnt(6)" ::: "memory"); }
        else if (wid >= 1) asm volatile("s_waitcnt vmcnt(0)" ::: "memory");
        __builtin_amdgcn_s_barrier(); asm volatile("" ::: "memory");
        if (wid == 0) {
            LAS const unsigned char* slot = L + (c & (RS_DEPTH - 1)) * RS_SLOT;
            u32x2 ga[4][2][2], hv[4];
#pragma unroll
            for (int mt = 0; mt < 4; ++mt) {
#pragma unroll
                for (int s = 0; s < 2; ++s)
#pragma unroll
                    for (int hh = 0; hh < 2; ++hh) ga[mt][s][hh] = *(LAS const u32x2*)(slot + ((16 * mt + fr) * GLD + 16 * (2 * s + hh) + 4 * fq) * 2);
                hv[mt] = *(LAS const u32x2*)(slot + 9216 + (fr * GLD + 16 * mt + 4 * fq) * 2); }
            bf16_t* Sc = SST + (size_t)c * 4096; u32x2 sp[4];
#pragma unroll
            for (int mt = 0; mt < 4; ++mt) { sp[mt].x = cvt_pk_bf16(acc[mt][0], acc[mt][1]); sp[mt].y = cvt_pk_bf16(acc[mt][2], acc[mt][3]);
                *(u32x2*)(Sc + (size_t)(16 * qi + fr) * 64 + 16 * mt + 4 * fq) = sp[mt]; }
            bf16x8 sb[2];
#pragma unroll
            for (int s = 0; s < 2; ++s) { u32x4 w; w.x = sp[2 * s].x; w.y = sp[2 * s].y; w.z = sp[2 * s + 1].x; w.w = sp[2 * s + 1].y; sb[s] = __builtin_bit_cast(bf16x8, w); }
#pragma unroll
            for (int mt = 0; mt < 4; ++mt) { f32x4 a = (f32x4){bf_lo(hv[mt].x), bf_hi(hv[mt].x), bf_lo(hv[mt].y), bf_hi(hv[mt].y)};
#pragma unroll
                for (int s = 0; s < 2; ++s) { u32x4 w; w.x = ga[mt][s][0].x; w.y = ga[mt][s][0].y; w.z = ga[mt][s][1].x; w.w = ga[mt][s][1].y;
                    a = __builtin_amdgcn_mfma_f32_16x16x32_bf16(__builtin_bit_cast(bf16x8, w), sb[s], a, 0, 0, 0); }
                acc[mt] = a; }
            asm volatile("s_waitcnt lgkmcnt(0)" ::: "memory");
        }
    }
    asm volatile("s_waitcnt vmcnt(0)" ::: "memory");
    __builtin_amdgcn_s_barrier(); asm volatile("" ::: "memory");
}
__device__ __forceinline__ void s5_scan_block(Frame& F, int gb) {
    const int g = gb >> 3, b = gb & 7, p = F.lane, w = F.wave;
    const float* aL = (const float*)(F.ws + WS_AL) + g * 128; const float ar = aL[2 * p], ai = aL[2 * p + 1];
    const float* SLc = (const float*)(F.ws + WS_SLOC) + ((size_t)g * S5ROWS + b * 256 + 32 * w) * 128 + 2 * p;
    bf16_t* UG = (bf16_t*)(F.ws + WS_UG) + ((size_t)g * S5ROWS + b * 256 + 32 * w) * UGLD + 256 + 2 * p;
    LAS float* E = (LAS float*)(F.lds);
    f32x2 l[32];
#pragma unroll
    for (int k = 0; k < 32; ++k) l[k] = *(const f32x2*)(SLc + (size_t)k * 128);
    float sr = 0.f, si = 0.f;
#pragma unroll
    for (int k = 0; k < 32; ++k) { const float nr = ar * sr - ai * si + l[k].x, ni = ar * si + ai * sr + l[k].y; l[k].x = sr; l[k].y = si; sr = nr; si = ni; }
    E[(w * 64 + p) * 2] = sr; E[(w * 64 + p) * 2 + 1] = si;
    float pr = ar, pi = ai;
#pragma unroll
    for (int q = 0; q < 5; ++q) { const float nr = pr * pr - pi * pi, ni = 2.f * pr * pi; pr = nr; pi = ni; }
    asm volatile("s_waitcnt lgkmcnt(0)" ::: "memory"); __builtin_amdgcn_s_barrier(); asm volatile("" ::: "memory");
    float cr = 0.f, ci = 0.f;
#pragma unroll
    for (int w2 = 0; w2 < 7; ++w2) { if (w2 < w) { const float er = E[(w2 * 64 + p) * 2], ei = E[(w2 * 64 + p) * 2 + 1]; const float nr = pr * cr - pi * ci + er, ni = pr * ci + pi * cr + ei; cr = nr; ci = ni; } }
#pragma unroll
    for (int k = 0; k < 32; ++k) { *(unsigned*)(UG + (size_t)k * UGLD) = cvt_pk_bf16(l[k].x + cr, l[k].y + ci); const float nr = ar * cr - ai * ci, ni = ar * ci + ai * cr; cr = nr; ci = ni; }
    asm volatile("s_waitcnt lgkmcnt(0)" ::: "memory"); __builtin_amdgcn_s_barrier(); asm volatile("" ::: "memory");
}
struct OutY { bf16x8 yq[2], yw[2]; u32x2 pv[4], pp[4], gv[4]; float bon; };
__device__ __forceinline__ void rwkv_out_loady(Frame& F, int unit, int at, OutY& Lq) {
    const int lane = F.lane, fr = lane & 15, fq = lane >> 4;
    const int bh = unit >> 6, c = unit & 63, b = bh >> 3, h = bh & 7;
    const bf16_t* QRT = (const bf16_t*)(F.ws + WS_QRT) + (size_t)unit * 4096; const bf16_t* WYT = (const bf16_t*)(F.ws + WS_WYT) + (size_t)unit * 4096;
#pragma unroll
    for (int s = 0; s < 2; ++s) { Lq.yq[s] = __builtin_nontemporal_load((const bf16x8*)(QRT + (size_t)(16 * at + fr) * 64 + 32 * s + 8 * fq)); Lq.yw[s] = __builtin_nontemporal_load((const bf16x8*)(WYT + (size_t)(16 * at + fr) * 64 + 32 * s + 8 * fq)); }
    const int tl = c * 64 + 16 * at + fr, tg = b * SEQ + tl;
    const bf16_t* prow = (const bf16_t*)(F.ws + WS_PR) + (size_t)tg * NRW + 1024 + h * 64;
    const bf16_t* gb = (const bf16_t*)(F.ws + WS_GBUF) + (size_t)tg * RW + h * 64;
    Lq.bon = ((const float*)(F.ws + WS_BONUS))[(size_t)tg * 8 + h];
    const bf16_t* pprev = prow - (tl > 0 ? NRW : 0);
#pragma unroll
    for (int bt = 0; bt < 4; ++bt) { const int i0 = 16 * bt + 4 * fq; Lq.pv[bt] = *(const u32x2*)(prow + i0); Lq.pp[bt] = *(const u32x2*)(pprev + i0); Lq.gv[bt] = *(const u32x2*)(gb + i0); }
}
__device__ __forceinline__ void rwkv_out_comp(Frame& F, int unit, int at, const bf16x8 (&xs)[2][4], const bf16x8 (&xv)[2][4], const OutY& Lq) {
    const int lane = F.lane, fr = lane & 15, fq = lane >> 4;
    const int bh = unit >> 6, c = unit & 63, b = bh >> 3, h = bh & 7;
    f32x4 m4[4], lw[4], lb[4];
#pragma unroll
    for (int bt = 0; bt < 4; ++bt) { const int i0 = 16 * bt + 4 * fq; m4[bt] = *(const f32x4*)(F.in[I_MU] + 1024 + h * 64 + i0); lw[bt] = *(const f32x4*)(F.in[I_LNW] + h * 64 + i0); lb[bt] = *(const f32x4*)(F.in[I_LNB] + h * 64 + i0); }
    f32x4 acc[4];
#pragma unroll
    for (int bt = 0; bt < 4; ++bt) acc[bt] = (f32x4){0.f, 0.f, 0.f, 0.f};
#pragma unroll
    for (int s = 0; s < 2; ++s)
#pragma unroll
        for (int bt = 0; bt < 4; ++bt) {
            acc[bt] = __builtin_amdgcn_mfma_f32_16x16x32_bf16(xs[s][bt], Lq.yq[s], acc[bt], 0, 0, 0);
            acc[bt] = __builtin_amdgcn_mfma_f32_16x16x32_bf16(xv[s][bt], Lq.yw[s], acc[bt], 0, 0, 0); }
    float s1 = 0.f;
#pragma unroll
    for (int bt = 0; bt < 4; ++bt) s1 += (acc[bt][0] + acc[bt][1]) + (acc[bt][2] + acc[bt][3]);
    s1 += __shfl_xor(s1, 16); s1 += __shfl_xor(s1, 32);
    const float mean = s1 * (1.f / 64.f); float s2 = 0.f;
#pragma unroll
    for (int bt = 0; bt < 4; ++bt) { const f32x4 d = acc[bt] - mean; s2 += (d[0] * d[0] + d[1] * d[1]) + (d[2] * d[2] + d[3] * d[3]); }
    s2 += __shfl_xor(s2, 16); s2 += __shfl_xor(s2, 32);
    const float rstd = __builtin_amdgcn_rsqf(s2 * (1.f / 64.f) + 64e-5f);
    const int tl = c * 64 + 16 * at + fr, tg = b * SEQ + tl;
    const float pmask = tl > 0 ? 1.f : 0.f;
    bf16_t* YRS = (bf16_t*)(F.dout + DO_YRS) + (size_t)tg * D + h * 64;
#pragma unroll
    for (int bt = 0; bt < 4; ++bt) { const int i0 = 16 * bt + 4 * fq;
        const u32x2 pv = Lq.pv[bt], pp = Lq.pp[bt], gv = Lq.gv[bt];
        const float x[4] = {bf_lo(pv.x), bf_hi(pv.x), bf_lo(pv.y), bf_hi(pv.y)}, xp[4] = {bf_lo(pp.x) * pmask, bf_hi(pp.x) * pmask, bf_lo(pp.y) * pmask, bf_hi(pp.y) * pmask}, gg[4] = {bf_lo(gv.x), bf_hi(gv.x), bf_lo(gv.y), bf_hi(gv.y)};
        float o[4];
#pragma unroll
        for (int e = 0; e < 4; ++e) { const float vsh = x[e] + (xp[e] - x[e]) * m4[bt][e]; o[e] = ((acc[bt][e] - mean) * rstd * lw[bt][e] + lb[bt][e] + Lq.bon * vsh) * gg[e]; }
        u32x2 w; w.x = cvt_pk_bf16(o[0], o[1]); w.y = cvt_pk_bf16(o[2], o[3]); *(u32x2*)(YRS + i0) = w; }
}
__device__ __forceinline__ void rwkv_out_units(Frame& F) {
    const int lane = F.lane, fr = lane & 15, fq = lane >> 4;
    for (int unit = F.vcu * NWAVES + F.wave; unit < NUNIT; unit += F.G * NWAVES) {
        const bf16_t* VT = (const bf16_t*)(F.ws + WS_VT) + (size_t)unit * 4096; const bf16_t* SST = (const bf16_t*)(F.dout + DO_SST) + (size_t)unit * 4096;
        bf16x8 xs[2][4], xv[2][4]; OutY A, B;
#pragma unroll
        for (int s = 0; s < 2; ++s)
#pragma unroll
            for (int bt = 0; bt < 4; ++bt) { xs[s][bt] = __builtin_nontemporal_load((const bf16x8*)(SST + (size_t)(16 * bt + fr) * 64 + 32 * s + 8 * fq)); xv[s][bt] = __builtin_nontemporal_load((const bf16x8*)(VT + (size_t)(16 * bt + fr) * 64 + 32 * s + 8 * fq)); }
        rwkv_out_loady(F, unit, 0, A); rwkv_out_loady(F, unit, 1, B); __builtin_amdgcn_sched_barrier(0);
        rwkv_out_comp(F, unit, 0, xs, xv, A); __builtin_amdgcn_sched_barrier(0); rwkv_out_loady(F, unit, 2, A); __builtin_amdgcn_sched_barrier(0);
        rwkv_out_comp(F, unit, 1, xs, xv, B); __builtin_amdgcn_sched_barrier(0); rwkv_out_loady(F, unit, 3, B); __builtin_amdgcn_sched_barrier(0);
        rwkv_out_comp(F, unit, 2, xs, xv, A); __builtin_amdgcn_sched_barrier(0);
        rwkv_out_comp(F, unit, 3, xs, xv, B); __builtin_amdgcn_sched_barrier(0);
    }
}

__device__ __forceinline__ void p8_rows(Frame& F) {
    const int gw = F.vcu * NWAVES + F.wave, NGW = F.G * NWAVES, lane = F.lane;
    const bf16_t* MX = (const bf16_t*)(F.ws + WS_MIXED); const float* ST = (const float*)(F.ws + WS_STAT1); bf16_t* H2 = (bf16_t*)(F.ws + WS_H2); float* X1 = (float*)F.dout;
    f32x4 gp[4];
#pragma unroll
    for (int j = 0; j < 4; ++j) gp[j] = *(const f32x4*)(F.in[I_NMPOST] + 256 * j + 4 * lane);
    for (int m0 = gw; m0 < T; m0 += 2 * NGW) {
        int mm[2] = {m0, (m0 + NGW < T) ? m0 + NGW : m0};
        f32x4 xv[2][4]; u32x2 mw[2][4]; float st[2];
#pragma unroll
        for (int q = 0; q < 2; ++q) { st[q] = (lane < 16) ? ST[(size_t)mm[q] * 16 + lane] : 0.f;
#pragma unroll
            for (int j = 0; j < 4; ++j) { const int col = 256 * j + 4 * lane; xv[q][j] = __builtin_nontemporal_load((const f32x4*)(F.in[I_X] + (size_t)mm[q] * D + col)); mw[q][j] = __builtin_nontemporal_load((const u32x2*)(MX + (size_t)mm[q] * D + col)); } }
#pragma unroll
        for (int q = 0; q < 2; ++q) {
            const float rstd1 = __builtin_amdgcn_rsqf(wave_sum(st[q]) * (1.f / D) + 1e-6f);
            f32x4 v[4]; float s = 0.f;
#pragma unroll
            for (int j = 0; j < 4; ++j) { const int col = 256 * j + 4 * lane;
                v[j].x = xv[q][j].x + bf_lo(mw[q][j].x) * rstd1 * gp[j].x; v[j].y = xv[q][j].y + bf_hi(mw[q][j].x) * rstd1 * gp[j].y; v[j].z = xv[q][j].z + bf_lo(mw[q][j].y) * rstd1 * gp[j].z; v[j].w = xv[q][j].w + bf_hi(mw[q][j].y) * rstd1 * gp[j].w;
                s += (v[j].x * v[j].x + v[j].y * v[j].y) + (v[j].z * v[j].z + v[j].w * v[j].w);
                }
            const float rstd2 = __builtin_amdgcn_rsqf(wave_sum(s) * (1.f / D) + 1e-6f);
#pragma unroll
            for (int j = 0; j < 4; ++j) { u32x2 w; w.x = cvt_pk_bf16(v[j].x * rstd2, v[j].y * rstd2); w.y = cvt_pk_bf16(v[j].z * rstd2, v[j].w * rstd2); *(u32x2*)(H2 + (size_t)mm[q] * D + 256 * j + 4 * lane) = w; }
        }
    }
}
__device__ __forceinline__ void p12_rows(Frame& F) {
    const int gw = F.vcu * NWAVES + F.wave, NGW = F.G * NWAVES, lane = F.lane;
    const bf16_t* FB = (const bf16_t*)(F.ws + WS_F); const bf16_t* MX = (const bf16_t*)(F.ws + WS_MIXED);
    const float* ST1 = (const float*)(F.ws + WS_STAT1); const float* ST2 = (const float*)(F.ws + WS_STAT2); float* OUT = (float*)F.dout;
    f32x4 gp[4], gq[4];
#pragma unroll
    for (int j = 0; j < 4; ++j) { gp[j] = *(const f32x4*)(F.in[I_NMPOST] + 256 * j + 4 * lane); gq[j] = *(const f32x4*)(F.in[I_NFPOST] + 256 * j + 4 * lane); }
    for (int m0 = gw; m0 < T; m0 += 2 * NGW) {
        int mm[2] = {m0, (m0 + NGW < T) ? m0 + NGW : m0};
        f32x4 xv[2][4]; u32x2 mw[2][4], fw[2][4]; float s1[2], s2[2];
#pragma unroll
        for (int q = 0; q < 2; ++q) { s1[q] = (lane < 16) ? ST1[(size_t)mm[q] * 16 + lane] : 0.f; s2[q] = (lane < 16) ? ST2[(size_t)mm[q] * 16 + lane] : 0.f;
#pragma unroll
            for (int j = 0; j < 4; ++j) { const int col = 256 * j + 4 * lane; xv[q][j] = __builtin_nontemporal_load((const f32x4*)(F.in[I_X] + (size_t)mm[q] * D + col));
                mw[q][j] = __builtin_nontemporal_load((const u32x2*)(MX + (size_t)mm[q] * D + col)); fw[q][j] = __builtin_nontemporal_load((const u32x2*)(FB + (size_t)mm[q] * D + col)); } }
#pragma unroll
        for (int q = 0; q < 2; ++q) {
            const float rstd1 = __builtin_amdgcn_rsqf(wave_sum(s1[q]) * (1.f / D) + 1e-6f), rstd3 = __builtin_amdgcn_rsqf(wave_sum(s2[q]) * (1.f / D) + 1e-6f);
#pragma unroll
            for (int j = 0; j < 4; ++j) { const int col = 256 * j + 4 * lane; f32x4 o;
                o.x = xv[q][j].x + bf_lo(mw[q][j].x) * rstd1 * gp[j].x; o.y = xv[q][j].y + bf_hi(mw[q][j].x) * rstd1 * gp[j].y; o.z = xv[q][j].z + bf_lo(mw[q][j].y) * rstd1 * gp[j].z; o.w = xv[q][j].w + bf_hi(mw[q][j].y) * rstd1 * gp[j].w;
                o.x += bf_lo(fw[q][j].x) * rstd3 * gq[j].x; o.y += bf_hi(fw[q][j].x) * rstd3 * gq[j].y; o.z += bf_lo(fw[q][j].y) * rstd3 * gq[j].z; o.w += bf_hi(fw[q][j].y) * rstd3 * gq[j].w;
                __builtin_nontemporal_store(o, (f32x4*)(OUT + (size_t)mm[q] * D + col)); }
        }
    }
}

#ifndef MK_PER_PHASE
#define MK_PER_PHASE 0
#endif
constexpr int NPHASE = 12;
struct Args { const float* in[35]; float* out; unsigned char* ws; int ph_lo, ph_hi; };
static_assert(sizeof(Args) == 35 * 8 + 8 + 8 + 8, "Args has no padding");

__device__ __forceinline__ bool phase_begin(Frame& F) { unsigned long long z = 0; asm volatile("" : "+s"(z), "+v"(F.tid)); F.ws = F.ws0 + z; F.dout = F.dout0 + z;     F.lane = F.tid & 63; F.wave = __builtin_amdgcn_readfirstlane(F.tid >> 6); return true; }
__global__ void __launch_bounds__(NWAVES * 64, 2) fwd_kernel(Args args) {
    extern __shared__ __attribute__((aligned(16))) unsigned char lds_raw[];
    Frame F;
    F.lds = (LAS unsigned char*)lds_raw;
    F.MISC = (volatile LAS unsigned*)(F.lds + MISC_OFF);
    F.tid = threadIdx.x; F.lane = F.tid & 63; F.wave = __builtin_amdgcn_readfirstlane(F.tid >> 6);
    F.G = gridDim.x; { const int bx = blockIdx.x; F.vcu = (F.G % 8 == 0) ? (bx % 8) * (F.G / 8) + bx / 8 : bx; }
    F.ws0 = args.ws; F.dout0 = (unsigned char*)args.out; F.ws = F.ws0; F.dout = F.dout0; F.ctl = (gu32*)(args.ws + WS_CTL);
    F.in = (InTab)__builtin_amdgcn_kernarg_segment_ptr();
    for (int u = F.tid; u < (LDS_BYTES - LDSCTL_OFF) / 4; u += NWAVES * 64) ((LAS unsigned*)(F.lds + LDSCTL_OFF))[u] = 0u;
    __syncthreads();
    XcdBarrier bar; bar.bar = (unsigned*)(F.ctl + CW_BAR); bar.x = 0; bar.st = nullptr;
    if (!MK_PER_PHASE) bar = xcd_barrier_post((unsigned*)(F.ctl + CW_BAR), F.MISC + 8);
    const int lo = args.ph_lo, hi = args.ph_hi;
#ifndef PHMASK
#define PHMASK 0xffffffffu
#endif
#define IN(k) (((PHMASK >> (k)) & 1u) && lo <= (k) && (k) < hi && phase_begin(F))
#ifndef REPMASK
#define REPMASK 0u
#endif
#define REPS(k) ((((REPMASK) >> (k)) & 1u) ? 2 : 1)
#define PH(k) for (int rep_ = 0; rep_ < REPS(k); ++rep_, (rep_ < REPS(k) ? xcd_barrier(bar) : (void)0))
#define INQ(k) (lo <= (k) && (k) < hi)
#define SEAM(k) do { if (INQ(k) && INQ((k) + 1)) xcd_barrier(bar); } while (0)
#define WSB(off) ((bf16_t*)(F.ws + (off)))
    const int bx = (int)blockIdx.x;

    PH(0) if (IN(0)) { p0_prologue(F); }
    SEAM(0);
    PH(1) if (IN(1)) {
        pg8::Gemm g{D, D, D, 0}; pg8::StaticOrder S; S.init(WSB(WS_XN), WSB(WS_WIN), D, D, T, NIN, F.G, bx);
        EpiInProj E{WSB(WS_PR), WSB(WS_UG), WSB(WS_GATES), F.in[I_BGATE], 0};
        pg8::gemm_phase<EpiInProj, pg8::StaticOrder, true>(F.lds, g, S, E, F.tid);
        { const int rem = ((T / 256) * (NIN / 256)) % F.G;
          if (rem == 0) p0_late_mats(F, bx * NWAVES + F.wave, F.G * NWAVES); else if (bx >= rem) p0_late_mats(F, (bx - rem) * NWAVES + F.wave, (F.G - rem) * NWAVES); }
    }
    SEAM(1);
    PH(2) if (IN(2)) {
        PrePf pf;
        if (F.vcu < NB * NCH) { rwkv_pre_fetch(F, (((F.vcu >> 6) * NHEAD) << 6) + (F.vcu & 63), true, pf, F.tid); rwkv_pre_put_w(F.lds, pf, F.tid); }
        {
            LAS f32x4* TB = (LAS f32x4*)(F.lds + XTRA_OFF + 4096);
            if (F.tid < NRW / 4) TB[F.tid] = ((const f32x4*)F.in[I_MU])[F.tid];
            const int pq = F.tid >> 7, pi = F.tid & 127;
            const float* psrc = pq == 0 ? F.in[I_W0] : pq == 1 ? F.in[I_A0] : pq == 2 ? F.in[I_KK] : F.in[I_KA];
            TB[NRW / 4 + F.tid] = ((const f32x4*)psrc)[pi];
            if (F.tid < 128) TB[NRW / 4 + 512 + F.tid] = ((const f32x4*)F.in[I_RK])[F.tid];
            BAR_LDS();
        }
        for (int pc = F.vcu; pc < NB * NCH; pc += F.G) {
#pragma unroll 1
            for (int hh = 0; hh < NHEAD; ++hh) { const int bq = pc >> 6, cq = pc & 63, u = ((bq * NHEAD + hh) << 6) + cq;
                const int un = (hh < NHEAD - 1) ? u + 64 : ((pc + F.G < NB * NCH) ? ((((pc + F.G) >> 6) * NHEAD) << 6) + ((pc + F.G) & 63) : NUNIT);
                rwkv_pre_unit(F, u, un, hh == 0, hh == NHEAD - 1, pf); } }
        BAR_LDS();
        pg8::Gemm g{256, UGLD, 256, 0}; S5Order S{WSB(WS_UG), WSB(WS_B1A), 256, F.G, bx};
        EpiSloc E{(float*)(F.ws + WS_SLOC), 0};
        pg8::gemm_phase<EpiSloc, S5Order, true>(F.lds, g, S, E, F.tid);
    }
    SEAM(2);
    PH(3) if (IN(3)) {
        for (int gb = F.vcu; gb < S5G * NB; gb += F.G) s5_scan_block(F, gb);
        for (int it = F.vcu; it < NB * NHEAD * 4; it += F.G) rwkv_scan_block(F, it);
    }
    SEAM(3);
    PH(4) if (IN(4)) {
        rwkv_out_units(F);
        VM_WAIT(); __syncthreads();
        pg8::Gemm g{384, UGLD, 384, 0}; S5Order S{WSB(WS_UG), WSB(WS_B1B), 384, F.G, bx};
        pg8::EpiGen8<FS5Out> E{FS5Out{WSB(WS_YSP)}, 0};
        pg8::gemm_phase<pg8::EpiGen8<FS5Out>, S5Order, true>(F.lds, g, S, E, F.tid);
    }
    SEAM(4);
    PH(5) if (IN(5)) {
        pg8::Gemm g{RW, RW, RW, 1}; pg8::StaticOrder S; S.init(WSB(WS_YSP), WSB(WS_WGLU), RW, RW, T, RW, F.G, bx); S.tstepA = (size_t)16 * 256 * 2;
        EpiGlu E{WSB(WS_YSP), (bf16_t*)(F.dout + DO_YRS), F.in[I_BGLU], 0};
        pg8::gemm_phase<EpiGlu, pg8::StaticOrder, true>(F.lds, g, S, E, F.tid);
    }
    SEAM(5);
    PH(6) if (IN(6)) {
        pg8::Gemm g{D, D, D, 0}; pg8::StaticOrder S; S.init((const bf16_t*)(F.dout + DO_YRS), WSB(WS_WBRS), D, D, T, D, F.G, bx);
        EpiMerge E{WSB(WS_GATES), WSB(WS_MERGED), RW / 64};
        pg8::gemm_phase<EpiMerge, pg8::StaticOrder, true>(F.lds, g, S, E, F.tid);
    }
    SEAM(6);
    PH(7) if (IN(7)) {
        pg8::Gemm g{D, D, D, 0}; pg8::StaticOrder S; S.init(WSB(WS_MERGED), WSB(WS_WOUT), D, D, T, D, F.G, bx);
        EpiRowStat E{WSB(WS_MIXED), (float*)(F.ws + WS_STAT1), 0};
        pg8::gemm_phase<EpiRowStat, pg8::StaticOrder, false>(F.lds, g, S, E, F.tid);
    }
    SEAM(7);
    PH(8) if (IN(8)) { p8_rows(F);
        for (size_t i = (size_t)bx * 512 + F.tid; i < HZ_BYTES / 16; i += (size_t)F.G * 512) ((u32x4*)(F.ws + WS_HZ))[i] = (u32x4){0u, 0u, 0u, 0u}; }
    SEAM(8);
    PH(9) if (IN(9)) {
        pg8::Gemm g{D, D, D, 0}; UpOrder S{WSB(WS_H2), WSB(WS_WUP), F.G, bx};
        EpiConvAct E{WSB(WS_ACT), F.in[I_CONVW], F.in[I_CONVB], (LAS unsigned*)(F.lds + XTRA_OFF), (unsigned long long*)(F.ws + WS_HZ), (unsigned*)(F.ctl + 2), 0};
        pg8::gemm_phase<EpiConvAct, UpOrder, true>(F.lds, g, S, E, F.tid);
    }
    SEAM(9);
    PH(10) if (IN(10)) {
        pg8::Gemm g{FF, FF, FF, 0}; pg8::StaticOrder S; S.init(WSB(WS_ACT), WSB(WS_WDN), FF, FF, T, D, F.G, bx);
        EpiRowStat E{WSB(WS_F), (float*)(F.ws + WS_STAT2), 0};
        pg8::gemm_phase<EpiRowStat, pg8::StaticOrder, false>(F.lds, g, S, E, F.tid);
    }
    SEAM(10);
    if (IN(11)) p12_rows(F);
#undef IN
#undef INQ
#undef SEAM
#undef WSB
}

extern "C" void kernel_launch(void* const* d_in, const int* in_sizes, int n_in, void* d_out, int out_size, void* d_ws, size_t ws_size, hipStream_t stream) {
    static int grid = 0;
    if (grid == 0) {
        if (n_in != 35 || in_sizes[0] != T * D || out_size != T * D || ws_size < WS_END) { fprintf(stderr, "kernel_launch: unexpected shapes: n_in %d in0 %d out %d ws %zu (need %zu)\n", n_in, n_in > 0 ? in_sizes[0] : -1, out_size, ws_size, (size_t)WS_END); grid = -1; return; }
        int dev = 0, cus = 0, per_cu = 0;
        if (hipGetDevice(&dev) != hipSuccess || hipDeviceGetAttribute(&cus, hipDeviceAttributeMultiprocessorCount, dev) != hipSuccess) { fprintf(stderr, "kernel_launch: device query failed\n"); grid = -1; return; }
        if (hipFuncSetAttribute((const void*)fwd_kernel, hipFuncAttributeMaxDynamicSharedMemorySize, LDS_BYTES) != hipSuccess) { fprintf(stderr, "kernel_launch: hipFuncSetAttribute failed\n"); grid = -1; return; }
        if (hipOccupancyMaxActiveBlocksPerMultiprocessor(&per_cu, (const void*)fwd_kernel, NWAVES * 64, LDS_BYTES) != hipSuccess || per_cu < 1) fprintf(stderr, "kernel_launch: occupancy query reports %d blocks per CU\n", per_cu);
        (void)hipGetLastError();
        grid = cus;
    }
    if (grid < 0) return;
    if (hipMemsetAsync((char*)d_ws + WS_CTL, 0, CTL_ZERO_BYTES, stream) != hipSuccess) { fprintf(stderr, "kernel_launch: memset failed\n"); return; }
    Args a{};
    for (int i = 0; i < 35; ++i) a.in[i] = (const float*)d_in[i];
    a.out = (float*)d_out; a.ws = (unsigned char*)d_ws;
#if MK_PER_PHASE
    for (int ph = 0; ph < NPHASE; ++ph) { a.ph_lo = ph; a.ph_hi = ph + 1; hipLaunchKernelGGL(fwd_kernel, dim3(grid), dim3(NWAVES * 64), LDS_BYTES, stream, a); }
#else
    a.ph_lo = 0; a.ph_hi = NPHASE;
    hipLaunchKernelGGL(fwd_kernel, dim3(grid), dim3(NWAVES * 64), LDS_BYTES, stream, a);
#endif
    const hipError_t le = hipPeekAtLastError();
    if (le != hipSuccess) fprintf(stderr, "kernel_launch: launch failed: %s\n", hipGetErrorName(le));
}
```

```cpp
#include <hip/hip_runtime.h>
#include <cstdio>
#include <cstdint>

#define LAS __attribute__((address_space(3)))
#define GAS __attribute__((address_space(1)))
typedef unsigned short bf16_t;
typedef short bf16x8 __attribute__((ext_vector_type(8)));
typedef float f32x4 __attribute__((ext_vector_type(4)));
typedef float f32x2 __attribute__((ext_vector_type(2)));
typedef unsigned u32x4 __attribute__((ext_vector_type(4)));
typedef unsigned u32x2 __attribute__((ext_vector_type(2)));
typedef GAS unsigned gu32;

constexpr int T = 32768, SEQ = 4096, NB = 8, D = 1024, NIN = 4352, NRW = 1792, RW = 512, FF = 2816, FH = 1408;
constexpr int NHEAD = 8, HD = 64, NCH = 64  , NUNIT = NB * NHEAD * NCH;
constexpr int S5G = 32, S5ROWS = T / 16, UGLD = 384;

constexpr size_t MiB = 1u << 20;
constexpr size_t WS_CTL = 0, CTL_ZERO_BYTES = 1 * MiB;
constexpr size_t WS_WIN = 1 * MiB;
constexpr size_t WS_WUP = WS_WIN + (size_t)NIN * D * 2;
constexpr size_t WS_WDN = WS_WUP + (size_t)2 * FF * D * 2;
constexpr size_t WS_WOUT = WS_WDN + (size_t)D * FF * 2;
constexpr size_t WS_WBRS = WS_WOUT + (size_t)D * D * 2;
constexpr size_t WS_WGLU = WS_WBRS + (size_t)D * D * 2;
constexpr size_t WS_W2T = WS_WGLU + (size_t)RW * RW * 2;
constexpr size_t WS_A2T = WS_W2T + (size_t)RW * 64 * 2;
constexpr size_t WS_G2T = WS_A2T + (size_t)RW * 64 * 2;
constexpr size_t WS_B1A = WS_G2T + (size_t)RW * 128 * 2;
constexpr size_t WS_B1B = WS_B1A + (size_t)S5G * 256 * 256 * 2;
constexpr size_t WS_AL = WS_B1B + (size_t)S5G * 256 * 384 * 2;
constexpr size_t WS_WEND = WS_AL + (size_t)S5G * 64 * 2 * 4;
static_assert(WS_WEND <= 44 * MiB, "weights region");
constexpr size_t WS_XN = 44 * MiB;
constexpr size_t WS_QRT = 44 * MiB, WS_WYT = 76 * MiB;
constexpr size_t WS_MERGED = 44 * MiB, WS_H2 = 44 * MiB, WS_F = 44 * MiB;
constexpr size_t WS_PR = 108 * MiB;
constexpr size_t WS_MIXED = 304 * MiB, WS_STAT1 = 368 * MiB;
constexpr size_t WS_ACT = 108 * MiB;
constexpr size_t WS_STAT2 = 284 * MiB;
constexpr size_t WS_UG = 220 * MiB;
constexpr size_t WS_GATES = 268 * MiB;
constexpr size_t WS_SLOC = 396 * MiB, WS_YSP = 396 * MiB;
constexpr size_t WS_GBUF = 428 * MiB;
constexpr size_t WS_BONUS = 460 * MiB;
constexpr size_t WS_VT = 461 * MiB;
constexpr size_t WS_LRSCR = 493 * MiB;
constexpr size_t WS_Z = 336 * MiB;
constexpr size_t WS_END = 512 * MiB;
constexpr size_t DO_H = 0, DO_GT = 36 * MiB, DO_SST = 96 * MiB, DO_YRS = 0;
constexpr int GLD = 72;

constexpr int CW_BAR = 4096, CW_HF = 32768, CW_XNQ = 64;
constexpr size_t WS_HZ = 290 * MiB, HZ_BYTES = (size_t)2816 * 4 * 2 * 32 * 8;

constexpr int RING_BYTES = 131072, LDSCTL_OFF = RING_BYTES, MISC_OFF = LDSCTL_OFF + 320, XTRA_OFF = LDSCTL_OFF + 1024, LDS_BYTES = 155648;
constexpr int NWAVES = 8;

#define RLX_AGENT __ATOMIC_RELAXED, __HIP_MEMORY_SCOPE_AGENT
#define LDS_WAIT() asm volatile("s_waitcnt lgkmcnt(0)" ::: "memory")
#define VM_WAIT() asm volatile("s_waitcnt vmcnt(0)" ::: "memory")

typedef __bf16 bf16x2_t __attribute__((ext_vector_type(2)));
__device__ __forceinline__ unsigned cvt_pk_bf16(float lo, float hi) { const f32x2 v = {lo, hi}; return __builtin_bit_cast(unsigned, __builtin_convertvector(v, bf16x2_t)); }
__device__ __forceinline__ float bf_lo(unsigned w) { return __uint_as_float(w << 16); }
__device__ __forceinline__ float bf_hi(unsigned w) { return __uint_as_float(w & 0xffff0000u); }
__device__ __forceinline__ float bf1(bf16_t h) { return __uint_as_float((unsigned)h << 16); }
__device__ __forceinline__ float fexp(float x) { return __builtin_amdgcn_exp2f(x * 1.44269504089f); }
__device__ __forceinline__ float fsigmoid(float x) { return __builtin_amdgcn_rcpf(1.0f + __builtin_amdgcn_exp2f(-1.44269504089f * x)); }
__device__ __forceinline__ float ftanh(float x) { return 1.0f - 2.0f * __builtin_amdgcn_rcpf(1.0f + __builtin_amdgcn_exp2f(2.88539008178f * x)); }
__device__ __forceinline__ float fgelu(float x) { const float u = 0.7978845608f * (x + 0.044715f * x * x * x); return x * fsigmoid(2.0f * u); }
__device__ __forceinline__ void unpack8(u32x4 w, float (&f)[8]) { f[0] = bf_lo(w.x); f[1] = bf_hi(w.x); f[2] = bf_lo(w.y); f[3] = bf_hi(w.y); f[4] = bf_lo(w.z); f[5] = bf_hi(w.z); f[6] = bf_lo(w.w); f[7] = bf_hi(w.w); }
__device__ __forceinline__ u32x4 pack8(const float (&f)[8]) { u32x4 w; w.x = cvt_pk_bf16(f[0], f[1]); w.y = cvt_pk_bf16(f[2], f[3]); w.z = cvt_pk_bf16(f[4], f[5]); w.w = cvt_pk_bf16(f[6], f[7]); return w; }
__device__ __forceinline__ float wave_sum(float v) {
#pragma unroll
    for (int o = 1; o < 64; o <<= 1) v += __shfl_xor(v, o);
    return v;
}

#define XB_TMO      128
#define XB_XCNT(j)  (256  + 64 * (j))
#define XB_XSUB(j)  (1280 + 64 * (j))
#define XB_XGEN(j)  (2304 + 64 * (j))
#define XB_TOP      3328
#define XB_TOPGEN   3392
#define XCD_BAR_WORDS 3456
#define XB_SPIN_CAP (1u << 18)
__device__ __forceinline__ unsigned xb_ld(unsigned* p)              { return __hip_atomic_load(p, __ATOMIC_RELAXED, __HIP_MEMORY_SCOPE_AGENT); }
__device__ __forceinline__ unsigned xb_add(unsigned* p, unsigned v) { return __hip_atomic_fetch_add(p, v, __ATOMIC_RELAXED, __HIP_MEMORY_SCOPE_AGENT); }
__device__ __forceinline__ unsigned xb_xcc_id() { return (unsigned)__builtin_amdgcn_s_getreg((3 << 11) | 20) & 0xFu; }
#define XB_SPIN(cond, bar) do { unsigned _sp = 0; while (cond) { __builtin_amdgcn_s_sleep(1); \
    if ((++_sp & 255u) == 0u) { if (xb_ld(&(bar)[XB_TMO])) break; if (_sp > XB_SPIN_CAP) { atomicAdd(&(bar)[XB_TMO], 1u); break; } } } } while (0)
struct XcdBarrier { unsigned* bar; unsigned x; volatile LAS unsigned* st; };
__device__ __forceinline__ XcdBarrier xcd_barrier_post(unsigned* bar, volatile LAS unsigned* st) {
    XcdBarrier b; b.bar = bar; b.x = xb_xcc_id(); b.st = st;
    if (threadIdx.x == 0) (void)xb_add(&bar[XB_XCNT(b.x)], 1u);
    return b;
}
__device__ __forceinline__ void xcd_barrier_complete(unsigned* bar, unsigned x, unsigned& nloc, unsigned& nx) {
    const unsigned G = gridDim.x * gridDim.y * gridDim.z;
    unsigned sum, cnt, mine, sp = 0u;
    for (;;) {
        sum = 0u; cnt = 0u; mine = 0u;
#pragma unroll
        for (unsigned j = 0; j < 16; ++j) { const unsigned c = xb_ld(&bar[XB_XCNT(j)]); sum += c; cnt += (c > 0u) ? 1u : 0u; mine = (j == x) ? c : mine; }
        if (sum == G) break;
        __builtin_amdgcn_s_sleep(1);
        if ((++sp & 255u) == 0u) { if (xb_ld(&bar[XB_TMO])) break; if (sp > XB_SPIN_CAP) { atomicAdd(&bar[XB_TMO], 1u); break; } }
    }
    nloc = mine > 0u ? mine : 1u; nx = cnt > 0u ? cnt : 1u;
}
__device__ __forceinline__ void xcd_barrier(const XcdBarrier& b) {
    asm volatile("s_waitcnt vmcnt(0)" ::: "memory");
    __syncthreads();
    if (threadIdx.x == 0) {
        unsigned* bar = b.bar;
        __builtin_amdgcn_s_waitcnt(0);
        unsigned nloc = b.st[0], nx = b.st[1];
        if (nloc == 0u) { xcd_barrier_complete(bar, b.x, nloc, nx); b.st[0] = nloc; b.st[1] = nx; }
        const unsigned old = xb_add(&bar[XB_XSUB(b.x)], 1u);
        const unsigned gen = old / nloc;
        if (old + 1u == (gen + 1u) * nloc) {
            __builtin_amdgcn_fence(__ATOMIC_RELEASE, "agent");
            asm volatile("s_waitcnt vmcnt(0)" ::: "memory");
            const unsigned og = xb_add(&bar[XB_TOP], 1u);
            const unsigned tg = og / nx;
            if (og + 1u == (tg + 1u) * nx) xb_add(&bar[XB_TOPGEN], 1u);
            else XB_SPIN(xb_ld(&bar[XB_TOPGEN]) == tg, bar);
            __builtin_amdgcn_fence(__ATOMIC_ACQUIRE, "agent");
            xb_add(&bar[XB_XGEN(b.x)], 1u);
            asm volatile("s_waitcnt vmcnt(0)" ::: "memory");
        } else {
            XB_SPIN(xb_ld(&bar[XB_XGEN(b.x)]) == gen, bar);
            __builtin_amdgcn_fence(__ATOMIC_ACQUIRE, "agent");
            asm volatile("s_waitcnt vmcnt(0)" ::: "memory");
        }
    }
    __syncthreads();
}

namespace pg8 {
constexpr int BM = 256, BK = 64, HALF = 128, HTB = HALF * BK * 2, STAGE_BYTES = 8 * HTB, NXCD = 8, WGM = 8;
__host__ __device__ __forceinline__ int lds_byte(int r, int c) { const int st = (r >> 4) * 2 + (c >> 5), rr = r & 15, cc = c & 31, ob = rr * 64 + cc * 2; return st * 1024 + (ob ^ (((ob >> 9) & 1) << 5)); }
__host__ __device__ __forceinline__ void stage_rc(int b, int& R, int& C) { const int st = b / 1024, sb = b % 1024, swz = sb ^ (((sb >> 9) & 1) << 5); R = (st >> 1) * 16 + swz / 64; C = (st & 1) * 32 + (swz % 64) / 2; }
__host__ __device__ __forceinline__ int perm32(int rho) { const int n = rho >> 4, i = rho & 15; return 8 * (i >> 2) + 4 * n + (i & 3); }

struct Unit { const char* a; const char* b; int pm, pn; };
struct Gemm { int K, lda, ldb, amode; };

struct StaticOrder {
    const bf16_t* A; const bf16_t* Bt; int lda, ldb;
    int nM, nN, nwg, G, c; size_t tstepA;
    __device__ void init(const bf16_t* A_, const bf16_t* Bt_, int lda_, int ldb_, int M, int N, int G_, int c_) { A = A_; Bt = Bt_; lda = lda_; ldb = ldb_; nM = M / BM; nN = N / BM; nwg = nM * nN; G = G_; c = c_; tstepA = (size_t)BM * lda * 2; }
    __device__ bool next(int i, Unit& u) const {
        const long L = (long)i * G + c; if (L >= nwg) return false;
        int wgid = (int)L; { const int q = nwg / NXCD, r = nwg % NXCD, xcd = wgid % NXCD, off = wgid / NXCD; wgid = (xcd < r ? xcd * (q + 1) : r * (q + 1) + (xcd - r) * q) + off; }
        const int nig = WGM * nN, gid = wgid / nig, fm = gid * WGM, gsz = (nM - fm) < WGM ? (nM - fm) : WGM;
        u.pm = fm + ((wgid % nig) % gsz); u.pn = (wgid % nig) / gsz;
        u.a = (const char*)A + (size_t)u.pm * tstepA; u.b = (const char*)Bt + (size_t)u.pn * BM * ldb * 2; return true;
    }
};

template <class Epi, class Sched, bool ALIGN_EPI = false, bool SP2 = true>
__device__ __forceinline__ void gemm_phase(LAS unsigned char* lds, const Gemm g, const Sched& S, const Epi& E, const int tid) {
    const int wid = __builtin_amdgcn_readfirstlane(tid >> 6), lane = tid & 63, wr = wid >> 2, wc = wid & 3, fr = lane & 15, fq = lane >> 4;
    const int K = g.K, nt = K / BK;
    unsigned voffA[2], voffB[2];
#pragma unroll
    for (int i = 0; i < 2; ++i) { int R, C; stage_rc(tid * 16 + i * 8192, R, C); const int Rb = Epi::PERM ? ((R & ~31) + perm32(R & 31)) : R;
        voffA[i] = g.amode ? (unsigned)((((C >> 4) * S5ROWS + (R >> 4)) * 256 + (R & 15) * 16 + (C & 15)) * 2) : (unsigned)(R * g.lda + C) * 2u; voffB[i] = (unsigned)(Rb * g.ldb + C) * 2u; }
    const size_t kstepB = (size_t)(BK * 2), kstepA = g.amode ? (size_t)4 * S5ROWS * 256 * 2 : (size_t)(BK * 2);
    const size_t hstepA = g.amode ? (size_t)8 * 256 * 2 : (size_t)HALF * g.lda * 2, hstepB = (size_t)HALF * g.ldb * 2;
    const unsigned ldsw = (unsigned)wid * 1024u;
    const int aoff = lds_byte(wr * 64 + fr, fq * 8), boff = lds_byte(wc * 32 + fr, fq * 8);
#define PG8_SA(b, h) (((b) * 2 + (h)) * HTB)
#define PG8_SB(b, h) ((4 + (b) * 2 + (h)) * HTB)
#define PG8_STAGE(bufoff, gbase, voff) do { _Pragma("unroll") for (int _i = 0; _i < 2; ++_i) \
        __builtin_amdgcn_global_load_lds((const unsigned*)((const char*)(gbase) + (voff)[_i]), (LAS unsigned*)(lds + (bufoff) + ldsw + _i * 8192), 16, 0, 0); } while (0)
#define PG8_LDA(dst, b, h) do { _Pragma("unroll") for (int m = 0; m < 4; ++m) _Pragma("unroll") for (int k = 0; k < 2; ++k) dst[m][k] = *(const LAS bf16x8*)(lds + PG8_SA(b, h) + aoff + m * 2048 + k * 1024); } while (0)
#define PG8_LDB(dst, b, h) do { _Pragma("unroll") for (int n = 0; n < 2; ++n) _Pragma("unroll") for (int k = 0; k < 2; ++k) dst[n][k] = *(const LAS bf16x8*)(lds + PG8_SB(b, h) + boff + n * 2048 + k * 1024); } while (0)
#define PG8_MMA(ai, bj, At, Bt) do { __builtin_amdgcn_s_setprio(1); _Pragma("unroll") for (int m = 0; m < 4; ++m) _Pragma("unroll") for (int n = 0; n < 2; ++n) _Pragma("unroll") for (int k = 0; k < 2; ++k) \
        acc[ai][bj][m][n] = __builtin_amdgcn_mfma_f32_16x16x32_bf16(Bt[n][k], At[m][k], acc[ai][bj][m][n], 0, 0, 0); __builtin_amdgcn_s_setprio(0); } while (0)
#define PG8_WAIT_V(n) asm volatile("s_waitcnt vmcnt(" #n ")" ::: "memory")
#define PG8_WAIT_L(n) asm volatile("s_waitcnt lgkmcnt(" #n ")" ::: "memory")
#define PG8_BAR __builtin_amdgcn_s_barrier()
#define PG8_SCHED __builtin_amdgcn_sched_barrier(0)
    Unit cur, nxt; int ui = 0;
    if (!S.next(0, cur)) return;
    f32x4 acc[2][2][4][2];
#pragma unroll
    for (int a = 0; a < 2; ++a)
#pragma unroll
        for (int b = 0; b < 2; ++b)
#pragma unroll
            for (int m = 0; m < 4; ++m)
#pragma unroll
                for (int n = 0; n < 2; ++n) acc[a][b][m][n] = (f32x4){0.f, 0.f, 0.f, 0.f};
    bf16x8 At[4][2], B0[2][2], B1[2][2];
    const char* cA = cur.a; const char* cB = cur.b;
    static_assert(SP2, "only the SP2 loop is kept");
    PG8_STAGE(PG8_SB(0, 0), cB, voffB); PG8_STAGE(PG8_SB(0, 1), cB + hstepB, voffB); PG8_STAGE(PG8_SA(0, 0), cA, voffA); PG8_STAGE(PG8_SA(0, 1), cA + hstepA, voffA);
    if (wr == 1) PG8_BAR;
    PG8_WAIT_V(2); PG8_BAR;
    PG8_STAGE(PG8_SB(1, 0), cB + kstepB, voffB); PG8_STAGE(PG8_SA(1, 0), cA + kstepA, voffA); PG8_STAGE(PG8_SB(1, 1), cB + hstepB + kstepB, voffB);
    PG8_WAIT_V(6); PG8_BAR;
    for (;;) {
        const bool has_next = S.next(ui + 1, nxt);
        const char* nA = has_next ? nxt.a : cA; const char* nB = has_next ? nxt.b : cB;
#pragma unroll 1
        for (int t = 0; t < nt; t += 2) {
            if constexpr (Epi::HAS_MID) { if (t == E.mid_t) { E.mid(acc, cur, wr, wc, fr, fq); PG8_SCHED; } }
            const bool last = (t == nt - 2);
            const char* a1 = cA + (size_t)(t + 1) * kstepA;
            const char* a2 = last ? nA : cA + (size_t)(t + 2) * kstepA; const char* b2 = last ? nB : cB + (size_t)(t + 2) * kstepB;
            const char* a3 = a2 + kstepA; const char* b3 = b2 + kstepB;
            PG8_LDB(B0, 0, 0); PG8_LDB(B1, 0, 1); PG8_SCHED; PG8_LDA(At, 0, 0); PG8_STAGE(PG8_SA(1, 1), a1 + hstepA, voffA);
            PG8_WAIT_V(8); PG8_WAIT_L(0); PG8_BAR; PG8_MMA(0, 0, At, B0); PG8_MMA(0, 1, At, B1); PG8_BAR; PG8_SCHED;
            PG8_LDA(At, 0, 1); PG8_STAGE(PG8_SB(0, 0), b2, voffB); PG8_STAGE(PG8_SB(0, 1), b2 + hstepB, voffB); PG8_STAGE(PG8_SA(0, 0), a2, voffA);
            PG8_WAIT_V(8); PG8_WAIT_L(0); PG8_BAR; PG8_MMA(1, 0, At, B0); PG8_MMA(1, 1, At, B1); PG8_BAR; PG8_SCHED;
            PG8_LDB(B0, 1, 0); PG8_LDB(B1, 1, 1); PG8_SCHED; PG8_LDA(At, 1, 0); PG8_STAGE(PG8_SA(0, 1), a2 + hstepA, voffA);
            PG8_WAIT_V(8); PG8_WAIT_L(0); PG8_BAR; PG8_MMA(0, 0, At, B0); PG8_MMA(0, 1, At, B1); PG8_BAR; PG8_SCHED;
            PG8_LDA(At, 1, 1); PG8_STAGE(PG8_SB(1, 0), b3, voffB); PG8_STAGE(PG8_SB(1, 1), b3 + hstepB, voffB); PG8_STAGE(PG8_SA(1, 0), a3, voffA);
            PG8_WAIT_V(8); PG8_WAIT_L(0); PG8_BAR; PG8_MMA(1, 0, At, B0); PG8_MMA(1, 1, At, B1); PG8_BAR; PG8_SCHED;
        }
        if constexpr (ALIGN_EPI) { if (wr == 0) PG8_BAR; }
        E(acc, cur, wr, wc, fr, fq);
        if (!has_next) break;
#pragma unroll
        for (int a = 0; a < 2; ++a)
#pragma unroll
            for (int b = 0; b < 2; ++b)
#pragma unroll
                for (int m = 0; m < 4; ++m)
#pragma unroll
                    for (int n = 0; n < 2; ++n) acc[a][b][m][n] = (f32x4){0.f, 0.f, 0.f, 0.f};
        cur = nxt; cA = nA; cB = nB; ++ui;
        if constexpr (ALIGN_EPI) { if (wr == 1) PG8_BAR; }
    }
    PG8_WAIT_V(0);
    if constexpr (!ALIGN_EPI) { if (wr == 0) PG8_BAR; }
    PG8_BAR;
#undef PG8_SA
#undef PG8_SB
#undef PG8_STAGE
#undef PG8_LDA
#undef PG8_LDB
#undef PG8_MMA
#undef PG8_WAIT_V
#undef PG8_WAIT_L
#undef PG8_BAR
#undef PG8_SCHED
}

template <class F> struct EpiGen8 {
    static constexpr bool PERM = true, HAS_MID = false; F f; int mid_t;
    __device__ __forceinline__ void mid(f32x4 (&)[2][2][4][2], const Unit&, int, int, int, int) const {}
    __device__ __forceinline__ void operator()(const f32x4 (&acc)[2][2][4][2], const Unit& u, int wr, int wc, int fr, int fq) const {
#pragma unroll
        for (int ai = 0; ai < 2; ++ai)
#pragma unroll
            for (int m = 0; m < 4; ++m) { const int r = ai * HALF + wr * 64 + m * 16 + fr;
#pragma unroll
                for (int bj = 0; bj < 2; ++bj) f(u, r, bj * HALF + wc * 32 + 8 * fq, acc[ai][bj][m][0], acc[ai][bj][m][1]);
                if constexpr (F::PIN) __builtin_amdgcn_sched_barrier(0); }
    }
};
}

typedef const float* cfp_t;
typedef __attribute__((address_space(4))) const cfp_t* InTab;
struct Frame {
    LAS unsigned char* lds;
    volatile LAS unsigned* MISC;
    gu32* ctl;
    int tid, lane, wave, vcu, G;
    unsigned char* ws; unsigned char* dout; unsigned char* ws0; unsigned char* dout0;
    InTab in;
};
enum { I_X = 0, I_NMPRE, I_NMPOST, I_NFPRE, I_NFPOST, I_WIN, I_BGATE, I_MU, I_W0, I_W2, I_A0, I_A2, I_G2, I_KK, I_KA, I_RK, I_LNW, I_LNB,
       I_SARE, I_SAIM, I_SBRE, I_SBIM, I_SCRE, I_SCIM, I_SD, I_SLOG, I_WGLU, I_BGLU, I_WBR, I_WBS, I_WOUT, I_WUP, I_CONVW, I_CONVB, I_WDN };

__device__ __forceinline__ void p0_transpose_item(const float* W, int ldw, int k0, int src0, bf16_t* WT, int ldt, int drow0, int koff, const float* kscale, LAS float* scr, int lane) {
    const int q = lane & 7, rb = lane >> 3;
    f32x4 v[8]; float sc[8];
#pragma unroll
    for (int i = 0; i < 8; ++i) { const int kk = 8 * i + rb; v[i] = __builtin_nontemporal_load((const f32x4*)(W + (size_t)(k0 + kk) * ldw + src0 + 4 * q)); sc[i] = kscale ? kscale[k0 + kk] : 1.0f; }
#pragma unroll
    for (int i = 0; i < 8; ++i) { const int kk = 8 * i + rb; LAS float* d = scr + kk * 33 + 4 * q; d[0] = v[i].x * sc[i]; d[1] = v[i].y * sc[i]; d[2] = v[i].z * sc[i]; d[3] = v[i].w * sc[i]; }
    LDS_WAIT(); asm volatile("" ::: "memory");
    const int c = lane & 7;
#pragma unroll
    for (int j = 0; j < 4; ++j) { const int n = (lane >> 3) + 8 * j; const LAS float* s = scr + (8 * c) * 33 + n;
        u32x4 o; o.x = cvt_pk_bf16(s[0 * 33], s[1 * 33]); o.y = cvt_pk_bf16(s[2 * 33], s[3 * 33]); o.z = cvt_pk_bf16(s[4 * 33], s[5 * 33]); o.w = cvt_pk_bf16(s[6 * 33], s[7 * 33]);
        *(GAS u32x4*)(WT + (size_t)(drow0 + n) * ldt + koff + k0 + 8 * c) = o; }
    LDS_WAIT(); asm volatile("" ::: "memory");
}
struct TrMat { int in_idx, K, N, ldt, koff, kind; size_t dst; int scale_idx; };
__device__ __forceinline__ void p0_do_matrix(Frame& F, const TrMat& mtx, int r, LAS float* scr) {
    const int nblk = mtx.N / 32, kb = r / nblk, nb = r % nblk;
    int src0 = 32 * nb;
    if (mtx.kind == 1) {
        const int pn = (32 * nb) >> 8, within = (32 * nb) & 255;
        src0 = (within < 128 ? 0 : FF - 128) + 128 * pn + within;
    }
    p0_transpose_item(F.in[mtx.in_idx], mtx.N, 64 * kb, src0, (bf16_t*)(F.ws + mtx.dst), mtx.ldt, 32 * nb, mtx.koff, mtx.scale_idx >= 0 ? F.in[mtx.scale_idx] : nullptr, scr, F.lane);
}
__device__ __forceinline__ void p0_s5_group(Frame& F, int g) {
    LAS float* pwr = (LAS float*)(F.lds);
    LAS float* pwi = pwr + 17 * 64;
    LAS float* bbr = pwi + 17 * 64;
    LAS float* bbi = bbr + 1024;
    LAS float* cre = bbi + 1024;
    LAS float* cim = cre + 1024;
    LAS float* kk = cim + 1024;
    const float dt = expf(F.in[I_SLOG][g]);
    for (int idx = F.tid; idx < 17 * 64; idx += 512) { const int k = idx >> 6, p = idx & 63;
        const float are = F.in[I_SARE][g * 64 + p], aim = F.in[I_SAIM][g * 64 + p];
        const float mag = expf((float)k * are * dt); float sn, cs; sincosf((float)k * aim * dt, &sn, &cs);
        pwr[idx] = mag * cs; pwi[idx] = mag * sn; }
    for (int idx = F.tid; idx < 1024; idx += 512) { cre[idx] = F.in[I_SCRE][g * 1024 + idx]; cim[idx] = F.in[I_SCIM][g * 1024 + idx]; }
    __syncthreads();
    for (int idx = F.tid; idx < 1024; idx += 512) { const int p = idx >> 4;
        const float are = F.in[I_SARE][g * 64 + p], aim = F.in[I_SAIM][g * 64 + p];
        const float nr = pwr[64 + p] - 1.0f, ni = pwi[64 + p];
        const float den = 1.0f / (are * are + aim * aim);
        const float qr = (nr * are + ni * aim) * den, qi = (ni * are - nr * aim) * den;
        const float br = F.in[I_SBRE][g * 1024 + idx], bi = F.in[I_SBIM][g * 1024 + idx];
        bbr[idx] = qr * br - qi * bi; bbi[idx] = qr * bi + qi * br; }
    __syncthreads();
    {
        const int kc = F.tid & 255, ph = F.tid >> 8, k = kc >> 4, c = kc & 15; float s[16];
#pragma unroll
        for (int e = 0; e < 16; ++e) s[e] = 0.f;
        for (int p = 32 * ph; p < 32 * ph + 32; ++p) { const float cr_ = cre[c * 64 + p], ci_ = cim[c * 64 + p], pr_ = pwr[k * 64 + p], pi_ = pwi[k * 64 + p];
            const float xr = cr_ * pr_ - ci_ * pi_, xi = cr_ * pi_ + ci_ * pr_;
#pragma unroll
            for (int e4 = 0; e4 < 4; ++e4) { const f32x4 br = *(LAS const f32x4*)(bbr + p * 16 + 4 * e4), bi = *(LAS const f32x4*)(bbi + p * 16 + 4 * e4);
#pragma unroll
                for (int e = 0; e < 4; ++e) s[4 * e4 + e] += xr * br[e] - xi * bi[e]; } }
        LAS float* part = kk + 4096;
        if (ph == 1) {
#pragma unroll
            for (int e4 = 0; e4 < 4; ++e4) *(LAS f32x4*)(part + kc * 16 + 4 * e4) = (f32x4){s[4 * e4], s[4 * e4 + 1], s[4 * e4 + 2], s[4 * e4 + 3]}; }
        __syncthreads();
        if (ph == 0) {
#pragma unroll
            for (int e4 = 0; e4 < 4; ++e4) { const f32x4 o = *(LAS const f32x4*)(part + kc * 16 + 4 * e4);
#pragma unroll
                for (int e = 0; e < 4; ++e) { float v = s[4 * e4 + e] + o[e]; if (k == 0 && c == 4 * e4 + e) v += F.in[I_SD][g * 16 + c]; kk[kc * 16 + 4 * e4 + e] = v; } } }
    }
    __syncthreads();
    bf16_t* B1b = (bf16_t*)(F.ws + WS_B1B) + (size_t)g * 256 * 384;
    for (int idx = F.tid; idx < 256 * 48; idx += 512) { const int n = idx / 48, j = idx - n * 48, t = n >> 4, c = n & 15; float v[8];
        if (j < 32) { const int tau = j >> 1, cp0 = (j & 1) * 8; const int ko = (t >= tau ? t - tau : 0) * 256 + c * 16 + cp0; const float m = (t >= tau) ? 1.f : 0.f;
            const f32x4 a0 = *(LAS const f32x4*)(kk + ko), a1 = *(LAS const f32x4*)(kk + ko + 4);
#pragma unroll
            for (int e = 0; e < 4; ++e) { v[e] = a0[e] * m; v[4 + e] = a1[e] * m; } }
        else { const int p0 = (j - 32) * 4; const f32x4 cr4 = *(LAS const f32x4*)(cre + c * 64 + p0), ci4 = *(LAS const f32x4*)(cim + c * 64 + p0), pr4 = *(LAS const f32x4*)(pwr + (t + 1) * 64 + p0), pi4 = *(LAS const f32x4*)(pwi + (t + 1) * 64 + p0);
#pragma unroll
            for (int q = 0; q < 4; ++q) { v[2 * q] = cr4[q] * pr4[q] - ci4[q] * pi4[q]; v[2 * q + 1] = -(cr4[q] * pi4[q] + ci4[q] * pr4[q]); } }
        *(u32x4*)(B1b + (size_t)n * 384 + 8 * j) = pack8(v); }
    bf16_t* B1a = (bf16_t*)(F.ws + WS_B1A) + (size_t)g * 256 * 256;
    for (int idx = F.tid; idx < 256 * 32; idx += 512) { const int n = idx >> 5, j = idx & 31; float v[8];
#pragma unroll
        for (int e = 0; e < 8; ++e) v[e] = 0.f;
        if (n < 128) { const int p = n >> 1, tau = j >> 1, cp0 = (j & 1) * 8; const float pr_ = pwr[(15 - tau) * 64 + p], pi_ = pwi[(15 - tau) * 64 + p];
            const f32x4 r0 = *(LAS const f32x4*)(bbr + p * 16 + cp0), r1 = *(LAS const f32x4*)(bbr + p * 16 + cp0 + 4), i0 = *(LAS const f32x4*)(bbi + p * 16 + cp0), i1 = *(LAS const f32x4*)(bbi + p * 16 + cp0 + 4);
#pragma unroll
            for (int e = 0; e < 8; ++e) { const float br = e < 4 ? r0[e & 3] : r1[e & 3], bi = e < 4 ? i0[e & 3] : i1[e & 3]; v[e] = (n & 1) ? (pr_ * bi + pi_ * br) : (pr_ * br - pi_ * bi); } }
        *(u32x4*)(B1a + (size_t)n * 256 + 8 * j) = pack8(v); }
    float* aL = (float*)(F.ws + WS_AL) + g * 128;
    if (F.tid < 64) { aL[2 * F.tid] = pwr[16 * 64 + F.tid]; aL[2 * F.tid + 1] = pwi[16 * 64 + F.tid]; }
    __syncthreads();
}
#define DO_MAT(in_idx, K_, N_, ldt_, koff_, kind_, dst_, sc_) do { const TrMat mtx{in_idx, K_, N_, ldt_, koff_, kind_, dst_, sc_}; const int items = ((K_) / 64) * ((N_) / 32); \
        for (int it = gw; it < base + items; it += NGW) { if (it >= base) p0_do_matrix(F, mtx, it - base, scr); } base += items; } while (0)
__device__ __forceinline__ void p0_late_mats(Frame& F, int gw, int NGW) {
    LAS float* scr = (LAS float*)(F.lds + F.wave * 16384);
    int base = 0;
    DO_MAT(I_WUP, D, 2 * FF, D, 0, 1, WS_WUP, I_NFPRE); DO_MAT(I_WDN, FF, D, FF, 0, 0, WS_WDN, -1); DO_MAT(I_WOUT, D, D, D, 0, 0, WS_WOUT, -1);
    DO_MAT(I_WBR, RW, D, D, 0, 0, WS_WBRS, -1); DO_MAT(I_WBS, RW, D, D, RW, 0, WS_WBRS, -1); DO_MAT(I_WGLU, RW, RW, RW, 0, 0, WS_WGLU, -1);
}
__device__ __forceinline__ void p0_prologue(Frame& F) {
    const bool s5wg = F.vcu < S5G && F.G > S5G;
    if (F.vcu < S5G) p0_s5_group(F, F.vcu);
    if (!s5wg) {
        LAS float* scr = (LAS float*)(F.lds + F.wave * 16384);
        const int gw = (F.G > S5G ? F.vcu - S5G : F.vcu) * NWAVES + F.wave, NGW = (F.G > S5G ? F.G - S5G : F.G) * NWAVES;
        int base = 0;
        DO_MAT(I_WIN, D, NIN, D, 0, 0, WS_WIN, I_NMPRE);
        DO_MAT(I_W2, 64, RW, 64, 0, 0, WS_W2T, -1); DO_MAT(I_A2, 64, RW, 64, 0, 0, WS_A2T, -1); DO_MAT(I_G2, 128, RW, 128, 0, 0, WS_G2T, -1);
    }
    {
        bf16_t* XN = (bf16_t*)(F.ws + WS_XN);
        const int nch = T / 4, split = (F.G > S5G) ? nch / 2 : 0;
#pragma unroll 1
        for (int pass = 0; pass < 2; ++pass) {
            if (pass == 0 && (s5wg || split == 0)) continue;
            const int lo = pass == 0 ? 0 : split, hi = pass == 0 ? split : nch;
            const int gw = (pass == 0 ? F.vcu - S5G : F.vcu) * NWAVES + F.wave, NGW = (pass == 0 ? F.G - S5G : F.G) * NWAVES;
#pragma unroll 1
            for (int ch = lo + gw; ch < hi; ch += NGW) {
                const int m = 4 * ch;
                f32x4 v[4][4]; float s[4];
#pragma unroll
                for (int q = 0; q < 4; ++q) { const GAS f32x4* xr = (const GAS f32x4*)(F.in[I_X] + (size_t)(m + q) * D) + F.lane;
#pragma unroll
                    for (int j = 0; j < 4; ++j) v[q][j] = __builtin_nontemporal_load((const f32x4*)(xr + 64 * j)); }
#pragma unroll
                for (int q = 0; q < 4; ++q) { s[q] = 0.f;
#pragma unroll
                    for (int j = 0; j < 4; ++j) s[q] += (v[q][j].x * v[q][j].x + v[q][j].y * v[q][j].y) + (v[q][j].z * v[q][j].z + v[q][j].w * v[q][j].w); }
#pragma unroll
                for (int q = 0; q < 4; ++q) { const float r = 1.0f / sqrtf(wave_sum(s[q]) * (1.f / D) + 1e-6f);
                    GAS u32x2* o = (GAS u32x2*)(XN + (size_t)(m + q) * D) + F.lane;
#pragma unroll
                    for (int j = 0; j < 4; ++j) { u32x2 w; w.x = cvt_pk_bf16(v[q][j].x * r, v[q][j].y * r); w.y = cvt_pk_bf16(v[q][j].z * r, v[q][j].w * r); o[64 * j] = w; } }
            }
        }
    }
}

struct EpiInProj {
    static constexpr bool PERM = true, HAS_MID = false;
    bf16_t* PR; bf16_t* UG; bf16_t* GT; const float* bg; int mid_t;
    __device__ __forceinline__ void mid(f32x4 (&)[2][2][4][2], const pg8::Unit&, int, int, int, int) const {}
    __device__ __forceinline__ void operator()(const f32x4 (&acc)[2][2][4][2], const pg8::Unit& u, int wr, int wc, int fr, int fq) const {
        f32x4 b0[2], b1[2];
        if (u.pn >= 9) {
#pragma unroll
            for (int bj = 0; bj < 2; ++bj) { const int gc = (u.pn - 9) * 256 + bj * 128 + wc * 32 + 8 * fq; b0[bj] = *(const f32x4*)(bg + gc); b1[bj] = *(const f32x4*)(bg + gc + 4); } }
#pragma unroll
        for (int ai = 0; ai < 2; ++ai)
#pragma unroll
            for (int m = 0; m < 4; ++m) { const int row = u.pm * 256 + ai * 128 + wr * 64 + m * 16 + fr;
#pragma unroll
                for (int bj = 0; bj < 2; ++bj) { const int cl = bj * 128 + wc * 32 + 8 * fq; const f32x4 v0 = acc[ai][bj][m][0], v1 = acc[ai][bj][m][1]; u32x4 w;
                    if (u.pn < 7) { w.x = cvt_pk_bf16(v0[0], v0[1]); w.y = cvt_pk_bf16(v0[2], v0[3]); w.z = cvt_pk_bf16(v1[0], v1[1]); w.w = cvt_pk_bf16(v1[2], v1[3]);
                        *(u32x4*)(PR + (size_t)row * NRW + u.pn * 256 + cl) = w; }
                    else if (u.pn < 9) { const int cr = (u.pn - 7) * 256 + cl, g = cr >> 4, c0 = cr & 15;
                        w.x = cvt_pk_bf16(v0[0], v0[1]); w.y = cvt_pk_bf16(v0[2], v0[3]); w.z = cvt_pk_bf16(v1[0], v1[1]); w.w = cvt_pk_bf16(v1[2], v1[3]);
                        *(u32x4*)(UG + ((size_t)g * S5ROWS + (row >> 4)) * UGLD + (row & 15) * 16 + c0) = w; }
                    else { const int gc = (u.pn - 9) * 256 + cl;
                        w.x = cvt_pk_bf16(fsigmoid(v0[0] + b0[bj][0]), fsigmoid(v0[1] + b0[bj][1])); w.y = cvt_pk_bf16(fsigmoid(v0[2] + b0[bj][2]), fsigmoid(v0[3] + b0[bj][3]));
                        w.z = cvt_pk_bf16(fsigmoid(v1[0] + b1[bj][0]), fsigmoid(v1[1] + b1[bj][1])); w.w = cvt_pk_bf16(fsigmoid(v1[2] + b1[bj][2]), fsigmoid(v1[3] + b1[bj][3]));
                        __builtin_nontemporal_store(w, (u32x4*)(GT + ((size_t)(u.pm * 8 + (u.pn - 9)) << 16) + (((wr * 4 + wc) * 16 + (ai * 4 + m) * 2 + bj) << 9) + (fq * 16 + fr) * 8)); } }
                __builtin_amdgcn_sched_barrier(0); }
    }
};
struct FS5Out {
    static constexpr bool PIN = true;
    bf16_t* YSP;
    __device__ __forceinline__ void operator()(const pg8::Unit& u, int r, int cl, f32x4 v0, f32x4 v1) const {
        const int crow = u.pm * 256 + r; u32x4 w;
        w.x = cvt_pk_bf16(fgelu(v0[0]), fgelu(v0[1])); w.y = cvt_pk_bf16(fgelu(v0[2]), fgelu(v0[3])); w.z = cvt_pk_bf16(fgelu(v1[0]), fgelu(v1[1])); w.w = cvt_pk_bf16(fgelu(v1[2]), fgelu(v1[3]));
        *(u32x4*)(YSP + ((size_t)u.pn * S5ROWS + crow) * 256 + cl) = w;
    }
};
struct EpiGlu {
    static constexpr bool PERM = true, HAS_MID = false;
    const bf16_t* YSP; bf16_t* YS; const float* bglu; int mid_t;
    __device__ __forceinline__ void mid(f32x4 (&)[2][2][4][2], const pg8::Unit&, int, int, int, int) const {}
    __device__ __forceinline__ void operator()(const f32x4 (&acc)[2][2][4][2], const pg8::Unit& u, int wr, int wc, int fr, int fq) const {
        u32x4 yv[2][4][2]; f32x4 b0[2], b1[2];
#pragma unroll
        for (int bj = 0; bj < 2; ++bj) { const int col = u.pn * 256 + bj * 128 + wc * 32 + 8 * fq; b0[bj] = *(const f32x4*)(bglu + col); b1[bj] = *(const f32x4*)(bglu + col + 4); }
#pragma unroll
        for (int ai = 0; ai < 2; ++ai)
#pragma unroll
            for (int m = 0; m < 4; ++m)
#pragma unroll
                for (int bj = 0; bj < 2; ++bj) { const int row = u.pm * 256 + ai * 128 + wr * 64 + m * 16 + fr, col = u.pn * 256 + bj * 128 + wc * 32 + 8 * fq;
                    yv[ai][m][bj] = __builtin_nontemporal_load((const u32x4*)(YSP + ((size_t)(col >> 4) * S5ROWS + (row >> 4)) * 256 + (row & 15) * 16 + (col & 15))); }
#pragma unroll
        for (int ai = 0; ai < 2; ++ai)
#pragma unroll
            for (int m = 0; m < 4; ++m) {
#pragma unroll
                for (int bj = 0; bj < 2; ++bj) { const int row = u.pm * 256 + ai * 128 + wr * 64 + m * 16 + fr, col = u.pn * 256 + bj * 128 + wc * 32 + 8 * fq; float y[8]; unpack8(yv[ai][m][bj], y);
                    const f32x4 v0 = acc[ai][bj][m][0], v1 = acc[ai][bj][m][1]; u32x4 w;
                    w.x = cvt_pk_bf16(y[0] * fsigmoid(v0[0] + b0[bj][0]), y[1] * fsigmoid(v0[1] + b0[bj][1])); w.y = cvt_pk_bf16(y[2] * fsigmoid(v0[2] + b0[bj][2]), y[3] * fsigmoid(v0[3] + b0[bj][3]));
                    w.z = cvt_pk_bf16(y[4] * fsigmoid(v1[0] + b1[bj][0]), y[5] * fsigmoid(v1[1] + b1[bj][1])); w.w = cvt_pk_bf16(y[6] * fsigmoid(v1[2] + b1[bj][2]), y[7] * fsigmoid(v1[3] + b1[bj][3]));
                    *(u32x4*)(YS + (size_t)row * D + RW + col) = w; }
                __builtin_amdgcn_sched_barrier(0); }
    }
};
struct FStore {
    static constexpr bool PIN = false;
    bf16_t* O; int ldc;
    __device__ __forceinline__ void operator()(const pg8::Unit& u, int r, int cl, f32x4 v0, f32x4 v1) const {
        u32x4 w; w.x = cvt_pk_bf16(v0[0], v0[1]); w.y = cvt_pk_bf16(v0[2], v0[3]); w.z = cvt_pk_bf16(v1[0], v1[1]); w.w = cvt_pk_bf16(v1[2], v1[3]);
        *(u32x4*)(O + (size_t)(u.pm * 256 + r) * ldc + u.pn * 256 + cl) = w;
    }
};
struct EpiMerge {
    static constexpr bool PERM = true, HAS_MID = true;
    const bf16_t* GT; bf16_t* O; int mid_t;
    __device__ __forceinline__ void mid(f32x4 (&acc)[2][2][4][2], const pg8::Unit& u, int wr, int wc, int fr, int fq) const {
        unsigned vo = (unsigned)((((wr * 4 + wc) * 16) << 9) + (fq * 16 + fr) * 8) * 2u; asm volatile("" : "+v"(vo));
        const char* gr = (const char*)(GT + ((size_t)(u.pm * 8 + u.pn) << 16)); const char* gs = (const char*)(GT + ((size_t)(u.pm * 8 + 4 + u.pn) << 16));
#pragma unroll
        for (int ai = 0; ai < 2; ++ai)
#pragma unroll
            for (int m = 0; m < 4; ++m) {
                u32x4 a[2], b[2];
#pragma unroll
                for (int bj = 0; bj < 2; ++bj) { const unsigned go = vo + (unsigned)((((ai * 4 + m) * 2 + bj) << 9) * 2); a[bj] = __builtin_nontemporal_load((const u32x4*)(gr + go)); b[bj] = __builtin_nontemporal_load((const u32x4*)(gs + go)); }
                __builtin_amdgcn_sched_barrier(0);
#pragma unroll
                for (int bj = 0; bj < 2; ++bj) {
                    const unsigned aw[4] = {a[bj].x, a[bj].y, a[bj].z, a[bj].w}, bw[4] = {b[bj].x, b[bj].y, b[bj].z, b[bj].w};
#pragma unroll
                    for (int h = 0; h < 4; ++h) {
                        acc[ai][bj][m][h >> 1][2 * (h & 1)] *= bf_lo(aw[h]) * __builtin_amdgcn_rcpf(bf_lo(bw[h]));
                        acc[ai][bj][m][h >> 1][2 * (h & 1) + 1] *= bf_hi(aw[h]) * __builtin_amdgcn_rcpf(bf_hi(bw[h])); } }
                __builtin_amdgcn_sched_barrier(0);
            }
    }
    __device__ __forceinline__ void operator()(const f32x4 (&acc)[2][2][4][2], const pg8::Unit& u, int wr, int wc, int fr, int fq) const {
        const size_t lo = ((size_t)((wr * 4 + wc) * 16) << 9) + (fq * 16 + fr) * 8;
        const bf16_t* gs = GT + ((size_t)(u.pm * 8 + 4 + u.pn) << 16) + lo;
        u32x4 gv[2][4][2];
#pragma unroll
        for (int ai = 0; ai < 2; ++ai)
#pragma unroll
            for (int m = 0; m < 4; ++m)
#pragma unroll
                for (int bj = 0; bj < 2; ++bj) gv[ai][m][bj] = __builtin_nontemporal_load((const u32x4*)(gs + (((ai * 4 + m) * 2 + bj) << 9)));
#pragma unroll
        for (int ai = 0; ai < 2; ++ai)
#pragma unroll
            for (int m = 0; m < 4; ++m) {
#pragma unroll
                for (int bj = 0; bj < 2; ++bj) { const int row = u.pm * 256 + ai * 128 + wr * 64 + m * 16 + fr, col = u.pn * 256 + bj * 128 + wc * 32 + 8 * fq; float g[8]; unpack8(gv[ai][m][bj], g);
                    const f32x4 v0 = acc[ai][bj][m][0], v1 = acc[ai][bj][m][1]; u32x4 w;
                    w.x = cvt_pk_bf16(v0[0] * g[0], v0[1] * g[1]); w.y = cvt_pk_bf16(v0[2] * g[2], v0[3] * g[3]); w.z = cvt_pk_bf16(v1[0] * g[4], v1[1] * g[5]); w.w = cvt_pk_bf16(v1[2] * g[6], v1[3] * g[7]);
                    *(u32x4*)(O + (size_t)row * D + col) = w; }
                __builtin_amdgcn_sched_barrier(0); }
    }
};
struct UpOrder {
    const bf16_t* H2; const bf16_t* Wt; int G, c;
    __device__ bool next(int i, pg8::Unit& u) const {
        constexpr int nM = NB * 16, nN = 22, nwg = nM * nN;
        const long L = (long)i * G + c; if (L >= nwg) return false;
        int wgid = (int)L; { const int q = nwg / 8, r = nwg % 8, xcd = wgid % 8, off = wgid / 8; wgid = (xcd < r ? xcd * (q + 1) : r * (q + 1) + (xcd - r) * q) + off; }
        const int nig = 8 * nN, gid = wgid / nig, fm = gid * 8, gsz = (nM - fm) < 8 ? (nM - fm) : 8;
        u.pm = fm + ((wgid % nig) % gsz); u.pn = (wgid % nig) / gsz;
        u.a = (const char*)H2 + ((size_t)u.pm * 256 * D) * 2; u.b = (const char*)(Wt + (size_t)u.pn * 256 * D); return true;
    }
};
template <int CTRL> __device__ __forceinline__ unsigned dppu(unsigned v) { return (unsigned)__builtin_amdgcn_update_dpp(0, (int)v, CTRL, 0xf, 0xf, true); }
struct EpiConvAct {
    static constexpr bool PERM = true, HAS_MID = false;
    bf16_t* ACT; const float* cw; const float* cb; LAS unsigned* EX; unsigned long long* HZ; unsigned* tmo; int mid_t;
    __device__ __forceinline__ void mid(f32x4 (&)[2][2][4][2], const pg8::Unit&, int, int, int, int) const {}
    __device__ __forceinline__ void operator()(f32x4 (&acc)[2][2][4][2], const pg8::Unit& u, int wr, int wc, int fr, int fq) const {
        const int b = u.pm >> 4, k = u.pm & 15, t0 = 256 * k;
        u32x2 zp[2][2][4][2];
#pragma unroll
        for (int ai = 0; ai < 2; ++ai)
#pragma unroll
            for (int bj = 0; bj < 2; ++bj)
#pragma unroll
                for (int m = 0; m < 4; ++m)
#pragma unroll
                    for (int n = 0; n < 2; ++n) { const f32x4 v = acc[ai][bj][m][n]; u32x2 w; w.x = cvt_pk_bf16(v[0], v[1]); w.y = cvt_pk_bf16(v[2], v[3]); zp[ai][bj][m][n] = w; }
        if (fr >= 14) {
#pragma unroll
            for (int ai = 0; ai < 2; ++ai)
#pragma unroll
                for (int bj = 0; bj < 2; ++bj)
#pragma unroll
                    for (int n = 0; n < 2; ++n) *(LAS u32x2*)(EX + (((wc * 4 + 2 * ai + wr) * 2 + (fr - 14)) * 32 + bj * 16 + fq * 4 + n * 2)) = zp[ai][bj][3][n]; }
        if (wr == 1 && k < 15 && fr >= 14) {
            unsigned long long* hz = HZ + ((size_t)(u.pm * 22 + u.pn) * 8 + wc * 2 + (fr - 14)) * 32;
#pragma unroll
            for (int bj = 0; bj < 2; ++bj)
#pragma unroll
                for (int n = 0; n < 2; ++n) { __hip_atomic_store(hz + bj * 16 + fq * 4 + n * 2, (1ull << 32) | zp[1][bj][3][n].x, RLX_AGENT); __hip_atomic_store(hz + bj * 16 + fq * 4 + n * 2 + 1, (1ull << 32) | zp[1][bj][3][n].y, RLX_AGENT); }
        }
        asm volatile("s_waitcnt lgkmcnt(0)" ::: "memory"); __builtin_amdgcn_s_barrier(); asm volatile("" ::: "memory");
        const int ch0 = u.pn * 128 + wc * 32 + 8 * fq;
        f32x4 wg[2][3], wv[2][3], bg[2], bv[2];
#pragma unroll
        for (int n = 0; n < 2; ++n) {
#pragma unroll
            for (int j = 0; j < 3; ++j) { wg[n][j] = *(const f32x4*)(cw + (size_t)j * 2 * FF + ch0 + 4 * n); wv[n][j] = *(const f32x4*)(cw + (size_t)j * 2 * FF + FF + ch0 + 4 * n); }
            bg[n] = *(const f32x4*)(cb + ch0 + 4 * n); bv[n] = *(const f32x4*)(cb + FF + ch0 + 4 * n); }
#pragma unroll
        for (int gi = 1; gi <= 8; ++gi) {
            const int ai = (gi & 7) >> 2, m = gi & 3, blk = 2 * ai + wr;
            u32x2 pp[2][2];
#pragma unroll
            for (int bj = 0; bj < 2; ++bj)
#pragma unroll
                for (int n = 0; n < 2; ++n) { pp[bj][n].x = 0u; pp[bj][n].y = 0u; }
            if (m > 0) {
#pragma unroll
                for (int bj = 0; bj < 2; ++bj)
#pragma unroll
                    for (int n = 0; n < 2; ++n) pp[bj][n] = zp[ai][bj][m - 1][n];
            } else if (blk > 0) {
                if (fr >= 14) {
#pragma unroll
                    for (int bj = 0; bj < 2; ++bj)
#pragma unroll
                        for (int n = 0; n < 2; ++n) pp[bj][n] = *(LAS const u32x2*)(EX + (((wc * 4 + blk - 1) * 2 + (fr - 14)) * 32 + bj * 16 + fq * 4 + n * 2)); }
            } else if (k > 0) {
                if (fr >= 14) {
                    const unsigned long long* hz = HZ + ((size_t)((u.pm - 1) * 22 + u.pn) * 8 + wc * 2 + (fr - 14)) * 32;
#pragma unroll
                    for (int bj = 0; bj < 2; ++bj)
#pragma unroll
                        for (int n = 0; n < 2; ++n) { unsigned long long x0, x1; unsigned sp_ = 0;
                            for (;;) { x0 = __hip_atomic_load(hz + bj * 16 + fq * 4 + n * 2, RLX_AGENT); x1 = __hip_atomic_load(hz + bj * 16 + fq * 4 + n * 2 + 1, RLX_AGENT);
                                if ((x0 >> 32) == 1ull && (x1 >> 32) == 1ull) break; __builtin_amdgcn_s_sleep(2); if (++sp_ > (1u << 20)) { __hip_atomic_store(tmo, 1u, RLX_AGENT); break; } }
                            pp[bj][n].x = (unsigned)x0; pp[bj][n].y = (unsigned)x1; } }
            }
            u32x2 outp[2];
#pragma unroll
            for (int n = 0; n < 2; ++n) {
                const u32x2 zg = zp[ai][0][m][n], zv = zp[ai][1][m][n], pg = pp[0][n], pv = pp[1][n];
                u32x2 g1, g2, v1, v2;
                g1.x = dppu<0x111>(zg.x) | dppu<0x10F>(pg.x); g1.y = dppu<0x111>(zg.y) | dppu<0x10F>(pg.y); g2.x = dppu<0x112>(zg.x) | dppu<0x10E>(pg.x); g2.y = dppu<0x112>(zg.y) | dppu<0x10E>(pg.y);
                v1.x = dppu<0x111>(zv.x) | dppu<0x10F>(pv.x); v1.y = dppu<0x111>(zv.y) | dppu<0x10F>(pv.y); v2.x = dppu<0x112>(zv.x) | dppu<0x10E>(pv.x); v2.y = dppu<0x112>(zv.y) | dppu<0x10E>(pv.y);
                const float z0g[4] = {bf_lo(zg.x), bf_hi(zg.x), bf_lo(zg.y), bf_hi(zg.y)}, z1g[4] = {bf_lo(g1.x), bf_hi(g1.x), bf_lo(g1.y), bf_hi(g1.y)}, z2g[4] = {bf_lo(g2.x), bf_hi(g2.x), bf_lo(g2.y), bf_hi(g2.y)};
                const float z0v[4] = {bf_lo(zv.x), bf_hi(zv.x), bf_lo(zv.y), bf_hi(zv.y)}, z1v[4] = {bf_lo(v1.x), bf_hi(v1.x), bf_lo(v1.y), bf_hi(v1.y)}, z2v[4] = {bf_lo(v2.x), bf_hi(v2.x), bf_lo(v2.y), bf_hi(v2.y)};
                float o[4];
#pragma unroll
                for (int e = 0; e < 4; ++e) { const float cg = bg[n][e] + wg[n][0][e] * z2g[e] + wg[n][1][e] * z1g[e] + wg[n][2][e] * z0g[e], cv = bv[n][e] + wv[n][0][e] * z2v[e] + wv[n][1][e] * z1v[e] + wv[n][2][e] * z0v[e];
                    o[e] = fgelu(cg) * cv; }
                outp[n].x = cvt_pk_bf16(o[0], o[1]); outp[n].y = cvt_pk_bf16(o[2], o[3]);
            }
            const int r = 128 * ai + 64 * wr + 16 * m + fr;
            { u32x4 w4; w4.x = outp[0].x; w4.y = outp[0].y; w4.z = outp[1].x; w4.w = outp[1].y; *(u32x4*)(ACT + ((size_t)(b * SEQ + t0 + r)) * FF + ch0) = w4; }
            __builtin_amdgcn_sched_barrier(0);
        }
    }
};
struct EpiRowStat {
    static constexpr bool PERM = true, HAS_MID = false; bf16_t* O; float* STAT; int mid_t;
    __device__ __forceinline__ void mid(f32x4 (&)[2][2][4][2], const pg8::Unit&, int, int, int, int) const {}
    __device__ __forceinline__ void operator()(const f32x4 (&acc)[2][2][4][2], const pg8::Unit& u, int wr, int wc, int fr, int fq) const {
#pragma unroll
        for (int ai = 0; ai < 2; ++ai)
#pragma unroll
            for (int m = 0; m < 4; ++m) { const int row = u.pm * 256 + ai * 128 + wr * 64 + m * 16 + fr; float s = 0.f;
#pragma unroll
                for (int bj = 0; bj < 2; ++bj) { const int col = u.pn * 256 + bj * 128 + wc * 32 + 8 * fq; const f32x4 v0 = acc[ai][bj][m][0], v1 = acc[ai][bj][m][1]; u32x4 w;
                    s += (v0[0] * v0[0] + v0[1] * v0[1]) + (v0[2] * v0[2] + v0[3] * v0[3]) + (v1[0] * v1[0] + v1[1] * v1[1]) + (v1[2] * v1[2] + v1[3] * v1[3]);
                    w.x = cvt_pk_bf16(v0[0], v0[1]); w.y = cvt_pk_bf16(v0[2], v0[3]); w.z = cvt_pk_bf16(v1[0], v1[1]); w.w = cvt_pk_bf16(v1[2], v1[3]);
                    __builtin_nontemporal_store(w, (u32x4*)(O + (size_t)row * D + col)); }
                s += __shfl_xor(s, 16); s += __shfl_xor(s, 32);
                if (fq == 0) STAT[(size_t)row * 16 + u.pn * 4 + wc] = s; }
    }
};
struct EpiSloc {
    static constexpr bool PERM = false, HAS_MID = false; float* SL; int mid_t;
    __device__ __forceinline__ void mid(f32x4 (&)[2][2][4][2], const pg8::Unit&, int, int, int, int) const {}
    __device__ __forceinline__ void operator()(const f32x4 (&acc)[2][2][4][2], const pg8::Unit& u, int wr, int wc, int fr, int fq) const {
#pragma unroll
        for (int ai = 0; ai < 2; ++ai)
#pragma unroll
            for (int m = 0; m < 4; ++m) { const int row = u.pm * 256 + ai * 128 + wr * 64 + m * 16 + fr; float* p = SL + ((size_t)u.pn * S5ROWS + row) * 128 + wc * 32 + 4 * fq;
                *(f32x4*)(p) = acc[ai][0][m][0]; *(f32x4*)(p + 16) = acc[ai][0][m][1]; }
    }
};
struct S5Order {
    const bf16_t* UG; const bf16_t* Bt; int ldb, G, c;
    __device__ bool next(int i, pg8::Unit& u) const { const int L = i * G + c; if (L >= S5G * 8) return false; const int g = L >> 3; u.pm = L & 7; u.pn = g;
        u.a = (const char*)(UG + ((size_t)g * S5ROWS + u.pm * 256) * UGLD); u.b = (const char*)(Bt + (size_t)g * 256 * ldb); return true; }
};

constexpr int LW = 72;
constexpr int SLOT = 64 * LW * 2;
#define SL(i) ((i) * SLOT)
#define BAR_LDS() do { asm volatile("s_waitcnt lgkmcnt(0)" ::: "memory"); __builtin_amdgcn_s_barrier(); asm volatile("" ::: "memory"); } while (0)
struct LdsMat { LAS const unsigned char* p; int ld; __device__ __forceinline__ bf16x8 frag(int row, int k) const { return *(LAS const bf16x8*)(p + ((size_t)row * ld + k) * 2); } };
struct GlbMat { const bf16_t* p; int ld; __device__ __forceinline__ bf16x8 frag(int row, int k) const { return *(const bf16x8*)(p + (size_t)row * ld + k); } };
template <int KD, class YM, class XM, class EPI>
__device__ __forceinline__ void mm64(const YM& Y, const XM& X, int wid, int lane, const EPI& epi) {
    asm volatile("" : "+v"(lane), "+s"(wid));
    const int at = wid >> 1, bt0 = (wid & 1) * 2, fr = lane & 15, fq = lane >> 4;
    f32x4 acc[2] = {(f32x4){0.f, 0.f, 0.f, 0.f}, (f32x4){0.f, 0.f, 0.f, 0.f}};
#pragma unroll
    for (int s = 0; s < KD / 32; ++s) {
        const bf16x8 yf = Y.frag(16 * at + fr, 32 * s + 8 * fq);
#pragma unroll
        for (int bi = 0; bi < 2; ++bi) { const bf16x8 xf = X.frag(16 * (bt0 + bi) + fr, 32 * s + 8 * fq);
            acc[bi] = __builtin_amdgcn_mfma_f32_16x16x32_bf16(xf, yf, acc[bi], 0, 0, 0); }
    }
#pragma unroll
    for (int bi = 0; bi < 2; ++bi) epi(16 * at + fr, 16 * (bt0 + bi) + 4 * fq, acc[bi]);
}
__device__ __forceinline__ void ld_yf(const LdsMat& Y, int at, int fr, int fq, bf16x8 (&y)[2]) {
#pragma unroll
    for (int s = 0; s < 2; ++s) y[s] = Y.frag(16 * at + fr, 32 * s + 8 * fq);
}
__device__ __forceinline__ void ld_xf(const LdsMat& X, int bt0, int fr, int fq, bf16x8 (&x)[2][2]) {
#pragma unroll
    for (int s = 0; s < 2; ++s)
#pragma unroll
        for (int bi = 0; bi < 2; ++bi) x[s][bi] = X.frag(16 * (bt0 + bi) + fr, 32 * s + 8 * fq);
}
__device__ __forceinline__ void mm_f(const bf16x8 (&y)[2], const bf16x8 (&x)[2][2], f32x4 (&acc)[2]) {
#pragma unroll
    for (int bi = 0; bi < 2; ++bi) acc[bi] = (f32x4){0.f, 0.f, 0.f, 0.f};
#pragma unroll
    for (int s = 0; s < 2; ++s)
#pragma unroll
        for (int bi = 0; bi < 2; ++bi) acc[bi] = __builtin_amdgcn_mfma_f32_16x16x32_bf16(x[s][bi], y[s], acc[bi], 0, 0, 0);
}
template <int KD>
__device__ __forceinline__ void preload_x(const GlbMat& X, int wid, int lane, bf16x8 (&xf)[KD / 32][2]) {
    const int bt0 = (wid & 1) * 2, fr = lane & 15, fq = lane >> 4;
#pragma unroll
    for (int s = 0; s < KD / 32; ++s)
#pragma unroll
        for (int bi = 0; bi < 2; ++bi) xf[s][bi] = X.frag(16 * (bt0 + bi) + fr, 32 * s + 8 * fq);
}
template <int KD, class YM, class EPI>
__device__ __forceinline__ void mm64_pre(const YM& Y, const bf16x8 (&xf)[KD / 32][2], int wid, int lane, const EPI& epi) {
    const int at = wid >> 1, bt0 = (wid & 1) * 2, fr = lane & 15, fq = lane >> 4;
    f32x4 acc[2] = {(f32x4){0.f, 0.f, 0.f, 0.f}, (f32x4){0.f, 0.f, 0.f, 0.f}};
#pragma unroll
    for (int s = 0; s < KD / 32; ++s) {
        const bf16x8 yf = Y.frag(16 * at + fr, 32 * s + 8 * fq);
#pragma unroll
        for (int bi = 0; bi < 2; ++bi) acc[bi] = __builtin_amdgcn_mfma_f32_16x16x32_bf16(xf[s][bi], yf, acc[bi], 0, 0, 0);
    }
#pragma unroll
    for (int bi = 0; bi < 2; ++bi) epi(16 * at + fr, 16 * (bt0 + bi) + 4 * fq, acc[bi]);
}
__device__ __forceinline__ void st_lds4(LAS unsigned char* base, int a, int b0, f32x4 v) { u32x2 w; w.x = cvt_pk_bf16(v[0], v[1]); w.y = cvt_pk_bf16(v[2], v[3]); *(LAS u32x2*)(base + ((size_t)a * LW + b0) * 2) = w; }
__device__ __forceinline__ f32x4 ld_lds4(LAS const unsigned char* base, int a, int b0) { const u32x2 w = *(LAS const u32x2*)(base + ((size_t)a * LW + b0) * 2); return (f32x4){bf_lo(w.x), bf_hi(w.x), bf_lo(w.y), bf_hi(w.y)}; }
__device__ __forceinline__ void st_glb4p(bf16_t* base, int a, int b0, f32x4 v) { u32x2 w; w.x = cvt_pk_bf16(v[0], v[1]); w.y = cvt_pk_bf16(v[2], v[3]); __builtin_nontemporal_store(w, (u32x2*)(base + (size_t)a * GLD + b0)); }
__device__ __forceinline__ void st_glb4(bf16_t* base, int a, int b0, f32x4 v) { u32x2 w; w.x = cvt_pk_bf16(v[0], v[1]); w.y = cvt_pk_bf16(v[2], v[3]); __builtin_nontemporal_store(w, (u32x2*)(base + (size_t)a * 64 + b0)); }

struct PrePf { u32x4 qa[3], qp[3], ra[4], rp[4], wt[4]; };
__device__ __forceinline__ void rwkv_pre_fetch(Frame& F, int unit, bool lr_first, PrePf& P, int tid) {
    const int bh = unit >> 6, c = unit & 63, b = bh >> 3, h = bh & 7;
    const int t = tid >> 3, jb = tid & 7, j0 = jb * 8;
    const int tg = b * SEQ + c * 64 + t;
    const bool hasprev = (c * 64 + t) > 0;
    const bf16_t* prow = (const bf16_t*)(F.ws + WS_PR) + (size_t)tg * NRW; const bf16_t* pprv = hasprev ? prow - NRW : prow;
#pragma unroll
    for (int seg = 0; seg < 3; ++seg) { const int col = seg * 512 + h * 64 + j0; P.qa[seg] = *(const u32x4*)(prow + col); P.qp[seg] = *(const u32x4*)(pprv + col); }
    const u32x4* scr = (const u32x4*)(F.ws + WS_LRSCR) + ((size_t)F.vcu * 512 + tid) * 4;
    const u32x4* pa = lr_first ? (const u32x4*)(prow + 1536 + jb * 32) : scr; const u32x4* pp = lr_first ? (const u32x4*)(pprv + 1536 + jb * 32) : scr;
#pragma unroll
    for (int q4 = 0; q4 < 4; ++q4) { P.ra[q4] = pa[q4]; P.rp[q4] = pp[q4]; }
    P.wt[0] = ((const u32x4*)(F.ws + WS_W2T) + (size_t)h * 512)[tid]; P.wt[1] = ((const u32x4*)(F.ws + WS_A2T) + (size_t)h * 512)[tid];
    P.wt[2] = ((const u32x4*)(F.ws + WS_G2T) + (size_t)h * 1024)[tid]; P.wt[3] = ((const u32x4*)(F.ws + WS_G2T) + (size_t)h * 1024)[512 + tid];
}
__device__ __forceinline__ void rwkv_pre_put_w(LAS unsigned char* L, const PrePf& P, int tid) {
    const int r8 = tid >> 3, c8 = tid & 7, r16 = tid >> 4, c16 = tid & 15;
    *(LAS u32x4*)(L + SL(10) + ((size_t)r8 * LW + c8 * 8) * 2) = P.wt[0]; *(LAS u32x4*)(L + SL(11) + ((size_t)r8 * LW + c8 * 8) * 2) = P.wt[1];
    *(LAS u32x4*)(L + SL(12) + ((size_t)r16 * 136 + c16 * 8) * 2) = P.wt[2]; *(LAS u32x4*)(L + SL(12) + ((size_t)(32 + r16) * 136 + c16 * 8) * 2) = P.wt[3];
}
__device__ __forceinline__ void rwkv_pre_unit(Frame& F, int unit, int next_unit, bool lr_first, bool next_first, PrePf& P) {
    LAS unsigned char* L = F.lds;
    LAS float* XT = (LAS float*)(F.lds + XTRA_OFF);
    int tid = F.tid; asm volatile("" : "+v"(tid));
    int wid = F.wave; asm volatile("" : "+s"(wid));
    const int lane = tid & 63;
    const int bh = unit >> 6, c = unit & 63, b = bh >> 3, h = bh & 7;
    const int t = tid >> 3, jb = tid & 7, j0 = jb * 8;
    const int tg = b * SEQ + c * 64 + t;
    const bool hasprev = (c * 64 + t) > 0;
    const bf16_t* PR = (const bf16_t*)(F.ws + WS_PR);
    const bf16_t* prow = PR + (size_t)tg * NRW; const bf16_t* pprev = prow - NRW;
    LAS const float* mu = (LAS const float*)(F.lds + XTRA_OFF + 4096);
    LAS const float* par = mu + NRW;
    float rs[8], ks[8], vs[8];
    {
        const int c0 = 1536 + jb * 32;
        const float pmask = hasprev ? 1.f : 0.f;
        f32x4 mq[3][2];
#pragma unroll
        for (int seg = 0; seg < 3; ++seg) { const int col = seg * 512 + h * 64 + j0; mq[seg][0] = *(LAS const f32x4*)(mu + col); mq[seg][1] = *(LAS const f32x4*)(mu + col + 4); }
        LAS unsigned char* dst = (jb < 2) ? (L + SL(0) + ((size_t)t * LW + jb * 32) * 2) : (jb < 4) ? (L + SL(1) + ((size_t)t * LW + (jb - 2) * 32) * 2) : (L + SL(2) + ((size_t)t * 136 + (jb - 4) * 32) * 2);
        u32x4* scr = (u32x4*)(F.ws + WS_LRSCR) + ((size_t)F.vcu * 512 + tid) * 4;
        if (lr_first) {
            f32x4 ma[4][2];
#pragma unroll
            for (int q4 = 0; q4 < 4; ++q4) { ma[q4][0] = *(LAS const f32x4*)(mu + c0 + q4 * 8); ma[q4][1] = *(LAS const f32x4*)(mu + c0 + q4 * 8 + 4); }
#pragma unroll
            for (int q4 = 0; q4 < 4; ++q4) { float x[8], xp[8], o[8]; unpack8(P.ra[q4], x); unpack8(P.rp[q4], xp);
#pragma unroll
                for (int e = 0; e < 8; ++e) { const float mm = e < 4 ? ma[q4][0][e] : ma[q4][1][e - 4]; const float s = x[e] + (xp[e] * pmask - x[e]) * mm;
                    const float ex = __builtin_amdgcn_exp2f((jb < 2 ? 2.88539008178f : -1.44269504089f) * s), rc = __builtin_amdgcn_rcpf(1.0f + ex);
                    o[e] = jb < 2 ? 1.0f - 2.0f * rc : (jb < 4 ? s : rc); }
                const u32x4 w = pack8(o); *(LAS u32x4*)(dst + q4 * 16) = w; scr[q4] = w; }
        } else {
#pragma unroll
            for (int q4 = 0; q4 < 4; ++q4) *(LAS u32x4*)(dst + q4 * 16) = P.ra[q4];
        }
#pragma unroll
        for (int seg = 0; seg < 3; ++seg) { float x[8], xp[8]; unpack8(P.qa[seg], x); unpack8(P.qp[seg], xp);
#pragma unroll
            for (int e = 0; e < 8; ++e) { const float mm = e < 4 ? mq[seg][0][e] : mq[seg][1][e - 4]; const float s = x[e] + (xp[e] * pmask - x[e]) * mm; if (seg == 0) rs[e] = s; else if (seg == 1) ks[e] = s; else vs[e] = s; } }
    }
    BAR_LDS();
    {
        const LdsMat Yw{L + SL(0), LW}, Ya{L + SL(1), LW}, Yg{L + SL(2), 136};
        const LdsMat Xw{L + SL(10), LW}, Xa{L + SL(11), LW}, Xg{L + SL(12), 136};
        mm64<64>(Yw, Xw, wid, lane, [&](int a, int b0, f32x4 v) { *(LAS f32x4*)(L + SL(4) + ((size_t)a * 68 + b0) * 4) = v; });
        mm64<64>(Ya, Xa, wid, lane, [&](int a, int b0, f32x4 v) { *(LAS f32x4*)(L + SL(6) + ((size_t)a * 68 + b0) * 4) = v; });
        mm64<128>(Yg, Xg, wid, lane, [&](int a, int b0, f32x4 v) { *(LAS f32x4*)(L + SL(8) + ((size_t)a * 68 + b0) * 4) = v; });
    }
    BAR_LDS();
    float ld[8], kp[8], av[8], bv[8];
    {
        const int hc = h * 64 + j0;
        float wp[8], ap[8], gg[8], w0[8], a0[8], kkw[8], kaw[8], rk[8];
        *(f32x4*)&wp[0] = *(LAS f32x4*)(L + SL(4) + ((size_t)t * 68 + j0) * 4); *(f32x4*)&wp[4] = *(LAS f32x4*)(L + SL(4) + ((size_t)t * 68 + j0 + 4) * 4);
        *(f32x4*)&ap[0] = *(LAS f32x4*)(L + SL(6) + ((size_t)t * 68 + j0) * 4); *(f32x4*)&ap[4] = *(LAS f32x4*)(L + SL(6) + ((size_t)t * 68 + j0 + 4) * 4);
        *(f32x4*)&gg[0] = *(LAS f32x4*)(L + SL(8) + ((size_t)t * 68 + j0) * 4); *(f32x4*)&gg[4] = *(LAS f32x4*)(L + SL(8) + ((size_t)t * 68 + j0 + 4) * 4);
        *(f32x4*)&w0[0] = *(LAS const f32x4*)(par + 0 + hc); *(f32x4*)&w0[4] = *(LAS const f32x4*)(par + 0 + hc + 4);
        *(f32x4*)&a0[0] = *(LAS const f32x4*)(par + 512 + hc); *(f32x4*)&a0[4] = *(LAS const f32x4*)(par + 512 + hc + 4);
        *(f32x4*)&kkw[0] = *(LAS const f32x4*)(par + 1024 + hc); *(f32x4*)&kkw[4] = *(LAS const f32x4*)(par + 1024 + hc + 4);
        *(f32x4*)&kaw[0] = *(LAS const f32x4*)(par + 1536 + hc); *(f32x4*)&kaw[4] = *(LAS const f32x4*)(par + 1536 + hc + 4);
        *(f32x4*)&rk[0] = *(LAS const f32x4*)(par + 2048 + hc); *(f32x4*)&rk[4] = *(LAS const f32x4*)(par + 2048 + hc + 4);
        float ss = 0.f, bon = 0.f, kkv[8], eta[8];
#pragma unroll
        for (int e = 0; e < 8; ++e) {
            ld[e] = -0.60653065971f * fsigmoid(w0[e] + wp[e]);
            eta[e] = fsigmoid(a0[e] + ap[e]);
            kkv[e] = ks[e] * kkw[e]; ss += kkv[e] * kkv[e];
            kp[e] = ks[e] * (1.0f + (eta[e] - 1.0f) * kaw[e]);
            bon += rs[e] * kp[e] * rk[e];
        }
        ss += __shfl_xor(ss, 1); ss += __shfl_xor(ss, 2); ss += __shfl_xor(ss, 4);
        bon += __shfl_xor(bon, 1); bon += __shfl_xor(bon, 2); bon += __shfl_xor(bon, 4);
        const float inv = __builtin_amdgcn_rcpf(fmaxf(__builtin_amdgcn_sqrtf(ss), 1e-12f));
#pragma unroll
        for (int e = 0; e < 8; ++e) { const float kk = kkv[e] * inv; av[e] = -kk; bv[e] = kk * eta[e]; }
        if (jb == 0) ((float*)(F.ws + WS_BONUS))[(size_t)tg * 8 + h] = bon;
        *(u32x4*)((bf16_t*)(F.ws + WS_GBUF) + (size_t)tg * RW + hc) = pack8(gg);
    }
    float Lc[8];
#pragma unroll
    for (int e = 0; e < 8; ++e) { float x = ld[e];
        float y = __shfl_up(x, 8); if (lane >= 8) x += y;
        y = __shfl_up(x, 16); if (lane >= 16) x += y;
        y = __shfl_up(x, 32); if (lane >= 32) x += y;
        Lc[e] = x; }
    if (lane >= 56) {
#pragma unroll
        for (int e = 0; e < 8; ++e) XT[wid * 64 + j0 + e] = Lc[e]; }
    BAR_LDS();
    {
        float pre[8];
#pragma unroll
        for (int e = 0; e < 8; ++e) pre[e] = 0.f;
#pragma unroll
        for (int w = 0; w < 7; ++w) if (w < wid) { const f32x4 x0 = *(LAS const f32x4*)(XT + w * 64 + j0), x1 = *(LAS const f32x4*)(XT + w * 64 + j0 + 4);
#pragma unroll
            for (int e = 0; e < 4; ++e) { pre[e] += x0[e]; pre[4 + e] += x1[e]; } }
#pragma unroll
        for (int e = 0; e < 8; ++e) Lc[e] += pre[e];
    }
    if (t == 63) {
#pragma unroll
        for (int e = 0; e < 8; ++e) XT[512 + j0 + e] = fexp(Lc[e]); }
    {
        float o0[8], o1[8], o2[8], o3[8];
#pragma unroll
        for (int e = 0; e < 8; ++e) { const float ein = fexp(Lc[e]), eout = __builtin_amdgcn_rcpf(ein), eex = fexp(Lc[e] - ld[e]);
            o0[e] = rs[e] * ein; o1[e] = kp[e] * eout; o2[e] = av[e] * eex; o3[e] = bv[e] * eout; }
        const size_t off = ((size_t)t * LW + j0) * 2;
        *(LAS u32x4*)(L + SL(10) + off) = pack8(o0); *(LAS u32x4*)(L + SL(11) + off) = pack8(o1); *(LAS u32x4*)(L + SL(12) + off) = pack8(o2); *(LAS u32x4*)(L + SL(13) + off) = pack8(o3);
        *(LAS u32x4*)(L + SL(2) + off) = pack8(vs);
    }
    BAR_LDS();
    {
        const int srcs[4] = {12, 13, 11, 2}, dsts[4] = {4, 5, 6, 7};
#pragma unroll
        for (int q = 0; q < 4; ++q) { unsigned short hv[8];
#pragma unroll
            for (int e = 0; e < 8; ++e) hv[e] = *(LAS const unsigned short*)(L + SL(srcs[q]) + ((size_t)(8 * wid + e) * LW + lane) * 2);
            u32x4 w; w.x = hv[0] | ((unsigned)hv[1] << 16); w.y = hv[2] | ((unsigned)hv[3] << 16); w.z = hv[4] | ((unsigned)hv[5] << 16); w.w = hv[6] | ((unsigned)hv[7] << 16);
            *(LAS u32x4*)(L + SL(dsts[q]) + ((size_t)lane * LW + 8 * wid) * 2) = w;
        }
    }
    BAR_LDS();
    if (next_unit < NUNIT) rwkv_pre_fetch(F, next_unit, next_first, P, tid);
    const int crow = tid >> 3, cch = tid & 7;
    __builtin_nontemporal_store(*(LAS const u32x4*)(L + SL(7) + ((size_t)crow * LW + cch * 8) * 2), (u32x4*)((bf16_t*)(F.ws + WS_VT) + (size_t)unit * 4096 + crow * 64 + cch * 8));
    {
        const LdsMat Rt{L + SL(10), LW}, Kt{L + SL(11), LW}, At{L + SL(12), LW}, Bt{L + SL(13), LW};
        f32x4 nd = (f32x4){0.f, 0.f, 0.f, 0.f}, ntd = nd;
        {
            int ln = lane, wd = wid; asm volatile("" : "+v"(ln), "+s"(wd));
            const int at = wd >> 1, bt0 = (wd & 1) * 2, fr = ln & 15, fq = ln >> 4, a = 16 * at + fr;
            bf16x8 yA[2], yK[2], yR[2], xB[2][2], xA[2][2], xK[2][2];
            ld_yf(At, at, fr, fq, yA); ld_xf(Bt, bt0, fr, fq, xB); ld_yf(Kt, at, fr, fq, yK); ld_xf(At, bt0, fr, fq, xA); ld_yf(Rt, at, fr, fq, yR); ld_xf(Kt, bt0, fr, fq, xK);
            const bool diag = bt0 == (at & 2);
            bf16x8 xd[2];
            if (diag) ld_yf(Bt, at, fr, fq, xd);
            f32x4 c0[2], c1[2], c2[2], c3[2];
            mm_f(yA, xB, c0); mm_f(yK, xA, c1); mm_f(yR, xB, c2); mm_f(yR, xK, c3);
            if (diag) {
                f32x4 v = (f32x4){0.f, 0.f, 0.f, 0.f};
#pragma unroll
                for (int s = 0; s < 2; ++s) v = __builtin_amdgcn_mfma_f32_16x16x32_bf16(yA[s], xd[s], v, 0, 0, 0);
#pragma unroll
                for (int e = 0; e < 4; ++e) v[e] = (fr < 4 * fq + e) ? v[e] : 0.f;
                nd = v; }
#pragma unroll
            for (int bi = 0; bi < 2; ++bi) { const int b0 = 16 * (bt0 + bi) + 4 * fq; f32x4 v0 = c0[bi], v1 = c1[bi], v2 = c2[bi], v3 = c3[bi];
#pragma unroll
                for (int e = 0; e < 4; ++e) { v0[e] = (b0 + e < a) ? v0[e] : 0.f; v1[e] = (a < b0 + e) ? v1[e] : 0.f; v2[e] = (b0 + e <= a) ? v2[e] : 0.f; v3[e] = (b0 + e <= a) ? v3[e] : 0.f; }
                st_lds4(L + SL(1), a, b0, v0); st_lds4(L + SL(2), a, b0, v1); st_lds4(L + SL(3), a, b0, v2); st_lds4(L + SL(8), a, b0, v3);
                if (bt0 + bi == at) ntd = v0; }
        }
        const int at = wid >> 1;
        if (((wid & 1) * 2 == (at & 2))) {
            const int fr = lane & 15, fq = lane >> 4;
            auto op = [](f32x4 v) { u32x4 w; w.x = cvt_pk_bf16(v[0], v[1]); w.y = cvt_pk_bf16(v[2], v[3]); w.z = 0u; w.w = 0u; return __builtin_bit_cast(bf16x8, w); };
            const f32x4 zero = (f32x4){0.f, 0.f, 0.f, 0.f};
            const f32x4 Lm = ntd, LT = nd;
            f32x4 Q = Lm;
#pragma unroll
            for (int e = 0; e < 4; ++e) Q[e] += (4 * fq + e == fr) ? 1.f : 0.f;
            const f32x4 L2 = __builtin_amdgcn_mfma_f32_16x16x32_bf16(op(LT), op(Lm), zero, 0, 0, 0), L2T = __builtin_amdgcn_mfma_f32_16x16x32_bf16(op(Lm), op(LT), zero, 0, 0, 0);
            Q = __builtin_amdgcn_mfma_f32_16x16x32_bf16(op(L2T), op(Q), Q, 0, 0, 0);
            const f32x4 L4 = __builtin_amdgcn_mfma_f32_16x16x32_bf16(op(L2T), op(L2), zero, 0, 0, 0), L4T = __builtin_amdgcn_mfma_f32_16x16x32_bf16(op(L2), op(L2T), zero, 0, 0, 0);
            Q = __builtin_amdgcn_mfma_f32_16x16x32_bf16(op(L4T), op(Q), Q, 0, 0, 0);
            const f32x4 L8T = __builtin_amdgcn_mfma_f32_16x16x32_bf16(op(L4), op(L4T), zero, 0, 0, 0);
            Q = __builtin_amdgcn_mfma_f32_16x16x32_bf16(op(L8T), op(Q), Q, 0, 0, 0);
            st_lds4(L + SL(9), 16 * at + fr, 4 * fq, Q);
        }
    }
    BAR_LDS();
    {
        const int fr = lane & 15, fq = lane >> 4;
        LAS const unsigned char* zsl = L + (wid < 4 ? SL(4) : SL(2)); LAS unsigned char* dsl = L + (wid < 4 ? SL(11) : SL(12));
        const int arow = 16 * (wid & 3) + fr;
        u32x2 zp[4];
#pragma unroll
        for (int c = 0; c < 4; ++c) {
            f32x4 acc = ld_lds4(zsl, arow, 16 * c + 4 * fq);
            if (c >= 1) {
                const u32x2 alo = *(LAS const u32x2*)(L + SL(1) + ((size_t)(16 * c + fr) * LW + 4 * fq) * 2), ahi = *(LAS const u32x2*)(L + SL(1) + ((size_t)(16 * c + fr) * LW + 16 + 4 * fq) * 2);
                u32x4 aw; aw.x = alo.x; aw.y = alo.y; aw.z = ahi.x; aw.w = ahi.y;
                u32x4 bw; bw.x = zp[0].x; bw.y = zp[0].y; bw.z = c >= 2 ? zp[1].x : 0u; bw.w = c >= 2 ? zp[1].y : 0u;
                acc = __builtin_amdgcn_mfma_f32_16x16x32_bf16(__builtin_bit_cast(bf16x8, aw), __builtin_bit_cast(bf16x8, bw), acc, 0, 0, 0); }
            if (c == 3) {
                const u32x2 alo = *(LAS const u32x2*)(L + SL(1) + ((size_t)(48 + fr) * LW + 32 + 4 * fq) * 2);
                u32x4 aw; aw.x = alo.x; aw.y = alo.y; aw.z = 0u; aw.w = 0u;
                u32x4 bw; bw.x = zp[2].x; bw.y = zp[2].y; bw.z = 0u; bw.w = 0u;
                acc = __builtin_amdgcn_mfma_f32_16x16x32_bf16(__builtin_bit_cast(bf16x8, aw), __builtin_bit_cast(bf16x8, bw), acc, 0, 0, 0); }
            const u32x2 dlo = *(LAS const u32x2*)(L + SL(9) + ((size_t)(16 * c + fr) * LW + 4 * fq) * 2);
            u32x4 aw; aw.x = dlo.x; aw.y = dlo.y; aw.z = 0u; aw.w = 0u;
            u32x4 bw; bw.x = cvt_pk_bf16(acc[0], acc[1]); bw.y = cvt_pk_bf16(acc[2], acc[3]); bw.z = 0u; bw.w = 0u;
            const f32x4 r = __builtin_amdgcn_mfma_f32_16x16x32_bf16(__builtin_bit_cast(bf16x8, aw), __builtin_bit_cast(bf16x8, bw), (f32x4){0.f, 0.f, 0.f, 0.f}, 0, 0, 0);
            zp[c].x = cvt_pk_bf16(r[0], r[1]); zp[c].y = cvt_pk_bf16(r[2], r[3]);
            *(LAS u32x2*)(dsl + ((size_t)arow * LW + 16 * c + 4 * fq) * 2) = zp[c];
        }
    }
    BAR_LDS();
    {
        const int sAT = 11, sAkT = 12, sHk = 0;
        const LdsMat AT{L + SL(sAT), LW}, AkT{L + SL(sAkT), LW}, AbrT{L + SL(3), LW}, BgT{L + SL(5), LW}, VTm{L + SL(7), LW};
        bf16_t* QRT = (bf16_t*)(F.ws + WS_QRT) + (size_t)unit * 4096; bf16_t* WYT = (bf16_t*)(F.ws + WS_WYT) + (size_t)unit * 4096;
        bf16_t* GTg = (bf16_t*)(F.dout + DO_GT) + (size_t)unit * (64 * GLD); bf16_t* Hg = (bf16_t*)(F.dout + DO_H) + (size_t)unit * (64 * GLD);
        {
            int ln = lane, wd = wid; asm volatile("" : "+v"(ln), "+s"(wd));
            const int at = wd >> 1, bt0 = (wd & 1) * 2, fr = ln & 15, fq = ln >> 4, a = 16 * at + fr;
            bf16x8 yA[2], yB[2], xT[2][2], xK[2][2];
            ld_yf(BgT, at, fr, fq, yB); ld_xf(AkT, bt0, fr, fq, xK); ld_yf(AbrT, at, fr, fq, yA); ld_xf(AT, bt0, fr, fq, xT);
            f32x4 eH[2], eR[2], eW[2];
#pragma unroll
            for (int bi = 0; bi < 2; ++bi) { const int b0 = 16 * (bt0 + bi) + 4 * fq; eH[bi] = ld_lds4(L + SL(6), a, b0); eR[bi] = ld_lds4(L + SL(10), a, b0); eW[bi] = ld_lds4(L + SL(8), a, b0); }
            const float gdiag = XT[512 + a];
            f32x4 cH[2], cQ[2], cW[2], cG[2];
            mm_f(yB, xK, cH); mm_f(yA, xT, cQ); mm_f(yA, xK, cW); mm_f(yB, xT, cG);
#pragma unroll
            for (int bi = 0; bi < 2; ++bi) { const int b0 = 16 * (bt0 + bi) + 4 * fq;
                st_lds4(L + SL(sHk), a, b0, (cH[bi] + eH[bi]) * gdiag);
                st_lds4(L + SL(1), a, b0, cQ[bi] + eR[bi]);
                st_lds4(L + SL(2), a, b0, cW[bi] + eW[bi]);
                f32x4 v = cG[bi];
#pragma unroll
                for (int e = 0; e < 4; ++e) v[e] += (b0 + e == a) ? 1.f : 0.f;
                st_lds4(L + SL(4), a, b0, v * gdiag); }
        }
        BAR_LDS();
        const LdsMat HkT{L + SL(sHk), LW};
        mm64<64>(VTm, HkT, wid, lane, [&](int a, int b0, f32x4 v) { st_lds4(L + SL(9), a, b0, v); });
        __builtin_nontemporal_store(*(LAS const u32x4*)(L + SL(1) + ((size_t)crow * LW + cch * 8) * 2), (u32x4*)(QRT + crow * 64 + cch * 8));
        __builtin_nontemporal_store(*(LAS const u32x4*)(L + SL(2) + ((size_t)crow * LW + cch * 8) * 2), (u32x4*)(WYT + crow * 64 + cch * 8));
        __builtin_nontemporal_store(*(LAS const u32x4*)(L + SL(4) + (size_t)tid * 16), (u32x4*)GTg + tid);
        if (tid < 64) __builtin_nontemporal_store(*(LAS const u32x4*)(L + SL(4) + (size_t)(512 + tid) * 16), (u32x4*)GTg + 512 + tid);
        if (next_unit < NUNIT) rwkv_pre_put_w(L, P, tid);
        BAR_LDS();
        __builtin_nontemporal_store(*(LAS const u32x4*)(L + SL(9) + (size_t)tid * 16), (u32x4*)Hg + tid);
        if (tid < 64) __builtin_nontemporal_store(*(LAS const u32x4*)(L + SL(9) + (size_t)(512 + tid) * 16), (u32x4*)Hg + 512 + tid);
    }
}

constexpr int RS_SLOT = 12 * 1024;
constexpr int RS_DEPTH = 8, RS_AHEAD = 6;
__device__ __forceinline__ void rwkv_scan_block(Frame& F, int item) {
    const int bh = item >> 2, qi = item & 3, lane = F.lane, fr = lane & 15, fq = lane >> 4, wid = F.wave;
    const char* GTg = (const char*)(F.dout + DO_GT) + (size_t)bh * 64 * (64 * GLD * 2);
    const char* Hg = (const char*)(F.dout + DO_H) + (size_t)bh * 64 * (64 * GLD * 2) + (size_t)qi * (16 * GLD * 2);
    bf16_t* SST = (bf16_t*)(F.dout + DO_SST) + (size_t)bh * 64 * 4096;
    LAS unsigned char* L = F.lds;
    auto issue = [&](int c) {
        if (wid >= 1) {
            LAS unsigned char* slot = L + (c & (RS_DEPTH - 1)) * RS_SLOT;
#pragma unroll
            for (int k = 0; k < 2; ++k) { const int pc = (wid - 1) + 7 * k;
                if (pc < 12) {
                    const char* src;
                    if (pc < 9) src = GTg + (size_t)c * (64 * GLD * 2) + pc * 1024 + lane * 16;
                    else { int off = (pc - 9) * 1024 + lane * 16; off = off > 2304 - 16 ? 2304 - 16 : off; src = Hg + (size_t)c * (64 * GLD * 2) + off; }
                    __builtin_amdgcn_global_load_lds((const unsigned*)src, (LAS unsigned*)(slot + pc * 1024), 16, 0, 0); } }
        }
    };
    f32x4 acc[4];
#pragma unroll
    for (int mt = 0; mt < 4; ++mt) acc[mt] = (f32x4){0.f, 0.f, 0.f, 0.f};
#pragma unroll 1
    for (int c = 0; c < RS_AHEAD; ++c) issue(c);
#pragma unroll 1
    for (int c = 0; c < NCH; ++c) {
        if (c + RS_AHEAD < NCH) issue(c + RS_AHEAD);
        if (c + RS_AHEAD < NCH) { if (wid >= 1 && wid <= 5) asm volatile("s_waitcnt vmcnt(12)" ::: "memory"); else if (wid >= 6) asm volatile("s_waitcnt vmcnt(6)" ::: "memory"); }
        else if (wid >= 1) asm volatile("s_waitcnt vmcnt(0)" ::: "memory");
        __builtin_amdgcn_s_barrier(); asm volatile("" ::: "memory");
        if (wid == 0) {
            LAS const unsigned char* slot = L + (c & (RS_DEPTH - 1)) * RS_SLOT;
            u32x2 ga[4][2][2], hv[4];
#pragma unroll
            for (int mt = 0; mt < 4; ++mt) {
#pragma unroll
                for (int s = 0; s < 2; ++s)
#pragma unroll
                    for (int hh = 0; hh < 2; ++hh) ga[mt][s][hh] = *(LAS const u32x2*)(slot + ((16 * mt + fr) * GLD + 16 * (2 * s + hh) + 4 * fq) * 2);
                hv[mt] = *(LAS const u32x2*)(slot + 9216 + (fr * GLD + 16 * mt + 4 * fq) * 2); }
            bf16_t* Sc = SST + (size_t)c * 4096; u32x2 sp[4];
#pragma unroll
            for (int mt = 0; mt < 4; ++mt) { sp[mt].x = cvt_pk_bf16(acc[mt][0], acc[mt][1]); sp[mt].y = cvt_pk_bf16(acc[mt][2], acc[mt][3]);
                *(u32x2*)(Sc + (size_t)(16 * qi + fr) * 64 + 16 * mt + 4 * fq) = sp[mt]; }
            bf16x8 sb[2];
#pragma unroll
            for (int s = 0; s < 2; ++s) { u32x4 w; w.x = sp[2 * s].x; w.y = sp[2 * s].y; w.z = sp[2 * s + 1].x; w.w = sp[2 * s + 1].y; sb[s] = __builtin_bit_cast(bf16x8, w); }
#pragma unroll
            for (int mt = 0; mt < 4; ++mt) { f32x4 a = (f32x4){bf_lo(hv[mt].x), bf_hi(hv[mt].x), bf_lo(hv[mt].y), bf_hi(hv[mt].y)};
#pragma unroll
                for (int s = 0; s < 2; ++s) { u32x4 w; w.x = ga[mt][s][0].x; w.y = ga[mt][s][0].y; w.z = ga[mt][s][1].x; w.w = ga[mt][s][1].y;
                    a = __builtin_amdgcn_mfma_f32_16x16x32_bf16(__builtin_bit_cast(bf16x8, w), sb[s], a, 0, 0, 0); }
                acc[mt] = a; }
            asm volatile("s_waitcnt lgkmcnt(0)" ::: "memory");
        }
    }
    asm volatile("s_waitcnt vmcnt(0)" ::: "memory");
    __builtin_amdgcn_s_barrier(); asm volatile("" ::: "memory");
}
__device__ __forceinline__ void s5_scan_block(Frame& F, int gb) {
    const int g = gb >> 3, b = gb & 7, p = F.lane, w = F.wave;
    const float* aL = (const float*)(F.ws + WS_AL) + g * 128; const float ar = aL[2 * p], ai = aL[2 * p + 1];
    const float* SLc = (const float*)(F.ws + WS_SLOC) + ((size_t)g * S5ROWS + b * 256 + 32 * w) * 128 + 2 * p;
    bf16_t* UG = (bf16_t*)(F.ws + WS_UG) + ((size_t)g * S5ROWS + b * 256 + 32 * w) * UGLD + 256 + 2 * p;
    LAS float* E = (LAS float*)(F.lds);
    f32x2 l[32];
#pragma unroll
    for (int k = 0; k < 32; ++k) l[k] = *(const f32x2*)(SLc + (size_t)k * 128);
    float sr = 0.f, si = 0.f;
#pragma unroll
    for (int k = 0; k < 32; ++k) { const float nr = ar * sr - ai * si + l[k].x, ni = ar * si + ai * sr + l[k].y; l[k].x = sr; l[k].y = si; sr = nr; si = ni; }
    E[(w * 64 + p) * 2] = sr; E[(w * 64 + p) * 2 + 1] = si;
    float pr = ar, pi = ai;
#pragma unroll
    for (int q = 0; q < 5; ++q) { const float nr = pr * pr - pi * pi, ni = 2.f * pr * pi; pr = nr; pi = ni; }
    asm volatile("s_waitcnt lgkmcnt(0)" ::: "memory"); __builtin_amdgcn_s_barrier(); asm volatile("" ::: "memory");
    float cr = 0.f, ci = 0.f;
#pragma unroll
    for (int w2 = 0; w2 < 7; ++w2) { if (w2 < w) { const float er = E[(w2 * 64 + p) * 2], ei = E[(w2 * 64 + p) * 2 + 1]; const float nr = pr * cr - pi * ci + er, ni = pr * ci + pi * cr + ei; cr = nr; ci = ni; } }
#pragma unroll
    for (int k = 0; k < 32; ++k) { *(unsigned*)(UG + (size_t)k * UGLD) = cvt_pk_bf16(l[k].x + cr, l[k].y + ci); const float nr = ar * cr - ai * ci, ni = ar * ci + ai * cr; cr = nr; ci = ni; }
    asm volatile("s_waitcnt lgkmcnt(0)" ::: "memory"); __builtin_amdgcn_s_barrier(); asm volatile("" ::: "memory");
}
struct OutY { bf16x8 yq[2], yw[2]; u32x2 gv[4]; float bon; };
__device__ __forceinline__ void rwkv_out_loady(Frame& F, int unit, int at, OutY& Lq) {
    const int lane = F.lane, fr = lane & 15, fq = lane >> 4;
    const int bh = unit >> 6, c = unit & 63, b = bh >> 3, h = bh & 7;
    const bf16_t* QRT = (const bf16_t*)(F.ws + WS_QRT) + (size_t)unit * 4096; const bf16_t* WYT = (const bf16_t*)(F.ws + WS_WYT) + (size_t)unit * 4096;
#pragma unroll
    for (int s = 0; s < 2; ++s) { Lq.yq[s] = __builtin_nontemporal_load((const bf16x8*)(QRT + (size_t)(16 * at + fr) * 64 + 32 * s + 8 * fq)); Lq.yw[s] = __builtin_nontemporal_load((const bf16x8*)(WYT + (size_t)(16 * at + fr) * 64 + 32 * s + 8 * fq)); }
    const int tl = c * 64 + 16 * at + fr, tg = b * SEQ + tl;
    const bf16_t* gb = (const bf16_t*)(F.ws + WS_GBUF) + (size_t)tg * RW + h * 64;
    Lq.bon = ((const float*)(F.ws + WS_BONUS))[(size_t)tg * 8 + h];
#pragma unroll
    for (int bt = 0; bt < 4; ++bt) { const int i0 = 16 * bt + 4 * fq; Lq.gv[bt] = *(const u32x2*)(gb + i0); }
}
__device__ __forceinline__ void rwkv_out_comp(Frame& F, int unit, int at, const bf16x8 (&xs)[2][4], const bf16x8 (&xv)[2][4], const OutY& Lq) {
    const int lane = F.lane, fr = lane & 15, fq = lane >> 4;
    const int bh = unit >> 6, c = unit & 63, b = bh >> 3, h = bh & 7;
    f32x4 lw[4], lb[4];
#pragma unroll
    for (int bt = 0; bt < 4; ++bt) { const int i0 = 16 * bt + 4 * fq; lw[bt] = *(const f32x4*)(F.in[I_LNW] + h * 64 + i0); lb[bt] = *(const f32x4*)(F.in[I_LNB] + h * 64 + i0); }
    f32x4 bv4[4];
    {
        const unsigned bb = cvt_pk_bf16(Lq.bon, Lq.bon); const bool mine = fq == 2 * (at & 1) + (fr >> 3); const int jw = (fr & 7) >> 1; const unsigned half = (fr & 1) ? (bb & 0xffff0000u) : (bb & 0xffffu);
        u32x4 dw; dw.x = (mine && jw == 0) ? half : 0u; dw.y = (mine && jw == 1) ? half : 0u; dw.z = (mine && jw == 2) ? half : 0u; dw.w = (mine && jw == 3) ? half : 0u;
        const bf16x8 df = __builtin_bit_cast(bf16x8, dw);
#pragma unroll
        for (int bt = 0; bt < 4; ++bt) bv4[bt] = __builtin_amdgcn_mfma_f32_16x16x32_bf16((at >> 1) ? xv[1][bt] : xv[0][bt], df, (f32x4){0.f, 0.f, 0.f, 0.f}, 0, 0, 0);
    }
    f32x4 acc[4];
#pragma unroll
    for (int bt = 0; bt < 4; ++bt) acc[bt] = (f32x4){0.f, 0.f, 0.f, 0.f};
#pragma unroll
    for (int s = 0; s < 2; ++s)
#pragma unroll
        for (int bt = 0; bt < 4; ++bt) {
            acc[bt] = __builtin_amdgcn_mfma_f32_16x16x32_bf16(xs[s][bt], Lq.yq[s], acc[bt], 0, 0, 0);
            acc[bt] = __builtin_amdgcn_mfma_f32_16x16x32_bf16(xv[s][bt], Lq.yw[s], acc[bt], 0, 0, 0); }
    float s1 = 0.f;
#pragma unroll
    for (int bt = 0; bt < 4; ++bt) s1 += (acc[bt][0] + acc[bt][1]) + (acc[bt][2] + acc[bt][3]);
    s1 += __shfl_xor(s1, 16); s1 += __shfl_xor(s1, 32);
    const float mean = s1 * (1.f / 64.f); float s2 = 0.f;
#pragma unroll
    for (int bt = 0; bt < 4; ++bt) { const f32x4 d = acc[bt] - mean; s2 += (d[0] * d[0] + d[1] * d[1]) + (d[2] * d[2] + d[3] * d[3]); }
    s2 += __shfl_xor(s2, 16); s2 += __shfl_xor(s2, 32);
    const float rstd = __builtin_amdgcn_rsqf(s2 * (1.f / 64.f) + 64e-5f);
    const int tl = c * 64 + 16 * at + fr, tg = b * SEQ + tl;
    bf16_t* YRS = (bf16_t*)(F.dout + DO_YRS) + (size_t)tg * D + h * 64;
#pragma unroll
    for (int bt = 0; bt < 4; ++bt) { const int i0 = 16 * bt + 4 * fq;
        const u32x2 gv = Lq.gv[bt];
        const float gg[4] = {bf_lo(gv.x), bf_hi(gv.x), bf_lo(gv.y), bf_hi(gv.y)};
        float o[4];
#pragma unroll
        for (int e = 0; e < 4; ++e) o[e] = ((acc[bt][e] - mean) * rstd * lw[bt][e] + lb[bt][e] + bv4[bt][e]) * gg[e];
        u32x2 w; w.x = cvt_pk_bf16(o[0], o[1]); w.y = cvt_pk_bf16(o[2], o[3]); *(u32x2*)(YRS + i0) = w; }
}
__device__ __forceinline__ void rwkv_out_units(Frame& F) {
    const int lane = F.lane, fr = lane & 15, fq = lane >> 4;
    for (int unit = F.vcu * NWAVES + F.wave; unit < NUNIT; unit += F.G * NWAVES) {
        const bf16_t* VT = (const bf16_t*)(F.ws + WS_VT) + (size_t)unit * 4096; const bf16_t* SST = (const bf16_t*)(F.dout + DO_SST) + (size_t)unit * 4096;
        bf16x8 xs[2][4], xv[2][4]; OutY A, B;
#pragma unroll
        for (int s = 0; s < 2; ++s)
#pragma unroll
            for (int bt = 0; bt < 4; ++bt) { xs[s][bt] = __builtin_nontemporal_load((const bf16x8*)(SST + (size_t)(16 * bt + fr) * 64 + 32 * s + 8 * fq)); xv[s][bt] = __builtin_nontemporal_load((const bf16x8*)(VT + (size_t)(16 * bt + fr) * 64 + 32 * s + 8 * fq)); }
        rwkv_out_loady(F, unit, 0, A); rwkv_out_loady(F, unit, 1, B); __builtin_amdgcn_sched_barrier(0);
        rwkv_out_comp(F, unit, 0, xs, xv, A); __builtin_amdgcn_sched_barrier(0); rwkv_out_loady(F, unit, 2, A); __builtin_amdgcn_sched_barrier(0);
        rwkv_out_comp(F, unit, 1, xs, xv, B); __builtin_amdgcn_sched_barrier(0); rwkv_out_loady(F, unit, 3, B); __builtin_amdgcn_sched_barrier(0);
        rwkv_out_comp(F, unit, 2, xs, xv, A); __builtin_amdgcn_sched_barrier(0);
        rwkv_out_comp(F, unit, 3, xs, xv, B); __builtin_amdgcn_sched_barrier(0);
    }
}

__device__ __forceinline__ void p8_rows(Frame& F) {
    const int gw = F.vcu * NWAVES + F.wave, NGW = F.G * NWAVES, lane = F.lane;
    const bf16_t* MX = (const bf16_t*)(F.ws + WS_MIXED); const float* ST = (const float*)(F.ws + WS_STAT1); bf16_t* H2 = (bf16_t*)(F.ws + WS_H2); float* X1 = (float*)F.dout;
    f32x4 gp[4];
#pragma unroll
    for (int j = 0; j < 4; ++j) gp[j] = *(const f32x4*)(F.in[I_NMPOST] + 256 * j + 4 * lane);
    for (int m0 = gw; m0 < T; m0 += 2 * NGW) {
        int mm[2] = {m0, (m0 + NGW < T) ? m0 + NGW : m0};
        f32x4 xv[2][4]; u32x2 mw[2][4]; float st[2];
#pragma unroll
        for (int q = 0; q < 2; ++q) { st[q] = (lane < 16) ? ST[(size_t)mm[q] * 16 + lane] : 0.f;
#pragma unroll
            for (int j = 0; j < 4; ++j) { const int col = 256 * j + 4 * lane; xv[q][j] = __builtin_nontemporal_load((const f32x4*)(F.in[I_X] + (size_t)mm[q] * D + col)); mw[q][j] = __builtin_nontemporal_load((const u32x2*)(MX + (size_t)mm[q] * D + col)); } }
#pragma unroll
        for (int q = 0; q < 2; ++q) {
            const float rstd1 = __builtin_amdgcn_rsqf(wave_sum(st[q]) * (1.f / D) + 1e-6f);
            f32x4 v[4]; float s = 0.f;
#pragma unroll
            for (int j = 0; j < 4; ++j) { const int col = 256 * j + 4 * lane;
                v[j].x = xv[q][j].x + bf_lo(mw[q][j].x) * rstd1 * gp[j].x; v[j].y = xv[q][j].y + bf_hi(mw[q][j].x) * rstd1 * gp[j].y; v[j].z = xv[q][j].z + bf_lo(mw[q][j].y) * rstd1 * gp[j].z; v[j].w = xv[q][j].w + bf_hi(mw[q][j].y) * rstd1 * gp[j].w;
                s += (v[j].x * v[j].x + v[j].y * v[j].y) + (v[j].z * v[j].z + v[j].w * v[j].w);
                }
            const float rstd2 = __builtin_amdgcn_rsqf(wave_sum(s) * (1.f / D) + 1e-6f);
#pragma unroll
            for (int j = 0; j < 4; ++j) { u32x2 w; w.x = cvt_pk_bf16(v[j].x * rstd2, v[j].y * rstd2); w.y = cvt_pk_bf16(v[j].z * rstd2, v[j].w * rstd2); *(u32x2*)(H2 + (size_t)mm[q] * D + 256 * j + 4 * lane) = w; }
        }
    }
}
__device__ __forceinline__ void p12_rows(Frame& F) {
    const int gw = F.vcu * NWAVES + F.wave, NGW = F.G * NWAVES, lane = F.lane;
    const bf16_t* FB = (const bf16_t*)(F.ws + WS_F); const bf16_t* MX = (const bf16_t*)(F.ws + WS_MIXED);
    const float* ST1 = (const float*)(F.ws + WS_STAT1); const float* ST2 = (const float*)(F.ws + WS_STAT2); float* OUT = (float*)F.dout;
    f32x4 gp[4], gq[4];
#pragma unroll
    for (int j = 0; j < 4; ++j) { gp[j] = *(const f32x4*)(F.in[I_NMPOST] + 256 * j + 4 * lane); gq[j] = *(const f32x4*)(F.in[I_NFPOST] + 256 * j + 4 * lane); }
    for (int m0 = gw; m0 < T; m0 += 2 * NGW) {
        int mm[2] = {m0, (m0 + NGW < T) ? m0 + NGW : m0};
        f32x4 xv[2][4]; u32x2 mw[2][4], fw[2][4]; float s1[2], s2[2];
#pragma unroll
        for (int q = 0; q < 2; ++q) { s1[q] = (lane < 16) ? ST1[(size_t)mm[q] * 16 + lane] : 0.f; s2[q] = (lane < 16) ? ST2[(size_t)mm[q] * 16 + lane] : 0.f;
#pragma unroll
            for (int j = 0; j < 4; ++j) { const int col = 256 * j + 4 * lane; xv[q][j] = __builtin_nontemporal_load((const f32x4*)(F.in[I_X] + (size_t)mm[q] * D + col));
                mw[q][j] = __builtin_nontemporal_load((const u32x2*)(MX + (size_t)mm[q] * D + col)); fw[q][j] = __builtin_nontemporal_load((const u32x2*)(FB + (size_t)mm[q] * D + col)); } }
#pragma unroll
        for (int q = 0; q < 2; ++q) {
            const float rstd1 = __builtin_amdgcn_rsqf(wave_sum(s1[q]) * (1.f / D) + 1e-6f), rstd3 = __builtin_amdgcn_rsqf(wave_sum(s2[q]) * (1.f / D) + 1e-6f);
#pragma unroll
            for (int j = 0; j < 4; ++j) { const int col = 256 * j + 4 * lane; f32x4 o;
                o.x = xv[q][j].x + bf_lo(mw[q][j].x) * rstd1 * gp[j].x; o.y = xv[q][j].y + bf_hi(mw[q][j].x) * rstd1 * gp[j].y; o.z = xv[q][j].z + bf_lo(mw[q][j].y) * rstd1 * gp[j].z; o.w = xv[q][j].w + bf_hi(mw[q][j].y) * rstd1 * gp[j].w;
                o.x += bf_lo(fw[q][j].x) * rstd3 * gq[j].x; o.y += bf_hi(fw[q][j].x) * rstd3 * gq[j].y; o.z += bf_lo(fw[q][j].y) * rstd3 * gq[j].z; o.w += bf_hi(fw[q][j].y) * rstd3 * gq[j].w;
                __builtin_nontemporal_store(o, (f32x4*)(OUT + (size_t)mm[q] * D + col)); }
        }
    }
}

#ifndef MK_PER_PHASE
#define MK_PER_PHASE 0
#endif
constexpr int NPHASE = 12;
struct Args { const float* in[35]; float* out; unsigned char* ws; int ph_lo, ph_hi; };
static_assert(sizeof(Args) == 35 * 8 + 8 + 8 + 8, "Args has no padding");

__device__ __forceinline__ bool phase_begin(Frame& F) { unsigned long long z = 0; asm volatile("" : "+s"(z), "+v"(F.tid)); F.ws = F.ws0 + z; F.dout = F.dout0 + z;     F.lane = F.tid & 63; F.wave = __builtin_amdgcn_readfirstlane(F.tid >> 6); return true; }
__global__ void __launch_bounds__(NWAVES * 64, 2) fwd_kernel(Args args) {
    extern __shared__ __attribute__((aligned(16))) unsigned char lds_raw[];
    Frame F;
    F.lds = (LAS unsigned char*)lds_raw;
    F.MISC = (volatile LAS unsigned*)(F.lds + MISC_OFF);
    F.tid = threadIdx.x; F.lane = F.tid & 63; F.wave = __builtin_amdgcn_readfirstlane(F.tid >> 6);
    F.G = gridDim.x; { const int bx = blockIdx.x; F.vcu = (F.G % 8 == 0) ? (bx % 8) * (F.G / 8) + bx / 8 : bx; }
    F.ws0 = args.ws; F.dout0 = (unsigned char*)args.out; F.ws = F.ws0; F.dout = F.dout0; F.ctl = (gu32*)(args.ws + WS_CTL);
    F.in = (InTab)__builtin_amdgcn_kernarg_segment_ptr();
    for (int u = F.tid; u < (LDS_BYTES - LDSCTL_OFF) / 4; u += NWAVES * 64) ((LAS unsigned*)(F.lds + LDSCTL_OFF))[u] = 0u;
    __syncthreads();
    XcdBarrier bar; bar.bar = (unsigned*)(F.ctl + CW_BAR); bar.x = 0; bar.st = nullptr;
    if (!MK_PER_PHASE) bar = xcd_barrier_post((unsigned*)(F.ctl + CW_BAR), F.MISC + 8);
    const int lo = args.ph_lo, hi = args.ph_hi;
#ifndef PHMASK
#define PHMASK 0xffffffffu
#endif
#define IN(k) (((PHMASK >> (k)) & 1u) && lo <= (k) && (k) < hi && phase_begin(F))
#ifndef REPMASK
#define REPMASK 0u
#endif
#define REPS(k) ((((REPMASK) >> (k)) & 1u) ? 2 : 1)
#define PH(k) for (int rep_ = 0; rep_ < REPS(k); ++rep_, (rep_ < REPS(k) ? xcd_barrier(bar) : (void)0))
#define INQ(k) (lo <= (k) && (k) < hi)
#define SEAM(k) do { if (INQ(k) && INQ((k) + 1)) xcd_barrier(bar); } while (0)
#define WSB(off) ((bf16_t*)(F.ws + (off)))
    const int bx = (int)blockIdx.x;

    PH(0) if (IN(0)) { p0_prologue(F); }
    SEAM(0);
    PH(1) if (IN(1)) {
        pg8::Gemm g{D, D, D, 0}; pg8::StaticOrder S; S.init(WSB(WS_XN), WSB(WS_WIN), D, D, T, NIN, F.G, bx);
        EpiInProj E{WSB(WS_PR), WSB(WS_UG), WSB(WS_GATES), F.in[I_BGATE], 0};
        pg8::gemm_phase<EpiInProj, pg8::StaticOrder, true>(F.lds, g, S, E, F.tid);
        { const int rem = ((T / 256) * (NIN / 256)) % F.G;
          if (rem == 0) p0_late_mats(F, bx * NWAVES + F.wave, F.G * NWAVES); else if (bx >= rem) p0_late_mats(F, (bx - rem) * NWAVES + F.wave, (F.G - rem) * NWAVES); }
    }
    SEAM(1);
    PH(2) if (IN(2)) {
        PrePf pf;
        if (F.vcu < NB * NCH) { rwkv_pre_fetch(F, (((F.vcu >> 6) * NHEAD) << 6) + (F.vcu & 63), true, pf, F.tid); rwkv_pre_put_w(F.lds, pf, F.tid); }
        {
            LAS f32x4* TB = (LAS f32x4*)(F.lds + XTRA_OFF + 4096);
            if (F.tid < NRW / 4) TB[F.tid] = ((const f32x4*)F.in[I_MU])[F.tid];
            const int pq = F.tid >> 7, pi = F.tid & 127;
            const float* psrc = pq == 0 ? F.in[I_W0] : pq == 1 ? F.in[I_A0] : pq == 2 ? F.in[I_KK] : F.in[I_KA];
            TB[NRW / 4 + F.tid] = ((const f32x4*)psrc)[pi];
            if (F.tid < 128) TB[NRW / 4 + 512 + F.tid] = ((const f32x4*)F.in[I_RK])[F.tid];
            BAR_LDS();
        }
        for (int pc = F.vcu; pc < NB * NCH; pc += F.G) {
#pragma unroll 1
            for (int hh = 0; hh < NHEAD; ++hh) { const int bq = pc >> 6, cq = pc & 63, u = ((bq * NHEAD + hh) << 6) + cq;
                const int un = (hh < NHEAD - 1) ? u + 64 : ((pc + F.G < NB * NCH) ? ((((pc + F.G) >> 6) * NHEAD) << 6) + ((pc + F.G) & 63) : NUNIT);
                rwkv_pre_unit(F, u, un, hh == 0, hh == NHEAD - 1, pf); } }
        BAR_LDS();
        pg8::Gemm g{256, UGLD, 256, 0}; S5Order S{WSB(WS_UG), WSB(WS_B1A), 256, F.G, bx};
        EpiSloc E{(float*)(F.ws + WS_SLOC), 0};
        pg8::gemm_phase<EpiSloc, S5Order, true>(F.lds, g, S, E, F.tid);
    }
    SEAM(2);
    PH(3) if (IN(3)) {
        for (int gb = F.vcu; gb < S5G * NB; gb += F.G) s5_scan_block(F, gb);
        for (int it = F.vcu; it < NB * NHEAD * 4; it += F.G) rwkv_scan_block(F, it);
    }
    SEAM(3);
    PH(4) if (IN(4)) {
        rwkv_out_units(F);
        VM_WAIT(); __syncthreads();
        pg8::Gemm g{384, UGLD, 384, 0}; S5Order S{WSB(WS_UG), WSB(WS_B1B), 384, F.G, bx};
        pg8::EpiGen8<FS5Out> E{FS5Out{WSB(WS_YSP)}, 0};
        pg8::gemm_phase<pg8::EpiGen8<FS5Out>, S5Order, true>(F.lds, g, S, E, F.tid);
    }
    SEAM(4);
    PH(5) if (IN(5)) {
        pg8::Gemm g{RW, RW, RW, 1}; pg8::StaticOrder S; S.init(WSB(WS_YSP), WSB(WS_WGLU), RW, RW, T, RW, F.G, bx); S.tstepA = (size_t)16 * 256 * 2;
        EpiGlu E{WSB(WS_YSP), (bf16_t*)(F.dout + DO_YRS), F.in[I_BGLU], 0};
        pg8::gemm_phase<EpiGlu, pg8::StaticOrder, true>(F.lds, g, S, E, F.tid);
    }
    SEAM(5);
    PH(6) if (IN(6)) {
        pg8::Gemm g{D, D, D, 0}; pg8::StaticOrder S; S.init((const bf16_t*)(F.dout + DO_YRS), WSB(WS_WBRS), D, D, T, D, F.G, bx);
        EpiMerge E{WSB(WS_GATES), WSB(WS_MERGED), RW / 64};
        pg8::gemm_phase<EpiMerge, pg8::StaticOrder, true>(F.lds, g, S, E, F.tid);
    }
    SEAM(6);
    PH(7) if (IN(7)) {
        pg8::Gemm g{D, D, D, 0}; pg8::StaticOrder S; S.init(WSB(WS_MERGED), WSB(WS_WOUT), D, D, T, D, F.G, bx);
        EpiRowStat E{WSB(WS_MIXED), (float*)(F.ws + WS_STAT1), 0};
        pg8::gemm_phase<EpiRowStat, pg8::StaticOrder, false>(F.lds, g, S, E, F.tid);
    }
    SEAM(7);
    PH(8) if (IN(8)) { p8_rows(F);
        for (size_t i = (size_t)bx * 512 + F.tid; i < HZ_BYTES / 16; i += (size_t)F.G * 512) ((u32x4*)(F.ws + WS_HZ))[i] = (u32x4){0u, 0u, 0u, 0u}; }
    SEAM(8);
    PH(9) if (IN(9)) {
        pg8::Gemm g{D, D, D, 0}; UpOrder S{WSB(WS_H2), WSB(WS_WUP), F.G, bx};
        EpiConvAct E{WSB(WS_ACT), F.in[I_CONVW], F.in[I_CONVB], (LAS unsigned*)(F.lds + XTRA_OFF), (unsigned long long*)(F.ws + WS_HZ), (unsigned*)(F.ctl + 2), 0};
        pg8::gemm_phase<EpiConvAct, UpOrder, true>(F.lds, g, S, E, F.tid);
    }
    SEAM(9);
    PH(10) if (IN(10)) {
        pg8::Gemm g{FF, FF, FF, 0}; pg8::StaticOrder S; S.init(WSB(WS_ACT), WSB(WS_WDN), FF, FF, T, D, F.G, bx);
        EpiRowStat E{WSB(WS_F), (float*)(F.ws + WS_STAT2), 0};
        pg8::gemm_phase<EpiRowStat, pg8::StaticOrder, false>(F.lds, g, S, E, F.tid);
    }
    SEAM(10);
    if (IN(11)) p12_rows(F);
#undef IN
#undef INQ
#undef SEAM
#undef WSB
}

extern "C" void kernel_launch(void* const* d_in, const int* in_sizes, int n_in, void* d_out, int out_size, void* d_ws, size_t ws_size, hipStream_t stream) {
    static int grid = 0;
    if (grid == 0) {
        if (n_in != 35 || in_sizes[0] != T * D || out_size != T * D || ws_size < WS_END) { fprintf(stderr, "kernel_launch: unexpected shapes: n_in %d in0 %d out %d ws %zu (need %zu)\n", n_in, n_in > 0 ? in_sizes[0] : -1, out_size, ws_size, (size_t)WS_END); grid = -1; return; }
        int dev = 0, cus = 0, per_cu = 0;
        if (hipGetDevice(&dev) != hipSuccess || hipDeviceGetAttribute(&cus, hipDeviceAttributeMultiprocessorCount, dev) != hipSuccess) { fprintf(stderr, "kernel_launch: device query failed\n"); grid = -1; return; }
        if (hipFuncSetAttribute((const void*)fwd_kernel, hipFuncAttributeMaxDynamicSharedMemorySize, LDS_BYTES) != hipSuccess) { fprintf(stderr, "kernel_launch: hipFuncSetAttribute failed\n"); grid = -1; return; }
        if (hipOccupancyMaxActiveBlocksPerMultiprocessor(&per_cu, (const void*)fwd_kernel, NWAVES * 64, LDS_BYTES) != hipSuccess || per_cu < 1) fprintf(stderr, "kernel_launch: occupancy query reports %d blocks per CU\n", per_cu);
        (void)hipGetLastError();
        grid = cus;
    }
    if (grid < 0) return;
    if (hipMemsetAsync((char*)d_ws + WS_CTL, 0, CTL_ZERO_BYTES, stream) != hipSuccess) { fprintf(stderr, "kernel_launch: memset failed\n"); return; }
    Args a{};
    for (int i = 0; i < 35; ++i) a.in[i] = (const float*)d_in[i];
    a.out = (float*)d_out; a.ws = (unsigned char*)d_ws;
#if MK_PER_PHASE
    for (int ph = 0; ph < NPHASE; ++ph) { a.ph_lo = ph; a.ph_hi = ph + 1; hipLaunchKernelGGL(fwd_kernel, dim3(grid), dim3(NWAVES * 64), LDS_BYTES, stream, a); }
#else
    a.ph_lo = 0; a.ph_hi = NPHASE;
    hipLaunchKernelGGL(fwd_kernel, dim3(grid), dim3(NWAVES * 64), LDS_BYTES, stream, a);
#endif
    const hipError_t le = hipPeekAtLastError();
    if (le != hipSuccess) fprintf(stderr, "kernel_launch: launch failed: %s\n", hipGetErrorName(le));
}
```

```cpp
#include <hip/hip_runtime.h>
#include <cstdio>
#include <cstdint>

#define LAS __attribute__((address_space(3)))
#define GAS __attribute__((address_space(1)))
typedef unsigned short bf16_t;
typedef short bf16x8 __attribute__((ext_vector_type(8)));
typedef float f32x4 __attribute__((ext_vector_type(4)));
typedef float f32x2 __attribute__((ext_vector_type(2)));
typedef unsigned u32x4 __attribute__((ext_vector_type(4)));
typedef unsigned u32x2 __attribute__((ext_vector_type(2)));
typedef GAS unsigned gu32;

constexpr int T = 32768, SEQ = 4096, NB = 8, D = 1024, NIN = 4352, NRW = 1792, RW = 512, FF = 2816, FH = 1408;
constexpr int NHEAD = 8, HD = 64, NCH = 64  , NUNIT = NB * NHEAD * NCH;
constexpr int S5G = 32, S5ROWS = T / 16, UGLD = 384;

constexpr size_t MiB = 1u << 20;
constexpr size_t WS_CTL = 0, CTL_ZERO_BYTES = 1 * MiB;
constexpr size_t WS_WIN = 1 * MiB;
constexpr size_t WS_WUP = WS_WIN + (size_t)NIN * D * 2;
constexpr size_t WS_WDN = WS_WUP + (size_t)2 * FF * D * 2;
constexpr size_t WS_WOUT = WS_WDN + (size_t)D * FF * 2;
constexpr size_t WS_WBRS = WS_WOUT + (size_t)D * D * 2;
constexpr size_t WS_WGLU = WS_WBRS + (size_t)D * D * 2;
constexpr size_t WS_W2T = WS_WGLU + (size_t)RW * RW * 2;
constexpr size_t WS_A2T = WS_W2T + (size_t)RW * 64 * 2;
constexpr size_t WS_G2T = WS_A2T + (size_t)RW * 64 * 2;
constexpr size_t WS_B1A = WS_G2T + (size_t)RW * 128 * 2;
constexpr size_t WS_B1B = WS_B1A + (size_t)S5G * 256 * 256 * 2;
constexpr size_t WS_AL = WS_B1B + (size_t)S5G * 256 * 384 * 2;
constexpr size_t WS_WEND = WS_AL + (size_t)S5G * 64 * 2 * 4;
static_assert(WS_WEND <= 44 * MiB, "weights region");
constexpr size_t WS_XN = 44 * MiB;
constexpr size_t WS_QRT = 44 * MiB, WS_WYT = 76 * MiB;
constexpr size_t WS_MERGED = 44 * MiB, WS_H2 = 44 * MiB, WS_F = 44 * MiB;
constexpr size_t WS_PR = 108 * MiB;
constexpr size_t WS_MIXED = 304 * MiB, WS_STAT1 = 368 * MiB;
constexpr size_t WS_ACT = 108 * MiB;
constexpr size_t WS_STAT2 = 284 * MiB;
constexpr size_t WS_UG = 220 * MiB;
constexpr size_t WS_GATES = 268 * MiB;
constexpr size_t WS_SLOC = 396 * MiB, WS_YSP = 396 * MiB;
constexpr size_t WS_GBUF = 428 * MiB;
constexpr size_t WS_BONUS = 460 * MiB;
constexpr size_t WS_VT = 461 * MiB;
constexpr size_t WS_LRSCR = 493 * MiB;
constexpr size_t WS_Z = 336 * MiB;
constexpr size_t WS_END = 512 * MiB;
constexpr size_t DO_H = 0, DO_GT = 36 * MiB, DO_SST = 96 * MiB, DO_YRS = 0;
constexpr int GLD = 72;

constexpr int CW_BAR = 4096, CW_HF = 32768, CW_XNQ = 64;
constexpr size_t WS_HZ = 290 * MiB, HZ_BYTES = (size_t)2816 * 4 * 2 * 32 * 8;

constexpr int RING_BYTES = 131072, LDSCTL_OFF = RING_BYTES, MISC_OFF = LDSCTL_OFF + 320, XTRA_OFF = LDSCTL_OFF + 1024, LDS_BYTES = 155648;
constexpr int NWAVES = 8;

#define RLX_AGENT __ATOMIC_RELAXED, __HIP_MEMORY_SCOPE_AGENT
#define LDS_WAIT() asm volatile("s_waitcnt lgkmcnt(0)" ::: "memory")
#define VM_WAIT() asm volatile("s_waitcnt vmcnt(0)" ::: "memory")

typedef __bf16 bf16x2_t __attribute__((ext_vector_type(2)));
__device__ __forceinline__ unsigned cvt_pk_bf16(float lo, float hi) { const f32x2 v = {lo, hi}; return __builtin_bit_cast(unsigned, __builtin_convertvector(v, bf16x2_t)); }
__device__ __forceinline__ float bf_lo(unsigned w) { return __uint_as_float(w << 16); }
__device__ __forceinline__ float bf_hi(unsigned w) { return __uint_as_float(w & 0xffff0000u); }
__device__ __forceinline__ float bf1(bf16_t h) { return __uint_as_float((unsigned)h << 16); }
__device__ __forceinline__ float fexp(float x) { return __builtin_amdgcn_exp2f(x * 1.44269504089f); }
__device__ __forceinline__ float fsigmoid(float x) { return __builtin_amdgcn_rcpf(1.0f + __builtin_amdgcn_exp2f(-1.44269504089f * x)); }
__device__ __forceinline__ float ftanh(float x) { return 1.0f - 2.0f * __builtin_amdgcn_rcpf(1.0f + __builtin_amdgcn_exp2f(2.88539008178f * x)); }
__device__ __forceinline__ float fgelu(float x) { const float u = 0.7978845608f * (x + 0.044715f * x * x * x); return x * fsigmoid(2.0f * u); }
__device__ __forceinline__ void unpack8(u32x4 w, float (&f)[8]) { f[0] = bf_lo(w.x); f[1] = bf_hi(w.x); f[2] = bf_lo(w.y); f[3] = bf_hi(w.y); f[4] = bf_lo(w.z); f[5] = bf_hi(w.z); f[6] = bf_lo(w.w); f[7] = bf_hi(w.w); }
__device__ __forceinline__ u32x4 pack8(const float (&f)[8]) { u32x4 w; w.x = cvt_pk_bf16(f[0], f[1]); w.y = cvt_pk_bf16(f[2], f[3]); w.z = cvt_pk_bf16(f[4], f[5]); w.w = cvt_pk_bf16(f[6], f[7]); return w; }
__device__ __forceinline__ float wave_sum(float v) {
#pragma unroll
    for (int o = 1; o < 64; o <<= 1) v += __shfl_xor(v, o);
    return v;
}

#define XB_TMO      128
#define XB_XCNT(j)  (256  + 64 * (j))
#define XB_XSUB(j)  (1280 + 64 * (j))
#define XB_XGEN(j)  (2304 + 64 * (j))
#define XB_TOP      3328
#define XB_TOPGEN   3392
#define XCD_BAR_WORDS 3456
#define XB_SPIN_CAP (1u << 18)
__device__ __forceinline__ unsigned xb_ld(unsigned* p)              { return __hip_atomic_load(p, __ATOMIC_RELAXED, __HIP_MEMORY_SCOPE_AGENT); }
__device__ __forceinline__ unsigned xb_add(unsigned* p, unsigned v) { return __hip_atomic_fetch_add(p, v, __ATOMIC_RELAXED, __HIP_MEMORY_SCOPE_AGENT); }
__device__ __forceinline__ unsigned xb_xcc_id() { return (unsigned)__builtin_amdgcn_s_getreg((3 << 11) | 20) & 0xFu; }
#define XB_SPIN(cond, bar) do { unsigned _sp = 0; while (cond) { __builtin_amdgcn_s_sleep(1); \
    if ((++_sp & 255u) == 0u) { if (xb_ld(&(bar)[XB_TMO])) break; if (_sp > XB_SPIN_CAP) { atomicAdd(&(bar)[XB_TMO], 1u); break; } } } } while (0)
struct XcdBarrier { unsigned* bar; unsigned x; volatile LAS unsigned* st; };
__device__ __forceinline__ XcdBarrier xcd_barrier_post(unsigned* bar, volatile LAS unsigned* st) {
    XcdBarrier b; b.bar = bar; b.x = xb_xcc_id(); b.st = st;
    if (threadIdx.x == 0) (void)xb_add(&bar[XB_XCNT(b.x)], 1u);
    return b;
}
__device__ __forceinline__ void xcd_barrier_complete(unsigned* bar, unsigned x, unsigned& nloc, unsigned& nx) {
    const unsigned G = gridDim.x * gridDim.y * gridDim.z;
    unsigned sum, cnt, mine, sp = 0u;
    for (;;) {
        sum = 0u; cnt = 0u; mine = 0u;
#pragma unroll
        for (unsigned j = 0; j < 16; ++j) { const unsigned c = xb_ld(&bar[XB_XCNT(j)]); sum += c; cnt += (c > 0u) ? 1u : 0u; mine = (j == x) ? c : mine; }
        if (sum == G) break;
        __builtin_amdgcn_s_sleep(1);
        if ((++sp & 255u) == 0u) { if (xb_ld(&bar[XB_TMO])) break; if (sp > XB_SPIN_CAP) { atomicAdd(&bar[XB_TMO], 1u); break; } }
    }
    nloc = mine > 0u ? mine : 1u; nx = cnt > 0u ? cnt : 1u;
}
__device__ __forceinline__ void xcd_barrier(const XcdBarrier& b) {
    asm volatile("s_waitcnt vmcnt(0)" ::: "memory");
    __syncthreads();
    if (threadIdx.x == 0) {
        unsigned* bar = b.bar;
        __builtin_amdgcn_s_waitcnt(0);
        unsigned nloc = b.st[0], nx = b.st[1];
        if (nloc == 0u) { xcd_barrier_complete(bar, b.x, nloc, nx); b.st[0] = nloc; b.st[1] = nx; }
        const unsigned old = xb_add(&bar[XB_XSUB(b.x)], 1u);
        const unsigned gen = old / nloc;
        if (old + 1u == (gen + 1u) * nloc) {
            __builtin_amdgcn_fence(__ATOMIC_RELEASE, "agent");
            asm volatile("s_waitcnt vmcnt(0)" ::: "memory");
            const unsigned og = xb_add(&bar[XB_TOP], 1u);
            const unsigned tg = og / nx;
            if (og + 1u == (tg + 1u) * nx) xb_add(&bar[XB_TOPGEN], 1u);
            else XB_SPIN(xb_ld(&bar[XB_TOPGEN]) == tg, bar);
            __builtin_amdgcn_fence(__ATOMIC_ACQUIRE, "agent");
            xb_add(&bar[XB_XGEN(b.x)], 1u);
            asm volatile("s_waitcnt vmcnt(0)" ::: "memory");
        } else {
            XB_SPIN(xb_ld(&bar[XB_XGEN(b.x)]) == gen, bar);
            __builtin_amdgcn_fence(__ATOMIC_ACQUIRE, "agent");
            asm volatile("s_waitcnt vmcnt(0)" ::: "memory");
        }
    }
    __syncthreads();
}

namespace pg8 {
constexpr int BM = 256, BK = 64, HALF = 128, HTB = HALF * BK * 2, STAGE_BYTES = 8 * HTB, NXCD = 8, WGM = 8;
__host__ __device__ __forceinline__ int lds_byte(int r, int c) { const int st = (r >> 4) * 2 + (c >> 5), rr = r & 15, cc = c & 31, ob = rr * 64 + cc * 2; return st * 1024 + (ob ^ (((ob >> 9) & 1) << 5)); }
__host__ __device__ __forceinline__ void stage_rc(int b, int& R, int& C) { const int st = b / 1024, sb = b % 1024, swz = sb ^ (((sb >> 9) & 1) << 5); R = (st >> 1) * 16 + swz / 64; C = (st & 1) * 32 + (swz % 64) / 2; }
__host__ __device__ __forceinline__ int perm32(int rho) { const int n = rho >> 4, i = rho & 15; return 8 * (i >> 2) + 4 * n + (i & 3); }

struct Unit { const char* a; const char* b; int pm, pn; };
struct Gemm { int K, lda, ldb, amode; };

struct StaticOrder {
    const bf16_t* A; const bf16_t* Bt; int lda, ldb;
    int nM, nN, nwg, G, c; size_t tstepA;
    __device__ void init(const bf16_t* A_, const bf16_t* Bt_, int lda_, int ldb_, int M, int N, int G_, int c_) { A = A_; Bt = Bt_; lda = lda_; ldb = ldb_; nM = M / BM; nN = N / BM; nwg = nM * nN; G = G_; c = c_; tstepA = (size_t)BM * lda * 2; }
    __device__ bool next(int i, Unit& u) const {
        const long L = (long)i * G + c; if (L >= nwg) return false;
        int wgid = (int)L; { const int q = nwg / NXCD, r = nwg % NXCD, xcd = wgid % NXCD, off = wgid / NXCD; wgid = (xcd < r ? xcd * (q + 1) : r * (q + 1) + (xcd - r) * q) + off; }
        const int nig = WGM * nN, gid = wgid / nig, fm = gid * WGM, gsz = (nM - fm) < WGM ? (nM - fm) : WGM;
        u.pm = fm + ((wgid % nig) % gsz); u.pn = (wgid % nig) / gsz;
        u.a = (const char*)A + (size_t)u.pm * tstepA; u.b = (const char*)Bt + (size_t)u.pn * BM * ldb * 2; return true;
    }
};

template <class Epi, class Sched, bool ALIGN_EPI = false, bool SP2 = true>
__device__ __forceinline__ void gemm_phase(LAS unsigned char* lds, const Gemm g, const Sched& S, const Epi& E, const int tid) {
    const int wid = __builtin_amdgcn_readfirstlane(tid >> 6), lane = tid & 63, wr = wid >> 2, wc = wid & 3, fr = lane & 15, fq = lane >> 4;
    const int K = g.K, nt = K / BK;
    unsigned voffA[2], voffB[2];
#pragma unroll
    for (int i = 0; i < 2; ++i) { int R, C; stage_rc(tid * 16 + i * 8192, R, C); const int Rb = Epi::PERM ? ((R & ~31) + perm32(R & 31)) : R;
        voffA[i] = g.amode ? (unsigned)((((C >> 4) * S5ROWS + (R >> 4)) * 256 + (R & 15) * 16 + (C & 15)) * 2) : (unsigned)(R * g.lda + C) * 2u; voffB[i] = (unsigned)(Rb * g.ldb + C) * 2u; }
    const size_t kstepB = (size_t)(BK * 2), kstepA = g.amode ? (size_t)4 * S5ROWS * 256 * 2 : (size_t)(BK * 2);
    const size_t hstepA = g.amode ? (size_t)8 * 256 * 2 : (size_t)HALF * g.lda * 2, hstepB = (size_t)HALF * g.ldb * 2;
    const unsigned ldsw = (unsigned)wid * 1024u;
    const int aoff = lds_byte(wr * 64 + fr, fq * 8), boff = lds_byte(wc * 32 + fr, fq * 8);
#define PG8_SA(b, h) (((b) * 2 + (h)) * HTB)
#define PG8_SB(b, h) ((4 + (b) * 2 + (h)) * HTB)
#define PG8_STAGE(bufoff, gbase, voff) do { _Pragma("unroll") for (int _i = 0; _i < 2; ++_i) \
        __builtin_amdgcn_global_load_lds((const unsigned*)((const char*)(gbase) + (voff)[_i]), (LAS unsigned*)(lds + (bufoff) + ldsw + _i * 8192), 16, 0, 0); } while (0)
#define PG8_LDA(dst, b, h) do { _Pragma("unroll") for (int m = 0; m < 4; ++m) _Pragma("unroll") for (int k = 0; k < 2; ++k) dst[m][k] = *(const LAS bf16x8*)(lds + PG8_SA(b, h) + aoff + m * 2048 + k * 1024); } while (0)
#define PG8_LDB(dst, b, h) do { _Pragma("unroll") for (int n = 0; n < 2; ++n) _Pragma("unroll") for (int k = 0; k < 2; ++k) dst[n][k] = *(const LAS bf16x8*)(lds + PG8_SB(b, h) + boff + n * 2048 + k * 1024); } while (0)
#define PG8_MMA(ai, bj, At, Bt) do { __builtin_amdgcn_s_setprio(1); _Pragma("unroll") for (int m = 0; m < 4; ++m) _Pragma("unroll") for (int n = 0; n < 2; ++n) _Pragma("unroll") for (int k = 0; k < 2; ++k) \
        acc[ai][bj][m][n] = __builtin_amdgcn_mfma_f32_16x16x32_bf16(Bt[n][k], At[m][k], acc[ai][bj][m][n], 0, 0, 0); __builtin_amdgcn_s_setprio(0); } while (0)
#define PG8_WAIT_V(n) asm volatile("s_waitcnt vmcnt(" #n ")" ::: "memory")
#define PG8_WAIT_L(n) asm volatile("s_waitcnt lgkmcnt(" #n ")" ::: "memory")
#define PG8_BAR __builtin_amdgcn_s_barrier()
#define PG8_SCHED __builtin_amdgcn_sched_barrier(0)
    Unit cur, nxt; int ui = 0;
    if (!S.next(0, cur)) return;
    f32x4 acc[2][2][4][2];
#pragma unroll
    for (int a = 0; a < 2; ++a)
#pragma unroll
        for (int b = 0; b < 2; ++b)
#pragma unroll
            for (int m = 0; m < 4; ++m)
#pragma unroll
                for (int n = 0; n < 2; ++n) acc[a][b][m][n] = (f32x4){0.f, 0.f, 0.f, 0.f};
    bf16x8 At[4][2], B0[2][2], B1[2][2];
    const char* cA = cur.a; const char* cB = cur.b;
    static_assert(SP2, "only the SP2 loop is kept");
    PG8_STAGE(PG8_SB(0, 0), cB, voffB); PG8_STAGE(PG8_SB(0, 1), cB + hstepB, voffB); PG8_STAGE(PG8_SA(0, 0), cA, voffA); PG8_STAGE(PG8_SA(0, 1), cA + hstepA, voffA);
    if (wr == 1) PG8_BAR;
    PG8_WAIT_V(2); PG8_BAR;
    PG8_STAGE(PG8_SB(1, 0), cB + kstepB, voffB); PG8_STAGE(PG8_SA(1, 0), cA + kstepA, voffA); PG8_STAGE(PG8_SB(1, 1), cB + hstepB + kstepB, voffB);
    PG8_WAIT_V(6); PG8_BAR;
    for (;;) {
        const bool has_next = S.next(ui + 1, nxt);
        const char* nA = has_next ? nxt.a : cA; const char* nB = has_next ? nxt.b : cB;
#pragma unroll 1
        for (int t = 0; t < nt; t += 2) {
            if constexpr (Epi::HAS_MID) { if (t == E.mid_t) { E.mid(acc, cur, wr, wc, fr, fq); PG8_SCHED; } }
            const bool last = (t == nt - 2);
            const char* a1 = cA + (size_t)(t + 1) * kstepA;
            const char* a2 = last ? nA : cA + (size_t)(t + 2) * kstepA; const char* b2 = last ? nB : cB + (size_t)(t + 2) * kstepB;
            const char* a3 = a2 + kstepA; const char* b3 = b2 + kstepB;
            PG8_LDB(B0, 0, 0); PG8_LDB(B1, 0, 1); PG8_SCHED; PG8_LDA(At, 0, 0); PG8_STAGE(PG8_SA(1, 1), a1 + hstepA, voffA);
            PG8_WAIT_V(8); PG8_WAIT_L(0); PG8_BAR; PG8_MMA(0, 0, At, B0); PG8_MMA(0, 1, At, B1); PG8_BAR; PG8_SCHED;
            PG8_LDA(At, 0, 1); PG8_STAGE(PG8_SB(0, 0), b2, voffB); PG8_STAGE(PG8_SB(0, 1), b2 + hstepB, voffB); PG8_STAGE(PG8_SA(0, 0), a2, voffA);
            PG8_WAIT_V(8); PG8_WAIT_L(0); PG8_BAR; PG8_MMA(1, 0, At, B0); PG8_MMA(1, 1, At, B1); PG8_BAR; PG8_SCHED;
            PG8_LDB(B0, 1, 0); PG8_LDB(B1, 1, 1); PG8_SCHED; PG8_LDA(At, 1, 0); PG8_STAGE(PG8_SA(0, 1), a2 + hstepA, voffA);
            PG8_WAIT_V(8); PG8_WAIT_L(0); PG8_BAR; PG8_MMA(0, 0, At, B0); PG8_MMA(0, 1, At, B1); PG8_BAR; PG8_SCHED;
            PG8_LDA(At, 1, 1); PG8_STAGE(PG8_SB(1, 0), b3, voffB); PG8_STAGE(PG8_SB(1, 1), b3 + hstepB, voffB); PG8_STAGE(PG8_SA(1, 0), a3, voffA);
            PG8_WAIT_V(8); PG8_WAIT_L(0); PG8_BAR; PG8_MMA(1, 0, At, B0); PG8_MMA(1, 1, At, B1); PG8_BAR; PG8_SCHED;
        }
        if constexpr (ALIGN_EPI) { if (wr == 0) PG8_BAR; }
        E(acc, cur, wr, wc, fr, fq);
        if (!has_next) break;
#pragma unroll
        for (int a = 0; a < 2; ++a)
#pragma unroll
            for (int b = 0; b < 2; ++b)
#pragma unroll
                for (int m = 0; m < 4; ++m)
#pragma unroll
                    for (int n = 0; n < 2; ++n) acc[a][b][m][n] = (f32x4){0.f, 0.f, 0.f, 0.f};
        cur = nxt; cA = nA; cB = nB; ++ui;
        if constexpr (ALIGN_EPI) { if (wr == 1) PG8_BAR; }
    }
    PG8_WAIT_V(0);
    if constexpr (!ALIGN_EPI) { if (wr == 0) PG8_BAR; }
    PG8_BAR;
#undef PG8_SA
#undef PG8_SB
#undef PG8_STAGE
#undef PG8_LDA
#undef PG8_LDB
#undef PG8_MMA
#undef PG8_WAIT_V
#undef PG8_WAIT_L
#undef PG8_BAR
#undef PG8_SCHED
}

template <class F> struct EpiGen8 {
    static constexpr bool PERM = true, HAS_MID = false; F f; int mid_t;
    __device__ __forceinline__ void mid(f32x4 (&)[2][2][4][2], const Unit&, int, int, int, int) const {}
    __device__ __forceinline__ void operator()(const f32x4 (&acc)[2][2][4][2], const Unit& u, int wr, int wc, int fr, int fq) const {
#pragma unroll
        for (int ai = 0; ai < 2; ++ai)
#pragma unroll
            for (int m = 0; m < 4; ++m) { const int r = ai * HALF + wr * 64 + m * 16 + fr;
#pragma unroll
                for (int bj = 0; bj < 2; ++bj) f(u, r, bj * HALF + wc * 32 + 8 * fq, acc[ai][bj][m][0], acc[ai][bj][m][1]);
                if constexpr (F::PIN) __builtin_amdgcn_sched_barrier(0); }
    }
};
}

typedef const float* cfp_t;
typedef __attribute__((address_space(4))) const cfp_t* InTab;
struct Frame {
    LAS unsigned char* lds;
    volatile LAS unsigned* MISC;
    gu32* ctl;
    int tid, lane, wave, vcu, G;
    unsigned char* ws; unsigned char* dout; unsigned char* ws0; unsigned char* dout0;
    InTab in;
};
enum { I_X = 0, I_NMPRE, I_NMPOST, I_NFPRE, I_NFPOST, I_WIN, I_BGATE, I_MU, I_W0, I_W2, I_A0, I_A2, I_G2, I_KK, I_KA, I_RK, I_LNW, I_LNB,
       I_SARE, I_SAIM, I_SBRE, I_SBIM, I_SCRE, I_SCIM, I_SD, I_SLOG, I_WGLU, I_BGLU, I_WBR, I_WBS, I_WOUT, I_WUP, I_CONVW, I_CONVB, I_WDN };

__device__ __forceinline__ void p0_transpose_item(const float* W, int ldw, int k0, int src0, bf16_t* WT, int ldt, int drow0, int koff, const float* kscale, LAS float* scr, int lane) {
    const int q = lane & 7, rb = lane >> 3;
    f32x4 v[8]; float sc[8];
#pragma unroll
    for (int i = 0; i < 8; ++i) { const int kk = 8 * i + rb; v[i] = __builtin_nontemporal_load((const f32x4*)(W + (size_t)(k0 + kk) * ldw + src0 + 4 * q)); sc[i] = kscale ? kscale[k0 + kk] : 1.0f; }
#pragma unroll
    for (int i = 0; i < 8; ++i) { const int kk = 8 * i + rb; LAS float* d = scr + kk * 33 + 4 * q; d[0] = v[i].x * sc[i]; d[1] = v[i].y * sc[i]; d[2] = v[i].z * sc[i]; d[3] = v[i].w * sc[i]; }
    LDS_WAIT(); asm volatile("" ::: "memory");
    const int c = lane & 7;
#pragma unroll
    for (int j = 0; j < 4; ++j) { const int n = (lane >> 3) + 8 * j; const LAS float* s = scr + (8 * c) * 33 + n;
        u32x4 o; o.x = cvt_pk_bf16(s[0 * 33], s[1 * 33]); o.y = cvt_pk_bf16(s[2 * 33], s[3 * 33]); o.z = cvt_pk_bf16(s[4 * 33], s[5 * 33]); o.w = cvt_pk_bf16(s[6 * 33], s[7 * 33]);
        *(GAS u32x4*)(WT + (size_t)(drow0 + n) * ldt + koff + k0 + 8 * c) = o; }
    LDS_WAIT(); asm volatile("" ::: "memory");
}
struct TrMat { int in_idx, K, N, ldt, koff, kind; size_t dst; int scale_idx; };
__device__ __forceinline__ void p0_do_matrix(Frame& F, const TrMat& mtx, int r, LAS float* scr) {
    const int nblk = mtx.N / 32, kb = r / nblk, nb = r % nblk;
    int src0 = 32 * nb;
    if (mtx.kind == 1) {
        const int pn = (32 * nb) >> 8, within = (32 * nb) & 255;
        src0 = (within < 128 ? 0 : FF - 128) + 128 * pn + within;
    }
    p0_transpose_item(F.in[mtx.in_idx], mtx.N, 64 * kb, src0, (bf16_t*)(F.ws + mtx.dst), mtx.ldt, 32 * nb, mtx.koff, mtx.scale_idx >= 0 ? F.in[mtx.scale_idx] : nullptr, scr, F.lane);
}
__device__ __forceinline__ void p0_s5_group(Frame& F, int g) {
    LAS float* pwr = (LAS float*)(F.lds);
    LAS float* pwi = pwr + 17 * 64;
    LAS float* bbr = pwi + 17 * 64;
    LAS float* bbi = bbr + 1024;
    LAS float* cre = bbi + 1024;
    LAS float* cim = cre + 1024;
    LAS float* kk = cim + 1024;
    const float dt = expf(F.in[I_SLOG][g]);
    for (int idx = F.tid; idx < 17 * 64; idx += 512) { const int k = idx >> 6, p = idx & 63;
        const float are = F.in[I_SARE][g * 64 + p], aim = F.in[I_SAIM][g * 64 + p];
        const float mag = expf((float)k * are * dt); float sn, cs; sincosf((float)k * aim * dt, &sn, &cs);
        pwr[idx] = mag * cs; pwi[idx] = mag * sn; }
    for (int idx = F.tid; idx < 1024; idx += 512) { cre[idx] = F.in[I_SCRE][g * 1024 + idx]; cim[idx] = F.in[I_SCIM][g * 1024 + idx]; }
    __syncthreads();
    for (int idx = F.tid; idx < 1024; idx += 512) { const int p = idx >> 4;
        const float are = F.in[I_SARE][g * 64 + p], aim = F.in[I_SAIM][g * 64 + p];
        const float nr = pwr[64 + p] - 1.0f, ni = pwi[64 + p];
        const float den = 1.0f / (are * are + aim * aim);
        const float qr = (nr * are + ni * aim) * den, qi = (ni * are - nr * aim) * den;
        const float br = F.in[I_SBRE][g * 1024 + idx], bi = F.in[I_SBIM][g * 1024 + idx];
        bbr[idx] = qr * br - qi * bi; bbi[idx] = qr * bi + qi * br; }
    __syncthreads();
    {
        const int kc = F.tid & 255, ph = F.tid >> 8, k = kc >> 4, c = kc & 15; float s[16];
#pragma unroll
        for (int e = 0; e < 16; ++e) s[e] = 0.f;
        for (int p = 32 * ph; p < 32 * ph + 32; ++p) { const float cr_ = cre[c * 64 + p], ci_ = cim[c * 64 + p], pr_ = pwr[k * 64 + p], pi_ = pwi[k * 64 + p];
            const float xr = cr_ * pr_ - ci_ * pi_, xi = cr_ * pi_ + ci_ * pr_;
#pragma unroll
            for (int e4 = 0; e4 < 4; ++e4) { const f32x4 br = *(LAS const f32x4*)(bbr + p * 16 + 4 * e4), bi = *(LAS const f32x4*)(bbi + p * 16 + 4 * e4);
#pragma unroll
                for (int e = 0; e < 4; ++e) s[4 * e4 + e] += xr * br[e] - xi * bi[e]; } }
        LAS float* part = kk + 4096;
        if (ph == 1) {
#pragma unroll
            for (int e4 = 0; e4 < 4; ++e4) *(LAS f32x4*)(part + kc * 16 + 4 * e4) = (f32x4){s[4 * e4], s[4 * e4 + 1], s[4 * e4 + 2], s[4 * e4 + 3]}; }
        __syncthreads();
        if (ph == 0) {
#pragma unroll
            for (int e4 = 0; e4 < 4; ++e4) { const f32x4 o = *(LAS const f32x4*)(part + kc * 16 + 4 * e4);
#pragma unroll
                for (int e = 0; e < 4; ++e) { float v = s[4 * e4 + e] + o[e]; if (k == 0 && c == 4 * e4 + e) v += F.in[I_SD][g * 16 + c]; kk[kc * 16 + 4 * e4 + e] = v; } } }
    }
    __syncthreads();
    bf16_t* B1b = (bf16_t*)(F.ws + WS_B1B) + (size_t)g * 256 * 384;
    for (int idx = F.tid; idx < 256 * 48; idx += 512) { const int n = idx / 48, j = idx - n * 48, t = n >> 4, c = n & 15; float v[8];
        if (j < 32) { const int tau = j >> 1, cp0 = (j & 1) * 8; const int ko = (t >= tau ? t - tau : 0) * 256 + c * 16 + cp0; const float m = (t >= tau) ? 1.f : 0.f;
            const f32x4 a0 = *(LAS const f32x4*)(kk + ko), a1 = *(LAS const f32x4*)(kk + ko + 4);
#pragma unroll
            for (int e = 0; e < 4; ++e) { v[e] = a0[e] * m; v[4 + e] = a1[e] * m; } }
        else { const int p0 = (j - 32) * 4; const f32x4 cr4 = *(LAS const f32x4*)(cre + c * 64 + p0), ci4 = *(LAS const f32x4*)(cim + c * 64 + p0), pr4 = *(LAS const f32x4*)(pwr + (t + 1) * 64 + p0), pi4 = *(LAS const f32x4*)(pwi + (t + 1) * 64 + p0);
#pragma unroll
            for (int q = 0; q < 4; ++q) { v[2 * q] = cr4[q] * pr4[q] - ci4[q] * pi4[q]; v[2 * q + 1] = -(cr4[q] * pi4[q] + ci4[q] * pr4[q]); } }
        *(u32x4*)(B1b + (size_t)n * 384 + 8 * j) = pack8(v); }
    bf16_t* B1a = (bf16_t*)(F.ws + WS_B1A) + (size_t)g * 256 * 256;
    for (int idx = F.tid; idx < 256 * 32; idx += 512) { const int n = idx >> 5, j = idx & 31; float v[8];
#pragma unroll
        for (int e = 0; e < 8; ++e) v[e] = 0.f;
        if (n < 128) { const int p = n >> 1, tau = j >> 1, cp0 = (j & 1) * 8; const float pr_ = pwr[(15 - tau) * 64 + p], pi_ = pwi[(15 - tau) * 64 + p];
            const f32x4 r0 = *(LAS const f32x4*)(bbr + p * 16 + cp0), r1 = *(LAS const f32x4*)(bbr + p * 16 + cp0 + 4), i0 = *(LAS const f32x4*)(bbi + p * 16 + cp0), i1 = *(LAS const f32x4*)(bbi + p * 16 + cp0 + 4);
#pragma unroll
            for (int e = 0; e < 8; ++e) { const float br = e < 4 ? r0[e & 3] : r1[e & 3], bi = e < 4 ? i0[e & 3] : i1[e & 3]; v[e] = (n & 1) ? (pr_ * bi + pi_ * br) : (pr_ * br - pi_ * bi); } }
        *(u32x4*)(B1a + (size_t)n * 256 + 8 * j) = pack8(v); }
    float* aL = (float*)(F.ws + WS_AL) + g * 128;
    if (F.tid < 64) { aL[2 * F.tid] = pwr[16 * 64 + F.tid]; aL[2 * F.tid + 1] = pwi[16 * 64 + F.tid]; }
    __syncthreads();
}
#define DO_MAT(in_idx, K_, N_, ldt_, koff_, kind_, dst_, sc_) do { const TrMat mtx{in_idx, K_, N_, ldt_, koff_, kind_, dst_, sc_}; const int items = ((K_) / 64) * ((N_) / 32); \
        for (int it = gw; it < base + items; it += NGW) { if (it >= base) p0_do_matrix(F, mtx, it - base, scr); } base += items; } while (0)
__device__ __forceinline__ void p0_late_mats(Frame& F, int gw, int NGW) {
    LAS float* scr = (LAS float*)(F.lds + F.wave * 16384);
    int base = 0;
    DO_MAT(I_WUP, D, 2 * FF, D, 0, 1, WS_WUP, I_NFPRE); DO_MAT(I_WDN, FF, D, FF, 0, 0, WS_WDN, -1); DO_MAT(I_WOUT, D, D, D, 0, 0, WS_WOUT, -1);
    DO_MAT(I_WBR, RW, D, D, 0, 0, WS_WBRS, -1); DO_MAT(I_WBS, RW, D, D, RW, 0, WS_WBRS, -1); DO_MAT(I_WGLU, RW, RW, RW, 0, 0, WS_WGLU, -1);
}
__device__ __forceinline__ void p0_prologue(Frame& F) {
    const bool s5wg = F.vcu < S5G && F.G > S5G;
    if (F.vcu < S5G) p0_s5_group(F, F.vcu);
    if (!s5wg) {
        LAS float* scr = (LAS float*)(F.lds + F.wave * 16384);
        const int gw = (F.G > S5G ? F.vcu - S5G : F.vcu) * NWAVES + F.wave, NGW = (F.G > S5G ? F.G - S5G : F.G) * NWAVES;
        int base = 0;
        DO_MAT(I_WIN, D, NIN, D, 0, 0, WS_WIN, I_NMPRE);
        DO_MAT(I_W2, 64, RW, 64, 0, 0, WS_W2T, -1); DO_MAT(I_A2, 64, RW, 64, 0, 0, WS_A2T, -1); DO_MAT(I_G2, 128, RW, 128, 0, 0, WS_G2T, -1);
    }
    {
        bf16_t* XN = (bf16_t*)(F.ws + WS_XN);
        const int nch = T / 4, split = (F.G > S5G) ? nch / 2 : 0;
#pragma unroll 1
        for (int pass = 0; pass < 2; ++pass) {
            if (pass == 0 && (s5wg || split == 0)) continue;
            const int lo = pass == 0 ? 0 : split, hi = pass == 0 ? split : nch;
            const int gw = (pass == 0 ? F.vcu - S5G : F.vcu) * NWAVES + F.wave, NGW = (pass == 0 ? F.G - S5G : F.G) * NWAVES;
#pragma unroll 1
            for (int ch = lo + gw; ch < hi; ch += NGW) {
                const int m = 4 * ch;
                f32x4 v[4][4]; float s[4];
#pragma unroll
                for (int q = 0; q < 4; ++q) { const GAS f32x4* xr = (const GAS f32x4*)(F.in[I_X] + (size_t)(m + q) * D) + F.lane;
#pragma unroll
                    for (int j = 0; j < 4; ++j) v[q][j] = __builtin_nontemporal_load((const f32x4*)(xr + 64 * j)); }
#pragma unroll
                for (int q = 0; q < 4; ++q) { s[q] = 0.f;
#pragma unroll
                    for (int j = 0; j < 4; ++j) s[q] += (v[q][j].x * v[q][j].x + v[q][j].y * v[q][j].y) + (v[q][j].z * v[q][j].z + v[q][j].w * v[q][j].w); }
#pragma unroll
                for (int q = 0; q < 4; ++q) { const float r = 1.0f / sqrtf(wave_sum(s[q]) * (1.f / D) + 1e-6f);
                    GAS u32x2* o = (GAS u32x2*)(XN + (size_t)(m + q) * D) + F.lane;
#pragma unroll
                    for (int j = 0; j < 4; ++j) { u32x2 w; w.x = cvt_pk_bf16(v[q][j].x * r, v[q][j].y * r); w.y = cvt_pk_bf16(v[q][j].z * r, v[q][j].w * r); o[64 * j] = w; } }
            }
        }
    }
}

struct EpiInProj {
    static constexpr bool PERM = true, HAS_MID = false;
    bf16_t* PR; bf16_t* UG; bf16_t* GT; const float* bg; int mid_t;
    __device__ __forceinline__ void mid(f32x4 (&)[2][2][4][2], const pg8::Unit&, int, int, int, int) const {}
    __device__ __forceinline__ void operator()(const f32x4 (&acc)[2][2][4][2], const pg8::Unit& u, int wr, int wc, int fr, int fq) const {
        f32x4 b0[2], b1[2];
        if (u.pn >= 9) {
#pragma unroll
            for (int bj = 0; bj < 2; ++bj) { const int gc = (u.pn - 9) * 256 + bj * 128 + wc * 32 + 8 * fq; b0[bj] = *(const f32x4*)(bg + gc); b1[bj] = *(const f32x4*)(bg + gc + 4); } }
#pragma unroll
        for (int ai = 0; ai < 2; ++ai)
#pragma unroll
            for (int m = 0; m < 4; ++m) { const int row = u.pm * 256 + ai * 128 + wr * 64 + m * 16 + fr;
#pragma unroll
                for (int bj = 0; bj < 2; ++bj) { const int cl = bj * 128 + wc * 32 + 8 * fq; const f32x4 v0 = acc[ai][bj][m][0], v1 = acc[ai][bj][m][1]; u32x4 w;
                    if (u.pn < 7) { w.x = cvt_pk_bf16(v0[0], v0[1]); w.y = cvt_pk_bf16(v0[2], v0[3]); w.z = cvt_pk_bf16(v1[0], v1[1]); w.w = cvt_pk_bf16(v1[2], v1[3]);
                        *(u32x4*)(PR + (size_t)row * NRW + u.pn * 256 + cl) = w; }
                    else if (u.pn < 9) { const int cr = (u.pn - 7) * 256 + cl, g = cr >> 4, c0 = cr & 15;
                        w.x = cvt_pk_bf16(v0[0], v0[1]); w.y = cvt_pk_bf16(v0[2], v0[3]); w.z = cvt_pk_bf16(v1[0], v1[1]); w.w = cvt_pk_bf16(v1[2], v1[3]);
                        *(u32x4*)(UG + ((size_t)g * S5ROWS + (row >> 4)) * UGLD + (row & 15) * 16 + c0) = w; }
                    else { const int gc = (u.pn - 9) * 256 + cl;
                        w.x = cvt_pk_bf16(fsigmoid(v0[0] + b0[bj][0]), fsigmoid(v0[1] + b0[bj][1])); w.y = cvt_pk_bf16(fsigmoid(v0[2] + b0[bj][2]), fsigmoid(v0[3] + b0[bj][3]));
                        w.z = cvt_pk_bf16(fsigmoid(v1[0] + b1[bj][0]), fsigmoid(v1[1] + b1[bj][1])); w.w = cvt_pk_bf16(fsigmoid(v1[2] + b1[bj][2]), fsigmoid(v1[3] + b1[bj][3]));
                        __builtin_nontemporal_store(w, (u32x4*)(GT + ((size_t)(u.pm * 8 + (u.pn - 9)) << 16) + (((wr * 4 + wc) * 16 + (ai * 4 + m) * 2 + bj) << 9) + (fq * 16 + fr) * 8)); } }
                __builtin_amdgcn_sched_barrier(0); }
    }
};
struct FS5Out {
    static constexpr bool PIN = true;
    bf16_t* YSP;
    __device__ __forceinline__ void operator()(const pg8::Unit& u, int r, int cl, f32x4 v0, f32x4 v1) const {
        const int crow = u.pm * 256 + r; u32x4 w;
        w.x = cvt_pk_bf16(fgelu(v0[0]), fgelu(v0[1])); w.y = cvt_pk_bf16(fgelu(v0[2]), fgelu(v0[3])); w.z = cvt_pk_bf16(fgelu(v1[0]), fgelu(v1[1])); w.w = cvt_pk_bf16(fgelu(v1[2]), fgelu(v1[3]));
        *(u32x4*)(YSP + ((size_t)u.pn * S5ROWS + crow) * 256 + cl) = w;
    }
};
struct EpiGlu {
    static constexpr bool PERM = true, HAS_MID = false;
    const bf16_t* YSP; bf16_t* YS; const float* bglu; int mid_t;
    __device__ __forceinline__ void mid(f32x4 (&)[2][2][4][2], const pg8::Unit&, int, int, int, int) const {}
    __device__ __forceinline__ void operator()(const f32x4 (&acc)[2][2][4][2], const pg8::Unit& u, int wr, int wc, int fr, int fq) const {
        u32x4 yv[2][4][2]; f32x4 b0[2], b1[2];
#pragma unroll
        for (int bj = 0; bj < 2; ++bj) { const int col = u.pn * 256 + bj * 128 + wc * 32 + 8 * fq; b0[bj] = *(const f32x4*)(bglu + col); b1[bj] = *(const f32x4*)(bglu + col + 4); }
#pragma unroll
        for (int ai = 0; ai < 2; ++ai)
#pragma unroll
            for (int m = 0; m < 4; ++m)
#pragma unroll
                for (int bj = 0; bj < 2; ++bj) { const int row = u.pm * 256 + ai * 128 + wr * 64 + m * 16 + fr, col = u.pn * 256 + bj * 128 + wc * 32 + 8 * fq;
                    yv[ai][m][bj] = __builtin_nontemporal_load((const u32x4*)(YSP + ((size_t)(col >> 4) * S5ROWS + (row >> 4)) * 256 + (row & 15) * 16 + (col & 15))); }
#pragma unroll
        for (int ai = 0; ai < 2; ++ai)
#pragma unroll
            for (int m = 0; m < 4; ++m) {
#pragma unroll
                for (int bj = 0; bj < 2; ++bj) { const int row = u.pm * 256 + ai * 128 + wr * 64 + m * 16 + fr, col = u.pn * 256 + bj * 128 + wc * 32 + 8 * fq; float y[8]; unpack8(yv[ai][m][bj], y);
                    const f32x4 v0 = acc[ai][bj][m][0], v1 = acc[ai][bj][m][1]; u32x4 w;
                    w.x = cvt_pk_bf16(y[0] * fsigmoid(v0[0] + b0[bj][0]), y[1] * fsigmoid(v0[1] + b0[bj][1])); w.y = cvt_pk_bf16(y[2] * fsigmoid(v0[2] + b0[bj][2]), y[3] * fsigmoid(v0[3] + b0[bj][3]));
                    w.z = cvt_pk_bf16(y[4] * fsigmoid(v1[0] + b1[bj][0]), y[5] * fsigmoid(v1[1] + b1[bj][1])); w.w = cvt_pk_bf16(y[6] * fsigmoid(v1[2] + b1[bj][2]), y[7] * fsigmoid(v1[3] + b1[bj][3]));
                    *(u32x4*)(YS + (size_t)row * D + RW + col) = w; }
                __builtin_amdgcn_sched_barrier(0); }
    }
};
struct FStore {
    static constexpr bool PIN = false;
    bf16_t* O; int ldc;
    __device__ __forceinline__ void operator()(const pg8::Unit& u, int r, int cl, f32x4 v0, f32x4 v1) const {
        u32x4 w; w.x = cvt_pk_bf16(v0[0], v0[1]); w.y = cvt_pk_bf16(v0[2], v0[3]); w.z = cvt_pk_bf16(v1[0], v1[1]); w.w = cvt_pk_bf16(v1[2], v1[3]);
        *(u32x4*)(O + (size_t)(u.pm * 256 + r) * ldc + u.pn * 256 + cl) = w;
    }
};
struct EpiMerge {
    static constexpr bool PERM = true, HAS_MID = true;
    const bf16_t* GT; bf16_t* O; int mid_t;
    __device__ __forceinline__ void mid(f32x4 (&acc)[2][2][4][2], const pg8::Unit& u, int wr, int wc, int fr, int fq) const {
        unsigned vo = (unsigned)((((wr * 4 + wc) * 16) << 9) + (fq * 16 + fr) * 8) * 2u; asm volatile("" : "+v"(vo));
        const char* gr = (const char*)(GT + ((size_t)(u.pm * 8 + u.pn) << 16)); const char* gs = (const char*)(GT + ((size_t)(u.pm * 8 + 4 + u.pn) << 16));
#pragma unroll
        for (int ai = 0; ai < 2; ++ai)
#pragma unroll
            for (int m = 0; m < 4; ++m) {
                u32x4 a[2], b[2];
#pragma unroll
                for (int bj = 0; bj < 2; ++bj) { const unsigned go = vo + (unsigned)((((ai * 4 + m) * 2 + bj) << 9) * 2); a[bj] = __builtin_nontemporal_load((const u32x4*)(gr + go)); b[bj] = __builtin_nontemporal_load((const u32x4*)(gs + go)); }
                __builtin_amdgcn_sched_barrier(0);
#pragma unroll
                for (int bj = 0; bj < 2; ++bj) {
                    const unsigned aw[4] = {a[bj].x, a[bj].y, a[bj].z, a[bj].w}, bw[4] = {b[bj].x, b[bj].y, b[bj].z, b[bj].w};
#pragma unroll
                    for (int h = 0; h < 4; ++h) {
                        acc[ai][bj][m][h >> 1][2 * (h & 1)] *= bf_lo(aw[h]) * __builtin_amdgcn_rcpf(bf_lo(bw[h]));
                        acc[ai][bj][m][h >> 1][2 * (h & 1) + 1] *= bf_hi(aw[h]) * __builtin_amdgcn_rcpf(bf_hi(bw[h])); } }
                __builtin_amdgcn_sched_barrier(0);
            }
    }
    __device__ __forceinline__ void operator()(const f32x4 (&acc)[2][2][4][2], const pg8::Unit& u, int wr, int wc, int fr, int fq) const {
        const size_t lo = ((size_t)((wr * 4 + wc) * 16) << 9) + (fq * 16 + fr) * 8;
        const bf16_t* gs = GT + ((size_t)(u.pm * 8 + 4 + u.pn) << 16) + lo;
        u32x4 gv[2][4][2];
#pragma unroll
        for (int ai = 0; ai < 2; ++ai)
#pragma unroll
            for (int m = 0; m < 4; ++m)
#pragma unroll
                for (int bj = 0; bj < 2; ++bj) gv[ai][m][bj] = __builtin_nontemporal_load((const u32x4*)(gs + (((ai * 4 + m) * 2 + bj) << 9)));
#pragma unroll
        for (int ai = 0; ai < 2; ++ai)
#pragma unroll
            for (int m = 0; m < 4; ++m) {
#pragma unroll
                for (int bj = 0; bj < 2; ++bj) { const int row = u.pm * 256 + ai * 128 + wr * 64 + m * 16 + fr, col = u.pn * 256 + bj * 128 + wc * 32 + 8 * fq; float g[8]; unpack8(gv[ai][m][bj], g);
                    const f32x4 v0 = acc[ai][bj][m][0], v1 = acc[ai][bj][m][1]; u32x4 w;
                    w.x = cvt_pk_bf16(v0[0] * g[0], v0[1] * g[1]); w.y = cvt_pk_bf16(v0[2] * g[2], v0[3] * g[3]); w.z = cvt_pk_bf16(v1[0] * g[4], v1[1] * g[5]); w.w = cvt_pk_bf16(v1[2] * g[6], v1[3] * g[7]);
                    *(u32x4*)(O + (size_t)row * D + col) = w; }
                __builtin_amdgcn_sched_barrier(0); }
    }
};
struct UpOrder {
    const bf16_t* H2; const bf16_t* Wt; int G, c;
    __device__ bool next(int i, pg8::Unit& u) const {
        constexpr int nM = NB * 16, nN = 22, nwg = nM * nN;
        const long L = (long)i * G + c; if (L >= nwg) return false;
        int wgid = (int)L; { const int q = nwg / 8, r = nwg % 8, xcd = wgid % 8, off = wgid / 8; wgid = (xcd < r ? xcd * (q + 1) : r * (q + 1) + (xcd - r) * q) + off; }
        const int nig = 8 * nN, gid = wgid / nig, fm = gid * 8, gsz = (nM - fm) < 8 ? (nM - fm) : 8;
        u.pm = fm + ((wgid % nig) % gsz); u.pn = (wgid % nig) / gsz;
        u.a = (const char*)H2 + ((size_t)u.pm * 256 * D) * 2; u.b = (const char*)(Wt + (size_t)u.pn * 256 * D); return true;
    }
};
template <int CTRL> __device__ __forceinline__ unsigned dppu(unsigned v) { return (unsigned)__builtin_amdgcn_update_dpp(0, (int)v, CTRL, 0xf, 0xf, true); }
template <int CTRL> __device__ __forceinline__ unsigned dppk(unsigned keep, unsigned v) { return (unsigned)__builtin_amdgcn_update_dpp((int)keep, (int)v, CTRL, 0xf, 0xf, false); }
struct EpiConvAct {
    static constexpr bool PERM = true, HAS_MID = false;
    bf16_t* ACT; const float* cw; const float* cb; LAS unsigned* EX; unsigned long long* HZ; unsigned* tmo; int mid_t;
    __device__ __forceinline__ void mid(f32x4 (&)[2][2][4][2], const pg8::Unit&, int, int, int, int) const {}
    __device__ __forceinline__ void operator()(f32x4 (&acc)[2][2][4][2], const pg8::Unit& u, int wr, int wc, int fr, int fq) const {
        const int b = u.pm >> 4, k = u.pm & 15, t0 = 256 * k;
        u32x2 zp[2][2][4][2];
#pragma unroll
        for (int ai = 0; ai < 2; ++ai)
#pragma unroll
            for (int bj = 0; bj < 2; ++bj)
#pragma unroll
                for (int m = 0; m < 4; ++m)
#pragma unroll
                    for (int n = 0; n < 2; ++n) { const f32x4 v = acc[ai][bj][m][n]; u32x2 w; w.x = cvt_pk_bf16(v[0], v[1]); w.y = cvt_pk_bf16(v[2], v[3]); zp[ai][bj][m][n] = w; }
        if (fr >= 14) {
#pragma unroll
            for (int ai = 0; ai < 2; ++ai)
#pragma unroll
                for (int bj = 0; bj < 2; ++bj)
#pragma unroll
                    for (int n = 0; n < 2; ++n) *(LAS u32x2*)(EX + (((wc * 4 + 2 * ai + wr) * 2 + (fr - 14)) * 32 + bj * 16 + fq * 4 + n * 2)) = zp[ai][bj][3][n]; }
        if (wr == 1 && k < 15 && fr >= 14) {
            unsigned long long* hz = HZ + ((size_t)(u.pm * 22 + u.pn) * 8 + wc * 2 + (fr - 14)) * 32;
#pragma unroll
            for (int bj = 0; bj < 2; ++bj)
#pragma unroll
                for (int n = 0; n < 2; ++n) { __hip_atomic_store(hz + bj * 16 + fq * 4 + n * 2, (1ull << 32) | zp[1][bj][3][n].x, RLX_AGENT); __hip_atomic_store(hz + bj * 16 + fq * 4 + n * 2 + 1, (1ull << 32) | zp[1][bj][3][n].y, RLX_AGENT); }
        }
        asm volatile("s_waitcnt lgkmcnt(0)" ::: "memory"); __builtin_amdgcn_s_barrier(); asm volatile("" ::: "memory");
        const int ch0 = u.pn * 128 + wc * 32 + 8 * fq;
        f32x4 wg[2][3], wv[2][3], bg[2], bv[2];
#pragma unroll
        for (int n = 0; n < 2; ++n) {
#pragma unroll
            for (int j = 0; j < 3; ++j) { wg[n][j] = *(const f32x4*)(cw + (size_t)j * 2 * FF + ch0 + 4 * n); wv[n][j] = *(const f32x4*)(cw + (size_t)j * 2 * FF + FF + ch0 + 4 * n); }
            bg[n] = *(const f32x4*)(cb + ch0 + 4 * n); bv[n] = *(const f32x4*)(cb + FF + ch0 + 4 * n); }
#pragma unroll
        for (int gi = 1; gi <= 8; ++gi) {
            const int ai = (gi & 7) >> 2, m = gi & 3, blk = 2 * ai + wr;
            u32x2 pp[2][2];
#pragma unroll
            for (int bj = 0; bj < 2; ++bj)
#pragma unroll
                for (int n = 0; n < 2; ++n) { pp[bj][n].x = 0u; pp[bj][n].y = 0u; }
            if (m > 0) {
#pragma unroll
                for (int bj = 0; bj < 2; ++bj)
#pragma unroll
                    for (int n = 0; n < 2; ++n) pp[bj][n] = zp[ai][bj][m - 1][n];
            } else if (blk > 0) {
                if (fr >= 14) {
#pragma unroll
                    for (int bj = 0; bj < 2; ++bj)
#pragma unroll
                        for (int n = 0; n < 2; ++n) pp[bj][n] = *(LAS const u32x2*)(EX + (((wc * 4 + blk - 1) * 2 + (fr - 14)) * 32 + bj * 16 + fq * 4 + n * 2)); }
            } else if (k > 0) {
                if (fr >= 14) {
                    const unsigned long long* hz = HZ + ((size_t)((u.pm - 1) * 22 + u.pn) * 8 + wc * 2 + (fr - 14)) * 32;
#pragma unroll
                    for (int bj = 0; bj < 2; ++bj)
#pragma unroll
                        for (int n = 0; n < 2; ++n) { unsigned long long x0, x1; unsigned sp_ = 0;
                            for (;;) { x0 = __hip_atomic_load(hz + bj * 16 + fq * 4 + n * 2, RLX_AGENT); x1 = __hip_atomic_load(hz + bj * 16 + fq * 4 + n * 2 + 1, RLX_AGENT);
                                if ((x0 >> 32) == 1ull && (x1 >> 32) == 1ull) break; __builtin_amdgcn_s_sleep(2); if (++sp_ > (1u << 20)) { __hip_atomic_store(tmo, 1u, RLX_AGENT); break; } }
                            pp[bj][n].x = (unsigned)x0; pp[bj][n].y = (unsigned)x1; } }
            }
            u32x2 outp[2];
#pragma unroll
            for (int n = 0; n < 2; ++n) {
                const u32x2 zg = zp[ai][0][m][n], zv = zp[ai][1][m][n], pg = pp[0][n], pv = pp[1][n];
                u32x2 g1, g2, v1, v2;
                g1.x = dppk<0x111>(dppu<0x10F>(pg.x), zg.x); g1.y = dppk<0x111>(dppu<0x10F>(pg.y), zg.y); g2.x = dppk<0x112>(dppu<0x10E>(pg.x), zg.x); g2.y = dppk<0x112>(dppu<0x10E>(pg.y), zg.y);
                v1.x = dppk<0x111>(dppu<0x10F>(pv.x), zv.x); v1.y = dppk<0x111>(dppu<0x10F>(pv.y), zv.y); v2.x = dppk<0x112>(dppu<0x10E>(pv.x), zv.x); v2.y = dppk<0x112>(dppu<0x10E>(pv.y), zv.y);
                f32x2 o2[2];
#pragma unroll
                for (int e = 0; e < 2; ++e) {
                    const unsigned w0g = e ? zg.y : zg.x, w1g = e ? g1.y : g1.x, w2g = e ? g2.y : g2.x, w0v = e ? zv.y : zv.x, w1v = e ? v1.y : v1.x, w2v = e ? v2.y : v2.x;
                    const f32x2 z0g = {bf_lo(w0g), bf_hi(w0g)}, z1g = {bf_lo(w1g), bf_hi(w1g)}, z2g = {bf_lo(w2g), bf_hi(w2g)}, z0v = {bf_lo(w0v), bf_hi(w0v)}, z1v = {bf_lo(w1v), bf_hi(w1v)}, z2v = {bf_lo(w2v), bf_hi(w2v)};
                    const f32x2 kg0 = {wg[n][0][2 * e], wg[n][0][2 * e + 1]}, kg1 = {wg[n][1][2 * e], wg[n][1][2 * e + 1]}, kg2 = {wg[n][2][2 * e], wg[n][2][2 * e + 1]}, kb = {bg[n][2 * e], bg[n][2 * e + 1]};
                    const f32x2 kv0 = {wv[n][0][2 * e], wv[n][0][2 * e + 1]}, kv1 = {wv[n][1][2 * e], wv[n][1][2 * e + 1]}, kv2 = {wv[n][2][2 * e], wv[n][2][2 * e + 1]}, kc = {bv[n][2 * e], bv[n][2 * e + 1]};
                    const f32x2 cg = kb + kg0 * z2g + kg1 * z1g + kg2 * z0g, cv = kc + kv0 * z2v + kv1 * z1v + kv2 * z0v;
                    const f32x2 t = cg * cg, q = t * (f32x2){-0.1029432f, -0.1029432f} + (f32x2){-2.3022082f, -2.3022082f}, pw = cg * q;
                    const f32x2 ex = {__builtin_amdgcn_exp2f(pw.x), __builtin_amdgcn_exp2f(pw.y)}, dn = ex + (f32x2){1.f, 1.f};
                    const f32x2 rc = {__builtin_amdgcn_rcpf(dn.x), __builtin_amdgcn_rcpf(dn.y)};
                    o2[e] = (cg * cv) * rc; }
                const float o[4] = {o2[0].x, o2[0].y, o2[1].x, o2[1].y};
                outp[n].x = cvt_pk_bf16(o[0], o[1]); outp[n].y = cvt_pk_bf16(o[2], o[3]);
            }
            const int r = 128 * ai + 64 * wr + 16 * m + fr;
            { u32x4 w4; w4.x = outp[0].x; w4.y = outp[0].y; w4.z = outp[1].x; w4.w = outp[1].y; *(u32x4*)(ACT + ((size_t)(b * SEQ + t0 + r)) * FF + ch0) = w4; }
            __builtin_amdgcn_sched_barrier(0);
        }
    }
};
struct EpiRowStat {
    static constexpr bool PERM = true, HAS_MID = false; bf16_t* O; float* STAT; int mid_t;
    __device__ __forceinline__ void mid(f32x4 (&)[2][2][4][2], const pg8::Unit&, int, int, int, int) const {}
    __device__ __forceinline__ void operator()(const f32x4 (&acc)[2][2][4][2], const pg8::Unit& u, int wr, int wc, int fr, int fq) const {
#pragma unroll
        for (int ai = 0; ai < 2; ++ai)
#pragma unroll
            for (int m = 0; m < 4; ++m) { const int row = u.pm * 256 + ai * 128 + wr * 64 + m * 16 + fr; float s = 0.f;
#pragma unroll
                for (int bj = 0; bj < 2; ++bj) { const int col = u.pn * 256 + bj * 128 + wc * 32 + 8 * fq; const f32x4 v0 = acc[ai][bj][m][0], v1 = acc[ai][bj][m][1]; u32x4 w;
                    s += (v0[0] * v0[0] + v0[1] * v0[1]) + (v0[2] * v0[2] + v0[3] * v0[3]) + (v1[0] * v1[0] + v1[1] * v1[1]) + (v1[2] * v1[2] + v1[3] * v1[3]);
                    w.x = cvt_pk_bf16(v0[0], v0[1]); w.y = cvt_pk_bf16(v0[2], v0[3]); w.z = cvt_pk_bf16(v1[0], v1[1]); w.w = cvt_pk_bf16(v1[2], v1[3]);
                    __builtin_nontemporal_store(w, (u32x4*)(O + (size_t)row * D + col)); }
                s += __shfl_xor(s, 16); s += __shfl_xor(s, 32);
                if (fq == 0) STAT[(size_t)row * 16 + u.pn * 4 + wc] = s; }
    }
};
struct EpiSloc {
    static constexpr bool PERM = false, HAS_MID = false; float* SL; int mid_t;
    __device__ __forceinline__ void mid(f32x4 (&)[2][2][4][2], const pg8::Unit&, int, int, int, int) const {}
    __device__ __forceinline__ void operator()(const f32x4 (&acc)[2][2][4][2], const pg8::Unit& u, int wr, int wc, int fr, int fq) const {
#pragma unroll
        for (int ai = 0; ai < 2; ++ai)
#pragma unroll
            for (int m = 0; m < 4; ++m) { const int row = u.pm * 256 + ai * 128 + wr * 64 + m * 16 + fr; float* p = SL + ((size_t)u.pn * S5ROWS + row) * 128 + wc * 32 + 4 * fq;
                *(f32x4*)(p) = acc[ai][0][m][0]; *(f32x4*)(p + 16) = acc[ai][0][m][1]; }
    }
};
struct S5Order {
    const bf16_t* UG; const bf16_t* Bt; int ldb, G, c;
    __device__ bool next(int i, pg8::Unit& u) const { const int L = i * G + c; if (L >= S5G * 8) return false; const int g = L >> 3; u.pm = L & 7; u.pn = g;
        u.a = (const char*)(UG + ((size_t)g * S5ROWS + u.pm * 256) * UGLD); u.b = (const char*)(Bt + (size_t)g * 256 * ldb); return true; }
};

constexpr int LW = 72;
constexpr int SLOT = 64 * LW * 2;
#define SL(i) ((i) * SLOT)
#define BAR_LDS() do { asm volatile("s_waitcnt lgkmcnt(0)" ::: "memory"); __builtin_amdgcn_s_barrier(); asm volatile("" ::: "memory"); } while (0)
struct LdsMat { LAS const unsigned char* p; int ld; __device__ __forceinline__ bf16x8 frag(int row, int k) const { return *(LAS const bf16x8*)(p + ((size_t)row * ld + k) * 2); } };
struct GlbMat { const bf16_t* p; int ld; __device__ __forceinline__ bf16x8 frag(int row, int k) const { return *(const bf16x8*)(p + (size_t)row * ld + k); } };
template <int KD, class YM, class XM, class EPI>
__device__ __forceinline__ void mm64(const YM& Y, const XM& X, int wid, int lane, const EPI& epi) {
    asm volatile("" : "+v"(lane), "+s"(wid));
    const int at = wid >> 1, bt0 = (wid & 1) * 2, fr = lane & 15, fq = lane >> 4;
    f32x4 acc[2] = {(f32x4){0.f, 0.f, 0.f, 0.f}, (f32x4){0.f, 0.f, 0.f, 0.f}};
#pragma unroll
    for (int s = 0; s < KD / 32; ++s) {
        const bf16x8 yf = Y.frag(16 * at + fr, 32 * s + 8 * fq);
#pragma unroll
        for (int bi = 0; bi < 2; ++bi) { const bf16x8 xf = X.frag(16 * (bt0 + bi) + fr, 32 * s + 8 * fq);
            acc[bi] = __builtin_amdgcn_mfma_f32_16x16x32_bf16(xf, yf, acc[bi], 0, 0, 0); }
    }
#pragma unroll
    for (int bi = 0; bi < 2; ++bi) epi(16 * at + fr, 16 * (bt0 + bi) + 4 * fq, acc[bi]);
}
__device__ __forceinline__ void ld_yf(const LdsMat& Y, int at, int fr, int fq, bf16x8 (&y)[2]) {
#pragma unroll
    for (int s = 0; s < 2; ++s) y[s] = Y.frag(16 * at + fr, 32 * s + 8 * fq);
}
__device__ __forceinline__ void ld_xf(const LdsMat& X, int bt0, int fr, int fq, bf16x8 (&x)[2][2]) {
#pragma unroll
    for (int s = 0; s < 2; ++s)
#pragma unroll
        for (int bi = 0; bi < 2; ++bi) x[s][bi] = X.frag(16 * (bt0 + bi) + fr, 32 * s + 8 * fq);
}
__device__ __forceinline__ void mm_f(const bf16x8 (&y)[2], const bf16x8 (&x)[2][2], f32x4 (&acc)[2]) {
#pragma unroll
    for (int bi = 0; bi < 2; ++bi) acc[bi] = (f32x4){0.f, 0.f, 0.f, 0.f};
#pragma unroll
    for (int s = 0; s < 2; ++s)
#pragma unroll
        for (int bi = 0; bi < 2; ++bi) acc[bi] = __builtin_amdgcn_mfma_f32_16x16x32_bf16(x[s][bi], y[s], acc[bi], 0, 0, 0);
}
template <int KD>
__device__ __forceinline__ void preload_x(const GlbMat& X, int wid, int lane, bf16x8 (&xf)[KD / 32][2]) {
    const int bt0 = (wid & 1) * 2, fr = lane & 15, fq = lane >> 4;
#pragma unroll
    for (int s = 0; s < KD / 32; ++s)
#pragma unroll
        for (int bi = 0; bi < 2; ++bi) xf[s][bi] = X.frag(16 * (bt0 + bi) + fr, 32 * s + 8 * fq);
}
template <int KD, class YM, class EPI>
__device__ __forceinline__ void mm64_pre(const YM& Y, const bf16x8 (&xf)[KD / 32][2], int wid, int lane, const EPI& epi) {
    const int at = wid >> 1, bt0 = (wid & 1) * 2, fr = lane & 15, fq = lane >> 4;
    f32x4 acc[2] = {(f32x4){0.f, 0.f, 0.f, 0.f}, (f32x4){0.f, 0.f, 0.f, 0.f}};
#pragma unroll
    for (int s = 0; s < KD / 32; ++s) {
        const bf16x8 yf = Y.frag(16 * at + fr, 32 * s + 8 * fq);
#pragma unroll
        for (int bi = 0; bi < 2; ++bi) acc[bi] = __builtin_amdgcn_mfma_f32_16x16x32_bf16(xf[s][bi], yf, acc[bi], 0, 0, 0);
    }
#pragma unroll
    for (int bi = 0; bi < 2; ++bi) epi(16 * at + fr, 16 * (bt0 + bi) + 4 * fq, acc[bi]);
}
__device__ __forceinline__ void st_lds4(LAS unsigned char* base, int a, int b0, f32x4 v) { u32x2 w; w.x = cvt_pk_bf16(v[0], v[1]); w.y = cvt_pk_bf16(v[2], v[3]); *(LAS u32x2*)(base + ((size_t)a * LW + b0) * 2) = w; }
__device__ __forceinline__ f32x4 ld_lds4(LAS const unsigned char* base, int a, int b0) { const u32x2 w = *(LAS const u32x2*)(base + ((size_t)a * LW + b0) * 2); return (f32x4){bf_lo(w.x), bf_hi(w.x), bf_lo(w.y), bf_hi(w.y)}; }
__device__ __forceinline__ void st_glb4p(bf16_t* base, int a, int b0, f32x4 v) { u32x2 w; w.x = cvt_pk_bf16(v[0], v[1]); w.y = cvt_pk_bf16(v[2], v[3]); __builtin_nontemporal_store(w, (u32x2*)(base + (size_t)a * GLD + b0)); }
__device__ __forceinline__ void st_glb4(bf16_t* base, int a, int b0, f32x4 v) { u32x2 w; w.x = cvt_pk_bf16(v[0], v[1]); w.y = cvt_pk_bf16(v[2], v[3]); __builtin_nontemporal_store(w, (u32x2*)(base + (size_t)a * 64 + b0)); }

struct PrePf { u32x4 qa[3], qp[3], ra[4], rp[4], wt[4]; };
__device__ __forceinline__ void rwkv_pre_fetch(Frame& F, int unit, bool lr_first, PrePf& P, int tid) {
    const int bh = unit >> 6, c = unit & 63, b = bh >> 3, h = bh & 7;
    const int t = tid >> 3, jb = tid & 7, j0 = jb * 8;
    const int tg = b * SEQ + c * 64 + t;
    const bool hasprev = (c * 64 + t) > 0;
    const bf16_t* prow = (const bf16_t*)(F.ws + WS_PR) + (size_t)tg * NRW; const bf16_t* pprv = hasprev ? prow - NRW : prow;
#pragma unroll
    for (int seg = 0; seg < 3; ++seg) { const int col = seg * 512 + h * 64 + j0; P.qa[seg] = *(const u32x4*)(prow + col); P.qp[seg] = *(const u32x4*)(pprv + col); }
    const u32x4* scr = (const u32x4*)(F.ws + WS_LRSCR) + ((size_t)F.vcu * 512 + tid) * 4;
    const u32x4* pa = lr_first ? (const u32x4*)(prow + 1536 + jb * 32) : scr; const u32x4* pp = lr_first ? (const u32x4*)(pprv + 1536 + jb * 32) : scr;
#pragma unroll
    for (int q4 = 0; q4 < 4; ++q4) { P.ra[q4] = pa[q4]; P.rp[q4] = pp[q4]; }
    P.wt[0] = ((const u32x4*)(F.ws + WS_W2T) + (size_t)h * 512)[tid]; P.wt[1] = ((const u32x4*)(F.ws + WS_A2T) + (size_t)h * 512)[tid];
    P.wt[2] = ((const u32x4*)(F.ws + WS_G2T) + (size_t)h * 1024)[tid]; P.wt[3] = ((const u32x4*)(F.ws + WS_G2T) + (size_t)h * 1024)[512 + tid];
}
__device__ __forceinline__ void rwkv_pre_put_w(LAS unsigned char* L, const PrePf& P, int tid) {
    const int r8 = tid >> 3, c8 = tid & 7, r16 = tid >> 4, c16 = tid & 15;
    *(LAS u32x4*)(L + SL(10) + ((size_t)r8 * LW + c8 * 8) * 2) = P.wt[0]; *(LAS u32x4*)(L + SL(11) + ((size_t)r8 * LW + c8 * 8) * 2) = P.wt[1];
    *(LAS u32x4*)(L + SL(12) + ((size_t)r16 * 136 + c16 * 8) * 2) = P.wt[2]; *(LAS u32x4*)(L + SL(12) + ((size_t)(32 + r16) * 136 + c16 * 8) * 2) = P.wt[3];
}
__device__ __forceinline__ void rwkv_pre_unit(Frame& F, int unit, int next_unit, bool lr_first, bool next_first, PrePf& P) {
    LAS unsigned char* L = F.lds;
    LAS float* XT = (LAS float*)(F.lds + XTRA_OFF);
    int tid = F.tid; asm volatile("" : "+v"(tid));
    int wid = F.wave; asm volatile("" : "+s"(wid));
    const int lane = tid & 63;
    const int bh = unit >> 6, c = unit & 63, b = bh >> 3, h = bh & 7;
    const int t = tid >> 3, jb = tid & 7, j0 = jb * 8;
    const int tg = b * SEQ + c * 64 + t;
    const bool hasprev = (c * 64 + t) > 0;
    const bf16_t* PR = (const bf16_t*)(F.ws + WS_PR);
    const bf16_t* prow = PR + (size_t)tg * NRW; const bf16_t* pprev = prow - NRW;
    LAS const float* mu = (LAS const float*)(F.lds + XTRA_OFF + 4096);
    LAS const float* par = mu + NRW;
    float rs[8], ks[8], vs[8];
    {
        const int c0 = 1536 + jb * 32;
        const float pmask = hasprev ? 1.f : 0.f;
        f32x4 mq[3][2];
#pragma unroll
        for (int seg = 0; seg < 3; ++seg) { const int col = seg * 512 + h * 64 + j0; mq[seg][0] = *(LAS const f32x4*)(mu + col); mq[seg][1] = *(LAS const f32x4*)(mu + col + 4); }
        LAS unsigned char* dst = (jb < 2) ? (L + SL(0) + ((size_t)t * LW + jb * 32) * 2) : (jb < 4) ? (L + SL(1) + ((size_t)t * LW + (jb - 2) * 32) * 2) : (L + SL(2) + ((size_t)t * 136 + (jb - 4) * 32) * 2);
        u32x4* scr = (u32x4*)(F.ws + WS_LRSCR) + ((size_t)F.vcu * 512 + tid) * 4;
        if (lr_first) {
            f32x4 ma[4][2];
#pragma unroll
            for (int q4 = 0; q4 < 4; ++q4) { ma[q4][0] = *(LAS const f32x4*)(mu + c0 + q4 * 8); ma[q4][1] = *(LAS const f32x4*)(mu + c0 + q4 * 8 + 4); }
#pragma unroll
            for (int q4 = 0; q4 < 4; ++q4) { float x[8], xp[8], o[8]; unpack8(P.ra[q4], x); unpack8(P.rp[q4], xp);
#pragma unroll
                for (int e = 0; e < 8; ++e) { const float mm = e < 4 ? ma[q4][0][e] : ma[q4][1][e - 4]; const float s = x[e] + (xp[e] * pmask - x[e]) * mm;
                    const float ex = __builtin_amdgcn_exp2f((jb < 2 ? 2.88539008178f : -1.44269504089f) * s), rc = __builtin_amdgcn_rcpf(1.0f + ex);
                    o[e] = jb < 2 ? 1.0f - 2.0f * rc : (jb < 4 ? s : rc); }
                const u32x4 w = pack8(o); *(LAS u32x4*)(dst + q4 * 16) = w; scr[q4] = w; }
        } else {
#pragma unroll
            for (int q4 = 0; q4 < 4; ++q4) *(LAS u32x4*)(dst + q4 * 16) = P.ra[q4];
        }
#pragma unroll
        for (int seg = 0; seg < 3; ++seg) { float x[8], xp[8]; unpack8(P.qa[seg], x); unpack8(P.qp[seg], xp);
#pragma unroll
            for (int e = 0; e < 8; ++e) { const float mm = e < 4 ? mq[seg][0][e] : mq[seg][1][e - 4]; const float s = x[e] + (xp[e] * pmask - x[e]) * mm; if (seg == 0) rs[e] = s; else if (seg == 1) ks[e] = s; else vs[e] = s; } }
    }
    BAR_LDS();
    {
        const LdsMat Yw{L + SL(0), LW}, Ya{L + SL(1), LW}, Yg{L + SL(2), 136};
        const LdsMat Xw{L + SL(10), LW}, Xa{L + SL(11), LW}, Xg{L + SL(12), 136};
        mm64<64>(Yw, Xw, wid, lane, [&](int a, int b0, f32x4 v) { *(LAS f32x4*)(L + SL(4) + ((size_t)a * 68 + b0) * 4) = v; });
        mm64<64>(Ya, Xa, wid, lane, [&](int a, int b0, f32x4 v) { *(LAS f32x4*)(L + SL(6) + ((size_t)a * 68 + b0) * 4) = v; });
        mm64<128>(Yg, Xg, wid, lane, [&](int a, int b0, f32x4 v) { *(LAS f32x4*)(L + SL(8) + ((size_t)a * 68 + b0) * 4) = v; });
    }
    BAR_LDS();
    float ld[8], kp[8], av[8], bv[8];
    {
        const int hc = h * 64 + j0;
        float wp[8], ap[8], gg[8], w0[8], a0[8], kkw[8], kaw[8], rk[8];
        *(f32x4*)&wp[0] = *(LAS f32x4*)(L + SL(4) + ((size_t)t * 68 + j0) * 4); *(f32x4*)&wp[4] = *(LAS f32x4*)(L + SL(4) + ((size_t)t * 68 + j0 + 4) * 4);
        *(f32x4*)&ap[0] = *(LAS f32x4*)(L + SL(6) + ((size_t)t * 68 + j0) * 4); *(f32x4*)&ap[4] = *(LAS f32x4*)(L + SL(6) + ((size_t)t * 68 + j0 + 4) * 4);
        *(f32x4*)&gg[0] = *(LAS f32x4*)(L + SL(8) + ((size_t)t * 68 + j0) * 4); *(f32x4*)&gg[4] = *(LAS f32x4*)(L + SL(8) + ((size_t)t * 68 + j0 + 4) * 4);
        *(f32x4*)&w0[0] = *(LAS const f32x4*)(par + 0 + hc); *(f32x4*)&w0[4] = *(LAS const f32x4*)(par + 0 + hc + 4);
        *(f32x4*)&a0[0] = *(LAS const f32x4*)(par + 512 + hc); *(f32x4*)&a0[4] = *(LAS const f32x4*)(par + 512 + hc + 4);
        *(f32x4*)&kkw[0] = *(LAS const f32x4*)(par + 1024 + hc); *(f32x4*)&kkw[4] = *(LAS const f32x4*)(par + 1024 + hc + 4);
        *(f32x4*)&kaw[0] = *(LAS const f32x4*)(par + 1536 + hc); *(f32x4*)&kaw[4] = *(LAS const f32x4*)(par + 1536 + hc + 4);
        *(f32x4*)&rk[0] = *(LAS const f32x4*)(par + 2048 + hc); *(f32x4*)&rk[4] = *(LAS const f32x4*)(par + 2048 + hc + 4);
        float ss = 0.f, bon = 0.f, kkv[8], eta[8];
#pragma unroll
        for (int e = 0; e < 8; ++e) {
            ld[e] = -0.60653065971f * fsigmoid(w0[e] + wp[e]);
            eta[e] = fsigmoid(a0[e] + ap[e]);
            kkv[e] = ks[e] * kkw[e]; ss += kkv[e] * kkv[e];
            kp[e] = ks[e] * (1.0f + (eta[e] - 1.0f) * kaw[e]);
            bon += rs[e] * kp[e] * rk[e];
        }
        ss += __shfl_xor(ss, 1); ss += __shfl_xor(ss, 2); ss += __shfl_xor(ss, 4);
        bon += __shfl_xor(bon, 1); bon += __shfl_xor(bon, 2); bon += __shfl_xor(bon, 4);
        const float inv = __builtin_amdgcn_rcpf(fmaxf(__builtin_amdgcn_sqrtf(ss), 1e-12f));
#pragma unroll
        for (int e = 0; e < 8; ++e) { const float kk = kkv[e] * inv; av[e] = -kk; bv[e] = kk * eta[e]; }
        if (jb == 0) ((float*)(F.ws + WS_BONUS))[(size_t)tg * 8 + h] = bon;
        *(u32x4*)((bf16_t*)(F.ws + WS_GBUF) + (size_t)tg * RW + hc) = pack8(gg);
    }
    float Lc[8];
#pragma unroll
    for (int e = 0; e < 8; ++e) { float x = ld[e];
        float y = __shfl_up(x, 8); if (lane >= 8) x += y;
        y = __shfl_up(x, 16); if (lane >= 16) x += y;
        y = __shfl_up(x, 32); if (lane >= 32) x += y;
        Lc[e] = x; }
    if (lane >= 56) {
#pragma unroll
        for (int e = 0; e < 8; ++e) XT[wid * 64 + j0 + e] = Lc[e]; }
    BAR_LDS();
    {
        float pre[8];
#pragma unroll
        for (int e = 0; e < 8; ++e) pre[e] = 0.f;
#pragma unroll
        for (int w = 0; w < 7; ++w) if (w < wid) { const f32x4 x0 = *(LAS const f32x4*)(XT + w * 64 + j0), x1 = *(LAS const f32x4*)(XT + w * 64 + j0 + 4);
#pragma unroll
            for (int e = 0; e < 4; ++e) { pre[e] += x0[e]; pre[4 + e] += x1[e]; } }
#pragma unroll
        for (int e = 0; e < 8; ++e) Lc[e] += pre[e];
    }
    if (t == 63) {
#pragma unroll
        for (int e = 0; e < 8; ++e) XT[512 + j0 + e] = fexp(Lc[e]); }
    {
        float o0[8], o1[8], o2[8], o3[8];
#pragma unroll
        for (int e = 0; e < 8; ++e) { const float ein = fexp(Lc[e]), eout = __builtin_amdgcn_rcpf(ein), eex = fexp(Lc[e] - ld[e]);
            o0[e] = rs[e] * ein; o1[e] = kp[e] * eout; o2[e] = av[e] * eex; o3[e] = bv[e] * eout; }
        const size_t off = ((size_t)t * LW + j0) * 2;
        *(LAS u32x4*)(L + SL(10) + off) = pack8(o0); *(LAS u32x4*)(L + SL(11) + off) = pack8(o1); *(LAS u32x4*)(L + SL(12) + off) = pack8(o2); *(LAS u32x4*)(L + SL(13) + off) = pack8(o3);
        *(LAS u32x4*)(L + SL(2) + off) = pack8(vs);
    }
    BAR_LDS();
    {
        const int srcs[4] = {12, 13, 11, 2}, dsts[4] = {4, 5, 6, 7};
#pragma unroll
        for (int q = 0; q < 4; ++q) { unsigned short hv[8];
#pragma unroll
            for (int e = 0; e < 8; ++e) hv[e] = *(LAS const unsigned short*)(L + SL(srcs[q]) + ((size_t)(8 * wid + e) * LW + lane) * 2);
            u32x4 w; w.x = hv[0] | ((unsigned)hv[1] << 16); w.y = hv[2] | ((unsigned)hv[3] << 16); w.z = hv[4] | ((unsigned)hv[5] << 16); w.w = hv[6] | ((unsigned)hv[7] << 16);
            *(LAS u32x4*)(L + SL(dsts[q]) + ((size_t)lane * LW + 8 * wid) * 2) = w;
        }
    }
    BAR_LDS();
    if (next_unit < NUNIT) rwkv_pre_fetch(F, next_unit, next_first, P, tid);
    const int crow = tid >> 3, cch = tid & 7;
    __builtin_nontemporal_store(*(LAS const u32x4*)(L + SL(7) + ((size_t)crow * LW + cch * 8) * 2), (u32x4*)((bf16_t*)(F.ws + WS_VT) + (size_t)unit * 4096 + crow * 64 + cch * 8));
    {
        const LdsMat Rt{L + SL(10), LW}, Kt{L + SL(11), LW}, At{L + SL(12), LW}, Bt{L + SL(13), LW};
        f32x4 nd = (f32x4){0.f, 0.f, 0.f, 0.f}, ntd = nd;
        {
            int ln = lane, wd = wid; asm volatile("" : "+v"(ln), "+s"(wd));
            const int at = wd >> 1, bt0 = (wd & 1) * 2, fr = ln & 15, fq = ln >> 4, a = 16 * at + fr;
            bf16x8 yA[2], yK[2], yR[2], xB[2][2], xA[2][2], xK[2][2];
            ld_yf(At, at, fr, fq, yA); ld_xf(Bt, bt0, fr, fq, xB); ld_yf(Kt, at, fr, fq, yK); ld_xf(At, bt0, fr, fq, xA); ld_yf(Rt, at, fr, fq, yR); ld_xf(Kt, bt0, fr, fq, xK);
            const bool diag = bt0 == (at & 2);
            bf16x8 xd[2];
            if (diag) ld_yf(Bt, at, fr, fq, xd);
            f32x4 c0[2], c1[2], c2[2], c3[2];
            mm_f(yA, xB, c0); mm_f(yK, xA, c1); mm_f(yR, xB, c2); mm_f(yR, xK, c3);
            if (diag) {
                f32x4 v = (f32x4){0.f, 0.f, 0.f, 0.f};
#pragma unroll
                for (int s = 0; s < 2; ++s) v = __builtin_amdgcn_mfma_f32_16x16x32_bf16(yA[s], xd[s], v, 0, 0, 0);
#pragma unroll
                for (int e = 0; e < 4; ++e) v[e] = (fr < 4 * fq + e) ? v[e] : 0.f;
                nd = v; }
#pragma unroll
            for (int bi = 0; bi < 2; ++bi) { const int b0 = 16 * (bt0 + bi) + 4 * fq; f32x4 v0 = c0[bi], v1 = c1[bi], v2 = c2[bi], v3 = c3[bi];
#pragma unroll
                for (int e = 0; e < 4; ++e) { v0[e] = (b0 + e < a) ? v0[e] : 0.f; v1[e] = (a < b0 + e) ? v1[e] : 0.f; v2[e] = (b0 + e <= a) ? v2[e] : 0.f; v3[e] = (b0 + e <= a) ? v3[e] : 0.f; }
                st_lds4(L + SL(1), a, b0, v0); st_lds4(L + SL(2), a, b0, v1); st_lds4(L + SL(3), a, b0, v2); st_lds4(L + SL(8), a, b0, v3);
                if (bt0 + bi == at) ntd = v0; }
        }
        const int at = wid >> 1;
        if (((wid & 1) * 2 == (at & 2))) {
            const int fr = lane & 15, fq = lane >> 4;
            auto op = [](f32x4 v) { u32x4 w; w.x = cvt_pk_bf16(v[0], v[1]); w.y = cvt_pk_bf16(v[2], v[3]); w.z = 0u; w.w = 0u; return __builtin_bit_cast(bf16x8, w); };
            const f32x4 zero = (f32x4){0.f, 0.f, 0.f, 0.f};
            const f32x4 Lm = ntd, LT = nd;
            f32x4 Q = Lm;
#pragma unroll
            for (int e = 0; e < 4; ++e) Q[e] += (4 * fq + e == fr) ? 1.f : 0.f;
            const f32x4 L2 = __builtin_amdgcn_mfma_f32_16x16x32_bf16(op(LT), op(Lm), zero, 0, 0, 0), L2T = __builtin_amdgcn_mfma_f32_16x16x32_bf16(op(Lm), op(LT), zero, 0, 0, 0);
            Q = __builtin_amdgcn_mfma_f32_16x16x32_bf16(op(L2T), op(Q), Q, 0, 0, 0);
            const f32x4 L4 = __builtin_amdgcn_mfma_f32_16x16x32_bf16(op(L2T), op(L2), zero, 0, 0, 0), L4T = __builtin_amdgcn_mfma_f32_16x16x32_bf16(op(L2), op(L2T), zero, 0, 0, 0);
            Q = __builtin_amdgcn_mfma_f32_16x16x32_bf16(op(L4T), op(Q), Q, 0, 0, 0);
            const f32x4 L8T = __builtin_amdgcn_mfma_f32_16x16x32_bf16(op(L4), op(L4T), zero, 0, 0, 0);
            Q = __builtin_amdgcn_mfma_f32_16x16x32_bf16(op(L8T), op(Q), Q, 0, 0, 0);
            st_lds4(L + SL(9), 16 * at + fr, 4 * fq, Q);
        }
    }
    BAR_LDS();
    {
        const int fr = lane & 15, fq = lane >> 4;
        LAS const unsigned char* zsl = L + (wid < 4 ? SL(4) : SL(2)); LAS unsigned char* dsl = L + (wid < 4 ? SL(11) : SL(12));
        const int arow = 16 * (wid & 3) + fr;
        u32x2 zp[4];
#pragma unroll
        for (int c = 0; c < 4; ++c) {
            f32x4 acc = ld_lds4(zsl, arow, 16 * c + 4 * fq);
            if (c >= 1) {
                const u32x2 alo = *(LAS const u32x2*)(L + SL(1) + ((size_t)(16 * c + fr) * LW + 4 * fq) * 2), ahi = *(LAS const u32x2*)(L + SL(1) + ((size_t)(16 * c + fr) * LW + 16 + 4 * fq) * 2);
                u32x4 aw; aw.x = alo.x; aw.y = alo.y; aw.z = ahi.x; aw.w = ahi.y;
                u32x4 bw; bw.x = zp[0].x; bw.y = zp[0].y; bw.z = c >= 2 ? zp[1].x : 0u; bw.w = c >= 2 ? zp[1].y : 0u;
                acc = __builtin_amdgcn_mfma_f32_16x16x32_bf16(__builtin_bit_cast(bf16x8, aw), __builtin_bit_cast(bf16x8, bw), acc, 0, 0, 0); }
            if (c == 3) {
                const u32x2 alo = *(LAS const u32x2*)(L + SL(1) + ((size_t)(48 + fr) * LW + 32 + 4 * fq) * 2);
                u32x4 aw; aw.x = alo.x; aw.y = alo.y; aw.z = 0u; aw.w = 0u;
                u32x4 bw; bw.x = zp[2].x; bw.y = zp[2].y; bw.z = 0u; bw.w = 0u;
                acc = __builtin_amdgcn_mfma_f32_16x16x32_bf16(__builtin_bit_cast(bf16x8, aw), __builtin_bit_cast(bf16x8, bw), acc, 0, 0, 0); }
            const u32x2 dlo = *(LAS const u32x2*)(L + SL(9) + ((size_t)(16 * c + fr) * LW + 4 * fq) * 2);
            u32x4 aw; aw.x = dlo.x; aw.y = dlo.y; aw.z = 0u; aw.w = 0u;
            u32x4 bw; bw.x = cvt_pk_bf16(acc[0], acc[1]); bw.y = cvt_pk_bf16(acc[2], acc[3]); bw.z = 0u; bw.w = 0u;
            const f32x4 r = __builtin_amdgcn_mfma_f32_16x16x32_bf16(__builtin_bit_cast(bf16x8, aw), __builtin_bit_cast(bf16x8, bw), (f32x4){0.f, 0.f, 0.f, 0.f}, 0, 0, 0);
            zp[c].x = cvt_pk_bf16(r[0], r[1]); zp[c].y = cvt_pk_bf16(r[2], r[3]);
            *(LAS u32x2*)(dsl + ((size_t)arow * LW + 16 * c + 4 * fq) * 2) = zp[c];
        }
    }
    BAR_LDS();
    {
        const int sAT = 11, sAkT = 12, sHk = 0;
        const LdsMat AT{L + SL(sAT), LW}, AkT{L + SL(sAkT), LW}, AbrT{L + SL(3), LW}, BgT{L + SL(5), LW}, VTm{L + SL(7), LW};
        bf16_t* QRT = (bf16_t*)(F.ws + WS_QRT) + (size_t)unit * 4096; bf16_t* WYT = (bf16_t*)(F.ws + WS_WYT) + (size_t)unit * 4096;
        bf16_t* GTg = (bf16_t*)(F.dout + DO_GT) + (size_t)unit * (64 * GLD); bf16_t* Hg = (bf16_t*)(F.dout + DO_H) + (size_t)unit * (64 * GLD);
        {
            int ln = lane, wd = wid; asm volatile("" : "+v"(ln), "+s"(wd));
            const int at = wd >> 1, bt0 = (wd & 1) * 2, fr = ln & 15, fq = ln >> 4, a = 16 * at + fr;
            bf16x8 yA[2], yB[2], xT[2][2], xK[2][2];
            ld_yf(BgT, at, fr, fq, yB); ld_xf(AkT, bt0, fr, fq, xK); ld_yf(AbrT, at, fr, fq, yA); ld_xf(AT, bt0, fr, fq, xT);
            f32x4 eH[2], eR[2], eW[2];
#pragma unroll
            for (int bi = 0; bi < 2; ++bi) { const int b0 = 16 * (bt0 + bi) + 4 * fq; eH[bi] = ld_lds4(L + SL(6), a, b0); eR[bi] = ld_lds4(L + SL(10), a, b0); eW[bi] = ld_lds4(L + SL(8), a, b0); }
            const float gdiag = XT[512 + a];
            f32x4 cH[2], cQ[2], cW[2], cG[2];
            mm_f(yB, xK, cH); mm_f(yA, xT, cQ); mm_f(yA, xK, cW); mm_f(yB, xT, cG);
#pragma unroll
            for (int bi = 0; bi < 2; ++bi) { const int b0 = 16 * (bt0 + bi) + 4 * fq;
                st_lds4(L + SL(sHk), a, b0, (cH[bi] + eH[bi]) * gdiag);
                st_lds4(L + SL(1), a, b0, cQ[bi] + eR[bi]);
                st_lds4(L + SL(2), a, b0, cW[bi] + eW[bi]);
                f32x4 v = cG[bi];
#pragma unroll
                for (int e = 0; e < 4; ++e) v[e] += (b0 + e == a) ? 1.f : 0.f;
                st_lds4(L + SL(4), a, b0, v * gdiag); }
        }
        BAR_LDS();
        const LdsMat HkT{L + SL(sHk), LW};
        mm64<64>(VTm, HkT, wid, lane, [&](int a, int b0, f32x4 v) { st_lds4(L + SL(9), a, b0, v); });
        __builtin_nontemporal_store(*(LAS const u32x4*)(L + SL(1) + ((size_t)crow * LW + cch * 8) * 2), (u32x4*)(QRT + crow * 64 + cch * 8));
        __builtin_nontemporal_store(*(LAS const u32x4*)(L + SL(2) + ((size_t)crow * LW + cch * 8) * 2), (u32x4*)(WYT + crow * 64 + cch * 8));
        __builtin_nontemporal_store(*(LAS const u32x4*)(L + SL(4) + (size_t)tid * 16), (u32x4*)GTg + tid);
        if (tid < 64) __builtin_nontemporal_store(*(LAS const u32x4*)(L + SL(4) + (size_t)(512 + tid) * 16), (u32x4*)GTg + 512 + tid);
        if (next_unit < NUNIT) rwkv_pre_put_w(L, P, tid);
        BAR_LDS();
        __builtin_nontemporal_store(*(LAS const u32x4*)(L + SL(9) + (size_t)tid * 16), (u32x4*)Hg + tid);
        if (tid < 64) __builtin_nontemporal_store(*(LAS const u32x4*)(L + SL(9) + (size_t)(512 + tid) * 16), (u32x4*)Hg + 512 + tid);
    }
}

constexpr int RS_SLOT = 12 * 1024;
constexpr int RS_DEPTH = 8, RS_AHEAD = 6;
__device__ __forceinline__ void rwkv_scan_block(Frame& F, int item) {
    const int bh = item >> 2, qi = item & 3, lane = F.lane, fr = lane & 15, fq = lane >> 4, wid = F.wave;
    const char* GTg = (const char*)(F.dout + DO_GT) + (size_t)bh * 64 * (64 * GLD * 2);
    const char* Hg = (const char*)(F.dout + DO_H) + (size_t)bh * 64 * (64 * GLD * 2) + (size_t)qi * (16 * GLD * 2);
    bf16_t* SST = (bf16_t*)(F.dout + DO_SST) + (size_t)bh * 64 * 4096;
    LAS unsigned char* L = F.lds;
    auto issue = [&](int c) {
        if (wid >= 1) {
            LAS unsigned char* slot = L + (c & (RS_DEPTH - 1)) * RS_SLOT;
#pragma unroll
            for (int k = 0; k < 2; ++k) { const int pc = (wid - 1) + 7 * k;
                if (pc < 12) {
                    const char* src;
                    if (pc < 9) src = GTg + (size_t)c * (64 * GLD * 2) + pc * 1024 + lane * 16;
                    else { int off = (pc - 9) * 1024 + lane * 16; off = off > 2304 - 16 ? 2304 - 16 : off; src = Hg + (size_t)c * (64 * GLD * 2) + off; }
                    __builtin_amdgcn_global_load_lds((const unsigned*)src, (LAS unsigned*)(slot + pc * 1024), 16, 0, 0); } }
        }
    };
    f32x4 acc[4];
#pragma unroll
    for (int mt = 0; mt < 4; ++mt) acc[mt] = (f32x4){0.f, 0.f, 0.f, 0.f};
#pragma unroll 1
    for (int c = 0; c < RS_AHEAD; ++c) issue(c);
#pragma unroll 1
    for (int c = 0; c < NCH; ++c) {
        if (c + RS_AHEAD < NCH) issue(c + RS_AHEAD);
        if (c + RS_AHEAD < NCH) { if (wid >= 1 && wid <= 5) asm volatile("s_waitcnt vmcnt(12)" ::: "memory"); else if (wid >= 6) asm volatile("s_waitcnt vmcnt(6)" ::: "memory"); }
        else if (wid >= 1) asm volatile("s_waitcnt vmcnt(0)" ::: "memory");
        __builtin_amdgcn_s_barrier(); asm volatile("" ::: "memory");
        if (wid == 0) {
            LAS const unsigned char* slot = L + (c & (RS_DEPTH - 1)) * RS_SLOT;
            u32x2 ga[4][2][2], hv[4];
#pragma unroll
            for (int mt = 0; mt < 4; ++mt) {
#pragma unroll
                for (int s = 0; s < 2; ++s)
#pragma unroll
                    for (int hh = 0; hh < 2; ++hh) ga[mt][s][hh] = *(LAS const u32x2*)(slot + ((16 * mt + fr) * GLD + 16 * (2 * s + hh) + 4 * fq) * 2);
                hv[mt] = *(LAS const u32x2*)(slot + 9216 + (fr * GLD + 16 * mt + 4 * fq) * 2); }
            bf16_t* Sc = SST + (size_t)c * 4096; u32x2 sp[4];
#pragma unroll
            for (int mt = 0; mt < 4; ++mt) { sp[mt].x = cvt_pk_bf16(acc[mt][0], acc[mt][1]); sp[mt].y = cvt_pk_bf16(acc[mt][2], acc[mt][3]);
                *(u32x2*)(Sc + (size_t)(16 * qi + fr) * 64 + 16 * mt + 4 * fq) = sp[mt]; }
            bf16x8 sb[2];
#pragma unroll
            for (int s = 0; s < 2; ++s) { u32x4 w; w.x = sp[2 * s].x; w.y = sp[2 * s].y; w.z = sp[2 * s + 1].x; w.w = sp[2 * s + 1].y; sb[s] = __builtin_bit_cast(bf16x8, w); }
#pragma unroll
            for (int mt = 0; mt < 4; ++mt) { f32x4 a = (f32x4){bf_lo(hv[mt].x), bf_hi(hv[mt].x), bf_lo(hv[mt].y), bf_hi(hv[mt].y)};
#pragma unroll
                for (int s = 0; s < 2; ++s) { u32x4 w; w.x = ga[mt][s][0].x; w.y = ga[mt][s][0].y; w.z = ga[mt][s][1].x; w.w = ga[mt][s][1].y;
                    a = __builtin_amdgcn_mfma_f32_16x16x32_bf16(__builtin_bit_cast(bf16x8, w), sb[s], a, 0, 0, 0); }
                acc[mt] = a; }
            asm volatile("s_waitcnt lgkmcnt(0)" ::: "memory");
        }
    }
    asm volatile("s_waitcnt vmcnt(0)" ::: "memory");
    __builtin_amdgcn_s_barrier(); asm volatile("" ::: "memory");
}
__device__ __forceinline__ void s5_scan_block(Frame& F, int gb) {
    const int g = gb >> 3, b = gb & 7, p = F.lane, w = F.wave;
    const float* aL = (const float*)(F.ws + WS_AL) + g * 128; const float ar = aL[2 * p], ai = aL[2 * p + 1];
    const float* SLc = (const float*)(F.ws + WS_SLOC) + ((size_t)g * S5ROWS + b * 256 + 32 * w) * 128 + 2 * p;
    bf16_t* UG = (bf16_t*)(F.ws + WS_UG) + ((size_t)g * S5ROWS + b * 256 + 32 * w) * UGLD + 256 + 2 * p;
    LAS float* E = (LAS float*)(F.lds);
    f32x2 l[32];
#pragma unroll
    for (int k = 0; k < 32; ++k) l[k] = *(const f32x2*)(SLc + (size_t)k * 128);
    float sr = 0.f, si = 0.f;
#pragma unroll
    for (int k = 0; k < 32; ++k) { const float nr = ar * sr - ai * si + l[k].x, ni = ar * si + ai * sr + l[k].y; l[k].x = sr; l[k].y = si; sr = nr; si = ni; }
    E[(w * 64 + p) * 2] = sr; E[(w * 64 + p) * 2 + 1] = si;
    float pr = ar, pi = ai;
#pragma unroll
    for (int q = 0; q < 5; ++q) { const float nr = pr * pr - pi * pi, ni = 2.f * pr * pi; pr = nr; pi = ni; }
    asm volatile("s_waitcnt lgkmcnt(0)" ::: "memory"); __builtin_amdgcn_s_barrier(); asm volatile("" ::: "memory");
    float cr = 0.f, ci = 0.f;
#pragma unroll
    for (int w2 = 0; w2 < 7; ++w2) { if (w2 < w) { const float er = E[(w2 * 64 + p) * 2], ei = E[(w2 * 64 + p) * 2 + 1]; const float nr = pr * cr - pi * ci + er, ni = pr * ci + pi * cr + ei; cr = nr; ci = ni; } }
#pragma unroll
    for (int k = 0; k < 32; ++k) { *(unsigned*)(UG + (size_t)k * UGLD) = cvt_pk_bf16(l[k].x + cr, l[k].y + ci); const float nr = ar * cr - ai * ci, ni = ar * ci + ai * cr; cr = nr; ci = ni; }
    asm volatile("s_waitcnt lgkmcnt(0)" ::: "memory"); __builtin_amdgcn_s_barrier(); asm volatile("" ::: "memory");
}
struct OutY { bf16x8 yq[2], yw[2]; u32x2 gv[4]; float bon; };
__device__ __forceinline__ void rwkv_out_loady(Frame& F, int unit, int at, OutY& Lq) {
    const int lane = F.lane, fr = lane & 15, fq = lane >> 4;
    const int bh = unit >> 6, c = unit & 63, b = bh >> 3, h = bh & 7;
    const bf16_t* QRT = (const bf16_t*)(F.ws + WS_QRT) + (size_t)unit * 4096; const bf16_t* WYT = (const bf16_t*)(F.ws + WS_WYT) + (size_t)unit * 4096;
#pragma unroll
    for (int s = 0; s < 2; ++s) { Lq.yq[s] = __builtin_nontemporal_load((const bf16x8*)(QRT + (size_t)(16 * at + fr) * 64 + 32 * s + 8 * fq)); Lq.yw[s] = __builtin_nontemporal_load((const bf16x8*)(WYT + (size_t)(16 * at + fr) * 64 + 32 * s + 8 * fq)); }
    const int tl = c * 64 + 16 * at + fr, tg = b * SEQ + tl;
    const bf16_t* gb = (const bf16_t*)(F.ws + WS_GBUF) + (size_t)tg * RW + h * 64;
    Lq.bon = ((const float*)(F.ws + WS_BONUS))[(size_t)tg * 8 + h];
#pragma unroll
    for (int bt = 0; bt < 4; ++bt) { const int i0 = 16 * bt + 4 * fq; Lq.gv[bt] = *(const u32x2*)(gb + i0); }
}
__device__ __forceinline__ void rwkv_out_comp(Frame& F, int unit, int at, const bf16x8 (&xs)[2][4], const bf16x8 (&xv)[2][4], const OutY& Lq) {
    const int lane = F.lane, fr = lane & 15, fq = lane >> 4;
    const int bh = unit >> 6, c = unit & 63, b = bh >> 3, h = bh & 7;
    f32x4 lw[4], lb[4];
#pragma unroll
    for (int bt = 0; bt < 4; ++bt) { const int i0 = 16 * bt + 4 * fq; lw[bt] = *(const f32x4*)(F.in[I_LNW] + h * 64 + i0); lb[bt] = *(const f32x4*)(F.in[I_LNB] + h * 64 + i0); }
    f32x4 bv4[4];
    {
        const unsigned bb = cvt_pk_bf16(Lq.bon, Lq.bon); const bool mine = fq == 2 * (at & 1) + (fr >> 3); const int jw = (fr & 7) >> 1; const unsigned half = (fr & 1) ? (bb & 0xffff0000u) : (bb & 0xffffu);
        u32x4 dw; dw.x = (mine && jw == 0) ? half : 0u; dw.y = (mine && jw == 1) ? half : 0u; dw.z = (mine && jw == 2) ? half : 0u; dw.w = (mine && jw == 3) ? half : 0u;
        const bf16x8 df = __builtin_bit_cast(bf16x8, dw);
#pragma unroll
        for (int bt = 0; bt < 4; ++bt) bv4[bt] = __builtin_amdgcn_mfma_f32_16x16x32_bf16((at >> 1) ? xv[1][bt] : xv[0][bt], df, (f32x4){0.f, 0.f, 0.f, 0.f}, 0, 0, 0);
    }
    f32x4 acc[4];
#pragma unroll
    for (int bt = 0; bt < 4; ++bt) acc[bt] = (f32x4){0.f, 0.f, 0.f, 0.f};
#pragma unroll
    for (int s = 0; s < 2; ++s)
#pragma unroll
        for (int bt = 0; bt < 4; ++bt) {
            acc[bt] = __builtin_amdgcn_mfma_f32_16x16x32_bf16(xs[s][bt], Lq.yq[s], acc[bt], 0, 0, 0);
            acc[bt] = __builtin_amdgcn_mfma_f32_16x16x32_bf16(xv[s][bt], Lq.yw[s], acc[bt], 0, 0, 0); }
    float s1 = 0.f;
#pragma unroll
    for (int bt = 0; bt < 4; ++bt) s1 += (acc[bt][0] + acc[bt][1]) + (acc[bt][2] + acc[bt][3]);
    s1 += __shfl_xor(s1, 16); s1 += __shfl_xor(s1, 32);
    const float mean = s1 * (1.f / 64.f); float s2 = 0.f;
#pragma unroll
    for (int bt = 0; bt < 4; ++bt) { const f32x4 d = acc[bt] - mean; s2 += (d[0] * d[0] + d[1] * d[1]) + (d[2] * d[2] + d[3] * d[3]); }
    s2 += __shfl_xor(s2, 16); s2 += __shfl_xor(s2, 32);
    const float rstd = __builtin_amdgcn_rsqf(s2 * (1.f / 64.f) + 64e-5f);
    const int tl = c * 64 + 16 * at + fr, tg = b * SEQ + tl;
    bf16_t* YRS = (bf16_t*)(F.dout + DO_YRS) + (size_t)tg * D + h * 64;
#pragma unroll
    for (int bt = 0; bt < 4; ++bt) { const int i0 = 16 * bt + 4 * fq;
        const u32x2 gv = Lq.gv[bt];
        const float gg[4] = {bf_lo(gv.x), bf_hi(gv.x), bf_lo(gv.y), bf_hi(gv.y)};
        float o[4];
#pragma unroll
        for (int e = 0; e < 4; ++e) o[e] = ((acc[bt][e] - mean) * rstd * lw[bt][e] + lb[bt][e] + bv4[bt][e]) * gg[e];
        u32x2 w; w.x = cvt_pk_bf16(o[0], o[1]); w.y = cvt_pk_bf16(o[2], o[3]); *(u32x2*)(YRS + i0) = w; }
}
__device__ __forceinline__ void rwkv_out_units(Frame& F) {
    const int lane = F.lane, fr = lane & 15, fq = lane >> 4;
    for (int unit = F.vcu * NWAVES + F.wave; unit < NUNIT; unit += F.G * NWAVES) {
        const bf16_t* VT = (const bf16_t*)(F.ws + WS_VT) + (size_t)unit * 4096; const bf16_t* SST = (const bf16_t*)(F.dout + DO_SST) + (size_t)unit * 4096;
        bf16x8 xs[2][4], xv[2][4]; OutY A, B;
#pragma unroll
        for (int s = 0; s < 2; ++s)
#pragma unroll
            for (int bt = 0; bt < 4; ++bt) { xs[s][bt] = __builtin_nontemporal_load((const bf16x8*)(SST + (size_t)(16 * bt + fr) * 64 + 32 * s + 8 * fq)); xv[s][bt] = __builtin_nontemporal_load((const bf16x8*)(VT + (size_t)(16 * bt + fr) * 64 + 32 * s + 8 * fq)); }
        rwkv_out_loady(F, unit, 0, A); rwkv_out_loady(F, unit, 1, B); __builtin_amdgcn_sched_barrier(0);
        rwkv_out_comp(F, unit, 0, xs, xv, A); __builtin_amdgcn_sched_barrier(0); rwkv_out_loady(F, unit, 2, A); __builtin_amdgcn_sched_barrier(0);
        rwkv_out_comp(F, unit, 1, xs, xv, B); __builtin_amdgcn_sched_barrier(0); rwkv_out_loady(F, unit, 3, B); __builtin_amdgcn_sched_barrier(0);
        rwkv_out_comp(F, unit, 2, xs, xv, A); __builtin_amdgcn_sched_barrier(0);
        rwkv_out_comp(F, unit, 3, xs, xv, B); __builtin_amdgcn_sched_barrier(0);
    }
}

__device__ __forceinline__ void p8_rows(Frame& F) {
    const int gw = F.vcu * NWAVES + F.wave, NGW = F.G * NWAVES, lane = F.lane;
    const bf16_t* MX = (const bf16_t*)(F.ws + WS_MIXED); const float* ST = (const float*)(F.ws + WS_STAT1); bf16_t* H2 = (bf16_t*)(F.ws + WS_H2); float* X1 = (float*)F.dout;
    f32x4 gp[4];
#pragma unroll
    for (int j = 0; j < 4; ++j) gp[j] = *(const f32x4*)(F.in[I_NMPOST] + 256 * j + 4 * lane);
    for (int m0 = gw; m0 < T; m0 += 2 * NGW) {
        int mm[2] = {m0, (m0 + NGW < T) ? m0 + NGW : m0};
        f32x4 xv[2][4]; u32x2 mw[2][4]; float st[2];
#pragma unroll
        for (int q = 0; q < 2; ++q) { st[q] = (lane < 16) ? ST[(size_t)mm[q] * 16 + lane] : 0.f;
#pragma unroll
            for (int j = 0; j < 4; ++j) { const int col = 256 * j + 4 * lane; xv[q][j] = __builtin_nontemporal_load((const f32x4*)(F.in[I_X] + (size_t)mm[q] * D + col)); mw[q][j] = __builtin_nontemporal_load((const u32x2*)(MX + (size_t)mm[q] * D + col)); } }
#pragma unroll
        for (int q = 0; q < 2; ++q) {
            const float rstd1 = __builtin_amdgcn_rsqf(wave_sum(st[q]) * (1.f / D) + 1e-6f);
            f32x4 v[4]; float s = 0.f;
#pragma unroll
            for (int j = 0; j < 4; ++j) { const int col = 256 * j + 4 * lane;
                v[j].x = xv[q][j].x + bf_lo(mw[q][j].x) * rstd1 * gp[j].x; v[j].y = xv[q][j].y + bf_hi(mw[q][j].x) * rstd1 * gp[j].y; v[j].z = xv[q][j].z + bf_lo(mw[q][j].y) * rstd1 * gp[j].z; v[j].w = xv[q][j].w + bf_hi(mw[q][j].y) * rstd1 * gp[j].w;
                s += (v[j].x * v[j].x + v[j].y * v[j].y) + (v[j].z * v[j].z + v[j].w * v[j].w);
                }
            const float rstd2 = __builtin_amdgcn_rsqf(wave_sum(s) * (1.f / D) + 1e-6f);
#pragma unroll
            for (int j = 0; j < 4; ++j) { u32x2 w; w.x = cvt_pk_bf16(v[j].x * rstd2, v[j].y * rstd2); w.y = cvt_pk_bf16(v[j].z * rstd2, v[j].w * rstd2); *(u32x2*)(H2 + (size_t)mm[q] * D + 256 * j + 4 * lane) = w; }
        }
    }
}
__device__ __forceinline__ void p12_rows(Frame& F) {
    const int gw = F.vcu * NWAVES + F.wave, NGW = F.G * NWAVES, lane = F.lane;
    const bf16_t* FB = (const bf16_t*)(F.ws + WS_F); const bf16_t* MX = (const bf16_t*)(F.ws + WS_MIXED);
    const float* ST1 = (const float*)(F.ws + WS_STAT1); const float* ST2 = (const float*)(F.ws + WS_STAT2); float* OUT = (float*)F.dout;
    f32x4 gp[4], gq[4];
#pragma unroll
    for (int j = 0; j < 4; ++j) { gp[j] = *(const f32x4*)(F.in[I_NMPOST] + 256 * j + 4 * lane); gq[j] = *(const f32x4*)(F.in[I_NFPOST] + 256 * j + 4 * lane); }
    for (int m0 = gw; m0 < T; m0 += 2 * NGW) {
        int mm[2] = {m0, (m0 + NGW < T) ? m0 + NGW : m0};
        f32x4 xv[2][4]; u32x2 mw[2][4], fw[2][4]; float s1[2], s2[2];
#pragma unroll
        for (int q = 0; q < 2; ++q) { s1[q] = (lane < 16) ? ST1[(size_t)mm[q] * 16 + lane] : 0.f; s2[q] = (lane < 16) ? ST2[(size_t)mm[q] * 16 + lane] : 0.f;
#pragma unroll
            for (int j = 0; j < 4; ++j) { const int col = 256 * j + 4 * lane; xv[q][j] = __builtin_nontemporal_load((const f32x4*)(F.in[I_X] + (size_t)mm[q] * D + col));
                mw[q][j] = __builtin_nontemporal_load((const u32x2*)(MX + (size_t)mm[q] * D + col)); fw[q][j] = __builtin_nontemporal_load((const u32x2*)(FB + (size_t)mm[q] * D + col)); } }
#pragma unroll
        for (int q = 0; q < 2; ++q) {
            const float rstd1 = __builtin_amdgcn_rsqf(wave_sum(s1[q]) * (1.f / D) + 1e-6f), rstd3 = __builtin_amdgcn_rsqf(wave_sum(s2[q]) * (1.f / D) + 1e-6f);
#pragma unroll
            for (int j = 0; j < 4; ++j) { const int col = 256 * j + 4 * lane; f32x4 o;
                o.x = xv[q][j].x + bf_lo(mw[q][j].x) * rstd1 * gp[j].x; o.y = xv[q][j].y + bf_hi(mw[q][j].x) * rstd1 * gp[j].y; o.z = xv[q][j].z + bf_lo(mw[q][j].y) * rstd1 * gp[j].z; o.w = xv[q][j].w + bf_hi(mw[q][j].y) * rstd1 * gp[j].w;
                o.x += bf_lo(fw[q][j].x) * rstd3 * gq[j].x; o.y += bf_hi(fw[q][j].x) * rstd3 * gq[j].y; o.z += bf_lo(fw[q][j].y) * rstd3 * gq[j].z; o.w += bf_hi(fw[q][j].y) * rstd3 * gq[j].w;
                __builtin_nontemporal_store(o, (f32x4*)(OUT + (size_t)mm[q] * D + col)); }
        }
    }
}

#ifndef MK_PER_PHASE
#define MK_PER_PHASE 0
#endif
constexpr int NPHASE = 12;
struct Args { const float* in[35]; float* out; unsigned char* ws; int ph_lo, ph_hi; };
static_assert(sizeof(Args) == 35 * 8 + 8 + 8 + 8, "Args has no padding");

__device__ __forceinline__ bool phase_begin(Frame& F) { unsigned long long z = 0; asm volatile("" : "+s"(z), "+v"(F.tid)); F.ws = F.ws0 + z; F.dout = F.dout0 + z;     F.lane = F.tid & 63; F.wave = __builtin_amdgcn_readfirstlane(F.tid >> 6); return true; }
__global__ void __launch_bounds__(NWAVES * 64, 2) fwd_kernel(Args args) {
    extern __shared__ __attribute__((aligned(16))) unsigned char lds_raw[];
    Frame F;
    F.lds = (LAS unsigned char*)lds_raw;
    F.MISC = (volatile LAS unsigned*)(F.lds + MISC_OFF);
    F.tid = threadIdx.x; F.lane = F.tid & 63; F.wave = __builtin_amdgcn_readfirstlane(F.tid >> 6);
    F.G = gridDim.x; { const int bx = blockIdx.x; F.vcu = (F.G % 8 == 0) ? (bx % 8) * (F.G / 8) + bx / 8 : bx; }
    F.ws0 = args.ws; F.dout0 = (unsigned char*)args.out; F.ws = F.ws0; F.dout = F.dout0; F.ctl = (gu32*)(args.ws + WS_CTL);
    F.in = (InTab)__builtin_amdgcn_kernarg_segment_ptr();
    for (int u = F.tid; u < (LDS_BYTES - LDSCTL_OFF) / 4; u += NWAVES * 64) ((LAS unsigned*)(F.lds + LDSCTL_OFF))[u] = 0u;
    __syncthreads();
    XcdBarrier bar; bar.bar = (unsigned*)(F.ctl + CW_BAR); bar.x = 0; bar.st = nullptr;
    if (!MK_PER_PHASE) bar = xcd_barrier_post((unsigned*)(F.ctl + CW_BAR), F.MISC + 8);
    const int lo = args.ph_lo, hi = args.ph_hi;
#ifndef PHMASK
#define PHMASK 0xffffffffu
#endif
#define IN(k) (((PHMASK >> (k)) & 1u) && lo <= (k) && (k) < hi && phase_begin(F))
#ifndef REPMASK
#define REPMASK 0u
#endif
#define REPS(k) ((((REPMASK) >> (k)) & 1u) ? 2 : 1)
#define PH(k) for (int rep_ = 0; rep_ < REPS(k); ++rep_, (rep_ < REPS(k) ? xcd_barrier(bar) : (void)0))
#define INQ(k) (lo <= (k) && (k) < hi)
#define SEAM(k) do { if (INQ(k) && INQ((k) + 1)) xcd_barrier(bar); } while (0)
#define WSB(off) ((bf16_t*)(F.ws + (off)))
    const int bx = (int)blockIdx.x;

    PH(0) if (IN(0)) { p0_prologue(F); }
    SEAM(0);
    PH(1) if (IN(1)) {
        pg8::Gemm g{D, D, D, 0}; pg8::StaticOrder S; S.init(WSB(WS_XN), WSB(WS_WIN), D, D, T, NIN, F.G, bx);
        EpiInProj E{WSB(WS_PR), WSB(WS_UG), WSB(WS_GATES), F.in[I_BGATE], 0};
        pg8::gemm_phase<EpiInProj, pg8::StaticOrder, true>(F.lds, g, S, E, F.tid);
        { const int rem = ((T / 256) * (NIN / 256)) % F.G;
          if (rem == 0) p0_late_mats(F, bx * NWAVES + F.wave, F.G * NWAVES); else if (bx >= rem) p0_late_mats(F, (bx - rem) * NWAVES + F.wave, (F.G - rem) * NWAVES); }
    }
    SEAM(1);
    PH(2) if (IN(2)) {
        PrePf pf;
        if (F.vcu < NB * NCH) { rwkv_pre_fetch(F, (((F.vcu >> 6) * NHEAD) << 6) + (F.vcu & 63), true, pf, F.tid); rwkv_pre_put_w(F.lds, pf, F.tid); }
        {
            LAS f32x4* TB = (LAS f32x4*)(F.lds + XTRA_OFF + 4096);
            if (F.tid < NRW / 4) TB[F.tid] = ((const f32x4*)F.in[I_MU])[F.tid];
            const int pq = F.tid >> 7, pi = F.tid & 127;
            const float* psrc = pq == 0 ? F.in[I_W0] : pq == 1 ? F.in[I_A0] : pq == 2 ? F.in[I_KK] : F.in[I_KA];
            TB[NRW / 4 + F.tid] = ((const f32x4*)psrc)[pi];
            if (F.tid < 128) TB[NRW / 4 + 512 + F.tid] = ((const f32x4*)F.in[I_RK])[F.tid];
            BAR_LDS();
        }
        for (int pc = F.vcu; pc < NB * NCH; pc += F.G) {
#pragma unroll 1
            for (int hh = 0; hh < NHEAD; ++hh) { const int bq = pc >> 6, cq = pc & 63, u = ((bq * NHEAD + hh) << 6) + cq;
                const int un = (hh < NHEAD - 1) ? u + 64 : ((pc + F.G < NB * NCH) ? ((((pc + F.G) >> 6) * NHEAD) << 6) + ((pc + F.G) & 63) : NUNIT);
                rwkv_pre_unit(F, u, un, hh == 0, hh == NHEAD - 1, pf); } }
        BAR_LDS();
        pg8::Gemm g{256, UGLD, 256, 0}; S5Order S{WSB(WS_UG), WSB(WS_B1A), 256, F.G, bx};
        EpiSloc E{(float*)(F.ws + WS_SLOC), 0};
        pg8::gemm_phase<EpiSloc, S5Order, true>(F.lds, g, S, E, F.tid);
    }
    SEAM(2);
    PH(3) if (IN(3)) {
        for (int gb = F.vcu; gb < S5G * NB; gb += F.G) s5_scan_block(F, gb);
        for (int it = F.vcu; it < NB * NHEAD * 4; it += F.G) rwkv_scan_block(F, it);
    }
    SEAM(3);
    PH(4) if (IN(4)) {
        rwkv_out_units(F);
        VM_WAIT(); __syncthreads();
        pg8::Gemm g{384, UGLD, 384, 0}; S5Order S{WSB(WS_UG), WSB(WS_B1B), 384, F.G, bx};
        pg8::EpiGen8<FS5Out> E{FS5Out{WSB(WS_YSP)}, 0};
        pg8::gemm_phase<pg8::EpiGen8<FS5Out>, S5Order, true>(F.lds, g, S, E, F.tid);
    }
    SEAM(4);
    PH(5) if (IN(5)) {
        pg8::Gemm g{RW, RW, RW, 1}; pg8::StaticOrder S; S.init(WSB(WS_YSP), WSB(WS_WGLU), RW, RW, T, RW, F.G, bx); S.tstepA = (size_t)16 * 256 * 2;
        EpiGlu E{WSB(WS_YSP), (bf16_t*)(F.dout + DO_YRS), F.in[I_BGLU], 0};
        pg8::gemm_phase<EpiGlu, pg8::StaticOrder, true>(F.lds, g, S, E, F.tid);
    }
    SEAM(5);
    PH(6) if (IN(6)) {
        pg8::Gemm g{D, D, D, 0}; pg8::StaticOrder S; S.init((const bf16_t*)(F.dout + DO_YRS), WSB(WS_WBRS), D, D, T, D, F.G, bx);
        EpiMerge E{WSB(WS_GATES), WSB(WS_MERGED), RW / 64};
        pg8::gemm_phase<EpiMerge, pg8::StaticOrder, true>(F.lds, g, S, E, F.tid);
    }
    SEAM(6);
    PH(7) if (IN(7)) {
        pg8::Gemm g{D, D, D, 0}; pg8::StaticOrder S; S.init(WSB(WS_MERGED), WSB(WS_WOUT), D, D, T, D, F.G, bx);
        EpiRowStat E{WSB(WS_MIXED), (float*)(F.ws + WS_STAT1), 0};
        pg8::gemm_phase<EpiRowStat, pg8::StaticOrder, false>(F.lds, g, S, E, F.tid);
    }
    SEAM(7);
    PH(8) if (IN(8)) { p8_rows(F);
        for (size_t i = (size_t)bx * 512 + F.tid; i < HZ_BYTES / 16; i += (size_t)F.G * 512) ((u32x4*)(F.ws + WS_HZ))[i] = (u32x4){0u, 0u, 0u, 0u}; }
    SEAM(8);
    PH(9) if (IN(9)) {
        pg8::Gemm g{D, D, D, 0}; UpOrder S{WSB(WS_H2), WSB(WS_WUP), F.G, bx};
        EpiConvAct E{WSB(WS_ACT), F.in[I_CONVW], F.in[I_CONVB], (LAS unsigned*)(F.lds + XTRA_OFF), (unsigned long long*)(F.ws + WS_HZ), (unsigned*)(F.ctl + 2), 0};
        pg8::gemm_phase<EpiConvAct, UpOrder, true>(F.lds, g, S, E, F.tid);
    }
    SEAM(9);
    PH(10) if (IN(10)) {
        pg8::Gemm g{FF, FF, FF, 0}; pg8::StaticOrder S; S.init(WSB(WS_ACT), WSB(WS_WDN), FF, FF, T, D, F.G, bx);
        EpiRowStat E{WSB(WS_F), (float*)(F.ws + WS_STAT2), 0};
        pg8::gemm_phase<EpiRowStat, pg8::StaticOrder, false>(F.lds, g, S, E, F.tid);
    }
    SEAM(10);
    if (IN(11)) p12_rows(F);
#undef IN
#undef INQ
#undef SEAM
#undef WSB
}

extern "C" void kernel_launch(void* const* d_in, const int* in_sizes, int n_in, void* d_out, int out_size, void* d_ws, size_t ws_size, hipStream_t stream) {
    static int grid = 0;
    if (grid == 0) {
        if (n_in != 35 || in_sizes[0] != T * D || out_size != T * D || ws_size < WS_END) { fprintf(stderr, "kernel_launch: unexpected shapes: n_in %d in0 %d out %d ws %zu (need %zu)\n", n_in, n_in > 0 ? in_sizes[0] : -1, out_size, ws_size, (size_t)WS_END); grid = -1; return; }
        int dev = 0, cus = 0, per_cu = 0;
        if (hipGetDevice(&dev) != hipSuccess || hipDeviceGetAttribute(&cus, hipDeviceAttributeMultiprocessorCount, dev) != hipSuccess) { fprintf(stderr, "kernel_launch: device query failed\n"); grid = -1; return; }
        if (hipFuncSetAttribute((const void*)fwd_kernel, hipFuncAttributeMaxDynamicSharedMemorySize, LDS_BYTES) != hipSuccess) { fprintf(stderr, "kernel_launch: hipFuncSetAttribute failed\n"); grid = -1; return; }
        if (hipOccupancyMaxActiveBlocksPerMultiprocessor(&per_cu, (const void*)fwd_kernel, NWAVES * 64, LDS_BYTES) != hipSuccess || per_cu < 1) fprintf(stderr, "kernel_launch: occupancy query reports %d blocks per CU\n", per_cu);
        (void)hipGetLastError();
        grid = cus;
    }
    if (grid < 0) return;
    if (hipMemsetAsync((char*)d_ws + WS_CTL, 0, CTL_ZERO_BYTES, stream) != hipSuccess) { fprintf(stderr, "kernel_launch: memset failed\n"); return; }
    Args a{};
    for (int i = 0; i < 35; ++i) a.in[i] = (const float*)d_in[i];
    a.out = (float*)d_out; a.ws = (unsigned char*)d_ws;
#if MK_PER_PHASE
    for (int ph = 0; ph < NPHASE; ++ph) { a.ph_lo = ph; a.ph_hi = ph + 1; hipLaunchKernelGGL(fwd_kernel, dim3(grid), dim3(NWAVES * 64), LDS_BYTES, stream, a); }
#else
    a.ph_lo = 0; a.ph_hi = NPHASE;
    hipLaunchKernelGGL(fwd_kernel, dim3(grid), dim3(NWAVES * 64), LDS_BYTES, stream, a);
#endif
    const hipError_t le = hipPeekAtLastError();
    if (le != hipSuccess) fprintf(stderr, "kernel_launch: launch failed: %s\n", hipGetErrorName(le));
}
```

```cpp
#include <hip/hip_runtime.h>
#include <cstdio>
#include <cstdint>

#define LAS __attribute__((address_space(3)))
#define GAS __attribute__((address_space(1)))
typedef unsigned short bf16_t;
typedef short bf16x8 __attribute__((ext_vector_type(8)));
typedef float f32x4 __attribute__((ext_vector_type(4)));
typedef float f32x2 __attribute__((ext_vector_type(2)));
typedef unsigned u32x4 __attribute__((ext_vector_type(4)));
typedef unsigned u32x2 __attribute__((ext_vector_type(2)));
typedef GAS unsigned gu32;

constexpr int T = 32768, SEQ = 4096, NB = 8, D = 1024, NIN = 4352, NRW = 1792, RW = 512, FF = 2816, FH = 1408;
constexpr int NHEAD = 8, HD = 64, NCH = 64  , NUNIT = NB * NHEAD * NCH;
constexpr int S5G = 32, S5ROWS = T / 16, UGLD = 384;

constexpr size_t MiB = 1u << 20;
constexpr size_t WS_CTL = 0, CTL_ZERO_BYTES = 1 * MiB;
constexpr size_t WS_WIN = 1 * MiB;
constexpr size_t WS_WUP = WS_WIN + (size_t)NIN * D * 2;
constexpr size_t WS_WDN = WS_WUP + (size_t)2 * FF * D * 2;
constexpr size_t WS_WOUT = WS_WDN + (size_t)D * FF * 2;
constexpr size_t WS_WBRS = WS_WOUT + (size_t)D * D * 2;
constexpr size_t WS_WGLU = WS_WBRS + (size_t)D * D * 2;
constexpr size_t WS_W2T = WS_WGLU + (size_t)RW * RW * 2;
constexpr size_t WS_A2T = WS_W2T + (size_t)RW * 64 * 2;
constexpr size_t WS_G2T = WS_A2T + (size_t)RW * 64 * 2;
constexpr size_t WS_B1A = WS_G2T + (size_t)RW * 128 * 2;
constexpr size_t WS_B1B = WS_B1A + (size_t)S5G * 256 * 256 * 2;
constexpr size_t WS_AL = WS_B1B + (size_t)S5G * 256 * 384 * 2;
constexpr size_t WS_WEND = WS_AL + (size_t)S5G * 64 * 2 * 4;
static_assert(WS_WEND <= 44 * MiB, "weights region");
constexpr size_t WS_XN = 44 * MiB;
constexpr size_t WS_QRT = 44 * MiB, WS_WYT = 76 * MiB;
constexpr size_t WS_MERGED = 44 * MiB, WS_H2 = 44 * MiB, WS_F = 44 * MiB;
constexpr size_t WS_PR = 108 * MiB;
constexpr size_t WS_MIXED = 304 * MiB, WS_STAT1 = 368 * MiB;
constexpr size_t WS_ACT = 108 * MiB;
constexpr size_t WS_STAT2 = 284 * MiB;
constexpr size_t WS_UG = 220 * MiB;
constexpr size_t WS_GATES = 268 * MiB;
constexpr size_t WS_SLOC = 396 * MiB, WS_YSP = 396 * MiB;
constexpr size_t WS_GBUF = 428 * MiB;
constexpr size_t WS_BONUS = 460 * MiB;
constexpr size_t WS_VT = 461 * MiB;
constexpr size_t WS_LRSCR = 493 * MiB;
constexpr size_t WS_Z = 336 * MiB;
constexpr size_t WS_END = 512 * MiB;
constexpr size_t DO_H = 0, DO_GT = 36 * MiB, DO_SST = 96 * MiB, DO_YRS = 0;
constexpr int GLD = 72;

constexpr int CW_BAR = 4096, CW_HF = 32768, CW_XNQ = 64;
constexpr size_t WS_HZ = 290 * MiB, HZ_BYTES = (size_t)2816 * 4 * 2 * 32 * 8;

constexpr int RING_BYTES = 131072, LDSCTL_OFF = RING_BYTES, MISC_OFF = LDSCTL_OFF + 320, XTRA_OFF = LDSCTL_OFF + 1024, LDS_BYTES = 155648;
constexpr int NWAVES = 8;

#define RLX_AGENT __ATOMIC_RELAXED, __HIP_MEMORY_SCOPE_AGENT
#define LDS_WAIT() asm volatile("s_waitcnt lgkmcnt(0)" ::: "memory")
#define VM_WAIT() asm volatile("s_waitcnt vmcnt(0)" ::: "memory")

typedef __bf16 bf16x2_t __attribute__((ext_vector_type(2)));
__device__ __forceinline__ unsigned cvt_pk_bf16(float lo, float hi) { const f32x2 v = {lo, hi}; return __builtin_bit_cast(unsigned, __builtin_convertvector(v, bf16x2_t)); }
__device__ __forceinline__ float bf_lo(unsigned w) { return __uint_as_float(w << 16); }
__device__ __forceinline__ float bf_hi(unsigned w) { return __uint_as_float(w & 0xffff0000u); }
__device__ __forceinline__ float bf1(bf16_t h) { return __uint_as_float((unsigned)h << 16); }
__device__ __forceinline__ float fexp(float x) { return __builtin_amdgcn_exp2f(x * 1.44269504089f); }
__device__ __forceinline__ float fsigmoid(float x) { return __builtin_amdgcn_rcpf(1.0f + __builtin_amdgcn_exp2f(-1.44269504089f * x)); }
__device__ __forceinline__ float ftanh(float x) { return 1.0f - 2.0f * __builtin_amdgcn_rcpf(1.0f + __builtin_amdgcn_exp2f(2.88539008178f * x)); }
__device__ __forceinline__ float fgelu(float x) { const float u = 0.7978845608f * (x + 0.044715f * x * x * x); return x * fsigmoid(2.0f * u); }
__device__ __forceinline__ void unpack8(u32x4 w, float (&f)[8]) { f[0] = bf_lo(w.x); f[1] = bf_hi(w.x); f[2] = bf_lo(w.y); f[3] = bf_hi(w.y); f[4] = bf_lo(w.z); f[5] = bf_hi(w.z); f[6] = bf_lo(w.w); f[7] = bf_hi(w.w); }
__device__ __forceinline__ u32x4 pack8(const float (&f)[8]) { u32x4 w; w.x = cvt_pk_bf16(f[0], f[1]); w.y = cvt_pk_bf16(f[2], f[3]); w.z = cvt_pk_bf16(f[4], f[5]); w.w = cvt_pk_bf16(f[6], f[7]); return w; }
__device__ __forceinline__ float wave_sum(float v) {
#pragma unroll
    for (int o = 1; o < 64; o <<= 1) v += __shfl_xor(v, o);
    return v;
}

#define XB_TMO      128
#define XB_XCNT(j)  (256  + 64 * (j))
#define XB_XSUB(j)  (1280 + 64 * (j))
#define XB_XGEN(j)  (2304 + 64 * (j))
#define XB_TOP      3328
#define XB_TOPGEN   3392
#define XCD_BAR_WORDS 3456
#define XB_SPIN_CAP (1u << 18)
__device__ __forceinline__ unsigned xb_ld(unsigned* p)              { return __hip_atomic_load(p, __ATOMIC_RELAXED, __HIP_MEMORY_SCOPE_AGENT); }
__device__ __forceinline__ unsigned xb_add(unsigned* p, unsigned v) { return __hip_atomic_fetch_add(p, v, __ATOMIC_RELAXED, __HIP_MEMORY_SCOPE_AGENT); }
__device__ __forceinline__ unsigned xb_xcc_id() { return (unsigned)__builtin_amdgcn_s_getreg((3 << 11) | 20) & 0xFu; }
#define XB_SPIN(cond, bar) do { unsigned _sp = 0; while (cond) { __builtin_amdgcn_s_sleep(1); \
    if ((++_sp & 255u) == 0u) { if (xb_ld(&(bar)[XB_TMO])) break; if (_sp > XB_SPIN_CAP) { atomicAdd(&(bar)[XB_TMO], 1u); break; } } } } while (0)
struct XcdBarrier { unsigned* bar; unsigned x; volatile LAS unsigned* st; };
__device__ __forceinline__ XcdBarrier xcd_barrier_post(unsigned* bar, volatile LAS unsigned* st) {
    XcdBarrier b; b.bar = bar; b.x = xb_xcc_id(); b.st = st;
    if (threadIdx.x == 0) (void)xb_add(&bar[XB_XCNT(b.x)], 1u);
    return b;
}
__device__ __forceinline__ void xcd_barrier_complete(unsigned* bar, unsigned x, unsigned& nloc, unsigned& nx) {
    const unsigned G = gridDim.x * gridDim.y * gridDim.z;
    unsigned sum, cnt, mine, sp = 0u;
    for (;;) {
        sum = 0u; cnt = 0u; mine = 0u;
#pragma unroll
        for (unsigned j = 0; j < 16; ++j) { const unsigned c = xb_ld(&bar[XB_XCNT(j)]); sum += c; cnt += (c > 0u) ? 1u : 0u; mine = (j == x) ? c : mine; }
        if (sum == G) break;
        __builtin_amdgcn_s_sleep(1);
        if ((++sp & 255u) == 0u) { if (xb_ld(&bar[XB_TMO])) break; if (sp > XB_SPIN_CAP) { atomicAdd(&bar[XB_TMO], 1u); break; } }
    }
    nloc = mine > 0u ? mine : 1u; nx = cnt > 0u ? cnt : 1u;
}
__device__ __forceinline__ void xcd_barrier(const XcdBarrier& b) {
    asm volatile("s_waitcnt vmcnt(0)" ::: "memory");
    __syncthreads();
    if (threadIdx.x == 0) {
        unsigned* bar = b.bar;
        __builtin_amdgcn_s_waitcnt(0);
        unsigned nloc = b.st[0], nx = b.st[1];
        if (nloc == 0u) { xcd_barrier_complete(bar, b.x, nloc, nx); b.st[0] = nloc; b.st[1] = nx; }
        const unsigned old = xb_add(&bar[XB_XSUB(b.x)], 1u);
        const unsigned gen = old / nloc;
        if (old + 1u == (gen + 1u) * nloc) {
            __builtin_amdgcn_fence(__ATOMIC_RELEASE, "agent");
            asm volatile("s_waitcnt vmcnt(0)" ::: "memory");
            const unsigned og = xb_add(&bar[XB_TOP], 1u);
            const unsigned tg = og / nx;
            if (og + 1u == (tg + 1u) * nx) xb_add(&bar[XB_TOPGEN], 1u);
            else XB_SPIN(xb_ld(&bar[XB_TOPGEN]) == tg, bar);
            __builtin_amdgcn_fence(__ATOMIC_ACQUIRE, "agent");
            xb_add(&bar[XB_XGEN(b.x)], 1u);
            asm volatile("s_waitcnt vmcnt(0)" ::: "memory");
        } else {
            XB_SPIN(xb_ld(&bar[XB_XGEN(b.x)]) == gen, bar);
            __builtin_amdgcn_fence(__ATOMIC_ACQUIRE, "agent");
            asm volatile("s_waitcnt vmcnt(0)" ::: "memory");
        }
    }
    __syncthreads();
}

namespace pg8 {
constexpr int BM = 256, BK = 64, HALF = 128, HTB = HALF * BK * 2, STAGE_BYTES = 8 * HTB, NXCD = 8, WGM = 8;
__host__ __device__ __forceinline__ int lds_byte(int r, int c) { const int st = (r >> 4) * 2 + (c >> 5), rr = r & 15, cc = c & 31, ob = rr * 64 + cc * 2; return st * 1024 + (ob ^ (((ob >> 9) & 1) << 5)); }
__host__ __device__ __forceinline__ void stage_rc(int b, int& R, int& C) { const int st = b / 1024, sb = b % 1024, swz = sb ^ (((sb >> 9) & 1) << 5); R = (st >> 1) * 16 + swz / 64; C = (st & 1) * 32 + (swz % 64) / 2; }
__host__ __device__ __forceinline__ int perm32(int rho) { const int n = rho >> 4, i = rho & 15; return 8 * (i >> 2) + 4 * n + (i & 3); }

struct Unit { const char* a; const char* b; int pm, pn; };
struct Gemm { int K, lda, ldb, amode; };

struct StaticOrder {
    const bf16_t* A; const bf16_t* Bt; int lda, ldb;
    int nM, nN, nwg, G, c; size_t tstepA;
    __device__ void init(const bf16_t* A_, const bf16_t* Bt_, int lda_, int ldb_, int M, int N, int G_, int c_) { A = A_; Bt = Bt_; lda = lda_; ldb = ldb_; nM = M / BM; nN = N / BM; nwg = nM * nN; G = G_; c = c_; tstepA = (size_t)BM * lda * 2; }
    __device__ bool next(int i, Unit& u) const {
        const long L = (long)i * G + c; if (L >= nwg) return false;
        int wgid = (int)L; { const int q = nwg / NXCD, r = nwg % NXCD, xcd = wgid % NXCD, off = wgid / NXCD; wgid = (xcd < r ? xcd * (q + 1) : r * (q + 1) + (xcd - r) * q) + off; }
        const int nig = WGM * nN, gid = wgid / nig, fm = gid * WGM, gsz = (nM - fm) < WGM ? (nM - fm) : WGM;
        u.pm = fm + ((wgid % nig) % gsz); u.pn = (wgid % nig) / gsz;
        u.a = (const char*)A + (size_t)u.pm * tstepA; u.b = (const char*)Bt + (size_t)u.pn * BM * ldb * 2; return true;
    }
};

template <class Epi, class Sched, bool ALIGN_EPI = false, bool SP2 = true>
__device__ __forceinline__ void gemm_phase(LAS unsigned char* lds, const Gemm g, const Sched& S, const Epi& E, const int tid) {
    const int wid = __builtin_amdgcn_readfirstlane(tid >> 6), lane = tid & 63, wr = wid >> 2, wc = wid & 3, fr = lane & 15, fq = lane >> 4;
    const int K = g.K, nt = K / BK;
    unsigned voffA[2], voffB[2];
#pragma unroll
    for (int i = 0; i < 2; ++i) { int R, C; stage_rc(tid * 16 + i * 8192, R, C); const int Rb = Epi::PERM ? ((R & ~31) + perm32(R & 31)) : R;
        voffA[i] = g.amode ? (unsigned)((((C >> 4) * S5ROWS + (R >> 4)) * 256 + (R & 15) * 16 + (C & 15)) * 2) : (unsigned)(R * g.lda + C) * 2u; voffB[i] = (unsigned)(Rb * g.ldb + C) * 2u; }
    const size_t kstepB = (size_t)(BK * 2), kstepA = g.amode ? (size_t)4 * S5ROWS * 256 * 2 : (size_t)(BK * 2);
    const size_t hstepA = g.amode ? (size_t)8 * 256 * 2 : (size_t)HALF * g.lda * 2, hstepB = (size_t)HALF * g.ldb * 2;
    const unsigned ldsw = (unsigned)wid * 1024u;
    const int aoff = lds_byte(wr * 64 + fr, fq * 8), boff = lds_byte(wc * 32 + fr, fq * 8);
#define PG8_SA(b, h) (((b) * 2 + (h)) * HTB)
#define PG8_SB(b, h) ((4 + (b) * 2 + (h)) * HTB)
#define PG8_STAGE(bufoff, gbase, voff) do { _Pragma("unroll") for (int _i = 0; _i < 2; ++_i) \
        __builtin_amdgcn_global_load_lds((const unsigned*)((const char*)(gbase) + (voff)[_i]), (LAS unsigned*)(lds + (bufoff) + ldsw + _i * 8192), 16, 0, 0); } while (0)
#define PG8_LDA(dst, b, h) do { _Pragma("unroll") for (int m = 0; m < 4; ++m) _Pragma("unroll") for (int k = 0; k < 2; ++k) dst[m][k] = *(const LAS bf16x8*)(lds + PG8_SA(b, h) + aoff + m * 2048 + k * 1024); } while (0)
#define PG8_LDB(dst, b, h) do { _Pragma("unroll") for (int n = 0; n < 2; ++n) _Pragma("unroll") for (int k = 0; k < 2; ++k) dst[n][k] = *(const LAS bf16x8*)(lds + PG8_SB(b, h) + boff + n * 2048 + k * 1024); } while (0)
#define PG8_MMA(ai, bj, At, Bt) do { __builtin_amdgcn_s_setprio(1); _Pragma("unroll") for (int m = 0; m < 4; ++m) _Pragma("unroll") for (int n = 0; n < 2; ++n) _Pragma("unroll") for (int k = 0; k < 2; ++k) \
        acc[ai][bj][m][n] = __builtin_amdgcn_mfma_f32_16x16x32_bf16(Bt[n][k], At[m][k], acc[ai][bj][m][n], 0, 0, 0); __builtin_amdgcn_s_setprio(0); } while (0)
#define PG8_WAIT_V(n) asm volatile("s_waitcnt vmcnt(" #n ")" ::: "memory")
#define PG8_WAIT_L(n) asm volatile("s_waitcnt lgkmcnt(" #n ")" ::: "memory")
#define PG8_BAR __builtin_amdgcn_s_barrier()
#define PG8_SCHED __builtin_amdgcn_sched_barrier(0)
    Unit cur, nxt; int ui = 0;
    if (!S.next(0, cur)) return;
    f32x4 acc[2][2][4][2];
#pragma unroll
    for (int a = 0; a < 2; ++a)
#pragma unroll
        for (int b = 0; b < 2; ++b)
#pragma unroll
            for (int m = 0; m < 4; ++m)
#pragma unroll
                for (int n = 0; n < 2; ++n) acc[a][b][m][n] = (f32x4){0.f, 0.f, 0.f, 0.f};
    bf16x8 At[4][2], B0[2][2], B1[2][2];
    const char* cA = cur.a; const char* cB = cur.b;
    static_assert(SP2, "only the SP2 loop is kept");
    PG8_STAGE(PG8_SB(0, 0), cB, voffB); PG8_STAGE(PG8_SB(0, 1), cB + hstepB, voffB); PG8_STAGE(PG8_SA(0, 0), cA, voffA); PG8_STAGE(PG8_SA(0, 1), cA + hstepA, voffA);
    if (wr == 1) PG8_BAR;
    PG8_WAIT_V(2); PG8_BAR;
    PG8_STAGE(PG8_SB(1, 0), cB + kstepB, voffB); PG8_STAGE(PG8_SA(1, 0), cA + kstepA, voffA); PG8_STAGE(PG8_SB(1, 1), cB + hstepB + kstepB, voffB);
    PG8_WAIT_V(6); PG8_BAR;
    for (;;) {
        const bool has_next = S.next(ui + 1, nxt);
        const char* nA = has_next ? nxt.a : cA; const char* nB = has_next ? nxt.b : cB;
#pragma unroll 1
        for (int t = 0; t < nt; t += 2) {
            if constexpr (Epi::HAS_MID) { if (t == E.mid_t) { E.mid(acc, cur, wr, wc, fr, fq); PG8_SCHED; } }
            const bool last = (t == nt - 2);
            const char* a1 = cA + (size_t)(t + 1) * kstepA;
            const char* a2 = last ? nA : cA + (size_t)(t + 2) * kstepA; const char* b2 = last ? nB : cB + (size_t)(t + 2) * kstepB;
            const char* a3 = a2 + kstepA; const char* b3 = b2 + kstepB;
            PG8_LDB(B0, 0, 0); PG8_LDB(B1, 0, 1); PG8_SCHED; PG8_LDA(At, 0, 0); PG8_STAGE(PG8_SA(1, 1), a1 + hstepA, voffA);
            PG8_WAIT_V(8); PG8_WAIT_L(0); PG8_BAR; PG8_MMA(0, 0, At, B0); PG8_MMA(0, 1, At, B1); PG8_BAR; PG8_SCHED;
            PG8_LDA(At, 0, 1); PG8_STAGE(PG8_SB(0, 0), b2, voffB); PG8_STAGE(PG8_SB(0, 1), b2 + hstepB, voffB); PG8_STAGE(PG8_SA(0, 0), a2, voffA);
            PG8_WAIT_V(8); PG8_WAIT_L(0); PG8_BAR; PG8_MMA(1, 0, At, B0); PG8_MMA(1, 1, At, B1); PG8_BAR; PG8_SCHED;
            PG8_LDB(B0, 1, 0); PG8_LDB(B1, 1, 1); PG8_SCHED; PG8_LDA(At, 1, 0); PG8_STAGE(PG8_SA(0, 1), a2 + hstepA, voffA);
            PG8_WAIT_V(8); PG8_WAIT_L(0); PG8_BAR; PG8_MMA(0, 0, At, B0); PG8_MMA(0, 1, At, B1); PG8_BAR; PG8_SCHED;
            PG8_LDA(At, 1, 1); PG8_STAGE(PG8_SB(1, 0), b3, voffB); PG8_STAGE(PG8_SB(1, 1), b3 + hstepB, voffB); PG8_STAGE(PG8_SA(1, 0), a3, voffA);
            PG8_WAIT_V(8); PG8_WAIT_L(0); PG8_BAR; PG8_MMA(1, 0, At, B0); PG8_MMA(1, 1, At, B1); PG8_BAR; PG8_SCHED;
        }
        if constexpr (ALIGN_EPI) { if (wr == 0) PG8_BAR; }
        E(acc, cur, wr, wc, fr, fq);
        if (!has_next) break;
#pragma unroll
        for (int a = 0; a < 2; ++a)
#pragma unroll
            for (int b = 0; b < 2; ++b)
#pragma unroll
                for (int m = 0; m < 4; ++m)
#pragma unroll
                    for (int n = 0; n < 2; ++n) acc[a][b][m][n] = (f32x4){0.f, 0.f, 0.f, 0.f};
        cur = nxt; cA = nA; cB = nB; ++ui;
        if constexpr (ALIGN_EPI) { if (wr == 1) PG8_BAR; }
    }
    PG8_WAIT_V(0);
    if constexpr (!ALIGN_EPI) { if (wr == 0) PG8_BAR; }
    PG8_BAR;
#undef PG8_SA
#undef PG8_SB
#undef PG8_STAGE
#undef PG8_LDA
#undef PG8_LDB
#undef PG8_MMA
#undef PG8_WAIT_V
#undef PG8_WAIT_L
#undef PG8_BAR
#undef PG8_SCHED
}

template <class F> struct EpiGen8 {
    static constexpr bool PERM = true, HAS_MID = false; F f; int mid_t;
    __device__ __forceinline__ void mid(f32x4 (&)[2][2][4][2], const Unit&, int, int, int, int) const {}
    __device__ __forceinline__ void operator()(const f32x4 (&acc)[2][2][4][2], const Unit& u, int wr, int wc, int fr, int fq) const {
#pragma unroll
        for (int ai = 0; ai < 2; ++ai)
#pragma unroll
            for (int m = 0; m < 4; ++m) { const int r = ai * HALF + wr * 64 + m * 16 + fr;
#pragma unroll
                for (int bj = 0; bj < 2; ++bj) f(u, r, bj * HALF + wc * 32 + 8 * fq, acc[ai][bj][m][0], acc[ai][bj][m][1]);
                if constexpr (F::PIN) __builtin_amdgcn_sched_barrier(0); }
    }
};
}

typedef const float* cfp_t;
typedef __attribute__((address_space(4))) const cfp_t* InTab;
struct Frame {
    LAS unsigned char* lds;
    volatile LAS unsigned* MISC;
    gu32* ctl;
    int tid, lane, wave, vcu, G;
    unsigned char* ws; unsigned char* dout; unsigned char* ws0; unsigned char* dout0;
    InTab in;
};
enum { I_X = 0, I_NMPRE, I_NMPOST, I_NFPRE, I_NFPOST, I_WIN, I_BGATE, I_MU, I_W0, I_W2, I_A0, I_A2, I_G2, I_KK, I_KA, I_RK, I_LNW, I_LNB,
       I_SARE, I_SAIM, I_SBRE, I_SBIM, I_SCRE, I_SCIM, I_SD, I_SLOG, I_WGLU, I_BGLU, I_WBR, I_WBS, I_WOUT, I_WUP, I_CONVW, I_CONVB, I_WDN };

__device__ __forceinline__ void p0_transpose_item(const float* W, int ldw, int k0, int src0, bf16_t* WT, int ldt, int drow0, int koff, const float* kscale, LAS float* scr, int lane) {
    const int q = lane & 7, rb = lane >> 3;
    f32x4 v[8]; float sc[8];
#pragma unroll
    for (int i = 0; i < 8; ++i) { const int kk = 8 * i + rb; v[i] = __builtin_nontemporal_load((const f32x4*)(W + (size_t)(k0 + kk) * ldw + src0 + 4 * q)); sc[i] = kscale ? kscale[k0 + kk] : 1.0f; }
#pragma unroll
    for (int i = 0; i < 8; ++i) { const int kk = 8 * i + rb; LAS float* d = scr + kk * 33 + 4 * q; d[0] = v[i].x * sc[i]; d[1] = v[i].y * sc[i]; d[2] = v[i].z * sc[i]; d[3] = v[i].w * sc[i]; }
    LDS_WAIT(); asm volatile("" ::: "memory");
    const int c = lane & 7;
#pragma unroll
    for (int j = 0; j < 4; ++j) { const int n = (lane >> 3) + 8 * j; const LAS float* s = scr + (8 * c) * 33 + n;
        u32x4 o; o.x = cvt_pk_bf16(s[0 * 33], s[1 * 33]); o.y = cvt_pk_bf16(s[2 * 33], s[3 * 33]); o.z = cvt_pk_bf16(s[4 * 33], s[5 * 33]); o.w = cvt_pk_bf16(s[6 * 33], s[7 * 33]);
        *(GAS u32x4*)(WT + (size_t)(drow0 + n) * ldt + koff + k0 + 8 * c) = o; }
    LDS_WAIT(); asm volatile("" ::: "memory");
}
struct TrMat { int in_idx, K, N, ldt, koff, kind; size_t dst; int scale_idx; };
__device__ __forceinline__ void p0_do_matrix(Frame& F, const TrMat& mtx, int r, LAS float* scr) {
    const int nblk = mtx.N / 32, kb = r / nblk, nb = r % nblk;
    int src0 = 32 * nb;
    if (mtx.kind == 1) {
        const int pn = (32 * nb) >> 8, within = (32 * nb) & 255;
        src0 = (within < 128 ? 0 : FF - 128) + 128 * pn + within;
    }
    p0_transpose_item(F.in[mtx.in_idx], mtx.N, 64 * kb, src0, (bf16_t*)(F.ws + mtx.dst), mtx.ldt, 32 * nb, mtx.koff, mtx.scale_idx >= 0 ? F.in[mtx.scale_idx] : nullptr, scr, F.lane);
}
__device__ __forceinline__ void p0_s5_group(Frame& F, int g) {
    LAS float* pwr = (LAS float*)(F.lds);
    LAS float* pwi = pwr + 17 * 64;
    LAS float* bbr = pwi + 17 * 64;
    LAS float* bbi = bbr + 1024;
    LAS float* cre = bbi + 1024;
    LAS float* cim = cre + 1024;
    LAS float* kk = cim + 1024;
    const float dt = expf(F.in[I_SLOG][g]);
    for (int idx = F.tid; idx < 17 * 64; idx += 512) { const int k = idx >> 6, p = idx & 63;
        const float are = F.in[I_SARE][g * 64 + p], aim = F.in[I_SAIM][g * 64 + p];
        const float mag = expf((float)k * are * dt); float sn, cs; sincosf((float)k * aim * dt, &sn, &cs);
        pwr[idx] = mag * cs; pwi[idx] = mag * sn; }
    for (int idx = F.tid; idx < 1024; idx += 512) { cre[idx] = F.in[I_SCRE][g * 1024 + idx]; cim[idx] = F.in[I_SCIM][g * 1024 + idx]; }
    __syncthreads();
    for (int idx = F.tid; idx < 1024; idx += 512) { const int p = idx >> 4;
        const float are = F.in[I_SARE][g * 64 + p], aim = F.in[I_SAIM][g * 64 + p];
        const float nr = pwr[64 + p] - 1.0f, ni = pwi[64 + p];
        const float den = 1.0f / (are * are + aim * aim);
        const float qr = (nr * are + ni * aim) * den, qi = (ni * are - nr * aim) * den;
        const float br = F.in[I_SBRE][g * 1024 + idx], bi = F.in[I_SBIM][g * 1024 + idx];
        bbr[idx] = qr * br - qi * bi; bbi[idx] = qr * bi + qi * br; }
    __syncthreads();
    {
        const int kc = F.tid & 255, ph = F.tid >> 8, k = kc >> 4, c = kc & 15; float s[16];
#pragma unroll
        for (int e = 0; e < 16; ++e) s[e] = 0.f;
        for (int p = 32 * ph; p < 32 * ph + 32; ++p) { const float cr_ = cre[c * 64 + p], ci_ = cim[c * 64 + p], pr_ = pwr[k * 64 + p], pi_ = pwi[k * 64 + p];
            const float xr = cr_ * pr_ - ci_ * pi_, xi = cr_ * pi_ + ci_ * pr_;
#pragma unroll
            for (int e4 = 0; e4 < 4; ++e4) { const f32x4 br = *(LAS const f32x4*)(bbr + p * 16 + 4 * e4), bi = *(LAS const f32x4*)(bbi + p * 16 + 4 * e4);
#pragma unroll
                for (int e = 0; e < 4; ++e) s[4 * e4 + e] += xr * br[e] - xi * bi[e]; } }
        LAS float* part = kk + 4096;
        if (ph == 1) {
#pragma unroll
            for (int e4 = 0; e4 < 4; ++e4) *(LAS f32x4*)(part + kc * 16 + 4 * e4) = (f32x4){s[4 * e4], s[4 * e4 + 1], s[4 * e4 + 2], s[4 * e4 + 3]}; }
        __syncthreads();
        if (ph == 0) {
#pragma unroll
            for (int e4 = 0; e4 < 4; ++e4) { const f32x4 o = *(LAS const f32x4*)(part + kc * 16 + 4 * e4);
#pragma unroll
                for (int e = 0; e < 4; ++e) { float v = s[4 * e4 + e] + o[e]; if (k == 0 && c == 4 * e4 + e) v += F.in[I_SD][g * 16 + c]; kk[kc * 16 + 4 * e4 + e] = v; } } }
    }
    __syncthreads();
    bf16_t* B1b = (bf16_t*)(F.ws + WS_B1B) + (size_t)g * 256 * 384;
    for (int idx = F.tid; idx < 256 * 48; idx += 512) { const int n = idx / 48, j = idx - n * 48, t = n >> 4, c = n & 15; float v[8];
        if (j < 32) { const int tau = j >> 1, cp0 = (j & 1) * 8; const int ko = (t >= tau ? t - tau : 0) * 256 + c * 16 + cp0; const float m = (t >= tau) ? 1.f : 0.f;
            const f32x4 a0 = *(LAS const f32x4*)(kk + ko), a1 = *(LAS const f32x4*)(kk + ko + 4);
#pragma unroll
            for (int e = 0; e < 4; ++e) { v[e] = a0[e] * m; v[4 + e] = a1[e] * m; } }
        else { const int p0 = (j - 32) * 4; const f32x4 cr4 = *(LAS const f32x4*)(cre + c * 64 + p0), ci4 = *(LAS const f32x4*)(cim + c * 64 + p0), pr4 = *(LAS const f32x4*)(pwr + (t + 1) * 64 + p0), pi4 = *(LAS const f32x4*)(pwi + (t + 1) * 64 + p0);
#pragma unroll
            for (int q = 0; q < 4; ++q) { v[2 * q] = cr4[q] * pr4[q] - ci4[q] * pi4[q]; v[2 * q + 1] = -(cr4[q] * pi4[q] + ci4[q] * pr4[q]); } }
        *(u32x4*)(B1b + (size_t)n * 384 + 8 * j) = pack8(v); }
    bf16_t* B1a = (bf16_t*)(F.ws + WS_B1A) + (size_t)g * 256 * 256;
    for (int idx = F.tid; idx < 256 * 32; idx += 512) { const int n = idx >> 5, j = idx & 31; float v[8];
#pragma unroll
        for (int e = 0; e < 8; ++e) v[e] = 0.f;
        if (n < 128) { const int p = n >> 1, tau = j >> 1, cp0 = (j & 1) * 8; const float pr_ = pwr[(15 - tau) * 64 + p], pi_ = pwi[(15 - tau) * 64 + p];
            const f32x4 r0 = *(LAS const f32x4*)(bbr + p * 16 + cp0), r1 = *(LAS const f32x4*)(bbr + p * 16 + cp0 + 4), i0 = *(LAS const f32x4*)(bbi + p * 16 + cp0), i1 = *(LAS const f32x4*)(bbi + p * 16 + cp0 + 4);
#pragma unroll
            for (int e = 0; e < 8; ++e) { const float br = e < 4 ? r0[e & 3] : r1[e & 3], bi = e < 4 ? i0[e & 3] : i1[e & 3]; v[e] = (n & 1) ? (pr_ * bi + pi_ * br) : (pr_ * br - pi_ * bi); } }
        *(u32x4*)(B1a + (size_t)n * 256 + 8 * j) = pack8(v); }
    float* aL = (float*)(F.ws + WS_AL) + g * 128;
    if (F.tid < 64) { aL[2 * F.tid] = pwr[16 * 64 + F.tid]; aL[2 * F.tid + 1] = pwi[16 * 64 + F.tid]; }
    __syncthreads();
}
#define DO_MAT(in_idx, K_, N_, ldt_, koff_, kind_, dst_, sc_) do { const TrMat mtx{in_idx, K_, N_, ldt_, koff_, kind_, dst_, sc_}; const int items = ((K_) / 64) * ((N_) / 32); \
        for (int it = gw; it < base + items; it += NGW) { if (it >= base) p0_do_matrix(F, mtx, it - base, scr); } base += items; } while (0)
__device__ __forceinline__ void p0_late_mats(Frame& F, int gw, int NGW) {
    LAS float* scr = (LAS float*)(F.lds + F.wave * 16384);
    int base = 0;
    DO_MAT(I_WUP, D, 2 * FF, D, 0, 1, WS_WUP, I_NFPRE); DO_MAT(I_WDN, FF, D, FF, 0, 0, WS_WDN, -1); DO_MAT(I_WOUT, D, D, D, 0, 0, WS_WOUT, -1);
    DO_MAT(I_WBR, RW, D, D, 0, 0, WS_WBRS, -1); DO_MAT(I_WBS, RW, D, D, RW, 0, WS_WBRS, -1); DO_MAT(I_WGLU, RW, RW, RW, 0, 0, WS_WGLU, -1);
}
__device__ __forceinline__ void p0_prologue(Frame& F) {
    const bool s5wg = F.vcu < S5G && F.G > S5G;
    if (F.vcu < S5G) p0_s5_group(F, F.vcu);
    if (!s5wg) {
        LAS float* scr = (LAS float*)(F.lds + F.wave * 16384);
        const int gw = (F.G > S5G ? F.vcu - S5G : F.vcu) * NWAVES + F.wave, NGW = (F.G > S5G ? F.G - S5G : F.G) * NWAVES;
        int base = 0;
        DO_MAT(I_WIN, D, NIN, D, 0, 0, WS_WIN, I_NMPRE);
        DO_MAT(I_W2, 64, RW, 64, 0, 0, WS_W2T, -1); DO_MAT(I_A2, 64, RW, 64, 0, 0, WS_A2T, -1); DO_MAT(I_G2, 128, RW, 128, 0, 0, WS_G2T, -1);
    }
    {
        bf16_t* XN = (bf16_t*)(F.ws + WS_XN);
        const int nch = T / 4, split = (F.G > S5G) ? nch / 2 : 0;
#pragma unroll 1
        for (int pass = 0; pass < 2; ++pass) {
            if (pass == 0 && (s5wg || split == 0)) continue;
            const int lo = pass == 0 ? 0 : split, hi = pass == 0 ? split : nch;
            const int gw = (pass == 0 ? F.vcu - S5G : F.vcu) * NWAVES + F.wave, NGW = (pass == 0 ? F.G - S5G : F.G) * NWAVES;
#pragma unroll 1
            for (int ch = lo + gw; ch < hi; ch += NGW) {
                const int m = 4 * ch;
                f32x4 v[4][4]; float s[4];
#pragma unroll
                for (int q = 0; q < 4; ++q) { const GAS f32x4* xr = (const GAS f32x4*)(F.in[I_X] + (size_t)(m + q) * D) + F.lane;
#pragma unroll
                    for (int j = 0; j < 4; ++j) v[q][j] = __builtin_nontemporal_load((const f32x4*)(xr + 64 * j)); }
#pragma unroll
                for (int q = 0; q < 4; ++q) { s[q] = 0.f;
#pragma unroll
                    for (int j = 0; j < 4; ++j) s[q] += (v[q][j].x * v[q][j].x + v[q][j].y * v[q][j].y) + (v[q][j].z * v[q][j].z + v[q][j].w * v[q][j].w); }
#pragma unroll
                for (int q = 0; q < 4; ++q) { const float r = 1.0f / sqrtf(wave_sum(s[q]) * (1.f / D) + 1e-6f);
                    GAS u32x2* o = (GAS u32x2*)(XN + (size_t)(m + q) * D) + F.lane;
#pragma unroll
                    for (int j = 0; j < 4; ++j) { u32x2 w; w.x = cvt_pk_bf16(v[q][j].x * r, v[q][j].y * r); w.y = cvt_pk_bf16(v[q][j].z * r, v[q][j].w * r); o[64 * j] = w; } }
            }
        }
    }
}

struct EpiInProj {
    static constexpr bool PERM = true, HAS_MID = false;
    bf16_t* PR; bf16_t* UG; bf16_t* GT; const float* bg; int mid_t;
    __device__ __forceinline__ void mid(f32x4 (&)[2][2][4][2], const pg8::Unit&, int, int, int, int) const {}
    __device__ __forceinline__ void operator()(const f32x4 (&acc)[2][2][4][2], const pg8::Unit& u, int wr, int wc, int fr, int fq) const {
        f32x4 b0[2], b1[2];
        if (u.pn >= 9) {
#pragma unroll
            for (int bj = 0; bj < 2; ++bj) { const int gc = (u.pn - 9) * 256 + bj * 128 + wc * 32 + 8 * fq; b0[bj] = *(const f32x4*)(bg + gc); b1[bj] = *(const f32x4*)(bg + gc + 4); } }
#pragma unroll
        for (int ai = 0; ai < 2; ++ai)
#pragma unroll
            for (int m = 0; m < 4; ++m) { const int row = u.pm * 256 + ai * 128 + wr * 64 + m * 16 + fr;
#pragma unroll
                for (int bj = 0; bj < 2; ++bj) { const int cl = bj * 128 + wc * 32 + 8 * fq; const f32x4 v0 = acc[ai][bj][m][0], v1 = acc[ai][bj][m][1]; u32x4 w;
                    if (u.pn < 7) { w.x = cvt_pk_bf16(v0[0], v0[1]); w.y = cvt_pk_bf16(v0[2], v0[3]); w.z = cvt_pk_bf16(v1[0], v1[1]); w.w = cvt_pk_bf16(v1[2], v1[3]);
                        *(u32x4*)(PR + (size_t)row * NRW + u.pn * 256 + cl) = w; }
                    else if (u.pn < 9) { const int cr = (u.pn - 7) * 256 + cl, g = cr >> 4, c0 = cr & 15;
                        w.x = cvt_pk_bf16(v0[0], v0[1]); w.y = cvt_pk_bf16(v0[2], v0[3]); w.z = cvt_pk_bf16(v1[0], v1[1]); w.w = cvt_pk_bf16(v1[2], v1[3]);
                        *(u32x4*)(UG + ((size_t)g * S5ROWS + (row >> 4)) * UGLD + (row & 15) * 16 + c0) = w; }
                    else { const int gc = (u.pn - 9) * 256 + cl;
                        w.x = cvt_pk_bf16(fsigmoid(v0[0] + b0[bj][0]), fsigmoid(v0[1] + b0[bj][1])); w.y = cvt_pk_bf16(fsigmoid(v0[2] + b0[bj][2]), fsigmoid(v0[3] + b0[bj][3]));
                        w.z = cvt_pk_bf16(fsigmoid(v1[0] + b1[bj][0]), fsigmoid(v1[1] + b1[bj][1])); w.w = cvt_pk_bf16(fsigmoid(v1[2] + b1[bj][2]), fsigmoid(v1[3] + b1[bj][3]));
                        __builtin_nontemporal_store(w, (u32x4*)(GT + ((size_t)(u.pm * 8 + (u.pn - 9)) << 16) + (((wr * 4 + wc) * 16 + (ai * 4 + m) * 2 + bj) << 9) + (fq * 16 + fr) * 8)); } }
                __builtin_amdgcn_sched_barrier(0); }
    }
};
struct FS5Out {
    static constexpr bool PIN = true;
    bf16_t* YSP;
    __device__ __forceinline__ void operator()(const pg8::Unit& u, int r, int cl, f32x4 v0, f32x4 v1) const {
        const int crow = u.pm * 256 + r; u32x4 w;
        w.x = cvt_pk_bf16(fgelu(v0[0]), fgelu(v0[1])); w.y = cvt_pk_bf16(fgelu(v0[2]), fgelu(v0[3])); w.z = cvt_pk_bf16(fgelu(v1[0]), fgelu(v1[1])); w.w = cvt_pk_bf16(fgelu(v1[2]), fgelu(v1[3]));
        *(u32x4*)(YSP + ((size_t)u.pn * S5ROWS + crow) * 256 + cl) = w;
    }
};
struct EpiGlu {
    static constexpr bool PERM = true, HAS_MID = false;
    const bf16_t* YSP; bf16_t* YS; const float* bglu; int mid_t;
    __device__ __forceinline__ void mid(f32x4 (&)[2][2][4][2], const pg8::Unit&, int, int, int, int) const {}
    __device__ __forceinline__ void operator()(const f32x4 (&acc)[2][2][4][2], const pg8::Unit& u, int wr, int wc, int fr, int fq) const {
        u32x4 yv[2][4][2]; f32x4 b0[2], b1[2];
#pragma unroll
        for (int bj = 0; bj < 2; ++bj) { const int col = u.pn * 256 + bj * 128 + wc * 32 + 8 * fq; b0[bj] = *(const f32x4*)(bglu + col); b1[bj] = *(const f32x4*)(bglu + col + 4); }
#pragma unroll
        for (int ai = 0; ai < 2; ++ai)
#pragma unroll
            for (int m = 0; m < 4; ++m)
#pragma unroll
                for (int bj = 0; bj < 2; ++bj) { const int row = u.pm * 256 + ai * 128 + wr * 64 + m * 16 + fr, col = u.pn * 256 + bj * 128 + wc * 32 + 8 * fq;
                    yv[ai][m][bj] = __builtin_nontemporal_load((const u32x4*)(YSP + ((size_t)(col >> 4) * S5ROWS + (row >> 4)) * 256 + (row & 15) * 16 + (col & 15))); }
#pragma unroll
        for (int ai = 0; ai < 2; ++ai)
#pragma unroll
            for (int m = 0; m < 4; ++m) {
#pragma unroll
                for (int bj = 0; bj < 2; ++bj) { const int row = u.pm * 256 + ai * 128 + wr * 64 + m * 16 + fr, col = u.pn * 256 + bj * 128 + wc * 32 + 8 * fq; float y[8]; unpack8(yv[ai][m][bj], y);
                    const f32x4 v0 = acc[ai][bj][m][0], v1 = acc[ai][bj][m][1]; u32x4 w;
                    w.x = cvt_pk_bf16(y[0] * fsigmoid(v0[0] + b0[bj][0]), y[1] * fsigmoid(v0[1] + b0[bj][1])); w.y = cvt_pk_bf16(y[2] * fsigmoid(v0[2] + b0[bj][2]), y[3] * fsigmoid(v0[3] + b0[bj][3]));
                    w.z = cvt_pk_bf16(y[4] * fsigmoid(v1[0] + b1[bj][0]), y[5] * fsigmoid(v1[1] + b1[bj][1])); w.w = cvt_pk_bf16(y[6] * fsigmoid(v1[2] + b1[bj][2]), y[7] * fsigmoid(v1[3] + b1[bj][3]));
                    *(u32x4*)(YS + (size_t)row * D + RW + col) = w; }
                __builtin_amdgcn_sched_barrier(0); }
    }
};
struct FStore {
    static constexpr bool PIN = false;
    bf16_t* O; int ldc;
    __device__ __forceinline__ void operator()(const pg8::Unit& u, int r, int cl, f32x4 v0, f32x4 v1) const {
        u32x4 w; w.x = cvt_pk_bf16(v0[0], v0[1]); w.y = cvt_pk_bf16(v0[2], v0[3]); w.z = cvt_pk_bf16(v1[0], v1[1]); w.w = cvt_pk_bf16(v1[2], v1[3]);
        *(u32x4*)(O + (size_t)(u.pm * 256 + r) * ldc + u.pn * 256 + cl) = w;
    }
};
struct EpiMerge {
    static constexpr bool PERM = true, HAS_MID = true;
    const bf16_t* GT; bf16_t* O; int mid_t;
    __device__ __forceinline__ void mid(f32x4 (&acc)[2][2][4][2], const pg8::Unit& u, int wr, int wc, int fr, int fq) const {
        unsigned vo = (unsigned)((((wr * 4 + wc) * 16) << 9) + (fq * 16 + fr) * 8) * 2u; asm volatile("" : "+v"(vo));
        const char* gr = (const char*)(GT + ((size_t)(u.pm * 8 + u.pn) << 16)); const char* gs = (const char*)(GT + ((size_t)(u.pm * 8 + 4 + u.pn) << 16));
#pragma unroll
        for (int ai = 0; ai < 2; ++ai)
#pragma unroll
            for (int m = 0; m < 4; ++m) {
                u32x4 a[2], b[2];
#pragma unroll
                for (int bj = 0; bj < 2; ++bj) { const unsigned go = vo + (unsigned)((((ai * 4 + m) * 2 + bj) << 9) * 2); a[bj] = __builtin_nontemporal_load((const u32x4*)(gr + go)); b[bj] = __builtin_nontemporal_load((const u32x4*)(gs + go)); }
                __builtin_amdgcn_sched_barrier(0);
#pragma unroll
                for (int bj = 0; bj < 2; ++bj) {
                    const unsigned aw[4] = {a[bj].x, a[bj].y, a[bj].z, a[bj].w}, bw[4] = {b[bj].x, b[bj].y, b[bj].z, b[bj].w};
#pragma unroll
                    for (int h = 0; h < 4; ++h) {
                        acc[ai][bj][m][h >> 1][2 * (h & 1)] *= bf_lo(aw[h]) * __builtin_amdgcn_rcpf(bf_lo(bw[h]));
                        acc[ai][bj][m][h >> 1][2 * (h & 1) + 1] *= bf_hi(aw[h]) * __builtin_amdgcn_rcpf(bf_hi(bw[h])); } }
                __builtin_amdgcn_sched_barrier(0);
            }
    }
    __device__ __forceinline__ void operator()(const f32x4 (&acc)[2][2][4][2], const pg8::Unit& u, int wr, int wc, int fr, int fq) const {
        const size_t lo = ((size_t)((wr * 4 + wc) * 16) << 9) + (fq * 16 + fr) * 8;
        const bf16_t* gs = GT + ((size_t)(u.pm * 8 + 4 + u.pn) << 16) + lo;
        u32x4 gv[2][4][2];
#pragma unroll
        for (int ai = 0; ai < 2; ++ai)
#pragma unroll
            for (int m = 0; m < 4; ++m)
#pragma unroll
                for (int bj = 0; bj < 2; ++bj) gv[ai][m][bj] = __builtin_nontemporal_load((const u32x4*)(gs + (((ai * 4 + m) * 2 + bj) << 9)));
#pragma unroll
        for (int ai = 0; ai < 2; ++ai)
#pragma unroll
            for (int m = 0; m < 4; ++m) {
#pragma unroll
                for (int bj = 0; bj < 2; ++bj) { const int row = u.pm * 256 + ai * 128 + wr * 64 + m * 16 + fr, col = u.pn * 256 + bj * 128 + wc * 32 + 8 * fq; float g[8]; unpack8(gv[ai][m][bj], g);
                    const f32x4 v0 = acc[ai][bj][m][0], v1 = acc[ai][bj][m][1]; u32x4 w;
                    w.x = cvt_pk_bf16(v0[0] * g[0], v0[1] * g[1]); w.y = cvt_pk_bf16(v0[2] * g[2], v0[3] * g[3]); w.z = cvt_pk_bf16(v1[0] * g[4], v1[1] * g[5]); w.w = cvt_pk_bf16(v1[2] * g[6], v1[3] * g[7]);
                    *(u32x4*)(O + (size_t)row * D + col) = w; }
                __builtin_amdgcn_sched_barrier(0); }
    }
};
struct UpOrder {
    const bf16_t* H2; const bf16_t* Wt; int G, c;
    __device__ bool next(int i, pg8::Unit& u) const {
        constexpr int nM = NB * 16, nN = 22, nwg = nM * nN;
        const long L = (long)i * G + c; if (L >= nwg) return false;
        int wgid = (int)L; { const int q = nwg / 8, r = nwg % 8, xcd = wgid % 8, off = wgid / 8; wgid = (xcd < r ? xcd * (q + 1) : r * (q + 1) + (xcd - r) * q) + off; }
        const int nig = 8 * nN, gid = wgid / nig, fm = gid * 8, gsz = (nM - fm) < 8 ? (nM - fm) : 8;
        u.pm = fm + ((wgid % nig) % gsz); u.pn = (wgid % nig) / gsz;
        u.a = (const char*)H2 + ((size_t)u.pm * 256 * D) * 2; u.b = (const char*)(Wt + (size_t)u.pn * 256 * D); return true;
    }
};
template <int CTRL> __device__ __forceinline__ unsigned dppu(unsigned v) { return (unsigned)__builtin_amdgcn_update_dpp(0, (int)v, CTRL, 0xf, 0xf, true); }
template <int CTRL> __device__ __forceinline__ unsigned dppk(unsigned keep, unsigned v) { return (unsigned)__builtin_amdgcn_update_dpp((int)keep, (int)v, CTRL, 0xf, 0xf, false); }
struct EpiConvAct {
    static constexpr bool PERM = true, HAS_MID = false;
    bf16_t* ACT; const float* cw; const float* cb; LAS unsigned* EX; unsigned long long* HZ; unsigned* tmo; int mid_t;
    __device__ __forceinline__ void mid(f32x4 (&)[2][2][4][2], const pg8::Unit&, int, int, int, int) const {}
    __device__ __forceinline__ void operator()(f32x4 (&acc)[2][2][4][2], const pg8::Unit& u, int wr, int wc, int fr, int fq) const {
        const int b = u.pm >> 4, k = u.pm & 15, t0 = 256 * k;
        u32x2 zp[2][2][4][2];
#pragma unroll
        for (int ai = 0; ai < 2; ++ai)
#pragma unroll
            for (int bj = 0; bj < 2; ++bj)
#pragma unroll
                for (int m = 0; m < 4; ++m)
#pragma unroll
                    for (int n = 0; n < 2; ++n) { const f32x4 v = acc[ai][bj][m][n]; u32x2 w; w.x = cvt_pk_bf16(v[0], v[1]); w.y = cvt_pk_bf16(v[2], v[3]); zp[ai][bj][m][n] = w; }
        if (fr >= 14) {
#pragma unroll
            for (int ai = 0; ai < 2; ++ai)
#pragma unroll
                for (int bj = 0; bj < 2; ++bj)
#pragma unroll
                    for (int n = 0; n < 2; ++n) *(LAS u32x2*)(EX + (((wc * 4 + 2 * ai + wr) * 2 + (fr - 14)) * 32 + bj * 16 + fq * 4 + n * 2)) = zp[ai][bj][3][n]; }
        if (wr == 1 && k < 15 && fr >= 14) {
            unsigned long long* hz = HZ + ((size_t)(u.pm * 22 + u.pn) * 8 + wc * 2 + (fr - 14)) * 32;
#pragma unroll
            for (int bj = 0; bj < 2; ++bj)
#pragma unroll
                for (int n = 0; n < 2; ++n) { __hip_atomic_store(hz + bj * 16 + fq * 4 + n * 2, (1ull << 32) | zp[1][bj][3][n].x, RLX_AGENT); __hip_atomic_store(hz + bj * 16 + fq * 4 + n * 2 + 1, (1ull << 32) | zp[1][bj][3][n].y, RLX_AGENT); }
        }
        asm volatile("s_waitcnt lgkmcnt(0)" ::: "memory"); __builtin_amdgcn_s_barrier(); asm volatile("" ::: "memory");
        const int ch0 = u.pn * 128 + wc * 32 + 8 * fq;
        f32x4 wg[2][3], wv[2][3], bg[2], bv[2];
#pragma unroll
        for (int n = 0; n < 2; ++n) {
#pragma unroll
            for (int j = 0; j < 3; ++j) { wg[n][j] = *(const f32x4*)(cw + (size_t)j * 2 * FF + ch0 + 4 * n); wv[n][j] = *(const f32x4*)(cw + (size_t)j * 2 * FF + FF + ch0 + 4 * n); }
            bg[n] = *(const f32x4*)(cb + ch0 + 4 * n); bv[n] = *(const f32x4*)(cb + FF + ch0 + 4 * n); }
#pragma unroll
        for (int gi = 1; gi <= 8; ++gi) {
            const int ai = (gi & 7) >> 2, m = gi & 3, blk = 2 * ai + wr;
            u32x2 pp[2][2];
#pragma unroll
            for (int bj = 0; bj < 2; ++bj)
#pragma unroll
                for (int n = 0; n < 2; ++n) { pp[bj][n].x = 0u; pp[bj][n].y = 0u; }
            if (m > 0) {
#pragma unroll
                for (int bj = 0; bj < 2; ++bj)
#pragma unroll
                    for (int n = 0; n < 2; ++n) pp[bj][n] = zp[ai][bj][m - 1][n];
            } else if (blk > 0) {
                if (fr >= 14) {
#pragma unroll
                    for (int bj = 0; bj < 2; ++bj)
#pragma unroll
                        for (int n = 0; n < 2; ++n) pp[bj][n] = *(LAS const u32x2*)(EX + (((wc * 4 + blk - 1) * 2 + (fr - 14)) * 32 + bj * 16 + fq * 4 + n * 2)); }
            } else if (k > 0) {
                if (fr >= 14) {
                    const unsigned long long* hz = HZ + ((size_t)((u.pm - 1) * 22 + u.pn) * 8 + wc * 2 + (fr - 14)) * 32;
#pragma unroll
                    for (int bj = 0; bj < 2; ++bj)
#pragma unroll
                        for (int n = 0; n < 2; ++n) { unsigned long long x0, x1; unsigned sp_ = 0;
                            for (;;) { x0 = __hip_atomic_load(hz + bj * 16 + fq * 4 + n * 2, RLX_AGENT); x1 = __hip_atomic_load(hz + bj * 16 + fq * 4 + n * 2 + 1, RLX_AGENT);
                                if ((x0 >> 32) == 1ull && (x1 >> 32) == 1ull) break; __builtin_amdgcn_s_sleep(2); if (++sp_ > (1u << 20)) { __hip_atomic_store(tmo, 1u, RLX_AGENT); break; } }
                            pp[bj][n].x = (unsigned)x0; pp[bj][n].y = (unsigned)x1; } }
            }
            u32x2 outp[2];
#pragma unroll
            for (int n = 0; n < 2; ++n) {
                const u32x2 zg = zp[ai][0][m][n], zv = zp[ai][1][m][n], pg = pp[0][n], pv = pp[1][n];
                u32x2 g1, g2, v1, v2;
                g1.x = dppk<0x111>(dppu<0x10F>(pg.x), zg.x); g1.y = dppk<0x111>(dppu<0x10F>(pg.y), zg.y); g2.x = dppk<0x112>(dppu<0x10E>(pg.x), zg.x); g2.y = dppk<0x112>(dppu<0x10E>(pg.y), zg.y);
                v1.x = dppk<0x111>(dppu<0x10F>(pv.x), zv.x); v1.y = dppk<0x111>(dppu<0x10F>(pv.y), zv.y); v2.x = dppk<0x112>(dppu<0x10E>(pv.x), zv.x); v2.y = dppk<0x112>(dppu<0x10E>(pv.y), zv.y);
                f32x2 o2[2];
#pragma unroll
                for (int e = 0; e < 2; ++e) {
                    const unsigned w0g = e ? zg.y : zg.x, w1g = e ? g1.y : g1.x, w2g = e ? g2.y : g2.x, w0v = e ? zv.y : zv.x, w1v = e ? v1.y : v1.x, w2v = e ? v2.y : v2.x;
                    const f32x2 z0g = {bf_lo(w0g), bf_hi(w0g)}, z1g = {bf_lo(w1g), bf_hi(w1g)}, z2g = {bf_lo(w2g), bf_hi(w2g)}, z0v = {bf_lo(w0v), bf_hi(w0v)}, z1v = {bf_lo(w1v), bf_hi(w1v)}, z2v = {bf_lo(w2v), bf_hi(w2v)};
                    const f32x2 kg0 = {wg[n][0][2 * e], wg[n][0][2 * e + 1]}, kg1 = {wg[n][1][2 * e], wg[n][1][2 * e + 1]}, kg2 = {wg[n][2][2 * e], wg[n][2][2 * e + 1]}, kb = {bg[n][2 * e], bg[n][2 * e + 1]};
                    const f32x2 kv0 = {wv[n][0][2 * e], wv[n][0][2 * e + 1]}, kv1 = {wv[n][1][2 * e], wv[n][1][2 * e + 1]}, kv2 = {wv[n][2][2 * e], wv[n][2][2 * e + 1]}, kc = {bv[n][2 * e], bv[n][2 * e + 1]};
                    const f32x2 cg = kb + kg0 * z2g + kg1 * z1g + kg2 * z0g, cv = kc + kv0 * z2v + kv1 * z1v + kv2 * z0v;
                    const f32x2 t = cg * cg, q = t * (f32x2){-0.1029432f, -0.1029432f} + (f32x2){-2.3022082f, -2.3022082f}, pw = cg * q;
                    const f32x2 ex = {__builtin_amdgcn_exp2f(pw.x), __builtin_amdgcn_exp2f(pw.y)}, dn = ex + (f32x2){1.f, 1.f};
                    const f32x2 rc = {__builtin_amdgcn_rcpf(dn.x), __builtin_amdgcn_rcpf(dn.y)};
                    o2[e] = (cg * cv) * rc; }
                const float o[4] = {o2[0].x, o2[0].y, o2[1].x, o2[1].y};
                outp[n].x = cvt_pk_bf16(o[0], o[1]); outp[n].y = cvt_pk_bf16(o[2], o[3]);
            }
            const int r = 128 * ai + 64 * wr + 16 * m + fr;
            { u32x4 w4; w4.x = outp[0].x; w4.y = outp[0].y; w4.z = outp[1].x; w4.w = outp[1].y; *(u32x4*)(ACT + ((size_t)(b * SEQ + t0 + r)) * FF + ch0) = w4; }
            __builtin_amdgcn_sched_barrier(0);
        }
    }
};
struct EpiRowStat {
    static constexpr bool PERM = true, HAS_MID = false; bf16_t* O; float* STAT; int mid_t;
    __device__ __forceinline__ void mid(f32x4 (&)[2][2][4][2], const pg8::Unit&, int, int, int, int) const {}
    __device__ __forceinline__ void operator()(const f32x4 (&acc)[2][2][4][2], const pg8::Unit& u, int wr, int wc, int fr, int fq) const {
#pragma unroll
        for (int ai = 0; ai < 2; ++ai)
#pragma unroll
            for (int m = 0; m < 4; ++m) { const int row = u.pm * 256 + ai * 128 + wr * 64 + m * 16 + fr; float s = 0.f;
#pragma unroll
                for (int bj = 0; bj < 2; ++bj) { const int col = u.pn * 256 + bj * 128 + wc * 32 + 8 * fq; const f32x4 v0 = acc[ai][bj][m][0], v1 = acc[ai][bj][m][1]; u32x4 w;
                    s += (v0[0] * v0[0] + v0[1] * v0[1]) + (v0[2] * v0[2] + v0[3] * v0[3]) + (v1[0] * v1[0] + v1[1] * v1[1]) + (v1[2] * v1[2] + v1[3] * v1[3]);
                    w.x = cvt_pk_bf16(v0[0], v0[1]); w.y = cvt_pk_bf16(v0[2], v0[3]); w.z = cvt_pk_bf16(v1[0], v1[1]); w.w = cvt_pk_bf16(v1[2], v1[3]);
                    __builtin_nontemporal_store(w, (u32x4*)(O + (size_t)row * D + col)); }
                s += __shfl_xor(s, 16); s += __shfl_xor(s, 32);
                if (fq == 0) STAT[(size_t)row * 16 + u.pn * 4 + wc] = s; }
    }
};
struct EpiSloc {
    static constexpr bool PERM = false, HAS_MID = false; float* SL; int mid_t;
    __device__ __forceinline__ void mid(f32x4 (&)[2][2][4][2], const pg8::Unit&, int, int, int, int) const {}
    __device__ __forceinline__ void operator()(const f32x4 (&acc)[2][2][4][2], const pg8::Unit& u, int wr, int wc, int fr, int fq) const {
#pragma unroll
        for (int ai = 0; ai < 2; ++ai)
#pragma unroll
            for (int m = 0; m < 4; ++m) { const int row = u.pm * 256 + ai * 128 + wr * 64 + m * 16 + fr; float* p = SL + ((size_t)u.pn * S5ROWS + row) * 128 + wc * 32 + 4 * fq;
                *(f32x4*)(p) = acc[ai][0][m][0]; *(f32x4*)(p + 16) = acc[ai][0][m][1]; }
    }
};
struct S5Order {
    const bf16_t* UG; const bf16_t* Bt; int ldb, G, c;
    __device__ bool next(int i, pg8::Unit& u) const { const int L = i * G + c; if (L >= S5G * 8) return false; const int g = L >> 3; u.pm = L & 7; u.pn = g;
        u.a = (const char*)(UG + ((size_t)g * S5ROWS + u.pm * 256) * UGLD); u.b = (const char*)(Bt + (size_t)g * 256 * ldb); return true; }
};

constexpr int LW = 72;
constexpr int SLOT = 64 * LW * 2;
#define SL(i) ((i) * SLOT)
#define BAR_LDS() do { asm volatile("s_waitcnt lgkmcnt(0)" ::: "memory"); __builtin_amdgcn_s_barrier(); asm volatile("" ::: "memory"); } while (0)
struct LdsMat { LAS const unsigned char* p; int ld; __device__ __forceinline__ bf16x8 frag(int row, int k) const { return *(LAS const bf16x8*)(p + ((size_t)row * ld + k) * 2); } };
struct GlbMat { const bf16_t* p; int ld; __device__ __forceinline__ bf16x8 frag(int row, int k) const { return *(const bf16x8*)(p + (size_t)row * ld + k); } };
template <int KD, class YM, class XM, class EPI>
__device__ __forceinline__ void mm64(const YM& Y, const XM& X, int wid, int lane, const EPI& epi) {
    asm volatile("" : "+v"(lane), "+s"(wid));
    const int at = wid >> 1, bt0 = (wid & 1) * 2, fr = lane & 15, fq = lane >> 4;
    f32x4 acc[2] = {(f32x4){0.f, 0.f, 0.f, 0.f}, (f32x4){0.f, 0.f, 0.f, 0.f}};
#pragma unroll
    for (int s = 0; s < KD / 32; ++s) {
        const bf16x8 yf = Y.frag(16 * at + fr, 32 * s + 8 * fq);
#pragma unroll
        for (int bi = 0; bi < 2; ++bi) { const bf16x8 xf = X.frag(16 * (bt0 + bi) + fr, 32 * s + 8 * fq);
            acc[bi] = __builtin_amdgcn_mfma_f32_16x16x32_bf16(xf, yf, acc[bi], 0, 0, 0); }
    }
#pragma unroll
    for (int bi = 0; bi < 2; ++bi) epi(16 * at + fr, 16 * (bt0 + bi) + 4 * fq, acc[bi]);
}
__device__ __forceinline__ void ld_yf(const LdsMat& Y, int at, int fr, int fq, bf16x8 (&y)[2]) {
#pragma unroll
    for (int s = 0; s < 2; ++s) y[s] = Y.frag(16 * at + fr, 32 * s + 8 * fq);
}
__device__ __forceinline__ void ld_xf(const LdsMat& X, int bt0, int fr, int fq, bf16x8 (&x)[2][2]) {
#pragma unroll
    for (int s = 0; s < 2; ++s)
#pragma unroll
        for (int bi = 0; bi < 2; ++bi) x[s][bi] = X.frag(16 * (bt0 + bi) + fr, 32 * s + 8 * fq);
}
__device__ __forceinline__ void mm_f(const bf16x8 (&y)[2], const bf16x8 (&x)[2][2], f32x4 (&acc)[2]) {
#pragma unroll
    for (int bi = 0; bi < 2; ++bi) acc[bi] = (f32x4){0.f, 0.f, 0.f, 0.f};
#pragma unroll
    for (int s = 0; s < 2; ++s)
#pragma unroll
        for (int bi = 0; bi < 2; ++bi) acc[bi] = __builtin_amdgcn_mfma_f32_16x16x32_bf16(x[s][bi], y[s], acc[bi], 0, 0, 0);
}
template <int KD>
__device__ __forceinline__ void preload_x(const GlbMat& X, int wid, int lane, bf16x8 (&xf)[KD / 32][2]) {
    const int bt0 = (wid & 1) * 2, fr = lane & 15, fq = lane >> 4;
#pragma unroll
    for (int s = 0; s < KD / 32; ++s)
#pragma unroll
        for (int bi = 0; bi < 2; ++bi) xf[s][bi] = X.frag(16 * (bt0 + bi) + fr, 32 * s + 8 * fq);
}
template <int KD, class YM, class EPI>
__device__ __forceinline__ void mm64_pre(const YM& Y, const bf16x8 (&xf)[KD / 32][2], int wid, int lane, const EPI& epi) {
    const int at = wid >> 1, bt0 = (wid & 1) * 2, fr = lane & 15, fq = lane >> 4;
    f32x4 acc[2] = {(f32x4){0.f, 0.f, 0.f, 0.f}, (f32x4){0.f, 0.f, 0.f, 0.f}};
#pragma unroll
    for (int s = 0; s < KD / 32; ++s) {
        const bf16x8 yf = Y.frag(16 * at + fr, 32 * s + 8 * fq);
#pragma unroll
        for (int bi = 0; bi < 2; ++bi) acc[bi] = __builtin_amdgcn_mfma_f32_16x16x32_bf16(xf[s][bi], yf, acc[bi], 0, 0, 0);
    }
#pragma unroll
    for (int bi = 0; bi < 2; ++bi) epi(16 * at + fr, 16 * (bt0 + bi) + 4 * fq, acc[bi]);
}
__device__ __forceinline__ void st_lds4(LAS unsigned char* base, int a, int b0, f32x4 v) { u32x2 w; w.x = cvt_pk_bf16(v[0], v[1]); w.y = cvt_pk_bf16(v[2], v[3]); *(LAS u32x2*)(base + ((size_t)a * LW + b0) * 2) = w; }
__device__ __forceinline__ f32x4 ld_lds4(LAS const unsigned char* base, int a, int b0) { const u32x2 w = *(LAS const u32x2*)(base + ((size_t)a * LW + b0) * 2); return (f32x4){bf_lo(w.x), bf_hi(w.x), bf_lo(w.y), bf_hi(w.y)}; }
__device__ __forceinline__ void st_glb4p(bf16_t* base, int a, int b0, f32x4 v) { u32x2 w; w.x = cvt_pk_bf16(v[0], v[1]); w.y = cvt_pk_bf16(v[2], v[3]); __builtin_nontemporal_store(w, (u32x2*)(base + (size_t)a * GLD + b0)); }
__device__ __forceinline__ void st_glb4(bf16_t* base, int a, int b0, f32x4 v) { u32x2 w; w.x = cvt_pk_bf16(v[0], v[1]); w.y = cvt_pk_bf16(v[2], v[3]); __builtin_nontemporal_store(w, (u32x2*)(base + (size_t)a * 64 + b0)); }

struct PrePf { u32x4 qa[3], qp[3], ra[4], rp[4], wt[4]; };
template <int PART>
__device__ __forceinline__ void rwkv_pre_fetch(Frame& F, int unit, bool lr_first, PrePf& P, int tid) {
    const int bh = unit >> 6, c = unit & 63, b = bh >> 3, h = bh & 7;
    const int t = tid >> 3, jb = tid & 7, j0 = jb * 8;
    const int tg = b * SEQ + c * 64 + t;
    const bool hasprev = (c * 64 + t) > 0;
    const bf16_t* prow = (const bf16_t*)(F.ws + WS_PR) + (size_t)tg * NRW; const bf16_t* pprv = hasprev ? prow - NRW : prow;
    if constexpr (PART != 1) {
#pragma unroll
        for (int seg = 0; seg < 3; ++seg) { const int col = seg * 512 + h * 64 + j0; P.qa[seg] = *(const u32x4*)(prow + col); P.qp[seg] = *(const u32x4*)(pprv + col); }
    }
    if constexpr (PART == 0) return;
    const u32x4* scr = (const u32x4*)(F.ws + WS_LRSCR) + ((size_t)F.vcu * 512 + tid) * 4;
    const u32x4* pa = lr_first ? (const u32x4*)(prow + 1536 + jb * 32) : scr; const u32x4* pp = lr_first ? (const u32x4*)(pprv + 1536 + jb * 32) : scr;
#pragma unroll
    for (int q4 = 0; q4 < 4; ++q4) { P.ra[q4] = pa[q4]; P.rp[q4] = pp[q4]; }
    P.wt[0] = ((const u32x4*)(F.ws + WS_W2T) + (size_t)h * 512)[tid]; P.wt[1] = ((const u32x4*)(F.ws + WS_A2T) + (size_t)h * 512)[tid];
    P.wt[2] = ((const u32x4*)(F.ws + WS_G2T) + (size_t)h * 1024)[tid]; P.wt[3] = ((const u32x4*)(F.ws + WS_G2T) + (size_t)h * 1024)[512 + tid];
}
__device__ __forceinline__ void rwkv_pre_put_w(LAS unsigned char* L, const PrePf& P, int tid) {
    const int r8 = tid >> 3, c8 = tid & 7, r16 = tid >> 4, c16 = tid & 15;
    *(LAS u32x4*)(L + SL(10) + ((size_t)r8 * LW + c8 * 8) * 2) = P.wt[0]; *(LAS u32x4*)(L + SL(11) + ((size_t)r8 * LW + c8 * 8) * 2) = P.wt[1];
    *(LAS u32x4*)(L + SL(12) + ((size_t)r16 * 136 + c16 * 8) * 2) = P.wt[2]; *(LAS u32x4*)(L + SL(12) + ((size_t)(32 + r16) * 136 + c16 * 8) * 2) = P.wt[3];
}
__device__ __forceinline__ void rwkv_pre_unit(Frame& F, int unit, int next_unit, bool lr_first, bool next_first, PrePf& P) {
    LAS unsigned char* L = F.lds;
    LAS float* XT = (LAS float*)(F.lds + XTRA_OFF);
    int tid = F.tid; asm volatile("" : "+v"(tid));
    int wid = F.wave; asm volatile("" : "+s"(wid));
    const int lane = tid & 63;
    const int bh = unit >> 6, c = unit & 63, b = bh >> 3, h = bh & 7;
    const int t = tid >> 3, jb = tid & 7, j0 = jb * 8;
    const int tg = b * SEQ + c * 64 + t;
    const bool hasprev = (c * 64 + t) > 0;
    const bf16_t* PR = (const bf16_t*)(F.ws + WS_PR);
    const bf16_t* prow = PR + (size_t)tg * NRW; const bf16_t* pprev = prow - NRW;
    LAS const float* mu = (LAS const float*)(F.lds + XTRA_OFF + 4096);
    LAS const float* par = mu + NRW;
    float rs[8], ks[8], vs[8];
    {
        const int c0 = 1536 + jb * 32;
        const float pmask = hasprev ? 1.f : 0.f;
        f32x4 mq[3][2];
#pragma unroll
        for (int seg = 0; seg < 3; ++seg) { const int col = seg * 512 + h * 64 + j0; mq[seg][0] = *(LAS const f32x4*)(mu + col); mq[seg][1] = *(LAS const f32x4*)(mu + col + 4); }
        LAS unsigned char* dst = (jb < 2) ? (L + SL(0) + ((size_t)t * LW + jb * 32) * 2) : (jb < 4) ? (L + SL(1) + ((size_t)t * LW + (jb - 2) * 32) * 2) : (L + SL(2) + ((size_t)t * 136 + (jb - 4) * 32) * 2);
        u32x4* scr = (u32x4*)(F.ws + WS_LRSCR) + ((size_t)F.vcu * 512 + tid) * 4;
        if (lr_first) {
            f32x4 ma[4][2];
#pragma unroll
            for (int q4 = 0; q4 < 4; ++q4) { ma[q4][0] = *(LAS const f32x4*)(mu + c0 + q4 * 8); ma[q4][1] = *(LAS const f32x4*)(mu + c0 + q4 * 8 + 4); }
#pragma unroll
            for (int q4 = 0; q4 < 4; ++q4) { float x[8], xp[8], o[8]; unpack8(P.ra[q4], x); unpack8(P.rp[q4], xp);
#pragma unroll
                for (int e = 0; e < 8; ++e) { const float mm = e < 4 ? ma[q4][0][e] : ma[q4][1][e - 4]; const float s = x[e] + (xp[e] * pmask - x[e]) * mm;
                    const float ex = __builtin_amdgcn_exp2f((jb < 2 ? 2.88539008178f : -1.44269504089f) * s), rc = __builtin_amdgcn_rcpf(1.0f + ex);
                    o[e] = jb < 2 ? 1.0f - 2.0f * rc : (jb < 4 ? s : rc); }
                const u32x4 w = pack8(o); *(LAS u32x4*)(dst + q4 * 16) = w; scr[q4] = w; }
        } else {
#pragma unroll
            for (int q4 = 0; q4 < 4; ++q4) *(LAS u32x4*)(dst + q4 * 16) = P.ra[q4];
        }
#pragma unroll
        for (int seg = 0; seg < 3; ++seg) { float x[8], xp[8]; unpack8(P.qa[seg], x); unpack8(P.qp[seg], xp);
#pragma unroll
            for (int e = 0; e < 8; ++e) { const float mm = e < 4 ? mq[seg][0][e] : mq[seg][1][e - 4]; const float s = x[e] + (xp[e] * pmask - x[e]) * mm; if (seg == 0) rs[e] = s; else if (seg == 1) ks[e] = s; else vs[e] = s; } }
    }
    BAR_LDS();
    if (next_unit < NUNIT) rwkv_pre_fetch<0>(F, next_unit, next_first, P, tid);
    {
        const LdsMat Yw{L + SL(0), LW}, Ya{L + SL(1), LW}, Yg{L + SL(2), 136};
        const LdsMat Xw{L + SL(10), LW}, Xa{L + SL(11), LW}, Xg{L + SL(12), 136};
        mm64<64>(Yw, Xw, wid, lane, [&](int a, int b0, f32x4 v) { *(LAS f32x4*)(L + SL(4) + ((size_t)a * 68 + b0) * 4) = v; });
        mm64<64>(Ya, Xa, wid, lane, [&](int a, int b0, f32x4 v) { *(LAS f32x4*)(L + SL(6) + ((size_t)a * 68 + b0) * 4) = v; });
        mm64<128>(Yg, Xg, wid, lane, [&](int a, int b0, f32x4 v) { *(LAS f32x4*)(L + SL(8) + ((size_t)a * 68 + b0) * 4) = v; });
    }
    BAR_LDS();
    float ld[8], kp[8], av[8], bv[8];
    {
        const int hc = h * 64 + j0;
        float wp[8], ap[8], gg[8], w0[8], a0[8], kkw[8], kaw[8], rk[8];
        *(f32x4*)&wp[0] = *(LAS f32x4*)(L + SL(4) + ((size_t)t * 68 + j0) * 4); *(f32x4*)&wp[4] = *(LAS f32x4*)(L + SL(4) + ((size_t)t * 68 + j0 + 4) * 4);
        *(f32x4*)&ap[0] = *(LAS f32x4*)(L + SL(6) + ((size_t)t * 68 + j0) * 4); *(f32x4*)&ap[4] = *(LAS f32x4*)(L + SL(6) + ((size_t)t * 68 + j0 + 4) * 4);
        *(f32x4*)&gg[0] = *(LAS f32x4*)(L + SL(8) + ((size_t)t * 68 + j0) * 4); *(f32x4*)&gg[4] = *(LAS f32x4*)(L + SL(8) + ((size_t)t * 68 + j0 + 4) * 4);
        *(f32x4*)&w0[0] = *(LAS const f32x4*)(par + 0 + hc); *(f32x4*)&w0[4] = *(LAS const f32x4*)(par + 0 + hc + 4);
        *(f32x4*)&a0[0] = *(LAS const f32x4*)(par + 512 + hc); *(f32x4*)&a0[4] = *(LAS const f32x4*)(par + 512 + hc + 4);
        *(f32x4*)&kkw[0] = *(LAS const f32x4*)(par + 1024 + hc); *(f32x4*)&kkw[4] = *(LAS const f32x4*)(par + 1024 + hc + 4);
        *(f32x4*)&kaw[0] = *(LAS const f32x4*)(par + 1536 + hc); *(f32x4*)&kaw[4] = *(LAS const f32x4*)(par + 1536 + hc + 4);
        *(f32x4*)&rk[0] = *(LAS const f32x4*)(par + 2048 + hc); *(f32x4*)&rk[4] = *(LAS const f32x4*)(par + 2048 + hc + 4);
        float ss = 0.f, bon = 0.f, kkv[8], eta[8];
#pragma unroll
        for (int e = 0; e < 8; ++e) {
            ld[e] = -0.60653065971f * fsigmoid(w0[e] + wp[e]);
            eta[e] = fsigmoid(a0[e] + ap[e]);
            kkv[e] = ks[e] * kkw[e]; ss += kkv[e] * kkv[e];
            kp[e] = ks[e] * (1.0f + (eta[e] - 1.0f) * kaw[e]);
            bon += rs[e] * kp[e] * rk[e];
        }
        ss += __shfl_xor(ss, 1); ss += __shfl_xor(ss, 2); ss += __shfl_xor(ss, 4);
        bon += __shfl_xor(bon, 1); bon += __shfl_xor(bon, 2); bon += __shfl_xor(bon, 4);
        const float inv = __builtin_amdgcn_rcpf(fmaxf(__builtin_amdgcn_sqrtf(ss), 1e-12f));
#pragma unroll
        for (int e = 0; e < 8; ++e) { const float kk = kkv[e] * inv; av[e] = -kk; bv[e] = kk * eta[e]; }
        if (jb == 0) ((float*)(F.ws + WS_BONUS))[(size_t)tg * 8 + h] = bon;
        *(u32x4*)((bf16_t*)(F.ws + WS_GBUF) + (size_t)tg * RW + hc) = pack8(gg);
    }
    float Lc[8];
#pragma unroll
    for (int e = 0; e < 8; ++e) { float x = ld[e];
        float y = __shfl_up(x, 8); if (lane >= 8) x += y;
        y = __shfl_up(x, 16); if (lane >= 16) x += y;
        y = __shfl_up(x, 32); if (lane >= 32) x += y;
        Lc[e] = x; }
    if (lane >= 56) {
#pragma unroll
        for (int e = 0; e < 8; ++e) XT[wid * 64 + j0 + e] = Lc[e]; }
    BAR_LDS();
    {
        float pre[8];
#pragma unroll
        for (int e = 0; e < 8; ++e) pre[e] = 0.f;
#pragma unroll
        for (int w = 0; w < 7; ++w) if (w < wid) { const f32x4 x0 = *(LAS const f32x4*)(XT + w * 64 + j0), x1 = *(LAS const f32x4*)(XT + w * 64 + j0 + 4);
#pragma unroll
            for (int e = 0; e < 4; ++e) { pre[e] += x0[e]; pre[4 + e] += x1[e]; } }
#pragma unroll
        for (int e = 0; e < 8; ++e) Lc[e] += pre[e];
    }
    if (t == 63) {
#pragma unroll
        for (int e = 0; e < 8; ++e) XT[512 + j0 + e] = fexp(Lc[e]); }
    {
        float o0[8], o1[8], o2[8], o3[8];
#pragma unroll
        for (int e = 0; e < 8; ++e) { const float ein = fexp(Lc[e]), eout = __builtin_amdgcn_rcpf(ein), eex = fexp(Lc[e] - ld[e]);
            o0[e] = rs[e] * ein; o1[e] = kp[e] * eout; o2[e] = av[e] * eex; o3[e] = bv[e] * eout; }
        const size_t off = ((size_t)t * LW + j0) * 2;
        *(LAS u32x4*)(L + SL(10) + off) = pack8(o0); *(LAS u32x4*)(L + SL(11) + off) = pack8(o1); *(LAS u32x4*)(L + SL(12) + off) = pack8(o2); *(LAS u32x4*)(L + SL(13) + off) = pack8(o3);
        *(LAS u32x4*)(L + SL(2) + off) = pack8(vs);
    }
    BAR_LDS();
    {
        const int srcs[4] = {12, 13, 11, 2}, dsts[4] = {4, 5, 6, 7};
#pragma unroll
        for (int q = 0; q < 4; ++q) { unsigned short hv[8];
#pragma unroll
            for (int e = 0; e < 8; ++e) hv[e] = *(LAS const unsigned short*)(L + SL(srcs[q]) + ((size_t)(8 * wid + e) * LW + lane) * 2);
            u32x4 w; w.x = hv[0] | ((unsigned)hv[1] << 16); w.y = hv[2] | ((unsigned)hv[3] << 16); w.z = hv[4] | ((unsigned)hv[5] << 16); w.w = hv[6] | ((unsigned)hv[7] << 16);
            *(LAS u32x4*)(L + SL(dsts[q]) + ((size_t)lane * LW + 8 * wid) * 2) = w;
        }
    }
    BAR_LDS();
    if (next_unit < NUNIT) rwkv_pre_fetch<1>(F, next_unit, next_first, P, tid);
    const int crow = tid >> 3, cch = tid & 7;
    __builtin_nontemporal_store(*(LAS const u32x4*)(L + SL(7) + ((size_t)crow * LW + cch * 8) * 2), (u32x4*)((bf16_t*)(F.ws + WS_VT) + (size_t)unit * 4096 + crow * 64 + cch * 8));
    {
        const LdsMat Rt{L + SL(10), LW}, Kt{L + SL(11), LW}, At{L + SL(12), LW}, Bt{L + SL(13), LW};
        f32x4 nd = (f32x4){0.f, 0.f, 0.f, 0.f}, ntd = nd;
        {
            int ln = lane, wd = wid; asm volatile("" : "+v"(ln), "+s"(wd));
            const int at = wd >> 1, bt0 = (wd & 1) * 2, fr = ln & 15, fq = ln >> 4, a = 16 * at + fr;
            bf16x8 yA[2], yK[2], yR[2], xB[2][2], xA[2][2], xK[2][2];
            ld_yf(At, at, fr, fq, yA); ld_xf(Bt, bt0, fr, fq, xB); ld_yf(Kt, at, fr, fq, yK); ld_xf(At, bt0, fr, fq, xA); ld_yf(Rt, at, fr, fq, yR); ld_xf(Kt, bt0, fr, fq, xK);
            const bool diag = bt0 == (at & 2);
            bf16x8 xd[2];
            if (diag) ld_yf(Bt, at, fr, fq, xd);
            f32x4 c0[2], c1[2], c2[2], c3[2];
            mm_f(yA, xB, c0); mm_f(yK, xA, c1); mm_f(yR, xB, c2); mm_f(yR, xK, c3);
            if (diag) {
                f32x4 v = (f32x4){0.f, 0.f, 0.f, 0.f};
#pragma unroll
                for (int s = 0; s < 2; ++s) v = __builtin_amdgcn_mfma_f32_16x16x32_bf16(yA[s], xd[s], v, 0, 0, 0);
#pragma unroll
                for (int e = 0; e < 4; ++e) v[e] = (fr < 4 * fq + e) ? v[e] : 0.f;
                nd = v; }
#pragma unroll
            for (int bi = 0; bi < 2; ++bi) { const int b0 = 16 * (bt0 + bi) + 4 * fq; f32x4 v0 = c0[bi], v1 = c1[bi], v2 = c2[bi], v3 = c3[bi];
#pragma unroll
                for (int e = 0; e < 4; ++e) { v0[e] = (b0 + e < a) ? v0[e] : 0.f; v1[e] = (a < b0 + e) ? v1[e] : 0.f; v2[e] = (b0 + e <= a) ? v2[e] : 0.f; v3[e] = (b0 + e <= a) ? v3[e] : 0.f; }
                st_lds4(L + SL(1), a, b0, v0); st_lds4(L + SL(2), a, b0, v1); st_lds4(L + SL(3), a, b0, v2); st_lds4(L + SL(8), a, b0, v3);
                if (bt0 + bi == at) ntd = v0; }
        }
        const int at = wid >> 1;
        if (((wid & 1) * 2 == (at & 2))) {
            const int fr = lane & 15, fq = lane >> 4;
            auto op = [](f32x4 v) { u32x4 w; w.x = cvt_pk_bf16(v[0], v[1]); w.y = cvt_pk_bf16(v[2], v[3]); w.z = 0u; w.w = 0u; return __builtin_bit_cast(bf16x8, w); };
            const f32x4 zero = (f32x4){0.f, 0.f, 0.f, 0.f};
            const f32x4 Lm = ntd, LT = nd;
            f32x4 Q = Lm;
#pragma unroll
            for (int e = 0; e < 4; ++e) Q[e] += (4 * fq + e == fr) ? 1.f : 0.f;
            const f32x4 L2 = __builtin_amdgcn_mfma_f32_16x16x32_bf16(op(LT), op(Lm), zero, 0, 0, 0), L2T = __builtin_amdgcn_mfma_f32_16x16x32_bf16(op(Lm), op(LT), zero, 0, 0, 0);
            Q = __builtin_amdgcn_mfma_f32_16x16x32_bf16(op(L2T), op(Q), Q, 0, 0, 0);
            const f32x4 L4 = __builtin_amdgcn_mfma_f32_16x16x32_bf16(op(L2T), op(L2), zero, 0, 0, 0), L4T = __builtin_amdgcn_mfma_f32_16x16x32_bf16(op(L2), op(L2T), zero, 0, 0, 0);
            Q = __builtin_amdgcn_mfma_f32_16x16x32_bf16(op(L4T), op(Q), Q, 0, 0, 0);
            const f32x4 L8T = __builtin_amdgcn_mfma_f32_16x16x32_bf16(op(L4), op(L4T), zero, 0, 0, 0);
            Q = __builtin_amdgcn_mfma_f32_16x16x32_bf16(op(L8T), op(Q), Q, 0, 0, 0);
            st_lds4(L + SL(9), 16 * at + fr, 4 * fq, Q);
        }
    }
    BAR_LDS();
    {
        const int fr = lane & 15, fq = lane >> 4;
        LAS const unsigned char* zsl = L + (wid < 4 ? SL(4) : SL(2)); LAS unsigned char* dsl = L + (wid < 4 ? SL(11) : SL(12));
        const int arow = 16 * (wid & 3) + fr;
        u32x2 zp[4];
#pragma unroll
        for (int c = 0; c < 4; ++c) {
            f32x4 acc = ld_lds4(zsl, arow, 16 * c + 4 * fq);
            if (c >= 1) {
                const u32x2 alo = *(LAS const u32x2*)(L + SL(1) + ((size_t)(16 * c + fr) * LW + 4 * fq) * 2), ahi = *(LAS const u32x2*)(L + SL(1) + ((size_t)(16 * c + fr) * LW + 16 + 4 * fq) * 2);
                u32x4 aw; aw.x = alo.x; aw.y = alo.y; aw.z = ahi.x; aw.w = ahi.y;
                u32x4 bw; bw.x = zp[0].x; bw.y = zp[0].y; bw.z = c >= 2 ? zp[1].x : 0u; bw.w = c >= 2 ? zp[1].y : 0u;
                acc = __builtin_amdgcn_mfma_f32_16x16x32_bf16(__builtin_bit_cast(bf16x8, aw), __builtin_bit_cast(bf16x8, bw), acc, 0, 0, 0); }
            if (c == 3) {
                const u32x2 alo = *(LAS const u32x2*)(L + SL(1) + ((size_t)(48 + fr) * LW + 32 + 4 * fq) * 2);
                u32x4 aw; aw.x = alo.x; aw.y = alo.y; aw.z = 0u; aw.w = 0u;
                u32x4 bw; bw.x = zp[2].x; bw.y = zp[2].y; bw.z = 0u; bw.w = 0u;
                acc = __builtin_amdgcn_mfma_f32_16x16x32_bf16(__builtin_bit_cast(bf16x8, aw), __builtin_bit_cast(bf16x8, bw), acc, 0, 0, 0); }
            const u32x2 dlo = *(LAS const u32x2*)(L + SL(9) + ((size_t)(16 * c + fr) * LW + 4 * fq) * 2);
            u32x4 aw; aw.x = dlo.x; aw.y = dlo.y; aw.z = 0u; aw.w = 0u;
            u32x4 bw; bw.x = cvt_pk_bf16(acc[0], acc[1]); bw.y = cvt_pk_bf16(acc[2], acc[3]); bw.z = 0u; bw.w = 0u;
            const f32x4 r = __builtin_amdgcn_mfma_f32_16x16x32_bf16(__builtin_bit_cast(bf16x8, aw), __builtin_bit_cast(bf16x8, bw), (f32x4){0.f, 0.f, 0.f, 0.f}, 0, 0, 0);
            zp[c].x = cvt_pk_bf16(r[0], r[1]); zp[c].y = cvt_pk_bf16(r[2], r[3]);
            *(LAS u32x2*)(dsl + ((size_t)arow * LW + 16 * c + 4 * fq) * 2) = zp[c];
        }
    }
    BAR_LDS();
    {
        const int sAT = 11, sAkT = 12, sHk = 0;
        const LdsMat AT{L + SL(sAT), LW}, AkT{L + SL(sAkT), LW}, AbrT{L + SL(3), LW}, BgT{L + SL(5), LW}, VTm{L + SL(7), LW};
        bf16_t* QRT = (bf16_t*)(F.ws + WS_QRT) + (size_t)unit * 4096; bf16_t* WYT = (bf16_t*)(F.ws + WS_WYT) + (size_t)unit * 4096;
        bf16_t* GTg = (bf16_t*)(F.dout + DO_GT) + (size_t)unit * (64 * GLD); bf16_t* Hg = (bf16_t*)(F.dout + DO_H) + (size_t)unit * (64 * GLD);
        {
            int ln = lane, wd = wid; asm volatile("" : "+v"(ln), "+s"(wd));
            const int at = wd >> 1, bt0 = (wd & 1) * 2, fr = ln & 15, fq = ln >> 4, a = 16 * at + fr;
            bf16x8 yA[2], yB[2], xT[2][2], xK[2][2];
            ld_yf(BgT, at, fr, fq, yB); ld_xf(AkT, bt0, fr, fq, xK); ld_yf(AbrT, at, fr, fq, yA); ld_xf(AT, bt0, fr, fq, xT);
            f32x4 eH[2], eR[2], eW[2];
#pragma unroll
            for (int bi = 0; bi < 2; ++bi) { const int b0 = 16 * (bt0 + bi) + 4 * fq; eH[bi] = ld_lds4(L + SL(6), a, b0); eR[bi] = ld_lds4(L + SL(10), a, b0); eW[bi] = ld_lds4(L + SL(8), a, b0); }
            const float gdiag = XT[512 + a];
            f32x4 cH[2], cQ[2], cW[2], cG[2];
            mm_f(yB, xK, cH); mm_f(yA, xT, cQ); mm_f(yA, xK, cW); mm_f(yB, xT, cG);
#pragma unroll
            for (int bi = 0; bi < 2; ++bi) { const int b0 = 16 * (bt0 + bi) + 4 * fq;
                st_lds4(L + SL(sHk), a, b0, (cH[bi] + eH[bi]) * gdiag);
                st_lds4(L + SL(1), a, b0, cQ[bi] + eR[bi]);
                st_lds4(L + SL(2), a, b0, cW[bi] + eW[bi]);
                f32x4 v = cG[bi];
#pragma unroll
                for (int e = 0; e < 4; ++e) v[e] += (b0 + e == a) ? 1.f : 0.f;
                st_lds4(L + SL(4), a, b0, v * gdiag); }
        }
        BAR_LDS();
        const LdsMat HkT{L + SL(sHk), LW};
        mm64<64>(VTm, HkT, wid, lane, [&](int a, int b0, f32x4 v) { st_lds4(L + SL(9), a, b0, v); });
        __builtin_nontemporal_store(*(LAS const u32x4*)(L + SL(1) + ((size_t)crow * LW + cch * 8) * 2), (u32x4*)(QRT + crow * 64 + cch * 8));
        __builtin_nontemporal_store(*(LAS const u32x4*)(L + SL(2) + ((size_t)crow * LW + cch * 8) * 2), (u32x4*)(WYT + crow * 64 + cch * 8));
        __builtin_nontemporal_store(*(LAS const u32x4*)(L + SL(4) + (size_t)tid * 16), (u32x4*)GTg + tid);
        if (tid < 64) __builtin_nontemporal_store(*(LAS const u32x4*)(L + SL(4) + (size_t)(512 + tid) * 16), (u32x4*)GTg + 512 + tid);
        if (next_unit < NUNIT) rwkv_pre_put_w(L, P, tid);
        BAR_LDS();
        __builtin_nontemporal_store(*(LAS const u32x4*)(L + SL(9) + (size_t)tid * 16), (u32x4*)Hg + tid);
        if (tid < 64) __builtin_nontemporal_store(*(LAS const u32x4*)(L + SL(9) + (size_t)(512 + tid) * 16), (u32x4*)Hg + 512 + tid);
    }
}

constexpr int RS_SLOT = 12 * 1024;
constexpr int RS_DEPTH = 8, RS_AHEAD = 6;
__device__ __forceinline__ void rwkv_scan_block(Frame& F, int item) {
    const int bh = item >> 2, qi = item & 3, lane = F.lane, fr = lane & 15, fq = lane >> 4, wid = F.wave;
    const char* GTg = (const char*)(F.dout + DO_GT) + (size_t)bh * 64 * (64 * GLD * 2);
    const char* Hg = (const char*)(F.dout + DO_H) + (size_t)bh * 64 * (64 * GLD * 2) + (size_t)qi * (16 * GLD * 2);
    bf16_t* SST = (bf16_t*)(F.dout + DO_SST) + (size_t)bh * 64 * 4096;
    LAS unsigned char* L = F.lds;
    auto issue = [&](int c) {
        if (wid >= 1) {
            LAS unsigned char* slot = L + (c & (RS_DEPTH - 1)) * RS_SLOT;
#pragma unroll
            for (int k = 0; k < 2; ++k) { const int pc = (wid - 1) + 7 * k;
                if (pc < 12) {
                    const char* src;
                    if (pc < 9) src = GTg + (size_t)c * (64 * GLD * 2) + pc * 1024 + lane * 16;
                    else { int off = (pc - 9) * 1024 + lane * 16; off = off > 2304 - 16 ? 2304 - 16 : off; src = Hg + (size_t)c * (64 * GLD * 2) + off; }
                    __builtin_amdgcn_global_load_lds((const unsigned*)src, (LAS unsigned*)(slot + pc * 1024), 16, 0, 0); } }
        }
    };
    f32x4 acc[4];
#pragma unroll
    for (int mt = 0; mt < 4; ++mt) acc[mt] = (f32x4){0.f, 0.f, 0.f, 0.f};
#pragma unroll 1
    for (int c = 0; c < RS_AHEAD; ++c) issue(c);
#pragma unroll 1
    for (int c = 0; c < NCH; ++c) {
        if (c + RS_AHEAD < NCH) issue(c + RS_AHEAD);
        if (c + RS_AHEAD < NCH) { if (wid >= 1 && wid <= 5) asm volatile("s_waitcnt vmcnt(12)" ::: "memory"); else if (wid >= 6) asm volatile("s_waitcnt vmcnt(6)" ::: "memory"); }
        else if (wid >= 1) asm volatile("s_waitcnt vmcnt(0)" ::: "memory");
        __builtin_amdgcn_s_barrier(); asm volatile("" ::: "memory");
        if (wid == 0) {
            LAS const unsigned char* slot = L + (c & (RS_DEPTH - 1)) * RS_SLOT;
            u32x2 ga[4][2][2], hv[4];
#pragma unroll
            for (int mt = 0; mt < 4; ++mt) {
#pragma unroll
                for (int s = 0; s < 2; ++s)
#pragma unroll
                    for (int hh = 0; hh < 2; ++hh) ga[mt][s][hh] = *(LAS const u32x2*)(slot + ((16 * mt + fr) * GLD + 16 * (2 * s + hh) + 4 * fq) * 2);
                hv[mt] = *(LAS const u32x2*)(slot + 9216 + (fr * GLD + 16 * mt + 4 * fq) * 2); }
            bf16_t* Sc = SST + (size_t)c * 4096; u32x2 sp[4];
#pragma unroll
            for (int mt = 0; mt < 4; ++mt) { sp[mt].x = cvt_pk_bf16(acc[mt][0], acc[mt][1]); sp[mt].y = cvt_pk_bf16(acc[mt][2], acc[mt][3]);
                *(u32x2*)(Sc + (size_t)(16 * qi + fr) * 64 + 16 * mt + 4 * fq) = sp[mt]; }
            bf16x8 sb[2];
#pragma unroll
            for (int s = 0; s < 2; ++s) { u32x4 w; w.x = sp[2 * s].x; w.y = sp[2 * s].y; w.z = sp[2 * s + 1].x; w.w = sp[2 * s + 1].y; sb[s] = __builtin_bit_cast(bf16x8, w); }
#pragma unroll
            for (int mt = 0; mt < 4; ++mt) { f32x4 a = (f32x4){bf_lo(hv[mt].x), bf_hi(hv[mt].x), bf_lo(hv[mt].y), bf_hi(hv[mt].y)};
#pragma unroll
                for (int s = 0; s < 2; ++s) { u32x4 w; w.x = ga[mt][s][0].x; w.y = ga[mt][s][0].y; w.z = ga[mt][s][1].x; w.w = ga[mt][s][1].y;
                    a = __builtin_amdgcn_mfma_f32_16x16x32_bf16(__builtin_bit_cast(bf16x8, w), sb[s], a, 0, 0, 0); }
                acc[mt] = a; }
            asm volatile("s_waitcnt lgkmcnt(0)" ::: "memory");
        }
    }
    asm volatile("s_waitcnt vmcnt(0)" ::: "memory");
    __builtin_amdgcn_s_barrier(); asm volatile("" ::: "memory");
}
__device__ __forceinline__ void s5_scan_block(Frame& F, int gb) {
    const int g = gb >> 3, b = gb & 7, p = F.lane, w = F.wave;
    const float* aL = (const float*)(F.ws + WS_AL) + g * 128; const float ar = aL[2 * p], ai = aL[2 * p + 1];
    const float* SLc = (const float*)(F.ws + WS_SLOC) + ((size_t)g * S5ROWS + b * 256 + 32 * w) * 128 + 2 * p;
    bf16_t* UG = (bf16_t*)(F.ws + WS_UG) + ((size_t)g * S5ROWS + b * 256 + 32 * w) * UGLD + 256 + 2 * p;
    LAS float* E = (LAS float*)(F.lds);
    f32x2 l[32];
#pragma unroll
    for (int k = 0; k < 32; ++k) l[k] = *(const f32x2*)(SLc + (size_t)k * 128);
    float sr = 0.f, si = 0.f;
#pragma unroll
    for (int k = 0; k < 32; ++k) { const float nr = ar * sr - ai * si + l[k].x, ni = ar * si + ai * sr + l[k].y; l[k].x = sr; l[k].y = si; sr = nr; si = ni; }
    E[(w * 64 + p) * 2] = sr; E[(w * 64 + p) * 2 + 1] = si;
    float pr = ar, pi = ai;
#pragma unroll
    for (int q = 0; q < 5; ++q) { const float nr = pr * pr - pi * pi, ni = 2.f * pr * pi; pr = nr; pi = ni; }
    asm volatile("s_waitcnt lgkmcnt(0)" ::: "memory"); __builtin_amdgcn_s_barrier(); asm volatile("" ::: "memory");
    float cr = 0.f, ci = 0.f;
#pragma unroll
    for (int w2 = 0; w2 < 7; ++w2) { if (w2 < w) { const float er = E[(w2 * 64 + p) * 2], ei = E[(w2 * 64 + p) * 2 + 1]; const float nr = pr * cr - pi * ci + er, ni = pr * ci + pi * cr + ei; cr = nr; ci = ni; } }
#pragma unroll
    for (int k = 0; k < 32; ++k) { *(unsigned*)(UG + (size_t)k * UGLD) = cvt_pk_bf16(l[k].x + cr, l[k].y + ci); const float nr = ar * cr - ai * ci, ni = ar * ci + ai * cr; cr = nr; ci = ni; }
    asm volatile("s_waitcnt lgkmcnt(0)" ::: "memory"); __builtin_amdgcn_s_barrier(); asm volatile("" ::: "memory");
}
struct OutY { bf16x8 yq[2], yw[2]; u32x2 gv[4]; float bon; };
__device__ __forceinline__ void rwkv_out_loady(Frame& F, int unit, int at, OutY& Lq) {
    const int lane = F.lane, fr = lane & 15, fq = lane >> 4;
    const int bh = unit >> 6, c = unit & 63, b = bh >> 3, h = bh & 7;
    const bf16_t* QRT = (const bf16_t*)(F.ws + WS_QRT) + (size_t)unit * 4096; const bf16_t* WYT = (const bf16_t*)(F.ws + WS_WYT) + (size_t)unit * 4096;
#pragma unroll
    for (int s = 0; s < 2; ++s) { Lq.yq[s] = __builtin_nontemporal_load((const bf16x8*)(QRT + (size_t)(16 * at + fr) * 64 + 32 * s + 8 * fq)); Lq.yw[s] = __builtin_nontemporal_load((const bf16x8*)(WYT + (size_t)(16 * at + fr) * 64 + 32 * s + 8 * fq)); }
    const int tl = c * 64 + 16 * at + fr, tg = b * SEQ + tl;
    const bf16_t* gb = (const bf16_t*)(F.ws + WS_GBUF) + (size_t)tg * RW + h * 64;
    Lq.bon = ((const float*)(F.ws + WS_BONUS))[(size_t)tg * 8 + h];
#pragma unroll
    for (int bt = 0; bt < 4; ++bt) { const int i0 = 16 * bt + 4 * fq; Lq.gv[bt] = *(const u32x2*)(gb + i0); }
}
__device__ __forceinline__ void rwkv_out_comp(Frame& F, int unit, int at, const bf16x8 (&xs)[2][4], const bf16x8 (&xv)[2][4], const OutY& Lq) {
    const int lane = F.lane, fr = lane & 15, fq = lane >> 4;
    const int bh = unit >> 6, c = unit & 63, b = bh >> 3, h = bh & 7;
    f32x4 lw[4], lb[4];
#pragma unroll
    for (int bt = 0; bt < 4; ++bt) { const int i0 = 16 * bt + 4 * fq; lw[bt] = *(const f32x4*)(F.in[I_LNW] + h * 64 + i0); lb[bt] = *(const f32x4*)(F.in[I_LNB] + h * 64 + i0); }
    f32x4 bv4[4];
    {
        const unsigned bb = cvt_pk_bf16(Lq.bon, Lq.bon); const bool mine = fq == 2 * (at & 1) + (fr >> 3); const int jw = (fr & 7) >> 1; const unsigned half = (fr & 1) ? (bb & 0xffff0000u) : (bb & 0xffffu);
        u32x4 dw; dw.x = (mine && jw == 0) ? half : 0u; dw.y = (mine && jw == 1) ? half : 0u; dw.z = (mine && jw == 2) ? half : 0u; dw.w = (mine && jw == 3) ? half : 0u;
        const bf16x8 df = __builtin_bit_cast(bf16x8, dw);
#pragma unroll
        for (int bt = 0; bt < 4; ++bt) bv4[bt] = __builtin_amdgcn_mfma_f32_16x16x32_bf16((at >> 1) ? xv[1][bt] : xv[0][bt], df, (f32x4){0.f, 0.f, 0.f, 0.f}, 0, 0, 0);
    }
    f32x4 acc[4];
#pragma unroll
    for (int bt = 0; bt < 4; ++bt) acc[bt] = (f32x4){0.f, 0.f, 0.f, 0.f};
#pragma unroll
    for (int s = 0; s < 2; ++s)
#pragma unroll
        for (int bt = 0; bt < 4; ++bt) {
            acc[bt] = __builtin_amdgcn_mfma_f32_16x16x32_bf16(xs[s][bt], Lq.yq[s], acc[bt], 0, 0, 0);
            acc[bt] = __builtin_amdgcn_mfma_f32_16x16x32_bf16(xv[s][bt], Lq.yw[s], acc[bt], 0, 0, 0); }
    float s1 = 0.f;
#pragma unroll
    for (int bt = 0; bt < 4; ++bt) s1 += (acc[bt][0] + acc[bt][1]) + (acc[bt][2] + acc[bt][3]);
    s1 += __shfl_xor(s1, 16); s1 += __shfl_xor(s1, 32);
    const float mean = s1 * (1.f / 64.f); float s2 = 0.f;
#pragma unroll
    for (int bt = 0; bt < 4; ++bt) { const f32x4 d = acc[bt] - mean; s2 += (d[0] * d[0] + d[1] * d[1]) + (d[2] * d[2] + d[3] * d[3]); }
    s2 += __shfl_xor(s2, 16); s2 += __shfl_xor(s2, 32);
    const float rstd = __builtin_amdgcn_rsqf(s2 * (1.f / 64.f) + 64e-5f);
    const int tl = c * 64 + 16 * at + fr, tg = b * SEQ + tl;
    bf16_t* YRS = (bf16_t*)(F.dout + DO_YRS) + (size_t)tg * D + h * 64;
#pragma unroll
    for (int bt = 0; bt < 4; ++bt) { const int i0 = 16 * bt + 4 * fq;
        const u32x2 gv = Lq.gv[bt];
        const float gg[4] = {bf_lo(gv.x), bf_hi(gv.x), bf_lo(gv.y), bf_hi(gv.y)};
        float o[4];
#pragma unroll
        for (int e = 0; e < 4; ++e) o[e] = ((acc[bt][e] - mean) * rstd * lw[bt][e] + lb[bt][e] + bv4[bt][e]) * gg[e];
        u32x2 w; w.x = cvt_pk_bf16(o[0], o[1]); w.y = cvt_pk_bf16(o[2], o[3]); *(u32x2*)(YRS + i0) = w; }
}
__device__ __forceinline__ void rwkv_out_units(Frame& F) {
    const int lane = F.lane, fr = lane & 15, fq = lane >> 4;
    for (int unit = F.vcu * NWAVES + F.wave; unit < NUNIT; unit += F.G * NWAVES) {
        const bf16_t* VT = (const bf16_t*)(F.ws + WS_VT) + (size_t)unit * 4096; const bf16_t* SST = (const bf16_t*)(F.dout + DO_SST) + (size_t)unit * 4096;
        bf16x8 xs[2][4], xv[2][4]; OutY A, B;
#pragma unroll
        for (int s = 0; s < 2; ++s)
#pragma unroll
            for (int bt = 0; bt < 4; ++bt) { xs[s][bt] = __builtin_nontemporal_load((const bf16x8*)(SST + (size_t)(16 * bt + fr) * 64 + 32 * s + 8 * fq)); xv[s][bt] = __builtin_nontemporal_load((const bf16x8*)(VT + (size_t)(16 * bt + fr) * 64 + 32 * s + 8 * fq)); }
        rwkv_out_loady(F, unit, 0, A); rwkv_out_loady(F, unit, 1, B); __builtin_amdgcn_sched_barrier(0);
        rwkv_out_comp(F, unit, 0, xs, xv, A); __builtin_amdgcn_sched_barrier(0); rwkv_out_loady(F, unit, 2, A); __builtin_amdgcn_sched_barrier(0);
        rwkv_out_comp(F, unit, 1, xs, xv, B); __builtin_amdgcn_sched_barrier(0); rwkv_out_loady(F, unit, 3, B); __builtin_amdgcn_sched_barrier(0);
        rwkv_out_comp(F, unit, 2, xs, xv, A); __builtin_amdgcn_sched_barrier(0);
        rwkv_out_comp(F, unit, 3, xs, xv, B); __builtin_amdgcn_sched_barrier(0);
    }
}

__device__ __forceinline__ void p8_rows(Frame& F) {
    const int gw = F.vcu * NWAVES + F.wave, NGW = F.G * NWAVES, lane = F.lane;
    const bf16_t* MX = (const bf16_t*)(F.ws + WS_MIXED); const float* ST = (const float*)(F.ws + WS_STAT1); bf16_t* H2 = (bf16_t*)(F.ws + WS_H2); float* X1 = (float*)F.dout;
    f32x4 gp[4];
#pragma unroll
    for (int j = 0; j < 4; ++j) gp[j] = *(const f32x4*)(F.in[I_NMPOST] + 256 * j + 4 * lane);
    for (int m0 = gw; m0 < T; m0 += 2 * NGW) {
        int mm[2] = {m0, (m0 + NGW < T) ? m0 + NGW : m0};
        f32x4 xv[2][4]; u32x2 mw[2][4]; float st[2];
#pragma unroll
        for (int q = 0; q < 2; ++q) { st[q] = (lane < 16) ? ST[(size_t)mm[q] * 16 + lane] : 0.f;
#pragma unroll
            for (int j = 0; j < 4; ++j) { const int col = 256 * j + 4 * lane; xv[q][j] = __builtin_nontemporal_load((const f32x4*)(F.in[I_X] + (size_t)mm[q] * D + col)); mw[q][j] = __builtin_nontemporal_load((const u32x2*)(MX + (size_t)mm[q] * D + col)); } }
#pragma unroll
        for (int q = 0; q < 2; ++q) {
            const float rstd1 = __builtin_amdgcn_rsqf(wave_sum(st[q]) * (1.f / D) + 1e-6f);
            f32x4 v[4]; float s = 0.f;
#pragma unroll
            for (int j = 0; j < 4; ++j) { const int col = 256 * j + 4 * lane;
                v[j].x = xv[q][j].x + bf_lo(mw[q][j].x) * rstd1 * gp[j].x; v[j].y = xv[q][j].y + bf_hi(mw[q][j].x) * rstd1 * gp[j].y; v[j].z = xv[q][j].z + bf_lo(mw[q][j].y) * rstd1 * gp[j].z; v[j].w = xv[q][j].w + bf_hi(mw[q][j].y) * rstd1 * gp[j].w;
                s += (v[j].x * v[j].x + v[j].y * v[j].y) + (v[j].z * v[j].z + v[j].w * v[j].w);
                }
            const float rstd2 = __builtin_amdgcn_rsqf(wave_sum(s) * (1.f / D) + 1e-6f);
#pragma unroll
            for (int j = 0; j < 4; ++j) { u32x2 w; w.x = cvt_pk_bf16(v[j].x * rstd2, v[j].y * rstd2); w.y = cvt_pk_bf16(v[j].z * rstd2, v[j].w * rstd2); *(u32x2*)(H2 + (size_t)mm[q] * D + 256 * j + 4 * lane) = w; }
        }
    }
}
__device__ __forceinline__ void p12_rows(Frame& F) {
    const int gw = F.vcu * NWAVES + F.wave, NGW = F.G * NWAVES, lane = F.lane;
    const bf16_t* FB = (const bf16_t*)(F.ws + WS_F); const bf16_t* MX = (const bf16_t*)(F.ws + WS_MIXED);
    const float* ST1 = (const float*)(F.ws + WS_STAT1); const float* ST2 = (const float*)(F.ws + WS_STAT2); float* OUT = (float*)F.dout;
    f32x4 gp[4], gq[4];
#pragma unroll
    for (int j = 0; j < 4; ++j) { gp[j] = *(const f32x4*)(F.in[I_NMPOST] + 256 * j + 4 * lane); gq[j] = *(const f32x4*)(F.in[I_NFPOST] + 256 * j + 4 * lane); }
    for (int m0 = gw; m0 < T; m0 += 2 * NGW) {
        int mm[2] = {m0, (m0 + NGW < T) ? m0 + NGW : m0};
        f32x4 xv[2][4]; u32x2 mw[2][4], fw[2][4]; float s1[2], s2[2];
#pragma unroll
        for (int q = 0; q < 2; ++q) { s1[q] = (lane < 16) ? ST1[(size_t)mm[q] * 16 + lane] : 0.f; s2[q] = (lane < 16) ? ST2[(size_t)mm[q] * 16 + lane] : 0.f;
#pragma unroll
            for (int j = 0; j < 4; ++j) { const int col = 256 * j + 4 * lane; xv[q][j] = __builtin_nontemporal_load((const f32x4*)(F.in[I_X] + (size_t)mm[q] * D + col));
                mw[q][j] = __builtin_nontemporal_load((const u32x2*)(MX + (size_t)mm[q] * D + col)); fw[q][j] = __builtin_nontemporal_load((const u32x2*)(FB + (size_t)mm[q] * D + col)); } }
#pragma unroll
        for (int q = 0; q < 2; ++q) {
            const float rstd1 = __builtin_amdgcn_rsqf(wave_sum(s1[q]) * (1.f / D) + 1e-6f), rstd3 = __builtin_amdgcn_rsqf(wave_sum(s2[q]) * (1.f / D) + 1e-6f);
#pragma unroll
            for (int j = 0; j < 4; ++j) { const int col = 256 * j + 4 * lane; f32x4 o;
                o.x = xv[q][j].x + bf_lo(mw[q][j].x) * rstd1 * gp[j].x; o.y = xv[q][j].y + bf_hi(mw[q][j].x) * rstd1 * gp[j].y; o.z = xv[q][j].z + bf_lo(mw[q][j].y) * rstd1 * gp[j].z; o.w = xv[q][j].w + bf_hi(mw[q][j].y) * rstd1 * gp[j].w;
                o.x += bf_lo(fw[q][j].x) * rstd3 * gq[j].x; o.y += bf_hi(fw[q][j].x) * rstd3 * gq[j].y; o.z += bf_lo(fw[q][j].y) * rstd3 * gq[j].z; o.w += bf_hi(fw[q][j].y) * rstd3 * gq[j].w;
                __builtin_nontemporal_store(o, (f32x4*)(OUT + (size_t)mm[q] * D + col)); }
        }
    }
}

#ifndef MK_PER_PHASE
#define MK_PER_PHASE 0
#endif
constexpr int NPHASE = 12;
struct Args { const float* in[35]; float* out; unsigned char* ws; int ph_lo, ph_hi; };
static_assert(sizeof(Args) == 35 * 8 + 8 + 8 + 8, "Args has no padding");

__device__ __forceinline__ bool phase_begin(Frame& F) { unsigned long long z = 0; asm volatile("" : "+s"(z), "+v"(F.tid)); F.ws = F.ws0 + z; F.dout = F.dout0 + z;     F.lane = F.tid & 63; F.wave = __builtin_amdgcn_readfirstlane(F.tid >> 6); return true; }
__global__ void __launch_bounds__(NWAVES * 64, 2) fwd_kernel(Args args) {
    extern __shared__ __attribute__((aligned(16))) unsigned char lds_raw[];
    Frame F;
    F.lds = (LAS unsigned char*)lds_raw;
    F.MISC = (volatile LAS unsigned*)(F.lds + MISC_OFF);
    F.tid = threadIdx.x; F.lane = F.tid & 63; F.wave = __builtin_amdgcn_readfirstlane(F.tid >> 6);
    F.G = gridDim.x; { const int bx = blockIdx.x; F.vcu = (F.G % 8 == 0) ? (bx % 8) * (F.G / 8) + bx / 8 : bx; }
    F.ws0 = args.ws; F.dout0 = (unsigned char*)args.out; F.ws = F.ws0; F.dout = F.dout0; F.ctl = (gu32*)(args.ws + WS_CTL);
    F.in = (InTab)__builtin_amdgcn_kernarg_segment_ptr();
    for (int u = F.tid; u < (LDS_BYTES - LDSCTL_OFF) / 4; u += NWAVES * 64) ((LAS unsigned*)(F.lds + LDSCTL_OFF))[u] = 0u;
    __syncthreads();
    XcdBarrier bar; bar.bar = (unsigned*)(F.ctl + CW_BAR); bar.x = 0; bar.st = nullptr;
    if (!MK_PER_PHASE) bar = xcd_barrier_post((unsigned*)(F.ctl + CW_BAR), F.MISC + 8);
    const int lo = args.ph_lo, hi = args.ph_hi;
#ifndef PHMASK
#define PHMASK 0xffffffffu
#endif
#define IN(k) (((PHMASK >> (k)) & 1u) && lo <= (k) && (k) < hi && phase_begin(F))
#ifndef REPMASK
#define REPMASK 0u
#endif
#define REPS(k) ((((REPMASK) >> (k)) & 1u) ? 2 : 1)
#define PH(k) for (int rep_ = 0; rep_ < REPS(k); ++rep_, (rep_ < REPS(k) ? xcd_barrier(bar) : (void)0))
#define INQ(k) (lo <= (k) && (k) < hi)
#define SEAM(k) do { if (INQ(k) && INQ((k) + 1)) xcd_barrier(bar); } while (0)
#define WSB(off) ((bf16_t*)(F.ws + (off)))
    const int bx = (int)blockIdx.x;

    PH(0) if (IN(0)) { p0_prologue(F); }
    SEAM(0);
    PH(1) if (IN(1)) {
        pg8::Gemm g{D, D, D, 0}; pg8::StaticOrder S; S.init(WSB(WS_XN), WSB(WS_WIN), D, D, T, NIN, F.G, bx);
        EpiInProj E{WSB(WS_PR), WSB(WS_UG), WSB(WS_GATES), F.in[I_BGATE], 0};
        pg8::gemm_phase<EpiInProj, pg8::StaticOrder, true>(F.lds, g, S, E, F.tid);
        { const int rem = ((T / 256) * (NIN / 256)) % F.G;
          if (rem == 0) p0_late_mats(F, bx * NWAVES + F.wave, F.G * NWAVES); else if (bx >= rem) p0_late_mats(F, (bx - rem) * NWAVES + F.wave, (F.G - rem) * NWAVES); }
    }
    SEAM(1);
    PH(2) if (IN(2)) {
        PrePf pf;
        if (F.vcu < NB * NCH) { rwkv_pre_fetch<2>(F, (((F.vcu >> 6) * NHEAD) << 6) + (F.vcu & 63), true, pf, F.tid); rwkv_pre_put_w(F.lds, pf, F.tid); }
        {
            LAS f32x4* TB = (LAS f32x4*)(F.lds + XTRA_OFF + 4096);
            if (F.tid < NRW / 4) TB[F.tid] = ((const f32x4*)F.in[I_MU])[F.tid];
            const int pq = F.tid >> 7, pi = F.tid & 127;
            const float* psrc = pq == 0 ? F.in[I_W0] : pq == 1 ? F.in[I_A0] : pq == 2 ? F.in[I_KK] : F.in[I_KA];
            TB[NRW / 4 + F.tid] = ((const f32x4*)psrc)[pi];
            if (F.tid < 128) TB[NRW / 4 + 512 + F.tid] = ((const f32x4*)F.in[I_RK])[F.tid];
            BAR_LDS();
        }
        for (int pc = F.vcu; pc < NB * NCH; pc += F.G) {
#pragma unroll 1
            for (int hh = 0; hh < NHEAD; ++hh) { const int bq = pc >> 6, cq = pc & 63, u = ((bq * NHEAD + hh) << 6) + cq;
                const int un = (hh < NHEAD - 1) ? u + 64 : ((pc + F.G < NB * NCH) ? ((((pc + F.G) >> 6) * NHEAD) << 6) + ((pc + F.G) & 63) : NUNIT);
                rwkv_pre_unit(F, u, un, hh == 0, hh == NHEAD - 1, pf); } }
        BAR_LDS();
        pg8::Gemm g{256, UGLD, 256, 0}; S5Order S{WSB(WS_UG), WSB(WS_B1A), 256, F.G, bx};
        EpiSloc E{(float*)(F.ws + WS_SLOC), 0};
        pg8::gemm_phase<EpiSloc, S5Order, true>(F.lds, g, S, E, F.tid);
    }
    SEAM(2);
    PH(3) if (IN(3)) {
        for (int gb = F.vcu; gb < S5G * NB; gb += F.G) s5_scan_block(F, gb);
        for (int it = F.vcu; it < NB * NHEAD * 4; it += F.G) rwkv_scan_block(F, it);
    }
    SEAM(3);
    PH(4) if (IN(4)) {
        rwkv_out_units(F);
        VM_WAIT(); __syncthreads();
        pg8::Gemm g{384, UGLD, 384, 0}; S5Order S{WSB(WS_UG), WSB(WS_B1B), 384, F.G, bx};
        pg8::EpiGen8<FS5Out> E{FS5Out{WSB(WS_YSP)}, 0};
        pg8::gemm_phase<pg8::EpiGen8<FS5Out>, S5Order, true>(F.lds, g, S, E, F.tid);
    }
    SEAM(4);
    PH(5) if (IN(5)) {
        pg8::Gemm g{RW, RW, RW, 1}; pg8::StaticOrder S; S.init(WSB(WS_YSP), WSB(WS_WGLU), RW, RW, T, RW, F.G, bx); S.tstepA = (size_t)16 * 256 * 2;
        EpiGlu E{WSB(WS_YSP), (bf16_t*)(F.dout + DO_YRS), F.in[I_BGLU], 0};
        pg8::gemm_phase<EpiGlu, pg8::StaticOrder, true>(F.lds, g, S, E, F.tid);
    }
    SEAM(5);
    PH(6) if (IN(6)) {
        pg8::Gemm g{D, D, D, 0}; pg8::StaticOrder S; S.init((const bf16_t*)(F.dout + DO_YRS), WSB(WS_WBRS), D, D, T, D, F.G, bx);
        EpiMerge E{WSB(WS_GATES), WSB(WS_MERGED), RW / 64};
        pg8::gemm_phase<EpiMerge, pg8::StaticOrder, true>(F.lds, g, S, E, F.tid);
    }
    SEAM(6);
    PH(7) if (IN(7)) {
        pg8::Gemm g{D, D, D, 0}; pg8::StaticOrder S; S.init(WSB(WS_MERGED), WSB(WS_WOUT), D, D, T, D, F.G, bx);
        EpiRowStat E{WSB(WS_MIXED), (float*)(F.ws + WS_STAT1), 0};
        pg8::gemm_phase<EpiRowStat, pg8::StaticOrder, false>(F.lds, g, S, E, F.tid);
    }
    SEAM(7);
    PH(8) if (IN(8)) { p8_rows(F);
        for (size_t i = (size_t)bx * 512 + F.tid; i < HZ_BYTES / 16; i += (size_t)F.G * 512) ((u32x4*)(F.ws + WS_HZ))[i] = (u32x4){0u, 0u, 0u, 0u}; }
    SEAM(8);
    PH(9) if (IN(9)) {
        pg8::Gemm g{D, D, D, 0}; UpOrder S{WSB(WS_H2), WSB(WS_WUP), F.G, bx};
        EpiConvAct E{WSB(WS_ACT), F.in[I_CONVW], F.in[I_CONVB], (LAS unsigned*)(F.lds + XTRA_OFF), (unsigned long long*)(F.ws + WS_HZ), (unsigned*)(F.ctl + 2), 0};
        pg8::gemm_phase<EpiConvAct, UpOrder, true>(F.lds, g, S, E, F.tid);
    }
    SEAM(9);
    PH(10) if (IN(10)) {
        pg8::Gemm g{FF, FF, FF, 0}; pg8::StaticOrder S; S.init(WSB(WS_ACT), WSB(WS_WDN), FF, FF, T, D, F.G, bx);
        EpiRowStat E{WSB(WS_F), (float*)(F.ws + WS_STAT2), 0};
        pg8::gemm_phase<EpiRowStat, pg8::StaticOrder, false>(F.lds, g, S, E, F.tid);
    }
    SEAM(10);
    if (IN(11)) p12_rows(F);
#undef IN
#undef INQ
#undef SEAM
#undef WSB
}

extern "C" void kernel_launch(void* const* d_in, const int* in_sizes, int n_in, void* d_out, int out_size, void* d_ws, size_t ws_size, hipStream_t stream) {
    static int grid = 0;
    if (grid == 0) {
        if (n_in != 35 || in_sizes[0] != T * D || out_size != T * D || ws_size < WS_END) { fprintf(stderr, "kernel_launch: unexpected shapes: n_in %d in0 %d out %d ws %zu (need %zu)\n", n_in, n_in > 0 ? in_sizes[0] : -1, out_size, ws_size, (size_t)WS_END); grid = -1; return; }
        int dev = 0, cus = 0, per_cu = 0;
        if (hipGetDevice(&dev) != hipSuccess || hipDeviceGetAttribute(&cus, hipDeviceAttributeMultiprocessorCount, dev) != hipSuccess) { fprintf(stderr, "kernel_launch: device query failed\n"); grid = -1; return; }
        if (hipFuncSetAttribute((const void*)fwd_kernel, hipFuncAttributeMaxDynamicSharedMemorySize, LDS_BYTES) != hipSuccess) { fprintf(stderr, "kernel_launch: hipFuncSetAttribute failed\n"); grid = -1; return; }
        if (hipOccupancyMaxActiveBlocksPerMultiprocessor(&per_cu, (const void*)fwd_kernel, NWAVES * 64, LDS_BYTES) != hipSuccess || per_cu < 1) fprintf(stderr, "kernel_launch: occupancy query reports %d blocks per CU\n", per_cu);
        (void)hipGetLastError();
        grid = cus;
    }
    if (grid < 0) return;
    if (hipMemsetAsync((char*)d_ws + WS_CTL, 0, CTL_ZERO_BYTES, stream) != hipSuccess) { fprintf(stderr, "kernel_launch: memset failed\n"); return; }
    Args a{};
    for (int i = 0; i < 35; ++i) a.in[i] = (const float*)d_in[i];
    a.out = (float*)d_out; a.ws = (unsigned char*)d_ws;
#if MK_PER_PHASE
    for (int ph = 0; ph < NPHASE; ++ph) { a.ph_lo = ph; a.ph_hi = ph + 1; hipLaunchKernelGGL(fwd_kernel, dim3(grid), dim3(NWAVES * 64), LDS_BYTES, stream, a); }
#else
    a.ph_lo = 0; a.ph_hi = NPHASE;
    hipLaunchKernelGGL(fwd_kernel, dim3(grid), dim3(NWAVES * 64), LDS_BYTES, stream, a);
#endif
    const hipError_t le = hipPeekAtLastError();
    if (le != hipSuccess) fprintf(stderr, "kernel_launch: launch failed: %s\n", hipGetErrorName(le));
}
```

```cpp
#include <hip/hip_runtime.h>
#include <cstdio>
#include <cstdint>

#define LAS __attribute__((address_space(3)))
#define GAS __attribute__((address_space(1)))
typedef unsigned short bf16_t;
typedef short bf16x8 __attribute__((ext_vector_type(8)));
typedef float f32x4 __attribute__((ext_vector_type(4)));
typedef float f32x2 __attribute__((ext_vector_type(2)));
typedef unsigned u32x4 __attribute__((ext_vector_type(4)));
typedef unsigned u32x2 __attribute__((ext_vector_type(2)));
typedef GAS unsigned gu32;

constexpr int T = 32768, SEQ = 4096, NB = 8, D = 1024, NIN = 4352, NRW = 1792, RW = 512, FF = 2816, FH = 1408;
constexpr int NHEAD = 8, HD = 64, NCH = 64  , NUNIT = NB * NHEAD * NCH;
constexpr int S5G = 32, S5ROWS = T / 16, UGLD = 384;

constexpr size_t MiB = 1u << 20;
constexpr size_t WS_CTL = 0, CTL_ZERO_BYTES = 1 * MiB;
constexpr size_t WS_WIN = 1 * MiB;
constexpr size_t WS_WUP = WS_WIN + (size_t)NIN * D * 2;
constexpr size_t WS_WDN = WS_WUP + (size_t)2 * FF * D * 2;
constexpr size_t WS_WOUT = WS_WDN + (size_t)D * FF * 2;
constexpr size_t WS_WBRS = WS_WOUT + (size_t)D * D * 2;
constexpr size_t WS_WGLU = WS_WBRS + (size_t)D * D * 2;
constexpr size_t WS_W2T = WS_WGLU + (size_t)RW * RW * 2;
constexpr size_t WS_A2T = WS_W2T + (size_t)RW * 64 * 2;
constexpr size_t WS_G2T = WS_A2T + (size_t)RW * 64 * 2;
constexpr size_t WS_B1A = WS_G2T + (size_t)RW * 128 * 2;
constexpr size_t WS_B1B = WS_B1A + (size_t)S5G * 256 * 256 * 2;
constexpr size_t WS_AL = WS_B1B + (size_t)S5G * 256 * 384 * 2;
constexpr size_t WS_WEND = WS_AL + (size_t)S5G * 64 * 2 * 4;
static_assert(WS_WEND <= 44 * MiB, "weights region");
constexpr size_t WS_XN = 44 * MiB;
constexpr size_t WS_QRT = 44 * MiB, WS_WYT = 76 * MiB;
constexpr size_t WS_MERGED = 44 * MiB, WS_H2 = 44 * MiB, WS_F = 44 * MiB;
constexpr size_t WS_PR = 108 * MiB;
constexpr size_t WS_MIXED = 304 * MiB, WS_STAT1 = 368 * MiB;
constexpr size_t WS_ACT = 108 * MiB;
constexpr size_t WS_STAT2 = 284 * MiB;
constexpr size_t WS_UG = 220 * MiB;
constexpr size_t WS_GATES = 268 * MiB;
constexpr size_t WS_SLOC = 396 * MiB, WS_YSP = 396 * MiB;
constexpr size_t WS_GBUF = 428 * MiB;
constexpr size_t WS_BONUS = 460 * MiB;
constexpr size_t WS_VT = 461 * MiB;
constexpr size_t WS_LRSCR = 493 * MiB;
constexpr size_t WS_Z = 336 * MiB;
constexpr size_t WS_END = 512 * MiB;
constexpr size_t DO_H = 0, DO_GT = 36 * MiB, DO_SST = 96 * MiB, DO_YRS = 0;
constexpr int GLD = 72;

constexpr int CW_BAR = 4096, CW_HF = 32768, CW_XNQ = 64;
constexpr size_t WS_HZ = 290 * MiB, HZ_BYTES = (size_t)2816 * 4 * 2 * 32 * 8;

constexpr int RING_BYTES = 131072, LDSCTL_OFF = RING_BYTES, MISC_OFF = LDSCTL_OFF + 320, XTRA_OFF = LDSCTL_OFF + 1024, LDS_BYTES = 155648;
constexpr int NWAVES = 8;

#define RLX_AGENT __ATOMIC_RELAXED, __HIP_MEMORY_SCOPE_AGENT
#define LDS_WAIT() asm volatile("s_waitcnt lgkmcnt(0)" ::: "memory")
#define VM_WAIT() asm volatile("s_waitcnt vmcnt(0)" ::: "memory")

typedef __bf16 bf16x2_t __attribute__((ext_vector_type(2)));
__device__ __forceinline__ unsigned cvt_pk_bf16(float lo, float hi) { const f32x2 v = {lo, hi}; return __builtin_bit_cast(unsigned, __builtin_convertvector(v, bf16x2_t)); }
__device__ __forceinline__ float bf_lo(unsigned w) { return __uint_as_float(w << 16); }
__device__ __forceinline__ float bf_hi(unsigned w) { return __uint_as_float(w & 0xffff0000u); }
__device__ __forceinline__ float bf1(bf16_t h) { return __uint_as_float((unsigned)h << 16); }
__device__ __forceinline__ float fexp(float x) { return __builtin_amdgcn_exp2f(x * 1.44269504089f); }
__device__ __forceinline__ float fsigmoid(float x) { return __builtin_amdgcn_rcpf(1.0f + __builtin_amdgcn_exp2f(-1.44269504089f * x)); }
__device__ __forceinline__ float ftanh(float x) { return 1.0f - 2.0f * __builtin_amdgcn_rcpf(1.0f + __builtin_amdgcn_exp2f(2.88539008178f * x)); }
__device__ __forceinline__ float fgelu(float x) { const float u = 0.7978845608f * (x + 0.044715f * x * x * x); return x * fsigmoid(2.0f * u); }
__device__ __forceinline__ void unpack8(u32x4 w, float (&f)[8]) { f[0] = bf_lo(w.x); f[1] = bf_hi(w.x); f[2] = bf_lo(w.y); f[3] = bf_hi(w.y); f[4] = bf_lo(w.z); f[5] = bf_hi(w.z); f[6] = bf_lo(w.w); f[7] = bf_hi(w.w); }
__device__ __forceinline__ u32x4 pack8(const float (&f)[8]) { u32x4 w; w.x = cvt_pk_bf16(f[0], f[1]); w.y = cvt_pk_bf16(f[2], f[3]); w.z = cvt_pk_bf16(f[4], f[5]); w.w = cvt_pk_bf16(f[6], f[7]); return w; }
__device__ __forceinline__ float wave_sum(float v) {
#pragma unroll
    for (int o = 1; o < 64; o <<= 1) v += __shfl_xor(v, o);
    return v;
}

#define XB_TMO      128
#define XB_XCNT(j)  (256  + 64 * (j))
#define XB_XSUB(j)  (1280 + 64 * (j))
#define XB_XGEN(j)  (2304 + 64 * (j))
#define XB_TOP      3328
#define XB_TOPGEN   3392
#define XCD_BAR_WORDS 3456
#define XB_SPIN_CAP (1u << 18)
__device__ __forceinline__ unsigned xb_ld(unsigned* p)              { return __hip_atomic_load(p, __ATOMIC_RELAXED, __HIP_MEMORY_SCOPE_AGENT); }
__device__ __forceinline__ unsigned xb_add(unsigned* p, unsigned v) { return __hip_atomic_fetch_add(p, v, __ATOMIC_RELAXED, __HIP_MEMORY_SCOPE_AGENT); }
__device__ __forceinline__ unsigned xb_xcc_id() { return (unsigned)__builtin_amdgcn_s_getreg((3 << 11) | 20) & 0xFu; }
#define XB_SPIN(cond, bar) do { unsigned _sp = 0; while (cond) { __builtin_amdgcn_s_sleep(1); \
    if ((++_sp & 255u) == 0u) { if (xb_ld(&(bar)[XB_TMO])) break; if (_sp > XB_SPIN_CAP) { atomicAdd(&(bar)[XB_TMO], 1u); break; } } } } while (0)
struct XcdBarrier { unsigned* bar; unsigned x; volatile LAS unsigned* st; };
__device__ __forceinline__ XcdBarrier xcd_barrier_post(unsigned* bar, volatile LAS unsigned* st) {
    XcdBarrier b; b.bar = bar; b.x = xb_xcc_id(); b.st = st;
    if (threadIdx.x == 0) (void)xb_add(&bar[XB_XCNT(b.x)], 1u);
    return b;
}
__device__ __forceinline__ void xcd_barrier_complete(unsigned* bar, unsigned x, unsigned& nloc, unsigned& nx) {
    const unsigned G = gridDim.x * gridDim.y * gridDim.z;
    unsigned sum, cnt, mine, sp = 0u;
    for (;;) {
        sum = 0u; cnt = 0u; mine = 0u;
#pragma unroll
        for (unsigned j = 0; j < 16; ++j) { const unsigned c = xb_ld(&bar[XB_XCNT(j)]); sum += c; cnt += (c > 0u) ? 1u : 0u; mine = (j == x) ? c : mine; }
        if (sum == G) break;
        __builtin_amdgcn_s_sleep(1);
        if ((++sp & 255u) == 0u) { if (xb_ld(&bar[XB_TMO])) break; if (sp > XB_SPIN_CAP) { atomicAdd(&bar[XB_TMO], 1u); break; } }
    }
    nloc = mine > 0u ? mine : 1u; nx = cnt > 0u ? cnt : 1u;
}
__device__ __forceinline__ void xcd_barrier(const XcdBarrier& b) {
    asm volatile("s_waitcnt vmcnt(0)" ::: "memory");
    __syncthreads();
    if (threadIdx.x == 0) {
        unsigned* bar = b.bar;
        __builtin_amdgcn_s_waitcnt(0);
        unsigned nloc = b.st[0], nx = b.st[1];
        if (nloc == 0u) { xcd_barrier_complete(bar, b.x, nloc, nx); b.st[0] = nloc; b.st[1] = nx; }
        const unsigned old = xb_add(&bar[XB_XSUB(b.x)], 1u);
        const unsigned gen = old / nloc;
        if (old + 1u == (gen + 1u) * nloc) {
            __builtin_amdgcn_fence(__ATOMIC_RELEASE, "agent");
            asm volatile("s_waitcnt vmcnt(0)" ::: "memory");
            const unsigned og = xb_add(&bar[XB_TOP], 1u);
            const unsigned tg = og / nx;
            if (og + 1u == (tg + 1u) * nx) xb_add(&bar[XB_TOPGEN], 1u);
            else XB_SPIN(xb_ld(&bar[XB_TOPGEN]) == tg, bar);
            __builtin_amdgcn_fence(__ATOMIC_ACQUIRE, "agent");
            xb_add(&bar[XB_XGEN(b.x)], 1u);
            asm volatile("s_waitcnt vmcnt(0)" ::: "memory");
        } else {
            XB_SPIN(xb_ld(&bar[XB_XGEN(b.x)]) == gen, bar);
            __builtin_amdgcn_fence(__ATOMIC_ACQUIRE, "agent");
            asm volatile("s_waitcnt vmcnt(0)" ::: "memory");
        }
    }
    __syncthreads();
}

namespace pg8 {
constexpr int BM = 256, BK = 64, HALF = 128, HTB = HALF * BK * 2, STAGE_BYTES = 8 * HTB, NXCD = 8, WGM = 8;
__host__ __device__ __forceinline__ int lds_byte(int r, int c) { const int st = (r >> 4) * 2 + (c >> 5), rr = r & 15, cc = c & 31, ob = rr * 64 + cc * 2; return st * 1024 + (ob ^ (((ob >> 9) & 1) << 5)); }
__host__ __device__ __forceinline__ void stage_rc(int b, int& R, int& C) { const int st = b / 1024, sb = b % 1024, swz = sb ^ (((sb >> 9) & 1) << 5); R = (st >> 1) * 16 + swz / 64; C = (st & 1) * 32 + (swz % 64) / 2; }
__host__ __device__ __forceinline__ int perm32(int rho) { const int n = rho >> 4, i = rho & 15; return 8 * (i >> 2) + 4 * n + (i & 3); }

struct Unit { const char* a; const char* b; int pm, pn; };
struct Gemm { int K, lda, ldb, amode; };

struct StaticOrder {
    const bf16_t* A; const bf16_t* Bt; int lda, ldb;
    int nM, nN, nwg, G, c; size_t tstepA;
    __device__ void init(const bf16_t* A_, const bf16_t* Bt_, int lda_, int ldb_, int M, int N, int G_, int c_) { A = A_; Bt = Bt_; lda = lda_; ldb = ldb_; nM = M / BM; nN = N / BM; nwg = nM * nN; G = G_; c = c_; tstepA = (size_t)BM * lda * 2; }
    __device__ bool next(int i, Unit& u) const {
        const long L = (long)i * G + c; if (L >= nwg) return false;
        int wgid = (int)L; { const int q = nwg / NXCD, r = nwg % NXCD, xcd = wgid % NXCD, off = wgid / NXCD; wgid = (xcd < r ? xcd * (q + 1) : r * (q + 1) + (xcd - r) * q) + off; }
        const int nig = WGM * nN, gid = wgid / nig, fm = gid * WGM, gsz = (nM - fm) < WGM ? (nM - fm) : WGM;
        u.pm = fm + ((wgid % nig) % gsz); u.pn = (wgid % nig) / gsz;
        u.a = (const char*)A + (size_t)u.pm * tstepA; u.b = (const char*)Bt + (size_t)u.pn * BM * ldb * 2; return true;
    }
};

template <class Epi, class Sched, bool ALIGN_EPI = false, bool SP2 = true>
__device__ __forceinline__ void gemm_phase(LAS unsigned char* lds, const Gemm g, const Sched& S, const Epi& E, const int tid) {
    const int wid = __builtin_amdgcn_readfirstlane(tid >> 6), lane = tid & 63, wr = wid >> 2, wc = wid & 3, fr = lane & 15, fq = lane >> 4;
    const int K = g.K, nt = K / BK;
    unsigned voffA[2], voffB[2];
#pragma unroll
    for (int i = 0; i < 2; ++i) { int R, C; stage_rc(tid * 16 + i * 8192, R, C); const int Rb = Epi::PERM ? ((R & ~31) + perm32(R & 31)) : R;
        voffA[i] = g.amode ? (unsigned)((((C >> 4) * S5ROWS + (R >> 4)) * 256 + (R & 15) * 16 + (C & 15)) * 2) : (unsigned)(R * g.lda + C) * 2u; voffB[i] = (unsigned)(Rb * g.ldb + C) * 2u; }
    const size_t kstepB = (size_t)(BK * 2), kstepA = g.amode ? (size_t)4 * S5ROWS * 256 * 2 : (size_t)(BK * 2);
    const size_t hstepA = g.amode ? (size_t)8 * 256 * 2 : (size_t)HALF * g.lda * 2, hstepB = (size_t)HALF * g.ldb * 2;
    const unsigned ldsw = (unsigned)wid * 1024u;
    const int aoff = lds_byte(wr * 64 + fr, fq * 8), boff = lds_byte(wc * 32 + fr, fq * 8);
#define PG8_SA(b, h) (((b) * 2 + (h)) * HTB)
#define PG8_SB(b, h) ((4 + (b) * 2 + (h)) * HTB)
#define PG8_STAGE(bufoff, gbase, voff) do { _Pragma("unroll") for (int _i = 0; _i < 2; ++_i) \
        __builtin_amdgcn_global_load_lds((const unsigned*)((const char*)(gbase) + (voff)[_i]), (LAS unsigned*)(lds + (bufoff) + ldsw + _i * 8192), 16, 0, 0); } while (0)
#define PG8_LDA(dst, b, h) do { _Pragma("unroll") for (int m = 0; m < 4; ++m) _Pragma("unroll") for (int k = 0; k < 2; ++k) dst[m][k] = *(const LAS bf16x8*)(lds + PG8_SA(b, h) + aoff + m * 2048 + k * 1024); } while (0)
#define PG8_LDB(dst, b, h) do { _Pragma("unroll") for (int n = 0; n < 2; ++n) _Pragma("unroll") for (int k = 0; k < 2; ++k) dst[n][k] = *(const LAS bf16x8*)(lds + PG8_SB(b, h) + boff + n * 2048 + k * 1024); } while (0)
#define PG8_MMA(ai, bj, At, Bt) do { __builtin_amdgcn_s_setprio(1); _Pragma("unroll") for (int m = 0; m < 4; ++m) _Pragma("unroll") for (int n = 0; n < 2; ++n) _Pragma("unroll") for (int k = 0; k < 2; ++k) \
        acc[ai][bj][m][n] = __builtin_amdgcn_mfma_f32_16x16x32_bf16(Bt[n][k], At[m][k], acc[ai][bj][m][n], 0, 0, 0); __builtin_amdgcn_s_setprio(0); } while (0)
#define PG8_WAIT_V(n) asm volatile("s_waitcnt vmcnt(" #n ")" ::: "memory")
#define PG8_WAIT_L(n) asm volatile("s_waitcnt lgkmcnt(" #n ")" ::: "memory")
#define PG8_BAR __builtin_amdgcn_s_barrier()
#define PG8_SCHED __builtin_amdgcn_sched_barrier(0)
    Unit cur, nxt; int ui = 0;
    if (!S.next(0, cur)) return;
    f32x4 acc[2][2][4][2];
#pragma unroll
    for (int a = 0; a < 2; ++a)
#pragma unroll
        for (int b = 0; b < 2; ++b)
#pragma unroll
            for (int m = 0; m < 4; ++m)
#pragma unroll
                for (int n = 0; n < 2; ++n) acc[a][b][m][n] = (f32x4){0.f, 0.f, 0.f, 0.f};
    bf16x8 At[4][2], B0[2][2], B1[2][2];
    const char* cA = cur.a; const char* cB = cur.b;
    static_assert(SP2, "only the SP2 loop is kept");
    PG8_STAGE(PG8_SB(0, 0), cB, voffB); PG8_STAGE(PG8_SB(0, 1), cB + hstepB, voffB); PG8_STAGE(PG8_SA(0, 0), cA, voffA); PG8_STAGE(PG8_SA(0, 1), cA + hstepA, voffA);
    if (wr == 1) PG8_BAR;
    PG8_WAIT_V(2); PG8_BAR;
    PG8_STAGE(PG8_SB(1, 0), cB + kstepB, voffB); PG8_STAGE(PG8_SA(1, 0), cA + kstepA, voffA); PG8_STAGE(PG8_SB(1, 1), cB + hstepB + kstepB, voffB);
    PG8_WAIT_V(6); PG8_BAR;
    for (;;) {
        const bool has_next = S.next(ui + 1, nxt);
        const char* nA = has_next ? nxt.a : cA; const char* nB = has_next ? nxt.b : cB;
#pragma unroll 1
        for (int t = 0; t < nt; t += 2) {
            if constexpr (Epi::HAS_MID) { if (t == E.mid_t) { E.mid(acc, cur, wr, wc, fr, fq); PG8_SCHED; } }
            const bool last = (t == nt - 2);
            const char* a1 = cA + (size_t)(t + 1) * kstepA;
            const char* a2 = last ? nA : cA + (size_t)(t + 2) * kstepA; const char* b2 = last ? nB : cB + (size_t)(t + 2) * kstepB;
            const char* a3 = a2 + kstepA; const char* b3 = b2 + kstepB;
            PG8_LDB(B0, 0, 0); PG8_LDB(B1, 0, 1); PG8_SCHED; PG8_LDA(At, 0, 0); PG8_STAGE(PG8_SA(1, 1), a1 + hstepA, voffA);
            PG8_WAIT_V(8); PG8_WAIT_L(0); PG8_BAR; PG8_MMA(0, 0, At, B0); PG8_MMA(0, 1, At, B1); PG8_BAR; PG8_SCHED;
            PG8_LDA(At, 0, 1); PG8_STAGE(PG8_SB(0, 0), b2, voffB); PG8_STAGE(PG8_SB(0, 1), b2 + hstepB, voffB); PG8_STAGE(PG8_SA(0, 0), a2, voffA);
            PG8_WAIT_V(8); PG8_WAIT_L(0); PG8_BAR; PG8_MMA(1, 0, At, B0); PG8_MMA(1, 1, At, B1); PG8_BAR; PG8_SCHED;
            PG8_LDB(B0, 1, 0); PG8_LDB(B1, 1, 1); PG8_SCHED; PG8_LDA(At, 1, 0); PG8_STAGE(PG8_SA(0, 1), a2 + hstepA, voffA);
            PG8_WAIT_V(8); PG8_WAIT_L(0); PG8_BAR; PG8_MMA(0, 0, At, B0); PG8_MMA(0, 1, At, B1); PG8_BAR; PG8_SCHED;
            PG8_LDA(At, 1, 1); PG8_STAGE(PG8_SB(1, 0), b3, voffB); PG8_STAGE(PG8_SB(1, 1), b3 + hstepB, voffB); PG8_STAGE(PG8_SA(1, 0), a3, voffA);
            PG8_WAIT_V(8); PG8_WAIT_L(0); PG8_BAR; PG8_MMA(1, 0, At, B0); PG8_MMA(1, 1, At, B1); PG8_BAR; PG8_SCHED;
        }
        if constexpr (ALIGN_EPI) { if (wr == 0) PG8_BAR; }
        E(acc, cur, wr, wc, fr, fq);
        if (!has_next) break;
#pragma unroll
        for (int a = 0; a < 2; ++a)
#pragma unroll
            for (int b = 0; b < 2; ++b)
#pragma unroll
                for (int m = 0; m < 4; ++m)
#pragma unroll
                    for (int n = 0; n < 2; ++n) acc[a][b][m][n] = (f32x4){0.f, 0.f, 0.f, 0.f};
        cur = nxt; cA = nA; cB = nB; ++ui;
        if constexpr (ALIGN_EPI) { if (wr == 1) PG8_BAR; }
    }
    PG8_WAIT_V(0);
    if constexpr (!ALIGN_EPI) { if (wr == 0) PG8_BAR; }
    PG8_BAR;
#undef PG8_SA
#undef PG8_SB
#undef PG8_STAGE
#undef PG8_LDA
#undef PG8_LDB
#undef PG8_MMA
#undef PG8_WAIT_V
#undef PG8_WAIT_L
#undef PG8_BAR
#undef PG8_SCHED
}

template <class F> struct EpiGen8 {
    static constexpr bool PERM = true, HAS_MID = false; F f; int mid_t;
    __device__ __forceinline__ void mid(f32x4 (&)[2][2][4][2], const Unit&, int, int, int, int) const {}
    __device__ __forceinline__ void operator()(const f32x4 (&acc)[2][2][4][2], const Unit& u, int wr, int wc, int fr, int fq) const {
#pragma unroll
        for (int ai = 0; ai < 2; ++ai)
#pragma unroll
            for (int m = 0; m < 4; ++m) { const int r = ai * HALF + wr * 64 + m * 16 + fr;
#pragma unroll
                for (int bj = 0; bj < 2; ++bj) f(u, r, bj * HALF + wc * 32 + 8 * fq, acc[ai][bj][m][0], acc[ai][bj][m][1]);
                if constexpr (F::PIN) __builtin_amdgcn_sched_barrier(0); }
    }
};
}

typedef const float* cfp_t;
typedef __attribute__((address_space(4))) const cfp_t* InTab;
struct Frame {
    LAS unsigned char* lds;
    volatile LAS unsigned* MISC;
    gu32* ctl;
    int tid, lane, wave, vcu, G;
    unsigned char* ws; unsigned char* dout; unsigned char* ws0; unsigned char* dout0;
    InTab in;
};
enum { I_X = 0, I_NMPRE, I_NMPOST, I_NFPRE, I_NFPOST, I_WIN, I_BGATE, I_MU, I_W0, I_W2, I_A0, I_A2, I_G2, I_KK, I_KA, I_RK, I_LNW, I_LNB,
       I_SARE, I_SAIM, I_SBRE, I_SBIM, I_SCRE, I_SCIM, I_SD, I_SLOG, I_WGLU, I_BGLU, I_WBR, I_WBS, I_WOUT, I_WUP, I_CONVW, I_CONVB, I_WDN };

__device__ __forceinline__ void p0_transpose_item(const float* W, int ldw, int k0, int src0, bf16_t* WT, int ldt, int drow0, int koff, const float* kscale, LAS float* scr, int lane) {
    const int q = lane & 7, rb = lane >> 3;
    f32x4 v[8]; float sc[8];
#pragma unroll
    for (int i = 0; i < 8; ++i) { const int kk = 8 * i + rb; v[i] = __builtin_nontemporal_load((const f32x4*)(W + (size_t)(k0 + kk) * ldw + src0 + 4 * q)); sc[i] = kscale ? kscale[k0 + kk] : 1.0f; }
#pragma unroll
    for (int i = 0; i < 8; ++i) { const int kk = 8 * i + rb; LAS float* d = scr + kk * 33 + 4 * q; d[0] = v[i].x * sc[i]; d[1] = v[i].y * sc[i]; d[2] = v[i].z * sc[i]; d[3] = v[i].w * sc[i]; }
    LDS_WAIT(); asm volatile("" ::: "memory");
    const int c = lane & 7;
#pragma unroll
    for (int j = 0; j < 4; ++j) { const int n = (lane >> 3) + 8 * j; const LAS float* s = scr + (8 * c) * 33 + n;
        u32x4 o; o.x = cvt_pk_bf16(s[0 * 33], s[1 * 33]); o.y = cvt_pk_bf16(s[2 * 33], s[3 * 33]); o.z = cvt_pk_bf16(s[4 * 33], s[5 * 33]); o.w = cvt_pk_bf16(s[6 * 33], s[7 * 33]);
        *(GAS u32x4*)(WT + (size_t)(drow0 + n) * ldt + koff + k0 + 8 * c) = o; }
    LDS_WAIT(); asm volatile("" ::: "memory");
}
struct TrMat { int in_idx, K, N, ldt, koff, kind; size_t dst; int scale_idx; };
__device__ __forceinline__ void p0_do_matrix(Frame& F, const TrMat& mtx, int r, LAS float* scr) {
    const int nblk = mtx.N / 32, kb = r / nblk, nb = r % nblk;
    int src0 = 32 * nb;
    if (mtx.kind == 1) {
        const int pn = (32 * nb) >> 8, within = (32 * nb) & 255;
        src0 = (within < 128 ? 0 : FF - 128) + 128 * pn + within;
    }
    p0_transpose_item(F.in[mtx.in_idx], mtx.N, 64 * kb, src0, (bf16_t*)(F.ws + mtx.dst), mtx.ldt, 32 * nb, mtx.koff, mtx.scale_idx >= 0 ? F.in[mtx.scale_idx] : nullptr, scr, F.lane);
}
__device__ __forceinline__ void p0_s5_group(Frame& F, int g) {
    LAS float* pwr = (LAS float*)(F.lds);
    LAS float* pwi = pwr + 17 * 64;
    LAS float* bbr = pwi + 17 * 64;
    LAS float* bbi = bbr + 1024;
    LAS float* cre = bbi + 1024;
    LAS float* cim = cre + 1024;
    LAS float* kk = cim + 1024;
    const float dt = expf(F.in[I_SLOG][g]);
    for (int idx = F.tid; idx < 17 * 64; idx += 512) { const int k = idx >> 6, p = idx & 63;
        const float are = F.in[I_SARE][g * 64 + p], aim = F.in[I_SAIM][g * 64 + p];
        const float mag = expf((float)k * are * dt); float sn, cs; sincosf((float)k * aim * dt, &sn, &cs);
        pwr[idx] = mag * cs; pwi[idx] = mag * sn; }
    for (int idx = F.tid; idx < 1024; idx += 512) { cre[idx] = F.in[I_SCRE][g * 1024 + idx]; cim[idx] = F.in[I_SCIM][g * 1024 + idx]; }
    __syncthreads();
    for (int idx = F.tid; idx < 1024; idx += 512) { const int p = idx >> 4;
        const float are = F.in[I_SARE][g * 64 + p], aim = F.in[I_SAIM][g * 64 + p];
        const float nr = pwr[64 + p] - 1.0f, ni = pwi[64 + p];
        const float den = 1.0f / (are * are + aim * aim);
        const float qr = (nr * are + ni * aim) * den, qi = (ni * are - nr * aim) * den;
        const float br = F.in[I_SBRE][g * 1024 + idx], bi = F.in[I_SBIM][g * 1024 + idx];
        bbr[idx] = qr * br - qi * bi; bbi[idx] = qr * bi + qi * br; }
    __syncthreads();
    {
        const int kc = F.tid & 255, ph = F.tid >> 8, k = kc >> 4, c = kc & 15; float s[16];
#pragma unroll
        for (int e = 0; e < 16; ++e) s[e] = 0.f;
        for (int p = 32 * ph; p < 32 * ph + 32; ++p) { const float cr_ = cre[c * 64 + p], ci_ = cim[c * 64 + p], pr_ = pwr[k * 64 + p], pi_ = pwi[k * 64 + p];
            const float xr = cr_ * pr_ - ci_ * pi_, xi = cr_ * pi_ + ci_ * pr_;
#pragma unroll
            for (int e4 = 0; e4 < 4; ++e4) { const f32x4 br = *(LAS const f32x4*)(bbr + p * 16 + 4 * e4), bi = *(LAS const f32x4*)(bbi + p * 16 + 4 * e4);
#pragma unroll
                for (int e = 0; e < 4; ++e) s[4 * e4 + e] += xr * br[e] - xi * bi[e]; } }
        LAS float* part = kk + 4096;
        if (ph == 1) {
#pragma unroll
            for (int e4 = 0; e4 < 4; ++e4) *(LAS f32x4*)(part + kc * 16 + 4 * e4) = (f32x4){s[4 * e4], s[4 * e4 + 1], s[4 * e4 + 2], s[4 * e4 + 3]}; }
        __syncthreads();
        if (ph == 0) {
#pragma unroll
            for (int e4 = 0; e4 < 4; ++e4) { const f32x4 o = *(LAS const f32x4*)(part + kc * 16 + 4 * e4);
#pragma unroll
                for (int e = 0; e < 4; ++e) { float v = s[4 * e4 + e] + o[e]; if (k == 0 && c == 4 * e4 + e) v += F.in[I_SD][g * 16 + c]; kk[kc * 16 + 4 * e4 + e] = v; } } }
    }
    __syncthreads();
    bf16_t* B1b = (bf16_t*)(F.ws + WS_B1B) + (size_t)g * 256 * 384;
    for (int idx = F.tid; idx < 256 * 48; idx += 512) { const int n = idx / 48, j = idx - n * 48, t = n >> 4, c = n & 15; float v[8];
        if (j < 32) { const int tau = j >> 1, cp0 = (j & 1) * 8; const int ko = (t >= tau ? t - tau : 0) * 256 + c * 16 + cp0; const float m = (t >= tau) ? 1.f : 0.f;
            const f32x4 a0 = *(LAS const f32x4*)(kk + ko), a1 = *(LAS const f32x4*)(kk + ko + 4);
#pragma unroll
            for (int e = 0; e < 4; ++e) { v[e] = a0[e] * m; v[4 + e] = a1[e] * m; } }
        else { const int p0 = (j - 32) * 4; const f32x4 cr4 = *(LAS const f32x4*)(cre + c * 64 + p0), ci4 = *(LAS const f32x4*)(cim + c * 64 + p0), pr4 = *(LAS const f32x4*)(pwr + (t + 1) * 64 + p0), pi4 = *(LAS const f32x4*)(pwi + (t + 1) * 64 + p0);
#pragma unroll
            for (int q = 0; q < 4; ++q) { v[2 * q] = cr4[q] * pr4[q] - ci4[q] * pi4[q]; v[2 * q + 1] = -(cr4[q] * pi4[q] + ci4[q] * pr4[q]); } }
        *(u32x4*)(B1b + (size_t)n * 384 + 8 * j) = pack8(v); }
    bf16_t* B1a = (bf16_t*)(F.ws + WS_B1A) + (size_t)g * 256 * 256;
    for (int idx = F.tid; idx < 256 * 32; idx += 512) { const int n = idx >> 5, j = idx & 31; float v[8];
#pragma unroll
        for (int e = 0; e < 8; ++e) v[e] = 0.f;
        if (n < 128) { const int p = n >> 1, tau = j >> 1, cp0 = (j & 1) * 8; const float pr_ = pwr[(15 - tau) * 64 + p], pi_ = pwi[(15 - tau) * 64 + p];
            const f32x4 r0 = *(LAS const f32x4*)(bbr + p * 16 + cp0), r1 = *(LAS const f32x4*)(bbr + p * 16 + cp0 + 4), i0 = *(LAS const f32x4*)(bbi + p * 16 + cp0), i1 = *(LAS const f32x4*)(bbi + p * 16 + cp0 + 4);
#pragma unroll
            for (int e = 0; e < 8; ++e) { const float br = e < 4 ? r0[e & 3] : r1[e & 3], bi = e < 4 ? i0[e & 3] : i1[e & 3]; v[e] = (n & 1) ? (pr_ * bi + pi_ * br) : (pr_ * br - pi_ * bi); } }
        *(u32x4*)(B1a + (size_t)n * 256 + 8 * j) = pack8(v); }
    float* aL = (float*)(F.ws + WS_AL) + g * 128;
    if (F.tid < 64) { aL[2 * F.tid] = pwr[16 * 64 + F.tid]; aL[2 * F.tid + 1] = pwi[16 * 64 + F.tid]; }
    __syncthreads();
}
#define DO_MAT(in_idx, K_, N_, ldt_, koff_, kind_, dst_, sc_) do { const TrMat mtx{in_idx, K_, N_, ldt_, koff_, kind_, dst_, sc_}; const int items = ((K_) / 64) * ((N_) / 32); \
        for (int it = gw; it < base + items; it += NGW) { if (it >= base) p0_do_matrix(F, mtx, it - base, scr); } base += items; } while (0)
__device__ __forceinline__ void p0_late_mats(Frame& F, int gw, int NGW) {
    LAS float* scr = (LAS float*)(F.lds + F.wave * 16384);
    int base = 0;
    DO_MAT(I_WUP, D, 2 * FF, D, 0, 1, WS_WUP, I_NFPRE); DO_MAT(I_WDN, FF, D, FF, 0, 0, WS_WDN, -1); DO_MAT(I_WOUT, D, D, D, 0, 0, WS_WOUT, -1);
    DO_MAT(I_WBR, RW, D, D, 0, 0, WS_WBRS, -1); DO_MAT(I_WBS, RW, D, D, RW, 0, WS_WBRS, -1); DO_MAT(I_WGLU, RW, RW, RW, 0, 0, WS_WGLU, -1);
}
__device__ __forceinline__ void p0_prologue(Frame& F) {
    const bool s5wg = F.vcu < S5G && F.G > S5G;
    if (F.vcu < S5G) p0_s5_group(F, F.vcu);
    if (!s5wg) {
        LAS float* scr = (LAS float*)(F.lds + F.wave * 16384);
        const int gw = (F.G > S5G ? F.vcu - S5G : F.vcu) * NWAVES + F.wave, NGW = (F.G > S5G ? F.G - S5G : F.G) * NWAVES;
        int base = 0;
        DO_MAT(I_WIN, D, NIN, D, 0, 0, WS_WIN, I_NMPRE);
        DO_MAT(I_W2, 64, RW, 64, 0, 0, WS_W2T, -1); DO_MAT(I_A2, 64, RW, 64, 0, 0, WS_A2T, -1); DO_MAT(I_G2, 128, RW, 128, 0, 0, WS_G2T, -1);
    }
    {
        bf16_t* XN = (bf16_t*)(F.ws + WS_XN);
        const int nch = T / 4, split = (F.G > S5G) ? nch / 2 : 0;
#pragma unroll 1
        for (int pass = 0; pass < 2; ++pass) {
            if (pass == 0 && (s5wg || split == 0)) continue;
            const int lo = pass == 0 ? 0 : split, hi = pass == 0 ? split : nch;
            const int gw = (pass == 0 ? F.vcu - S5G : F.vcu) * NWAVES + F.wave, NGW = (pass == 0 ? F.G - S5G : F.G) * NWAVES;
#pragma unroll 1
            for (int ch = lo + gw; ch < hi; ch += NGW) {
                const int m = 4 * ch;
                f32x4 v[4][4]; float s[4];
#pragma unroll
                for (int q = 0; q < 4; ++q) { const GAS f32x4* xr = (const GAS f32x4*)(F.in[I_X] + (size_t)(m + q) * D) + F.lane;
#pragma unroll
                    for (int j = 0; j < 4; ++j) v[q][j] = __builtin_nontemporal_load((const f32x4*)(xr + 64 * j)); }
#pragma unroll
                for (int q = 0; q < 4; ++q) { s[q] = 0.f;
#pragma unroll
                    for (int j = 0; j < 4; ++j) s[q] += (v[q][j].x * v[q][j].x + v[q][j].y * v[q][j].y) + (v[q][j].z * v[q][j].z + v[q][j].w * v[q][j].w); }
#pragma unroll
                for (int q = 0; q < 4; ++q) { const float r = 1.0f / sqrtf(wave_sum(s[q]) * (1.f / D) + 1e-6f);
                    GAS u32x2* o = (GAS u32x2*)(XN + (size_t)(m + q) * D) + F.lane;
#pragma unroll
                    for (int j = 0; j < 4; ++j) { u32x2 w; w.x = cvt_pk_bf16(v[q][j].x * r, v[q][j].y * r); w.y = cvt_pk_bf16(v[q][j].z * r, v[q][j].w * r); o[64 * j] = w; } }
            }
        }
    }
}

struct EpiInProj {
    static constexpr bool PERM = true, HAS_MID = false;
    bf16_t* PR; bf16_t* UG; bf16_t* GT; const float* bg; int mid_t;
    __device__ __forceinline__ void mid(f32x4 (&)[2][2][4][2], const pg8::Unit&, int, int, int, int) const {}
    __device__ __forceinline__ void operator()(const f32x4 (&acc)[2][2][4][2], const pg8::Unit& u, int wr, int wc, int fr, int fq) const {
        f32x4 b0[2], b1[2];
        if (u.pn >= 9) {
#pragma unroll
            for (int bj = 0; bj < 2; ++bj) { const int gc = (u.pn - 9) * 256 + bj * 128 + wc * 32 + 8 * fq; b0[bj] = *(const f32x4*)(bg + gc); b1[bj] = *(const f32x4*)(bg + gc + 4); } }
#pragma unroll
        for (int ai = 0; ai < 2; ++ai)
#pragma unroll
            for (int m = 0; m < 4; ++m) { const int row = u.pm * 256 + ai * 128 + wr * 64 + m * 16 + fr;
#pragma unroll
                for (int bj = 0; bj < 2; ++bj) { const int cl = bj * 128 + wc * 32 + 8 * fq; const f32x4 v0 = acc[ai][bj][m][0], v1 = acc[ai][bj][m][1]; u32x4 w;
                    if (u.pn < 7) { w.x = cvt_pk_bf16(v0[0], v0[1]); w.y = cvt_pk_bf16(v0[2], v0[3]); w.z = cvt_pk_bf16(v1[0], v1[1]); w.w = cvt_pk_bf16(v1[2], v1[3]);
                        *(u32x4*)(PR + (size_t)row * NRW + u.pn * 256 + cl) = w; }
                    else if (u.pn < 9) { const int cr = (u.pn - 7) * 256 + cl, g = cr >> 4, c0 = cr & 15;
                        w.x = cvt_pk_bf16(v0[0], v0[1]); w.y = cvt_pk_bf16(v0[2], v0[3]); w.z = cvt_pk_bf16(v1[0], v1[1]); w.w = cvt_pk_bf16(v1[2], v1[3]);
                        *(u32x4*)(UG + ((size_t)g * S5ROWS + (row >> 4)) * UGLD + (row & 15) * 16 + c0) = w; }
                    else { const int gc = (u.pn - 9) * 256 + cl;
                        w.x = cvt_pk_bf16(fsigmoid(v0[0] + b0[bj][0]), fsigmoid(v0[1] + b0[bj][1])); w.y = cvt_pk_bf16(fsigmoid(v0[2] + b0[bj][2]), fsigmoid(v0[3] + b0[bj][3]));
                        w.z = cvt_pk_bf16(fsigmoid(v1[0] + b1[bj][0]), fsigmoid(v1[1] + b1[bj][1])); w.w = cvt_pk_bf16(fsigmoid(v1[2] + b1[bj][2]), fsigmoid(v1[3] + b1[bj][3]));
                        __builtin_nontemporal_store(w, (u32x4*)(GT + ((size_t)(u.pm * 8 + (u.pn - 9)) << 16) + (((wr * 4 + wc) * 16 + (ai * 4 + m) * 2 + bj) << 9) + (fq * 16 + fr) * 8)); } }
                __builtin_amdgcn_sched_barrier(0); }
    }
};
struct FS5Out {
    static constexpr bool PIN = true;
    bf16_t* YSP;
    __device__ __forceinline__ void operator()(const pg8::Unit& u, int r, int cl, f32x4 v0, f32x4 v1) const {
        const int crow = u.pm * 256 + r; u32x4 w;
        w.x = cvt_pk_bf16(fgelu(v0[0]), fgelu(v0[1])); w.y = cvt_pk_bf16(fgelu(v0[2]), fgelu(v0[3])); w.z = cvt_pk_bf16(fgelu(v1[0]), fgelu(v1[1])); w.w = cvt_pk_bf16(fgelu(v1[2]), fgelu(v1[3]));
        *(u32x4*)(YSP + ((size_t)u.pn * S5ROWS + crow) * 256 + cl) = w;
    }
};
struct EpiGlu {
    static constexpr bool PERM = true, HAS_MID = false;
    const bf16_t* YSP; bf16_t* YS; const float* bglu; int mid_t;
    __device__ __forceinline__ void mid(f32x4 (&)[2][2][4][2], const pg8::Unit&, int, int, int, int) const {}
    __device__ __forceinline__ void operator()(const f32x4 (&acc)[2][2][4][2], const pg8::Unit& u, int wr, int wc, int fr, int fq) const {
        u32x4 yv[2][4][2]; f32x4 b0[2], b1[2];
#pragma unroll
        for (int bj = 0; bj < 2; ++bj) { const int col = u.pn * 256 + bj * 128 + wc * 32 + 8 * fq; b0[bj] = *(const f32x4*)(bglu + col); b1[bj] = *(const f32x4*)(bglu + col + 4); }
#pragma unroll
        for (int ai = 0; ai < 2; ++ai)
#pragma unroll
            for (int m = 0; m < 4; ++m)
#pragma unroll
                for (int bj = 0; bj < 2; ++bj) { const int row = u.pm * 256 + ai * 128 + wr * 64 + m * 16 + fr, col = u.pn * 256 + bj * 128 + wc * 32 + 8 * fq;
                    yv[ai][m][bj] = __builtin_nontemporal_load((const u32x4*)(YSP + ((size_t)(col >> 4) * S5ROWS + (row >> 4)) * 256 + (row & 15) * 16 + (col & 15))); }
#pragma unroll
        for (int ai = 0; ai < 2; ++ai)
#pragma unroll
            for (int m = 0; m < 4; ++m) {
#pragma unroll
                for (int bj = 0; bj < 2; ++bj) { const int row = u.pm * 256 + ai * 128 + wr * 64 + m * 16 + fr, col = u.pn * 256 + bj * 128 + wc * 32 + 8 * fq; float y[8]; unpack8(yv[ai][m][bj], y);
                    const f32x4 v0 = acc[ai][bj][m][0], v1 = acc[ai][bj][m][1]; u32x4 w;
                    w.x = cvt_pk_bf16(y[0] * fsigmoid(v0[0] + b0[bj][0]), y[1] * fsigmoid(v0[1] + b0[bj][1])); w.y = cvt_pk_bf16(y[2] * fsigmoid(v0[2] + b0[bj][2]), y[3] * fsigmoid(v0[3] + b0[bj][3]));
                    w.z = cvt_pk_bf16(y[4] * fsigmoid(v1[0] + b1[bj][0]), y[5] * fsigmoid(v1[1] + b1[bj][1])); w.w = cvt_pk_bf16(y[6] * fsigmoid(v1[2] + b1[bj][2]), y[7] * fsigmoid(v1[3] + b1[bj][3]));
                    *(u32x4*)(YS + (size_t)row * D + RW + col) = w; }
                __builtin_amdgcn_sched_barrier(0); }
    }
};
struct FStore {
    static constexpr bool PIN = false;
    bf16_t* O; int ldc;
    __device__ __forceinline__ void operator()(const pg8::Unit& u, int r, int cl, f32x4 v0, f32x4 v1) const {
        u32x4 w; w.x = cvt_pk_bf16(v0[0], v0[1]); w.y = cvt_pk_bf16(v0[2], v0[3]); w.z = cvt_pk_bf16(v1[0], v1[1]); w.w = cvt_pk_bf16(v1[2], v1[3]);
        *(u32x4*)(O + (size_t)(u.pm * 256 + r) * ldc + u.pn * 256 + cl) = w;
    }
};
struct EpiMerge {
    static constexpr bool PERM = true, HAS_MID = true;
    const bf16_t* GT; bf16_t* O; int mid_t;
    __device__ __forceinline__ void mid(f32x4 (&acc)[2][2][4][2], const pg8::Unit& u, int wr, int wc, int fr, int fq) const {
        unsigned vo = (unsigned)((((wr * 4 + wc) * 16) << 9) + (fq * 16 + fr) * 8) * 2u; asm volatile("" : "+v"(vo));
        const char* gr = (const char*)(GT + ((size_t)(u.pm * 8 + u.pn) << 16)); const char* gs = (const char*)(GT + ((size_t)(u.pm * 8 + 4 + u.pn) << 16));
#pragma unroll
        for (int ai = 0; ai < 2; ++ai)
#pragma unroll
            for (int m = 0; m < 4; ++m) {
                u32x4 a[2], b[2];
#pragma unroll
                for (int bj = 0; bj < 2; ++bj) { const unsigned go = vo + (unsigned)((((ai * 4 + m) * 2 + bj) << 9) * 2); a[bj] = __builtin_nontemporal_load((const u32x4*)(gr + go)); b[bj] = __builtin_nontemporal_load((const u32x4*)(gs + go)); }
                __builtin_amdgcn_sched_barrier(0);
#pragma unroll
                for (int bj = 0; bj < 2; ++bj) {
                    const unsigned aw[4] = {a[bj].x, a[bj].y, a[bj].z, a[bj].w}, bw[4] = {b[bj].x, b[bj].y, b[bj].z, b[bj].w};
#pragma unroll
                    for (int h = 0; h < 4; ++h) {
                        acc[ai][bj][m][h >> 1][2 * (h & 1)] *= bf_lo(aw[h]) * __builtin_amdgcn_rcpf(bf_lo(bw[h]));
                        acc[ai][bj][m][h >> 1][2 * (h & 1) + 1] *= bf_hi(aw[h]) * __builtin_amdgcn_rcpf(bf_hi(bw[h])); } }
                __builtin_amdgcn_sched_barrier(0);
            }
    }
    __device__ __forceinline__ void operator()(const f32x4 (&acc)[2][2][4][2], const pg8::Unit& u, int wr, int wc, int fr, int fq) const {
        const size_t lo = ((size_t)((wr * 4 + wc) * 16) << 9) + (fq * 16 + fr) * 8;
        const bf16_t* gs = GT + ((size_t)(u.pm * 8 + 4 + u.pn) << 16) + lo;
        u32x4 gv[2][4][2];
#pragma unroll
        for (int ai = 0; ai < 2; ++ai)
#pragma unroll
            for (int m = 0; m < 4; ++m)
#pragma unroll
                for (int bj = 0; bj < 2; ++bj) gv[ai][m][bj] = __builtin_nontemporal_load((const u32x4*)(gs + (((ai * 4 + m) * 2 + bj) << 9)));
#pragma unroll
        for (int ai = 0; ai < 2; ++ai)
#pragma unroll
            for (int m = 0; m < 4; ++m) {
#pragma unroll
                for (int bj = 0; bj < 2; ++bj) { const int row = u.pm * 256 + ai * 128 + wr * 64 + m * 16 + fr, col = u.pn * 256 + bj * 128 + wc * 32 + 8 * fq; float g[8]; unpack8(gv[ai][m][bj], g);
                    const f32x4 v0 = acc[ai][bj][m][0], v1 = acc[ai][bj][m][1]; u32x4 w;
                    w.x = cvt_pk_bf16(v0[0] * g[0], v0[1] * g[1]); w.y = cvt_pk_bf16(v0[2] * g[2], v0[3] * g[3]); w.z = cvt_pk_bf16(v1[0] * g[4], v1[1] * g[5]); w.w = cvt_pk_bf16(v1[2] * g[6], v1[3] * g[7]);
                    *(u32x4*)(O + (size_t)row * D + col) = w; }
                __builtin_amdgcn_sched_barrier(0); }
    }
};
struct UpOrder {
    const bf16_t* H2; const bf16_t* Wt; int G, c;
    __device__ bool next(int i, pg8::Unit& u) const {
        constexpr int nM = NB * 16, nN = 22, nwg = nM * nN;
        const long L = (long)i * G + c; if (L >= nwg) return false;
        int wgid = (int)L; { const int q = nwg / 8, r = nwg % 8, xcd = wgid % 8, off = wgid / 8; wgid = (xcd < r ? xcd * (q + 1) : r * (q + 1) + (xcd - r) * q) + off; }
        const int nig = 8 * nN, gid = wgid / nig, fm = gid * 8, gsz = (nM - fm) < 8 ? (nM - fm) : 8;
        u.pm = fm + ((wgid % nig) % gsz); u.pn = (wgid % nig) / gsz;
        u.a = (const char*)H2 + ((size_t)u.pm * 256 * D) * 2; u.b = (const char*)(Wt + (size_t)u.pn * 256 * D); return true;
    }
};
template <int CTRL> __device__ __forceinline__ unsigned dppu(unsigned v) { return (unsigned)__builtin_amdgcn_update_dpp(0, (int)v, CTRL, 0xf, 0xf, true); }
template <int CTRL> __device__ __forceinline__ unsigned dppk(unsigned keep, unsigned v) { return (unsigned)__builtin_amdgcn_update_dpp((int)keep, (int)v, CTRL, 0xf, 0xf, false); }
struct EpiConvAct {
    static constexpr bool PERM = true, HAS_MID = false;
    bf16_t* ACT; const float* cw; const float* cb; LAS unsigned* EX; unsigned long long* HZ; unsigned* tmo; int mid_t;
    __device__ __forceinline__ void mid(f32x4 (&)[2][2][4][2], const pg8::Unit&, int, int, int, int) const {}
    __device__ __forceinline__ void operator()(f32x4 (&acc)[2][2][4][2], const pg8::Unit& u, int wr, int wc, int fr, int fq) const {
        const int b = u.pm >> 4, k = u.pm & 15, t0 = 256 * k;
        u32x2 zp[2][2][4][2];
#pragma unroll
        for (int ai = 0; ai < 2; ++ai)
#pragma unroll
            for (int bj = 0; bj < 2; ++bj)
#pragma unroll
                for (int m = 0; m < 4; ++m)
#pragma unroll
                    for (int n = 0; n < 2; ++n) { const f32x4 v = acc[ai][bj][m][n]; u32x2 w; w.x = cvt_pk_bf16(v[0], v[1]); w.y = cvt_pk_bf16(v[2], v[3]); zp[ai][bj][m][n] = w; }
        if (fr >= 14) {
#pragma unroll
            for (int ai = 0; ai < 2; ++ai)
#pragma unroll
                for (int bj = 0; bj < 2; ++bj)
#pragma unroll
                    for (int n = 0; n < 2; ++n) *(LAS u32x2*)(EX + (((wc * 4 + 2 * ai + wr) * 2 + (fr - 14)) * 32 + bj * 16 + fq * 4 + n * 2)) = zp[ai][bj][3][n]; }
        if (wr == 1 && k < 15 && fr >= 14) {
            unsigned long long* hz = HZ + ((size_t)(u.pm * 22 + u.pn) * 8 + wc * 2 + (fr - 14)) * 32;
#pragma unroll
            for (int bj = 0; bj < 2; ++bj)
#pragma unroll
                for (int n = 0; n < 2; ++n) { __hip_atomic_store(hz + bj * 16 + fq * 4 + n * 2, (1ull << 32) | zp[1][bj][3][n].x, RLX_AGENT); __hip_atomic_store(hz + bj * 16 + fq * 4 + n * 2 + 1, (1ull << 32) | zp[1][bj][3][n].y, RLX_AGENT); }
        }
        asm volatile("s_waitcnt lgkmcnt(0)" ::: "memory"); __builtin_amdgcn_s_barrier(); asm volatile("" ::: "memory");
        const int ch0 = u.pn * 128 + wc * 32 + 8 * fq;
        f32x4 wg[2][3], wv[2][3], bg[2], bv[2];
#pragma unroll
        for (int n = 0; n < 2; ++n) {
#pragma unroll
            for (int j = 0; j < 3; ++j) { wg[n][j] = *(const f32x4*)(cw + (size_t)j * 2 * FF + ch0 + 4 * n); wv[n][j] = *(const f32x4*)(cw + (size_t)j * 2 * FF + FF + ch0 + 4 * n); }
            bg[n] = *(const f32x4*)(cb + ch0 + 4 * n); bv[n] = *(const f32x4*)(cb + FF + ch0 + 4 * n); }
#pragma unroll
        for (int gi = 1; gi <= 8; ++gi) {
            const int ai = (gi & 7) >> 2, m = gi & 3, blk = 2 * ai + wr;
            u32x2 pp[2][2];
#pragma unroll
            for (int bj = 0; bj < 2; ++bj)
#pragma unroll
                for (int n = 0; n < 2; ++n) { pp[bj][n].x = 0u; pp[bj][n].y = 0u; }
            if (m > 0) {
#pragma unroll
                for (int bj = 0; bj < 2; ++bj)
#pragma unroll
                    for (int n = 0; n < 2; ++n) pp[bj][n] = zp[ai][bj][m - 1][n];
            } else if (blk > 0) {
                if (fr >= 14) {
#pragma unroll
                    for (int bj = 0; bj < 2; ++bj)
#pragma unroll
                        for (int n = 0; n < 2; ++n) pp[bj][n] = *(LAS const u32x2*)(EX + (((wc * 4 + blk - 1) * 2 + (fr - 14)) * 32 + bj * 16 + fq * 4 + n * 2)); }
            } else if (k > 0) {
                if (fr >= 14) {
                    const unsigned long long* hz = HZ + ((size_t)((u.pm - 1) * 22 + u.pn) * 8 + wc * 2 + (fr - 14)) * 32;
#pragma unroll
                    for (int bj = 0; bj < 2; ++bj)
#pragma unroll
                        for (int n = 0; n < 2; ++n) { unsigned long long x0, x1; unsigned sp_ = 0;
                            for (;;) { x0 = __hip_atomic_load(hz + bj * 16 + fq * 4 + n * 2, RLX_AGENT); x1 = __hip_atomic_load(hz + bj * 16 + fq * 4 + n * 2 + 1, RLX_AGENT);
                                if ((x0 >> 32) == 1ull && (x1 >> 32) == 1ull) break; __builtin_amdgcn_s_sleep(2); if (++sp_ > (1u << 20)) { __hip_atomic_store(tmo, 1u, RLX_AGENT); break; } }
                            pp[bj][n].x = (unsigned)x0; pp[bj][n].y = (unsigned)x1; } }
            }
            u32x2 outp[2];
#pragma unroll
            for (int n = 0; n < 2; ++n) {
                const u32x2 zg = zp[ai][0][m][n], zv = zp[ai][1][m][n], pg = pp[0][n], pv = pp[1][n];
                u32x2 g1, g2, v1, v2;
                g1.x = dppk<0x111>(dppu<0x10F>(pg.x), zg.x); g1.y = dppk<0x111>(dppu<0x10F>(pg.y), zg.y); g2.x = dppk<0x112>(dppu<0x10E>(pg.x), zg.x); g2.y = dppk<0x112>(dppu<0x10E>(pg.y), zg.y);
                v1.x = dppk<0x111>(dppu<0x10F>(pv.x), zv.x); v1.y = dppk<0x111>(dppu<0x10F>(pv.y), zv.y); v2.x = dppk<0x112>(dppu<0x10E>(pv.x), zv.x); v2.y = dppk<0x112>(dppu<0x10E>(pv.y), zv.y);
                f32x2 o2[2];
#pragma unroll
                for (int e = 0; e < 2; ++e) {
                    const unsigned w0g = e ? zg.y : zg.x, w1g = e ? g1.y : g1.x, w2g = e ? g2.y : g2.x, w0v = e ? zv.y : zv.x, w1v = e ? v1.y : v1.x, w2v = e ? v2.y : v2.x;
                    const f32x2 z0g = {bf_lo(w0g), bf_hi(w0g)}, z1g = {bf_lo(w1g), bf_hi(w1g)}, z2g = {bf_lo(w2g), bf_hi(w2g)}, z0v = {bf_lo(w0v), bf_hi(w0v)}, z1v = {bf_lo(w1v), bf_hi(w1v)}, z2v = {bf_lo(w2v), bf_hi(w2v)};
                    const f32x2 kg0 = {wg[n][0][2 * e], wg[n][0][2 * e + 1]}, kg1 = {wg[n][1][2 * e], wg[n][1][2 * e + 1]}, kg2 = {wg[n][2][2 * e], wg[n][2][2 * e + 1]}, kb = {bg[n][2 * e], bg[n][2 * e + 1]};
                    const f32x2 kv0 = {wv[n][0][2 * e], wv[n][0][2 * e + 1]}, kv1 = {wv[n][1][2 * e], wv[n][1][2 * e + 1]}, kv2 = {wv[n][2][2 * e], wv[n][2][2 * e + 1]}, kc = {bv[n][2 * e], bv[n][2 * e + 1]};
                    const f32x2 cg = kb + kg0 * z2g + kg1 * z1g + kg2 * z0g, cv = kc + kv0 * z2v + kv1 * z1v + kv2 * z0v;
                    const f32x2 t = cg * cg, q = t * (f32x2){-0.1029432f, -0.1029432f} + (f32x2){-2.3022082f, -2.3022082f}, pw = cg * q;
                    const f32x2 ex = {__builtin_amdgcn_exp2f(pw.x), __builtin_amdgcn_exp2f(pw.y)}, dn = ex + (f32x2){1.f, 1.f};
                    const f32x2 rc = {__builtin_amdgcn_rcpf(dn.x), __builtin_amdgcn_rcpf(dn.y)};
                    o2[e] = (cg * cv) * rc; }
                const float o[4] = {o2[0].x, o2[0].y, o2[1].x, o2[1].y};
                outp[n].x = cvt_pk_bf16(o[0], o[1]); outp[n].y = cvt_pk_bf16(o[2], o[3]);
            }
            const int r = 128 * ai + 64 * wr + 16 * m + fr;
            { u32x4 w4; w4.x = outp[0].x; w4.y = outp[0].y; w4.z = outp[1].x; w4.w = outp[1].y; *(u32x4*)(ACT + ((size_t)(b * SEQ + t0 + r)) * FF + ch0) = w4; }
            __builtin_amdgcn_sched_barrier(0);
        }
    }
};
struct EpiRowStat {
    static constexpr bool PERM = true, HAS_MID = false; bf16_t* O; float* STAT; int mid_t;
    __device__ __forceinline__ void mid(f32x4 (&)[2][2][4][2], const pg8::Unit&, int, int, int, int) const {}
    __device__ __forceinline__ void operator()(const f32x4 (&acc)[2][2][4][2], const pg8::Unit& u, int wr, int wc, int fr, int fq) const {
#pragma unroll
        for (int ai = 0; ai < 2; ++ai)
#pragma unroll
            for (int m = 0; m < 4; ++m) { const int row = u.pm * 256 + ai * 128 + wr * 64 + m * 16 + fr; float s = 0.f;
#pragma unroll
                for (int bj = 0; bj < 2; ++bj) { const int col = u.pn * 256 + bj * 128 + wc * 32 + 8 * fq; const f32x4 v0 = acc[ai][bj][m][0], v1 = acc[ai][bj][m][1]; u32x4 w;
                    s += (v0[0] * v0[0] + v0[1] * v0[1]) + (v0[2] * v0[2] + v0[3] * v0[3]) + (v1[0] * v1[0] + v1[1] * v1[1]) + (v1[2] * v1[2] + v1[3] * v1[3]);
                    w.x = cvt_pk_bf16(v0[0], v0[1]); w.y = cvt_pk_bf16(v0[2], v0[3]); w.z = cvt_pk_bf16(v1[0], v1[1]); w.w = cvt_pk_bf16(v1[2], v1[3]);
                    __builtin_nontemporal_store(w, (u32x4*)(O + (size_t)row * D + col)); }
                s += __shfl_xor(s, 16); s += __shfl_xor(s, 32);
                if (fq == 0) STAT[(size_t)row * 16 + u.pn * 4 + wc] = s; }
    }
};
struct EpiSloc {
    static constexpr bool PERM = false, HAS_MID = false; float* SL; int mid_t;
    __device__ __forceinline__ void mid(f32x4 (&)[2][2][4][2], const pg8::Unit&, int, int, int, int) const {}
    __device__ __forceinline__ void operator()(const f32x4 (&acc)[2][2][4][2], const pg8::Unit& u, int wr, int wc, int fr, int fq) const {
#pragma unroll
        for (int ai = 0; ai < 2; ++ai)
#pragma unroll
            for (int m = 0; m < 4; ++m) { const int row = u.pm * 256 + ai * 128 + wr * 64 + m * 16 + fr; float* p = SL + ((size_t)u.pn * S5ROWS + row) * 128 + wc * 32 + 4 * fq;
                *(f32x4*)(p) = acc[ai][0][m][0]; *(f32x4*)(p + 16) = acc[ai][0][m][1]; }
    }
};
struct EpiSlocLds {
    static constexpr bool PERM = false, HAS_MID = false; LAS float* SL; int mid_t;
    __device__ __forceinline__ void mid(f32x4 (&)[2][2][4][2], const pg8::Unit&, int, int, int, int) const {}
    __device__ __forceinline__ void operator()(const f32x4 (&acc)[2][2][4][2], const pg8::Unit&, int wr, int wc, int fr, int fq) const {
        asm volatile("s_waitcnt vmcnt(0)" ::: "memory"); __builtin_amdgcn_s_barrier(); asm volatile("" ::: "memory");
#pragma unroll
        for (int ai = 0; ai < 2; ++ai)
#pragma unroll
            for (int m = 0; m < 4; ++m) { const int row = ai * 128 + wr * 64 + m * 16 + fr;
#pragma unroll
                for (int n = 0; n < 2; ++n) *(LAS f32x4*)(SL + row * 128 + (((wc * 8 + 4 * n + fq) ^ (row & 15)) << 2)) = acc[ai][0][m][n]; }
    }
};
struct S5One {
    const bf16_t* UG; const bf16_t* Bt; int ldb, gb;
    __device__ bool next(int i, pg8::Unit& u) const { if (i > 0) return false; const int g = gb >> 3; u.pm = gb & 7; u.pn = g;
        u.a = (const char*)(UG + ((size_t)g * S5ROWS + u.pm * 256) * UGLD); u.b = (const char*)(Bt + (size_t)g * 256 * ldb); return true; }
};
struct S5Order {
    const bf16_t* UG; const bf16_t* Bt; int ldb, G, c;
    __device__ bool next(int i, pg8::Unit& u) const { const int L = i * G + c; if (L >= S5G * 8) return false; const int g = L >> 3; u.pm = L & 7; u.pn = g;
        u.a = (const char*)(UG + ((size_t)g * S5ROWS + u.pm * 256) * UGLD); u.b = (const char*)(Bt + (size_t)g * 256 * ldb); return true; }
};

constexpr int LW = 72;
constexpr int SLOT = 64 * LW * 2;
#define SL(i) ((i) * SLOT)
#define BAR_LDS() do { asm volatile("s_waitcnt lgkmcnt(0)" ::: "memory"); __builtin_amdgcn_s_barrier(); asm volatile("" ::: "memory"); } while (0)
struct LdsMat { LAS const unsigned char* p; int ld; __device__ __forceinline__ bf16x8 frag(int row, int k) const { return *(LAS const bf16x8*)(p + ((size_t)row * ld + k) * 2); } };
struct GlbMat { const bf16_t* p; int ld; __device__ __forceinline__ bf16x8 frag(int row, int k) const { return *(const bf16x8*)(p + (size_t)row * ld + k); } };
template <int KD, class YM, class XM, class EPI>
__device__ __forceinline__ void mm64(const YM& Y, const XM& X, int wid, int lane, const EPI& epi) {
    asm volatile("" : "+v"(lane), "+s"(wid));
    const int at = wid >> 1, bt0 = (wid & 1) * 2, fr = lane & 15, fq = lane >> 4;
    f32x4 acc[2] = {(f32x4){0.f, 0.f, 0.f, 0.f}, (f32x4){0.f, 0.f, 0.f, 0.f}};
#pragma unroll
    for (int s = 0; s < KD / 32; ++s) {
        const bf16x8 yf = Y.frag(16 * at + fr, 32 * s + 8 * fq);
#pragma unroll
        for (int bi = 0; bi < 2; ++bi) { const bf16x8 xf = X.frag(16 * (bt0 + bi) + fr, 32 * s + 8 * fq);
            acc[bi] = __builtin_amdgcn_mfma_f32_16x16x32_bf16(xf, yf, acc[bi], 0, 0, 0); }
    }
#pragma unroll
    for (int bi = 0; bi < 2; ++bi) epi(16 * at + fr, 16 * (bt0 + bi) + 4 * fq, acc[bi]);
}
__device__ __forceinline__ void ld_yf(const LdsMat& Y, int at, int fr, int fq, bf16x8 (&y)[2]) {
#pragma unroll
    for (int s = 0; s < 2; ++s) y[s] = Y.frag(16 * at + fr, 32 * s + 8 * fq);
}
__device__ __forceinline__ void ld_xf(const LdsMat& X, int bt0, int fr, int fq, bf16x8 (&x)[2][2]) {
#pragma unroll
    for (int s = 0; s < 2; ++s)
#pragma unroll
        for (int bi = 0; bi < 2; ++bi) x[s][bi] = X.frag(16 * (bt0 + bi) + fr, 32 * s + 8 * fq);
}
__device__ __forceinline__ void mm_f(const bf16x8 (&y)[2], const bf16x8 (&x)[2][2], f32x4 (&acc)[2]) {
#pragma unroll
    for (int bi = 0; bi < 2; ++bi) acc[bi] = (f32x4){0.f, 0.f, 0.f, 0.f};
#pragma unroll
    for (int s = 0; s < 2; ++s)
#pragma unroll
        for (int bi = 0; bi < 2; ++bi) acc[bi] = __builtin_amdgcn_mfma_f32_16x16x32_bf16(x[s][bi], y[s], acc[bi], 0, 0, 0);
}
template <int KD>
__device__ __forceinline__ void preload_x(const GlbMat& X, int wid, int lane, bf16x8 (&xf)[KD / 32][2]) {
    const int bt0 = (wid & 1) * 2, fr = lane & 15, fq = lane >> 4;
#pragma unroll
    for (int s = 0; s < KD / 32; ++s)
#pragma unroll
        for (int bi = 0; bi < 2; ++bi) xf[s][bi] = X.frag(16 * (bt0 + bi) + fr, 32 * s + 8 * fq);
}
template <int KD, class YM, class EPI>
__device__ __forceinline__ void mm64_pre(const YM& Y, const bf16x8 (&xf)[KD / 32][2], int wid, int lane, const EPI& epi) {
    const int at = wid >> 1, bt0 = (wid & 1) * 2, fr = lane & 15, fq = lane >> 4;
    f32x4 acc[2] = {(f32x4){0.f, 0.f, 0.f, 0.f}, (f32x4){0.f, 0.f, 0.f, 0.f}};
#pragma unroll
    for (int s = 0; s < KD / 32; ++s) {
        const bf16x8 yf = Y.frag(16 * at + fr, 32 * s + 8 * fq);
#pragma unroll
        for (int bi = 0; bi < 2; ++bi) acc[bi] = __builtin_amdgcn_mfma_f32_16x16x32_bf16(xf[s][bi], yf, acc[bi], 0, 0, 0);
    }
#pragma unroll
    for (int bi = 0; bi < 2; ++bi) epi(16 * at + fr, 16 * (bt0 + bi) + 4 * fq, acc[bi]);
}
__device__ __forceinline__ void st_lds4(LAS unsigned char* base, int a, int b0, f32x4 v) { u32x2 w; w.x = cvt_pk_bf16(v[0], v[1]); w.y = cvt_pk_bf16(v[2], v[3]); *(LAS u32x2*)(base + ((size_t)a * LW + b0) * 2) = w; }
__device__ __forceinline__ f32x4 ld_lds4(LAS const unsigned char* base, int a, int b0) { const u32x2 w = *(LAS const u32x2*)(base + ((size_t)a * LW + b0) * 2); return (f32x4){bf_lo(w.x), bf_hi(w.x), bf_lo(w.y), bf_hi(w.y)}; }
__device__ __forceinline__ void st_glb4p(bf16_t* base, int a, int b0, f32x4 v) { u32x2 w; w.x = cvt_pk_bf16(v[0], v[1]); w.y = cvt_pk_bf16(v[2], v[3]); __builtin_nontemporal_store(w, (u32x2*)(base + (size_t)a * GLD + b0)); }
__device__ __forceinline__ void st_glb4(bf16_t* base, int a, int b0, f32x4 v) { u32x2 w; w.x = cvt_pk_bf16(v[0], v[1]); w.y = cvt_pk_bf16(v[2], v[3]); __builtin_nontemporal_store(w, (u32x2*)(base + (size_t)a * 64 + b0)); }

struct PrePf { u32x4 qa[3], qp[3], ra[4], rp[4], wt[4]; };
template <int PART>
__device__ __forceinline__ void rwkv_pre_fetch(Frame& F, int unit, bool lr_first, PrePf& P, int tid) {
    const int bh = unit >> 6, c = unit & 63, b = bh >> 3, h = bh & 7;
    const int t = tid >> 3, jb = tid & 7, j0 = jb * 8;
    const int tg = b * SEQ + c * 64 + t;
    const bool hasprev = (c * 64 + t) > 0;
    const bf16_t* prow = (const bf16_t*)(F.ws + WS_PR) + (size_t)tg * NRW; const bf16_t* pprv = hasprev ? prow - NRW : prow;
    if constexpr (PART != 1) {
#pragma unroll
        for (int seg = 0; seg < 3; ++seg) { const int col = seg * 512 + h * 64 + j0; P.qa[seg] = *(const u32x4*)(prow + col); P.qp[seg] = *(const u32x4*)(pprv + col); }
    }
    if constexpr (PART == 0) return;
    const u32x4* scr = (const u32x4*)(F.ws + WS_LRSCR) + ((size_t)F.vcu * 512 + tid) * 4;
    const u32x4* pa = lr_first ? (const u32x4*)(prow + 1536 + jb * 32) : scr; const u32x4* pp = lr_first ? (const u32x4*)(pprv + 1536 + jb * 32) : scr;
#pragma unroll
    for (int q4 = 0; q4 < 4; ++q4) { P.ra[q4] = pa[q4]; P.rp[q4] = pp[q4]; }
    P.wt[0] = ((const u32x4*)(F.ws + WS_W2T) + (size_t)h * 512)[tid]; P.wt[1] = ((const u32x4*)(F.ws + WS_A2T) + (size_t)h * 512)[tid];
    P.wt[2] = ((const u32x4*)(F.ws + WS_G2T) + (size_t)h * 1024)[tid]; P.wt[3] = ((const u32x4*)(F.ws + WS_G2T) + (size_t)h * 1024)[512 + tid];
}
__device__ __forceinline__ void rwkv_pre_put_w(LAS unsigned char* L, const PrePf& P, int tid) {
    const int r8 = tid >> 3, c8 = tid & 7, r16 = tid >> 4, c16 = tid & 15;
    *(LAS u32x4*)(L + SL(10) + ((size_t)r8 * LW + c8 * 8) * 2) = P.wt[0]; *(LAS u32x4*)(L + SL(11) + ((size_t)r8 * LW + c8 * 8) * 2) = P.wt[1];
    *(LAS u32x4*)(L + SL(12) + ((size_t)r16 * 136 + c16 * 8) * 2) = P.wt[2]; *(LAS u32x4*)(L + SL(12) + ((size_t)(32 + r16) * 136 + c16 * 8) * 2) = P.wt[3];
}
__device__ __forceinline__ void rwkv_pre_unit(Frame& F, int unit, int next_unit, bool lr_first, bool next_first, PrePf& P) {
    LAS unsigned char* L = F.lds;
    LAS float* XT = (LAS float*)(F.lds + XTRA_OFF);
    int tid = F.tid; asm volatile("" : "+v"(tid));
    int wid = F.wave; asm volatile("" : "+s"(wid));
    const int lane = tid & 63;
    const int bh = unit >> 6, c = unit & 63, b = bh >> 3, h = bh & 7;
    const int t = tid >> 3, jb = tid & 7, j0 = jb * 8;
    const int tg = b * SEQ + c * 64 + t;
    const bool hasprev = (c * 64 + t) > 0;
    const bf16_t* PR = (const bf16_t*)(F.ws + WS_PR);
    const bf16_t* prow = PR + (size_t)tg * NRW; const bf16_t* pprev = prow - NRW;
    LAS const float* mu = (LAS const float*)(F.lds + XTRA_OFF + 4096);
    LAS const float* par = mu + NRW;
    float rs[8], ks[8], vs[8];
    {
        const int c0 = 1536 + jb * 32;
        const float pmask = hasprev ? 1.f : 0.f;
        f32x4 mq[3][2];
#pragma unroll
        for (int seg = 0; seg < 3; ++seg) { const int col = seg * 512 + h * 64 + j0; mq[seg][0] = *(LAS const f32x4*)(mu + col); mq[seg][1] = *(LAS const f32x4*)(mu + col + 4); }
        LAS unsigned char* dst = (jb < 2) ? (L + SL(0) + ((size_t)t * LW + jb * 32) * 2) : (jb < 4) ? (L + SL(1) + ((size_t)t * LW + (jb - 2) * 32) * 2) : (L + SL(2) + ((size_t)t * 136 + (jb - 4) * 32) * 2);
        u32x4* scr = (u32x4*)(F.ws + WS_LRSCR) + ((size_t)F.vcu * 512 + tid) * 4;
        if (lr_first) {
            f32x4 ma[4][2];
#pragma unroll
            for (int q4 = 0; q4 < 4; ++q4) { ma[q4][0] = *(LAS const f32x4*)(mu + c0 + q4 * 8); ma[q4][1] = *(LAS const f32x4*)(mu + c0 + q4 * 8 + 4); }
#pragma unroll
            for (int q4 = 0; q4 < 4; ++q4) { float x[8], xp[8], o[8]; unpack8(P.ra[q4], x); unpack8(P.rp[q4], xp);
#pragma unroll
                for (int e = 0; e < 8; ++e) { const float mm = e < 4 ? ma[q4][0][e] : ma[q4][1][e - 4]; const float s = x[e] + (xp[e] * pmask - x[e]) * mm;
                    const float ex = __builtin_amdgcn_exp2f((jb < 2 ? 2.88539008178f : -1.44269504089f) * s), rc = __builtin_amdgcn_rcpf(1.0f + ex);
                    o[e] = jb < 2 ? 1.0f - 2.0f * rc : (jb < 4 ? s : rc); }
                const u32x4 w = pack8(o); *(LAS u32x4*)(dst + q4 * 16) = w; scr[q4] = w; }
        } else {
#pragma unroll
            for (int q4 = 0; q4 < 4; ++q4) *(LAS u32x4*)(dst + q4 * 16) = P.ra[q4];
        }
#pragma unroll
        for (int seg = 0; seg < 3; ++seg) { float x[8], xp[8]; unpack8(P.qa[seg], x); unpack8(P.qp[seg], xp);
#pragma unroll
            for (int e = 0; e < 8; ++e) { const float mm = e < 4 ? mq[seg][0][e] : mq[seg][1][e - 4]; const float s = x[e] + (xp[e] * pmask - x[e]) * mm; if (seg == 0) rs[e] = s; else if (seg == 1) ks[e] = s; else vs[e] = s; } }
    }
    BAR_LDS();
    if (next_unit < NUNIT) rwkv_pre_fetch<0>(F, next_unit, next_first, P, tid);
    {
        const LdsMat Yw{L + SL(0), LW}, Ya{L + SL(1), LW}, Yg{L + SL(2), 136};
        const LdsMat Xw{L + SL(10), LW}, Xa{L + SL(11), LW}, Xg{L + SL(12), 136};
        mm64<64>(Yw, Xw, wid, lane, [&](int a, int b0, f32x4 v) { *(LAS f32x4*)(L + SL(4) + ((size_t)a * 68 + b0) * 4) = v; });
        mm64<64>(Ya, Xa, wid, lane, [&](int a, int b0, f32x4 v) { *(LAS f32x4*)(L + SL(6) + ((size_t)a * 68 + b0) * 4) = v; });
        mm64<128>(Yg, Xg, wid, lane, [&](int a, int b0, f32x4 v) { *(LAS f32x4*)(L + SL(8) + ((size_t)a * 68 + b0) * 4) = v; });
    }
    BAR_LDS();
    float ld[8], kp[8], av[8], bv[8];
    {
        const int hc = h * 64 + j0;
        float wp[8], ap[8], gg[8], w0[8], a0[8], kkw[8], kaw[8], rk[8];
        *(f32x4*)&wp[0] = *(LAS f32x4*)(L + SL(4) + ((size_t)t * 68 + j0) * 4); *(f32x4*)&wp[4] = *(LAS f32x4*)(L + SL(4) + ((size_t)t * 68 + j0 + 4) * 4);
        *(f32x4*)&ap[0] = *(LAS f32x4*)(L + SL(6) + ((size_t)t * 68 + j0) * 4); *(f32x4*)&ap[4] = *(LAS f32x4*)(L + SL(6) + ((size_t)t * 68 + j0 + 4) * 4);
        *(f32x4*)&gg[0] = *(LAS f32x4*)(L + SL(8) + ((size_t)t * 68 + j0) * 4); *(f32x4*)&gg[4] = *(LAS f32x4*)(L + SL(8) + ((size_t)t * 68 + j0 + 4) * 4);
        *(f32x4*)&w0[0] = *(LAS const f32x4*)(par + 0 + hc); *(f32x4*)&w0[4] = *(LAS const f32x4*)(par + 0 + hc + 4);
        *(f32x4*)&a0[0] = *(LAS const f32x4*)(par + 512 + hc); *(f32x4*)&a0[4] = *(LAS const f32x4*)(par + 512 + hc + 4);
        *(f32x4*)&kkw[0] = *(LAS const f32x4*)(par + 1024 + hc); *(f32x4*)&kkw[4] = *(LAS const f32x4*)(par + 1024 + hc + 4);
        *(f32x4*)&kaw[0] = *(LAS const f32x4*)(par + 1536 + hc); *(f32x4*)&kaw[4] = *(LAS const f32x4*)(par + 1536 + hc + 4);
        *(f32x4*)&rk[0] = *(LAS const f32x4*)(par + 2048 + hc); *(f32x4*)&rk[4] = *(LAS const f32x4*)(par + 2048 + hc + 4);
        float ss = 0.f, bon = 0.f, kkv[8], eta[8];
#pragma unroll
        for (int e = 0; e < 8; ++e) {
            ld[e] = -0.60653065971f * fsigmoid(w0[e] + wp[e]);
            eta[e] = fsigmoid(a0[e] + ap[e]);
            kkv[e] = ks[e] * kkw[e]; ss += kkv[e] * kkv[e];
            kp[e] = ks[e] * (1.0f + (eta[e] - 1.0f) * kaw[e]);
            bon += rs[e] * kp[e] * rk[e];
        }
        ss += __shfl_xor(ss, 1); ss += __shfl_xor(ss, 2); ss += __shfl_xor(ss, 4);
        bon += __shfl_xor(bon, 1); bon += __shfl_xor(bon, 2); bon += __shfl_xor(bon, 4);
        const float inv = __builtin_amdgcn_rcpf(fmaxf(__builtin_amdgcn_sqrtf(ss), 1e-12f));
#pragma unroll
        for (int e = 0; e < 8; ++e) { const float kk = kkv[e] * inv; av[e] = -kk; bv[e] = kk * eta[e]; }
        if (jb == 0) ((float*)(F.ws + WS_BONUS))[(size_t)tg * 8 + h] = bon;
        *(u32x4*)((bf16_t*)(F.ws + WS_GBUF) + (size_t)tg * RW + hc) = pack8(gg);
    }
    float Lc[8];
#pragma unroll
    for (int e = 0; e < 8; ++e) { float x = ld[e];
        float y = __shfl_up(x, 8); if (lane >= 8) x += y;
        y = __shfl_up(x, 16); if (lane >= 16) x += y;
        y = __shfl_up(x, 32); if (lane >= 32) x += y;
        Lc[e] = x; }
    if (lane >= 56) {
#pragma unroll
        for (int e = 0; e < 8; ++e) XT[wid * 64 + j0 + e] = Lc[e]; }
    BAR_LDS();
    {
        float pre[8];
#pragma unroll
        for (int e = 0; e < 8; ++e) pre[e] = 0.f;
#pragma unroll
        for (int w = 0; w < 7; ++w) if (w < wid) { const f32x4 x0 = *(LAS const f32x4*)(XT + w * 64 + j0), x1 = *(LAS const f32x4*)(XT + w * 64 + j0 + 4);
#pragma unroll
            for (int e = 0; e < 4; ++e) { pre[e] += x0[e]; pre[4 + e] += x1[e]; } }
#pragma unroll
        for (int e = 0; e < 8; ++e) Lc[e] += pre[e];
    }
    if (t == 63) {
#pragma unroll
        for (int e = 0; e < 8; ++e) XT[512 + j0 + e] = fexp(Lc[e]); }
    {
        float o0[8], o1[8], o2[8], o3[8];
#pragma unroll
        for (int e = 0; e < 8; ++e) { const float ein = fexp(Lc[e]), eout = __builtin_amdgcn_rcpf(ein), eex = fexp(Lc[e] - ld[e]);
            o0[e] = rs[e] * ein; o1[e] = kp[e] * eout; o2[e] = av[e] * eex; o3[e] = bv[e] * eout; }
        const size_t off = ((size_t)t * LW + j0) * 2;
        *(LAS u32x4*)(L + SL(10) + off) = pack8(o0); *(LAS u32x4*)(L + SL(11) + off) = pack8(o1); *(LAS u32x4*)(L + SL(12) + off) = pack8(o2); *(LAS u32x4*)(L + SL(13) + off) = pack8(o3);
        *(LAS u32x4*)(L + SL(2) + off) = pack8(vs);
    }
    BAR_LDS();
    {
        const int srcs[4] = {12, 13, 11, 2}, dsts[4] = {4, 5, 6, 7};
#pragma unroll
        for (int q = 0; q < 4; ++q) { unsigned short hv[8];
#pragma unroll
            for (int e = 0; e < 8; ++e) hv[e] = *(LAS const unsigned short*)(L + SL(srcs[q]) + ((size_t)(8 * wid + e) * LW + lane) * 2);
            u32x4 w; w.x = hv[0] | ((unsigned)hv[1] << 16); w.y = hv[2] | ((unsigned)hv[3] << 16); w.z = hv[4] | ((unsigned)hv[5] << 16); w.w = hv[6] | ((unsigned)hv[7] << 16);
            *(LAS u32x4*)(L + SL(dsts[q]) + ((size_t)lane * LW + 8 * wid) * 2) = w;
        }
    }
    BAR_LDS();
    if (next_unit < NUNIT) rwkv_pre_fetch<1>(F, next_unit, next_first, P, tid);
    const int crow = tid >> 3, cch = tid & 7;
    __builtin_nontemporal_store(*(LAS const u32x4*)(L + SL(7) + ((size_t)crow * LW + cch * 8) * 2), (u32x4*)((bf16_t*)(F.ws + WS_VT) + (size_t)unit * 4096 + crow * 64 + cch * 8));
    {
        const LdsMat Rt{L + SL(10), LW}, Kt{L + SL(11), LW}, At{L + SL(12), LW}, Bt{L + SL(13), LW};
        f32x4 nd = (f32x4){0.f, 0.f, 0.f, 0.f}, ntd = nd;
        {
            int ln = lane, wd = wid; asm volatile("" : "+v"(ln), "+s"(wd));
            const int at = wd >> 1, bt0 = (wd & 1) * 2, fr = ln & 15, fq = ln >> 4, a = 16 * at + fr;
            bf16x8 yA[2], yK[2], yR[2], xB[2][2], xA[2][2], xK[2][2];
            ld_yf(At, at, fr, fq, yA); ld_xf(Bt, bt0, fr, fq, xB); ld_yf(Kt, at, fr, fq, yK); ld_xf(At, bt0, fr, fq, xA); ld_yf(Rt, at, fr, fq, yR); ld_xf(Kt, bt0, fr, fq, xK);
            const bool diag = bt0 == (at & 2);
            bf16x8 xd[2];
            if (diag) ld_yf(Bt, at, fr, fq, xd);
            f32x4 c0[2], c1[2], c2[2], c3[2];
            mm_f(yA, xB, c0); mm_f(yK, xA, c1); mm_f(yR, xB, c2); mm_f(yR, xK, c3);
            if (diag) {
                f32x4 v = (f32x4){0.f, 0.f, 0.f, 0.f};
#pragma unroll
                for (int s = 0; s < 2; ++s) v = __builtin_amdgcn_mfma_f32_16x16x32_bf16(yA[s], xd[s], v, 0, 0, 0);
#pragma unroll
                for (int e = 0; e < 4; ++e) v[e] = (fr < 4 * fq + e) ? v[e] : 0.f;
                nd = v; }
#pragma unroll
            for (int bi = 0; bi < 2; ++bi) { const int b0 = 16 * (bt0 + bi) + 4 * fq; f32x4 v0 = c0[bi], v1 = c1[bi], v2 = c2[bi], v3 = c3[bi];
#pragma unroll
                for (int e = 0; e < 4; ++e) { v0[e] = (b0 + e < a) ? v0[e] : 0.f; v1[e] = (a < b0 + e) ? v1[e] : 0.f; v2[e] = (b0 + e <= a) ? v2[e] : 0.f; v3[e] = (b0 + e <= a) ? v3[e] : 0.f; }
                st_lds4(L + SL(1), a, b0, v0); st_lds4(L + SL(2), a, b0, v1); st_lds4(L + SL(3), a, b0, v2); st_lds4(L + SL(8), a, b0, v3);
                if (bt0 + bi == at) ntd = v0; }
        }
        const int at = wid >> 1;
        if (((wid & 1) * 2 == (at & 2))) {
            const int fr = lane & 15, fq = lane >> 4;
            auto op = [](f32x4 v) { u32x4 w; w.x = cvt_pk_bf16(v[0], v[1]); w.y = cvt_pk_bf16(v[2], v[3]); w.z = 0u; w.w = 0u; return __builtin_bit_cast(bf16x8, w); };
            const f32x4 zero = (f32x4){0.f, 0.f, 0.f, 0.f};
            const f32x4 Lm = ntd, LT = nd;
            f32x4 Q = Lm;
#pragma unroll
            for (int e = 0; e < 4; ++e) Q[e] += (4 * fq + e == fr) ? 1.f : 0.f;
            const f32x4 L2 = __builtin_amdgcn_mfma_f32_16x16x32_bf16(op(LT), op(Lm), zero, 0, 0, 0), L2T = __builtin_amdgcn_mfma_f32_16x16x32_bf16(op(Lm), op(LT), zero, 0, 0, 0);
            Q = __builtin_amdgcn_mfma_f32_16x16x32_bf16(op(L2T), op(Q), Q, 0, 0, 0);
            const f32x4 L4 = __builtin_amdgcn_mfma_f32_16x16x32_bf16(op(L2T), op(L2), zero, 0, 0, 0), L4T = __builtin_amdgcn_mfma_f32_16x16x32_bf16(op(L2), op(L2T), zero, 0, 0, 0);
            Q = __builtin_amdgcn_mfma_f32_16x16x32_bf16(op(L4T), op(Q), Q, 0, 0, 0);
            const f32x4 L8T = __builtin_amdgcn_mfma_f32_16x16x32_bf16(op(L4), op(L4T), zero, 0, 0, 0);
            Q = __builtin_amdgcn_mfma_f32_16x16x32_bf16(op(L8T), op(Q), Q, 0, 0, 0);
            st_lds4(L + SL(9), 16 * at + fr, 4 * fq, Q);
        }
    }
    BAR_LDS();
    {
        const int fr = lane & 15, fq = lane >> 4;
        LAS const unsigned char* zsl = L + (wid < 4 ? SL(4) : SL(2)); LAS unsigned char* dsl = L + (wid < 4 ? SL(11) : SL(12));
        const int arow = 16 * (wid & 3) + fr;
        u32x2 zp[4];
#pragma unroll
        for (int c = 0; c < 4; ++c) {
            f32x4 acc = ld_lds4(zsl, arow, 16 * c + 4 * fq);
            if (c >= 1) {
                const u32x2 alo = *(LAS const u32x2*)(L + SL(1) + ((size_t)(16 * c + fr) * LW + 4 * fq) * 2), ahi = *(LAS const u32x2*)(L + SL(1) + ((size_t)(16 * c + fr) * LW + 16 + 4 * fq) * 2);
                u32x4 aw; aw.x = alo.x; aw.y = alo.y; aw.z = ahi.x; aw.w = ahi.y;
                u32x4 bw; bw.x = zp[0].x; bw.y = zp[0].y; bw.z = c >= 2 ? zp[1].x : 0u; bw.w = c >= 2 ? zp[1].y : 0u;
                acc = __builtin_amdgcn_mfma_f32_16x16x32_bf16(__builtin_bit_cast(bf16x8, aw), __builtin_bit_cast(bf16x8, bw), acc, 0, 0, 0); }
            if (c == 3) {
                const u32x2 alo = *(LAS const u32x2*)(L + SL(1) + ((size_t)(48 + fr) * LW + 32 + 4 * fq) * 2);
                u32x4 aw; aw.x = alo.x; aw.y = alo.y; aw.z = 0u; aw.w = 0u;
                u32x4 bw; bw.x = zp[2].x; bw.y = zp[2].y; bw.z = 0u; bw.w = 0u;
                acc = __builtin_amdgcn_mfma_f32_16x16x32_bf16(__builtin_bit_cast(bf16x8, aw), __builtin_bit_cast(bf16x8, bw), acc, 0, 0, 0); }
            const u32x2 dlo = *(LAS const u32x2*)(L + SL(9) + ((size_t)(16 * c + fr) * LW + 4 * fq) * 2);
            u32x4 aw; aw.x = dlo.x; aw.y = dlo.y; aw.z = 0u; aw.w = 0u;
            u32x4 bw; bw.x = cvt_pk_bf16(acc[0], acc[1]); bw.y = cvt_pk_bf16(acc[2], acc[3]); bw.z = 0u; bw.w = 0u;
            const f32x4 r = __builtin_amdgcn_mfma_f32_16x16x32_bf16(__builtin_bit_cast(bf16x8, aw), __builtin_bit_cast(bf16x8, bw), (f32x4){0.f, 0.f, 0.f, 0.f}, 0, 0, 0);
            zp[c].x = cvt_pk_bf16(r[0], r[1]); zp[c].y = cvt_pk_bf16(r[2], r[3]);
            *(LAS u32x2*)(dsl + ((size_t)arow * LW + 16 * c + 4 * fq) * 2) = zp[c];
        }
    }
    BAR_LDS();
    {
        const int sAT = 11, sAkT = 12, sHk = 0;
        const LdsMat AT{L + SL(sAT), LW}, AkT{L + SL(sAkT), LW}, AbrT{L + SL(3), LW}, BgT{L + SL(5), LW}, VTm{L + SL(7), LW};
        bf16_t* QRT = (bf16_t*)(F.ws + WS_QRT) + (size_t)unit * 4096; bf16_t* WYT = (bf16_t*)(F.ws + WS_WYT) + (size_t)unit * 4096;
        bf16_t* GTg = (bf16_t*)(F.dout + DO_GT) + (size_t)unit * (64 * GLD); bf16_t* Hg = (bf16_t*)(F.dout + DO_H) + (size_t)unit * (64 * GLD);
        {
            int ln = lane, wd = wid; asm volatile("" : "+v"(ln), "+s"(wd));
            const int at = wd >> 1, bt0 = (wd & 1) * 2, fr = ln & 15, fq = ln >> 4, a = 16 * at + fr;
            bf16x8 yA[2], yB[2], xT[2][2], xK[2][2];
            ld_yf(BgT, at, fr, fq, yB); ld_xf(AkT, bt0, fr, fq, xK); ld_yf(AbrT, at, fr, fq, yA); ld_xf(AT, bt0, fr, fq, xT);
            f32x4 eH[2], eR[2], eW[2];
#pragma unroll
            for (int bi = 0; bi < 2; ++bi) { const int b0 = 16 * (bt0 + bi) + 4 * fq; eH[bi] = ld_lds4(L + SL(6), a, b0); eR[bi] = ld_lds4(L + SL(10), a, b0); eW[bi] = ld_lds4(L + SL(8), a, b0); }
            const float gdiag = XT[512 + a];
            f32x4 cH[2], cQ[2], cW[2], cG[2];
            mm_f(yB, xK, cH); mm_f(yA, xT, cQ); mm_f(yA, xK, cW); mm_f(yB, xT, cG);
#pragma unroll
            for (int bi = 0; bi < 2; ++bi) { const int b0 = 16 * (bt0 + bi) + 4 * fq;
                st_lds4(L + SL(sHk), a, b0, (cH[bi] + eH[bi]) * gdiag);
                st_lds4(L + SL(1), a, b0, cQ[bi] + eR[bi]);
                st_lds4(L + SL(2), a, b0, cW[bi] + eW[bi]);
                f32x4 v = cG[bi];
#pragma unroll
                for (int e = 0; e < 4; ++e) v[e] += (b0 + e == a) ? 1.f : 0.f;
                st_lds4(L + SL(4), a, b0, v * gdiag); }
        }
        BAR_LDS();
        const LdsMat HkT{L + SL(sHk), LW};
        mm64<64>(VTm, HkT, wid, lane, [&](int a, int b0, f32x4 v) { st_lds4(L + SL(9), a, b0, v); });
        __builtin_nontemporal_store(*(LAS const u32x4*)(L + SL(1) + ((size_t)crow * LW + cch * 8) * 2), (u32x4*)(QRT + crow * 64 + cch * 8));
        __builtin_nontemporal_store(*(LAS const u32x4*)(L + SL(2) + ((size_t)crow * LW + cch * 8) * 2), (u32x4*)(WYT + crow * 64 + cch * 8));
        __builtin_nontemporal_store(*(LAS const u32x4*)(L + SL(4) + (size_t)tid * 16), (u32x4*)GTg + tid);
        if (tid < 64) __builtin_nontemporal_store(*(LAS const u32x4*)(L + SL(4) + (size_t)(512 + tid) * 16), (u32x4*)GTg + 512 + tid);
        if (next_unit < NUNIT) rwkv_pre_put_w(L, P, tid);
        BAR_LDS();
        __builtin_nontemporal_store(*(LAS const u32x4*)(L + SL(9) + (size_t)tid * 16), (u32x4*)Hg + tid);
        if (tid < 64) __builtin_nontemporal_store(*(LAS const u32x4*)(L + SL(9) + (size_t)(512 + tid) * 16), (u32x4*)Hg + 512 + tid);
    }
}

constexpr int RS_SLOT = 12 * 1024;
constexpr int RS_DEPTH = 8, RS_AHEAD = 6;
__device__ __forceinline__ void rwkv_scan_block(Frame& F, int item) {
    const int bh = item >> 2, qi = item & 3, lane = F.lane, fr = lane & 15, fq = lane >> 4, wid = F.wave;
    const char* GTg = (const char*)(F.dout + DO_GT) + (size_t)bh * 64 * (64 * GLD * 2);
    const char* Hg = (const char*)(F.dout + DO_H) + (size_t)bh * 64 * (64 * GLD * 2) + (size_t)qi * (16 * GLD * 2);
    bf16_t* SST = (bf16_t*)(F.dout + DO_SST) + (size_t)bh * 64 * 4096;
    LAS unsigned char* L = F.lds;
    auto issue = [&](int c) {
        if (wid >= 1) {
            LAS unsigned char* slot = L + (c & (RS_DEPTH - 1)) * RS_SLOT;
#pragma unroll
            for (int k = 0; k < 2; ++k) { const int pc = (wid - 1) + 7 * k;
                if (pc < 12) {
                    const char* src;
                    if (pc < 9) src = GTg + (size_t)c * (64 * GLD * 2) + pc * 1024 + lane * 16;
                    else { int off = (pc - 9) * 1024 + lane * 16; off = off > 2304 - 16 ? 2304 - 16 : off; src = Hg + (size_t)c * (64 * GLD * 2) + off; }
                    __builtin_amdgcn_global_load_lds((const unsigned*)src, (LAS unsigned*)(slot + pc * 1024), 16, 0, 0); } }
        }
    };
    f32x4 acc[4];
#pragma unroll
    for (int mt = 0; mt < 4; ++mt) acc[mt] = (f32x4){0.f, 0.f, 0.f, 0.f};
#pragma unroll 1
    for (int c = 0; c < RS_AHEAD; ++c) issue(c);
#pragma unroll 1
    for (int c = 0; c < NCH; ++c) {
        if (c + RS_AHEAD < NCH) issue(c + RS_AHEAD);
        if (c + RS_AHEAD < NCH) { if (wid >= 1 && wid <= 5) asm volatile("s_waitcnt vmcnt(12)" ::: "memory"); else if (wid >= 6) asm volatile("s_waitcnt vmcnt(6)" ::: "memory"); }
        else if (wid >= 1) asm volatile("s_waitcnt vmcnt(0)" ::: "memory");
        __builtin_amdgcn_s_barrier(); asm volatile("" ::: "memory");
        if (wid == 0) {
            LAS const unsigned char* slot = L + (c & (RS_DEPTH - 1)) * RS_SLOT;
            u32x2 ga[4][2][2], hv[4];
#pragma unroll
            for (int mt = 0; mt < 4; ++mt) {
#pragma unroll
                for (int s = 0; s < 2; ++s)
#pragma unroll
                    for (int hh = 0; hh < 2; ++hh) ga[mt][s][hh] = *(LAS const u32x2*)(slot + ((16 * mt + fr) * GLD + 16 * (2 * s + hh) + 4 * fq) * 2);
                hv[mt] = *(LAS const u32x2*)(slot + 9216 + (fr * GLD + 16 * mt + 4 * fq) * 2); }
            bf16_t* Sc = SST + (size_t)c * 4096; u32x2 sp[4];
#pragma unroll
            for (int mt = 0; mt < 4; ++mt) { sp[mt].x = cvt_pk_bf16(acc[mt][0], acc[mt][1]); sp[mt].y = cvt_pk_bf16(acc[mt][2], acc[mt][3]);
                *(u32x2*)(Sc + (size_t)(16 * qi + fr) * 64 + 16 * mt + 4 * fq) = sp[mt]; }
            bf16x8 sb[2];
#pragma unroll
            for (int s = 0; s < 2; ++s) { u32x4 w; w.x = sp[2 * s].x; w.y = sp[2 * s].y; w.z = sp[2 * s + 1].x; w.w = sp[2 * s + 1].y; sb[s] = __builtin_bit_cast(bf16x8, w); }
#pragma unroll
            for (int mt = 0; mt < 4; ++mt) { f32x4 a = (f32x4){bf_lo(hv[mt].x), bf_hi(hv[mt].x), bf_lo(hv[mt].y), bf_hi(hv[mt].y)};
#pragma unroll
                for (int s = 0; s < 2; ++s) { u32x4 w; w.x = ga[mt][s][0].x; w.y = ga[mt][s][0].y; w.z = ga[mt][s][1].x; w.w = ga[mt][s][1].y;
                    a = __builtin_amdgcn_mfma_f32_16x16x32_bf16(__builtin_bit_cast(bf16x8, w), sb[s], a, 0, 0, 0); }
                acc[mt] = a; }
            asm volatile("s_waitcnt lgkmcnt(0)" ::: "memory");
        }
    }
    asm volatile("s_waitcnt vmcnt(0)" ::: "memory");
    __builtin_amdgcn_s_barrier(); asm volatile("" ::: "memory");
}
__device__ __forceinline__ void s5_scan_block(Frame& F, int gb) {
    const int g = gb >> 3, b = gb & 7, p = F.lane, w = F.wave;
    const float* aL = (const float*)(F.ws + WS_AL) + g * 128; const float ar = aL[2 * p], ai = aL[2 * p + 1];
    bf16_t* UG = (bf16_t*)(F.ws + WS_UG) + ((size_t)g * S5ROWS + b * 256 + 32 * w) * UGLD + 256 + 2 * p;
    LAS float* E = (LAS float*)(F.lds + XTRA_OFF);
    LAS const float* SLl = (LAS const float*)F.lds;
    f32x2 l[32];
#pragma unroll
    for (int k = 0; k < 32; ++k) { const int row = 32 * w + k; l[k] = *(LAS const f32x2*)(SLl + row * 128 + ((((p >> 1) ^ (row & 15)) << 2) | ((p & 1) << 1))); }
    float sr = 0.f, si = 0.f;
#pragma unroll
    for (int k = 0; k < 32; ++k) { const float nr = ar * sr - ai * si + l[k].x, ni = ar * si + ai * sr + l[k].y; l[k].x = sr; l[k].y = si; sr = nr; si = ni; }
    E[(w * 64 + p) * 2] = sr; E[(w * 64 + p) * 2 + 1] = si;
    float pr = ar, pi = ai;
#pragma unroll
    for (int q = 0; q < 5; ++q) { const float nr = pr * pr - pi * pi, ni = 2.f * pr * pi; pr = nr; pi = ni; }
    asm volatile("s_waitcnt lgkmcnt(0)" ::: "memory"); __builtin_amdgcn_s_barrier(); asm volatile("" ::: "memory");
    float cr = 0.f, ci = 0.f;
#pragma unroll
    for (int w2 = 0; w2 < 7; ++w2) { if (w2 < w) { const float er = E[(w2 * 64 + p) * 2], ei = E[(w2 * 64 + p) * 2 + 1]; const float nr = pr * cr - pi * ci + er, ni = pr * ci + pi * cr + ei; cr = nr; ci = ni; } }
#pragma unroll
    for (int k = 0; k < 32; ++k) { *(unsigned*)(UG + (size_t)k * UGLD) = cvt_pk_bf16(l[k].x + cr, l[k].y + ci); const float nr = ar * cr - ai * ci, ni = ar * ci + ai * cr; cr = nr; ci = ni; }
    asm volatile("s_waitcnt lgkmcnt(0)" ::: "memory"); __builtin_amdgcn_s_barrier(); asm volatile("" ::: "memory");
}
struct OutY { bf16x8 yq[2], yw[2]; u32x2 gv[4]; float bon; };
__device__ __forceinline__ void rwkv_out_loady(Frame& F, int unit, int at, OutY& Lq) {
    const int lane = F.lane, fr = lane & 15, fq = lane >> 4;
    const int bh = unit >> 6, c = unit & 63, b = bh >> 3, h = bh & 7;
    const bf16_t* QRT = (const bf16_t*)(F.ws + WS_QRT) + (size_t)unit * 4096; const bf16_t* WYT = (const bf16_t*)(F.ws + WS_WYT) + (size_t)unit * 4096;
#pragma unroll
    for (int s = 0; s < 2; ++s) { Lq.yq[s] = __builtin_nontemporal_load((const bf16x8*)(QRT + (size_t)(16 * at + fr) * 64 + 32 * s + 8 * fq)); Lq.yw[s] = __builtin_nontemporal_load((const bf16x8*)(WYT + (size_t)(16 * at + fr) * 64 + 32 * s + 8 * fq)); }
    const int tl = c * 64 + 16 * at + fr, tg = b * SEQ + tl;
    const bf16_t* gb = (const bf16_t*)(F.ws + WS_GBUF) + (size_t)tg * RW + h * 64;
    Lq.bon = ((const float*)(F.ws + WS_BONUS))[(size_t)tg * 8 + h];
#pragma unroll
    for (int bt = 0; bt < 4; ++bt) { const int i0 = 16 * bt + 4 * fq; Lq.gv[bt] = *(const u32x2*)(gb + i0); }
}
__device__ __forceinline__ void rwkv_out_comp(Frame& F, int unit, int at, const bf16x8 (&xs)[2][4], const bf16x8 (&xv)[2][4], const OutY& Lq) {
    const int lane = F.lane, fr = lane & 15, fq = lane >> 4;
    const int bh = unit >> 6, c = unit & 63, b = bh >> 3, h = bh & 7;
    f32x4 lw[4], lb[4];
#pragma unroll
    for (int bt = 0; bt < 4; ++bt) { const int i0 = 16 * bt + 4 * fq; lw[bt] = *(const f32x4*)(F.in[I_LNW] + h * 64 + i0); lb[bt] = *(const f32x4*)(F.in[I_LNB] + h * 64 + i0); }
    f32x4 bv4[4];
    {
        const unsigned bb = cvt_pk_bf16(Lq.bon, Lq.bon); const bool mine = fq == 2 * (at & 1) + (fr >> 3); const int jw = (fr & 7) >> 1; const unsigned half = (fr & 1) ? (bb & 0xffff0000u) : (bb & 0xffffu);
        u32x4 dw; dw.x = (mine && jw == 0) ? half : 0u; dw.y = (mine && jw == 1) ? half : 0u; dw.z = (mine && jw == 2) ? half : 0u; dw.w = (mine && jw == 3) ? half : 0u;
        const bf16x8 df = __builtin_bit_cast(bf16x8, dw);
#pragma unroll
        for (int bt = 0; bt < 4; ++bt) bv4[bt] = __builtin_amdgcn_mfma_f32_16x16x32_bf16((at >> 1) ? xv[1][bt] : xv[0][bt], df, (f32x4){0.f, 0.f, 0.f, 0.f}, 0, 0, 0);
    }
    f32x4 acc[4];
#pragma unroll
    for (int bt = 0; bt < 4; ++bt) acc[bt] = (f32x4){0.f, 0.f, 0.f, 0.f};
#pragma unroll
    for (int s = 0; s < 2; ++s)
#pragma unroll
        for (int bt = 0; bt < 4; ++bt) {
            acc[bt] = __builtin_amdgcn_mfma_f32_16x16x32_bf16(xs[s][bt], Lq.yq[s], acc[bt], 0, 0, 0);
            acc[bt] = __builtin_amdgcn_mfma_f32_16x16x32_bf16(xv[s][bt], Lq.yw[s], acc[bt], 0, 0, 0); }
    float s1 = 0.f;
#pragma unroll
    for (int bt = 0; bt < 4; ++bt) s1 += (acc[bt][0] + acc[bt][1]) + (acc[bt][2] + acc[bt][3]);
    s1 += __shfl_xor(s1, 16); s1 += __shfl_xor(s1, 32);
    const float mean = s1 * (1.f / 64.f); float s2 = 0.f;
#pragma unroll
    for (int bt = 0; bt < 4; ++bt) { const f32x4 d = acc[bt] - mean; s2 += (d[0] * d[0] + d[1] * d[1]) + (d[2] * d[2] + d[3] * d[3]); }
    s2 += __shfl_xor(s2, 16); s2 += __shfl_xor(s2, 32);
    const float rstd = __builtin_amdgcn_rsqf(s2 * (1.f / 64.f) + 64e-5f);
    const int tl = c * 64 + 16 * at + fr, tg = b * SEQ + tl;
    bf16_t* YRS = (bf16_t*)(F.dout + DO_YRS) + (size_t)tg * D + h * 64;
#pragma unroll
    for (int bt = 0; bt < 4; ++bt) { const int i0 = 16 * bt + 4 * fq;
        const u32x2 gv = Lq.gv[bt];
        const float gg[4] = {bf_lo(gv.x), bf_hi(gv.x), bf_lo(gv.y), bf_hi(gv.y)};
        float o[4];
#pragma unroll
        for (int e = 0; e < 4; ++e) o[e] = ((acc[bt][e] - mean) * rstd * lw[bt][e] + lb[bt][e] + bv4[bt][e]) * gg[e];
        u32x2 w; w.x = cvt_pk_bf16(o[0], o[1]); w.y = cvt_pk_bf16(o[2], o[3]); *(u32x2*)(YRS + i0) = w; }
}
__device__ __forceinline__ void rwkv_out_units(Frame& F) {
    const int lane = F.lane, fr = lane & 15, fq = lane >> 4;
    for (int unit = F.vcu * NWAVES + F.wave; unit < NUNIT; unit += F.G * NWAVES) {
        const bf16_t* VT = (const bf16_t*)(F.ws + WS_VT) + (size_t)unit * 4096; const bf16_t* SST = (const bf16_t*)(F.dout + DO_SST) + (size_t)unit * 4096;
        bf16x8 xs[2][4], xv[2][4]; OutY A, B;
#pragma unroll
        for (int s = 0; s < 2; ++s)
#pragma unroll
            for (int bt = 0; bt < 4; ++bt) { xs[s][bt] = __builtin_nontemporal_load((const bf16x8*)(SST + (size_t)(16 * bt + fr) * 64 + 32 * s + 8 * fq)); xv[s][bt] = __builtin_nontemporal_load((const bf16x8*)(VT + (size_t)(16 * bt + fr) * 64 + 32 * s + 8 * fq)); }
        rwkv_out_loady(F, unit, 0, A); rwkv_out_loady(F, unit, 1, B); __builtin_amdgcn_sched_barrier(0);
        rwkv_out_comp(F, unit, 0, xs, xv, A); __builtin_amdgcn_sched_barrier(0); rwkv_out_loady(F, unit, 2, A); __builtin_amdgcn_sched_barrier(0);
        rwkv_out_comp(F, unit, 1, xs, xv, B); __builtin_amdgcn_sched_barrier(0); rwkv_out_loady(F, unit, 3, B); __builtin_amdgcn_sched_barrier(0);
        rwkv_out_comp(F, unit, 2, xs, xv, A); __builtin_amdgcn_sched_barrier(0);
        rwkv_out_comp(F, unit, 3, xs, xv, B); __builtin_amdgcn_sched_barrier(0);
    }
}

__device__ __forceinline__ void p8_rows(Frame& F) {
    const int gw = F.vcu * NWAVES + F.wave, NGW = F.G * NWAVES, lane = F.lane;
    const bf16_t* MX = (const bf16_t*)(F.ws + WS_MIXED); const float* ST = (const float*)(F.ws + WS_STAT1); bf16_t* H2 = (bf16_t*)(F.ws + WS_H2); float* X1 = (float*)F.dout;
    f32x4 gp[4];
#pragma unroll
    for (int j = 0; j < 4; ++j) gp[j] = *(const f32x4*)(F.in[I_NMPOST] + 256 * j + 4 * lane);
    for (int m0 = gw; m0 < T; m0 += 2 * NGW) {
        int mm[2] = {m0, (m0 + NGW < T) ? m0 + NGW : m0};
        f32x4 xv[2][4]; u32x2 mw[2][4]; float st[2];
#pragma unroll
        for (int q = 0; q < 2; ++q) { st[q] = (lane < 16) ? ST[(size_t)mm[q] * 16 + lane] : 0.f;
#pragma unroll
            for (int j = 0; j < 4; ++j) { const int col = 256 * j + 4 * lane; xv[q][j] = __builtin_nontemporal_load((const f32x4*)(F.in[I_X] + (size_t)mm[q] * D + col)); mw[q][j] = __builtin_nontemporal_load((const u32x2*)(MX + (size_t)mm[q] * D + col)); } }
#pragma unroll
        for (int q = 0; q < 2; ++q) {
            const float rstd1 = __builtin_amdgcn_rsqf(wave_sum(st[q]) * (1.f / D) + 1e-6f);
            f32x4 v[4]; float s = 0.f;
#pragma unroll
            for (int j = 0; j < 4; ++j) { const int col = 256 * j + 4 * lane;
                v[j].x = xv[q][j].x + bf_lo(mw[q][j].x) * rstd1 * gp[j].x; v[j].y = xv[q][j].y + bf_hi(mw[q][j].x) * rstd1 * gp[j].y; v[j].z = xv[q][j].z + bf_lo(mw[q][j].y) * rstd1 * gp[j].z; v[j].w = xv[q][j].w + bf_hi(mw[q][j].y) * rstd1 * gp[j].w;
                s += (v[j].x * v[j].x + v[j].y * v[j].y) + (v[j].z * v[j].z + v[j].w * v[j].w);
                }
            const float rstd2 = __builtin_amdgcn_rsqf(wave_sum(s) * (1.f / D) + 1e-6f);
#pragma unroll
            for (int j = 0; j < 4; ++j) { u32x2 w; w.x = cvt_pk_bf16(v[j].x * rstd2, v[j].y * rstd2); w.y = cvt_pk_bf16(v[j].z * rstd2, v[j].w * rstd2); *(u32x2*)(H2 + (size_t)mm[q] * D + 256 * j + 4 * lane) = w; }
        }
    }
}
__device__ __forceinline__ void p12_rows(Frame& F) {
    const int gw = F.vcu * NWAVES + F.wave, NGW = F.G * NWAVES, lane = F.lane;
    const bf16_t* FB = (const bf16_t*)(F.ws + WS_F); const bf16_t* MX = (const bf16_t*)(F.ws + WS_MIXED);
    const float* ST1 = (const float*)(F.ws + WS_STAT1); const float* ST2 = (const float*)(F.ws + WS_STAT2); float* OUT = (float*)F.dout;
    f32x4 gp[4], gq[4];
#pragma unroll
    for (int j = 0; j < 4; ++j) { gp[j] = *(const f32x4*)(F.in[I_NMPOST] + 256 * j + 4 * lane); gq[j] = *(const f32x4*)(F.in[I_NFPOST] + 256 * j + 4 * lane); }
    for (int m0 = gw; m0 < T; m0 += 2 * NGW) {
        int mm[2] = {m0, (m0 + NGW < T) ? m0 + NGW : m0};
        f32x4 xv[2][4]; u32x2 mw[2][4], fw[2][4]; float s1[2], s2[2];
#pragma unroll
        for (int q = 0; q < 2; ++q) { s1[q] = (lane < 16) ? ST1[(size_t)mm[q] * 16 + lane] : 0.f; s2[q] = (lane < 16) ? ST2[(size_t)mm[q] * 16 + lane] : 0.f;
#pragma unroll
            for (int j = 0; j < 4; ++j) { const int col = 256 * j + 4 * lane; xv[q][j] = __builtin_nontemporal_load((const f32x4*)(F.in[I_X] + (size_t)mm[q] * D + col));
                mw[q][j] = __builtin_nontemporal_load((const u32x2*)(MX + (size_t)mm[q] * D + col)); fw[q][j] = __builtin_nontemporal_load((const u32x2*)(FB + (size_t)mm[q] * D + col)); } }
#pragma unroll
        for (int q = 0; q < 2; ++q) {
            const float rstd1 = __builtin_amdgcn_rsqf(wave_sum(s1[q]) * (1.f / D) + 1e-6f), rstd3 = __builtin_amdgcn_rsqf(wave_sum(s2[q]) * (1.f / D) + 1e-6f);
#pragma unroll
            for (int j = 0; j < 4; ++j) { const int col = 256 * j + 4 * lane; f32x4 o;
                o.x = xv[q][j].x + bf_lo(mw[q][j].x) * rstd1 * gp[j].x; o.y = xv[q][j].y + bf_hi(mw[q][j].x) * rstd1 * gp[j].y; o.z = xv[q][j].z + bf_lo(mw[q][j].y) * rstd1 * gp[j].z; o.w = xv[q][j].w + bf_hi(mw[q][j].y) * rstd1 * gp[j].w;
                o.x += bf_lo(fw[q][j].x) * rstd3 * gq[j].x; o.y += bf_hi(fw[q][j].x) * rstd3 * gq[j].y; o.z += bf_lo(fw[q][j].y) * rstd3 * gq[j].z; o.w += bf_hi(fw[q][j].y) * rstd3 * gq[j].w;
                __builtin_nontemporal_store(o, (f32x4*)(OUT + (size_t)mm[q] * D + col)); }
        }
    }
}

#ifndef MK_PER_PHASE
#define MK_PER_PHASE 0
#endif
constexpr int NPHASE = 12;
struct Args { const float* in[35]; float* out; unsigned char* ws; int ph_lo, ph_hi; };
static_assert(sizeof(Args) == 35 * 8 + 8 + 8 + 8, "Args has no padding");

__device__ __forceinline__ bool phase_begin(Frame& F) { unsigned long long z = 0; asm volatile("" : "+s"(z), "+v"(F.tid)); F.ws = F.ws0 + z; F.dout = F.dout0 + z;     F.lane = F.tid & 63; F.wave = __builtin_amdgcn_readfirstlane(F.tid >> 6); return true; }
__global__ void __launch_bounds__(NWAVES * 64, 2) fwd_kernel(Args args) {
    extern __shared__ __attribute__((aligned(16))) unsigned char lds_raw[];
    Frame F;
    F.lds = (LAS unsigned char*)lds_raw;
    F.MISC = (volatile LAS unsigned*)(F.lds + MISC_OFF);
    F.tid = threadIdx.x; F.lane = F.tid & 63; F.wave = __builtin_amdgcn_readfirstlane(F.tid >> 6);
    F.G = gridDim.x; { const int bx = blockIdx.x; F.vcu = (F.G % 8 == 0) ? (bx % 8) * (F.G / 8) + bx / 8 : bx; }
    F.ws0 = args.ws; F.dout0 = (unsigned char*)args.out; F.ws = F.ws0; F.dout = F.dout0; F.ctl = (gu32*)(args.ws + WS_CTL);
    F.in = (InTab)__builtin_amdgcn_kernarg_segment_ptr();
    for (int u = F.tid; u < (LDS_BYTES - LDSCTL_OFF) / 4; u += NWAVES * 64) ((LAS unsigned*)(F.lds + LDSCTL_OFF))[u] = 0u;
    __syncthreads();
    XcdBarrier bar; bar.bar = (unsigned*)(F.ctl + CW_BAR); bar.x = 0; bar.st = nullptr;
    if (!MK_PER_PHASE) bar = xcd_barrier_post((unsigned*)(F.ctl + CW_BAR), F.MISC + 8);
    const int lo = args.ph_lo, hi = args.ph_hi;
#ifndef PHMASK
#define PHMASK 0xffffffffu
#endif
#define IN(k) (((PHMASK >> (k)) & 1u) && lo <= (k) && (k) < hi && phase_begin(F))
#ifndef REPMASK
#define REPMASK 0u
#endif
#define REPS(k) ((((REPMASK) >> (k)) & 1u) ? 2 : 1)
#define PH(k) for (int rep_ = 0; rep_ < REPS(k); ++rep_, (rep_ < REPS(k) ? xcd_barrier(bar) : (void)0))
#define INQ(k) (lo <= (k) && (k) < hi)
#define SEAM(k) do { if (INQ(k) && INQ((k) + 1)) xcd_barrier(bar); } while (0)
#define WSB(off) ((bf16_t*)(F.ws + (off)))
    const int bx = (int)blockIdx.x;

    PH(0) if (IN(0)) { p0_prologue(F); }
    SEAM(0);
    PH(1) if (IN(1)) {
        pg8::Gemm g{D, D, D, 0}; pg8::StaticOrder S; S.init(WSB(WS_XN), WSB(WS_WIN), D, D, T, NIN, F.G, bx);
        EpiInProj E{WSB(WS_PR), WSB(WS_UG), WSB(WS_GATES), F.in[I_BGATE], 0};
        pg8::gemm_phase<EpiInProj, pg8::StaticOrder, true>(F.lds, g, S, E, F.tid);
        { const int rem = ((T / 256) * (NIN / 256)) % F.G;
          if (rem == 0) p0_late_mats(F, bx * NWAVES + F.wave, F.G * NWAVES); else if (bx >= rem) p0_late_mats(F, (bx - rem) * NWAVES + F.wave, (F.G - rem) * NWAVES); }
    }
    SEAM(1);
    PH(2) if (IN(2)) {
        PrePf pf;
        if (F.vcu < NB * NCH) { rwkv_pre_fetch<2>(F, (((F.vcu >> 6) * NHEAD) << 6) + (F.vcu & 63), true, pf, F.tid); rwkv_pre_put_w(F.lds, pf, F.tid); }
        {
            LAS f32x4* TB = (LAS f32x4*)(F.lds + XTRA_OFF + 4096);
            if (F.tid < NRW / 4) TB[F.tid] = ((const f32x4*)F.in[I_MU])[F.tid];
            const int pq = F.tid >> 7, pi = F.tid & 127;
            const float* psrc = pq == 0 ? F.in[I_W0] : pq == 1 ? F.in[I_A0] : pq == 2 ? F.in[I_KK] : F.in[I_KA];
            TB[NRW / 4 + F.tid] = ((const f32x4*)psrc)[pi];
            if (F.tid < 128) TB[NRW / 4 + 512 + F.tid] = ((const f32x4*)F.in[I_RK])[F.tid];
            BAR_LDS();
        }
        for (int pc = F.vcu; pc < NB * NCH; pc += F.G) {
#pragma unroll 1
            for (int hh = 0; hh < NHEAD; ++hh) { const int bq = pc >> 6, cq = pc & 63, u = ((bq * NHEAD + hh) << 6) + cq;
                const int un = (hh < NHEAD - 1) ? u + 64 : ((pc + F.G < NB * NCH) ? ((((pc + F.G) >> 6) * NHEAD) << 6) + ((pc + F.G) & 63) : NUNIT);
                rwkv_pre_unit(F, u, un, hh == 0, hh == NHEAD - 1, pf); } }
        BAR_LDS();
    }
    SEAM(2);
    PH(3) if (IN(3)) {
        for (int gb = F.vcu; gb < S5G * NB; gb += F.G) {
            pg8::Gemm g{256, UGLD, 256, 0}; S5One S{WSB(WS_UG), WSB(WS_B1A), 256, gb}; EpiSlocLds E{(LAS float*)F.lds, 0};
            pg8::gemm_phase<EpiSlocLds, S5One, true>(F.lds, g, S, E, F.tid);
            asm volatile("s_waitcnt lgkmcnt(0)" ::: "memory"); __builtin_amdgcn_s_barrier(); asm volatile("" ::: "memory");
            s5_scan_block(F, gb); }
        for (int it = F.vcu; it < NB * NHEAD * 4; it += F.G) rwkv_scan_block(F, it);
    }
    SEAM(3);
    PH(4) if (IN(4)) {
        rwkv_out_units(F);
        VM_WAIT(); __syncthreads();
        pg8::Gemm g{384, UGLD, 384, 0}; S5Order S{WSB(WS_UG), WSB(WS_B1B), 384, F.G, bx};
        pg8::EpiGen8<FS5Out> E{FS5Out{WSB(WS_YSP)}, 0};
        pg8::gemm_phase<pg8::EpiGen8<FS5Out>, S5Order, true>(F.lds, g, S, E, F.tid);
    }
    SEAM(4);
    PH(5) if (IN(5)) {
        pg8::Gemm g{RW, RW, RW, 1}; pg8::StaticOrder S; S.init(WSB(WS_YSP), WSB(WS_WGLU), RW, RW, T, RW, F.G, bx); S.tstepA = (size_t)16 * 256 * 2;
        EpiGlu E{WSB(WS_YSP), (bf16_t*)(F.dout + DO_YRS), F.in[I_BGLU], 0};
        pg8::gemm_phase<EpiGlu, pg8::StaticOrder, true>(F.lds, g, S, E, F.tid);
    }
    SEAM(5);
    PH(6) if (IN(6)) {
        pg8::Gemm g{D, D, D, 0}; pg8::StaticOrder S; S.init((const bf16_t*)(F.dout + DO_YRS), WSB(WS_WBRS), D, D, T, D, F.G, bx);
        EpiMerge E{WSB(WS_GATES), WSB(WS_MERGED), RW / 64};
        pg8::gemm_phase<EpiMerge, pg8::StaticOrder, true>(F.lds, g, S, E, F.tid);
    }
    SEAM(6);
    PH(7) if (IN(7)) {
        pg8::Gemm g{D, D, D, 0}; pg8::StaticOrder S; S.init(WSB(WS_MERGED), WSB(WS_WOUT), D, D, T, D, F.G, bx);
        EpiRowStat E{WSB(WS_MIXED), (float*)(F.ws + WS_STAT1), 0};
        pg8::gemm_phase<EpiRowStat, pg8::StaticOrder, false>(F.lds, g, S, E, F.tid);
    }
    SEAM(7);
    PH(8) if (IN(8)) { p8_rows(F);
        for (size_t i = (size_t)bx * 512 + F.tid; i < HZ_BYTES / 16; i += (size_t)F.G * 512) ((u32x4*)(F.ws + WS_HZ))[i] = (u32x4){0u, 0u, 0u, 0u}; }
    SEAM(8);
    PH(9) if (IN(9)) {
        pg8::Gemm g{D, D, D, 0}; UpOrder S{WSB(WS_H2), WSB(WS_WUP), F.G, bx};
        EpiConvAct E{WSB(WS_ACT), F.in[I_CONVW], F.in[I_CONVB], (LAS unsigned*)(F.lds + XTRA_OFF), (unsigned long long*)(F.ws + WS_HZ), (unsigned*)(F.ctl + 2), 0};
        pg8::gemm_phase<EpiConvAct, UpOrder, true>(F.lds, g, S, E, F.tid);
    }
    SEAM(9);
    PH(10) if (IN(10)) {
        pg8::Gemm g{FF, FF, FF, 0}; pg8::StaticOrder S; S.init(WSB(WS_ACT), WSB(WS_WDN), FF, FF, T, D, F.G, bx);
        EpiRowStat E{WSB(WS_F), (float*)(F.ws + WS_STAT2), 0};
        pg8::gemm_phase<EpiRowStat, pg8::StaticOrder, false>(F.lds, g, S, E, F.tid);
    }
    SEAM(10);
    if (IN(11)) p12_rows(F);
#undef IN
#undef INQ
#undef SEAM
#undef WSB
}

extern "C" void kernel_launch(void* const* d_in, const int* in_sizes, int n_in, void* d_out, int out_size, void* d_ws, size_t ws_size, hipStream_t stream) {
    static int grid = 0;
    if (grid == 0) {
        if (n_in != 35 || in_sizes[0] != T * D || out_size != T * D || ws_size < WS_END) { fprintf(stderr, "kernel_launch: unexpected shapes: n_in %d in0 %d out %d ws %zu (need %zu)\n", n_in, n_in > 0 ? in_sizes[0] : -1, out_size, ws_size, (size_t)WS_END); grid = -1; return; }
        int dev = 0, cus = 0, per_cu = 0;
        if (hipGetDevice(&dev) != hipSuccess || hipDeviceGetAttribute(&cus, hipDeviceAttributeMultiprocessorCount, dev) != hipSuccess) { fprintf(stderr, "kernel_launch: device query failed\n"); grid = -1; return; }
        if (hipFuncSetAttribute((const void*)fwd_kernel, hipFuncAttributeMaxDynamicSharedMemorySize, LDS_BYTES) != hipSuccess) { fprintf(stderr, "kernel_launch: hipFuncSetAttribute failed\n"); grid = -1; return; }
        if (hipOccupancyMaxActiveBlocksPerMultiprocessor(&per_cu, (const void*)fwd_kernel, NWAVES * 64, LDS_BYTES) != hipSuccess || per_cu < 1) fprintf(stderr, "kernel_launch: occupancy query reports %d blocks per CU\n", per_cu);
        (void)hipGetLastError();
        grid = cus;
    }
    if (grid < 0) return;
    if (hipMemsetAsync((char*)d_ws + WS_CTL, 0, CTL_ZERO_BYTES, stream) != hipSuccess) { fprintf(stderr, "kernel_launch: memset failed\n"); return; }
    Args a{};
    for (int i = 0; i < 35; ++i) a.in[i] = (const float*)d_in[i];
    a.out = (float*)d_out; a.ws = (unsigned char*)d_ws;
#if MK_PER_PHASE
    for (int ph = 0; ph < NPHASE; ++ph) { a.ph_lo = ph; a.ph_hi = ph + 1; hipLaunchKernelGGL(fwd_kernel, dim3(grid), dim3(NWAVES * 64), LDS_BYTES, stream, a); }
#else
    a.ph_lo = 0; a.ph_hi = NPHASE;
    hipLaunchKernelGGL(fwd_kernel, dim3(grid), dim3(NWAVES * 64), LDS_BYTES, stream, a);
#endif
    const hipError_t le = hipPeekAtLastError();
    if (le != hipSuccess) fprintf(stderr, "kernel_launch: launch failed: %s\n", hipGetErrorName(le));
}
```

```cpp
#include <hip/hip_runtime.h>
#include <cstdio>
#include <cstdint>

#define LAS __attribute__((address_space(3)))
#define GAS __attribute__((address_space(1)))
typedef unsigned short bf16_t;
typedef short bf16x8 __attribute__((ext_vector_type(8)));
typedef float f32x4 __attribute__((ext_vector_type(4)));
typedef float f32x2 __attribute__((ext_vector_type(2)));
typedef unsigned u32x4 __attribute__((ext_vector_type(4)));
typedef unsigned u32x2 __attribute__((ext_vector_type(2)));
typedef GAS unsigned gu32;

constexpr int T = 32768, SEQ = 4096, NB = 8, D = 1024, NIN = 4352, NRW = 1792, RW = 512, FF = 2816, FH = 1408;
constexpr int NHEAD = 8, HD = 64, NCH = 64  , NUNIT = NB * NHEAD * NCH;
constexpr int S5G = 32, S5ROWS = T / 16, UGLD = 384;

constexpr size_t MiB = 1u << 20;
constexpr size_t WS_CTL = 0, CTL_ZERO_BYTES = 1 * MiB;
constexpr size_t WS_WIN = 1 * MiB;
constexpr size_t WS_WUP = WS_WIN + (size_t)NIN * D * 2;
constexpr size_t WS_WDN = WS_WUP + (size_t)2 * FF * D * 2;
constexpr size_t WS_WOUT = WS_WDN + (size_t)D * FF * 2;
constexpr size_t WS_WBRS = WS_WOUT + (size_t)D * D * 2;
constexpr size_t WS_WGLU = WS_WBRS + (size_t)D * D * 2;
constexpr size_t WS_W2T = WS_WGLU + (size_t)RW * RW * 2;
constexpr size_t WS_A2T = WS_W2T + (size_t)RW * 64 * 2;
constexpr size_t WS_G2T = WS_A2T + (size_t)RW * 64 * 2;
constexpr size_t WS_B1A = WS_G2T + (size_t)RW * 128 * 2;
constexpr size_t WS_B1B = WS_B1A + (size_t)S5G * 256 * 256 * 2;
constexpr size_t WS_AL = WS_B1B + (size_t)S5G * 256 * 384 * 2;
constexpr size_t WS_WEND = WS_AL + (size_t)S5G * 64 * 2 * 4;
static_assert(WS_WEND <= 44 * MiB, "weights region");
constexpr size_t WS_XN = 44 * MiB;
constexpr size_t WS_QRT = 44 * MiB, WS_WYT = 76 * MiB;
constexpr size_t WS_MERGED = 44 * MiB, WS_H2 = 44 * MiB, WS_F = 44 * MiB;
constexpr size_t WS_PR = 108 * MiB;
constexpr size_t WS_MIXED = 304 * MiB, WS_STAT1 = 368 * MiB;
constexpr size_t WS_ACT = 108 * MiB;
constexpr size_t WS_STAT2 = 284 * MiB;
constexpr size_t WS_UG = 220 * MiB;
constexpr size_t WS_GATES = 268 * MiB;
constexpr size_t WS_SLOC = 396 * MiB, WS_YSP = 396 * MiB;
constexpr size_t WS_GBUF = 428 * MiB;
constexpr size_t WS_BONUS = 460 * MiB;
constexpr size_t WS_VT = 461 * MiB;
constexpr size_t WS_LRSCR = 493 * MiB;
constexpr size_t WS_Z = 336 * MiB;
constexpr size_t WS_END = 512 * MiB;
constexpr size_t DO_H = 0, DO_GT = 36 * MiB, DO_SST = 96 * MiB, DO_YRS = 0;
constexpr int GLD = 72;

constexpr int CW_BAR = 4096, CW_HF = 32768, CW_XNQ = 64;
constexpr size_t WS_HZ = 290 * MiB, HZ_BYTES = (size_t)2816 * 4 * 2 * 32 * 8;

constexpr int RING_BYTES = 131072, LDSCTL_OFF = RING_BYTES, MISC_OFF = LDSCTL_OFF + 320, XTRA_OFF = LDSCTL_OFF + 1024, LDS_BYTES = 155648;
constexpr int NWAVES = 8;

#define RLX_AGENT __ATOMIC_RELAXED, __HIP_MEMORY_SCOPE_AGENT
#define LDS_WAIT() asm volatile("s_waitcnt lgkmcnt(0)" ::: "memory")
#define VM_WAIT() asm volatile("s_waitcnt vmcnt(0)" ::: "memory")

typedef __bf16 bf16x2_t __attribute__((ext_vector_type(2)));
__device__ __forceinline__ unsigned cvt_pk_bf16(float lo, float hi) { const f32x2 v = {lo, hi}; return __builtin_bit_cast(unsigned, __builtin_convertvector(v, bf16x2_t)); }
__device__ __forceinline__ float bf_lo(unsigned w) { return __uint_as_float(w << 16); }
__device__ __forceinline__ float bf_hi(unsigned w) { return __uint_as_float(w & 0xffff0000u); }
__device__ __forceinline__ float bf1(bf16_t h) { return __uint_as_float((unsigned)h << 16); }
__device__ __forceinline__ float fexp(float x) { return __builtin_amdgcn_exp2f(x * 1.44269504089f); }
__device__ __forceinline__ float fsigmoid(float x) { return __builtin_amdgcn_rcpf(1.0f + __builtin_amdgcn_exp2f(-1.44269504089f * x)); }
__device__ __forceinline__ float ftanh(float x) { return 1.0f - 2.0f * __builtin_amdgcn_rcpf(1.0f + __builtin_amdgcn_exp2f(2.88539008178f * x)); }
__device__ __forceinline__ float fgelu(float x) { const float u = 0.7978845608f * (x + 0.044715f * x * x * x); return x * fsigmoid(2.0f * u); }
__device__ __forceinline__ void unpack8(u32x4 w, float (&f)[8]) { f[0] = bf_lo(w.x); f[1] = bf_hi(w.x); f[2] = bf_lo(w.y); f[3] = bf_hi(w.y); f[4] = bf_lo(w.z); f[5] = bf_hi(w.z); f[6] = bf_lo(w.w); f[7] = bf_hi(w.w); }
__device__ __forceinline__ u32x4 pack8(const float (&f)[8]) { u32x4 w; w.x = cvt_pk_bf16(f[0], f[1]); w.y = cvt_pk_bf16(f[2], f[3]); w.z = cvt_pk_bf16(f[4], f[5]); w.w = cvt_pk_bf16(f[6], f[7]); return w; }
__device__ __forceinline__ float wave_sum(float v) {
#pragma unroll
    for (int o = 1; o < 64; o <<= 1) v += __shfl_xor(v, o);
    return v;
}

#define XB_TMO      128
#define XB_XCNT(j)  (256  + 64 * (j))
#define XB_XSUB(j)  (1280 + 64 * (j))
#define XB_XGEN(j)  (2304 + 64 * (j))
#define XB_TOP      3328
#define XB_TOPGEN   3392
#define XCD_BAR_WORDS 3456
#define XB_SPIN_CAP (1u << 18)
__device__ __forceinline__ unsigned xb_ld(unsigned* p)              { return __hip_atomic_load(p, __ATOMIC_RELAXED, __HIP_MEMORY_SCOPE_AGENT); }
__device__ __forceinline__ unsigned xb_add(unsigned* p, unsigned v) { return __hip_atomic_fetch_add(p, v, __ATOMIC_RELAXED, __HIP_MEMORY_SCOPE_AGENT); }
__device__ __forceinline__ unsigned xb_xcc_id() { return (unsigned)__builtin_amdgcn_s_getreg((3 << 11) | 20) & 0xFu; }
#define XB_SPIN(cond, bar) do { unsigned _sp = 0; while (cond) { __builtin_amdgcn_s_sleep(1); \
    if ((++_sp & 255u) == 0u) { if (xb_ld(&(bar)[XB_TMO])) break; if (_sp > XB_SPIN_CAP) { atomicAdd(&(bar)[XB_TMO], 1u); break; } } } } while (0)
struct XcdBarrier { unsigned* bar; unsigned x; volatile LAS unsigned* st; };
__device__ __forceinline__ XcdBarrier xcd_barrier_post(unsigned* bar, volatile LAS unsigned* st) {
    XcdBarrier b; b.bar = bar; b.x = xb_xcc_id(); b.st = st;
    if (threadIdx.x == 0) (void)xb_add(&bar[XB_XCNT(b.x)], 1u);
    return b;
}
__device__ __forceinline__ void xcd_barrier_complete(unsigned* bar, unsigned x, unsigned& nloc, unsigned& nx) {
    const unsigned G = gridDim.x * gridDim.y * gridDim.z;
    unsigned sum, cnt, mine, sp = 0u;
    for (;;) {
        sum = 0u; cnt = 0u; mine = 0u;
#pragma unroll
        for (unsigned j = 0; j < 16; ++j) { const unsigned c = xb_ld(&bar[XB_XCNT(j)]); sum += c; cnt += (c > 0u) ? 1u : 0u; mine = (j == x) ? c : mine; }
        if (sum == G) break;
        __builtin_amdgcn_s_sleep(1);
        if ((++sp & 255u) == 0u) { if (xb_ld(&bar[XB_TMO])) break; if (sp > XB_SPIN_CAP) { atomicAdd(&bar[XB_TMO], 1u); break; } }
    }
    nloc = mine > 0u ? mine : 1u; nx = cnt > 0u ? cnt : 1u;
}
__device__ __forceinline__ void xcd_barrier(const XcdBarrier& b) {
    asm volatile("s_waitcnt vmcnt(0)" ::: "memory");
    __syncthreads();
    if (threadIdx.x == 0) {
        unsigned* bar = b.bar;
        __builtin_amdgcn_s_waitcnt(0);
        unsigned nloc = b.st[0], nx = b.st[1];
        if (nloc == 0u) { xcd_barrier_complete(bar, b.x, nloc, nx); b.st[0] = nloc; b.st[1] = nx; }
        const unsigned old = xb_add(&bar[XB_XSUB(b.x)], 1u);
        const unsigned gen = old / nloc;
        if (old + 1u == (gen + 1u) * nloc) {
            __builtin_amdgcn_fence(__ATOMIC_RELEASE, "agent");
            asm volatile("s_waitcnt vmcnt(0)" ::: "memory");
            const unsigned og = xb_add(&bar[XB_TOP], 1u);
            const unsigned tg = og / nx;
            if (og + 1u == (tg + 1u) * nx) xb_add(&bar[XB_TOPGEN], 1u);
            else XB_SPIN(xb_ld(&bar[XB_TOPGEN]) == tg, bar);
            __builtin_amdgcn_fence(__ATOMIC_ACQUIRE, "agent");
            xb_add(&bar[XB_XGEN(b.x)], 1u);
            asm volatile("s_waitcnt vmcnt(0)" ::: "memory");
        } else {
            XB_SPIN(xb_ld(&bar[XB_XGEN(b.x)]) == gen, bar);
            __builtin_amdgcn_fence(__ATOMIC_ACQUIRE, "agent");
            asm volatile("s_waitcnt vmcnt(0)" ::: "memory");
        }
    }
    __syncthreads();
}

namespace pg8 {
constexpr int BM = 256, BK = 64, HALF = 128, HTB = HALF * BK * 2, STAGE_BYTES = 8 * HTB, NXCD = 8, WGM = 8;
__host__ __device__ __forceinline__ int lds_byte(int r, int c) { const int st = (r >> 4) * 2 + (c >> 5), rr = r & 15, cc = c & 31, ob = rr * 64 + cc * 2; return st * 1024 + (ob ^ (((ob >> 9) & 1) << 5)); }
__host__ __device__ __forceinline__ void stage_rc(int b, int& R, int& C) { const int st = b / 1024, sb = b % 1024, swz = sb ^ (((sb >> 9) & 1) << 5); R = (st >> 1) * 16 + swz / 64; C = (st & 1) * 32 + (swz % 64) / 2; }
__host__ __device__ __forceinline__ int perm32(int rho) { const int n = rho >> 4, i = rho & 15; return 8 * (i >> 2) + 4 * n + (i & 3); }

struct Unit { const char* a; const char* b; int pm, pn; };
struct Gemm { int K, lda, ldb, amode; };

struct StaticOrder {
    const bf16_t* A; const bf16_t* Bt; int lda, ldb;
    int nM, nN, nwg, G, c; size_t tstepA;
    __device__ void init(const bf16_t* A_, const bf16_t* Bt_, int lda_, int ldb_, int M, int N, int G_, int c_) { A = A_; Bt = Bt_; lda = lda_; ldb = ldb_; nM = M / BM; nN = N / BM; nwg = nM * nN; G = G_; c = c_; tstepA = (size_t)BM * lda * 2; }
    __device__ bool next(int i, Unit& u) const {
        const long L = (long)i * G + c; if (L >= nwg) return false;
        int wgid = (int)L; { const int q = nwg / NXCD, r = nwg % NXCD, xcd = wgid % NXCD, off = wgid / NXCD; wgid = (xcd < r ? xcd * (q + 1) : r * (q + 1) + (xcd - r) * q) + off; }
        const int nig = WGM * nN, gid = wgid / nig, fm = gid * WGM, gsz = (nM - fm) < WGM ? (nM - fm) : WGM;
        u.pm = fm + ((wgid % nig) % gsz); u.pn = (wgid % nig) / gsz;
        u.a = (const char*)A + (size_t)u.pm * tstepA; u.b = (const char*)Bt + (size_t)u.pn * BM * ldb * 2; return true;
    }
};

template <class Epi, class Sched, bool ALIGN_EPI = false, bool SP2 = true>
__device__ __forceinline__ void gemm_phase(LAS unsigned char* lds, const Gemm g, const Sched& S, const Epi& E, const int tid) {
    const int wid = __builtin_amdgcn_readfirstlane(tid >> 6), lane = tid & 63, wr = wid >> 2, wc = wid & 3, fr = lane & 15, fq = lane >> 4;
    const int K = g.K, nt = K / BK;
    unsigned voffA[2], voffB[2];
#pragma unroll
    for (int i = 0; i < 2; ++i) { int R, C; stage_rc(tid * 16 + i * 8192, R, C); const int Rb = Epi::PERM ? ((R & ~31) + perm32(R & 31)) : R;
        voffA[i] = g.amode ? (unsigned)((((C >> 4) * S5ROWS + (R >> 4)) * 256 + (R & 15) * 16 + (C & 15)) * 2) : (unsigned)(R * g.lda + C) * 2u; voffB[i] = (unsigned)(Rb * g.ldb + C) * 2u; }
    const size_t kstepB = (size_t)(BK * 2), kstepA = g.amode ? (size_t)4 * S5ROWS * 256 * 2 : (size_t)(BK * 2);
    const size_t hstepA = g.amode ? (size_t)8 * 256 * 2 : (size_t)HALF * g.lda * 2, hstepB = (size_t)HALF * g.ldb * 2;
    const unsigned ldsw = (unsigned)wid * 1024u;
    const int aoff = lds_byte(wr * 64 + fr, fq * 8), boff = lds_byte(wc * 32 + fr, fq * 8);
#define PG8_SA(b, h) (((b) * 2 + (h)) * HTB)
#define PG8_SB(b, h) ((4 + (b) * 2 + (h)) * HTB)
#define PG8_STAGE(bufoff, gbase, voff) do { _Pragma("unroll") for (int _i = 0; _i < 2; ++_i) \
        __builtin_amdgcn_global_load_lds((const unsigned*)((const char*)(gbase) + (voff)[_i]), (LAS unsigned*)(lds + (bufoff) + ldsw + _i * 8192), 16, 0, 0); } while (0)
#define PG8_LDA(dst, b, h) do { _Pragma("unroll") for (int m = 0; m < 4; ++m) _Pragma("unroll") for (int k = 0; k < 2; ++k) dst[m][k] = *(const LAS bf16x8*)(lds + PG8_SA(b, h) + aoff + m * 2048 + k * 1024); } while (0)
#define PG8_LDB(dst, b, h) do { _Pragma("unroll") for (int n = 0; n < 2; ++n) _Pragma("unroll") for (int k = 0; k < 2; ++k) dst[n][k] = *(const LAS bf16x8*)(lds + PG8_SB(b, h) + boff + n * 2048 + k * 1024); } while (0)
#define PG8_MMA(ai, bj, At, Bt) do { __builtin_amdgcn_s_setprio(1); _Pragma("unroll") for (int m = 0; m < 4; ++m) _Pragma("unroll") for (int n = 0; n < 2; ++n) _Pragma("unroll") for (int k = 0; k < 2; ++k) \
        acc[ai][bj][m][n] = __builtin_amdgcn_mfma_f32_16x16x32_bf16(Bt[n][k], At[m][k], acc[ai][bj][m][n], 0, 0, 0); __builtin_amdgcn_s_setprio(0); } while (0)
#define PG8_WAIT_V(n) asm volatile("s_waitcnt vmcnt(" #n ")" ::: "memory")
#define PG8_WAIT_L(n) asm volatile("s_waitcnt lgkmcnt(" #n ")" ::: "memory")
#define PG8_BAR __builtin_amdgcn_s_barrier()
#define PG8_SCHED __builtin_amdgcn_sched_barrier(0)
    Unit cur, nxt; int ui = 0;
    if (!S.next(0, cur)) return;
    f32x4 acc[2][2][4][2];
#pragma unroll
    for (int a = 0; a < 2; ++a)
#pragma unroll
        for (int b = 0; b < 2; ++b)
#pragma unroll
            for (int m = 0; m < 4; ++m)
#pragma unroll
                for (int n = 0; n < 2; ++n) acc[a][b][m][n] = (f32x4){0.f, 0.f, 0.f, 0.f};
    bf16x8 At[4][2], B0[2][2], B1[2][2];
    const char* cA = cur.a; const char* cB = cur.b;
    static_assert(SP2, "only the SP2 loop is kept");
    PG8_STAGE(PG8_SB(0, 0), cB, voffB); PG8_STAGE(PG8_SB(0, 1), cB + hstepB, voffB); PG8_STAGE(PG8_SA(0, 0), cA, voffA); PG8_STAGE(PG8_SA(0, 1), cA + hstepA, voffA);
    if (wr == 1) PG8_BAR;
    PG8_WAIT_V(2); PG8_BAR;
    PG8_STAGE(PG8_SB(1, 0), cB + kstepB, voffB); PG8_STAGE(PG8_SA(1, 0), cA + kstepA, voffA); PG8_STAGE(PG8_SB(1, 1), cB + hstepB + kstepB, voffB);
    PG8_WAIT_V(6); PG8_BAR;
    for (;;) {
        const bool has_next = S.next(ui + 1, nxt);
        const char* nA = has_next ? nxt.a : cA; const char* nB = has_next ? nxt.b : cB;
#pragma unroll 1
        for (int t = 0; t < nt; t += 2) {
            if constexpr (Epi::HAS_MID) { if (t == E.mid_t) { E.mid(acc, cur, wr, wc, fr, fq); PG8_SCHED; } }
            const bool last = (t == nt - 2);
            const char* a1 = cA + (size_t)(t + 1) * kstepA;
            const char* a2 = last ? nA : cA + (size_t)(t + 2) * kstepA; const char* b2 = last ? nB : cB + (size_t)(t + 2) * kstepB;
            const char* a3 = a2 + kstepA; const char* b3 = b2 + kstepB;
            PG8_LDB(B0, 0, 0); PG8_LDB(B1, 0, 1); PG8_SCHED; PG8_LDA(At, 0, 0); PG8_STAGE(PG8_SA(1, 1), a1 + hstepA, voffA);
            PG8_WAIT_V(8); PG8_WAIT_L(0); PG8_BAR; PG8_MMA(0, 0, At, B0); PG8_MMA(0, 1, At, B1); PG8_BAR; PG8_SCHED;
            PG8_LDA(At, 0, 1); PG8_STAGE(PG8_SB(0, 0), b2, voffB); PG8_STAGE(PG8_SB(0, 1), b2 + hstepB, voffB); PG8_STAGE(PG8_SA(0, 0), a2, voffA);
            PG8_WAIT_V(8); PG8_WAIT_L(0); PG8_BAR; PG8_MMA(1, 0, At, B0); PG8_MMA(1, 1, At, B1); PG8_BAR; PG8_SCHED;
            PG8_LDB(B0, 1, 0); PG8_LDB(B1, 1, 1); PG8_SCHED; PG8_LDA(At, 1, 0); PG8_STAGE(PG8_SA(0, 1), a2 + hstepA, voffA);
            PG8_WAIT_V(8); PG8_WAIT_L(0); PG8_BAR; PG8_MMA(0, 0, At, B0); PG8_MMA(0, 1, At, B1); PG8_BAR; PG8_SCHED;
            PG8_LDA(At, 1, 1); PG8_STAGE(PG8_SB(1, 0), b3, voffB); PG8_STAGE(PG8_SB(1, 1), b3 + hstepB, voffB); PG8_STAGE(PG8_SA(1, 0), a3, voffA);
            PG8_WAIT_V(8); PG8_WAIT_L(0); PG8_BAR; PG8_MMA(1, 0, At, B0); PG8_MMA(1, 1, At, B1); PG8_BAR; PG8_SCHED;
        }
        if constexpr (ALIGN_EPI) { if (wr == 0) PG8_BAR; }
        E(acc, cur, wr, wc, fr, fq);
        if (!has_next) break;
#pragma unroll
        for (int a = 0; a < 2; ++a)
#pragma unroll
            for (int b = 0; b < 2; ++b)
#pragma unroll
                for (int m = 0; m < 4; ++m)
#pragma unroll
                    for (int n = 0; n < 2; ++n) acc[a][b][m][n] = (f32x4){0.f, 0.f, 0.f, 0.f};
        cur = nxt; cA = nA; cB = nB; ++ui;
        if constexpr (ALIGN_EPI) { if (wr == 1) PG8_BAR; }
    }
    PG8_WAIT_V(0);
    if constexpr (!ALIGN_EPI) { if (wr == 0) PG8_BAR; }
    PG8_BAR;
#undef PG8_SA
#undef PG8_SB
#undef PG8_STAGE
#undef PG8_LDA
#undef PG8_LDB
#undef PG8_MMA
#undef PG8_WAIT_V
#undef PG8_WAIT_L
#undef PG8_BAR
#undef PG8_SCHED
}

template <class F> struct EpiGen8 {
    static constexpr bool PERM = true, HAS_MID = false; F f; int mid_t;
    __device__ __forceinline__ void mid(f32x4 (&)[2][2][4][2], const Unit&, int, int, int, int) const {}
    __device__ __forceinline__ void operator()(const f32x4 (&acc)[2][2][4][2], const Unit& u, int wr, int wc, int fr, int fq) const {
#pragma unroll
        for (int ai = 0; ai < 2; ++ai)
#pragma unroll
            for (int m = 0; m < 4; ++m) { const int r = ai * HALF + wr * 64 + m * 16 + fr;
#pragma unroll
                for (int bj = 0; bj < 2; ++bj) f(u, r, bj * HALF + wc * 32 + 8 * fq, acc[ai][bj][m][0], acc[ai][bj][m][1]);
                if constexpr (F::PIN) __builtin_amdgcn_sched_barrier(0); }
    }
};
}

typedef const float* cfp_t;
typedef __attribute__((address_space(4))) const cfp_t* InTab;
struct Frame {
    LAS unsigned char* lds;
    volatile LAS unsigned* MISC;
    gu32* ctl;
    int tid, lane, wave, vcu, G;
    unsigned char* ws; unsigned char* dout; unsigned char* ws0; unsigned char* dout0;
    InTab in;
};
enum { I_X = 0, I_NMPRE, I_NMPOST, I_NFPRE, I_NFPOST, I_WIN, I_BGATE, I_MU, I_W0, I_W2, I_A0, I_A2, I_G2, I_KK, I_KA, I_RK, I_LNW, I_LNB,
       I_SARE, I_SAIM, I_SBRE, I_SBIM, I_SCRE, I_SCIM, I_SD, I_SLOG, I_WGLU, I_BGLU, I_WBR, I_WBS, I_WOUT, I_WUP, I_CONVW, I_CONVB, I_WDN };

__device__ __forceinline__ void p0_transpose_item(const float* W, int ldw, int k0, int src0, bf16_t* WT, int ldt, int drow0, int koff, const float* kscale, LAS float* scr, int lane) {
    const int q = lane & 7, rb = lane >> 3;
    f32x4 v[8]; float sc[8];
#pragma unroll
    for (int i = 0; i < 8; ++i) { const int kk = 8 * i + rb; v[i] = __builtin_nontemporal_load((const f32x4*)(W + (size_t)(k0 + kk) * ldw + src0 + 4 * q)); sc[i] = kscale ? kscale[k0 + kk] : 1.0f; }
#pragma unroll
    for (int i = 0; i < 8; ++i) { const int kk = 8 * i + rb; LAS float* d = scr + kk * 33 + 4 * q; d[0] = v[i].x * sc[i]; d[1] = v[i].y * sc[i]; d[2] = v[i].z * sc[i]; d[3] = v[i].w * sc[i]; }
    LDS_WAIT(); asm volatile("" ::: "memory");
    const int c = lane & 7;
#pragma unroll
    for (int j = 0; j < 4; ++j) { const int n = (lane >> 3) + 8 * j; const LAS float* s = scr + (8 * c) * 33 + n;
        u32x4 o; o.x = cvt_pk_bf16(s[0 * 33], s[1 * 33]); o.y = cvt_pk_bf16(s[2 * 33], s[3 * 33]); o.z = cvt_pk_bf16(s[4 * 33], s[5 * 33]); o.w = cvt_pk_bf16(s[6 * 33], s[7 * 33]);
        *(GAS u32x4*)(WT + (size_t)(drow0 + n) * ldt + koff + k0 + 8 * c) = o; }
    LDS_WAIT(); asm volatile("" ::: "memory");
}
struct TrMat { int in_idx, K, N, ldt, koff, kind; size_t dst; int scale_idx; };
__device__ __forceinline__ void p0_do_matrix(Frame& F, const TrMat& mtx, int r, LAS float* scr) {
    const int nblk = mtx.N / 32, kb = r / nblk, nb = r % nblk;
    int src0 = 32 * nb;
    if (mtx.kind == 1) {
        const int pn = (32 * nb) >> 8, within = (32 * nb) & 255;
        src0 = (within < 128 ? 0 : FF - 128) + 128 * pn + within;
    }
    p0_transpose_item(F.in[mtx.in_idx], mtx.N, 64 * kb, src0, (bf16_t*)(F.ws + mtx.dst), mtx.ldt, 32 * nb, mtx.koff, mtx.scale_idx >= 0 ? F.in[mtx.scale_idx] : nullptr, scr, F.lane);
}
__device__ __forceinline__ void p0_s5_group(Frame& F, int g) {
    LAS float* pwr = (LAS float*)(F.lds);
    LAS float* pwi = pwr + 17 * 64;
    LAS float* bbr = pwi + 17 * 64;
    LAS float* bbi = bbr + 1024;
    LAS float* cre = bbi + 1024;
    LAS float* cim = cre + 1024;
    LAS float* kk = cim + 1024;
    const float dt = expf(F.in[I_SLOG][g]);
    for (int idx = F.tid; idx < 17 * 64; idx += 512) { const int k = idx >> 6, p = idx & 63;
        const float are = F.in[I_SARE][g * 64 + p], aim = F.in[I_SAIM][g * 64 + p];
        const float mag = expf((float)k * are * dt); float sn, cs; sincosf((float)k * aim * dt, &sn, &cs);
        pwr[idx] = mag * cs; pwi[idx] = mag * sn; }
    for (int idx = F.tid; idx < 1024; idx += 512) { cre[idx] = F.in[I_SCRE][g * 1024 + idx]; cim[idx] = F.in[I_SCIM][g * 1024 + idx]; }
    __syncthreads();
    for (int idx = F.tid; idx < 1024; idx += 512) { const int p = idx >> 4;
        const float are = F.in[I_SARE][g * 64 + p], aim = F.in[I_SAIM][g * 64 + p];
        const float nr = pwr[64 + p] - 1.0f, ni = pwi[64 + p];
        const float den = 1.0f / (are * are + aim * aim);
        const float qr = (nr * are + ni * aim) * den, qi = (ni * are - nr * aim) * den;
        const float br = F.in[I_SBRE][g * 1024 + idx], bi = F.in[I_SBIM][g * 1024 + idx];
        bbr[idx] = qr * br - qi * bi; bbi[idx] = qr * bi + qi * br; }
    __syncthreads();
    {
        const int kc = F.tid & 255, ph = F.tid >> 8, k = kc >> 4, c = kc & 15; float s[16];
#pragma unroll
        for (int e = 0; e < 16; ++e) s[e] = 0.f;
        for (int p = 32 * ph; p < 32 * ph + 32; ++p) { const float cr_ = cre[c * 64 + p], ci_ = cim[c * 64 + p], pr_ = pwr[k * 64 + p], pi_ = pwi[k * 64 + p];
            const float xr = cr_ * pr_ - ci_ * pi_, xi = cr_ * pi_ + ci_ * pr_;
#pragma unroll
            for (int e4 = 0; e4 < 4; ++e4) { const f32x4 br = *(LAS const f32x4*)(bbr + p * 16 + 4 * e4), bi = *(LAS const f32x4*)(bbi + p * 16 + 4 * e4);
#pragma unroll
                for (int e = 0; e < 4; ++e) s[4 * e4 + e] += xr * br[e] - xi * bi[e]; } }
        LAS float* part = kk + 4096;
        if (ph == 1) {
#pragma unroll
            for (int e4 = 0; e4 < 4; ++e4) *(LAS f32x4*)(part + kc * 16 + 4 * e4) = (f32x4){s[4 * e4], s[4 * e4 + 1], s[4 * e4 + 2], s[4 * e4 + 3]}; }
        __syncthreads();
        if (ph == 0) {
#pragma unroll
            for (int e4 = 0; e4 < 4; ++e4) { const f32x4 o = *(LAS const f32x4*)(part + kc * 16 + 4 * e4);
#pragma unroll
                for (int e = 0; e < 4; ++e) { float v = s[4 * e4 + e] + o[e]; if (k == 0 && c == 4 * e4 + e) v += F.in[I_SD][g * 16 + c]; kk[kc * 16 + 4 * e4 + e] = v; } } }
    }
    __syncthreads();
    bf16_t* B1b = (bf16_t*)(F.ws + WS_B1B) + (size_t)g * 256 * 384;
    for (int idx = F.tid; idx < 256 * 48; idx += 512) { const int n = idx / 48, j = idx - n * 48, t = n >> 4, c = n & 15; float v[8];
        if (j < 32) { const int tau = j >> 1, cp0 = (j & 1) * 8; const int ko = (t >= tau ? t - tau : 0) * 256 + c * 16 + cp0; const float m = (t >= tau) ? 1.f : 0.f;
            const f32x4 a0 = *(LAS const f32x4*)(kk + ko), a1 = *(LAS const f32x4*)(kk + ko + 4);
#pragma unroll
            for (int e = 0; e < 4; ++e) { v[e] = a0[e] * m; v[4 + e] = a1[e] * m; } }
        else { const int p0 = (j - 32) * 4; const f32x4 cr4 = *(LAS const f32x4*)(cre + c * 64 + p0), ci4 = *(LAS const f32x4*)(cim + c * 64 + p0), pr4 = *(LAS const f32x4*)(pwr + (t + 1) * 64 + p0), pi4 = *(LAS const f32x4*)(pwi + (t + 1) * 64 + p0);
#pragma unroll
            for (int q = 0; q < 4; ++q) { v[2 * q] = cr4[q] * pr4[q] - ci4[q] * pi4[q]; v[2 * q + 1] = -(cr4[q] * pi4[q] + ci4[q] * pr4[q]); } }
        *(u32x4*)(B1b + (size_t)n * 384 + 8 * j) = pack8(v); }
    bf16_t* B1a = (bf16_t*)(F.ws + WS_B1A) + (size_t)g * 256 * 256;
    for (int idx = F.tid; idx < 256 * 32; idx += 512) { const int n = idx >> 5, j = idx & 31; float v[8];
#pragma unroll
        for (int e = 0; e < 8; ++e) v[e] = 0.f;
        if (n < 128) { const int p = n >> 1, tau = j >> 1, cp0 = (j & 1) * 8; const float pr_ = pwr[(15 - tau) * 64 + p], pi_ = pwi[(15 - tau) * 64 + p];
            const f32x4 r0 = *(LAS const f32x4*)(bbr + p * 16 + cp0), r1 = *(LAS const f32x4*)(bbr + p * 16 + cp0 + 4), i0 = *(LAS const f32x4*)(bbi + p * 16 + cp0), i1 = *(LAS const f32x4*)(bbi + p * 16 + cp0 + 4);
#pragma unroll
            for (int e = 0; e < 8; ++e) { const float br = e < 4 ? r0[e & 3] : r1[e & 3], bi = e < 4 ? i0[e & 3] : i1[e & 3]; v[e] = (n & 1) ? (pr_ * bi + pi_ * br) : (pr_ * br - pi_ * bi); } }
        *(u32x4*)(B1a + (size_t)n * 256 + 8 * j) = pack8(v); }
    float* aL = (float*)(F.ws + WS_AL) + g * 128;
    if (F.tid < 64) { aL[2 * F.tid] = pwr[16 * 64 + F.tid]; aL[2 * F.tid + 1] = pwi[16 * 64 + F.tid]; }
    __syncthreads();
}
#define DO_MAT(in_idx, K_, N_, ldt_, koff_, kind_, dst_, sc_) do { const TrMat mtx{in_idx, K_, N_, ldt_, koff_, kind_, dst_, sc_}; const int items = ((K_) / 64) * ((N_) / 32); \
        for (int it = gw; it < base + items; it += NGW) { if (it >= base) p0_do_matrix(F, mtx, it - base, scr); } base += items; } while (0)
__device__ __forceinline__ void p0_late_mats(Frame& F, int gw, int NGW) {
    LAS float* scr = (LAS float*)(F.lds + F.wave * 16384);
    int base = 0;
    DO_MAT(I_WUP, D, 2 * FF, D, 0, 1, WS_WUP, I_NFPRE); DO_MAT(I_WDN, FF, D, FF, 0, 0, WS_WDN, -1); DO_MAT(I_WOUT, D, D, D, 0, 0, WS_WOUT, -1);
    DO_MAT(I_WBR, RW, D, D, 0, 0, WS_WBRS, -1); DO_MAT(I_WBS, RW, D, D, RW, 0, WS_WBRS, -1); DO_MAT(I_WGLU, RW, RW, RW, 0, 0, WS_WGLU, -1);
}
__device__ __forceinline__ void p0_prologue(Frame& F) {
    const bool s5wg = F.vcu < S5G && F.G > S5G;
    if (F.vcu < S5G) p0_s5_group(F, F.vcu);
    if (!s5wg) {
        LAS float* scr = (LAS float*)(F.lds + F.wave * 16384);
        const int gw = (F.G > S5G ? F.vcu - S5G : F.vcu) * NWAVES + F.wave, NGW = (F.G > S5G ? F.G - S5G : F.G) * NWAVES;
        int base = 0;
        DO_MAT(I_WIN, D, NIN, D, 0, 0, WS_WIN, I_NMPRE);
        DO_MAT(I_W2, 64, RW, 64, 0, 0, WS_W2T, -1); DO_MAT(I_A2, 64, RW, 64, 0, 0, WS_A2T, -1); DO_MAT(I_G2, 128, RW, 128, 0, 0, WS_G2T, -1);
    }
    {
        bf16_t* XN = (bf16_t*)(F.ws + WS_XN);
        const int nch = T / 4, split = (F.G > S5G) ? nch / 2 : 0;
#pragma unroll 1
        for (int pass = 0; pass < 2; ++pass) {
            if (pass == 0 && (s5wg || split == 0)) continue;
            const int lo = pass == 0 ? 0 : split, hi = pass == 0 ? split : nch;
            const int gw = (pass == 0 ? F.vcu - S5G : F.vcu) * NWAVES + F.wave, NGW = (pass == 0 ? F.G - S5G : F.G) * NWAVES;
#pragma unroll 1
            for (int ch = lo + gw; ch < hi; ch += NGW) {
                const int m = 4 * ch;
                f32x4 v[4][4]; float s[4];
#pragma unroll
                for (int q = 0; q < 4; ++q) { const GAS f32x4* xr = (const GAS f32x4*)(F.in[I_X] + (size_t)(m + q) * D) + F.lane;
#pragma unroll
                    for (int j = 0; j < 4; ++j) v[q][j] = __builtin_nontemporal_load((const f32x4*)(xr + 64 * j)); }
#pragma unroll
                for (int q = 0; q < 4; ++q) { s[q] = 0.f;
#pragma unroll
                    for (int j = 0; j < 4; ++j) s[q] += (v[q][j].x * v[q][j].x + v[q][j].y * v[q][j].y) + (v[q][j].z * v[q][j].z + v[q][j].w * v[q][j].w); }
#pragma unroll
                for (int q = 0; q < 4; ++q) { const float r = 1.0f / sqrtf(wave_sum(s[q]) * (1.f / D) + 1e-6f);
                    GAS u32x2* o = (GAS u32x2*)(XN + (size_t)(m + q) * D) + F.lane;
#pragma unroll
                    for (int j = 0; j < 4; ++j) { u32x2 w; w.x = cvt_pk_bf16(v[q][j].x * r, v[q][j].y * r); w.y = cvt_pk_bf16(v[q][j].z * r, v[q][j].w * r); o[64 * j] = w; } }
            }
        }
    }
}

struct EpiInProj {
    static constexpr bool PERM = true, HAS_MID = false;
    bf16_t* PR; bf16_t* UG; bf16_t* GT; const float* bg; int mid_t;
    __device__ __forceinline__ void mid(f32x4 (&)[2][2][4][2], const pg8::Unit&, int, int, int, int) const {}
    __device__ __forceinline__ void operator()(const f32x4 (&acc)[2][2][4][2], const pg8::Unit& u, int wr, int wc, int fr, int fq) const {
        f32x4 b0[2], b1[2];
        if (u.pn >= 9) {
#pragma unroll
            for (int bj = 0; bj < 2; ++bj) { const int gc = (u.pn - 9) * 256 + bj * 128 + wc * 32 + 8 * fq; b0[bj] = *(const f32x4*)(bg + gc); b1[bj] = *(const f32x4*)(bg + gc + 4); } }
#pragma unroll
        for (int ai = 0; ai < 2; ++ai)
#pragma unroll
            for (int m = 0; m < 4; ++m) { const int row = u.pm * 256 + ai * 128 + wr * 64 + m * 16 + fr;
#pragma unroll
                for (int bj = 0; bj < 2; ++bj) { const int cl = bj * 128 + wc * 32 + 8 * fq; const f32x4 v0 = acc[ai][bj][m][0], v1 = acc[ai][bj][m][1]; u32x4 w;
                    if (u.pn < 7) { w.x = cvt_pk_bf16(v0[0], v0[1]); w.y = cvt_pk_bf16(v0[2], v0[3]); w.z = cvt_pk_bf16(v1[0], v1[1]); w.w = cvt_pk_bf16(v1[2], v1[3]);
                        *(u32x4*)(PR + (size_t)row * NRW + u.pn * 256 + cl) = w; }
                    else if (u.pn < 9) { const int cr = (u.pn - 7) * 256 + cl, g = cr >> 4, c0 = cr & 15;
                        w.x = cvt_pk_bf16(v0[0], v0[1]); w.y = cvt_pk_bf16(v0[2], v0[3]); w.z = cvt_pk_bf16(v1[0], v1[1]); w.w = cvt_pk_bf16(v1[2], v1[3]);
                        *(u32x4*)(UG + ((size_t)g * S5ROWS + (row >> 4)) * UGLD + (row & 15) * 16 + c0) = w; }
                    else { const int gc = (u.pn - 9) * 256 + cl;
                        w.x = cvt_pk_bf16(fsigmoid(v0[0] + b0[bj][0]), fsigmoid(v0[1] + b0[bj][1])); w.y = cvt_pk_bf16(fsigmoid(v0[2] + b0[bj][2]), fsigmoid(v0[3] + b0[bj][3]));
                        w.z = cvt_pk_bf16(fsigmoid(v1[0] + b1[bj][0]), fsigmoid(v1[1] + b1[bj][1])); w.w = cvt_pk_bf16(fsigmoid(v1[2] + b1[bj][2]), fsigmoid(v1[3] + b1[bj][3]));
                        __builtin_nontemporal_store(w, (u32x4*)(GT + ((size_t)(u.pm * 8 + (u.pn - 9)) << 16) + (((wr * 4 + wc) * 16 + (ai * 4 + m) * 2 + bj) << 9) + (fq * 16 + fr) * 8)); } }
                __builtin_amdgcn_sched_barrier(0); }
    }
};
struct FS5Out {
    static constexpr bool PIN = true;
    bf16_t* YSP;
    __device__ __forceinline__ void operator()(const pg8::Unit& u, int r, int cl, f32x4 v0, f32x4 v1) const {
        const int crow = u.pm * 256 + r; u32x4 w;
        w.x = cvt_pk_bf16(fgelu(v0[0]), fgelu(v0[1])); w.y = cvt_pk_bf16(fgelu(v0[2]), fgelu(v0[3])); w.z = cvt_pk_bf16(fgelu(v1[0]), fgelu(v1[1])); w.w = cvt_pk_bf16(fgelu(v1[2]), fgelu(v1[3]));
        *(u32x4*)(YSP + ((size_t)u.pn * S5ROWS + crow) * 256 + cl) = w;
    }
};
struct EpiGlu {
    static constexpr bool PERM = true, HAS_MID = false;
    const bf16_t* YSP; bf16_t* YS; const float* bglu; int mid_t;
    __device__ __forceinline__ void mid(f32x4 (&)[2][2][4][2], const pg8::Unit&, int, int, int, int) const {}
    __device__ __forceinline__ void operator()(const f32x4 (&acc)[2][2][4][2], const pg8::Unit& u, int wr, int wc, int fr, int fq) const {
        u32x4 yv[2][4][2]; f32x4 b0[2], b1[2];
#pragma unroll
        for (int bj = 0; bj < 2; ++bj) { const int col = u.pn * 256 + bj * 128 + wc * 32 + 8 * fq; b0[bj] = *(const f32x4*)(bglu + col); b1[bj] = *(const f32x4*)(bglu + col + 4); }
#pragma unroll
        for (int ai = 0; ai < 2; ++ai)
#pragma unroll
            for (int m = 0; m < 4; ++m)
#pragma unroll
                for (int bj = 0; bj < 2; ++bj) { const int row = u.pm * 256 + ai * 128 + wr * 64 + m * 16 + fr, col = u.pn * 256 + bj * 128 + wc * 32 + 8 * fq;
                    yv[ai][m][bj] = __builtin_nontemporal_load((const u32x4*)(YSP + ((size_t)(col >> 4) * S5ROWS + (row >> 4)) * 256 + (row & 15) * 16 + (col & 15))); }
#pragma unroll
        for (int ai = 0; ai < 2; ++ai)
#pragma unroll
            for (int m = 0; m < 4; ++m) {
#pragma unroll
                for (int bj = 0; bj < 2; ++bj) { const int row = u.pm * 256 + ai * 128 + wr * 64 + m * 16 + fr, col = u.pn * 256 + bj * 128 + wc * 32 + 8 * fq; float y[8]; unpack8(yv[ai][m][bj], y);
                    const f32x4 v0 = acc[ai][bj][m][0], v1 = acc[ai][bj][m][1]; u32x4 w;
                    w.x = cvt_pk_bf16(y[0] * fsigmoid(v0[0] + b0[bj][0]), y[1] * fsigmoid(v0[1] + b0[bj][1])); w.y = cvt_pk_bf16(y[2] * fsigmoid(v0[2] + b0[bj][2]), y[3] * fsigmoid(v0[3] + b0[bj][3]));
                    w.z = cvt_pk_bf16(y[4] * fsigmoid(v1[0] + b1[bj][0]), y[5] * fsigmoid(v1[1] + b1[bj][1])); w.w = cvt_pk_bf16(y[6] * fsigmoid(v1[2] + b1[bj][2]), y[7] * fsigmoid(v1[3] + b1[bj][3]));
                    *(u32x4*)(YS + (size_t)row * D + RW + col) = w; }
                __builtin_amdgcn_sched_barrier(0); }
    }
};
struct FStore {
    static constexpr bool PIN = false;
    bf16_t* O; int ldc;
    __device__ __forceinline__ void operator()(const pg8::Unit& u, int r, int cl, f32x4 v0, f32x4 v1) const {
        u32x4 w; w.x = cvt_pk_bf16(v0[0], v0[1]); w.y = cvt_pk_bf16(v0[2], v0[3]); w.z = cvt_pk_bf16(v1[0], v1[1]); w.w = cvt_pk_bf16(v1[2], v1[3]);
        *(u32x4*)(O + (size_t)(u.pm * 256 + r) * ldc + u.pn * 256 + cl) = w;
    }
};
struct EpiMerge {
    static constexpr bool PERM = true, HAS_MID = true;
    const bf16_t* GT; bf16_t* O; int mid_t;
    __device__ __forceinline__ void mid(f32x4 (&acc)[2][2][4][2], const pg8::Unit& u, int wr, int wc, int fr, int fq) const {
        unsigned vo = (unsigned)((((wr * 4 + wc) * 16) << 9) + (fq * 16 + fr) * 8) * 2u; asm volatile("" : "+v"(vo));
        const char* gr = (const char*)(GT + ((size_t)(u.pm * 8 + u.pn) << 16)); const char* gs = (const char*)(GT + ((size_t)(u.pm * 8 + 4 + u.pn) << 16));
#pragma unroll
        for (int ai = 0; ai < 2; ++ai)
#pragma unroll
            for (int m = 0; m < 4; ++m) {
                u32x4 a[2], b[2];
#pragma unroll
                for (int bj = 0; bj < 2; ++bj) { const unsigned go = vo + (unsigned)((((ai * 4 + m) * 2 + bj) << 9) * 2); a[bj] = __builtin_nontemporal_load((const u32x4*)(gr + go)); b[bj] = __builtin_nontemporal_load((const u32x4*)(gs + go)); }
                __builtin_amdgcn_sched_barrier(0);
#pragma unroll
                for (int bj = 0; bj < 2; ++bj) {
                    const unsigned aw[4] = {a[bj].x, a[bj].y, a[bj].z, a[bj].w}, bw[4] = {b[bj].x, b[bj].y, b[bj].z, b[bj].w};
#pragma unroll
                    for (int h = 0; h < 4; ++h) {
                        acc[ai][bj][m][h >> 1][2 * (h & 1)] *= bf_lo(aw[h]) * __builtin_amdgcn_rcpf(bf_lo(bw[h]));
                        acc[ai][bj][m][h >> 1][2 * (h & 1) + 1] *= bf_hi(aw[h]) * __builtin_amdgcn_rcpf(bf_hi(bw[h])); } }
                __builtin_amdgcn_sched_barrier(0);
            }
    }
    __device__ __forceinline__ void operator()(const f32x4 (&acc)[2][2][4][2], const pg8::Unit& u, int wr, int wc, int fr, int fq) const {
        const size_t lo = ((size_t)((wr * 4 + wc) * 16) << 9) + (fq * 16 + fr) * 8;
        const bf16_t* gs = GT + ((size_t)(u.pm * 8 + 4 + u.pn) << 16) + lo;
        u32x4 gv[2][4][2];
#pragma unroll
        for (int ai = 0; ai < 2; ++ai)
#pragma unroll
            for (int m = 0; m < 4; ++m)
#pragma unroll
                for (int bj = 0; bj < 2; ++bj) gv[ai][m][bj] = __builtin_nontemporal_load((const u32x4*)(gs + (((ai * 4 + m) * 2 + bj) << 9)));
#pragma unroll
        for (int ai = 0; ai < 2; ++ai)
#pragma unroll
            for (int m = 0; m < 4; ++m) {
#pragma unroll
                for (int bj = 0; bj < 2; ++bj) { const int row = u.pm * 256 + ai * 128 + wr * 64 + m * 16 + fr, col = u.pn * 256 + bj * 128 + wc * 32 + 8 * fq; float g[8]; unpack8(gv[ai][m][bj], g);
                    const f32x4 v0 = acc[ai][bj][m][0], v1 = acc[ai][bj][m][1]; u32x4 w;
                    w.x = cvt_pk_bf16(v0[0] * g[0], v0[1] * g[1]); w.y = cvt_pk_bf16(v0[2] * g[2], v0[3] * g[3]); w.z = cvt_pk_bf16(v1[0] * g[4], v1[1] * g[5]); w.w = cvt_pk_bf16(v1[2] * g[6], v1[3] * g[7]);
                    *(u32x4*)(O + (size_t)row * D + col) = w; }
                __builtin_amdgcn_sched_barrier(0); }
    }
};
struct UpOrder {
    const bf16_t* H2; const bf16_t* Wt; int G, c;
    __device__ bool next(int i, pg8::Unit& u) const {
        constexpr int nM = NB * 16, nN = 22, nwg = nM * nN;
        const long L = (long)i * G + c; if (L >= nwg) return false;
        int wgid = (int)L; { const int q = nwg / 8, r = nwg % 8, xcd = wgid % 8, off = wgid / 8; wgid = (xcd < r ? xcd * (q + 1) : r * (q + 1) + (xcd - r) * q) + off; }
        const int nig = 8 * nN, gid = wgid / nig, fm = gid * 8, gsz = (nM - fm) < 8 ? (nM - fm) : 8;
        u.pm = fm + ((wgid % nig) % gsz); u.pn = (wgid % nig) / gsz;
        u.a = (const char*)H2 + ((size_t)u.pm * 256 * D) * 2; u.b = (const char*)(Wt + (size_t)u.pn * 256 * D); return true;
    }
};
template <int CTRL> __device__ __forceinline__ unsigned dppu(unsigned v) { return (unsigned)__builtin_amdgcn_update_dpp(0, (int)v, CTRL, 0xf, 0xf, true); }
template <int CTRL> __device__ __forceinline__ unsigned dppk(unsigned keep, unsigned v) { return (unsigned)__builtin_amdgcn_update_dpp((int)keep, (int)v, CTRL, 0xf, 0xf, false); }
struct EpiConvAct {
    static constexpr bool PERM = true, HAS_MID = false;
    bf16_t* ACT; const float* cw; const float* cb; LAS unsigned* EX; unsigned long long* HZ; unsigned* tmo; int mid_t;
    __device__ __forceinline__ void mid(f32x4 (&)[2][2][4][2], const pg8::Unit&, int, int, int, int) const {}
    __device__ __forceinline__ void operator()(f32x4 (&acc)[2][2][4][2], const pg8::Unit& u, int wr, int wc, int fr, int fq) const {
        const int b = u.pm >> 4, k = u.pm & 15, t0 = 256 * k;
        u32x2 zp[2][2][4][2];
#pragma unroll
        for (int ai = 0; ai < 2; ++ai)
#pragma unroll
            for (int bj = 0; bj < 2; ++bj)
#pragma unroll
                for (int m = 0; m < 4; ++m)
#pragma unroll
                    for (int n = 0; n < 2; ++n) { const f32x4 v = acc[ai][bj][m][n]; u32x2 w; w.x = cvt_pk_bf16(v[0], v[1]); w.y = cvt_pk_bf16(v[2], v[3]); zp[ai][bj][m][n] = w; }
        if (fr >= 14) {
#pragma unroll
            for (int ai = 0; ai < 2; ++ai)
#pragma unroll
                for (int bj = 0; bj < 2; ++bj)
#pragma unroll
                    for (int n = 0; n < 2; ++n) *(LAS u32x2*)(EX + (((wc * 4 + 2 * ai + wr) * 2 + (fr - 14)) * 32 + bj * 16 + fq * 4 + n * 2)) = zp[ai][bj][3][n]; }
        if (wr == 1 && k < 15 && fr >= 14) {
            unsigned long long* hz = HZ + ((size_t)(u.pm * 22 + u.pn) * 8 + wc * 2 + (fr - 14)) * 32;
#pragma unroll
            for (int bj = 0; bj < 2; ++bj)
#pragma unroll
                for (int n = 0; n < 2; ++n) { __hip_atomic_store(hz + bj * 16 + fq * 4 + n * 2, (1ull << 32) | zp[1][bj][3][n].x, RLX_AGENT); __hip_atomic_store(hz + bj * 16 + fq * 4 + n * 2 + 1, (1ull << 32) | zp[1][bj][3][n].y, RLX_AGENT); }
        }
        asm volatile("s_waitcnt lgkmcnt(0)" ::: "memory"); __builtin_amdgcn_s_barrier(); asm volatile("" ::: "memory");
        const int ch0 = u.pn * 128 + wc * 32 + 8 * fq;
        f32x4 wg[2][3], wv[2][3], bg[2], bv[2];
#pragma unroll
        for (int n = 0; n < 2; ++n) {
#pragma unroll
            for (int j = 0; j < 3; ++j) { wg[n][j] = *(const f32x4*)(cw + (size_t)j * 2 * FF + ch0 + 4 * n); wv[n][j] = *(const f32x4*)(cw + (size_t)j * 2 * FF + FF + ch0 + 4 * n); }
            bg[n] = *(const f32x4*)(cb + ch0 + 4 * n); bv[n] = *(const f32x4*)(cb + FF + ch0 + 4 * n); }
#pragma unroll
        for (int gi = 1; gi <= 8; ++gi) {
            const int ai = (gi & 7) >> 2, m = gi & 3, blk = 2 * ai + wr;
            u32x2 pp[2][2];
#pragma unroll
            for (int bj = 0; bj < 2; ++bj)
#pragma unroll
                for (int n = 0; n < 2; ++n) { pp[bj][n].x = 0u; pp[bj][n].y = 0u; }
            if (m > 0) {
#pragma unroll
                for (int bj = 0; bj < 2; ++bj)
#pragma unroll
                    for (int n = 0; n < 2; ++n) pp[bj][n] = zp[ai][bj][m - 1][n];
            } else if (blk > 0) {
                if (fr >= 14) {
#pragma unroll
                    for (int bj = 0; bj < 2; ++bj)
#pragma unroll
                        for (int n = 0; n < 2; ++n) pp[bj][n] = *(LAS const u32x2*)(EX + (((wc * 4 + blk - 1) * 2 + (fr - 14)) * 32 + bj * 16 + fq * 4 + n * 2)); }
            } else if (k > 0) {
                if (fr >= 14) {
                    const unsigned long long* hz = HZ + ((size_t)((u.pm - 1) * 22 + u.pn) * 8 + wc * 2 + (fr - 14)) * 32;
#pragma unroll
                    for (int bj = 0; bj < 2; ++bj)
#pragma unroll
                        for (int n = 0; n < 2; ++n) { unsigned long long x0, x1; unsigned sp_ = 0;
                            for (;;) { x0 = __hip_atomic_load(hz + bj * 16 + fq * 4 + n * 2, RLX_AGENT); x1 = __hip_atomic_load(hz + bj * 16 + fq * 4 + n * 2 + 1, RLX_AGENT);
                                if ((x0 >> 32) == 1ull && (x1 >> 32) == 1ull) break; __builtin_amdgcn_s_sleep(2); if (++sp_ > (1u << 20)) { __hip_atomic_store(tmo, 1u, RLX_AGENT); break; } }
                            pp[bj][n].x = (unsigned)x0; pp[bj][n].y = (unsigned)x1; } }
            }
            u32x2 outp[2];
#pragma unroll
            for (int n = 0; n < 2; ++n) {
                const u32x2 zg = zp[ai][0][m][n], zv = zp[ai][1][m][n], pg = pp[0][n], pv = pp[1][n];
                u32x2 g1, g2, v1, v2;
                g1.x = dppk<0x111>(dppu<0x10F>(pg.x), zg.x); g1.y = dppk<0x111>(dppu<0x10F>(pg.y), zg.y); g2.x = dppk<0x112>(dppu<0x10E>(pg.x), zg.x); g2.y = dppk<0x112>(dppu<0x10E>(pg.y), zg.y);
                v1.x = dppk<0x111>(dppu<0x10F>(pv.x), zv.x); v1.y = dppk<0x111>(dppu<0x10F>(pv.y), zv.y); v2.x = dppk<0x112>(dppu<0x10E>(pv.x), zv.x); v2.y = dppk<0x112>(dppu<0x10E>(pv.y), zv.y);
                f32x2 o2[2];
#pragma unroll
                for (int e = 0; e < 2; ++e) {
                    const unsigned w0g = e ? zg.y : zg.x, w1g = e ? g1.y : g1.x, w2g = e ? g2.y : g2.x, w0v = e ? zv.y : zv.x, w1v = e ? v1.y : v1.x, w2v = e ? v2.y : v2.x;
                    const f32x2 z0g = {bf_lo(w0g), bf_hi(w0g)}, z1g = {bf_lo(w1g), bf_hi(w1g)}, z2g = {bf_lo(w2g), bf_hi(w2g)}, z0v = {bf_lo(w0v), bf_hi(w0v)}, z1v = {bf_lo(w1v), bf_hi(w1v)}, z2v = {bf_lo(w2v), bf_hi(w2v)};
                    const f32x2 kg0 = {wg[n][0][2 * e], wg[n][0][2 * e + 1]}, kg1 = {wg[n][1][2 * e], wg[n][1][2 * e + 1]}, kg2 = {wg[n][2][2 * e], wg[n][2][2 * e + 1]}, kb = {bg[n][2 * e], bg[n][2 * e + 1]};
                    const f32x2 kv0 = {wv[n][0][2 * e], wv[n][0][2 * e + 1]}, kv1 = {wv[n][1][2 * e], wv[n][1][2 * e + 1]}, kv2 = {wv[n][2][2 * e], wv[n][2][2 * e + 1]}, kc = {bv[n][2 * e], bv[n][2 * e + 1]};
                    const f32x2 cg = kb + kg0 * z2g + kg1 * z1g + kg2 * z0g, cv = kc + kv0 * z2v + kv1 * z1v + kv2 * z0v;
                    const f32x2 t = cg * cg, q = t * (f32x2){-0.1029432f, -0.1029432f} + (f32x2){-2.3022082f, -2.3022082f}, pw = cg * q;
                    const f32x2 ex = {__builtin_amdgcn_exp2f(pw.x), __builtin_amdgcn_exp2f(pw.y)}, dn = ex + (f32x2){1.f, 1.f};
                    const f32x2 rc = {__builtin_amdgcn_rcpf(dn.x), __builtin_amdgcn_rcpf(dn.y)};
                    o2[e] = (cg * cv) * rc; }
                const float o[4] = {o2[0].x, o2[0].y, o2[1].x, o2[1].y};
                outp[n].x = cvt_pk_bf16(o[0], o[1]); outp[n].y = cvt_pk_bf16(o[2], o[3]);
            }
            const int r = 128 * ai + 64 * wr + 16 * m + fr;
            { u32x4 w4; w4.x = outp[0].x; w4.y = outp[0].y; w4.z = outp[1].x; w4.w = outp[1].y; *(u32x4*)(ACT + ((size_t)(b * SEQ + t0 + r)) * FF + ch0) = w4; }
            __builtin_amdgcn_sched_barrier(0);
        }
    }
};
struct EpiRowStat {
    static constexpr bool PERM = true, HAS_MID = false; bf16_t* O; float* STAT; int mid_t;
    __device__ __forceinline__ void mid(f32x4 (&)[2][2][4][2], const pg8::Unit&, int, int, int, int) const {}
    __device__ __forceinline__ void operator()(const f32x4 (&acc)[2][2][4][2], const pg8::Unit& u, int wr, int wc, int fr, int fq) const {
#pragma unroll
        for (int ai = 0; ai < 2; ++ai)
#pragma unroll
            for (int m = 0; m < 4; ++m) { const int row = u.pm * 256 + ai * 128 + wr * 64 + m * 16 + fr; float s = 0.f;
#pragma unroll
                for (int bj = 0; bj < 2; ++bj) { const int col = u.pn * 256 + bj * 128 + wc * 32 + 8 * fq; const f32x4 v0 = acc[ai][bj][m][0], v1 = acc[ai][bj][m][1]; u32x4 w;
                    s += (v0[0] * v0[0] + v0[1] * v0[1]) + (v0[2] * v0[2] + v0[3] * v0[3]) + (v1[0] * v1[0] + v1[1] * v1[1]) + (v1[2] * v1[2] + v1[3] * v1[3]);
                    w.x = cvt_pk_bf16(v0[0], v0[1]); w.y = cvt_pk_bf16(v0[2], v0[3]); w.z = cvt_pk_bf16(v1[0], v1[1]); w.w = cvt_pk_bf16(v1[2], v1[3]);
                    __builtin_nontemporal_store(w, (u32x4*)(O + (size_t)row * D + col)); }
                s += __shfl_xor(s, 16); s += __shfl_xor(s, 32);
                if (fq == 0) STAT[(size_t)row * 16 + u.pn * 4 + wc] = s; }
    }
};
struct EpiSloc {
    static constexpr bool PERM = false, HAS_MID = false; float* SL; int mid_t;
    __device__ __forceinline__ void mid(f32x4 (&)[2][2][4][2], const pg8::Unit&, int, int, int, int) const {}
    __device__ __forceinline__ void operator()(const f32x4 (&acc)[2][2][4][2], const pg8::Unit& u, int wr, int wc, int fr, int fq) const {
#pragma unroll
        for (int ai = 0; ai < 2; ++ai)
#pragma unroll
            for (int m = 0; m < 4; ++m) { const int row = u.pm * 256 + ai * 128 + wr * 64 + m * 16 + fr; float* p = SL + ((size_t)u.pn * S5ROWS + row) * 128 + wc * 32 + 4 * fq;
                *(f32x4*)(p) = acc[ai][0][m][0]; *(f32x4*)(p + 16) = acc[ai][0][m][1]; }
    }
};
struct EpiSlocLds {
    static constexpr bool PERM = false, HAS_MID = false; LAS float* SL; int mid_t;
    __device__ __forceinline__ void mid(f32x4 (&)[2][2][4][2], const pg8::Unit&, int, int, int, int) const {}
    __device__ __forceinline__ void operator()(const f32x4 (&acc)[2][2][4][2], const pg8::Unit&, int wr, int wc, int fr, int fq) const {
        asm volatile("s_waitcnt vmcnt(0)" ::: "memory"); __builtin_amdgcn_s_barrier(); asm volatile("" ::: "memory");
#pragma unroll
        for (int ai = 0; ai < 2; ++ai)
#pragma unroll
            for (int m = 0; m < 4; ++m) { const int row = ai * 128 + wr * 64 + m * 16 + fr;
#pragma unroll
                for (int n = 0; n < 2; ++n) *(LAS f32x4*)(SL + row * 128 + (((wc * 8 + 4 * n + fq) ^ (row & 15)) << 2)) = acc[ai][0][m][n]; }
    }
};
struct S5One {
    const bf16_t* UG; const bf16_t* Bt; int ldb, gb;
    __device__ bool next(int i, pg8::Unit& u) const { if (i > 0) return false; const int g = gb >> 3; u.pm = gb & 7; u.pn = g;
        u.a = (const char*)(UG + ((size_t)g * S5ROWS + u.pm * 256) * UGLD); u.b = (const char*)(Bt + (size_t)g * 256 * ldb); return true; }
};
struct S5Order {
    const bf16_t* UG; const bf16_t* Bt; int ldb, G, c;
    __device__ bool next(int i, pg8::Unit& u) const { const int L = i * G + c; if (L >= S5G * 8) return false; const int g = L >> 3; u.pm = L & 7; u.pn = g;
        u.a = (const char*)(UG + ((size_t)g * S5ROWS + u.pm * 256) * UGLD); u.b = (const char*)(Bt + (size_t)g * 256 * ldb); return true; }
};

constexpr int LW = 72;
constexpr int SLOT = 64 * LW * 2;
#define SL(i) ((i) * SLOT)
#define BAR_LDS() do { asm volatile("s_waitcnt lgkmcnt(0)" ::: "memory"); __builtin_amdgcn_s_barrier(); asm volatile("" ::: "memory"); } while (0)
struct LdsMat { LAS const unsigned char* p; int ld; __device__ __forceinline__ bf16x8 frag(int row, int k) const { return *(LAS const bf16x8*)(p + ((size_t)row * ld + k) * 2); } };
struct GlbMat { const bf16_t* p; int ld; __device__ __forceinline__ bf16x8 frag(int row, int k) const { return *(const bf16x8*)(p + (size_t)row * ld + k); } };
template <int KD, class YM, class XM, class EPI>
__device__ __forceinline__ void mm64(const YM& Y, const XM& X, int wid, int lane, const EPI& epi) {
    asm volatile("" : "+v"(lane), "+s"(wid));
    const int at = wid >> 1, bt0 = (wid & 1) * 2, fr = lane & 15, fq = lane >> 4;
    f32x4 acc[2] = {(f32x4){0.f, 0.f, 0.f, 0.f}, (f32x4){0.f, 0.f, 0.f, 0.f}};
#pragma unroll
    for (int s = 0; s < KD / 32; ++s) {
        const bf16x8 yf = Y.frag(16 * at + fr, 32 * s + 8 * fq);
#pragma unroll
        for (int bi = 0; bi < 2; ++bi) { const bf16x8 xf = X.frag(16 * (bt0 + bi) + fr, 32 * s + 8 * fq);
            acc[bi] = __builtin_amdgcn_mfma_f32_16x16x32_bf16(xf, yf, acc[bi], 0, 0, 0); }
    }
#pragma unroll
    for (int bi = 0; bi < 2; ++bi) epi(16 * at + fr, 16 * (bt0 + bi) + 4 * fq, acc[bi]);
}
__device__ __forceinline__ void ld_yf(const LdsMat& Y, int at, int fr, int fq, bf16x8 (&y)[2]) {
#pragma unroll
    for (int s = 0; s < 2; ++s) y[s] = Y.frag(16 * at + fr, 32 * s + 8 * fq);
}
__device__ __forceinline__ void ld_xf(const LdsMat& X, int bt0, int fr, int fq, bf16x8 (&x)[2][2]) {
#pragma unroll
    for (int s = 0; s < 2; ++s)
#pragma unroll
        for (int bi = 0; bi < 2; ++bi) x[s][bi] = X.frag(16 * (bt0 + bi) + fr, 32 * s + 8 * fq);
}
__device__ __forceinline__ void mm_f(const bf16x8 (&y)[2], const bf16x8 (&x)[2][2], f32x4 (&acc)[2]) {
#pragma unroll
    for (int bi = 0; bi < 2; ++bi) acc[bi] = (f32x4){0.f, 0.f, 0.f, 0.f};
#pragma unroll
    for (int s = 0; s < 2; ++s)
#pragma unroll
        for (int bi = 0; bi < 2; ++bi) acc[bi] = __builtin_amdgcn_mfma_f32_16x16x32_bf16(x[s][bi], y[s], acc[bi], 0, 0, 0);
}
template <int KD>
__device__ __forceinline__ void preload_x(const GlbMat& X, int wid, int lane, bf16x8 (&xf)[KD / 32][2]) {
    const int bt0 = (wid & 1) * 2, fr = lane & 15, fq = lane >> 4;
#pragma unroll
    for (int s = 0; s < KD / 32; ++s)
#pragma unroll
        for (int bi = 0; bi < 2; ++bi) xf[s][bi] = X.frag(16 * (bt0 + bi) + fr, 32 * s + 8 * fq);
}
template <int KD, class YM, class EPI>
__device__ __forceinline__ void mm64_pre(const YM& Y, const bf16x8 (&xf)[KD / 32][2], int wid, int lane, const EPI& epi) {
    const int at = wid >> 1, bt0 = (wid & 1) * 2, fr = lane & 15, fq = lane >> 4;
    f32x4 acc[2] = {(f32x4){0.f, 0.f, 0.f, 0.f}, (f32x4){0.f, 0.f, 0.f, 0.f}};
#pragma unroll
    for (int s = 0; s < KD / 32; ++s) {
        const bf16x8 yf = Y.frag(16 * at + fr, 32 * s + 8 * fq);
#pragma unroll
        for (int bi = 0; bi < 2; ++bi) acc[bi] = __builtin_amdgcn_mfma_f32_16x16x32_bf16(xf[s][bi], yf, acc[bi], 0, 0, 0);
    }
#pragma unroll
    for (int bi = 0; bi < 2; ++bi) epi(16 * at + fr, 16 * (bt0 + bi) + 4 * fq, acc[bi]);
}
__device__ __forceinline__ void st_lds4(LAS unsigned char* base, int a, int b0, f32x4 v) { u32x2 w; w.x = cvt_pk_bf16(v[0], v[1]); w.y = cvt_pk_bf16(v[2], v[3]); *(LAS u32x2*)(base + ((size_t)a * LW + b0) * 2) = w; }
__device__ __forceinline__ f32x4 ld_lds4(LAS const unsigned char* base, int a, int b0) { const u32x2 w = *(LAS const u32x2*)(base + ((size_t)a * LW + b0) * 2); return (f32x4){bf_lo(w.x), bf_hi(w.x), bf_lo(w.y), bf_hi(w.y)}; }
__device__ __forceinline__ void st_glb4p(bf16_t* base, int a, int b0, f32x4 v) { u32x2 w; w.x = cvt_pk_bf16(v[0], v[1]); w.y = cvt_pk_bf16(v[2], v[3]); __builtin_nontemporal_store(w, (u32x2*)(base + (size_t)a * GLD + b0)); }
__device__ __forceinline__ void st_glb4(bf16_t* base, int a, int b0, f32x4 v) { u32x2 w; w.x = cvt_pk_bf16(v[0], v[1]); w.y = cvt_pk_bf16(v[2], v[3]); __builtin_nontemporal_store(w, (u32x2*)(base + (size_t)a * 64 + b0)); }

struct PrePf { u32x4 qa[3], qp[3], ra[4], rp[4], wt[4]; };
template <int PART>
__device__ __forceinline__ void rwkv_pre_fetch(Frame& F, int unit, bool lr_first, PrePf& P, int tid) {
    const int bh = unit >> 6, c = unit & 63, b = bh >> 3, h = bh & 7;
    const int t = tid >> 3, jb = tid & 7, j0 = jb * 8;
    const int tg = b * SEQ + c * 64 + t;
    const bool hasprev = (c * 64 + t) > 0;
    const bf16_t* prow = (const bf16_t*)(F.ws + WS_PR) + (size_t)tg * NRW; const bf16_t* pprv = hasprev ? prow - NRW : prow;
    if constexpr (PART != 1) {
#pragma unroll
        for (int seg = 0; seg < 3; ++seg) { const int col = seg * 512 + h * 64 + j0; P.qa[seg] = *(const u32x4*)(prow + col); P.qp[seg] = *(const u32x4*)(pprv + col); }
    }
    if constexpr (PART == 0) return;
    const u32x4* scr = (const u32x4*)(F.ws + WS_LRSCR) + ((size_t)F.vcu * 512 + tid) * 4;
    const u32x4* pa = lr_first ? (const u32x4*)(prow + 1536 + jb * 32) : scr; const u32x4* pp = lr_first ? (const u32x4*)(pprv + 1536 + jb * 32) : scr;
#pragma unroll
    for (int q4 = 0; q4 < 4; ++q4) { P.ra[q4] = pa[q4]; P.rp[q4] = pp[q4]; }
    P.wt[0] = ((const u32x4*)(F.ws + WS_W2T) + (size_t)h * 512)[tid]; P.wt[1] = ((const u32x4*)(F.ws + WS_A2T) + (size_t)h * 512)[tid];
    P.wt[2] = ((const u32x4*)(F.ws + WS_G2T) + (size_t)h * 1024)[tid]; P.wt[3] = ((const u32x4*)(F.ws + WS_G2T) + (size_t)h * 1024)[512 + tid];
}
__device__ __forceinline__ void rwkv_pre_put_w(LAS unsigned char* L, const PrePf& P, int tid) {
    const int r8 = tid >> 3, c8 = tid & 7, r16 = tid >> 4, c16 = tid & 15;
    *(LAS u32x4*)(L + SL(10) + ((size_t)r8 * LW + c8 * 8) * 2) = P.wt[0]; *(LAS u32x4*)(L + SL(11) + ((size_t)r8 * LW + c8 * 8) * 2) = P.wt[1];
    *(LAS u32x4*)(L + SL(12) + ((size_t)r16 * 136 + c16 * 8) * 2) = P.wt[2]; *(LAS u32x4*)(L + SL(12) + ((size_t)(32 + r16) * 136 + c16 * 8) * 2) = P.wt[3];
}
__device__ __forceinline__ void rwkv_pre_unit(Frame& F, int unit, int next_unit, bool lr_first, bool next_first, PrePf& P) {
    LAS unsigned char* L = F.lds;
    LAS float* XT = (LAS float*)(F.lds + XTRA_OFF);
    int tid = F.tid; asm volatile("" : "+v"(tid));
    int wid = F.wave; asm volatile("" : "+s"(wid));
    const int lane = tid & 63;
    const int bh = unit >> 6, c = unit & 63, b = bh >> 3, h = bh & 7;
    const int t = tid >> 3, jb = tid & 7, j0 = jb * 8;
    const int tg = b * SEQ + c * 64 + t;
    const bool hasprev = (c * 64 + t) > 0;
    const bf16_t* PR = (const bf16_t*)(F.ws + WS_PR);
    const bf16_t* prow = PR + (size_t)tg * NRW; const bf16_t* pprev = prow - NRW;
    LAS const float* mu = (LAS const float*)(F.lds + XTRA_OFF + 4096);
    LAS const float* par = mu + NRW;
    float rs[8], ks[8], vs[8];
    {
        const int c0 = 1536 + jb * 32;
        const float pmask = hasprev ? 1.f : 0.f;
        f32x4 mq[3][2];
#pragma unroll
        for (int seg = 0; seg < 3; ++seg) { const int col = seg * 512 + h * 64 + j0; mq[seg][0] = *(LAS const f32x4*)(mu + col); mq[seg][1] = *(LAS const f32x4*)(mu + col + 4); }
        LAS unsigned char* dst = (jb < 2) ? (L + SL(0) + ((size_t)t * LW + jb * 32) * 2) : (jb < 4) ? (L + SL(1) + ((size_t)t * LW + (jb - 2) * 32) * 2) : (L + SL(2) + ((size_t)t * 136 + (jb - 4) * 32) * 2);
        u32x4* scr = (u32x4*)(F.ws + WS_LRSCR) + ((size_t)F.vcu * 512 + tid) * 4;
        if (lr_first) {
            f32x4 ma[4][2];
#pragma unroll
            for (int q4 = 0; q4 < 4; ++q4) { ma[q4][0] = *(LAS const f32x4*)(mu + c0 + q4 * 8); ma[q4][1] = *(LAS const f32x4*)(mu + c0 + q4 * 8 + 4); }
#pragma unroll
            for (int q4 = 0; q4 < 4; ++q4) { float x[8], xp[8], o[8]; unpack8(P.ra[q4], x); unpack8(P.rp[q4], xp);
#pragma unroll
                for (int e = 0; e < 8; ++e) { const float mm = e < 4 ? ma[q4][0][e] : ma[q4][1][e - 4]; const float s = x[e] + (xp[e] * pmask - x[e]) * mm;
                    const float ex = __builtin_amdgcn_exp2f((jb < 2 ? 2.88539008178f : -1.44269504089f) * s), rc = __builtin_amdgcn_rcpf(1.0f + ex);
                    o[e] = jb < 2 ? 1.0f - 2.0f * rc : (jb < 4 ? s : rc); }
                const u32x4 w = pack8(o); *(LAS u32x4*)(dst + q4 * 16) = w; scr[q4] = w; }
        } else {
#pragma unroll
            for (int q4 = 0; q4 < 4; ++q4) *(LAS u32x4*)(dst + q4 * 16) = P.ra[q4];
        }
#pragma unroll
        for (int seg = 0; seg < 3; ++seg) { float x[8], xp[8]; unpack8(P.qa[seg], x); unpack8(P.qp[seg], xp);
#pragma unroll
            for (int e = 0; e < 8; ++e) { const float mm = e < 4 ? mq[seg][0][e] : mq[seg][1][e - 4]; const float s = x[e] + (xp[e] * pmask - x[e]) * mm; if (seg == 0) rs[e] = s; else if (seg == 1) ks[e] = s; else vs[e] = s; } }
    }
    BAR_LDS();
    if (next_unit < NUNIT) rwkv_pre_fetch<0>(F, next_unit, next_first, P, tid);
    {
        const LdsMat Yw{L + SL(0), LW}, Ya{L + SL(1), LW}, Yg{L + SL(2), 136};
        const LdsMat Xw{L + SL(10), LW}, Xa{L + SL(11), LW}, Xg{L + SL(12), 136};
        mm64<64>(Yw, Xw, wid, lane, [&](int a, int b0, f32x4 v) { *(LAS f32x4*)(L + SL(4) + ((size_t)a * 68 + b0) * 4) = v; });
        mm64<64>(Ya, Xa, wid, lane, [&](int a, int b0, f32x4 v) { *(LAS f32x4*)(L + SL(6) + ((size_t)a * 68 + b0) * 4) = v; });
        mm64<128>(Yg, Xg, wid, lane, [&](int a, int b0, f32x4 v) { *(LAS f32x4*)(L + SL(8) + ((size_t)a * 68 + b0) * 4) = v; });
    }
    BAR_LDS();
    float ld[8], kp[8], av[8], bv[8];
    {
        const int hc = h * 64 + j0;
        float wp[8], ap[8], gg[8], w0[8], a0[8], kkw[8], kaw[8], rk[8];
        *(f32x4*)&wp[0] = *(LAS f32x4*)(L + SL(4) + ((size_t)t * 68 + j0) * 4); *(f32x4*)&wp[4] = *(LAS f32x4*)(L + SL(4) + ((size_t)t * 68 + j0 + 4) * 4);
        *(f32x4*)&ap[0] = *(LAS f32x4*)(L + SL(6) + ((size_t)t * 68 + j0) * 4); *(f32x4*)&ap[4] = *(LAS f32x4*)(L + SL(6) + ((size_t)t * 68 + j0 + 4) * 4);
        *(f32x4*)&gg[0] = *(LAS f32x4*)(L + SL(8) + ((size_t)t * 68 + j0) * 4); *(f32x4*)&gg[4] = *(LAS f32x4*)(L + SL(8) + ((size_t)t * 68 + j0 + 4) * 4);
        *(f32x4*)&w0[0] = *(LAS const f32x4*)(par + 0 + hc); *(f32x4*)&w0[4] = *(LAS const f32x4*)(par + 0 + hc + 4);
        *(f32x4*)&a0[0] = *(LAS const f32x4*)(par + 512 + hc); *(f32x4*)&a0[4] = *(LAS const f32x4*)(par + 512 + hc + 4);
        *(f32x4*)&kkw[0] = *(LAS const f32x4*)(par + 1024 + hc); *(f32x4*)&kkw[4] = *(LAS const f32x4*)(par + 1024 + hc + 4);
        *(f32x4*)&kaw[0] = *(LAS const f32x4*)(par + 1536 + hc); *(f32x4*)&kaw[4] = *(LAS const f32x4*)(par + 1536 + hc + 4);
        *(f32x4*)&rk[0] = *(LAS const f32x4*)(par + 2048 + hc); *(f32x4*)&rk[4] = *(LAS const f32x4*)(par + 2048 + hc + 4);
        float ss = 0.f, bon = 0.f, kkv[8], eta[8];
#pragma unroll
        for (int e = 0; e < 8; ++e) {
            ld[e] = -0.60653065971f * fsigmoid(w0[e] + wp[e]);
            eta[e] = fsigmoid(a0[e] + ap[e]);
            kkv[e] = ks[e] * kkw[e]; ss += kkv[e] * kkv[e];
            kp[e] = ks[e] * (1.0f + (eta[e] - 1.0f) * kaw[e]);
            bon += rs[e] * kp[e] * rk[e];
        }
        ss += __shfl_xor(ss, 1); ss += __shfl_xor(ss, 2); ss += __shfl_xor(ss, 4);
        bon += __shfl_xor(bon, 1); bon += __shfl_xor(bon, 2); bon += __shfl_xor(bon, 4);
        const float inv = __builtin_amdgcn_rcpf(fmaxf(__builtin_amdgcn_sqrtf(ss), 1e-12f));
#pragma unroll
        for (int e = 0; e < 8; ++e) { const float kk = kkv[e] * inv; av[e] = -kk; bv[e] = kk * eta[e]; }
        if (jb == 0) ((float*)(F.ws + WS_BONUS))[(size_t)tg * 8 + h] = bon;
        *(u32x4*)((bf16_t*)(F.ws + WS_GBUF) + (size_t)tg * RW + hc) = pack8(gg);
    }
    float Lc[8];
#pragma unroll
    for (int e = 0; e < 8; ++e) { float x = ld[e];
        float y = __shfl_up(x, 8); if (lane >= 8) x += y;
        y = __shfl_up(x, 16); if (lane >= 16) x += y;
        y = __shfl_up(x, 32); if (lane >= 32) x += y;
        Lc[e] = x; }
    if (lane >= 56) {
#pragma unroll
        for (int e = 0; e < 8; ++e) XT[wid * 64 + j0 + e] = Lc[e]; }
    BAR_LDS();
    {
        float pre[8];
#pragma unroll
        for (int e = 0; e < 8; ++e) pre[e] = 0.f;
#pragma unroll
        for (int w = 0; w < 7; ++w) if (w < wid) { const f32x4 x0 = *(LAS const f32x4*)(XT + w * 64 + j0), x1 = *(LAS const f32x4*)(XT + w * 64 + j0 + 4);
#pragma unroll
            for (int e = 0; e < 4; ++e) { pre[e] += x0[e]; pre[4 + e] += x1[e]; } }
#pragma unroll
        for (int e = 0; e < 8; ++e) Lc[e] += pre[e];
    }
    if (t == 63) {
#pragma unroll
        for (int e = 0; e < 8; ++e) XT[512 + j0 + e] = fexp(Lc[e]); }
    {
        float o0[8], o1[8], o2[8], o3[8];
#pragma unroll
        for (int e = 0; e < 8; ++e) { const float ein = fexp(Lc[e]), eout = __builtin_amdgcn_rcpf(ein), eex = fexp(Lc[e] - ld[e]);
            o0[e] = rs[e] * ein; o1[e] = kp[e] * eout; o2[e] = av[e] * eex; o3[e] = bv[e] * eout; }
        const size_t off = ((size_t)t * LW + j0) * 2;
        *(LAS u32x4*)(L + SL(10) + off) = pack8(o0); *(LAS u32x4*)(L + SL(11) + off) = pack8(o1); *(LAS u32x4*)(L + SL(12) + off) = pack8(o2); *(LAS u32x4*)(L + SL(13) + off) = pack8(o3);
        *(LAS u32x4*)(L + SL(2) + off) = pack8(vs);
    }
    BAR_LDS();
    {
        const int srcs[4] = {12, 13, 11, 2}, dsts[4] = {4, 5, 6, 7};
#pragma unroll
        for (int q = 0; q < 4; ++q) { unsigned short hv[8];
#pragma unroll
            for (int e = 0; e < 8; ++e) hv[e] = *(LAS const unsigned short*)(L + SL(srcs[q]) + ((size_t)(8 * wid + e) * LW + lane) * 2);
            u32x4 w; w.x = hv[0] | ((unsigned)hv[1] << 16); w.y = hv[2] | ((unsigned)hv[3] << 16); w.z = hv[4] | ((unsigned)hv[5] << 16); w.w = hv[6] | ((unsigned)hv[7] << 16);
            *(LAS u32x4*)(L + SL(dsts[q]) + ((size_t)lane * LW + 8 * wid) * 2) = w;
        }
    }
    BAR_LDS();
    if (next_unit < NUNIT) rwkv_pre_fetch<1>(F, next_unit, next_first, P, tid);
    const size_t fsrc = ((size_t)(16 * (tid >> 7) + (tid & 15)) * LW + 32 * ((tid >> 6) & 1) + 8 * ((tid >> 4) & 3)) * 2;
    __builtin_nontemporal_store(*(LAS const u32x4*)(L + SL(7) + fsrc), (u32x4*)((bf16_t*)(F.ws + WS_VT) + (size_t)unit * 4096) + tid);
    {
        const LdsMat Rt{L + SL(10), LW}, Kt{L + SL(11), LW}, At{L + SL(12), LW}, Bt{L + SL(13), LW};
        f32x4 nd = (f32x4){0.f, 0.f, 0.f, 0.f}, ntd = nd;
        {
            int ln = lane, wd = wid; asm volatile("" : "+v"(ln), "+s"(wd));
            const int at = wd >> 1, bt0 = (wd & 1) * 2, fr = ln & 15, fq = ln >> 4, a = 16 * at + fr;
            bf16x8 yA[2], yK[2], yR[2], xB[2][2], xA[2][2], xK[2][2];
            ld_yf(At, at, fr, fq, yA); ld_xf(Bt, bt0, fr, fq, xB); ld_yf(Kt, at, fr, fq, yK); ld_xf(At, bt0, fr, fq, xA); ld_yf(Rt, at, fr, fq, yR); ld_xf(Kt, bt0, fr, fq, xK);
            const bool diag = bt0 == (at & 2);
            bf16x8 xd[2];
            if (diag) ld_yf(Bt, at, fr, fq, xd);
            f32x4 c0[2], c1[2], c2[2], c3[2];
            mm_f(yA, xB, c0); mm_f(yK, xA, c1); mm_f(yR, xB, c2); mm_f(yR, xK, c3);
            if (diag) {
                f32x4 v = (f32x4){0.f, 0.f, 0.f, 0.f};
#pragma unroll
                for (int s = 0; s < 2; ++s) v = __builtin_amdgcn_mfma_f32_16x16x32_bf16(yA[s], xd[s], v, 0, 0, 0);
#pragma unroll
                for (int e = 0; e < 4; ++e) v[e] = (fr < 4 * fq + e) ? v[e] : 0.f;
                nd = v; }
#pragma unroll
            for (int bi = 0; bi < 2; ++bi) { const int b0 = 16 * (bt0 + bi) + 4 * fq; f32x4 v0 = c0[bi], v1 = c1[bi], v2 = c2[bi], v3 = c3[bi];
#pragma unroll
                for (int e = 0; e < 4; ++e) { v0[e] = (b0 + e < a) ? v0[e] : 0.f; v1[e] = (a < b0 + e) ? v1[e] : 0.f; v2[e] = (b0 + e <= a) ? v2[e] : 0.f; v3[e] = (b0 + e <= a) ? v3[e] : 0.f; }
                st_lds4(L + SL(1), a, b0, v0); st_lds4(L + SL(2), a, b0, v1); st_lds4(L + SL(3), a, b0, v2); st_lds4(L + SL(8), a, b0, v3);
                if (bt0 + bi == at) ntd = v0; }
        }
        const int at = wid >> 1;
        if (((wid & 1) * 2 == (at & 2))) {
            const int fr = lane & 15, fq = lane >> 4;
            auto op = [](f32x4 v) { u32x4 w; w.x = cvt_pk_bf16(v[0], v[1]); w.y = cvt_pk_bf16(v[2], v[3]); w.z = 0u; w.w = 0u; return __builtin_bit_cast(bf16x8, w); };
            const f32x4 zero = (f32x4){0.f, 0.f, 0.f, 0.f};
            const f32x4 Lm = ntd, LT = nd;
            f32x4 Q = Lm;
#pragma unroll
            for (int e = 0; e < 4; ++e) Q[e] += (4 * fq + e == fr) ? 1.f : 0.f;
            const f32x4 L2 = __builtin_amdgcn_mfma_f32_16x16x32_bf16(op(LT), op(Lm), zero, 0, 0, 0), L2T = __builtin_amdgcn_mfma_f32_16x16x32_bf16(op(Lm), op(LT), zero, 0, 0, 0);
            Q = __builtin_amdgcn_mfma_f32_16x16x32_bf16(op(L2T), op(Q), Q, 0, 0, 0);
            const f32x4 L4 = __builtin_amdgcn_mfma_f32_16x16x32_bf16(op(L2T), op(L2), zero, 0, 0, 0), L4T = __builtin_amdgcn_mfma_f32_16x16x32_bf16(op(L2), op(L2T), zero, 0, 0, 0);
            Q = __builtin_amdgcn_mfma_f32_16x16x32_bf16(op(L4T), op(Q), Q, 0, 0, 0);
            const f32x4 L8T = __builtin_amdgcn_mfma_f32_16x16x32_bf16(op(L4), op(L4T), zero, 0, 0, 0);
            Q = __builtin_amdgcn_mfma_f32_16x16x32_bf16(op(L8T), op(Q), Q, 0, 0, 0);
            st_lds4(L + SL(9), 16 * at + fr, 4 * fq, Q);
        }
    }
    BAR_LDS();
    {
        const int fr = lane & 15, fq = lane >> 4;
        LAS const unsigned char* zsl = L + (wid < 4 ? SL(4) : SL(2)); LAS unsigned char* dsl = L + (wid < 4 ? SL(11) : SL(12));
        const int arow = 16 * (wid & 3) + fr;
        u32x2 zp[4];
#pragma unroll
        for (int c = 0; c < 4; ++c) {
            f32x4 acc = ld_lds4(zsl, arow, 16 * c + 4 * fq);
            if (c >= 1) {
                const u32x2 alo = *(LAS const u32x2*)(L + SL(1) + ((size_t)(16 * c + fr) * LW + 4 * fq) * 2), ahi = *(LAS const u32x2*)(L + SL(1) + ((size_t)(16 * c + fr) * LW + 16 + 4 * fq) * 2);
                u32x4 aw; aw.x = alo.x; aw.y = alo.y; aw.z = ahi.x; aw.w = ahi.y;
                u32x4 bw; bw.x = zp[0].x; bw.y = zp[0].y; bw.z = c >= 2 ? zp[1].x : 0u; bw.w = c >= 2 ? zp[1].y : 0u;
                acc = __builtin_amdgcn_mfma_f32_16x16x32_bf16(__builtin_bit_cast(bf16x8, aw), __builtin_bit_cast(bf16x8, bw), acc, 0, 0, 0); }
            if (c == 3) {
                const u32x2 alo = *(LAS const u32x2*)(L + SL(1) + ((size_t)(48 + fr) * LW + 32 + 4 * fq) * 2);
                u32x4 aw; aw.x = alo.x; aw.y = alo.y; aw.z = 0u; aw.w = 0u;
                u32x4 bw; bw.x = zp[2].x; bw.y = zp[2].y; bw.z = 0u; bw.w = 0u;
                acc = __builtin_amdgcn_mfma_f32_16x16x32_bf16(__builtin_bit_cast(bf16x8, aw), __builtin_bit_cast(bf16x8, bw), acc, 0, 0, 0); }
            const u32x2 dlo = *(LAS const u32x2*)(L + SL(9) + ((size_t)(16 * c + fr) * LW + 4 * fq) * 2);
            u32x4 aw; aw.x = dlo.x; aw.y = dlo.y; aw.z = 0u; aw.w = 0u;
            u32x4 bw; bw.x = cvt_pk_bf16(acc[0], acc[1]); bw.y = cvt_pk_bf16(acc[2], acc[3]); bw.z = 0u; bw.w = 0u;
            const f32x4 r = __builtin_amdgcn_mfma_f32_16x16x32_bf16(__builtin_bit_cast(bf16x8, aw), __builtin_bit_cast(bf16x8, bw), (f32x4){0.f, 0.f, 0.f, 0.f}, 0, 0, 0);
            zp[c].x = cvt_pk_bf16(r[0], r[1]); zp[c].y = cvt_pk_bf16(r[2], r[3]);
            *(LAS u32x2*)(dsl + ((size_t)arow * LW + 16 * c + 4 * fq) * 2) = zp[c];
        }
    }
    BAR_LDS();
    {
        const int sAT = 11, sAkT = 12, sHk = 0;
        const LdsMat AT{L + SL(sAT), LW}, AkT{L + SL(sAkT), LW}, AbrT{L + SL(3), LW}, BgT{L + SL(5), LW}, VTm{L + SL(7), LW};
        bf16_t* QRT = (bf16_t*)(F.ws + WS_QRT) + (size_t)unit * 4096; bf16_t* WYT = (bf16_t*)(F.ws + WS_WYT) + (size_t)unit * 4096;
        bf16_t* GTg = (bf16_t*)(F.dout + DO_GT) + (size_t)unit * (64 * GLD); bf16_t* Hg = (bf16_t*)(F.dout + DO_H) + (size_t)unit * (64 * GLD);
        {
            int ln = lane, wd = wid; asm volatile("" : "+v"(ln), "+s"(wd));
            const int at = wd >> 1, bt0 = (wd & 1) * 2, fr = ln & 15, fq = ln >> 4, a = 16 * at + fr;
            bf16x8 yA[2], yB[2], xT[2][2], xK[2][2];
            ld_yf(BgT, at, fr, fq, yB); ld_xf(AkT, bt0, fr, fq, xK); ld_yf(AbrT, at, fr, fq, yA); ld_xf(AT, bt0, fr, fq, xT);
            f32x4 eH[2], eR[2], eW[2];
#pragma unroll
            for (int bi = 0; bi < 2; ++bi) { const int b0 = 16 * (bt0 + bi) + 4 * fq; eH[bi] = ld_lds4(L + SL(6), a, b0); eR[bi] = ld_lds4(L + SL(10), a, b0); eW[bi] = ld_lds4(L + SL(8), a, b0); }
            const float gdiag = XT[512 + a];
            f32x4 cH[2], cQ[2], cW[2], cG[2];
            mm_f(yB, xK, cH); mm_f(yA, xT, cQ); mm_f(yA, xK, cW); mm_f(yB, xT, cG);
#pragma unroll
            for (int bi = 0; bi < 2; ++bi) { const int b0 = 16 * (bt0 + bi) + 4 * fq;
                st_lds4(L + SL(sHk), a, b0, (cH[bi] + eH[bi]) * gdiag);
                st_lds4(L + SL(1), a, b0, cQ[bi] + eR[bi]);
                st_lds4(L + SL(2), a, b0, cW[bi] + eW[bi]);
                f32x4 v = cG[bi];
#pragma unroll
                for (int e = 0; e < 4; ++e) v[e] += (b0 + e == a) ? 1.f : 0.f;
                st_lds4(L + SL(4), a, b0, v * gdiag); }
        }
        BAR_LDS();
        const LdsMat HkT{L + SL(sHk), LW};
        mm64<64>(VTm, HkT, wid, lane, [&](int a, int b0, f32x4 v) { st_lds4(L + SL(9), a, b0, v); });
        __builtin_nontemporal_store(*(LAS const u32x4*)(L + SL(1) + fsrc), (u32x4*)QRT + tid);
        __builtin_nontemporal_store(*(LAS const u32x4*)(L + SL(2) + fsrc), (u32x4*)WYT + tid);
        __builtin_nontemporal_store(*(LAS const u32x4*)(L + SL(4) + (size_t)tid * 16), (u32x4*)GTg + tid);
        if (tid < 64) __builtin_nontemporal_store(*(LAS const u32x4*)(L + SL(4) + (size_t)(512 + tid) * 16), (u32x4*)GTg + 512 + tid);
        if (next_unit < NUNIT) rwkv_pre_put_w(L, P, tid);
        BAR_LDS();
        __builtin_nontemporal_store(*(LAS const u32x4*)(L + SL(9) + (size_t)tid * 16), (u32x4*)Hg + tid);
        if (tid < 64) __builtin_nontemporal_store(*(LAS const u32x4*)(L + SL(9) + (size_t)(512 + tid) * 16), (u32x4*)Hg + 512 + tid);
    }
}

constexpr int RS_SLOT = 12 * 1024;
constexpr int RS_DEPTH = 8, RS_AHEAD = 6;
__device__ __forceinline__ void rwkv_scan_block(Frame& F, int item) {
    const int bh = item >> 2, qi = item & 3, lane = F.lane, fr = lane & 15, fq = lane >> 4, wid = F.wave;
    const char* GTg = (const char*)(F.dout + DO_GT) + (size_t)bh * 64 * (64 * GLD * 2);
    const char* Hg = (const char*)(F.dout + DO_H) + (size_t)bh * 64 * (64 * GLD * 2) + (size_t)qi * (16 * GLD * 2);
    bf16_t* SST = (bf16_t*)(F.dout + DO_SST) + (size_t)bh * 64 * 4096;
    LAS unsigned char* L = F.lds;
    auto issue = [&](int c) {
        if (wid >= 1) {
            LAS unsigned char* slot = L + (c & (RS_DEPTH - 1)) * RS_SLOT;
#pragma unroll
            for (int k = 0; k < 2; ++k) { const int pc = (wid - 1) + 7 * k;
                if (pc < 12) {
                    const char* src;
                    if (pc < 9) src = GTg + (size_t)c * (64 * GLD * 2) + pc * 1024 + lane * 16;
                    else { int off = (pc - 9) * 1024 + lane * 16; off = off > 2304 - 16 ? 2304 - 16 : off; src = Hg + (size_t)c * (64 * GLD * 2) + off; }
                    __builtin_amdgcn_global_load_lds((const unsigned*)src, (LAS unsigned*)(slot + pc * 1024), 16, 0, 0); } }
        }
    };
    f32x4 acc[4];
#pragma unroll
    for (int mt = 0; mt < 4; ++mt) acc[mt] = (f32x4){0.f, 0.f, 0.f, 0.f};
#pragma unroll 1
    for (int c = 0; c < RS_AHEAD; ++c) issue(c);
#pragma unroll 1
    for (int c = 0; c < NCH; ++c) {
        if (c + RS_AHEAD < NCH) issue(c + RS_AHEAD);
        if (c + RS_AHEAD < NCH) { if (wid >= 1 && wid <= 5) asm volatile("s_waitcnt vmcnt(12)" ::: "memory"); else if (wid >= 6) asm volatile("s_waitcnt vmcnt(6)" ::: "memory"); }
        else if (wid >= 1) asm volatile("s_waitcnt vmcnt(0)" ::: "memory");
        __builtin_amdgcn_s_barrier(); asm volatile("" ::: "memory");
        if (wid == 0) {
            LAS const unsigned char* slot = L + (c & (RS_DEPTH - 1)) * RS_SLOT;
            u32x2 ga[4][2][2], hv[4];
#pragma unroll
            for (int mt = 0; mt < 4; ++mt) {
#pragma unroll
                for (int s = 0; s < 2; ++s)
#pragma unroll
                    for (int hh = 0; hh < 2; ++hh) ga[mt][s][hh] = *(LAS const u32x2*)(slot + ((16 * mt + fr) * GLD + 16 * (2 * s + hh) + 4 * fq) * 2);
                hv[mt] = *(LAS const u32x2*)(slot + 9216 + (fr * GLD + 16 * mt + 4 * fq) * 2); }
            bf16_t* Sc = SST + (size_t)c * 4096; u32x2 sp[4];
#pragma unroll
            for (int mt = 0; mt < 4; ++mt) { sp[mt].x = cvt_pk_bf16(acc[mt][0], acc[mt][1]); sp[mt].y = cvt_pk_bf16(acc[mt][2], acc[mt][3]);
                *(u32x2*)(Sc + ((size_t)((qi * 2 + (mt >> 1)) * 64 + (2 * (mt & 1) + (fq >> 1)) * 16 + fr)) * 8 + 4 * (fq & 1)) = sp[mt]; }
            bf16x8 sb[2];
#pragma unroll
            for (int s = 0; s < 2; ++s) { u32x4 w; w.x = sp[2 * s].x; w.y = sp[2 * s].y; w.z = sp[2 * s + 1].x; w.w = sp[2 * s + 1].y; sb[s] = __builtin_bit_cast(bf16x8, w); }
#pragma unroll
            for (int mt = 0; mt < 4; ++mt) { f32x4 a = (f32x4){bf_lo(hv[mt].x), bf_hi(hv[mt].x), bf_lo(hv[mt].y), bf_hi(hv[mt].y)};
#pragma unroll
                for (int s = 0; s < 2; ++s) { u32x4 w; w.x = ga[mt][s][0].x; w.y = ga[mt][s][0].y; w.z = ga[mt][s][1].x; w.w = ga[mt][s][1].y;
                    a = __builtin_amdgcn_mfma_f32_16x16x32_bf16(__builtin_bit_cast(bf16x8, w), sb[s], a, 0, 0, 0); }
                acc[mt] = a; }
            asm volatile("s_waitcnt lgkmcnt(0)" ::: "memory");
        }
    }
    asm volatile("s_waitcnt vmcnt(0)" ::: "memory");
    __builtin_amdgcn_s_barrier(); asm volatile("" ::: "memory");
}
__device__ __forceinline__ void s5_scan_block(Frame& F, int gb) {
    const int g = gb >> 3, b = gb & 7, p = F.lane, w = F.wave;
    const float* aL = (const float*)(F.ws + WS_AL) + g * 128; const float ar = aL[2 * p], ai = aL[2 * p + 1];
    bf16_t* UG = (bf16_t*)(F.ws + WS_UG) + ((size_t)g * S5ROWS + b * 256 + 32 * w) * UGLD + 256 + 2 * p;
    LAS float* E = (LAS float*)(F.lds + XTRA_OFF);
    LAS const float* SLl = (LAS const float*)F.lds;
    f32x2 l[32];
#pragma unroll
    for (int k = 0; k < 32; ++k) { const int row = 32 * w + k; l[k] = *(LAS const f32x2*)(SLl + row * 128 + ((((p >> 1) ^ (row & 15)) << 2) | ((p & 1) << 1))); }
    float sr = 0.f, si = 0.f;
#pragma unroll
    for (int k = 0; k < 32; ++k) { const float nr = ar * sr - ai * si + l[k].x, ni = ar * si + ai * sr + l[k].y; l[k].x = sr; l[k].y = si; sr = nr; si = ni; }
    E[(w * 64 + p) * 2] = sr; E[(w * 64 + p) * 2 + 1] = si;
    float pr = ar, pi = ai;
#pragma unroll
    for (int q = 0; q < 5; ++q) { const float nr = pr * pr - pi * pi, ni = 2.f * pr * pi; pr = nr; pi = ni; }
    asm volatile("s_waitcnt lgkmcnt(0)" ::: "memory"); __builtin_amdgcn_s_barrier(); asm volatile("" ::: "memory");
    float cr = 0.f, ci = 0.f;
#pragma unroll
    for (int w2 = 0; w2 < 7; ++w2) { if (w2 < w) { const float er = E[(w2 * 64 + p) * 2], ei = E[(w2 * 64 + p) * 2 + 1]; const float nr = pr * cr - pi * ci + er, ni = pr * ci + pi * cr + ei; cr = nr; ci = ni; } }
#pragma unroll
    for (int k = 0; k < 32; ++k) { *(unsigned*)(UG + (size_t)k * UGLD) = cvt_pk_bf16(l[k].x + cr, l[k].y + ci); const float nr = ar * cr - ai * ci, ni = ar * ci + ai * cr; cr = nr; ci = ni; }
    asm volatile("s_waitcnt lgkmcnt(0)" ::: "memory"); __builtin_amdgcn_s_barrier(); asm volatile("" ::: "memory");
}
struct OutY { bf16x8 yq[2], yw[2]; u32x2 gv[4]; float bon; };
__device__ __forceinline__ void rwkv_out_loady(Frame& F, int unit, int at, OutY& Lq) {
    const int lane = F.lane, fr = lane & 15, fq = lane >> 4;
    const int bh = unit >> 6, c = unit & 63, b = bh >> 3, h = bh & 7;
    const bf16_t* QRT = (const bf16_t*)(F.ws + WS_QRT) + (size_t)unit * 4096; const bf16_t* WYT = (const bf16_t*)(F.ws + WS_WYT) + (size_t)unit * 4096;
#pragma unroll
    for (int s = 0; s < 2; ++s) { Lq.yq[s] = __builtin_nontemporal_load((const bf16x8*)(QRT + (size_t)((at * 2 + s) * 64 + lane) * 8)); Lq.yw[s] = __builtin_nontemporal_load((const bf16x8*)(WYT + (size_t)((at * 2 + s) * 64 + lane) * 8)); }
    const int tl = c * 64 + 16 * at + fr, tg = b * SEQ + tl;
    const bf16_t* gb = (const bf16_t*)(F.ws + WS_GBUF) + (size_t)tg * RW + h * 64;
    Lq.bon = ((const float*)(F.ws + WS_BONUS))[(size_t)tg * 8 + h];
#pragma unroll
    for (int bt = 0; bt < 4; ++bt) { const int i0 = 16 * bt + 4 * fq; Lq.gv[bt] = *(const u32x2*)(gb + i0); }
}
__device__ __forceinline__ void rwkv_out_comp(Frame& F, int unit, int at, const bf16x8 (&xs)[2][4], const bf16x8 (&xv)[2][4], const OutY& Lq) {
    const int lane = F.lane, fr = lane & 15, fq = lane >> 4;
    const int bh = unit >> 6, c = unit & 63, b = bh >> 3, h = bh & 7;
    f32x4 lw[4], lb[4];
#pragma unroll
    for (int bt = 0; bt < 4; ++bt) { const int i0 = 16 * bt + 4 * fq; lw[bt] = *(const f32x4*)(F.in[I_LNW] + h * 64 + i0); lb[bt] = *(const f32x4*)(F.in[I_LNB] + h * 64 + i0); }
    f32x4 bv4[4];
    {
        const unsigned bb = cvt_pk_bf16(Lq.bon, Lq.bon); const bool mine = fq == 2 * (at & 1) + (fr >> 3); const int jw = (fr & 7) >> 1; const unsigned half = (fr & 1) ? (bb & 0xffff0000u) : (bb & 0xffffu);
        u32x4 dw; dw.x = (mine && jw == 0) ? half : 0u; dw.y = (mine && jw == 1) ? half : 0u; dw.z = (mine && jw == 2) ? half : 0u; dw.w = (mine && jw == 3) ? half : 0u;
        const bf16x8 df = __builtin_bit_cast(bf16x8, dw);
#pragma unroll
        for (int bt = 0; bt < 4; ++bt) bv4[bt] = __builtin_amdgcn_mfma_f32_16x16x32_bf16((at >> 1) ? xv[1][bt] : xv[0][bt], df, (f32x4){0.f, 0.f, 0.f, 0.f}, 0, 0, 0);
    }
    f32x4 acc[4];
#pragma unroll
    for (int bt = 0; bt < 4; ++bt) acc[bt] = (f32x4){0.f, 0.f, 0.f, 0.f};
#pragma unroll
    for (int s = 0; s < 2; ++s)
#pragma unroll
        for (int bt = 0; bt < 4; ++bt) {
            acc[bt] = __builtin_amdgcn_mfma_f32_16x16x32_bf16(xs[s][bt], Lq.yq[s], acc[bt], 0, 0, 0);
            acc[bt] = __builtin_amdgcn_mfma_f32_16x16x32_bf16(xv[s][bt], Lq.yw[s], acc[bt], 0, 0, 0); }
    float s1 = 0.f;
#pragma unroll
    for (int bt = 0; bt < 4; ++bt) s1 += (acc[bt][0] + acc[bt][1]) + (acc[bt][2] + acc[bt][3]);
    s1 += __shfl_xor(s1, 16); s1 += __shfl_xor(s1, 32);
    const float mean = s1 * (1.f / 64.f); float s2 = 0.f;
#pragma unroll
    for (int bt = 0; bt < 4; ++bt) { const f32x4 d = acc[bt] - mean; s2 += (d[0] * d[0] + d[1] * d[1]) + (d[2] * d[2] + d[3] * d[3]); }
    s2 += __shfl_xor(s2, 16); s2 += __shfl_xor(s2, 32);
    const float rstd = __builtin_amdgcn_rsqf(s2 * (1.f / 64.f) + 64e-5f);
    const int tl = c * 64 + 16 * at + fr, tg = b * SEQ + tl;
    bf16_t* YRS = (bf16_t*)(F.dout + DO_YRS) + (size_t)tg * D + h * 64;
#pragma unroll
    for (int bt = 0; bt < 4; ++bt) { const int i0 = 16 * bt + 4 * fq;
        const u32x2 gv = Lq.gv[bt];
        const float gg[4] = {bf_lo(gv.x), bf_hi(gv.x), bf_lo(gv.y), bf_hi(gv.y)};
        float o[4];
#pragma unroll
        for (int e = 0; e < 4; ++e) o[e] = ((acc[bt][e] - mean) * rstd * lw[bt][e] + lb[bt][e] + bv4[bt][e]) * gg[e];
        u32x2 w; w.x = cvt_pk_bf16(o[0], o[1]); w.y = cvt_pk_bf16(o[2], o[3]); *(u32x2*)(YRS + i0) = w; }
}
__device__ __forceinline__ void rwkv_out_units(Frame& F) {
    const int lane = F.lane, fr = lane & 15, fq = lane >> 4;
    for (int unit = F.vcu * NWAVES + F.wave; unit < NUNIT; unit += F.G * NWAVES) {
        const bf16_t* VT = (const bf16_t*)(F.ws + WS_VT) + (size_t)unit * 4096; const bf16_t* SST = (const bf16_t*)(F.dout + DO_SST) + (size_t)unit * 4096;
        bf16x8 xs[2][4], xv[2][4]; OutY A, B;
#pragma unroll
        for (int s = 0; s < 2; ++s)
#pragma unroll
            for (int bt = 0; bt < 4; ++bt) { xs[s][bt] = __builtin_nontemporal_load((const bf16x8*)(SST + (size_t)((bt * 2 + s) * 64 + lane) * 8)); xv[s][bt] = __builtin_nontemporal_load((const bf16x8*)(VT + (size_t)((bt * 2 + s) * 64 + lane) * 8)); }
        rwkv_out_loady(F, unit, 0, A); rwkv_out_loady(F, unit, 1, B); __builtin_amdgcn_sched_barrier(0);
        rwkv_out_comp(F, unit, 0, xs, xv, A); __builtin_amdgcn_sched_barrier(0); rwkv_out_loady(F, unit, 2, A); __builtin_amdgcn_sched_barrier(0);
        rwkv_out_comp(F, unit, 1, xs, xv, B); __builtin_amdgcn_sched_barrier(0); rwkv_out_loady(F, unit, 3, B); __builtin_amdgcn_sched_barrier(0);
        rwkv_out_comp(F, unit, 2, xs, xv, A); __builtin_amdgcn_sched_barrier(0);
        rwkv_out_comp(F, unit, 3, xs, xv, B); __builtin_amdgcn_sched_barrier(0);
    }
}

__device__ __forceinline__ void p8_rows(Frame& F) {
    const int gw = F.vcu * NWAVES + F.wave, NGW = F.G * NWAVES, lane = F.lane;
    const bf16_t* MX = (const bf16_t*)(F.ws + WS_MIXED); const float* ST = (const float*)(F.ws + WS_STAT1); bf16_t* H2 = (bf16_t*)(F.ws + WS_H2); float* X1 = (float*)F.dout;
    f32x4 gp[4];
#pragma unroll
    for (int j = 0; j < 4; ++j) gp[j] = *(const f32x4*)(F.in[I_NMPOST] + 256 * j + 4 * lane);
    for (int m0 = gw; m0 < T; m0 += 2 * NGW) {
        int mm[2] = {m0, (m0 + NGW < T) ? m0 + NGW : m0};
        f32x4 xv[2][4]; u32x2 mw[2][4]; float st[2];
#pragma unroll
        for (int q = 0; q < 2; ++q) { st[q] = (lane < 16) ? ST[(size_t)mm[q] * 16 + lane] : 0.f;
#pragma unroll
            for (int j = 0; j < 4; ++j) { const int col = 256 * j + 4 * lane; xv[q][j] = __builtin_nontemporal_load((const f32x4*)(F.in[I_X] + (size_t)mm[q] * D + col)); mw[q][j] = __builtin_nontemporal_load((const u32x2*)(MX + (size_t)mm[q] * D + col)); } }
#pragma unroll
        for (int q = 0; q < 2; ++q) {
            const float rstd1 = __builtin_amdgcn_rsqf(wave_sum(st[q]) * (1.f / D) + 1e-6f);
            f32x4 v[4]; float s = 0.f;
#pragma unroll
            for (int j = 0; j < 4; ++j) { const int col = 256 * j + 4 * lane;
                v[j].x = xv[q][j].x + bf_lo(mw[q][j].x) * rstd1 * gp[j].x; v[j].y = xv[q][j].y + bf_hi(mw[q][j].x) * rstd1 * gp[j].y; v[j].z = xv[q][j].z + bf_lo(mw[q][j].y) * rstd1 * gp[j].z; v[j].w = xv[q][j].w + bf_hi(mw[q][j].y) * rstd1 * gp[j].w;
                s += (v[j].x * v[j].x + v[j].y * v[j].y) + (v[j].z * v[j].z + v[j].w * v[j].w);
                }
            const float rstd2 = __builtin_amdgcn_rsqf(wave_sum(s) * (1.f / D) + 1e-6f);
#pragma unroll
            for (int j = 0; j < 4; ++j) { u32x2 w; w.x = cvt_pk_bf16(v[j].x * rstd2, v[j].y * rstd2); w.y = cvt_pk_bf16(v[j].z * rstd2, v[j].w * rstd2); *(u32x2*)(H2 + (size_t)mm[q] * D + 256 * j + 4 * lane) = w; }
        }
    }
}
__device__ __forceinline__ void p12_rows(Frame& F) {
    const int gw = F.vcu * NWAVES + F.wave, NGW = F.G * NWAVES, lane = F.lane;
    const bf16_t* FB = (const bf16_t*)(F.ws + WS_F); const bf16_t* MX = (const bf16_t*)(F.ws + WS_MIXED);
    const float* ST1 = (const float*)(F.ws + WS_STAT1); const float* ST2 = (const float*)(F.ws + WS_STAT2); float* OUT = (float*)F.dout;
    f32x4 gp[4], gq[4];
#pragma unroll
    for (int j = 0; j < 4; ++j) { gp[j] = *(const f32x4*)(F.in[I_NMPOST] + 256 * j + 4 * lane); gq[j] = *(const f32x4*)(F.in[I_NFPOST] + 256 * j + 4 * lane); }
    for (int m0 = gw; m0 < T; m0 += 2 * NGW) {
        int mm[2] = {m0, (m0 + NGW < T) ? m0 + NGW : m0};
        f32x4 xv[2][4]; u32x2 mw[2][4], fw[2][4]; float s1[2], s2[2];
#pragma unroll
        for (int q = 0; q < 2; ++q) { s1[q] = (lane < 16) ? ST1[(size_t)mm[q] * 16 + lane] : 0.f; s2[q] = (lane < 16) ? ST2[(size_t)mm[q] * 16 + lane] : 0.f;
#pragma unroll
            for (int j = 0; j < 4; ++j) { const int col = 256 * j + 4 * lane; xv[q][j] = __builtin_nontemporal_load((const f32x4*)(F.in[I_X] + (size_t)mm[q] * D + col));
                mw[q][j] = __builtin_nontemporal_load((const u32x2*)(MX + (size_t)mm[q] * D + col)); fw[q][j] = __builtin_nontemporal_load((const u32x2*)(FB + (size_t)mm[q] * D + col)); } }
#pragma unroll
        for (int q = 0; q < 2; ++q) {
            const float rstd1 = __builtin_amdgcn_rsqf(wave_sum(s1[q]) * (1.f / D) + 1e-6f), rstd3 = __builtin_amdgcn_rsqf(wave_sum(s2[q]) * (1.f / D) + 1e-6f);
#pragma unroll
            for (int j = 0; j < 4; ++j) { const int col = 256 * j + 4 * lane; f32x4 o;
                o.x = xv[q][j].x + bf_lo(mw[q][j].x) * rstd1 * gp[j].x; o.y = xv[q][j].y + bf_hi(mw[q][j].x) * rstd1 * gp[j].y; o.z = xv[q][j].z + bf_lo(mw[q][j].y) * rstd1 * gp[j].z; o.w = xv[q][j].w + bf_hi(mw[q][j].y) * rstd1 * gp[j].w;
                o.x += bf_lo(fw[q][j].x) * rstd3 * gq[j].x; o.y += bf_hi(fw[q][j].x) * rstd3 * gq[j].y; o.z += bf_lo(fw[q][j].y) * rstd3 * gq[j].z; o.w += bf_hi(fw[q][j].y) * rstd3 * gq[j].w;
                __builtin_nontemporal_store(o, (f32x4*)(OUT + (size_t)mm[q] * D + col)); }
        }
    }
}

#ifndef MK_PER_PHASE
#define MK_PER_PHASE 0
#endif
constexpr int NPHASE = 12;
struct Args { const float* in[35]; float* out; unsigned char* ws; int ph_lo, ph_hi; };
static_assert(sizeof(Args) == 35 * 8 + 8 + 8 + 8, "Args has no padding");

__device__ __forceinline__ bool phase_begin(Frame& F) { unsigned long long z = 0; asm volatile("" : "+s"(z), "+v"(F.tid)); F.ws = F.ws0 + z; F.dout = F.dout0 + z;     F.lane = F.tid & 63; F.wave = __builtin_amdgcn_readfirstlane(F.tid >> 6); return true; }
__global__ void __launch_bounds__(NWAVES * 64, 2) fwd_kernel(Args args) {
    extern __shared__ __attribute__((aligned(16))) unsigned char lds_raw[];
    Frame F;
    F.lds = (LAS unsigned char*)lds_raw;
    F.MISC = (volatile LAS unsigned*)(F.lds + MISC_OFF);
    F.tid = threadIdx.x; F.lane = F.tid & 63; F.wave = __builtin_amdgcn_readfirstlane(F.tid >> 6);
    F.G = gridDim.x; { const int bx = blockIdx.x; F.vcu = (F.G % 8 == 0) ? (bx % 8) * (F.G / 8) + bx / 8 : bx; }
    F.ws0 = args.ws; F.dout0 = (unsigned char*)args.out; F.ws = F.ws0; F.dout = F.dout0; F.ctl = (gu32*)(args.ws + WS_CTL);
    F.in = (InTab)__builtin_amdgcn_kernarg_segment_ptr();
    for (int u = F.tid; u < (LDS_BYTES - LDSCTL_OFF) / 4; u += NWAVES * 64) ((LAS unsigned*)(F.lds + LDSCTL_OFF))[u] = 0u;
    __syncthreads();
    XcdBarrier bar; bar.bar = (unsigned*)(F.ctl + CW_BAR); bar.x = 0; bar.st = nullptr;
    if (!MK_PER_PHASE) bar = xcd_barrier_post((unsigned*)(F.ctl + CW_BAR), F.MISC + 8);
    const int lo = args.ph_lo, hi = args.ph_hi;
#ifndef PHMASK
#define PHMASK 0xffffffffu
#endif
#define IN(k) (((PHMASK >> (k)) & 1u) && lo <= (k) && (k) < hi && phase_begin(F))
#ifndef REPMASK
#define REPMASK 0u
#endif
#define REPS(k) ((((REPMASK) >> (k)) & 1u) ? 2 : 1)
#define PH(k) for (int rep_ = 0; rep_ < REPS(k); ++rep_, (rep_ < REPS(k) ? xcd_barrier(bar) : (void)0))
#define INQ(k) (lo <= (k) && (k) < hi)
#define SEAM(k) do { if (INQ(k) && INQ((k) + 1)) xcd_barrier(bar); } while (0)
#define WSB(off) ((bf16_t*)(F.ws + (off)))
    const int bx = (int)blockIdx.x;

    PH(0) if (IN(0)) { p0_prologue(F); }
    SEAM(0);
    PH(1) if (IN(1)) {
        pg8::Gemm g{D, D, D, 0}; pg8::StaticOrder S; S.init(WSB(WS_XN), WSB(WS_WIN), D, D, T, NIN, F.G, bx);
        EpiInProj E{WSB(WS_PR), WSB(WS_UG), WSB(WS_GATES), F.in[I_BGATE], 0};
        pg8::gemm_phase<EpiInProj, pg8::StaticOrder, true>(F.lds, g, S, E, F.tid);
        { const int rem = ((T / 256) * (NIN / 256)) % F.G;
          if (rem == 0) p0_late_mats(F, bx * NWAVES + F.wave, F.G * NWAVES); else if (bx >= rem) p0_late_mats(F, (bx - rem) * NWAVES + F.wave, (F.G - rem) * NWAVES); }
    }
    SEAM(1);
    PH(2) if (IN(2)) {
        PrePf pf;
        if (F.vcu < NB * NCH) { rwkv_pre_fetch<2>(F, (((F.vcu >> 6) * NHEAD) << 6) + (F.vcu & 63), true, pf, F.tid); rwkv_pre_put_w(F.lds, pf, F.tid); }
        {
            LAS f32x4* TB = (LAS f32x4*)(F.lds + XTRA_OFF + 4096);
            if (F.tid < NRW / 4) TB[F.tid] = ((const f32x4*)F.in[I_MU])[F.tid];
            const int pq = F.tid >> 7, pi = F.tid & 127;
            const float* psrc = pq == 0 ? F.in[I_W0] : pq == 1 ? F.in[I_A0] : pq == 2 ? F.in[I_KK] : F.in[I_KA];
            TB[NRW / 4 + F.tid] = ((const f32x4*)psrc)[pi];
            if (F.tid < 128) TB[NRW / 4 + 512 + F.tid] = ((const f32x4*)F.in[I_RK])[F.tid];
            BAR_LDS();
        }
        for (int pc = F.vcu; pc < NB * NCH; pc += F.G) {
#pragma unroll 1
            for (int hh = 0; hh < NHEAD; ++hh) { const int bq = pc >> 6, cq = pc & 63, u = ((bq * NHEAD + hh) << 6) + cq;
                const int un = (hh < NHEAD - 1) ? u + 64 : ((pc + F.G < NB * NCH) ? ((((pc + F.G) >> 6) * NHEAD) << 6) + ((pc + F.G) & 63) : NUNIT);
                rwkv_pre_unit(F, u, un, hh == 0, hh == NHEAD - 1, pf); } }
        BAR_LDS();
    }
    SEAM(2);
    PH(3) if (IN(3)) {
        for (int gb = F.vcu; gb < S5G * NB; gb += F.G) {
            pg8::Gemm g{256, UGLD, 256, 0}; S5One S{WSB(WS_UG), WSB(WS_B1A), 256, gb}; EpiSlocLds E{(LAS float*)F.lds, 0};
            pg8::gemm_phase<EpiSlocLds, S5One, true>(F.lds, g, S, E, F.tid);
            asm volatile("s_waitcnt lgkmcnt(0)" ::: "memory"); __builtin_amdgcn_s_barrier(); asm volatile("" ::: "memory");
            s5_scan_block(F, gb); }
        for (int it = F.vcu; it < NB * NHEAD * 4; it += F.G) rwkv_scan_block(F, it);
    }
    SEAM(3);
    PH(4) if (IN(4)) {
        rwkv_out_units(F);
        VM_WAIT(); __syncthreads();
        pg8::Gemm g{384, UGLD, 384, 0}; S5Order S{WSB(WS_UG), WSB(WS_B1B), 384, F.G, bx};
        pg8::EpiGen8<FS5Out> E{FS5Out{WSB(WS_YSP)}, 0};
        pg8::gemm_phase<pg8::EpiGen8<FS5Out>, S5Order, true>(F.lds, g, S, E, F.tid);
    }
    SEAM(4);
    PH(5) if (IN(5)) {
        pg8::Gemm g{RW, RW, RW, 1}; pg8::StaticOrder S; S.init(WSB(WS_YSP), WSB(WS_WGLU), RW, RW, T, RW, F.G, bx); S.tstepA = (size_t)16 * 256 * 2;
        EpiGlu E{WSB(WS_YSP), (bf16_t*)(F.dout + DO_YRS), F.in[I_BGLU], 0};
        pg8::gemm_phase<EpiGlu, pg8::StaticOrder, true>(F.lds, g, S, E, F.tid);
    }
    SEAM(5);
    PH(6) if (IN(6)) {
        pg8::Gemm g{D, D, D, 0}; pg8::StaticOrder S; S.init((const bf16_t*)(F.dout + DO_YRS), WSB(WS_WBRS), D, D, T, D, F.G, bx);
        EpiMerge E{WSB(WS_GATES), WSB(WS_MERGED), RW / 64};
        pg8::gemm_phase<EpiMerge, pg8::StaticOrder, true>(F.lds, g, S, E, F.tid);
    }
    SEAM(6);
    PH(7) if (IN(7)) {
        pg8::Gemm g{D, D, D, 0}; pg8::StaticOrder S; S.init(WSB(WS_MERGED), WSB(WS_WOUT), D, D, T, D, F.G, bx);
        EpiRowStat E{WSB(WS_MIXED), (float*)(F.ws + WS_STAT1), 0};
        pg8::gemm_phase<EpiRowStat, pg8::StaticOrder, false>(F.lds, g, S, E, F.tid);
    }
    SEAM(7);
    PH(8) if (IN(8)) { p8_rows(F);
        for (size_t i = (size_t)bx * 512 + F.tid; i < HZ_BYTES / 16; i += (size_t)F.G * 512) ((u32x4*)(F.ws + WS_HZ))[i] = (u32x4){0u, 0u, 0u, 0u}; }
    SEAM(8);
    PH(9) if (IN(9)) {
        pg8::Gemm g{D, D, D, 0}; UpOrder S{WSB(WS_H2), WSB(WS_WUP), F.G, bx};
        EpiConvAct E{WSB(WS_ACT), F.in[I_CONVW], F.in[I_CONVB], (LAS unsigned*)(F.lds + XTRA_OFF), (unsigned long long*)(F.ws + WS_HZ), (unsigned*)(F.ctl + 2), 0};
        pg8::gemm_phase<EpiConvAct, UpOrder, true>(F.lds, g, S, E, F.tid);
    }
    SEAM(9);
    PH(10) if (IN(10)) {
        pg8::Gemm g{FF, FF, FF, 0}; pg8::StaticOrder S; S.init(WSB(WS_ACT), WSB(WS_WDN), FF, FF, T, D, F.G, bx);
        EpiRowStat E{WSB(WS_F), (float*)(F.ws + WS_STAT2), 0};
        pg8::gemm_phase<EpiRowStat, pg8::StaticOrder, false>(F.lds, g, S, E, F.tid);
    }
    SEAM(10);
    if (IN(11)) p12_rows(F);
#undef IN
#undef INQ
#undef SEAM
#undef WSB
}

extern "C" void kernel_launch(void* const* d_in, const int* in_sizes, int n_in, void* d_out, int out_size, void* d_ws, size_t ws_size, hipStream_t stream) {
    static int grid = 0;
    if (grid == 0) {
        if (n_in != 35 || in_sizes[0] != T * D || out_size != T * D || ws_size < WS_END) { fprintf(stderr, "kernel_launch: unexpected shapes: n_in %d in0 %d out %d ws %zu (need %zu)\n", n_in, n_in > 0 ? in_sizes[0] : -1, out_size, ws_size, (size_t)WS_END); grid = -1; return; }
        int dev = 0, cus = 0, per_cu = 0;
        if (hipGetDevice(&dev) != hipSuccess || hipDeviceGetAttribute(&cus, hipDeviceAttributeMultiprocessorCount, dev) != hipSuccess) { fprintf(stderr, "kernel_launch: device query failed\n"); grid = -1; return; }
        if (hipFuncSetAttribute((const void*)fwd_kernel, hipFuncAttributeMaxDynamicSharedMemorySize, LDS_BYTES) != hipSuccess) { fprintf(stderr, "kernel_launch: hipFuncSetAttribute failed\n"); grid = -1; return; }
        if (hipOccupancyMaxActiveBlocksPerMultiprocessor(&per_cu, (const void*)fwd_kernel, NWAVES * 64, LDS_BYTES) != hipSuccess || per_cu < 1) fprintf(stderr, "kernel_launch: occupancy query reports %d blocks per CU\n", per_cu);
        (void)hipGetLastError();
        grid = cus;
    }
    if (grid < 0) return;
    if (hipMemsetAsync((char*)d_ws + WS_CTL, 0, CTL_ZERO_BYTES, stream) != hipSuccess) { fprintf(stderr, "kernel_launch: memset failed\n"); return; }
    Args a{};
    for (int i = 0; i < 35; ++i) a.in[i] = (const float*)d_in[i];
    a.out = (float*)d_out; a.ws = (unsigned char*)d_ws;
#if MK_PER_PHASE
    for (int ph = 0; ph < NPHASE; ++ph) { a.ph_lo = ph; a.ph_hi = ph + 1; hipLaunchKernelGGL(fwd_kernel, dim3(grid), dim3(NWAVES * 64), LDS_BYTES, stream, a); }
#else
    a.ph_lo = 0; a.ph_hi = NPHASE;
    hipLaunchKernelGGL(fwd_kernel, dim3(grid), dim3(NWAVES * 64), LDS_BYTES, stream, a);
#endif
    const hipError_t le = hipPeekAtLastError();
    if (le != hipSuccess) fprintf(stderr, "kernel_launch: launch failed: %s\n", hipGetErrorName(le));
}
```

```cpp
#include <hip/hip_runtime.h>
#include <cstdio>
#include <cstdint>

#define LAS __attribute__((address_space(3)))
#define GAS __attribute__((address_space(1)))
typedef unsigned short bf16_t;
typedef short bf16x8 __attribute__((ext_vector_type(8)));
typedef float f32x4 __attribute__((ext_vector_type(4)));
typedef float f32x2 __attribute__((ext_vector_type(2)));
typedef unsigned u32x4 __attribute__((ext_vector_type(4)));
typedef unsigned u32x2 __attribute__((ext_vector_type(2)));
typedef GAS unsigned gu32;

constexpr int T = 32768, SEQ = 4096, NB = 8, D = 1024, NIN = 4352, NRW = 1792, RW = 512, FF = 2816, FH = 1408;
constexpr int NHEAD = 8, HD = 64, NCH = 64  , NUNIT = NB * NHEAD * NCH;
constexpr int S5G = 32, S5ROWS = T / 16, UGLD = 384;

constexpr size_t MiB = 1u << 20;
constexpr size_t WS_CTL = 0, CTL_ZERO_BYTES = 1 * MiB;
constexpr size_t WS_WIN = 1 * MiB;
constexpr size_t WS_WUP = WS_WIN + (size_t)NIN * D * 2;
constexpr size_t WS_WDN = WS_WUP + (size_t)2 * FF * D * 2;
constexpr size_t WS_WOUT = WS_WDN + (size_t)D * FF * 2;
constexpr size_t WS_WBRS = WS_WOUT + (size_t)D * D * 2;
constexpr size_t WS_WGLU = WS_WBRS + (size_t)D * D * 2;
constexpr size_t WS_W2T = WS_WGLU + (size_t)RW * RW * 2;
constexpr size_t WS_A2T = WS_W2T + (size_t)RW * 64 * 2;
constexpr size_t WS_G2T = WS_A2T + (size_t)RW * 64 * 2;
constexpr size_t WS_B1A = WS_G2T + (size_t)RW * 128 * 2;
constexpr size_t WS_B1B = WS_B1A + (size_t)S5G * 256 * 256 * 2;
constexpr size_t WS_AL = WS_B1B + (size_t)S5G * 256 * 384 * 2;
constexpr size_t WS_WEND = WS_AL + (size_t)S5G * 64 * 2 * 4;
static_assert(WS_WEND <= 44 * MiB, "weights region");
constexpr size_t WS_XN = 44 * MiB;
constexpr size_t WS_WYT = 396 * MiB;
constexpr size_t WS_R0 = 501 * MiB;
constexpr size_t WS_MERGED = 140 * MiB, WS_H2 = 44 * MiB, WS_F = 372 * MiB;
constexpr size_t WS_R2 = 370 * MiB;
constexpr size_t WS_PR = 108 * MiB;
constexpr size_t WS_MIXED = 304 * MiB, WS_STAT1 = 368 * MiB;
constexpr size_t WS_ACT = 108 * MiB;
constexpr size_t WS_STAT2 = 284 * MiB;
constexpr size_t WS_UG = 220 * MiB;
constexpr size_t WS_GATES = 268 * MiB;
constexpr size_t WS_SLOC = 396 * MiB, WS_YSP = 108 * MiB;
constexpr size_t WS_GBUF = 428 * MiB;
constexpr size_t WS_BONUS = 460 * MiB;
constexpr size_t WS_VT = 461 * MiB;
constexpr size_t WS_LRSCR = 493 * MiB;
constexpr size_t WS_Z = 336 * MiB;
constexpr size_t WS_END = 512 * MiB;
constexpr size_t DO_H = 0, DO_GT = 32 * MiB, DO_QRT = 64 * MiB, DO_SST = 96 * MiB, DO_YRS = 0;
constexpr int GLD = 72;

constexpr int CW_BAR = 4096, CW_HF = 32768, CW_XNQ = 64;
constexpr size_t WS_HZ = 290 * MiB, HZ_BYTES = (size_t)2816 * 4 * 2 * 32 * 8;

constexpr int RING_BYTES = 131072, LDSCTL_OFF = RING_BYTES, MISC_OFF = LDSCTL_OFF + 320, XTRA_OFF = LDSCTL_OFF + 1024, LDS_BYTES = 155648;
constexpr int NWAVES = 8;

#define RLX_AGENT __ATOMIC_RELAXED, __HIP_MEMORY_SCOPE_AGENT
#define LDS_WAIT() asm volatile("s_waitcnt lgkmcnt(0)" ::: "memory")
#define VM_WAIT() asm volatile("s_waitcnt vmcnt(0)" ::: "memory")

typedef __bf16 bf16x2_t __attribute__((ext_vector_type(2)));
__device__ __forceinline__ unsigned cvt_pk_bf16(float lo, float hi) { const f32x2 v = {lo, hi}; return __builtin_bit_cast(unsigned, __builtin_convertvector(v, bf16x2_t)); }
__device__ __forceinline__ float bf_lo(unsigned w) { return __uint_as_float(w << 16); }
__device__ __forceinline__ float bf_hi(unsigned w) { return __uint_as_float(w & 0xffff0000u); }
__device__ __forceinline__ float bf1(bf16_t h) { return __uint_as_float((unsigned)h << 16); }
__device__ __forceinline__ float fexp(float x) { return __builtin_amdgcn_exp2f(x * 1.44269504089f); }
__device__ __forceinline__ float fden(float x) { return 1.0f + __builtin_amdgcn_exp2f(-1.44269504089f * x); }
__device__ __forceinline__ float fsigmoid(float x) { return __builtin_amdgcn_rcpf(1.0f + __builtin_amdgcn_exp2f(-1.44269504089f * x)); }
__device__ __forceinline__ float ftanh(float x) { return 1.0f - 2.0f * __builtin_amdgcn_rcpf(1.0f + __builtin_amdgcn_exp2f(2.88539008178f * x)); }
__device__ __forceinline__ float fgelu(float x) { const float u = 0.7978845608f * (x + 0.044715f * x * x * x); return x * fsigmoid(2.0f * u); }
__device__ __forceinline__ void unpack8(u32x4 w, float (&f)[8]) { f[0] = bf_lo(w.x); f[1] = bf_hi(w.x); f[2] = bf_lo(w.y); f[3] = bf_hi(w.y); f[4] = bf_lo(w.z); f[5] = bf_hi(w.z); f[6] = bf_lo(w.w); f[7] = bf_hi(w.w); }
__device__ __forceinline__ u32x4 pack8(const float (&f)[8]) { u32x4 w; w.x = cvt_pk_bf16(f[0], f[1]); w.y = cvt_pk_bf16(f[2], f[3]); w.z = cvt_pk_bf16(f[4], f[5]); w.w = cvt_pk_bf16(f[6], f[7]); return w; }
__device__ __forceinline__ float wave_sum(float v) {
#pragma unroll
    for (int o = 1; o < 64; o <<= 1) v += __shfl_xor(v, o);
    return v;
}

typedef unsigned v4u_t __attribute__((__vector_size__(16)));
typedef unsigned v2u_t __attribute__((__vector_size__(8)));
typedef __amdgpu_buffer_rsrc_t rsrc_t;
__device__ __forceinline__ rsrc_t mk_rsrc(const void* base) { return __builtin_amdgcn_make_buffer_rsrc((void*)base, 0, 0x7fffffff, 0x00020000); }
__device__ __forceinline__ void st16_wt(rsrc_t r, unsigned byte_off, u32x4 v) { __builtin_amdgcn_raw_buffer_store_b128(__builtin_bit_cast(v4u_t, v), r, (int)byte_off, 0, 16); }
__device__ __forceinline__ void st8_wt(rsrc_t r, unsigned byte_off, u32x2 v) { __builtin_amdgcn_raw_buffer_store_b64(__builtin_bit_cast(v2u_t, v), r, (int)byte_off, 0, 16); }

#define XB_TMO      128
#define XB_XCNT(j)  (256  + 64 * (j))
#define XB_XSUB(j)  (1280 + 64 * (j))
#define XB_XGEN(j)  (2304 + 64 * (j))
#define XB_TOP      3328
#define XB_TOPGEN   3392
#define XCD_BAR_WORDS 3456
#define XB_SPIN_CAP (1u << 18)
__device__ __forceinline__ unsigned xb_ld(unsigned* p)              { return __hip_atomic_load(p, __ATOMIC_RELAXED, __HIP_MEMORY_SCOPE_AGENT); }
__device__ __forceinline__ unsigned xb_add(unsigned* p, unsigned v) { return __hip_atomic_fetch_add(p, v, __ATOMIC_RELAXED, __HIP_MEMORY_SCOPE_AGENT); }
__device__ __forceinline__ unsigned xb_xcc_id() { return (unsigned)__builtin_amdgcn_s_getreg((3 << 11) | 20) & 0xFu; }
#define XB_SPIN(cond, bar) do { unsigned _sp = 0; while (cond) { __builtin_amdgcn_s_sleep(1); \
    if ((++_sp & 255u) == 0u) { if (xb_ld(&(bar)[XB_TMO])) break; if (_sp > XB_SPIN_CAP) { atomicAdd(&(bar)[XB_TMO], 1u); break; } } } } while (0)
struct XcdBarrier { unsigned* bar; unsigned x; volatile LAS unsigned* st; };
__device__ __forceinline__ XcdBarrier xcd_barrier_post(unsigned* bar, volatile LAS unsigned* st) {
    XcdBarrier b; b.bar = bar; b.x = xb_xcc_id(); b.st = st;
    if (threadIdx.x == 0) (void)xb_add(&bar[XB_XCNT(b.x)], 1u);
    return b;
}
__device__ __forceinline__ void xcd_barrier_complete(unsigned* bar, unsigned x, unsigned& nloc, unsigned& nx) {
    const unsigned G = gridDim.x * gridDim.y * gridDim.z;
    unsigned sum, cnt, mine, sp = 0u;
    for (;;) {
        sum = 0u; cnt = 0u; mine = 0u;
#pragma unroll
        for (unsigned j = 0; j < 16; ++j) { const unsigned c = xb_ld(&bar[XB_XCNT(j)]); sum += c; cnt += (c > 0u) ? 1u : 0u; mine = (j == x) ? c : mine; }
        if (sum == G) break;
        __builtin_amdgcn_s_sleep(1);
        if ((++sp & 255u) == 0u) { if (xb_ld(&bar[XB_TMO])) break; if (sp > XB_SPIN_CAP) { atomicAdd(&bar[XB_TMO], 1u); break; } }
    }
    nloc = mine > 0u ? mine : 1u; nx = cnt > 0u ? cnt : 1u;
}
__device__ __forceinline__ void xcd_barrier(const XcdBarrier& b) {
    asm volatile("s_waitcnt vmcnt(0)" ::: "memory");
    __syncthreads();
    if (threadIdx.x == 0) {
        unsigned* bar = b.bar;
        __builtin_amdgcn_s_waitcnt(0);
        unsigned nloc = b.st[0], nx = b.st[1];
        if (nloc == 0u) { xcd_barrier_complete(bar, b.x, nloc, nx); b.st[0] = nloc; b.st[1] = nx; }
        const unsigned old = xb_add(&bar[XB_XSUB(b.x)], 1u);
        const unsigned gen = old / nloc;
        if (old + 1u == (gen + 1u) * nloc) {
            __builtin_amdgcn_fence(__ATOMIC_RELEASE, "agent");
            asm volatile("s_waitcnt vmcnt(0)" ::: "memory");
            const unsigned og = xb_add(&bar[XB_TOP], 1u);
            const unsigned tg = og / nx;
            if (og + 1u == (tg + 1u) * nx) xb_add(&bar[XB_TOPGEN], 1u);
            else XB_SPIN(xb_ld(&bar[XB_TOPGEN]) == tg, bar);
            __builtin_amdgcn_fence(__ATOMIC_ACQUIRE, "agent");
            xb_add(&bar[XB_XGEN(b.x)], 1u);
            asm volatile("s_waitcnt vmcnt(0)" ::: "memory");
        } else {
            XB_SPIN(xb_ld(&bar[XB_XGEN(b.x)]) == gen, bar);
            __builtin_amdgcn_fence(__ATOMIC_ACQUIRE, "agent");
            asm volatile("s_waitcnt vmcnt(0)" ::: "memory");
        }
    }
    __syncthreads();
}

namespace pg8 {
constexpr int BM = 256, BK = 64, HALF = 128, HTB = HALF * BK * 2, STAGE_BYTES = 8 * HTB, NXCD = 8, WGM = 8;
__host__ __device__ __forceinline__ int lds_byte(int r, int c) { const int st = (r >> 4) * 2 + (c >> 5), rr = r & 15, cc = c & 31, ob = rr * 64 + cc * 2; return st * 1024 + (ob ^ (((ob >> 9) & 1) << 5)); }
__host__ __device__ __forceinline__ void stage_rc(int b, int& R, int& C) { const int st = b / 1024, sb = b % 1024, swz = sb ^ (((sb >> 9) & 1) << 5); R = (st >> 1) * 16 + swz / 64; C = (st & 1) * 32 + (swz % 64) / 2; }
__host__ __device__ __forceinline__ int perm32(int rho) { const int n = rho >> 4, i = rho & 15; return 8 * (i >> 2) + 4 * n + (i & 3); }

struct Unit { const char* a; const char* b; int pm, pn; };
struct Gemm { int K, lda, ldb, amode; };

struct StaticOrder {
    const bf16_t* A; const bf16_t* Bt; int lda, ldb;
    int nM, nN, nwg, G, c; size_t tstepA;
    __device__ void init(const bf16_t* A_, const bf16_t* Bt_, int lda_, int ldb_, int M, int N, int G_, int c_) { A = A_; Bt = Bt_; lda = lda_; ldb = ldb_; nM = M / BM; nN = N / BM; nwg = nM * nN; G = G_; c = c_; tstepA = (size_t)BM * lda * 2; }
    __device__ bool next(int i, Unit& u) const {
        const long L = (long)i * G + c; if (L >= nwg) return false;
        int wgid = (int)L; { const int q = nwg / NXCD, r = nwg % NXCD, xcd = wgid % NXCD, off = wgid / NXCD; wgid = (xcd < r ? xcd * (q + 1) : r * (q + 1) + (xcd - r) * q) + off; }
        const int nig = WGM * nN, gid = wgid / nig, fm = gid * WGM, gsz = (nM - fm) < WGM ? (nM - fm) : WGM;
        u.pm = fm + ((wgid % nig) % gsz); u.pn = (wgid % nig) / gsz;
        u.a = (const char*)A + (size_t)u.pm * tstepA; u.b = (const char*)Bt + (size_t)u.pn * BM * ldb * 2; return true;
    }
};

template <class Epi, class Sched, bool ALIGN_EPI = false, bool SP2 = true>
__device__ __forceinline__ void gemm_phase(LAS unsigned char* lds, const Gemm g, const Sched& S, const Epi& E, const int tid) {
    const int wid = __builtin_amdgcn_readfirstlane(tid >> 6), lane = tid & 63, wr = wid >> 2, wc = wid & 3, fr = lane & 15, fq = lane >> 4;
    const int K = g.K, nt = K / BK;
    unsigned voffA[2], voffB[2];
#pragma unroll
    for (int i = 0; i < 2; ++i) { int R, C; stage_rc(tid * 16 + i * 8192, R, C); const int Rb = Epi::PERM ? ((R & ~31) + perm32(R & 31)) : R;
        voffA[i] = g.amode ? (unsigned)((((C >> 4) * S5ROWS + (R >> 4)) * 256 + (R & 15) * 16 + (C & 15)) * 2) : (unsigned)(R * g.lda + C) * 2u; voffB[i] = (unsigned)(Rb * g.ldb + C) * 2u; }
    const size_t kstepB = (size_t)(BK * 2), kstepA = g.amode ? (size_t)4 * S5ROWS * 256 * 2 : (size_t)(BK * 2);
    const size_t hstepA = g.amode ? (size_t)8 * 256 * 2 : (size_t)HALF * g.lda * 2, hstepB = (size_t)HALF * g.ldb * 2;
    const unsigned ldsw = (unsigned)wid * 1024u;
    const int aoff = lds_byte(wr * 64 + fr, fq * 8), boff = lds_byte(wc * 32 + fr, fq * 8);
#define PG8_SA(b, h) (((b) * 2 + (h)) * HTB)
#define PG8_SB(b, h) ((4 + (b) * 2 + (h)) * HTB)
#define PG8_STAGE(bufoff, gbase, voff) do { _Pragma("unroll") for (int _i = 0; _i < 2; ++_i) \
        __builtin_amdgcn_global_load_lds((const unsigned*)((const char*)(gbase) + (voff)[_i]), (LAS unsigned*)(lds + (bufoff) + ldsw + _i * 8192), 16, 0, 0); } while (0)
#define PG8_LDA(dst, b, h) do { _Pragma("unroll") for (int m = 0; m < 4; ++m) _Pragma("unroll") for (int k = 0; k < 2; ++k) dst[m][k] = *(const LAS bf16x8*)(lds + PG8_SA(b, h) + aoff + m * 2048 + k * 1024); } while (0)
#define PG8_LDB(dst, b, h) do { _Pragma("unroll") for (int n = 0; n < 2; ++n) _Pragma("unroll") for (int k = 0; k < 2; ++k) dst[n][k] = *(const LAS bf16x8*)(lds + PG8_SB(b, h) + boff + n * 2048 + k * 1024); } while (0)
#define PG8_MMA(ai, bj, At, Bt) do { __builtin_amdgcn_s_setprio(1); _Pragma("unroll") for (int m = 0; m < 4; ++m) _Pragma("unroll") for (int n = 0; n < 2; ++n) _Pragma("unroll") for (int k = 0; k < 2; ++k) \
        acc[ai][bj][m][n] = __builtin_amdgcn_mfma_f32_16x16x32_bf16(Bt[n][k], At[m][k], acc[ai][bj][m][n], 0, 0, 0); __builtin_amdgcn_s_setprio(0); } while (0)
#define PG8_WAIT_V(n) asm volatile("s_waitcnt vmcnt(" #n ")" ::: "memory")
#define PG8_WAIT_L(n) asm volatile("s_waitcnt lgkmcnt(" #n ")" ::: "memory")
#define PG8_BAR __builtin_amdgcn_s_barrier()
#define PG8_SCHED __builtin_amdgcn_sched_barrier(0)
    Unit cur, nxt; int ui = 0;
    if (!S.next(0, cur)) return;
    f32x4 acc[2][2][4][2];
#pragma unroll
    for (int a = 0; a < 2; ++a)
#pragma unroll
        for (int b = 0; b < 2; ++b)
#pragma unroll
            for (int m = 0; m < 4; ++m)
#pragma unroll
                for (int n = 0; n < 2; ++n) acc[a][b][m][n] = (f32x4){0.f, 0.f, 0.f, 0.f};
    bf16x8 At[4][2], B0[2][2], B1[2][2];
    const char* cA = cur.a; const char* cB = cur.b;
    static_assert(SP2, "only the SP2 loop is kept");
    PG8_STAGE(PG8_SB(0, 0), cB, voffB); PG8_STAGE(PG8_SB(0, 1), cB + hstepB, voffB); PG8_STAGE(PG8_SA(0, 0), cA, voffA); PG8_STAGE(PG8_SA(0, 1), cA + hstepA, voffA);
    if (wr == 1) PG8_BAR;
    PG8_WAIT_V(2); PG8_BAR;
    PG8_STAGE(PG8_SB(1, 0), cB + kstepB, voffB); PG8_STAGE(PG8_SA(1, 0), cA + kstepA, voffA); PG8_STAGE(PG8_SB(1, 1), cB + hstepB + kstepB, voffB);
    PG8_WAIT_V(6); PG8_BAR;
    for (;;) {
        const bool has_next = S.next(ui + 1, nxt);
        const char* nA = has_next ? nxt.a : cA; const char* nB = has_next ? nxt.b : cB;
#pragma unroll 1
        for (int t = 0; t < nt; t += 2) {
            if constexpr (Epi::HAS_MID) { if (t == E.mid_t) { E.mid(acc, cur, wr, wc, fr, fq); PG8_SCHED; } }
            const bool last = (t == nt - 2);
            const char* a1 = cA + (size_t)(t + 1) * kstepA;
            const char* a2 = last ? nA : cA + (size_t)(t + 2) * kstepA; const char* b2 = last ? nB : cB + (size_t)(t + 2) * kstepB;
            const char* a3 = a2 + kstepA; const char* b3 = b2 + kstepB;
            PG8_LDB(B0, 0, 0); PG8_LDB(B1, 0, 1); PG8_SCHED; PG8_LDA(At, 0, 0); PG8_STAGE(PG8_SA(1, 1), a1 + hstepA, voffA);
            PG8_WAIT_V(8); PG8_WAIT_L(0); PG8_BAR; PG8_MMA(0, 0, At, B0); PG8_MMA(0, 1, At, B1); PG8_BAR; PG8_SCHED;
            PG8_LDA(At, 0, 1); PG8_STAGE(PG8_SB(0, 0), b2, voffB); PG8_STAGE(PG8_SB(0, 1), b2 + hstepB, voffB); PG8_STAGE(PG8_SA(0, 0), a2, voffA);
            PG8_WAIT_V(8); PG8_WAIT_L(0); PG8_BAR; PG8_MMA(1, 0, At, B0); PG8_MMA(1, 1, At, B1); PG8_BAR; PG8_SCHED;
            PG8_LDB(B0, 1, 0); PG8_LDB(B1, 1, 1); PG8_SCHED; PG8_LDA(At, 1, 0); PG8_STAGE(PG8_SA(0, 1), a2 + hstepA, voffA);
            PG8_WAIT_V(8); PG8_WAIT_L(0); PG8_BAR; PG8_MMA(0, 0, At, B0); PG8_MMA(0, 1, At, B1); PG8_BAR; PG8_SCHED;
            PG8_LDA(At, 1, 1); PG8_STAGE(PG8_SB(1, 0), b3, voffB); PG8_STAGE(PG8_SB(1, 1), b3 + hstepB, voffB); PG8_STAGE(PG8_SA(1, 0), a3, voffA);
            PG8_WAIT_V(8); PG8_WAIT_L(0); PG8_BAR; PG8_MMA(1, 0, At, B0); PG8_MMA(1, 1, At, B1); PG8_BAR; PG8_SCHED;
        }
        if constexpr (ALIGN_EPI) { if (wr == 0) PG8_BAR; }
        E(acc, cur, wr, wc, fr, fq);
        if (!has_next) break;
#pragma unroll
        for (int a = 0; a < 2; ++a)
#pragma unroll
            for (int b = 0; b < 2; ++b)
#pragma unroll
                for (int m = 0; m < 4; ++m)
#pragma unroll
                    for (int n = 0; n < 2; ++n) acc[a][b][m][n] = (f32x4){0.f, 0.f, 0.f, 0.f};
        cur = nxt; cA = nA; cB = nB; ++ui;
        if constexpr (ALIGN_EPI) { if (wr == 1) PG8_BAR; }
    }
    PG8_WAIT_V(0);
    if constexpr (!ALIGN_EPI) { if (wr == 0) PG8_BAR; }
    PG8_BAR;
#undef PG8_SA
#undef PG8_SB
#undef PG8_STAGE
#undef PG8_LDA
#undef PG8_LDB
#undef PG8_MMA
#undef PG8_WAIT_V
#undef PG8_WAIT_L
#undef PG8_BAR
#undef PG8_SCHED
}

template <class F> struct EpiGen8 {
    static constexpr bool PERM = true, HAS_MID = false; F f; int mid_t;
    __device__ __forceinline__ void mid(f32x4 (&)[2][2][4][2], const Unit&, int, int, int, int) const {}
    __device__ __forceinline__ void operator()(const f32x4 (&acc)[2][2][4][2], const Unit& u, int wr, int wc, int fr, int fq) const {
#pragma unroll
        for (int ai = 0; ai < 2; ++ai)
#pragma unroll
            for (int m = 0; m < 4; ++m) { const int r = ai * HALF + wr * 64 + m * 16 + fr;
#pragma unroll
                for (int bj = 0; bj < 2; ++bj) f(u, r, bj * HALF + wc * 32 + 8 * fq, acc[ai][bj][m][0], acc[ai][bj][m][1]);
                if constexpr (F::PIN) __builtin_amdgcn_sched_barrier(0); }
    }
};
}

typedef const float* cfp_t;
typedef __attribute__((address_space(4))) const cfp_t* InTab;
struct Frame {
    LAS unsigned char* lds;
    volatile LAS unsigned* MISC;
    gu32* ctl;
    int tid, lane, wave, vcu, G;
    unsigned char* ws; unsigned char* dout; unsigned char* ws0; unsigned char* dout0;
    InTab in;
};
enum { I_X = 0, I_NMPRE, I_NMPOST, I_NFPRE, I_NFPOST, I_WIN, I_BGATE, I_MU, I_W0, I_W2, I_A0, I_A2, I_G2, I_KK, I_KA, I_RK, I_LNW, I_LNB,
       I_SARE, I_SAIM, I_SBRE, I_SBIM, I_SCRE, I_SCIM, I_SD, I_SLOG, I_WGLU, I_BGLU, I_WBR, I_WBS, I_WOUT, I_WUP, I_CONVW, I_CONVB, I_WDN };

__device__ __forceinline__ void p0_transpose_item(const float* W, int ldw, int k0, int src0, bf16_t* WT, int ldt, int drow0, int koff, const float* kscale, LAS float* scr, int lane) {
    const int q = lane & 7, rb = lane >> 3;
    f32x4 v[8]; float sc[8];
#pragma unroll
    for (int i = 0; i < 8; ++i) { const int kk = 8 * i + rb; v[i] = __builtin_nontemporal_load((const f32x4*)(W + (size_t)(k0 + kk) * ldw + src0 + 4 * q)); sc[i] = kscale ? kscale[k0 + kk] : 1.0f; }
#pragma unroll
    for (int i = 0; i < 8; ++i) { const int kk = 8 * i + rb; LAS float* d = scr + kk * 33 + 4 * q; d[0] = v[i].x * sc[i]; d[1] = v[i].y * sc[i]; d[2] = v[i].z * sc[i]; d[3] = v[i].w * sc[i]; }
    LDS_WAIT(); asm volatile("" ::: "memory");
    const int c = lane & 7;
#pragma unroll
    for (int j = 0; j < 4; ++j) { const int n = (lane >> 3) + 8 * j; const LAS float* s = scr + (8 * c) * 33 + n;
        u32x4 o; o.x = cvt_pk_bf16(s[0 * 33], s[1 * 33]); o.y = cvt_pk_bf16(s[2 * 33], s[3 * 33]); o.z = cvt_pk_bf16(s[4 * 33], s[5 * 33]); o.w = cvt_pk_bf16(s[6 * 33], s[7 * 33]);
        *(GAS u32x4*)(WT + (size_t)(drow0 + n) * ldt + koff + k0 + 8 * c) = o; }
    LDS_WAIT(); asm volatile("" ::: "memory");
}
struct TrMat { int in_idx, K, N, ldt, koff, kind; size_t dst; int scale_idx; };
__device__ __forceinline__ void p0_do_matrix(Frame& F, const TrMat& mtx, int r, LAS float* scr) {
    const int nblk = mtx.N / 32, kb = r / nblk, nb = r % nblk;
    int src0 = 32 * nb;
    if (mtx.kind == 1) {
        const int pn = (32 * nb) >> 8, within = (32 * nb) & 255;
        src0 = (within < 128 ? 0 : FF - 128) + 128 * pn + within;
    }
    if (mtx.kind == 2 && 32 * nb >= NRW + RW) {
        const int d = 32 * nb - (NRW + RW), q = d >> 8, within = d & 255;
        src0 = (NRW + RW) + (within < 128 ? 0 : D - 128) + 128 * q + within;
    }
    p0_transpose_item(F.in[mtx.in_idx], mtx.N, 64 * kb, src0, (bf16_t*)(F.ws + mtx.dst), mtx.ldt, 32 * nb, mtx.koff, mtx.scale_idx >= 0 ? F.in[mtx.scale_idx] : nullptr, scr, F.lane);
}
__device__ __forceinline__ void p0_s5_group(Frame& F, int g) {
    LAS float* pwr = (LAS float*)(F.lds);
    LAS float* pwi = pwr + 17 * 64;
    LAS float* bbr = pwi + 17 * 64;
    LAS float* bbi = bbr + 1024;
    LAS float* cre = bbi + 1024;
    LAS float* cim = cre + 1024;
    LAS float* kk = cim + 1024;
    const float dt = expf(F.in[I_SLOG][g]);
    for (int idx = F.tid; idx < 17 * 64; idx += 512) { const int k = idx >> 6, p = idx & 63;
        const float are = F.in[I_SARE][g * 64 + p], aim = F.in[I_SAIM][g * 64 + p];
        const float mag = expf((float)k * are * dt); float sn, cs; sincosf((float)k * aim * dt, &sn, &cs);
        pwr[idx] = mag * cs; pwi[idx] = mag * sn; }
    for (int idx = F.tid; idx < 1024; idx += 512) { cre[idx] = F.in[I_SCRE][g * 1024 + idx]; cim[idx] = F.in[I_SCIM][g * 1024 + idx]; }
    __syncthreads();
    for (int idx = F.tid; idx < 1024; idx += 512) { const int p = idx >> 4;
        const float are = F.in[I_SARE][g * 64 + p], aim = F.in[I_SAIM][g * 64 + p];
        const float nr = pwr[64 + p] - 1.0f, ni = pwi[64 + p];
        const float den = 1.0f / (are * are + aim * aim);
        const float qr = (nr * are + ni * aim) * den, qi = (ni * are - nr * aim) * den;
        const float br = F.in[I_SBRE][g * 1024 + idx], bi = F.in[I_SBIM][g * 1024 + idx];
        bbr[idx] = qr * br - qi * bi; bbi[idx] = qr * bi + qi * br; }
    __syncthreads();
    {
        const int kc = F.tid & 255, ph = F.tid >> 8, k = kc >> 4, c = kc & 15; float s[16];
#pragma unroll
        for (int e = 0; e < 16; ++e) s[e] = 0.f;
        for (int p = 32 * ph; p < 32 * ph + 32; ++p) { const float cr_ = cre[c * 64 + p], ci_ = cim[c * 64 + p], pr_ = pwr[k * 64 + p], pi_ = pwi[k * 64 + p];
            const float xr = cr_ * pr_ - ci_ * pi_, xi = cr_ * pi_ + ci_ * pr_;
#pragma unroll
            for (int e4 = 0; e4 < 4; ++e4) { const f32x4 br = *(LAS const f32x4*)(bbr + p * 16 + 4 * e4), bi = *(LAS const f32x4*)(bbi + p * 16 + 4 * e4);
#pragma unroll
                for (int e = 0; e < 4; ++e) s[4 * e4 + e] += xr * br[e] - xi * bi[e]; } }
        LAS float* part = kk + 4096;
        if (ph == 1) {
#pragma unroll
            for (int e4 = 0; e4 < 4; ++e4) *(LAS f32x4*)(part + kc * 16 + 4 * e4) = (f32x4){s[4 * e4], s[4 * e4 + 1], s[4 * e4 + 2], s[4 * e4 + 3]}; }
        __syncthreads();
        if (ph == 0) {
#pragma unroll
            for (int e4 = 0; e4 < 4; ++e4) { const f32x4 o = *(LAS const f32x4*)(part + kc * 16 + 4 * e4);
#pragma unroll
                for (int e = 0; e < 4; ++e) { float v = s[4 * e4 + e] + o[e]; if (k == 0 && c == 4 * e4 + e) v += F.in[I_SD][g * 16 + c]; kk[kc * 16 + 4 * e4 + e] = v; } } }
    }
    __syncthreads();
    bf16_t* B1b = (bf16_t*)(F.ws + WS_B1B) + (size_t)g * 256 * 384;
    for (int idx = F.tid; idx < 256 * 48; idx += 512) { const int n = idx / 48, j = idx - n * 48, t = n >> 4, c = n & 15; float v[8];
        if (j < 32) { const int tau = j >> 1, cp0 = (j & 1) * 8; const int ko = (t >= tau ? t - tau : 0) * 256 + c * 16 + cp0; const float m = (t >= tau) ? 1.f : 0.f;
            const f32x4 a0 = *(LAS const f32x4*)(kk + ko), a1 = *(LAS const f32x4*)(kk + ko + 4);
#pragma unroll
            for (int e = 0; e < 4; ++e) { v[e] = a0[e] * m; v[4 + e] = a1[e] * m; } }
        else { const int p0 = (j - 32) * 4; const f32x4 cr4 = *(LAS const f32x4*)(cre + c * 64 + p0), ci4 = *(LAS const f32x4*)(cim + c * 64 + p0), pr4 = *(LAS const f32x4*)(pwr + (t + 1) * 64 + p0), pi4 = *(LAS const f32x4*)(pwi + (t + 1) * 64 + p0);
#pragma unroll
            for (int q = 0; q < 4; ++q) { v[2 * q] = cr4[q] * pr4[q] - ci4[q] * pi4[q]; v[2 * q + 1] = -(cr4[q] * pi4[q] + ci4[q] * pr4[q]); } }
        *(u32x4*)(B1b + (size_t)n * 384 + 8 * j) = pack8(v); }
    bf16_t* B1a = (bf16_t*)(F.ws + WS_B1A) + (size_t)g * 256 * 256;
    for (int idx = F.tid; idx < 256 * 32; idx += 512) { const int n = idx >> 5, j = idx & 31; float v[8];
#pragma unroll
        for (int e = 0; e < 8; ++e) v[e] = 0.f;
        if (n < 128) { const int p = n >> 1, tau = j >> 1, cp0 = (j & 1) * 8; const float pr_ = pwr[(15 - tau) * 64 + p], pi_ = pwi[(15 - tau) * 64 + p];
            const f32x4 r0 = *(LAS const f32x4*)(bbr + p * 16 + cp0), r1 = *(LAS const f32x4*)(bbr + p * 16 + cp0 + 4), i0 = *(LAS const f32x4*)(bbi + p * 16 + cp0), i1 = *(LAS const f32x4*)(bbi + p * 16 + cp0 + 4);
#pragma unroll
            for (int e = 0; e < 8; ++e) { const float br = e < 4 ? r0[e & 3] : r1[e & 3], bi = e < 4 ? i0[e & 3] : i1[e & 3]; v[e] = (n & 1) ? (pr_ * bi + pi_ * br) : (pr_ * br - pi_ * bi); } }
        *(u32x4*)(B1a + (size_t)n * 256 + 8 * j) = pack8(v); }
    float* aL = (float*)(F.ws + WS_AL) + g * 128;
    if (F.tid < 64) { aL[2 * F.tid] = pwr[16 * 64 + F.tid]; aL[2 * F.tid + 1] = pwi[16 * 64 + F.tid]; }
    __syncthreads();
}
#define DO_MAT(in_idx, K_, N_, ldt_, koff_, kind_, dst_, sc_) do { const TrMat mtx{in_idx, K_, N_, ldt_, koff_, kind_, dst_, sc_}; const int items = ((K_) / 64) * ((N_) / 32); \
        for (int it = gw; it < base + items; it += NGW) { if (it >= base) p0_do_matrix(F, mtx, it - base, scr); } base += items; } while (0)
__device__ __forceinline__ void p0_late_mats(Frame& F, int gw, int NGW) {
    LAS float* scr = (LAS float*)(F.lds + F.wave * 16384);
    int base = 0;
    DO_MAT(I_WUP, D, 2 * FF, D, 0, 1, WS_WUP, I_NFPRE); DO_MAT(I_WDN, FF, D, FF, 0, 0, WS_WDN, -1); DO_MAT(I_WOUT, D, D, D, 0, 0, WS_WOUT, -1);
    DO_MAT(I_WBR, RW, D, D, 0, 0, WS_WBRS, -1); DO_MAT(I_WBS, RW, D, D, RW, 0, WS_WBRS, -1); DO_MAT(I_WGLU, RW, RW, RW, 0, 0, WS_WGLU, -1);
}
__device__ __forceinline__ void p0_prologue(Frame& F) {
    const bool s5wg = F.vcu < S5G && F.G > S5G;
    if (F.vcu < S5G) p0_s5_group(F, F.vcu);
    if (!s5wg) {
        LAS float* scr = (LAS float*)(F.lds + F.wave * 16384);
        const int gw = (F.G > S5G ? F.vcu - S5G : F.vcu) * NWAVES + F.wave, NGW = (F.G > S5G ? F.G - S5G : F.G) * NWAVES;
        int base = 0;
        DO_MAT(I_WIN, D, NIN, D, 0, 2, WS_WIN, I_NMPRE);
        DO_MAT(I_W2, 64, RW, 64, 0, 0, WS_W2T, -1); DO_MAT(I_A2, 64, RW, 64, 0, 0, WS_A2T, -1); DO_MAT(I_G2, 128, RW, 128, 0, 0, WS_G2T, -1);
    }
    {
        bf16_t* XN = (bf16_t*)(F.ws + WS_XN); const rsrc_t xnrc = mk_rsrc(XN);
        const int nch = T / 4, split = (F.G > S5G) ? (nch / 4) * 3 : 0;
#pragma unroll 1
        for (int pass = 0; pass < 2; ++pass) {
            if (pass == 0 && (s5wg || split == 0)) continue;
            const int lo = pass == 0 ? 0 : split, hi = pass == 0 ? split : nch;
            const int gw = (pass == 0 ? F.vcu - S5G : F.vcu) * NWAVES + F.wave, NGW = (pass == 0 ? F.G - S5G : F.G) * NWAVES;
#pragma unroll 1
            for (int ch = lo + gw; ch < hi; ch += NGW) {
                const int m = 4 * ch;
                f32x4 v[4][4]; float s[4];
#pragma unroll
                for (int q = 0; q < 4; ++q) { const GAS f32x4* xr = (const GAS f32x4*)(F.in[I_X] + (size_t)(m + q) * D) + F.lane;
#pragma unroll
                    for (int j = 0; j < 4; ++j) v[q][j] = __builtin_nontemporal_load((const f32x4*)(xr + 64 * j)); }
#pragma unroll
                for (int q = 0; q < 4; ++q) { s[q] = 0.f;
#pragma unroll
                    for (int j = 0; j < 4; ++j) s[q] += (v[q][j].x * v[q][j].x + v[q][j].y * v[q][j].y) + (v[q][j].z * v[q][j].z + v[q][j].w * v[q][j].w); }
#pragma unroll
                for (int q = 0; q < 4; ++q) { const float sq = sqrtf(wave_sum(s[q]) * (1.f / D) + 1e-6f), r = 1.0f / sq; if (F.lane == 0) ((float*)(F.ws + WS_R0))[m + q] = sq;
#pragma unroll
                    for (int j = 0; j < 4; ++j) { u32x2 w; w.x = cvt_pk_bf16(v[q][j].x * r, v[q][j].y * r); w.y = cvt_pk_bf16(v[q][j].z * r, v[q][j].w * r); st8_wt(xnrc, (unsigned)(((m + q) * D + 256 * j + 4 * F.lane) * 2), w); } }
            }
        }
    }
}

struct EpiInProj {
    static constexpr bool PERM = true, HAS_MID = false;
    bf16_t* PR; bf16_t* UG; bf16_t* GT; const float* bg; int mid_t;
    __device__ __forceinline__ void mid(f32x4 (&)[2][2][4][2], const pg8::Unit&, int, int, int, int) const {}
    __device__ __forceinline__ void operator()(const f32x4 (&acc)[2][2][4][2], const pg8::Unit& u, int wr, int wc, int fr, int fq) const {
        if (u.pn >= 9) {
            const int ch = (u.pn - 9) * 128 + wc * 32 + 8 * fq;
            f32x4 br[2], bs[2];
#pragma unroll
            for (int n = 0; n < 2; ++n) { br[n] = *(const f32x4*)(bg + ch + 4 * n); bs[n] = *(const f32x4*)(bg + D + ch + 4 * n); }
            bf16_t* RH = GT + ((size_t)(u.pm * 8 + (u.pn - 9)) << 15) + (((wr * 4 + wc) * 8) << 9) + (fq * 16 + fr) * 8;
#pragma unroll
            for (int ai = 0; ai < 2; ++ai)
#pragma unroll
                for (int m = 0; m < 4; ++m) { float rho[8], gs[8];
#pragma unroll
                    for (int n = 0; n < 2; ++n)
#pragma unroll
                        for (int e = 0; e < 4; ++e) { const float dr = fden(acc[ai][0][m][n][e] + br[n][e]), ds = fden(acc[ai][1][m][n][e] + bs[n][e]);
                            gs[4 * n + e] = __builtin_amdgcn_rcpf(ds); rho[4 * n + e] = ds * __builtin_amdgcn_rcpf(dr); }
                    __builtin_nontemporal_store(pack8(rho), (u32x4*)(RH + ((ai * 4 + m) << 9)));
                    __builtin_nontemporal_store(pack8(gs), (u32x4*)(RH + ((size_t)32 << 20) + ((ai * 4 + m) << 9)));
                    __builtin_amdgcn_sched_barrier(0); }
            return;
        }
#pragma unroll
        for (int ai = 0; ai < 2; ++ai)
#pragma unroll
            for (int m = 0; m < 4; ++m) { const int row = u.pm * 256 + ai * 128 + wr * 64 + m * 16 + fr;
#pragma unroll
                for (int bj = 0; bj < 2; ++bj) { const int cl = bj * 128 + wc * 32 + 8 * fq; const f32x4 v0 = acc[ai][bj][m][0], v1 = acc[ai][bj][m][1]; u32x4 w;
                    w.x = cvt_pk_bf16(v0[0], v0[1]); w.y = cvt_pk_bf16(v0[2], v0[3]); w.z = cvt_pk_bf16(v1[0], v1[1]); w.w = cvt_pk_bf16(v1[2], v1[3]);
                    if (u.pn < 7) __builtin_nontemporal_store(w, (u32x4*)(PR + (size_t)row * NRW + u.pn * 256 + cl));
                    else { const int cr = (u.pn - 7) * 256 + cl, g = cr >> 4, c0 = cr & 15;
                        *(u32x4*)(UG + ((size_t)g * S5ROWS + (row >> 4)) * UGLD + (row & 15) * 16 + c0) = w; } }
                __builtin_amdgcn_sched_barrier(0); }
    }
};
struct FS5Out {
    static constexpr bool PIN = true;
    bf16_t* YSP;
    __device__ __forceinline__ void operator()(const pg8::Unit& u, int r, int cl, f32x4 v0, f32x4 v1) const {
        const int crow = u.pm * 256 + r; u32x4 w;
        w.x = cvt_pk_bf16(fgelu(v0[0]), fgelu(v0[1])); w.y = cvt_pk_bf16(fgelu(v0[2]), fgelu(v0[3])); w.z = cvt_pk_bf16(fgelu(v1[0]), fgelu(v1[1])); w.w = cvt_pk_bf16(fgelu(v1[2]), fgelu(v1[3]));
        *(u32x4*)(YSP + ((size_t)u.pn * S5ROWS + crow) * 256 + cl) = w;
    }
};
struct EpiGlu {
    static constexpr bool PERM = true, HAS_MID = false;
    const bf16_t* YSP; bf16_t* YS; const float* bglu; int mid_t;
    __device__ __forceinline__ void mid(f32x4 (&)[2][2][4][2], const pg8::Unit&, int, int, int, int) const {}
    __device__ __forceinline__ void operator()(const f32x4 (&acc)[2][2][4][2], const pg8::Unit& u, int wr, int wc, int fr, int fq) const {
        u32x4 yv[2][4][2]; f32x4 b0[2], b1[2];
#pragma unroll
        for (int bj = 0; bj < 2; ++bj) { const int col = u.pn * 256 + bj * 128 + wc * 32 + 8 * fq; b0[bj] = *(const f32x4*)(bglu + col); b1[bj] = *(const f32x4*)(bglu + col + 4); }
#pragma unroll
        for (int ai = 0; ai < 2; ++ai)
#pragma unroll
            for (int m = 0; m < 4; ++m)
#pragma unroll
                for (int bj = 0; bj < 2; ++bj) { const int row = u.pm * 256 + ai * 128 + wr * 64 + m * 16 + fr, col = u.pn * 256 + bj * 128 + wc * 32 + 8 * fq;
                    yv[ai][m][bj] = __builtin_nontemporal_load((const u32x4*)(YSP + ((size_t)(col >> 4) * S5ROWS + (row >> 4)) * 256 + (row & 15) * 16 + (col & 15))); }
#pragma unroll
        for (int ai = 0; ai < 2; ++ai)
#pragma unroll
            for (int m = 0; m < 4; ++m) {
#pragma unroll
                for (int bj = 0; bj < 2; ++bj) { const int row = u.pm * 256 + ai * 128 + wr * 64 + m * 16 + fr, col = u.pn * 256 + bj * 128 + wc * 32 + 8 * fq; float y[8]; unpack8(yv[ai][m][bj], y);
                    const f32x4 v0 = acc[ai][bj][m][0], v1 = acc[ai][bj][m][1]; u32x4 w;
                    w.x = cvt_pk_bf16(y[0] * fsigmoid(v0[0] + b0[bj][0]), y[1] * fsigmoid(v0[1] + b0[bj][1])); w.y = cvt_pk_bf16(y[2] * fsigmoid(v0[2] + b0[bj][2]), y[3] * fsigmoid(v0[3] + b0[bj][3]));
                    w.z = cvt_pk_bf16(y[4] * fsigmoid(v1[0] + b1[bj][0]), y[5] * fsigmoid(v1[1] + b1[bj][1])); w.w = cvt_pk_bf16(y[6] * fsigmoid(v1[2] + b1[bj][2]), y[7] * fsigmoid(v1[3] + b1[bj][3]));
                    *(u32x4*)(YS + (size_t)row * D + RW + col) = w; }
                __builtin_amdgcn_sched_barrier(0); }
    }
};
struct FStore {
    static constexpr bool PIN = false;
    bf16_t* O; int ldc;
    __device__ __forceinline__ void operator()(const pg8::Unit& u, int r, int cl, f32x4 v0, f32x4 v1) const {
        u32x4 w; w.x = cvt_pk_bf16(v0[0], v0[1]); w.y = cvt_pk_bf16(v0[2], v0[3]); w.z = cvt_pk_bf16(v1[0], v1[1]); w.w = cvt_pk_bf16(v1[2], v1[3]);
        *(u32x4*)(O + (size_t)(u.pm * 256 + r) * ldc + u.pn * 256 + cl) = w;
    }
};
struct EpiMerge {
    static constexpr bool PERM = true, HAS_MID = true;
    const bf16_t* GT; bf16_t* O; int mid_t;
    __device__ __forceinline__ void mid(f32x4 (&acc)[2][2][4][2], const pg8::Unit& u, int wr, int wc, int fr, int fq) const {
        unsigned vo = (unsigned)((((wr * 4 + wc) * 8) << 9) + (fq * 16 + fr) * 8) * 2u; asm volatile("" : "+v"(vo));
        const char* rh = (const char*)(GT + ((size_t)(u.pm * 8 + 2 * u.pn) << 15));
        u32x4 A[2][4][2];
        auto ld = [&](int ai) {
#pragma unroll
            for (int m = 0; m < 4; ++m)
#pragma unroll
                for (int bj = 0; bj < 2; ++bj) A[ai][m][bj] = __builtin_nontemporal_load((const u32x4*)(rh + vo + (unsigned)(((bj << 15) + ((ai * 4 + m) << 9)) * 2)));
        };
        ld(0);
#pragma unroll
        for (int ai = 0; ai < 2; ++ai) {
            if (ai == 0) ld(1);
            __builtin_amdgcn_sched_barrier(0);
#pragma unroll
            for (int m = 0; m < 4; ++m)
#pragma unroll
                for (int bj = 0; bj < 2; ++bj) { const u32x4 a = A[ai][m][bj]; const unsigned aw[4] = {a.x, a.y, a.z, a.w};
#pragma unroll
                    for (int h = 0; h < 4; ++h) { acc[ai][bj][m][h >> 1][2 * (h & 1)] *= bf_lo(aw[h]); acc[ai][bj][m][h >> 1][2 * (h & 1) + 1] *= bf_hi(aw[h]); } }
            __builtin_amdgcn_sched_barrier(0);
        }
    }
    __device__ __forceinline__ void operator()(const f32x4 (&acc)[2][2][4][2], const pg8::Unit& u, int wr, int wc, int fr, int fq) const {
        const bf16_t* gs = GT + ((size_t)32 << 20) + ((size_t)(u.pm * 8 + 2 * u.pn) << 15) + (((wr * 4 + wc) * 8) << 9) + (fq * 16 + fr) * 8;
        u32x4 gv[2][4][2];
#pragma unroll
        for (int ai = 0; ai < 2; ++ai)
#pragma unroll
            for (int m = 0; m < 4; ++m)
#pragma unroll
                for (int bj = 0; bj < 2; ++bj) gv[ai][m][bj] = __builtin_nontemporal_load((const u32x4*)(gs + (bj << 15) + ((ai * 4 + m) << 9)));
#pragma unroll
        for (int ai = 0; ai < 2; ++ai)
#pragma unroll
            for (int m = 0; m < 4; ++m) {
#pragma unroll
                for (int bj = 0; bj < 2; ++bj) { const int row = u.pm * 256 + ai * 128 + wr * 64 + m * 16 + fr, col = u.pn * 256 + bj * 128 + wc * 32 + 8 * fq; float g[8]; unpack8(gv[ai][m][bj], g);
                    const f32x4 v0 = acc[ai][bj][m][0], v1 = acc[ai][bj][m][1]; u32x4 w;
                    w.x = cvt_pk_bf16(v0[0] * g[0], v0[1] * g[1]); w.y = cvt_pk_bf16(v0[2] * g[2], v0[3] * g[3]); w.z = cvt_pk_bf16(v1[0] * g[4], v1[1] * g[5]); w.w = cvt_pk_bf16(v1[2] * g[6], v1[3] * g[7]);
                    *(u32x4*)(O + (size_t)row * D + col) = w; }
                __builtin_amdgcn_sched_barrier(0); }
    }
};
struct UpOrder {
    const bf16_t* H2; const bf16_t* Wt; int G, c;
    __device__ bool next(int i, pg8::Unit& u) const {
        constexpr int nM = NB * 16, nN = 22, nwg = nM * nN;
        const long L = (long)i * G + c; if (L >= nwg) return false;
        int wgid = (int)L; { const int q = nwg / 8, r = nwg % 8, xcd = wgid % 8, off = wgid / 8; wgid = (xcd < r ? xcd * (q + 1) : r * (q + 1) + (xcd - r) * q) + off; }
        const int nig = 8 * nN, gid = wgid / nig, fm = gid * 8, gsz = (nM - fm) < 8 ? (nM - fm) : 8;
        u.pm = fm + ((wgid % nig) % gsz); u.pn = (wgid % nig) / gsz;
        u.a = (const char*)H2 + ((size_t)u.pm * 256 * D) * 2; u.b = (const char*)(Wt + (size_t)u.pn * 256 * D); return true;
    }
};
template <int CTRL> __device__ __forceinline__ unsigned dppu(unsigned v) { return (unsigned)__builtin_amdgcn_update_dpp(0, (int)v, CTRL, 0xf, 0xf, true); }
template <int CTRL> __device__ __forceinline__ unsigned dppk(unsigned keep, unsigned v) { return (unsigned)__builtin_amdgcn_update_dpp((int)keep, (int)v, CTRL, 0xf, 0xf, false); }
struct EpiConvAct {
    static constexpr bool PERM = true, HAS_MID = false;
    bf16_t* ACT; const float* cw; const float* cb; LAS unsigned* EX; unsigned long long* HZ; unsigned* tmo; int mid_t;
    __device__ __forceinline__ void mid(f32x4 (&)[2][2][4][2], const pg8::Unit&, int, int, int, int) const {}
    __device__ __forceinline__ void operator()(f32x4 (&acc)[2][2][4][2], const pg8::Unit& u, int wr, int wc, int fr, int fq) const {
        const int b = u.pm >> 4, k = u.pm & 15, t0 = 256 * k;
        u32x2 zp[2][2][4][2];
#pragma unroll
        for (int ai = 0; ai < 2; ++ai)
#pragma unroll
            for (int bj = 0; bj < 2; ++bj)
#pragma unroll
                for (int m = 0; m < 4; ++m)
#pragma unroll
                    for (int n = 0; n < 2; ++n) { const f32x4 v = acc[ai][bj][m][n]; u32x2 w; w.x = cvt_pk_bf16(v[0], v[1]); w.y = cvt_pk_bf16(v[2], v[3]); zp[ai][bj][m][n] = w; }
        if (fr >= 14) {
#pragma unroll
            for (int ai = 0; ai < 2; ++ai)
#pragma unroll
                for (int bj = 0; bj < 2; ++bj)
#pragma unroll
                    for (int n = 0; n < 2; ++n) *(LAS u32x2*)(EX + (((wc * 4 + 2 * ai + wr) * 2 + (fr - 14)) * 32 + bj * 16 + fq * 4 + n * 2)) = zp[ai][bj][3][n]; }
        if (wr == 1 && k < 15 && fr >= 14) {
            unsigned long long* hz = HZ + ((size_t)(u.pm * 22 + u.pn) * 8 + wc * 2 + (fr - 14)) * 32;
#pragma unroll
            for (int bj = 0; bj < 2; ++bj)
#pragma unroll
                for (int n = 0; n < 2; ++n) { __hip_atomic_store(hz + bj * 16 + fq * 4 + n * 2, (1ull << 32) | zp[1][bj][3][n].x, RLX_AGENT); __hip_atomic_store(hz + bj * 16 + fq * 4 + n * 2 + 1, (1ull << 32) | zp[1][bj][3][n].y, RLX_AGENT); }
        }
        asm volatile("s_waitcnt lgkmcnt(0)" ::: "memory"); __builtin_amdgcn_s_barrier(); asm volatile("" ::: "memory");
        const int ch0 = u.pn * 128 + wc * 32 + 8 * fq;
        f32x4 wg[2][3], wv[2][3], bg[2], bv[2];
#pragma unroll
        for (int n = 0; n < 2; ++n) {
#pragma unroll
            for (int j = 0; j < 3; ++j) { wg[n][j] = *(const f32x4*)(cw + (size_t)j * 2 * FF + ch0 + 4 * n); wv[n][j] = *(const f32x4*)(cw + (size_t)j * 2 * FF + FF + ch0 + 4 * n); }
            bg[n] = *(const f32x4*)(cb + ch0 + 4 * n); bv[n] = *(const f32x4*)(cb + FF + ch0 + 4 * n); }
#pragma unroll
        for (int gi = 1; gi <= 8; ++gi) {
            const int ai = (gi & 7) >> 2, m = gi & 3, blk = 2 * ai + wr;
            u32x2 pp[2][2];
#pragma unroll
            for (int bj = 0; bj < 2; ++bj)
#pragma unroll
                for (int n = 0; n < 2; ++n) { pp[bj][n].x = 0u; pp[bj][n].y = 0u; }
            if (m > 0) {
#pragma unroll
                for (int bj = 0; bj < 2; ++bj)
#pragma unroll
                    for (int n = 0; n < 2; ++n) pp[bj][n] = zp[ai][bj][m - 1][n];
            } else if (blk > 0) {
                if (fr >= 14) {
#pragma unroll
                    for (int bj = 0; bj < 2; ++bj)
#pragma unroll
                        for (int n = 0; n < 2; ++n) pp[bj][n] = *(LAS const u32x2*)(EX + (((wc * 4 + blk - 1) * 2 + (fr - 14)) * 32 + bj * 16 + fq * 4 + n * 2)); }
            } else if (k > 0) {
                if (fr >= 14) {
                    const unsigned long long* hz = HZ + ((size_t)((u.pm - 1) * 22 + u.pn) * 8 + wc * 2 + (fr - 14)) * 32;
#pragma unroll
                    for (int bj = 0; bj < 2; ++bj)
#pragma unroll
                        for (int n = 0; n < 2; ++n) { unsigned long long x0, x1; unsigned sp_ = 0;
                            for (;;) { x0 = __hip_atomic_load(hz + bj * 16 + fq * 4 + n * 2, RLX_AGENT); x1 = __hip_atomic_load(hz + bj * 16 + fq * 4 + n * 2 + 1, RLX_AGENT);
                                if ((x0 >> 32) == 1ull && (x1 >> 32) == 1ull) break; __builtin_amdgcn_s_sleep(2); if (++sp_ > (1u << 20)) { __hip_atomic_store(tmo, 1u, RLX_AGENT); break; } }
                            pp[bj][n].x = (unsigned)x0; pp[bj][n].y = (unsigned)x1; } }
            }
            u32x2 outp[2];
#pragma unroll
            for (int n = 0; n < 2; ++n) {
                const u32x2 zg = zp[ai][0][m][n], zv = zp[ai][1][m][n], pg = pp[0][n], pv = pp[1][n];
                u32x2 g1, g2, v1, v2;
                g1.x = dppk<0x111>(dppu<0x10F>(pg.x), zg.x); g1.y = dppk<0x111>(dppu<0x10F>(pg.y), zg.y); g2.x = dppk<0x112>(dppu<0x10E>(pg.x), zg.x); g2.y = dppk<0x112>(dppu<0x10E>(pg.y), zg.y);
                v1.x = dppk<0x111>(dppu<0x10F>(pv.x), zv.x); v1.y = dppk<0x111>(dppu<0x10F>(pv.y), zv.y); v2.x = dppk<0x112>(dppu<0x10E>(pv.x), zv.x); v2.y = dppk<0x112>(dppu<0x10E>(pv.y), zv.y);
                f32x2 o2[2];
#pragma unroll
                for (int e = 0; e < 2; ++e) {
                    const unsigned w0g = e ? zg.y : zg.x, w1g = e ? g1.y : g1.x, w2g = e ? g2.y : g2.x, w0v = e ? zv.y : zv.x, w1v = e ? v1.y : v1.x, w2v = e ? v2.y : v2.x;
                    const f32x2 z0g = {bf_lo(w0g), bf_hi(w0g)}, z1g = {bf_lo(w1g), bf_hi(w1g)}, z2g = {bf_lo(w2g), bf_hi(w2g)}, z0v = {bf_lo(w0v), bf_hi(w0v)}, z1v = {bf_lo(w1v), bf_hi(w1v)}, z2v = {bf_lo(w2v), bf_hi(w2v)};
                    const f32x2 kg0 = {wg[n][0][2 * e], wg[n][0][2 * e + 1]}, kg1 = {wg[n][1][2 * e], wg[n][1][2 * e + 1]}, kg2 = {wg[n][2][2 * e], wg[n][2][2 * e + 1]}, kb = {bg[n][2 * e], bg[n][2 * e + 1]};
                    const f32x2 kv0 = {wv[n][0][2 * e], wv[n][0][2 * e + 1]}, kv1 = {wv[n][1][2 * e], wv[n][1][2 * e + 1]}, kv2 = {wv[n][2][2 * e], wv[n][2][2 * e + 1]}, kc = {bv[n][2 * e], bv[n][2 * e + 1]};
                    const f32x2 cg = kb + kg0 * z2g + kg1 * z1g + kg2 * z0g, cv = kc + kv0 * z2v + kv1 * z1v + kv2 * z0v;
                    const f32x2 t = cg * cg, q = t * (f32x2){-0.1029432f, -0.1029432f} + (f32x2){-2.3022082f, -2.3022082f}, pw = cg * q;
                    const f32x2 ex = {__builtin_amdgcn_exp2f(pw.x), __builtin_amdgcn_exp2f(pw.y)}, dn = ex + (f32x2){1.f, 1.f};
                    const f32x2 rc = {__builtin_amdgcn_rcpf(dn.x), __builtin_amdgcn_rcpf(dn.y)};
                    o2[e] = (cg * cv) * rc; }
                const float o[4] = {o2[0].x, o2[0].y, o2[1].x, o2[1].y};
                outp[n].x = cvt_pk_bf16(o[0], o[1]); outp[n].y = cvt_pk_bf16(o[2], o[3]);
            }
            const int r = 128 * ai + 64 * wr + 16 * m + fr;
            { u32x4 w4; w4.x = outp[0].x; w4.y = outp[0].y; w4.z = outp[1].x; w4.w = outp[1].y; __builtin_nontemporal_store(w4, (u32x4*)(ACT + ((size_t)(b * SEQ + t0 + r)) * FF + ch0)); }
            __builtin_amdgcn_sched_barrier(0);
        }
    }
};
struct EpiRowStat {
    static constexpr bool PERM = true, HAS_MID = false; bf16_t* O; float* STAT; int mid_t;
    __device__ __forceinline__ void mid(f32x4 (&)[2][2][4][2], const pg8::Unit&, int, int, int, int) const {}
    __device__ __forceinline__ void operator()(const f32x4 (&acc)[2][2][4][2], const pg8::Unit& u, int wr, int wc, int fr, int fq) const {
#pragma unroll
        for (int ai = 0; ai < 2; ++ai)
#pragma unroll
            for (int m = 0; m < 4; ++m) { const int row = u.pm * 256 + ai * 128 + wr * 64 + m * 16 + fr; float s = 0.f;
#pragma unroll
                for (int bj = 0; bj < 2; ++bj) { const int col = u.pn * 256 + bj * 128 + wc * 32 + 8 * fq; const f32x4 v0 = acc[ai][bj][m][0], v1 = acc[ai][bj][m][1]; u32x4 w;
                    s += (v0[0] * v0[0] + v0[1] * v0[1]) + (v0[2] * v0[2] + v0[3] * v0[3]) + (v1[0] * v1[0] + v1[1] * v1[1]) + (v1[2] * v1[2] + v1[3] * v1[3]);
                    w.x = cvt_pk_bf16(v0[0], v0[1]); w.y = cvt_pk_bf16(v0[2], v0[3]); w.z = cvt_pk_bf16(v1[0], v1[1]); w.w = cvt_pk_bf16(v1[2], v1[3]);
                    *(u32x4*)(O + (size_t)row * D + col) = w; }
                s += __shfl_xor(s, 16); s += __shfl_xor(s, 32);
                if (fq == 0) STAT[(size_t)row * 16 + u.pn * 4 + wc] = s; }
    }
};
struct EpiSloc {
    static constexpr bool PERM = false, HAS_MID = false; float* SL; int mid_t;
    __device__ __forceinline__ void mid(f32x4 (&)[2][2][4][2], const pg8::Unit&, int, int, int, int) const {}
    __device__ __forceinline__ void operator()(const f32x4 (&acc)[2][2][4][2], const pg8::Unit& u, int wr, int wc, int fr, int fq) const {
#pragma unroll
        for (int ai = 0; ai < 2; ++ai)
#pragma unroll
            for (int m = 0; m < 4; ++m) { const int row = u.pm * 256 + ai * 128 + wr * 64 + m * 16 + fr; float* p = SL + ((size_t)u.pn * S5ROWS + row) * 128 + wc * 32 + 4 * fq;
                *(f32x4*)(p) = acc[ai][0][m][0]; *(f32x4*)(p + 16) = acc[ai][0][m][1]; }
    }
};
struct EpiSlocLds {
    static constexpr bool PERM = false, HAS_MID = false; LAS float* SL; int mid_t;
    __device__ __forceinline__ void mid(f32x4 (&)[2][2][4][2], const pg8::Unit&, int, int, int, int) const {}
    __device__ __forceinline__ void operator()(const f32x4 (&acc)[2][2][4][2], const pg8::Unit&, int wr, int wc, int fr, int fq) const {
        asm volatile("s_waitcnt vmcnt(0)" ::: "memory"); __builtin_amdgcn_s_barrier(); asm volatile("" ::: "memory");
#pragma unroll
        for (int ai = 0; ai < 2; ++ai)
#pragma unroll
            for (int m = 0; m < 4; ++m) { const int row = ai * 128 + wr * 64 + m * 16 + fr;
#pragma unroll
                for (int n = 0; n < 2; ++n) *(LAS f32x4*)(SL + row * 128 + (((wc * 8 + 4 * n + fq) ^ (row & 15)) << 2)) = acc[ai][0][m][n]; }
    }
};
struct S5One {
    const bf16_t* UG; const bf16_t* Bt; int ldb, gb;
    __device__ bool next(int i, pg8::Unit& u) const { if (i > 0) return false; const int g = gb >> 3; u.pm = gb & 7; u.pn = g;
        u.a = (const char*)(UG + ((size_t)g * S5ROWS + u.pm * 256) * UGLD); u.b = (const char*)(Bt + (size_t)g * 256 * ldb); return true; }
};
struct S5Order {
    const bf16_t* UG; const bf16_t* Bt; int ldb, G, c;
    __device__ bool next(int i, pg8::Unit& u) const { const int L = i * G + c; if (L >= S5G * 8) return false; const int g = L >> 3; u.pm = L & 7; u.pn = g;
        u.a = (const char*)(UG + ((size_t)g * S5ROWS + u.pm * 256) * UGLD); u.b = (const char*)(Bt + (size_t)g * 256 * ldb); return true; }
};

constexpr int LW = 72;
constexpr int SLOT = 64 * LW * 2;
#define SL(i) ((i) * SLOT)
#define BAR_LDS() do { asm volatile("s_waitcnt lgkmcnt(0)" ::: "memory"); __builtin_amdgcn_s_barrier(); asm volatile("" ::: "memory"); } while (0)
struct LdsMat { LAS const unsigned char* p; int ld; __device__ __forceinline__ bf16x8 frag(int row, int k) const { return *(LAS const bf16x8*)(p + ((size_t)row * ld + k) * 2); } };
struct GlbMat { const bf16_t* p; int ld; __device__ __forceinline__ bf16x8 frag(int row, int k) const { return *(const bf16x8*)(p + (size_t)row * ld + k); } };
template <int KD, class YM, class XM, class EPI>
__device__ __forceinline__ void mm64(const YM& Y, const XM& X, int wid, int lane, const EPI& epi) {
    asm volatile("" : "+v"(lane), "+s"(wid));
    const int at = wid >> 1, bt0 = (wid & 1) * 2, fr = lane & 15, fq = lane >> 4;
    f32x4 acc[2] = {(f32x4){0.f, 0.f, 0.f, 0.f}, (f32x4){0.f, 0.f, 0.f, 0.f}};
#pragma unroll
    for (int s = 0; s < KD / 32; ++s) {
        const bf16x8 yf = Y.frag(16 * at + fr, 32 * s + 8 * fq);
#pragma unroll
        for (int bi = 0; bi < 2; ++bi) { const bf16x8 xf = X.frag(16 * (bt0 + bi) + fr, 32 * s + 8 * fq);
            acc[bi] = __builtin_amdgcn_mfma_f32_16x16x32_bf16(xf, yf, acc[bi], 0, 0, 0); }
    }
#pragma unroll
    for (int bi = 0; bi < 2; ++bi) epi(16 * at + fr, 16 * (bt0 + bi) + 4 * fq, acc[bi]);
}
__device__ __forceinline__ void ld_yf(const LdsMat& Y, int at, int fr, int fq, bf16x8 (&y)[2]) {
#pragma unroll
    for (int s = 0; s < 2; ++s) y[s] = Y.frag(16 * at + fr, 32 * s + 8 * fq);
}
__device__ __forceinline__ void ld_xf(const LdsMat& X, int bt0, int fr, int fq, bf16x8 (&x)[2][2]) {
#pragma unroll
    for (int s = 0; s < 2; ++s)
#pragma unroll
        for (int bi = 0; bi < 2; ++bi) x[s][bi] = X.frag(16 * (bt0 + bi) + fr, 32 * s + 8 * fq);
}
__device__ __forceinline__ void mm_f(const bf16x8 (&y)[2], const bf16x8 (&x)[2][2], f32x4 (&acc)[2]) {
#pragma unroll
    for (int bi = 0; bi < 2; ++bi) acc[bi] = (f32x4){0.f, 0.f, 0.f, 0.f};
#pragma unroll
    for (int s = 0; s < 2; ++s)
#pragma unroll
        for (int bi = 0; bi < 2; ++bi) acc[bi] = __builtin_amdgcn_mfma_f32_16x16x32_bf16(x[s][bi], y[s], acc[bi], 0, 0, 0);
}
template <int KD>
__device__ __forceinline__ void preload_x(const GlbMat& X, int wid, int lane, bf16x8 (&xf)[KD / 32][2]) {
    const int bt0 = (wid & 1) * 2, fr = lane & 15, fq = lane >> 4;
#pragma unroll
    for (int s = 0; s < KD / 32; ++s)
#pragma unroll
        for (int bi = 0; bi < 2; ++bi) xf[s][bi] = X.frag(16 * (bt0 + bi) + fr, 32 * s + 8 * fq);
}
template <int KD, class YM, class EPI>
__device__ __forceinline__ void mm64_pre(const YM& Y, const bf16x8 (&xf)[KD / 32][2], int wid, int lane, const EPI& epi) {
    const int at = wid >> 1, bt0 = (wid & 1) * 2, fr = lane & 15, fq = lane >> 4;
    f32x4 acc[2] = {(f32x4){0.f, 0.f, 0.f, 0.f}, (f32x4){0.f, 0.f, 0.f, 0.f}};
#pragma unroll
    for (int s = 0; s < KD / 32; ++s) {
        const bf16x8 yf = Y.frag(16 * at + fr, 32 * s + 8 * fq);
#pragma unroll
        for (int bi = 0; bi < 2; ++bi) acc[bi] = __builtin_amdgcn_mfma_f32_16x16x32_bf16(xf[s][bi], yf, acc[bi], 0, 0, 0);
    }
#pragma unroll
    for (int bi = 0; bi < 2; ++bi) epi(16 * at + fr, 16 * (bt0 + bi) + 4 * fq, acc[bi]);
}
__device__ __forceinline__ void st_lds4(LAS unsigned char* base, int a, int b0, f32x4 v) { u32x2 w; w.x = cvt_pk_bf16(v[0], v[1]); w.y = cvt_pk_bf16(v[2], v[3]); *(LAS u32x2*)(base + ((size_t)a * LW + b0) * 2) = w; }
__device__ __forceinline__ f32x4 ld_lds4(LAS const unsigned char* base, int a, int b0) { const u32x2 w = *(LAS const u32x2*)(base + ((size_t)a * LW + b0) * 2); return (f32x4){bf_lo(w.x), bf_hi(w.x), bf_lo(w.y), bf_hi(w.y)}; }
__device__ __forceinline__ void st_glb4p(bf16_t* base, int a, int b0, f32x4 v) { u32x2 w; w.x = cvt_pk_bf16(v[0], v[1]); w.y = cvt_pk_bf16(v[2], v[3]); __builtin_nontemporal_store(w, (u32x2*)(base + (size_t)a * GLD + b0)); }
__device__ __forceinline__ void st_glb4(bf16_t* base, int a, int b0, f32x4 v) { u32x2 w; w.x = cvt_pk_bf16(v[0], v[1]); w.y = cvt_pk_bf16(v[2], v[3]); __builtin_nontemporal_store(w, (u32x2*)(base + (size_t)a * 64 + b0)); }

struct PrePf { u32x4 qa[3], qp[3], ra[4], rp[4], wt[4]; };
template <int PART>
__device__ __forceinline__ void rwkv_pre_fetch(Frame& F, int unit, bool lr_first, PrePf& P, int tid) {
    const int bh = unit >> 6, c = unit & 63, b = bh >> 3, h = bh & 7;
    const int t = tid >> 3, jb = tid & 7, j0 = jb * 8;
    const int tg = b * SEQ + c * 64 + t;
    const bool hasprev = (c * 64 + t) > 0;
    const bf16_t* prow = (const bf16_t*)(F.ws + WS_PR) + (size_t)tg * NRW; const bf16_t* pprv = hasprev ? prow - NRW : prow;
    if constexpr (PART != 1) {
#pragma unroll
        for (int seg = 0; seg < 3; ++seg) { const int col = seg * 512 + h * 64 + j0; P.qa[seg] = __builtin_nontemporal_load((const u32x4*)(prow + col)); P.qp[seg] = *(const u32x4*)(pprv + col); }
    }
    if constexpr (PART == 0) return;
    const u32x4* scr = (const u32x4*)(F.ws + WS_LRSCR) + ((size_t)F.vcu * 512 + tid) * 4;
#pragma unroll
    for (int q4 = 0; q4 < 4; ++q4) { const u32x4* pa = lr_first ? (const u32x4*)(prow + 1536 + q4 * 64 + jb * 8) : scr + q4; const u32x4* pp = lr_first ? (const u32x4*)(pprv + 1536 + q4 * 64 + jb * 8) : scr + q4;
        P.ra[q4] = *pa; P.rp[q4] = *pp; }
    P.wt[0] = ((const u32x4*)(F.ws + WS_W2T) + (size_t)h * 512)[tid]; P.wt[1] = ((const u32x4*)(F.ws + WS_A2T) + (size_t)h * 512)[tid];
    P.wt[2] = ((const u32x4*)(F.ws + WS_G2T) + (size_t)h * 1024)[tid]; P.wt[3] = ((const u32x4*)(F.ws + WS_G2T) + (size_t)h * 1024)[512 + tid];
}
__device__ __forceinline__ void rwkv_pre_put_w(LAS unsigned char* L, const PrePf& P, int tid) {
    const int r8 = tid >> 3, c8 = tid & 7, r16 = tid >> 4, c16 = tid & 15;
    *(LAS u32x4*)(L + SL(10) + ((size_t)r8 * LW + c8 * 8) * 2) = P.wt[0]; *(LAS u32x4*)(L + SL(11) + ((size_t)r8 * LW + c8 * 8) * 2) = P.wt[1];
    *(LAS u32x4*)(L + SL(12) + ((size_t)r16 * 136 + c16 * 8) * 2) = P.wt[2]; *(LAS u32x4*)(L + SL(12) + ((size_t)(32 + r16) * 136 + c16 * 8) * 2) = P.wt[3];
}
__device__ __forceinline__ void rwkv_pre_unit(Frame& F, int unit, int next_unit, bool lr_first, bool next_first, PrePf& P) {
    LAS unsigned char* L = F.lds;
    LAS float* XT = (LAS float*)(F.lds + XTRA_OFF);
    int tid = F.tid; asm volatile("" : "+v"(tid));
    int wid = F.wave; asm volatile("" : "+s"(wid));
    const int lane = tid & 63;
    const int bh = unit >> 6, c = unit & 63, b = bh >> 3, h = bh & 7;
    const int t = tid >> 3, jb = tid & 7, j0 = jb * 8;
    const int tg = b * SEQ + c * 64 + t;
    const bool hasprev = (c * 64 + t) > 0;
    const bf16_t* PR = (const bf16_t*)(F.ws + WS_PR);
    const bf16_t* prow = PR + (size_t)tg * NRW; const bf16_t* pprev = prow - NRW;
    LAS const float* mu = (LAS const float*)(F.lds + XTRA_OFF + 4096);
    LAS const float* par = mu + NRW;
    float rs[8], ks[8], vs[8];
    {
        const float pmask = hasprev ? 1.f : 0.f;
        f32x4 mq[3][2];
#pragma unroll
        for (int seg = 0; seg < 3; ++seg) { const int col = seg * 512 + h * 64 + j0; mq[seg][0] = *(LAS const f32x4*)(mu + col); mq[seg][1] = *(LAS const f32x4*)(mu + col + 4); }
        LAS unsigned char* dst[4] = {L + SL(0) + ((size_t)t * LW + j0) * 2, L + SL(1) + ((size_t)t * LW + j0) * 2, L + SL(2) + ((size_t)t * 136 + j0) * 2, L + SL(2) + ((size_t)t * 136 + 64 + j0) * 2};
        u32x4* scr = (u32x4*)(F.ws + WS_LRSCR) + ((size_t)F.vcu * 512 + tid) * 4;
        if (lr_first) {
            f32x4 ma[4][2];
#pragma unroll
            for (int q4 = 0; q4 < 4; ++q4) { ma[q4][0] = *(LAS const f32x4*)(mu + 1536 + q4 * 64 + j0); ma[q4][1] = *(LAS const f32x4*)(mu + 1536 + q4 * 64 + j0 + 4); }
#pragma unroll
            for (int q4 = 0; q4 < 4; ++q4) { float x[8], xp[8], o[8]; unpack8(P.ra[q4], x); unpack8(P.rp[q4], xp);
#pragma unroll
                for (int e = 0; e < 8; ++e) { const float mm = e < 4 ? ma[q4][0][e] : ma[q4][1][e - 4]; const float s = x[e] + (xp[e] * pmask - x[e]) * mm;
                    if (q4 == 1) o[e] = s;
                    else { const float ex = __builtin_amdgcn_exp2f((q4 == 0 ? 2.88539008178f : -1.44269504089f) * s), rc = __builtin_amdgcn_rcpf(1.0f + ex);
                        o[e] = q4 == 0 ? 1.0f - 2.0f * rc : rc; } }
                const u32x4 w = pack8(o); *(LAS u32x4*)(dst[q4]) = w; scr[q4] = w; }
        } else {
#pragma unroll
            for (int q4 = 0; q4 < 4; ++q4) *(LAS u32x4*)(dst[q4]) = P.ra[q4];
        }
#pragma unroll
        for (int seg = 0; seg < 3; ++seg) { float x[8], xp[8]; unpack8(P.qa[seg], x); unpack8(P.qp[seg], xp);
#pragma unroll
            for (int e = 0; e < 8; ++e) { const float mm = e < 4 ? mq[seg][0][e] : mq[seg][1][e - 4]; const float s = x[e] + (xp[e] * pmask - x[e]) * mm; if (seg == 0) rs[e] = s; else if (seg == 1) ks[e] = s; else vs[e] = s; } }
    }
    BAR_LDS();
    if (next_unit < NUNIT) rwkv_pre_fetch<0>(F, next_unit, next_first, P, tid);
    {
        const LdsMat Yw{L + SL(0), LW}, Ya{L + SL(1), LW}, Yg{L + SL(2), 136};
        const LdsMat Xw{L + SL(10), LW}, Xa{L + SL(11), LW}, Xg{L + SL(12), 136};
        mm64<64>(Yw, Xw, wid, lane, [&](int a, int b0, f32x4 v) { *(LAS f32x4*)(L + SL(4) + ((size_t)a * 68 + b0) * 4) = v; });
        mm64<64>(Ya, Xa, wid, lane, [&](int a, int b0, f32x4 v) { *(LAS f32x4*)(L + SL(6) + ((size_t)a * 68 + b0) * 4) = v; });
        mm64<128>(Yg, Xg, wid, lane, [&](int a, int b0, f32x4 v) { *(LAS f32x4*)(L + SL(8) + ((size_t)a * 68 + b0) * 4) = v; });
    }
    BAR_LDS();
    float ld[8], kp[8], av[8], bv[8];
    {
        const int hc = h * 64 + j0;
        float wp[8], ap[8], gg[8], w0[8], a0[8], kkw[8], kaw[8], rk[8];
        *(f32x4*)&wp[0] = *(LAS f32x4*)(L + SL(4) + ((size_t)t * 68 + j0) * 4); *(f32x4*)&wp[4] = *(LAS f32x4*)(L + SL(4) + ((size_t)t * 68 + j0 + 4) * 4);
        *(f32x4*)&ap[0] = *(LAS f32x4*)(L + SL(6) + ((size_t)t * 68 + j0) * 4); *(f32x4*)&ap[4] = *(LAS f32x4*)(L + SL(6) + ((size_t)t * 68 + j0 + 4) * 4);
        *(f32x4*)&gg[0] = *(LAS f32x4*)(L + SL(8) + ((size_t)t * 68 + j0) * 4); *(f32x4*)&gg[4] = *(LAS f32x4*)(L + SL(8) + ((size_t)t * 68 + j0 + 4) * 4);
        *(f32x4*)&w0[0] = *(LAS const f32x4*)(par + 0 + hc); *(f32x4*)&w0[4] = *(LAS const f32x4*)(par + 0 + hc + 4);
        *(f32x4*)&a0[0] = *(LAS const f32x4*)(par + 512 + hc); *(f32x4*)&a0[4] = *(LAS const f32x4*)(par + 512 + hc + 4);
        *(f32x4*)&kkw[0] = *(LAS const f32x4*)(par + 1024 + hc); *(f32x4*)&kkw[4] = *(LAS const f32x4*)(par + 1024 + hc + 4);
        *(f32x4*)&kaw[0] = *(LAS const f32x4*)(par + 1536 + hc); *(f32x4*)&kaw[4] = *(LAS const f32x4*)(par + 1536 + hc + 4);
        *(f32x4*)&rk[0] = *(LAS const f32x4*)(par + 2048 + hc); *(f32x4*)&rk[4] = *(LAS const f32x4*)(par + 2048 + hc + 4);
        float ss = 0.f, bon = 0.f, kkv[8], eta[8];
#pragma unroll
        for (int e = 0; e < 8; ++e) {
            ld[e] = -0.60653065971f * fsigmoid(w0[e] + wp[e]);
            eta[e] = fsigmoid(a0[e] + ap[e]);
            kkv[e] = ks[e] * kkw[e]; ss += kkv[e] * kkv[e];
            kp[e] = ks[e] * (1.0f + (eta[e] - 1.0f) * kaw[e]);
            bon += rs[e] * kp[e] * rk[e];
        }
        ss += __shfl_xor(ss, 1); ss += __shfl_xor(ss, 2); ss += __shfl_xor(ss, 4);
        bon += __shfl_xor(bon, 1); bon += __shfl_xor(bon, 2); bon += __shfl_xor(bon, 4);
        const float inv = __builtin_amdgcn_rcpf(fmaxf(__builtin_amdgcn_sqrtf(ss), 1e-12f));
#pragma unroll
        for (int e = 0; e < 8; ++e) { const float kk = kkv[e] * inv; av[e] = -kk; bv[e] = kk * eta[e]; }
        if (jb == 0) ((float*)(F.ws + WS_BONUS))[(size_t)unit * 64 + t] = bon;
        *(u32x4*)((bf16_t*)(F.ws + WS_GBUF) + (size_t)tg * RW + hc) = pack8(gg);
    }
    float Lc[8];
#pragma unroll
    for (int e = 0; e < 8; ++e) { float x = ld[e];
        float y = __shfl_up(x, 8); if (lane >= 8) x += y;
        y = __shfl_up(x, 16); if (lane >= 16) x += y;
        y = __shfl_up(x, 32); if (lane >= 32) x += y;
        Lc[e] = x; }
    if (lane >= 56) {
#pragma unroll
        for (int e = 0; e < 8; ++e) XT[wid * 64 + j0 + e] = Lc[e]; }
    BAR_LDS();
    {
        float pre[8];
#pragma unroll
        for (int e = 0; e < 8; ++e) pre[e] = 0.f;
#pragma unroll
        for (int w = 0; w < 7; ++w) if (w < wid) { const f32x4 x0 = *(LAS const f32x4*)(XT + w * 64 + j0), x1 = *(LAS const f32x4*)(XT + w * 64 + j0 + 4);
#pragma unroll
            for (int e = 0; e < 4; ++e) { pre[e] += x0[e]; pre[4 + e] += x1[e]; } }
#pragma unroll
        for (int e = 0; e < 8; ++e) Lc[e] += pre[e];
    }
    if (t == 63) {
#pragma unroll
        for (int e = 0; e < 8; ++e) XT[512 + j0 + e] = fexp(Lc[e]); }
    {
        float o0[8], o1[8], o2[8], o3[8];
#pragma unroll
        for (int e = 0; e < 8; ++e) { const float ein = fexp(Lc[e]), eout = __builtin_amdgcn_rcpf(ein), eex = fexp(Lc[e] - ld[e]);
            o0[e] = rs[e] * ein; o1[e] = kp[e] * eout; o2[e] = av[e] * eex; o3[e] = bv[e] * eout; }
        const size_t off = ((size_t)t * LW + j0) * 2;
        *(LAS u32x4*)(L + SL(10) + off) = pack8(o0); *(LAS u32x4*)(L + SL(11) + off) = pack8(o1); *(LAS u32x4*)(L + SL(12) + off) = pack8(o2); *(LAS u32x4*)(L + SL(13) + off) = pack8(o3);
        *(LAS u32x4*)(L + SL(2) + off) = pack8(vs);
    }
    BAR_LDS();
    {
        const int srcs[4] = {12, 13, 11, 2}, dsts[4] = {4, 5, 6, 7};
#pragma unroll
        for (int q = 0; q < 4; ++q) { unsigned short hv[8];
#pragma unroll
            for (int e = 0; e < 8; ++e) hv[e] = *(LAS const unsigned short*)(L + SL(srcs[q]) + ((size_t)(8 * wid + e) * LW + lane) * 2);
            u32x4 w; w.x = hv[0] | ((unsigned)hv[1] << 16); w.y = hv[2] | ((unsigned)hv[3] << 16); w.z = hv[4] | ((unsigned)hv[5] << 16); w.w = hv[6] | ((unsigned)hv[7] << 16);
            *(LAS u32x4*)(L + SL(dsts[q]) + ((size_t)lane * LW + 8 * wid) * 2) = w;
        }
    }
    BAR_LDS();
    if (next_unit < NUNIT) rwkv_pre_fetch<1>(F, next_unit, next_first, P, tid);
    const size_t fsrc = ((size_t)(16 * (tid >> 7) + (tid & 15)) * LW + 32 * ((tid >> 6) & 1) + 8 * ((tid >> 4) & 3)) * 2;
    __builtin_nontemporal_store(*(LAS const u32x4*)(L + SL(7) + fsrc), (u32x4*)((bf16_t*)(F.ws + WS_VT) + (size_t)unit * 4096) + tid);
    {
        const LdsMat Rt{L + SL(10), LW}, Kt{L + SL(11), LW}, At{L + SL(12), LW}, Bt{L + SL(13), LW};
        f32x4 nd = (f32x4){0.f, 0.f, 0.f, 0.f}, ntd = nd;
        {
            int ln = lane, wd = wid; asm volatile("" : "+v"(ln), "+s"(wd));
            const int at = wd >> 1, bt0 = (wd & 1) * 2, fr = ln & 15, fq = ln >> 4, a = 16 * at + fr;
            bf16x8 yA[2], yK[2], yR[2], xB[2][2], xA[2][2], xK[2][2];
            ld_yf(At, at, fr, fq, yA); ld_xf(Bt, bt0, fr, fq, xB); ld_yf(Kt, at, fr, fq, yK); ld_xf(At, bt0, fr, fq, xA); ld_yf(Rt, at, fr, fq, yR); ld_xf(Kt, bt0, fr, fq, xK);
            const bool diag = bt0 == (at & 2);
            bf16x8 xd[2];
            if (diag) ld_yf(Bt, at, fr, fq, xd);
            f32x4 c0[2], c1[2], c2[2], c3[2];
            mm_f(yA, xB, c0); mm_f(yK, xA, c1); mm_f(yR, xB, c2); mm_f(yR, xK, c3);
            if (diag) {
                f32x4 v = (f32x4){0.f, 0.f, 0.f, 0.f};
#pragma unroll
                for (int s = 0; s < 2; ++s) v = __builtin_amdgcn_mfma_f32_16x16x32_bf16(yA[s], xd[s], v, 0, 0, 0);
#pragma unroll
                for (int e = 0; e < 4; ++e) v[e] = (fr < 4 * fq + e) ? v[e] : 0.f;
                nd = v; }
#pragma unroll
            for (int bi = 0; bi < 2; ++bi) { const int b0 = 16 * (bt0 + bi) + 4 * fq; f32x4 v0 = c0[bi], v1 = c1[bi], v2 = c2[bi], v3 = c3[bi];
#pragma unroll
                for (int e = 0; e < 4; ++e) { v0[e] = (b0 + e < a) ? v0[e] : 0.f; v1[e] = (a < b0 + e) ? v1[e] : 0.f; v2[e] = (b0 + e <= a) ? v2[e] : 0.f; v3[e] = (b0 + e <= a) ? v3[e] : 0.f; }
                st_lds4(L + SL(1), a, b0, v0); st_lds4(L + SL(2), a, b0, v1); st_lds4(L + SL(3), a, b0, v2); st_lds4(L + SL(8), a, b0, v3);
                if (bt0 + bi == at) ntd = v0; }
        }
        const int at = wid >> 1;
        if (((wid & 1) * 2 == (at & 2))) {
            const int fr = lane & 15, fq = lane >> 4;
            auto op = [](f32x4 v) { u32x4 w; w.x = cvt_pk_bf16(v[0], v[1]); w.y = cvt_pk_bf16(v[2], v[3]); w.z = 0u; w.w = 0u; return __builtin_bit_cast(bf16x8, w); };
            const f32x4 zero = (f32x4){0.f, 0.f, 0.f, 0.f};
            const f32x4 Lm = ntd, LT = nd;
            f32x4 Q = Lm;
#pragma unroll
            for (int e = 0; e < 4; ++e) Q[e] += (4 * fq + e == fr) ? 1.f : 0.f;
            const f32x4 L2 = __builtin_amdgcn_mfma_f32_16x16x32_bf16(op(LT), op(Lm), zero, 0, 0, 0), L2T = __builtin_amdgcn_mfma_f32_16x16x32_bf16(op(Lm), op(LT), zero, 0, 0, 0);
            Q = __builtin_amdgcn_mfma_f32_16x16x32_bf16(op(L2T), op(Q), Q, 0, 0, 0);
            const f32x4 L4 = __builtin_amdgcn_mfma_f32_16x16x32_bf16(op(L2T), op(L2), zero, 0, 0, 0), L4T = __builtin_amdgcn_mfma_f32_16x16x32_bf16(op(L2), op(L2T), zero, 0, 0, 0);
            Q = __builtin_amdgcn_mfma_f32_16x16x32_bf16(op(L4T), op(Q), Q, 0, 0, 0);
            const f32x4 L8T = __builtin_amdgcn_mfma_f32_16x16x32_bf16(op(L4), op(L4T), zero, 0, 0, 0);
            Q = __builtin_amdgcn_mfma_f32_16x16x32_bf16(op(L8T), op(Q), Q, 0, 0, 0);
            st_lds4(L + SL(9), 16 * at + fr, 4 * fq, Q);
        }
    }
    BAR_LDS();
    {
        const int fr = lane & 15, fq = lane >> 4;
        LAS const unsigned char* zsl = L + (wid < 4 ? SL(4) : SL(2)); LAS unsigned char* dsl = L + (wid < 4 ? SL(11) : SL(12));
        const int arow = 16 * (wid & 3) + fr;
        u32x2 zp[4];
#pragma unroll
        for (int c = 0; c < 4; ++c) {
            f32x4 acc = ld_lds4(zsl, arow, 16 * c + 4 * fq);
            if (c >= 1) {
                const u32x2 alo = *(LAS const u32x2*)(L + SL(1) + ((size_t)(16 * c + fr) * LW + 4 * fq) * 2), ahi = *(LAS const u32x2*)(L + SL(1) + ((size_t)(16 * c + fr) * LW + 16 + 4 * fq) * 2);
                u32x4 aw; aw.x = alo.x; aw.y = alo.y; aw.z = ahi.x; aw.w = ahi.y;
                u32x4 bw; bw.x = zp[0].x; bw.y = zp[0].y; bw.z = c >= 2 ? zp[1].x : 0u; bw.w = c >= 2 ? zp[1].y : 0u;
                acc = __builtin_amdgcn_mfma_f32_16x16x32_bf16(__builtin_bit_cast(bf16x8, aw), __builtin_bit_cast(bf16x8, bw), acc, 0, 0, 0); }
            if (c == 3) {
                const u32x2 alo = *(LAS const u32x2*)(L + SL(1) + ((size_t)(48 + fr) * LW + 32 + 4 * fq) * 2);
                u32x4 aw; aw.x = alo.x; aw.y = alo.y; aw.z = 0u; aw.w = 0u;
                u32x4 bw; bw.x = zp[2].x; bw.y = zp[2].y; bw.z = 0u; bw.w = 0u;
                acc = __builtin_amdgcn_mfma_f32_16x16x32_bf16(__builtin_bit_cast(bf16x8, aw), __builtin_bit_cast(bf16x8, bw), acc, 0, 0, 0); }
            const u32x2 dlo = *(LAS const u32x2*)(L + SL(9) + ((size_t)(16 * c + fr) * LW + 4 * fq) * 2);
            u32x4 aw; aw.x = dlo.x; aw.y = dlo.y; aw.z = 0u; aw.w = 0u;
            u32x4 bw; bw.x = cvt_pk_bf16(acc[0], acc[1]); bw.y = cvt_pk_bf16(acc[2], acc[3]); bw.z = 0u; bw.w = 0u;
            const f32x4 r = __builtin_amdgcn_mfma_f32_16x16x32_bf16(__builtin_bit_cast(bf16x8, aw), __builtin_bit_cast(bf16x8, bw), (f32x4){0.f, 0.f, 0.f, 0.f}, 0, 0, 0);
            zp[c].x = cvt_pk_bf16(r[0], r[1]); zp[c].y = cvt_pk_bf16(r[2], r[3]);
            *(LAS u32x2*)(dsl + ((size_t)arow * LW + 16 * c + 4 * fq) * 2) = zp[c];
        }
    }
    BAR_LDS();
    {
        const int sAT = 11, sAkT = 12, sHk = 0;
        const LdsMat AT{L + SL(sAT), LW}, AkT{L + SL(sAkT), LW}, AbrT{L + SL(3), LW}, BgT{L + SL(5), LW}, VTm{L + SL(7), LW};
        bf16_t* QRT = (bf16_t*)(F.dout + DO_QRT) + (size_t)unit * 4096; bf16_t* WYT = (bf16_t*)(F.ws + WS_WYT) + (size_t)unit * 4096;
        bf16_t* GTg = (bf16_t*)(F.dout + DO_GT) + (size_t)unit * 4096; bf16_t* Hg = (bf16_t*)(F.dout + DO_H) + (size_t)unit * 4096;
        const int grow = tid >> 3, gch = tid & 7; const size_t gsrc = ((size_t)grow * LW + gch * 8) * 2; const int gdst = grow * 8 + (gch ^ ((grow >> 1) & 7));
        {
            int ln = lane, wd = wid; asm volatile("" : "+v"(ln), "+s"(wd));
            const int at = wd >> 1, bt0 = (wd & 1) * 2, fr = ln & 15, fq = ln >> 4, a = 16 * at + fr;
            bf16x8 yA[2], yB[2], xT[2][2], xK[2][2];
            ld_yf(BgT, at, fr, fq, yB); ld_xf(AkT, bt0, fr, fq, xK); ld_yf(AbrT, at, fr, fq, yA); ld_xf(AT, bt0, fr, fq, xT);
            f32x4 eH[2], eR[2], eW[2];
#pragma unroll
            for (int bi = 0; bi < 2; ++bi) { const int b0 = 16 * (bt0 + bi) + 4 * fq; eH[bi] = ld_lds4(L + SL(6), a, b0); eR[bi] = ld_lds4(L + SL(10), a, b0); eW[bi] = ld_lds4(L + SL(8), a, b0); }
            const float gdiag = XT[512 + a];
            f32x4 cH[2], cQ[2], cW[2], cG[2];
            mm_f(yB, xK, cH); mm_f(yA, xT, cQ); mm_f(yA, xK, cW); mm_f(yB, xT, cG);
#pragma unroll
            for (int bi = 0; bi < 2; ++bi) { const int b0 = 16 * (bt0 + bi) + 4 * fq;
                st_lds4(L + SL(sHk), a, b0, (cH[bi] + eH[bi]) * gdiag);
                st_lds4(L + SL(1), a, b0, cQ[bi] + eR[bi]);
                st_lds4(L + SL(2), a, b0, cW[bi] + eW[bi]);
                f32x4 v = cG[bi];
#pragma unroll
                for (int e = 0; e < 4; ++e) v[e] += (b0 + e == a) ? 1.f : 0.f;
                st_lds4(L + SL(4), a, b0, v * gdiag); }
        }
        BAR_LDS();
        const LdsMat HkT{L + SL(sHk), LW};
        mm64<64>(VTm, HkT, wid, lane, [&](int a, int b0, f32x4 v) { st_lds4(L + SL(9), a, b0, v); });
        __builtin_nontemporal_store(*(LAS const u32x4*)(L + SL(1) + fsrc), (u32x4*)QRT + tid);
        __builtin_nontemporal_store(*(LAS const u32x4*)(L + SL(2) + fsrc), (u32x4*)WYT + tid);
        __builtin_nontemporal_store(*(LAS const u32x4*)(L + SL(4) + gsrc), (u32x4*)GTg + gdst);
        if (next_unit < NUNIT) rwkv_pre_put_w(L, P, tid);
        BAR_LDS();
        __builtin_nontemporal_store(*(LAS const u32x4*)(L + SL(9) + gsrc), (u32x4*)Hg + gdst);
    }
}

constexpr int RS_SLOT = 10 * 1024;
constexpr int RS_DEPTH = 8, RS_AHEAD = 6;
__device__ __forceinline__ void rwkv_scan_block(Frame& F, int item) {
    const int bh = item >> 2, qi = item & 3, lane = F.lane, fr = lane & 15, fq = lane >> 4, wid = F.wave;
    const char* GTg = (const char*)(F.dout + DO_GT) + (size_t)bh * 64 * 8192;
    const char* Hg = (const char*)(F.dout + DO_H) + (size_t)bh * 64 * 8192 + (size_t)qi * 2048;
    bf16_t* SST = (bf16_t*)(F.dout + DO_SST) + (size_t)bh * 64 * 4096;
    LAS unsigned char* L = F.lds;
    auto issue = [&](int c) {
        if (wid >= 1) {
            LAS unsigned char* slot = L + (c & (RS_DEPTH - 1)) * RS_SLOT;
#pragma unroll
            for (int k = 0; k < 2; ++k) { const int pc = (wid - 1) + 7 * k;
                if (pc < 10) {
                    const char* src = (pc < 8) ? GTg + (size_t)c * 8192 + pc * 1024 + lane * 16 : Hg + (size_t)c * 8192 + (pc - 8) * 1024 + lane * 16;
                    __builtin_amdgcn_global_load_lds((const unsigned*)src, (LAS unsigned*)(slot + pc * 1024), 16, 0, 0); } }
        }
    };
    f32x4 acc[4];
#pragma unroll
    for (int mt = 0; mt < 4; ++mt) acc[mt] = (f32x4){0.f, 0.f, 0.f, 0.f};
#pragma unroll 1
    for (int c = 0; c < RS_AHEAD; ++c) issue(c);
#pragma unroll 1
    for (int c = 0; c < NCH; ++c) {
        if (c + RS_AHEAD < NCH) issue(c + RS_AHEAD);
        if (c + RS_AHEAD < NCH) { if (wid >= 1 && wid <= 3) asm volatile("s_waitcnt vmcnt(12)" ::: "memory"); else if (wid >= 4) asm volatile("s_waitcnt vmcnt(6)" ::: "memory"); }
        else if (wid >= 1) asm volatile("s_waitcnt vmcnt(0)" ::: "memory");
        __builtin_amdgcn_s_barrier(); asm volatile("" ::: "memory");
        if (wid == 0) {
            LAS const unsigned char* slot = L + (c & (RS_DEPTH - 1)) * RS_SLOT;
            u32x2 ga[4][2][2], hv[4];
#pragma unroll
            for (int mt = 0; mt < 4; ++mt) {
#pragma unroll
                for (int s = 0; s < 2; ++s)
#pragma unroll
                    for (int hh = 0; hh < 2; ++hh) ga[mt][s][hh] = *(LAS const u32x2*)(slot + (16 * mt + fr) * 128 + (((2 * (2 * s + hh) + (fq >> 1)) ^ ((fr >> 1) & 7)) << 4) + (fq & 1) * 8);
                hv[mt] = *(LAS const u32x2*)(slot + 8192 + fr * 128 + (((2 * mt + (fq >> 1)) ^ ((fr >> 1) & 7)) << 4) + (fq & 1) * 8); }
            bf16_t* Sc = SST + (size_t)c * 4096; u32x2 sp[4];
#pragma unroll
            for (int mt = 0; mt < 4; ++mt) { sp[mt].x = cvt_pk_bf16(acc[mt][0], acc[mt][1]); sp[mt].y = cvt_pk_bf16(acc[mt][2], acc[mt][3]);
                *(u32x2*)(Sc + ((size_t)((qi * 2 + (mt >> 1)) * 64 + (2 * (mt & 1) + (fq >> 1)) * 16 + fr)) * 8 + 4 * (fq & 1)) = sp[mt]; }
            bf16x8 sb[2];
#pragma unroll
            for (int s = 0; s < 2; ++s) { u32x4 w; w.x = sp[2 * s].x; w.y = sp[2 * s].y; w.z = sp[2 * s + 1].x; w.w = sp[2 * s + 1].y; sb[s] = __builtin_bit_cast(bf16x8, w); }
#pragma unroll
            for (int mt = 0; mt < 4; ++mt) { f32x4 a = (f32x4){bf_lo(hv[mt].x), bf_hi(hv[mt].x), bf_lo(hv[mt].y), bf_hi(hv[mt].y)};
#pragma unroll
                for (int s = 0; s < 2; ++s) { u32x4 w; w.x = ga[mt][s][0].x; w.y = ga[mt][s][0].y; w.z = ga[mt][s][1].x; w.w = ga[mt][s][1].y;
                    a = __builtin_amdgcn_mfma_f32_16x16x32_bf16(__builtin_bit_cast(bf16x8, w), sb[s], a, 0, 0, 0); }
                acc[mt] = a; }
            asm volatile("s_waitcnt lgkmcnt(0)" ::: "memory");
        }
    }
    asm volatile("s_waitcnt vmcnt(0)" ::: "memory");
    __builtin_amdgcn_s_barrier(); asm volatile("" ::: "memory");
}
__device__ __forceinline__ void s5_scan_block(Frame& F, int gb) {
    const int g = gb >> 3, b = gb & 7, p = F.lane, w = F.wave;
    const float* aL = (const float*)(F.ws + WS_AL) + g * 128; const float ar = aL[2 * p], ai = aL[2 * p + 1];
    bf16_t* UG = (bf16_t*)(F.ws + WS_UG) + ((size_t)g * S5ROWS + b * 256 + 32 * w) * UGLD + 256 + 2 * p;
    LAS float* E = (LAS float*)(F.lds + XTRA_OFF);
    LAS const float* SLl = (LAS const float*)F.lds;
    f32x2 l[32];
#pragma unroll
    for (int k = 0; k < 32; ++k) { const int row = 32 * w + k; l[k] = *(LAS const f32x2*)(SLl + row * 128 + ((((p >> 1) ^ (row & 15)) << 2) | ((p & 1) << 1))); }
    float sr = 0.f, si = 0.f;
#pragma unroll
    for (int k = 0; k < 32; ++k) { const float nr = ar * sr - ai * si + l[k].x, ni = ar * si + ai * sr + l[k].y; l[k].x = sr; l[k].y = si; sr = nr; si = ni; }
    E[(w * 64 + p) * 2] = sr; E[(w * 64 + p) * 2 + 1] = si;
    float pr = ar, pi = ai;
#pragma unroll
    for (int q = 0; q < 5; ++q) { const float nr = pr * pr - pi * pi, ni = 2.f * pr * pi; pr = nr; pi = ni; }
    asm volatile("s_waitcnt lgkmcnt(0)" ::: "memory"); __builtin_amdgcn_s_barrier(); asm volatile("" ::: "memory");
    float cr = 0.f, ci = 0.f;
#pragma unroll
    for (int w2 = 0; w2 < 7; ++w2) { if (w2 < w) { const float er = E[(w2 * 64 + p) * 2], ei = E[(w2 * 64 + p) * 2 + 1]; const float nr = pr * cr - pi * ci + er, ni = pr * ci + pi * cr + ei; cr = nr; ci = ni; } }
#pragma unroll
    for (int k = 0; k < 32; ++k) { *(unsigned*)(UG + (size_t)k * UGLD) = cvt_pk_bf16(l[k].x + cr, l[k].y + ci); const float nr = ar * cr - ai * ci, ni = ar * ci + ai * cr; cr = nr; ci = ni; }
    asm volatile("s_waitcnt lgkmcnt(0)" ::: "memory"); __builtin_amdgcn_s_barrier(); asm volatile("" ::: "memory");
}
struct OutY { bf16x8 yq[2], yw[2]; u32x4 gr[2]; float bon; };
__device__ __forceinline__ void rwkv_out_loady(Frame& F, int unit, int at, OutY& Lq) {
    const int lane = F.lane, fr = lane & 15, fq = lane >> 4;
    const int bh = unit >> 6, c = unit & 63, b = bh >> 3, h = bh & 7;
    const bf16_t* QRT = (const bf16_t*)(F.dout + DO_QRT) + (size_t)unit * 4096; const bf16_t* WYT = (const bf16_t*)(F.ws + WS_WYT) + (size_t)unit * 4096;
#pragma unroll
    for (int s = 0; s < 2; ++s) { Lq.yq[s] = __builtin_nontemporal_load((const bf16x8*)(QRT + (size_t)((at * 2 + s) * 64 + lane) * 8)); Lq.yw[s] = __builtin_nontemporal_load((const bf16x8*)(WYT + (size_t)((at * 2 + s) * 64 + lane) * 8)); }
    const int tl = c * 64 + 16 * at + fr, tg = b * SEQ + tl;
    Lq.bon = ((const float*)(F.ws + WS_BONUS))[(size_t)unit * 64 + 16 * at + fr];
#pragma unroll
    for (int k = 0; k < 2; ++k) Lq.gr[k] = __builtin_nontemporal_load((const u32x4*)((const bf16_t*)(F.ws + WS_GBUF) + (size_t)(b * SEQ + c * 64 + 16 * at + (lane >> 3) + 8 * k) * RW + h * 64 + (lane & 7) * 8));
}
__device__ __forceinline__ void rwkv_out_comp(Frame& F, int unit, int at, const bf16x8 (&xs)[2][4], const bf16x8 (&xv)[2][4], const OutY& Lq) {
    const int lane = F.lane, fr = lane & 15, fq = lane >> 4;
    const int bh = unit >> 6, c = unit & 63, b = bh >> 3, h = bh & 7;
    LAS unsigned char* YL = F.lds + F.wave * 4096;
#pragma unroll
    for (int k = 0; k < 2; ++k) *(LAS u32x4*)(YL + (((lane >> 3) + 8 * k) * 72 + (lane & 7) * 8) * 2) = Lq.gr[k];
    u32x2 gvv[4];
#pragma unroll
    for (int bt = 0; bt < 4; ++bt) gvv[bt] = *(LAS const u32x2*)(YL + (fr * 72 + 16 * bt + 4 * fq) * 2);
    f32x4 lw[4], lb[4];
#pragma unroll
    for (int bt = 0; bt < 4; ++bt) { const int i0 = 16 * bt + 4 * fq; lw[bt] = *(const f32x4*)(F.in[I_LNW] + h * 64 + i0); lb[bt] = *(const f32x4*)(F.in[I_LNB] + h * 64 + i0); }
    f32x4 bv4[4];
    {
        const unsigned bb = cvt_pk_bf16(Lq.bon, Lq.bon); const bool mine = fq == 2 * (at & 1) + (fr >> 3); const int jw = (fr & 7) >> 1; const unsigned half = (fr & 1) ? (bb & 0xffff0000u) : (bb & 0xffffu);
        u32x4 dw; dw.x = (mine && jw == 0) ? half : 0u; dw.y = (mine && jw == 1) ? half : 0u; dw.z = (mine && jw == 2) ? half : 0u; dw.w = (mine && jw == 3) ? half : 0u;
        const bf16x8 df = __builtin_bit_cast(bf16x8, dw);
#pragma unroll
        for (int bt = 0; bt < 4; ++bt) bv4[bt] = __builtin_amdgcn_mfma_f32_16x16x32_bf16((at >> 1) ? xv[1][bt] : xv[0][bt], df, (f32x4){0.f, 0.f, 0.f, 0.f}, 0, 0, 0);
    }
    f32x4 acc[4];
#pragma unroll
    for (int bt = 0; bt < 4; ++bt) acc[bt] = (f32x4){0.f, 0.f, 0.f, 0.f};
#pragma unroll
    for (int s = 0; s < 2; ++s)
#pragma unroll
        for (int bt = 0; bt < 4; ++bt) {
            acc[bt] = __builtin_amdgcn_mfma_f32_16x16x32_bf16(xs[s][bt], Lq.yq[s], acc[bt], 0, 0, 0);
            acc[bt] = __builtin_amdgcn_mfma_f32_16x16x32_bf16(xv[s][bt], Lq.yw[s], acc[bt], 0, 0, 0); }
    float s1 = 0.f;
#pragma unroll
    for (int bt = 0; bt < 4; ++bt) s1 += (acc[bt][0] + acc[bt][1]) + (acc[bt][2] + acc[bt][3]);
    s1 += __shfl_xor(s1, 16); s1 += __shfl_xor(s1, 32);
    const float mean = s1 * (1.f / 64.f); float s2 = 0.f;
#pragma unroll
    for (int bt = 0; bt < 4; ++bt) { const f32x4 d = acc[bt] - mean; s2 += (d[0] * d[0] + d[1] * d[1]) + (d[2] * d[2] + d[3] * d[3]); }
    s2 += __shfl_xor(s2, 16); s2 += __shfl_xor(s2, 32);
    const float rstd = __builtin_amdgcn_rsqf(s2 * (1.f / 64.f) + 64e-5f);
    const int tl = c * 64 + 16 * at + fr, tg = b * SEQ + tl;
#pragma unroll
    for (int bt = 0; bt < 4; ++bt) { const int i0 = 16 * bt + 4 * fq;
        const u32x2 gv = gvv[bt];
        const float gg[4] = {bf_lo(gv.x), bf_hi(gv.x), bf_lo(gv.y), bf_hi(gv.y)};
        float o[4];
#pragma unroll
        for (int e = 0; e < 4; ++e) o[e] = ((acc[bt][e] - mean) * rstd * lw[bt][e] + lb[bt][e] + bv4[bt][e]) * gg[e];
        u32x2 w; w.x = cvt_pk_bf16(o[0], o[1]); w.y = cvt_pk_bf16(o[2], o[3]); *(LAS u32x2*)(YL + (fr * 72 + i0) * 2) = w; }
    bf16_t* YRS = (bf16_t*)(F.dout + DO_YRS) + ((size_t)(b * SEQ + c * 64 + 16 * at)) * D + h * 64;
#pragma unroll
    for (int k = 0; k < 2; ++k) { const int row = (lane >> 3) + 8 * k, ch = lane & 7;
        const u32x4 w = *(LAS const u32x4*)(YL + (row * 72 + ch * 8) * 2);
        *(u32x4*)(YRS + (size_t)row * D + ch * 8) = w; }
    asm volatile("s_waitcnt lgkmcnt(0)" ::: "memory");
}
__device__ __forceinline__ void rwkv_out_units(Frame& F) {
    const int lane = F.lane, fr = lane & 15, fq = lane >> 4;
    for (int unit = F.vcu * NWAVES + F.wave; unit < NUNIT; unit += F.G * NWAVES) {
        const bf16_t* VT = (const bf16_t*)(F.ws + WS_VT) + (size_t)unit * 4096; const bf16_t* SST = (const bf16_t*)(F.dout + DO_SST) + (size_t)unit * 4096;
        bf16x8 xs[2][4], xv[2][4]; OutY A, B;
#pragma unroll
        for (int s = 0; s < 2; ++s)
#pragma unroll
            for (int bt = 0; bt < 4; ++bt) { xs[s][bt] = __builtin_nontemporal_load((const bf16x8*)(SST + (size_t)((bt * 2 + s) * 64 + lane) * 8)); xv[s][bt] = __builtin_nontemporal_load((const bf16x8*)(VT + (size_t)((bt * 2 + s) * 64 + lane) * 8)); }
        rwkv_out_loady(F, unit, 0, A); rwkv_out_loady(F, unit, 1, B); __builtin_amdgcn_sched_barrier(0);
        rwkv_out_comp(F, unit, 0, xs, xv, A); __builtin_amdgcn_sched_barrier(0); rwkv_out_loady(F, unit, 2, A); __builtin_amdgcn_sched_barrier(0);
        rwkv_out_comp(F, unit, 1, xs, xv, B); __builtin_amdgcn_sched_barrier(0); rwkv_out_loady(F, unit, 3, B); __builtin_amdgcn_sched_barrier(0);
        rwkv_out_comp(F, unit, 2, xs, xv, A); __builtin_amdgcn_sched_barrier(0);
        rwkv_out_comp(F, unit, 3, xs, xv, B); __builtin_amdgcn_sched_barrier(0);
    }
}

__device__ __forceinline__ void p8_rows(Frame& F) {
    const int gw = F.vcu * NWAVES + F.wave, NGW = F.G * NWAVES, lane = F.lane;
    const bf16_t* MX = (const bf16_t*)(F.ws + WS_MIXED); const float* ST = (const float*)(F.ws + WS_STAT1); bf16_t* H2 = (bf16_t*)(F.ws + WS_H2); float* X1 = (float*)F.dout;
    const rsrc_t h2rc = mk_rsrc(H2);
    const bf16_t* XNB = (const bf16_t*)(F.ws + WS_XN); const float* R0 = (const float*)(F.ws + WS_R0);
    f32x4 gp[4];
#pragma unroll
    for (int j = 0; j < 4; ++j) gp[j] = *(const f32x4*)(F.in[I_NMPOST] + 256 * j + 4 * lane);
    for (int m0 = gw; m0 < T; m0 += 2 * NGW) {
        int mm[2] = {m0, (m0 + NGW < T) ? m0 + NGW : m0};
        u32x2 xw[2][4], mw[2][4]; float st[2], i0[2];
#pragma unroll
        for (int q = 0; q < 2; ++q) { st[q] = (lane < 16) ? ST[(size_t)mm[q] * 16 + lane] : 0.f; i0[q] = R0[mm[q]];
#pragma unroll
            for (int j = 0; j < 4; ++j) { const int col = 256 * j + 4 * lane; xw[q][j] = __builtin_nontemporal_load((const u32x2*)(XNB + (size_t)mm[q] * D + col)); mw[q][j] = *(const u32x2*)(MX + (size_t)mm[q] * D + col); } }
#pragma unroll
        for (int q = 0; q < 2; ++q) {
            const float rstd1 = __builtin_amdgcn_rsqf(wave_sum(st[q]) * (1.f / D) + 1e-6f);
            f32x4 xv[2][4];
#pragma unroll
            for (int j = 0; j < 4; ++j) { xv[q][j].x = bf_lo(xw[q][j].x) * i0[q]; xv[q][j].y = bf_hi(xw[q][j].x) * i0[q]; xv[q][j].z = bf_lo(xw[q][j].y) * i0[q]; xv[q][j].w = bf_hi(xw[q][j].y) * i0[q]; }
            f32x4 v[4]; float s = 0.f;
#pragma unroll
            for (int j = 0; j < 4; ++j) { const int col = 256 * j + 4 * lane;
                v[j].x = xv[q][j].x + bf_lo(mw[q][j].x) * rstd1 * gp[j].x; v[j].y = xv[q][j].y + bf_hi(mw[q][j].x) * rstd1 * gp[j].y; v[j].z = xv[q][j].z + bf_lo(mw[q][j].y) * rstd1 * gp[j].z; v[j].w = xv[q][j].w + bf_hi(mw[q][j].y) * rstd1 * gp[j].w;
                s += (v[j].x * v[j].x + v[j].y * v[j].y) + (v[j].z * v[j].z + v[j].w * v[j].w);
                }
            const float rstd2 = __builtin_amdgcn_rsqf(wave_sum(s) * (1.f / D) + 1e-6f);
            if (lane == 0) ((float*)(F.ws + WS_R2))[mm[q]] = __builtin_amdgcn_rcpf(rstd2);
#pragma unroll
            for (int j = 0; j < 4; ++j) { u32x2 w; w.x = cvt_pk_bf16(v[j].x * rstd2, v[j].y * rstd2); w.y = cvt_pk_bf16(v[j].z * rstd2, v[j].w * rstd2); st8_wt(h2rc, (unsigned)((mm[q] * D + 256 * j + 4 * lane) * 2), w); }
        }
    }
}
__device__ __forceinline__ void p12_rows(Frame& F) {
    const int gw = F.vcu * NWAVES + F.wave, NGW = F.G * NWAVES, lane = F.lane;
    const bf16_t* FB = (const bf16_t*)(F.ws + WS_F); const bf16_t* HB = (const bf16_t*)(F.ws + WS_H2);
    const float* R2 = (const float*)(F.ws + WS_R2); const float* ST2 = (const float*)(F.ws + WS_STAT2); float* OUT = (float*)F.dout;
    f32x4 gq[4];
#pragma unroll
    for (int j = 0; j < 4; ++j) gq[j] = *(const f32x4*)(F.in[I_NFPOST] + 256 * j + 4 * lane);
    for (int m0 = gw; m0 < T; m0 += 2 * NGW) {
        int mm[2] = {m0, (m0 + NGW < T) ? m0 + NGW : m0};
        u32x2 hw[2][4], fw[2][4]; float s2[2], i2[2];
#pragma unroll
        for (int q = 0; q < 2; ++q) { s2[q] = (lane < 16) ? ST2[(size_t)mm[q] * 16 + lane] : 0.f; i2[q] = R2[mm[q]];
#pragma unroll
            for (int j = 0; j < 4; ++j) { const int col = 256 * j + 4 * lane; hw[q][j] = __builtin_nontemporal_load((const u32x2*)(HB + (size_t)mm[q] * D + col)); fw[q][j] = *(const u32x2*)(FB + (size_t)mm[q] * D + col); } }
#pragma unroll
        for (int q = 0; q < 2; ++q) {
            const float rstd3 = __builtin_amdgcn_rsqf(wave_sum(s2[q]) * (1.f / D) + 1e-6f), inv2 = i2[q];
#pragma unroll
            for (int j = 0; j < 4; ++j) { const int col = 256 * j + 4 * lane; f32x4 o;
                o.x = bf_lo(hw[q][j].x) * inv2 + bf_lo(fw[q][j].x) * rstd3 * gq[j].x; o.y = bf_hi(hw[q][j].x) * inv2 + bf_hi(fw[q][j].x) * rstd3 * gq[j].y;
                o.z = bf_lo(hw[q][j].y) * inv2 + bf_lo(fw[q][j].y) * rstd3 * gq[j].z; o.w = bf_hi(hw[q][j].y) * inv2 + bf_hi(fw[q][j].y) * rstd3 * gq[j].w;
                __builtin_nontemporal_store(o, (f32x4*)(OUT + (size_t)mm[q] * D + col)); }
        }
    }
}

#ifndef MK_PER_PHASE
#define MK_PER_PHASE 0
#endif
constexpr int NPHASE = 12;
struct Args { const float* in[35]; float* out; unsigned char* ws; int ph_lo, ph_hi; };
static_assert(sizeof(Args) == 35 * 8 + 8 + 8 + 8, "Args has no padding");

__device__ __forceinline__ bool phase_begin(Frame& F) { unsigned long long z = 0; asm volatile("" : "+s"(z), "+v"(F.tid)); F.ws = F.ws0 + z; F.dout = F.dout0 + z;     F.lane = F.tid & 63; F.wave = __builtin_amdgcn_readfirstlane(F.tid >> 6); return true; }
__global__ void __launch_bounds__(NWAVES * 64, 2) fwd_kernel(Args args) {
    extern __shared__ __attribute__((aligned(16))) unsigned char lds_raw[];
    Frame F;
    F.lds = (LAS unsigned char*)lds_raw;
    F.MISC = (volatile LAS unsigned*)(F.lds + MISC_OFF);
    F.tid = threadIdx.x; F.lane = F.tid & 63; F.wave = __builtin_amdgcn_readfirstlane(F.tid >> 6);
    F.G = gridDim.x; { const int bx = blockIdx.x; F.vcu = (F.G % 8 == 0) ? (bx % 8) * (F.G / 8) + bx / 8 : bx; }
    F.ws0 = args.ws; F.dout0 = (unsigned char*)args.out; F.ws = F.ws0; F.dout = F.dout0; F.ctl = (gu32*)(args.ws + WS_CTL);
    F.in = (InTab)__builtin_amdgcn_kernarg_segment_ptr();
    for (int u = F.tid; u < (LDS_BYTES - LDSCTL_OFF) / 4; u += NWAVES * 64) ((LAS unsigned*)(F.lds + LDSCTL_OFF))[u] = 0u;
    __syncthreads();
    XcdBarrier bar; bar.bar = (unsigned*)(F.ctl + CW_BAR); bar.x = 0; bar.st = nullptr;
    if (!MK_PER_PHASE) bar = xcd_barrier_post((unsigned*)(F.ctl + CW_BAR), F.MISC + 8);
    const int lo = args.ph_lo, hi = args.ph_hi;
#ifndef PHMASK
#define PHMASK 0xffffffffu
#endif
#define IN(k) (((PHMASK >> (k)) & 1u) && lo <= (k) && (k) < hi && phase_begin(F))
#ifndef REPMASK
#define REPMASK 0u
#endif
#define REPS(k) ((((REPMASK) >> (k)) & 1u) ? 2 : 1)
#define PH(k) for (int rep_ = 0; rep_ < REPS(k); ++rep_, (rep_ < REPS(k) ? xcd_barrier(bar) : (void)0))
#define INQ(k) (lo <= (k) && (k) < hi)
#define SEAM(k) do { if (INQ(k) && INQ((k) + 1)) xcd_barrier(bar); } while (0)
#define WSB(off) ((bf16_t*)(F.ws + (off)))
    const int bx = (int)blockIdx.x;

    PH(0) if (IN(0)) { p0_prologue(F); }
    SEAM(0);
    PH(1) if (IN(1)) {
        pg8::Gemm g{D, D, D, 0}; pg8::StaticOrder S; S.init(WSB(WS_XN), WSB(WS_WIN), D, D, T, NIN, F.G, bx);
        EpiInProj E{WSB(WS_PR), WSB(WS_UG), WSB(WS_GATES), F.in[I_BGATE], 0};
        pg8::gemm_phase<EpiInProj, pg8::StaticOrder, true>(F.lds, g, S, E, F.tid);
        { const int rem = ((T / 256) * (NIN / 256)) % F.G;
          if (rem == 0) p0_late_mats(F, bx * NWAVES + F.wave, F.G * NWAVES); else if (bx >= rem) p0_late_mats(F, (bx - rem) * NWAVES + F.wave, (F.G - rem) * NWAVES); }
    }
    SEAM(1);
    PH(2) if (IN(2)) {
        PrePf pf;
        if (F.vcu < NB * NCH) { rwkv_pre_fetch<2>(F, (((F.vcu >> 6) * NHEAD) << 6) + (F.vcu & 63), true, pf, F.tid); rwkv_pre_put_w(F.lds, pf, F.tid); }
        {
            LAS f32x4* TB = (LAS f32x4*)(F.lds + XTRA_OFF + 4096);
            if (F.tid < NRW / 4) TB[F.tid] = ((const f32x4*)F.in[I_MU])[F.tid];
            const int pq = F.tid >> 7, pi = F.tid & 127;
            const float* psrc = pq == 0 ? F.in[I_W0] : pq == 1 ? F.in[I_A0] : pq == 2 ? F.in[I_KK] : F.in[I_KA];
            TB[NRW / 4 + F.tid] = ((const f32x4*)psrc)[pi];
            if (F.tid < 128) TB[NRW / 4 + 512 + F.tid] = ((const f32x4*)F.in[I_RK])[F.tid];
            BAR_LDS();
        }
        for (int pc = F.vcu; pc < NB * NCH; pc += F.G) {
#pragma unroll 1
            for (int hh = 0; hh < NHEAD; ++hh) { const int bq = pc >> 6, cq = pc & 63, u = ((bq * NHEAD + hh) << 6) + cq;
                const int un = (hh < NHEAD - 1) ? u + 64 : ((pc + F.G < NB * NCH) ? ((((pc + F.G) >> 6) * NHEAD) << 6) + ((pc + F.G) & 63) : NUNIT);
                rwkv_pre_unit(F, u, un, hh == 0, hh == NHEAD - 1, pf); } }
        BAR_LDS();
    }
    SEAM(2);
    PH(3) if (IN(3)) {
        for (int gb = F.vcu; gb < S5G * NB; gb += F.G) {
            pg8::Gemm g{256, UGLD, 256, 0}; S5One S{WSB(WS_UG), WSB(WS_B1A), 256, gb}; EpiSlocLds E{(LAS float*)F.lds, 0};
            int tA = F.tid; asm volatile("" : "+v"(tA));
            pg8::gemm_phase<EpiSlocLds, S5One, true>(F.lds, g, S, E, tA);
            asm volatile("s_waitcnt lgkmcnt(0)" ::: "memory"); __builtin_amdgcn_s_barrier(); asm volatile("" ::: "memory");
            s5_scan_block(F, gb);
            asm volatile("s_waitcnt vmcnt(0)" ::: "memory"); __builtin_amdgcn_s_barrier(); asm volatile("" ::: "memory");
            { pg8::Gemm g2{384, UGLD, 384, 0}; S5One S2{WSB(WS_UG), WSB(WS_B1B), 384, gb}; pg8::EpiGen8<FS5Out> E2{FS5Out{WSB(WS_YSP)}, 0};
              int tB = F.tid; asm volatile("" : "+v"(tB));
              pg8::gemm_phase<pg8::EpiGen8<FS5Out>, S5One, true>(F.lds, g2, S2, E2, tB); } }
        for (int it = F.vcu; it < NB * NHEAD * 4; it += F.G) rwkv_scan_block(F, it);
    }
    SEAM(3);
    PH(4) if (IN(4)) {
        rwkv_out_units(F);
        VM_WAIT(); __syncthreads();
    }
    PH(5) if (IN(5)) {
        pg8::Gemm g{RW, RW, RW, 1}; pg8::StaticOrder S; S.init(WSB(WS_YSP), WSB(WS_WGLU), RW, RW, T, RW, F.G, bx); S.tstepA = (size_t)16 * 256 * 2;
        EpiGlu E{WSB(WS_YSP), (bf16_t*)(F.dout + DO_YRS), F.in[I_BGLU], 0};
        pg8::gemm_phase<EpiGlu, pg8::StaticOrder, true>(F.lds, g, S, E, F.tid);
    }
    SEAM(5);
    PH(6) if (IN(6)) {
        pg8::Gemm g{D, D, D, 0}; pg8::StaticOrder S; S.init((const bf16_t*)(F.dout + DO_YRS), WSB(WS_WBRS), D, D, T, D, F.G, bx);
        EpiMerge E{WSB(WS_GATES), WSB(WS_MERGED), RW / 64};
        pg8::gemm_phase<EpiMerge, pg8::StaticOrder, true>(F.lds, g, S, E, F.tid);
    }
    SEAM(6);
    PH(7) if (IN(7)) {
        pg8::Gemm g{D, D, D, 0}; pg8::StaticOrder S; S.init(WSB(WS_MERGED), WSB(WS_WOUT), D, D, T, D, F.G, bx);
        EpiRowStat E{WSB(WS_MIXED), (float*)(F.ws + WS_STAT1), 0};
        pg8::gemm_phase<EpiRowStat, pg8::StaticOrder, false>(F.lds, g, S, E, F.tid);
    }
    SEAM(7);
    PH(8) if (IN(8)) { p8_rows(F);
        for (size_t i = (size_t)bx * 512 + F.tid; i < HZ_BYTES / 16; i += (size_t)F.G * 512) ((u32x4*)(F.ws + WS_HZ))[i] = (u32x4){0u, 0u, 0u, 0u}; }
    SEAM(8);
    PH(9) if (IN(9)) {
        pg8::Gemm g{D, D, D, 0}; UpOrder S{WSB(WS_H2), WSB(WS_WUP), F.G, bx};
        EpiConvAct E{WSB(WS_ACT), F.in[I_CONVW], F.in[I_CONVB], (LAS unsigned*)(F.lds + XTRA_OFF), (unsigned long long*)(F.ws + WS_HZ), (unsigned*)(F.ctl + 2), 0};
        pg8::gemm_phase<EpiConvAct, UpOrder, true>(F.lds, g, S, E, F.tid);
    }
    SEAM(9);
    PH(10) if (IN(10)) {
        pg8::Gemm g{FF, FF, FF, 0}; pg8::StaticOrder S; S.init(WSB(WS_ACT), WSB(WS_WDN), FF, FF, T, D, F.G, bx);
        EpiRowStat E{WSB(WS_F), (float*)(F.ws + WS_STAT2), 0};
        pg8::gemm_phase<EpiRowStat, pg8::StaticOrder, false>(F.lds, g, S, E, F.tid);
    }
    SEAM(10);
    if (IN(11)) p12_rows(F);
#undef IN
#undef INQ
#undef SEAM
#undef WSB
}

extern "C" void kernel_launch(void* const* d_in, const int* in_sizes, int n_in, void* d_out, int out_size, void* d_ws, size_t ws_size, hipStream_t stream) {
    static int grid = 0;
    if (grid == 0) {
        if (n_in != 35 || in_sizes[0] != T * D || out_size != T * D || ws_size < WS_END) { fprintf(stderr, "kernel_launch: unexpected shapes: n_in %d in0 %d out %d ws %zu (need %zu)\n", n_in, n_in > 0 ? in_sizes[0] : -1, out_size, ws_size, (size_t)WS_END); grid = -1; return; }
        int dev = 0, cus = 0, per_cu = 0;
        if (hipGetDevice(&dev) != hipSuccess || hipDeviceGetAttribute(&cus, hipDeviceAttributeMultiprocessorCount, dev) != hipSuccess) { fprintf(stderr, "kernel_launch: device query failed\n"); grid = -1; return; }
        if (hipFuncSetAttribute((const void*)fwd_kernel, hipFuncAttributeMaxDynamicSharedMemorySize, LDS_BYTES) != hipSuccess) { fprintf(stderr, "kernel_launch: hipFuncSetAttribute failed\n"); grid = -1; return; }
        if (hipOccupancyMaxActiveBlocksPerMultiprocessor(&per_cu, (const void*)fwd_kernel, NWAVES * 64, LDS_BYTES) != hipSuccess || per_cu < 1) fprintf(stderr, "kernel_launch: occupancy query reports %d blocks per CU\n", per_cu);
        (void)hipGetLastError();
        grid = cus;
    }
    if (grid < 0) return;
    if (hipMemsetAsync((char*)d_ws + WS_CTL, 0, CTL_ZERO_BYTES, stream) != hipSuccess) { fprintf(stderr, "kernel_launch: memset failed\n"); return; }
    Args a{};
    for (int i = 0; i < 35; ++i) a.in[i] = (const float*)d_in[i];
    a.out = (float*)d_out; a.ws = (unsigned char*)d_ws;
#if MK_PER_PHASE
    for (int ph = 0; ph < NPHASE; ++ph) { a.ph_lo = ph; a.ph_hi = ph + 1; hipLaunchKernelGGL(fwd_kernel, dim3(grid), dim3(NWAVES * 64), LDS_BYTES, stream, a); }
#else
    a.ph_lo = 0; a.ph_hi = NPHASE;
    hipLaunchKernelGGL(fwd_kernel, dim3(grid), dim3(NWAVES * 64), LDS_BYTES, stream, a);
#endif
    const hipError_t le = hipPeekAtLastError();
    if (le != hipSuccess) fprintf(stderr, "kernel_launch: launch failed: %s\n", hipGetErrorName(le));
}
```
